# Optimizing an MI355X kernel written in HIP

```python
import jax
import jax.numpy as jnp
from jax import lax
import numpy as np

D_MODEL = 1024
BATCH = 8
SEQ = 4096
DEPTH = 1

CHUNK = 64
RET_HEADS = 4
RET_DK = 128
RET_DV = 256
GLA_HEADS = 4
GLA_DK = 128
GLA_DV = 256
GLA_GATE_RANK = 16
GLA_GATE_TAU = 16.0
ROPE_THETA = 10000.0
N_EXPERTS = 256
TOP_K = 8
N_GROUPS = 8
TOPK_GROUPS = 4
D_EXPERT = 256
D_SHARED = 256
ROUTED_SCALE = 2.5
MOE_BLOCK = 128
LN_EPS = 1e-5
NORM_EPS = 1e-6
DN_ALPHA = (2.0 * DEPTH) ** 0.25
DN_BETA = (8.0 * DEPTH) ** -0.25

RET_QK = RET_HEADS * RET_DK
RET_V = RET_HEADS * RET_DV
GLA_QK = GLA_HEADS * GLA_DK
GLA_V = GLA_HEADS * GLA_DV
IN_SPLITS = (RET_QK, RET_QK, RET_V, RET_V, GLA_QK, GLA_QK, GLA_V, GLA_V, GLA_GATE_RANK, 2 * D_MODEL)
D_IN = sum(IN_SPLITS)

kernel_name = 'hybrid_retention_gla_moe_deepnorm'


def _layernorm(x, g, b, out_dtype):
    xf = x.astype(jnp.float32)
    mu = jnp.mean(xf, -1, keepdims=True)
    xc = xf - mu
    var = jnp.mean(xc * xc, -1, keepdims=True)
    return (xc * lax.rsqrt(var + LN_EPS) * g.astype(jnp.float32) + b.astype(jnp.float32)).astype(out_dtype)


def _head_layernorm(y, g, n_heads):
    B, S, W = y.shape
    yh = y.reshape(B, S, n_heads, W // n_heads)
    yc = yh - jnp.mean(yh, -1, keepdims=True)
    var = jnp.mean(yc * yc, -1, keepdims=True)
    return (yc * lax.rsqrt(var + LN_EPS)).reshape(B, S, W) * g.astype(jnp.float32)


def _head_rmsnorm(y, g, n_heads):
    B, S, W = y.shape
    yh = y.reshape(B, S, n_heads, W // n_heads)
    ms = jnp.mean(yh * yh, -1, keepdims=True)
    return (yh * lax.rsqrt(ms + NORM_EPS)).reshape(B, S, W) * g.astype(jnp.float32)


def _rope(t, pos):
    half = t.shape[-1] // 2
    inv = ROPE_THETA ** (-jnp.arange(half, dtype=jnp.float32) / half)
    ang = pos[:, None] * inv[None, :]
    cos = jnp.cos(ang)[None, :, None, :]
    sin = jnp.sin(ang)[None, :, None, :]
    t1, t2 = t[..., :half], t[..., half:]
    return jnp.concatenate([t1 * cos - t2 * sin, t1 * sin + t2 * cos], axis=-1)


def _to_chunks(t):
    B, S, H, d = t.shape
    return t.reshape(B, S // CHUNK, CHUNK, H, d).transpose(1, 0, 3, 2, 4)


def _from_chunks(t):
    N, B, H, C, d = t.shape
    return t.transpose(1, 0, 3, 2, 4).reshape(B, N * C, H * d)


def _retention(q, k, v):
    B, S, H, dk = q.shape
    dv = v.shape[-1]
    h = jnp.arange(H, dtype=jnp.float32)
    log_g = jnp.log1p(-jnp.exp2(-5.0 - h))
    j = jnp.arange(CHUNK, dtype=jnp.float32)
    dist = jnp.abs(j[:, None] - j[None, :])
    intra_decay = jnp.exp(log_g[:, None, None] * dist)
    q_decay = jnp.exp(log_g[:, None] * (j[None, :] + 1.0))
    k_decay = jnp.exp(log_g[:, None] * (CHUNK - 1.0 - j[None, :]))
    chunk_decay = jnp.exp(log_g * CHUNK)
    k = k * (dk ** -0.5)

    def step(state, inp):
        qc, kc, vc = inp
        scores = jnp.einsum('bhjd,bhmd->bhjm', qc, kc) * intra_decay
        o = jnp.einsum('bhjm,bhme->bhje', scores, vc)
        o = o + jnp.einsum('bhjd,bhde->bhje', qc, state) * q_decay[:, :, None]
        state = chunk_decay[:, None, None] * state + jnp.einsum('bhmd,bhme->bhde', kc * k_decay[:, :, None], vc)
        return state, o

    s0 = jnp.zeros((B, H, dk, dv), jnp.float32)
    _, o = lax.scan(step, s0, (_to_chunks(q), _to_chunks(k), _to_chunks(v)))
    return _from_chunks(o)


def _gla(q, k, v, log_a):
    B, S, H, dk = q.shape
    dv = v.shape[-1]
    q = q * (dk ** -0.5)

    def step(state, inp):
        qc, kc, vc, ac = inp
        b = jnp.cumsum(ac, axis=2)
        b_end = b[:, :, -1:, :]
        kt = kc * jnp.exp(b_end - b)
        state = jnp.exp(b_end[:, :, 0, :])[..., None] * state + jnp.einsum('bhmd,bhme->bhde', kt, vc)
        o = jnp.einsum('bhjd,bhde->bhje', qc, state)
        return state, o

    s0 = jnp.zeros((B, H, dk, dv), jnp.float32)
    _, o = lax.scan(step, s0, (_to_chunks(q), _to_chunks(k), _to_chunks(v), _to_chunks(log_a)))
    return _from_chunks(o)


def _moe(x, router_w, router_bias, w_gate, w_up, w_down, sw_gate, sw_up, sw_down):
    B, S, D = x.shape
    T = B * S
    E = N_EXPERTS
    xt = x.reshape(T, D)
    scores = jax.nn.sigmoid(jnp.einsum('td,de->te', xt, router_w).astype(jnp.float32))
    biased = scores + router_bias.astype(jnp.float32)
    grp = biased.reshape(T, N_GROUPS, E // N_GROUPS)
    grp_score = lax.top_k(grp, 2)[0].sum(-1)
    _, grp_idx = lax.top_k(grp_score, TOPK_GROUPS)
    grp_mask = jax.nn.one_hot(grp_idx, N_GROUPS, dtype=jnp.float32).sum(1) > 0
    exp_mask = jnp.repeat(grp_mask, E // N_GROUPS, axis=1)
    _, idx = lax.top_k(jnp.where(exp_mask, biased, -jnp.inf), TOP_K)
    w = jnp.take_along_axis(scores, idx, axis=1)
    w = w / jnp.sum(w, -1, keepdims=True) * ROUTED_SCALE

    TK = T * TOP_K
    flat_e = idx.reshape(TK).astype(jnp.int32)
    flat_tok = jnp.repeat(jnp.arange(T, dtype=jnp.int32), TOP_K)
    flat_w = w.reshape(TK)
    order = jnp.argsort(flat_e)
    sorted_e = flat_e[order]
    counts = jnp.zeros((E,), jnp.int32).at[flat_e].add(1)
    starts = jnp.cumsum(counts) - counts
    padded = (counts + MOE_BLOCK - 1) // MOE_BLOCK * MOE_BLOCK
    pad_ends = jnp.cumsum(padded)
    pad_starts = pad_ends - padded
    dest = pad_starts[sorted_e] + jnp.arange(TK, dtype=jnp.int32) - starts[sorted_e]
    n_blocks = -(-(TK + E * (MOE_BLOCK - 1)) // MOE_BLOCK)
    R = n_blocks * MOE_BLOCK
    row_tok = jnp.full((R,), T, jnp.int32).at[dest].set(flat_tok[order])
    row_w = jnp.zeros((R,), jnp.float32).at[dest].set(flat_w[order])
    block_start = jnp.arange(n_blocks, dtype=jnp.int32) * MOE_BLOCK
    block_e = jnp.minimum(jnp.searchsorted(pad_ends, block_start, side='right'), E - 1).astype(jnp.int32)
    x_pad = jnp.concatenate([xt, jnp.zeros((1, D), xt.dtype)], axis=0)

    def block_fn(args):
        e, tok, wt = args
        xb = x_pad[tok]
        hb = jax.nn.silu(xb @ w_gate[e]) * (xb @ w_up[e])
        return (hb @ w_down[e]) * wt[:, None]

    ys = lax.map(block_fn, (block_e, row_tok.reshape(n_blocks, MOE_BLOCK), row_w.reshape(n_blocks, MOE_BLOCK)))
    routed = jnp.zeros((T + 1, D), ys.dtype).at[row_tok].add(ys.reshape(R, D))[:T]
    shared = (jax.nn.silu(xt @ sw_gate) * (xt @ sw_up)) @ sw_down
    return (routed.astype(x.dtype) + shared).reshape(B, S, D)


def setup_inputs(seed: int = 0) -> dict:
    key = jax.random.key(seed)
    ks = jax.random.split(key, 40)
    f32 = jnp.float32

    def nrm(k, shape, scale):
        return jax.random.normal(k, shape, f32) * scale

    sD = D_MODEL ** -0.5
    in_scales = (sD, sD, sD * DN_BETA, sD, sD, sD, sD * DN_BETA, sD, sD, sD)
    w_in = jnp.concatenate([nrm(ks[1 + i], (DEPTH, D_MODEL, wd), sc) for i, (wd, sc) in enumerate(zip(IN_SPLITS, in_scales))], axis=-1)
    return {
        'x': nrm(ks[0], (BATCH, SEQ, D_MODEL), 1.0),
        'w_in': w_in,
        'ret_norm_g': 1.0 + nrm(ks[11], (DEPTH, RET_V), 0.1),
        'gla_gate_w2': nrm(ks[12], (DEPTH, GLA_GATE_RANK, GLA_QK), GLA_GATE_RANK ** -0.5),
        'gla_gate_b': nrm(ks[13], (DEPTH, GLA_QK), 0.1),
        'gla_norm_g': 1.0 + nrm(ks[14], (DEPTH, GLA_V), 0.1),
        'w_ret_out': nrm(ks[15], (DEPTH, RET_V, D_MODEL), RET_V ** -0.5 * DN_BETA),
        'w_gla_out': nrm(ks[16], (DEPTH, GLA_V, D_MODEL), GLA_V ** -0.5 * DN_BETA),
        'w_o': nrm(ks[17], (DEPTH, D_MODEL, D_MODEL), sD * DN_BETA),
        'ln1_g': 1.0 + nrm(ks[18], (DEPTH, D_MODEL), 0.1),
        'ln1_b': nrm(ks[19], (DEPTH, D_MODEL), 0.02),
        'router_w': nrm(ks[20], (DEPTH, D_MODEL, N_EXPERTS), sD),
        'router_bias': nrm(ks[21], (DEPTH, N_EXPERTS), 0.01),
        'exp_w_gate': nrm(ks[22], (DEPTH, N_EXPERTS, D_MODEL, D_EXPERT), sD),
        'exp_w_up': nrm(ks[23], (DEPTH, N_EXPERTS, D_MODEL, D_EXPERT), sD),
        'exp_w_down': nrm(ks[24], (DEPTH, N_EXPERTS, D_EXPERT, D_MODEL), D_EXPERT ** -0.5 * DN_BETA),
        'shared_w_gate': nrm(ks[25], (DEPTH, D_MODEL, D_SHARED), sD),
        'shared_w_up': nrm(ks[26], (DEPTH, D_MODEL, D_SHARED), sD),
        'shared_w_down': nrm(ks[27], (DEPTH, D_SHARED, D_MODEL), D_SHARED ** -0.5 * DN_BETA),
        'ln2_g': 1.0 + nrm(ks[28], (DEPTH, D_MODEL), 0.1),
        'ln2_b': nrm(ks[29], (DEPTH, D_MODEL), 0.02),
    }


def reference(x, w_in, ret_norm_g, gla_gate_w2, gla_gate_b, gla_norm_g, w_ret_out, w_gla_out, w_o, ln1_g, ln1_b, router_w, router_bias, exp_w_gate, exp_w_up, exp_w_down, shared_w_gate, shared_w_up, shared_w_down, ln2_g, ln2_b):
    dt = x.dtype
    B, S, _ = x.shape
    f32 = jnp.float32
    pos = jnp.arange(S, dtype=f32)
    offsets = np.cumsum(IN_SPLITS)[:-1].tolist()
    for l in range(DEPTH):
        proj = jnp.einsum('bsd,de->bse', x, w_in[l]).astype(f32)
        rq, rk, rv, rg, gq, gk, gv, gg, ga, mg = jnp.split(proj, offsets, axis=-1)
        rq = _rope(rq.reshape(B, S, RET_HEADS, RET_DK), pos)
        rk = _rope(rk.reshape(B, S, RET_HEADS, RET_DK), pos)
        y_ret = _retention(rq, rk, rv.reshape(B, S, RET_HEADS, RET_DV))
        y_ret = _head_layernorm(y_ret, ret_norm_g[l], RET_HEADS) * jax.nn.silu(rg)
        log_a = jax.nn.log_sigmoid(ga @ gla_gate_w2[l].astype(f32) + gla_gate_b[l].astype(f32)) / GLA_GATE_TAU
        y_gla = _gla(gq.reshape(B, S, GLA_HEADS, GLA_DK), gk.reshape(B, S, GLA_HEADS, GLA_DK),
                     gv.reshape(B, S, GLA_HEADS, GLA_DV), log_a.reshape(B, S, GLA_HEADS, GLA_DK))
        y_gla = _head_rmsnorm(y_gla, gla_norm_g[l], GLA_HEADS) * jax.nn.silu(gg)
        u_ret = jnp.einsum('bsv,vd->bsd', y_ret.astype(dt), w_ret_out[l])
        u_gla = jnp.einsum('bsv,vd->bsd', y_gla.astype(dt), w_gla_out[l])
        gate = jax.nn.sigmoid(mg)
        merged = gate[..., :D_MODEL] * u_ret + gate[..., D_MODEL:] * u_gla
        mix = jnp.einsum('bsd,de->bse', merged.astype(dt), w_o[l])
        x = _layernorm(DN_ALPHA * x + mix, ln1_g[l], ln1_b[l], dt)
        ffn = _moe(x, router_w[l], router_bias[l], exp_w_gate[l], exp_w_up[l], exp_w_down[l],
                   shared_w_gate[l], shared_w_up[l], shared_w_down[l])
        x = _layernorm(DN_ALPHA * x + ffn, ln2_g[l], ln2_b[l], dt)
    return x
```

```cpp
#include <hip/hip_runtime.h>
#include <hip/hip_cooperative_groups.h>
#include <cstdio>
#include <cstdint>
namespace cg = cooperative_groups;

typedef unsigned short bf16_t;
typedef short bf16x8 __attribute__((ext_vector_type(8)));
typedef float f32x4 __attribute__((ext_vector_type(4)));
typedef unsigned u32x2 __attribute__((ext_vector_type(2)));
typedef unsigned u32x4 __attribute__((ext_vector_type(4)));
#define DEVI __device__ __forceinline__

constexpr int T_ = 32768;
constexpr int D_ = 1024;
constexpr int DIN_ = 8208;
constexpr int NE_ = 256;
constexpr float ALPHA_ = 1.189207115002721f;
constexpr float KSCALE_ = 0.08838834764831845f;

constexpr size_t MB = 1ull << 20;
constexpr size_t OFF_CS   = 0;
constexpr size_t OFF_WT   = 2 * MB;
constexpr size_t OFF_CNT  = 25 * MB;
constexpr size_t OFF_XB   = 26 * MB;
constexpr size_t OFF_QR   = 90 * MB;
constexpr size_t OFF_KR   = 122 * MB;
constexpr size_t OFF_KRT  = 154 * MB;
constexpr size_t OFF_VRT  = 186 * MB;
constexpr size_t OFF_GS   = 250 * MB;
constexpr size_t OFF_QG   = 378 * MB;
constexpr size_t OFF_KGT  = 410 * MB;
constexpr size_t OFF_VGT  = 442 * MB;
constexpr size_t OFF_GA   = 506 * MB;
constexpr size_t OFF_MG   = 508 * MB;
constexpr size_t OFF_DEC  = 636 * MB;
constexpr size_t OFF_OO   = 638 * MB;
constexpr size_t OFF_Y    = 766 * MB;
constexpr size_t OFF_MRG  = 896 * MB;
constexpr size_t OFF_X1B  = 26 * MB;
constexpr size_t OFF_LIST = 90 * MB;
constexpr size_t OFF_WTS  = 122 * MB;
constexpr size_t OFF_H    = 124 * MB;
constexpr size_t OFF_YX   = 268 * MB;
constexpr size_t OFF_WGU  = 268 * MB;
constexpr size_t OFF_T1   = 536 * MB;
constexpr size_t OFF_LOG  = 600 * MB;
constexpr size_t OFF_WD   = 844 * MB;
constexpr size_t OFF_KG2  = 960 * MB;
constexpr size_t WS_NEEDED = 992 * MB;

constexpr int WT_IN = 0, WT_RET = 8320, WT_GLA = 9344, WT_O = 10368, WT_R = 11392, WT_ROWS = 11648;

struct Params {
    const float *x, *w_in, *ret_norm_g, *gate_w2, *gate_b, *gla_norm_g, *w_ret_out, *w_gla_out, *w_o, *ln1_g, *ln1_b,
                *router_w, *router_bias, *ew_gate, *ew_up, *ew_down, *sw_gate, *sw_up, *sw_down, *ln2_g, *ln2_b;
    float* out;
    unsigned char* ws;
    int phase_lo, phase_hi;
};

static __device__ const float c_inv_freq[64] = {
  1.000000000e+00f, 8.659643531e-01f, 7.498942018e-01f, 6.493816376e-01f,
  5.623413324e-01f, 4.869675338e-01f, 4.216965139e-01f, 3.651741147e-01f,
  3.162277639e-01f, 2.738419771e-01f, 2.371373773e-01f, 2.053525001e-01f,
  1.778279394e-01f, 1.539926529e-01f, 1.333521456e-01f, 1.154781953e-01f,
  1.000000015e-01f, 8.659642935e-02f, 7.498942316e-02f, 6.493816525e-02f,
  5.623413250e-02f, 4.869675264e-02f, 4.216964915e-02f, 3.651741147e-02f,
  3.162277490e-02f, 2.738419548e-02f, 2.371373773e-02f, 2.053525113e-02f,
  1.778279431e-02f, 1.539926510e-02f, 1.333521400e-02f, 1.154781971e-02f,
  9.999999776e-03f, 8.659643121e-03f, 7.498942316e-03f, 6.493816152e-03f,
  5.623413250e-03f, 4.869675264e-03f, 4.216964822e-03f, 3.651741194e-03f,
  3.162277630e-03f, 2.738419687e-03f, 2.371373819e-03f, 2.053525066e-03f,
  1.778279431e-03f, 1.539926510e-03f, 1.333521446e-03f, 1.154782018e-03f,
  1.000000047e-03f, 8.659643354e-04f, 7.498941850e-04f, 6.493816036e-04f,
  5.623413017e-04f, 4.869675322e-04f, 4.216965172e-04f, 3.651741135e-04f,
  3.162277571e-04f, 2.738419571e-04f, 2.371373703e-04f, 2.053525095e-04f,
  1.778279402e-04f, 1.539926598e-04f, 1.333521504e-04f, 1.154782003e-04f };

DEVI float bf2f(unsigned short u) { return __uint_as_float(((unsigned)u) << 16); }
DEVI float bflo(unsigned u) { return __uint_as_float(u << 16); }
DEVI float bfhi(unsigned u) { return __uint_as_float(u & 0xffff0000u); }
typedef float f32x2 __attribute__((ext_vector_type(2)));
typedef __bf16 bf16x2_t __attribute__((ext_vector_type(2)));
DEVI unsigned pk2(float lo, float hi) { const f32x2 v = {lo, hi}; const bf16x2_t b = __builtin_convertvector(v, bf16x2_t); return __builtin_bit_cast(unsigned, b); }
DEVI unsigned short f2bf(float f) { return (unsigned short)(pk2(f, 0.f) & 0xffffu); }
DEVI u32x2 pk4(f32x4 v) { u32x2 r; r.x = pk2(v[0], v[1]); r.y = pk2(v[2], v[3]); return r; }
DEVI f32x4 unpk4(u32x2 u) { f32x4 r; r[0] = bflo(u.x); r[1] = bfhi(u.x); r[2] = bflo(u.y); r[3] = bfhi(u.y); return r; }
DEVI float sigmoidf_(float v) { return 1.0f / (1.0f + __expf(-v)); }
DEVI float siluf_(float v) { return v / (1.0f + __expf(-v)); }
DEVI float gamma_log2(int h) { return log2f(1.0f - exp2f(-5.0f - (float)h)); }
DEVI f32x4 mfma16(bf16x8 a, bf16x8 b, f32x4 c) { return __builtin_amdgcn_mfma_f32_16x16x32_bf16(a, b, c, 0, 0, 0); }
DEVI int vperm(int n) { const int wc = n >> 6, nt = (n >> 4) & 3, i = n & 15; return wc * 64 + (nt >> 1) * 32 + 8 * (i >> 2) + 4 * (nt & 1) + (i & 3); }
DEVI int dperm2(int v) { return ((v >> 5) & 1) * 64 + (v >> 6) * 32 + (v & 31); }
DEVI u32x4 pk8(f32x4 a, f32x4 b) { u32x4 r; r.x = pk2(a[0], a[1]); r.y = pk2(a[2], a[3]); r.z = pk2(b[0], b[1]); r.w = pk2(b[2], b[3]); return r; }
DEVI void unpk8(u32x4 u, f32x4& a, f32x4& b) { a[0] = bflo(u.x); a[1] = bfhi(u.x); a[2] = bflo(u.y); a[3] = bfhi(u.y); b[0] = bflo(u.z); b[1] = bfhi(u.z); b[2] = bflo(u.w); b[3] = bfhi(u.w); }
DEVI int dperm(int v) { const int wc = v >> 6, nt = (v >> 4) & 3, c = v & 15; return (nt & 1) * 16 + wc * 32 + c + (nt >> 1) * 64; }

struct __attribute__((aligned(16))) GemmSmem { bf16_t a[2][128 * 64]; bf16_t b[2][128 * 64]; };
constexpr int SMEM_GEMM = sizeof(GemmSmem);
constexpr int SMEM_BYTES = SMEM_GEMM + 2048 + 16;
DEVI int gemm_src_chunk(int t) { return ((t & 7) ^ ((t >> 4) & 7)) * 8; }

template <bool SWAP, int BKIND>
DEVI void gemm_kloop(f32x4 (&acc)[4][4], const bf16_t* const (&pa)[4], const bf16_t* const (&pb)[4],
                     const float* pbf, int ldb, int nk, GemmSmem& sm) {
    const int t = threadIdx.x, lane = t & 63, w = t >> 6, wr = w >> 1, wc = w & 1, l15 = lane & 15, q = lane >> 4;
    const int kg = t & 7, ng = t >> 3;
    f32x4 rf[8];
#define GEMM_ISSUE(BUF, KO) do { \
        _Pragma("unroll") for (int i = 0; i < 4; ++i) \
            __builtin_amdgcn_global_load_lds((const unsigned*)(pa[i] + (KO)), (unsigned*)((char*)sm.a[BUF] + i * 4096 + t * 16), 16, 0, 0); \
        if (BKIND == 0) { _Pragma("unroll") for (int i = 0; i < 4; ++i) \
            __builtin_amdgcn_global_load_lds((const unsigned*)(pb[i] + (KO)), (unsigned*)((char*)sm.b[BUF] + i * 4096 + t * 16), 16, 0, 0); } \
        else { const float* pp = pbf + (size_t)((KO) + 4 * kg) * ldb; \
            _Pragma("unroll") for (int i = 0; i < 4; ++i) { rf[i] = *(const f32x4*)(pp + (size_t)i * ldb); rf[4 + i] = *(const f32x4*)(pp + (size_t)(32 + i) * ldb); } } } while (0)
#define GEMM_LSTORE_B(BUF) do { if (BKIND == 1) { \
            _Pragma("unroll") for (int i = 0; i < 4; ++i) { \
                u32x2 v0, v1; \
                v0.x = pk2(rf[0][i], rf[1][i]); v0.y = pk2(rf[2][i], rf[3][i]); v1.x = pk2(rf[4][i], rf[5][i]); v1.y = pk2(rf[6][i], rf[7][i]); \
                const int n = 4 * ng + i, sw = (n >> 1) & 7; \
                char* rowp = (char*)sm.b[BUF] + n * 128 + (kg & 1) * 8; \
                *(u32x2*)(rowp + (((kg >> 1) ^ sw) * 16)) = v0; *(u32x2*)(rowp + (((4 + (kg >> 1)) ^ sw) * 16)) = v1; } } } while (0)
    GEMM_ISSUE(0, 0);
    GEMM_LSTORE_B(0);
    __syncthreads();
#define GEMM_KSTEP(CUR, KT) do { \
        const bool more = ((KT) + 1 < nk); \
        if (more) { GEMM_ISSUE((CUR) ^ 1, ((KT) + 1) * 64); } \
        __builtin_amdgcn_sched_barrier(0); \
        _Pragma("unroll") for (int ss = 0; ss < 2; ++ss) { \
            bf16x8 af[4], bfr[4]; \
            const int coff = ((ss * 4 + q) ^ (l15 >> 1)) * 16; \
            _Pragma("unroll") for (int i = 0; i < 4; ++i) { \
                af[i]  = *(const bf16x8*)((const char*)sm.a[CUR] + (wr * 64 + i * 16 + l15) * 128 + coff); \
                bfr[i] = *(const bf16x8*)((const char*)sm.b[CUR] + (wc * 64 + i * 16 + l15) * 128 + coff); } \
            _Pragma("unroll") for (int mt = 0; mt < 4; ++mt) \
                _Pragma("unroll") for (int nt = 0; nt < 4; ++nt) \
                    acc[mt][nt] = SWAP ? mfma16(bfr[nt], af[mt], acc[mt][nt]) : mfma16(af[mt], bfr[nt], acc[mt][nt]); } \
        __builtin_amdgcn_sched_barrier(0); \
        if (more) { GEMM_LSTORE_B((CUR) ^ 1); } \
        __syncthreads(); } while (0)
#pragma unroll 1
    for (int kt = 0; kt < nk; kt += 2) { GEMM_KSTEP(0, kt); GEMM_KSTEP(1, kt + 1); }
#undef GEMM_KSTEP
#undef GEMM_LSTORE_B
#undef GEMM_ISSUE
}

DEVI void zero_acc(f32x4 (&acc)[4][4]) {
#pragma unroll
    for (int i = 0; i < 4; ++i)
#pragma unroll
        for (int j = 0; j < 4; ++j) acc[i][j] = (f32x4){0.f, 0.f, 0.f, 0.f};
}

DEVI void wt_colinfo(const Params& p, int R, const float*& src, int& ld, float& scale) {
    scale = 1.0f; src = nullptr; ld = 0;
    if (R < WT_RET) {
        const int tile = R >> 7, n = R & 127; ld = DIN_;
        const bool normal = (tile >= 4 && tile < 16) || (tile >= 28 && tile < 40);
        const int v = normal ? n : vperm(n);
        if (tile < 48) {
            const int col = tile * 128 + (tile < 4 ? dperm2(v) : (tile < 8 ? dperm(v) : v));
            src = p.w_in + col;
            if ((tile >= 4 && tile < 8) || (tile >= 24 && tile < 28)) scale = KSCALE_;
        } else if (tile == 48) { if (v < 16) src = p.w_in + 6144 + v; }
        else src = p.w_in + 6160 + (tile - 49) * 128 + v;
    } else {
        int Rr, ldd; const float* base;
        if (R < WT_GLA)    { Rr = R - WT_RET; base = p.w_ret_out; ldd = 1024; }
        else if (R < WT_O) { Rr = R - WT_GLA; base = p.w_gla_out; ldd = 1024; }
        else if (R < WT_R) { Rr = R - WT_O;   base = p.w_o;       ldd = 1024; }
        else               { Rr = R - WT_R;   base = p.router_w;  ldd = 256; }
        src = base + (Rr & ~127) + vperm(Rr & 127); ld = ldd;
    }
}

DEVI void phase0(const Params& p, unsigned char* smem) {
    const int tid = threadIdx.x, nb = gridDim.x, bid = blockIdx.x;
    float2* cs = (float2*)(p.ws + OFF_CS);
    for (int i = bid * 256 + tid; i < 4096 * 64; i += nb * 256) {
        const int pos = i >> 6, k = i & 63;
        const float angf = (float)pos * c_inv_freq[k];
        const double a = (double)angf;
        const double TWO_PI = 6.283185307179586476925286766559, HALF_PI = 1.5707963267948966192313216916398;
        const double kk = rint(a * (1.0 / TWO_PI));
        const double r = a - kk * TWO_PI;
        const double qd = rint(r * (1.0 / HALF_PI));
        const double y = r - qd * HALF_PI;
        const double y2 = y * y;
        double sn = y * (1.0 + y2 * (-1.0 / 6 + y2 * (1.0 / 120 + y2 * (-1.0 / 5040 + y2 * (1.0 / 362880 + y2 * (-1.0 / 39916800 + y2 * (1.0 / 6227020800.0)))))));
        double cn = 1.0 + y2 * (-0.5 + y2 * (1.0 / 24 + y2 * (-1.0 / 720 + y2 * (1.0 / 40320 + y2 * (-1.0 / 3628800 + y2 * (1.0 / 479001600.0))))));
        const int qi = ((int)qd) & 3;
        double s, c;
        if (qi == 0) { s = sn; c = cn; } else if (qi == 1) { s = cn; c = -sn; } else if (qi == 2) { s = -sn; c = -cn; } else { s = -cn; c = sn; }
        cs[i] = make_float2((float)c, (float)s);
    }
    if (bid == 0) { int* cnt = (int*)(p.ws + OFF_CNT); for (int i = tid; i < 512; i += 256) cnt[i] = 0; }
    {
        const f32x4* xs = (const f32x4*)p.x; u32x4* xd = (u32x4*)(p.ws + OFF_XB);
        const int n8 = T_ * D_ / 8;
        for (int g = bid * 256 + tid; g < n8; g += nb * 256) {
            const f32x4 v0 = xs[2 * g], v1 = xs[2 * g + 1];
            u32x4 o; o.x = pk2(v0[0], v0[1]); o.y = pk2(v0[2], v0[3]); o.z = pk2(v1[0], v1[1]); o.w = pk2(v1[2], v1[3]);
            xd[g] = o;
        }
    }
    {
        float* tile = (float*)smem;
        bf16_t* wt = (bf16_t*)(p.ws + OFF_WT);
        const int ntask = (WT_ROWS / 64) * 16;
        for (int task = bid; task < ntask; task += nb) {
            const int rt = task >> 4, kt = task & 15, R0 = rt * 64, k0 = kt * 64;
            {
                const int n = tid & 63, kq = tid >> 6;
                const float* src; int ld; float sc; wt_colinfo(p, R0 + n, src, ld, sc);
#pragma unroll
                for (int i = 0; i < 16; ++i) { const int k = kq + 4 * i; tile[k * 65 + n] = src ? src[(size_t)(k0 + k) * ld] * sc : 0.f; }
            }
            __syncthreads();
            {
                const int n = tid >> 2, ks = (tid & 3) * 16;
                unsigned o[8];
#pragma unroll
                for (int j = 0; j < 8; ++j) o[j] = pk2(tile[(ks + 2 * j) * 65 + n], tile[(ks + 2 * j + 1) * 65 + n]);
                u32x4* dst = (u32x4*)(wt + (size_t)(R0 + n) * 1024 + k0 + ks);
                dst[0] = (u32x4){o[0], o[1], o[2], o[3]}; dst[1] = (u32x4){o[4], o[5], o[6], o[7]};
            }
            __syncthreads();
        }
    }
}

template <int DUMMY>
DEVI void phase1(const Params& p, unsigned char* smem) {
    GemmSmem& sm = *(GemmSmem*)smem;
    const int t = threadIdx.x, lane = t & 63, w = t >> 6, wr = w >> 1, wc = w & 1, l15 = lane & 15, q = lane >> 4;
    const bf16_t* xb = (const bf16_t*)(p.ws + OFF_XB);
    const bf16_t* wt = (const bf16_t*)(p.ws + OFF_WT);
    const float2* cs = (const float2*)(p.ws + OFF_CS);
    bf16_t* Qr = (bf16_t*)(p.ws + OFF_QR); bf16_t* Kr = (bf16_t*)(p.ws + OFF_KR); bf16_t* Krt = (bf16_t*)(p.ws + OFF_KRT);
    bf16_t* Vrt = (bf16_t*)(p.ws + OFF_VRT); bf16_t* Gs = (bf16_t*)(p.ws + OFF_GS); bf16_t* Qg = (bf16_t*)(p.ws + OFF_QG);
    bf16_t* Kgt = (bf16_t*)(p.ws + OFF_KGT); bf16_t* Vgt = (bf16_t*)(p.ws + OFF_VGT); float* Ga = (float*)(p.ws + OFF_GA);
    bf16_t* Mg = (bf16_t*)(p.ws + OFF_MG);
    const int xg = blockIdx.x & 7, jl = blockIdx.x >> 3, nloc = gridDim.x >> 3, SM = nloc >> 3, nrg = 32 / SM;
    for (int it = 0; it < 8 * nrg + 1; ++it) {
        int mtg, ntg;
        if (it < 8 * nrg) { const int ng = it / nrg, rg = it - ng * nrg; mtg = 32 * xg + rg * SM + (jl >> 3); ntg = ng * 8 + (jl & 7); }
        else { if (jl >= 32) break; mtg = 32 * xg + jl; ntg = 64; }
        const int m0 = mtg * 128;
        const bool normal = (ntg >= 4 && ntg < 16) || (ntg >= 28 && ntg < 40);
        const bf16_t* pb0 = wt + (size_t)(WT_IN + (DUMMY >= 1 ? 0 : ntg) * 128 + (t >> 3)) * 1024 + gemm_src_chunk(t);
        const bf16_t* const pb[4] = {pb0, pb0 + 32 * 1024, pb0 + 64 * 1024, pb0 + 96 * 1024};
        const bf16_t* pa[4];
#pragma unroll
        for (int i = 0; i < 4; ++i) {
            const int n = (t >> 3) + 32 * i;
            pa[i] = xb + (size_t)((DUMMY >= 1 ? 0 : m0) + (normal ? vperm(n) : n)) * 1024 + gemm_src_chunk(t);
        }
        f32x4 acc[4][4]; zero_acc(acc);
        if (DUMMY == 2) {
            gemm_kloop<true, 0>(acc, pa, pb, nullptr, 0, 16, sm);
#pragma unroll
            for (int mt = 0; mt < 4; ++mt)
#pragma unroll
                for (int nt = 0; nt < 4; ++nt) asm volatile("" :: "v"(acc[mt][nt]));
        } else if (normal) {
            gemm_kloop<false, 0>(acc, pa, pb, nullptr, 0, 16, sm);
            const int trow0 = m0 + wr * 64;
            const int bb = trow0 >> 12, cc = (trow0 >> 6) & 63;
            if (ntg < 8) {
                const int h = ntg - 4; const float lg = gamma_log2(h);
                const size_t tb = ((size_t)((bb * 64 + cc) * 4 + h) * 128) * 64;
#pragma unroll
                for (int pm = 0; pm < 2; ++pm) {
                    const int m8 = pm * 32 + 8 * q;
#pragma unroll
                    for (int nt = 0; nt < 2; ++nt) {
                        const int i = nt * 16 + wc * 32 + l15;
                        f32x4 t1[2], t2[2];
#pragma unroll
                        for (int hh = 0; hh < 2; ++hh)
#pragma unroll
                            for (int r = 0; r < 4; ++r) {
                                const int m = m8 + 4 * hh + r; const int row = trow0 + m; const int pos = row & 4095;
                                const float2 c_s = cs[pos * 64 + i];
                                const float x1 = acc[2 * pm + hh][nt][r], x2 = acc[2 * pm + hh][nt + 2][r];
                                const float o1 = x1 * c_s.x - x2 * c_s.y, o2 = x1 * c_s.y + x2 * c_s.x;
                                Kr[(size_t)row * 512 + h * 128 + i] = f2bf(o1);
                                Kr[(size_t)row * 512 + h * 128 + 64 + i] = f2bf(o2);
                                const float kd = exp2f(lg * (float)(63 - m));
                                t1[hh][r] = o1 * kd; t2[hh][r] = o2 * kd;
                            }
                        *(u32x4*)(Krt + tb + (size_t)i * 64 + m8) = pk8(t1[0], t1[1]);
                        *(u32x4*)(Krt + tb + (size_t)(i + 64) * 64 + m8) = pk8(t2[0], t2[1]);
                    }
                }
            } else {
                bf16_t* dst; int h, d0, hd;
                if (ntg < 16)      { dst = Vrt; h = (ntg - 8) >> 1;  d0 = ((ntg - 8) & 1) * 128;  hd = 256; }
                else if (ntg < 32) { dst = Kgt; h = ntg - 28;        d0 = 0;                      hd = 128; }
                else               { dst = Vgt; h = (ntg - 32) >> 1; d0 = ((ntg - 32) & 1) * 128; hd = 256; }
                const size_t tb = ((size_t)((bb * 64 + cc) * 4 + h) * hd) * 64;
#pragma unroll
                for (int pm = 0; pm < 2; ++pm)
#pragma unroll
                    for (int nt = 0; nt < 4; ++nt) {
                        const int d = d0 + wc * 64 + nt * 16 + l15, m8 = pm * 32 + 8 * q;
                        *(u32x4*)(dst + tb + (size_t)d * 64 + m8) = pk8(acc[2 * pm][nt], acc[2 * pm + 1][nt]);
                    }
            }
        } else {
            gemm_kloop<true, 0>(acc, pa, pb, nullptr, 0, 16, sm);
            if (ntg < 4) {
                const int h = ntg, d0 = wc * 32 + 8 * q;
                f32x4 cst[4][4];
#pragma unroll
                for (int mt = 0; mt < 4; ++mt) {
                    const int pos = (m0 + wr * 64 + mt * 16 + l15) & 4095;
#pragma unroll
                    for (int j = 0; j < 4; ++j) cst[mt][j] = *(const f32x4*)(cs + pos * 64 + d0 + 2 * j);
                }
#pragma unroll
                for (int mt = 0; mt < 4; ++mt) {
                    const int row = m0 + wr * 64 + mt * 16 + l15;
                    f32x4 o1[2], o2[2];
#pragma unroll
                    for (int hh = 0; hh < 2; ++hh)
#pragma unroll
                        for (int r = 0; r < 4; ++r) {
                            const f32x4 c4 = cst[mt][2 * hh + (r >> 1)];
                            const float c_ = c4[(r & 1) * 2], s_ = c4[(r & 1) * 2 + 1];
                            const float x1 = acc[mt][hh][r], x2 = acc[mt][2 + hh][r];
                            o1[hh][r] = x1 * c_ - x2 * s_; o2[hh][r] = x1 * s_ + x2 * c_;
                        }
                    *(u32x4*)(Qr + (size_t)row * 512 + h * 128 + d0) = pk8(o1[0], o1[1]);
                    *(u32x4*)(Qr + (size_t)row * 512 + h * 128 + 64 + d0) = pk8(o2[0], o2[1]);
                }
            } else {
#pragma unroll
                for (int mt = 0; mt < 4; ++mt) {
                    const int row = m0 + wr * 64 + mt * 16 + l15;
#pragma unroll
                    for (int pp = 0; pp < 2; ++pp) {
                        const int colv = wc * 64 + pp * 32 + 8 * q;
                        f32x4 v0 = acc[mt][2 * pp], v1 = acc[mt][2 * pp + 1];
                        if (ntg >= 16 && ntg < 24) {
#pragma unroll
                            for (int r = 0; r < 4; ++r) { v0[r] = siluf_(v0[r]); v1[r] = siluf_(v1[r]); }
                            *(u32x4*)(Gs + (size_t)row * 2048 + (ntg - 16) * 128 + colv) = pk8(v0, v1);
                        } else if (ntg >= 24 && ntg < 28) {
                            *(u32x4*)(Qg + (size_t)row * 512 + (ntg - 24) * 128 + colv) = pk8(v0, v1);
                        } else if (ntg >= 40 && ntg < 48) {
#pragma unroll
                            for (int r = 0; r < 4; ++r) { v0[r] = siluf_(v0[r]); v1[r] = siluf_(v1[r]); }
                            *(u32x4*)(Gs + (size_t)row * 2048 + 1024 + (ntg - 40) * 128 + colv) = pk8(v0, v1);
                        } else if (ntg == 48) {
                            if (wc == 0 && pp == 0 && q < 2) { *(f32x4*)(Ga + (size_t)row * 16 + 8 * q) = v0; *(f32x4*)(Ga + (size_t)row * 16 + 8 * q + 4) = v1; }
                        } else {
#pragma unroll
                            for (int r = 0; r < 4; ++r) { v0[r] = sigmoidf_(v0[r]); v1[r] = sigmoidf_(v1[r]); }
                            *(u32x4*)(Mg + (size_t)row * 2048 + (ntg - 49) * 128 + colv) = pk8(v0, v1);
                        }
                    }
                }
            }
        }
    }
}

DEVI void phase2(const Params& p, unsigned char* smem) {
    float* ga_s = (float*)smem;
    float* tot = (float*)(smem + 4096);
    const int tid = threadIdx.x;
    const float* Ga = (const float*)(p.ws + OFF_GA);
    const bf16_t* Kgt = (const bf16_t*)(p.ws + OFF_KGT); bf16_t* Kg2 = (bf16_t*)(p.ws + OFF_KG2);
    float* dec = (float*)(p.ws + OFF_DEC);
    for (int it = blockIdx.x; it < 2048; it += gridDim.x) {
        const int h = it & 3, c = (it >> 2) & 63, b = it >> 8;
        const int tok0 = b * 4096 + c * 64;
        ((f32x4*)ga_s)[tid] = ((const f32x4*)(Ga + (size_t)tok0 * 16))[tid];
        const int dk = tid & 127, half = tid >> 7;
        float w2[16];
#pragma unroll
        for (int r = 0; r < 16; ++r) w2[r] = p.gate_w2[r * 512 + h * 128 + dk];
        const float bias = p.gate_b[h * 128 + dk];
        __syncthreads();
        float run = 0.f; float bc[32];
#pragma unroll
        for (int ml = 0; ml < 32; ++ml) {
            const int m = half * 32 + ml;
            float z = bias;
#pragma unroll
            for (int r4 = 0; r4 < 4; ++r4) { const f32x4 g4 = *(const f32x4*)&ga_s[m * 16 + 4 * r4];
                z += g4[0] * w2[4 * r4] + g4[1] * w2[4 * r4 + 1] + g4[2] * w2[4 * r4 + 2] + g4[3] * w2[4 * r4 + 3]; }
            const float la = (fminf(z, 0.f) - __logf(1.0f + __expf(-fabsf(z)))) * (1.0f / 16.0f);
            run += la; bc[ml] = run;
        }
        tot[half * 128 + dk] = run;
        __syncthreads();
        const float t0 = tot[dk], t1 = tot[128 + dk];
        const float bend = t0 + t1, off = half ? t0 : 0.f;
        const u32x4* kp = (const u32x4*)(Kgt + ((size_t)it * 128 + dk) * 64 + half * 32);
        u32x4* kq = (u32x4*)(Kg2 + ((size_t)it * 128 + dk) * 64 + half * 32);
#pragma unroll
        for (int j = 0; j < 4; ++j) {
            u32x4 v = kp[j];
            unsigned uu[4] = {v.x, v.y, v.z, v.w};
#pragma unroll
            for (int e = 0; e < 4; ++e) {
                const float f0 = bflo(uu[e]) * __expf(bend - (bc[8 * j + 2 * e] + off));
                const float f1 = bfhi(uu[e]) * __expf(bend - (bc[8 * j + 2 * e + 1] + off));
                uu[e] = pk2(f0, f1);
            }
            kq[j] = (u32x4){uu[0], uu[1], uu[2], uu[3]};
        }
        if (half == 0) dec[(size_t)it * 128 + dk] = __expf(bend);
        __syncthreads();
    }
}

constexpr int ST_LD = 136;
template <bool GLA, int DUMMY>
DEVI void scan_item(const Params& p, bf16_t* St, int b, int h, int s) {
    const int t = threadIdx.x, lane = t & 63, w = t >> 6, l15 = lane & 15, q = lane >> 4;
    const bf16_t* Ktb = (const bf16_t*)(p.ws + (GLA ? OFF_KG2 : OFF_KRT));
    const bf16_t* Vtb = (const bf16_t*)(p.ws + (GLA ? OFF_VGT : OFF_VRT));
    const bf16_t* Qb  = (const bf16_t*)(p.ws + (GLA ? OFF_QG : OFF_QR));
    const float* dec = (const float*)(p.ws + OFF_DEC);
    bf16_t* Oo = (bf16_t*)(p.ws + OFF_OO);
    const float lg = gamma_log2(h);
    const float cd = exp2f(lg * 64.0f);
    const float qdec = exp2f(lg * (float)(16 * w + l15 + 1));
    f32x4 S[2][2];
#pragma unroll
    for (int i = 0; i < 2; ++i)
#pragma unroll
        for (int j = 0; j < 2; ++j) S[i][j] = (f32x4){0.f, 0.f, 0.f, 0.f};
    if (!GLA) {
        for (int i = t; i < 32 * ST_LD / 2; i += 256) ((unsigned*)St)[i] = 0u;
        __syncthreads();
    }
    bf16x8 an[2][2], bn[2][2], qn[4]; f32x4 dn[2];
    auto issue = [&](int c_) {
        const int c = (DUMMY == 1) ? 0 : c_;
        const size_t it = (size_t)((b * 64 + c) * 4 + h);
        const bf16_t* kt = Ktb + it * 128 * 64; const bf16_t* vt = Vtb + it * 256 * 64;
#pragma unroll
        for (int mt = 0; mt < 2; ++mt)
#pragma unroll
            for (int ks = 0; ks < 2; ++ks) an[mt][ks] = *(const bf16x8*)(kt + (size_t)(32 * w + 16 * mt + l15) * 64 + ks * 32 + q * 8);
#pragma unroll
        for (int nt = 0; nt < 2; ++nt)
#pragma unroll
            for (int ks = 0; ks < 2; ++ks) bn[nt][ks] = *(const bf16x8*)(vt + (size_t)(s * 32 + 16 * nt + l15) * 64 + ks * 32 + q * 8);
        const size_t tok = (size_t)b * 4096 + c * 64 + 16 * w + l15;
#pragma unroll
        for (int ks = 0; ks < 4; ++ks) qn[ks] = *(const bf16x8*)(Qb + tok * 512 + h * 128 + ks * 32 + q * 8);
        if (GLA) {
#pragma unroll
            for (int mt = 0; mt < 2; ++mt) dn[mt] = *(const f32x4*)(dec + it * 128 + 32 * w + 16 * mt + 4 * q);
        }
    };
    issue(0);
    for (int c = 0; c < 64; ++c) {
        bf16x8 a[2][2], bv[2][2], qf[4]; f32x4 d[2];
#pragma unroll
        for (int i = 0; i < 2; ++i)
#pragma unroll
            for (int j = 0; j < 2; ++j) { a[i][j] = an[i][j]; bv[i][j] = bn[i][j]; }
#pragma unroll
        for (int i = 0; i < 4; ++i) qf[i] = qn[i];
        d[0] = dn[0]; d[1] = dn[1];
        if (c + 1 < 64) issue(c + 1);
        const size_t tok = (size_t)b * 4096 + c * 64 + 16 * w + l15;
        bf16_t* op = Oo + tok * 2048 + (GLA ? 1024 : 0) + h * 256 + s * 32 + 4 * q;
        if (!GLA) {
            f32x4 O[2] = {(f32x4){0.f, 0.f, 0.f, 0.f}, (f32x4){0.f, 0.f, 0.f, 0.f}};
#pragma unroll
            for (int ks = 0; ks < 4; ++ks)
#pragma unroll
                for (int nt = 0; nt < 2; ++nt) {
                    const bf16x8 sf = *(const bf16x8*)&St[(16 * nt + l15) * ST_LD + ks * 32 + q * 8];
                    O[nt] = mfma16(sf, qf[ks], O[nt]);
                }
#pragma unroll
            for (int nt = 0; nt < 2; ++nt) { f32x4 o = O[nt] * qdec; if (DUMMY != 2) *(u32x2*)(op + 16 * nt) = pk4(o); else asm volatile("" :: "v"(o)); }
#pragma unroll
            for (int mt = 0; mt < 2; ++mt)
#pragma unroll
                for (int nt = 0; nt < 2; ++nt) {
                    f32x4 sv = S[mt][nt] * cd;
                    sv = mfma16(a[mt][0], bv[nt][0], sv);
                    sv = mfma16(a[mt][1], bv[nt][1], sv);
                    S[mt][nt] = sv;
                }
            __syncthreads();
#pragma unroll
            for (int mt = 0; mt < 2; ++mt)
#pragma unroll
                for (int nt = 0; nt < 2; ++nt) *(u32x2*)&St[(16 * nt + l15) * ST_LD + 32 * w + 16 * mt + 4 * q] = pk4(S[mt][nt]);
            __syncthreads();
        } else {
#pragma unroll
            for (int mt = 0; mt < 2; ++mt)
#pragma unroll
                for (int nt = 0; nt < 2; ++nt) {
                    f32x4 sv = S[mt][nt] * d[mt];
                    sv = mfma16(a[mt][0], bv[nt][0], sv);
                    sv = mfma16(a[mt][1], bv[nt][1], sv);
                    S[mt][nt] = sv;
                }
            __syncthreads();
#pragma unroll
            for (int mt = 0; mt < 2; ++mt)
#pragma unroll
                for (int nt = 0; nt < 2; ++nt) *(u32x2*)&St[(16 * nt + l15) * ST_LD + 32 * w + 16 * mt + 4 * q] = pk4(S[mt][nt]);
            __syncthreads();
            f32x4 O[2] = {(f32x4){0.f, 0.f, 0.f, 0.f}, (f32x4){0.f, 0.f, 0.f, 0.f}};
#pragma unroll
            for (int ks = 0; ks < 4; ++ks)
#pragma unroll
                for (int nt = 0; nt < 2; ++nt) {
                    const bf16x8 sf = *(const bf16x8*)&St[(16 * nt + l15) * ST_LD + ks * 32 + q * 8];
                    O[nt] = mfma16(sf, qf[ks], O[nt]);
                }
#pragma unroll
            for (int nt = 0; nt < 2; ++nt) { if (DUMMY != 2) *(u32x2*)(op + 16 * nt) = pk4(O[nt]); else asm volatile("" :: "v"(O[nt])); }
        }
    }
    __syncthreads();
}

template <int DUMMY>
DEVI void phase3(const Params& p, unsigned char* smem) {
    bf16_t* St = (bf16_t*)smem;
    for (int it0 = blockIdx.x; it0 < 512; it0 += gridDim.x) {
        const int it = ((it0 & 7) * 8 + ((it0 >> 3) & 63) / 8) * 8 + ((it0 >> 3) & 7);
        const int s = it & 7, h = (it >> 3) & 3, b = (it >> 5) & 7, br = it >> 8;
        if (br == 0) scan_item<false, DUMMY>(p, St, b, h, s); else scan_item<true, DUMMY>(p, St, b, h, s);
    }
}

constexpr int PS_LD = 72;
DEVI void phase4(const Params& p, unsigned char* smem) {
    const int t = threadIdx.x, lane = t & 63, w = t >> 6, l15 = lane & 15, q = lane >> 4;
    bf16_t* Ps = (bf16_t*)smem + w * 16 * PS_LD;
    const bf16_t* Qr = (const bf16_t*)(p.ws + OFF_QR); const bf16_t* Kr = (const bf16_t*)(p.ws + OFF_KR);
    const bf16_t* Vrt = (const bf16_t*)(p.ws + OFF_VRT); const bf16_t* Oo = (const bf16_t*)(p.ws + OFF_OO);
    const bf16_t* Gs = (const bf16_t*)(p.ws + OFF_GS); bf16_t* Y = (bf16_t*)(p.ws + OFF_Y);
    for (int it = blockIdx.x; it < 4096; it += gridDim.x) {
        const int br = it >> 11, idx = it & 2047;
        const int h = idx & 3, c = (idx >> 2) & 63, b = idx >> 8;
        const size_t tok0 = (size_t)b * 4096 + c * 64;
        const size_t tok = tok0 + 16 * w + l15;
        f32x4 O[16];
        const bf16_t* orow = Oo + tok * 2048 + br * 1024 + h * 256 + 4 * q;
        const bf16_t* grow = Gs + tok * 2048 + br * 1024 + h * 256 + 4 * q;
        u32x2 oraw[16], graw[16];
        if (br == 0) {
            const float lg = gamma_log2(h);
            const bf16_t* vt = Vrt + (size_t)idx * 256 * 64;
            bf16x8 vf[8][2];
#pragma unroll
            for (int nt = 0; nt < 8; ++nt) { vf[nt][0] = *(const bf16x8*)(vt + (size_t)(16 * nt + l15) * 64 + q * 8); vf[nt][1] = *(const bf16x8*)(vt + (size_t)(16 * nt + l15) * 64 + 32 + q * 8); }
            __builtin_amdgcn_sched_barrier(0);
            f32x4 P[4] = {(f32x4){0.f, 0.f, 0.f, 0.f}, (f32x4){0.f, 0.f, 0.f, 0.f}, (f32x4){0.f, 0.f, 0.f, 0.f}, (f32x4){0.f, 0.f, 0.f, 0.f}};
#pragma unroll
            for (int ks = 0; ks < 4; ++ks) {
                const bf16x8 qf = *(const bf16x8*)(Qr + tok * 512 + h * 128 + ks * 32 + q * 8);
#pragma unroll
                for (int mt = 0; mt < 4; ++mt) {
                    const bf16x8 kf = *(const bf16x8*)(Kr + (tok0 + 16 * mt + l15) * 512 + h * 128 + ks * 32 + q * 8);
                    P[mt] = mfma16(kf, qf, P[mt]);
                }
            }
            const int j = 16 * w + l15;
#pragma unroll
            for (int mt = 0; mt < 4; ++mt) {
                f32x4 v = P[mt];
#pragma unroll
                for (int r = 0; r < 4; ++r) { const int m = 16 * mt + 4 * q + r; const int dd = j > m ? j - m : m - j; v[r] *= exp2f(lg * (float)dd); }
                *(u32x2*)&Ps[l15 * PS_LD + 16 * mt + 4 * q] = pk4(v);
            }
            __syncthreads();
            const bf16x8 pf0 = *(const bf16x8*)&Ps[l15 * PS_LD + q * 8];
            const bf16x8 pf1 = *(const bf16x8*)&Ps[l15 * PS_LD + 32 + q * 8];
            __builtin_amdgcn_sched_barrier(0);
#pragma unroll
            for (int nt = 0; nt < 8; ++nt) {
                f32x4 o = (f32x4){0.f, 0.f, 0.f, 0.f};
                o = mfma16(vf[nt][0], pf0, o); O[nt] = mfma16(vf[nt][1], pf1, o);
            }
            __builtin_amdgcn_sched_barrier(0);
#pragma unroll
            for (int nt = 0; nt < 8; ++nt) { vf[nt][0] = *(const bf16x8*)(vt + (size_t)(16 * (8 + nt) + l15) * 64 + q * 8); vf[nt][1] = *(const bf16x8*)(vt + (size_t)(16 * (8 + nt) + l15) * 64 + 32 + q * 8); }
#pragma unroll
            for (int nt = 0; nt < 16; ++nt) { oraw[nt] = *(const u32x2*)(orow + 16 * nt); graw[nt] = *(const u32x2*)(grow + 16 * nt); }
            __builtin_amdgcn_sched_barrier(0);
#pragma unroll
            for (int nt = 0; nt < 8; ++nt) {
                f32x4 o = (f32x4){0.f, 0.f, 0.f, 0.f};
                o = mfma16(vf[nt][0], pf0, o); O[8 + nt] = mfma16(vf[nt][1], pf1, o);
            }
#pragma unroll
            for (int nt = 0; nt < 16; ++nt) O[nt] += unpk4(oraw[nt]);
            __syncthreads();
        } else {
#pragma unroll
            for (int nt = 0; nt < 16; ++nt) { oraw[nt] = *(const u32x2*)(orow + 16 * nt); graw[nt] = *(const u32x2*)(grow + 16 * nt); }
#pragma unroll
            for (int nt = 0; nt < 16; ++nt) O[nt] = unpk4(oraw[nt]);
        }
        float s1 = 0.f;
#pragma unroll
        for (int nt = 0; nt < 16; ++nt) s1 += (O[nt][0] + O[nt][1]) + (O[nt][2] + O[nt][3]);
        s1 += __shfl_xor(s1, 16); s1 += __shfl_xor(s1, 32);
        const float mean = (br == 0) ? s1 * (1.0f / 256.0f) : 0.f;
        float s2 = 0.f;
#pragma unroll
        for (int nt = 0; nt < 16; ++nt) {
#pragma unroll
            for (int r = 0; r < 4; ++r) { const float dlt = O[nt][r] - mean; s2 += dlt * dlt; }
        }
        s2 += __shfl_xor(s2, 16); s2 += __shfl_xor(s2, 32);
        const float rstd = rsqrtf(s2 * (1.0f / 256.0f) + (br == 0 ? 1e-5f : 1e-6f));
        const float* gw = (br == 0 ? p.ret_norm_g : p.gla_norm_g) + h * 256 + 4 * q;
        bf16_t* yrow = Y + tok * 2048 + br * 1024 + h * 256 + 4 * q;
#pragma unroll
        for (int nt = 0; nt < 16; ++nt) {
            const f32x4 g = *(const f32x4*)(gw + 16 * nt);
            const f32x4 gate = unpk4(graw[nt]);
            f32x4 y;
#pragma unroll
            for (int r = 0; r < 4; ++r) y[r] = (O[nt][r] - mean) * rstd * g[r] * gate[r];
            *(u32x2*)(yrow + 16 * nt) = pk4(y);
        }
    }
}

DEVI void phase5(const Params& p, unsigned char* smem) {
    GemmSmem& sm = *(GemmSmem*)smem;
    const int t = threadIdx.x, lane = t & 63, w = t >> 6, wr = w >> 1, wc = w & 1, l15 = lane & 15, q = lane >> 4;
    const bf16_t* Y = (const bf16_t*)(p.ws + OFF_Y); const bf16_t* wt = (const bf16_t*)(p.ws + OFF_WT);
    const bf16_t* Mg = (const bf16_t*)(p.ws + OFF_MG); bf16_t* Mrg = (bf16_t*)(p.ws + OFF_MRG);
    const int xg = blockIdx.x & 7, jl = blockIdx.x >> 3, nloc = gridDim.x >> 3, SM = nloc >> 3, nrg = 32 / SM;
    for (int rg = 0; rg < nrg; ++rg) {
        const int mtg = 32 * xg + rg * SM + (jl >> 3), ntg = jl & 7, m0 = mtg * 128, n0 = ntg * 128;
        const bf16_t* pa0 = Y + (size_t)(m0 + (t >> 3)) * 2048 + gemm_src_chunk(t);
        const bf16_t* pb0 = wt + (size_t)(WT_RET + n0 + (t >> 3)) * 1024 + gemm_src_chunk(t);
        const bf16_t* const pa[4] = {pa0, pa0 + 32 * 2048, pa0 + 64 * 2048, pa0 + 96 * 2048};
        const bf16_t* const pb[4] = {pb0, pb0 + 32 * 1024, pb0 + 64 * 1024, pb0 + 96 * 1024};
        f32x4 acc[4][4]; zero_acc(acc);
        gemm_kloop<true, 0>(acc, pa, pb, nullptr, 0, 16, sm);
        u32x4 gg[4][2], prt[4][2];
#pragma unroll
        for (int mt = 0; mt < 4; ++mt)
#pragma unroll
            for (int pp = 0; pp < 2; ++pp) {
                const int row = m0 + wr * 64 + mt * 16 + l15, col = n0 + wc * 64 + pp * 32 + 8 * q;
                gg[mt][pp] = *(const u32x4*)(Mg + (size_t)row * 2048 + col);
            }
#pragma unroll
        for (int mt = 0; mt < 4; ++mt)
#pragma unroll
            for (int pp = 0; pp < 2; ++pp) {
                const int row = m0 + wr * 64 + mt * 16 + l15, col = n0 + wc * 64 + pp * 32 + 8 * q;
                f32x4 g0, g1; unpk8(gg[mt][pp], g0, g1);
                *(u32x4*)(Mrg + (size_t)row * 1024 + col) = pk8(acc[mt][2 * pp] * g0, acc[mt][2 * pp + 1] * g1);
            }
        zero_acc(acc);
        const bf16_t* pb2 = wt + (size_t)(WT_GLA + n0 + (t >> 3)) * 1024 + gemm_src_chunk(t);
        const bf16_t* const pa2[4] = {pa0 + 1024, pa0 + 1024 + 32 * 2048, pa0 + 1024 + 64 * 2048, pa0 + 1024 + 96 * 2048};
        const bf16_t* const pbb[4] = {pb2, pb2 + 32 * 1024, pb2 + 64 * 1024, pb2 + 96 * 1024};
        gemm_kloop<true, 0>(acc, pa2, pbb, nullptr, 0, 16, sm);
#pragma unroll
        for (int mt = 0; mt < 4; ++mt)
#pragma unroll
            for (int pp = 0; pp < 2; ++pp) {
                const int row = m0 + wr * 64 + mt * 16 + l15, col = n0 + wc * 64 + pp * 32 + 8 * q;
                gg[mt][pp] = *(const u32x4*)(Mg + (size_t)row * 2048 + 1024 + col);
                prt[mt][pp] = *(const u32x4*)(Mrg + (size_t)row * 1024 + col);
            }
#pragma unroll
        for (int mt = 0; mt < 4; ++mt)
#pragma unroll
            for (int pp = 0; pp < 2; ++pp) {
                const int row = m0 + wr * 64 + mt * 16 + l15, col = n0 + wc * 64 + pp * 32 + 8 * q;
                f32x4 g0, g1, p0, p1; unpk8(gg[mt][pp], g0, g1); unpk8(prt[mt][pp], p0, p1);
                *(u32x4*)(Mrg + (size_t)row * 1024 + col) = pk8(p0 + acc[mt][2 * pp] * g0, p1 + acc[mt][2 * pp + 1] * g1);
            }
    }
}

DEVI void phase6(const Params& p, unsigned char* smem) {
    GemmSmem& sm = *(GemmSmem*)smem;
    const int t = threadIdx.x, lane = t & 63, w = t >> 6, wr = w >> 1, wc = w & 1, l15 = lane & 15, q = lane >> 4;
    const bf16_t* Mrg = (const bf16_t*)(p.ws + OFF_MRG); const bf16_t* wt = (const bf16_t*)(p.ws + OFF_WT);
    bf16_t* T1 = (bf16_t*)(p.ws + OFF_T1);
    const int xg = blockIdx.x & 7, jl = blockIdx.x >> 3, nloc = gridDim.x >> 3, SM = nloc >> 3, nrg = 32 / SM;
    for (int rg = 0; rg < nrg; ++rg) {
        const int mtg = 32 * xg + rg * SM + (jl >> 3), ntg = jl & 7, m0 = mtg * 128, n0 = ntg * 128;
        const bf16_t* pa0 = Mrg + (size_t)(m0 + (t >> 3)) * 1024 + gemm_src_chunk(t);
        const bf16_t* pb0 = wt + (size_t)(WT_O + n0 + (t >> 3)) * 1024 + gemm_src_chunk(t);
        const bf16_t* const pa[4] = {pa0, pa0 + 32 * 1024, pa0 + 64 * 1024, pa0 + 96 * 1024};
        const bf16_t* const pb[4] = {pb0, pb0 + 32 * 1024, pb0 + 64 * 1024, pb0 + 96 * 1024};
        f32x4 acc[4][4]; zero_acc(acc);
        gemm_kloop<true, 0>(acc, pa, pb, nullptr, 0, 16, sm);
        f32x4 xin[4][4];
#pragma unroll
        for (int mt = 0; mt < 4; ++mt)
#pragma unroll
            for (int nt = 0; nt < 4; ++nt) {
                const int row = m0 + wr * 64 + mt * 16 + l15, col = n0 + wc * 64 + (nt >> 1) * 32 + 8 * q + 4 * (nt & 1);
                xin[mt][nt] = *(const f32x4*)(p.x + (size_t)row * 1024 + col);
            }
#pragma unroll
        for (int mt = 0; mt < 4; ++mt)
#pragma unroll
            for (int pp = 0; pp < 2; ++pp) {
                const int row = m0 + wr * 64 + mt * 16 + l15, col = n0 + wc * 64 + pp * 32 + 8 * q;
                *(u32x4*)(T1 + (size_t)row * 1024 + col) = pk8(xin[mt][2 * pp] * ALPHA_ + acc[mt][2 * pp], xin[mt][2 * pp + 1] * ALPHA_ + acc[mt][2 * pp + 1]);
            }
    }
}

DEVI void conv_expert_weights(const Params& p, unsigned char* smem) {
    bf16_t* tile = (bf16_t*)smem;
    const int t = threadIdx.x, ng = t & 31, kg = t >> 5;
    bf16_t* WGU = (bf16_t*)(p.ws + OFF_WGU); bf16_t* WD = (bf16_t*)(p.ws + OFF_WD);
    const int ntask = 257 * 3 * 32;
    for (int task = blockIdx.x; task < ntask; task += gridDim.x) {
        const int e = task / 96, rem = task - e * 96, mat = rem >> 5, tl = rem & 31;
        const float* src; bf16_t* dst; int K, N, kt, nt;
        if (mat < 2) { K = 1024; N = 256; kt = tl >> 1; nt = tl & 1;
            src = (mat == 0) ? (e < 256 ? p.ew_gate + (size_t)e * 262144 : p.sw_gate) : (e < 256 ? p.ew_up + (size_t)e * 262144 : p.sw_up);
            dst = WGU + ((size_t)e * 2 + mat) * 262144; }
        else { K = 256; N = 1024; kt = tl >> 3; nt = tl & 7;
            src = e < 256 ? p.ew_down + (size_t)e * 262144 : p.sw_down; dst = WD + (size_t)e * 262144; }
        const float* sp = src + (size_t)(kt * 64 + 4 * kg) * N + nt * 128 + 4 * ng;
        f32x4 rf[8];
#pragma unroll
        for (int i = 0; i < 4; ++i) { rf[i] = *(const f32x4*)(sp + (size_t)i * N); rf[4 + i] = *(const f32x4*)(sp + (size_t)(32 + i) * N); }
#pragma unroll
        for (int i = 0; i < 4; ++i) {
            u32x2 v0, v1;
            v0.x = pk2(rf[0][i], rf[1][i]); v0.y = pk2(rf[2][i], rf[3][i]); v1.x = pk2(rf[4][i], rf[5][i]); v1.y = pk2(rf[6][i], rf[7][i]);
            *(u32x2*)&tile[(4 * ng + i) * 72 + 4 * kg] = v0; *(u32x2*)&tile[(4 * ng + i) * 72 + 32 + 4 * kg] = v1;
        }
        __syncthreads();
        {
            const int n = t >> 1, hf = t & 1;
            bf16_t* dp = dst + (size_t)(nt * 128 + n) * K + kt * 64 + hf * 32;
#pragma unroll
            for (int j = 0; j < 4; ++j) *(u32x4*)(dp + 8 * j) = *(const u32x4*)&tile[n * 72 + hf * 32 + 8 * j];
        }
        __syncthreads();
    }
}

DEVI void phase7(const Params& p, unsigned char* smem) {
    const int t = threadIdx.x, lane = t & 63, w = t >> 6;
    const bf16_t* T1 = (const bf16_t*)(p.ws + OFF_T1); bf16_t* X1b = (bf16_t*)(p.ws + OFF_X1B);
    for (int row = blockIdx.x * 4 + w; row < T_; row += gridDim.x * 4) {
        f32x4 v[4]; float s = 0.f;
#pragma unroll
        for (int i = 0; i < 4; ++i) { v[i] = unpk4(*(const u32x2*)(T1 + (size_t)row * 1024 + i * 256 + lane * 4)); s += (v[i][0] + v[i][1]) + (v[i][2] + v[i][3]); }
#pragma unroll
        for (int o = 32; o > 0; o >>= 1) s += __shfl_xor(s, o);
        const float mean = s * (1.0f / 1024.0f); float s2 = 0.f;
#pragma unroll
        for (int i = 0; i < 4; ++i)
#pragma unroll
            for (int r = 0; r < 4; ++r) { const float d = v[i][r] - mean; s2 += d * d; }
#pragma unroll
        for (int o = 32; o > 0; o >>= 1) s2 += __shfl_xor(s2, o);
        const float rstd = rsqrtf(s2 * (1.0f / 1024.0f) + 1e-5f);
#pragma unroll
        for (int i = 0; i < 4; ++i) {
            const int col = i * 256 + lane * 4;
            const f32x4 g = *(const f32x4*)(p.ln1_g + col), bb = *(const f32x4*)(p.ln1_b + col);
            f32x4 y;
#pragma unroll
            for (int r = 0; r < 4; ++r) y[r] = (v[i][r] - mean) * rstd * g[r] + bb[r];
            *(u32x2*)(X1b + (size_t)row * 1024 + col) = pk4(y);
        }
    }
    conv_expert_weights(p, smem);
}

DEVI void phase8(const Params& p, unsigned char* smem) {
    GemmSmem& sm = *(GemmSmem*)smem;
    const int t = threadIdx.x, lane = t & 63, w = t >> 6, wr = w >> 1, wc = w & 1, l15 = lane & 15, q = lane >> 4;
    const bf16_t* X1b = (const bf16_t*)(p.ws + OFF_X1B); const bf16_t* wt = (const bf16_t*)(p.ws + OFF_WT);
    float* LG = (float*)(p.ws + OFF_LOG);
    for (int tile = blockIdx.x; tile < 256 * 2; tile += gridDim.x) {
        const int mtg = tile >> 1, ntg = tile & 1, m0 = mtg * 128, n0 = ntg * 128;
        const bf16_t* pa0 = X1b + (size_t)(m0 + (t >> 3)) * 1024 + gemm_src_chunk(t);
        const bf16_t* pb0 = wt + (size_t)(WT_R + n0 + (t >> 3)) * 1024 + gemm_src_chunk(t);
        const bf16_t* const pa[4] = {pa0, pa0 + 32 * 1024, pa0 + 64 * 1024, pa0 + 96 * 1024};
        const bf16_t* const pb[4] = {pb0, pb0 + 32 * 1024, pb0 + 64 * 1024, pb0 + 96 * 1024};
        f32x4 acc[4][4]; zero_acc(acc);
        gemm_kloop<true, 0>(acc, pa, pb, nullptr, 0, 16, sm);
#pragma unroll
        for (int mt = 0; mt < 4; ++mt)
#pragma unroll
            for (int nt = 0; nt < 4; ++nt) {
                const int row = m0 + wr * 64 + mt * 16 + l15, col = n0 + wc * 64 + (nt >> 1) * 32 + 8 * q + 4 * (nt & 1);
                *(f32x4*)(LG + (size_t)row * 256 + col) = acc[mt][nt];
            }
    }
}

DEVI unsigned f2ord(float f) { const unsigned u = __float_as_uint(f); return (u & 0x80000000u) ? ~u : (u | 0x80000000u); }
DEVI void phase9(const Params& p) {
    const int t = threadIdx.x, lane = t & 63, w = t >> 6;
    const float* LG = (const float*)(p.ws + OFF_LOG);
    int* cnt = (int*)(p.ws + OFF_CNT); int* list = (int*)(p.ws + OFF_LIST); float* wts = (float*)(p.ws + OFF_WTS);
    const int tstep = gridDim.x * 4;
    int tok = blockIdx.x * 4 + w;
    float lgn[4]; float rb[4];
#pragma unroll
    for (int r = 0; r < 4; ++r) { rb[r] = p.router_bias[lane + 64 * r]; lgn[r] = tok < T_ ? LG[(size_t)tok * 256 + lane + 64 * r] : 0.f; }
    int ppos = 0, pe = -1, ptk9 = 0;
    for (; tok < T_; tok += tstep) {
        float sc[4], bi[4];
#pragma unroll
        for (int r = 0; r < 4; ++r) { sc[r] = sigmoidf_(lgn[r]); bi[r] = sc[r] + rb[r]; }
        { const int tn = tok + tstep;
#pragma unroll
          for (int r = 0; r < 4; ++r) lgn[r] = tn < T_ ? LG[(size_t)tn * 256 + lane + 64 * r] : 0.f; }
        float gsc[8];
#pragma unroll
        for (int r = 0; r < 4; ++r) {
            float m1 = bi[r];
#pragma unroll
            for (int o = 16; o > 0; o >>= 1) m1 = fmaxf(m1, __shfl_xor(m1, o));
            const unsigned long long bal = __ballot(bi[r] == m1);
            const unsigned halfmask = (lane < 32) ? (unsigned)(bal & 0xffffffffull) : (unsigned)(bal >> 32);
            const int first = __ffs(halfmask) - 1;
            float m2 = ((lane & 31) == first) ? -INFINITY : bi[r];
#pragma unroll
            for (int o = 16; o > 0; o >>= 1) m2 = fmaxf(m2, __shfl_xor(m2, o));
            const float g = m1 + m2;
            gsc[2 * r] = __shfl(g, 0); gsc[2 * r + 1] = __shfl(g, 32);
        }
        unsigned selmask = 0;
#pragma unroll
        for (int g = 0; g < 8; ++g) {
            int rank = 0;
#pragma unroll
            for (int g2 = 0; g2 < 8; ++g2) rank += (gsc[g2] > gsc[g] || (gsc[g2] == gsc[g] && g2 < g)) ? 1 : 0;
            if (rank < 4) selmask |= 1u << g;
        }
        float cand[4];
#pragma unroll
        for (int r = 0; r < 4; ++r) cand[r] = ((selmask >> (2 * r + (lane >> 5))) & 1u) ? bi[r] : -INFINITY;
        float wsum = 0.f, myw = 0.f; int mye = 0;
#pragma unroll 1
        for (int k = 0; k < 8; ++k) {
            unsigned long long best = 0ull;
#pragma unroll
            for (int r = 0; r < 4; ++r) {
                const unsigned long long key = ((unsigned long long)f2ord(cand[r]) << 32) | (unsigned)(0xffffffffu - (unsigned)(lane + 64 * r));
                best = key > best ? key : best;
            }
#pragma unroll
            for (int o = 32; o > 0; o >>= 1) { const unsigned long long oth = __shfl_xor(best, o); best = oth > best ? oth : best; }
            const int e = (int)(0xffffffffu - (unsigned)(best & 0xffffffffull));
            float mine = 0.f;
#pragma unroll
            for (int r = 0; r < 4; ++r) if (e == lane + 64 * r) { mine = sc[r]; cand[r] = -INFINITY; }
            const float sv = __shfl(mine, e & 63);
            wsum += sv;
            if (lane == k) { mye = e; myw = sv; }
        }
        if (lane < 8) {
            if (pe >= 0) list[(size_t)pe * T_ + ppos] = ptk9;
            ppos = atomicAdd(&cnt[mye], 1); pe = mye; ptk9 = tok * 9 + lane;
            wts[(size_t)tok * 9 + lane] = myw / wsum * 2.5f;
        } else if (lane == 8) wts[(size_t)tok * 9 + 8] = 1.0f;
    }
    if (lane < 8 && pe >= 0) list[(size_t)pe * T_ + ppos] = ptk9;
}

DEVI void moe_prefix(const Params& p, int* pre  , int xg) {
    const int tid = threadIdx.x;
    const int* cnt = (const int*)(p.ws + OFF_CNT);
    __syncthreads();
    if (tid < 64) {
        int v = 0;
        if (tid < 32) v = (__hip_atomic_load(&cnt[xg + 8 * tid], __ATOMIC_RELAXED, __HIP_MEMORY_SCOPE_AGENT) + 127) >> 7;
        else if (tid == 32) v = 32;
#pragma unroll
        for (int o = 1; o < 64; o <<= 1) { const int u = __shfl_up(v, o); if (tid >= o) v += u; }
        if (tid < 33) pre[tid + 1] = v;
        if (tid == 0) pre[0] = 0;
    }
    __syncthreads();
}
DEVI int moe_find(const int* pre, int mb) {
    int lo = 0, hi = 32;
    while (lo < hi) { const int mid = (lo + hi + 1) >> 1; if (pre[mid] <= mb) lo = mid; else hi = mid - 1; }
    return lo;
}
DEVI int moe_tk9(const int* list, int e, int pos) { return e < 256 ? list[(size_t)e * T_ + pos] : pos * 9 + 8; }

DEVI void phase10(const Params& p, unsigned char* smem) {
    GemmSmem& sm = *(GemmSmem*)smem; int* pre = (int*)(smem + SMEM_GEMM);
    const int t = threadIdx.x, lane = t & 63, w = t >> 6, wr = w >> 1, wc = w & 1, l15 = lane & 15, q = lane >> 4;
    const bf16_t* X1b = (const bf16_t*)(p.ws + OFF_X1B); const int* list = (const int*)(p.ws + OFF_LIST);
    const int* cnt = (const int*)(p.ws + OFF_CNT); bf16_t* H = (bf16_t*)(p.ws + OFF_H); const bf16_t* WGU = (const bf16_t*)(p.ws + OFF_WGU);
    const int xg = blockIdx.x & 7, jl = blockIdx.x >> 3, nloc = gridDim.x >> 3;
    moe_prefix(p, pre, xg);
    const int ntiles = pre[33] * 4;
    for (int tile = jl; tile < ntiles; tile += nloc) {
        const int mbg = tile >> 2, nt4 = tile & 3;
        const int gi = moe_find(pre, mbg), mb = mbg - pre[gi];
        const int e = gi < 32 ? xg + 8 * gi : 256;
        const int ce = e < 256 ? cnt[e] : T_;
        const int pbase = e < 256 ? 0 : xg * 4096;
        const bf16_t* pa[4]; const bf16_t* pb[4];
#pragma unroll
        for (int i = 0; i < 4; ++i) { int r = pbase + mb * 128 + (t >> 3) + 32 * i; if (r >= ce) r = pbase; pa[i] = X1b + (size_t)(moe_tk9(list, e, r) / 9) * 1024 + gemm_src_chunk(t); }
#pragma unroll
        for (int i = 0; i < 4; ++i) {
            const int vv = vperm((t >> 3) + 32 * i);
            pb[i] = WGU + ((size_t)e * 2 + ((vv >> 5) & 1)) * 262144 + (size_t)(nt4 * 64 + (vv >> 6) * 32 + (vv & 31)) * 1024 + gemm_src_chunk(t);
        }
        f32x4 acc[4][4]; zero_acc(acc);
        gemm_kloop<true, 0>(acc, pa, pb, nullptr, 0, 16, sm);
        int tk9s[4];
#pragma unroll
        for (int mt = 0; mt < 4; ++mt) { const int pos = pbase + mb * 128 + wr * 64 + mt * 16 + l15; tk9s[mt] = moe_tk9(list, e, pos < ce ? pos : pbase); }
#pragma unroll
        for (int mt = 0; mt < 4; ++mt) {
            const int pos = pbase + mb * 128 + wr * 64 + mt * 16 + l15;
            if (pos < ce) {
                const int tk9 = tk9s[mt];
                f32x4 hv[2];
#pragma unroll
                for (int nt = 0; nt < 2; ++nt)
#pragma unroll
                    for (int r = 0; r < 4; ++r) hv[nt][r] = siluf_(acc[mt][nt][r]) * acc[mt][nt + 2][r];
                *(u32x4*)(H + (size_t)tk9 * 256 + nt4 * 64 + wc * 32 + 8 * q) = pk8(hv[0], hv[1]);
            }
        }
    }
}

DEVI void phase11(const Params& p, unsigned char* smem) {
    GemmSmem& sm = *(GemmSmem*)smem; int* pre = (int*)(smem + SMEM_GEMM);
    const int t = threadIdx.x, lane = t & 63, w = t >> 6, wr = w >> 1, wc = w & 1, l15 = lane & 15, q = lane >> 4;
    const bf16_t* H = (const bf16_t*)(p.ws + OFF_H); const int* list = (const int*)(p.ws + OFF_LIST);
    const int* cnt = (const int*)(p.ws + OFF_CNT); const float* wts = (const float*)(p.ws + OFF_WTS); bf16_t* YX = (bf16_t*)(p.ws + OFF_YX); const bf16_t* WD = (const bf16_t*)(p.ws + OFF_WD);
    const int xg = blockIdx.x & 7, jl = blockIdx.x >> 3, nloc = gridDim.x >> 3;
    moe_prefix(p, pre, xg);
    const int nitems = pre[33] * 2;
    for (int item = jl; item < nitems; item += nloc) {
        const int mbg = item >> 1, ng4 = item & 1;
        const int gi = moe_find(pre, mbg), mb = mbg - pre[gi];
        const int e = gi < 32 ? xg + 8 * gi : 256;
        const int ce = e < 256 ? cnt[e] : T_;
        const int pbase = e < 256 ? 0 : xg * 4096;
        const bf16_t* pa[4];
        int tk9s[4]; float wg4[4];
#pragma unroll
        for (int i = 0; i < 4; ++i) { int r = pbase + mb * 128 + (t >> 3) + 32 * i; if (r >= ce) r = pbase; pa[i] = H + (size_t)moe_tk9(list, e, r) * 256 + gemm_src_chunk(t); }
#pragma unroll
        for (int mt = 0; mt < 4; ++mt) { const int pos = pbase + mb * 128 + wr * 64 + mt * 16 + l15; tk9s[mt] = moe_tk9(list, e, pos < ce ? pos : pbase); }
#pragma unroll
        for (int mt = 0; mt < 4; ++mt) wg4[mt] = wts[tk9s[mt]];
#pragma unroll 1
        for (int j = 0; j < 4; ++j) {
            const int nt8 = ng4 * 4 + j;
            const bf16_t* pb[4];
#pragma unroll
            for (int i = 0; i < 4; ++i) pb[i] = WD + (size_t)e * 262144 + (size_t)(nt8 * 128 + vperm((t >> 3) + 32 * i)) * 256 + gemm_src_chunk(t);
            f32x4 acc[4][4]; zero_acc(acc);
            gemm_kloop<true, 0>(acc, pa, pb, nullptr, 0, 4, sm);
#pragma unroll
            for (int mt = 0; mt < 4; ++mt) {
                const int pos = pbase + mb * 128 + wr * 64 + mt * 16 + l15;
                if (pos < ce) {
                    const float wgt = wg4[mt];
#pragma unroll
                    for (int pp = 0; pp < 2; ++pp)
                        *(u32x4*)(YX + (size_t)tk9s[mt] * 1024 + nt8 * 128 + wc * 64 + pp * 32 + 8 * q) = pk8(acc[mt][2 * pp] * wgt, acc[mt][2 * pp + 1] * wgt);
                }
            }
        }
    }
}

DEVI void phase12(const Params& p) {
    const int t = threadIdx.x, lane = t & 63, w = t >> 6;
    const bf16_t* X1b = (const bf16_t*)(p.ws + OFF_X1B); const bf16_t* YX = (const bf16_t*)(p.ws + OFF_YX);
    for (int row = blockIdx.x * 4 + w; row < T_; row += gridDim.x * 4) {
        f32x4 v[4]; float s = 0.f;
#pragma unroll
        for (int i = 0; i < 4; ++i) {
            const int col = i * 256 + lane * 4;
            f32x4 a = unpk4(*(const u32x2*)(X1b + (size_t)row * 1024 + col)) * ALPHA_;
#pragma unroll
            for (int k = 0; k < 9; ++k) a += unpk4(*(const u32x2*)(YX + ((size_t)row * 9 + k) * 1024 + col));
            v[i] = a; s += (a[0] + a[1]) + (a[2] + a[3]);
        }
#pragma unroll
        for (int o = 32; o > 0; o >>= 1) s += __shfl_xor(s, o);
        const float mean = s * (1.0f / 1024.0f); float s2 = 0.f;
#pragma unroll
        for (int i = 0; i < 4; ++i)
#pragma unroll
            for (int r = 0; r < 4; ++r) { const float d = v[i][r] - mean; s2 += d * d; }
#pragma unroll
        for (int o = 32; o > 0; o >>= 1) s2 += __shfl_xor(s2, o);
        const float rstd = rsqrtf(s2 * (1.0f / 1024.0f) + 1e-5f);
#pragma unroll
        for (int i = 0; i < 4; ++i) {
            const int col = i * 256 + lane * 4;
            const f32x4 g = *(const f32x4*)(p.ln2_g + col), bb = *(const f32x4*)(p.ln2_b + col);
            f32x4 y;
#pragma unroll
            for (int r = 0; r < 4; ++r) y[r] = (v[i][r] - mean) * rstd * g[r] + bb[r];
            *(f32x4*)(p.out + (size_t)row * 1024 + col) = y;
        }
    }
}


#define XB_TMO      128
#define XB_XCNT(j)  (256  + 64 * (j))
#define XB_XSUB(j)  (1280 + 64 * (j))
#define XB_XGEN(j)  (2304 + 64 * (j))
#define XB_TOP      3328
#define XB_TOPGEN   3392
#define XCD_BAR_WORDS 3456
#define XB_SPIN_CAP (1u << 20)
#define LAS __attribute__((address_space(3)))
DEVI unsigned xb_ld(unsigned* p)              { return __hip_atomic_load(p, __ATOMIC_RELAXED, __HIP_MEMORY_SCOPE_AGENT); }
DEVI unsigned xb_add(unsigned* p, unsigned v) { return __hip_atomic_fetch_add(p, v, __ATOMIC_RELAXED, __HIP_MEMORY_SCOPE_AGENT); }
DEVI unsigned xb_xcc_id() { return (unsigned)__builtin_amdgcn_s_getreg((3 << 11) | 20) & 0xFu; }
#define XB_SPIN(cond, bar) do { unsigned _sp = 0; while (cond) { __builtin_amdgcn_s_sleep(1); \
    if ((++_sp & 255u) == 0u) { if (xb_ld(&(bar)[XB_TMO])) break; if (_sp > XB_SPIN_CAP) { atomicAdd(&(bar)[XB_TMO], 1u); break; } } } } while (0)
struct XcdBarrier { unsigned* bar; unsigned x; volatile LAS unsigned* st; };
DEVI XcdBarrier xcd_barrier_post(unsigned* bar, volatile LAS unsigned* st) {
    XcdBarrier b; b.bar = bar; b.x = xb_xcc_id(); b.st = st;
    if (threadIdx.x == 0) (void)xb_add(&bar[XB_XCNT(b.x)], 1u);
    return b;
}
DEVI void xcd_barrier_complete(unsigned* bar, unsigned x, unsigned& nloc, unsigned& nx) {
    const unsigned G = gridDim.x * gridDim.y * gridDim.z;
    unsigned sum, cnt, mine, sp = 0u;
    for (;;) {
        sum = 0u; cnt = 0u; mine = 0u;
#pragma unroll
        for (unsigned j = 0; j < 16; ++j) { const unsigned c = xb_ld(&bar[XB_XCNT(j)]); sum += c; cnt += (c > 0u) ? 1u : 0u; mine = (j == x) ? c : mine; }
        if (sum == G) break;
        __builtin_amdgcn_s_sleep(1);
        if ((++sp & 255u) == 0u) { if (xb_ld(&bar[XB_TMO])) break; if (sp > XB_SPIN_CAP) { atomicAdd(&bar[XB_TMO], 1u); break; } }
    }
    nloc = mine > 0u ? mine : 1u; nx = cnt > 0u ? cnt : 1u;
}
DEVI void xcd_barrier(const XcdBarrier& b) {
    asm volatile("s_waitcnt vmcnt(0)" ::: "memory");
    __syncthreads();
    if (threadIdx.x == 0) {
        unsigned* bar = b.bar;
        __builtin_amdgcn_s_waitcnt(0);
        unsigned nloc = b.st[0], nx = b.st[1];
        if (nloc == 0u) { xcd_barrier_complete(bar, b.x, nloc, nx); b.st[0] = nloc; b.st[1] = nx; }
        const unsigned old = xb_add(&bar[XB_XSUB(b.x)], 1u);
        const unsigned gen = old / nloc;
        if (old + 1u == (gen + 1u) * nloc) {
            __builtin_amdgcn_fence(__ATOMIC_RELEASE, "agent");
            asm volatile("s_waitcnt vmcnt(0)" ::: "memory");
            const unsigned og = xb_add(&bar[XB_TOP], 1u);
            const unsigned tg = og / nx;
            if (og + 1u == (tg + 1u) * nx) xb_add(&bar[XB_TOPGEN], 1u);
            else XB_SPIN(xb_ld(&bar[XB_TOPGEN]) == tg, bar);
            __builtin_amdgcn_fence(__ATOMIC_ACQUIRE, "agent");
            xb_add(&bar[XB_XGEN(b.x)], 1u);
            asm volatile("s_waitcnt vmcnt(0)" ::: "memory");
        } else {
            XB_SPIN(xb_ld(&bar[XB_XGEN(b.x)]) == gen, bar);
            __builtin_amdgcn_fence(__ATOMIC_ACQUIRE, "agent");
            asm volatile("s_waitcnt vmcnt(0)" ::: "memory");
        }
    }
    __syncthreads();
}
constexpr size_t OFF_BAR = OFF_CNT + 65536;

#ifndef DBG
#define DBG 0
#endif
DEVI void dump_f32(const Params& p, size_t off) {
    const f32x4* src = (const f32x4*)(p.ws + off); f32x4* dst = (f32x4*)p.out;
    for (int i = blockIdx.x * 256 + threadIdx.x; i < T_ * D_ / 4; i += gridDim.x * 256) dst[i] = src[i];
}
DEVI void dump_bf16(const Params& p, size_t off, int ld, int coff) {
    const bf16_t* src = (const bf16_t*)(p.ws + off);
    for (int i = blockIdx.x * 256 + threadIdx.x; i < T_ * D_; i += gridDim.x * 256) { const int row = i >> 10, col = i & 1023; p.out[i] = bf2f(src[(size_t)row * ld + coff + col]); }
}
DEVI float flat_bf(const Params& p, size_t off, size_t n, size_t i) { const bf16_t* b = (const bf16_t*)(p.ws + off); float a = 0.f; for (size_t j = i; j < n; j += (size_t)T_ * D_) a += bf2f(b[j]); return a; }
DEVI void dump_p1(const Params& p) {
    const size_t N = (size_t)T_ * D_;
    for (size_t i = (size_t)blockIdx.x * 256 + threadIdx.x; i < N; i += (size_t)gridDim.x * 256) {
        float a = 0.f;
        a += flat_bf(p, OFF_MG, 2 * N, i) + flat_bf(p, OFF_GS, 2 * N, i);
        a += flat_bf(p, OFF_QR, N / 2, i % (N / 2)) + flat_bf(p, OFF_KR, N / 2, i % (N / 2)) + flat_bf(p, OFF_QG, N / 2, i % (N / 2));
        a += flat_bf(p, OFF_KRT, N / 2, i % (N / 2)) + flat_bf(p, OFF_KGT, N / 2, i % (N / 2));
        a += flat_bf(p, OFF_VRT, N, i) + flat_bf(p, OFF_VGT, N, i);
        a += ((const float*)(p.ws + OFF_GA))[i % ((size_t)T_ * 16)];
        p.out[i] = a;
    }
}
constexpr int NPHASE = 13;
__global__ void __launch_bounds__(256, 2) fwd_megakernel(Params p) {
    __shared__ __attribute__((aligned(16))) unsigned char smem[SMEM_BYTES];
    uint4* xb_words = (uint4*)(smem + SMEM_GEMM + 2048);
    if (threadIdx.x == 0) *xb_words = make_uint4(0u, 0u, 0u, 0u);
    __syncthreads();
    const XcdBarrier xb = xcd_barrier_post((unsigned*)(p.ws + OFF_BAR), (volatile LAS unsigned*)xb_words);
#ifndef REPMASK
#define REPMASK 0
#endif
#define RUN_PHASE(K, CALL) do { if (p.phase_lo <= (K) && (K) < p.phase_hi) { if ((REPMASK >> (K)) & 1) { CALL; xcd_barrier(xb); } CALL; if ((K) + 1 < p.phase_hi) xcd_barrier(xb); } } while (0)
    RUN_PHASE(0, phase0(p, smem));
#ifdef P1DUMMY
    phase1<P1DUMMY>(p, smem); xcd_barrier(xb);
#endif
    RUN_PHASE(1, phase1<0>(p, smem));
#if DBG == 2
    dump_p1(p); return;
#endif
    RUN_PHASE(2, phase2(p, smem));
#if DBG == 5
    { const size_t N = (size_t)T_ * D_; for (size_t i = (size_t)blockIdx.x * 256 + threadIdx.x; i < N; i += (size_t)gridDim.x * 256) p.out[i] = flat_bf(p, OFF_KG2, N / 2, i % (N / 2)) + ((const float*)(p.ws + OFF_DEC))[i % (2048 * 128)]; } return;
#endif
#ifdef SCANDUMMY
    phase3<SCANDUMMY>(p, smem); xcd_barrier(xb);
#endif
    RUN_PHASE(3, phase3<0>(p, smem));
#if DBG == 6
    dump_bf16(p, OFF_OO, 2048, 1024); return;
#endif
#if DBG == 7
    { const bf16_t* src = (const bf16_t*)(p.ws + OFF_OO);
      for (int i = blockIdx.x * 256 + threadIdx.x; i < T_ * D_; i += gridDim.x * 256) { const int row = i >> 10, col = i & 1023; const float v = bf2f(src[(size_t)row * 2048 + 1024 + col]); p.out[i] = (fabsf(v) < 1e30f) ? v : 12345.0f; } } return;
#endif
    RUN_PHASE(4, phase4(p, smem));
#if DBG == 3
    dump_bf16(p, OFF_Y, 2048, 0); return;
#endif
#if DBG == 4
    dump_bf16(p, OFF_Y, 2048, 1024); return;
#endif
    RUN_PHASE(5, phase5(p, smem));
    RUN_PHASE(6, phase6(p, smem));
    RUN_PHASE(7, phase7(p, smem));
#if DBG == 1
    return;
#endif
    RUN_PHASE(8, phase8(p, smem));
    RUN_PHASE(9, phase9(p));
    RUN_PHASE(10, phase10(p, smem));
    RUN_PHASE(11, phase11(p, smem));
    RUN_PHASE(12, phase12(p));
#undef RUN_PHASE
}

extern "C" void kernel_launch(void* const* d_in, const int* in_sizes, int n_in, void* d_out, int out_size, void* d_ws, size_t ws_size,
                              hipStream_t stream) {
    static int grid_blocks = 0;
    if (!grid_blocks) {
        int dev = 0, cus = 0, per_cu = 0;
        hipGetDevice(&dev);
        hipDeviceGetAttribute(&cus, hipDeviceAttributeMultiprocessorCount, dev);
        hipOccupancyMaxActiveBlocksPerMultiprocessor(&per_cu, fwd_megakernel, 256, 0);
        if (per_cu > 2) per_cu = 2;
        if (per_cu < 1) per_cu = 1;
        grid_blocks = cus * per_cu;
    }
    if (ws_size < WS_NEEDED) { fprintf(stderr, "workspace too small: %zu < %zu\n", ws_size, (size_t)WS_NEEDED); return; }
    Params p{};
    p.x = (const float*)d_in[0]; p.w_in = (const float*)d_in[1]; p.ret_norm_g = (const float*)d_in[2]; p.gate_w2 = (const float*)d_in[3];
    p.gate_b = (const float*)d_in[4]; p.gla_norm_g = (const float*)d_in[5]; p.w_ret_out = (const float*)d_in[6]; p.w_gla_out = (const float*)d_in[7];
    p.w_o = (const float*)d_in[8]; p.ln1_g = (const float*)d_in[9]; p.ln1_b = (const float*)d_in[10]; p.router_w = (const float*)d_in[11];
    p.router_bias = (const float*)d_in[12]; p.ew_gate = (const float*)d_in[13]; p.ew_up = (const float*)d_in[14]; p.ew_down = (const float*)d_in[15];
    p.sw_gate = (const float*)d_in[16]; p.sw_up = (const float*)d_in[17]; p.sw_down = (const float*)d_in[18]; p.ln2_g = (const float*)d_in[19];
    p.ln2_b = (const float*)d_in[20];
    p.out = (float*)d_out; p.ws = (unsigned char*)d_ws; p.phase_lo = 0; p.phase_hi = NPHASE;
    void* args[] = {&p};
    (void)hipMemsetAsync((unsigned char*)d_ws + OFF_BAR, 0, XCD_BAR_WORDS * 4, stream);
    hipError_t e = hipLaunchCooperativeKernel((void*)fwd_megakernel, dim3(grid_blocks), dim3(256), args, 0, stream);
    if (e != hipSuccess) fprintf(stderr, "cooperative launch failed: %s (grid %d)\n", hipGetErrorString(e), grid_blocks);
}
```

```cpp
#include <hip/hip_runtime.h>
#include <hip/hip_cooperative_groups.h>
#include <cstdio>
#include <cstdint>
namespace cg = cooperative_groups;

typedef unsigned short bf16_t;
typedef short bf16x8 __attribute__((ext_vector_type(8)));
typedef float f32x4 __attribute__((ext_vector_type(4)));
typedef unsigned u32x2 __attribute__((ext_vector_type(2)));
typedef unsigned u32x4 __attribute__((ext_vector_type(4)));
#define DEVI __device__ __forceinline__
#define VH ((int)(threadIdx.x >> 8))
#define VT ((int)(threadIdx.x & 255))
#define RB ((int)blockIdx.x)
#define RG ((int)gridDim.x)
#define VB (RB * 2 + VH)
#define VG (RG * 2)

constexpr int T_ = 32768;
constexpr int D_ = 1024;
constexpr int DIN_ = 8208;
constexpr int NE_ = 256;
constexpr float ALPHA_ = 1.189207115002721f;
constexpr float KSCALE_ = 0.08838834764831845f;

constexpr size_t MB = 1ull << 20;
constexpr size_t OFF_CNT  = 0;
constexpr size_t OFF_CS   = 1 * MB;
constexpr size_t OFF_WT   = 3 * MB;
constexpr size_t FB = 27 * MB;
constexpr size_t OFF_QR   = FB + 0 * MB;
constexpr size_t OFF_KR   = FB + 32 * MB;
constexpr size_t OFF_VRT  = FB + 64 * MB;
constexpr size_t OFF_GS   = FB + 128 * MB;
constexpr size_t OFF_MG   = FB + 256 * MB;
constexpr size_t OFF_KRT  = FB + 384 * MB;
constexpr size_t OFF_QG   = FB + 416 * MB;
constexpr size_t OFF_VGT  = FB + 448 * MB;
constexpr size_t OFF_KGT  = FB + 512 * MB;
constexpr size_t OFF_GA   = FB + 544 * MB;
constexpr size_t OFF_XB   = FB + 546 * MB;
constexpr size_t OFF_KG2  = FB + 546 * MB;
constexpr size_t OFF_DEC  = FB + 578 * MB;
constexpr size_t OFF_OO   = FB + 579 * MB;
constexpr size_t OFF_Y    = FB + 384 * MB;
constexpr size_t OFF_MRG  = FB + 0 * MB;
constexpr size_t OFF_WGU  = 767 * MB;
constexpr size_t OFF_X1B  = FB + 0 * MB;
constexpr size_t OFF_WD   = FB + 64 * MB;
constexpr size_t OFF_LIST = FB + 193 * MB;
constexpr size_t OFF_WTS  = FB + 225 * MB;
constexpr size_t OFF_H    = FB + 227 * MB;
constexpr size_t OFF_YX   = FB + 371 * MB;
constexpr size_t OFF_T1   = FB + 371 * MB;
constexpr size_t OFF_LOG  = FB + 435 * MB;
constexpr size_t WS_NEEDED = 1024 * MB;

constexpr int WT_BN = 0, WT_AT = 5888, WT_RET = 8960, WT_GLA = 9984, WT_O = 11008, WT_R = 12032, WT_ROWS = 12288;

struct Params {
    const float *x, *w_in, *ret_norm_g, *gate_w2, *gate_b, *gla_norm_g, *w_ret_out, *w_gla_out, *w_o, *ln1_g, *ln1_b,
                *router_w, *router_bias, *ew_gate, *ew_up, *ew_down, *sw_gate, *sw_up, *sw_down, *ln2_g, *ln2_b;
    float* out;
    unsigned char* ws;
    int phase_lo, phase_hi;
};

static __device__ const float c_inv_freq[64] = {
  1.000000000e+00f, 8.659643531e-01f, 7.498942018e-01f, 6.493816376e-01f,
  5.623413324e-01f, 4.869675338e-01f, 4.216965139e-01f, 3.651741147e-01f,
  3.162277639e-01f, 2.738419771e-01f, 2.371373773e-01f, 2.053525001e-01f,
  1.778279394e-01f, 1.539926529e-01f, 1.333521456e-01f, 1.154781953e-01f,
  1.000000015e-01f, 8.659642935e-02f, 7.498942316e-02f, 6.493816525e-02f,
  5.623413250e-02f, 4.869675264e-02f, 4.216964915e-02f, 3.651741147e-02f,
  3.162277490e-02f, 2.738419548e-02f, 2.371373773e-02f, 2.053525113e-02f,
  1.778279431e-02f, 1.539926510e-02f, 1.333521400e-02f, 1.154781971e-02f,
  9.999999776e-03f, 8.659643121e-03f, 7.498942316e-03f, 6.493816152e-03f,
  5.623413250e-03f, 4.869675264e-03f, 4.216964822e-03f, 3.651741194e-03f,
  3.162277630e-03f, 2.738419687e-03f, 2.371373819e-03f, 2.053525066e-03f,
  1.778279431e-03f, 1.539926510e-03f, 1.333521446e-03f, 1.154782018e-03f,
  1.000000047e-03f, 8.659643354e-04f, 7.498941850e-04f, 6.493816036e-04f,
  5.623413017e-04f, 4.869675322e-04f, 4.216965172e-04f, 3.651741135e-04f,
  3.162277571e-04f, 2.738419571e-04f, 2.371373703e-04f, 2.053525095e-04f,
  1.778279402e-04f, 1.539926598e-04f, 1.333521504e-04f, 1.154782003e-04f };

DEVI float bf2f(unsigned short u) { return __uint_as_float(((unsigned)u) << 16); }
DEVI float bflo(unsigned u) { return __uint_as_float(u << 16); }
DEVI float bfhi(unsigned u) { return __uint_as_float(u & 0xffff0000u); }
typedef float f32x2 __attribute__((ext_vector_type(2)));
typedef __bf16 bf16x2_t __attribute__((ext_vector_type(2)));
DEVI unsigned pk2(float lo, float hi) { const f32x2 v = {lo, hi}; const bf16x2_t b = __builtin_convertvector(v, bf16x2_t); return __builtin_bit_cast(unsigned, b); }
DEVI unsigned short f2bf(float f) { return (unsigned short)(pk2(f, 0.f) & 0xffffu); }
DEVI u32x2 pk4(f32x4 v) { u32x2 r; r.x = pk2(v[0], v[1]); r.y = pk2(v[2], v[3]); return r; }
DEVI f32x4 unpk4(u32x2 u) { f32x4 r; r[0] = bflo(u.x); r[1] = bfhi(u.x); r[2] = bflo(u.y); r[3] = bfhi(u.y); return r; }
DEVI float sigmoidf_(float v) { return 1.0f / (1.0f + __expf(-v)); }
DEVI float siluf_(float v) { return v / (1.0f + __expf(-v)); }
DEVI float gamma_log2(int h) { return log2f(1.0f - exp2f(-5.0f - (float)h)); }
DEVI f32x4 mfma16(bf16x8 a, bf16x8 b, f32x4 c) { return __builtin_amdgcn_mfma_f32_16x16x32_bf16(a, b, c, 0, 0, 0); }
DEVI int vperm(int n) { const int wc = n >> 6, nt = (n >> 4) & 3, i = n & 15; return wc * 64 + (nt >> 1) * 32 + 8 * (i >> 2) + 4 * (nt & 1) + (i & 3); }
DEVI int dperm2(int v) { return ((v >> 5) & 1) * 64 + (v >> 6) * 32 + (v & 31); }
DEVI u32x4 pk8(f32x4 a, f32x4 b) { u32x4 r; r.x = pk2(a[0], a[1]); r.y = pk2(a[2], a[3]); r.z = pk2(b[0], b[1]); r.w = pk2(b[2], b[3]); return r; }
DEVI void unpk8(u32x4 u, f32x4& a, f32x4& b) { a[0] = bflo(u.x); a[1] = bfhi(u.x); a[2] = bflo(u.y); a[3] = bfhi(u.y); b[0] = bflo(u.z); b[1] = bfhi(u.z); b[2] = bflo(u.w); b[3] = bfhi(u.w); }
DEVI int dperm(int v) { const int wc = v >> 6, nt = (v >> 4) & 3, c = v & 15; return (nt & 1) * 16 + wc * 32 + c + (nt >> 1) * 64; }

struct __attribute__((aligned(16))) GemmSmem { bf16_t a[2][128 * 64]; bf16_t b[2][128 * 64]; };
constexpr int SMEM_GEMM = sizeof(GemmSmem);
constexpr int SMEM_BYTES = SMEM_GEMM + 2048 + 16;
constexpr int SMEM_HALF = (SMEM_BYTES + 255) & ~255;
DEVI int gemm_src_chunk(int t) { return ((t & 7) ^ ((t >> 4) & 7)) * 8; }

template <bool SWAP, int BKIND>
DEVI void gemm_kloop(f32x4 (&acc)[4][4], const bf16_t* const (&pa)[4], const bf16_t* const (&pb)[4],
                     const float* pbf, int ldb, int nk, GemmSmem& sm) {
    const int t = VT, lane = t & 63, w = t >> 6, wr = w >> 1, wc = w & 1, l15 = lane & 15, q = lane >> 4;
    const int kg = t & 7, ng = t >> 3;
    f32x4 rf[8];
#define GEMM_ISSUE(BUF, KO) do { \
        _Pragma("unroll") for (int i = 0; i < 4; ++i) \
            __builtin_amdgcn_global_load_lds((const unsigned*)(pa[i] + (KO)), (unsigned*)((char*)sm.a[BUF] + i * 4096 + t * 16), 16, 0, 0); \
        if (BKIND == 0) { _Pragma("unroll") for (int i = 0; i < 4; ++i) \
            __builtin_amdgcn_global_load_lds((const unsigned*)(pb[i] + (KO)), (unsigned*)((char*)sm.b[BUF] + i * 4096 + t * 16), 16, 0, 0); } \
        else { const float* pp = pbf + (size_t)((KO) + 4 * kg) * ldb; \
            _Pragma("unroll") for (int i = 0; i < 4; ++i) { rf[i] = *(const f32x4*)(pp + (size_t)i * ldb); rf[4 + i] = *(const f32x4*)(pp + (size_t)(32 + i) * ldb); } } } while (0)
#define GEMM_LSTORE_B(BUF) do { if (BKIND == 1) { \
            _Pragma("unroll") for (int i = 0; i < 4; ++i) { \
                u32x2 v0, v1; \
                v0.x = pk2(rf[0][i], rf[1][i]); v0.y = pk2(rf[2][i], rf[3][i]); v1.x = pk2(rf[4][i], rf[5][i]); v1.y = pk2(rf[6][i], rf[7][i]); \
                const int n = 4 * ng + i, sw = (n >> 1) & 7; \
                char* rowp = (char*)sm.b[BUF] + n * 128 + (kg & 1) * 8; \
                *(u32x2*)(rowp + (((kg >> 1) ^ sw) * 16)) = v0; *(u32x2*)(rowp + (((4 + (kg >> 1)) ^ sw) * 16)) = v1; } } } while (0)
    GEMM_ISSUE(0, 0);
    GEMM_LSTORE_B(0);
    __syncthreads();
#define GEMM_KSTEP(CUR, KT) do { \
        const bool more = ((KT) + 1 < nk); \
        if (more) { GEMM_ISSUE((CUR) ^ 1, ((KT) + 1) * 64); } \
        __builtin_amdgcn_sched_barrier(0); \
        _Pragma("unroll") for (int ss = 0; ss < 2; ++ss) { \
            bf16x8 af[4], bfr[4]; \
            const int coff = ((ss * 4 + q) ^ (l15 >> 1)) * 16; \
            _Pragma("unroll") for (int i = 0; i < 4; ++i) { \
                af[i]  = *(const bf16x8*)((const char*)sm.a[CUR] + (wr * 64 + i * 16 + l15) * 128 + coff); \
                bfr[i] = *(const bf16x8*)((const char*)sm.b[CUR] + (wc * 64 + i * 16 + l15) * 128 + coff); } \
            _Pragma("unroll") for (int mt = 0; mt < 4; ++mt) \
                _Pragma("unroll") for (int nt = 0; nt < 4; ++nt) \
                    acc[mt][nt] = SWAP ? mfma16(bfr[nt], af[mt], acc[mt][nt]) : mfma16(af[mt], bfr[nt], acc[mt][nt]); } \
        __builtin_amdgcn_sched_barrier(0); \
        if (more) { GEMM_LSTORE_B((CUR) ^ 1); } \
        __syncthreads(); } while (0)
#pragma unroll 1
    for (int kt = 0; kt < nk; kt += 2) { GEMM_KSTEP(0, kt); GEMM_KSTEP(1, kt + 1); }
#undef GEMM_KSTEP
#undef GEMM_LSTORE_B
#undef GEMM_ISSUE
}

DEVI void zero_acc(f32x4 (&acc)[4][4]) {
#pragma unroll
    for (int i = 0; i < 4; ++i)
#pragma unroll
        for (int j = 0; j < 4; ++j) acc[i][j] = (f32x4){0.f, 0.f, 0.f, 0.f};
}

namespace pg8 {
#define PG8_LAS __attribute__((address_space(3)))
typedef unsigned short bf16_t;
typedef short bf16x8 __attribute__((ext_vector_type(8)));
typedef float f32x4 __attribute__((ext_vector_type(4)));
typedef unsigned u32x4 __attribute__((ext_vector_type(4)));
constexpr int BM = 256, BK = 64, HALF = 128, HTB = HALF * BK * 2  , STAGE_BYTES = 8 * HTB, NXCD = 8, WGM = 8;

__host__ __device__ __forceinline__ int lds_byte(int r, int c) { const int st = (r >> 4) * 2 + (c >> 5), rr = r & 15, cc = c & 31, ob = rr * 64 + cc * 2; return st * 1024 + (ob ^ (((ob >> 9) & 1) << 5)); }
__host__ __device__ __forceinline__ void stage_rc(int b, int& R, int& C) { const int st = b / 1024, sb = b % 1024, swz = sb ^ (((sb >> 9) & 1) << 5); R = (st >> 1) * 16 + swz / 64; C = (st & 1) * 32 + (swz % 64) / 2; }
__host__ __device__ __forceinline__ int perm32(int rho) { const int n = rho >> 4, i = rho & 15; return 8 * (i >> 2) + 4 * n + (i & 3); }

struct Unit { int pm, pn; };
struct Gemm { const bf16_t* A; const bf16_t* Bt; int M, N, K; };

struct StaticOrder {
    int nM, nN, nwg, G, c;
    __host__ __device__ void init(int M, int N, int G_, int c_) { nM = M / BM; nN = N / BM; nwg = nM * nN; G = G_; c = c_; }
    __host__ __device__ bool next(int i, Unit& u) const {
        const long L = (long)i * G + c; if (L >= nwg) return false;
        int wgid = (int)L; { const int q = nwg / NXCD, r = nwg % NXCD, xcd = wgid % NXCD, off = wgid / NXCD; wgid = (xcd < r ? xcd * (q + 1) : r * (q + 1) + (xcd - r) * q) + off; }
        const int nig = WGM * nN, gid = wgid / nig, fm = gid * WGM, gsz = (nM - fm) < WGM ? (nM - fm) : WGM;
        u.pm = fm + ((wgid % nig) % gsz); u.pn = (wgid % nig) / gsz; return true;
    }
    __device__ __forceinline__ void a_ready(const Unit&) const {}
    __device__ __forceinline__ void done(const Unit&) const {}
};


template <class Epi, class Sched, bool ALIGN_EPI = false, bool SP2 = false>
__device__ __forceinline__ void gemm_phase(PG8_LAS unsigned char* lds, const Gemm g, const Sched& S, const Epi& E) {
    const int tid = threadIdx.x, wid = __builtin_amdgcn_readfirstlane(tid >> 6), lane = tid & 63, wr = wid >> 2, wc = wid & 3, fr = lane & 15, fq = lane >> 4;
    const int K = g.K, nt = K / BK;
    unsigned voffA[2], voffB[2];
#pragma unroll
    for (int i = 0; i < 2; ++i) { int R, C; stage_rc(tid * 16 + i * 8192, R, C); const int Rb = Epi::PERM ? ((R & ~31) + perm32(R & 31)) : R;
        voffA[i] = (unsigned)(R * K + C) * 2u; voffB[i] = (unsigned)(Rb * K + C) * 2u; }
    const size_t kstep = (size_t)(BK * 2);
    const size_t hstep = (size_t)HALF * K * 2;
    const size_t tstep = 2 * hstep;
    const unsigned ldsw = (unsigned)wid * 1024u;
    const int aoff = lds_byte(wr * 64 + fr, fq * 8), boff = lds_byte(wc * 32 + fr, fq * 8);
#define PG8_SA(b, h) (((b) * 2 + (h)) * HTB)
#define PG8_SB(b, h) ((4 + (b) * 2 + (h)) * HTB)
#define PG8_STAGE(bufoff, gbase, voff) do { _Pragma("unroll") for (int _i = 0; _i < 2; ++_i) \
        __builtin_amdgcn_global_load_lds((const unsigned*)((const char*)(gbase) + (voff)[_i]), (PG8_LAS unsigned*)(lds + (bufoff) + ldsw + _i * 8192), 16, 0, 0); } while (0)
#define PG8_LDA(dst, b, h) do { _Pragma("unroll") for (int m = 0; m < 4; ++m) _Pragma("unroll") for (int k = 0; k < 2; ++k) dst[m][k] = *(const PG8_LAS bf16x8*)(lds + PG8_SA(b, h) + aoff + m * 2048 + k * 1024); } while (0)
#define PG8_LDB(dst, b, h) do { _Pragma("unroll") for (int n = 0; n < 2; ++n) _Pragma("unroll") for (int k = 0; k < 2; ++k) dst[n][k] = *(const PG8_LAS bf16x8*)(lds + PG8_SB(b, h) + boff + n * 2048 + k * 1024); } while (0)
#define PG8_MMA(ai, bj, At, Bt) do { __builtin_amdgcn_s_setprio(1); _Pragma("unroll") for (int m = 0; m < 4; ++m) _Pragma("unroll") for (int n = 0; n < 2; ++n) _Pragma("unroll") for (int k = 0; k < 2; ++k) \
        acc[ai][bj][m][n] = __builtin_amdgcn_mfma_f32_16x16x32_bf16(Bt[n][k], At[m][k], acc[ai][bj][m][n], 0, 0, 0); __builtin_amdgcn_s_setprio(0); } while (0)
#define PG8_WAIT_V(n) asm volatile("s_waitcnt vmcnt(" #n ")" ::: "memory")
#define PG8_WAIT_L(n) asm volatile("s_waitcnt lgkmcnt(" #n ")" ::: "memory")
#define PG8_BAR __builtin_amdgcn_s_barrier()
#define PG8_SCHED __builtin_amdgcn_sched_barrier(0)
    Unit cur, nxt; int ui = 0;
    if (!S.next(0, cur)) return;
    f32x4 acc[2][2][4][2];
#pragma unroll
    for (int a = 0; a < 2; ++a)
#pragma unroll
        for (int b = 0; b < 2; ++b)
#pragma unroll
            for (int m = 0; m < 4; ++m)
#pragma unroll
                for (int n = 0; n < 2; ++n) acc[a][b][m][n] = (f32x4){0.f, 0.f, 0.f, 0.f};
    bf16x8 At[4][2], B0[2][2], B1[2][2];
    const char* cA = (const char*)g.A + (size_t)cur.pm * tstep; const char* cB = (const char*)g.Bt + (size_t)cur.pn * tstep;
    S.a_ready(cur);
    if constexpr (SP2) {
        PG8_STAGE(PG8_SB(0, 0), cB, voffB); PG8_STAGE(PG8_SB(0, 1), cB + hstep, voffB); PG8_STAGE(PG8_SA(0, 0), cA, voffA); PG8_STAGE(PG8_SA(0, 1), cA + hstep, voffA);
        if (wr == 1) PG8_BAR;
        PG8_WAIT_V(2); PG8_BAR;
        PG8_STAGE(PG8_SB(1, 0), cB + kstep, voffB); PG8_STAGE(PG8_SA(1, 0), cA + kstep, voffA); PG8_STAGE(PG8_SB(1, 1), cB + hstep + kstep, voffB);
        PG8_WAIT_V(6); PG8_BAR;
    } else {
        PG8_STAGE(PG8_SB(0, 0), cB, voffB); PG8_STAGE(PG8_SA(0, 0), cA, voffA); PG8_STAGE(PG8_SB(0, 1), cB + hstep, voffB); PG8_STAGE(PG8_SA(0, 1), cA + hstep, voffA);
        if (wr == 1) PG8_BAR;
        PG8_WAIT_V(4); PG8_BAR;
        PG8_STAGE(PG8_SB(1, 0), cB + kstep, voffB); PG8_STAGE(PG8_SA(1, 0), cA + kstep, voffA); PG8_STAGE(PG8_SB(1, 1), cB + hstep + kstep, voffB);
        PG8_WAIT_V(6); PG8_BAR;
    }
    for (;;) {
        const bool has_next = S.next(ui + 1, nxt);
        const char* nA = has_next ? (const char*)g.A + (size_t)nxt.pm * tstep : cA; const char* nB = has_next ? (const char*)g.Bt + (size_t)nxt.pn * tstep : cB;
        for (int t = 0; t < nt; t += 2) {
            const bool last = (t == nt - 2);
            const char* a1 = cA + (size_t)(t + 1) * kstep;
            const char* a2 = last ? nA : cA + (size_t)(t + 2) * kstep; const char* b2 = last ? nB : cB + (size_t)(t + 2) * kstep;
            const char* a3 = a2 + kstep; const char* b3 = b2 + kstep;
            if (last && has_next) S.a_ready(nxt);
            if constexpr (SP2) {
            PG8_LDB(B0, 0, 0); PG8_LDB(B1, 0, 1); PG8_SCHED; PG8_LDA(At, 0, 0); PG8_STAGE(PG8_SA(1, 1), a1 + hstep, voffA);
            PG8_WAIT_V(8); PG8_WAIT_L(0); PG8_BAR; PG8_MMA(0, 0, At, B0); PG8_MMA(0, 1, At, B1); PG8_BAR; PG8_SCHED;
            PG8_LDA(At, 0, 1); PG8_STAGE(PG8_SB(0, 0), b2, voffB); PG8_STAGE(PG8_SB(0, 1), b2 + hstep, voffB); PG8_STAGE(PG8_SA(0, 0), a2, voffA);
            PG8_WAIT_V(8); PG8_WAIT_L(0); PG8_BAR; PG8_MMA(1, 0, At, B0); PG8_MMA(1, 1, At, B1); PG8_BAR; PG8_SCHED;
            PG8_LDB(B0, 1, 0); PG8_LDB(B1, 1, 1); PG8_SCHED; PG8_LDA(At, 1, 0); PG8_STAGE(PG8_SA(0, 1), a2 + hstep, voffA);
            PG8_WAIT_V(8); PG8_WAIT_L(0); PG8_BAR; PG8_MMA(0, 0, At, B0); PG8_MMA(0, 1, At, B1); PG8_BAR; PG8_SCHED;
            PG8_LDA(At, 1, 1); PG8_STAGE(PG8_SB(1, 0), b3, voffB); PG8_STAGE(PG8_SB(1, 1), b3 + hstep, voffB); PG8_STAGE(PG8_SA(1, 0), a3, voffA);
            PG8_WAIT_V(8); PG8_WAIT_L(0); PG8_BAR; PG8_MMA(1, 0, At, B0); PG8_MMA(1, 1, At, B1); PG8_BAR; PG8_SCHED;
            } else {
            PG8_LDB(B0, 0, 0); PG8_SCHED; PG8_LDA(At, 0, 0); PG8_STAGE(PG8_SA(1, 1), a1 + hstep, voffA);
            PG8_WAIT_L(8); PG8_BAR; PG8_WAIT_L(0); PG8_MMA(0, 0, At, B0); PG8_BAR; PG8_SCHED;
            PG8_LDB(B1, 0, 1); PG8_STAGE(PG8_SB(0, 0), b2, voffB);
            PG8_BAR; PG8_WAIT_L(0); PG8_MMA(0, 1, At, B1); PG8_BAR;
            PG8_LDA(At, 0, 1); PG8_STAGE(PG8_SA(0, 0), a2, voffA);
            PG8_BAR; PG8_WAIT_L(0); PG8_MMA(1, 0, At, B0); PG8_BAR; PG8_SCHED;
            PG8_STAGE(PG8_SB(0, 1), b2 + hstep, voffB);
            PG8_WAIT_V(6); PG8_BAR; PG8_MMA(1, 1, At, B1); PG8_BAR;
            PG8_LDB(B0, 1, 0); PG8_SCHED; PG8_LDA(At, 1, 0); PG8_STAGE(PG8_SA(0, 1), a2 + hstep, voffA);
            PG8_WAIT_L(8); PG8_BAR; PG8_WAIT_L(0); PG8_MMA(0, 0, At, B0); PG8_BAR; PG8_SCHED;
            PG8_LDB(B1, 1, 1); PG8_STAGE(PG8_SB(1, 0), b3, voffB);
            PG8_BAR; PG8_WAIT_L(0); PG8_MMA(0, 1, At, B1); PG8_BAR;
            PG8_LDA(At, 1, 1); PG8_STAGE(PG8_SA(1, 0), a3, voffA);
            PG8_BAR; PG8_WAIT_L(0); PG8_MMA(1, 0, At, B0); PG8_BAR; PG8_SCHED;
            PG8_STAGE(PG8_SB(1, 1), b3 + hstep, voffB);
            PG8_WAIT_V(6); PG8_BAR; PG8_MMA(1, 1, At, B1); PG8_BAR;
            }
        }
        if constexpr (ALIGN_EPI) { if (wr == 0) PG8_BAR; }
        if constexpr (!Epi::AFTER_DRAIN) { E(acc, cur, wr, wc, fr, fq); S.done(cur); }
        if (!has_next) break;
#pragma unroll
        for (int a = 0; a < 2; ++a)
#pragma unroll
            for (int b = 0; b < 2; ++b)
#pragma unroll
                for (int m = 0; m < 4; ++m)
#pragma unroll
                    for (int n = 0; n < 2; ++n) acc[a][b][m][n] = (f32x4){0.f, 0.f, 0.f, 0.f};
        cur = nxt; cA = nA; cB = nB; ++ui;
        if constexpr (ALIGN_EPI) { if (wr == 1) PG8_BAR; }
    }
    PG8_WAIT_V(0);
    if constexpr (!ALIGN_EPI) { if (wr == 0) PG8_BAR; }
    PG8_BAR;
    if constexpr (Epi::AFTER_DRAIN) { E.fused(acc, cur, wr, wc, fr, fq, lds, wid, lane); S.done(cur); }
#undef PG8_SA
#undef PG8_SB
#undef PG8_STAGE
#undef PG8_LDA
#undef PG8_LDB
#undef PG8_MMA
#undef PG8_WAIT_V
#undef PG8_WAIT_L
#undef PG8_BAR
#undef PG8_SCHED
}
template <class Epi, class Sched, bool ALIGN_EPI = false, bool SP2 = false>
__device__ __forceinline__ void gemm_phase_g(PG8_LAS unsigned char* lds, const int K, const Sched& S, const Epi& E) {
    const int tid = threadIdx.x, wid = __builtin_amdgcn_readfirstlane(tid >> 6), lane = tid & 63, wr = wid >> 2, wc = wid & 3, fr = lane & 15, fq = lane >> 4;
    const int nt = K / BK;
    unsigned voffB[2]; int rowA[2], colA[2];
#pragma unroll
    for (int i = 0; i < 2; ++i) { int R, C; stage_rc(tid * 16 + i * 8192, R, C); const int Rb = Epi::PERM ? ((R & ~31) + perm32(R & 31)) : R;
        rowA[i] = R; colA[i] = C * 2; voffB[i] = (unsigned)(Rb * K + C) * 2u; }
    const size_t kstep = (size_t)(BK * 2);
    const size_t hstep = (size_t)HALF * K * 2;
    const size_t tstep = 2 * hstep;
    const unsigned ldsw = (unsigned)wid * 1024u;
    const int aoff = lds_byte(wr * 64 + fr, fq * 8), boff = lds_byte(wc * 32 + fr, fq * 8);
#define PG8_SA(b, h) (((b) * 2 + (h)) * HTB)
#define PG8_SB(b, h) ((4 + (b) * 2 + (h)) * HTB)
#define PG8_STAGE(bufoff, gbase, voff) do { _Pragma("unroll") for (int _i = 0; _i < 2; ++_i) \
        __builtin_amdgcn_global_load_lds((const unsigned*)((const char*)(gbase) + (voff)[_i]), (PG8_LAS unsigned*)(lds + (bufoff) + ldsw + _i * 8192), 16, 0, 0); } while (0)
#define PG8_STAGEA(bufoff, P0, P1, koff) do { \
        __builtin_amdgcn_global_load_lds((const unsigned*)(Ab + (size_t)(P0) + (koff)), (PG8_LAS unsigned*)(lds + (bufoff) + ldsw), 16, 0, 0); \
        __builtin_amdgcn_global_load_lds((const unsigned*)(Ab + (size_t)(P1) + (koff)), (PG8_LAS unsigned*)(lds + (bufoff) + ldsw + 8192), 16, 0, 0); } while (0)
#define PG8_LDA(dst, b, h) do { _Pragma("unroll") for (int m = 0; m < 4; ++m) _Pragma("unroll") for (int k = 0; k < 2; ++k) dst[m][k] = *(const PG8_LAS bf16x8*)(lds + PG8_SA(b, h) + aoff + m * 2048 + k * 1024); } while (0)
#define PG8_LDB(dst, b, h) do { _Pragma("unroll") for (int n = 0; n < 2; ++n) _Pragma("unroll") for (int k = 0; k < 2; ++k) dst[n][k] = *(const PG8_LAS bf16x8*)(lds + PG8_SB(b, h) + boff + n * 2048 + k * 1024); } while (0)
#define PG8_MMA(ai, bj, At, Bt) do { __builtin_amdgcn_s_setprio(1); _Pragma("unroll") for (int m = 0; m < 4; ++m) _Pragma("unroll") for (int n = 0; n < 2; ++n) _Pragma("unroll") for (int k = 0; k < 2; ++k) \
        acc[ai][bj][m][n] = __builtin_amdgcn_mfma_f32_16x16x32_bf16(Bt[n][k], At[m][k], acc[ai][bj][m][n], 0, 0, 0); __builtin_amdgcn_s_setprio(0); } while (0)
#define PG8_WAIT_V(n) asm volatile("s_waitcnt vmcnt(" #n ")" ::: "memory")
#define PG8_WAIT_L(n) asm volatile("s_waitcnt lgkmcnt(" #n ")" ::: "memory")
#define PG8_BAR __builtin_amdgcn_s_barrier()
#define PG8_SCHED __builtin_amdgcn_sched_barrier(0)
    Unit cur, nxt; int ui = 0;
    if (!S.next(0, cur)) return;
    f32x4 acc[2][2][4][2];
#pragma unroll
    for (int a = 0; a < 2; ++a)
#pragma unroll
        for (int b = 0; b < 2; ++b)
#pragma unroll
            for (int m = 0; m < 4; ++m)
#pragma unroll
                for (int n = 0; n < 2; ++n) acc[a][b][m][n] = (f32x4){0.f, 0.f, 0.f, 0.f};
    bf16x8 At[4][2], B0[2][2], B1[2][2];
    const char* cB = S.b_base(cur);
    unsigned cA00, cA01, cA10, cA11, nA00, nA01, nA10, nA11;
    const char* const Ab = S.a_base();
    S.a_rows(cur, rowA, colA, cA00, cA01, cA10, cA11);
    S.a_ready(cur);
    if constexpr (SP2) {
        PG8_STAGE(PG8_SB(0, 0), cB, voffB); PG8_STAGE(PG8_SB(0, 1), cB + hstep, voffB); PG8_STAGEA(PG8_SA(0, 0), cA00, cA01, 0); PG8_STAGEA(PG8_SA(0, 1), cA10, cA11, 0);
        if (wr == 1) PG8_BAR;
        PG8_WAIT_V(2); PG8_BAR;
        PG8_STAGE(PG8_SB(1, 0), cB + kstep, voffB); PG8_STAGEA(PG8_SA(1, 0), cA00, cA01, kstep); PG8_STAGE(PG8_SB(1, 1), cB + hstep + kstep, voffB);
        PG8_WAIT_V(6); PG8_BAR;
    } else {
        PG8_STAGE(PG8_SB(0, 0), cB, voffB); PG8_STAGEA(PG8_SA(0, 0), cA00, cA01, 0); PG8_STAGE(PG8_SB(0, 1), cB + hstep, voffB); PG8_STAGEA(PG8_SA(0, 1), cA10, cA11, 0);
        if (wr == 1) PG8_BAR;
        PG8_WAIT_V(4); PG8_BAR;
        PG8_STAGE(PG8_SB(1, 0), cB + kstep, voffB); PG8_STAGEA(PG8_SA(1, 0), cA00, cA01, kstep); PG8_STAGE(PG8_SB(1, 1), cB + hstep + kstep, voffB);
        PG8_WAIT_V(6); PG8_BAR;
    }
    for (;;) {
        const bool has_next = S.next(ui + 1, nxt);
        const char* nB = has_next ? S.b_base(nxt) : cB;
        if (has_next) S.a_rows(nxt, rowA, colA, nA00, nA01, nA10, nA11); else { nA00 = cA00; nA01 = cA01; nA10 = cA10; nA11 = cA11; }
        for (int t = 0; t < nt; t += 2) {
            const bool last = (t == nt - 2);
            const size_t k1 = (size_t)(t + 1) * kstep;
            const size_t k2 = last ? 0 : (size_t)(t + 2) * kstep; const char* b2 = last ? nB : cB + (size_t)(t + 2) * kstep;
            const unsigned q00 = last ? nA00 : cA00, q01 = last ? nA01 : cA01, q10 = last ? nA10 : cA10, q11 = last ? nA11 : cA11;
            const size_t k3 = k2 + kstep; const char* b3 = b2 + kstep;
            if (last && has_next) S.a_ready(nxt);
            if constexpr (SP2) {
            PG8_LDB(B0, 0, 0); PG8_LDB(B1, 0, 1); PG8_SCHED; PG8_LDA(At, 0, 0); PG8_STAGEA(PG8_SA(1, 1), cA10, cA11, k1);
            PG8_WAIT_V(8); PG8_WAIT_L(0); PG8_BAR; PG8_MMA(0, 0, At, B0); PG8_MMA(0, 1, At, B1); PG8_BAR; PG8_SCHED;
            PG8_LDA(At, 0, 1); PG8_STAGE(PG8_SB(0, 0), b2, voffB); PG8_STAGE(PG8_SB(0, 1), b2 + hstep, voffB); PG8_STAGEA(PG8_SA(0, 0), q00, q01, k2);
            PG8_WAIT_V(8); PG8_WAIT_L(0); PG8_BAR; PG8_MMA(1, 0, At, B0); PG8_MMA(1, 1, At, B1); PG8_BAR; PG8_SCHED;
            PG8_LDB(B0, 1, 0); PG8_LDB(B1, 1, 1); PG8_SCHED; PG8_LDA(At, 1, 0); PG8_STAGEA(PG8_SA(0, 1), q10, q11, k2);
            PG8_WAIT_V(8); PG8_WAIT_L(0); PG8_BAR; PG8_MMA(0, 0, At, B0); PG8_MMA(0, 1, At, B1); PG8_BAR; PG8_SCHED;
            PG8_LDA(At, 1, 1); PG8_STAGE(PG8_SB(1, 0), b3, voffB); PG8_STAGE(PG8_SB(1, 1), b3 + hstep, voffB); PG8_STAGEA(PG8_SA(1, 0), q00, q01, k3);
            PG8_WAIT_V(8); PG8_WAIT_L(0); PG8_BAR; PG8_MMA(1, 0, At, B0); PG8_MMA(1, 1, At, B1); PG8_BAR; PG8_SCHED;
            } else {
            PG8_LDB(B0, 0, 0); PG8_SCHED; PG8_LDA(At, 0, 0); PG8_STAGEA(PG8_SA(1, 1), cA10, cA11, k1);
            PG8_WAIT_L(8); PG8_BAR; PG8_WAIT_L(0); PG8_MMA(0, 0, At, B0); PG8_BAR; PG8_SCHED;
            PG8_LDB(B1, 0, 1); PG8_STAGE(PG8_SB(0, 0), b2, voffB);
            PG8_BAR; PG8_WAIT_L(0); PG8_MMA(0, 1, At, B1); PG8_BAR;
            PG8_LDA(At, 0, 1); PG8_STAGEA(PG8_SA(0, 0), q00, q01, k2);
            PG8_BAR; PG8_WAIT_L(0); PG8_MMA(1, 0, At, B0); PG8_BAR; PG8_SCHED;
            PG8_STAGE(PG8_SB(0, 1), b2 + hstep, voffB);
            PG8_WAIT_V(6); PG8_BAR; PG8_MMA(1, 1, At, B1); PG8_BAR;
            PG8_LDB(B0, 1, 0); PG8_SCHED; PG8_LDA(At, 1, 0); PG8_STAGEA(PG8_SA(0, 1), q10, q11, k2);
            PG8_WAIT_L(8); PG8_BAR; PG8_WAIT_L(0); PG8_MMA(0, 0, At, B0); PG8_BAR; PG8_SCHED;
            PG8_LDB(B1, 1, 1); PG8_STAGE(PG8_SB(1, 0), b3, voffB);
            PG8_BAR; PG8_WAIT_L(0); PG8_MMA(0, 1, At, B1); PG8_BAR;
            PG8_LDA(At, 1, 1); PG8_STAGEA(PG8_SA(1, 0), q00, q01, k3);
            PG8_BAR; PG8_WAIT_L(0); PG8_MMA(1, 0, At, B0); PG8_BAR; PG8_SCHED;
            PG8_STAGE(PG8_SB(1, 1), b3 + hstep, voffB);
            PG8_WAIT_V(6); PG8_BAR; PG8_MMA(1, 1, At, B1); PG8_BAR;
            }
        }
        if constexpr (ALIGN_EPI) { if (wr == 0) PG8_BAR; }
        if constexpr (!Epi::AFTER_DRAIN) { E(acc, cur, wr, wc, fr, fq); S.done(cur); }
        if (!has_next) break;
#pragma unroll
        for (int a = 0; a < 2; ++a)
#pragma unroll
            for (int b = 0; b < 2; ++b)
#pragma unroll
                for (int m = 0; m < 4; ++m)
#pragma unroll
                    for (int n = 0; n < 2; ++n) acc[a][b][m][n] = (f32x4){0.f, 0.f, 0.f, 0.f};
        cur = nxt; cA00 = nA00; cA01 = nA01; cA10 = nA10; cA11 = nA11; cB = nB; ++ui;
        if constexpr (ALIGN_EPI) { if (wr == 1) PG8_BAR; }
    }
    PG8_WAIT_V(0);
    if constexpr (!ALIGN_EPI) { if (wr == 0) PG8_BAR; }
    PG8_BAR;
    if constexpr (Epi::AFTER_DRAIN) { E.fused(acc, cur, wr, wc, fr, fq, lds, wid, lane); S.done(cur); }
#undef PG8_SA
#undef PG8_SB
#undef PG8_STAGE
#undef PG8_STAGEA
#undef PG8_LDA
#undef PG8_LDB
#undef PG8_MMA
#undef PG8_WAIT_V
#undef PG8_WAIT_L
#undef PG8_BAR
#undef PG8_SCHED
}
}

DEVI void wt_colinfo(const Params& p, int R, const float*& src, int& ld, float& scale) {
    scale = 1.0f; src = nullptr; ld = 0;
    if (R < WT_AT) {
        const int pn = R >> 8, cl = R & 255; ld = DIN_; int col = -1;
        if (pn < 4) { const int wcq = (cl >> 5) & 3; col = (pn >> 1) * 512 + (2 * (pn & 1) + (wcq >> 1)) * 128 + 64 * (cl >> 7) + 32 * (wcq & 1) + (cl & 31);
                      if (pn >= 2) scale = KSCALE_; }
        else if (pn < 8)  col = 2048 + (pn - 4) * 256 + cl;
        else if (pn < 10) { col = 3072 + (pn - 8) * 256 + cl; scale = KSCALE_; }
        else if (pn < 14) col = 5120 + (pn - 10) * 256 + cl;
        else if (pn < 22) col = 6160 + (pn - 14) * 256 + cl;
        else if (cl < 16) col = 6144 + cl;
        if (col >= 0) src = p.w_in + col;
    } else if (R < WT_RET) {
        const int Rr = R - WT_AT, pm = Rr >> 8, rl = Rr & 255; ld = DIN_; int col;
        if (pm < 2) { col = 512 + (2 * pm + ((rl >> 6) & 1)) * 128 + 64 * (rl >> 7) + (rl & 63); scale = KSCALE_; }
        else if (pm < 6) col = 1024 + (pm - 2) * 256 + rl;
        else if (pm < 8) col = 3584 + (pm - 6) * 256 + rl;
        else             col = 4096 + (pm - 8) * 256 + rl;
        src = p.w_in + col;
    } else {
        int Rr, ldd; const float* base;
        if (R < WT_GLA)    { Rr = R - WT_RET; base = p.w_ret_out; ldd = 1024; }
        else if (R < WT_O) { Rr = R - WT_GLA; base = p.w_gla_out; ldd = 1024; }
        else if (R < WT_R) { Rr = R - WT_O;   base = p.w_o;       ldd = 1024; }
        else               { Rr = R - WT_R;   base = p.router_w;  ldd = 256; }
        src = base + ((R >= WT_R) ? ((Rr & ~127) + vperm(Rr & 127)) : Rr); ld = ldd;
    }
}

DEVI void phase0(const Params& p, unsigned char* smem) {
    const int tid = VT, nb = VG, bid = VB;
    float2* cs = (float2*)(p.ws + OFF_CS);
    for (int i = bid * 256 + tid; i < 4096 * 64; i += nb * 256) {
        const int pos = i >> 6, k = i & 63;
        const float angf = (float)pos * c_inv_freq[k];
        const double a = (double)angf;
        const double TWO_PI = 6.283185307179586476925286766559, HALF_PI = 1.5707963267948966192313216916398;
        const double kk = rint(a * (1.0 / TWO_PI));
        const double r = a - kk * TWO_PI;
        const double qd = rint(r * (1.0 / HALF_PI));
        const double y = r - qd * HALF_PI;
        const double y2 = y * y;
        double sn = y * (1.0 + y2 * (-1.0 / 6 + y2 * (1.0 / 120 + y2 * (-1.0 / 5040 + y2 * (1.0 / 362880 + y2 * (-1.0 / 39916800 + y2 * (1.0 / 6227020800.0)))))));
        double cn = 1.0 + y2 * (-0.5 + y2 * (1.0 / 24 + y2 * (-1.0 / 720 + y2 * (1.0 / 40320 + y2 * (-1.0 / 3628800 + y2 * (1.0 / 479001600.0))))));
        const int qi = ((int)qd) & 3;
        double s, c;
        if (qi == 0) { s = sn; c = cn; } else if (qi == 1) { s = cn; c = -sn; } else if (qi == 2) { s = -sn; c = -cn; } else { s = -cn; c = sn; }
        cs[i] = make_float2((float)c, (float)s);
    }
    if (bid == 0) { int* cnt = (int*)(p.ws + OFF_CNT); for (int i = tid; i < 512; i += 256) cnt[i] = 0; }
    {
        const f32x4* xs = (const f32x4*)p.x; u32x4* xd = (u32x4*)(p.ws + OFF_XB);
        const int n8 = T_ * D_ / 8;
        for (int g = bid * 256 + tid; g < n8; g += nb * 256) {
            const f32x4 v0 = xs[2 * g], v1 = xs[2 * g + 1];
            u32x4 o; o.x = pk2(v0[0], v0[1]); o.y = pk2(v0[2], v0[3]); o.z = pk2(v1[0], v1[1]); o.w = pk2(v1[2], v1[3]);
            xd[g] = o;
        }
    }
    {
        float* tile = (float*)smem;
        bf16_t* wt = (bf16_t*)(p.ws + OFF_WT);
        const int ntask = (WT_ROWS / 64) * 16;
        for (int task = bid; task < ntask; task += nb) {
            const int rt = task >> 4, kt = task & 15, R0 = rt * 64, k0 = kt * 64;
            {
                const int n = tid & 63, kq = tid >> 6;
                const float* src; int ld; float sc; wt_colinfo(p, R0 + n, src, ld, sc);
#pragma unroll
                for (int i = 0; i < 16; ++i) { const int k = kq + 4 * i; tile[k * 65 + n] = src ? src[(size_t)(k0 + k) * ld] * sc : 0.f; }
            }
            __syncthreads();
            {
                const int n = tid >> 2, ks = (tid & 3) * 16;
                unsigned o[8];
#pragma unroll
                for (int j = 0; j < 8; ++j) o[j] = pk2(tile[(ks + 2 * j) * 65 + n], tile[(ks + 2 * j + 1) * 65 + n]);
                u32x4* dst = (u32x4*)(wt + (size_t)(R0 + n) * 1024 + k0 + ks);
                dst[0] = (u32x4){o[0], o[1], o[2], o[3]}; dst[1] = (u32x4){o[4], o[5], o[6], o[7]};
            }
            __syncthreads();
        }
    }
}

struct EpiP1N {
    static constexpr bool PERM = true, AFTER_DRAIN = false;
    unsigned char* ws;
    __device__ __forceinline__ void operator()(const pg8::f32x4 (&acc)[2][2][4][2], const pg8::Unit& u, int wr, int wc, int fr, int fq) const {
        const int pn = u.pn, row0 = u.pm * 256 + wr * 64 + fr, c8 = wc * 32 + 8 * fq;
        if (pn < 4) {
            const float2* cs = (const float2*)(ws + OFF_CS); bf16_t* Qr = (bf16_t*)(ws + (pn < 2 ? OFF_QR : OFF_KR));
            const int head = 2 * (pn & 1) + (wc >> 1), d0 = 32 * (wc & 1) + 8 * fq;
#pragma unroll
            for (int ai = 0; ai < 2; ++ai)
#pragma unroll
                for (int m = 0; m < 4; ++m) {
                    const size_t row = row0 + ai * 128 + m * 16; const int pos = (int)(row & 4095);
                    f32x4 c4[4];
#pragma unroll
                    for (int j = 0; j < 4; ++j) c4[j] = *(const f32x4*)(cs + pos * 64 + d0 + 2 * j);
                    f32x4 o1[2], o2[2];
#pragma unroll
                    for (int n = 0; n < 2; ++n)
#pragma unroll
                        for (int r = 0; r < 4; ++r) {
                            const f32x4 cc = c4[2 * n + (r >> 1)]; const float c_ = cc[(r & 1) * 2], s_ = cc[(r & 1) * 2 + 1];
                            const float x1 = acc[ai][0][m][n][r], x2 = acc[ai][1][m][n][r];
                            o1[n][r] = x1 * c_ - x2 * s_; o2[n][r] = x1 * s_ + x2 * c_;
                        }
                    *(u32x4*)(Qr + row * 512 + head * 128 + d0) = pk8(o1[0], o1[1]);
                    *(u32x4*)(Qr + row * 512 + head * 128 + 64 + d0) = pk8(o2[0], o2[1]);
                    asm volatile("" ::: "memory");
                }
        } else {
#pragma unroll
            for (int ai = 0; ai < 2; ++ai)
#pragma unroll
                for (int m = 0; m < 4; ++m) {
                    const size_t row = row0 + ai * 128 + m * 16;
#pragma unroll
                    for (int bj = 0; bj < 2; ++bj) {
                        const int cl = bj * 128 + c8;
                        f32x4 v0 = acc[ai][bj][m][0], v1 = acc[ai][bj][m][1];
                        if (pn < 8) {
#pragma unroll
                            for (int r = 0; r < 4; ++r) { v0[r] = siluf_(v0[r]); v1[r] = siluf_(v1[r]); }
                            *(u32x4*)((bf16_t*)(ws + OFF_GS) + row * 2048 + (pn - 4) * 256 + cl) = pk8(v0, v1);
                        } else if (pn < 10) {
                            *(u32x4*)((bf16_t*)(ws + OFF_QG) + row * 512 + (pn - 8) * 256 + cl) = pk8(v0, v1);
                        } else if (pn < 14) {
#pragma unroll
                            for (int r = 0; r < 4; ++r) { v0[r] = siluf_(v0[r]); v1[r] = siluf_(v1[r]); }
                            *(u32x4*)((bf16_t*)(ws + OFF_GS) + row * 2048 + 1024 + (pn - 10) * 256 + cl) = pk8(v0, v1);
                        } else if (pn < 22) {
#pragma unroll
                            for (int r = 0; r < 4; ++r) { v0[r] = sigmoidf_(v0[r]); v1[r] = sigmoidf_(v1[r]); }
                            *(u32x4*)((bf16_t*)(ws + OFF_MG) + row * 2048 + (pn - 14) * 256 + cl) = pk8(v0, v1);
                        } else if (cl < 16) {
                            float* Ga = (float*)(ws + OFF_GA); *(f32x4*)(Ga + row * 16 + cl) = v0; *(f32x4*)(Ga + row * 16 + cl + 4) = v1;
                        }
                    }
                    asm volatile("" ::: "memory");
                }
        }
    }
};
struct EpiP1K {
    static constexpr bool PERM = true, AFTER_DRAIN = false;
    unsigned char* ws;
    __device__ __forceinline__ void operator()(const pg8::f32x4 (&acc)[2][2][4][2], const pg8::Unit& u, int wr, int wc, int fr, int fq) const {
        const int pm = u.pm;
        {
            const float2* cs = (const float2*)(ws + OFF_CS); bf16_t* Krt = (bf16_t*)(ws + OFF_KRT);
            const int head = 2 * pm + wr; const float lg = gamma_log2(head);
            const float2* csl = cs + fr;
#pragma unroll
            for (int bj = 0; bj < 2; ++bj) {
                const int tok0 = u.pn * 256 + bj * 128 + wc * 32 + 8 * fq; const int bb = tok0 >> 12, cc = (tok0 >> 6) & 63, m0 = tok0 & 63;
                const size_t tb = ((size_t)((bb * 64 + cc) * 4 + head) * 128) * 64;
#pragma unroll
                for (int m = 0; m < 4; ++m) {
                    const int i = 16 * m + fr;
#pragma unroll
                    for (int n = 0; n < 2; ++n) {
                        f32x4 t1, t2;
#pragma unroll
                        for (int r = 0; r < 4; ++r) {
                            const int tok = tok0 + 4 * n + r;
                            const float2 c_s = csl[(tok & 4095) * 64 + 16 * m];
                            const float x1 = acc[0][bj][m][n][r], x2 = acc[1][bj][m][n][r];
                            const float o1 = x1 * c_s.x - x2 * c_s.y, o2 = x1 * c_s.y + x2 * c_s.x;
                            const float kd = __builtin_amdgcn_exp2f(lg * (float)(63 - (m0 + 4 * n + r)));
                            t1[r] = o1 * kd; t2[r] = o2 * kd;
                        }
                        *(u32x2*)(Krt + tb + (size_t)i * 64 + m0 + 4 * n) = pk4(t1);
                        *(u32x2*)(Krt + tb + (size_t)(i + 64) * 64 + m0 + 4 * n) = pk4(t2);
                        asm volatile("" ::: "memory");
                    }
                }
            }
        }
    }
};
struct EpiP1V {
    static constexpr bool PERM = true, AFTER_DRAIN = false;
    unsigned char* ws;
    __device__ __forceinline__ void operator()(const pg8::f32x4 (&acc)[2][2][4][2], const pg8::Unit& u, int wr, int wc, int fr, int fq) const {
        const int pm = u.pm + 2;
        {
#pragma unroll
            for (int ai = 0; ai < 2; ++ai) {
                bf16_t* dst; int head, hd, dbase;
                if (pm < 6)      { dst = (bf16_t*)(ws + OFF_VRT); head = pm - 2;            hd = 256; dbase = ai * 128; }
                else if (pm < 8) { dst = (bf16_t*)(ws + OFF_KGT); head = 2 * (pm - 6) + ai; hd = 128; dbase = 0; }
                else             { dst = (bf16_t*)(ws + OFF_VGT); head = pm - 8;            hd = 256; dbase = ai * 128; }
#pragma unroll
                for (int bj = 0; bj < 2; ++bj) {
                    const int tok0 = u.pn * 256 + bj * 128 + wc * 32 + 8 * fq; const int bb = tok0 >> 12, cc = (tok0 >> 6) & 63, m0 = tok0 & 63;
                    const size_t tb = ((size_t)((bb * 64 + cc) * 4 + head) * hd) * 64;
#pragma unroll
                    for (int m = 0; m < 4; ++m) {
                        const int d = dbase + wr * 64 + m * 16 + fr;
                        *(u32x4*)(dst + tb + (size_t)d * 64 + m0) = pk8(acc[ai][bj][m][0], acc[ai][bj][m][1]);
                        asm volatile("" ::: "memory");
                    }
                }
            }
        }
    }
};
DEVI void phase1(const Params& p, unsigned char* smem_all) {
    {
        pg8::StaticOrder S; S.init(T_, 5888, RG, RB);
        pg8::Gemm g; g.A = (const bf16_t*)(p.ws + OFF_XB); g.Bt = (const bf16_t*)(p.ws + OFF_WT) + (size_t)WT_BN * 1024; g.M = T_; g.N = 5888; g.K = 1024;
        EpiP1N E; E.ws = p.ws;
        pg8::gemm_phase<EpiP1N, pg8::StaticOrder, true, true>((PG8_LAS unsigned char*)smem_all, g, S, E);
    }
    __syncthreads();
    {
        pg8::StaticOrder S; S.init(2560, T_, RG, RB);
        pg8::Gemm g; g.A = (const bf16_t*)(p.ws + OFF_WT) + (size_t)(WT_AT + 512) * 1024; g.Bt = (const bf16_t*)(p.ws + OFF_XB); g.M = 2560; g.N = T_; g.K = 1024;
        EpiP1V E; E.ws = p.ws;
        pg8::gemm_phase<EpiP1V, pg8::StaticOrder, true, true>((PG8_LAS unsigned char*)smem_all, g, S, E);
    }
    __syncthreads();
    {
        pg8::StaticOrder S; S.init(512, T_, RG, RB);
        pg8::Gemm g; g.A = (const bf16_t*)(p.ws + OFF_WT) + (size_t)WT_AT * 1024; g.Bt = (const bf16_t*)(p.ws + OFF_XB); g.M = 512; g.N = T_; g.K = 1024;
        EpiP1K E; E.ws = p.ws;
        pg8::gemm_phase<EpiP1K, pg8::StaticOrder, true, true>((PG8_LAS unsigned char*)smem_all, g, S, E);
    }
}

DEVI void phase2(const Params& p, unsigned char* smem) {
    float* ga_s = (float*)smem;
    float* tot = (float*)(smem + 4096);
    const int tid = VT;
    const float* Ga = (const float*)(p.ws + OFF_GA);
    const bf16_t* Kgt = (const bf16_t*)(p.ws + OFF_KGT); bf16_t* Kg2 = (bf16_t*)(p.ws + OFF_KG2);
    float* dec = (float*)(p.ws + OFF_DEC);
    for (int it = VB; it < 2048; it += VG) {
        const int h = it & 3, c = (it >> 2) & 63, b = it >> 8;
        const int tok0 = b * 4096 + c * 64;
        ((f32x4*)ga_s)[tid] = ((const f32x4*)(Ga + (size_t)tok0 * 16))[tid];
        const int dk = tid & 127, half = tid >> 7;
        float w2[16];
#pragma unroll
        for (int r = 0; r < 16; ++r) w2[r] = p.gate_w2[r * 512 + h * 128 + dk];
        const float bias = p.gate_b[h * 128 + dk];
        __syncthreads();
        float run = 0.f; float bc[32];
#pragma unroll
        for (int ml = 0; ml < 32; ++ml) {
            const int m = half * 32 + ml;
            float z = bias;
#pragma unroll
            for (int r4 = 0; r4 < 4; ++r4) { const f32x4 g4 = *(const f32x4*)&ga_s[m * 16 + 4 * r4];
                z += g4[0] * w2[4 * r4] + g4[1] * w2[4 * r4 + 1] + g4[2] * w2[4 * r4 + 2] + g4[3] * w2[4 * r4 + 3]; }
            const float la = (fminf(z, 0.f) - __logf(1.0f + __expf(-fabsf(z)))) * (1.0f / 16.0f);
            run += la; bc[ml] = run;
        }
        tot[half * 128 + dk] = run;
        __syncthreads();
        const float t0 = tot[dk], t1 = tot[128 + dk];
        const float bend = t0 + t1, off = half ? t0 : 0.f;
        const u32x4* kp = (const u32x4*)(Kgt + ((size_t)it * 128 + dk) * 64 + half * 32);
        u32x4* kq = (u32x4*)(Kg2 + ((size_t)it * 128 + dk) * 64 + half * 32);
#pragma unroll
        for (int j = 0; j < 4; ++j) {
            u32x4 v = kp[j];
            unsigned uu[4] = {v.x, v.y, v.z, v.w};
#pragma unroll
            for (int e = 0; e < 4; ++e) {
                const float f0 = bflo(uu[e]) * __expf(bend - (bc[8 * j + 2 * e] + off));
                const float f1 = bfhi(uu[e]) * __expf(bend - (bc[8 * j + 2 * e + 1] + off));
                uu[e] = pk2(f0, f1);
            }
            kq[j] = (u32x4){uu[0], uu[1], uu[2], uu[3]};
        }
        if (half == 0) dec[(size_t)it * 128 + dk] = __expf(bend);
        __syncthreads();
    }
}

constexpr int ST_LD = 136;
template <bool GLA, int DUMMY>
DEVI void scan_item(const Params& p, bf16_t* St, int b, int h, int s) {
    const int t = VT, lane = t & 63, w = t >> 6, l15 = lane & 15, q = lane >> 4;
    const bf16_t* Ktb = (const bf16_t*)(p.ws + (GLA ? OFF_KG2 : OFF_KRT));
    const bf16_t* Vtb = (const bf16_t*)(p.ws + (GLA ? OFF_VGT : OFF_VRT));
    const bf16_t* Qb  = (const bf16_t*)(p.ws + (GLA ? OFF_QG : OFF_QR));
    const float* dec = (const float*)(p.ws + OFF_DEC);
    bf16_t* Oo = (bf16_t*)(p.ws + OFF_OO);
    const float lg = gamma_log2(h);
    const float cd = exp2f(lg * 64.0f);
    const float qdec = exp2f(lg * (float)(16 * w + l15 + 1));
    f32x4 S[2][2];
#pragma unroll
    for (int i = 0; i < 2; ++i)
#pragma unroll
        for (int j = 0; j < 2; ++j) S[i][j] = (f32x4){0.f, 0.f, 0.f, 0.f};
    if (!GLA) {
        for (int i = t; i < 32 * ST_LD / 2; i += 256) ((unsigned*)St)[i] = 0u;
        __syncthreads();
    }
    bf16x8 an[2][2], bn[2][2], qn[4]; f32x4 dn[2];
    auto issue = [&](int c_) {
        const int c = (DUMMY == 1) ? 0 : c_;
        const size_t it = (size_t)((b * 64 + c) * 4 + h);
        const bf16_t* kt = Ktb + it * 128 * 64; const bf16_t* vt = Vtb + it * 256 * 64;
#pragma unroll
        for (int mt = 0; mt < 2; ++mt)
#pragma unroll
            for (int ks = 0; ks < 2; ++ks) an[mt][ks] = *(const bf16x8*)(kt + (size_t)(32 * w + 16 * mt + l15) * 64 + ks * 32 + q * 8);
#pragma unroll
        for (int nt = 0; nt < 2; ++nt)
#pragma unroll
            for (int ks = 0; ks < 2; ++ks) bn[nt][ks] = *(const bf16x8*)(vt + (size_t)(s * 32 + 16 * nt + l15) * 64 + ks * 32 + q * 8);
        const size_t tok = (size_t)b * 4096 + c * 64 + 16 * w + l15;
#pragma unroll
        for (int ks = 0; ks < 4; ++ks) qn[ks] = *(const bf16x8*)(Qb + tok * 512 + h * 128 + ks * 32 + q * 8);
        if (GLA) {
#pragma unroll
            for (int mt = 0; mt < 2; ++mt) dn[mt] = *(const f32x4*)(dec + it * 128 + 32 * w + 16 * mt + 4 * q);
        }
    };
    issue(0);
    for (int c = 0; c < 64; ++c) {
        bf16x8 a[2][2], bv[2][2], qf[4]; f32x4 d[2];
#pragma unroll
        for (int i = 0; i < 2; ++i)
#pragma unroll
            for (int j = 0; j < 2; ++j) { a[i][j] = an[i][j]; bv[i][j] = bn[i][j]; }
#pragma unroll
        for (int i = 0; i < 4; ++i) qf[i] = qn[i];
        d[0] = dn[0]; d[1] = dn[1];
        if (c + 1 < 64) issue(c + 1);
        const size_t tok = (size_t)b * 4096 + c * 64 + 16 * w + l15;
        bf16_t* op = Oo + tok * 2048 + (GLA ? 1024 : 0) + h * 256 + s * 32 + 4 * q;
        if (!GLA) {
            f32x4 O[2] = {(f32x4){0.f, 0.f, 0.f, 0.f}, (f32x4){0.f, 0.f, 0.f, 0.f}};
#pragma unroll
            for (int ks = 0; ks < 4; ++ks)
#pragma unroll
                for (int nt = 0; nt < 2; ++nt) {
                    const bf16x8 sf = *(const bf16x8*)&St[(16 * nt + l15) * ST_LD + ks * 32 + q * 8];
                    O[nt] = mfma16(sf, qf[ks], O[nt]);
                }
#pragma unroll
            for (int nt = 0; nt < 2; ++nt) { f32x4 o = O[nt] * qdec; if (DUMMY != 2) *(u32x2*)(op + 16 * nt) = pk4(o); else asm volatile("" :: "v"(o)); }
#pragma unroll
            for (int mt = 0; mt < 2; ++mt)
#pragma unroll
                for (int nt = 0; nt < 2; ++nt) {
                    f32x4 sv = S[mt][nt] * cd;
                    sv = mfma16(a[mt][0], bv[nt][0], sv);
                    sv = mfma16(a[mt][1], bv[nt][1], sv);
                    S[mt][nt] = sv;
                }
            __syncthreads();
#pragma unroll
            for (int mt = 0; mt < 2; ++mt)
#pragma unroll
                for (int nt = 0; nt < 2; ++nt) *(u32x2*)&St[(16 * nt + l15) * ST_LD + 32 * w + 16 * mt + 4 * q] = pk4(S[mt][nt]);
            __syncthreads();
        } else {
#pragma unroll
            for (int mt = 0; mt < 2; ++mt)
#pragma unroll
                for (int nt = 0; nt < 2; ++nt) {
                    f32x4 sv = S[mt][nt] * d[mt];
                    sv = mfma16(a[mt][0], bv[nt][0], sv);
                    sv = mfma16(a[mt][1], bv[nt][1], sv);
                    S[mt][nt] = sv;
                }
            __syncthreads();
#pragma unroll
            for (int mt = 0; mt < 2; ++mt)
#pragma unroll
                for (int nt = 0; nt < 2; ++nt) *(u32x2*)&St[(16 * nt + l15) * ST_LD + 32 * w + 16 * mt + 4 * q] = pk4(S[mt][nt]);
            __syncthreads();
            f32x4 O[2] = {(f32x4){0.f, 0.f, 0.f, 0.f}, (f32x4){0.f, 0.f, 0.f, 0.f}};
#pragma unroll
            for (int ks = 0; ks < 4; ++ks)
#pragma unroll
                for (int nt = 0; nt < 2; ++nt) {
                    const bf16x8 sf = *(const bf16x8*)&St[(16 * nt + l15) * ST_LD + ks * 32 + q * 8];
                    O[nt] = mfma16(sf, qf[ks], O[nt]);
                }
#pragma unroll
            for (int nt = 0; nt < 2; ++nt) { if (DUMMY != 2) *(u32x2*)(op + 16 * nt) = pk4(O[nt]); else asm volatile("" :: "v"(O[nt])); }
        }
    }
    __syncthreads();
}

template <int DUMMY>
DEVI void phase3(const Params& p, unsigned char* smem) {
    bf16_t* St = (bf16_t*)smem;
    for (int it0 = VB; it0 < 512; it0 += VG) {
        const int lcl = (RB >> 3) * 2 + VH;
        const int it = (VG == 512) ? ((RB & 7) * 8 + lcl / 8) * 8 + (lcl & 7) : it0;
        const int s = it & 7, h = (it >> 3) & 3, b = (it >> 5) & 7, br = it >> 8;
        if (br == 0) scan_item<false, DUMMY>(p, St, b, h, s); else scan_item<true, DUMMY>(p, St, b, h, s);
    }
}

constexpr int PS_LD = 72;
DEVI void phase4(const Params& p, unsigned char* smem) {
    const int t = VT, lane = t & 63, w = t >> 6, l15 = lane & 15, q = lane >> 4;
    bf16_t* Ps = (bf16_t*)smem + w * 16 * PS_LD;
    const bf16_t* Qr = (const bf16_t*)(p.ws + OFF_QR); const bf16_t* Kr = (const bf16_t*)(p.ws + OFF_KR);
    const bf16_t* Vrt = (const bf16_t*)(p.ws + OFF_VRT); const bf16_t* Oo = (const bf16_t*)(p.ws + OFF_OO);
    const bf16_t* Gs = (const bf16_t*)(p.ws + OFF_GS); bf16_t* Y = (bf16_t*)(p.ws + OFF_Y);
    for (int it = VB; it < 4096; it += VG) {
        const int br = it >> 11, idx = it & 2047;
        const int h = idx & 3, c = (idx >> 2) & 63, b = idx >> 8;
        const size_t tok0 = (size_t)b * 4096 + c * 64;
        const size_t tok = tok0 + 16 * w + l15;
        f32x4 O[16];
        const bf16_t* orow = Oo + tok * 2048 + br * 1024 + h * 256 + 4 * q;
        const bf16_t* grow = Gs + tok * 2048 + br * 1024 + h * 256 + 4 * q;
        u32x2 oraw[16], graw[16];
        if (br == 0) {
            const float lg = gamma_log2(h);
            const bf16_t* vt = Vrt + (size_t)idx * 256 * 64;
            bf16x8 vf[8][2];
#pragma unroll
            for (int nt = 0; nt < 8; ++nt) { vf[nt][0] = *(const bf16x8*)(vt + (size_t)(16 * nt + l15) * 64 + q * 8); vf[nt][1] = *(const bf16x8*)(vt + (size_t)(16 * nt + l15) * 64 + 32 + q * 8); }
            __builtin_amdgcn_sched_barrier(0);
            f32x4 P[4] = {(f32x4){0.f, 0.f, 0.f, 0.f}, (f32x4){0.f, 0.f, 0.f, 0.f}, (f32x4){0.f, 0.f, 0.f, 0.f}, (f32x4){0.f, 0.f, 0.f, 0.f}};
#pragma unroll
            for (int ks = 0; ks < 4; ++ks) {
                const bf16x8 qf = *(const bf16x8*)(Qr + tok * 512 + h * 128 + ks * 32 + q * 8);
#pragma unroll
                for (int mt = 0; mt < 4; ++mt) {
                    const bf16x8 kf = *(const bf16x8*)(Kr + (tok0 + 16 * mt + l15) * 512 + h * 128 + ks * 32 + q * 8);
                    P[mt] = mfma16(kf, qf, P[mt]);
                }
            }
            const int j = 16 * w + l15;
#pragma unroll
            for (int mt = 0; mt < 4; ++mt) {
                f32x4 v = P[mt];
#pragma unroll
                for (int r = 0; r < 4; ++r) { const int m = 16 * mt + 4 * q + r; const int dd = j > m ? j - m : m - j; v[r] *= exp2f(lg * (float)dd); }
                *(u32x2*)&Ps[l15 * PS_LD + 16 * mt + 4 * q] = pk4(v);
            }
            __syncthreads();
            const bf16x8 pf0 = *(const bf16x8*)&Ps[l15 * PS_LD + q * 8];
            const bf16x8 pf1 = *(const bf16x8*)&Ps[l15 * PS_LD + 32 + q * 8];
            __builtin_amdgcn_sched_barrier(0);
#pragma unroll
            for (int nt = 0; nt < 8; ++nt) {
                f32x4 o = (f32x4){0.f, 0.f, 0.f, 0.f};
                o = mfma16(vf[nt][0], pf0, o); O[nt] = mfma16(vf[nt][1], pf1, o);
            }
            __builtin_amdgcn_sched_barrier(0);
#pragma unroll
            for (int nt = 0; nt < 8; ++nt) { vf[nt][0] = *(const bf16x8*)(vt + (size_t)(16 * (8 + nt) + l15) * 64 + q * 8); vf[nt][1] = *(const bf16x8*)(vt + (size_t)(16 * (8 + nt) + l15) * 64 + 32 + q * 8); }
#pragma unroll
            for (int nt = 0; nt < 16; ++nt) { oraw[nt] = *(const u32x2*)(orow + 16 * nt); graw[nt] = *(const u32x2*)(grow + 16 * nt); }
            __builtin_amdgcn_sched_barrier(0);
#pragma unroll
            for (int nt = 0; nt < 8; ++nt) {
                f32x4 o = (f32x4){0.f, 0.f, 0.f, 0.f};
                o = mfma16(vf[nt][0], pf0, o); O[8 + nt] = mfma16(vf[nt][1], pf1, o);
            }
#pragma unroll
            for (int nt = 0; nt < 16; ++nt) O[nt] += unpk4(oraw[nt]);
            __syncthreads();
        } else {
#pragma unroll
            for (int nt = 0; nt < 16; ++nt) { oraw[nt] = *(const u32x2*)(orow + 16 * nt); graw[nt] = *(const u32x2*)(grow + 16 * nt); }
#pragma unroll
            for (int nt = 0; nt < 16; ++nt) O[nt] = unpk4(oraw[nt]);
        }
        float s1 = 0.f;
#pragma unroll
        for (int nt = 0; nt < 16; ++nt) s1 += (O[nt][0] + O[nt][1]) + (O[nt][2] + O[nt][3]);
        s1 += __shfl_xor(s1, 16); s1 += __shfl_xor(s1, 32);
        const float mean = (br == 0) ? s1 * (1.0f / 256.0f) : 0.f;
        float s2 = 0.f;
#pragma unroll
        for (int nt = 0; nt < 16; ++nt) {
#pragma unroll
            for (int r = 0; r < 4; ++r) { const float dlt = O[nt][r] - mean; s2 += dlt * dlt; }
        }
        s2 += __shfl_xor(s2, 16); s2 += __shfl_xor(s2, 32);
        const float rstd = rsqrtf(s2 * (1.0f / 256.0f) + (br == 0 ? 1e-5f : 1e-6f));
        const float* gw = (br == 0 ? p.ret_norm_g : p.gla_norm_g) + h * 256 + 4 * q;
        bf16_t* yrow = Y + ((size_t)br * T_ + tok) * 1024 + h * 256 + 4 * q;
#pragma unroll
        for (int nt = 0; nt < 16; ++nt) {
            const f32x4 g = *(const f32x4*)(gw + 16 * nt);
            const f32x4 gate = unpk4(graw[nt]);
            f32x4 y;
#pragma unroll
            for (int r = 0; r < 4; ++r) y[r] = (O[nt][r] - mean) * rstd * g[r] * gate[r];
            *(u32x2*)(yrow + 16 * nt) = pk4(y);
        }
    }
}

struct EpiMerge {
    static constexpr bool PERM = true, AFTER_DRAIN = false;
    const bf16_t* Mg; bf16_t* Mrg; int pass;
    __device__ __forceinline__ void operator()(const pg8::f32x4 (&acc)[2][2][4][2], const pg8::Unit& u, int wr, int wc, int fr, int fq) const {
        const int row0 = u.pm * 256 + wr * 64 + fr, col0 = u.pn * 256 + wc * 32 + 8 * fq;
#pragma unroll
        for (int ai = 0; ai < 2; ++ai) {
            u32x4 gg[4][2], pr[4][2];
#pragma unroll
            for (int m = 0; m < 4; ++m)
#pragma unroll
                for (int bj = 0; bj < 2; ++bj) {
                    const size_t row = row0 + ai * 128 + m * 16; const int col = col0 + bj * 128;
                    gg[m][bj] = *(const u32x4*)(Mg + row * 2048 + pass * 1024 + col);
                    if (pass) pr[m][bj] = *(const u32x4*)(Mrg + row * 1024 + col);
                }
#pragma unroll
            for (int m = 0; m < 4; ++m)
#pragma unroll
                for (int bj = 0; bj < 2; ++bj) {
                    const size_t row = row0 + ai * 128 + m * 16; const int col = col0 + bj * 128;
                    f32x4 g0, g1; unpk8(gg[m][bj], g0, g1);
                    f32x4 o0 = acc[ai][bj][m][0] * g0, o1 = acc[ai][bj][m][1] * g1;
                    if (pass) { f32x4 p0, p1; unpk8(pr[m][bj], p0, p1); o0 += p0; o1 += p1; }
                    *(u32x4*)(Mrg + row * 1024 + col) = pk8(o0, o1);
                }
        }
    }
};
DEVI void phase5(const Params& p, unsigned char* smem_all) {
    pg8::StaticOrder S; S.init(T_, 1024, RG, RB);
    const bf16_t* Y = (const bf16_t*)(p.ws + OFF_Y); const bf16_t* wt = (const bf16_t*)(p.ws + OFF_WT);
    for (int pass = 0; pass < 2; ++pass) {
        pg8::Gemm g; g.A = Y + (size_t)pass * T_ * 1024; g.Bt = wt + (size_t)(pass ? WT_GLA : WT_RET) * 1024; g.M = T_; g.N = 1024; g.K = 1024;
        EpiMerge E; E.Mg = (const bf16_t*)(p.ws + OFF_MG); E.Mrg = (bf16_t*)(p.ws + OFF_MRG); E.pass = pass;
        pg8::gemm_phase<EpiMerge, pg8::StaticOrder, true, true>((PG8_LAS unsigned char*)smem_all, g, S, E);
        __syncthreads();
    }
}

struct EpiResid {
    static constexpr bool PERM = true, AFTER_DRAIN = false;
    const float* x; bf16_t* T1;
    __device__ __forceinline__ void operator()(const pg8::f32x4 (&acc)[2][2][4][2], const pg8::Unit& u, int wr, int wc, int fr, int fq) const {
        const int row0 = u.pm * 256 + wr * 64 + fr, col0 = u.pn * 256 + wc * 32 + 8 * fq;
#pragma unroll
        for (int ai = 0; ai < 2; ++ai)
#pragma unroll
            for (int m = 0; m < 4; ++m) {
                const size_t row = row0 + ai * 128 + m * 16;
                f32x4 xv[2][2];
#pragma unroll
                for (int bj = 0; bj < 2; ++bj) { xv[bj][0] = *(const f32x4*)(x + row * 1024 + col0 + bj * 128); xv[bj][1] = *(const f32x4*)(x + row * 1024 + col0 + bj * 128 + 4); }
#pragma unroll
                for (int bj = 0; bj < 2; ++bj)
                    *(u32x4*)(T1 + row * 1024 + col0 + bj * 128) = pk8(xv[bj][0] * ALPHA_ + acc[ai][bj][m][0], xv[bj][1] * ALPHA_ + acc[ai][bj][m][1]);
            }
    }
};
DEVI void phase6(const Params& p, unsigned char* smem_all) {
    pg8::StaticOrder S; S.init(T_, 1024, RG, RB);
    pg8::Gemm g; g.A = (const bf16_t*)(p.ws + OFF_MRG); g.Bt = (const bf16_t*)(p.ws + OFF_WT) + (size_t)WT_O * 1024; g.M = T_; g.N = 1024; g.K = 1024;
    EpiResid E; E.x = p.x; E.T1 = (bf16_t*)(p.ws + OFF_T1);
    pg8::gemm_phase<EpiResid, pg8::StaticOrder, true, true>((PG8_LAS unsigned char*)smem_all, g, S, E);
}

DEVI void conv_expert_weights(const Params& p, unsigned char* smem) {
    bf16_t* tile = (bf16_t*)smem;
    const int t = VT, ng = t & 31, kg = t >> 5;
    bf16_t* WGU = (bf16_t*)(p.ws + OFF_WGU); bf16_t* WD = (bf16_t*)(p.ws + OFF_WD);
    const int ntask = 257 * 3 * 32;
    for (int task = VB; task < ntask; task += VG) {
        const int e = task / 96, rem = task - e * 96, mat = rem >> 5, tl = rem & 31;
        const float* src; bf16_t* dst; int K, N, kt, nt;
        if (mat < 2) { K = 1024; N = 256; kt = tl >> 1; nt = tl & 1;
            src = (mat == 0) ? (e < 256 ? p.ew_gate + (size_t)e * 262144 : p.sw_gate) : (e < 256 ? p.ew_up + (size_t)e * 262144 : p.sw_up);
            dst = WGU + (size_t)e * 524288 + (size_t)(nt + mat) * 131072; }
        else { K = 256; N = 1024; kt = tl >> 3; nt = tl & 7;
            src = e < 256 ? p.ew_down + (size_t)e * 262144 : p.sw_down; dst = WD + (size_t)e * 262144; }
        const float* sp = src + (size_t)(kt * 64 + 4 * kg) * N + nt * 128 + 4 * ng;
        f32x4 rf[8];
#pragma unroll
        for (int i = 0; i < 4; ++i) { rf[i] = *(const f32x4*)(sp + (size_t)i * N); rf[4 + i] = *(const f32x4*)(sp + (size_t)(32 + i) * N); }
#pragma unroll
        for (int i = 0; i < 4; ++i) {
            u32x2 v0, v1;
            v0.x = pk2(rf[0][i], rf[1][i]); v0.y = pk2(rf[2][i], rf[3][i]); v1.x = pk2(rf[4][i], rf[5][i]); v1.y = pk2(rf[6][i], rf[7][i]);
            *(u32x2*)&tile[(4 * ng + i) * 72 + 4 * kg] = v0; *(u32x2*)&tile[(4 * ng + i) * 72 + 32 + 4 * kg] = v1;
        }
        __syncthreads();
        {
            const int n = t >> 1, hf = t & 1;
            bf16_t* dp = dst + (size_t)(nt * 128 + n) * K + kt * 64 + hf * 32;
#pragma unroll
            for (int j = 0; j < 4; ++j) *(u32x4*)(dp + 8 * j) = *(const u32x4*)&tile[n * 72 + hf * 32 + 8 * j];
        }
        __syncthreads();
    }
}

DEVI void phase7(const Params& p, unsigned char* smem) {
    const int t = VT, lane = t & 63, w = t >> 6;
    const bf16_t* T1 = (const bf16_t*)(p.ws + OFF_T1); bf16_t* X1b = (bf16_t*)(p.ws + OFF_X1B);
    for (int row = VB * 4 + w; row < T_; row += VG * 4) {
        f32x4 v[4]; float s = 0.f;
#pragma unroll
        for (int i = 0; i < 4; ++i) { v[i] = unpk4(*(const u32x2*)(T1 + (size_t)row * 1024 + i * 256 + lane * 4)); s += (v[i][0] + v[i][1]) + (v[i][2] + v[i][3]); }
#pragma unroll
        for (int o = 32; o > 0; o >>= 1) s += __shfl_xor(s, o);
        const float mean = s * (1.0f / 1024.0f); float s2 = 0.f;
#pragma unroll
        for (int i = 0; i < 4; ++i)
#pragma unroll
            for (int r = 0; r < 4; ++r) { const float d = v[i][r] - mean; s2 += d * d; }
#pragma unroll
        for (int o = 32; o > 0; o >>= 1) s2 += __shfl_xor(s2, o);
        const float rstd = rsqrtf(s2 * (1.0f / 1024.0f) + 1e-5f);
#pragma unroll
        for (int i = 0; i < 4; ++i) {
            const int col = i * 256 + lane * 4;
            const f32x4 g = *(const f32x4*)(p.ln1_g + col), bb = *(const f32x4*)(p.ln1_b + col);
            f32x4 y;
#pragma unroll
            for (int r = 0; r < 4; ++r) y[r] = (v[i][r] - mean) * rstd * g[r] + bb[r];
            *(u32x2*)(X1b + (size_t)row * 1024 + col) = pk4(y);
        }
    }
    conv_expert_weights(p, smem);
}

DEVI void phase8(const Params& p, unsigned char* smem) {
    GemmSmem& sm = *(GemmSmem*)smem;
    const int t = VT, lane = t & 63, w = t >> 6, wr = w >> 1, wc = w & 1, l15 = lane & 15, q = lane >> 4;
    const bf16_t* X1b = (const bf16_t*)(p.ws + OFF_X1B); const bf16_t* wt = (const bf16_t*)(p.ws + OFF_WT);
    float* LG = (float*)(p.ws + OFF_LOG);
    for (int tile = VB; tile < 256 * 2; tile += VG) {
        const int mtg = tile >> 1, ntg = tile & 1, m0 = mtg * 128, n0 = ntg * 128;
        const bf16_t* pa0 = X1b + (size_t)(m0 + (t >> 3)) * 1024 + gemm_src_chunk(t);
        const bf16_t* pb0 = wt + (size_t)(WT_R + n0 + (t >> 3)) * 1024 + gemm_src_chunk(t);
        const bf16_t* const pa[4] = {pa0, pa0 + 32 * 1024, pa0 + 64 * 1024, pa0 + 96 * 1024};
        const bf16_t* const pb[4] = {pb0, pb0 + 32 * 1024, pb0 + 64 * 1024, pb0 + 96 * 1024};
        f32x4 acc[4][4]; zero_acc(acc);
        gemm_kloop<true, 0>(acc, pa, pb, nullptr, 0, 16, sm);
#pragma unroll
        for (int mt = 0; mt < 4; ++mt)
#pragma unroll
            for (int nt = 0; nt < 4; ++nt) {
                const int row = m0 + wr * 64 + mt * 16 + l15, col = n0 + wc * 64 + (nt >> 1) * 32 + 8 * q + 4 * (nt & 1);
                *(f32x4*)(LG + (size_t)row * 256 + col) = acc[mt][nt];
            }
    }
}

DEVI unsigned f2ord(float f) { const unsigned u = __float_as_uint(f); return (u & 0x80000000u) ? ~u : (u | 0x80000000u); }
DEVI void phase9(const Params& p) {
    const int t = VT, lane = t & 63, w = t >> 6;
    const float* LG = (const float*)(p.ws + OFF_LOG);
    int* cnt = (int*)(p.ws + OFF_CNT); int* list = (int*)(p.ws + OFF_LIST); float* wts = (float*)(p.ws + OFF_WTS);
    const int tstep = VG * 4;
    int tok = VB * 4 + w;
    float lgn[4]; float rb[4];
#pragma unroll
    for (int r = 0; r < 4; ++r) { rb[r] = p.router_bias[lane + 64 * r]; lgn[r] = tok < T_ ? LG[(size_t)tok * 256 + lane + 64 * r] : 0.f; }
    int ppos = 0, pe = -1, ptk9 = 0;
    for (; tok < T_; tok += tstep) {
        float sc[4], bi[4];
#pragma unroll
        for (int r = 0; r < 4; ++r) { sc[r] = sigmoidf_(lgn[r]); bi[r] = sc[r] + rb[r]; }
        { const int tn = tok + tstep;
#pragma unroll
          for (int r = 0; r < 4; ++r) lgn[r] = tn < T_ ? LG[(size_t)tn * 256 + lane + 64 * r] : 0.f; }
        float gsc[8];
#pragma unroll
        for (int r = 0; r < 4; ++r) {
            float m1 = bi[r];
#pragma unroll
            for (int o = 16; o > 0; o >>= 1) m1 = fmaxf(m1, __shfl_xor(m1, o));
            const unsigned long long bal = __ballot(bi[r] == m1);
            const unsigned halfmask = (lane < 32) ? (unsigned)(bal & 0xffffffffull) : (unsigned)(bal >> 32);
            const int first = __ffs(halfmask) - 1;
            float m2 = ((lane & 31) == first) ? -INFINITY : bi[r];
#pragma unroll
            for (int o = 16; o > 0; o >>= 1) m2 = fmaxf(m2, __shfl_xor(m2, o));
            const float g = m1 + m2;
            gsc[2 * r] = __shfl(g, 0); gsc[2 * r + 1] = __shfl(g, 32);
        }
        unsigned selmask = 0;
#pragma unroll
        for (int g = 0; g < 8; ++g) {
            int rank = 0;
#pragma unroll
            for (int g2 = 0; g2 < 8; ++g2) rank += (gsc[g2] > gsc[g] || (gsc[g2] == gsc[g] && g2 < g)) ? 1 : 0;
            if (rank < 4) selmask |= 1u << g;
        }
        float cand[4];
#pragma unroll
        for (int r = 0; r < 4; ++r) cand[r] = ((selmask >> (2 * r + (lane >> 5))) & 1u) ? bi[r] : -INFINITY;
        float wsum = 0.f, myw = 0.f; int mye = 0;
#pragma unroll 1
        for (int k = 0; k < 8; ++k) {
            unsigned long long best = 0ull;
#pragma unroll
            for (int r = 0; r < 4; ++r) {
                const unsigned long long key = ((unsigned long long)f2ord(cand[r]) << 32) | (unsigned)(0xffffffffu - (unsigned)(lane + 64 * r));
                best = key > best ? key : best;
            }
#pragma unroll
            for (int o = 32; o > 0; o >>= 1) { const unsigned long long oth = __shfl_xor(best, o); best = oth > best ? oth : best; }
            const int e = (int)(0xffffffffu - (unsigned)(best & 0xffffffffull));
            float mine = 0.f;
#pragma unroll
            for (int r = 0; r < 4; ++r) if (e == lane + 64 * r) { mine = sc[r]; cand[r] = -INFINITY; }
            const float sv = __shfl(mine, e & 63);
            wsum += sv;
            if (lane == k) { mye = e; myw = sv; }
        }
        if (lane < 8) {
            if (pe >= 0) list[(size_t)pe * T_ + ppos] = ptk9;
            ppos = atomicAdd(&cnt[mye], 1); pe = mye; ptk9 = tok * 9 + lane;
            wts[(size_t)tok * 9 + lane] = myw / wsum * 2.5f;
        } else if (lane == 8) wts[(size_t)tok * 9 + 8] = 1.0f;
    }
    if (lane < 8 && pe >= 0) list[(size_t)pe * T_ + ppos] = ptk9;
}

DEVI void moe_prefix(const Params& p, int* pre  , int xg) {
    const int tid = VT;
    const int* cnt = (const int*)(p.ws + OFF_CNT);
    __syncthreads();
    if (tid < 64) {
        int v = 0;
        if (tid < 32) v = (__hip_atomic_load(&cnt[xg + 8 * tid], __ATOMIC_RELAXED, __HIP_MEMORY_SCOPE_AGENT) + 127) >> 7;
        else if (tid == 32) v = 32;
#pragma unroll
        for (int o = 1; o < 64; o <<= 1) { const int u = __shfl_up(v, o); if (tid >= o) v += u; }
        if (tid < 33) pre[tid + 1] = v;
        if (tid == 0) pre[0] = 0;
    }
    __syncthreads();
}
DEVI int moe_find(const int* pre, int mb) {
    int lo = 0, hi = 32;
    while (lo < hi) { const int mid = (lo + hi + 1) >> 1; if (pre[mid] <= mb) lo = mid; else hi = mid - 1; }
    return lo;
}
DEVI int moe_tk9(const int* list, int e, int pos) { return e < 256 ? list[(size_t)e * T_ + pos] : pos * 9 + 8; }

DEVI void moe_prefix256(const Params& p, int* pre  , int xg) {
    const int tid = threadIdx.x;
    const int* cnt = (const int*)(p.ws + OFF_CNT);
    __syncthreads();
    if (tid < 64) {
        int v = 0;
        if (tid < 32) v = (__hip_atomic_load(&cnt[xg + 8 * tid], __ATOMIC_RELAXED, __HIP_MEMORY_SCOPE_AGENT) + 255) >> 8;
        else if (tid == 32) v = 16;
#pragma unroll
        for (int o = 1; o < 64; o <<= 1) { const int u = __shfl_up(v, o); if (tid >= o) v += u; }
        if (tid < 33) pre[tid + 1] = v;
        if (tid == 0) pre[0] = 0;
    }
    __syncthreads();
}
struct MoeSched {
    const int* pre; const int* cnt; const int* list;
    int xg, jl, nloc, nun;
    const char* Abase; int arow_bytes; bool by_token;
    const char* Bbase; size_t b_expert_bytes, b_unit_bytes;
    __device__ __forceinline__ bool next(int i, pg8::Unit& u) const { const int item = jl + i * nloc; if (item >= pre[33] * nun) return false; u.pm = item / nun; u.pn = item - u.pm * nun; return true; }
    __device__ __forceinline__ void decode(const pg8::Unit& u, int& e, int& r0, int& ce) const {
        const int gi = moe_find(pre, u.pm), mb = u.pm - pre[gi];
        e = gi < 32 ? xg + 8 * gi : 256; ce = e < 256 ? cnt[e] : T_; r0 = (e < 256 ? 0 : xg * 4096) + mb * 256;
    }
    __device__ __forceinline__ int slot(int e, int pos) const { return e < 256 ? list[(size_t)e * T_ + pos] : pos * 9 + 8; }
    __device__ __forceinline__ const char* a_base() const { return Abase; }
    __device__ __forceinline__ void a_rows(const pg8::Unit& u, const int (&rowA)[2], const int (&colA)[2], unsigned& p00, unsigned& p01, unsigned& p10, unsigned& p11) const {
        int e, r0, ce; decode(u, e, r0, ce);
        const int fb = e < 256 ? 0 : xg * 4096;
        int s4[4];
#pragma unroll
        for (int k = 0; k < 4; ++k) { int pos = r0 + (k >> 1) * 128 + rowA[k & 1]; if (pos >= ce) pos = fb; s4[k] = slot(e, pos); }
#pragma unroll
        for (int k = 0; k < 4; ++k) if (by_token) s4[k] = s4[k] / 9;
        p00 = (unsigned)s4[0] * (unsigned)arow_bytes + (unsigned)colA[0]; p01 = (unsigned)s4[1] * (unsigned)arow_bytes + (unsigned)colA[1];
        p10 = (unsigned)s4[2] * (unsigned)arow_bytes + (unsigned)colA[0]; p11 = (unsigned)s4[3] * (unsigned)arow_bytes + (unsigned)colA[1];
    }
    __device__ __forceinline__ const char* b_base(const pg8::Unit& u) const { int e, r0, ce; decode(u, e, r0, ce); return Bbase + (size_t)e * b_expert_bytes + (size_t)u.pn * b_unit_bytes; }
    __device__ __forceinline__ void a_ready(const pg8::Unit&) const {}
    __device__ __forceinline__ void done(const pg8::Unit&) const {}
};
struct EpiMoe1 {
    static constexpr bool PERM = true, AFTER_DRAIN = false;
    const MoeSched* S; bf16_t* H;
    __device__ __forceinline__ void operator()(const pg8::f32x4 (&acc)[2][2][4][2], const pg8::Unit& u, int wr, int wc, int fr, int fq) const {
        int e, r0, ce; S->decode(u, e, r0, ce);
#pragma unroll
        for (int ai = 0; ai < 2; ++ai) {
            int sl[4];
#pragma unroll
            for (int m = 0; m < 4; ++m) { const int pos = r0 + ai * 128 + wr * 64 + m * 16 + fr; sl[m] = pos < ce ? S->slot(e, pos) : -1; }
#pragma unroll
            for (int m = 0; m < 4; ++m) if (sl[m] >= 0) {
                f32x4 h0, h1;
#pragma unroll
                for (int r = 0; r < 4; ++r) { h0[r] = siluf_(acc[ai][0][m][0][r]) * acc[ai][1][m][0][r]; h1[r] = siluf_(acc[ai][0][m][1][r]) * acc[ai][1][m][1][r]; }
                *(u32x4*)(H + (size_t)sl[m] * 256 + u.pn * 128 + wc * 32 + 8 * fq) = pk8(h0, h1);
            }
            asm volatile("" ::: "memory");
        }
    }
};
struct EpiMoe2 {
    static constexpr bool PERM = true, AFTER_DRAIN = false;
    const MoeSched* S; const float* wts; bf16_t* YX;
    __device__ __forceinline__ void operator()(const pg8::f32x4 (&acc)[2][2][4][2], const pg8::Unit& u, int wr, int wc, int fr, int fq) const {
        int e, r0, ce; S->decode(u, e, r0, ce);
#pragma unroll
        for (int ai = 0; ai < 2; ++ai) {
            int sl[4]; float wg[4];
#pragma unroll
            for (int m = 0; m < 4; ++m) { const int pos = r0 + ai * 128 + wr * 64 + m * 16 + fr; sl[m] = pos < ce ? S->slot(e, pos) : -1; }
#pragma unroll
            for (int m = 0; m < 4; ++m) wg[m] = sl[m] >= 0 ? wts[sl[m]] : 0.f;
#pragma unroll
            for (int m = 0; m < 4; ++m) if (sl[m] >= 0) {
#pragma unroll
                for (int bj = 0; bj < 2; ++bj)
                    *(u32x4*)(YX + (size_t)sl[m] * 1024 + u.pn * 256 + bj * 128 + wc * 32 + 8 * fq) = pk8(acc[ai][bj][m][0] * wg[m], acc[ai][bj][m][1] * wg[m]);
            }
            asm volatile("" ::: "memory");
        }
    }
};
DEVI void moe_sched_init(const Params& p, MoeSched& S, int* pre) {
    S.pre = pre; S.cnt = (const int*)(p.ws + OFF_CNT); S.list = (const int*)(p.ws + OFF_LIST);
    S.xg = RB & 7; S.jl = RB >> 3; S.nloc = RG >> 3;
}
DEVI void phase10(const Params& p, unsigned char* smem_all) {
    int* pre = (int*)(smem_all + 131072);
    MoeSched S; moe_sched_init(p, S, pre); moe_prefix256(p, pre, S.xg);
    S.nun = 2; S.Abase = (const char*)(p.ws + OFF_X1B); S.arow_bytes = 2048; S.by_token = true;
    S.Bbase = (const char*)(p.ws + OFF_WGU); S.b_expert_bytes = (size_t)512 * 1024 * 2; S.b_unit_bytes = (size_t)256 * 1024 * 2;
    EpiMoe1 E; E.S = &S; E.H = (bf16_t*)(p.ws + OFF_H);
    pg8::gemm_phase_g<EpiMoe1, MoeSched, true, true>((PG8_LAS unsigned char*)smem_all, 1024, S, E);
}
DEVI void phase11(const Params& p, unsigned char* smem_all) {
    int* pre = (int*)(smem_all + 131072);
    MoeSched S; moe_sched_init(p, S, pre); moe_prefix256(p, pre, S.xg);
    S.nun = 4; S.Abase = (const char*)(p.ws + OFF_H); S.arow_bytes = 512; S.by_token = false;
    S.Bbase = (const char*)(p.ws + OFF_WD); S.b_expert_bytes = (size_t)1024 * 256 * 2; S.b_unit_bytes = (size_t)256 * 256 * 2;
    EpiMoe2 E; E.S = &S; E.wts = (const float*)(p.ws + OFF_WTS); E.YX = (bf16_t*)(p.ws + OFF_YX);
    pg8::gemm_phase_g<EpiMoe2, MoeSched, true, true>((PG8_LAS unsigned char*)smem_all, 256, S, E);
}

DEVI void phase12(const Params& p) {
    const int t = VT, lane = t & 63, w = t >> 6;
    const bf16_t* X1b = (const bf16_t*)(p.ws + OFF_X1B); const bf16_t* YX = (const bf16_t*)(p.ws + OFF_YX);
    for (int row = VB * 4 + w; row < T_; row += VG * 4) {
        f32x4 v[4]; float s = 0.f;
#pragma unroll
        for (int i = 0; i < 4; ++i) {
            const int col = i * 256 + lane * 4;
            f32x4 a = unpk4(*(const u32x2*)(X1b + (size_t)row * 1024 + col)) * ALPHA_;
#pragma unroll
            for (int k = 0; k < 9; ++k) a += unpk4(*(const u32x2*)(YX + ((size_t)row * 9 + k) * 1024 + col));
            v[i] = a; s += (a[0] + a[1]) + (a[2] + a[3]);
        }
#pragma unroll
        for (int o = 32; o > 0; o >>= 1) s += __shfl_xor(s, o);
        const float mean = s * (1.0f / 1024.0f); float s2 = 0.f;
#pragma unroll
        for (int i = 0; i < 4; ++i)
#pragma unroll
            for (int r = 0; r < 4; ++r) { const float d = v[i][r] - mean; s2 += d * d; }
#pragma unroll
        for (int o = 32; o > 0; o >>= 1) s2 += __shfl_xor(s2, o);
        const float rstd = rsqrtf(s2 * (1.0f / 1024.0f) + 1e-5f);
#pragma unroll
        for (int i = 0; i < 4; ++i) {
            const int col = i * 256 + lane * 4;
            const f32x4 g = *(const f32x4*)(p.ln2_g + col), bb = *(const f32x4*)(p.ln2_b + col);
            f32x4 y;
#pragma unroll
            for (int r = 0; r < 4; ++r) y[r] = (v[i][r] - mean) * rstd * g[r] + bb[r];
            *(f32x4*)(p.out + (size_t)row * 1024 + col) = y;
        }
    }
}


#define XB_TMO      128
#define XB_XCNT(j)  (256  + 64 * (j))
#define XB_XSUB(j)  (1280 + 64 * (j))
#define XB_XGEN(j)  (2304 + 64 * (j))
#define XB_TOP      3328
#define XB_TOPGEN   3392
#define XCD_BAR_WORDS 3456
#define XB_SPIN_CAP (1u << 20)
#define LAS __attribute__((address_space(3)))
DEVI unsigned xb_ld(unsigned* p)              { return __hip_atomic_load(p, __ATOMIC_RELAXED, __HIP_MEMORY_SCOPE_AGENT); }
DEVI unsigned xb_add(unsigned* p, unsigned v) { return __hip_atomic_fetch_add(p, v, __ATOMIC_RELAXED, __HIP_MEMORY_SCOPE_AGENT); }
DEVI unsigned xb_xcc_id() { return (unsigned)__builtin_amdgcn_s_getreg((3 << 11) | 20) & 0xFu; }
#define XB_SPIN(cond, bar) do { unsigned _sp = 0; while (cond) { __builtin_amdgcn_s_sleep(1); \
    if ((++_sp & 255u) == 0u) { if (xb_ld(&(bar)[XB_TMO])) break; if (_sp > XB_SPIN_CAP) { atomicAdd(&(bar)[XB_TMO], 1u); break; } } } } while (0)
struct XcdBarrier { unsigned* bar; unsigned x; volatile LAS unsigned* st; };
DEVI XcdBarrier xcd_barrier_post(unsigned* bar, volatile LAS unsigned* st) {
    XcdBarrier b; b.bar = bar; b.x = xb_xcc_id(); b.st = st;
    if (threadIdx.x == 0) (void)xb_add(&bar[XB_XCNT(b.x)], 1u);
    return b;
}
DEVI void xcd_barrier_complete(unsigned* bar, unsigned x, unsigned& nloc, unsigned& nx) {
    const unsigned G = gridDim.x * gridDim.y * gridDim.z;
    unsigned sum, cnt, mine, sp = 0u;
    for (;;) {
        sum = 0u; cnt = 0u; mine = 0u;
#pragma unroll
        for (unsigned j = 0; j < 16; ++j) { const unsigned c = xb_ld(&bar[XB_XCNT(j)]); sum += c; cnt += (c > 0u) ? 1u : 0u; mine = (j == x) ? c : mine; }
        if (sum == G) break;
        __builtin_amdgcn_s_sleep(1);
        if ((++sp & 255u) == 0u) { if (xb_ld(&bar[XB_TMO])) break; if (sp > XB_SPIN_CAP) { atomicAdd(&bar[XB_TMO], 1u); break; } }
    }
    nloc = mine > 0u ? mine : 1u; nx = cnt > 0u ? cnt : 1u;
}
DEVI void xcd_barrier(const XcdBarrier& b) {
    asm volatile("s_waitcnt vmcnt(0)" ::: "memory");
    __syncthreads();
    if (threadIdx.x == 0) {
        unsigned* bar = b.bar;
        __builtin_amdgcn_s_waitcnt(0);
        unsigned nloc = b.st[0], nx = b.st[1];
        if (nloc == 0u) { xcd_barrier_complete(bar, b.x, nloc, nx); b.st[0] = nloc; b.st[1] = nx; }
        const unsigned old = xb_add(&bar[XB_XSUB(b.x)], 1u);
        const unsigned gen = old / nloc;
        if (old + 1u == (gen + 1u) * nloc) {
            __builtin_amdgcn_fence(__ATOMIC_RELEASE, "agent");
            asm volatile("s_waitcnt vmcnt(0)" ::: "memory");
            const unsigned og = xb_add(&bar[XB_TOP], 1u);
            const unsigned tg = og / nx;
            if (og + 1u == (tg + 1u) * nx) xb_add(&bar[XB_TOPGEN], 1u);
            else XB_SPIN(xb_ld(&bar[XB_TOPGEN]) == tg, bar);
            __builtin_amdgcn_fence(__ATOMIC_ACQUIRE, "agent");
            xb_add(&bar[XB_XGEN(b.x)], 1u);
            asm volatile("s_waitcnt vmcnt(0)" ::: "memory");
        } else {
            XB_SPIN(xb_ld(&bar[XB_XGEN(b.x)]) == gen, bar);
            __builtin_amdgcn_fence(__ATOMIC_ACQUIRE, "agent");
            asm volatile("s_waitcnt vmcnt(0)" ::: "memory");
        }
    }
    __syncthreads();
}
constexpr size_t OFF_BAR = OFF_CNT + 65536;

#ifndef DBG
#define DBG 0
#endif
DEVI void dump_f32(const Params& p, size_t off) {
    const f32x4* src = (const f32x4*)(p.ws + off); f32x4* dst = (f32x4*)p.out;
    for (int i = blockIdx.x * 256 + threadIdx.x; i < T_ * D_ / 4; i += gridDim.x * 256) dst[i] = src[i];
}
DEVI void dump_bf16(const Params& p, size_t off, int ld, int coff) {
    const bf16_t* src = (const bf16_t*)(p.ws + off);
    for (int i = blockIdx.x * 256 + threadIdx.x; i < T_ * D_; i += gridDim.x * 256) { const int row = i >> 10, col = i & 1023; p.out[i] = bf2f(src[(size_t)row * ld + coff + col]); }
}
DEVI float flat_bf(const Params& p, size_t off, size_t n, size_t i) { const bf16_t* b = (const bf16_t*)(p.ws + off); float a = 0.f; for (size_t j = i; j < n; j += (size_t)T_ * D_) a += bf2f(b[j]); return a; }
DEVI void dump_p1(const Params& p) {
    const size_t N = (size_t)T_ * D_;
    for (size_t i = (size_t)blockIdx.x * 256 + threadIdx.x; i < N; i += (size_t)gridDim.x * 256) {
        float a = 0.f;
        a += flat_bf(p, OFF_MG, 2 * N, i) + flat_bf(p, OFF_GS, 2 * N, i);
        a += flat_bf(p, OFF_QR, N / 2, i % (N / 2)) + flat_bf(p, OFF_KR, N / 2, i % (N / 2)) + flat_bf(p, OFF_QG, N / 2, i % (N / 2));
        a += flat_bf(p, OFF_KRT, N / 2, i % (N / 2)) + flat_bf(p, OFF_KGT, N / 2, i % (N / 2));
        a += flat_bf(p, OFF_VRT, N, i) + flat_bf(p, OFF_VGT, N, i);
        a += ((const float*)(p.ws + OFF_GA))[i % ((size_t)T_ * 16)];
        p.out[i] = a;
    }
}
constexpr int NPHASE = 13;
__global__ void __launch_bounds__(512, 2) fwd_megakernel(Params p) {
    __shared__ __attribute__((aligned(16))) unsigned char smem_all[2 * SMEM_HALF];
    unsigned char* smem = smem_all + VH * SMEM_HALF;
    uint4* xb_words = (uint4*)(smem_all + 2 * SMEM_HALF - 16);
    if (threadIdx.x == 0) *xb_words = make_uint4(0u, 0u, 0u, 0u);
    __syncthreads();
    const XcdBarrier xb = xcd_barrier_post((unsigned*)(p.ws + OFF_BAR), (volatile LAS unsigned*)xb_words);
#ifndef REPMASK
#define REPMASK 0
#endif
#define RUN_PHASE(K, CALL) do { if (p.phase_lo <= (K) && (K) < p.phase_hi) { if ((REPMASK >> (K)) & 1) { CALL; xcd_barrier(xb); } CALL; if ((K) + 1 < p.phase_hi) xcd_barrier(xb); } } while (0)
    RUN_PHASE(0, phase0(p, smem));
    RUN_PHASE(1, phase1(p, smem_all));
#if DBG == 2
    dump_p1(p); return;
#endif
    RUN_PHASE(2, phase2(p, smem));
#if DBG == 5
    { const size_t N = (size_t)T_ * D_; for (size_t i = (size_t)blockIdx.x * 256 + threadIdx.x; i < N; i += (size_t)gridDim.x * 256) p.out[i] = flat_bf(p, OFF_KG2, N / 2, i % (N / 2)) + ((const float*)(p.ws + OFF_DEC))[i % (2048 * 128)]; } return;
#endif
#ifdef SCANDUMMY
    phase3<SCANDUMMY>(p, smem); xcd_barrier(xb);
#endif
    RUN_PHASE(3, phase3<0>(p, smem));
#if DBG == 6
    dump_bf16(p, OFF_OO, 2048, 1024); return;
#endif
#if DBG == 7
    { const bf16_t* src = (const bf16_t*)(p.ws + OFF_OO);
      for (int i = blockIdx.x * 256 + threadIdx.x; i < T_ * D_; i += gridDim.x * 256) { const int row = i >> 10, col = i & 1023; const float v = bf2f(src[(size_t)row * 2048 + 1024 + col]); p.out[i] = (fabsf(v) < 1e30f) ? v : 12345.0f; } } return;
#endif
    RUN_PHASE(4, phase4(p, smem));
#if DBG == 3
    dump_bf16(p, OFF_Y, 2048, 0); return;
#endif
#if DBG == 4
    dump_bf16(p, OFF_Y, 2048, 1024); return;
#endif
    RUN_PHASE(5, phase5(p, smem_all));
    RUN_PHASE(6, phase6(p, smem_all));
    RUN_PHASE(7, phase7(p, smem));
#if DBG == 1
    return;
#endif
    RUN_PHASE(8, phase8(p, smem));
    RUN_PHASE(9, phase9(p));
    RUN_PHASE(10, phase10(p, smem_all));
    RUN_PHASE(11, phase11(p, smem_all));
    RUN_PHASE(12, phase12(p));
#undef RUN_PHASE
}

extern "C" void kernel_launch(void* const* d_in, const int* in_sizes, int n_in, void* d_out, int out_size, void* d_ws, size_t ws_size,
                              hipStream_t stream) {
    static int grid_blocks = 0;
    if (!grid_blocks) {
        int dev = 0, cus = 0, per_cu = 0;
        hipGetDevice(&dev);
        hipDeviceGetAttribute(&cus, hipDeviceAttributeMultiprocessorCount, dev);
        hipOccupancyMaxActiveBlocksPerMultiprocessor(&per_cu, fwd_megakernel, 512, 0);
        if (per_cu > 1) per_cu = 1;
        if (per_cu < 1) per_cu = 1;
        grid_blocks = cus * per_cu;
    }
    if (ws_size < WS_NEEDED) { fprintf(stderr, "workspace too small: %zu < %zu\n", ws_size, (size_t)WS_NEEDED); return; }
    Params p{};
    p.x = (const float*)d_in[0]; p.w_in = (const float*)d_in[1]; p.ret_norm_g = (const float*)d_in[2]; p.gate_w2 = (const float*)d_in[3];
    p.gate_b = (const float*)d_in[4]; p.gla_norm_g = (const float*)d_in[5]; p.w_ret_out = (const float*)d_in[6]; p.w_gla_out = (const float*)d_in[7];
    p.w_o = (const float*)d_in[8]; p.ln1_g = (const float*)d_in[9]; p.ln1_b = (const float*)d_in[10]; p.router_w = (const float*)d_in[11];
    p.router_bias = (const float*)d_in[12]; p.ew_gate = (const float*)d_in[13]; p.ew_up = (const float*)d_in[14]; p.ew_down = (const float*)d_in[15];
    p.sw_gate = (const float*)d_in[16]; p.sw_up = (const float*)d_in[17]; p.sw_down = (const float*)d_in[18]; p.ln2_g = (const float*)d_in[19];
    p.ln2_b = (const float*)d_in[20];
    p.out = (float*)d_out; p.ws = (unsigned char*)d_ws; p.phase_lo = 0; p.phase_hi = NPHASE;
    void* args[] = {&p};
    (void)hipMemsetAsync((unsigned char*)d_ws + OFF_BAR, 0, XCD_BAR_WORDS * 4, stream);
    hipError_t e = hipLaunchCooperativeKernel((void*)fwd_megakernel, dim3(grid_blocks), dim3(512), args, 0, stream);
    if (e != hipSuccess) fprintf(stderr, "cooperative launch failed: %s (grid %d)\n", hipGetErrorString(e), grid_blocks);
}
```

```cpp
#include <hip/hip_runtime.h>
#include <hip/hip_cooperative_groups.h>
#include <cstdio>
#include <cstdint>
namespace cg = cooperative_groups;

typedef unsigned short bf16_t;
typedef short bf16x8 __attribute__((ext_vector_type(8)));
typedef float f32x4 __attribute__((ext_vector_type(4)));
typedef unsigned u32x2 __attribute__((ext_vector_type(2)));
typedef unsigned u32x4 __attribute__((ext_vector_type(4)));
#define DEVI __device__ __forceinline__
#define VH ((int)(threadIdx.x >> 8))
#define VT ((int)(threadIdx.x & 255))
#define RB ((int)blockIdx.x)
#define RG ((int)gridDim.x)
#define VB (RB * 2 + VH)
#define VG (RG * 2)

constexpr int T_ = 32768;
constexpr int D_ = 1024;
constexpr int DIN_ = 8208;
constexpr int NE_ = 256;
constexpr float ALPHA_ = 1.189207115002721f;
constexpr float KSCALE_ = 0.08838834764831845f;

constexpr size_t MB = 1ull << 20;
constexpr size_t OFF_CNT  = 0;
constexpr size_t OFF_CS   = 1 * MB;
constexpr size_t OFF_WT   = 3 * MB;
constexpr size_t FB = 27 * MB;
constexpr size_t OFF_QR   = FB + 0 * MB;
constexpr size_t OFF_KR   = FB + 32 * MB;
constexpr size_t OFF_VRT  = FB + 64 * MB;
constexpr size_t OFF_GS   = FB + 128 * MB;
constexpr size_t OFF_MG   = FB + 256 * MB;
constexpr size_t OFF_KRT  = FB + 384 * MB;
constexpr size_t OFF_QG   = FB + 416 * MB;
constexpr size_t OFF_VGT  = FB + 448 * MB;
constexpr size_t OFF_KGT  = FB + 512 * MB;
constexpr size_t OFF_GA   = FB + 544 * MB;
constexpr size_t OFF_XB   = FB + 546 * MB;
constexpr size_t OFF_KG2  = FB + 546 * MB;
constexpr size_t OFF_DEC  = FB + 578 * MB;
constexpr size_t OFF_OO   = FB + 579 * MB;
constexpr size_t OFF_Y    = FB + 384 * MB;
constexpr size_t OFF_MRG  = FB + 0 * MB;
constexpr size_t OFF_WGU  = 767 * MB;
constexpr size_t OFF_X1B  = FB + 0 * MB;
constexpr size_t OFF_WD   = FB + 64 * MB;
constexpr size_t OFF_LIST = FB + 193 * MB;
constexpr size_t OFF_WTS  = FB + 225 * MB;
constexpr size_t OFF_H    = FB + 227 * MB;
constexpr size_t OFF_YX   = FB + 371 * MB;
constexpr size_t OFF_T1   = FB + 371 * MB;
constexpr size_t OFF_LOG  = FB + 435 * MB;
constexpr size_t WS_NEEDED = 1024 * MB;

constexpr int WT_BN = 0, WT_AT = 5888, WT_RET = 8960, WT_GLA = 9984, WT_O = 11008, WT_R = 12032, WT_ROWS = 12288;

struct Params {
    const float *x, *w_in, *ret_norm_g, *gate_w2, *gate_b, *gla_norm_g, *w_ret_out, *w_gla_out, *w_o, *ln1_g, *ln1_b,
                *router_w, *router_bias, *ew_gate, *ew_up, *ew_down, *sw_gate, *sw_up, *sw_down, *ln2_g, *ln2_b;
    float* out;
    unsigned char* ws;
    int phase_lo, phase_hi;
};

static __device__ const float c_inv_freq[64] = {
  1.000000000e+00f, 8.659643531e-01f, 7.498942018e-01f, 6.493816376e-01f,
  5.623413324e-01f, 4.869675338e-01f, 4.216965139e-01f, 3.651741147e-01f,
  3.162277639e-01f, 2.738419771e-01f, 2.371373773e-01f, 2.053525001e-01f,
  1.778279394e-01f, 1.539926529e-01f, 1.333521456e-01f, 1.154781953e-01f,
  1.000000015e-01f, 8.659642935e-02f, 7.498942316e-02f, 6.493816525e-02f,
  5.623413250e-02f, 4.869675264e-02f, 4.216964915e-02f, 3.651741147e-02f,
  3.162277490e-02f, 2.738419548e-02f, 2.371373773e-02f, 2.053525113e-02f,
  1.778279431e-02f, 1.539926510e-02f, 1.333521400e-02f, 1.154781971e-02f,
  9.999999776e-03f, 8.659643121e-03f, 7.498942316e-03f, 6.493816152e-03f,
  5.623413250e-03f, 4.869675264e-03f, 4.216964822e-03f, 3.651741194e-03f,
  3.162277630e-03f, 2.738419687e-03f, 2.371373819e-03f, 2.053525066e-03f,
  1.778279431e-03f, 1.539926510e-03f, 1.333521446e-03f, 1.154782018e-03f,
  1.000000047e-03f, 8.659643354e-04f, 7.498941850e-04f, 6.493816036e-04f,
  5.623413017e-04f, 4.869675322e-04f, 4.216965172e-04f, 3.651741135e-04f,
  3.162277571e-04f, 2.738419571e-04f, 2.371373703e-04f, 2.053525095e-04f,
  1.778279402e-04f, 1.539926598e-04f, 1.333521504e-04f, 1.154782003e-04f };

DEVI float bf2f(unsigned short u) { return __uint_as_float(((unsigned)u) << 16); }
DEVI float bflo(unsigned u) { return __uint_as_float(u << 16); }
DEVI float bfhi(unsigned u) { return __uint_as_float(u & 0xffff0000u); }
typedef float f32x2 __attribute__((ext_vector_type(2)));
typedef __bf16 bf16x2_t __attribute__((ext_vector_type(2)));
DEVI unsigned pk2(float lo, float hi) { const f32x2 v = {lo, hi}; const bf16x2_t b = __builtin_convertvector(v, bf16x2_t); return __builtin_bit_cast(unsigned, b); }
DEVI unsigned short f2bf(float f) { return (unsigned short)(pk2(f, 0.f) & 0xffffu); }
DEVI u32x2 pk4(f32x4 v) { u32x2 r; r.x = pk2(v[0], v[1]); r.y = pk2(v[2], v[3]); return r; }
DEVI f32x4 unpk4(u32x2 u) { f32x4 r; r[0] = bflo(u.x); r[1] = bfhi(u.x); r[2] = bflo(u.y); r[3] = bfhi(u.y); return r; }
constexpr float YX_SCALE = 16.0f;
DEVI unsigned pk4_fp8(f32x4 v) { int w = 0; w = __builtin_amdgcn_cvt_pk_fp8_f32(v[0], v[1], w, false); w = __builtin_amdgcn_cvt_pk_fp8_f32(v[2], v[3], w, true); return (unsigned)w; }
DEVI f32x4 unpk4_fp8(unsigned u) { f32x4 r; r[0] = __builtin_amdgcn_cvt_f32_fp8((int)u, 0); r[1] = __builtin_amdgcn_cvt_f32_fp8((int)u, 1); r[2] = __builtin_amdgcn_cvt_f32_fp8((int)u, 2); r[3] = __builtin_amdgcn_cvt_f32_fp8((int)u, 3); return r; }
DEVI f32x4 clamp4(f32x4 v, float lim) { f32x4 r; for (int i = 0; i < 4; ++i) r[i] = fminf(fmaxf(v[i], -lim), lim); return r; }
DEVI float sigmoidf_(float v) { return 1.0f / (1.0f + __expf(-v)); }
DEVI float siluf_(float v) { return v / (1.0f + __expf(-v)); }
DEVI float gamma_log2(int h) { return log2f(1.0f - exp2f(-5.0f - (float)h)); }
DEVI f32x4 mfma16(bf16x8 a, bf16x8 b, f32x4 c) { return __builtin_amdgcn_mfma_f32_16x16x32_bf16(a, b, c, 0, 0, 0); }
DEVI int vperm(int n) { const int wc = n >> 6, nt = (n >> 4) & 3, i = n & 15; return wc * 64 + (nt >> 1) * 32 + 8 * (i >> 2) + 4 * (nt & 1) + (i & 3); }
DEVI int dperm2(int v) { return ((v >> 5) & 1) * 64 + (v >> 6) * 32 + (v & 31); }
DEVI u32x4 pk8(f32x4 a, f32x4 b) { u32x4 r; r.x = pk2(a[0], a[1]); r.y = pk2(a[2], a[3]); r.z = pk2(b[0], b[1]); r.w = pk2(b[2], b[3]); return r; }
DEVI void unpk8(u32x4 u, f32x4& a, f32x4& b) { a[0] = bflo(u.x); a[1] = bfhi(u.x); a[2] = bflo(u.y); a[3] = bfhi(u.y); b[0] = bflo(u.z); b[1] = bfhi(u.z); b[2] = bflo(u.w); b[3] = bfhi(u.w); }
DEVI int dperm(int v) { const int wc = v >> 6, nt = (v >> 4) & 3, c = v & 15; return (nt & 1) * 16 + wc * 32 + c + (nt >> 1) * 64; }

struct __attribute__((aligned(16))) GemmSmem { bf16_t a[2][128 * 64]; bf16_t b[2][128 * 64]; };
constexpr int SMEM_GEMM = sizeof(GemmSmem);
constexpr int SMEM_BYTES = SMEM_GEMM + 2048 + 16;
constexpr int SMEM_HALF = (SMEM_BYTES + 255) & ~255;
DEVI int gemm_src_chunk(int t) { return ((t & 7) ^ ((t >> 4) & 7)) * 8; }

template <bool SWAP, int BKIND>
DEVI void gemm_kloop(f32x4 (&acc)[4][4], const bf16_t* const (&pa)[4], const bf16_t* const (&pb)[4],
                     const float* pbf, int ldb, int nk, GemmSmem& sm) {
    const int t = VT, lane = t & 63, w = t >> 6, wr = w >> 1, wc = w & 1, l15 = lane & 15, q = lane >> 4;
    const int kg = t & 7, ng = t >> 3;
    f32x4 rf[8];
#define GEMM_ISSUE(BUF, KO) do { \
        _Pragma("unroll") for (int i = 0; i < 4; ++i) \
            __builtin_amdgcn_global_load_lds((const unsigned*)(pa[i] + (KO)), (unsigned*)((char*)sm.a[BUF] + i * 4096 + t * 16), 16, 0, 0); \
        if (BKIND == 0) { _Pragma("unroll") for (int i = 0; i < 4; ++i) \
            __builtin_amdgcn_global_load_lds((const unsigned*)(pb[i] + (KO)), (unsigned*)((char*)sm.b[BUF] + i * 4096 + t * 16), 16, 0, 0); } \
        else { const float* pp = pbf + (size_t)((KO) + 4 * kg) * ldb; \
            _Pragma("unroll") for (int i = 0; i < 4; ++i) { rf[i] = *(const f32x4*)(pp + (size_t)i * ldb); rf[4 + i] = *(const f32x4*)(pp + (size_t)(32 + i) * ldb); } } } while (0)
#define GEMM_LSTORE_B(BUF) do { if (BKIND == 1) { \
            _Pragma("unroll") for (int i = 0; i < 4; ++i) { \
                u32x2 v0, v1; \
                v0.x = pk2(rf[0][i], rf[1][i]); v0.y = pk2(rf[2][i], rf[3][i]); v1.x = pk2(rf[4][i], rf[5][i]); v1.y = pk2(rf[6][i], rf[7][i]); \
                const int n = 4 * ng + i, sw = (n >> 1) & 7; \
                char* rowp = (char*)sm.b[BUF] + n * 128 + (kg & 1) * 8; \
                *(u32x2*)(rowp + (((kg >> 1) ^ sw) * 16)) = v0; *(u32x2*)(rowp + (((4 + (kg >> 1)) ^ sw) * 16)) = v1; } } } while (0)
    GEMM_ISSUE(0, 0);
    GEMM_LSTORE_B(0);
    __syncthreads();
#define GEMM_KSTEP(CUR, KT) do { \
        const bool more = ((KT) + 1 < nk); \
        if (more) { GEMM_ISSUE((CUR) ^ 1, ((KT) + 1) * 64); } \
        __builtin_amdgcn_sched_barrier(0); \
        _Pragma("unroll") for (int ss = 0; ss < 2; ++ss) { \
            bf16x8 af[4], bfr[4]; \
            const int coff = ((ss * 4 + q) ^ (l15 >> 1)) * 16; \
            _Pragma("unroll") for (int i = 0; i < 4; ++i) { \
                af[i]  = *(const bf16x8*)((const char*)sm.a[CUR] + (wr * 64 + i * 16 + l15) * 128 + coff); \
                bfr[i] = *(const bf16x8*)((const char*)sm.b[CUR] + (wc * 64 + i * 16 + l15) * 128 + coff); } \
            _Pragma("unroll") for (int mt = 0; mt < 4; ++mt) \
                _Pragma("unroll") for (int nt = 0; nt < 4; ++nt) \
                    acc[mt][nt] = SWAP ? mfma16(bfr[nt], af[mt], acc[mt][nt]) : mfma16(af[mt], bfr[nt], acc[mt][nt]); } \
        __builtin_amdgcn_sched_barrier(0); \
        if (more) { GEMM_LSTORE_B((CUR) ^ 1); } \
        __syncthreads(); } while (0)
#pragma unroll 1
    for (int kt = 0; kt < nk; kt += 2) { GEMM_KSTEP(0, kt); GEMM_KSTEP(1, kt + 1); }
#undef GEMM_KSTEP
#undef GEMM_LSTORE_B
#undef GEMM_ISSUE
}

DEVI void zero_acc(f32x4 (&acc)[4][4]) {
#pragma unroll
    for (int i = 0; i < 4; ++i)
#pragma unroll
        for (int j = 0; j < 4; ++j) acc[i][j] = (f32x4){0.f, 0.f, 0.f, 0.f};
}

namespace pg8 {
#define PG8_LAS __attribute__((address_space(3)))
typedef unsigned short bf16_t;
typedef short bf16x8 __attribute__((ext_vector_type(8)));
typedef float f32x4 __attribute__((ext_vector_type(4)));
typedef unsigned u32x4 __attribute__((ext_vector_type(4)));
constexpr int BM = 256, BK = 64, HALF = 128, HTB = HALF * BK * 2  , STAGE_BYTES = 8 * HTB, NXCD = 8, WGM = 8;

__host__ __device__ __forceinline__ int lds_byte(int r, int c) { const int st = (r >> 4) * 2 + (c >> 5), rr = r & 15, cc = c & 31, ob = rr * 64 + cc * 2; return st * 1024 + (ob ^ (((ob >> 9) & 1) << 5)); }
__host__ __device__ __forceinline__ void stage_rc(int b, int& R, int& C) { const int st = b / 1024, sb = b % 1024, swz = sb ^ (((sb >> 9) & 1) << 5); R = (st >> 1) * 16 + swz / 64; C = (st & 1) * 32 + (swz % 64) / 2; }
__host__ __device__ __forceinline__ int perm32(int rho) { const int n = rho >> 4, i = rho & 15; return 8 * (i >> 2) + 4 * n + (i & 3); }

struct Unit { int pm, pn; };
struct Gemm { const bf16_t* A; const bf16_t* Bt; int M, N, K; };

struct StaticOrder {
    int nM, nN, nwg, G, c;
    __host__ __device__ void init(int M, int N, int G_, int c_) { nM = M / BM; nN = N / BM; nwg = nM * nN; G = G_; c = c_; }
    __host__ __device__ bool next(int i, Unit& u) const {
        const long L = (long)i * G + c; if (L >= nwg) return false;
        int wgid = (int)L; { const int q = nwg / NXCD, r = nwg % NXCD, xcd = wgid % NXCD, off = wgid / NXCD; wgid = (xcd < r ? xcd * (q + 1) : r * (q + 1) + (xcd - r) * q) + off; }
        const int nig = WGM * nN, gid = wgid / nig, fm = gid * WGM, gsz = (nM - fm) < WGM ? (nM - fm) : WGM;
        u.pm = fm + ((wgid % nig) % gsz); u.pn = (wgid % nig) / gsz; return true;
    }
    __device__ __forceinline__ void a_ready(const Unit&) const {}
    __device__ __forceinline__ void done(const Unit&) const {}
};


template <class Epi, class Sched, bool ALIGN_EPI = false, bool SP2 = false>
__device__ __forceinline__ void gemm_phase(PG8_LAS unsigned char* lds, const Gemm g, const Sched& S, const Epi& E) {
    const int tid = threadIdx.x, wid = __builtin_amdgcn_readfirstlane(tid >> 6), lane = tid & 63, wr = wid >> 2, wc = wid & 3, fr = lane & 15, fq = lane >> 4;
    const int K = g.K, nt = K / BK;
    unsigned voffA[2], voffB[2];
#pragma unroll
    for (int i = 0; i < 2; ++i) { int R, C; stage_rc(tid * 16 + i * 8192, R, C); const int Rb = Epi::PERM ? ((R & ~31) + perm32(R & 31)) : R;
        voffA[i] = (unsigned)(R * K + C) * 2u; voffB[i] = (unsigned)(Rb * K + C) * 2u; }
    const size_t kstep = (size_t)(BK * 2);
    const size_t hstep = (size_t)HALF * K * 2;
    const size_t tstep = 2 * hstep;
    const unsigned ldsw = (unsigned)wid * 1024u;
    const int aoff = lds_byte(wr * 64 + fr, fq * 8), boff = lds_byte(wc * 32 + fr, fq * 8);
#define PG8_SA(b, h) (((b) * 2 + (h)) * HTB)
#define PG8_SB(b, h) ((4 + (b) * 2 + (h)) * HTB)
#define PG8_STAGE(bufoff, gbase, voff) do { _Pragma("unroll") for (int _i = 0; _i < 2; ++_i) \
        __builtin_amdgcn_global_load_lds((const unsigned*)((const char*)(gbase) + (voff)[_i]), (PG8_LAS unsigned*)(lds + (bufoff) + ldsw + _i * 8192), 16, 0, 0); } while (0)
#define PG8_LDA(dst, b, h) do { _Pragma("unroll") for (int m = 0; m < 4; ++m) _Pragma("unroll") for (int k = 0; k < 2; ++k) dst[m][k] = *(const PG8_LAS bf16x8*)(lds + PG8_SA(b, h) + aoff + m * 2048 + k * 1024); } while (0)
#define PG8_LDB(dst, b, h) do { _Pragma("unroll") for (int n = 0; n < 2; ++n) _Pragma("unroll") for (int k = 0; k < 2; ++k) dst[n][k] = *(const PG8_LAS bf16x8*)(lds + PG8_SB(b, h) + boff + n * 2048 + k * 1024); } while (0)
#define PG8_MMA(ai, bj, At, Bt) do { __builtin_amdgcn_s_setprio(1); _Pragma("unroll") for (int m = 0; m < 4; ++m) _Pragma("unroll") for (int n = 0; n < 2; ++n) _Pragma("unroll") for (int k = 0; k < 2; ++k) \
        acc[ai][bj][m][n] = __builtin_amdgcn_mfma_f32_16x16x32_bf16(Bt[n][k], At[m][k], acc[ai][bj][m][n], 0, 0, 0); __builtin_amdgcn_s_setprio(0); } while (0)
#define PG8_WAIT_V(n) asm volatile("s_waitcnt vmcnt(" #n ")" ::: "memory")
#define PG8_WAIT_L(n) asm volatile("s_waitcnt lgkmcnt(" #n ")" ::: "memory")
#define PG8_BAR __builtin_amdgcn_s_barrier()
#define PG8_SCHED __builtin_amdgcn_sched_barrier(0)
    Unit cur, nxt; int ui = 0;
    if (!S.next(0, cur)) return;
    f32x4 acc[2][2][4][2];
#pragma unroll
    for (int a = 0; a < 2; ++a)
#pragma unroll
        for (int b = 0; b < 2; ++b)
#pragma unroll
            for (int m = 0; m < 4; ++m)
#pragma unroll
                for (int n = 0; n < 2; ++n) acc[a][b][m][n] = (f32x4){0.f, 0.f, 0.f, 0.f};
    bf16x8 At[4][2], B0[2][2], B1[2][2];
    const char* cA = (const char*)g.A + (size_t)cur.pm * tstep; const char* cB = (const char*)g.Bt + (size_t)cur.pn * tstep;
    S.a_ready(cur);
    if constexpr (SP2) {
        PG8_STAGE(PG8_SB(0, 0), cB, voffB); PG8_STAGE(PG8_SB(0, 1), cB + hstep, voffB); PG8_STAGE(PG8_SA(0, 0), cA, voffA); PG8_STAGE(PG8_SA(0, 1), cA + hstep, voffA);
        if (wr == 1) PG8_BAR;
        PG8_WAIT_V(2); PG8_BAR;
        PG8_STAGE(PG8_SB(1, 0), cB + kstep, voffB); PG8_STAGE(PG8_SA(1, 0), cA + kstep, voffA); PG8_STAGE(PG8_SB(1, 1), cB + hstep + kstep, voffB);
        PG8_WAIT_V(6); PG8_BAR;
    } else {
        PG8_STAGE(PG8_SB(0, 0), cB, voffB); PG8_STAGE(PG8_SA(0, 0), cA, voffA); PG8_STAGE(PG8_SB(0, 1), cB + hstep, voffB); PG8_STAGE(PG8_SA(0, 1), cA + hstep, voffA);
        if (wr == 1) PG8_BAR;
        PG8_WAIT_V(4); PG8_BAR;
        PG8_STAGE(PG8_SB(1, 0), cB + kstep, voffB); PG8_STAGE(PG8_SA(1, 0), cA + kstep, voffA); PG8_STAGE(PG8_SB(1, 1), cB + hstep + kstep, voffB);
        PG8_WAIT_V(6); PG8_BAR;
    }
    for (;;) {
        const bool has_next = S.next(ui + 1, nxt);
        const char* nA = has_next ? (const char*)g.A + (size_t)nxt.pm * tstep : cA; const char* nB = has_next ? (const char*)g.Bt + (size_t)nxt.pn * tstep : cB;
        for (int t = 0; t < nt; t += 2) {
            const bool last = (t == nt - 2);
            const char* a1 = cA + (size_t)(t + 1) * kstep;
            const char* a2 = last ? nA : cA + (size_t)(t + 2) * kstep; const char* b2 = last ? nB : cB + (size_t)(t + 2) * kstep;
            const char* a3 = a2 + kstep; const char* b3 = b2 + kstep;
            if (last && has_next) S.a_ready(nxt);
            if constexpr (SP2) {
            PG8_LDB(B0, 0, 0); PG8_LDB(B1, 0, 1); PG8_SCHED; PG8_LDA(At, 0, 0); PG8_STAGE(PG8_SA(1, 1), a1 + hstep, voffA);
            PG8_WAIT_V(8); PG8_WAIT_L(0); PG8_BAR; PG8_MMA(0, 0, At, B0); PG8_MMA(0, 1, At, B1); PG8_BAR; PG8_SCHED;
            PG8_LDA(At, 0, 1); PG8_STAGE(PG8_SB(0, 0), b2, voffB); PG8_STAGE(PG8_SB(0, 1), b2 + hstep, voffB); PG8_STAGE(PG8_SA(0, 0), a2, voffA);
            PG8_WAIT_V(8); PG8_WAIT_L(0); PG8_BAR; PG8_MMA(1, 0, At, B0); PG8_MMA(1, 1, At, B1); PG8_BAR; PG8_SCHED;
            PG8_LDB(B0, 1, 0); PG8_LDB(B1, 1, 1); PG8_SCHED; PG8_LDA(At, 1, 0); PG8_STAGE(PG8_SA(0, 1), a2 + hstep, voffA);
            PG8_WAIT_V(8); PG8_WAIT_L(0); PG8_BAR; PG8_MMA(0, 0, At, B0); PG8_MMA(0, 1, At, B1); PG8_BAR; PG8_SCHED;
            PG8_LDA(At, 1, 1); PG8_STAGE(PG8_SB(1, 0), b3, voffB); PG8_STAGE(PG8_SB(1, 1), b3 + hstep, voffB); PG8_STAGE(PG8_SA(1, 0), a3, voffA);
            PG8_WAIT_V(8); PG8_WAIT_L(0); PG8_BAR; PG8_MMA(1, 0, At, B0); PG8_MMA(1, 1, At, B1); PG8_BAR; PG8_SCHED;
            } else {
            PG8_LDB(B0, 0, 0); PG8_SCHED; PG8_LDA(At, 0, 0); PG8_STAGE(PG8_SA(1, 1), a1 + hstep, voffA);
            PG8_WAIT_L(8); PG8_BAR; PG8_WAIT_L(0); PG8_MMA(0, 0, At, B0); PG8_BAR; PG8_SCHED;
            PG8_LDB(B1, 0, 1); PG8_STAGE(PG8_SB(0, 0), b2, voffB);
            PG8_BAR; PG8_WAIT_L(0); PG8_MMA(0, 1, At, B1); PG8_BAR;
            PG8_LDA(At, 0, 1); PG8_STAGE(PG8_SA(0, 0), a2, voffA);
            PG8_BAR; PG8_WAIT_L(0); PG8_MMA(1, 0, At, B0); PG8_BAR; PG8_SCHED;
            PG8_STAGE(PG8_SB(0, 1), b2 + hstep, voffB);
            PG8_WAIT_V(6); PG8_BAR; PG8_MMA(1, 1, At, B1); PG8_BAR;
            PG8_LDB(B0, 1, 0); PG8_SCHED; PG8_LDA(At, 1, 0); PG8_STAGE(PG8_SA(0, 1), a2 + hstep, voffA);
            PG8_WAIT_L(8); PG8_BAR; PG8_WAIT_L(0); PG8_MMA(0, 0, At, B0); PG8_BAR; PG8_SCHED;
            PG8_LDB(B1, 1, 1); PG8_STAGE(PG8_SB(1, 0), b3, voffB);
            PG8_BAR; PG8_WAIT_L(0); PG8_MMA(0, 1, At, B1); PG8_BAR;
            PG8_LDA(At, 1, 1); PG8_STAGE(PG8_SA(1, 0), a3, voffA);
            PG8_BAR; PG8_WAIT_L(0); PG8_MMA(1, 0, At, B0); PG8_BAR; PG8_SCHED;
            PG8_STAGE(PG8_SB(1, 1), b3 + hstep, voffB);
            PG8_WAIT_V(6); PG8_BAR; PG8_MMA(1, 1, At, B1); PG8_BAR;
            }
        }
        if constexpr (ALIGN_EPI) { if (wr == 0) PG8_BAR; }
        if constexpr (!Epi::AFTER_DRAIN) { E(acc, cur, wr, wc, fr, fq); S.done(cur); }
        if (!has_next) break;
#pragma unroll
        for (int a = 0; a < 2; ++a)
#pragma unroll
            for (int b = 0; b < 2; ++b)
#pragma unroll
                for (int m = 0; m < 4; ++m)
#pragma unroll
                    for (int n = 0; n < 2; ++n) acc[a][b][m][n] = (f32x4){0.f, 0.f, 0.f, 0.f};
        cur = nxt; cA = nA; cB = nB; ++ui;
        if constexpr (ALIGN_EPI) { if (wr == 1) PG8_BAR; }
    }
    PG8_WAIT_V(0);
    if constexpr (!ALIGN_EPI) { if (wr == 0) PG8_BAR; }
    PG8_BAR;
    if constexpr (Epi::AFTER_DRAIN) { E.fused(acc, cur, wr, wc, fr, fq, lds, wid, lane); S.done(cur); }
#undef PG8_SA
#undef PG8_SB
#undef PG8_STAGE
#undef PG8_LDA
#undef PG8_LDB
#undef PG8_MMA
#undef PG8_WAIT_V
#undef PG8_WAIT_L
#undef PG8_BAR
#undef PG8_SCHED
}
template <class Epi, class Sched, bool ALIGN_EPI = false, bool SP2 = false>
__device__ __forceinline__ void gemm_phase_g(PG8_LAS unsigned char* lds, const int K, const Sched& S, const Epi& E) {
    const int tid = threadIdx.x, wid = __builtin_amdgcn_readfirstlane(tid >> 6), lane = tid & 63, wr = wid >> 2, wc = wid & 3, fr = lane & 15, fq = lane >> 4;
    const int nt = K / BK;
    unsigned voffB[2]; int rowA[2], colA[2];
#pragma unroll
    for (int i = 0; i < 2; ++i) { int R, C; stage_rc(tid * 16 + i * 8192, R, C); const int Rb = Epi::PERM ? ((R & ~31) + perm32(R & 31)) : R;
        rowA[i] = R; colA[i] = C * 2; voffB[i] = (unsigned)(Rb * K + C) * 2u; }
    const size_t kstep = (size_t)(BK * 2);
    const size_t hstep = (size_t)HALF * K * 2;
    const size_t tstep = 2 * hstep;
    const unsigned ldsw = (unsigned)wid * 1024u;
    const int aoff = lds_byte(wr * 64 + fr, fq * 8), boff = lds_byte(wc * 32 + fr, fq * 8);
#define PG8_SA(b, h) (((b) * 2 + (h)) * HTB)
#define PG8_SB(b, h) ((4 + (b) * 2 + (h)) * HTB)
#define PG8_STAGE(bufoff, gbase, voff) do { _Pragma("unroll") for (int _i = 0; _i < 2; ++_i) \
        __builtin_amdgcn_global_load_lds((const unsigned*)((const char*)(gbase) + (voff)[_i]), (PG8_LAS unsigned*)(lds + (bufoff) + ldsw + _i * 8192), 16, 0, 0); } while (0)
#define PG8_STAGEA(bufoff, P0, P1, koff) do { \
        __builtin_amdgcn_global_load_lds((const unsigned*)(Ab + (size_t)(P0) + (koff)), (PG8_LAS unsigned*)(lds + (bufoff) + ldsw), 16, 0, 0); \
        __builtin_amdgcn_global_load_lds((const unsigned*)(Ab + (size_t)(P1) + (koff)), (PG8_LAS unsigned*)(lds + (bufoff) + ldsw + 8192), 16, 0, 0); } while (0)
#define PG8_LDA(dst, b, h) do { _Pragma("unroll") for (int m = 0; m < 4; ++m) _Pragma("unroll") for (int k = 0; k < 2; ++k) dst[m][k] = *(const PG8_LAS bf16x8*)(lds + PG8_SA(b, h) + aoff + m * 2048 + k * 1024); } while (0)
#define PG8_LDB(dst, b, h) do { _Pragma("unroll") for (int n = 0; n < 2; ++n) _Pragma("unroll") for (int k = 0; k < 2; ++k) dst[n][k] = *(const PG8_LAS bf16x8*)(lds + PG8_SB(b, h) + boff + n * 2048 + k * 1024); } while (0)
#define PG8_MMA(ai, bj, At, Bt) do { __builtin_amdgcn_s_setprio(1); _Pragma("unroll") for (int m = 0; m < 4; ++m) _Pragma("unroll") for (int n = 0; n < 2; ++n) _Pragma("unroll") for (int k = 0; k < 2; ++k) \
        acc[ai][bj][m][n] = __builtin_amdgcn_mfma_f32_16x16x32_bf16(Bt[n][k], At[m][k], acc[ai][bj][m][n], 0, 0, 0); __builtin_amdgcn_s_setprio(0); } while (0)
#define PG8_WAIT_V(n) asm volatile("s_waitcnt vmcnt(" #n ")" ::: "memory")
#define PG8_WAIT_L(n) asm volatile("s_waitcnt lgkmcnt(" #n ")" ::: "memory")
#define PG8_BAR __builtin_amdgcn_s_barrier()
#define PG8_SCHED __builtin_amdgcn_sched_barrier(0)
    Unit cur, nxt; int ui = 0;
    if (!S.next(0, cur)) return;
    f32x4 acc[2][2][4][2];
#pragma unroll
    for (int a = 0; a < 2; ++a)
#pragma unroll
        for (int b = 0; b < 2; ++b)
#pragma unroll
            for (int m = 0; m < 4; ++m)
#pragma unroll
                for (int n = 0; n < 2; ++n) acc[a][b][m][n] = (f32x4){0.f, 0.f, 0.f, 0.f};
    bf16x8 At[4][2], B0[2][2], B1[2][2];
    const char* cB = S.b_base(cur);
    unsigned cA00, cA01, cA10, cA11, nA00, nA01, nA10, nA11;
    const char* const Ab = S.a_base();
    S.a_rows(cur, rowA, colA, cA00, cA01, cA10, cA11);
    S.a_ready(cur);
    if constexpr (SP2) {
        PG8_STAGE(PG8_SB(0, 0), cB, voffB); PG8_STAGE(PG8_SB(0, 1), cB + hstep, voffB); PG8_STAGEA(PG8_SA(0, 0), cA00, cA01, 0); PG8_STAGEA(PG8_SA(0, 1), cA10, cA11, 0);
        if (wr == 1) PG8_BAR;
        PG8_WAIT_V(2); PG8_BAR;
        PG8_STAGE(PG8_SB(1, 0), cB + kstep, voffB); PG8_STAGEA(PG8_SA(1, 0), cA00, cA01, kstep); PG8_STAGE(PG8_SB(1, 1), cB + hstep + kstep, voffB);
        PG8_WAIT_V(6); PG8_BAR;
    } else {
        PG8_STAGE(PG8_SB(0, 0), cB, voffB); PG8_STAGEA(PG8_SA(0, 0), cA00, cA01, 0); PG8_STAGE(PG8_SB(0, 1), cB + hstep, voffB); PG8_STAGEA(PG8_SA(0, 1), cA10, cA11, 0);
        if (wr == 1) PG8_BAR;
        PG8_WAIT_V(4); PG8_BAR;
        PG8_STAGE(PG8_SB(1, 0), cB + kstep, voffB); PG8_STAGEA(PG8_SA(1, 0), cA00, cA01, kstep); PG8_STAGE(PG8_SB(1, 1), cB + hstep + kstep, voffB);
        PG8_WAIT_V(6); PG8_BAR;
    }
    for (;;) {
        const bool has_next = S.next(ui + 1, nxt);
        const char* nB = has_next ? S.b_base(nxt) : cB;
        if (has_next) S.a_rows(nxt, rowA, colA, nA00, nA01, nA10, nA11); else { nA00 = cA00; nA01 = cA01; nA10 = cA10; nA11 = cA11; }
        for (int t = 0; t < nt; t += 2) {
            const bool last = (t == nt - 2);
            const size_t k1 = (size_t)(t + 1) * kstep;
            const size_t k2 = last ? 0 : (size_t)(t + 2) * kstep; const char* b2 = last ? nB : cB + (size_t)(t + 2) * kstep;
            const unsigned q00 = last ? nA00 : cA00, q01 = last ? nA01 : cA01, q10 = last ? nA10 : cA10, q11 = last ? nA11 : cA11;
            const size_t k3 = k2 + kstep; const char* b3 = b2 + kstep;
            if (last && has_next) S.a_ready(nxt);
            if constexpr (SP2) {
            PG8_LDB(B0, 0, 0); PG8_LDB(B1, 0, 1); PG8_SCHED; PG8_LDA(At, 0, 0); PG8_STAGEA(PG8_SA(1, 1), cA10, cA11, k1);
            PG8_WAIT_V(8); PG8_WAIT_L(0); PG8_BAR; PG8_MMA(0, 0, At, B0); PG8_MMA(0, 1, At, B1); PG8_BAR; PG8_SCHED;
            PG8_LDA(At, 0, 1); PG8_STAGE(PG8_SB(0, 0), b2, voffB); PG8_STAGE(PG8_SB(0, 1), b2 + hstep, voffB); PG8_STAGEA(PG8_SA(0, 0), q00, q01, k2);
            PG8_WAIT_V(8); PG8_WAIT_L(0); PG8_BAR; PG8_MMA(1, 0, At, B0); PG8_MMA(1, 1, At, B1); PG8_BAR; PG8_SCHED;
            PG8_LDB(B0, 1, 0); PG8_LDB(B1, 1, 1); PG8_SCHED; PG8_LDA(At, 1, 0); PG8_STAGEA(PG8_SA(0, 1), q10, q11, k2);
            PG8_WAIT_V(8); PG8_WAIT_L(0); PG8_BAR; PG8_MMA(0, 0, At, B0); PG8_MMA(0, 1, At, B1); PG8_BAR; PG8_SCHED;
            PG8_LDA(At, 1, 1); PG8_STAGE(PG8_SB(1, 0), b3, voffB); PG8_STAGE(PG8_SB(1, 1), b3 + hstep, voffB); PG8_STAGEA(PG8_SA(1, 0), q00, q01, k3);
            PG8_WAIT_V(8); PG8_WAIT_L(0); PG8_BAR; PG8_MMA(1, 0, At, B0); PG8_MMA(1, 1, At, B1); PG8_BAR; PG8_SCHED;
            } else {
            PG8_LDB(B0, 0, 0); PG8_SCHED; PG8_LDA(At, 0, 0); PG8_STAGEA(PG8_SA(1, 1), cA10, cA11, k1);
            PG8_WAIT_L(8); PG8_BAR; PG8_WAIT_L(0); PG8_MMA(0, 0, At, B0); PG8_BAR; PG8_SCHED;
            PG8_LDB(B1, 0, 1); PG8_STAGE(PG8_SB(0, 0), b2, voffB);
            PG8_BAR; PG8_WAIT_L(0); PG8_MMA(0, 1, At, B1); PG8_BAR;
            PG8_LDA(At, 0, 1); PG8_STAGEA(PG8_SA(0, 0), q00, q01, k2);
            PG8_BAR; PG8_WAIT_L(0); PG8_MMA(1, 0, At, B0); PG8_BAR; PG8_SCHED;
            PG8_STAGE(PG8_SB(0, 1), b2 + hstep, voffB);
            PG8_WAIT_V(6); PG8_BAR; PG8_MMA(1, 1, At, B1); PG8_BAR;
            PG8_LDB(B0, 1, 0); PG8_SCHED; PG8_LDA(At, 1, 0); PG8_STAGEA(PG8_SA(0, 1), q10, q11, k2);
            PG8_WAIT_L(8); PG8_BAR; PG8_WAIT_L(0); PG8_MMA(0, 0, At, B0); PG8_BAR; PG8_SCHED;
            PG8_LDB(B1, 1, 1); PG8_STAGE(PG8_SB(1, 0), b3, voffB);
            PG8_BAR; PG8_WAIT_L(0); PG8_MMA(0, 1, At, B1); PG8_BAR;
            PG8_LDA(At, 1, 1); PG8_STAGEA(PG8_SA(1, 0), q00, q01, k3);
            PG8_BAR; PG8_WAIT_L(0); PG8_MMA(1, 0, At, B0); PG8_BAR; PG8_SCHED;
            PG8_STAGE(PG8_SB(1, 1), b3 + hstep, voffB);
            PG8_WAIT_V(6); PG8_BAR; PG8_MMA(1, 1, At, B1); PG8_BAR;
            }
        }
        if constexpr (ALIGN_EPI) { if (wr == 0) PG8_BAR; }
        if constexpr (!Epi::AFTER_DRAIN) { E(acc, cur, wr, wc, fr, fq); S.done(cur); }
        if (!has_next) break;
#pragma unroll
        for (int a = 0; a < 2; ++a)
#pragma unroll
            for (int b = 0; b < 2; ++b)
#pragma unroll
                for (int m = 0; m < 4; ++m)
#pragma unroll
                    for (int n = 0; n < 2; ++n) acc[a][b][m][n] = (f32x4){0.f, 0.f, 0.f, 0.f};
        cur = nxt; cA00 = nA00; cA01 = nA01; cA10 = nA10; cA11 = nA11; cB = nB; ++ui;
        if constexpr (ALIGN_EPI) { if (wr == 1) PG8_BAR; }
    }
    PG8_WAIT_V(0);
    if constexpr (!ALIGN_EPI) { if (wr == 0) PG8_BAR; }
    PG8_BAR;
    if constexpr (Epi::AFTER_DRAIN) { E.fused(acc, cur, wr, wc, fr, fq, lds, wid, lane); S.done(cur); }
#undef PG8_SA
#undef PG8_SB
#undef PG8_STAGE
#undef PG8_STAGEA
#undef PG8_LDA
#undef PG8_LDB
#undef PG8_MMA
#undef PG8_WAIT_V
#undef PG8_WAIT_L
#undef PG8_BAR
#undef PG8_SCHED
}
}

DEVI void wt_colinfo(const Params& p, int R, const float*& src, int& ld, float& scale) {
    scale = 1.0f; src = nullptr; ld = 0;
    if (R < WT_AT) {
        const int pn = R >> 8, cl = R & 255; ld = DIN_; int col = -1;
        if (pn < 4) { const int wcq = (cl >> 5) & 3; col = (pn >> 1) * 512 + (2 * (pn & 1) + (wcq >> 1)) * 128 + 64 * (cl >> 7) + 32 * (wcq & 1) + (cl & 31);
                      if (pn >= 2) scale = KSCALE_; }
        else if (pn < 8)  col = 2048 + (pn - 4) * 256 + cl;
        else if (pn < 10) { col = 3072 + (pn - 8) * 256 + cl; scale = KSCALE_; }
        else if (pn < 14) col = 5120 + (pn - 10) * 256 + cl;
        else if (pn < 22) col = 6160 + (pn - 14) * 256 + cl;
        else if (cl < 16) col = 6144 + cl;
        if (col >= 0) src = p.w_in + col;
    } else if (R < WT_RET) {
        const int Rr = R - WT_AT, pm = Rr >> 8, rl = Rr & 255; ld = DIN_; int col;
        if (pm < 2) { col = 512 + (2 * pm + ((rl >> 6) & 1)) * 128 + 64 * (rl >> 7) + (rl & 63); scale = KSCALE_; }
        else if (pm < 6) col = 1024 + (pm - 2) * 256 + rl;
        else if (pm < 8) col = 3584 + (pm - 6) * 256 + rl;
        else             col = 4096 + (pm - 8) * 256 + rl;
        src = p.w_in + col;
    } else {
        int Rr, ldd; const float* base;
        if (R < WT_GLA)    { Rr = R - WT_RET; base = p.w_ret_out; ldd = 1024; }
        else if (R < WT_O) { Rr = R - WT_GLA; base = p.w_gla_out; ldd = 1024; }
        else if (R < WT_R) { Rr = R - WT_O;   base = p.w_o;       ldd = 1024; }
        else               { Rr = R - WT_R;   base = p.router_w;  ldd = 256; }
        src = base + ((R >= WT_R) ? ((Rr & ~127) + vperm(Rr & 127)) : Rr); ld = ldd;
    }
}

DEVI void phase0(const Params& p, unsigned char* smem) {
    const int tid = VT, nb = VG, bid = VB;
    float2* cs = (float2*)(p.ws + OFF_CS);
    for (int i = bid * 256 + tid; i < 4096 * 64; i += nb * 256) {
        const int pos = i >> 6, k = i & 63;
        const float angf = (float)pos * c_inv_freq[k];
        const double a = (double)angf;
        const double TWO_PI = 6.283185307179586476925286766559, HALF_PI = 1.5707963267948966192313216916398;
        const double kk = rint(a * (1.0 / TWO_PI));
        const double r = a - kk * TWO_PI;
        const double qd = rint(r * (1.0 / HALF_PI));
        const double y = r - qd * HALF_PI;
        const double y2 = y * y;
        double sn = y * (1.0 + y2 * (-1.0 / 6 + y2 * (1.0 / 120 + y2 * (-1.0 / 5040 + y2 * (1.0 / 362880 + y2 * (-1.0 / 39916800 + y2 * (1.0 / 6227020800.0)))))));
        double cn = 1.0 + y2 * (-0.5 + y2 * (1.0 / 24 + y2 * (-1.0 / 720 + y2 * (1.0 / 40320 + y2 * (-1.0 / 3628800 + y2 * (1.0 / 479001600.0))))));
        const int qi = ((int)qd) & 3;
        double s, c;
        if (qi == 0) { s = sn; c = cn; } else if (qi == 1) { s = cn; c = -sn; } else if (qi == 2) { s = -sn; c = -cn; } else { s = -cn; c = sn; }
        cs[i] = make_float2((float)c, (float)s);
    }
    if (bid == 0) { int* cnt = (int*)(p.ws + OFF_CNT); for (int i = tid; i < 512; i += 256) cnt[i] = 0; }
    {
        const f32x4* xs = (const f32x4*)p.x; u32x4* xd = (u32x4*)(p.ws + OFF_XB);
        const int n8 = T_ * D_ / 8;
        for (int g = bid * 256 + tid; g < n8; g += nb * 256) {
            const f32x4 v0 = xs[2 * g], v1 = xs[2 * g + 1];
            u32x4 o; o.x = pk2(v0[0], v0[1]); o.y = pk2(v0[2], v0[3]); o.z = pk2(v1[0], v1[1]); o.w = pk2(v1[2], v1[3]);
            xd[g] = o;
        }
    }
    {
        float* tile = (float*)smem;
        bf16_t* wt = (bf16_t*)(p.ws + OFF_WT);
        const int ntask = (WT_ROWS / 64) * 16;
        for (int task = bid; task < ntask; task += nb) {
            const int rt = task >> 4, kt = task & 15, R0 = rt * 64, k0 = kt * 64;
            {
                const int n = tid & 63, kq = tid >> 6;
                const float* src; int ld; float sc; wt_colinfo(p, R0 + n, src, ld, sc);
#pragma unroll
                for (int i = 0; i < 16; ++i) { const int k = kq + 4 * i; tile[k * 65 + n] = src ? src[(size_t)(k0 + k) * ld] * sc : 0.f; }
            }
            __syncthreads();
            {
                const int n = tid >> 2, ks = (tid & 3) * 16;
                unsigned o[8];
#pragma unroll
                for (int j = 0; j < 8; ++j) o[j] = pk2(tile[(ks + 2 * j) * 65 + n], tile[(ks + 2 * j + 1) * 65 + n]);
                u32x4* dst = (u32x4*)(wt + (size_t)(R0 + n) * 1024 + k0 + ks);
                dst[0] = (u32x4){o[0], o[1], o[2], o[3]}; dst[1] = (u32x4){o[4], o[5], o[6], o[7]};
            }
            __syncthreads();
        }
    }
}

struct EpiP1N {
    static constexpr bool PERM = true, AFTER_DRAIN = false;
    unsigned char* ws;
    __device__ __forceinline__ void operator()(const pg8::f32x4 (&acc)[2][2][4][2], const pg8::Unit& u, int wr, int wc, int fr, int fq) const {
        const int pn = u.pn, row0 = u.pm * 256 + wr * 64 + fr, c8 = wc * 32 + 8 * fq;
        if (pn < 4) {
            const float2* cs = (const float2*)(ws + OFF_CS); bf16_t* Qr = (bf16_t*)(ws + (pn < 2 ? OFF_QR : OFF_KR));
            const int head = 2 * (pn & 1) + (wc >> 1), d0 = 32 * (wc & 1) + 8 * fq;
#pragma unroll
            for (int ai = 0; ai < 2; ++ai)
#pragma unroll
                for (int m = 0; m < 4; ++m) {
                    const size_t row = row0 + ai * 128 + m * 16; const int pos = (int)(row & 4095);
                    f32x4 c4[4];
#pragma unroll
                    for (int j = 0; j < 4; ++j) c4[j] = *(const f32x4*)(cs + pos * 64 + d0 + 2 * j);
                    f32x4 o1[2], o2[2];
#pragma unroll
                    for (int n = 0; n < 2; ++n)
#pragma unroll
                        for (int r = 0; r < 4; ++r) {
                            const f32x4 cc = c4[2 * n + (r >> 1)]; const float c_ = cc[(r & 1) * 2], s_ = cc[(r & 1) * 2 + 1];
                            const float x1 = acc[ai][0][m][n][r], x2 = acc[ai][1][m][n][r];
                            o1[n][r] = x1 * c_ - x2 * s_; o2[n][r] = x1 * s_ + x2 * c_;
                        }
                    *(u32x4*)(Qr + row * 512 + head * 128 + d0) = pk8(o1[0], o1[1]);
                    *(u32x4*)(Qr + row * 512 + head * 128 + 64 + d0) = pk8(o2[0], o2[1]);
                    asm volatile("" ::: "memory");
                }
        } else {
#pragma unroll
            for (int ai = 0; ai < 2; ++ai)
#pragma unroll
                for (int m = 0; m < 4; ++m) {
                    const size_t row = row0 + ai * 128 + m * 16;
#pragma unroll
                    for (int bj = 0; bj < 2; ++bj) {
                        const int cl = bj * 128 + c8;
                        f32x4 v0 = acc[ai][bj][m][0], v1 = acc[ai][bj][m][1];
                        if (pn < 8) {
#pragma unroll
                            for (int r = 0; r < 4; ++r) { v0[r] = siluf_(v0[r]); v1[r] = siluf_(v1[r]); }
                            *(u32x4*)((bf16_t*)(ws + OFF_GS) + row * 2048 + (pn - 4) * 256 + cl) = pk8(v0, v1);
                        } else if (pn < 10) {
                            *(u32x4*)((bf16_t*)(ws + OFF_QG) + row * 512 + (pn - 8) * 256 + cl) = pk8(v0, v1);
                        } else if (pn < 14) {
#pragma unroll
                            for (int r = 0; r < 4; ++r) { v0[r] = siluf_(v0[r]); v1[r] = siluf_(v1[r]); }
                            *(u32x4*)((bf16_t*)(ws + OFF_GS) + row * 2048 + 1024 + (pn - 10) * 256 + cl) = pk8(v0, v1);
                        } else if (pn < 22) {
#pragma unroll
                            for (int r = 0; r < 4; ++r) { v0[r] = sigmoidf_(v0[r]); v1[r] = sigmoidf_(v1[r]); }
                            *(u32x4*)((bf16_t*)(ws + OFF_MG) + row * 2048 + (pn - 14) * 256 + cl) = pk8(v0, v1);
                        } else if (cl < 16) {
                            float* Ga = (float*)(ws + OFF_GA); *(f32x4*)(Ga + row * 16 + cl) = v0; *(f32x4*)(Ga + row * 16 + cl + 4) = v1;
                        }
                    }
                    asm volatile("" ::: "memory");
                }
        }
    }
};
struct EpiP1K {
    static constexpr bool PERM = true, AFTER_DRAIN = false;
    unsigned char* ws;
    __device__ __forceinline__ void operator()(const pg8::f32x4 (&acc)[2][2][4][2], const pg8::Unit& u, int wr, int wc, int fr, int fq) const {
        const int pm = u.pm;
        {
            const float2* cs = (const float2*)(ws + OFF_CS); bf16_t* Krt = (bf16_t*)(ws + OFF_KRT);
            const int head = 2 * pm + wr; const float lg = gamma_log2(head);
            const float2* csl = cs + fr;
#pragma unroll
            for (int bj = 0; bj < 2; ++bj) {
                const int tok0 = u.pn * 256 + bj * 128 + wc * 32 + 8 * fq; const int bb = tok0 >> 12, cc = (tok0 >> 6) & 63, m0 = tok0 & 63;
                const size_t tb = ((size_t)((bb * 64 + cc) * 4 + head) * 128) * 64;
#pragma unroll
                for (int m = 0; m < 4; ++m) {
                    const int i = 16 * m + fr;
#pragma unroll
                    for (int n = 0; n < 2; ++n) {
                        f32x4 t1, t2;
#pragma unroll
                        for (int r = 0; r < 4; ++r) {
                            const int tok = tok0 + 4 * n + r;
                            const float2 c_s = csl[(tok & 4095) * 64 + 16 * m];
                            const float x1 = acc[0][bj][m][n][r], x2 = acc[1][bj][m][n][r];
                            const float o1 = x1 * c_s.x - x2 * c_s.y, o2 = x1 * c_s.y + x2 * c_s.x;
                            const float kd = __builtin_amdgcn_exp2f(lg * (float)(63 - (m0 + 4 * n + r)));
                            t1[r] = o1 * kd; t2[r] = o2 * kd;
                        }
                        *(u32x2*)(Krt + tb + (size_t)i * 64 + m0 + 4 * n) = pk4(t1);
                        *(u32x2*)(Krt + tb + (size_t)(i + 64) * 64 + m0 + 4 * n) = pk4(t2);
                        asm volatile("" ::: "memory");
                    }
                }
            }
        }
    }
};
struct EpiP1V {
    static constexpr bool PERM = true, AFTER_DRAIN = false;
    unsigned char* ws;
    __device__ __forceinline__ void operator()(const pg8::f32x4 (&acc)[2][2][4][2], const pg8::Unit& u, int wr, int wc, int fr, int fq) const {
        const int pm = u.pm + 2;
        {
#pragma unroll
            for (int ai = 0; ai < 2; ++ai) {
                bf16_t* dst; int head, hd, dbase;
                if (pm < 6)      { dst = (bf16_t*)(ws + OFF_VRT); head = pm - 2;            hd = 256; dbase = ai * 128; }
                else if (pm < 8) { dst = (bf16_t*)(ws + OFF_KGT); head = 2 * (pm - 6) + ai; hd = 128; dbase = 0; }
                else             { dst = (bf16_t*)(ws + OFF_VGT); head = pm - 8;            hd = 256; dbase = ai * 128; }
#pragma unroll
                for (int bj = 0; bj < 2; ++bj) {
                    const int tok0 = u.pn * 256 + bj * 128 + wc * 32 + 8 * fq; const int bb = tok0 >> 12, cc = (tok0 >> 6) & 63, m0 = tok0 & 63;
                    const size_t tb = ((size_t)((bb * 64 + cc) * 4 + head) * hd) * 64;
#pragma unroll
                    for (int m = 0; m < 4; ++m) {
                        const int d = dbase + wr * 64 + m * 16 + fr;
                        *(u32x4*)(dst + tb + (size_t)d * 64 + m0) = pk8(acc[ai][bj][m][0], acc[ai][bj][m][1]);
                        asm volatile("" ::: "memory");
                    }
                }
            }
        }
    }
};
DEVI void phase1(const Params& p, unsigned char* smem_all) {
    {
        pg8::StaticOrder S; S.init(T_, 5888, RG, RB);
        pg8::Gemm g; g.A = (const bf16_t*)(p.ws + OFF_XB); g.Bt = (const bf16_t*)(p.ws + OFF_WT) + (size_t)WT_BN * 1024; g.M = T_; g.N = 5888; g.K = 1024;
        EpiP1N E; E.ws = p.ws;
        pg8::gemm_phase<EpiP1N, pg8::StaticOrder, true, true>((PG8_LAS unsigned char*)smem_all, g, S, E);
    }
    __syncthreads();
    {
        pg8::StaticOrder S; S.init(2560, T_, RG, RB);
        pg8::Gemm g; g.A = (const bf16_t*)(p.ws + OFF_WT) + (size_t)(WT_AT + 512) * 1024; g.Bt = (const bf16_t*)(p.ws + OFF_XB); g.M = 2560; g.N = T_; g.K = 1024;
        EpiP1V E; E.ws = p.ws;
        pg8::gemm_phase<EpiP1V, pg8::StaticOrder, true, true>((PG8_LAS unsigned char*)smem_all, g, S, E);
    }
    __syncthreads();
    {
        pg8::StaticOrder S; S.init(512, T_, RG, RB);
        pg8::Gemm g; g.A = (const bf16_t*)(p.ws + OFF_WT) + (size_t)WT_AT * 1024; g.Bt = (const bf16_t*)(p.ws + OFF_XB); g.M = 512; g.N = T_; g.K = 1024;
        EpiP1K E; E.ws = p.ws;
        pg8::gemm_phase<EpiP1K, pg8::StaticOrder, true, true>((PG8_LAS unsigned char*)smem_all, g, S, E);
    }
}

DEVI void phase2(const Params& p, unsigned char* smem) {
    float* ga_s = (float*)smem;
    float* tot = (float*)(smem + 4096);
    const int tid = VT;
    const float* Ga = (const float*)(p.ws + OFF_GA);
    const bf16_t* Kgt = (const bf16_t*)(p.ws + OFF_KGT); bf16_t* Kg2 = (bf16_t*)(p.ws + OFF_KG2);
    float* dec = (float*)(p.ws + OFF_DEC);
    for (int it = VB; it < 2048; it += VG) {
        const int h = it & 3, c = (it >> 2) & 63, b = it >> 8;
        const int tok0 = b * 4096 + c * 64;
        ((f32x4*)ga_s)[tid] = ((const f32x4*)(Ga + (size_t)tok0 * 16))[tid];
        const int dk = tid & 127, half = tid >> 7;
        float w2[16];
#pragma unroll
        for (int r = 0; r < 16; ++r) w2[r] = p.gate_w2[r * 512 + h * 128 + dk];
        const float bias = p.gate_b[h * 128 + dk];
        __syncthreads();
        float run = 0.f; float bc[32];
#pragma unroll
        for (int ml = 0; ml < 32; ++ml) {
            const int m = half * 32 + ml;
            float z = bias;
#pragma unroll
            for (int r4 = 0; r4 < 4; ++r4) { const f32x4 g4 = *(const f32x4*)&ga_s[m * 16 + 4 * r4];
                z += g4[0] * w2[4 * r4] + g4[1] * w2[4 * r4 + 1] + g4[2] * w2[4 * r4 + 2] + g4[3] * w2[4 * r4 + 3]; }
            const float la = (fminf(z, 0.f) - __logf(1.0f + __expf(-fabsf(z)))) * (1.0f / 16.0f);
            run += la; bc[ml] = run;
        }
        tot[half * 128 + dk] = run;
        __syncthreads();
        const float t0 = tot[dk], t1 = tot[128 + dk];
        const float bend = t0 + t1, off = half ? t0 : 0.f;
        const u32x4* kp = (const u32x4*)(Kgt + ((size_t)it * 128 + dk) * 64 + half * 32);
        u32x4* kq = (u32x4*)(Kg2 + ((size_t)it * 128 + dk) * 64 + half * 32);
#pragma unroll
        for (int j = 0; j < 4; ++j) {
            u32x4 v = kp[j];
            unsigned uu[4] = {v.x, v.y, v.z, v.w};
#pragma unroll
            for (int e = 0; e < 4; ++e) {
                const float f0 = bflo(uu[e]) * __expf(bend - (bc[8 * j + 2 * e] + off));
                const float f1 = bfhi(uu[e]) * __expf(bend - (bc[8 * j + 2 * e + 1] + off));
                uu[e] = pk2(f0, f1);
            }
            kq[j] = (u32x4){uu[0], uu[1], uu[2], uu[3]};
        }
        if (half == 0) dec[(size_t)it * 128 + dk] = __expf(bend);
        __syncthreads();
    }
}

constexpr int ST_LD = 136;
template <bool GLA, int DUMMY>
DEVI void scan_item(const Params& p, bf16_t* St, int b, int h, int s) {
    const int t = VT, lane = t & 63, w = t >> 6, l15 = lane & 15, q = lane >> 4;
    const bf16_t* Ktb = (const bf16_t*)(p.ws + (GLA ? OFF_KG2 : OFF_KRT));
    const bf16_t* Vtb = (const bf16_t*)(p.ws + (GLA ? OFF_VGT : OFF_VRT));
    const bf16_t* Qb  = (const bf16_t*)(p.ws + (GLA ? OFF_QG : OFF_QR));
    const float* dec = (const float*)(p.ws + OFF_DEC);
    bf16_t* Oo = (bf16_t*)(p.ws + OFF_OO);
    const float lg = gamma_log2(h);
    const float cd = exp2f(lg * 64.0f);
    const float qdec = exp2f(lg * (float)(16 * w + l15 + 1));
    f32x4 S[2][2];
#pragma unroll
    for (int i = 0; i < 2; ++i)
#pragma unroll
        for (int j = 0; j < 2; ++j) S[i][j] = (f32x4){0.f, 0.f, 0.f, 0.f};
    if (!GLA) {
        for (int i = t; i < 32 * ST_LD / 2; i += 256) ((unsigned*)St)[i] = 0u;
        __syncthreads();
    }
    bf16x8 an[2][2], bn[2][2], qn[4]; f32x4 dn[2];
    auto issue = [&](int c_) {
        const int c = (DUMMY == 1) ? 0 : c_;
        const size_t it = (size_t)((b * 64 + c) * 4 + h);
        const bf16_t* kt = Ktb + it * 128 * 64; const bf16_t* vt = Vtb + it * 256 * 64;
#pragma unroll
        for (int mt = 0; mt < 2; ++mt)
#pragma unroll
            for (int ks = 0; ks < 2; ++ks) an[mt][ks] = *(const bf16x8*)(kt + (size_t)(32 * w + 16 * mt + l15) * 64 + ks * 32 + q * 8);
#pragma unroll
        for (int nt = 0; nt < 2; ++nt)
#pragma unroll
            for (int ks = 0; ks < 2; ++ks) bn[nt][ks] = *(const bf16x8*)(vt + (size_t)(s * 32 + 16 * nt + l15) * 64 + ks * 32 + q * 8);
        const size_t tok = (size_t)b * 4096 + c * 64 + 16 * w + l15;
#pragma unroll
        for (int ks = 0; ks < 4; ++ks) qn[ks] = *(const bf16x8*)(Qb + tok * 512 + h * 128 + ks * 32 + q * 8);
        if (GLA) {
#pragma unroll
            for (int mt = 0; mt < 2; ++mt) dn[mt] = *(const f32x4*)(dec + it * 128 + 32 * w + 16 * mt + 4 * q);
        }
    };
    issue(0);
    for (int c = 0; c < 64; ++c) {
        bf16x8 a[2][2], bv[2][2], qf[4]; f32x4 d[2];
#pragma unroll
        for (int i = 0; i < 2; ++i)
#pragma unroll
            for (int j = 0; j < 2; ++j) { a[i][j] = an[i][j]; bv[i][j] = bn[i][j]; }
#pragma unroll
        for (int i = 0; i < 4; ++i) qf[i] = qn[i];
        d[0] = dn[0]; d[1] = dn[1];
        if (c + 1 < 64) issue(c + 1);
        const size_t tok = (size_t)b * 4096 + c * 64 + 16 * w + l15;
        bf16_t* op = Oo + tok * 2048 + (GLA ? 1024 : 0) + h * 256 + s * 32 + 4 * q;
        if (!GLA) {
            f32x4 O[2] = {(f32x4){0.f, 0.f, 0.f, 0.f}, (f32x4){0.f, 0.f, 0.f, 0.f}};
#pragma unroll
            for (int ks = 0; ks < 4; ++ks)
#pragma unroll
                for (int nt = 0; nt < 2; ++nt) {
                    const bf16x8 sf = *(const bf16x8*)&St[(16 * nt + l15) * ST_LD + ks * 32 + q * 8];
                    O[nt] = mfma16(sf, qf[ks], O[nt]);
                }
#pragma unroll
            for (int nt = 0; nt < 2; ++nt) { f32x4 o = O[nt] * qdec; if (DUMMY != 2) *(u32x2*)(op + 16 * nt) = pk4(o); else asm volatile("" :: "v"(o)); }
#pragma unroll
            for (int mt = 0; mt < 2; ++mt)
#pragma unroll
                for (int nt = 0; nt < 2; ++nt) {
                    f32x4 sv = S[mt][nt] * cd;
                    sv = mfma16(a[mt][0], bv[nt][0], sv);
                    sv = mfma16(a[mt][1], bv[nt][1], sv);
                    S[mt][nt] = sv;
                }
            __syncthreads();
#pragma unroll
            for (int mt = 0; mt < 2; ++mt)
#pragma unroll
                for (int nt = 0; nt < 2; ++nt) *(u32x2*)&St[(16 * nt + l15) * ST_LD + 32 * w + 16 * mt + 4 * q] = pk4(S[mt][nt]);
            __syncthreads();
        } else {
#pragma unroll
            for (int mt = 0; mt < 2; ++mt)
#pragma unroll
                for (int nt = 0; nt < 2; ++nt) {
                    f32x4 sv = S[mt][nt] * d[mt];
                    sv = mfma16(a[mt][0], bv[nt][0], sv);
                    sv = mfma16(a[mt][1], bv[nt][1], sv);
                    S[mt][nt] = sv;
                }
            __syncthreads();
#pragma unroll
            for (int mt = 0; mt < 2; ++mt)
#pragma unroll
                for (int nt = 0; nt < 2; ++nt) *(u32x2*)&St[(16 * nt + l15) * ST_LD + 32 * w + 16 * mt + 4 * q] = pk4(S[mt][nt]);
            __syncthreads();
            f32x4 O[2] = {(f32x4){0.f, 0.f, 0.f, 0.f}, (f32x4){0.f, 0.f, 0.f, 0.f}};
#pragma unroll
            for (int ks = 0; ks < 4; ++ks)
#pragma unroll
                for (int nt = 0; nt < 2; ++nt) {
                    const bf16x8 sf = *(const bf16x8*)&St[(16 * nt + l15) * ST_LD + ks * 32 + q * 8];
                    O[nt] = mfma16(sf, qf[ks], O[nt]);
                }
#pragma unroll
            for (int nt = 0; nt < 2; ++nt) { if (DUMMY != 2) *(u32x2*)(op + 16 * nt) = pk4(O[nt]); else asm volatile("" :: "v"(O[nt])); }
        }
    }
    __syncthreads();
}

template <int DUMMY>
DEVI void phase3(const Params& p, unsigned char* smem) {
    bf16_t* St = (bf16_t*)smem;
    for (int it0 = VB; it0 < 512; it0 += VG) {
        const int lcl = (RB >> 3) * 2 + VH;
        const int it = (VG == 512) ? ((RB & 7) * 8 + lcl / 8) * 8 + (lcl & 7) : it0;
        const int s = it & 7, h = (it >> 3) & 3, b = (it >> 5) & 7, br = it >> 8;
        if (br == 0) scan_item<false, DUMMY>(p, St, b, h, s); else scan_item<true, DUMMY>(p, St, b, h, s);
    }
}

constexpr int PS_LD = 72;
DEVI void phase4(const Params& p, unsigned char* smem) {
    const int t = VT, lane = t & 63, w = t >> 6, l15 = lane & 15, q = lane >> 4;
    bf16_t* Ps = (bf16_t*)smem + w * 16 * PS_LD;
    const bf16_t* Qr = (const bf16_t*)(p.ws + OFF_QR); const bf16_t* Kr = (const bf16_t*)(p.ws + OFF_KR);
    const bf16_t* Vrt = (const bf16_t*)(p.ws + OFF_VRT); const bf16_t* Oo = (const bf16_t*)(p.ws + OFF_OO);
    const bf16_t* Gs = (const bf16_t*)(p.ws + OFF_GS); bf16_t* Y = (bf16_t*)(p.ws + OFF_Y);
    for (int it = VB; it < 4096; it += VG) {
        const int br = it >> 11, idx = it & 2047;
        const int h = idx & 3, c = (idx >> 2) & 63, b = idx >> 8;
        const size_t tok0 = (size_t)b * 4096 + c * 64;
        const size_t tok = tok0 + 16 * w + l15;
        f32x4 O[16];
        const bf16_t* orow = Oo + tok * 2048 + br * 1024 + h * 256 + 4 * q;
        const bf16_t* grow = Gs + tok * 2048 + br * 1024 + h * 256 + 4 * q;
        u32x2 oraw[16], graw[16];
        if (br == 0) {
            const float lg = gamma_log2(h);
            const bf16_t* vt = Vrt + (size_t)idx * 256 * 64;
            bf16x8 vf[8][2];
#pragma unroll
            for (int nt = 0; nt < 8; ++nt) { vf[nt][0] = *(const bf16x8*)(vt + (size_t)(16 * nt + l15) * 64 + q * 8); vf[nt][1] = *(const bf16x8*)(vt + (size_t)(16 * nt + l15) * 64 + 32 + q * 8); }
            __builtin_amdgcn_sched_barrier(0);
            f32x4 P[4] = {(f32x4){0.f, 0.f, 0.f, 0.f}, (f32x4){0.f, 0.f, 0.f, 0.f}, (f32x4){0.f, 0.f, 0.f, 0.f}, (f32x4){0.f, 0.f, 0.f, 0.f}};
#pragma unroll
            for (int ks = 0; ks < 4; ++ks) {
                const bf16x8 qf = *(const bf16x8*)(Qr + tok * 512 + h * 128 + ks * 32 + q * 8);
#pragma unroll
                for (int mt = 0; mt < 4; ++mt) {
                    const bf16x8 kf = *(const bf16x8*)(Kr + (tok0 + 16 * mt + l15) * 512 + h * 128 + ks * 32 + q * 8);
                    P[mt] = mfma16(kf, qf, P[mt]);
                }
            }
            const int j = 16 * w + l15;
#pragma unroll
            for (int mt = 0; mt < 4; ++mt) {
                f32x4 v = P[mt];
#pragma unroll
                for (int r = 0; r < 4; ++r) { const int m = 16 * mt + 4 * q + r; const int dd = j > m ? j - m : m - j; v[r] *= exp2f(lg * (float)dd); }
                *(u32x2*)&Ps[l15 * PS_LD + 16 * mt + 4 * q] = pk4(v);
            }
            __syncthreads();
            const bf16x8 pf0 = *(const bf16x8*)&Ps[l15 * PS_LD + q * 8];
            const bf16x8 pf1 = *(const bf16x8*)&Ps[l15 * PS_LD + 32 + q * 8];
            __builtin_amdgcn_sched_barrier(0);
#pragma unroll
            for (int nt = 0; nt < 8; ++nt) {
                f32x4 o = (f32x4){0.f, 0.f, 0.f, 0.f};
                o = mfma16(vf[nt][0], pf0, o); O[nt] = mfma16(vf[nt][1], pf1, o);
            }
            __builtin_amdgcn_sched_barrier(0);
#pragma unroll
            for (int nt = 0; nt < 8; ++nt) { vf[nt][0] = *(const bf16x8*)(vt + (size_t)(16 * (8 + nt) + l15) * 64 + q * 8); vf[nt][1] = *(const bf16x8*)(vt + (size_t)(16 * (8 + nt) + l15) * 64 + 32 + q * 8); }
#pragma unroll
            for (int nt = 0; nt < 16; ++nt) { oraw[nt] = *(const u32x2*)(orow + 16 * nt); graw[nt] = *(const u32x2*)(grow + 16 * nt); }
            __builtin_amdgcn_sched_barrier(0);
#pragma unroll
            for (int nt = 0; nt < 8; ++nt) {
                f32x4 o = (f32x4){0.f, 0.f, 0.f, 0.f};
                o = mfma16(vf[nt][0], pf0, o); O[8 + nt] = mfma16(vf[nt][1], pf1, o);
            }
#pragma unroll
            for (int nt = 0; nt < 16; ++nt) O[nt] += unpk4(oraw[nt]);
            __syncthreads();
        } else {
#pragma unroll
            for (int nt = 0; nt < 16; ++nt) { oraw[nt] = *(const u32x2*)(orow + 16 * nt); graw[nt] = *(const u32x2*)(grow + 16 * nt); }
#pragma unroll
            for (int nt = 0; nt < 16; ++nt) O[nt] = unpk4(oraw[nt]);
        }
        float s1 = 0.f;
#pragma unroll
        for (int nt = 0; nt < 16; ++nt) s1 += (O[nt][0] + O[nt][1]) + (O[nt][2] + O[nt][3]);
        s1 += __shfl_xor(s1, 16); s1 += __shfl_xor(s1, 32);
        const float mean = (br == 0) ? s1 * (1.0f / 256.0f) : 0.f;
        float s2 = 0.f;
#pragma unroll
        for (int nt = 0; nt < 16; ++nt) {
#pragma unroll
            for (int r = 0; r < 4; ++r) { const float dlt = O[nt][r] - mean; s2 += dlt * dlt; }
        }
        s2 += __shfl_xor(s2, 16); s2 += __shfl_xor(s2, 32);
        const float rstd = rsqrtf(s2 * (1.0f / 256.0f) + (br == 0 ? 1e-5f : 1e-6f));
        const float* gw = (br == 0 ? p.ret_norm_g : p.gla_norm_g) + h * 256 + 4 * q;
        bf16_t* yrow = Y + ((size_t)br * T_ + tok) * 1024 + h * 256 + 4 * q;
#pragma unroll
        for (int nt = 0; nt < 16; ++nt) {
            const f32x4 g = *(const f32x4*)(gw + 16 * nt);
            const f32x4 gate = unpk4(graw[nt]);
            f32x4 y;
#pragma unroll
            for (int r = 0; r < 4; ++r) y[r] = (O[nt][r] - mean) * rstd * g[r] * gate[r];
            *(u32x2*)(yrow + 16 * nt) = pk4(y);
        }
    }
}

struct EpiMerge {
    static constexpr bool PERM = true, AFTER_DRAIN = false;
    const bf16_t* Mg; bf16_t* Mrg; int pass;
    __device__ __forceinline__ void operator()(const pg8::f32x4 (&acc)[2][2][4][2], const pg8::Unit& u, int wr, int wc, int fr, int fq) const {
        const int row0 = u.pm * 256 + wr * 64 + fr, col0 = u.pn * 256 + wc * 32 + 8 * fq;
#pragma unroll
        for (int ai = 0; ai < 2; ++ai) {
            u32x4 gg[4][2], pr[4][2];
#pragma unroll
            for (int m = 0; m < 4; ++m)
#pragma unroll
                for (int bj = 0; bj < 2; ++bj) {
                    const size_t row = row0 + ai * 128 + m * 16; const int col = col0 + bj * 128;
                    gg[m][bj] = *(const u32x4*)(Mg + row * 2048 + pass * 1024 + col);
                    if (pass) pr[m][bj] = *(const u32x4*)(Mrg + row * 1024 + col);
                }
#pragma unroll
            for (int m = 0; m < 4; ++m)
#pragma unroll
                for (int bj = 0; bj < 2; ++bj) {
                    const size_t row = row0 + ai * 128 + m * 16; const int col = col0 + bj * 128;
                    f32x4 g0, g1; unpk8(gg[m][bj], g0, g1);
                    f32x4 o0 = acc[ai][bj][m][0] * g0, o1 = acc[ai][bj][m][1] * g1;
                    if (pass) { f32x4 p0, p1; unpk8(pr[m][bj], p0, p1); o0 += p0; o1 += p1; }
                    *(u32x4*)(Mrg + row * 1024 + col) = pk8(o0, o1);
                }
        }
    }
};
DEVI void phase5(const Params& p, unsigned char* smem_all) {
    pg8::StaticOrder S; S.init(T_, 1024, RG, RB);
    const bf16_t* Y = (const bf16_t*)(p.ws + OFF_Y); const bf16_t* wt = (const bf16_t*)(p.ws + OFF_WT);
    for (int pass = 0; pass < 2; ++pass) {
        pg8::Gemm g; g.A = Y + (size_t)pass * T_ * 1024; g.Bt = wt + (size_t)(pass ? WT_GLA : WT_RET) * 1024; g.M = T_; g.N = 1024; g.K = 1024;
        EpiMerge E; E.Mg = (const bf16_t*)(p.ws + OFF_MG); E.Mrg = (bf16_t*)(p.ws + OFF_MRG); E.pass = pass;
        pg8::gemm_phase<EpiMerge, pg8::StaticOrder, true, true>((PG8_LAS unsigned char*)smem_all, g, S, E);
        __syncthreads();
    }
}

struct EpiResid {
    static constexpr bool PERM = true, AFTER_DRAIN = false;
    const float* x; bf16_t* T1;
    __device__ __forceinline__ void operator()(const pg8::f32x4 (&acc)[2][2][4][2], const pg8::Unit& u, int wr, int wc, int fr, int fq) const {
        const int row0 = u.pm * 256 + wr * 64 + fr, col0 = u.pn * 256 + wc * 32 + 8 * fq;
#pragma unroll
        for (int ai = 0; ai < 2; ++ai)
#pragma unroll
            for (int m = 0; m < 4; ++m) {
                const size_t row = row0 + ai * 128 + m * 16;
                f32x4 xv[2][2];
#pragma unroll
                for (int bj = 0; bj < 2; ++bj) { xv[bj][0] = *(const f32x4*)(x + row * 1024 + col0 + bj * 128); xv[bj][1] = *(const f32x4*)(x + row * 1024 + col0 + bj * 128 + 4); }
#pragma unroll
                for (int bj = 0; bj < 2; ++bj)
                    *(u32x4*)(T1 + row * 1024 + col0 + bj * 128) = pk8(xv[bj][0] * ALPHA_ + acc[ai][bj][m][0], xv[bj][1] * ALPHA_ + acc[ai][bj][m][1]);
            }
    }
};
DEVI void phase6(const Params& p, unsigned char* smem_all) {
    pg8::StaticOrder S; S.init(T_, 1024, RG, RB);
    pg8::Gemm g; g.A = (const bf16_t*)(p.ws + OFF_MRG); g.Bt = (const bf16_t*)(p.ws + OFF_WT) + (size_t)WT_O * 1024; g.M = T_; g.N = 1024; g.K = 1024;
    EpiResid E; E.x = p.x; E.T1 = (bf16_t*)(p.ws + OFF_T1);
    pg8::gemm_phase<EpiResid, pg8::StaticOrder, true, true>((PG8_LAS unsigned char*)smem_all, g, S, E);
}

DEVI void conv_expert_weights(const Params& p, unsigned char* smem) {
    bf16_t* tile = (bf16_t*)smem;
    const int t = VT, ng = t & 31, kg = t >> 5;
    bf16_t* WGU = (bf16_t*)(p.ws + OFF_WGU); bf16_t* WD = (bf16_t*)(p.ws + OFF_WD);
    const int ntask = 257 * 3 * 32;
    for (int task = VB; task < ntask; task += VG) {
        const int e = task / 96, rem = task - e * 96, mat = rem >> 5, tl = rem & 31;
        const float* src; bf16_t* dst; int K, N, kt, nt;
        if (mat < 2) { K = 1024; N = 256; kt = tl >> 1; nt = tl & 1;
            src = (mat == 0) ? (e < 256 ? p.ew_gate + (size_t)e * 262144 : p.sw_gate) : (e < 256 ? p.ew_up + (size_t)e * 262144 : p.sw_up);
            dst = WGU + (size_t)e * 524288 + (size_t)(nt + mat) * 131072; }
        else { K = 256; N = 1024; kt = tl >> 3; nt = tl & 7;
            src = e < 256 ? p.ew_down + (size_t)e * 262144 : p.sw_down; dst = WD + (size_t)e * 262144; }
        const float* sp = src + (size_t)(kt * 64 + 4 * kg) * N + nt * 128 + 4 * ng;
        f32x4 rf[8];
#pragma unroll
        for (int i = 0; i < 4; ++i) { rf[i] = *(const f32x4*)(sp + (size_t)i * N); rf[4 + i] = *(const f32x4*)(sp + (size_t)(32 + i) * N); }
#pragma unroll
        for (int i = 0; i < 4; ++i) {
            u32x2 v0, v1;
            v0.x = pk2(rf[0][i], rf[1][i]); v0.y = pk2(rf[2][i], rf[3][i]); v1.x = pk2(rf[4][i], rf[5][i]); v1.y = pk2(rf[6][i], rf[7][i]);
            *(u32x2*)&tile[(4 * ng + i) * 72 + 4 * kg] = v0; *(u32x2*)&tile[(4 * ng + i) * 72 + 32 + 4 * kg] = v1;
        }
        __syncthreads();
        {
            const int n = t >> 1, hf = t & 1;
            bf16_t* dp = dst + (size_t)(nt * 128 + n) * K + kt * 64 + hf * 32;
#pragma unroll
            for (int j = 0; j < 4; ++j) *(u32x4*)(dp + 8 * j) = *(const u32x4*)&tile[n * 72 + hf * 32 + 8 * j];
        }
        __syncthreads();
    }
}

DEVI void phase7(const Params& p, unsigned char* smem) {
    const int t = VT, lane = t & 63, w = t >> 6;
    const bf16_t* T1 = (const bf16_t*)(p.ws + OFF_T1); bf16_t* X1b = (bf16_t*)(p.ws + OFF_X1B);
    for (int row = VB * 4 + w; row < T_; row += VG * 4) {
        f32x4 v[4]; float s = 0.f;
#pragma unroll
        for (int i = 0; i < 4; ++i) { v[i] = unpk4(*(const u32x2*)(T1 + (size_t)row * 1024 + i * 256 + lane * 4)); s += (v[i][0] + v[i][1]) + (v[i][2] + v[i][3]); }
#pragma unroll
        for (int o = 32; o > 0; o >>= 1) s += __shfl_xor(s, o);
        const float mean = s * (1.0f / 1024.0f); float s2 = 0.f;
#pragma unroll
        for (int i = 0; i < 4; ++i)
#pragma unroll
            for (int r = 0; r < 4; ++r) { const float d = v[i][r] - mean; s2 += d * d; }
#pragma unroll
        for (int o = 32; o > 0; o >>= 1) s2 += __shfl_xor(s2, o);
        const float rstd = rsqrtf(s2 * (1.0f / 1024.0f) + 1e-5f);
#pragma unroll
        for (int i = 0; i < 4; ++i) {
            const int col = i * 256 + lane * 4;
            const f32x4 g = *(const f32x4*)(p.ln1_g + col), bb = *(const f32x4*)(p.ln1_b + col);
            f32x4 y;
#pragma unroll
            for (int r = 0; r < 4; ++r) y[r] = (v[i][r] - mean) * rstd * g[r] + bb[r];
            *(u32x2*)(X1b + (size_t)row * 1024 + col) = pk4(y);
        }
    }
    conv_expert_weights(p, smem);
}

DEVI void phase8(const Params& p, unsigned char* smem) {
    GemmSmem& sm = *(GemmSmem*)smem;
    const int t = VT, lane = t & 63, w = t >> 6, wr = w >> 1, wc = w & 1, l15 = lane & 15, q = lane >> 4;
    const bf16_t* X1b = (const bf16_t*)(p.ws + OFF_X1B); const bf16_t* wt = (const bf16_t*)(p.ws + OFF_WT);
    float* LG = (float*)(p.ws + OFF_LOG);
    for (int tile = VB; tile < 256 * 2; tile += VG) {
        const int mtg = tile >> 1, ntg = tile & 1, m0 = mtg * 128, n0 = ntg * 128;
        const bf16_t* pa0 = X1b + (size_t)(m0 + (t >> 3)) * 1024 + gemm_src_chunk(t);
        const bf16_t* pb0 = wt + (size_t)(WT_R + n0 + (t >> 3)) * 1024 + gemm_src_chunk(t);
        const bf16_t* const pa[4] = {pa0, pa0 + 32 * 1024, pa0 + 64 * 1024, pa0 + 96 * 1024};
        const bf16_t* const pb[4] = {pb0, pb0 + 32 * 1024, pb0 + 64 * 1024, pb0 + 96 * 1024};
        f32x4 acc[4][4]; zero_acc(acc);
        gemm_kloop<true, 0>(acc, pa, pb, nullptr, 0, 16, sm);
#pragma unroll
        for (int mt = 0; mt < 4; ++mt)
#pragma unroll
            for (int nt = 0; nt < 4; ++nt) {
                const int row = m0 + wr * 64 + mt * 16 + l15, col = n0 + wc * 64 + (nt >> 1) * 32 + 8 * q + 4 * (nt & 1);
                *(f32x4*)(LG + (size_t)row * 256 + col) = acc[mt][nt];
            }
    }
}

DEVI unsigned f2ord(float f) { const unsigned u = __float_as_uint(f); return (u & 0x80000000u) ? ~u : (u | 0x80000000u); }
DEVI void phase9(const Params& p) {
    const int t = VT, lane = t & 63, w = t >> 6;
    const float* LG = (const float*)(p.ws + OFF_LOG);
    int* cnt = (int*)(p.ws + OFF_CNT); int* list = (int*)(p.ws + OFF_LIST); float* wts = (float*)(p.ws + OFF_WTS);
    const int tstep = VG * 4;
    int tok = VB * 4 + w;
    float lgn[4]; float rb[4];
#pragma unroll
    for (int r = 0; r < 4; ++r) { rb[r] = p.router_bias[lane + 64 * r]; lgn[r] = tok < T_ ? LG[(size_t)tok * 256 + lane + 64 * r] : 0.f; }
    int ppos = 0, pe = -1, ptk9 = 0;
    for (; tok < T_; tok += tstep) {
        float sc[4], bi[4];
#pragma unroll
        for (int r = 0; r < 4; ++r) { sc[r] = sigmoidf_(lgn[r]); bi[r] = sc[r] + rb[r]; }
        { const int tn = tok + tstep;
#pragma unroll
          for (int r = 0; r < 4; ++r) lgn[r] = tn < T_ ? LG[(size_t)tn * 256 + lane + 64 * r] : 0.f; }
        float gsc[8];
#pragma unroll
        for (int r = 0; r < 4; ++r) {
            float m1 = bi[r];
#pragma unroll
            for (int o = 16; o > 0; o >>= 1) m1 = fmaxf(m1, __shfl_xor(m1, o));
            const unsigned long long bal = __ballot(bi[r] == m1);
            const unsigned halfmask = (lane < 32) ? (unsigned)(bal & 0xffffffffull) : (unsigned)(bal >> 32);
            const int first = __ffs(halfmask) - 1;
            float m2 = ((lane & 31) == first) ? -INFINITY : bi[r];
#pragma unroll
            for (int o = 16; o > 0; o >>= 1) m2 = fmaxf(m2, __shfl_xor(m2, o));
            const float g = m1 + m2;
            gsc[2 * r] = __shfl(g, 0); gsc[2 * r + 1] = __shfl(g, 32);
        }
        unsigned selmask = 0;
#pragma unroll
        for (int g = 0; g < 8; ++g) {
            int rank = 0;
#pragma unroll
            for (int g2 = 0; g2 < 8; ++g2) rank += (gsc[g2] > gsc[g] || (gsc[g2] == gsc[g] && g2 < g)) ? 1 : 0;
            if (rank < 4) selmask |= 1u << g;
        }
        float cand[4];
#pragma unroll
        for (int r = 0; r < 4; ++r) cand[r] = ((selmask >> (2 * r + (lane >> 5))) & 1u) ? bi[r] : -INFINITY;
        float wsum = 0.f, myw = 0.f; int mye = 0;
#pragma unroll 1
        for (int k = 0; k < 8; ++k) {
            unsigned long long best = 0ull;
#pragma unroll
            for (int r = 0; r < 4; ++r) {
                const unsigned long long key = ((unsigned long long)f2ord(cand[r]) << 32) | (unsigned)(0xffffffffu - (unsigned)(lane + 64 * r));
                best = key > best ? key : best;
            }
#pragma unroll
            for (int o = 32; o > 0; o >>= 1) { const unsigned long long oth = __shfl_xor(best, o); best = oth > best ? oth : best; }
            const int e = (int)(0xffffffffu - (unsigned)(best & 0xffffffffull));
            float mine = 0.f;
#pragma unroll
            for (int r = 0; r < 4; ++r) if (e == lane + 64 * r) { mine = sc[r]; cand[r] = -INFINITY; }
            const float sv = __shfl(mine, e & 63);
            wsum += sv;
            if (lane == k) { mye = e; myw = sv; }
        }
        if (lane < 8) {
            if (pe >= 0) list[(size_t)pe * T_ + ppos] = ptk9;
            ppos = atomicAdd(&cnt[mye], 1); pe = mye; ptk9 = tok * 9 + lane;
            wts[(size_t)tok * 9 + lane] = myw / wsum * 2.5f;
        } else if (lane == 8) wts[(size_t)tok * 9 + 8] = 1.0f;
    }
    if (lane < 8 && pe >= 0) list[(size_t)pe * T_ + ppos] = ptk9;
}

DEVI void moe_prefix(const Params& p, int* pre  , int xg) {
    const int tid = VT;
    const int* cnt = (const int*)(p.ws + OFF_CNT);
    __syncthreads();
    if (tid < 64) {
        int v = 0;
        if (tid < 32) v = (__hip_atomic_load(&cnt[xg + 8 * tid], __ATOMIC_RELAXED, __HIP_MEMORY_SCOPE_AGENT) + 127) >> 7;
        else if (tid == 32) v = 32;
#pragma unroll
        for (int o = 1; o < 64; o <<= 1) { const int u = __shfl_up(v, o); if (tid >= o) v += u; }
        if (tid < 33) pre[tid + 1] = v;
        if (tid == 0) pre[0] = 0;
    }
    __syncthreads();
}
DEVI int moe_find(const int* pre, int mb) {
    int lo = 0, hi = 32;
    while (lo < hi) { const int mid = (lo + hi + 1) >> 1; if (pre[mid] <= mb) lo = mid; else hi = mid - 1; }
    return lo;
}
DEVI int moe_tk9(const int* list, int e, int pos) { return e < 256 ? list[(size_t)e * T_ + pos] : pos * 9 + 8; }

DEVI void moe_prefix256(const Params& p, int* pre  , int xg) {
    const int tid = threadIdx.x;
    const int* cnt = (const int*)(p.ws + OFF_CNT);
    __syncthreads();
    if (tid < 64) {
        int v = 0;
        if (tid < 32) v = (__hip_atomic_load(&cnt[xg + 8 * tid], __ATOMIC_RELAXED, __HIP_MEMORY_SCOPE_AGENT) + 255) >> 8;
        else if (tid == 32) v = 16;
#pragma unroll
        for (int o = 1; o < 64; o <<= 1) { const int u = __shfl_up(v, o); if (tid >= o) v += u; }
        if (tid < 33) pre[tid + 1] = v;
        if (tid == 0) pre[0] = 0;
    }
    __syncthreads();
}
struct MoeSched {
    const int* pre; const int* cnt; const int* list;
    int xg, jl, nloc, nun;
    const char* Abase; int arow_bytes; bool by_token;
    const char* Bbase; size_t b_expert_bytes, b_unit_bytes;
    __device__ __forceinline__ bool next(int i, pg8::Unit& u) const { const int item = jl + i * nloc; if (item >= pre[33] * nun) return false; u.pm = item / nun; u.pn = item - u.pm * nun; return true; }
    __device__ __forceinline__ void decode(const pg8::Unit& u, int& e, int& r0, int& ce) const {
        const int gi = moe_find(pre, u.pm), mb = u.pm - pre[gi];
        e = gi < 32 ? xg + 8 * gi : 256; ce = e < 256 ? cnt[e] : T_; r0 = (e < 256 ? 0 : xg * 4096) + mb * 256;
    }
    __device__ __forceinline__ int slot(int e, int pos) const { return e < 256 ? list[(size_t)e * T_ + pos] : pos * 9 + 8; }
    __device__ __forceinline__ const char* a_base() const { return Abase; }
    __device__ __forceinline__ void a_rows(const pg8::Unit& u, const int (&rowA)[2], const int (&colA)[2], unsigned& p00, unsigned& p01, unsigned& p10, unsigned& p11) const {
        int e, r0, ce; decode(u, e, r0, ce);
        const int fb = e < 256 ? 0 : xg * 4096;
        int s4[4];
#pragma unroll
        for (int k = 0; k < 4; ++k) { int pos = r0 + (k >> 1) * 128 + rowA[k & 1]; if (pos >= ce) pos = fb; s4[k] = slot(e, pos); }
#pragma unroll
        for (int k = 0; k < 4; ++k) if (by_token) s4[k] = s4[k] / 9;
        p00 = (unsigned)s4[0] * (unsigned)arow_bytes + (unsigned)colA[0]; p01 = (unsigned)s4[1] * (unsigned)arow_bytes + (unsigned)colA[1];
        p10 = (unsigned)s4[2] * (unsigned)arow_bytes + (unsigned)colA[0]; p11 = (unsigned)s4[3] * (unsigned)arow_bytes + (unsigned)colA[1];
    }
    __device__ __forceinline__ const char* b_base(const pg8::Unit& u) const { int e, r0, ce; decode(u, e, r0, ce); return Bbase + (size_t)e * b_expert_bytes + (size_t)u.pn * b_unit_bytes; }
    __device__ __forceinline__ void a_ready(const pg8::Unit&) const {}
    __device__ __forceinline__ void done(const pg8::Unit&) const {}
};
struct EpiMoe1 {
    static constexpr bool PERM = true, AFTER_DRAIN = false;
    const MoeSched* S; bf16_t* H;
    __device__ __forceinline__ void operator()(const pg8::f32x4 (&acc)[2][2][4][2], const pg8::Unit& u, int wr, int wc, int fr, int fq) const {
        int e, r0, ce; S->decode(u, e, r0, ce);
#pragma unroll
        for (int ai = 0; ai < 2; ++ai) {
            int sl[4];
#pragma unroll
            for (int m = 0; m < 4; ++m) { const int pos = r0 + ai * 128 + wr * 64 + m * 16 + fr; sl[m] = pos < ce ? S->slot(e, pos) : -1; }
#pragma unroll
            for (int m = 0; m < 4; ++m) if (sl[m] >= 0) {
                f32x4 h0, h1;
#pragma unroll
                for (int r = 0; r < 4; ++r) { h0[r] = siluf_(acc[ai][0][m][0][r]) * acc[ai][1][m][0][r]; h1[r] = siluf_(acc[ai][0][m][1][r]) * acc[ai][1][m][1][r]; }
                *(u32x4*)(H + (size_t)sl[m] * 256 + u.pn * 128 + wc * 32 + 8 * fq) = pk8(h0, h1);
            }
            asm volatile("" ::: "memory");
        }
    }
};
struct EpiMoe2 {
    static constexpr bool PERM = true, AFTER_DRAIN = false;
    const MoeSched* S; const float* wts; unsigned char* YX;
    __device__ __forceinline__ void operator()(const pg8::f32x4 (&acc)[2][2][4][2], const pg8::Unit& u, int wr, int wc, int fr, int fq) const {
        int e, r0, ce; S->decode(u, e, r0, ce);
#pragma unroll
        for (int ai = 0; ai < 2; ++ai) {
            int sl[4]; float wg[4];
#pragma unroll
            for (int m = 0; m < 4; ++m) { const int pos = r0 + ai * 128 + wr * 64 + m * 16 + fr; sl[m] = pos < ce ? S->slot(e, pos) : -1; }
#pragma unroll
            for (int m = 0; m < 4; ++m) wg[m] = sl[m] >= 0 ? wts[sl[m]] * YX_SCALE : 0.f;
#pragma unroll
            for (int m = 0; m < 4; ++m) if (sl[m] >= 0) {
#pragma unroll
                for (int bj = 0; bj < 2; ++bj)
                    { u32x2 w8; w8.x = pk4_fp8(clamp4(acc[ai][bj][m][0] * wg[m], 440.f)); w8.y = pk4_fp8(clamp4(acc[ai][bj][m][1] * wg[m], 440.f));
                      *(u32x2*)(YX + (size_t)sl[m] * 1024 + u.pn * 256 + bj * 128 + wc * 32 + 8 * fq) = w8; }
            }
            asm volatile("" ::: "memory");
        }
    }
};
DEVI void moe_sched_init(const Params& p, MoeSched& S, int* pre) {
    S.pre = pre; S.cnt = (const int*)(p.ws + OFF_CNT); S.list = (const int*)(p.ws + OFF_LIST);
    S.xg = RB & 7; S.jl = RB >> 3; S.nloc = RG >> 3;
}
DEVI void phase10(const Params& p, unsigned char* smem_all) {
    int* pre = (int*)(smem_all + 131072);
    MoeSched S; moe_sched_init(p, S, pre); moe_prefix256(p, pre, S.xg);
    S.nun = 2; S.Abase = (const char*)(p.ws + OFF_X1B); S.arow_bytes = 2048; S.by_token = true;
    S.Bbase = (const char*)(p.ws + OFF_WGU); S.b_expert_bytes = (size_t)512 * 1024 * 2; S.b_unit_bytes = (size_t)256 * 1024 * 2;
    EpiMoe1 E; E.S = &S; E.H = (bf16_t*)(p.ws + OFF_H);
    pg8::gemm_phase_g<EpiMoe1, MoeSched, true, true>((PG8_LAS unsigned char*)smem_all, 1024, S, E);
}
DEVI void phase11(const Params& p, unsigned char* smem_all) {
    int* pre = (int*)(smem_all + 131072);
    MoeSched S; moe_sched_init(p, S, pre); moe_prefix256(p, pre, S.xg);
    S.nun = 4; S.Abase = (const char*)(p.ws + OFF_H); S.arow_bytes = 512; S.by_token = false;
    S.Bbase = (const char*)(p.ws + OFF_WD); S.b_expert_bytes = (size_t)1024 * 256 * 2; S.b_unit_bytes = (size_t)256 * 256 * 2;
    EpiMoe2 E; E.S = &S; E.wts = (const float*)(p.ws + OFF_WTS); E.YX = (unsigned char*)(p.ws + OFF_YX);
    pg8::gemm_phase_g<EpiMoe2, MoeSched, true, true>((PG8_LAS unsigned char*)smem_all, 256, S, E);
}

DEVI void phase12(const Params& p) {
    const int t = VT, lane = t & 63, w = t >> 6;
    const bf16_t* X1b = (const bf16_t*)(p.ws + OFF_X1B); const unsigned char* YX = (const unsigned char*)(p.ws + OFF_YX);
    for (int row = VB * 4 + w; row < T_; row += VG * 4) {
        f32x4 v[4]; float s = 0.f;
#pragma unroll
        for (int i = 0; i < 4; ++i) {
            const int col = i * 256 + lane * 4;
            f32x4 a = unpk4(*(const u32x2*)(X1b + (size_t)row * 1024 + col)) * ALPHA_;
            f32x4 ys = (f32x4){0.f, 0.f, 0.f, 0.f};
#pragma unroll
            for (int k = 0; k < 9; ++k) ys += unpk4_fp8(*(const unsigned*)(YX + ((size_t)row * 9 + k) * 1024 + col));
            a += ys * (1.0f / YX_SCALE);
            v[i] = a; s += (a[0] + a[1]) + (a[2] + a[3]);
        }
#pragma unroll
        for (int o = 32; o > 0; o >>= 1) s += __shfl_xor(s, o);
        const float mean = s * (1.0f / 1024.0f); float s2 = 0.f;
#pragma unroll
        for (int i = 0; i < 4; ++i)
#pragma unroll
            for (int r = 0; r < 4; ++r) { const float d = v[i][r] - mean; s2 += d * d; }
#pragma unroll
        for (int o = 32; o > 0; o >>= 1) s2 += __shfl_xor(s2, o);
        const float rstd = rsqrtf(s2 * (1.0f / 1024.0f) + 1e-5f);
#pragma unroll
        for (int i = 0; i < 4; ++i) {
            const int col = i * 256 + lane * 4;
            const f32x4 g = *(const f32x4*)(p.ln2_g + col), bb = *(const f32x4*)(p.ln2_b + col);
            f32x4 y;
#pragma unroll
            for (int r = 0; r < 4; ++r) y[r] = (v[i][r] - mean) * rstd * g[r] + bb[r];
            *(f32x4*)(p.out + (size_t)row * 1024 + col) = y;
        }
    }
}


#define XB_TMO      128
#define XB_XCNT(j)  (256  + 64 * (j))
#define XB_XSUB(j)  (1280 + 64 * (j))
#define XB_XGEN(j)  (2304 + 64 * (j))
#define XB_TOP      3328
#define XB_TOPGEN   3392
#define XCD_BAR_WORDS 3456
#define XB_SPIN_CAP (1u << 20)
#define LAS __attribute__((address_space(3)))
DEVI unsigned xb_ld(unsigned* p)              { return __hip_atomic_load(p, __ATOMIC_RELAXED, __HIP_MEMORY_SCOPE_AGENT); }
DEVI unsigned xb_add(unsigned* p, unsigned v) { return __hip_atomic_fetch_add(p, v, __ATOMIC_RELAXED, __HIP_MEMORY_SCOPE_AGENT); }
DEVI unsigned xb_xcc_id() { return (unsigned)__builtin_amdgcn_s_getreg((3 << 11) | 20) & 0xFu; }
#define XB_SPIN(cond, bar) do { unsigned _sp = 0; while (cond) { __builtin_amdgcn_s_sleep(1); \
    if ((++_sp & 255u) == 0u) { if (xb_ld(&(bar)[XB_TMO])) break; if (_sp > XB_SPIN_CAP) { atomicAdd(&(bar)[XB_TMO], 1u); break; } } } } while (0)
struct XcdBarrier { unsigned* bar; unsigned x; volatile LAS unsigned* st; };
DEVI XcdBarrier xcd_barrier_post(unsigned* bar, volatile LAS unsigned* st) {
    XcdBarrier b; b.bar = bar; b.x = xb_xcc_id(); b.st = st;
    if (threadIdx.x == 0) (void)xb_add(&bar[XB_XCNT(b.x)], 1u);
    return b;
}
DEVI void xcd_barrier_complete(unsigned* bar, unsigned x, unsigned& nloc, unsigned& nx) {
    const unsigned G = gridDim.x * gridDim.y * gridDim.z;
    unsigned sum, cnt, mine, sp = 0u;
    for (;;) {
        sum = 0u; cnt = 0u; mine = 0u;
#pragma unroll
        for (unsigned j = 0; j < 16; ++j) { const unsigned c = xb_ld(&bar[XB_XCNT(j)]); sum += c; cnt += (c > 0u) ? 1u : 0u; mine = (j == x) ? c : mine; }
        if (sum == G) break;
        __builtin_amdgcn_s_sleep(1);
        if ((++sp & 255u) == 0u) { if (xb_ld(&bar[XB_TMO])) break; if (sp > XB_SPIN_CAP) { atomicAdd(&bar[XB_TMO], 1u); break; } }
    }
    nloc = mine > 0u ? mine : 1u; nx = cnt > 0u ? cnt : 1u;
}
DEVI void xcd_barrier(const XcdBarrier& b) {
    asm volatile("s_waitcnt vmcnt(0)" ::: "memory");
    __syncthreads();
    if (threadIdx.x == 0) {
        unsigned* bar = b.bar;
        __builtin_amdgcn_s_waitcnt(0);
        unsigned nloc = b.st[0], nx = b.st[1];
        if (nloc == 0u) { xcd_barrier_complete(bar, b.x, nloc, nx); b.st[0] = nloc; b.st[1] = nx; }
        const unsigned old = xb_add(&bar[XB_XSUB(b.x)], 1u);
        const unsigned gen = old / nloc;
        if (old + 1u == (gen + 1u) * nloc) {
            __builtin_amdgcn_fence(__ATOMIC_RELEASE, "agent");
            asm volatile("s_waitcnt vmcnt(0)" ::: "memory");
            const unsigned og = xb_add(&bar[XB_TOP], 1u);
            const unsigned tg = og / nx;
            if (og + 1u == (tg + 1u) * nx) xb_add(&bar[XB_TOPGEN], 1u);
            else XB_SPIN(xb_ld(&bar[XB_TOPGEN]) == tg, bar);
            __builtin_amdgcn_fence(__ATOMIC_ACQUIRE, "agent");
            xb_add(&bar[XB_XGEN(b.x)], 1u);
            asm volatile("s_waitcnt vmcnt(0)" ::: "memory");
        } else {
            XB_SPIN(xb_ld(&bar[XB_XGEN(b.x)]) == gen, bar);
            __builtin_amdgcn_fence(__ATOMIC_ACQUIRE, "agent");
            asm volatile("s_waitcnt vmcnt(0)" ::: "memory");
        }
    }
    __syncthreads();
}
constexpr size_t OFF_BAR = OFF_CNT + 65536;

#ifndef DBG
#define DBG 0
#endif
DEVI void dump_f32(const Params& p, size_t off) {
    const f32x4* src = (const f32x4*)(p.ws + off); f32x4* dst = (f32x4*)p.out;
    for (int i = blockIdx.x * 256 + threadIdx.x; i < T_ * D_ / 4; i += gridDim.x * 256) dst[i] = src[i];
}
DEVI void dump_bf16(const Params& p, size_t off, int ld, int coff) {
    const bf16_t* src = (const bf16_t*)(p.ws + off);
    for (int i = blockIdx.x * 256 + threadIdx.x; i < T_ * D_; i += gridDim.x * 256) { const int row = i >> 10, col = i & 1023; p.out[i] = bf2f(src[(size_t)row * ld + coff + col]); }
}
DEVI float flat_bf(const Params& p, size_t off, size_t n, size_t i) { const bf16_t* b = (const bf16_t*)(p.ws + off); float a = 0.f; for (size_t j = i; j < n; j += (size_t)T_ * D_) a += bf2f(b[j]); return a; }
DEVI void dump_p1(const Params& p) {
    const size_t N = (size_t)T_ * D_;
    for (size_t i = (size_t)blockIdx.x * 256 + threadIdx.x; i < N; i += (size_t)gridDim.x * 256) {
        float a = 0.f;
        a += flat_bf(p, OFF_MG, 2 * N, i) + flat_bf(p, OFF_GS, 2 * N, i);
        a += flat_bf(p, OFF_QR, N / 2, i % (N / 2)) + flat_bf(p, OFF_KR, N / 2, i % (N / 2)) + flat_bf(p, OFF_QG, N / 2, i % (N / 2));
        a += flat_bf(p, OFF_KRT, N / 2, i % (N / 2)) + flat_bf(p, OFF_KGT, N / 2, i % (N / 2));
        a += flat_bf(p, OFF_VRT, N, i) + flat_bf(p, OFF_VGT, N, i);
        a += ((const float*)(p.ws + OFF_GA))[i % ((size_t)T_ * 16)];
        p.out[i] = a;
    }
}
constexpr int NPHASE = 13;
__global__ void __launch_bounds__(512, 2) fwd_megakernel(Params p) {
    __shared__ __attribute__((aligned(16))) unsigned char smem_all[2 * SMEM_HALF];
    unsigned char* smem = smem_all + VH * SMEM_HALF;
    uint4* xb_words = (uint4*)(smem_all + 2 * SMEM_HALF - 16);
    if (threadIdx.x == 0) *xb_words = make_uint4(0u, 0u, 0u, 0u);
    __syncthreads();
    const XcdBarrier xb = xcd_barrier_post((unsigned*)(p.ws + OFF_BAR), (volatile LAS unsigned*)xb_words);
#ifndef REPMASK
#define REPMASK 0
#endif
#define RUN_PHASE(K, CALL) do { if (p.phase_lo <= (K) && (K) < p.phase_hi) { _Pragma("unroll 1") for (int rep_ = ((REPMASK >> (K)) & 1); rep_ >= 0; --rep_) { CALL; if (rep_ > 0 || (K) + 1 < p.phase_hi) xcd_barrier(xb); } } } while (0)
    RUN_PHASE(0, phase0(p, smem));
    RUN_PHASE(1, phase1(p, smem_all));
#if DBG == 2
    dump_p1(p); return;
#endif
    RUN_PHASE(2, phase2(p, smem));
#if DBG == 5
    { const size_t N = (size_t)T_ * D_; for (size_t i = (size_t)blockIdx.x * 256 + threadIdx.x; i < N; i += (size_t)gridDim.x * 256) p.out[i] = flat_bf(p, OFF_KG2, N / 2, i % (N / 2)) + ((const float*)(p.ws + OFF_DEC))[i % (2048 * 128)]; } return;
#endif
#ifdef SCANDUMMY
    phase3<SCANDUMMY>(p, smem); xcd_barrier(xb);
#endif
    RUN_PHASE(3, phase3<0>(p, smem));
#if DBG == 6
    dump_bf16(p, OFF_OO, 2048, 1024); return;
#endif
#if DBG == 7
    { const bf16_t* src = (const bf16_t*)(p.ws + OFF_OO);
      for (int i = blockIdx.x * 256 + threadIdx.x; i < T_ * D_; i += gridDim.x * 256) { const int row = i >> 10, col = i & 1023; const float v = bf2f(src[(size_t)row * 2048 + 1024 + col]); p.out[i] = (fabsf(v) < 1e30f) ? v : 12345.0f; } } return;
#endif
    RUN_PHASE(4, phase4(p, smem));
#if DBG == 3
    dump_bf16(p, OFF_Y, 2048, 0); return;
#endif
#if DBG == 4
    dump_bf16(p, OFF_Y, 2048, 1024); return;
#endif
    RUN_PHASE(5, phase5(p, smem_all));
    RUN_PHASE(6, phase6(p, smem_all));
    RUN_PHASE(7, phase7(p, smem));
#if DBG == 1
    return;
#endif
    RUN_PHASE(8, phase8(p, smem));
    RUN_PHASE(9, phase9(p));
    RUN_PHASE(10, phase10(p, smem_all));
    RUN_PHASE(11, phase11(p, smem_all));
    RUN_PHASE(12, phase12(p));
#undef RUN_PHASE
}

extern "C" void kernel_launch(void* const* d_in, const int* in_sizes, int n_in, void* d_out, int out_size, void* d_ws, size_t ws_size,
                              hipStream_t stream) {
    static int grid_blocks = 0;
    if (!grid_blocks) {
        int dev = 0, cus = 0, per_cu = 0;
        hipGetDevice(&dev);
        hipDeviceGetAttribute(&cus, hipDeviceAttributeMultiprocessorCount, dev);
        hipOccupancyMaxActiveBlocksPerMultiprocessor(&per_cu, fwd_megakernel, 512, 0);
        if (per_cu > 1) per_cu = 1;
        if (per_cu < 1) per_cu = 1;
        grid_blocks = cus * per_cu;
    }
    if (ws_size < WS_NEEDED) { fprintf(stderr, "workspace too small: %zu < %zu\n", ws_size, (size_t)WS_NEEDED); return; }
    Params p{};
    p.x = (const float*)d_in[0]; p.w_in = (const float*)d_in[1]; p.ret_norm_g = (const float*)d_in[2]; p.gate_w2 = (const float*)d_in[3];
    p.gate_b = (const float*)d_in[4]; p.gla_norm_g = (const float*)d_in[5]; p.w_ret_out = (const float*)d_in[6]; p.w_gla_out = (const float*)d_in[7];
    p.w_o = (const float*)d_in[8]; p.ln1_g = (const float*)d_in[9]; p.ln1_b = (const float*)d_in[10]; p.router_w = (const float*)d_in[11];
    p.router_bias = (const float*)d_in[12]; p.ew_gate = (const float*)d_in[13]; p.ew_up = (const float*)d_in[14]; p.ew_down = (const float*)d_in[15];
    p.sw_gate = (const float*)d_in[16]; p.sw_up = (const float*)d_in[17]; p.sw_down = (const float*)d_in[18]; p.ln2_g = (const float*)d_in[19];
    p.ln2_b = (const float*)d_in[20];
    p.out = (float*)d_out; p.ws = (unsigned char*)d_ws; p.phase_lo = 0; p.phase_hi = NPHASE;
    void* args[] = {&p};
    (void)hipMemsetAsync((unsigned char*)d_ws + OFF_BAR, 0, XCD_BAR_WORDS * 4, stream);
    hipError_t e = hipLaunchCooperativeKernel((void*)fwd_megakernel, dim3(grid_blocks), dim3(512), args, 0, stream);
    if (e != hipSuccess) fprintf(stderr, "cooperative launch failed: %s (grid %d)\n", hipGetErrorString(e), grid_blocks);
}
```

```cpp
#include <hip/hip_runtime.h>
#include <hip/hip_cooperative_groups.h>
#include <cstdio>
#include <cstdint>
namespace cg = cooperative_groups;

typedef unsigned short bf16_t;
typedef short bf16x8 __attribute__((ext_vector_type(8)));
typedef float f32x4 __attribute__((ext_vector_type(4)));
typedef unsigned u32x2 __attribute__((ext_vector_type(2)));
typedef unsigned u32x4 __attribute__((ext_vector_type(4)));
#define DEVI __device__ __forceinline__
#define VH ((int)(threadIdx.x >> 8))
#define VT ((int)(threadIdx.x & 255))
#define RB (__builtin_amdgcn_readfirstlane(((const int*)(smem_all_g + 2 * SMEM_HALF - 16))[2]))
#define RG ((int)gridDim.x)
#define VB (RB * 2 + VH)
#define VG (RG * 2)

constexpr int T_ = 32768;
constexpr int D_ = 1024;
constexpr int DIN_ = 8208;
constexpr int NE_ = 256;
constexpr float ALPHA_ = 1.189207115002721f;
constexpr float KSCALE_ = 0.08838834764831845f;

constexpr size_t MB = 1ull << 20;
constexpr size_t OFF_CNT  = 0;
constexpr size_t OFF_CS   = 1 * MB;
constexpr size_t OFF_WT   = 3 * MB;
constexpr size_t FB = 27 * MB;
constexpr size_t OFF_QR   = FB + 0 * MB;
constexpr size_t OFF_KR   = FB + 32 * MB;
constexpr size_t OFF_VRT  = FB + 64 * MB;
constexpr size_t OFF_GS   = FB + 128 * MB;
constexpr size_t OFF_MG   = FB + 256 * MB;
constexpr size_t OFF_KRT  = FB + 384 * MB;
constexpr size_t OFF_QG   = FB + 416 * MB;
constexpr size_t OFF_VGT  = FB + 448 * MB;
constexpr size_t OFF_KGT  = FB + 512 * MB;
constexpr size_t OFF_GA   = FB + 544 * MB;
constexpr size_t OFF_XB   = FB + 546 * MB;
constexpr size_t OFF_KG2  = FB + 546 * MB;
constexpr size_t OFF_DEC  = FB + 578 * MB;
constexpr size_t OFF_OO   = FB + 579 * MB;
constexpr size_t OFF_Y    = FB + 384 * MB;
constexpr size_t OFF_MRG  = FB + 0 * MB;
constexpr size_t OFF_QGN  = 767 * MB;
constexpr size_t OFF_QFR  = 734 * MB;
constexpr size_t OFF_WGU  = 767 * MB;
constexpr size_t OFF_X1B  = FB + 0 * MB;
constexpr size_t OFF_WD   = FB + 64 * MB;
constexpr size_t OFF_LIST = FB + 193 * MB;
constexpr size_t OFF_WTS  = FB + 225 * MB;
constexpr size_t OFF_H    = FB + 227 * MB;
constexpr size_t OFF_YX   = FB + 371 * MB;
constexpr size_t OFF_T1   = FB + 371 * MB;
constexpr size_t OFF_LOG  = FB + 435 * MB;
constexpr size_t WS_NEEDED = 1024 * MB;

constexpr int WT_BN = 0, WT_AT = 5888, WT_RET = 8960, WT_GLA = 9984, WT_O = 11008, WT_R = 12032, WT_ROWS = 12288;

struct Params {
    const float *x, *w_in, *ret_norm_g, *gate_w2, *gate_b, *gla_norm_g, *w_ret_out, *w_gla_out, *w_o, *ln1_g, *ln1_b,
                *router_w, *router_bias, *ew_gate, *ew_up, *ew_down, *sw_gate, *sw_up, *sw_down, *ln2_g, *ln2_b;
    float* out;
    unsigned char* ws;
    int phase_lo, phase_hi;
};

static __device__ const float c_inv_freq[64] = {
  1.000000000e+00f, 8.659643531e-01f, 7.498942018e-01f, 6.493816376e-01f,
  5.623413324e-01f, 4.869675338e-01f, 4.216965139e-01f, 3.651741147e-01f,
  3.162277639e-01f, 2.738419771e-01f, 2.371373773e-01f, 2.053525001e-01f,
  1.778279394e-01f, 1.539926529e-01f, 1.333521456e-01f, 1.154781953e-01f,
  1.000000015e-01f, 8.659642935e-02f, 7.498942316e-02f, 6.493816525e-02f,
  5.623413250e-02f, 4.869675264e-02f, 4.216964915e-02f, 3.651741147e-02f,
  3.162277490e-02f, 2.738419548e-02f, 2.371373773e-02f, 2.053525113e-02f,
  1.778279431e-02f, 1.539926510e-02f, 1.333521400e-02f, 1.154781971e-02f,
  9.999999776e-03f, 8.659643121e-03f, 7.498942316e-03f, 6.493816152e-03f,
  5.623413250e-03f, 4.869675264e-03f, 4.216964822e-03f, 3.651741194e-03f,
  3.162277630e-03f, 2.738419687e-03f, 2.371373819e-03f, 2.053525066e-03f,
  1.778279431e-03f, 1.539926510e-03f, 1.333521446e-03f, 1.154782018e-03f,
  1.000000047e-03f, 8.659643354e-04f, 7.498941850e-04f, 6.493816036e-04f,
  5.623413017e-04f, 4.869675322e-04f, 4.216965172e-04f, 3.651741135e-04f,
  3.162277571e-04f, 2.738419571e-04f, 2.371373703e-04f, 2.053525095e-04f,
  1.778279402e-04f, 1.539926598e-04f, 1.333521504e-04f, 1.154782003e-04f };

DEVI float bf2f(unsigned short u) { return __uint_as_float(((unsigned)u) << 16); }
DEVI float bflo(unsigned u) { return __uint_as_float(u << 16); }
DEVI float bfhi(unsigned u) { return __uint_as_float(u & 0xffff0000u); }
typedef float f32x2 __attribute__((ext_vector_type(2)));
typedef __bf16 bf16x2_t __attribute__((ext_vector_type(2)));
DEVI unsigned pk2(float lo, float hi) { const f32x2 v = {lo, hi}; const bf16x2_t b = __builtin_convertvector(v, bf16x2_t); return __builtin_bit_cast(unsigned, b); }
DEVI unsigned short f2bf(float f) { return (unsigned short)(pk2(f, 0.f) & 0xffffu); }
DEVI u32x2 pk4(f32x4 v) { u32x2 r; r.x = pk2(v[0], v[1]); r.y = pk2(v[2], v[3]); return r; }
DEVI f32x4 unpk4(u32x2 u) { f32x4 r; r[0] = bflo(u.x); r[1] = bfhi(u.x); r[2] = bflo(u.y); r[3] = bfhi(u.y); return r; }
constexpr float YX_SCALE = 16.0f;
DEVI unsigned pk4_fp8(f32x4 v) { int w = 0; w = __builtin_amdgcn_cvt_pk_fp8_f32(v[0], v[1], w, false); w = __builtin_amdgcn_cvt_pk_fp8_f32(v[2], v[3], w, true); return (unsigned)w; }
DEVI f32x4 unpk4_fp8(unsigned u) { f32x4 r; r[0] = __builtin_amdgcn_cvt_f32_fp8((int)u, 0); r[1] = __builtin_amdgcn_cvt_f32_fp8((int)u, 1); r[2] = __builtin_amdgcn_cvt_f32_fp8((int)u, 2); r[3] = __builtin_amdgcn_cvt_f32_fp8((int)u, 3); return r; }
DEVI f32x4 clamp4(f32x4 v, float lim) { f32x4 r; for (int i = 0; i < 4; ++i) r[i] = fminf(fmaxf(v[i], -lim), lim); return r; }
DEVI float sigmoidf_(float v) { return 1.0f / (1.0f + __expf(-v)); }
DEVI float siluf_(float v) { return v / (1.0f + __expf(-v)); }
DEVI float gamma_log2(int h) { return log2f(1.0f - exp2f(-5.0f - (float)h)); }
DEVI f32x4 mfma16(bf16x8 a, bf16x8 b, f32x4 c) { return __builtin_amdgcn_mfma_f32_16x16x32_bf16(a, b, c, 0, 0, 0); }
DEVI unsigned kf_off(int item, int dk, int m8) { return ((((unsigned)item * 4u + (unsigned)(dk >> 5)) * 4u + (unsigned)(m8 >> 4)) * 64u + (unsigned)((m8 >> 3) & 1) * 32u + (unsigned)(dk & 31)) * 8u; }
DEVI unsigned vf_off(int item, int dv, int m8) { return ((((unsigned)item * 8u + (unsigned)(dv >> 5)) * 4u + (unsigned)(m8 >> 4)) * 64u + (unsigned)((m8 >> 3) & 1) * 32u + (unsigned)(dv & 31)) * 8u; }
DEVI unsigned qf_off(int bc, int h, int tokl, int dk8, int hh) {
    return ((((((unsigned)bc * 4u + (unsigned)h) * 2u + (unsigned)(tokl >> 5)) * 4u + (unsigned)(dk8 >> 5)) * 2u + (unsigned)((dk8 >> 4) & 1)) * 64u + (unsigned)hh * 32u + (unsigned)(tokl & 31)) * 8u + (unsigned)((dk8 >> 3) & 1) * 4u; }
DEVI int vperm(int n) { const int wc = n >> 6, nt = (n >> 4) & 3, i = n & 15; return wc * 64 + (nt >> 1) * 32 + 8 * (i >> 2) + 4 * (nt & 1) + (i & 3); }
DEVI int dperm2(int v) { return ((v >> 5) & 1) * 64 + (v >> 6) * 32 + (v & 31); }
DEVI u32x4 pk8(f32x4 a, f32x4 b) { u32x4 r; r.x = pk2(a[0], a[1]); r.y = pk2(a[2], a[3]); r.z = pk2(b[0], b[1]); r.w = pk2(b[2], b[3]); return r; }
DEVI void unpk8(u32x4 u, f32x4& a, f32x4& b) { a[0] = bflo(u.x); a[1] = bfhi(u.x); a[2] = bflo(u.y); a[3] = bfhi(u.y); b[0] = bflo(u.z); b[1] = bfhi(u.z); b[2] = bflo(u.w); b[3] = bfhi(u.w); }
DEVI int dperm(int v) { const int wc = v >> 6, nt = (v >> 4) & 3, c = v & 15; return (nt & 1) * 16 + wc * 32 + c + (nt >> 1) * 64; }

struct __attribute__((aligned(16))) GemmSmem { bf16_t a[2][128 * 64]; bf16_t b[2][128 * 64]; };
constexpr int SMEM_GEMM = sizeof(GemmSmem);
constexpr int SMEM_BYTES = SMEM_GEMM + 2048 + 16;
constexpr int SMEM_HALF = (SMEM_BYTES + 255) & ~255;
__shared__ __attribute__((aligned(16))) unsigned char smem_all_g[2 * SMEM_HALF];
DEVI int gemm_src_chunk(int t) { return ((t & 7) ^ ((t >> 4) & 7)) * 8; }

template <bool SWAP, int BKIND>
DEVI void gemm_kloop(f32x4 (&acc)[4][4], const bf16_t* const (&pa)[4], const bf16_t* const (&pb)[4],
                     const float* pbf, int ldb, int nk, GemmSmem& sm) {
    const int t = VT, lane = t & 63, w = t >> 6, wr = w >> 1, wc = w & 1, l15 = lane & 15, q = lane >> 4;
    const int kg = t & 7, ng = t >> 3;
    f32x4 rf[8];
#define GEMM_ISSUE(BUF, KO) do { \
        _Pragma("unroll") for (int i = 0; i < 4; ++i) \
            __builtin_amdgcn_global_load_lds((const unsigned*)(pa[i] + (KO)), (unsigned*)((char*)sm.a[BUF] + i * 4096 + t * 16), 16, 0, 0); \
        if (BKIND == 0) { _Pragma("unroll") for (int i = 0; i < 4; ++i) \
            __builtin_amdgcn_global_load_lds((const unsigned*)(pb[i] + (KO)), (unsigned*)((char*)sm.b[BUF] + i * 4096 + t * 16), 16, 0, 0); } \
        else { const float* pp = pbf + (size_t)((KO) + 4 * kg) * ldb; \
            _Pragma("unroll") for (int i = 0; i < 4; ++i) { rf[i] = *(const f32x4*)(pp + (size_t)i * ldb); rf[4 + i] = *(const f32x4*)(pp + (size_t)(32 + i) * ldb); } } } while (0)
#define GEMM_LSTORE_B(BUF) do { if (BKIND == 1) { \
            _Pragma("unroll") for (int i = 0; i < 4; ++i) { \
                u32x2 v0, v1; \
                v0.x = pk2(rf[0][i], rf[1][i]); v0.y = pk2(rf[2][i], rf[3][i]); v1.x = pk2(rf[4][i], rf[5][i]); v1.y = pk2(rf[6][i], rf[7][i]); \
                const int n = 4 * ng + i, sw = (n >> 1) & 7; \
                char* rowp = (char*)sm.b[BUF] + n * 128 + (kg & 1) * 8; \
                *(u32x2*)(rowp + (((kg >> 1) ^ sw) * 16)) = v0; *(u32x2*)(rowp + (((4 + (kg >> 1)) ^ sw) * 16)) = v1; } } } while (0)
    GEMM_ISSUE(0, 0);
    GEMM_LSTORE_B(0);
    __syncthreads();
#define GEMM_KSTEP(CUR, KT) do { \
        const bool more = ((KT) + 1 < nk); \
        if (more) { GEMM_ISSUE((CUR) ^ 1, ((KT) + 1) * 64); } \
        __builtin_amdgcn_sched_barrier(0); \
        _Pragma("unroll") for (int ss = 0; ss < 2; ++ss) { \
            bf16x8 af[4], bfr[4]; \
            const int coff = ((ss * 4 + q) ^ (l15 >> 1)) * 16; \
            _Pragma("unroll") for (int i = 0; i < 4; ++i) { \
                af[i]  = *(const bf16x8*)((const char*)sm.a[CUR] + (wr * 64 + i * 16 + l15) * 128 + coff); \
                bfr[i] = *(const bf16x8*)((const char*)sm.b[CUR] + (wc * 64 + i * 16 + l15) * 128 + coff); } \
            _Pragma("unroll") for (int mt = 0; mt < 4; ++mt) \
                _Pragma("unroll") for (int nt = 0; nt < 4; ++nt) \
                    acc[mt][nt] = SWAP ? mfma16(bfr[nt], af[mt], acc[mt][nt]) : mfma16(af[mt], bfr[nt], acc[mt][nt]); } \
        __builtin_amdgcn_sched_barrier(0); \
        if (more) { GEMM_LSTORE_B((CUR) ^ 1); } \
        __syncthreads(); } while (0)
#pragma unroll 1
    for (int kt = 0; kt < nk; kt += 2) { GEMM_KSTEP(0, kt); GEMM_KSTEP(1, kt + 1); }
#undef GEMM_KSTEP
#undef GEMM_LSTORE_B
#undef GEMM_ISSUE
}

DEVI void zero_acc(f32x4 (&acc)[4][4]) {
#pragma unroll
    for (int i = 0; i < 4; ++i)
#pragma unroll
        for (int j = 0; j < 4; ++j) acc[i][j] = (f32x4){0.f, 0.f, 0.f, 0.f};
}

namespace pg8 {
#define PG8_LAS __attribute__((address_space(3)))
typedef unsigned short bf16_t;
typedef short bf16x8 __attribute__((ext_vector_type(8)));
typedef float f32x4 __attribute__((ext_vector_type(4)));
typedef unsigned u32x4 __attribute__((ext_vector_type(4)));
constexpr int BM = 256, BK = 64, HALF = 128, HTB = HALF * BK * 2  , STAGE_BYTES = 8 * HTB, NXCD = 8, WGM = 8;

__host__ __device__ __forceinline__ int lds_byte(int r, int c) { const int st = (r >> 4) * 2 + (c >> 5), rr = r & 15, cc = c & 31, ob = rr * 64 + cc * 2; return st * 1024 + (ob ^ (((ob >> 9) & 1) << 5)); }
__host__ __device__ __forceinline__ void stage_rc(int b, int& R, int& C) { const int st = b / 1024, sb = b % 1024, swz = sb ^ (((sb >> 9) & 1) << 5); R = (st >> 1) * 16 + swz / 64; C = (st & 1) * 32 + (swz % 64) / 2; }
__host__ __device__ __forceinline__ int perm32(int rho) { const int n = rho >> 4, i = rho & 15; return 8 * (i >> 2) + 4 * n + (i & 3); }

struct Unit { int pm, pn; };
struct Gemm { const bf16_t* A; const bf16_t* Bt; int M, N, K; };

struct StaticOrder {
    int nM, nN, nwg, G, c;
    __host__ __device__ void init(int M, int N, int G_, int c_) { nM = M / BM; nN = N / BM; nwg = nM * nN; G = G_; c = c_; }
    __host__ __device__ bool next(int i, Unit& u) const {
        const long L = (long)i * G + c; if (L >= nwg) return false;
        int wgid = (int)L; { const int q = nwg / NXCD, r = nwg % NXCD, xcd = wgid % NXCD, off = wgid / NXCD; wgid = (xcd < r ? xcd * (q + 1) : r * (q + 1) + (xcd - r) * q) + off; }
        const int nig = WGM * nN, gid = wgid / nig, fm = gid * WGM, gsz = (nM - fm) < WGM ? (nM - fm) : WGM;
        u.pm = fm + ((wgid % nig) % gsz); u.pn = (wgid % nig) / gsz; return true;
    }
    __device__ __forceinline__ void a_ready(const Unit&) const {}
    __device__ __forceinline__ void done(const Unit&) const {}
};


template <class Epi, class Sched, bool ALIGN_EPI = false, bool SP2 = false>
__device__ __forceinline__ void gemm_phase(PG8_LAS unsigned char* lds, const Gemm g, const Sched& S, const Epi& E) {
    const int tid = threadIdx.x, wid = __builtin_amdgcn_readfirstlane(tid >> 6), lane = tid & 63, wr = wid >> 2, wc = wid & 3, fr = lane & 15, fq = lane >> 4;
    const int K = g.K, nt = K / BK;
    unsigned voffA[2], voffB[2];
#pragma unroll
    for (int i = 0; i < 2; ++i) { int R, C; stage_rc(tid * 16 + i * 8192, R, C); const int Rb = Epi::PERM ? ((R & ~31) + perm32(R & 31)) : R;
        voffA[i] = (unsigned)(R * K + C) * 2u; voffB[i] = (unsigned)(Rb * K + C) * 2u; }
    const size_t kstep = (size_t)(BK * 2);
    const size_t hstep = (size_t)HALF * K * 2;
    const size_t tstep = 2 * hstep;
    const unsigned ldsw = (unsigned)wid * 1024u;
    const int aoff = lds_byte(wr * 64 + fr, fq * 8), boff = lds_byte(wc * 32 + fr, fq * 8);
#define PG8_SA(b, h) (((b) * 2 + (h)) * HTB)
#define PG8_SB(b, h) ((4 + (b) * 2 + (h)) * HTB)
#define PG8_STAGE(bufoff, gbase, voff) do { _Pragma("unroll") for (int _i = 0; _i < 2; ++_i) \
        __builtin_amdgcn_global_load_lds((const unsigned*)((const char*)(gbase) + (voff)[_i]), (PG8_LAS unsigned*)(lds + (bufoff) + ldsw + _i * 8192), 16, 0, 0); } while (0)
#define PG8_LDA(dst, b, h) do { _Pragma("unroll") for (int m = 0; m < 4; ++m) _Pragma("unroll") for (int k = 0; k < 2; ++k) dst[m][k] = *(const PG8_LAS bf16x8*)(lds + PG8_SA(b, h) + aoff + m * 2048 + k * 1024); } while (0)
#define PG8_LDB(dst, b, h) do { _Pragma("unroll") for (int n = 0; n < 2; ++n) _Pragma("unroll") for (int k = 0; k < 2; ++k) dst[n][k] = *(const PG8_LAS bf16x8*)(lds + PG8_SB(b, h) + boff + n * 2048 + k * 1024); } while (0)
#define PG8_MMA(ai, bj, At, Bt) do { __builtin_amdgcn_s_setprio(1); _Pragma("unroll") for (int m = 0; m < 4; ++m) _Pragma("unroll") for (int n = 0; n < 2; ++n) _Pragma("unroll") for (int k = 0; k < 2; ++k) \
        acc[ai][bj][m][n] = __builtin_amdgcn_mfma_f32_16x16x32_bf16(Bt[n][k], At[m][k], acc[ai][bj][m][n], 0, 0, 0); __builtin_amdgcn_s_setprio(0); } while (0)
#define PG8_WAIT_V(n) asm volatile("s_waitcnt vmcnt(" #n ")" ::: "memory")
#define PG8_WAIT_L(n) asm volatile("s_waitcnt lgkmcnt(" #n ")" ::: "memory")
#define PG8_BAR __builtin_amdgcn_s_barrier()
#define PG8_SCHED __builtin_amdgcn_sched_barrier(0)
    Unit cur, nxt; int ui = 0;
    if (!S.next(0, cur)) return;
    f32x4 acc[2][2][4][2];
#pragma unroll
    for (int a = 0; a < 2; ++a)
#pragma unroll
        for (int b = 0; b < 2; ++b)
#pragma unroll
            for (int m = 0; m < 4; ++m)
#pragma unroll
                for (int n = 0; n < 2; ++n) acc[a][b][m][n] = (f32x4){0.f, 0.f, 0.f, 0.f};
    bf16x8 At[4][2], B0[2][2], B1[2][2];
    const char* cA = (const char*)g.A + (size_t)cur.pm * tstep; const char* cB = (const char*)g.Bt + (size_t)cur.pn * tstep;
    S.a_ready(cur);
    if constexpr (SP2) {
        PG8_STAGE(PG8_SB(0, 0), cB, voffB); PG8_STAGE(PG8_SB(0, 1), cB + hstep, voffB); PG8_STAGE(PG8_SA(0, 0), cA, voffA); PG8_STAGE(PG8_SA(0, 1), cA + hstep, voffA);
        if (wr == 1) PG8_BAR;
        PG8_WAIT_V(2); PG8_BAR;
        PG8_STAGE(PG8_SB(1, 0), cB + kstep, voffB); PG8_STAGE(PG8_SA(1, 0), cA + kstep, voffA); PG8_STAGE(PG8_SB(1, 1), cB + hstep + kstep, voffB);
        PG8_WAIT_V(6); PG8_BAR;
    } else {
        PG8_STAGE(PG8_SB(0, 0), cB, voffB); PG8_STAGE(PG8_SA(0, 0), cA, voffA); PG8_STAGE(PG8_SB(0, 1), cB + hstep, voffB); PG8_STAGE(PG8_SA(0, 1), cA + hstep, voffA);
        if (wr == 1) PG8_BAR;
        PG8_WAIT_V(4); PG8_BAR;
        PG8_STAGE(PG8_SB(1, 0), cB + kstep, voffB); PG8_STAGE(PG8_SA(1, 0), cA + kstep, voffA); PG8_STAGE(PG8_SB(1, 1), cB + hstep + kstep, voffB);
        PG8_WAIT_V(6); PG8_BAR;
    }
    for (;;) {
        const bool has_next = S.next(ui + 1, nxt);
        const char* nA = has_next ? (const char*)g.A + (size_t)nxt.pm * tstep : cA; const char* nB = has_next ? (const char*)g.Bt + (size_t)nxt.pn * tstep : cB;
        for (int t = 0; t < nt; t += 2) {
            const bool last = (t == nt - 2);
            const char* a1 = cA + (size_t)(t + 1) * kstep;
            const char* a2 = last ? nA : cA + (size_t)(t + 2) * kstep; const char* b2 = last ? nB : cB + (size_t)(t + 2) * kstep;
            const char* a3 = a2 + kstep; const char* b3 = b2 + kstep;
            if (last && has_next) S.a_ready(nxt);
            if constexpr (SP2) {
            PG8_LDB(B0, 0, 0); PG8_LDB(B1, 0, 1); PG8_SCHED; PG8_LDA(At, 0, 0); PG8_STAGE(PG8_SA(1, 1), a1 + hstep, voffA);
            PG8_WAIT_V(8); PG8_WAIT_L(0); PG8_BAR; PG8_MMA(0, 0, At, B0); PG8_MMA(0, 1, At, B1); PG8_BAR; PG8_SCHED;
            PG8_LDA(At, 0, 1); PG8_STAGE(PG8_SB(0, 0), b2, voffB); PG8_STAGE(PG8_SB(0, 1), b2 + hstep, voffB); PG8_STAGE(PG8_SA(0, 0), a2, voffA);
            PG8_WAIT_V(8); PG8_WAIT_L(0); PG8_BAR; PG8_MMA(1, 0, At, B0); PG8_MMA(1, 1, At, B1); PG8_BAR; PG8_SCHED;
            PG8_LDB(B0, 1, 0); PG8_LDB(B1, 1, 1); PG8_SCHED; PG8_LDA(At, 1, 0); PG8_STAGE(PG8_SA(0, 1), a2 + hstep, voffA);
            PG8_WAIT_V(8); PG8_WAIT_L(0); PG8_BAR; PG8_MMA(0, 0, At, B0); PG8_MMA(0, 1, At, B1); PG8_BAR; PG8_SCHED;
            PG8_LDA(At, 1, 1); PG8_STAGE(PG8_SB(1, 0), b3, voffB); PG8_STAGE(PG8_SB(1, 1), b3 + hstep, voffB); PG8_STAGE(PG8_SA(1, 0), a3, voffA);
            PG8_WAIT_V(8); PG8_WAIT_L(0); PG8_BAR; PG8_MMA(1, 0, At, B0); PG8_MMA(1, 1, At, B1); PG8_BAR; PG8_SCHED;
            } else {
            PG8_LDB(B0, 0, 0); PG8_SCHED; PG8_LDA(At, 0, 0); PG8_STAGE(PG8_SA(1, 1), a1 + hstep, voffA);
            PG8_WAIT_L(8); PG8_BAR; PG8_WAIT_L(0); PG8_MMA(0, 0, At, B0); PG8_BAR; PG8_SCHED;
            PG8_LDB(B1, 0, 1); PG8_STAGE(PG8_SB(0, 0), b2, voffB);
            PG8_BAR; PG8_WAIT_L(0); PG8_MMA(0, 1, At, B1); PG8_BAR;
            PG8_LDA(At, 0, 1); PG8_STAGE(PG8_SA(0, 0), a2, voffA);
            PG8_BAR; PG8_WAIT_L(0); PG8_MMA(1, 0, At, B0); PG8_BAR; PG8_SCHED;
            PG8_STAGE(PG8_SB(0, 1), b2 + hstep, voffB);
            PG8_WAIT_V(6); PG8_BAR; PG8_MMA(1, 1, At, B1); PG8_BAR;
            PG8_LDB(B0, 1, 0); PG8_SCHED; PG8_LDA(At, 1, 0); PG8_STAGE(PG8_SA(0, 1), a2 + hstep, voffA);
            PG8_WAIT_L(8); PG8_BAR; PG8_WAIT_L(0); PG8_MMA(0, 0, At, B0); PG8_BAR; PG8_SCHED;
            PG8_LDB(B1, 1, 1); PG8_STAGE(PG8_SB(1, 0), b3, voffB);
            PG8_BAR; PG8_WAIT_L(0); PG8_MMA(0, 1, At, B1); PG8_BAR;
            PG8_LDA(At, 1, 1); PG8_STAGE(PG8_SA(1, 0), a3, voffA);
            PG8_BAR; PG8_WAIT_L(0); PG8_MMA(1, 0, At, B0); PG8_BAR; PG8_SCHED;
            PG8_STAGE(PG8_SB(1, 1), b3 + hstep, voffB);
            PG8_WAIT_V(6); PG8_BAR; PG8_MMA(1, 1, At, B1); PG8_BAR;
            }
        }
        if constexpr (ALIGN_EPI) { if (wr == 0) PG8_BAR; }
        if constexpr (!Epi::AFTER_DRAIN) { E(acc, cur, wr, wc, fr, fq); S.done(cur); }
        if (!has_next) break;
#pragma unroll
        for (int a = 0; a < 2; ++a)
#pragma unroll
            for (int b = 0; b < 2; ++b)
#pragma unroll
                for (int m = 0; m < 4; ++m)
#pragma unroll
                    for (int n = 0; n < 2; ++n) acc[a][b][m][n] = (f32x4){0.f, 0.f, 0.f, 0.f};
        cur = nxt; cA = nA; cB = nB; ++ui;
        if constexpr (ALIGN_EPI) { if (wr == 1) PG8_BAR; }
    }
    PG8_WAIT_V(0);
    if constexpr (!ALIGN_EPI) { if (wr == 0) PG8_BAR; }
    PG8_BAR;
    if constexpr (Epi::AFTER_DRAIN) { E.fused(acc, cur, wr, wc, fr, fq, lds, wid, lane); S.done(cur); }
#undef PG8_SA
#undef PG8_SB
#undef PG8_STAGE
#undef PG8_LDA
#undef PG8_LDB
#undef PG8_MMA
#undef PG8_WAIT_V
#undef PG8_WAIT_L
#undef PG8_BAR
#undef PG8_SCHED
}
template <class Epi, class Sched, bool ALIGN_EPI = false, bool SP2 = false>
__device__ __forceinline__ void gemm_phase_g(PG8_LAS unsigned char* lds, const int K, const Sched& S, const Epi& E) {
    const int tid = threadIdx.x, wid = __builtin_amdgcn_readfirstlane(tid >> 6), lane = tid & 63, wr = wid >> 2, wc = wid & 3, fr = lane & 15, fq = lane >> 4;
    const int nt = K / BK;
    unsigned voffB[2]; int rowA[2], colA[2];
#pragma unroll
    for (int i = 0; i < 2; ++i) { int R, C; stage_rc(tid * 16 + i * 8192, R, C); const int Rb = Epi::PERM ? ((R & ~31) + perm32(R & 31)) : R;
        rowA[i] = R; colA[i] = C * 2; voffB[i] = (unsigned)(Rb * K + C) * 2u; }
    const size_t kstep = (size_t)(BK * 2);
    const size_t hstep = (size_t)HALF * K * 2;
    const size_t tstep = 2 * hstep;
    const unsigned ldsw = (unsigned)wid * 1024u;
    const int aoff = lds_byte(wr * 64 + fr, fq * 8), boff = lds_byte(wc * 32 + fr, fq * 8);
#define PG8_SA(b, h) (((b) * 2 + (h)) * HTB)
#define PG8_SB(b, h) ((4 + (b) * 2 + (h)) * HTB)
#define PG8_STAGE(bufoff, gbase, voff) do { _Pragma("unroll") for (int _i = 0; _i < 2; ++_i) \
        __builtin_amdgcn_global_load_lds((const unsigned*)((const char*)(gbase) + (voff)[_i]), (PG8_LAS unsigned*)(lds + (bufoff) + ldsw + _i * 8192), 16, 0, 0); } while (0)
#define PG8_STAGEA(bufoff, P0, P1, koff) do { \
        __builtin_amdgcn_global_load_lds((const unsigned*)(Ab + (size_t)(P0) + (koff)), (PG8_LAS unsigned*)(lds + (bufoff) + ldsw), 16, 0, 0); \
        __builtin_amdgcn_global_load_lds((const unsigned*)(Ab + (size_t)(P1) + (koff)), (PG8_LAS unsigned*)(lds + (bufoff) + ldsw + 8192), 16, 0, 0); } while (0)
#define PG8_LDA(dst, b, h) do { _Pragma("unroll") for (int m = 0; m < 4; ++m) _Pragma("unroll") for (int k = 0; k < 2; ++k) dst[m][k] = *(const PG8_LAS bf16x8*)(lds + PG8_SA(b, h) + aoff + m * 2048 + k * 1024); } while (0)
#define PG8_LDB(dst, b, h) do { _Pragma("unroll") for (int n = 0; n < 2; ++n) _Pragma("unroll") for (int k = 0; k < 2; ++k) dst[n][k] = *(const PG8_LAS bf16x8*)(lds + PG8_SB(b, h) + boff + n * 2048 + k * 1024); } while (0)
#define PG8_MMA(ai, bj, At, Bt) do { __builtin_amdgcn_s_setprio(1); _Pragma("unroll") for (int m = 0; m < 4; ++m) _Pragma("unroll") for (int n = 0; n < 2; ++n) _Pragma("unroll") for (int k = 0; k < 2; ++k) \
        acc[ai][bj][m][n] = __builtin_amdgcn_mfma_f32_16x16x32_bf16(Bt[n][k], At[m][k], acc[ai][bj][m][n], 0, 0, 0); __builtin_amdgcn_s_setprio(0); } while (0)
#define PG8_WAIT_V(n) asm volatile("s_waitcnt vmcnt(" #n ")" ::: "memory")
#define PG8_WAIT_L(n) asm volatile("s_waitcnt lgkmcnt(" #n ")" ::: "memory")
#define PG8_BAR __builtin_amdgcn_s_barrier()
#define PG8_SCHED __builtin_amdgcn_sched_barrier(0)
    Unit cur, nxt; int ui = 0;
    if (!S.next(0, cur)) return;
    f32x4 acc[2][2][4][2];
#pragma unroll
    for (int a = 0; a < 2; ++a)
#pragma unroll
        for (int b = 0; b < 2; ++b)
#pragma unroll
            for (int m = 0; m < 4; ++m)
#pragma unroll
                for (int n = 0; n < 2; ++n) acc[a][b][m][n] = (f32x4){0.f, 0.f, 0.f, 0.f};
    bf16x8 At[4][2], B0[2][2], B1[2][2];
    const char* cB = S.b_base(cur);
    unsigned cA00, cA01, cA10, cA11, nA00, nA01, nA10, nA11;
    const char* const Ab = S.a_base();
    S.a_rows(cur, rowA, colA, cA00, cA01, cA10, cA11);
    S.a_ready(cur);
    if constexpr (SP2) {
        PG8_STAGE(PG8_SB(0, 0), cB, voffB); PG8_STAGE(PG8_SB(0, 1), cB + hstep, voffB); PG8_STAGEA(PG8_SA(0, 0), cA00, cA01, 0); PG8_STAGEA(PG8_SA(0, 1), cA10, cA11, 0);
        if (wr == 1) PG8_BAR;
        PG8_WAIT_V(2); PG8_BAR;
        PG8_STAGE(PG8_SB(1, 0), cB + kstep, voffB); PG8_STAGEA(PG8_SA(1, 0), cA00, cA01, kstep); PG8_STAGE(PG8_SB(1, 1), cB + hstep + kstep, voffB);
        PG8_WAIT_V(6); PG8_BAR;
    } else {
        PG8_STAGE(PG8_SB(0, 0), cB, voffB); PG8_STAGEA(PG8_SA(0, 0), cA00, cA01, 0); PG8_STAGE(PG8_SB(0, 1), cB + hstep, voffB); PG8_STAGEA(PG8_SA(0, 1), cA10, cA11, 0);
        if (wr == 1) PG8_BAR;
        PG8_WAIT_V(4); PG8_BAR;
        PG8_STAGE(PG8_SB(1, 0), cB + kstep, voffB); PG8_STAGEA(PG8_SA(1, 0), cA00, cA01, kstep); PG8_STAGE(PG8_SB(1, 1), cB + hstep + kstep, voffB);
        PG8_WAIT_V(6); PG8_BAR;
    }
    for (;;) {
        const bool has_next = S.next(ui + 1, nxt);
        const char* nB = has_next ? S.b_base(nxt) : cB;
        if (has_next) S.a_rows(nxt, rowA, colA, nA00, nA01, nA10, nA11); else { nA00 = cA00; nA01 = cA01; nA10 = cA10; nA11 = cA11; }
        for (int t = 0; t < nt; t += 2) {
            const bool last = (t == nt - 2);
            const size_t k1 = (size_t)(t + 1) * kstep;
            const size_t k2 = last ? 0 : (size_t)(t + 2) * kstep; const char* b2 = last ? nB : cB + (size_t)(t + 2) * kstep;
            const unsigned q00 = last ? nA00 : cA00, q01 = last ? nA01 : cA01, q10 = last ? nA10 : cA10, q11 = last ? nA11 : cA11;
            const size_t k3 = k2 + kstep; const char* b3 = b2 + kstep;
            if (last && has_next) S.a_ready(nxt);
            if constexpr (SP2) {
            PG8_LDB(B0, 0, 0); PG8_LDB(B1, 0, 1); PG8_SCHED; PG8_LDA(At, 0, 0); PG8_STAGEA(PG8_SA(1, 1), cA10, cA11, k1);
            PG8_WAIT_V(8); PG8_WAIT_L(0); PG8_BAR; PG8_MMA(0, 0, At, B0); PG8_MMA(0, 1, At, B1); PG8_BAR; PG8_SCHED;
            PG8_LDA(At, 0, 1); PG8_STAGE(PG8_SB(0, 0), b2, voffB); PG8_STAGE(PG8_SB(0, 1), b2 + hstep, voffB); PG8_STAGEA(PG8_SA(0, 0), q00, q01, k2);
            PG8_WAIT_V(8); PG8_WAIT_L(0); PG8_BAR; PG8_MMA(1, 0, At, B0); PG8_MMA(1, 1, At, B1); PG8_BAR; PG8_SCHED;
            PG8_LDB(B0, 1, 0); PG8_LDB(B1, 1, 1); PG8_SCHED; PG8_LDA(At, 1, 0); PG8_STAGEA(PG8_SA(0, 1), q10, q11, k2);
            PG8_WAIT_V(8); PG8_WAIT_L(0); PG8_BAR; PG8_MMA(0, 0, At, B0); PG8_MMA(0, 1, At, B1); PG8_BAR; PG8_SCHED;
            PG8_LDA(At, 1, 1); PG8_STAGE(PG8_SB(1, 0), b3, voffB); PG8_STAGE(PG8_SB(1, 1), b3 + hstep, voffB); PG8_STAGEA(PG8_SA(1, 0), q00, q01, k3);
            PG8_WAIT_V(8); PG8_WAIT_L(0); PG8_BAR; PG8_MMA(1, 0, At, B0); PG8_MMA(1, 1, At, B1); PG8_BAR; PG8_SCHED;
            } else {
            PG8_LDB(B0, 0, 0); PG8_SCHED; PG8_LDA(At, 0, 0); PG8_STAGEA(PG8_SA(1, 1), cA10, cA11, k1);
            PG8_WAIT_L(8); PG8_BAR; PG8_WAIT_L(0); PG8_MMA(0, 0, At, B0); PG8_BAR; PG8_SCHED;
            PG8_LDB(B1, 0, 1); PG8_STAGE(PG8_SB(0, 0), b2, voffB);
            PG8_BAR; PG8_WAIT_L(0); PG8_MMA(0, 1, At, B1); PG8_BAR;
            PG8_LDA(At, 0, 1); PG8_STAGEA(PG8_SA(0, 0), q00, q01, k2);
            PG8_BAR; PG8_WAIT_L(0); PG8_MMA(1, 0, At, B0); PG8_BAR; PG8_SCHED;
            PG8_STAGE(PG8_SB(0, 1), b2 + hstep, voffB);
            PG8_WAIT_V(6); PG8_BAR; PG8_MMA(1, 1, At, B1); PG8_BAR;
            PG8_LDB(B0, 1, 0); PG8_SCHED; PG8_LDA(At, 1, 0); PG8_STAGEA(PG8_SA(0, 1), q10, q11, k2);
            PG8_WAIT_L(8); PG8_BAR; PG8_WAIT_L(0); PG8_MMA(0, 0, At, B0); PG8_BAR; PG8_SCHED;
            PG8_LDB(B1, 1, 1); PG8_STAGE(PG8_SB(1, 0), b3, voffB);
            PG8_BAR; PG8_WAIT_L(0); PG8_MMA(0, 1, At, B1); PG8_BAR;
            PG8_LDA(At, 1, 1); PG8_STAGEA(PG8_SA(1, 0), q00, q01, k3);
            PG8_BAR; PG8_WAIT_L(0); PG8_MMA(1, 0, At, B0); PG8_BAR; PG8_SCHED;
            PG8_STAGE(PG8_SB(1, 1), b3 + hstep, voffB);
            PG8_WAIT_V(6); PG8_BAR; PG8_MMA(1, 1, At, B1); PG8_BAR;
            }
        }
        if constexpr (ALIGN_EPI) { if (wr == 0) PG8_BAR; }
        if constexpr (!Epi::AFTER_DRAIN) { E(acc, cur, wr, wc, fr, fq); S.done(cur); }
        if (!has_next) break;
#pragma unroll
        for (int a = 0; a < 2; ++a)
#pragma unroll
            for (int b = 0; b < 2; ++b)
#pragma unroll
                for (int m = 0; m < 4; ++m)
#pragma unroll
                    for (int n = 0; n < 2; ++n) acc[a][b][m][n] = (f32x4){0.f, 0.f, 0.f, 0.f};
        cur = nxt; cA00 = nA00; cA01 = nA01; cA10 = nA10; cA11 = nA11; cB = nB; ++ui;
        if constexpr (ALIGN_EPI) { if (wr == 1) PG8_BAR; }
    }
    PG8_WAIT_V(0);
    if constexpr (!ALIGN_EPI) { if (wr == 0) PG8_BAR; }
    PG8_BAR;
    if constexpr (Epi::AFTER_DRAIN) { E.fused(acc, cur, wr, wc, fr, fq, lds, wid, lane); S.done(cur); }
#undef PG8_SA
#undef PG8_SB
#undef PG8_STAGE
#undef PG8_STAGEA
#undef PG8_LDA
#undef PG8_LDB
#undef PG8_MMA
#undef PG8_WAIT_V
#undef PG8_WAIT_L
#undef PG8_BAR
#undef PG8_SCHED
}
}

DEVI void wt_colinfo(const Params& p, int R, const float*& src, int& ld, float& scale) {
    scale = 1.0f; src = nullptr; ld = 0;
    if (R < WT_AT) {
        const int pn = R >> 8, cl = R & 255; ld = DIN_; int col = -1;
        if (pn < 4) { const int wcq = (cl >> 5) & 3; col = (pn >> 1) * 512 + (2 * (pn & 1) + (wcq >> 1)) * 128 + 64 * (cl >> 7) + 32 * (wcq & 1) + (cl & 31);
                      if (pn >= 2) scale = KSCALE_; }
        else if (pn < 8)  col = 2048 + (pn - 4) * 256 + cl;
        else if (pn < 10) { col = 3072 + (pn - 8) * 256 + cl; scale = KSCALE_; }
        else if (pn < 14) col = 5120 + (pn - 10) * 256 + cl;
        else if (pn < 22) col = 6160 + (pn - 14) * 256 + cl;
        else if (cl < 16) col = 6144 + cl;
        if (col >= 0) src = p.w_in + col;
    } else if (R < WT_RET) {
        const int Rr = R - WT_AT, pm = Rr >> 8, rl = Rr & 255; ld = DIN_; int col;
        if (pm < 2) { col = 512 + (2 * pm + ((rl >> 6) & 1)) * 128 + 64 * (rl >> 7) + (rl & 63); scale = KSCALE_; }
        else if (pm < 6)  col = 1024 + (pm - 2) * 256 + rl;
        else if (pm < 10) col = 4096 + (pm - 6) * 256 + rl;
        else              col = 3584 + (pm - 10) * 256 + rl;
        src = p.w_in + col;
    } else {
        int Rr, ldd; const float* base;
        if (R < WT_GLA)    { Rr = R - WT_RET; base = p.w_ret_out; ldd = 1024; }
        else if (R < WT_O) { Rr = R - WT_GLA; base = p.w_gla_out; ldd = 1024; }
        else if (R < WT_R) { Rr = R - WT_O;   base = p.w_o;       ldd = 1024; }
        else               { Rr = R - WT_R;   base = p.router_w;  ldd = 256; }
        src = base + ((R >= WT_R) ? ((Rr & ~127) + vperm(Rr & 127)) : Rr); ld = ldd;
    }
}

DEVI void phase0(const Params& p, unsigned char* smem) {
    const int tid = VT, nb = VG, bid = VB;
    float2* cs = (float2*)(p.ws + OFF_CS);
    for (int i = bid * 256 + tid; i < 4096 * 64; i += nb * 256) {
        const int pos = i >> 6, k = i & 63;
        const float angf = (float)pos * c_inv_freq[k];
        const double a = (double)angf;
        const double TWO_PI = 6.283185307179586476925286766559, HALF_PI = 1.5707963267948966192313216916398;
        const double kk = rint(a * (1.0 / TWO_PI));
        const double r = a - kk * TWO_PI;
        const double qd = rint(r * (1.0 / HALF_PI));
        const double y = r - qd * HALF_PI;
        const double y2 = y * y;
        double sn = y * (1.0 + y2 * (-1.0 / 6 + y2 * (1.0 / 120 + y2 * (-1.0 / 5040 + y2 * (1.0 / 362880 + y2 * (-1.0 / 39916800 + y2 * (1.0 / 6227020800.0)))))));
        double cn = 1.0 + y2 * (-0.5 + y2 * (1.0 / 24 + y2 * (-1.0 / 720 + y2 * (1.0 / 40320 + y2 * (-1.0 / 3628800 + y2 * (1.0 / 479001600.0))))));
        const int qi = ((int)qd) & 3;
        double s, c;
        if (qi == 0) { s = sn; c = cn; } else if (qi == 1) { s = cn; c = -sn; } else if (qi == 2) { s = -sn; c = -cn; } else { s = -cn; c = sn; }
        cs[i] = make_float2((float)c, (float)s);
    }
    if (bid == 0) { int* cnt = (int*)(p.ws + OFF_CNT); for (int i = tid; i < 512; i += 256) cnt[i] = 0; }
    {
        const f32x4* xs = (const f32x4*)p.x; u32x4* xd = (u32x4*)(p.ws + OFF_XB);
        const int n8 = T_ * D_ / 8;
        for (int g = bid * 256 + tid; g < n8; g += nb * 256) {
            const f32x4 v0 = xs[2 * g], v1 = xs[2 * g + 1];
            u32x4 o; o.x = pk2(v0[0], v0[1]); o.y = pk2(v0[2], v0[3]); o.z = pk2(v1[0], v1[1]); o.w = pk2(v1[2], v1[3]);
            xd[g] = o;
        }
    }
    {
        float* tile = (float*)smem;
        bf16_t* wt = (bf16_t*)(p.ws + OFF_WT);
        const int ntask = (WT_ROWS / 64) * 16;
        for (int task = bid; task < ntask; task += nb) {
            const int rt = task >> 4, kt = task & 15, R0 = rt * 64, k0 = kt * 64;
            {
                const int n = tid & 63, kq = tid >> 6;
                const float* src; int ld; float sc; wt_colinfo(p, R0 + n, src, ld, sc);
#pragma unroll
                for (int i = 0; i < 16; ++i) { const int k = kq + 4 * i; tile[k * 65 + n] = src ? src[(size_t)(k0 + k) * ld] * sc : 0.f; }
            }
            __syncthreads();
            {
                const int n = tid >> 2, ks = (tid & 3) * 16;
                unsigned o[8];
#pragma unroll
                for (int j = 0; j < 8; ++j) o[j] = pk2(tile[(ks + 2 * j) * 65 + n], tile[(ks + 2 * j + 1) * 65 + n]);
                u32x4* dst = (u32x4*)(wt + (size_t)(R0 + n) * 1024 + k0 + ks);
                dst[0] = (u32x4){o[0], o[1], o[2], o[3]}; dst[1] = (u32x4){o[4], o[5], o[6], o[7]};
            }
            __syncthreads();
        }
    }
}

struct EpiP1N {
    static constexpr bool PERM = true, AFTER_DRAIN = false;
    unsigned char* ws;
    __device__ __forceinline__ void operator()(const pg8::f32x4 (&acc)[2][2][4][2], const pg8::Unit& u, int wr, int wc, int fr, int fq) const {
        const int pn = u.pn, row0 = u.pm * 256 + wr * 64 + fr, c8 = wc * 32 + 8 * fq;
        if (pn < 4) {
            const float2* cs = (const float2*)(ws + OFF_CS); bf16_t* Qr = (bf16_t*)(ws + (pn < 2 ? OFF_QR : OFF_KR));
            const int head = 2 * (pn & 1) + (wc >> 1), d0 = 32 * (wc & 1) + 8 * fq;
#pragma unroll
            for (int ai = 0; ai < 2; ++ai)
#pragma unroll
                for (int m = 0; m < 4; ++m) {
                    const size_t row = row0 + ai * 128 + m * 16; const int pos = (int)(row & 4095);
                    f32x4 c4[4];
#pragma unroll
                    for (int j = 0; j < 4; ++j) c4[j] = *(const f32x4*)(cs + pos * 64 + d0 + 2 * j);
                    f32x4 o1[2], o2[2];
#pragma unroll
                    for (int n = 0; n < 2; ++n)
#pragma unroll
                        for (int r = 0; r < 4; ++r) {
                            const f32x4 cc = c4[2 * n + (r >> 1)]; const float c_ = cc[(r & 1) * 2], s_ = cc[(r & 1) * 2 + 1];
                            const float x1 = acc[ai][0][m][n][r], x2 = acc[ai][1][m][n][r];
                            o1[n][r] = x1 * c_ - x2 * s_; o2[n][r] = x1 * s_ + x2 * c_;
                        }
                    *(u32x4*)(Qr + row * 512 + head * 128 + d0) = pk8(o1[0], o1[1]);
                    *(u32x4*)(Qr + row * 512 + head * 128 + 64 + d0) = pk8(o2[0], o2[1]);
                    asm volatile("" ::: "memory");
                }
        } else {
#pragma unroll
            for (int ai = 0; ai < 2; ++ai)
#pragma unroll
                for (int m = 0; m < 4; ++m) {
                    const size_t row = row0 + ai * 128 + m * 16;
#pragma unroll
                    for (int bj = 0; bj < 2; ++bj) {
                        const int cl = bj * 128 + c8;
                        f32x4 v0 = acc[ai][bj][m][0], v1 = acc[ai][bj][m][1];
                        if (pn < 8) {
#pragma unroll
                            for (int r = 0; r < 4; ++r) { v0[r] = siluf_(v0[r]); v1[r] = siluf_(v1[r]); }
                            *(u32x4*)((bf16_t*)(ws + OFF_GS) + row * 2048 + (pn - 4) * 256 + cl) = pk8(v0, v1);
                        } else if (pn < 10) {
                            *(u32x4*)((bf16_t*)(ws + OFF_QGN) + row * 512 + (pn - 8) * 256 + cl) = pk8(v0, v1);
                        } else if (pn < 14) {
#pragma unroll
                            for (int r = 0; r < 4; ++r) { v0[r] = siluf_(v0[r]); v1[r] = siluf_(v1[r]); }
                            *(u32x4*)((bf16_t*)(ws + OFF_GS) + row * 2048 + 1024 + (pn - 10) * 256 + cl) = pk8(v0, v1);
                        } else if (pn < 22) {
#pragma unroll
                            for (int r = 0; r < 4; ++r) { v0[r] = sigmoidf_(v0[r]); v1[r] = sigmoidf_(v1[r]); }
                            *(u32x4*)((bf16_t*)(ws + OFF_MG) + row * 2048 + (pn - 14) * 256 + cl) = pk8(v0, v1);
                        } else if (cl < 16) {
                            float* Ga = (float*)(ws + OFF_GA); *(f32x4*)(Ga + row * 16 + cl) = v0; *(f32x4*)(Ga + row * 16 + cl + 4) = v1;
                        }
                    }
                    asm volatile("" ::: "memory");
                }
        }
    }
};
struct EpiP1V {
    static constexpr bool PERM = true, AFTER_DRAIN = false;
    unsigned char* ws;
    __device__ __forceinline__ void operator()(const pg8::f32x4 (&acc)[2][2][4][2], const pg8::Unit& u, int wr, int wc, int fr, int fq) const {
        bf16_t* dst = (bf16_t*)(ws + (u.pm < 4 ? OFF_VRT : OFF_VGT)); const int head = u.pm & 3;
#pragma unroll
        for (int bj = 0; bj < 2; ++bj) {
            const int tok0 = u.pn * 256 + bj * 128 + wc * 32 + 8 * fq; const int item = (tok0 >> 6) * 4 + head, m0 = tok0 & 63;
#pragma unroll
            for (int ai = 0; ai < 2; ++ai)
#pragma unroll
                for (int m = 0; m < 4; ++m) {
                    *(u32x4*)(dst + vf_off(item, ai * 128 + wr * 64 + m * 16 + fr, m0)) = pk8(acc[ai][bj][m][0], acc[ai][bj][m][1]);
                    asm volatile("" ::: "memory");
                }
        }
    }
};
struct EpiP1G {
    static constexpr bool PERM = true, AFTER_DRAIN = false;
    unsigned char* ws;
    __device__ __forceinline__ void operator()(const pg8::f32x4 (&acc)[2][2][4][2], const pg8::Unit& u, int wr, int wc, int fr, int fq) const {
        bf16_t* dst = (bf16_t*)(ws + OFF_KGT);
#pragma unroll
        for (int bj = 0; bj < 2; ++bj) {
            const int tok0 = u.pn * 256 + bj * 128 + wc * 32 + 8 * fq; const int m0 = tok0 & 63;
#pragma unroll
            for (int ai = 0; ai < 2; ++ai) {
                const unsigned item = (unsigned)((tok0 >> 6) * 4 + 2 * u.pm + ai);
#pragma unroll
                for (int m = 0; m < 4; ++m) {
                    *(u32x4*)(dst + (item * 128u + (unsigned)(wr * 64 + m * 16 + fr)) * 64u + (unsigned)m0) = pk8(acc[ai][bj][m][0], acc[ai][bj][m][1]);
                    asm volatile("" ::: "memory");
                }
            }
        }
    }
};
DEVI void phase1(const Params& p, unsigned char* smem_all) {
    {
        pg8::StaticOrder S; S.init(T_, 5888, RG, RB);
        pg8::Gemm g; g.A = (const bf16_t*)(p.ws + OFF_XB); g.Bt = (const bf16_t*)(p.ws + OFF_WT) + (size_t)WT_BN * 1024; g.M = T_; g.N = 5888; g.K = 1024;
        EpiP1N E; E.ws = p.ws;
        pg8::gemm_phase<EpiP1N, pg8::StaticOrder, true, true>((PG8_LAS unsigned char*)smem_all, g, S, E);
    }
    __syncthreads();
    {
        pg8::StaticOrder S; S.init(2048, T_, RG, RB);
        pg8::Gemm g; g.A = (const bf16_t*)(p.ws + OFF_WT) + (size_t)(WT_AT + 512) * 1024; g.Bt = (const bf16_t*)(p.ws + OFF_XB); g.M = 2048; g.N = T_; g.K = 1024;
        EpiP1V E; E.ws = p.ws;
        pg8::gemm_phase<EpiP1V, pg8::StaticOrder, true, true>((PG8_LAS unsigned char*)smem_all, g, S, E);
    }
    __syncthreads();
    {
        pg8::StaticOrder S; S.init(512, T_, RG, RB);
        pg8::Gemm g; g.A = (const bf16_t*)(p.ws + OFF_WT) + (size_t)(WT_AT + 2560) * 1024; g.Bt = (const bf16_t*)(p.ws + OFF_XB); g.M = 512; g.N = T_; g.K = 1024;
        EpiP1G E; E.ws = p.ws;
        pg8::gemm_phase<EpiP1G, pg8::StaticOrder, true, true>((PG8_LAS unsigned char*)smem_all, g, S, E);
    }
}

DEVI void phase2(const Params& p, unsigned char* smem) {
    float* ga_s = (float*)smem;
    float* tot = (float*)(smem + 4096);
    const int tid = VT;
    const float* Ga = (const float*)(p.ws + OFF_GA);
    const bf16_t* Kgt = (const bf16_t*)(p.ws + OFF_KGT); bf16_t* Kg2 = (bf16_t*)(p.ws + OFF_KG2);
    float* dec = (float*)(p.ws + OFF_DEC);
    for (int it = VB; it < 2048; it += VG) {
        const int h = it & 3, c = (it >> 2) & 63, b = it >> 8;
        const int tok0 = b * 4096 + c * 64;
        ((f32x4*)ga_s)[tid] = ((const f32x4*)(Ga + (size_t)tok0 * 16))[tid];
        const int dk = tid & 127, half = tid >> 7;
        float w2[16];
#pragma unroll
        for (int r = 0; r < 16; ++r) w2[r] = p.gate_w2[r * 512 + h * 128 + dk];
        const float bias = p.gate_b[h * 128 + dk];
        __syncthreads();
        float run = 0.f; float bc[32];
#pragma unroll
        for (int ml = 0; ml < 32; ++ml) {
            const int m = half * 32 + ml;
            float z = bias;
#pragma unroll
            for (int r4 = 0; r4 < 4; ++r4) { const f32x4 g4 = *(const f32x4*)&ga_s[m * 16 + 4 * r4];
                z += g4[0] * w2[4 * r4] + g4[1] * w2[4 * r4 + 1] + g4[2] * w2[4 * r4 + 2] + g4[3] * w2[4 * r4 + 3]; }
            const float la = (fminf(z, 0.f) - __logf(1.0f + __expf(-fabsf(z)))) * (1.0f / 16.0f);
            run += la; bc[ml] = run;
        }
        tot[half * 128 + dk] = run;
        __syncthreads();
        const float t0 = tot[dk], t1 = tot[128 + dk];
        const float bend = t0 + t1, off = half ? t0 : 0.f;
        const u32x4* kp = (const u32x4*)(Kgt + ((size_t)it * 128 + dk) * 64 + half * 32);
        bf16_t* const kqb = Kg2;
#pragma unroll
        for (int j = 0; j < 4; ++j) {
            u32x4 v = kp[j];
            unsigned uu[4] = {v.x, v.y, v.z, v.w};
#pragma unroll
            for (int e = 0; e < 4; ++e) {
                const float f0 = bflo(uu[e]) * __expf(bend - (bc[8 * j + 2 * e] + off));
                const float f1 = bfhi(uu[e]) * __expf(bend - (bc[8 * j + 2 * e + 1] + off));
                uu[e] = pk2(f0, f1);
            }
            *(u32x4*)(kqb + kf_off(it, dk, half * 32 + 8 * j)) = (u32x4){uu[0], uu[1], uu[2], uu[3]};
        }
        if (half == 0) dec[(size_t)it * 128 + dk] = __expf(bend);
        {
            const bf16_t* Qn = (const bf16_t*)(p.ws + OFF_QGN); bf16_t* QF = (bf16_t*)(p.ws + OFF_QG);
            const int m = tid & 63, qd = tid >> 6, bc = b * 64 + c;
            const u32x4* qs = (const u32x4*)(Qn + ((size_t)tok0 + m) * 512 + h * 128 + 32 * qd);
            u32x4 qv[4];
#pragma unroll
            for (int j = 0; j < 4; ++j) qv[j] = qs[j];
#pragma unroll
            for (int j = 0; j < 4; ++j) {
                *(u32x2*)(QF + qf_off(bc, h, m, 32 * qd + 8 * j, 0)) = (u32x2){qv[j].x, qv[j].y};
                *(u32x2*)(QF + qf_off(bc, h, m, 32 * qd + 8 * j, 1)) = (u32x2){qv[j].z, qv[j].w};
            }
        }
        __syncthreads();
    }
    {
        bf16_t* tile = (bf16_t*)smem;
        const bf16_t* Kr = (const bf16_t*)(p.ws + OFF_KR); bf16_t* Krt = (bf16_t*)(p.ws + OFF_KRT);
        for (int it = VB; it < 2048; it += VG) {
            const int h = it & 3, c = (it >> 2) & 63, b = it >> 8;
            const size_t tok0 = (size_t)b * 4096 + c * 64;
            const int m = tid & 63, qd = tid >> 6;
            const float kd = exp2f(gamma_log2(h) * (float)(63 - m));
            const u32x4* src = (const u32x4*)(Kr + (tok0 + m) * 512 + h * 128 + 32 * qd);
            u32x4 v[4];
#pragma unroll
            for (int j = 0; j < 4; ++j) v[j] = src[j];
#pragma unroll
            for (int j = 0; j < 4; ++j) {
                const unsigned uu[4] = {v[j].x, v[j].y, v[j].z, v[j].w};
#pragma unroll
                for (int e = 0; e < 4; ++e) {
                    const int dk = 32 * qd + 8 * j + 2 * e;
                    tile[dk * 72 + m] = f2bf(bflo(uu[e]) * kd); tile[(dk + 1) * 72 + m] = f2bf(bfhi(uu[e]) * kd);
                }
            }
            {
                const bf16_t* Qr = (const bf16_t*)(p.ws + OFF_QR); bf16_t* QF = (bf16_t*)(p.ws + OFF_QFR);
                const u32x4* qs = (const u32x4*)(Qr + (tok0 + m) * 512 + h * 128 + 32 * qd);
                u32x4 qv[4];
#pragma unroll
                for (int j = 0; j < 4; ++j) qv[j] = qs[j];
                const int bc = b * 64 + c;
#pragma unroll
                for (int j = 0; j < 4; ++j) {
                    *(u32x2*)(QF + qf_off(bc, h, m, 32 * qd + 8 * j, 0)) = (u32x2){qv[j].x, qv[j].y};
                    *(u32x2*)(QF + qf_off(bc, h, m, 32 * qd + 8 * j, 1)) = (u32x2){qv[j].z, qv[j].w};
                }
            }
            __syncthreads();
            {
                const int dk = tid >> 1, hf = tid & 1;
#pragma unroll
                for (int j = 0; j < 4; ++j) *(u32x4*)(Krt + kf_off(it, dk, hf * 32 + 8 * j)) = *(const u32x4*)&tile[dk * 72 + hf * 32 + 8 * j];
            }
            __syncthreads();
        }
    }
}

typedef float f32x16 __attribute__((ext_vector_type(16)));
DEVI f32x16 mfma32(bf16x8 a, bf16x8 b, f32x16 c) { return __builtin_amdgcn_mfma_f32_32x32x16_bf16(a, b, c, 0, 0, 0); }
#ifndef SCAN_DEPTH
#define SCAN_DEPTH 1
#endif
struct ScanSet { bf16x8 kf[4], vf[4], qf[2][2]; f32x4 dc[4]; };
template <bool GLA>
DEVI void scan_tile(const Params& p, unsigned char* zb  , int b, int h, int s, int dummy) {
    const int t = VT >> 6, lane = VT & 63, r = lane & 31, hh = lane >> 5;
    const bf16_t* Ktb = (const bf16_t*)(p.ws + (GLA ? OFF_KG2 : OFF_KRT));
    const bf16_t* Vtb = (const bf16_t*)(p.ws + (GLA ? OFF_VGT : OFF_VRT));
    const bf16_t* Qb  = (const bf16_t*)(p.ws + (GLA ? OFF_QG : OFF_QFR));
    const float* dec = (const float*)(p.ws + OFF_DEC);
    bf16_t* Oo = (bf16_t*)(p.ws + OFF_OO);
    const float lg = gamma_log2(h);
    const float cd = exp2f(lg * 64.0f);
    f32x16 S;
#pragma unroll
    for (int i = 0; i < 16; ++i) S[i] = 0.f;
    const unsigned it0 = (unsigned)(b * 64 * 4 + h);
    const bf16_t* const kp = Ktb + ((size_t)it0 * 4 + t) * 4 * 512; const unsigned ko = (unsigned)lane * 8;
    const bf16_t* const vp = Vtb + ((size_t)it0 * 8 + s) * 4 * 512; const unsigned vo = (unsigned)lane * 8;
    const bf16_t* const qp = Qb + ((((size_t)(b * 64) * 4 + h) * 2) * 4 + t) * 2 * 512; const unsigned qo = (unsigned)lane * 8;
    const float* const dp = dec + (size_t)it0 * 128 + t * 32; const unsigned dofs = 4 * hh;
    const int rt = t >> 1, rg0 = 2 * (t & 1);
    bf16_t* const op = Oo + (size_t)b * 4096 * 2048 + (GLA ? 1024 : 0) + h * 256 + s * 32 + (size_t)rt * 32 * 2048; const unsigned oo = (unsigned)r * 2048 + 4 * hh;
    const float qd = GLA ? 1.0f : exp2f(lg * (float)(32 * rt + r + 1));
    bf16_t* const ob = Oo + (size_t)b * 4096 * 2048 + (GLA ? 1024 : 0) + h * 256 + s * 32;
#define ST_LOAD(SET, C) do { const int c_ = dummy ? 0 : ((C) < 64 ? (C) : 63); \
        const bf16_t* kq = kp + (size_t)c_ * (4 * 16 * 512) + ko; const bf16_t* vq = vp + (size_t)c_ * (4 * 32 * 512) + vo; const bf16_t* qq = qp + (size_t)c_ * (4 * 16 * 512) + qo; \
        _Pragma("unroll") for (int ks = 0; ks < 4; ++ks) { (SET).kf[ks] = *(const bf16x8*)(kq + ks * 512); (SET).vf[ks] = *(const bf16x8*)(vq + ks * 512); } \
        _Pragma("unroll") for (int ss = 0; ss < 2; ++ss) _Pragma("unroll") for (int tt = 0; tt < 2; ++tt) (SET).qf[ss][tt] = *(const bf16x8*)(qq + tt * (8 * 512) + ss * 512); \
        } while (0)
#define ST_LOADDC(SET, C) do { if (GLA) { const int c_ = (C) < 64 ? (C) : 63; const float* dq = dp + (size_t)c_ * (4 * 128) + dofs; \
        _Pragma("unroll") for (int g = 0; g < 4; ++g) (SET).dc[g] = *(const f32x4*)(dq + 8 * g); } } while (0)
#define ST_Z(SET, ZC) do { \
        _Pragma("unroll") for (int tt = 0; tt < 2; ++tt) { \
            f32x16 Zt; _Pragma("unroll") for (int i = 0; i < 16; ++i) Zt[i] = 0.f; \
            _Pragma("unroll") for (int ss = 0; ss < 2; ++ss) { \
                u32x4 pk; pk.x = pk2(S[8 * ss + 0], S[8 * ss + 1]); pk.y = pk2(S[8 * ss + 2], S[8 * ss + 3]); pk.z = pk2(S[8 * ss + 4], S[8 * ss + 5]); pk.w = pk2(S[8 * ss + 6], S[8 * ss + 7]); \
                Zt = mfma32(__builtin_bit_cast(bf16x8, pk), (SET).qf[ss][tt], Zt); } \
            _Pragma("unroll") for (int g = 0; g < 4; ++g) { \
                f32x4 z4; z4[0] = Zt[4 * g]; z4[1] = Zt[4 * g + 1]; z4[2] = Zt[4 * g + 2]; z4[3] = Zt[4 * g + 3]; \
                *(u32x2*)((ZC) + (((t * 2 + tt) * 4 + g) * 64 + lane) * 8) = pk4(z4); } } } while (0)
#define ST_UPD(SET) do { \
        if (GLA) { _Pragma("unroll") for (int g = 0; g < 4; ++g) _Pragma("unroll") for (int i = 0; i < 4; ++i) S[4 * g + i] *= (SET).dc[g][i]; } \
        else { _Pragma("unroll") for (int i = 0; i < 16; ++i) S[i] *= cd; } \
        _Pragma("unroll") for (int ks = 0; ks < 4; ++ks) S = mfma32((SET).kf[ks], (SET).vf[ks], S); } while (0)
#define ST_STEP(CUR, NXT, OTH, C) do { \
        ST_LOAD(NXT, (C) + SCAN_DEPTH); ST_LOADDC(OTH, (C) + 1);      \
        __builtin_amdgcn_sched_barrier(0); \
        unsigned char* zc = zb + ((C) & 1) * 16384; \
        if (GLA) { ST_UPD(CUR); ST_Z(CUR, zc); } else { ST_Z(CUR, zc); ST_UPD(CUR); } \
        __syncthreads(); \
        _Pragma("unroll") for (int gi = 0; gi < 2; ++gi) { const int g = rg0 + gi; \
            f32x4 o = (f32x4){0.f, 0.f, 0.f, 0.f}; \
            _Pragma("unroll") for (int t2 = 0; t2 < 4; ++t2) o += unpk4(*(const u32x2*)(zc + (((t2 * 2 + rt) * 4 + g) * 64 + lane) * 8)); \
            *(u32x2*)(zb + 32768 + ((C) & 7) * 4096 + (32 * rt + r) * 64 + (8 * g + 4 * hh) * 2) = pk4(o * qd); } \
          \
        if (((C) & 7) == 7) { __syncthreads(); \
            _Pragma("unroll") for (int i = 0; i < 8; ++i) { const int idx = i * 256 + VT, row = idx >> 2, part = idx & 3; \
                *(u32x4*)(ob + ((size_t)((C) - 7) * 64 + row) * 2048 + part * 8) = *(const u32x4*)(zb + 32768 + row * 64 + part * 16); } } } while (0)
#if SCAN_DEPTH == 2
    ScanSet A, B, Cc;
    ST_LOAD(A, 0); ST_LOADDC(A, 0); ST_LOAD(B, 1);
#pragma unroll 1
    for (int c0 = 0; c0 < 63; c0 += 3) { ST_STEP(A, Cc, B, c0); ST_STEP(B, A, Cc, c0 + 1); ST_STEP(Cc, B, A, c0 + 2); }
    ST_STEP(A, Cc, B, 63);
#else
    ScanSet A, B;
    ST_LOAD(A, 0); ST_LOADDC(A, 0);
#pragma unroll 1
    for (int c0 = 0; c0 < 64; c0 += 2) { ST_STEP(A, B, B, c0); ST_STEP(B, A, A, c0 + 1); }
#endif
    __syncthreads();
#undef ST_STEP
#undef ST_UPD
#undef ST_Z
#undef ST_LOADDC
#undef ST_LOAD
}
DEVI void phase3t(const Params& p, unsigned char* smem, int dummy) {
    for (int it0 = VB; it0 < 512; it0 += VG) {
        const int lcl = (RB >> 3) * 2 + VH;
        const int it = (VG == 512) ? ((RB & 7) * 8 + lcl / 8) * 8 + (lcl & 7) : it0;
        const int s = it & 7, h = (it >> 3) & 3, b = (it >> 5) & 7, br = it >> 8;
        if (br == 0) scan_tile<false>(p, smem, b, h, s, dummy); else scan_tile<true>(p, smem, b, h, s, dummy);
    }
}

constexpr int PS_LD = 72;
DEVI void phase4(const Params& p, unsigned char* smem) {
    const int t = VT, lane = t & 63, w = t >> 6, l15 = lane & 15, q = lane >> 4;
    bf16_t* Ps = (bf16_t*)smem + w * 16 * PS_LD;
    const bf16_t* Qr = (const bf16_t*)(p.ws + OFF_QR); const bf16_t* Kr = (const bf16_t*)(p.ws + OFF_KR);
    const bf16_t* Vrt = (const bf16_t*)(p.ws + OFF_VRT); const bf16_t* Oo = (const bf16_t*)(p.ws + OFF_OO);
    const bf16_t* Gs = (const bf16_t*)(p.ws + OFF_GS); bf16_t* Y = (bf16_t*)(p.ws + OFF_Y);
    for (int it = VB; it < 4096; it += VG) {
        const int br = it >> 11, idx = it & 2047;
        const int h = idx & 3, c = (idx >> 2) & 63, b = idx >> 8;
        const size_t tok0 = (size_t)b * 4096 + c * 64;
        const size_t tok = tok0 + 16 * w + l15;
        f32x4 O[16];
        const bf16_t* orow = Oo + tok * 2048 + br * 1024 + h * 256 + 4 * q;
        const bf16_t* grow = Gs + tok * 2048 + br * 1024 + h * 256 + 4 * q;
        u32x2 oraw[16], graw[16];
        if (br == 0) {
            const float lg = gamma_log2(h);
            bf16x8 vf[8][2];
#pragma unroll
            for (int nt = 0; nt < 8; ++nt) { vf[nt][0] = *(const bf16x8*)(Vrt + vf_off(idx, 16 * nt + l15, q * 8)); vf[nt][1] = *(const bf16x8*)(Vrt + vf_off(idx, 16 * nt + l15, 32 + q * 8)); }
            __builtin_amdgcn_sched_barrier(0);
            f32x4 P[4] = {(f32x4){0.f, 0.f, 0.f, 0.f}, (f32x4){0.f, 0.f, 0.f, 0.f}, (f32x4){0.f, 0.f, 0.f, 0.f}, (f32x4){0.f, 0.f, 0.f, 0.f}};
#pragma unroll
            for (int ks = 0; ks < 4; ++ks) {
                const bf16x8 qf = *(const bf16x8*)(Qr + tok * 512 + h * 128 + ks * 32 + q * 8);
#pragma unroll
                for (int mt = 0; mt < 4; ++mt) {
                    const bf16x8 kf = *(const bf16x8*)(Kr + (tok0 + 16 * mt + l15) * 512 + h * 128 + ks * 32 + q * 8);
                    P[mt] = mfma16(kf, qf, P[mt]);
                }
            }
            const int j = 16 * w + l15;
#pragma unroll
            for (int mt = 0; mt < 4; ++mt) {
                f32x4 v = P[mt];
#pragma unroll
                for (int r = 0; r < 4; ++r) { const int m = 16 * mt + 4 * q + r; const int dd = j > m ? j - m : m - j; v[r] *= exp2f(lg * (float)dd); }
                *(u32x2*)&Ps[l15 * PS_LD + 16 * mt + 4 * q] = pk4(v);
            }
            __syncthreads();
            const bf16x8 pf0 = *(const bf16x8*)&Ps[l15 * PS_LD + q * 8];
            const bf16x8 pf1 = *(const bf16x8*)&Ps[l15 * PS_LD + 32 + q * 8];
            __builtin_amdgcn_sched_barrier(0);
#pragma unroll
            for (int nt = 0; nt < 8; ++nt) {
                f32x4 o = (f32x4){0.f, 0.f, 0.f, 0.f};
                o = mfma16(vf[nt][0], pf0, o); O[nt] = mfma16(vf[nt][1], pf1, o);
            }
            __builtin_amdgcn_sched_barrier(0);
#pragma unroll
            for (int nt = 0; nt < 8; ++nt) { vf[nt][0] = *(const bf16x8*)(Vrt + vf_off(idx, 16 * (8 + nt) + l15, q * 8)); vf[nt][1] = *(const bf16x8*)(Vrt + vf_off(idx, 16 * (8 + nt) + l15, 32 + q * 8)); }
#pragma unroll
            for (int nt = 0; nt < 16; ++nt) { oraw[nt] = *(const u32x2*)(orow + 16 * nt); graw[nt] = *(const u32x2*)(grow + 16 * nt); }
            __builtin_amdgcn_sched_barrier(0);
#pragma unroll
            for (int nt = 0; nt < 8; ++nt) {
                f32x4 o = (f32x4){0.f, 0.f, 0.f, 0.f};
                o = mfma16(vf[nt][0], pf0, o); O[8 + nt] = mfma16(vf[nt][1], pf1, o);
            }
#pragma unroll
            for (int nt = 0; nt < 16; ++nt) O[nt] += unpk4(oraw[nt]);
            __syncthreads();
        } else {
#pragma unroll
            for (int nt = 0; nt < 16; ++nt) { oraw[nt] = *(const u32x2*)(orow + 16 * nt); graw[nt] = *(const u32x2*)(grow + 16 * nt); }
#pragma unroll
            for (int nt = 0; nt < 16; ++nt) O[nt] = unpk4(oraw[nt]);
        }
        float s1 = 0.f;
#pragma unroll
        for (int nt = 0; nt < 16; ++nt) s1 += (O[nt][0] + O[nt][1]) + (O[nt][2] + O[nt][3]);
        s1 += __shfl_xor(s1, 16); s1 += __shfl_xor(s1, 32);
        const float mean = (br == 0) ? s1 * (1.0f / 256.0f) : 0.f;
        float s2 = 0.f;
#pragma unroll
        for (int nt = 0; nt < 16; ++nt) {
#pragma unroll
            for (int r = 0; r < 4; ++r) { const float dlt = O[nt][r] - mean; s2 += dlt * dlt; }
        }
        s2 += __shfl_xor(s2, 16); s2 += __shfl_xor(s2, 32);
        const float rstd = rsqrtf(s2 * (1.0f / 256.0f) + (br == 0 ? 1e-5f : 1e-6f));
        const float* gw = (br == 0 ? p.ret_norm_g : p.gla_norm_g) + h * 256 + 4 * q;
        bf16_t* yrow = Y + ((size_t)br * T_ + tok) * 1024 + h * 256 + 4 * q;
#pragma unroll
        for (int nt = 0; nt < 16; ++nt) {
            const f32x4 g = *(const f32x4*)(gw + 16 * nt);
            const f32x4 gate = unpk4(graw[nt]);
            f32x4 y;
#pragma unroll
            for (int r = 0; r < 4; ++r) y[r] = (O[nt][r] - mean) * rstd * g[r] * gate[r];
            *(u32x2*)(yrow + 16 * nt) = pk4(y);
        }
    }
}

struct EpiMerge {
    static constexpr bool PERM = true, AFTER_DRAIN = false;
    const bf16_t* Mg; bf16_t* Mrg; int pass;
    __device__ __forceinline__ void operator()(const pg8::f32x4 (&acc)[2][2][4][2], const pg8::Unit& u, int wr, int wc, int fr, int fq) const {
        const int row0 = u.pm * 256 + wr * 64 + fr, col0 = u.pn * 256 + wc * 32 + 8 * fq;
#pragma unroll
        for (int ai = 0; ai < 2; ++ai) {
            u32x4 gg[4][2], pr[4][2];
#pragma unroll
            for (int m = 0; m < 4; ++m)
#pragma unroll
                for (int bj = 0; bj < 2; ++bj) {
                    const size_t row = row0 + ai * 128 + m * 16; const int col = col0 + bj * 128;
                    gg[m][bj] = *(const u32x4*)(Mg + row * 2048 + pass * 1024 + col);
                    if (pass) pr[m][bj] = *(const u32x4*)(Mrg + row * 1024 + col);
                }
#pragma unroll
            for (int m = 0; m < 4; ++m)
#pragma unroll
                for (int bj = 0; bj < 2; ++bj) {
                    const size_t row = row0 + ai * 128 + m * 16; const int col = col0 + bj * 128;
                    f32x4 g0, g1; unpk8(gg[m][bj], g0, g1);
                    f32x4 o0 = acc[ai][bj][m][0] * g0, o1 = acc[ai][bj][m][1] * g1;
                    if (pass) { f32x4 p0, p1; unpk8(pr[m][bj], p0, p1); o0 += p0; o1 += p1; }
                    *(u32x4*)(Mrg + row * 1024 + col) = pk8(o0, o1);
                }
        }
    }
};
DEVI void phase5(const Params& p, unsigned char* smem_all) {
    pg8::StaticOrder S; S.init(T_, 1024, RG, RB);
    const bf16_t* Y = (const bf16_t*)(p.ws + OFF_Y); const bf16_t* wt = (const bf16_t*)(p.ws + OFF_WT);
    for (int pass = 0; pass < 2; ++pass) {
        pg8::Gemm g; g.A = Y + (size_t)pass * T_ * 1024; g.Bt = wt + (size_t)(pass ? WT_GLA : WT_RET) * 1024; g.M = T_; g.N = 1024; g.K = 1024;
        EpiMerge E; E.Mg = (const bf16_t*)(p.ws + OFF_MG); E.Mrg = (bf16_t*)(p.ws + OFF_MRG); E.pass = pass;
        pg8::gemm_phase<EpiMerge, pg8::StaticOrder, true, true>((PG8_LAS unsigned char*)smem_all, g, S, E);
        __syncthreads();
    }
}

struct EpiResid {
    static constexpr bool PERM = true, AFTER_DRAIN = false;
    const float* x; bf16_t* T1;
    __device__ __forceinline__ void operator()(const pg8::f32x4 (&acc)[2][2][4][2], const pg8::Unit& u, int wr, int wc, int fr, int fq) const {
        const int row0 = u.pm * 256 + wr * 64 + fr, col0 = u.pn * 256 + wc * 32 + 8 * fq;
#pragma unroll
        for (int ai = 0; ai < 2; ++ai)
#pragma unroll
            for (int m = 0; m < 4; ++m) {
                const size_t row = row0 + ai * 128 + m * 16;
                f32x4 xv[2][2];
#pragma unroll
                for (int bj = 0; bj < 2; ++bj) { xv[bj][0] = *(const f32x4*)(x + row * 1024 + col0 + bj * 128); xv[bj][1] = *(const f32x4*)(x + row * 1024 + col0 + bj * 128 + 4); }
#pragma unroll
                for (int bj = 0; bj < 2; ++bj)
                    *(u32x4*)(T1 + row * 1024 + col0 + bj * 128) = pk8(xv[bj][0] * ALPHA_ + acc[ai][bj][m][0], xv[bj][1] * ALPHA_ + acc[ai][bj][m][1]);
            }
    }
};
DEVI void phase6(const Params& p, unsigned char* smem_all) {
    pg8::StaticOrder S; S.init(T_, 1024, RG, RB);
    pg8::Gemm g; g.A = (const bf16_t*)(p.ws + OFF_MRG); g.Bt = (const bf16_t*)(p.ws + OFF_WT) + (size_t)WT_O * 1024; g.M = T_; g.N = 1024; g.K = 1024;
    EpiResid E; E.x = p.x; E.T1 = (bf16_t*)(p.ws + OFF_T1);
    pg8::gemm_phase<EpiResid, pg8::StaticOrder, true, true>((PG8_LAS unsigned char*)smem_all, g, S, E);
}

DEVI void conv_expert_weights(const Params& p, unsigned char* smem) {
    bf16_t* tile = (bf16_t*)smem;
    const int t = VT, ng = t & 31, kg = t >> 5;
    bf16_t* WGU = (bf16_t*)(p.ws + OFF_WGU); bf16_t* WD = (bf16_t*)(p.ws + OFF_WD);
    const int ntask = 257 * 3 * 32;
    for (int task = VB; task < ntask; task += VG) {
        const int e = task / 96, rem = task - e * 96, mat = rem >> 5, tl = rem & 31;
        const float* src; bf16_t* dst; int K, N, kt, nt;
        if (mat < 2) { K = 1024; N = 256; kt = tl >> 1; nt = tl & 1;
            src = (mat == 0) ? (e < 256 ? p.ew_gate + (size_t)e * 262144 : p.sw_gate) : (e < 256 ? p.ew_up + (size_t)e * 262144 : p.sw_up);
            dst = WGU + (size_t)e * 524288 + (size_t)(nt + mat) * 131072; }
        else { K = 256; N = 1024; kt = tl >> 3; nt = tl & 7;
            src = e < 256 ? p.ew_down + (size_t)e * 262144 : p.sw_down; dst = WD + (size_t)e * 262144; }
        const float* sp = src + (size_t)(kt * 64 + 4 * kg) * N + nt * 128 + 4 * ng;
        f32x4 rf[8];
#pragma unroll
        for (int i = 0; i < 4; ++i) { rf[i] = *(const f32x4*)(sp + (size_t)i * N); rf[4 + i] = *(const f32x4*)(sp + (size_t)(32 + i) * N); }
#pragma unroll
        for (int i = 0; i < 4; ++i) {
            u32x2 v0, v1;
            v0.x = pk2(rf[0][i], rf[1][i]); v0.y = pk2(rf[2][i], rf[3][i]); v1.x = pk2(rf[4][i], rf[5][i]); v1.y = pk2(rf[6][i], rf[7][i]);
            *(u32x2*)&tile[(4 * ng + i) * 72 + 4 * kg] = v0; *(u32x2*)&tile[(4 * ng + i) * 72 + 32 + 4 * kg] = v1;
        }
        __syncthreads();
        {
            const int n = t >> 1, hf = t & 1;
            bf16_t* dp = dst + (size_t)(nt * 128 + n) * K + kt * 64 + hf * 32;
#pragma unroll
            for (int j = 0; j < 4; ++j) *(u32x4*)(dp + 8 * j) = *(const u32x4*)&tile[n * 72 + hf * 32 + 8 * j];
        }
        __syncthreads();
    }
}

DEVI void phase7(const Params& p, unsigned char* smem) {
    const int t = VT, lane = t & 63, w = t >> 6;
    const bf16_t* T1 = (const bf16_t*)(p.ws + OFF_T1); bf16_t* X1b = (bf16_t*)(p.ws + OFF_X1B);
    for (int row = VB * 4 + w; row < T_; row += VG * 4) {
        f32x4 v[4]; float s = 0.f;
#pragma unroll
        for (int i = 0; i < 4; ++i) { v[i] = unpk4(*(const u32x2*)(T1 + (size_t)row * 1024 + i * 256 + lane * 4)); s += (v[i][0] + v[i][1]) + (v[i][2] + v[i][3]); }
#pragma unroll
        for (int o = 32; o > 0; o >>= 1) s += __shfl_xor(s, o);
        const float mean = s * (1.0f / 1024.0f); float s2 = 0.f;
#pragma unroll
        for (int i = 0; i < 4; ++i)
#pragma unroll
            for (int r = 0; r < 4; ++r) { const float d = v[i][r] - mean; s2 += d * d; }
#pragma unroll
        for (int o = 32; o > 0; o >>= 1) s2 += __shfl_xor(s2, o);
        const float rstd = rsqrtf(s2 * (1.0f / 1024.0f) + 1e-5f);
#pragma unroll
        for (int i = 0; i < 4; ++i) {
            const int col = i * 256 + lane * 4;
            const f32x4 g = *(const f32x4*)(p.ln1_g + col), bb = *(const f32x4*)(p.ln1_b + col);
            f32x4 y;
#pragma unroll
            for (int r = 0; r < 4; ++r) y[r] = (v[i][r] - mean) * rstd * g[r] + bb[r];
            *(u32x2*)(X1b + (size_t)row * 1024 + col) = pk4(y);
        }
    }
    conv_expert_weights(p, smem);
}

DEVI void phase8(const Params& p, unsigned char* smem) {
    GemmSmem& sm = *(GemmSmem*)smem;
    const int t = VT, lane = t & 63, w = t >> 6, wr = w >> 1, wc = w & 1, l15 = lane & 15, q = lane >> 4;
    const bf16_t* X1b = (const bf16_t*)(p.ws + OFF_X1B); const bf16_t* wt = (const bf16_t*)(p.ws + OFF_WT);
    float* LG = (float*)(p.ws + OFF_LOG);
    for (int tile = VB; tile < 256 * 2; tile += VG) {
        const int mtg = tile >> 1, ntg = tile & 1, m0 = mtg * 128, n0 = ntg * 128;
        const bf16_t* pa0 = X1b + (size_t)(m0 + (t >> 3)) * 1024 + gemm_src_chunk(t);
        const bf16_t* pb0 = wt + (size_t)(WT_R + n0 + (t >> 3)) * 1024 + gemm_src_chunk(t);
        const bf16_t* const pa[4] = {pa0, pa0 + 32 * 1024, pa0 + 64 * 1024, pa0 + 96 * 1024};
        const bf16_t* const pb[4] = {pb0, pb0 + 32 * 1024, pb0 + 64 * 1024, pb0 + 96 * 1024};
        f32x4 acc[4][4]; zero_acc(acc);
        gemm_kloop<true, 0>(acc, pa, pb, nullptr, 0, 16, sm);
#pragma unroll
        for (int mt = 0; mt < 4; ++mt)
#pragma unroll
            for (int nt = 0; nt < 4; ++nt) {
                const int row = m0 + wr * 64 + mt * 16 + l15, col = n0 + wc * 64 + (nt >> 1) * 32 + 8 * q + 4 * (nt & 1);
                *(f32x4*)(LG + (size_t)row * 256 + col) = acc[mt][nt];
            }
    }
}

DEVI unsigned f2ord(float f) { const unsigned u = __float_as_uint(f); return (u & 0x80000000u) ? ~u : (u | 0x80000000u); }
DEVI void phase9(const Params& p) {
    const int t = VT, lane = t & 63, w = t >> 6;
    const float* LG = (const float*)(p.ws + OFF_LOG);
    int* cnt = (int*)(p.ws + OFF_CNT); int* list = (int*)(p.ws + OFF_LIST); float* wts = (float*)(p.ws + OFF_WTS);
    const int tstep = VG * 4;
    int tok = VB * 4 + w;
    float lgn[4]; float rb[4];
#pragma unroll
    for (int r = 0; r < 4; ++r) { rb[r] = p.router_bias[lane + 64 * r]; lgn[r] = tok < T_ ? LG[(size_t)tok * 256 + lane + 64 * r] : 0.f; }
    int ppos = 0, pe = -1, ptk9 = 0;
    for (; tok < T_; tok += tstep) {
        float sc[4], bi[4];
#pragma unroll
        for (int r = 0; r < 4; ++r) { sc[r] = sigmoidf_(lgn[r]); bi[r] = sc[r] + rb[r]; }
        { const int tn = tok + tstep;
#pragma unroll
          for (int r = 0; r < 4; ++r) lgn[r] = tn < T_ ? LG[(size_t)tn * 256 + lane + 64 * r] : 0.f; }
        float gsc[8];
#pragma unroll
        for (int r = 0; r < 4; ++r) {
            float m1 = bi[r];
#pragma unroll
            for (int o = 16; o > 0; o >>= 1) m1 = fmaxf(m1, __shfl_xor(m1, o));
            const unsigned long long bal = __ballot(bi[r] == m1);
            const unsigned halfmask = (lane < 32) ? (unsigned)(bal & 0xffffffffull) : (unsigned)(bal >> 32);
            const int first = __ffs(halfmask) - 1;
            float m2 = ((lane & 31) == first) ? -INFINITY : bi[r];
#pragma unroll
            for (int o = 16; o > 0; o >>= 1) m2 = fmaxf(m2, __shfl_xor(m2, o));
            const float g = m1 + m2;
            gsc[2 * r] = __shfl(g, 0); gsc[2 * r + 1] = __shfl(g, 32);
        }
        unsigned selmask = 0;
#pragma unroll
        for (int g = 0; g < 8; ++g) {
            int rank = 0;
#pragma unroll
            for (int g2 = 0; g2 < 8; ++g2) rank += (gsc[g2] > gsc[g] || (gsc[g2] == gsc[g] && g2 < g)) ? 1 : 0;
            if (rank < 4) selmask |= 1u << g;
        }
        float cand[4];
#pragma unroll
        for (int r = 0; r < 4; ++r) cand[r] = ((selmask >> (2 * r + (lane >> 5))) & 1u) ? bi[r] : -INFINITY;
        float wsum = 0.f, myw = 0.f; int mye = 0;
#pragma unroll 1
        for (int k = 0; k < 8; ++k) {
            unsigned long long best = 0ull;
#pragma unroll
            for (int r = 0; r < 4; ++r) {
                const unsigned long long key = ((unsigned long long)f2ord(cand[r]) << 32) | (unsigned)(0xffffffffu - (unsigned)(lane + 64 * r));
                best = key > best ? key : best;
            }
#pragma unroll
            for (int o = 32; o > 0; o >>= 1) { const unsigned long long oth = __shfl_xor(best, o); best = oth > best ? oth : best; }
            const int e = (int)(0xffffffffu - (unsigned)(best & 0xffffffffull));
            float mine = 0.f;
#pragma unroll
            for (int r = 0; r < 4; ++r) if (e == lane + 64 * r) { mine = sc[r]; cand[r] = -INFINITY; }
            const float sv = __shfl(mine, e & 63);
            wsum += sv;
            if (lane == k) { mye = e; myw = sv; }
        }
        if (lane < 8) {
            if (pe >= 0) list[(size_t)pe * T_ + ppos] = ptk9;
            ppos = atomicAdd(&cnt[mye], 1); pe = mye; ptk9 = tok * 9 + lane;
            wts[(size_t)tok * 9 + lane] = myw / wsum * 2.5f;
        } else if (lane == 8) wts[(size_t)tok * 9 + 8] = 1.0f;
    }
    if (lane < 8 && pe >= 0) list[(size_t)pe * T_ + ppos] = ptk9;
}

DEVI void moe_prefix(const Params& p, int* pre  , int xg) {
    const int tid = VT;
    const int* cnt = (const int*)(p.ws + OFF_CNT);
    __syncthreads();
    if (tid < 64) {
        int v = 0;
        if (tid < 32) v = (__hip_atomic_load(&cnt[xg + 8 * tid], __ATOMIC_RELAXED, __HIP_MEMORY_SCOPE_AGENT) + 127) >> 7;
        else if (tid == 32) v = 32;
#pragma unroll
        for (int o = 1; o < 64; o <<= 1) { const int u = __shfl_up(v, o); if (tid >= o) v += u; }
        if (tid < 33) pre[tid + 1] = v;
        if (tid == 0) pre[0] = 0;
    }
    __syncthreads();
}
DEVI int moe_find(const int* pre, int mb) {
    int lo = 0, hi = 32;
    while (lo < hi) { const int mid = (lo + hi + 1) >> 1; if (pre[mid] <= mb) lo = mid; else hi = mid - 1; }
    return lo;
}
DEVI int moe_tk9(const int* list, int e, int pos) { return e < 256 ? list[(size_t)e * T_ + pos] : pos * 9 + 8; }

DEVI void moe_prefix256(const Params& p, int* pre  , int xg) {
    const int tid = threadIdx.x;
    const int* cnt = (const int*)(p.ws + OFF_CNT);
    __syncthreads();
    if (tid < 64) {
        int v = 0;
        if (tid < 32) v = (__hip_atomic_load(&cnt[xg + 8 * tid], __ATOMIC_RELAXED, __HIP_MEMORY_SCOPE_AGENT) + 255) >> 8;
        else if (tid == 32) v = 16;
#pragma unroll
        for (int o = 1; o < 64; o <<= 1) { const int u = __shfl_up(v, o); if (tid >= o) v += u; }
        if (tid < 33) pre[tid + 1] = v;
        if (tid == 0) pre[0] = 0;
    }
    __syncthreads();
}
struct MoeSched {
    const int* pre; const int* cnt; const int* list;
    int xg, jl, nloc, nun;
    const char* Abase; int arow_bytes; bool by_token;
    const char* Bbase; size_t b_expert_bytes, b_unit_bytes;
    __device__ __forceinline__ bool next(int i, pg8::Unit& u) const { const int item = jl + i * nloc; if (item >= pre[33] * nun) return false; u.pm = item / nun; u.pn = item - u.pm * nun; return true; }
    __device__ __forceinline__ void decode(const pg8::Unit& u, int& e, int& r0, int& ce) const {
        const int gi = moe_find(pre, u.pm), mb = u.pm - pre[gi];
        e = gi < 32 ? xg + 8 * gi : 256; ce = e < 256 ? cnt[e] : T_; r0 = (e < 256 ? 0 : xg * 4096) + mb * 256;
    }
    __device__ __forceinline__ int slot(int e, int pos) const { return e < 256 ? list[(size_t)e * T_ + pos] : pos * 9 + 8; }
    __device__ __forceinline__ const char* a_base() const { return Abase; }
    __device__ __forceinline__ void a_rows(const pg8::Unit& u, const int (&rowA)[2], const int (&colA)[2], unsigned& p00, unsigned& p01, unsigned& p10, unsigned& p11) const {
        int e, r0, ce; decode(u, e, r0, ce);
        const int fb = e < 256 ? 0 : xg * 4096;
        int s4[4];
#pragma unroll
        for (int k = 0; k < 4; ++k) { int pos = r0 + (k >> 1) * 128 + rowA[k & 1]; if (pos >= ce) pos = fb; s4[k] = slot(e, pos); }
#pragma unroll
        for (int k = 0; k < 4; ++k) if (by_token) s4[k] = s4[k] / 9;
        p00 = (unsigned)s4[0] * (unsigned)arow_bytes + (unsigned)colA[0]; p01 = (unsigned)s4[1] * (unsigned)arow_bytes + (unsigned)colA[1];
        p10 = (unsigned)s4[2] * (unsigned)arow_bytes + (unsigned)colA[0]; p11 = (unsigned)s4[3] * (unsigned)arow_bytes + (unsigned)colA[1];
    }
    __device__ __forceinline__ const char* b_base(const pg8::Unit& u) const { int e, r0, ce; decode(u, e, r0, ce); return Bbase + (size_t)e * b_expert_bytes + (size_t)u.pn * b_unit_bytes; }
    __device__ __forceinline__ void a_ready(const pg8::Unit&) const {}
    __device__ __forceinline__ void done(const pg8::Unit&) const {}
};
struct EpiMoe1 {
    static constexpr bool PERM = true, AFTER_DRAIN = false;
    const MoeSched* S; bf16_t* H;
    __device__ __forceinline__ void operator()(const pg8::f32x4 (&acc)[2][2][4][2], const pg8::Unit& u, int wr, int wc, int fr, int fq) const {
        int e, r0, ce; S->decode(u, e, r0, ce);
#pragma unroll
        for (int ai = 0; ai < 2; ++ai) {
            int sl[4];
#pragma unroll
            for (int m = 0; m < 4; ++m) { const int pos = r0 + ai * 128 + wr * 64 + m * 16 + fr; sl[m] = pos < ce ? S->slot(e, pos) : -1; }
#pragma unroll
            for (int m = 0; m < 4; ++m) if (sl[m] >= 0) {
                f32x4 h0, h1;
#pragma unroll
                for (int r = 0; r < 4; ++r) { h0[r] = siluf_(acc[ai][0][m][0][r]) * acc[ai][1][m][0][r]; h1[r] = siluf_(acc[ai][0][m][1][r]) * acc[ai][1][m][1][r]; }
                *(u32x4*)(H + (size_t)sl[m] * 256 + u.pn * 128 + wc * 32 + 8 * fq) = pk8(h0, h1);
            }
            asm volatile("" ::: "memory");
        }
    }
};
struct EpiMoe2 {
    static constexpr bool PERM = true, AFTER_DRAIN = false;
    const MoeSched* S; const float* wts; unsigned char* YX;
    __device__ __forceinline__ void operator()(const pg8::f32x4 (&acc)[2][2][4][2], const pg8::Unit& u, int wr, int wc, int fr, int fq) const {
        int e, r0, ce; S->decode(u, e, r0, ce);
#pragma unroll
        for (int ai = 0; ai < 2; ++ai) {
            int sl[4]; float wg[4];
#pragma unroll
            for (int m = 0; m < 4; ++m) { const int pos = r0 + ai * 128 + wr * 64 + m * 16 + fr; sl[m] = pos < ce ? S->slot(e, pos) : -1; }
#pragma unroll
            for (int m = 0; m < 4; ++m) wg[m] = sl[m] >= 0 ? wts[sl[m]] * YX_SCALE : 0.f;
#pragma unroll
            for (int m = 0; m < 4; ++m) if (sl[m] >= 0) {
#pragma unroll
                for (int bj = 0; bj < 2; ++bj)
                    { u32x2 w8; w8.x = pk4_fp8(clamp4(acc[ai][bj][m][0] * wg[m], 440.f)); w8.y = pk4_fp8(clamp4(acc[ai][bj][m][1] * wg[m], 440.f));
                      *(u32x2*)(YX + (size_t)sl[m] * 1024 + u.pn * 256 + bj * 128 + wc * 32 + 8 * fq) = w8; }
            }
            asm volatile("" ::: "memory");
        }
    }
};
DEVI void moe_sched_init(const Params& p, MoeSched& S, int* pre) {
    S.pre = pre; S.cnt = (const int*)(p.ws + OFF_CNT); S.list = (const int*)(p.ws + OFF_LIST);
    S.xg = RB & 7; S.jl = RB >> 3; S.nloc = RG >> 3;
}
DEVI void phase10(const Params& p, unsigned char* smem_all) {
    int* pre = (int*)(smem_all + 131072);
    MoeSched S; moe_sched_init(p, S, pre); moe_prefix256(p, pre, S.xg);
    S.nun = 2; S.Abase = (const char*)(p.ws + OFF_X1B); S.arow_bytes = 2048; S.by_token = true;
    S.Bbase = (const char*)(p.ws + OFF_WGU); S.b_expert_bytes = (size_t)512 * 1024 * 2; S.b_unit_bytes = (size_t)256 * 1024 * 2;
    EpiMoe1 E; E.S = &S; E.H = (bf16_t*)(p.ws + OFF_H);
    pg8::gemm_phase_g<EpiMoe1, MoeSched, true, true>((PG8_LAS unsigned char*)smem_all, 1024, S, E);
}
DEVI void phase11(const Params& p, unsigned char* smem_all) {
    int* pre = (int*)(smem_all + 131072);
    MoeSched S; moe_sched_init(p, S, pre); moe_prefix256(p, pre, S.xg);
    S.nun = 4; S.Abase = (const char*)(p.ws + OFF_H); S.arow_bytes = 512; S.by_token = false;
    S.Bbase = (const char*)(p.ws + OFF_WD); S.b_expert_bytes = (size_t)1024 * 256 * 2; S.b_unit_bytes = (size_t)256 * 256 * 2;
    EpiMoe2 E; E.S = &S; E.wts = (const float*)(p.ws + OFF_WTS); E.YX = (unsigned char*)(p.ws + OFF_YX);
    pg8::gemm_phase_g<EpiMoe2, MoeSched, true, true>((PG8_LAS unsigned char*)smem_all, 256, S, E);
}

DEVI void phase12(const Params& p) {
    const int t = VT, lane = t & 63, w = t >> 6;
    const bf16_t* X1b = (const bf16_t*)(p.ws + OFF_X1B); const unsigned char* YX = (const unsigned char*)(p.ws + OFF_YX);
    for (int row = VB * 4 + w; row < T_; row += VG * 4) {
        f32x4 v[4]; float s = 0.f;
#pragma unroll
        for (int i = 0; i < 4; ++i) {
            const int col = i * 256 + lane * 4;
            f32x4 a = unpk4(*(const u32x2*)(X1b + (size_t)row * 1024 + col)) * ALPHA_;
            f32x4 ys = (f32x4){0.f, 0.f, 0.f, 0.f};
#pragma unroll
            for (int k = 0; k < 9; ++k) ys += unpk4_fp8(*(const unsigned*)(YX + ((size_t)row * 9 + k) * 1024 + col));
            a += ys * (1.0f / YX_SCALE);
            v[i] = a; s += (a[0] + a[1]) + (a[2] + a[3]);
        }
#pragma unroll
        for (int o = 32; o > 0; o >>= 1) s += __shfl_xor(s, o);
        const float mean = s * (1.0f / 1024.0f); float s2 = 0.f;
#pragma unroll
        for (int i = 0; i < 4; ++i)
#pragma unroll
            for (int r = 0; r < 4; ++r) { const float d = v[i][r] - mean; s2 += d * d; }
#pragma unroll
        for (int o = 32; o > 0; o >>= 1) s2 += __shfl_xor(s2, o);
        const float rstd = rsqrtf(s2 * (1.0f / 1024.0f) + 1e-5f);
#pragma unroll
        for (int i = 0; i < 4; ++i) {
            const int col = i * 256 + lane * 4;
            const f32x4 g = *(const f32x4*)(p.ln2_g + col), bb = *(const f32x4*)(p.ln2_b + col);
            f32x4 y;
#pragma unroll
            for (int r = 0; r < 4; ++r) y[r] = (v[i][r] - mean) * rstd * g[r] + bb[r];
            *(f32x4*)(p.out + (size_t)row * 1024 + col) = y;
        }
    }
}


#define XB_TMO      128
#define XB_XCNT(j)  (256  + 64 * (j))
#define XB_XSUB(j)  (1280 + 64 * (j))
#define XB_XGEN(j)  (2304 + 64 * (j))
#define XB_TOP      3328
#define XB_TOPGEN   3392
#define XCD_BAR_WORDS 3456
#define XB_SPIN_CAP (1u << 20)
#define LAS __attribute__((address_space(3)))
DEVI unsigned xb_ld(unsigned* p)              { return __hip_atomic_load(p, __ATOMIC_RELAXED, __HIP_MEMORY_SCOPE_AGENT); }
DEVI unsigned xb_add(unsigned* p, unsigned v) { return __hip_atomic_fetch_add(p, v, __ATOMIC_RELAXED, __HIP_MEMORY_SCOPE_AGENT); }
DEVI unsigned xb_xcc_id() { return (unsigned)__builtin_amdgcn_s_getreg((3 << 11) | 20) & 0xFu; }
#define XB_SPIN(cond, bar) do { unsigned _sp = 0; while (cond) { __builtin_amdgcn_s_sleep(1); \
    if ((++_sp & 255u) == 0u) { if (xb_ld(&(bar)[XB_TMO])) break; if (_sp > XB_SPIN_CAP) { atomicAdd(&(bar)[XB_TMO], 1u); break; } } } } while (0)
struct XcdBarrier { unsigned* bar; unsigned x; volatile LAS unsigned* st; };
DEVI XcdBarrier xcd_barrier_post(unsigned* bar, volatile LAS unsigned* st) {
    XcdBarrier b; b.bar = bar; b.x = xb_xcc_id(); b.st = st;
    if (threadIdx.x == 0) st[3] = xb_add(&bar[XB_XCNT(b.x)], 1u);
    return b;
}
DEVI void xcd_barrier_complete(unsigned* bar, unsigned x, unsigned& nloc, unsigned& nx) {
    const unsigned G = gridDim.x * gridDim.y * gridDim.z;
    unsigned sum, cnt, mine, sp = 0u;
    for (;;) {
        sum = 0u; cnt = 0u; mine = 0u;
#pragma unroll
        for (unsigned j = 0; j < 16; ++j) { const unsigned c = xb_ld(&bar[XB_XCNT(j)]); sum += c; cnt += (c > 0u) ? 1u : 0u; mine = (j == x) ? c : mine; }
        if (sum == G) break;
        __builtin_amdgcn_s_sleep(1);
        if ((++sp & 255u) == 0u) { if (xb_ld(&bar[XB_TMO])) break; if (sp > XB_SPIN_CAP) { atomicAdd(&bar[XB_TMO], 1u); break; } }
    }
    nloc = mine > 0u ? mine : 1u; nx = cnt > 0u ? cnt : 1u;
}
DEVI void xcd_barrier(const XcdBarrier& b) {
    asm volatile("s_waitcnt vmcnt(0)" ::: "memory");
    __syncthreads();
    if (threadIdx.x == 0) {
        unsigned* bar = b.bar;
        __builtin_amdgcn_s_waitcnt(0);
        unsigned nloc = b.st[0], nx = b.st[1];
        if (nloc == 0u) { xcd_barrier_complete(bar, b.x, nloc, nx); b.st[0] = nloc; b.st[1] = nx; }
        const unsigned old = xb_add(&bar[XB_XSUB(b.x)], 1u);
        const unsigned gen = old / nloc;
        if (old + 1u == (gen + 1u) * nloc) {
            __builtin_amdgcn_fence(__ATOMIC_RELEASE, "agent");
            asm volatile("s_waitcnt vmcnt(0)" ::: "memory");
            const unsigned og = xb_add(&bar[XB_TOP], 1u);
            const unsigned tg = og / nx;
            if (og + 1u == (tg + 1u) * nx) xb_add(&bar[XB_TOPGEN], 1u);
            else XB_SPIN(xb_ld(&bar[XB_TOPGEN]) == tg, bar);
            __builtin_amdgcn_fence(__ATOMIC_ACQUIRE, "agent");
            xb_add(&bar[XB_XGEN(b.x)], 1u);
            asm volatile("s_waitcnt vmcnt(0)" ::: "memory");
        } else {
            XB_SPIN(xb_ld(&bar[XB_XGEN(b.x)]) == gen, bar);
            __builtin_amdgcn_fence(__ATOMIC_ACQUIRE, "agent");
            asm volatile("s_waitcnt vmcnt(0)" ::: "memory");
        }
    }
    __syncthreads();
}
constexpr size_t OFF_BAR = OFF_CNT + 65536;

#ifndef DBG
#define DBG 0
#endif
DEVI void dump_f32(const Params& p, size_t off) {
    const f32x4* src = (const f32x4*)(p.ws + off); f32x4* dst = (f32x4*)p.out;
    for (int i = blockIdx.x * 256 + threadIdx.x; i < T_ * D_ / 4; i += gridDim.x * 256) dst[i] = src[i];
}
DEVI void dump_bf16(const Params& p, size_t off, int ld, int coff) {
    const bf16_t* src = (const bf16_t*)(p.ws + off);
    for (int i = blockIdx.x * 256 + threadIdx.x; i < T_ * D_; i += gridDim.x * 256) { const int row = i >> 10, col = i & 1023; p.out[i] = bf2f(src[(size_t)row * ld + coff + col]); }
}
DEVI float flat_bf(const Params& p, size_t off, size_t n, size_t i) { const bf16_t* b = (const bf16_t*)(p.ws + off); float a = 0.f; for (size_t j = i; j < n; j += (size_t)T_ * D_) a += bf2f(b[j]); return a; }
DEVI void dump_p1(const Params& p) {
    const size_t N = (size_t)T_ * D_;
    for (size_t i = (size_t)blockIdx.x * 256 + threadIdx.x; i < N; i += (size_t)gridDim.x * 256) {
        float a = 0.f;
        a += flat_bf(p, OFF_MG, 2 * N, i) + flat_bf(p, OFF_GS, 2 * N, i);
        a += flat_bf(p, OFF_QR, N / 2, i % (N / 2)) + flat_bf(p, OFF_KR, N / 2, i % (N / 2)) + flat_bf(p, OFF_QG, N / 2, i % (N / 2));
        a += flat_bf(p, OFF_KRT, N / 2, i % (N / 2)) + flat_bf(p, OFF_KGT, N / 2, i % (N / 2));
        a += flat_bf(p, OFF_VRT, N, i) + flat_bf(p, OFF_VGT, N, i);
        a += ((const float*)(p.ws + OFF_GA))[i % ((size_t)T_ * 16)];
        p.out[i] = a;
    }
}
constexpr int NPHASE = 13;
__global__ void __launch_bounds__(512, 2) fwd_megakernel(Params p) {
    unsigned char* const smem_all = smem_all_g;
    unsigned char* smem = smem_all + VH * SMEM_HALF;
    uint4* xb_words = (uint4*)(smem_all + 2 * SMEM_HALF - 16);
    if (threadIdx.x == 0) *xb_words = make_uint4(0u, 0u, blockIdx.x, 0u);
    __syncthreads();
    const XcdBarrier xb = xcd_barrier_post((unsigned*)(p.ws + OFF_BAR), (volatile LAS unsigned*)xb_words);
#ifndef REPMASK
#define REPMASK 0
#endif
#define RUN_PHASE(K, CALL) do { if (p.phase_lo <= (K) && (K) < p.phase_hi) { _Pragma("unroll 1") for (int rep_ = ((REPMASK >> (K)) & 1); rep_ >= 0; --rep_) { CALL; if (rep_ > 0 || (K) + 1 < p.phase_hi) xcd_barrier(xb); } } } while (0)
    RUN_PHASE(0, phase0(p, smem));
    if (p.phase_lo == 0 && p.phase_hi > 1) {
        if (threadIdx.x == 0) {
            unsigned* bar = (unsigned*)(p.ws + OFF_BAR); bool ok = (gridDim.x & 7u) == 0u && xb.x < 8u;
            for (unsigned j = 0; j < 16; ++j) { const unsigned c = xb_ld(&bar[XB_XCNT(j)]); ok = ok && (j < 8 ? c == gridDim.x / 8u : c == 0u); }
            if (ok) ((volatile int*)xb_words)[2] = (int)(((volatile unsigned*)xb_words)[3] * 8u + xb.x);
        }
        __syncthreads();
    }
    RUN_PHASE(1, phase1(p, smem_all));
#if DBG == 2
    dump_p1(p); return;
#endif
    RUN_PHASE(2, phase2(p, smem));
#if DBG == 5
    { const size_t N = (size_t)T_ * D_; for (size_t i = (size_t)blockIdx.x * 256 + threadIdx.x; i < N; i += (size_t)gridDim.x * 256) p.out[i] = flat_bf(p, OFF_KG2, N / 2, i % (N / 2)) + ((const float*)(p.ws + OFF_DEC))[i % (2048 * 128)]; } return;
#endif
#ifdef SCANPROBE
    phase3t(p, smem, 1); xcd_barrier(xb);
#endif
    RUN_PHASE(3, phase3t(p, smem, 0));
#if DBG == 6
    dump_bf16(p, OFF_OO, 2048, 1024); return;
#endif
#if DBG == 7
    { const bf16_t* src = (const bf16_t*)(p.ws + OFF_OO);
      for (int i = blockIdx.x * 256 + threadIdx.x; i < T_ * D_; i += gridDim.x * 256) { const int row = i >> 10, col = i & 1023; const float v = bf2f(src[(size_t)row * 2048 + 1024 + col]); p.out[i] = (fabsf(v) < 1e30f) ? v : 12345.0f; } } return;
#endif
    RUN_PHASE(4, phase4(p, smem));
#if DBG == 3
    dump_bf16(p, OFF_Y, 2048, 0); return;
#endif
#if DBG == 4
    dump_bf16(p, OFF_Y, 2048, 1024); return;
#endif
    RUN_PHASE(5, phase5(p, smem_all));
    RUN_PHASE(6, phase6(p, smem_all));
    RUN_PHASE(7, phase7(p, smem));
#if DBG == 1
    return;
#endif
    RUN_PHASE(8, phase8(p, smem));
    RUN_PHASE(9, phase9(p));
    RUN_PHASE(10, phase10(p, smem_all));
    RUN_PHASE(11, phase11(p, smem_all));
    RUN_PHASE(12, phase12(p));
#undef RUN_PHASE
}

extern "C" void kernel_launch(void* const* d_in, const int* in_sizes, int n_in, void* d_out, int out_size, void* d_ws, size_t ws_size,
                              hipStream_t stream) {
    static int grid_blocks = 0;
    if (!grid_blocks) {
        int dev = 0, cus = 0, per_cu = 0;
        hipGetDevice(&dev);
        hipDeviceGetAttribute(&cus, hipDeviceAttributeMultiprocessorCount, dev);
        hipOccupancyMaxActiveBlocksPerMultiprocessor(&per_cu, fwd_megakernel, 512, 0);
        if (per_cu > 1) per_cu = 1;
        if (per_cu < 1) per_cu = 1;
        grid_blocks = cus * per_cu;
    }
    if (ws_size < WS_NEEDED) { fprintf(stderr, "workspace too small: %zu < %zu\n", ws_size, (size_t)WS_NEEDED); return; }
    Params p{};
    p.x = (const float*)d_in[0]; p.w_in = (const float*)d_in[1]; p.ret_norm_g = (const float*)d_in[2]; p.gate_w2 = (const float*)d_in[3];
    p.gate_b = (const float*)d_in[4]; p.gla_norm_g = (const float*)d_in[5]; p.w_ret_out = (const float*)d_in[6]; p.w_gla_out = (const float*)d_in[7];
    p.w_o = (const float*)d_in[8]; p.ln1_g = (const float*)d_in[9]; p.ln1_b = (const float*)d_in[10]; p.router_w = (const float*)d_in[11];
    p.router_bias = (const float*)d_in[12]; p.ew_gate = (const float*)d_in[13]; p.ew_up = (const float*)d_in[14]; p.ew_down = (const float*)d_in[15];
    p.sw_gate = (const float*)d_in[16]; p.sw_up = (const float*)d_in[17]; p.sw_down = (const float*)d_in[18]; p.ln2_g = (const float*)d_in[19];
    p.ln2_b = (const float*)d_in[20];
    p.out = (float*)d_out; p.ws = (unsigned char*)d_ws; p.phase_lo = 0; p.phase_hi = NPHASE;
    void* args[] = {&p};
    (void)hipMemsetAsync((unsigned char*)d_ws + OFF_BAR, 0, XCD_BAR_WORDS * 4, stream);
    hipError_t e = hipLaunchCooperativeKernel((void*)fwd_megakernel, dim3(grid_blocks), dim3(512), args, 0, stream);
    if (e != hipSuccess) fprintf(stderr, "cooperative launch failed: %s (grid %d)\n", hipGetErrorString(e), grid_blocks);
}
```

```cpp
#include <hip/hip_runtime.h>
#include <hip/hip_cooperative_groups.h>
#include <cstdio>
#include <cstdint>
namespace cg = cooperative_groups;

typedef unsigned short bf16_t;
typedef short bf16x8 __attribute__((ext_vector_type(8)));
typedef float f32x4 __attribute__((ext_vector_type(4)));
typedef unsigned u32x2 __attribute__((ext_vector_type(2)));
typedef unsigned u32x4 __attribute__((ext_vector_type(4)));
#define DEVI __device__ __forceinline__
#define VH ((int)(threadIdx.x >> 8))
#define VT ((int)(threadIdx.x & 255))
#define RB (__builtin_amdgcn_readfirstlane(((const int*)(smem_all_g + 2 * SMEM_HALF - 16))[2]))
#define RG ((int)gridDim.x)
#define VB (RB * 2 + VH)
#define VG (RG * 2)

constexpr int T_ = 32768;
constexpr int D_ = 1024;
constexpr int DIN_ = 8208;
constexpr int NE_ = 256;
constexpr float ALPHA_ = 1.189207115002721f;
constexpr float KSCALE_ = 0.08838834764831845f;

constexpr size_t MB = 1ull << 20;
constexpr size_t OFF_CNT  = 0;
constexpr int CNT_STRIDE = 64;
constexpr size_t OFF_CNT2 = 65536;
constexpr size_t OFF_CS   = 1 * MB;
constexpr size_t OFF_WT   = 3 * MB;
constexpr size_t FB = 27 * MB;
constexpr size_t OFF_QR   = FB + 0 * MB;
constexpr size_t OFF_KR   = FB + 32 * MB;
constexpr size_t OFF_VRT  = FB + 64 * MB;
constexpr size_t OFF_GS   = FB + 128 * MB;
constexpr size_t OFF_MG   = FB + 256 * MB;
constexpr size_t OFF_KRT  = FB + 384 * MB;
constexpr size_t OFF_QG   = FB + 416 * MB;
constexpr size_t OFF_VGT  = FB + 448 * MB;
constexpr size_t OFF_KGT  = FB + 512 * MB;
constexpr size_t OFF_GA   = FB + 544 * MB;
constexpr size_t OFF_XB   = FB + 546 * MB;
constexpr size_t OFF_KG2  = FB + 546 * MB;
constexpr size_t OFF_DEC  = FB + 578 * MB;
constexpr size_t OFF_OO   = FB + 579 * MB;
constexpr size_t OFF_Y    = FB + 384 * MB;
constexpr size_t OFF_MRG  = FB + 0 * MB;
constexpr size_t OFF_QGN  = 767 * MB;
constexpr size_t OFF_QFR  = 734 * MB;
constexpr size_t OFF_WGU  = 767 * MB;
constexpr size_t OFF_X1B  = FB + 0 * MB;
constexpr size_t OFF_WD   = FB + 64 * MB;
constexpr size_t OFF_LIST = FB + 193 * MB;
constexpr size_t OFF_WTS  = FB + 225 * MB;
constexpr size_t OFF_H    = FB + 227 * MB;
constexpr size_t OFF_YX   = FB + 371 * MB;
constexpr size_t OFF_T1   = FB + 371 * MB;
constexpr size_t OFF_LOG  = FB + 435 * MB;
constexpr size_t WS_NEEDED = 1024 * MB;

constexpr int WT_BN = 0, WT_AT = 5888, WT_RET = 8960, WT_GLA = 9984, WT_O = 11008, WT_R = 12032, WT_ROWS = 12288;

struct Params {
    const float *x, *w_in, *ret_norm_g, *gate_w2, *gate_b, *gla_norm_g, *w_ret_out, *w_gla_out, *w_o, *ln1_g, *ln1_b,
                *router_w, *router_bias, *ew_gate, *ew_up, *ew_down, *sw_gate, *sw_up, *sw_down, *ln2_g, *ln2_b;
    float* out;
    unsigned char* ws;
    int phase_lo, phase_hi;
};

static __device__ const float c_inv_freq[64] = {
  1.000000000e+00f, 8.659643531e-01f, 7.498942018e-01f, 6.493816376e-01f,
  5.623413324e-01f, 4.869675338e-01f, 4.216965139e-01f, 3.651741147e-01f,
  3.162277639e-01f, 2.738419771e-01f, 2.371373773e-01f, 2.053525001e-01f,
  1.778279394e-01f, 1.539926529e-01f, 1.333521456e-01f, 1.154781953e-01f,
  1.000000015e-01f, 8.659642935e-02f, 7.498942316e-02f, 6.493816525e-02f,
  5.623413250e-02f, 4.869675264e-02f, 4.216964915e-02f, 3.651741147e-02f,
  3.162277490e-02f, 2.738419548e-02f, 2.371373773e-02f, 2.053525113e-02f,
  1.778279431e-02f, 1.539926510e-02f, 1.333521400e-02f, 1.154781971e-02f,
  9.999999776e-03f, 8.659643121e-03f, 7.498942316e-03f, 6.493816152e-03f,
  5.623413250e-03f, 4.869675264e-03f, 4.216964822e-03f, 3.651741194e-03f,
  3.162277630e-03f, 2.738419687e-03f, 2.371373819e-03f, 2.053525066e-03f,
  1.778279431e-03f, 1.539926510e-03f, 1.333521446e-03f, 1.154782018e-03f,
  1.000000047e-03f, 8.659643354e-04f, 7.498941850e-04f, 6.493816036e-04f,
  5.623413017e-04f, 4.869675322e-04f, 4.216965172e-04f, 3.651741135e-04f,
  3.162277571e-04f, 2.738419571e-04f, 2.371373703e-04f, 2.053525095e-04f,
  1.778279402e-04f, 1.539926598e-04f, 1.333521504e-04f, 1.154782003e-04f };

DEVI float bf2f(unsigned short u) { return __uint_as_float(((unsigned)u) << 16); }
DEVI float bflo(unsigned u) { return __uint_as_float(u << 16); }
DEVI float bfhi(unsigned u) { return __uint_as_float(u & 0xffff0000u); }
typedef float f32x2 __attribute__((ext_vector_type(2)));
typedef __bf16 bf16x2_t __attribute__((ext_vector_type(2)));
DEVI unsigned pk2(float lo, float hi) { const f32x2 v = {lo, hi}; const bf16x2_t b = __builtin_convertvector(v, bf16x2_t); return __builtin_bit_cast(unsigned, b); }
DEVI unsigned short f2bf(float f) { return (unsigned short)(pk2(f, 0.f) & 0xffffu); }
DEVI u32x2 pk4(f32x4 v) { u32x2 r; r.x = pk2(v[0], v[1]); r.y = pk2(v[2], v[3]); return r; }
DEVI f32x4 unpk4(u32x2 u) { f32x4 r; r[0] = bflo(u.x); r[1] = bfhi(u.x); r[2] = bflo(u.y); r[3] = bfhi(u.y); return r; }
constexpr float YX_SCALE = 16.0f;
DEVI unsigned pk4_fp8(f32x4 v) { int w = 0; w = __builtin_amdgcn_cvt_pk_fp8_f32(v[0], v[1], w, false); w = __builtin_amdgcn_cvt_pk_fp8_f32(v[2], v[3], w, true); return (unsigned)w; }
DEVI f32x4 unpk4_fp8(unsigned u) { f32x4 r; r[0] = __builtin_amdgcn_cvt_f32_fp8((int)u, 0); r[1] = __builtin_amdgcn_cvt_f32_fp8((int)u, 1); r[2] = __builtin_amdgcn_cvt_f32_fp8((int)u, 2); r[3] = __builtin_amdgcn_cvt_f32_fp8((int)u, 3); return r; }
DEVI f32x4 clamp4(f32x4 v, float lim) { f32x4 r; for (int i = 0; i < 4; ++i) r[i] = fminf(fmaxf(v[i], -lim), lim); return r; }
DEVI float sigmoidf_(float v) { return 1.0f / (1.0f + __expf(-v)); }
DEVI float siluf_(float v) { return v / (1.0f + __expf(-v)); }
DEVI float gamma_log2(int h) { return log2f(1.0f - exp2f(-5.0f - (float)h)); }
DEVI f32x4 mfma16(bf16x8 a, bf16x8 b, f32x4 c) { return __builtin_amdgcn_mfma_f32_16x16x32_bf16(a, b, c, 0, 0, 0); }
DEVI unsigned kf_off(int item, int dk, int m8) { return ((((unsigned)item * 4u + (unsigned)(dk >> 5)) * 4u + (unsigned)(m8 >> 4)) * 64u + (unsigned)((m8 >> 3) & 1) * 32u + (unsigned)(dk & 31)) * 8u; }
DEVI unsigned vf_off(int item, int dv, int m8) { return ((((unsigned)item * 8u + (unsigned)(dv >> 5)) * 4u + (unsigned)(m8 >> 4)) * 64u + (unsigned)((m8 >> 3) & 1) * 32u + (unsigned)(dv & 31)) * 8u; }
DEVI unsigned qf_off(int bc, int h, int tokl, int dk8, int hh) {
    return ((((((unsigned)bc * 4u + (unsigned)h) * 2u + (unsigned)(tokl >> 5)) * 4u + (unsigned)(dk8 >> 5)) * 2u + (unsigned)((dk8 >> 4) & 1)) * 64u + (unsigned)hh * 32u + (unsigned)(tokl & 31)) * 8u + (unsigned)((dk8 >> 3) & 1) * 4u; }
DEVI int vperm(int n) { const int wc = n >> 6, nt = (n >> 4) & 3, i = n & 15; return wc * 64 + (nt >> 1) * 32 + 8 * (i >> 2) + 4 * (nt & 1) + (i & 3); }
DEVI int dperm2(int v) { return ((v >> 5) & 1) * 64 + (v >> 6) * 32 + (v & 31); }
DEVI u32x4 pk8(f32x4 a, f32x4 b) { u32x4 r; r.x = pk2(a[0], a[1]); r.y = pk2(a[2], a[3]); r.z = pk2(b[0], b[1]); r.w = pk2(b[2], b[3]); return r; }
DEVI void unpk8(u32x4 u, f32x4& a, f32x4& b) { a[0] = bflo(u.x); a[1] = bfhi(u.x); a[2] = bflo(u.y); a[3] = bfhi(u.y); b[0] = bflo(u.z); b[1] = bfhi(u.z); b[2] = bflo(u.w); b[3] = bfhi(u.w); }
DEVI int dperm(int v) { const int wc = v >> 6, nt = (v >> 4) & 3, c = v & 15; return (nt & 1) * 16 + wc * 32 + c + (nt >> 1) * 64; }

struct __attribute__((aligned(16))) GemmSmem { bf16_t a[2][128 * 64]; bf16_t b[2][128 * 64]; };
constexpr int SMEM_GEMM = sizeof(GemmSmem);
constexpr int SMEM_BYTES = SMEM_GEMM + 2048 + 16;
constexpr int SMEM_HALF = (SMEM_BYTES + 255) & ~255;
__shared__ __attribute__((aligned(16))) unsigned char smem_all_g[2 * SMEM_HALF];
DEVI int gemm_src_chunk(int t) { return ((t & 7) ^ ((t >> 4) & 7)) * 8; }

template <bool SWAP, int BKIND>
DEVI void gemm_kloop(f32x4 (&acc)[4][4], const bf16_t* const (&pa)[4], const bf16_t* const (&pb)[4],
                     const float* pbf, int ldb, int nk, GemmSmem& sm) {
    const int t = VT, lane = t & 63, w = t >> 6, wr = w >> 1, wc = w & 1, l15 = lane & 15, q = lane >> 4;
    const int kg = t & 7, ng = t >> 3;
    f32x4 rf[8];
#define GEMM_ISSUE(BUF, KO) do { \
        _Pragma("unroll") for (int i = 0; i < 4; ++i) \
            __builtin_amdgcn_global_load_lds((const unsigned*)(pa[i] + (KO)), (unsigned*)((char*)sm.a[BUF] + i * 4096 + t * 16), 16, 0, 0); \
        if (BKIND == 0) { _Pragma("unroll") for (int i = 0; i < 4; ++i) \
            __builtin_amdgcn_global_load_lds((const unsigned*)(pb[i] + (KO)), (unsigned*)((char*)sm.b[BUF] + i * 4096 + t * 16), 16, 0, 0); } \
        else { const float* pp = pbf + (size_t)((KO) + 4 * kg) * ldb; \
            _Pragma("unroll") for (int i = 0; i < 4; ++i) { rf[i] = *(const f32x4*)(pp + (size_t)i * ldb); rf[4 + i] = *(const f32x4*)(pp + (size_t)(32 + i) * ldb); } } } while (0)
#define GEMM_LSTORE_B(BUF) do { if (BKIND == 1) { \
            _Pragma("unroll") for (int i = 0; i < 4; ++i) { \
                u32x2 v0, v1; \
                v0.x = pk2(rf[0][i], rf[1][i]); v0.y = pk2(rf[2][i], rf[3][i]); v1.x = pk2(rf[4][i], rf[5][i]); v1.y = pk2(rf[6][i], rf[7][i]); \
                const int n = 4 * ng + i, sw = (n >> 1) & 7; \
                char* rowp = (char*)sm.b[BUF] + n * 128 + (kg & 1) * 8; \
                *(u32x2*)(rowp + (((kg >> 1) ^ sw) * 16)) = v0; *(u32x2*)(rowp + (((4 + (kg >> 1)) ^ sw) * 16)) = v1; } } } while (0)
    GEMM_ISSUE(0, 0);
    GEMM_LSTORE_B(0);
    __syncthreads();
#define GEMM_KSTEP(CUR, KT) do { \
        const bool more = ((KT) + 1 < nk); \
        if (more) { GEMM_ISSUE((CUR) ^ 1, ((KT) + 1) * 64); } \
        __builtin_amdgcn_sched_barrier(0); \
        _Pragma("unroll") for (int ss = 0; ss < 2; ++ss) { \
            bf16x8 af[4], bfr[4]; \
            const int coff = ((ss * 4 + q) ^ (l15 >> 1)) * 16; \
            _Pragma("unroll") for (int i = 0; i < 4; ++i) { \
                af[i]  = *(const bf16x8*)((const char*)sm.a[CUR] + (wr * 64 + i * 16 + l15) * 128 + coff); \
                bfr[i] = *(const bf16x8*)((const char*)sm.b[CUR] + (wc * 64 + i * 16 + l15) * 128 + coff); } \
            _Pragma("unroll") for (int mt = 0; mt < 4; ++mt) \
                _Pragma("unroll") for (int nt = 0; nt < 4; ++nt) \
                    acc[mt][nt] = SWAP ? mfma16(bfr[nt], af[mt], acc[mt][nt]) : mfma16(af[mt], bfr[nt], acc[mt][nt]); } \
        __builtin_amdgcn_sched_barrier(0); \
        if (more) { GEMM_LSTORE_B((CUR) ^ 1); } \
        __syncthreads(); } while (0)
#pragma unroll 1
    for (int kt = 0; kt < nk; kt += 2) { GEMM_KSTEP(0, kt); GEMM_KSTEP(1, kt + 1); }
#undef GEMM_KSTEP
#undef GEMM_LSTORE_B
#undef GEMM_ISSUE
}

DEVI void zero_acc(f32x4 (&acc)[4][4]) {
#pragma unroll
    for (int i = 0; i < 4; ++i)
#pragma unroll
        for (int j = 0; j < 4; ++j) acc[i][j] = (f32x4){0.f, 0.f, 0.f, 0.f};
}

namespace pg8 {
#define PG8_LAS __attribute__((address_space(3)))
typedef unsigned short bf16_t;
typedef short bf16x8 __attribute__((ext_vector_type(8)));
typedef float f32x4 __attribute__((ext_vector_type(4)));
typedef unsigned u32x4 __attribute__((ext_vector_type(4)));
constexpr int BM = 256, BK = 64, HALF = 128, HTB = HALF * BK * 2  , STAGE_BYTES = 8 * HTB, NXCD = 8, WGM = 8;

__host__ __device__ __forceinline__ int lds_byte(int r, int c) { const int st = (r >> 4) * 2 + (c >> 5), rr = r & 15, cc = c & 31, ob = rr * 64 + cc * 2; return st * 1024 + (ob ^ (((ob >> 9) & 1) << 5)); }
__host__ __device__ __forceinline__ void stage_rc(int b, int& R, int& C) { const int st = b / 1024, sb = b % 1024, swz = sb ^ (((sb >> 9) & 1) << 5); R = (st >> 1) * 16 + swz / 64; C = (st & 1) * 32 + (swz % 64) / 2; }
__host__ __device__ __forceinline__ int perm32(int rho) { const int n = rho >> 4, i = rho & 15; return 8 * (i >> 2) + 4 * n + (i & 3); }

struct Unit { int pm, pn; };
struct Gemm { const bf16_t* A; const bf16_t* Bt; int M, N, K; };

struct StaticOrder {
    int nM, nN, nwg, G, c;
    __host__ __device__ void init(int M, int N, int G_, int c_) { nM = M / BM; nN = N / BM; nwg = nM * nN; G = G_; c = c_; }
    __host__ __device__ bool next(int i, Unit& u) const {
        const long L = (long)i * G + c; if (L >= nwg) return false;
        int wgid = (int)L; { const int q = nwg / NXCD, r = nwg % NXCD, xcd = wgid % NXCD, off = wgid / NXCD; wgid = (xcd < r ? xcd * (q + 1) : r * (q + 1) + (xcd - r) * q) + off; }
        const int nig = WGM * nN, gid = wgid / nig, fm = gid * WGM, gsz = (nM - fm) < WGM ? (nM - fm) : WGM;
        u.pm = fm + ((wgid % nig) % gsz); u.pn = (wgid % nig) / gsz; return true;
    }
    __device__ __forceinline__ void a_ready(const Unit&) const {}
    __device__ __forceinline__ void done(const Unit&) const {}
};


template <class Epi, class Sched, bool ALIGN_EPI = false, bool SP2 = false>
__device__ __forceinline__ void gemm_phase(PG8_LAS unsigned char* lds, const Gemm g, const Sched& S, const Epi& E) {
    const int tid = threadIdx.x, wid = __builtin_amdgcn_readfirstlane(tid >> 6), lane = tid & 63, wr = wid >> 2, wc = wid & 3, fr = lane & 15, fq = lane >> 4;
    const int K = g.K, nt = K / BK;
    unsigned voffA[2], voffB[2];
#pragma unroll
    for (int i = 0; i < 2; ++i) { int R, C; stage_rc(tid * 16 + i * 8192, R, C); const int Rb = Epi::PERM ? ((R & ~31) + perm32(R & 31)) : R;
        voffA[i] = (unsigned)(R * K + C) * 2u; voffB[i] = (unsigned)(Rb * K + C) * 2u; }
    const size_t kstep = (size_t)(BK * 2);
    const size_t hstep = (size_t)HALF * K * 2;
    const size_t tstep = 2 * hstep;
    const unsigned ldsw = (unsigned)wid * 1024u;
    const int aoff = lds_byte(wr * 64 + fr, fq * 8), boff = lds_byte(wc * 32 + fr, fq * 8);
#define PG8_SA(b, h) (((b) * 2 + (h)) * HTB)
#define PG8_SB(b, h) ((4 + (b) * 2 + (h)) * HTB)
#define PG8_STAGE(bufoff, gbase, voff) do { _Pragma("unroll") for (int _i = 0; _i < 2; ++_i) \
        __builtin_amdgcn_global_load_lds((const unsigned*)((const char*)(gbase) + (voff)[_i]), (PG8_LAS unsigned*)(lds + (bufoff) + ldsw + _i * 8192), 16, 0, 0); } while (0)
#define PG8_LDA(dst, b, h) do { _Pragma("unroll") for (int m = 0; m < 4; ++m) _Pragma("unroll") for (int k = 0; k < 2; ++k) dst[m][k] = *(const PG8_LAS bf16x8*)(lds + PG8_SA(b, h) + aoff + m * 2048 + k * 1024); } while (0)
#define PG8_LDB(dst, b, h) do { _Pragma("unroll") for (int n = 0; n < 2; ++n) _Pragma("unroll") for (int k = 0; k < 2; ++k) dst[n][k] = *(const PG8_LAS bf16x8*)(lds + PG8_SB(b, h) + boff + n * 2048 + k * 1024); } while (0)
#define PG8_MMA(ai, bj, At, Bt) do { __builtin_amdgcn_s_setprio(1); _Pragma("unroll") for (int m = 0; m < 4; ++m) _Pragma("unroll") for (int n = 0; n < 2; ++n) _Pragma("unroll") for (int k = 0; k < 2; ++k) \
        acc[ai][bj][m][n] = __builtin_amdgcn_mfma_f32_16x16x32_bf16(Bt[n][k], At[m][k], acc[ai][bj][m][n], 0, 0, 0); __builtin_amdgcn_s_setprio(0); } while (0)
#define PG8_WAIT_V(n) asm volatile("s_waitcnt vmcnt(" #n ")" ::: "memory")
#define PG8_WAIT_L(n) asm volatile("s_waitcnt lgkmcnt(" #n ")" ::: "memory")
#define PG8_BAR __builtin_amdgcn_s_barrier()
#define PG8_SCHED __builtin_amdgcn_sched_barrier(0)
    Unit cur, nxt; int ui = 0;
    if (!S.next(0, cur)) return;
    f32x4 acc[2][2][4][2];
#pragma unroll
    for (int a = 0; a < 2; ++a)
#pragma unroll
        for (int b = 0; b < 2; ++b)
#pragma unroll
            for (int m = 0; m < 4; ++m)
#pragma unroll
                for (int n = 0; n < 2; ++n) acc[a][b][m][n] = (f32x4){0.f, 0.f, 0.f, 0.f};
    bf16x8 At[4][2], B0[2][2], B1[2][2];
    const char* cA = (const char*)g.A + (size_t)cur.pm * tstep; const char* cB = (const char*)g.Bt + (size_t)cur.pn * tstep;
    S.a_ready(cur);
    if constexpr (SP2) {
        PG8_STAGE(PG8_SB(0, 0), cB, voffB); PG8_STAGE(PG8_SB(0, 1), cB + hstep, voffB); PG8_STAGE(PG8_SA(0, 0), cA, voffA); PG8_STAGE(PG8_SA(0, 1), cA + hstep, voffA);
        if (wr == 1) PG8_BAR;
        PG8_WAIT_V(2); PG8_BAR;
        PG8_STAGE(PG8_SB(1, 0), cB + kstep, voffB); PG8_STAGE(PG8_SA(1, 0), cA + kstep, voffA); PG8_STAGE(PG8_SB(1, 1), cB + hstep + kstep, voffB);
        PG8_WAIT_V(6); PG8_BAR;
    } else {
        PG8_STAGE(PG8_SB(0, 0), cB, voffB); PG8_STAGE(PG8_SA(0, 0), cA, voffA); PG8_STAGE(PG8_SB(0, 1), cB + hstep, voffB); PG8_STAGE(PG8_SA(0, 1), cA + hstep, voffA);
        if (wr == 1) PG8_BAR;
        PG8_WAIT_V(4); PG8_BAR;
        PG8_STAGE(PG8_SB(1, 0), cB + kstep, voffB); PG8_STAGE(PG8_SA(1, 0), cA + kstep, voffA); PG8_STAGE(PG8_SB(1, 1), cB + hstep + kstep, voffB);
        PG8_WAIT_V(6); PG8_BAR;
    }
    for (;;) {
        const bool has_next = S.next(ui + 1, nxt);
        const char* nA = has_next ? (const char*)g.A + (size_t)nxt.pm * tstep : cA; const char* nB = has_next ? (const char*)g.Bt + (size_t)nxt.pn * tstep : cB;
        for (int t = 0; t < nt; t += 2) {
            const bool last = (t == nt - 2);
            const char* a1 = cA + (size_t)(t + 1) * kstep;
            const char* a2 = last ? nA : cA + (size_t)(t + 2) * kstep; const char* b2 = last ? nB : cB + (size_t)(t + 2) * kstep;
            const char* a3 = a2 + kstep; const char* b3 = b2 + kstep;
            if (last && has_next) S.a_ready(nxt);
            if constexpr (SP2) {
            PG8_LDB(B0, 0, 0); PG8_LDB(B1, 0, 1); PG8_SCHED; PG8_LDA(At, 0, 0); PG8_STAGE(PG8_SA(1, 1), a1 + hstep, voffA);
            PG8_WAIT_V(8); PG8_WAIT_L(0); PG8_BAR; PG8_MMA(0, 0, At, B0); PG8_MMA(0, 1, At, B1); PG8_BAR; PG8_SCHED;
            PG8_LDA(At, 0, 1); PG8_STAGE(PG8_SB(0, 0), b2, voffB); PG8_STAGE(PG8_SB(0, 1), b2 + hstep, voffB); PG8_STAGE(PG8_SA(0, 0), a2, voffA);
            PG8_WAIT_V(8); PG8_WAIT_L(0); PG8_BAR; PG8_MMA(1, 0, At, B0); PG8_MMA(1, 1, At, B1); PG8_BAR; PG8_SCHED;
            PG8_LDB(B0, 1, 0); PG8_LDB(B1, 1, 1); PG8_SCHED; PG8_LDA(At, 1, 0); PG8_STAGE(PG8_SA(0, 1), a2 + hstep, voffA);
            PG8_WAIT_V(8); PG8_WAIT_L(0); PG8_BAR; PG8_MMA(0, 0, At, B0); PG8_MMA(0, 1, At, B1); PG8_BAR; PG8_SCHED;
            PG8_LDA(At, 1, 1); PG8_STAGE(PG8_SB(1, 0), b3, voffB); PG8_STAGE(PG8_SB(1, 1), b3 + hstep, voffB); PG8_STAGE(PG8_SA(1, 0), a3, voffA);
            PG8_WAIT_V(8); PG8_WAIT_L(0); PG8_BAR; PG8_MMA(1, 0, At, B0); PG8_MMA(1, 1, At, B1); PG8_BAR; PG8_SCHED;
            } else {
            PG8_LDB(B0, 0, 0); PG8_SCHED; PG8_LDA(At, 0, 0); PG8_STAGE(PG8_SA(1, 1), a1 + hstep, voffA);
            PG8_WAIT_L(8); PG8_BAR; PG8_WAIT_L(0); PG8_MMA(0, 0, At, B0); PG8_BAR; PG8_SCHED;
            PG8_LDB(B1, 0, 1); PG8_STAGE(PG8_SB(0, 0), b2, voffB);
            PG8_BAR; PG8_WAIT_L(0); PG8_MMA(0, 1, At, B1); PG8_BAR;
            PG8_LDA(At, 0, 1); PG8_STAGE(PG8_SA(0, 0), a2, voffA);
            PG8_BAR; PG8_WAIT_L(0); PG8_MMA(1, 0, At, B0); PG8_BAR; PG8_SCHED;
            PG8_STAGE(PG8_SB(0, 1), b2 + hstep, voffB);
            PG8_WAIT_V(6); PG8_BAR; PG8_MMA(1, 1, At, B1); PG8_BAR;
            PG8_LDB(B0, 1, 0); PG8_SCHED; PG8_LDA(At, 1, 0); PG8_STAGE(PG8_SA(0, 1), a2 + hstep, voffA);
            PG8_WAIT_L(8); PG8_BAR; PG8_WAIT_L(0); PG8_MMA(0, 0, At, B0); PG8_BAR; PG8_SCHED;
            PG8_LDB(B1, 1, 1); PG8_STAGE(PG8_SB(1, 0), b3, voffB);
            PG8_BAR; PG8_WAIT_L(0); PG8_MMA(0, 1, At, B1); PG8_BAR;
            PG8_LDA(At, 1, 1); PG8_STAGE(PG8_SA(1, 0), a3, voffA);
            PG8_BAR; PG8_WAIT_L(0); PG8_MMA(1, 0, At, B0); PG8_BAR; PG8_SCHED;
            PG8_STAGE(PG8_SB(1, 1), b3 + hstep, voffB);
            PG8_WAIT_V(6); PG8_BAR; PG8_MMA(1, 1, At, B1); PG8_BAR;
            }
        }
        if constexpr (ALIGN_EPI) { if (wr == 0) PG8_BAR; }
        if constexpr (!Epi::AFTER_DRAIN) { E(acc, cur, wr, wc, fr, fq); S.done(cur); }
        if (!has_next) break;
#pragma unroll
        for (int a = 0; a < 2; ++a)
#pragma unroll
            for (int b = 0; b < 2; ++b)
#pragma unroll
                for (int m = 0; m < 4; ++m)
#pragma unroll
                    for (int n = 0; n < 2; ++n) acc[a][b][m][n] = (f32x4){0.f, 0.f, 0.f, 0.f};
        cur = nxt; cA = nA; cB = nB; ++ui;
        if constexpr (ALIGN_EPI) { if (wr == 1) PG8_BAR; }
    }
    PG8_WAIT_V(0);
    if constexpr (!ALIGN_EPI) { if (wr == 0) PG8_BAR; }
    PG8_BAR;
    if constexpr (Epi::AFTER_DRAIN) { E.fused(acc, cur, wr, wc, fr, fq, lds, wid, lane); S.done(cur); }
#undef PG8_SA
#undef PG8_SB
#undef PG8_STAGE
#undef PG8_LDA
#undef PG8_LDB
#undef PG8_MMA
#undef PG8_WAIT_V
#undef PG8_WAIT_L
#undef PG8_BAR
#undef PG8_SCHED
}
template <class Epi, class Sched, bool ALIGN_EPI = false, bool SP2 = false>
__device__ __forceinline__ void gemm_phase_g(PG8_LAS unsigned char* lds, const int K, const Sched& S, const Epi& E) {
    const int tid = threadIdx.x, wid = __builtin_amdgcn_readfirstlane(tid >> 6), lane = tid & 63, wr = wid >> 2, wc = wid & 3, fr = lane & 15, fq = lane >> 4;
    const int nt = K / BK;
    unsigned voffB[2]; int rowA[2], colA[2];
#pragma unroll
    for (int i = 0; i < 2; ++i) { int R, C; stage_rc(tid * 16 + i * 8192, R, C); const int Rb = Epi::PERM ? ((R & ~31) + perm32(R & 31)) : R;
        rowA[i] = R; colA[i] = C * 2; voffB[i] = (unsigned)(Rb * K + C) * 2u; }
    const size_t kstep = (size_t)(BK * 2);
    const size_t hstep = (size_t)HALF * K * 2;
    const size_t tstep = 2 * hstep;
    const unsigned ldsw = (unsigned)wid * 1024u;
    const int aoff = lds_byte(wr * 64 + fr, fq * 8), boff = lds_byte(wc * 32 + fr, fq * 8);
#define PG8_SA(b, h) (((b) * 2 + (h)) * HTB)
#define PG8_SB(b, h) ((4 + (b) * 2 + (h)) * HTB)
#define PG8_STAGE(bufoff, gbase, voff) do { _Pragma("unroll") for (int _i = 0; _i < 2; ++_i) \
        __builtin_amdgcn_global_load_lds((const unsigned*)((const char*)(gbase) + (voff)[_i]), (PG8_LAS unsigned*)(lds + (bufoff) + ldsw + _i * 8192), 16, 0, 0); } while (0)
#define PG8_STAGEA(bufoff, P0, P1, koff) do { \
        __builtin_amdgcn_global_load_lds((const unsigned*)(Ab + (size_t)(P0) + (koff)), (PG8_LAS unsigned*)(lds + (bufoff) + ldsw), 16, 0, 0); \
        __builtin_amdgcn_global_load_lds((const unsigned*)(Ab + (size_t)(P1) + (koff)), (PG8_LAS unsigned*)(lds + (bufoff) + ldsw + 8192), 16, 0, 0); } while (0)
#define PG8_LDA(dst, b, h) do { _Pragma("unroll") for (int m = 0; m < 4; ++m) _Pragma("unroll") for (int k = 0; k < 2; ++k) dst[m][k] = *(const PG8_LAS bf16x8*)(lds + PG8_SA(b, h) + aoff + m * 2048 + k * 1024); } while (0)
#define PG8_LDB(dst, b, h) do { _Pragma("unroll") for (int n = 0; n < 2; ++n) _Pragma("unroll") for (int k = 0; k < 2; ++k) dst[n][k] = *(const PG8_LAS bf16x8*)(lds + PG8_SB(b, h) + boff + n * 2048 + k * 1024); } while (0)
#define PG8_MMA(ai, bj, At, Bt) do { __builtin_amdgcn_s_setprio(1); _Pragma("unroll") for (int m = 0; m < 4; ++m) _Pragma("unroll") for (int n = 0; n < 2; ++n) _Pragma("unroll") for (int k = 0; k < 2; ++k) \
        acc[ai][bj][m][n] = __builtin_amdgcn_mfma_f32_16x16x32_bf16(Bt[n][k], At[m][k], acc[ai][bj][m][n], 0, 0, 0); __builtin_amdgcn_s_setprio(0); } while (0)
#define PG8_WAIT_V(n) asm volatile("s_waitcnt vmcnt(" #n ")" ::: "memory")
#define PG8_WAIT_L(n) asm volatile("s_waitcnt lgkmcnt(" #n ")" ::: "memory")
#define PG8_BAR __builtin_amdgcn_s_barrier()
#define PG8_SCHED __builtin_amdgcn_sched_barrier(0)
    Unit cur, nxt; int ui = 0;
    if (!S.next(0, cur)) return;
    f32x4 acc[2][2][4][2];
#pragma unroll
    for (int a = 0; a < 2; ++a)
#pragma unroll
        for (int b = 0; b < 2; ++b)
#pragma unroll
            for (int m = 0; m < 4; ++m)
#pragma unroll
                for (int n = 0; n < 2; ++n) acc[a][b][m][n] = (f32x4){0.f, 0.f, 0.f, 0.f};
    bf16x8 At[4][2], B0[2][2], B1[2][2];
    const char* cB = S.b_base(cur);
    unsigned cA00, cA01, cA10, cA11, nA00, nA01, nA10, nA11;
    const char* const Ab = S.a_base();
    S.a_rows(cur, rowA, colA, cA00, cA01, cA10, cA11);
    S.a_ready(cur);
    if constexpr (SP2) {
        PG8_STAGE(PG8_SB(0, 0), cB, voffB); PG8_STAGE(PG8_SB(0, 1), cB + hstep, voffB); PG8_STAGEA(PG8_SA(0, 0), cA00, cA01, 0); PG8_STAGEA(PG8_SA(0, 1), cA10, cA11, 0);
        if (wr == 1) PG8_BAR;
        PG8_WAIT_V(2); PG8_BAR;
        PG8_STAGE(PG8_SB(1, 0), cB + kstep, voffB); PG8_STAGEA(PG8_SA(1, 0), cA00, cA01, kstep); PG8_STAGE(PG8_SB(1, 1), cB + hstep + kstep, voffB);
        PG8_WAIT_V(6); PG8_BAR;
    } else {
        PG8_STAGE(PG8_SB(0, 0), cB, voffB); PG8_STAGEA(PG8_SA(0, 0), cA00, cA01, 0); PG8_STAGE(PG8_SB(0, 1), cB + hstep, voffB); PG8_STAGEA(PG8_SA(0, 1), cA10, cA11, 0);
        if (wr == 1) PG8_BAR;
        PG8_WAIT_V(4); PG8_BAR;
        PG8_STAGE(PG8_SB(1, 0), cB + kstep, voffB); PG8_STAGEA(PG8_SA(1, 0), cA00, cA01, kstep); PG8_STAGE(PG8_SB(1, 1), cB + hstep + kstep, voffB);
        PG8_WAIT_V(6); PG8_BAR;
    }
    for (;;) {
        const bool has_next = S.next(ui + 1, nxt);
        const char* nB = has_next ? S.b_base(nxt) : cB;
        if (has_next) S.a_rows(nxt, rowA, colA, nA00, nA01, nA10, nA11); else { nA00 = cA00; nA01 = cA01; nA10 = cA10; nA11 = cA11; }
        for (int t = 0; t < nt; t += 2) {
            const bool last = (t == nt - 2);
            const size_t k1 = (size_t)(t + 1) * kstep;
            const size_t k2 = last ? 0 : (size_t)(t + 2) * kstep; const char* b2 = last ? nB : cB + (size_t)(t + 2) * kstep;
            const unsigned q00 = last ? nA00 : cA00, q01 = last ? nA01 : cA01, q10 = last ? nA10 : cA10, q11 = last ? nA11 : cA11;
            const size_t k3 = k2 + kstep; const char* b3 = b2 + kstep;
            if (last && has_next) S.a_ready(nxt);
            if constexpr (SP2) {
            PG8_LDB(B0, 0, 0); PG8_LDB(B1, 0, 1); PG8_SCHED; PG8_LDA(At, 0, 0); PG8_STAGEA(PG8_SA(1, 1), cA10, cA11, k1);
            PG8_WAIT_V(8); PG8_WAIT_L(0); PG8_BAR; PG8_MMA(0, 0, At, B0); PG8_MMA(0, 1, At, B1); PG8_BAR; PG8_SCHED;
            PG8_LDA(At, 0, 1); PG8_STAGE(PG8_SB(0, 0), b2, voffB); PG8_STAGE(PG8_SB(0, 1), b2 + hstep, voffB); PG8_STAGEA(PG8_SA(0, 0), q00, q01, k2);
            PG8_WAIT_V(8); PG8_WAIT_L(0); PG8_BAR; PG8_MMA(1, 0, At, B0); PG8_MMA(1, 1, At, B1); PG8_BAR; PG8_SCHED;
            PG8_LDB(B0, 1, 0); PG8_LDB(B1, 1, 1); PG8_SCHED; PG8_LDA(At, 1, 0); PG8_STAGEA(PG8_SA(0, 1), q10, q11, k2);
            PG8_WAIT_V(8); PG8_WAIT_L(0); PG8_BAR; PG8_MMA(0, 0, At, B0); PG8_MMA(0, 1, At, B1); PG8_BAR; PG8_SCHED;
            PG8_LDA(At, 1, 1); PG8_STAGE(PG8_SB(1, 0), b3, voffB); PG8_STAGE(PG8_SB(1, 1), b3 + hstep, voffB); PG8_STAGEA(PG8_SA(1, 0), q00, q01, k3);
            PG8_WAIT_V(8); PG8_WAIT_L(0); PG8_BAR; PG8_MMA(1, 0, At, B0); PG8_MMA(1, 1, At, B1); PG8_BAR; PG8_SCHED;
            } else {
            PG8_LDB(B0, 0, 0); PG8_SCHED; PG8_LDA(At, 0, 0); PG8_STAGEA(PG8_SA(1, 1), cA10, cA11, k1);
            PG8_WAIT_L(8); PG8_BAR; PG8_WAIT_L(0); PG8_MMA(0, 0, At, B0); PG8_BAR; PG8_SCHED;
            PG8_LDB(B1, 0, 1); PG8_STAGE(PG8_SB(0, 0), b2, voffB);
            PG8_BAR; PG8_WAIT_L(0); PG8_MMA(0, 1, At, B1); PG8_BAR;
            PG8_LDA(At, 0, 1); PG8_STAGEA(PG8_SA(0, 0), q00, q01, k2);
            PG8_BAR; PG8_WAIT_L(0); PG8_MMA(1, 0, At, B0); PG8_BAR; PG8_SCHED;
            PG8_STAGE(PG8_SB(0, 1), b2 + hstep, voffB);
            PG8_WAIT_V(6); PG8_BAR; PG8_MMA(1, 1, At, B1); PG8_BAR;
            PG8_LDB(B0, 1, 0); PG8_SCHED; PG8_LDA(At, 1, 0); PG8_STAGEA(PG8_SA(0, 1), q10, q11, k2);
            PG8_WAIT_L(8); PG8_BAR; PG8_WAIT_L(0); PG8_MMA(0, 0, At, B0); PG8_BAR; PG8_SCHED;
            PG8_LDB(B1, 1, 1); PG8_STAGE(PG8_SB(1, 0), b3, voffB);
            PG8_BAR; PG8_WAIT_L(0); PG8_MMA(0, 1, At, B1); PG8_BAR;
            PG8_LDA(At, 1, 1); PG8_STAGEA(PG8_SA(1, 0), q00, q01, k3);
            PG8_BAR; PG8_WAIT_L(0); PG8_MMA(1, 0, At, B0); PG8_BAR; PG8_SCHED;
            PG8_STAGE(PG8_SB(1, 1), b3 + hstep, voffB);
            PG8_WAIT_V(6); PG8_BAR; PG8_MMA(1, 1, At, B1); PG8_BAR;
            }
        }
        if constexpr (ALIGN_EPI) { if (wr == 0) PG8_BAR; }
        if constexpr (!Epi::AFTER_DRAIN) { E(acc, cur, wr, wc, fr, fq); S.done(cur); }
        if (!has_next) break;
#pragma unroll
        for (int a = 0; a < 2; ++a)
#pragma unroll
            for (int b = 0; b < 2; ++b)
#pragma unroll
                for (int m = 0; m < 4; ++m)
#pragma unroll
                    for (int n = 0; n < 2; ++n) acc[a][b][m][n] = (f32x4){0.f, 0.f, 0.f, 0.f};
        cur = nxt; cA00 = nA00; cA01 = nA01; cA10 = nA10; cA11 = nA11; cB = nB; ++ui;
        if constexpr (ALIGN_EPI) { if (wr == 1) PG8_BAR; }
    }
    PG8_WAIT_V(0);
    if constexpr (!ALIGN_EPI) { if (wr == 0) PG8_BAR; }
    PG8_BAR;
    if constexpr (Epi::AFTER_DRAIN) { E.fused(acc, cur, wr, wc, fr, fq, lds, wid, lane); S.done(cur); }
#undef PG8_SA
#undef PG8_SB
#undef PG8_STAGE
#undef PG8_STAGEA
#undef PG8_LDA
#undef PG8_LDB
#undef PG8_MMA
#undef PG8_WAIT_V
#undef PG8_WAIT_L
#undef PG8_BAR
#undef PG8_SCHED
}
}

DEVI void wt_colinfo(const Params& p, int R, const float*& src, int& ld, float& scale) {
    scale = 1.0f; src = nullptr; ld = 0;
    if (R < WT_AT) {
        const int pn = R >> 8, cl = R & 255; ld = DIN_; int col = -1;
        if (pn < 4) { const int wcq = (cl >> 5) & 3; col = (pn >> 1) * 512 + (2 * (pn & 1) + (wcq >> 1)) * 128 + 64 * (cl >> 7) + 32 * (wcq & 1) + (cl & 31);
                      if (pn >= 2) scale = KSCALE_; }
        else if (pn < 8)  col = 2048 + (pn - 4) * 256 + cl;
        else if (pn < 10) { col = 3072 + (pn - 8) * 256 + cl; scale = KSCALE_; }
        else if (pn < 14) col = 5120 + (pn - 10) * 256 + cl;
        else if (pn < 22) col = 6160 + (pn - 14) * 256 + cl;
        else if (cl < 16) col = 6144 + cl;
        if (col >= 0) src = p.w_in + col;
    } else if (R < WT_RET) {
        const int Rr = R - WT_AT, pm = Rr >> 8, rl = Rr & 255; ld = DIN_; int col;
        if (pm < 2) { col = 512 + (2 * pm + ((rl >> 6) & 1)) * 128 + 64 * (rl >> 7) + (rl & 63); scale = KSCALE_; }
        else if (pm < 6)  col = 1024 + (pm - 2) * 256 + rl;
        else if (pm < 10) col = 4096 + (pm - 6) * 256 + rl;
        else              col = 3584 + (pm - 10) * 256 + rl;
        src = p.w_in + col;
    } else {
        int Rr, ldd; const float* base;
        if (R < WT_GLA)    { Rr = R - WT_RET; base = p.w_ret_out; ldd = 1024; }
        else if (R < WT_O) { Rr = R - WT_GLA; base = p.w_gla_out; ldd = 1024; }
        else if (R < WT_R) { Rr = R - WT_O;   base = p.w_o;       ldd = 1024; }
        else               { Rr = R - WT_R;   base = p.router_w;  ldd = 256; }
        src = base + ((R >= WT_R) ? ((Rr & ~127) + vperm(Rr & 127)) : Rr); ld = ldd;
    }
}

DEVI void phase0(const Params& p, unsigned char* smem) {
    const int tid = VT, nb = VG, bid = VB;
    float2* cs = (float2*)(p.ws + OFF_CS);
    for (int i = bid * 256 + tid; i < 4096 * 64; i += nb * 256) {
        const int pos = i >> 6, k = i & 63;
        const float angf = (float)pos * c_inv_freq[k];
        const double a = (double)angf;
        const double TWO_PI = 6.283185307179586476925286766559, HALF_PI = 1.5707963267948966192313216916398;
        const double kk = rint(a * (1.0 / TWO_PI));
        const double r = a - kk * TWO_PI;
        const double qd = rint(r * (1.0 / HALF_PI));
        const double y = r - qd * HALF_PI;
        const double y2 = y * y;
        double sn = y * (1.0 + y2 * (-1.0 / 6 + y2 * (1.0 / 120 + y2 * (-1.0 / 5040 + y2 * (1.0 / 362880 + y2 * (-1.0 / 39916800 + y2 * (1.0 / 6227020800.0)))))));
        double cn = 1.0 + y2 * (-0.5 + y2 * (1.0 / 24 + y2 * (-1.0 / 720 + y2 * (1.0 / 40320 + y2 * (-1.0 / 3628800 + y2 * (1.0 / 479001600.0))))));
        const int qi = ((int)qd) & 3;
        double s, c;
        if (qi == 0) { s = sn; c = cn; } else if (qi == 1) { s = cn; c = -sn; } else if (qi == 2) { s = -sn; c = -cn; } else { s = -cn; c = sn; }
        cs[i] = make_float2((float)c, (float)s);
    }
    if (bid < 64) { int* cnt = (int*)(p.ws + OFF_CNT); cnt[bid * 256 + tid] = 0; }
    {
        const f32x4* xs = (const f32x4*)p.x; u32x4* xd = (u32x4*)(p.ws + OFF_XB);
        const int n8 = T_ * D_ / 8;
        for (int g = bid * 256 + tid; g < n8; g += nb * 256) {
            const f32x4 v0 = xs[2 * g], v1 = xs[2 * g + 1];
            u32x4 o; o.x = pk2(v0[0], v0[1]); o.y = pk2(v0[2], v0[3]); o.z = pk2(v1[0], v1[1]); o.w = pk2(v1[2], v1[3]);
            xd[g] = o;
        }
    }
    {
        float* tile = (float*)smem;
        bf16_t* wt = (bf16_t*)(p.ws + OFF_WT);
        const int ntask = (WT_ROWS / 64) * 16;
        for (int task = bid; task < ntask; task += nb) {
            const int rt = task >> 4, kt = task & 15, R0 = rt * 64, k0 = kt * 64;
            {
                const int n = tid & 63, kq = tid >> 6;
                const float* src; int ld; float sc; wt_colinfo(p, R0 + n, src, ld, sc);
#pragma unroll
                for (int i = 0; i < 16; ++i) { const int k = kq + 4 * i; tile[k * 65 + n] = src ? src[(size_t)(k0 + k) * ld] * sc : 0.f; }
            }
            __syncthreads();
            {
                const int n = tid >> 2, ks = (tid & 3) * 16;
                unsigned o[8];
#pragma unroll
                for (int j = 0; j < 8; ++j) o[j] = pk2(tile[(ks + 2 * j) * 65 + n], tile[(ks + 2 * j + 1) * 65 + n]);
                u32x4* dst = (u32x4*)(wt + (size_t)(R0 + n) * 1024 + k0 + ks);
                dst[0] = (u32x4){o[0], o[1], o[2], o[3]}; dst[1] = (u32x4){o[4], o[5], o[6], o[7]};
            }
            __syncthreads();
        }
    }
}

struct EpiP1N {
    static constexpr bool PERM = true, AFTER_DRAIN = false;
    unsigned char* ws;
    __device__ __forceinline__ void operator()(const pg8::f32x4 (&acc)[2][2][4][2], const pg8::Unit& u, int wr, int wc, int fr, int fq) const {
        const int pn = u.pn, row0 = u.pm * 256 + wr * 64 + fr, c8 = wc * 32 + 8 * fq;
        if (pn < 4) {
            const float2* cs = (const float2*)(ws + OFF_CS); bf16_t* Qr = (bf16_t*)(ws + (pn < 2 ? OFF_QR : OFF_KR));
            const int head = 2 * (pn & 1) + (wc >> 1), d0 = 32 * (wc & 1) + 8 * fq;
#pragma unroll
            for (int ai = 0; ai < 2; ++ai)
#pragma unroll
                for (int m = 0; m < 4; ++m) {
                    const size_t row = row0 + ai * 128 + m * 16; const int pos = (int)(row & 4095);
                    f32x4 c4[4];
#pragma unroll
                    for (int j = 0; j < 4; ++j) c4[j] = *(const f32x4*)(cs + pos * 64 + d0 + 2 * j);
                    f32x4 o1[2], o2[2];
#pragma unroll
                    for (int n = 0; n < 2; ++n)
#pragma unroll
                        for (int r = 0; r < 4; ++r) {
                            const f32x4 cc = c4[2 * n + (r >> 1)]; const float c_ = cc[(r & 1) * 2], s_ = cc[(r & 1) * 2 + 1];
                            const float x1 = acc[ai][0][m][n][r], x2 = acc[ai][1][m][n][r];
                            o1[n][r] = x1 * c_ - x2 * s_; o2[n][r] = x1 * s_ + x2 * c_;
                        }
                    *(u32x4*)(Qr + row * 512 + head * 128 + d0) = pk8(o1[0], o1[1]);
                    *(u32x4*)(Qr + row * 512 + head * 128 + 64 + d0) = pk8(o2[0], o2[1]);
                    asm volatile("" ::: "memory");
                }
        } else {
#pragma unroll
            for (int ai = 0; ai < 2; ++ai)
#pragma unroll
                for (int m = 0; m < 4; ++m) {
                    const size_t row = row0 + ai * 128 + m * 16;
#pragma unroll
                    for (int bj = 0; bj < 2; ++bj) {
                        const int cl = bj * 128 + c8;
                        f32x4 v0 = acc[ai][bj][m][0], v1 = acc[ai][bj][m][1];
                        if (pn < 8) {
#pragma unroll
                            for (int r = 0; r < 4; ++r) { v0[r] = siluf_(v0[r]); v1[r] = siluf_(v1[r]); }
                            *(u32x4*)((bf16_t*)(ws + OFF_GS) + row * 2048 + (pn - 4) * 256 + cl) = pk8(v0, v1);
                        } else if (pn < 10) {
                            *(u32x4*)((bf16_t*)(ws + OFF_QGN) + row * 512 + (pn - 8) * 256 + cl) = pk8(v0, v1);
                        } else if (pn < 14) {
#pragma unroll
                            for (int r = 0; r < 4; ++r) { v0[r] = siluf_(v0[r]); v1[r] = siluf_(v1[r]); }
                            *(u32x4*)((bf16_t*)(ws + OFF_GS) + row * 2048 + 1024 + (pn - 10) * 256 + cl) = pk8(v0, v1);
                        } else if (pn < 22) {
#pragma unroll
                            for (int r = 0; r < 4; ++r) { v0[r] = sigmoidf_(v0[r]); v1[r] = sigmoidf_(v1[r]); }
                            *(u32x4*)((bf16_t*)(ws + OFF_MG) + row * 2048 + (pn - 14) * 256 + cl) = pk8(v0, v1);
                        } else if (cl < 16) {
                            float* Ga = (float*)(ws + OFF_GA); *(f32x4*)(Ga + row * 16 + cl) = v0; *(f32x4*)(Ga + row * 16 + cl + 4) = v1;
                        }
                    }
                    asm volatile("" ::: "memory");
                }
        }
    }
};
struct EpiP1V {
    static constexpr bool PERM = true, AFTER_DRAIN = false;
    unsigned char* ws;
    __device__ __forceinline__ void operator()(const pg8::f32x4 (&acc)[2][2][4][2], const pg8::Unit& u, int wr, int wc, int fr, int fq) const {
        bf16_t* dst = (bf16_t*)(ws + (u.pm < 4 ? OFF_VRT : OFF_VGT)); const int head = u.pm & 3;
#pragma unroll
        for (int bj = 0; bj < 2; ++bj) {
            const int tok0 = u.pn * 256 + bj * 128 + wc * 32 + 8 * fq; const int item = (tok0 >> 6) * 4 + head, m0 = tok0 & 63;
#pragma unroll
            for (int ai = 0; ai < 2; ++ai)
#pragma unroll
                for (int m = 0; m < 4; ++m) {
                    *(u32x4*)(dst + vf_off(item, ai * 128 + wr * 64 + m * 16 + fr, m0)) = pk8(acc[ai][bj][m][0], acc[ai][bj][m][1]);
                    asm volatile("" ::: "memory");
                }
        }
    }
};
struct EpiP1G {
    static constexpr bool PERM = true, AFTER_DRAIN = false;
    unsigned char* ws;
    __device__ __forceinline__ void operator()(const pg8::f32x4 (&acc)[2][2][4][2], const pg8::Unit& u, int wr, int wc, int fr, int fq) const {
        bf16_t* dst = (bf16_t*)(ws + OFF_KGT);
#pragma unroll
        for (int bj = 0; bj < 2; ++bj) {
            const int tok0 = u.pn * 256 + bj * 128 + wc * 32 + 8 * fq; const int m0 = tok0 & 63;
#pragma unroll
            for (int ai = 0; ai < 2; ++ai) {
                const unsigned item = (unsigned)((tok0 >> 6) * 4 + 2 * u.pm + ai);
#pragma unroll
                for (int m = 0; m < 4; ++m) {
                    *(u32x4*)(dst + (item * 128u + (unsigned)(wr * 64 + m * 16 + fr)) * 64u + (unsigned)m0) = pk8(acc[ai][bj][m][0], acc[ai][bj][m][1]);
                    asm volatile("" ::: "memory");
                }
            }
        }
    }
};
DEVI void phase1(const Params& p, unsigned char* smem_all) {
    {
        pg8::StaticOrder S; S.init(T_, 5888, RG, RB);
        pg8::Gemm g; g.A = (const bf16_t*)(p.ws + OFF_XB); g.Bt = (const bf16_t*)(p.ws + OFF_WT) + (size_t)WT_BN * 1024; g.M = T_; g.N = 5888; g.K = 1024;
        EpiP1N E; E.ws = p.ws;
        pg8::gemm_phase<EpiP1N, pg8::StaticOrder, true, true>((PG8_LAS unsigned char*)smem_all, g, S, E);
    }
    __syncthreads();
    {
        pg8::StaticOrder S; S.init(2048, T_, RG, RB);
        pg8::Gemm g; g.A = (const bf16_t*)(p.ws + OFF_WT) + (size_t)(WT_AT + 512) * 1024; g.Bt = (const bf16_t*)(p.ws + OFF_XB); g.M = 2048; g.N = T_; g.K = 1024;
        EpiP1V E; E.ws = p.ws;
        pg8::gemm_phase<EpiP1V, pg8::StaticOrder, true, true>((PG8_LAS unsigned char*)smem_all, g, S, E);
    }
    __syncthreads();
    {
        pg8::StaticOrder S; S.init(512, T_, RG, RB);
        pg8::Gemm g; g.A = (const bf16_t*)(p.ws + OFF_WT) + (size_t)(WT_AT + 2560) * 1024; g.Bt = (const bf16_t*)(p.ws + OFF_XB); g.M = 512; g.N = T_; g.K = 1024;
        EpiP1G E; E.ws = p.ws;
        pg8::gemm_phase<EpiP1G, pg8::StaticOrder, true, true>((PG8_LAS unsigned char*)smem_all, g, S, E);
    }
}

DEVI void phase2(const Params& p, unsigned char* smem) {
    float* ga_s = (float*)smem;
    float* tot = (float*)(smem + 4096);
    const int tid = VT;
    const float* Ga = (const float*)(p.ws + OFF_GA);
    const bf16_t* Kgt = (const bf16_t*)(p.ws + OFF_KGT); bf16_t* Kg2 = (bf16_t*)(p.ws + OFF_KG2);
    float* dec = (float*)(p.ws + OFF_DEC);
    for (int it = VB; it < 2048; it += VG) {
        const int h = it & 3, c = (it >> 2) & 63, b = it >> 8;
        const int tok0 = b * 4096 + c * 64;
        ((f32x4*)ga_s)[tid] = ((const f32x4*)(Ga + (size_t)tok0 * 16))[tid];
        const int dk = tid & 127, half = tid >> 7;
        float w2[16];
#pragma unroll
        for (int r = 0; r < 16; ++r) w2[r] = p.gate_w2[r * 512 + h * 128 + dk];
        const float bias = p.gate_b[h * 128 + dk];
        __syncthreads();
        float run = 0.f; float bc[32];
#pragma unroll
        for (int ml = 0; ml < 32; ++ml) {
            const int m = half * 32 + ml;
            float z = bias;
#pragma unroll
            for (int r4 = 0; r4 < 4; ++r4) { const f32x4 g4 = *(const f32x4*)&ga_s[m * 16 + 4 * r4];
                z += g4[0] * w2[4 * r4] + g4[1] * w2[4 * r4 + 1] + g4[2] * w2[4 * r4 + 2] + g4[3] * w2[4 * r4 + 3]; }
            const float la = (fminf(z, 0.f) - __logf(1.0f + __expf(-fabsf(z)))) * (1.0f / 16.0f);
            run += la; bc[ml] = run;
        }
        tot[half * 128 + dk] = run;
        __syncthreads();
        const float t0 = tot[dk], t1 = tot[128 + dk];
        const float bend = t0 + t1, off = half ? t0 : 0.f;
        const u32x4* kp = (const u32x4*)(Kgt + ((size_t)it * 128 + dk) * 64 + half * 32);
        bf16_t* const kqb = Kg2;
#pragma unroll
        for (int j = 0; j < 4; ++j) {
            u32x4 v = kp[j];
            unsigned uu[4] = {v.x, v.y, v.z, v.w};
#pragma unroll
            for (int e = 0; e < 4; ++e) {
                const float f0 = bflo(uu[e]) * __expf(bend - (bc[8 * j + 2 * e] + off));
                const float f1 = bfhi(uu[e]) * __expf(bend - (bc[8 * j + 2 * e + 1] + off));
                uu[e] = pk2(f0, f1);
            }
            *(u32x4*)(kqb + kf_off(it, dk, half * 32 + 8 * j)) = (u32x4){uu[0], uu[1], uu[2], uu[3]};
        }
        if (half == 0) dec[(size_t)it * 128 + dk] = __expf(bend);
        {
            const bf16_t* Qn = (const bf16_t*)(p.ws + OFF_QGN); bf16_t* QF = (bf16_t*)(p.ws + OFF_QG);
            const int m = tid & 63, qd = tid >> 6, bc = b * 64 + c;
            const u32x4* qs = (const u32x4*)(Qn + ((size_t)tok0 + m) * 512 + h * 128 + 32 * qd);
            u32x4 qv[4];
#pragma unroll
            for (int j = 0; j < 4; ++j) qv[j] = qs[j];
#pragma unroll
            for (int j = 0; j < 4; ++j) {
                *(u32x2*)(QF + qf_off(bc, h, m, 32 * qd + 8 * j, 0)) = (u32x2){qv[j].x, qv[j].y};
                *(u32x2*)(QF + qf_off(bc, h, m, 32 * qd + 8 * j, 1)) = (u32x2){qv[j].z, qv[j].w};
            }
        }
        __syncthreads();
    }
    {
        bf16_t* tile = (bf16_t*)smem;
        const bf16_t* Kr = (const bf16_t*)(p.ws + OFF_KR); bf16_t* Krt = (bf16_t*)(p.ws + OFF_KRT);
        for (int it = VB; it < 2048; it += VG) {
            const int h = it & 3, c = (it >> 2) & 63, b = it >> 8;
            const size_t tok0 = (size_t)b * 4096 + c * 64;
            const int m = tid & 63, qd = tid >> 6;
            const float kd = exp2f(gamma_log2(h) * (float)(63 - m));
            const u32x4* src = (const u32x4*)(Kr + (tok0 + m) * 512 + h * 128 + 32 * qd);
            u32x4 v[4];
#pragma unroll
            for (int j = 0; j < 4; ++j) v[j] = src[j];
#pragma unroll
            for (int j = 0; j < 4; ++j) {
                const unsigned uu[4] = {v[j].x, v[j].y, v[j].z, v[j].w};
#pragma unroll
                for (int e = 0; e < 4; ++e) {
                    const int dk = 32 * qd + 8 * j + 2 * e;
                    tile[dk * 72 + m] = f2bf(bflo(uu[e]) * kd); tile[(dk + 1) * 72 + m] = f2bf(bfhi(uu[e]) * kd);
                }
            }
            {
                const bf16_t* Qr = (const bf16_t*)(p.ws + OFF_QR); bf16_t* QF = (bf16_t*)(p.ws + OFF_QFR);
                const u32x4* qs = (const u32x4*)(Qr + (tok0 + m) * 512 + h * 128 + 32 * qd);
                u32x4 qv[4];
#pragma unroll
                for (int j = 0; j < 4; ++j) qv[j] = qs[j];
                const int bc = b * 64 + c;
#pragma unroll
                for (int j = 0; j < 4; ++j) {
                    *(u32x2*)(QF + qf_off(bc, h, m, 32 * qd + 8 * j, 0)) = (u32x2){qv[j].x, qv[j].y};
                    *(u32x2*)(QF + qf_off(bc, h, m, 32 * qd + 8 * j, 1)) = (u32x2){qv[j].z, qv[j].w};
                }
            }
            __syncthreads();
            {
                const int dk = tid >> 1, hf = tid & 1;
#pragma unroll
                for (int j = 0; j < 4; ++j) *(u32x4*)(Krt + kf_off(it, dk, hf * 32 + 8 * j)) = *(const u32x4*)&tile[dk * 72 + hf * 32 + 8 * j];
            }
            __syncthreads();
        }
    }
}

typedef float f32x16 __attribute__((ext_vector_type(16)));
DEVI f32x16 mfma32(bf16x8 a, bf16x8 b, f32x16 c) { return __builtin_amdgcn_mfma_f32_32x32x16_bf16(a, b, c, 0, 0, 0); }
#ifndef SCAN_DEPTH
#define SCAN_DEPTH 1
#endif
struct ScanSet { bf16x8 kf[4], vf[4], qf[2][2]; f32x4 dc[4]; };
template <bool GLA>
DEVI void scan_tile(const Params& p, unsigned char* zb  , int b, int h, int s, int dummy) {
    const int t = VT >> 6, lane = VT & 63, r = lane & 31, hh = lane >> 5;
    const bf16_t* Ktb = (const bf16_t*)(p.ws + (GLA ? OFF_KG2 : OFF_KRT));
    const bf16_t* Vtb = (const bf16_t*)(p.ws + (GLA ? OFF_VGT : OFF_VRT));
    const bf16_t* Qb  = (const bf16_t*)(p.ws + (GLA ? OFF_QG : OFF_QFR));
    const float* dec = (const float*)(p.ws + OFF_DEC);
    bf16_t* Oo = (bf16_t*)(p.ws + OFF_OO);
    const float lg = gamma_log2(h);
    const float cd = exp2f(lg * 64.0f);
    f32x16 S;
#pragma unroll
    for (int i = 0; i < 16; ++i) S[i] = 0.f;
    const unsigned it0 = (unsigned)(b * 64 * 4 + h);
    const bf16_t* const kp = Ktb + ((size_t)it0 * 4 + t) * 4 * 512; const unsigned ko = (unsigned)lane * 8;
    const bf16_t* const vp = Vtb + ((size_t)it0 * 8 + s) * 4 * 512; const unsigned vo = (unsigned)lane * 8;
    const bf16_t* const qp = Qb + ((((size_t)(b * 64) * 4 + h) * 2) * 4 + t) * 2 * 512; const unsigned qo = (unsigned)lane * 8;
    const float* const dp = dec + (size_t)it0 * 128 + t * 32; const unsigned dofs = 4 * hh;
    const int rt = t >> 1, rg0 = 2 * (t & 1);
    bf16_t* const op = Oo + (size_t)b * 4096 * 2048 + (GLA ? 1024 : 0) + h * 256 + s * 32 + (size_t)rt * 32 * 2048; const unsigned oo = (unsigned)r * 2048 + 4 * hh;
    const float qd = GLA ? 1.0f : exp2f(lg * (float)(32 * rt + r + 1));
    bf16_t* const ob = Oo + (size_t)b * 4096 * 2048 + (GLA ? 1024 : 0) + h * 256 + s * 32;
#define ST_LOAD(SET, C) do { const int c_ = dummy ? 0 : ((C) < 64 ? (C) : 63); \
        const bf16_t* kq = kp + (size_t)c_ * (4 * 16 * 512) + ko; const bf16_t* vq = vp + (size_t)c_ * (4 * 32 * 512) + vo; const bf16_t* qq = qp + (size_t)c_ * (4 * 16 * 512) + qo; \
        _Pragma("unroll") for (int ks = 0; ks < 4; ++ks) { (SET).kf[ks] = *(const bf16x8*)(kq + ks * 512); (SET).vf[ks] = *(const bf16x8*)(vq + ks * 512); } \
        _Pragma("unroll") for (int ss = 0; ss < 2; ++ss) _Pragma("unroll") for (int tt = 0; tt < 2; ++tt) (SET).qf[ss][tt] = *(const bf16x8*)(qq + tt * (8 * 512) + ss * 512); \
        } while (0)
#define ST_LOADDC(SET, C) do { if (GLA) { const int c_ = (C) < 64 ? (C) : 63; const float* dq = dp + (size_t)c_ * (4 * 128) + dofs; \
        _Pragma("unroll") for (int g = 0; g < 4; ++g) (SET).dc[g] = *(const f32x4*)(dq + 8 * g); } } while (0)
#define ST_Z(SET, ZC) do { \
        _Pragma("unroll") for (int tt = 0; tt < 2; ++tt) { \
            f32x16 Zt; _Pragma("unroll") for (int i = 0; i < 16; ++i) Zt[i] = 0.f; \
            _Pragma("unroll") for (int ss = 0; ss < 2; ++ss) { \
                u32x4 pk; pk.x = pk2(S[8 * ss + 0], S[8 * ss + 1]); pk.y = pk2(S[8 * ss + 2], S[8 * ss + 3]); pk.z = pk2(S[8 * ss + 4], S[8 * ss + 5]); pk.w = pk2(S[8 * ss + 6], S[8 * ss + 7]); \
                Zt = mfma32(__builtin_bit_cast(bf16x8, pk), (SET).qf[ss][tt], Zt); } \
            _Pragma("unroll") for (int g = 0; g < 4; ++g) { \
                f32x4 z4; z4[0] = Zt[4 * g]; z4[1] = Zt[4 * g + 1]; z4[2] = Zt[4 * g + 2]; z4[3] = Zt[4 * g + 3]; \
                *(u32x2*)((ZC) + (((t * 2 + tt) * 4 + g) * 64 + lane) * 8) = pk4(z4); } } } while (0)
#define ST_UPD(SET) do { \
        if (GLA) { _Pragma("unroll") for (int g = 0; g < 4; ++g) _Pragma("unroll") for (int i = 0; i < 4; ++i) S[4 * g + i] *= (SET).dc[g][i]; } \
        else { _Pragma("unroll") for (int i = 0; i < 16; ++i) S[i] *= cd; } \
        _Pragma("unroll") for (int ks = 0; ks < 4; ++ks) S = mfma32((SET).kf[ks], (SET).vf[ks], S); } while (0)
#define ST_STEP(CUR, NXT, OTH, C) do { \
        ST_LOAD(NXT, (C) + SCAN_DEPTH); ST_LOADDC(OTH, (C) + 1);      \
        __builtin_amdgcn_sched_barrier(0); \
        unsigned char* zc = zb + ((C) & 1) * 16384; \
        if (GLA) { ST_UPD(CUR); ST_Z(CUR, zc); } else { ST_Z(CUR, zc); ST_UPD(CUR); } \
        __syncthreads(); \
        _Pragma("unroll") for (int gi = 0; gi < 2; ++gi) { const int g = rg0 + gi; \
            f32x4 o = (f32x4){0.f, 0.f, 0.f, 0.f}; \
            _Pragma("unroll") for (int t2 = 0; t2 < 4; ++t2) o += unpk4(*(const u32x2*)(zc + (((t2 * 2 + rt) * 4 + g) * 64 + lane) * 8)); \
            *(u32x2*)(zb + 32768 + ((C) & 7) * 4096 + (32 * rt + r) * 64 + (8 * g + 4 * hh) * 2) = pk4(o * qd); } \
          \
        if (((C) & 7) == 7) { __syncthreads(); \
            _Pragma("unroll") for (int i = 0; i < 8; ++i) { const int idx = i * 256 + VT, row = idx >> 2, part = idx & 3; \
                *(u32x4*)(ob + ((size_t)((C) - 7) * 64 + row) * 2048 + part * 8) = *(const u32x4*)(zb + 32768 + row * 64 + part * 16); } } } while (0)
#if SCAN_DEPTH == 2
    ScanSet A, B, Cc;
    ST_LOAD(A, 0); ST_LOADDC(A, 0); ST_LOAD(B, 1);
#pragma unroll 1
    for (int c0 = 0; c0 < 63; c0 += 3) { ST_STEP(A, Cc, B, c0); ST_STEP(B, A, Cc, c0 + 1); ST_STEP(Cc, B, A, c0 + 2); }
    ST_STEP(A, Cc, B, 63);
#else
    ScanSet A, B;
    ST_LOAD(A, 0); ST_LOADDC(A, 0);
#pragma unroll 1
    for (int c0 = 0; c0 < 64; c0 += 2) { ST_STEP(A, B, B, c0); ST_STEP(B, A, A, c0 + 1); }
#endif
    __syncthreads();
#undef ST_STEP
#undef ST_UPD
#undef ST_Z
#undef ST_LOADDC
#undef ST_LOAD
}
DEVI void phase3t(const Params& p, unsigned char* smem, int dummy) {
    for (int it0 = VB; it0 < 512; it0 += VG) {
        const int lcl = (RB >> 3) * 2 + VH;
        const int it = (VG == 512) ? ((RB & 7) * 8 + lcl / 8) * 8 + (lcl & 7) : it0;
        const int s = it & 7, h = (it >> 3) & 3, b = (it >> 5) & 7, br = it >> 8;
        if (br == 0) scan_tile<false>(p, smem, b, h, s, dummy); else scan_tile<true>(p, smem, b, h, s, dummy);
    }
}

constexpr int PS_LD = 72;
DEVI void phase4(const Params& p, unsigned char* smem) {
    const int t = VT, lane = t & 63, w = t >> 6, l15 = lane & 15, q = lane >> 4;
    bf16_t* Ps = (bf16_t*)smem + w * 16 * PS_LD;
    const bf16_t* Qr = (const bf16_t*)(p.ws + OFF_QR); const bf16_t* Kr = (const bf16_t*)(p.ws + OFF_KR);
    const bf16_t* Vrt = (const bf16_t*)(p.ws + OFF_VRT); const bf16_t* Oo = (const bf16_t*)(p.ws + OFF_OO);
    const bf16_t* Gs = (const bf16_t*)(p.ws + OFF_GS); bf16_t* Y = (bf16_t*)(p.ws + OFF_Y);
    for (int it = VB; it < 4096; it += VG) {
        const int br = it >> 11, idx = it & 2047;
        const int h = idx & 3, c = (idx >> 2) & 63, b = idx >> 8;
        const size_t tok0 = (size_t)b * 4096 + c * 64;
        const size_t tok = tok0 + 16 * w + l15;
        f32x4 O[16];
        const bf16_t* orow = Oo + tok * 2048 + br * 1024 + h * 256 + 4 * q;
        const bf16_t* grow = Gs + tok * 2048 + br * 1024 + h * 256 + 4 * q;
        u32x2 oraw[16], graw[16];
        if (br == 0) {
            const float lg = gamma_log2(h);
            bf16x8 vf[8][2];
#pragma unroll
            for (int nt = 0; nt < 8; ++nt) { vf[nt][0] = *(const bf16x8*)(Vrt + vf_off(idx, 16 * nt + l15, q * 8)); vf[nt][1] = *(const bf16x8*)(Vrt + vf_off(idx, 16 * nt + l15, 32 + q * 8)); }
            __builtin_amdgcn_sched_barrier(0);
            f32x4 P[4] = {(f32x4){0.f, 0.f, 0.f, 0.f}, (f32x4){0.f, 0.f, 0.f, 0.f}, (f32x4){0.f, 0.f, 0.f, 0.f}, (f32x4){0.f, 0.f, 0.f, 0.f}};
#pragma unroll
            for (int ks = 0; ks < 4; ++ks) {
                const bf16x8 qf = *(const bf16x8*)(Qr + tok * 512 + h * 128 + ks * 32 + q * 8);
#pragma unroll
                for (int mt = 0; mt < 4; ++mt) {
                    const bf16x8 kf = *(const bf16x8*)(Kr + (tok0 + 16 * mt + l15) * 512 + h * 128 + ks * 32 + q * 8);
                    P[mt] = mfma16(kf, qf, P[mt]);
                }
            }
            const int j = 16 * w + l15;
#pragma unroll
            for (int mt = 0; mt < 4; ++mt) {
                f32x4 v = P[mt];
#pragma unroll
                for (int r = 0; r < 4; ++r) { const int m = 16 * mt + 4 * q + r; const int dd = j > m ? j - m : m - j; v[r] *= exp2f(lg * (float)dd); }
                *(u32x2*)&Ps[l15 * PS_LD + 16 * mt + 4 * q] = pk4(v);
            }
            __syncthreads();
            const bf16x8 pf0 = *(const bf16x8*)&Ps[l15 * PS_LD + q * 8];
            const bf16x8 pf1 = *(const bf16x8*)&Ps[l15 * PS_LD + 32 + q * 8];
            __builtin_amdgcn_sched_barrier(0);
#pragma unroll
            for (int nt = 0; nt < 8; ++nt) {
                f32x4 o = (f32x4){0.f, 0.f, 0.f, 0.f};
                o = mfma16(vf[nt][0], pf0, o); O[nt] = mfma16(vf[nt][1], pf1, o);
            }
            __builtin_amdgcn_sched_barrier(0);
#pragma unroll
            for (int nt = 0; nt < 8; ++nt) { vf[nt][0] = *(const bf16x8*)(Vrt + vf_off(idx, 16 * (8 + nt) + l15, q * 8)); vf[nt][1] = *(const bf16x8*)(Vrt + vf_off(idx, 16 * (8 + nt) + l15, 32 + q * 8)); }
#pragma unroll
            for (int nt = 0; nt < 16; ++nt) { oraw[nt] = *(const u32x2*)(orow + 16 * nt); graw[nt] = *(const u32x2*)(grow + 16 * nt); }
            __builtin_amdgcn_sched_barrier(0);
#pragma unroll
            for (int nt = 0; nt < 8; ++nt) {
                f32x4 o = (f32x4){0.f, 0.f, 0.f, 0.f};
                o = mfma16(vf[nt][0], pf0, o); O[8 + nt] = mfma16(vf[nt][1], pf1, o);
            }
#pragma unroll
            for (int nt = 0; nt < 16; ++nt) O[nt] += unpk4(oraw[nt]);
            __syncthreads();
        } else {
#pragma unroll
            for (int nt = 0; nt < 16; ++nt) { oraw[nt] = *(const u32x2*)(orow + 16 * nt); graw[nt] = *(const u32x2*)(grow + 16 * nt); }
#pragma unroll
            for (int nt = 0; nt < 16; ++nt) O[nt] = unpk4(oraw[nt]);
        }
        float s1 = 0.f;
#pragma unroll
        for (int nt = 0; nt < 16; ++nt) s1 += (O[nt][0] + O[nt][1]) + (O[nt][2] + O[nt][3]);
        s1 += __shfl_xor(s1, 16); s1 += __shfl_xor(s1, 32);
        const float mean = (br == 0) ? s1 * (1.0f / 256.0f) : 0.f;
        float s2 = 0.f;
#pragma unroll
        for (int nt = 0; nt < 16; ++nt) {
#pragma unroll
            for (int r = 0; r < 4; ++r) { const float dlt = O[nt][r] - mean; s2 += dlt * dlt; }
        }
        s2 += __shfl_xor(s2, 16); s2 += __shfl_xor(s2, 32);
        const float rstd = rsqrtf(s2 * (1.0f / 256.0f) + (br == 0 ? 1e-5f : 1e-6f));
        const float* gw = (br == 0 ? p.ret_norm_g : p.gla_norm_g) + h * 256 + 4 * q;
        bf16_t* yrow = Y + ((size_t)br * T_ + tok) * 1024 + h * 256 + 4 * q;
#pragma unroll
        for (int nt = 0; nt < 16; ++nt) {
            const f32x4 g = *(const f32x4*)(gw + 16 * nt);
            const f32x4 gate = unpk4(graw[nt]);
            f32x4 y;
#pragma unroll
            for (int r = 0; r < 4; ++r) y[r] = (O[nt][r] - mean) * rstd * g[r] * gate[r];
            *(u32x2*)(yrow + 16 * nt) = pk4(y);
        }
    }
}

struct EpiMerge {
    static constexpr bool PERM = true, AFTER_DRAIN = false;
    const bf16_t* Mg; bf16_t* Mrg; int pass;
    __device__ __forceinline__ void operator()(const pg8::f32x4 (&acc)[2][2][4][2], const pg8::Unit& u, int wr, int wc, int fr, int fq) const {
        const int row0 = u.pm * 256 + wr * 64 + fr, col0 = u.pn * 256 + wc * 32 + 8 * fq;
#pragma unroll
        for (int ai = 0; ai < 2; ++ai) {
            u32x4 gg[4][2], pr[4][2];
#pragma unroll
            for (int m = 0; m < 4; ++m)
#pragma unroll
                for (int bj = 0; bj < 2; ++bj) {
                    const size_t row = row0 + ai * 128 + m * 16; const int col = col0 + bj * 128;
                    gg[m][bj] = *(const u32x4*)(Mg + row * 2048 + pass * 1024 + col);
                    if (pass) pr[m][bj] = *(const u32x4*)(Mrg + row * 1024 + col);
                }
#pragma unroll
            for (int m = 0; m < 4; ++m)
#pragma unroll
                for (int bj = 0; bj < 2; ++bj) {
                    const size_t row = row0 + ai * 128 + m * 16; const int col = col0 + bj * 128;
                    f32x4 g0, g1; unpk8(gg[m][bj], g0, g1);
                    f32x4 o0 = acc[ai][bj][m][0] * g0, o1 = acc[ai][bj][m][1] * g1;
                    if (pass) { f32x4 p0, p1; unpk8(pr[m][bj], p0, p1); o0 += p0; o1 += p1; }
                    *(u32x4*)(Mrg + row * 1024 + col) = pk8(o0, o1);
                }
        }
    }
};
DEVI void phase5(const Params& p, unsigned char* smem_all) {
    pg8::StaticOrder S; S.init(T_, 1024, RG, RB);
    const bf16_t* Y = (const bf16_t*)(p.ws + OFF_Y); const bf16_t* wt = (const bf16_t*)(p.ws + OFF_WT);
    for (int pass = 0; pass < 2; ++pass) {
        pg8::Gemm g; g.A = Y + (size_t)pass * T_ * 1024; g.Bt = wt + (size_t)(pass ? WT_GLA : WT_RET) * 1024; g.M = T_; g.N = 1024; g.K = 1024;
        EpiMerge E; E.Mg = (const bf16_t*)(p.ws + OFF_MG); E.Mrg = (bf16_t*)(p.ws + OFF_MRG); E.pass = pass;
        pg8::gemm_phase<EpiMerge, pg8::StaticOrder, true, true>((PG8_LAS unsigned char*)smem_all, g, S, E);
        __syncthreads();
    }
}

struct EpiResid {
    static constexpr bool PERM = true, AFTER_DRAIN = false;
    const float* x; bf16_t* T1;
    __device__ __forceinline__ void operator()(const pg8::f32x4 (&acc)[2][2][4][2], const pg8::Unit& u, int wr, int wc, int fr, int fq) const {
        const int row0 = u.pm * 256 + wr * 64 + fr, col0 = u.pn * 256 + wc * 32 + 8 * fq;
#pragma unroll
        for (int ai = 0; ai < 2; ++ai)
#pragma unroll
            for (int m = 0; m < 4; ++m) {
                const size_t row = row0 + ai * 128 + m * 16;
                f32x4 xv[2][2];
#pragma unroll
                for (int bj = 0; bj < 2; ++bj) { xv[bj][0] = *(const f32x4*)(x + row * 1024 + col0 + bj * 128); xv[bj][1] = *(const f32x4*)(x + row * 1024 + col0 + bj * 128 + 4); }
#pragma unroll
                for (int bj = 0; bj < 2; ++bj)
                    *(u32x4*)(T1 + row * 1024 + col0 + bj * 128) = pk8(xv[bj][0] * ALPHA_ + acc[ai][bj][m][0], xv[bj][1] * ALPHA_ + acc[ai][bj][m][1]);
            }
    }
};
DEVI void phase6(const Params& p, unsigned char* smem_all) {
    pg8::StaticOrder S; S.init(T_, 1024, RG, RB);
    pg8::Gemm g; g.A = (const bf16_t*)(p.ws + OFF_MRG); g.Bt = (const bf16_t*)(p.ws + OFF_WT) + (size_t)WT_O * 1024; g.M = T_; g.N = 1024; g.K = 1024;
    EpiResid E; E.x = p.x; E.T1 = (bf16_t*)(p.ws + OFF_T1);
    pg8::gemm_phase<EpiResid, pg8::StaticOrder, true, true>((PG8_LAS unsigned char*)smem_all, g, S, E);
}

DEVI void conv_expert_weights(const Params& p, unsigned char* smem) {
    bf16_t* tile = (bf16_t*)smem;
    const int t = VT, ng = t & 31, kg = t >> 5;
    bf16_t* WGU = (bf16_t*)(p.ws + OFF_WGU); bf16_t* WD = (bf16_t*)(p.ws + OFF_WD);
    const int ntask = 257 * 3 * 32;
    for (int task = VB; task < ntask; task += VG) {
        const int e = task / 96, rem = task - e * 96, mat = rem >> 5, tl = rem & 31;
        const float* src; bf16_t* dst; int K, N, kt, nt;
        if (mat < 2) { K = 1024; N = 256; kt = tl >> 1; nt = tl & 1;
            src = (mat == 0) ? (e < 256 ? p.ew_gate + (size_t)e * 262144 : p.sw_gate) : (e < 256 ? p.ew_up + (size_t)e * 262144 : p.sw_up);
            dst = WGU + (size_t)e * 524288 + (size_t)(nt + mat) * 131072; }
        else { K = 256; N = 1024; kt = tl >> 3; nt = tl & 7;
            src = e < 256 ? p.ew_down + (size_t)e * 262144 : p.sw_down; dst = WD + (size_t)e * 262144; }
        const float* sp = src + (size_t)(kt * 64 + 4 * kg) * N + nt * 128 + 4 * ng;
        f32x4 rf[8];
#pragma unroll
        for (int i = 0; i < 4; ++i) { rf[i] = *(const f32x4*)(sp + (size_t)i * N); rf[4 + i] = *(const f32x4*)(sp + (size_t)(32 + i) * N); }
#pragma unroll
        for (int i = 0; i < 4; ++i) {
            u32x2 v0, v1;
            v0.x = pk2(rf[0][i], rf[1][i]); v0.y = pk2(rf[2][i], rf[3][i]); v1.x = pk2(rf[4][i], rf[5][i]); v1.y = pk2(rf[6][i], rf[7][i]);
            *(u32x2*)&tile[(4 * ng + i) * 72 + 4 * kg] = v0; *(u32x2*)&tile[(4 * ng + i) * 72 + 32 + 4 * kg] = v1;
        }
        __syncthreads();
        {
            const int n = t >> 1, hf = t & 1;
            bf16_t* dp = dst + (size_t)(nt * 128 + n) * K + kt * 64 + hf * 32;
#pragma unroll
            for (int j = 0; j < 4; ++j) *(u32x4*)(dp + 8 * j) = *(const u32x4*)&tile[n * 72 + hf * 32 + 8 * j];
        }
        __syncthreads();
    }
}

DEVI void phase7(const Params& p, unsigned char* smem) {
    const int t = VT, lane = t & 63, w = t >> 6;
    const bf16_t* T1 = (const bf16_t*)(p.ws + OFF_T1); bf16_t* X1b = (bf16_t*)(p.ws + OFF_X1B);
    for (int row = VB * 4 + w; row < T_; row += VG * 4) {
        f32x4 v[4]; float s = 0.f;
#pragma unroll
        for (int i = 0; i < 4; ++i) { v[i] = unpk4(*(const u32x2*)(T1 + (size_t)row * 1024 + i * 256 + lane * 4)); s += (v[i][0] + v[i][1]) + (v[i][2] + v[i][3]); }
#pragma unroll
        for (int o = 32; o > 0; o >>= 1) s += __shfl_xor(s, o);
        const float mean = s * (1.0f / 1024.0f); float s2 = 0.f;
#pragma unroll
        for (int i = 0; i < 4; ++i)
#pragma unroll
            for (int r = 0; r < 4; ++r) { const float d = v[i][r] - mean; s2 += d * d; }
#pragma unroll
        for (int o = 32; o > 0; o >>= 1) s2 += __shfl_xor(s2, o);
        const float rstd = rsqrtf(s2 * (1.0f / 1024.0f) + 1e-5f);
#pragma unroll
        for (int i = 0; i < 4; ++i) {
            const int col = i * 256 + lane * 4;
            const f32x4 g = *(const f32x4*)(p.ln1_g + col), bb = *(const f32x4*)(p.ln1_b + col);
            f32x4 y;
#pragma unroll
            for (int r = 0; r < 4; ++r) y[r] = (v[i][r] - mean) * rstd * g[r] + bb[r];
            *(u32x2*)(X1b + (size_t)row * 1024 + col) = pk4(y);
        }
    }
    conv_expert_weights(p, smem);
}

DEVI void phase8(const Params& p, unsigned char* smem) {
    GemmSmem& sm = *(GemmSmem*)smem;
    const int t = VT, lane = t & 63, w = t >> 6, wr = w >> 1, wc = w & 1, l15 = lane & 15, q = lane >> 4;
    const bf16_t* X1b = (const bf16_t*)(p.ws + OFF_X1B); const bf16_t* wt = (const bf16_t*)(p.ws + OFF_WT);
    float* LG = (float*)(p.ws + OFF_LOG);
    for (int tile = VB; tile < 256 * 2; tile += VG) {
        const int mtg = tile >> 1, ntg = tile & 1, m0 = mtg * 128, n0 = ntg * 128;
        const bf16_t* pa0 = X1b + (size_t)(m0 + (t >> 3)) * 1024 + gemm_src_chunk(t);
        const bf16_t* pb0 = wt + (size_t)(WT_R + n0 + (t >> 3)) * 1024 + gemm_src_chunk(t);
        const bf16_t* const pa[4] = {pa0, pa0 + 32 * 1024, pa0 + 64 * 1024, pa0 + 96 * 1024};
        const bf16_t* const pb[4] = {pb0, pb0 + 32 * 1024, pb0 + 64 * 1024, pb0 + 96 * 1024};
        f32x4 acc[4][4]; zero_acc(acc);
        gemm_kloop<true, 0>(acc, pa, pb, nullptr, 0, 16, sm);
#pragma unroll
        for (int mt = 0; mt < 4; ++mt)
#pragma unroll
            for (int nt = 0; nt < 4; ++nt) {
                const int row = m0 + wr * 64 + mt * 16 + l15, col = n0 + wc * 64 + (nt >> 1) * 32 + 8 * q + 4 * (nt & 1);
                *(f32x4*)(LG + (size_t)row * 256 + col) = acc[mt][nt];
            }
    }
}

DEVI unsigned f2ord(float f) { const unsigned u = __float_as_uint(f); return (u & 0x80000000u) ? ~u : (u | 0x80000000u); }
DEVI void phase9(const Params& p) {
    const int t = VT, lane = t & 63, w = t >> 6;
    const float* LG = (const float*)(p.ws + OFF_LOG);
    int* cnt = (int*)(p.ws + OFF_CNT); int* list = (int*)(p.ws + OFF_LIST); float* wts = (float*)(p.ws + OFF_WTS);
    const int tstep = VG * 4;
    int tok = VB * 4 + w;
    float lgn[4]; float rb[4];
#pragma unroll
    for (int r = 0; r < 4; ++r) { rb[r] = p.router_bias[lane + 64 * r]; lgn[r] = tok < T_ ? LG[(size_t)tok * 256 + lane + 64 * r] : 0.f; }
    int ppos = 0, pe = -1, ptk9 = 0;
    for (; tok < T_; tok += tstep) {
        float sc[4], bi[4];
#pragma unroll
        for (int r = 0; r < 4; ++r) { sc[r] = sigmoidf_(lgn[r]); bi[r] = sc[r] + rb[r]; }
        { const int tn = tok + tstep;
#pragma unroll
          for (int r = 0; r < 4; ++r) lgn[r] = tn < T_ ? LG[(size_t)tn * 256 + lane + 64 * r] : 0.f; }
        float gsc[8];
#pragma unroll
        for (int r = 0; r < 4; ++r) {
            float m1 = bi[r];
#pragma unroll
            for (int o = 16; o > 0; o >>= 1) m1 = fmaxf(m1, __shfl_xor(m1, o));
            const unsigned long long bal = __ballot(bi[r] == m1);
            const unsigned halfmask = (lane < 32) ? (unsigned)(bal & 0xffffffffull) : (unsigned)(bal >> 32);
            const int first = __ffs(halfmask) - 1;
            float m2 = ((lane & 31) == first) ? -INFINITY : bi[r];
#pragma unroll
            for (int o = 16; o > 0; o >>= 1) m2 = fmaxf(m2, __shfl_xor(m2, o));
            const float g = m1 + m2;
            gsc[2 * r] = __shfl(g, 0); gsc[2 * r + 1] = __shfl(g, 32);
        }
        unsigned selmask = 0;
#pragma unroll
        for (int g = 0; g < 8; ++g) {
            int rank = 0;
#pragma unroll
            for (int g2 = 0; g2 < 8; ++g2) rank += (gsc[g2] > gsc[g] || (gsc[g2] == gsc[g] && g2 < g)) ? 1 : 0;
            if (rank < 4) selmask |= 1u << g;
        }
        unsigned ck[4];
#pragma unroll
        for (int r = 0; r < 4; ++r) ck[r] = ((selmask >> (2 * r + (lane >> 5))) & 1u) ? f2ord(bi[r]) : 0u;
        unsigned thr = 0u;
#pragma unroll 1
        for (int bit = 31; bit >= 0; --bit) {
            const unsigned cnd = thr | (1u << bit);
            const int c8 = __popcll(__ballot(ck[0] >= cnd)) + __popcll(__ballot(ck[1] >= cnd)) + __popcll(__ballot(ck[2] >= cnd)) + __popcll(__ballot(ck[3] >= cnd));
            if (c8 >= 8) thr = cnd;
        }
        unsigned long long selm[4]; int need;
        {
            unsigned long long gt[4], eq[4]; int ngt = 0;
#pragma unroll
            for (int r = 0; r < 4; ++r) { gt[r] = __ballot(ck[r] > thr); eq[r] = __ballot(ck[r] == thr); ngt += __popcll(gt[r]); }
            need = 8 - ngt;
#pragma unroll
            for (int r = 0; r < 4; ++r) {
                unsigned long long take = 0ull, m = eq[r];
                while (m != 0ull && need > 0) { const unsigned long long low = m & (~m + 1ull); take |= low; m ^= low; --need; }
                selm[r] = gt[r] | take;
            }
        }
        float wsum = 0.f, myw = 0.f; int mye = 0, kk = 0;
#pragma unroll
        for (int r = 0; r < 4; ++r) {
            unsigned long long m = selm[r];
            while (m != 0ull) {
                const int L = __builtin_ctzll(m); m &= m - 1ull;
                const float sv = __builtin_bit_cast(float, __builtin_amdgcn_readlane(__builtin_bit_cast(int, sc[r]), L));
                wsum += sv;
                if (lane == kk) { mye = L + 64 * r; myw = sv; }
                ++kk;
            }
        }
        if (lane < 8) {
            if (pe >= 0) list[(size_t)pe * T_ + ppos] = ptk9;
            ppos = atomicAdd(&cnt[mye * CNT_STRIDE], 1); pe = mye; ptk9 = tok * 9 + lane;
            wts[(size_t)tok * 9 + lane] = myw / wsum * 2.5f;
        } else if (lane == 8) wts[(size_t)tok * 9 + 8] = 1.0f;
    }
    if (lane < 8 && pe >= 0) list[(size_t)pe * T_ + ppos] = ptk9;
}

DEVI void moe_prefix(const Params& p, int* pre  , int xg) {
    const int tid = VT;
    const int* cnt = (const int*)(p.ws + OFF_CNT);
    __syncthreads();
    if (tid < 64) {
        int v = 0;
        if (tid < 32) v = (__hip_atomic_load(&cnt[(xg + 8 * tid) * CNT_STRIDE], __ATOMIC_RELAXED, __HIP_MEMORY_SCOPE_AGENT) + 127) >> 7;
        else if (tid == 32) v = 32;
#pragma unroll
        for (int o = 1; o < 64; o <<= 1) { const int u = __shfl_up(v, o); if (tid >= o) v += u; }
        if (tid < 33) pre[tid + 1] = v;
        if (tid == 0) pre[0] = 0;
    }
    __syncthreads();
}
DEVI int moe_find(const int* pre, int mb) {
    int lo = 0, hi = 32;
    while (lo < hi) { const int mid = (lo + hi + 1) >> 1; if (pre[mid] <= mb) lo = mid; else hi = mid - 1; }
    return lo;
}
DEVI int moe_tk9(const int* list, int e, int pos) { return e < 256 ? list[(size_t)e * T_ + pos] : pos * 9 + 8; }

DEVI void moe_prefix256(const Params& p, int* pre  , int xg) {
    const int tid = threadIdx.x;
    const int* cnt = (const int*)(p.ws + OFF_CNT);
    __syncthreads();
    if (tid < 64) {
        int v = 0;
        if (tid < 32) { const int c = __hip_atomic_load(&cnt[(xg + 8 * tid) * CNT_STRIDE], __ATOMIC_RELAXED, __HIP_MEMORY_SCOPE_AGENT); ((int*)(p.ws + OFF_CNT2))[xg + 8 * tid] = c; v = (c + 255) >> 8; }
        else if (tid == 32) v = 16;
#pragma unroll
        for (int o = 1; o < 64; o <<= 1) { const int u = __shfl_up(v, o); if (tid >= o) v += u; }
        if (tid < 33) pre[tid + 1] = v;
        if (tid == 0) pre[0] = 0;
    }
    __syncthreads();
}
struct MoeSched {
    const int* pre; const int* cnt; const int* list;
    int xg, jl, nloc, nun;
    const char* Abase; int arow_bytes; bool by_token;
    const char* Bbase; size_t b_expert_bytes, b_unit_bytes;
    __device__ __forceinline__ bool next(int i, pg8::Unit& u) const { const int item = jl + i * nloc; if (item >= pre[33] * nun) return false; u.pm = item / nun; u.pn = item - u.pm * nun; return true; }
    __device__ __forceinline__ void decode(const pg8::Unit& u, int& e, int& r0, int& ce) const {
        const int gi = moe_find(pre, u.pm), mb = u.pm - pre[gi];
        e = gi < 32 ? xg + 8 * gi : 256; ce = e < 256 ? cnt[e] : T_; r0 = (e < 256 ? 0 : xg * 4096) + mb * 256;
    }
    __device__ __forceinline__ int slot(int e, int pos) const { return e < 256 ? list[(size_t)e * T_ + pos] : pos * 9 + 8; }
    __device__ __forceinline__ const char* a_base() const { return Abase; }
    __device__ __forceinline__ void a_rows(const pg8::Unit& u, const int (&rowA)[2], const int (&colA)[2], unsigned& p00, unsigned& p01, unsigned& p10, unsigned& p11) const {
        int e, r0, ce; decode(u, e, r0, ce);
        const int fb = e < 256 ? 0 : xg * 4096;
        int s4[4];
#pragma unroll
        for (int k = 0; k < 4; ++k) { int pos = r0 + (k >> 1) * 128 + rowA[k & 1]; if (pos >= ce) pos = fb; s4[k] = slot(e, pos); }
#pragma unroll
        for (int k = 0; k < 4; ++k) if (by_token) s4[k] = s4[k] / 9;
        p00 = (unsigned)s4[0] * (unsigned)arow_bytes + (unsigned)colA[0]; p01 = (unsigned)s4[1] * (unsigned)arow_bytes + (unsigned)colA[1];
        p10 = (unsigned)s4[2] * (unsigned)arow_bytes + (unsigned)colA[0]; p11 = (unsigned)s4[3] * (unsigned)arow_bytes + (unsigned)colA[1];
    }
    __device__ __forceinline__ const char* b_base(const pg8::Unit& u) const { int e, r0, ce; decode(u, e, r0, ce); return Bbase + (size_t)e * b_expert_bytes + (size_t)u.pn * b_unit_bytes; }
    __device__ __forceinline__ void a_ready(const pg8::Unit&) const {}
    __device__ __forceinline__ void done(const pg8::Unit&) const {}
};
struct EpiMoe1 {
    static constexpr bool PERM = true, AFTER_DRAIN = false;
    const MoeSched* S; bf16_t* H;
    __device__ __forceinline__ void operator()(const pg8::f32x4 (&acc)[2][2][4][2], const pg8::Unit& u, int wr, int wc, int fr, int fq) const {
        int e, r0, ce; S->decode(u, e, r0, ce);
#pragma unroll
        for (int ai = 0; ai < 2; ++ai) {
            int sl[4];
#pragma unroll
            for (int m = 0; m < 4; ++m) { const int pos = r0 + ai * 128 + wr * 64 + m * 16 + fr; sl[m] = pos < ce ? S->slot(e, pos) : -1; }
#pragma unroll
            for (int m = 0; m < 4; ++m) if (sl[m] >= 0) {
                f32x4 h0, h1;
#pragma unroll
                for (int r = 0; r < 4; ++r) { h0[r] = siluf_(acc[ai][0][m][0][r]) * acc[ai][1][m][0][r]; h1[r] = siluf_(acc[ai][0][m][1][r]) * acc[ai][1][m][1][r]; }
                *(u32x4*)(H + (size_t)sl[m] * 256 + u.pn * 128 + wc * 32 + 8 * fq) = pk8(h0, h1);
            }
            asm volatile("" ::: "memory");
        }
    }
};
struct EpiMoe2 {
    static constexpr bool PERM = true, AFTER_DRAIN = false;
    const MoeSched* S; const float* wts; unsigned char* YX;
    __device__ __forceinline__ void operator()(const pg8::f32x4 (&acc)[2][2][4][2], const pg8::Unit& u, int wr, int wc, int fr, int fq) const {
        int e, r0, ce; S->decode(u, e, r0, ce);
#pragma unroll
        for (int ai = 0; ai < 2; ++ai) {
            int sl[4]; float wg[4];
#pragma unroll
            for (int m = 0; m < 4; ++m) { const int pos = r0 + ai * 128 + wr * 64 + m * 16 + fr; sl[m] = pos < ce ? S->slot(e, pos) : -1; }
#pragma unroll
            for (int m = 0; m < 4; ++m) wg[m] = sl[m] >= 0 ? wts[sl[m]] * YX_SCALE : 0.f;
#pragma unroll
            for (int m = 0; m < 4; ++m) if (sl[m] >= 0) {
#pragma unroll
                for (int bj = 0; bj < 2; ++bj)
                    { u32x2 w8; w8.x = pk4_fp8(clamp4(acc[ai][bj][m][0] * wg[m], 440.f)); w8.y = pk4_fp8(clamp4(acc[ai][bj][m][1] * wg[m], 440.f));
                      *(u32x2*)(YX + (size_t)sl[m] * 1024 + u.pn * 256 + bj * 128 + wc * 32 + 8 * fq) = w8; }
            }
            asm volatile("" ::: "memory");
        }
    }
};
DEVI void moe_sched_init(const Params& p, MoeSched& S, int* pre) {
    S.pre = pre; S.cnt = (const int*)(p.ws + OFF_CNT2); S.list = (const int*)(p.ws + OFF_LIST);
    S.xg = RB & 7; S.jl = RB >> 3; S.nloc = RG >> 3;
}
DEVI void phase10(const Params& p, unsigned char* smem_all) {
    int* pre = (int*)(smem_all + 131072);
    MoeSched S; moe_sched_init(p, S, pre); moe_prefix256(p, pre, S.xg);
    S.nun = 2; S.Abase = (const char*)(p.ws + OFF_X1B); S.arow_bytes = 2048; S.by_token = true;
    S.Bbase = (const char*)(p.ws + OFF_WGU); S.b_expert_bytes = (size_t)512 * 1024 * 2; S.b_unit_bytes = (size_t)256 * 1024 * 2;
    EpiMoe1 E; E.S = &S; E.H = (bf16_t*)(p.ws + OFF_H);
    pg8::gemm_phase_g<EpiMoe1, MoeSched, true, true>((PG8_LAS unsigned char*)smem_all, 1024, S, E);
}
DEVI void phase11(const Params& p, unsigned char* smem_all) {
    int* pre = (int*)(smem_all + 131072);
    MoeSched S; moe_sched_init(p, S, pre); moe_prefix256(p, pre, S.xg);
    S.nun = 4; S.Abase = (const char*)(p.ws + OFF_H); S.arow_bytes = 512; S.by_token = false;
    S.Bbase = (const char*)(p.ws + OFF_WD); S.b_expert_bytes = (size_t)1024 * 256 * 2; S.b_unit_bytes = (size_t)256 * 256 * 2;
    EpiMoe2 E; E.S = &S; E.wts = (const float*)(p.ws + OFF_WTS); E.YX = (unsigned char*)(p.ws + OFF_YX);
    pg8::gemm_phase_g<EpiMoe2, MoeSched, true, true>((PG8_LAS unsigned char*)smem_all, 256, S, E);
}

DEVI void phase12(const Params& p) {
    const int t = VT, lane = t & 63, w = t >> 6;
    const bf16_t* X1b = (const bf16_t*)(p.ws + OFF_X1B); const unsigned char* YX = (const unsigned char*)(p.ws + OFF_YX);
    for (int row = VB * 4 + w; row < T_; row += VG * 4) {
        f32x4 v[4]; float s = 0.f;
#pragma unroll
        for (int i = 0; i < 4; ++i) {
            const int col = i * 256 + lane * 4;
            f32x4 a = unpk4(*(const u32x2*)(X1b + (size_t)row * 1024 + col)) * ALPHA_;
            f32x4 ys = (f32x4){0.f, 0.f, 0.f, 0.f};
#pragma unroll
            for (int k = 0; k < 9; ++k) ys += unpk4_fp8(*(const unsigned*)(YX + ((size_t)row * 9 + k) * 1024 + col));
            a += ys * (1.0f / YX_SCALE);
            v[i] = a; s += (a[0] + a[1]) + (a[2] + a[3]);
        }
#pragma unroll
        for (int o = 32; o > 0; o >>= 1) s += __shfl_xor(s, o);
        const float mean = s * (1.0f / 1024.0f); float s2 = 0.f;
#pragma unroll
        for (int i = 0; i < 4; ++i)
#pragma unroll
            for (int r = 0; r < 4; ++r) { const float d = v[i][r] - mean; s2 += d * d; }
#pragma unroll
        for (int o = 32; o > 0; o >>= 1) s2 += __shfl_xor(s2, o);
        const float rstd = rsqrtf(s2 * (1.0f / 1024.0f) + 1e-5f);
#pragma unroll
        for (int i = 0; i < 4; ++i) {
            const int col = i * 256 + lane * 4;
            const f32x4 g = *(const f32x4*)(p.ln2_g + col), bb = *(const f32x4*)(p.ln2_b + col);
            f32x4 y;
#pragma unroll
            for (int r = 0; r < 4; ++r) y[r] = (v[i][r] - mean) * rstd * g[r] + bb[r];
            *(f32x4*)(p.out + (size_t)row * 1024 + col) = y;
        }
    }
}


#define XB_TMO      128
#define XB_XCNT(j)  (256  + 64 * (j))
#define XB_XSUB(j)  (1280 + 64 * (j))
#define XB_XGEN(j)  (2304 + 64 * (j))
#define XB_TOP      3328
#define XB_TOPGEN   3392
#define XCD_BAR_WORDS 3456
#define XB_SPIN_CAP (1u << 20)
#define LAS __attribute__((address_space(3)))
DEVI unsigned xb_ld(unsigned* p)              { return __hip_atomic_load(p, __ATOMIC_RELAXED, __HIP_MEMORY_SCOPE_AGENT); }
DEVI unsigned xb_add(unsigned* p, unsigned v) { return __hip_atomic_fetch_add(p, v, __ATOMIC_RELAXED, __HIP_MEMORY_SCOPE_AGENT); }
DEVI unsigned xb_xcc_id() { return (unsigned)__builtin_amdgcn_s_getreg((3 << 11) | 20) & 0xFu; }
#define XB_SPIN(cond, bar) do { unsigned _sp = 0; while (cond) { __builtin_amdgcn_s_sleep(1); \
    if ((++_sp & 255u) == 0u) { if (xb_ld(&(bar)[XB_TMO])) break; if (_sp > XB_SPIN_CAP) { atomicAdd(&(bar)[XB_TMO], 1u); break; } } } } while (0)
struct XcdBarrier { unsigned* bar; unsigned x; volatile LAS unsigned* st; };
DEVI XcdBarrier xcd_barrier_post(unsigned* bar, volatile LAS unsigned* st) {
    XcdBarrier b; b.bar = bar; b.x = xb_xcc_id(); b.st = st;
    if (threadIdx.x == 0) st[3] = xb_add(&bar[XB_XCNT(b.x)], 1u);
    return b;
}
DEVI void xcd_barrier_complete(unsigned* bar, unsigned x, unsigned& nloc, unsigned& nx) {
    const unsigned G = gridDim.x * gridDim.y * gridDim.z;
    unsigned sum, cnt, mine, sp = 0u;
    for (;;) {
        sum = 0u; cnt = 0u; mine = 0u;
#pragma unroll
        for (unsigned j = 0; j < 16; ++j) { const unsigned c = xb_ld(&bar[XB_XCNT(j)]); sum += c; cnt += (c > 0u) ? 1u : 0u; mine = (j == x) ? c : mine; }
        if (sum == G) break;
        __builtin_amdgcn_s_sleep(1);
        if ((++sp & 255u) == 0u) { if (xb_ld(&bar[XB_TMO])) break; if (sp > XB_SPIN_CAP) { atomicAdd(&bar[XB_TMO], 1u); break; } }
    }
    nloc = mine > 0u ? mine : 1u; nx = cnt > 0u ? cnt : 1u;
}
DEVI void xcd_barrier(const XcdBarrier& b) {
    asm volatile("s_waitcnt vmcnt(0)" ::: "memory");
    __syncthreads();
    if (threadIdx.x == 0) {
        unsigned* bar = b.bar;
        __builtin_amdgcn_s_waitcnt(0);
        unsigned nloc = b.st[0], nx = b.st[1];
        if (nloc == 0u) { xcd_barrier_complete(bar, b.x, nloc, nx); b.st[0] = nloc; b.st[1] = nx; }
        const unsigned old = xb_add(&bar[XB_XSUB(b.x)], 1u);
        const unsigned gen = old / nloc;
        if (old + 1u == (gen + 1u) * nloc) {
            __builtin_amdgcn_fence(__ATOMIC_RELEASE, "agent");
            asm volatile("s_waitcnt vmcnt(0)" ::: "memory");
            const unsigned og = xb_add(&bar[XB_TOP], 1u);
            const unsigned tg = og / nx;
            if (og + 1u == (tg + 1u) * nx) xb_add(&bar[XB_TOPGEN], 1u);
            else XB_SPIN(xb_ld(&bar[XB_TOPGEN]) == tg, bar);
            __builtin_amdgcn_fence(__ATOMIC_ACQUIRE, "agent");
            xb_add(&bar[XB_XGEN(b.x)], 1u);
            asm volatile("s_waitcnt vmcnt(0)" ::: "memory");
        } else {
            XB_SPIN(xb_ld(&bar[XB_XGEN(b.x)]) == gen, bar);
            __builtin_amdgcn_fence(__ATOMIC_ACQUIRE, "agent");
            asm volatile("s_waitcnt vmcnt(0)" ::: "memory");
        }
    }
    __syncthreads();
}
constexpr size_t OFF_BAR = OFF_CNT + 131072;

#ifndef DBG
#define DBG 0
#endif
DEVI void dump_f32(const Params& p, size_t off) {
    const f32x4* src = (const f32x4*)(p.ws + off); f32x4* dst = (f32x4*)p.out;
    for (int i = blockIdx.x * 256 + threadIdx.x; i < T_ * D_ / 4; i += gridDim.x * 256) dst[i] = src[i];
}
DEVI void dump_bf16(const Params& p, size_t off, int ld, int coff) {
    const bf16_t* src = (const bf16_t*)(p.ws + off);
    for (int i = blockIdx.x * 256 + threadIdx.x; i < T_ * D_; i += gridDim.x * 256) { const int row = i >> 10, col = i & 1023; p.out[i] = bf2f(src[(size_t)row * ld + coff + col]); }
}
DEVI float flat_bf(const Params& p, size_t off, size_t n, size_t i) { const bf16_t* b = (const bf16_t*)(p.ws + off); float a = 0.f; for (size_t j = i; j < n; j += (size_t)T_ * D_) a += bf2f(b[j]); return a; }
DEVI void dump_p1(const Params& p) {
    const size_t N = (size_t)T_ * D_;
    for (size_t i = (size_t)blockIdx.x * 256 + threadIdx.x; i < N; i += (size_t)gridDim.x * 256) {
        float a = 0.f;
        a += flat_bf(p, OFF_MG, 2 * N, i) + flat_bf(p, OFF_GS, 2 * N, i);
        a += flat_bf(p, OFF_QR, N / 2, i % (N / 2)) + flat_bf(p, OFF_KR, N / 2, i % (N / 2)) + flat_bf(p, OFF_QG, N / 2, i % (N / 2));
        a += flat_bf(p, OFF_KRT, N / 2, i % (N / 2)) + flat_bf(p, OFF_KGT, N / 2, i % (N / 2));
        a += flat_bf(p, OFF_VRT, N, i) + flat_bf(p, OFF_VGT, N, i);
        a += ((const float*)(p.ws + OFF_GA))[i % ((size_t)T_ * 16)];
        p.out[i] = a;
    }
}
constexpr int NPHASE = 13;
__global__ void __launch_bounds__(512, 2) fwd_megakernel(Params p) {
    unsigned char* const smem_all = smem_all_g;
    unsigned char* smem = smem_all + VH * SMEM_HALF;
    uint4* xb_words = (uint4*)(smem_all + 2 * SMEM_HALF - 16);
    if (threadIdx.x == 0) *xb_words = make_uint4(0u, 0u, blockIdx.x, 0u);
    __syncthreads();
    const XcdBarrier xb = xcd_barrier_post((unsigned*)(p.ws + OFF_BAR), (volatile LAS unsigned*)xb_words);
#ifndef REPMASK
#define REPMASK 0
#endif
#ifndef TIMEPHASE
#define TIMEPHASE -1
#endif
#define RUN_PHASE(K, CALL) do { if (p.phase_lo <= (K) && (K) < p.phase_hi) { \
        const unsigned long long tp0_ = (TIMEPHASE == (K)) ? __builtin_amdgcn_s_memrealtime() : 0ull; \
        _Pragma("unroll 1") for (int rep_ = ((REPMASK >> (K)) & 1); rep_ >= 0; --rep_) { CALL; if (rep_ > 0 || (K) + 1 < p.phase_hi) xcd_barrier(xb); } \
        if (TIMEPHASE == (K)) { const unsigned long long tp1_ = __builtin_amdgcn_s_memrealtime(); while (__builtin_amdgcn_s_memrealtime() - tp1_ < tp1_ - tp0_) __builtin_amdgcn_s_sleep(8); } } } while (0)
    RUN_PHASE(0, phase0(p, smem));
    if (p.phase_lo == 0 && p.phase_hi > 1) {
        if (threadIdx.x == 0) {
            unsigned* bar = (unsigned*)(p.ws + OFF_BAR); bool ok = (gridDim.x & 7u) == 0u && xb.x < 8u;
            for (unsigned j = 0; j < 16; ++j) { const unsigned c = xb_ld(&bar[XB_XCNT(j)]); ok = ok && (j < 8 ? c == gridDim.x / 8u : c == 0u); }
            if (ok) ((volatile int*)xb_words)[2] = (int)(((volatile unsigned*)xb_words)[3] * 8u + xb.x);
        }
        __syncthreads();
    }
    RUN_PHASE(1, phase1(p, smem_all));
#if DBG == 2
    dump_p1(p); return;
#endif
    RUN_PHASE(2, phase2(p, smem));
#if DBG == 5
    { const size_t N = (size_t)T_ * D_; for (size_t i = (size_t)blockIdx.x * 256 + threadIdx.x; i < N; i += (size_t)gridDim.x * 256) p.out[i] = flat_bf(p, OFF_KG2, N / 2, i % (N / 2)) + ((const float*)(p.ws + OFF_DEC))[i % (2048 * 128)]; } return;
#endif
#ifdef SCANPROBE
    phase3t(p, smem, 1); xcd_barrier(xb);
#endif
    RUN_PHASE(3, phase3t(p, smem, 0));
#if DBG == 6
    dump_bf16(p, OFF_OO, 2048, 1024); return;
#endif
#if DBG == 7
    { const bf16_t* src = (const bf16_t*)(p.ws + OFF_OO);
      for (int i = blockIdx.x * 256 + threadIdx.x; i < T_ * D_; i += gridDim.x * 256) { const int row = i >> 10, col = i & 1023; const float v = bf2f(src[(size_t)row * 2048 + 1024 + col]); p.out[i] = (fabsf(v) < 1e30f) ? v : 12345.0f; } } return;
#endif
    RUN_PHASE(4, phase4(p, smem));
#if DBG == 3
    dump_bf16(p, OFF_Y, 2048, 0); return;
#endif
#if DBG == 4
    dump_bf16(p, OFF_Y, 2048, 1024); return;
#endif
    RUN_PHASE(5, phase5(p, smem_all));
    RUN_PHASE(6, phase6(p, smem_all));
    RUN_PHASE(7, phase7(p, smem));
#if DBG == 1
    return;
#endif
    RUN_PHASE(8, phase8(p, smem));
    RUN_PHASE(9, phase9(p));
    RUN_PHASE(10, phase10(p, smem_all));
    RUN_PHASE(11, phase11(p, smem_all));
    RUN_PHASE(12, phase12(p));
#undef RUN_PHASE
}

extern "C" void kernel_launch(void* const* d_in, const int* in_sizes, int n_in, void* d_out, int out_size, void* d_ws, size_t ws_size,
                              hipStream_t stream) {
    static int grid_blocks = 0;
    if (!grid_blocks) {
        int dev = 0, cus = 0, per_cu = 0;
        hipGetDevice(&dev);
        hipDeviceGetAttribute(&cus, hipDeviceAttributeMultiprocessorCount, dev);
        hipOccupancyMaxActiveBlocksPerMultiprocessor(&per_cu, fwd_megakernel, 512, 0);
        if (per_cu > 1) per_cu = 1;
        if (per_cu < 1) per_cu = 1;
        grid_blocks = cus * per_cu;
    }
    if (ws_size < WS_NEEDED) { fprintf(stderr, "workspace too small: %zu < %zu\n", ws_size, (size_t)WS_NEEDED); return; }
    Params p{};
    p.x = (const float*)d_in[0]; p.w_in = (const float*)d_in[1]; p.ret_norm_g = (const float*)d_in[2]; p.gate_w2 = (const float*)d_in[3];
    p.gate_b = (const float*)d_in[4]; p.gla_norm_g = (const float*)d_in[5]; p.w_ret_out = (const float*)d_in[6]; p.w_gla_out = (const float*)d_in[7];
    p.w_o = (const float*)d_in[8]; p.ln1_g = (const float*)d_in[9]; p.ln1_b = (const float*)d_in[10]; p.router_w = (const float*)d_in[11];
    p.router_bias = (const float*)d_in[12]; p.ew_gate = (const float*)d_in[13]; p.ew_up = (const float*)d_in[14]; p.ew_down = (const float*)d_in[15];
    p.sw_gate = (const float*)d_in[16]; p.sw_up = (const float*)d_in[17]; p.sw_down = (const float*)d_in[18]; p.ln2_g = (const float*)d_in[19];
    p.ln2_b = (const float*)d_in[20];
    p.out = (float*)d_out; p.ws = (unsigned char*)d_ws; p.phase_lo = 0; p.phase_hi = NPHASE;
    void* args[] = {&p};
    (void)hipMemsetAsync((unsigned char*)d_ws + OFF_BAR, 0, XCD_BAR_WORDS * 4, stream);
    hipError_t e = hipLaunchCooperativeKernel((void*)fwd_megakernel, dim3(grid_blocks), dim3(512), args, 0, stream);
    if (e != hipSuccess) fprintf(stderr, "cooperative launch failed: %s (grid %d)\n", hipGetErrorString(e), grid_blocks);
}
```

```cpp
#include <hip/hip_runtime.h>
#include <hip/hip_cooperative_groups.h>
#include <cstdio>
#include <cstdint>
namespace cg = cooperative_groups;

typedef unsigned short bf16_t;
typedef short bf16x8 __attribute__((ext_vector_type(8)));
typedef float f32x4 __attribute__((ext_vector_type(4)));
typedef unsigned u32x2 __attribute__((ext_vector_type(2)));
typedef unsigned u32x4 __attribute__((ext_vector_type(4)));
#define DEVI __device__ __forceinline__
#define VH ((int)(threadIdx.x >> 8))
#define VT ((int)(threadIdx.x & 255))
#define RB (__builtin_amdgcn_readfirstlane(((const int*)(smem_all_g + 2 * SMEM_HALF - 16))[2]))
#define RG ((int)gridDim.x)
#define VB (RB * 2 + VH)
#define VG (RG * 2)

constexpr int T_ = 32768;
constexpr int D_ = 1024;
constexpr int DIN_ = 8208;
constexpr int NE_ = 256;
constexpr float ALPHA_ = 1.189207115002721f;
constexpr float KSCALE_ = 0.08838834764831845f;

constexpr size_t MB = 1ull << 20;
constexpr size_t OFF_CNT  = (size_t)766 << 20;
constexpr int CNT_STRIDE = 1024;
constexpr size_t OFF_CNT2 = 65536;
constexpr size_t OFF_CS   = 1 * MB;
constexpr size_t OFF_WT   = 3 * MB;
constexpr size_t FB = 27 * MB;
constexpr size_t OFF_QR   = FB + 0 * MB;
constexpr size_t OFF_KR   = FB + 32 * MB;
constexpr size_t OFF_VRT  = FB + 64 * MB;
constexpr size_t OFF_GS   = FB + 128 * MB;
constexpr size_t OFF_MG   = FB + 256 * MB;
constexpr size_t OFF_KRT  = FB + 384 * MB;
constexpr size_t OFF_QG   = FB + 416 * MB;
constexpr size_t OFF_VGT  = FB + 448 * MB;
constexpr size_t OFF_KGT  = FB + 512 * MB;
constexpr size_t OFF_GA   = FB + 544 * MB;
constexpr size_t OFF_XB   = FB + 546 * MB;
constexpr size_t OFF_KG2  = FB + 546 * MB;
constexpr size_t OFF_DEC  = FB + 578 * MB;
constexpr size_t OFF_OO   = FB + 579 * MB;
constexpr size_t OFF_Y    = FB + 384 * MB;
constexpr size_t OFF_MRG  = FB + 0 * MB;
constexpr size_t OFF_QGN  = 767 * MB;
constexpr size_t OFF_QFR  = 734 * MB;
constexpr size_t OFF_WGU  = 767 * MB;
constexpr size_t OFF_X1B  = FB + 0 * MB;
constexpr size_t OFF_WD   = FB + 64 * MB;
constexpr size_t OFF_LIST = FB + 193 * MB;
constexpr size_t OFF_WTS  = FB + 225 * MB;
constexpr size_t OFF_H    = FB + 227 * MB;
constexpr size_t OFF_YX   = FB + 371 * MB;
constexpr size_t OFF_T1   = FB + 371 * MB;
constexpr size_t OFF_LOG  = FB + 435 * MB;
constexpr size_t WS_NEEDED = 1024 * MB;

constexpr int WT_BN = 0, WT_AT = 5888, WT_RET = 8960, WT_GLA = 9984, WT_O = 11008, WT_R = 12032, WT_ROWS = 12288;

struct Params {
    const float *x, *w_in, *ret_norm_g, *gate_w2, *gate_b, *gla_norm_g, *w_ret_out, *w_gla_out, *w_o, *ln1_g, *ln1_b,
                *router_w, *router_bias, *ew_gate, *ew_up, *ew_down, *sw_gate, *sw_up, *sw_down, *ln2_g, *ln2_b;
    float* out;
    unsigned char* ws;
    int phase_lo, phase_hi;
};

static __device__ const float c_inv_freq[64] = {
  1.000000000e+00f, 8.659643531e-01f, 7.498942018e-01f, 6.493816376e-01f,
  5.623413324e-01f, 4.869675338e-01f, 4.216965139e-01f, 3.651741147e-01f,
  3.162277639e-01f, 2.738419771e-01f, 2.371373773e-01f, 2.053525001e-01f,
  1.778279394e-01f, 1.539926529e-01f, 1.333521456e-01f, 1.154781953e-01f,
  1.000000015e-01f, 8.659642935e-02f, 7.498942316e-02f, 6.493816525e-02f,
  5.623413250e-02f, 4.869675264e-02f, 4.216964915e-02f, 3.651741147e-02f,
  3.162277490e-02f, 2.738419548e-02f, 2.371373773e-02f, 2.053525113e-02f,
  1.778279431e-02f, 1.539926510e-02f, 1.333521400e-02f, 1.154781971e-02f,
  9.999999776e-03f, 8.659643121e-03f, 7.498942316e-03f, 6.493816152e-03f,
  5.623413250e-03f, 4.869675264e-03f, 4.216964822e-03f, 3.651741194e-03f,
  3.162277630e-03f, 2.738419687e-03f, 2.371373819e-03f, 2.053525066e-03f,
  1.778279431e-03f, 1.539926510e-03f, 1.333521446e-03f, 1.154782018e-03f,
  1.000000047e-03f, 8.659643354e-04f, 7.498941850e-04f, 6.493816036e-04f,
  5.623413017e-04f, 4.869675322e-04f, 4.216965172e-04f, 3.651741135e-04f,
  3.162277571e-04f, 2.738419571e-04f, 2.371373703e-04f, 2.053525095e-04f,
  1.778279402e-04f, 1.539926598e-04f, 1.333521504e-04f, 1.154782003e-04f };

DEVI float bf2f(unsigned short u) { return __uint_as_float(((unsigned)u) << 16); }
DEVI float bflo(unsigned u) { return __uint_as_float(u << 16); }
DEVI float bfhi(unsigned u) { return __uint_as_float(u & 0xffff0000u); }
typedef float f32x2 __attribute__((ext_vector_type(2)));
typedef __bf16 bf16x2_t __attribute__((ext_vector_type(2)));
DEVI unsigned pk2(float lo, float hi) { const f32x2 v = {lo, hi}; const bf16x2_t b = __builtin_convertvector(v, bf16x2_t); return __builtin_bit_cast(unsigned, b); }
DEVI unsigned short f2bf(float f) { return (unsigned short)(pk2(f, 0.f) & 0xffffu); }
DEVI u32x2 pk4(f32x4 v) { u32x2 r; r.x = pk2(v[0], v[1]); r.y = pk2(v[2], v[3]); return r; }
DEVI f32x4 unpk4(u32x2 u) { f32x4 r; r[0] = bflo(u.x); r[1] = bfhi(u.x); r[2] = bflo(u.y); r[3] = bfhi(u.y); return r; }
constexpr float YX_SCALE = 16.0f;
DEVI unsigned pk4_fp8(f32x4 v) { int w = 0; w = __builtin_amdgcn_cvt_pk_fp8_f32(v[0], v[1], w, false); w = __builtin_amdgcn_cvt_pk_fp8_f32(v[2], v[3], w, true); return (unsigned)w; }
DEVI f32x4 unpk4_fp8(unsigned u) { f32x4 r; r[0] = __builtin_amdgcn_cvt_f32_fp8((int)u, 0); r[1] = __builtin_amdgcn_cvt_f32_fp8((int)u, 1); r[2] = __builtin_amdgcn_cvt_f32_fp8((int)u, 2); r[3] = __builtin_amdgcn_cvt_f32_fp8((int)u, 3); return r; }
DEVI f32x4 clamp4(f32x4 v, float lim) { f32x4 r; for (int i = 0; i < 4; ++i) r[i] = fminf(fmaxf(v[i], -lim), lim); return r; }
DEVI float sigmoidf_(float v) { return 1.0f / (1.0f + __expf(-v)); }
DEVI float siluf_(float v) { return v / (1.0f + __expf(-v)); }
DEVI float gamma_log2(int h) { return log2f(1.0f - exp2f(-5.0f - (float)h)); }
DEVI f32x4 mfma16(bf16x8 a, bf16x8 b, f32x4 c) { return __builtin_amdgcn_mfma_f32_16x16x32_bf16(a, b, c, 0, 0, 0); }
DEVI unsigned kf_off(int item, int dk, int m8) { return ((((unsigned)item * 4u + (unsigned)(dk >> 5)) * 4u + (unsigned)(m8 >> 4)) * 64u + (unsigned)((m8 >> 3) & 1) * 32u + (unsigned)(dk & 31)) * 8u; }
DEVI unsigned vf_off(int item, int dv, int m8) { return ((((unsigned)item * 8u + (unsigned)(dv >> 5)) * 4u + (unsigned)(m8 >> 4)) * 64u + (unsigned)((m8 >> 3) & 1) * 32u + (unsigned)(dv & 31)) * 8u; }
DEVI unsigned qf_off(int bc, int h, int tokl, int dk8, int hh) {
    return ((((((unsigned)bc * 4u + (unsigned)h) * 2u + (unsigned)(tokl >> 5)) * 4u + (unsigned)(dk8 >> 5)) * 2u + (unsigned)((dk8 >> 4) & 1)) * 64u + (unsigned)hh * 32u + (unsigned)(tokl & 31)) * 8u + (unsigned)((dk8 >> 3) & 1) * 4u; }
DEVI int vperm(int n) { const int wc = n >> 6, nt = (n >> 4) & 3, i = n & 15; return wc * 64 + (nt >> 1) * 32 + 8 * (i >> 2) + 4 * (nt & 1) + (i & 3); }
DEVI int dperm2(int v) { return ((v >> 5) & 1) * 64 + (v >> 6) * 32 + (v & 31); }
DEVI u32x4 pk8(f32x4 a, f32x4 b) { u32x4 r; r.x = pk2(a[0], a[1]); r.y = pk2(a[2], a[3]); r.z = pk2(b[0], b[1]); r.w = pk2(b[2], b[3]); return r; }
DEVI void unpk8(u32x4 u, f32x4& a, f32x4& b) { a[0] = bflo(u.x); a[1] = bfhi(u.x); a[2] = bflo(u.y); a[3] = bfhi(u.y); b[0] = bflo(u.z); b[1] = bfhi(u.z); b[2] = bflo(u.w); b[3] = bfhi(u.w); }
DEVI int dperm(int v) { const int wc = v >> 6, nt = (v >> 4) & 3, c = v & 15; return (nt & 1) * 16 + wc * 32 + c + (nt >> 1) * 64; }

struct __attribute__((aligned(16))) GemmSmem { bf16_t a[2][128 * 64]; bf16_t b[2][128 * 64]; };
constexpr int SMEM_GEMM = sizeof(GemmSmem);
constexpr int SMEM_BYTES = SMEM_GEMM + 2048 + 16;
constexpr int SMEM_HALF = (SMEM_BYTES + 255) & ~255;
__shared__ __attribute__((aligned(16))) unsigned char smem_all_g[2 * SMEM_HALF];
DEVI int gemm_src_chunk(int t) { return ((t & 7) ^ ((t >> 4) & 7)) * 8; }

template <bool SWAP, int BKIND>
DEVI void gemm_kloop(f32x4 (&acc)[4][4], const bf16_t* const (&pa)[4], const bf16_t* const (&pb)[4],
                     const float* pbf, int ldb, int nk, GemmSmem& sm) {
    const int t = VT, lane = t & 63, w = t >> 6, wr = w >> 1, wc = w & 1, l15 = lane & 15, q = lane >> 4;
    const int kg = t & 7, ng = t >> 3;
    f32x4 rf[8];
#define GEMM_ISSUE(BUF, KO) do { \
        _Pragma("unroll") for (int i = 0; i < 4; ++i) \
            __builtin_amdgcn_global_load_lds((const unsigned*)(pa[i] + (KO)), (unsigned*)((char*)sm.a[BUF] + i * 4096 + t * 16), 16, 0, 0); \
        if (BKIND == 0) { _Pragma("unroll") for (int i = 0; i < 4; ++i) \
            __builtin_amdgcn_global_load_lds((const unsigned*)(pb[i] + (KO)), (unsigned*)((char*)sm.b[BUF] + i * 4096 + t * 16), 16, 0, 0); } \
        else { const float* pp = pbf + (size_t)((KO) + 4 * kg) * ldb; \
            _Pragma("unroll") for (int i = 0; i < 4; ++i) { rf[i] = *(const f32x4*)(pp + (size_t)i * ldb); rf[4 + i] = *(const f32x4*)(pp + (size_t)(32 + i) * ldb); } } } while (0)
#define GEMM_LSTORE_B(BUF) do { if (BKIND == 1) { \
            _Pragma("unroll") for (int i = 0; i < 4; ++i) { \
                u32x2 v0, v1; \
                v0.x = pk2(rf[0][i], rf[1][i]); v0.y = pk2(rf[2][i], rf[3][i]); v1.x = pk2(rf[4][i], rf[5][i]); v1.y = pk2(rf[6][i], rf[7][i]); \
                const int n = 4 * ng + i, sw = (n >> 1) & 7; \
                char* rowp = (char*)sm.b[BUF] + n * 128 + (kg & 1) * 8; \
                *(u32x2*)(rowp + (((kg >> 1) ^ sw) * 16)) = v0; *(u32x2*)(rowp + (((4 + (kg >> 1)) ^ sw) * 16)) = v1; } } } while (0)
    GEMM_ISSUE(0, 0);
    GEMM_LSTORE_B(0);
    __syncthreads();
#define GEMM_KSTEP(CUR, KT) do { \
        const bool more = ((KT) + 1 < nk); \
        if (more) { GEMM_ISSUE((CUR) ^ 1, ((KT) + 1) * 64); } \
        __builtin_amdgcn_sched_barrier(0); \
        _Pragma("unroll") for (int ss = 0; ss < 2; ++ss) { \
            bf16x8 af[4], bfr[4]; \
            const int coff = ((ss * 4 + q) ^ (l15 >> 1)) * 16; \
            _Pragma("unroll") for (int i = 0; i < 4; ++i) { \
                af[i]  = *(const bf16x8*)((const char*)sm.a[CUR] + (wr * 64 + i * 16 + l15) * 128 + coff); \
                bfr[i] = *(const bf16x8*)((const char*)sm.b[CUR] + (wc * 64 + i * 16 + l15) * 128 + coff); } \
            _Pragma("unroll") for (int mt = 0; mt < 4; ++mt) \
                _Pragma("unroll") for (int nt = 0; nt < 4; ++nt) \
                    acc[mt][nt] = SWAP ? mfma16(bfr[nt], af[mt], acc[mt][nt]) : mfma16(af[mt], bfr[nt], acc[mt][nt]); } \
        __builtin_amdgcn_sched_barrier(0); \
        if (more) { GEMM_LSTORE_B((CUR) ^ 1); } \
        __syncthreads(); } while (0)
#pragma unroll 1
    for (int kt = 0; kt < nk; kt += 2) { GEMM_KSTEP(0, kt); GEMM_KSTEP(1, kt + 1); }
#undef GEMM_KSTEP
#undef GEMM_LSTORE_B
#undef GEMM_ISSUE
}

DEVI void zero_acc(f32x4 (&acc)[4][4]) {
#pragma unroll
    for (int i = 0; i < 4; ++i)
#pragma unroll
        for (int j = 0; j < 4; ++j) acc[i][j] = (f32x4){0.f, 0.f, 0.f, 0.f};
}

namespace pg8 {
#define PG8_LAS __attribute__((address_space(3)))
typedef unsigned short bf16_t;
typedef short bf16x8 __attribute__((ext_vector_type(8)));
typedef float f32x4 __attribute__((ext_vector_type(4)));
typedef unsigned u32x4 __attribute__((ext_vector_type(4)));
constexpr int BM = 256, BK = 64, HALF = 128, HTB = HALF * BK * 2  , STAGE_BYTES = 8 * HTB, NXCD = 8, WGM = 8;

__host__ __device__ __forceinline__ int lds_byte(int r, int c) { const int st = (r >> 4) * 2 + (c >> 5), rr = r & 15, cc = c & 31, ob = rr * 64 + cc * 2; return st * 1024 + (ob ^ (((ob >> 9) & 1) << 5)); }
__host__ __device__ __forceinline__ void stage_rc(int b, int& R, int& C) { const int st = b / 1024, sb = b % 1024, swz = sb ^ (((sb >> 9) & 1) << 5); R = (st >> 1) * 16 + swz / 64; C = (st & 1) * 32 + (swz % 64) / 2; }
__host__ __device__ __forceinline__ int perm32(int rho) { const int n = rho >> 4, i = rho & 15; return 8 * (i >> 2) + 4 * n + (i & 3); }

struct Unit { int pm, pn; };
struct Gemm { const bf16_t* A; const bf16_t* Bt; int M, N, K; };

struct StaticOrder {
    int nM, nN, nwg, G, c;
    __host__ __device__ void init(int M, int N, int G_, int c_) { nM = M / BM; nN = N / BM; nwg = nM * nN; G = G_; c = c_; }
    __host__ __device__ bool next(int i, Unit& u) const {
        const long L = (long)i * G + c; if (L >= nwg) return false;
        int wgid = (int)L; { const int q = nwg / NXCD, r = nwg % NXCD, xcd = wgid % NXCD, off = wgid / NXCD; wgid = (xcd < r ? xcd * (q + 1) : r * (q + 1) + (xcd - r) * q) + off; }
        const int nig = WGM * nN, gid = wgid / nig, fm = gid * WGM, gsz = (nM - fm) < WGM ? (nM - fm) : WGM;
        u.pm = fm + ((wgid % nig) % gsz); u.pn = (wgid % nig) / gsz; return true;
    }
    __device__ __forceinline__ void a_ready(const Unit&) const {}
    __device__ __forceinline__ void done(const Unit&) const {}
};


template <class Epi, class Sched, bool ALIGN_EPI = false, bool SP2 = false>
__device__ __forceinline__ void gemm_phase(PG8_LAS unsigned char* lds, const Gemm g, const Sched& S, const Epi& E) {
    const int tid = threadIdx.x, wid = __builtin_amdgcn_readfirstlane(tid >> 6), lane = tid & 63, wr = wid >> 2, wc = wid & 3, fr = lane & 15, fq = lane >> 4;
    const int K = g.K, nt = K / BK;
    unsigned voffA[2], voffB[2];
#pragma unroll
    for (int i = 0; i < 2; ++i) { int R, C; stage_rc(tid * 16 + i * 8192, R, C); const int Rb = Epi::PERM ? ((R & ~31) + perm32(R & 31)) : R;
        voffA[i] = (unsigned)(R * K + C) * 2u; voffB[i] = (unsigned)(Rb * K + C) * 2u; }
    const size_t kstep = (size_t)(BK * 2);
    const size_t hstep = (size_t)HALF * K * 2;
    const size_t tstep = 2 * hstep;
    const unsigned ldsw = (unsigned)wid * 1024u;
    const int aoff = lds_byte(wr * 64 + fr, fq * 8), boff = lds_byte(wc * 32 + fr, fq * 8);
#define PG8_SA(b, h) (((b) * 2 + (h)) * HTB)
#define PG8_SB(b, h) ((4 + (b) * 2 + (h)) * HTB)
#define PG8_STAGE(bufoff, gbase, voff) do { _Pragma("unroll") for (int _i = 0; _i < 2; ++_i) \
        __builtin_amdgcn_global_load_lds((const unsigned*)((const char*)(gbase) + (voff)[_i]), (PG8_LAS unsigned*)(lds + (bufoff) + ldsw + _i * 8192), 16, 0, 0); } while (0)
#define PG8_LDA(dst, b, h) do { _Pragma("unroll") for (int m = 0; m < 4; ++m) _Pragma("unroll") for (int k = 0; k < 2; ++k) dst[m][k] = *(const PG8_LAS bf16x8*)(lds + PG8_SA(b, h) + aoff + m * 2048 + k * 1024); } while (0)
#define PG8_LDB(dst, b, h) do { _Pragma("unroll") for (int n = 0; n < 2; ++n) _Pragma("unroll") for (int k = 0; k < 2; ++k) dst[n][k] = *(const PG8_LAS bf16x8*)(lds + PG8_SB(b, h) + boff + n * 2048 + k * 1024); } while (0)
#define PG8_MMA(ai, bj, At, Bt) do { __builtin_amdgcn_s_setprio(1); _Pragma("unroll") for (int m = 0; m < 4; ++m) _Pragma("unroll") for (int n = 0; n < 2; ++n) _Pragma("unroll") for (int k = 0; k < 2; ++k) \
        acc[ai][bj][m][n] = __builtin_amdgcn_mfma_f32_16x16x32_bf16(Bt[n][k], At[m][k], acc[ai][bj][m][n], 0, 0, 0); __builtin_amdgcn_s_setprio(0); } while (0)
#define PG8_WAIT_V(n) asm volatile("s_waitcnt vmcnt(" #n ")" ::: "memory")
#define PG8_WAIT_L(n) asm volatile("s_waitcnt lgkmcnt(" #n ")" ::: "memory")
#define PG8_BAR __builtin_amdgcn_s_barrier()
#define PG8_SCHED __builtin_amdgcn_sched_barrier(0)
    Unit cur, nxt; int ui = 0;
    if (!S.next(0, cur)) return;
    f32x4 acc[2][2][4][2];
#pragma unroll
    for (int a = 0; a < 2; ++a)
#pragma unroll
        for (int b = 0; b < 2; ++b)
#pragma unroll
            for (int m = 0; m < 4; ++m)
#pragma unroll
                for (int n = 0; n < 2; ++n) acc[a][b][m][n] = (f32x4){0.f, 0.f, 0.f, 0.f};
    bf16x8 At[4][2], B0[2][2], B1[2][2];
    const char* cA = (const char*)g.A + (size_t)cur.pm * tstep; const char* cB = (const char*)g.Bt + (size_t)cur.pn * tstep;
    S.a_ready(cur);
    if constexpr (SP2) {
        PG8_STAGE(PG8_SB(0, 0), cB, voffB); PG8_STAGE(PG8_SB(0, 1), cB + hstep, voffB); PG8_STAGE(PG8_SA(0, 0), cA, voffA); PG8_STAGE(PG8_SA(0, 1), cA + hstep, voffA);
        if (wr == 1) PG8_BAR;
        PG8_WAIT_V(2); PG8_BAR;
        PG8_STAGE(PG8_SB(1, 0), cB + kstep, voffB); PG8_STAGE(PG8_SA(1, 0), cA + kstep, voffA); PG8_STAGE(PG8_SB(1, 1), cB + hstep + kstep, voffB);
        PG8_WAIT_V(6); PG8_BAR;
    } else {
        PG8_STAGE(PG8_SB(0, 0), cB, voffB); PG8_STAGE(PG8_SA(0, 0), cA, voffA); PG8_STAGE(PG8_SB(0, 1), cB + hstep, voffB); PG8_STAGE(PG8_SA(0, 1), cA + hstep, voffA);
        if (wr == 1) PG8_BAR;
        PG8_WAIT_V(4); PG8_BAR;
        PG8_STAGE(PG8_SB(1, 0), cB + kstep, voffB); PG8_STAGE(PG8_SA(1, 0), cA + kstep, voffA); PG8_STAGE(PG8_SB(1, 1), cB + hstep + kstep, voffB);
        PG8_WAIT_V(6); PG8_BAR;
    }
    for (;;) {
        const bool has_next = S.next(ui + 1, nxt);
        const char* nA = has_next ? (const char*)g.A + (size_t)nxt.pm * tstep : cA; const char* nB = has_next ? (const char*)g.Bt + (size_t)nxt.pn * tstep : cB;
        for (int t = 0; t < nt; t += 2) {
            const bool last = (t == nt - 2);
            const char* a1 = cA + (size_t)(t + 1) * kstep;
            const char* a2 = last ? nA : cA + (size_t)(t + 2) * kstep; const char* b2 = last ? nB : cB + (size_t)(t + 2) * kstep;
            const char* a3 = a2 + kstep; const char* b3 = b2 + kstep;
            if (last && has_next) S.a_ready(nxt);
            if constexpr (SP2) {
            PG8_LDB(B0, 0, 0); PG8_LDB(B1, 0, 1); PG8_SCHED; PG8_LDA(At, 0, 0); PG8_STAGE(PG8_SA(1, 1), a1 + hstep, voffA);
            PG8_WAIT_V(8); PG8_WAIT_L(0); PG8_BAR; PG8_MMA(0, 0, At, B0); PG8_MMA(0, 1, At, B1); PG8_BAR; PG8_SCHED;
            PG8_LDA(At, 0, 1); PG8_STAGE(PG8_SB(0, 0), b2, voffB); PG8_STAGE(PG8_SB(0, 1), b2 + hstep, voffB); PG8_STAGE(PG8_SA(0, 0), a2, voffA);
            PG8_WAIT_V(8); PG8_WAIT_L(0); PG8_BAR; PG8_MMA(1, 0, At, B0); PG8_MMA(1, 1, At, B1); PG8_BAR; PG8_SCHED;
            PG8_LDB(B0, 1, 0); PG8_LDB(B1, 1, 1); PG8_SCHED; PG8_LDA(At, 1, 0); PG8_STAGE(PG8_SA(0, 1), a2 + hstep, voffA);
            PG8_WAIT_V(8); PG8_WAIT_L(0); PG8_BAR; PG8_MMA(0, 0, At, B0); PG8_MMA(0, 1, At, B1); PG8_BAR; PG8_SCHED;
            PG8_LDA(At, 1, 1); PG8_STAGE(PG8_SB(1, 0), b3, voffB); PG8_STAGE(PG8_SB(1, 1), b3 + hstep, voffB); PG8_STAGE(PG8_SA(1, 0), a3, voffA);
            PG8_WAIT_V(8); PG8_WAIT_L(0); PG8_BAR; PG8_MMA(1, 0, At, B0); PG8_MMA(1, 1, At, B1); PG8_BAR; PG8_SCHED;
            } else {
            PG8_LDB(B0, 0, 0); PG8_SCHED; PG8_LDA(At, 0, 0); PG8_STAGE(PG8_SA(1, 1), a1 + hstep, voffA);
            PG8_WAIT_L(8); PG8_BAR; PG8_WAIT_L(0); PG8_MMA(0, 0, At, B0); PG8_BAR; PG8_SCHED;
            PG8_LDB(B1, 0, 1); PG8_STAGE(PG8_SB(0, 0), b2, voffB);
            PG8_BAR; PG8_WAIT_L(0); PG8_MMA(0, 1, At, B1); PG8_BAR;
            PG8_LDA(At, 0, 1); PG8_STAGE(PG8_SA(0, 0), a2, voffA);
            PG8_BAR; PG8_WAIT_L(0); PG8_MMA(1, 0, At, B0); PG8_BAR; PG8_SCHED;
            PG8_STAGE(PG8_SB(0, 1), b2 + hstep, voffB);
            PG8_WAIT_V(6); PG8_BAR; PG8_MMA(1, 1, At, B1); PG8_BAR;
            PG8_LDB(B0, 1, 0); PG8_SCHED; PG8_LDA(At, 1, 0); PG8_STAGE(PG8_SA(0, 1), a2 + hstep, voffA);
            PG8_WAIT_L(8); PG8_BAR; PG8_WAIT_L(0); PG8_MMA(0, 0, At, B0); PG8_BAR; PG8_SCHED;
            PG8_LDB(B1, 1, 1); PG8_STAGE(PG8_SB(1, 0), b3, voffB);
            PG8_BAR; PG8_WAIT_L(0); PG8_MMA(0, 1, At, B1); PG8_BAR;
            PG8_LDA(At, 1, 1); PG8_STAGE(PG8_SA(1, 0), a3, voffA);
            PG8_BAR; PG8_WAIT_L(0); PG8_MMA(1, 0, At, B0); PG8_BAR; PG8_SCHED;
            PG8_STAGE(PG8_SB(1, 1), b3 + hstep, voffB);
            PG8_WAIT_V(6); PG8_BAR; PG8_MMA(1, 1, At, B1); PG8_BAR;
            }
        }
        if constexpr (ALIGN_EPI) { if (wr == 0) PG8_BAR; }
        if constexpr (!Epi::AFTER_DRAIN) { E(acc, cur, wr, wc, fr, fq); S.done(cur); }
        if (!has_next) break;
#pragma unroll
        for (int a = 0; a < 2; ++a)
#pragma unroll
            for (int b = 0; b < 2; ++b)
#pragma unroll
                for (int m = 0; m < 4; ++m)
#pragma unroll
                    for (int n = 0; n < 2; ++n) acc[a][b][m][n] = (f32x4){0.f, 0.f, 0.f, 0.f};
        cur = nxt; cA = nA; cB = nB; ++ui;
        if constexpr (ALIGN_EPI) { if (wr == 1) PG8_BAR; }
    }
    PG8_WAIT_V(0);
    if constexpr (!ALIGN_EPI) { if (wr == 0) PG8_BAR; }
    PG8_BAR;
    if constexpr (Epi::AFTER_DRAIN) { E.fused(acc, cur, wr, wc, fr, fq, lds, wid, lane); S.done(cur); }
#undef PG8_SA
#undef PG8_SB
#undef PG8_STAGE
#undef PG8_LDA
#undef PG8_LDB
#undef PG8_MMA
#undef PG8_WAIT_V
#undef PG8_WAIT_L
#undef PG8_BAR
#undef PG8_SCHED
}
template <class Epi, class Sched, bool ALIGN_EPI = false, bool SP2 = false>
__device__ __forceinline__ void gemm_phase_g(PG8_LAS unsigned char* lds, const int K, const Sched& S, const Epi& E) {
    const int tid = threadIdx.x, wid = __builtin_amdgcn_readfirstlane(tid >> 6), lane = tid & 63, wr = wid >> 2, wc = wid & 3, fr = lane & 15, fq = lane >> 4;
    const int nt = K / BK;
    unsigned voffB[2]; int rowA[2], colA[2];
#pragma unroll
    for (int i = 0; i < 2; ++i) { int R, C; stage_rc(tid * 16 + i * 8192, R, C); const int Rb = Epi::PERM ? ((R & ~31) + perm32(R & 31)) : R;
        rowA[i] = R; colA[i] = C * 2; voffB[i] = (unsigned)(Rb * K + C) * 2u; }
    const size_t kstep = (size_t)(BK * 2);
    const size_t hstep = (size_t)HALF * K * 2;
    const size_t tstep = 2 * hstep;
    const unsigned ldsw = (unsigned)wid * 1024u;
    const int aoff = lds_byte(wr * 64 + fr, fq * 8), boff = lds_byte(wc * 32 + fr, fq * 8);
#define PG8_SA(b, h) (((b) * 2 + (h)) * HTB)
#define PG8_SB(b, h) ((4 + (b) * 2 + (h)) * HTB)
#define PG8_STAGE(bufoff, gbase, voff) do { _Pragma("unroll") for (int _i = 0; _i < 2; ++_i) \
        __builtin_amdgcn_global_load_lds((const unsigned*)((const char*)(gbase) + (voff)[_i]), (PG8_LAS unsigned*)(lds + (bufoff) + ldsw + _i * 8192), 16, 0, 0); } while (0)
#define PG8_STAGEA(bufoff, P0, P1, koff) do { \
        __builtin_amdgcn_global_load_lds((const unsigned*)(Ab + (size_t)(P0) + (koff)), (PG8_LAS unsigned*)(lds + (bufoff) + ldsw), 16, 0, 0); \
        __builtin_amdgcn_global_load_lds((const unsigned*)(Ab + (size_t)(P1) + (koff)), (PG8_LAS unsigned*)(lds + (bufoff) + ldsw + 8192), 16, 0, 0); } while (0)
#define PG8_LDA(dst, b, h) do { _Pragma("unroll") for (int m = 0; m < 4; ++m) _Pragma("unroll") for (int k = 0; k < 2; ++k) dst[m][k] = *(const PG8_LAS bf16x8*)(lds + PG8_SA(b, h) + aoff + m * 2048 + k * 1024); } while (0)
#define PG8_LDB(dst, b, h) do { _Pragma("unroll") for (int n = 0; n < 2; ++n) _Pragma("unroll") for (int k = 0; k < 2; ++k) dst[n][k] = *(const PG8_LAS bf16x8*)(lds + PG8_SB(b, h) + boff + n * 2048 + k * 1024); } while (0)
#define PG8_MMA(ai, bj, At, Bt) do { __builtin_amdgcn_s_setprio(1); _Pragma("unroll") for (int m = 0; m < 4; ++m) _Pragma("unroll") for (int n = 0; n < 2; ++n) _Pragma("unroll") for (int k = 0; k < 2; ++k) \
        acc[ai][bj][m][n] = __builtin_amdgcn_mfma_f32_16x16x32_bf16(Bt[n][k], At[m][k], acc[ai][bj][m][n], 0, 0, 0); __builtin_amdgcn_s_setprio(0); } while (0)
#define PG8_WAIT_V(n) asm volatile("s_waitcnt vmcnt(" #n ")" ::: "memory")
#define PG8_WAIT_L(n) asm volatile("s_waitcnt lgkmcnt(" #n ")" ::: "memory")
#define PG8_BAR __builtin_amdgcn_s_barrier()
#define PG8_SCHED __builtin_amdgcn_sched_barrier(0)
    Unit cur, nxt; int ui = 0;
    if (!S.next(0, cur)) return;
    f32x4 acc[2][2][4][2];
#pragma unroll
    for (int a = 0; a < 2; ++a)
#pragma unroll
        for (int b = 0; b < 2; ++b)
#pragma unroll
            for (int m = 0; m < 4; ++m)
#pragma unroll
                for (int n = 0; n < 2; ++n) acc[a][b][m][n] = (f32x4){0.f, 0.f, 0.f, 0.f};
    bf16x8 At[4][2], B0[2][2], B1[2][2];
    const char* cB = S.b_base(cur);
    unsigned cA00, cA01, cA10, cA11, nA00, nA01, nA10, nA11;
    const char* const Ab = S.a_base();
    S.a_rows(cur, rowA, colA, cA00, cA01, cA10, cA11);
    S.a_ready(cur);
    if constexpr (SP2) {
        PG8_STAGE(PG8_SB(0, 0), cB, voffB); PG8_STAGE(PG8_SB(0, 1), cB + hstep, voffB); PG8_STAGEA(PG8_SA(0, 0), cA00, cA01, 0); PG8_STAGEA(PG8_SA(0, 1), cA10, cA11, 0);
        if (wr == 1) PG8_BAR;
        PG8_WAIT_V(2); PG8_BAR;
        PG8_STAGE(PG8_SB(1, 0), cB + kstep, voffB); PG8_STAGEA(PG8_SA(1, 0), cA00, cA01, kstep); PG8_STAGE(PG8_SB(1, 1), cB + hstep + kstep, voffB);
        PG8_WAIT_V(6); PG8_BAR;
    } else {
        PG8_STAGE(PG8_SB(0, 0), cB, voffB); PG8_STAGEA(PG8_SA(0, 0), cA00, cA01, 0); PG8_STAGE(PG8_SB(0, 1), cB + hstep, voffB); PG8_STAGEA(PG8_SA(0, 1), cA10, cA11, 0);
        if (wr == 1) PG8_BAR;
        PG8_WAIT_V(4); PG8_BAR;
        PG8_STAGE(PG8_SB(1, 0), cB + kstep, voffB); PG8_STAGEA(PG8_SA(1, 0), cA00, cA01, kstep); PG8_STAGE(PG8_SB(1, 1), cB + hstep + kstep, voffB);
        PG8_WAIT_V(6); PG8_BAR;
    }
    for (;;) {
        const bool has_next = S.next(ui + 1, nxt);
        const char* nB = has_next ? S.b_base(nxt) : cB;
        if (has_next) S.a_rows(nxt, rowA, colA, nA00, nA01, nA10, nA11); else { nA00 = cA00; nA01 = cA01; nA10 = cA10; nA11 = cA11; }
        for (int t = 0; t < nt; t += 2) {
            const bool last = (t == nt - 2);
            const size_t k1 = (size_t)(t + 1) * kstep;
            const size_t k2 = last ? 0 : (size_t)(t + 2) * kstep; const char* b2 = last ? nB : cB + (size_t)(t + 2) * kstep;
            const unsigned q00 = last ? nA00 : cA00, q01 = last ? nA01 : cA01, q10 = last ? nA10 : cA10, q11 = last ? nA11 : cA11;
            const size_t k3 = k2 + kstep; const char* b3 = b2 + kstep;
            if (last && has_next) S.a_ready(nxt);
            if constexpr (SP2) {
            PG8_LDB(B0, 0, 0); PG8_LDB(B1, 0, 1); PG8_SCHED; PG8_LDA(At, 0, 0); PG8_STAGEA(PG8_SA(1, 1), cA10, cA11, k1);
            PG8_WAIT_V(8); PG8_WAIT_L(0); PG8_BAR; PG8_MMA(0, 0, At, B0); PG8_MMA(0, 1, At, B1); PG8_BAR; PG8_SCHED;
            PG8_LDA(At, 0, 1); PG8_STAGE(PG8_SB(0, 0), b2, voffB); PG8_STAGE(PG8_SB(0, 1), b2 + hstep, voffB); PG8_STAGEA(PG8_SA(0, 0), q00, q01, k2);
            PG8_WAIT_V(8); PG8_WAIT_L(0); PG8_BAR; PG8_MMA(1, 0, At, B0); PG8_MMA(1, 1, At, B1); PG8_BAR; PG8_SCHED;
            PG8_LDB(B0, 1, 0); PG8_LDB(B1, 1, 1); PG8_SCHED; PG8_LDA(At, 1, 0); PG8_STAGEA(PG8_SA(0, 1), q10, q11, k2);
            PG8_WAIT_V(8); PG8_WAIT_L(0); PG8_BAR; PG8_MMA(0, 0, At, B0); PG8_MMA(0, 1, At, B1); PG8_BAR; PG8_SCHED;
            PG8_LDA(At, 1, 1); PG8_STAGE(PG8_SB(1, 0), b3, voffB); PG8_STAGE(PG8_SB(1, 1), b3 + hstep, voffB); PG8_STAGEA(PG8_SA(1, 0), q00, q01, k3);
            PG8_WAIT_V(8); PG8_WAIT_L(0); PG8_BAR; PG8_MMA(1, 0, At, B0); PG8_MMA(1, 1, At, B1); PG8_BAR; PG8_SCHED;
            } else {
            PG8_LDB(B0, 0, 0); PG8_SCHED; PG8_LDA(At, 0, 0); PG8_STAGEA(PG8_SA(1, 1), cA10, cA11, k1);
            PG8_WAIT_L(8); PG8_BAR; PG8_WAIT_L(0); PG8_MMA(0, 0, At, B0); PG8_BAR; PG8_SCHED;
            PG8_LDB(B1, 0, 1); PG8_STAGE(PG8_SB(0, 0), b2, voffB);
            PG8_BAR; PG8_WAIT_L(0); PG8_MMA(0, 1, At, B1); PG8_BAR;
            PG8_LDA(At, 0, 1); PG8_STAGEA(PG8_SA(0, 0), q00, q01, k2);
            PG8_BAR; PG8_WAIT_L(0); PG8_MMA(1, 0, At, B0); PG8_BAR; PG8_SCHED;
            PG8_STAGE(PG8_SB(0, 1), b2 + hstep, voffB);
            PG8_WAIT_V(6); PG8_BAR; PG8_MMA(1, 1, At, B1); PG8_BAR;
            PG8_LDB(B0, 1, 0); PG8_SCHED; PG8_LDA(At, 1, 0); PG8_STAGEA(PG8_SA(0, 1), q10, q11, k2);
            PG8_WAIT_L(8); PG8_BAR; PG8_WAIT_L(0); PG8_MMA(0, 0, At, B0); PG8_BAR; PG8_SCHED;
            PG8_LDB(B1, 1, 1); PG8_STAGE(PG8_SB(1, 0), b3, voffB);
            PG8_BAR; PG8_WAIT_L(0); PG8_MMA(0, 1, At, B1); PG8_BAR;
            PG8_LDA(At, 1, 1); PG8_STAGEA(PG8_SA(1, 0), q00, q01, k3);
            PG8_BAR; PG8_WAIT_L(0); PG8_MMA(1, 0, At, B0); PG8_BAR; PG8_SCHED;
            PG8_STAGE(PG8_SB(1, 1), b3 + hstep, voffB);
            PG8_WAIT_V(6); PG8_BAR; PG8_MMA(1, 1, At, B1); PG8_BAR;
            }
        }
        if constexpr (ALIGN_EPI) { if (wr == 0) PG8_BAR; }
        if constexpr (!Epi::AFTER_DRAIN) { E(acc, cur, wr, wc, fr, fq); S.done(cur); }
        if (!has_next) break;
#pragma unroll
        for (int a = 0; a < 2; ++a)
#pragma unroll
            for (int b = 0; b < 2; ++b)
#pragma unroll
                for (int m = 0; m < 4; ++m)
#pragma unroll
                    for (int n = 0; n < 2; ++n) acc[a][b][m][n] = (f32x4){0.f, 0.f, 0.f, 0.f};
        cur = nxt; cA00 = nA00; cA01 = nA01; cA10 = nA10; cA11 = nA11; cB = nB; ++ui;
        if constexpr (ALIGN_EPI) { if (wr == 1) PG8_BAR; }
    }
    PG8_WAIT_V(0);
    if constexpr (!ALIGN_EPI) { if (wr == 0) PG8_BAR; }
    PG8_BAR;
    if constexpr (Epi::AFTER_DRAIN) { E.fused(acc, cur, wr, wc, fr, fq, lds, wid, lane); S.done(cur); }
#undef PG8_SA
#undef PG8_SB
#undef PG8_STAGE
#undef PG8_STAGEA
#undef PG8_LDA
#undef PG8_LDB
#undef PG8_MMA
#undef PG8_WAIT_V
#undef PG8_WAIT_L
#undef PG8_BAR
#undef PG8_SCHED
}
}

DEVI void wt_colinfo(const Params& p, int R, const float*& src, int& ld, float& scale) {
    scale = 1.0f; src = nullptr; ld = 0;
    if (R < WT_AT) {
        const int pn = R >> 8, cl = R & 255; ld = DIN_; int col = -1;
        if (pn < 4) { const int wcq = (cl >> 5) & 3; col = (pn >> 1) * 512 + (2 * (pn & 1) + (wcq >> 1)) * 128 + 64 * (cl >> 7) + 32 * (wcq & 1) + (cl & 31);
                      if (pn >= 2) scale = KSCALE_; }
        else if (pn < 8)  col = 2048 + (pn - 4) * 256 + cl;
        else if (pn < 10) { col = 3072 + (pn - 8) * 256 + cl; scale = KSCALE_; }
        else if (pn < 14) col = 5120 + (pn - 10) * 256 + cl;
        else if (pn < 22) col = 6160 + (pn - 14) * 256 + cl;
        else if (cl < 16) col = 6144 + cl;
        if (col >= 0) src = p.w_in + col;
    } else if (R < WT_RET) {
        const int Rr = R - WT_AT, pm = Rr >> 8, rl = Rr & 255; ld = DIN_; int col;
        if (pm < 2) { col = 512 + (2 * pm + ((rl >> 6) & 1)) * 128 + 64 * (rl >> 7) + (rl & 63); scale = KSCALE_; }
        else if (pm < 6)  col = 1024 + (pm - 2) * 256 + rl;
        else if (pm < 10) col = 4096 + (pm - 6) * 256 + rl;
        else              col = 3584 + (pm - 10) * 256 + rl;
        src = p.w_in + col;
    } else {
        int Rr, ldd; const float* base;
        if (R < WT_GLA)    { Rr = R - WT_RET; base = p.w_ret_out; ldd = 1024; }
        else if (R < WT_O) { Rr = R - WT_GLA; base = p.w_gla_out; ldd = 1024; }
        else if (R < WT_R) { Rr = R - WT_O;   base = p.w_o;       ldd = 1024; }
        else               { Rr = R - WT_R;   base = p.router_w;  ldd = 256; }
        src = base + ((R >= WT_R) ? ((Rr & ~127) + vperm(Rr & 127)) : Rr); ld = ldd;
    }
}

DEVI void phase0(const Params& p, unsigned char* smem) {
    const int tid = VT, nb = VG, bid = VB;
    float2* cs = (float2*)(p.ws + OFF_CS);
    for (int i = bid * 256 + tid; i < 4096 * 64; i += nb * 256) {
        const int pos = i >> 6, k = i & 63;
        const float angf = (float)pos * c_inv_freq[k];
        const double a = (double)angf;
        const double TWO_PI = 6.283185307179586476925286766559, HALF_PI = 1.5707963267948966192313216916398;
        const double kk = rint(a * (1.0 / TWO_PI));
        const double r = a - kk * TWO_PI;
        const double qd = rint(r * (1.0 / HALF_PI));
        const double y = r - qd * HALF_PI;
        const double y2 = y * y;
        double sn = y * (1.0 + y2 * (-1.0 / 6 + y2 * (1.0 / 120 + y2 * (-1.0 / 5040 + y2 * (1.0 / 362880 + y2 * (-1.0 / 39916800 + y2 * (1.0 / 6227020800.0)))))));
        double cn = 1.0 + y2 * (-0.5 + y2 * (1.0 / 24 + y2 * (-1.0 / 720 + y2 * (1.0 / 40320 + y2 * (-1.0 / 3628800 + y2 * (1.0 / 479001600.0))))));
        const int qi = ((int)qd) & 3;
        double s, c;
        if (qi == 0) { s = sn; c = cn; } else if (qi == 1) { s = cn; c = -sn; } else if (qi == 2) { s = -sn; c = -cn; } else { s = -cn; c = sn; }
        cs[i] = make_float2((float)c, (float)s);
    }
    if (bid == 0) { int* cnt = (int*)(p.ws + OFF_CNT); cnt[tid * CNT_STRIDE] = 0; }
    {
        const f32x4* xs = (const f32x4*)p.x; u32x4* xd = (u32x4*)(p.ws + OFF_XB);
        const int n8 = T_ * D_ / 8;
        for (int g = bid * 256 + tid; g < n8; g += nb * 256) {
            const f32x4 v0 = xs[2 * g], v1 = xs[2 * g + 1];
            u32x4 o; o.x = pk2(v0[0], v0[1]); o.y = pk2(v0[2], v0[3]); o.z = pk2(v1[0], v1[1]); o.w = pk2(v1[2], v1[3]);
            xd[g] = o;
        }
    }
    {
        float* tile = (float*)smem;
        bf16_t* wt = (bf16_t*)(p.ws + OFF_WT);
        const int ntask = (WT_ROWS / 64) * 16;
        for (int task = bid; task < ntask; task += nb) {
            const int rt = task >> 4, kt = task & 15, R0 = rt * 64, k0 = kt * 64;
            {
                const int n = tid & 63, kq = tid >> 6;
                const float* src; int ld; float sc; wt_colinfo(p, R0 + n, src, ld, sc);
#pragma unroll
                for (int i = 0; i < 16; ++i) { const int k = kq + 4 * i; tile[k * 65 + n] = src ? src[(size_t)(k0 + k) * ld] * sc : 0.f; }
            }
            __syncthreads();
            {
                const int n = tid >> 2, ks = (tid & 3) * 16;
                unsigned o[8];
#pragma unroll
                for (int j = 0; j < 8; ++j) o[j] = pk2(tile[(ks + 2 * j) * 65 + n], tile[(ks + 2 * j + 1) * 65 + n]);
                u32x4* dst = (u32x4*)(wt + (size_t)(R0 + n) * 1024 + k0 + ks);
                dst[0] = (u32x4){o[0], o[1], o[2], o[3]}; dst[1] = (u32x4){o[4], o[5], o[6], o[7]};
            }
            __syncthreads();
        }
    }
}

struct EpiP1N {
    static constexpr bool PERM = true, AFTER_DRAIN = false;
    unsigned char* ws;
    __device__ __forceinline__ void operator()(const pg8::f32x4 (&acc)[2][2][4][2], const pg8::Unit& u, int wr, int wc, int fr, int fq) const {
        const int pn = u.pn, row0 = u.pm * 256 + wr * 64 + fr, c8 = wc * 32 + 8 * fq;
        if (pn < 4) {
            const float2* cs = (const float2*)(ws + OFF_CS); bf16_t* Qr = (bf16_t*)(ws + (pn < 2 ? OFF_QR : OFF_KR));
            const int head = 2 * (pn & 1) + (wc >> 1), d0 = 32 * (wc & 1) + 8 * fq;
#pragma unroll
            for (int ai = 0; ai < 2; ++ai)
#pragma unroll
                for (int m = 0; m < 4; ++m) {
                    const size_t row = row0 + ai * 128 + m * 16; const int pos = (int)(row & 4095);
                    f32x4 c4[4];
#pragma unroll
                    for (int j = 0; j < 4; ++j) c4[j] = *(const f32x4*)(cs + pos * 64 + d0 + 2 * j);
                    f32x4 o1[2], o2[2];
#pragma unroll
                    for (int n = 0; n < 2; ++n)
#pragma unroll
                        for (int r = 0; r < 4; ++r) {
                            const f32x4 cc = c4[2 * n + (r >> 1)]; const float c_ = cc[(r & 1) * 2], s_ = cc[(r & 1) * 2 + 1];
                            const float x1 = acc[ai][0][m][n][r], x2 = acc[ai][1][m][n][r];
                            o1[n][r] = x1 * c_ - x2 * s_; o2[n][r] = x1 * s_ + x2 * c_;
                        }
                    *(u32x4*)(Qr + row * 512 + head * 128 + d0) = pk8(o1[0], o1[1]);
                    *(u32x4*)(Qr + row * 512 + head * 128 + 64 + d0) = pk8(o2[0], o2[1]);
                    asm volatile("" ::: "memory");
                }
        } else {
#pragma unroll
            for (int ai = 0; ai < 2; ++ai)
#pragma unroll
                for (int m = 0; m < 4; ++m) {
                    const size_t row = row0 + ai * 128 + m * 16;
#pragma unroll
                    for (int bj = 0; bj < 2; ++bj) {
                        const int cl = bj * 128 + c8;
                        f32x4 v0 = acc[ai][bj][m][0], v1 = acc[ai][bj][m][1];
                        if (pn < 8) {
#pragma unroll
                            for (int r = 0; r < 4; ++r) { v0[r] = siluf_(v0[r]); v1[r] = siluf_(v1[r]); }
                            *(u32x4*)((bf16_t*)(ws + OFF_GS) + row * 2048 + (pn - 4) * 256 + cl) = pk8(v0, v1);
                        } else if (pn < 10) {
                            *(u32x4*)((bf16_t*)(ws + OFF_QGN) + row * 512 + (pn - 8) * 256 + cl) = pk8(v0, v1);
                        } else if (pn < 14) {
#pragma unroll
                            for (int r = 0; r < 4; ++r) { v0[r] = siluf_(v0[r]); v1[r] = siluf_(v1[r]); }
                            *(u32x4*)((bf16_t*)(ws + OFF_GS) + row * 2048 + 1024 + (pn - 10) * 256 + cl) = pk8(v0, v1);
                        } else if (pn < 22) {
#pragma unroll
                            for (int r = 0; r < 4; ++r) { v0[r] = sigmoidf_(v0[r]); v1[r] = sigmoidf_(v1[r]); }
                            *(u32x4*)((bf16_t*)(ws + OFF_MG) + row * 2048 + (pn - 14) * 256 + cl) = pk8(v0, v1);
                        } else if (cl < 16) {
                            float* Ga = (float*)(ws + OFF_GA); *(f32x4*)(Ga + row * 16 + cl) = v0; *(f32x4*)(Ga + row * 16 + cl + 4) = v1;
                        }
                    }
                    asm volatile("" ::: "memory");
                }
        }
    }
};
struct EpiP1V {
    static constexpr bool PERM = true, AFTER_DRAIN = false;
    unsigned char* ws;
    __device__ __forceinline__ void operator()(const pg8::f32x4 (&acc)[2][2][4][2], const pg8::Unit& u, int wr, int wc, int fr, int fq) const {
        bf16_t* dst = (bf16_t*)(ws + (u.pm < 4 ? OFF_VRT : OFF_VGT)); const int head = u.pm & 3;
#pragma unroll
        for (int bj = 0; bj < 2; ++bj) {
            const int tok0 = u.pn * 256 + bj * 128 + wc * 32 + 8 * fq; const int item = (tok0 >> 6) * 4 + head, m0 = tok0 & 63;
#pragma unroll
            for (int ai = 0; ai < 2; ++ai)
#pragma unroll
                for (int m = 0; m < 4; ++m) {
                    *(u32x4*)(dst + vf_off(item, ai * 128 + wr * 64 + m * 16 + fr, m0)) = pk8(acc[ai][bj][m][0], acc[ai][bj][m][1]);
                    asm volatile("" ::: "memory");
                }
        }
    }
};
struct EpiP1G {
    static constexpr bool PERM = true, AFTER_DRAIN = false;
    unsigned char* ws;
    __device__ __forceinline__ void operator()(const pg8::f32x4 (&acc)[2][2][4][2], const pg8::Unit& u, int wr, int wc, int fr, int fq) const {
        bf16_t* dst = (bf16_t*)(ws + OFF_KGT);
#pragma unroll
        for (int bj = 0; bj < 2; ++bj) {
            const int tok0 = u.pn * 256 + bj * 128 + wc * 32 + 8 * fq; const int m0 = tok0 & 63;
#pragma unroll
            for (int ai = 0; ai < 2; ++ai) {
                const unsigned item = (unsigned)((tok0 >> 6) * 4 + 2 * u.pm + ai);
#pragma unroll
                for (int m = 0; m < 4; ++m) {
                    *(u32x4*)(dst + (item * 128u + (unsigned)(wr * 64 + m * 16 + fr)) * 64u + (unsigned)m0) = pk8(acc[ai][bj][m][0], acc[ai][bj][m][1]);
                    asm volatile("" ::: "memory");
                }
            }
        }
    }
};
DEVI void phase1(const Params& p, unsigned char* smem_all) {
    {
        pg8::StaticOrder S; S.init(T_, 5888, RG, RB);
        pg8::Gemm g; g.A = (const bf16_t*)(p.ws + OFF_XB); g.Bt = (const bf16_t*)(p.ws + OFF_WT) + (size_t)WT_BN * 1024; g.M = T_; g.N = 5888; g.K = 1024;
        EpiP1N E; E.ws = p.ws;
        pg8::gemm_phase<EpiP1N, pg8::StaticOrder, true, true>((PG8_LAS unsigned char*)smem_all, g, S, E);
    }
    __syncthreads();
    {
        pg8::StaticOrder S; S.init(2048, T_, RG, RB);
        pg8::Gemm g; g.A = (const bf16_t*)(p.ws + OFF_WT) + (size_t)(WT_AT + 512) * 1024; g.Bt = (const bf16_t*)(p.ws + OFF_XB); g.M = 2048; g.N = T_; g.K = 1024;
        EpiP1V E; E.ws = p.ws;
        pg8::gemm_phase<EpiP1V, pg8::StaticOrder, true, true>((PG8_LAS unsigned char*)smem_all, g, S, E);
    }
    __syncthreads();
    {
        pg8::StaticOrder S; S.init(512, T_, RG, RB);
        pg8::Gemm g; g.A = (const bf16_t*)(p.ws + OFF_WT) + (size_t)(WT_AT + 2560) * 1024; g.Bt = (const bf16_t*)(p.ws + OFF_XB); g.M = 512; g.N = T_; g.K = 1024;
        EpiP1G E; E.ws = p.ws;
        pg8::gemm_phase<EpiP1G, pg8::StaticOrder, true, true>((PG8_LAS unsigned char*)smem_all, g, S, E);
    }
}

DEVI void phase2(const Params& p, unsigned char* smem) {
    float* ga_s = (float*)smem;
    float* tot = (float*)(smem + 4096);
    const int tid = VT;
    const float* Ga = (const float*)(p.ws + OFF_GA);
    const bf16_t* Kgt = (const bf16_t*)(p.ws + OFF_KGT); bf16_t* Kg2 = (bf16_t*)(p.ws + OFF_KG2);
    float* dec = (float*)(p.ws + OFF_DEC);
    for (int it = VB; it < 2048; it += VG) {
        const int h = it & 3, c = (it >> 2) & 63, b = it >> 8;
        const int tok0 = b * 4096 + c * 64;
        ((f32x4*)ga_s)[tid] = ((const f32x4*)(Ga + (size_t)tok0 * 16))[tid];
        const int dk = tid & 127, half = tid >> 7;
        float w2[16];
#pragma unroll
        for (int r = 0; r < 16; ++r) w2[r] = p.gate_w2[r * 512 + h * 128 + dk];
        const float bias = p.gate_b[h * 128 + dk];
        __syncthreads();
        float run = 0.f; float bc[32];
#pragma unroll
        for (int ml = 0; ml < 32; ++ml) {
            const int m = half * 32 + ml;
            float z = bias;
#pragma unroll
            for (int r4 = 0; r4 < 4; ++r4) { const f32x4 g4 = *(const f32x4*)&ga_s[m * 16 + 4 * r4];
                z += g4[0] * w2[4 * r4] + g4[1] * w2[4 * r4 + 1] + g4[2] * w2[4 * r4 + 2] + g4[3] * w2[4 * r4 + 3]; }
            const float la = (fminf(z, 0.f) - __logf(1.0f + __expf(-fabsf(z)))) * (1.0f / 16.0f);
            run += la; bc[ml] = run;
        }
        tot[half * 128 + dk] = run;
        __syncthreads();
        const float t0 = tot[dk], t1 = tot[128 + dk];
        const float bend = t0 + t1, off = half ? t0 : 0.f;
        const u32x4* kp = (const u32x4*)(Kgt + ((size_t)it * 128 + dk) * 64 + half * 32);
        bf16_t* const kqb = Kg2;
#pragma unroll
        for (int j = 0; j < 4; ++j) {
            u32x4 v = kp[j];
            unsigned uu[4] = {v.x, v.y, v.z, v.w};
#pragma unroll
            for (int e = 0; e < 4; ++e) {
                const float f0 = bflo(uu[e]) * __expf(bend - (bc[8 * j + 2 * e] + off));
                const float f1 = bfhi(uu[e]) * __expf(bend - (bc[8 * j + 2 * e + 1] + off));
                uu[e] = pk2(f0, f1);
            }
            *(u32x4*)(kqb + kf_off(it, dk, half * 32 + 8 * j)) = (u32x4){uu[0], uu[1], uu[2], uu[3]};
        }
        if (half == 0) dec[(size_t)it * 128 + dk] = __expf(bend);
        {
            const bf16_t* Qn = (const bf16_t*)(p.ws + OFF_QGN); bf16_t* QF = (bf16_t*)(p.ws + OFF_QG);
            const int m = tid & 63, qd = tid >> 6, bc = b * 64 + c;
            const u32x4* qs = (const u32x4*)(Qn + ((size_t)tok0 + m) * 512 + h * 128 + 32 * qd);
            u32x4 qv[4];
#pragma unroll
            for (int j = 0; j < 4; ++j) qv[j] = qs[j];
#pragma unroll
            for (int j = 0; j < 4; ++j) {
                *(u32x2*)(QF + qf_off(bc, h, m, 32 * qd + 8 * j, 0)) = (u32x2){qv[j].x, qv[j].y};
                *(u32x2*)(QF + qf_off(bc, h, m, 32 * qd + 8 * j, 1)) = (u32x2){qv[j].z, qv[j].w};
            }
        }
        __syncthreads();
    }
    {
        bf16_t* tile = (bf16_t*)smem;
        const bf16_t* Kr = (const bf16_t*)(p.ws + OFF_KR); bf16_t* Krt = (bf16_t*)(p.ws + OFF_KRT);
        for (int it = VB; it < 2048; it += VG) {
            const int h = it & 3, c = (it >> 2) & 63, b = it >> 8;
            const size_t tok0 = (size_t)b * 4096 + c * 64;
            const int m = tid & 63, qd = tid >> 6;
            const float kd = exp2f(gamma_log2(h) * (float)(63 - m));
            const u32x4* src = (const u32x4*)(Kr + (tok0 + m) * 512 + h * 128 + 32 * qd);
            u32x4 v[4];
#pragma unroll
            for (int j = 0; j < 4; ++j) v[j] = src[j];
#pragma unroll
            for (int j = 0; j < 4; ++j) {
                const unsigned uu[4] = {v[j].x, v[j].y, v[j].z, v[j].w};
#pragma unroll
                for (int e = 0; e < 4; ++e) {
                    const int dk = 32 * qd + 8 * j + 2 * e;
                    tile[dk * 72 + m] = f2bf(bflo(uu[e]) * kd); tile[(dk + 1) * 72 + m] = f2bf(bfhi(uu[e]) * kd);
                }
            }
            {
                const bf16_t* Qr = (const bf16_t*)(p.ws + OFF_QR); bf16_t* QF = (bf16_t*)(p.ws + OFF_QFR);
                const u32x4* qs = (const u32x4*)(Qr + (tok0 + m) * 512 + h * 128 + 32 * qd);
                u32x4 qv[4];
#pragma unroll
                for (int j = 0; j < 4; ++j) qv[j] = qs[j];
                const int bc = b * 64 + c;
#pragma unroll
                for (int j = 0; j < 4; ++j) {
                    *(u32x2*)(QF + qf_off(bc, h, m, 32 * qd + 8 * j, 0)) = (u32x2){qv[j].x, qv[j].y};
                    *(u32x2*)(QF + qf_off(bc, h, m, 32 * qd + 8 * j, 1)) = (u32x2){qv[j].z, qv[j].w};
                }
            }
            __syncthreads();
            {
                const int dk = tid >> 1, hf = tid & 1;
#pragma unroll
                for (int j = 0; j < 4; ++j) *(u32x4*)(Krt + kf_off(it, dk, hf * 32 + 8 * j)) = *(const u32x4*)&tile[dk * 72 + hf * 32 + 8 * j];
            }
            __syncthreads();
        }
    }
}

typedef float f32x16 __attribute__((ext_vector_type(16)));
DEVI f32x16 mfma32(bf16x8 a, bf16x8 b, f32x16 c) { return __builtin_amdgcn_mfma_f32_32x32x16_bf16(a, b, c, 0, 0, 0); }
#ifndef SCAN_DEPTH
#define SCAN_DEPTH 1
#endif
struct ScanSet { bf16x8 kf[4], vf[4], qf[2][2]; f32x4 dc[4]; };
template <bool GLA>
DEVI void scan_tile(const Params& p, unsigned char* zb  , int b, int h, int s, int dummy) {
    const int t = VT >> 6, lane = VT & 63, r = lane & 31, hh = lane >> 5;
    const bf16_t* Ktb = (const bf16_t*)(p.ws + (GLA ? OFF_KG2 : OFF_KRT));
    const bf16_t* Vtb = (const bf16_t*)(p.ws + (GLA ? OFF_VGT : OFF_VRT));
    const bf16_t* Qb  = (const bf16_t*)(p.ws + (GLA ? OFF_QG : OFF_QFR));
    const float* dec = (const float*)(p.ws + OFF_DEC);
    bf16_t* Oo = (bf16_t*)(p.ws + OFF_OO);
    const float lg = gamma_log2(h);
    const float cd = exp2f(lg * 64.0f);
    f32x16 S;
#pragma unroll
    for (int i = 0; i < 16; ++i) S[i] = 0.f;
    const unsigned it0 = (unsigned)(b * 64 * 4 + h);
    const bf16_t* const kp = Ktb + ((size_t)it0 * 4 + t) * 4 * 512; const unsigned ko = (unsigned)lane * 8;
    const bf16_t* const vp = Vtb + ((size_t)it0 * 8 + s) * 4 * 512; const unsigned vo = (unsigned)lane * 8;
    const bf16_t* const qp = Qb + ((((size_t)(b * 64) * 4 + h) * 2) * 4 + t) * 2 * 512; const unsigned qo = (unsigned)lane * 8;
    const float* const dp = dec + (size_t)it0 * 128 + t * 32; const unsigned dofs = 4 * hh;
    const int rt = t >> 1, rg0 = 2 * (t & 1);
    bf16_t* const op = Oo + (size_t)b * 4096 * 2048 + (GLA ? 1024 : 0) + h * 256 + s * 32 + (size_t)rt * 32 * 2048; const unsigned oo = (unsigned)r * 2048 + 4 * hh;
    const float qd = GLA ? 1.0f : exp2f(lg * (float)(32 * rt + r + 1));
    bf16_t* const ob = Oo + (size_t)b * 4096 * 2048 + (GLA ? 1024 : 0) + h * 256 + s * 32;
#define ST_LOAD(SET, C) do { const int c_ = dummy ? 0 : ((C) < 64 ? (C) : 63); \
        const bf16_t* kq = kp + (size_t)c_ * (4 * 16 * 512) + ko; const bf16_t* vq = vp + (size_t)c_ * (4 * 32 * 512) + vo; const bf16_t* qq = qp + (size_t)c_ * (4 * 16 * 512) + qo; \
        _Pragma("unroll") for (int ks = 0; ks < 4; ++ks) { (SET).kf[ks] = *(const bf16x8*)(kq + ks * 512); (SET).vf[ks] = *(const bf16x8*)(vq + ks * 512); } \
        _Pragma("unroll") for (int ss = 0; ss < 2; ++ss) _Pragma("unroll") for (int tt = 0; tt < 2; ++tt) (SET).qf[ss][tt] = *(const bf16x8*)(qq + tt * (8 * 512) + ss * 512); \
        } while (0)
#define ST_LOADDC(SET, C) do { if (GLA) { const int c_ = (C) < 64 ? (C) : 63; const float* dq = dp + (size_t)c_ * (4 * 128) + dofs; \
        _Pragma("unroll") for (int g = 0; g < 4; ++g) (SET).dc[g] = *(const f32x4*)(dq + 8 * g); } } while (0)
#define ST_Z(SET, ZC) do { \
        _Pragma("unroll") for (int tt = 0; tt < 2; ++tt) { \
            f32x16 Zt; _Pragma("unroll") for (int i = 0; i < 16; ++i) Zt[i] = 0.f; \
            _Pragma("unroll") for (int ss = 0; ss < 2; ++ss) { \
                u32x4 pk; pk.x = pk2(S[8 * ss + 0], S[8 * ss + 1]); pk.y = pk2(S[8 * ss + 2], S[8 * ss + 3]); pk.z = pk2(S[8 * ss + 4], S[8 * ss + 5]); pk.w = pk2(S[8 * ss + 6], S[8 * ss + 7]); \
                Zt = mfma32(__builtin_bit_cast(bf16x8, pk), (SET).qf[ss][tt], Zt); } \
            _Pragma("unroll") for (int g = 0; g < 4; ++g) { \
                f32x4 z4; z4[0] = Zt[4 * g]; z4[1] = Zt[4 * g + 1]; z4[2] = Zt[4 * g + 2]; z4[3] = Zt[4 * g + 3]; \
                *(u32x2*)((ZC) + (((t * 2 + tt) * 4 + g) * 64 + lane) * 8) = pk4(z4); } } } while (0)
#define ST_UPD(SET) do { \
        if (GLA) { _Pragma("unroll") for (int g = 0; g < 4; ++g) _Pragma("unroll") for (int i = 0; i < 4; ++i) S[4 * g + i] *= (SET).dc[g][i]; } \
        else { _Pragma("unroll") for (int i = 0; i < 16; ++i) S[i] *= cd; } \
        _Pragma("unroll") for (int ks = 0; ks < 4; ++ks) S = mfma32((SET).kf[ks], (SET).vf[ks], S); } while (0)
#define ST_STEP(CUR, NXT, OTH, C) do { \
        ST_LOAD(NXT, (C) + SCAN_DEPTH); ST_LOADDC(OTH, (C) + 1);      \
        __builtin_amdgcn_sched_barrier(0); \
        unsigned char* zc = zb + ((C) & 1) * 16384; \
        if (GLA) { ST_UPD(CUR); ST_Z(CUR, zc); } else { ST_Z(CUR, zc); ST_UPD(CUR); } \
        __syncthreads(); \
        _Pragma("unroll") for (int gi = 0; gi < 2; ++gi) { const int g = rg0 + gi; \
            f32x4 o = (f32x4){0.f, 0.f, 0.f, 0.f}; \
            _Pragma("unroll") for (int t2 = 0; t2 < 4; ++t2) o += unpk4(*(const u32x2*)(zc + (((t2 * 2 + rt) * 4 + g) * 64 + lane) * 8)); \
            *(u32x2*)(zb + 32768 + ((C) & 7) * 4096 + (32 * rt + r) * 64 + (8 * g + 4 * hh) * 2) = pk4(o * qd); } \
          \
        if (((C) & 7) == 7) { __syncthreads(); \
            _Pragma("unroll") for (int i = 0; i < 8; ++i) { const int idx = i * 256 + VT, row = idx >> 2, part = idx & 3; \
                *(u32x4*)(ob + ((size_t)((C) - 7) * 64 + row) * 2048 + part * 8) = *(const u32x4*)(zb + 32768 + row * 64 + part * 16); } } } while (0)
#if SCAN_DEPTH == 2
    ScanSet A, B, Cc;
    ST_LOAD(A, 0); ST_LOADDC(A, 0); ST_LOAD(B, 1);
#pragma unroll 1
    for (int c0 = 0; c0 < 63; c0 += 3) { ST_STEP(A, Cc, B, c0); ST_STEP(B, A, Cc, c0 + 1); ST_STEP(Cc, B, A, c0 + 2); }
    ST_STEP(A, Cc, B, 63);
#else
    ScanSet A, B;
    ST_LOAD(A, 0); ST_LOADDC(A, 0);
#pragma unroll 1
    for (int c0 = 0; c0 < 64; c0 += 2) { ST_STEP(A, B, B, c0); ST_STEP(B, A, A, c0 + 1); }
#endif
    __syncthreads();
#undef ST_STEP
#undef ST_UPD
#undef ST_Z
#undef ST_LOADDC
#undef ST_LOAD
}
DEVI void phase3t(const Params& p, unsigned char* smem, int dummy) {
    for (int it0 = VB; it0 < 512; it0 += VG) {
        const int lcl = (RB >> 3) * 2 + VH;
        const int it = (VG == 512) ? ((RB & 7) * 8 + lcl / 8) * 8 + (lcl & 7) : it0;
        const int s = it & 7, h = (it >> 3) & 3, b = (it >> 5) & 7, br = it >> 8;
        if (br == 0) scan_tile<false>(p, smem, b, h, s, dummy); else scan_tile<true>(p, smem, b, h, s, dummy);
    }
}

constexpr int PS_LD = 72;
DEVI void phase4(const Params& p, unsigned char* smem) {
    const int t = VT, lane = t & 63, w = t >> 6, l15 = lane & 15, q = lane >> 4;
    bf16_t* Ps = (bf16_t*)smem + w * 16 * PS_LD;
    const bf16_t* Qr = (const bf16_t*)(p.ws + OFF_QR); const bf16_t* Kr = (const bf16_t*)(p.ws + OFF_KR);
    const bf16_t* Vrt = (const bf16_t*)(p.ws + OFF_VRT); const bf16_t* Oo = (const bf16_t*)(p.ws + OFF_OO);
    const bf16_t* Gs = (const bf16_t*)(p.ws + OFF_GS); bf16_t* Y = (bf16_t*)(p.ws + OFF_Y);
    for (int it = VB; it < 4096; it += VG) {
        const int br = it >> 11, idx = it & 2047;
        const int h = idx & 3, c = (idx >> 2) & 63, b = idx >> 8;
        const size_t tok0 = (size_t)b * 4096 + c * 64;
        const size_t tok = tok0 + 16 * w + l15;
        f32x4 O[16];
        const bf16_t* orow = Oo + tok * 2048 + br * 1024 + h * 256 + 4 * q;
        const bf16_t* grow = Gs + tok * 2048 + br * 1024 + h * 256 + 4 * q;
        u32x2 oraw[16], graw[16];
        if (br == 0) {
            const float lg = gamma_log2(h);
            bf16x8 vf[8][2];
#pragma unroll
            for (int nt = 0; nt < 8; ++nt) { vf[nt][0] = *(const bf16x8*)(Vrt + vf_off(idx, 16 * nt + l15, q * 8)); vf[nt][1] = *(const bf16x8*)(Vrt + vf_off(idx, 16 * nt + l15, 32 + q * 8)); }
            __builtin_amdgcn_sched_barrier(0);
            f32x4 P[4] = {(f32x4){0.f, 0.f, 0.f, 0.f}, (f32x4){0.f, 0.f, 0.f, 0.f}, (f32x4){0.f, 0.f, 0.f, 0.f}, (f32x4){0.f, 0.f, 0.f, 0.f}};
#pragma unroll
            for (int ks = 0; ks < 4; ++ks) {
                const bf16x8 qf = *(const bf16x8*)(Qr + tok * 512 + h * 128 + ks * 32 + q * 8);
#pragma unroll
                for (int mt = 0; mt < 4; ++mt) {
                    const bf16x8 kf = *(const bf16x8*)(Kr + (tok0 + 16 * mt + l15) * 512 + h * 128 + ks * 32 + q * 8);
                    P[mt] = mfma16(kf, qf, P[mt]);
                }
            }
            const int j = 16 * w + l15;
#pragma unroll
            for (int mt = 0; mt < 4; ++mt) {
                f32x4 v = P[mt];
#pragma unroll
                for (int r = 0; r < 4; ++r) { const int m = 16 * mt + 4 * q + r; const int dd = j > m ? j - m : m - j; v[r] *= exp2f(lg * (float)dd); }
                *(u32x2*)&Ps[l15 * PS_LD + 16 * mt + 4 * q] = pk4(v);
            }
            __syncthreads();
            const bf16x8 pf0 = *(const bf16x8*)&Ps[l15 * PS_LD + q * 8];
            const bf16x8 pf1 = *(const bf16x8*)&Ps[l15 * PS_LD + 32 + q * 8];
            __builtin_amdgcn_sched_barrier(0);
#pragma unroll
            for (int nt = 0; nt < 8; ++nt) {
                f32x4 o = (f32x4){0.f, 0.f, 0.f, 0.f};
                o = mfma16(vf[nt][0], pf0, o); O[nt] = mfma16(vf[nt][1], pf1, o);
            }
            __builtin_amdgcn_sched_barrier(0);
#pragma unroll
            for (int nt = 0; nt < 8; ++nt) { vf[nt][0] = *(const bf16x8*)(Vrt + vf_off(idx, 16 * (8 + nt) + l15, q * 8)); vf[nt][1] = *(const bf16x8*)(Vrt + vf_off(idx, 16 * (8 + nt) + l15, 32 + q * 8)); }
#pragma unroll
            for (int nt = 0; nt < 16; ++nt) { oraw[nt] = *(const u32x2*)(orow + 16 * nt); graw[nt] = *(const u32x2*)(grow + 16 * nt); }
            __builtin_amdgcn_sched_barrier(0);
#pragma unroll
            for (int nt = 0; nt < 8; ++nt) {
                f32x4 o = (f32x4){0.f, 0.f, 0.f, 0.f};
                o = mfma16(vf[nt][0], pf0, o); O[8 + nt] = mfma16(vf[nt][1], pf1, o);
            }
#pragma unroll
            for (int nt = 0; nt < 16; ++nt) O[nt] += unpk4(oraw[nt]);
            __syncthreads();
        } else {
#pragma unroll
            for (int nt = 0; nt < 16; ++nt) { oraw[nt] = *(const u32x2*)(orow + 16 * nt); graw[nt] = *(const u32x2*)(grow + 16 * nt); }
#pragma unroll
            for (int nt = 0; nt < 16; ++nt) O[nt] = unpk4(oraw[nt]);
        }
        float s1 = 0.f;
#pragma unroll
        for (int nt = 0; nt < 16; ++nt) s1 += (O[nt][0] + O[nt][1]) + (O[nt][2] + O[nt][3]);
        s1 += __shfl_xor(s1, 16); s1 += __shfl_xor(s1, 32);
        const float mean = (br == 0) ? s1 * (1.0f / 256.0f) : 0.f;
        float s2 = 0.f;
#pragma unroll
        for (int nt = 0; nt < 16; ++nt) {
#pragma unroll
            for (int r = 0; r < 4; ++r) { const float dlt = O[nt][r] - mean; s2 += dlt * dlt; }
        }
        s2 += __shfl_xor(s2, 16); s2 += __shfl_xor(s2, 32);
        const float rstd = rsqrtf(s2 * (1.0f / 256.0f) + (br == 0 ? 1e-5f : 1e-6f));
        const float* gw = (br == 0 ? p.ret_norm_g : p.gla_norm_g) + h * 256 + 4 * q;
        bf16_t* yrow = Y + ((size_t)br * T_ + tok) * 1024 + h * 256 + 4 * q;
#pragma unroll
        for (int nt = 0; nt < 16; ++nt) {
            const f32x4 g = *(const f32x4*)(gw + 16 * nt);
            const f32x4 gate = unpk4(graw[nt]);
            f32x4 y;
#pragma unroll
            for (int r = 0; r < 4; ++r) y[r] = (O[nt][r] - mean) * rstd * g[r] * gate[r];
            *(u32x2*)(yrow + 16 * nt) = pk4(y);
        }
    }
}

struct EpiMerge {
    static constexpr bool PERM = true, AFTER_DRAIN = false;
    const bf16_t* Mg; bf16_t* Mrg; int pass;
    __device__ __forceinline__ void operator()(const pg8::f32x4 (&acc)[2][2][4][2], const pg8::Unit& u, int wr, int wc, int fr, int fq) const {
        const int row0 = u.pm * 256 + wr * 64 + fr, col0 = u.pn * 256 + wc * 32 + 8 * fq;
#pragma unroll
        for (int ai = 0; ai < 2; ++ai) {
            u32x4 gg[4][2], pr[4][2];
#pragma unroll
            for (int m = 0; m < 4; ++m)
#pragma unroll
                for (int bj = 0; bj < 2; ++bj) {
                    const size_t row = row0 + ai * 128 + m * 16; const int col = col0 + bj * 128;
                    gg[m][bj] = *(const u32x4*)(Mg + row * 2048 + pass * 1024 + col);
                    if (pass) pr[m][bj] = *(const u32x4*)(Mrg + row * 1024 + col);
                }
#pragma unroll
            for (int m = 0; m < 4; ++m)
#pragma unroll
                for (int bj = 0; bj < 2; ++bj) {
                    const size_t row = row0 + ai * 128 + m * 16; const int col = col0 + bj * 128;
                    f32x4 g0, g1; unpk8(gg[m][bj], g0, g1);
                    f32x4 o0 = acc[ai][bj][m][0] * g0, o1 = acc[ai][bj][m][1] * g1;
                    if (pass) { f32x4 p0, p1; unpk8(pr[m][bj], p0, p1); o0 += p0; o1 += p1; }
                    *(u32x4*)(Mrg + row * 1024 + col) = pk8(o0, o1);
                }
        }
    }
};
DEVI void phase5(const Params& p, unsigned char* smem_all) {
    pg8::StaticOrder S; S.init(T_, 1024, RG, RB);
    const bf16_t* Y = (const bf16_t*)(p.ws + OFF_Y); const bf16_t* wt = (const bf16_t*)(p.ws + OFF_WT);
    for (int pass = 0; pass < 2; ++pass) {
        pg8::Gemm g; g.A = Y + (size_t)pass * T_ * 1024; g.Bt = wt + (size_t)(pass ? WT_GLA : WT_RET) * 1024; g.M = T_; g.N = 1024; g.K = 1024;
        EpiMerge E; E.Mg = (const bf16_t*)(p.ws + OFF_MG); E.Mrg = (bf16_t*)(p.ws + OFF_MRG); E.pass = pass;
        pg8::gemm_phase<EpiMerge, pg8::StaticOrder, true, true>((PG8_LAS unsigned char*)smem_all, g, S, E);
        __syncthreads();
    }
}

struct EpiResid {
    static constexpr bool PERM = true, AFTER_DRAIN = false;
    const float* x; bf16_t* T1;
    __device__ __forceinline__ void operator()(const pg8::f32x4 (&acc)[2][2][4][2], const pg8::Unit& u, int wr, int wc, int fr, int fq) const {
        const int row0 = u.pm * 256 + wr * 64 + fr, col0 = u.pn * 256 + wc * 32 + 8 * fq;
#pragma unroll
        for (int ai = 0; ai < 2; ++ai)
#pragma unroll
            for (int m = 0; m < 4; ++m) {
                const size_t row = row0 + ai * 128 + m * 16;
                f32x4 xv[2][2];
#pragma unroll
                for (int bj = 0; bj < 2; ++bj) { xv[bj][0] = *(const f32x4*)(x + row * 1024 + col0 + bj * 128); xv[bj][1] = *(const f32x4*)(x + row * 1024 + col0 + bj * 128 + 4); }
#pragma unroll
                for (int bj = 0; bj < 2; ++bj)
                    *(u32x4*)(T1 + row * 1024 + col0 + bj * 128) = pk8(xv[bj][0] * ALPHA_ + acc[ai][bj][m][0], xv[bj][1] * ALPHA_ + acc[ai][bj][m][1]);
            }
    }
};
DEVI void phase6(const Params& p, unsigned char* smem_all) {
    pg8::StaticOrder S; S.init(T_, 1024, RG, RB);
    pg8::Gemm g; g.A = (const bf16_t*)(p.ws + OFF_MRG); g.Bt = (const bf16_t*)(p.ws + OFF_WT) + (size_t)WT_O * 1024; g.M = T_; g.N = 1024; g.K = 1024;
    EpiResid E; E.x = p.x; E.T1 = (bf16_t*)(p.ws + OFF_T1);
    pg8::gemm_phase<EpiResid, pg8::StaticOrder, true, true>((PG8_LAS unsigned char*)smem_all, g, S, E);
}

DEVI void conv_expert_weights(const Params& p, unsigned char* smem) {
    bf16_t* tile = (bf16_t*)smem;
    const int t = VT, ng = t & 31, kg = t >> 5;
    bf16_t* WGU = (bf16_t*)(p.ws + OFF_WGU); bf16_t* WD = (bf16_t*)(p.ws + OFF_WD);
    const int ntask = 257 * 3 * 32;
    for (int task = VB; task < ntask; task += VG) {
        const int e = task / 96, rem = task - e * 96, mat = rem >> 5, tl = rem & 31;
        const float* src; bf16_t* dst; int K, N, kt, nt;
        if (mat < 2) { K = 1024; N = 256; kt = tl >> 1; nt = tl & 1;
            src = (mat == 0) ? (e < 256 ? p.ew_gate + (size_t)e * 262144 : p.sw_gate) : (e < 256 ? p.ew_up + (size_t)e * 262144 : p.sw_up);
            dst = WGU + (size_t)e * 524288 + (size_t)(nt + mat) * 131072; }
        else { K = 256; N = 1024; kt = tl >> 3; nt = tl & 7;
            src = e < 256 ? p.ew_down + (size_t)e * 262144 : p.sw_down; dst = WD + (size_t)e * 262144; }
        const float* sp = src + (size_t)(kt * 64 + 4 * kg) * N + nt * 128 + 4 * ng;
        f32x4 rf[8];
#pragma unroll
        for (int i = 0; i < 4; ++i) { rf[i] = *(const f32x4*)(sp + (size_t)i * N); rf[4 + i] = *(const f32x4*)(sp + (size_t)(32 + i) * N); }
#pragma unroll
        for (int i = 0; i < 4; ++i) {
            u32x2 v0, v1;
            v0.x = pk2(rf[0][i], rf[1][i]); v0.y = pk2(rf[2][i], rf[3][i]); v1.x = pk2(rf[4][i], rf[5][i]); v1.y = pk2(rf[6][i], rf[7][i]);
            *(u32x2*)&tile[(4 * ng + i) * 72 + 4 * kg] = v0; *(u32x2*)&tile[(4 * ng + i) * 72 + 32 + 4 * kg] = v1;
        }
        __syncthreads();
        {
            const int n = t >> 1, hf = t & 1;
            bf16_t* dp = dst + (size_t)(nt * 128 + n) * K + kt * 64 + hf * 32;
#pragma unroll
            for (int j = 0; j < 4; ++j) *(u32x4*)(dp + 8 * j) = *(const u32x4*)&tile[n * 72 + hf * 32 + 8 * j];
        }
        __syncthreads();
    }
}

DEVI void phase7(const Params& p, unsigned char* smem) {
    const int t = VT, lane = t & 63, w = t >> 6;
    const bf16_t* T1 = (const bf16_t*)(p.ws + OFF_T1); bf16_t* X1b = (bf16_t*)(p.ws + OFF_X1B);
    for (int row = VB * 4 + w; row < T_; row += VG * 4) {
        f32x4 v[4]; float s = 0.f;
#pragma unroll
        for (int i = 0; i < 4; ++i) { v[i] = unpk4(*(const u32x2*)(T1 + (size_t)row * 1024 + i * 256 + lane * 4)); s += (v[i][0] + v[i][1]) + (v[i][2] + v[i][3]); }
#pragma unroll
        for (int o = 32; o > 0; o >>= 1) s += __shfl_xor(s, o);
        const float mean = s * (1.0f / 1024.0f); float s2 = 0.f;
#pragma unroll
        for (int i = 0; i < 4; ++i)
#pragma unroll
            for (int r = 0; r < 4; ++r) { const float d = v[i][r] - mean; s2 += d * d; }
#pragma unroll
        for (int o = 32; o > 0; o >>= 1) s2 += __shfl_xor(s2, o);
        const float rstd = rsqrtf(s2 * (1.0f / 1024.0f) + 1e-5f);
#pragma unroll
        for (int i = 0; i < 4; ++i) {
            const int col = i * 256 + lane * 4;
            const f32x4 g = *(const f32x4*)(p.ln1_g + col), bb = *(const f32x4*)(p.ln1_b + col);
            f32x4 y;
#pragma unroll
            for (int r = 0; r < 4; ++r) y[r] = (v[i][r] - mean) * rstd * g[r] + bb[r];
            *(u32x2*)(X1b + (size_t)row * 1024 + col) = pk4(y);
        }
    }
    conv_expert_weights(p, smem);
}

DEVI void phase8(const Params& p, unsigned char* smem) {
    GemmSmem& sm = *(GemmSmem*)smem;
    const int t = VT, lane = t & 63, w = t >> 6, wr = w >> 1, wc = w & 1, l15 = lane & 15, q = lane >> 4;
    const bf16_t* X1b = (const bf16_t*)(p.ws + OFF_X1B); const bf16_t* wt = (const bf16_t*)(p.ws + OFF_WT);
    float* LG = (float*)(p.ws + OFF_LOG);
    for (int tile = VB; tile < 256 * 2; tile += VG) {
        const int mtg = tile >> 1, ntg = tile & 1, m0 = mtg * 128, n0 = ntg * 128;
        const bf16_t* pa0 = X1b + (size_t)(m0 + (t >> 3)) * 1024 + gemm_src_chunk(t);
        const bf16_t* pb0 = wt + (size_t)(WT_R + n0 + (t >> 3)) * 1024 + gemm_src_chunk(t);
        const bf16_t* const pa[4] = {pa0, pa0 + 32 * 1024, pa0 + 64 * 1024, pa0 + 96 * 1024};
        const bf16_t* const pb[4] = {pb0, pb0 + 32 * 1024, pb0 + 64 * 1024, pb0 + 96 * 1024};
        f32x4 acc[4][4]; zero_acc(acc);
        gemm_kloop<true, 0>(acc, pa, pb, nullptr, 0, 16, sm);
#pragma unroll
        for (int mt = 0; mt < 4; ++mt)
#pragma unroll
            for (int nt = 0; nt < 4; ++nt) {
                const int row = m0 + wr * 64 + mt * 16 + l15, col = n0 + wc * 64 + (nt >> 1) * 32 + 8 * q + 4 * (nt & 1);
                *(f32x4*)(LG + (size_t)row * 256 + col) = acc[mt][nt];
            }
    }
}

DEVI unsigned f2ord(float f) { const unsigned u = __float_as_uint(f); return (u & 0x80000000u) ? ~u : (u | 0x80000000u); }
template <int CTRL> DEVI float dppf(float v) { const int x = __float_as_int(v); return __int_as_float(__builtin_amdgcn_update_dpp(x, x, CTRL, 0xf, 0xf, false)); }
template <int CTRL> DEVI void top2_merge(float& m1, float& m2) {
    const float p1 = dppf<CTRL>(m1), p2 = dppf<CTRL>(m2);
    const float n1 = fmaxf(m1, p1), n2 = fmaxf(fminf(m1, p1), fmaxf(m2, p2));
    m1 = n1; m2 = n2;
}
template <bool DRY> DEVI void phase9(const Params& p) {
    const int t = VT, lane = t & 63, w = t >> 6;
    const float* LG = (const float*)(p.ws + OFF_LOG);
    int* cnt = (int*)(p.ws + OFF_CNT); int* list = (int*)(p.ws + OFF_LIST); float* wts = (float*)(p.ws + OFF_WTS);
    const int tstep = VG * 4;
    int tok = VB * 4 + w;
    const f32x4 rb = *(const f32x4*)(p.router_bias + 4 * lane);
    f32x4 lgn = {0.f, 0.f, 0.f, 0.f};
    if (tok < T_) lgn = *(const f32x4*)(LG + (size_t)tok * 256 + 4 * lane);
    const int mygrp = lane >> 3;
    int ppos = 0, pe = -1, ptk9 = 0;
    for (; tok < T_; tok += tstep) {
        float sc[4], bi[4];
#pragma unroll
        for (int r = 0; r < 4; ++r) { sc[r] = sigmoidf_(lgn[r]); bi[r] = sc[r] + rb[r]; }
        { const int tn = tok + tstep; if (tn < T_) lgn = *(const f32x4*)(LG + (size_t)tn * 256 + 4 * lane); }
        float m1, m2;
        { const float h01 = fmaxf(bi[0], bi[1]), l01 = fminf(bi[0], bi[1]), h23 = fmaxf(bi[2], bi[3]), l23 = fminf(bi[2], bi[3]);
          m1 = fmaxf(h01, h23); m2 = fmaxf(fminf(h01, h23), fmaxf(l01, l23)); }
        top2_merge<0xB1>(m1, m2);
        top2_merge<0x4E>(m1, m2);
        top2_merge<0x141>(m1, m2);
        const float gown = m1 + m2;
        int rank = 0;
#pragma unroll
        for (int g2 = 0; g2 < 8; ++g2) {
            const float go = __builtin_bit_cast(float, __builtin_amdgcn_readlane(__builtin_bit_cast(int, gown), 8 * g2));
            rank += (go > gown || (go == gown && g2 < mygrp)) ? 1 : 0;
        }
        unsigned ck[4];
#pragma unroll
        for (int r = 0; r < 4; ++r) ck[r] = rank < 4 ? f2ord(bi[r]) : 0u;
        unsigned thr = 0u; bool exact = false;
#pragma unroll 1
        for (int bit = 31; bit >= 0; --bit) {
            const unsigned cnd = thr | (1u << bit);
            const int c8 = __popcll(__ballot(ck[0] >= cnd)) + __popcll(__ballot(ck[1] >= cnd)) + __popcll(__ballot(ck[2] >= cnd)) + __popcll(__ballot(ck[3] >= cnd));
            if (c8 >= 8) { thr = cnd; if (c8 == 8) { exact = true; break; } }
        }
        unsigned long long selm[4];
        if (exact) {
#pragma unroll
            for (int r = 0; r < 4; ++r) selm[r] = __ballot(ck[r] >= thr);
        } else {
            unsigned long long eq[4], any = 0ull; int need = 8;
#pragma unroll
            for (int r = 0; r < 4; ++r) { selm[r] = __ballot(ck[r] > thr); eq[r] = __ballot(ck[r] == thr); need -= __popcll(selm[r]); any |= eq[r]; }
            while (need > 0 && any != 0ull) {
                const int L = __builtin_ctzll(any); any &= any - 1ull;
#pragma unroll
                for (int r = 0; r < 4; ++r) if (((eq[r] >> L) & 1ull) != 0ull && need > 0) { selm[r] |= 1ull << L; --need; }
            }
        }
        float wsum = 0.f, myw = 0.f; int mye = 0, kk = 0;
#pragma unroll
        for (int r = 0; r < 4; ++r) {
            unsigned long long m = selm[r];
            while (m != 0ull) {
                const int L = __builtin_ctzll(m); m &= m - 1ull;
                const float sv = __builtin_bit_cast(float, __builtin_amdgcn_readlane(__builtin_bit_cast(int, sc[r]), L));
                wsum += sv;
                if (lane == kk) { mye = 4 * L + r; myw = sv; }
                ++kk;
            }
        }
        if (DRY) { asm volatile("" :: "v"(mye), "v"(myw), "v"(wsum)); }
        else if (lane < 8) {
            if (pe >= 0) list[(size_t)pe * T_ + ppos] = ptk9;
            ppos = atomicAdd(&cnt[mye * CNT_STRIDE], 1); pe = mye; ptk9 = tok * 9 + lane;
            wts[(size_t)tok * 9 + lane] = myw / wsum * 2.5f;
        } else if (lane == 8) wts[(size_t)tok * 9 + 8] = 1.0f;
    }
    if (!DRY && lane < 8 && pe >= 0) list[(size_t)pe * T_ + ppos] = ptk9;
}

DEVI void moe_prefix(const Params& p, int* pre  , int xg) {
    const int tid = VT;
    const int* cnt = (const int*)(p.ws + OFF_CNT);
    __syncthreads();
    if (tid < 64) {
        int v = 0;
        if (tid < 32) v = (__hip_atomic_load(&cnt[(xg + 8 * tid) * CNT_STRIDE], __ATOMIC_RELAXED, __HIP_MEMORY_SCOPE_AGENT) + 127) >> 7;
        else if (tid == 32) v = 32;
#pragma unroll
        for (int o = 1; o < 64; o <<= 1) { const int u = __shfl_up(v, o); if (tid >= o) v += u; }
        if (tid < 33) pre[tid + 1] = v;
        if (tid == 0) pre[0] = 0;
    }
    __syncthreads();
}
DEVI int moe_find(const int* pre, int mb) {
    int lo = 0, hi = 32;
    while (lo < hi) { const int mid = (lo + hi + 1) >> 1; if (pre[mid] <= mb) lo = mid; else hi = mid - 1; }
    return lo;
}
DEVI int moe_tk9(const int* list, int e, int pos) { return e < 256 ? list[(size_t)e * T_ + pos] : pos * 9 + 8; }

DEVI void moe_prefix256(const Params& p, int* pre  , int xg) {
    const int tid = threadIdx.x;
    const int* cnt = (const int*)(p.ws + OFF_CNT);
    __syncthreads();
    if (tid < 64) {
        int v = 0;
        if (tid < 32) { const int c = __hip_atomic_load(&cnt[(xg + 8 * tid) * CNT_STRIDE], __ATOMIC_RELAXED, __HIP_MEMORY_SCOPE_AGENT); ((int*)(p.ws + OFF_CNT2))[xg + 8 * tid] = c; v = (c + 255) >> 8; }
        else if (tid == 32) v = 16;
#pragma unroll
        for (int o = 1; o < 64; o <<= 1) { const int u = __shfl_up(v, o); if (tid >= o) v += u; }
        if (tid < 33) pre[tid + 1] = v;
        if (tid == 0) pre[0] = 0;
    }
    __syncthreads();
}
struct MoeSched {
    const int* pre; const int* cnt; const int* list;
    int xg, jl, nloc, nun;
    const char* Abase; int arow_bytes; bool by_token;
    const char* Bbase; size_t b_expert_bytes, b_unit_bytes;
    __device__ __forceinline__ bool next(int i, pg8::Unit& u) const { const int item = jl + i * nloc; if (item >= pre[33] * nun) return false; u.pm = item / nun; u.pn = item - u.pm * nun; return true; }
    __device__ __forceinline__ void decode(const pg8::Unit& u, int& e, int& r0, int& ce) const {
        const int gi = moe_find(pre, u.pm), mb = u.pm - pre[gi];
        e = gi < 32 ? xg + 8 * gi : 256; ce = e < 256 ? cnt[e] : T_; r0 = (e < 256 ? 0 : xg * 4096) + mb * 256;
    }
    __device__ __forceinline__ int slot(int e, int pos) const { return e < 256 ? list[(size_t)e * T_ + pos] : pos * 9 + 8; }
    __device__ __forceinline__ const char* a_base() const { return Abase; }
    __device__ __forceinline__ void a_rows(const pg8::Unit& u, const int (&rowA)[2], const int (&colA)[2], unsigned& p00, unsigned& p01, unsigned& p10, unsigned& p11) const {
        int e, r0, ce; decode(u, e, r0, ce);
        const int fb = e < 256 ? 0 : xg * 4096;
        int s4[4];
#pragma unroll
        for (int k = 0; k < 4; ++k) { int pos = r0 + (k >> 1) * 128 + rowA[k & 1]; if (pos >= ce) pos = fb; s4[k] = slot(e, pos); }
#pragma unroll
        for (int k = 0; k < 4; ++k) if (by_token) s4[k] = s4[k] / 9;
        p00 = (unsigned)s4[0] * (unsigned)arow_bytes + (unsigned)colA[0]; p01 = (unsigned)s4[1] * (unsigned)arow_bytes + (unsigned)colA[1];
        p10 = (unsigned)s4[2] * (unsigned)arow_bytes + (unsigned)colA[0]; p11 = (unsigned)s4[3] * (unsigned)arow_bytes + (unsigned)colA[1];
    }
    __device__ __forceinline__ const char* b_base(const pg8::Unit& u) const { int e, r0, ce; decode(u, e, r0, ce); return Bbase + (size_t)e * b_expert_bytes + (size_t)u.pn * b_unit_bytes; }
    __device__ __forceinline__ void a_ready(const pg8::Unit&) const {}
    __device__ __forceinline__ void done(const pg8::Unit&) const {}
};
struct EpiMoe1 {
    static constexpr bool PERM = true, AFTER_DRAIN = false;
    const MoeSched* S; bf16_t* H;
    __device__ __forceinline__ void operator()(const pg8::f32x4 (&acc)[2][2][4][2], const pg8::Unit& u, int wr, int wc, int fr, int fq) const {
        int e, r0, ce; S->decode(u, e, r0, ce);
#pragma unroll
        for (int ai = 0; ai < 2; ++ai) {
            int sl[4];
#pragma unroll
            for (int m = 0; m < 4; ++m) { const int pos = r0 + ai * 128 + wr * 64 + m * 16 + fr; sl[m] = pos < ce ? S->slot(e, pos) : -1; }
#pragma unroll
            for (int m = 0; m < 4; ++m) if (sl[m] >= 0) {
                f32x4 h0, h1;
#pragma unroll
                for (int r = 0; r < 4; ++r) { h0[r] = siluf_(acc[ai][0][m][0][r]) * acc[ai][1][m][0][r]; h1[r] = siluf_(acc[ai][0][m][1][r]) * acc[ai][1][m][1][r]; }
                *(u32x4*)(H + (size_t)sl[m] * 256 + u.pn * 128 + wc * 32 + 8 * fq) = pk8(h0, h1);
            }
            asm volatile("" ::: "memory");
        }
    }
};
struct EpiMoe2 {
    static constexpr bool PERM = true, AFTER_DRAIN = false;
    const MoeSched* S; const float* wts; unsigned char* YX;
    __device__ __forceinline__ void operator()(const pg8::f32x4 (&acc)[2][2][4][2], const pg8::Unit& u, int wr, int wc, int fr, int fq) const {
        int e, r0, ce; S->decode(u, e, r0, ce);
#pragma unroll
        for (int ai = 0; ai < 2; ++ai) {
            int sl[4]; float wg[4];
#pragma unroll
            for (int m = 0; m < 4; ++m) { const int pos = r0 + ai * 128 + wr * 64 + m * 16 + fr; sl[m] = pos < ce ? S->slot(e, pos) : -1; }
#pragma unroll
            for (int m = 0; m < 4; ++m) wg[m] = sl[m] >= 0 ? wts[sl[m]] * YX_SCALE : 0.f;
#pragma unroll
            for (int m = 0; m < 4; ++m) if (sl[m] >= 0) {
#pragma unroll
                for (int bj = 0; bj < 2; ++bj)
                    { u32x2 w8; w8.x = pk4_fp8(clamp4(acc[ai][bj][m][0] * wg[m], 440.f)); w8.y = pk4_fp8(clamp4(acc[ai][bj][m][1] * wg[m], 440.f));
                      *(u32x2*)(YX + (size_t)sl[m] * 1024 + u.pn * 256 + bj * 128 + wc * 32 + 8 * fq) = w8; }
            }
            asm volatile("" ::: "memory");
        }
    }
};
DEVI void moe_sched_init(const Params& p, MoeSched& S, int* pre) {
    S.pre = pre; S.cnt = (const int*)(p.ws + OFF_CNT2); S.list = (const int*)(p.ws + OFF_LIST);
    S.xg = RB & 7; S.jl = RB >> 3; S.nloc = RG >> 3;
}
DEVI void phase10(const Params& p, unsigned char* smem_all) {
    int* pre = (int*)(smem_all + 131072);
    MoeSched S; moe_sched_init(p, S, pre); moe_prefix256(p, pre, S.xg);
    S.nun = 2; S.Abase = (const char*)(p.ws + OFF_X1B); S.arow_bytes = 2048; S.by_token = true;
    S.Bbase = (const char*)(p.ws + OFF_WGU); S.b_expert_bytes = (size_t)512 * 1024 * 2; S.b_unit_bytes = (size_t)256 * 1024 * 2;
    EpiMoe1 E; E.S = &S; E.H = (bf16_t*)(p.ws + OFF_H);
    pg8::gemm_phase_g<EpiMoe1, MoeSched, true, true>((PG8_LAS unsigned char*)smem_all, 1024, S, E);
}
DEVI void phase11(const Params& p, unsigned char* smem_all) {
    int* pre = (int*)(smem_all + 131072);
    MoeSched S; moe_sched_init(p, S, pre); moe_prefix256(p, pre, S.xg);
    S.nun = 4; S.Abase = (const char*)(p.ws + OFF_H); S.arow_bytes = 512; S.by_token = false;
    S.Bbase = (const char*)(p.ws + OFF_WD); S.b_expert_bytes = (size_t)1024 * 256 * 2; S.b_unit_bytes = (size_t)256 * 256 * 2;
    EpiMoe2 E; E.S = &S; E.wts = (const float*)(p.ws + OFF_WTS); E.YX = (unsigned char*)(p.ws + OFF_YX);
    pg8::gemm_phase_g<EpiMoe2, MoeSched, true, true>((PG8_LAS unsigned char*)smem_all, 256, S, E);
}

DEVI void phase12(const Params& p) {
    const int t = VT, lane = t & 63, w = t >> 6;
    const bf16_t* X1b = (const bf16_t*)(p.ws + OFF_X1B); const unsigned char* YX = (const unsigned char*)(p.ws + OFF_YX);
    for (int row = VB * 4 + w; row < T_; row += VG * 4) {
        f32x4 v[4]; float s = 0.f;
#pragma unroll
        for (int i = 0; i < 4; ++i) {
            const int col = i * 256 + lane * 4;
            f32x4 a = unpk4(*(const u32x2*)(X1b + (size_t)row * 1024 + col)) * ALPHA_;
            f32x4 ys = (f32x4){0.f, 0.f, 0.f, 0.f};
#pragma unroll
            for (int k = 0; k < 9; ++k) ys += unpk4_fp8(*(const unsigned*)(YX + ((size_t)row * 9 + k) * 1024 + col));
            a += ys * (1.0f / YX_SCALE);
            v[i] = a; s += (a[0] + a[1]) + (a[2] + a[3]);
        }
#pragma unroll
        for (int o = 32; o > 0; o >>= 1) s += __shfl_xor(s, o);
        const float mean = s * (1.0f / 1024.0f); float s2 = 0.f;
#pragma unroll
        for (int i = 0; i < 4; ++i)
#pragma unroll
            for (int r = 0; r < 4; ++r) { const float d = v[i][r] - mean; s2 += d * d; }
#pragma unroll
        for (int o = 32; o > 0; o >>= 1) s2 += __shfl_xor(s2, o);
        const float rstd = rsqrtf(s2 * (1.0f / 1024.0f) + 1e-5f);
#pragma unroll
        for (int i = 0; i < 4; ++i) {
            const int col = i * 256 + lane * 4;
            const f32x4 g = *(const f32x4*)(p.ln2_g + col), bb = *(const f32x4*)(p.ln2_b + col);
            f32x4 y;
#pragma unroll
            for (int r = 0; r < 4; ++r) y[r] = (v[i][r] - mean) * rstd * g[r] + bb[r];
            *(f32x4*)(p.out + (size_t)row * 1024 + col) = y;
        }
    }
}


#define XB_TMO      128
#define XB_XCNT(j)  (256  + 64 * (j))
#define XB_XSUB(j)  (1280 + 64 * (j))
#define XB_XGEN(j)  (2304 + 64 * (j))
#define XB_TOP      3328
#define XB_TOPGEN   3392
#define XCD_BAR_WORDS 3456
#define XB_SPIN_CAP (1u << 20)
#define LAS __attribute__((address_space(3)))
DEVI unsigned xb_ld(unsigned* p)              { return __hip_atomic_load(p, __ATOMIC_RELAXED, __HIP_MEMORY_SCOPE_AGENT); }
DEVI unsigned xb_add(unsigned* p, unsigned v) { return __hip_atomic_fetch_add(p, v, __ATOMIC_RELAXED, __HIP_MEMORY_SCOPE_AGENT); }
DEVI unsigned xb_xcc_id() { return (unsigned)__builtin_amdgcn_s_getreg((3 << 11) | 20) & 0xFu; }
#define XB_SPIN(cond, bar) do { unsigned _sp = 0; while (cond) { __builtin_amdgcn_s_sleep(1); \
    if ((++_sp & 255u) == 0u) { if (xb_ld(&(bar)[XB_TMO])) break; if (_sp > XB_SPIN_CAP) { atomicAdd(&(bar)[XB_TMO], 1u); break; } } } } while (0)
struct XcdBarrier { unsigned* bar; unsigned x; volatile LAS unsigned* st; };
DEVI XcdBarrier xcd_barrier_post(unsigned* bar, volatile LAS unsigned* st) {
    XcdBarrier b; b.bar = bar; b.x = xb_xcc_id(); b.st = st;
    if (threadIdx.x == 0) st[3] = xb_add(&bar[XB_XCNT(b.x)], 1u);
    return b;
}
DEVI void xcd_barrier_complete(unsigned* bar, unsigned x, unsigned& nloc, unsigned& nx) {
    const unsigned G = gridDim.x * gridDim.y * gridDim.z;
    unsigned sum, cnt, mine, sp = 0u;
    for (;;) {
        sum = 0u; cnt = 0u; mine = 0u;
#pragma unroll
        for (unsigned j = 0; j < 16; ++j) { const unsigned c = xb_ld(&bar[XB_XCNT(j)]); sum += c; cnt += (c > 0u) ? 1u : 0u; mine = (j == x) ? c : mine; }
        if (sum == G) break;
        __builtin_amdgcn_s_sleep(1);
        if ((++sp & 255u) == 0u) { if (xb_ld(&bar[XB_TMO])) break; if (sp > XB_SPIN_CAP) { atomicAdd(&bar[XB_TMO], 1u); break; } }
    }
    nloc = mine > 0u ? mine : 1u; nx = cnt > 0u ? cnt : 1u;
}
DEVI void xcd_barrier(const XcdBarrier& b) {
    asm volatile("s_waitcnt vmcnt(0)" ::: "memory");
    __syncthreads();
    if (threadIdx.x == 0) {
        unsigned* bar = b.bar;
        __builtin_amdgcn_s_waitcnt(0);
        unsigned nloc = b.st[0], nx = b.st[1];
        if (nloc == 0u) { xcd_barrier_complete(bar, b.x, nloc, nx); b.st[0] = nloc; b.st[1] = nx; }
        const unsigned old = xb_add(&bar[XB_XSUB(b.x)], 1u);
        const unsigned gen = old / nloc;
        if (old + 1u == (gen + 1u) * nloc) {
            __builtin_amdgcn_fence(__ATOMIC_RELEASE, "agent");
            asm volatile("s_waitcnt vmcnt(0)" ::: "memory");
            const unsigned og = xb_add(&bar[XB_TOP], 1u);
            const unsigned tg = og / nx;
            if (og + 1u == (tg + 1u) * nx) xb_add(&bar[XB_TOPGEN], 1u);
            else XB_SPIN(xb_ld(&bar[XB_TOPGEN]) == tg, bar);
            __builtin_amdgcn_fence(__ATOMIC_ACQUIRE, "agent");
            xb_add(&bar[XB_XGEN(b.x)], 1u);
            asm volatile("s_waitcnt vmcnt(0)" ::: "memory");
        } else {
            XB_SPIN(xb_ld(&bar[XB_XGEN(b.x)]) == gen, bar);
            __builtin_amdgcn_fence(__ATOMIC_ACQUIRE, "agent");
            asm volatile("s_waitcnt vmcnt(0)" ::: "memory");
        }
    }
    __syncthreads();
}
constexpr size_t OFF_BAR = 131072;

#ifndef DBG
#define DBG 0
#endif
DEVI void dump_f32(const Params& p, size_t off) {
    const f32x4* src = (const f32x4*)(p.ws + off); f32x4* dst = (f32x4*)p.out;
    for (int i = blockIdx.x * 256 + threadIdx.x; i < T_ * D_ / 4; i += gridDim.x * 256) dst[i] = src[i];
}
DEVI void dump_bf16(const Params& p, size_t off, int ld, int coff) {
    const bf16_t* src = (const bf16_t*)(p.ws + off);
    for (int i = blockIdx.x * 256 + threadIdx.x; i < T_ * D_; i += gridDim.x * 256) { const int row = i >> 10, col = i & 1023; p.out[i] = bf2f(src[(size_t)row * ld + coff + col]); }
}
DEVI float flat_bf(const Params& p, size_t off, size_t n, size_t i) { const bf16_t* b = (const bf16_t*)(p.ws + off); float a = 0.f; for (size_t j = i; j < n; j += (size_t)T_ * D_) a += bf2f(b[j]); return a; }
DEVI void dump_p1(const Params& p) {
    const size_t N = (size_t)T_ * D_;
    for (size_t i = (size_t)blockIdx.x * 256 + threadIdx.x; i < N; i += (size_t)gridDim.x * 256) {
        float a = 0.f;
        a += flat_bf(p, OFF_MG, 2 * N, i) + flat_bf(p, OFF_GS, 2 * N, i);
        a += flat_bf(p, OFF_QR, N / 2, i % (N / 2)) + flat_bf(p, OFF_KR, N / 2, i % (N / 2)) + flat_bf(p, OFF_QG, N / 2, i % (N / 2));
        a += flat_bf(p, OFF_KRT, N / 2, i % (N / 2)) + flat_bf(p, OFF_KGT, N / 2, i % (N / 2));
        a += flat_bf(p, OFF_VRT, N, i) + flat_bf(p, OFF_VGT, N, i);
        a += ((const float*)(p.ws + OFF_GA))[i % ((size_t)T_ * 16)];
        p.out[i] = a;
    }
}
constexpr int NPHASE = 13;
__global__ void __launch_bounds__(512, 2) fwd_megakernel(Params p) {
    unsigned char* const smem_all = smem_all_g;
    unsigned char* smem = smem_all + VH * SMEM_HALF;
    uint4* xb_words = (uint4*)(smem_all + 2 * SMEM_HALF - 16);
    if (threadIdx.x == 0) *xb_words = make_uint4(0u, 0u, blockIdx.x, 0u);
    __syncthreads();
    const XcdBarrier xb = xcd_barrier_post((unsigned*)(p.ws + OFF_BAR), (volatile LAS unsigned*)xb_words);
#ifndef REPMASK
#define REPMASK 0
#endif
#ifndef TIMEPHASE
#define TIMEPHASE -1
#endif
#define RUN_PHASE(K, CALL) do { if (p.phase_lo <= (K) && (K) < p.phase_hi) { \
        const unsigned long long tp0_ = (TIMEPHASE == (K)) ? __builtin_amdgcn_s_memrealtime() : 0ull; \
        _Pragma("unroll 1") for (int rep_ = ((REPMASK >> (K)) & 1); rep_ >= 0; --rep_) { CALL; if (rep_ > 0 || (K) + 1 < p.phase_hi) xcd_barrier(xb); } \
        if (TIMEPHASE == (K)) { const unsigned long long tp1_ = __builtin_amdgcn_s_memrealtime(); while (__builtin_amdgcn_s_memrealtime() - tp1_ < tp1_ - tp0_) __builtin_amdgcn_s_sleep(8); } } } while (0)
    RUN_PHASE(0, phase0(p, smem));
    if (p.phase_lo == 0 && p.phase_hi > 1) {
        if (threadIdx.x == 0) {
            unsigned* bar = (unsigned*)(p.ws + OFF_BAR); bool ok = (gridDim.x & 7u) == 0u && xb.x < 8u;
            for (unsigned j = 0; j < 16; ++j) { const unsigned c = xb_ld(&bar[XB_XCNT(j)]); ok = ok && (j < 8 ? c == gridDim.x / 8u : c == 0u); }
            if (ok) ((volatile int*)xb_words)[2] = (int)(((volatile unsigned*)xb_words)[3] * 8u + xb.x);
        }
        __syncthreads();
    }
    RUN_PHASE(1, phase1(p, smem_all));
#if DBG == 2
    dump_p1(p); return;
#endif
    RUN_PHASE(2, phase2(p, smem));
#if DBG == 5
    { const size_t N = (size_t)T_ * D_; for (size_t i = (size_t)blockIdx.x * 256 + threadIdx.x; i < N; i += (size_t)gridDim.x * 256) p.out[i] = flat_bf(p, OFF_KG2, N / 2, i % (N / 2)) + ((const float*)(p.ws + OFF_DEC))[i % (2048 * 128)]; } return;
#endif
#ifdef SCANPROBE
    phase3t(p, smem, 1); xcd_barrier(xb);
#endif
    RUN_PHASE(3, phase3t(p, smem, 0));
#if DBG == 6
    dump_bf16(p, OFF_OO, 2048, 1024); return;
#endif
#if DBG == 7
    { const bf16_t* src = (const bf16_t*)(p.ws + OFF_OO);
      for (int i = blockIdx.x * 256 + threadIdx.x; i < T_ * D_; i += gridDim.x * 256) { const int row = i >> 10, col = i & 1023; const float v = bf2f(src[(size_t)row * 2048 + 1024 + col]); p.out[i] = (fabsf(v) < 1e30f) ? v : 12345.0f; } } return;
#endif
    RUN_PHASE(4, phase4(p, smem));
#if DBG == 3
    dump_bf16(p, OFF_Y, 2048, 0); return;
#endif
#if DBG == 4
    dump_bf16(p, OFF_Y, 2048, 1024); return;
#endif
    RUN_PHASE(5, phase5(p, smem_all));
    RUN_PHASE(6, phase6(p, smem_all));
    RUN_PHASE(7, phase7(p, smem));
#if DBG == 1
    return;
#endif
    RUN_PHASE(8, phase8(p, smem));
#ifdef P9DRY
    RUN_PHASE(9, (phase9<true>(p), phase9<false>(p)));
#else
    RUN_PHASE(9, phase9<false>(p));
#endif
    RUN_PHASE(10, phase10(p, smem_all));
    RUN_PHASE(11, phase11(p, smem_all));
    RUN_PHASE(12, phase12(p));
#undef RUN_PHASE
}

extern "C" void kernel_launch(void* const* d_in, const int* in_sizes, int n_in, void* d_out, int out_size, void* d_ws, size_t ws_size,
                              hipStream_t stream) {
    static int grid_blocks = 0;
    if (!grid_blocks) {
        int dev = 0, cus = 0, per_cu = 0;
        hipGetDevice(&dev);
        hipDeviceGetAttribute(&cus, hipDeviceAttributeMultiprocessorCount, dev);
        hipOccupancyMaxActiveBlocksPerMultiprocessor(&per_cu, fwd_megakernel, 512, 0);
        if (per_cu > 1) per_cu = 1;
        if (per_cu < 1) per_cu = 1;
        grid_blocks = cus * per_cu;
    }
    if (ws_size < WS_NEEDED) { fprintf(stderr, "workspace too small: %zu < %zu\n", ws_size, (size_t)WS_NEEDED); return; }
    Params p{};
    p.x = (const float*)d_in[0]; p.w_in = (const float*)d_in[1]; p.ret_norm_g = (const float*)d_in[2]; p.gate_w2 = (const float*)d_in[3];
    p.gate_b = (const float*)d_in[4]; p.gla_norm_g = (const float*)d_in[5]; p.w_ret_out = (const float*)d_in[6]; p.w_gla_out = (const float*)d_in[7];
    p.w_o = (const float*)d_in[8]; p.ln1_g = (const float*)d_in[9]; p.ln1_b = (const float*)d_in[10]; p.router_w = (const float*)d_in[11];
    p.router_bias = (const float*)d_in[12]; p.ew_gate = (const float*)d_in[13]; p.ew_up = (const float*)d_in[14]; p.ew_down = (const float*)d_in[15];
    p.sw_gate = (const float*)d_in[16]; p.sw_up = (const float*)d_in[17]; p.sw_down = (const float*)d_in[18]; p.ln2_g = (const float*)d_in[19];
    p.ln2_b = (const float*)d_in[20];
    p.out = (float*)d_out; p.ws = (unsigned char*)d_ws; p.phase_lo = 0; p.phase_hi = NPHASE;
    void* args[] = {&p};
    (void)hipMemsetAsync((unsigned char*)d_ws + OFF_BAR, 0, XCD_BAR_WORDS * 4, stream);
    hipError_t e = hipLaunchCooperativeKernel((void*)fwd_megakernel, dim3(grid_blocks), dim3(512), args, 0, stream);
    if (e != hipSuccess) fprintf(stderr, "cooperative launch failed: %s (grid %d)\n", hipGetErrorString(e), grid_blocks);
}
```

```cpp
#include <hip/hip_runtime.h>
#include <hip/hip_cooperative_groups.h>
#include <cstdio>
#include <cstdint>
namespace cg = cooperative_groups;

typedef unsigned short bf16_t;
typedef short bf16x8 __attribute__((ext_vector_type(8)));
typedef float f32x4 __attribute__((ext_vector_type(4)));
typedef unsigned u32x2 __attribute__((ext_vector_type(2)));
typedef unsigned u32x4 __attribute__((ext_vector_type(4)));
#define DEVI __device__ __forceinline__
#define VH ((int)(threadIdx.x >> 8))
#define VT ((int)(threadIdx.x & 255))
#define RB (__builtin_amdgcn_readfirstlane(((const int*)(smem_all_g + 2 * SMEM_HALF - 16))[2]))
#define RG ((int)gridDim.x)
#define VB (RB * 2 + VH)
#define VG (RG * 2)

constexpr int T_ = 32768;
constexpr int D_ = 1024;
constexpr int DIN_ = 8208;
constexpr int NE_ = 256;
constexpr float ALPHA_ = 1.189207115002721f;
constexpr float KSCALE_ = 0.08838834764831845f;

constexpr size_t MB = 1ull << 20;
constexpr size_t OFF_CNT  = (size_t)766 << 20;
constexpr int CNT_STRIDE = 1024;
constexpr size_t OFF_CS   = 1 * MB;
constexpr size_t OFF_WT   = 3 * MB;
constexpr size_t FB = 27 * MB;
constexpr size_t OFF_QR   = FB + 0 * MB;
constexpr size_t OFF_KR   = FB + 32 * MB;
constexpr size_t OFF_VRT  = FB + 64 * MB;
constexpr size_t OFF_GS   = FB + 128 * MB;
constexpr size_t OFF_MG   = FB + 256 * MB;
constexpr size_t OFF_KRT  = FB + 384 * MB;
constexpr size_t OFF_QG   = FB + 416 * MB;
constexpr size_t OFF_VGT  = FB + 448 * MB;
constexpr size_t OFF_KGT  = FB + 512 * MB;
constexpr size_t OFF_GA   = FB + 544 * MB;
constexpr size_t OFF_XB   = FB + 546 * MB;
constexpr size_t OFF_KG2  = FB + 546 * MB;
constexpr size_t OFF_DEC  = FB + 578 * MB;
constexpr size_t OFF_OO   = FB + 579 * MB;
constexpr size_t OFF_Y    = FB + 384 * MB;
constexpr size_t OFF_MRG  = FB + 0 * MB;
constexpr size_t OFF_QGN  = 767 * MB;
constexpr size_t OFF_QFR  = 734 * MB;
constexpr size_t OFF_WGU  = 767 * MB;
constexpr size_t OFF_X1B  = FB + 0 * MB;
constexpr size_t OFF_WD   = FB + 64 * MB;
constexpr size_t OFF_LIST = FB + 193 * MB;
constexpr size_t OFF_WL   = 686 * MB;
constexpr size_t OFF_H    = FB + 227 * MB;
constexpr size_t OFF_YX   = FB + 371 * MB;
constexpr size_t OFF_T1   = FB + 371 * MB;
constexpr size_t OFF_LOG  = FB + 435 * MB;
constexpr size_t WS_NEEDED = 1024 * MB;

constexpr int WT_BN = 0, WT_AT = 5888, WT_RET = 8960, WT_GLA = 9984, WT_O = 11008, WT_R = 12032, WT_ROWS = 12288;

struct Params {
    const float *x, *w_in, *ret_norm_g, *gate_w2, *gate_b, *gla_norm_g, *w_ret_out, *w_gla_out, *w_o, *ln1_g, *ln1_b,
                *router_w, *router_bias, *ew_gate, *ew_up, *ew_down, *sw_gate, *sw_up, *sw_down, *ln2_g, *ln2_b;
    float* out;
    unsigned char* ws;
    int phase_lo, phase_hi;
};

static __device__ const float c_inv_freq[64] = {
  1.000000000e+00f, 8.659643531e-01f, 7.498942018e-01f, 6.493816376e-01f,
  5.623413324e-01f, 4.869675338e-01f, 4.216965139e-01f, 3.651741147e-01f,
  3.162277639e-01f, 2.738419771e-01f, 2.371373773e-01f, 2.053525001e-01f,
  1.778279394e-01f, 1.539926529e-01f, 1.333521456e-01f, 1.154781953e-01f,
  1.000000015e-01f, 8.659642935e-02f, 7.498942316e-02f, 6.493816525e-02f,
  5.623413250e-02f, 4.869675264e-02f, 4.216964915e-02f, 3.651741147e-02f,
  3.162277490e-02f, 2.738419548e-02f, 2.371373773e-02f, 2.053525113e-02f,
  1.778279431e-02f, 1.539926510e-02f, 1.333521400e-02f, 1.154781971e-02f,
  9.999999776e-03f, 8.659643121e-03f, 7.498942316e-03f, 6.493816152e-03f,
  5.623413250e-03f, 4.869675264e-03f, 4.216964822e-03f, 3.651741194e-03f,
  3.162277630e-03f, 2.738419687e-03f, 2.371373819e-03f, 2.053525066e-03f,
  1.778279431e-03f, 1.539926510e-03f, 1.333521446e-03f, 1.154782018e-03f,
  1.000000047e-03f, 8.659643354e-04f, 7.498941850e-04f, 6.493816036e-04f,
  5.623413017e-04f, 4.869675322e-04f, 4.216965172e-04f, 3.651741135e-04f,
  3.162277571e-04f, 2.738419571e-04f, 2.371373703e-04f, 2.053525095e-04f,
  1.778279402e-04f, 1.539926598e-04f, 1.333521504e-04f, 1.154782003e-04f };

DEVI float bf2f(unsigned short u) { return __uint_as_float(((unsigned)u) << 16); }
DEVI float bflo(unsigned u) { return __uint_as_float(u << 16); }
DEVI float bfhi(unsigned u) { return __uint_as_float(u & 0xffff0000u); }
typedef float f32x2 __attribute__((ext_vector_type(2)));
typedef __bf16 bf16x2_t __attribute__((ext_vector_type(2)));
DEVI unsigned pk2(float lo, float hi) { const f32x2 v = {lo, hi}; const bf16x2_t b = __builtin_convertvector(v, bf16x2_t); return __builtin_bit_cast(unsigned, b); }
DEVI unsigned short f2bf(float f) { return (unsigned short)(pk2(f, 0.f) & 0xffffu); }
DEVI u32x2 pk4(f32x4 v) { u32x2 r; r.x = pk2(v[0], v[1]); r.y = pk2(v[2], v[3]); return r; }
DEVI f32x4 unpk4(u32x2 u) { f32x4 r; r[0] = bflo(u.x); r[1] = bfhi(u.x); r[2] = bflo(u.y); r[3] = bfhi(u.y); return r; }
constexpr float YX_SCALE = 16.0f;
DEVI unsigned pk4_fp8(f32x4 v) { int w = 0; w = __builtin_amdgcn_cvt_pk_fp8_f32(v[0], v[1], w, false); w = __builtin_amdgcn_cvt_pk_fp8_f32(v[2], v[3], w, true); return (unsigned)w; }
DEVI f32x4 unpk4_fp8(unsigned u) { f32x4 r; r[0] = __builtin_amdgcn_cvt_f32_fp8((int)u, 0); r[1] = __builtin_amdgcn_cvt_f32_fp8((int)u, 1); r[2] = __builtin_amdgcn_cvt_f32_fp8((int)u, 2); r[3] = __builtin_amdgcn_cvt_f32_fp8((int)u, 3); return r; }
DEVI f32x4 clamp4(f32x4 v, float lim) { f32x4 r; for (int i = 0; i < 4; ++i) r[i] = fminf(fmaxf(v[i], -lim), lim); return r; }
DEVI float sigmoidf_(float v) { return 1.0f / (1.0f + __expf(-v)); }
DEVI float siluf_(float v) { return v / (1.0f + __expf(-v)); }
DEVI float gamma_log2(int h) { return log2f(1.0f - exp2f(-5.0f - (float)h)); }
DEVI f32x4 mfma16(bf16x8 a, bf16x8 b, f32x4 c) { return __builtin_amdgcn_mfma_f32_16x16x32_bf16(a, b, c, 0, 0, 0); }
DEVI unsigned kf_off(int item, int dk, int m8) { return ((((unsigned)item * 4u + (unsigned)(dk >> 5)) * 4u + (unsigned)(m8 >> 4)) * 64u + (unsigned)((m8 >> 3) & 1) * 32u + (unsigned)(dk & 31)) * 8u; }
DEVI unsigned vf_off(int item, int dv, int m8) { return ((((unsigned)item * 8u + (unsigned)(dv >> 5)) * 4u + (unsigned)(m8 >> 4)) * 64u + (unsigned)((m8 >> 3) & 1) * 32u + (unsigned)(dv & 31)) * 8u; }
DEVI unsigned qf_off(int bc, int h, int tokl, int dk8, int hh) {
    return ((((((unsigned)bc * 4u + (unsigned)h) * 2u + (unsigned)(tokl >> 5)) * 4u + (unsigned)(dk8 >> 5)) * 2u + (unsigned)((dk8 >> 4) & 1)) * 64u + (unsigned)hh * 32u + (unsigned)(tokl & 31)) * 8u + (unsigned)((dk8 >> 3) & 1) * 4u; }
DEVI int vperm(int n) { const int wc = n >> 6, nt = (n >> 4) & 3, i = n & 15; return wc * 64 + (nt >> 1) * 32 + 8 * (i >> 2) + 4 * (nt & 1) + (i & 3); }
DEVI int dperm2(int v) { return ((v >> 5) & 1) * 64 + (v >> 6) * 32 + (v & 31); }
DEVI u32x4 pk8(f32x4 a, f32x4 b) { u32x4 r; r.x = pk2(a[0], a[1]); r.y = pk2(a[2], a[3]); r.z = pk2(b[0], b[1]); r.w = pk2(b[2], b[3]); return r; }
DEVI void unpk8(u32x4 u, f32x4& a, f32x4& b) { a[0] = bflo(u.x); a[1] = bfhi(u.x); a[2] = bflo(u.y); a[3] = bfhi(u.y); b[0] = bflo(u.z); b[1] = bfhi(u.z); b[2] = bflo(u.w); b[3] = bfhi(u.w); }
DEVI int dperm(int v) { const int wc = v >> 6, nt = (v >> 4) & 3, c = v & 15; return (nt & 1) * 16 + wc * 32 + c + (nt >> 1) * 64; }

struct __attribute__((aligned(16))) GemmSmem { bf16_t a[2][128 * 64]; bf16_t b[2][128 * 64]; };
constexpr int SMEM_GEMM = sizeof(GemmSmem);
constexpr int SMEM_BYTES = SMEM_GEMM + 2048 + 16;
constexpr int SMEM_HALF = (SMEM_BYTES + 255) & ~255;
constexpr int SMEM_MOE = 6144;
__shared__ __attribute__((aligned(16))) unsigned char smem_all_g[2 * SMEM_HALF + SMEM_MOE];
DEVI int gemm_src_chunk(int t) { return ((t & 7) ^ ((t >> 4) & 7)) * 8; }

template <bool SWAP, int BKIND>
DEVI void gemm_kloop(f32x4 (&acc)[4][4], const bf16_t* const (&pa)[4], const bf16_t* const (&pb)[4],
                     const float* pbf, int ldb, int nk, GemmSmem& sm) {
    const int t = VT, lane = t & 63, w = t >> 6, wr = w >> 1, wc = w & 1, l15 = lane & 15, q = lane >> 4;
    const int kg = t & 7, ng = t >> 3;
    f32x4 rf[8];
#define GEMM_ISSUE(BUF, KO) do { \
        _Pragma("unroll") for (int i = 0; i < 4; ++i) \
            __builtin_amdgcn_global_load_lds((const unsigned*)(pa[i] + (KO)), (unsigned*)((char*)sm.a[BUF] + i * 4096 + t * 16), 16, 0, 0); \
        if (BKIND == 0) { _Pragma("unroll") for (int i = 0; i < 4; ++i) \
            __builtin_amdgcn_global_load_lds((const unsigned*)(pb[i] + (KO)), (unsigned*)((char*)sm.b[BUF] + i * 4096 + t * 16), 16, 0, 0); } \
        else { const float* pp = pbf + (size_t)((KO) + 4 * kg) * ldb; \
            _Pragma("unroll") for (int i = 0; i < 4; ++i) { rf[i] = *(const f32x4*)(pp + (size_t)i * ldb); rf[4 + i] = *(const f32x4*)(pp + (size_t)(32 + i) * ldb); } } } while (0)
#define GEMM_LSTORE_B(BUF) do { if (BKIND == 1) { \
            _Pragma("unroll") for (int i = 0; i < 4; ++i) { \
                u32x2 v0, v1; \
                v0.x = pk2(rf[0][i], rf[1][i]); v0.y = pk2(rf[2][i], rf[3][i]); v1.x = pk2(rf[4][i], rf[5][i]); v1.y = pk2(rf[6][i], rf[7][i]); \
                const int n = 4 * ng + i, sw = (n >> 1) & 7; \
                char* rowp = (char*)sm.b[BUF] + n * 128 + (kg & 1) * 8; \
                *(u32x2*)(rowp + (((kg >> 1) ^ sw) * 16)) = v0; *(u32x2*)(rowp + (((4 + (kg >> 1)) ^ sw) * 16)) = v1; } } } while (0)
    GEMM_ISSUE(0, 0);
    GEMM_LSTORE_B(0);
    __syncthreads();
#define GEMM_KSTEP(CUR, KT) do { \
        const bool more = ((KT) + 1 < nk); \
        if (more) { GEMM_ISSUE((CUR) ^ 1, ((KT) + 1) * 64); } \
        __builtin_amdgcn_sched_barrier(0); \
        _Pragma("unroll") for (int ss = 0; ss < 2; ++ss) { \
            bf16x8 af[4], bfr[4]; \
            const int coff = ((ss * 4 + q) ^ (l15 >> 1)) * 16; \
            _Pragma("unroll") for (int i = 0; i < 4; ++i) { \
                af[i]  = *(const bf16x8*)((const char*)sm.a[CUR] + (wr * 64 + i * 16 + l15) * 128 + coff); \
                bfr[i] = *(const bf16x8*)((const char*)sm.b[CUR] + (wc * 64 + i * 16 + l15) * 128 + coff); } \
            _Pragma("unroll") for (int mt = 0; mt < 4; ++mt) \
                _Pragma("unroll") for (int nt = 0; nt < 4; ++nt) \
                    acc[mt][nt] = SWAP ? mfma16(bfr[nt], af[mt], acc[mt][nt]) : mfma16(af[mt], bfr[nt], acc[mt][nt]); } \
        __builtin_amdgcn_sched_barrier(0); \
        if (more) { GEMM_LSTORE_B((CUR) ^ 1); } \
        __syncthreads(); } while (0)
#pragma unroll 1
    for (int kt = 0; kt < nk; kt += 2) { GEMM_KSTEP(0, kt); GEMM_KSTEP(1, kt + 1); }
#undef GEMM_KSTEP
#undef GEMM_LSTORE_B
#undef GEMM_ISSUE
}

DEVI void zero_acc(f32x4 (&acc)[4][4]) {
#pragma unroll
    for (int i = 0; i < 4; ++i)
#pragma unroll
        for (int j = 0; j < 4; ++j) acc[i][j] = (f32x4){0.f, 0.f, 0.f, 0.f};
}

namespace pg8 {
#define PG8_LAS __attribute__((address_space(3)))
typedef unsigned short bf16_t;
typedef short bf16x8 __attribute__((ext_vector_type(8)));
typedef float f32x4 __attribute__((ext_vector_type(4)));
typedef unsigned u32x4 __attribute__((ext_vector_type(4)));
constexpr int BM = 256, BK = 64, HALF = 128, HTB = HALF * BK * 2  , STAGE_BYTES = 8 * HTB, NXCD = 8, WGM = 8;

__host__ __device__ __forceinline__ int lds_byte(int r, int c) { const int st = (r >> 4) * 2 + (c >> 5), rr = r & 15, cc = c & 31, ob = rr * 64 + cc * 2; return st * 1024 + (ob ^ (((ob >> 9) & 1) << 5)); }
__host__ __device__ __forceinline__ void stage_rc(int b, int& R, int& C) { const int st = b / 1024, sb = b % 1024, swz = sb ^ (((sb >> 9) & 1) << 5); R = (st >> 1) * 16 + swz / 64; C = (st & 1) * 32 + (swz % 64) / 2; }
__host__ __device__ __forceinline__ int perm32(int rho) { const int n = rho >> 4, i = rho & 15; return 8 * (i >> 2) + 4 * n + (i & 3); }

struct Unit { int pm, pn; };
struct Gemm { const bf16_t* A; const bf16_t* Bt; int M, N, K; };

struct StaticOrder {
    int nM, nN, nwg, G, c;
    __host__ __device__ void init(int M, int N, int G_, int c_) { nM = M / BM; nN = N / BM; nwg = nM * nN; G = G_; c = c_; }
    __host__ __device__ bool next(int i, Unit& u) const {
        const long L = (long)i * G + c; if (L >= nwg) return false;
        int wgid = (int)L; { const int q = nwg / NXCD, r = nwg % NXCD, xcd = wgid % NXCD, off = wgid / NXCD; wgid = (xcd < r ? xcd * (q + 1) : r * (q + 1) + (xcd - r) * q) + off; }
        const int nig = WGM * nN, gid = wgid / nig, fm = gid * WGM, gsz = (nM - fm) < WGM ? (nM - fm) : WGM;
        u.pm = fm + ((wgid % nig) % gsz); u.pn = (wgid % nig) / gsz; return true;
    }
    __device__ __forceinline__ void a_ready(const Unit&) const {}
    __device__ __forceinline__ void done(const Unit&) const {}
};


template <class Epi, class Sched, bool ALIGN_EPI = false, bool SP2 = false>
__device__ __forceinline__ void gemm_phase(PG8_LAS unsigned char* lds, const Gemm g, const Sched& S, const Epi& E) {
    const int tid = threadIdx.x, wid = __builtin_amdgcn_readfirstlane(tid >> 6), lane = tid & 63, wr = wid >> 2, wc = wid & 3, fr = lane & 15, fq = lane >> 4;
    const int K = g.K, nt = K / BK;
    unsigned voffA[2], voffB[2];
#pragma unroll
    for (int i = 0; i < 2; ++i) { int R, C; stage_rc(tid * 16 + i * 8192, R, C); const int Rb = Epi::PERM ? ((R & ~31) + perm32(R & 31)) : R;
        voffA[i] = (unsigned)(R * K + C) * 2u; voffB[i] = (unsigned)(Rb * K + C) * 2u; }
    const size_t kstep = (size_t)(BK * 2);
    const size_t hstep = (size_t)HALF * K * 2;
    const size_t tstep = 2 * hstep;
    const unsigned ldsw = (unsigned)wid * 1024u;
    const int aoff = lds_byte(wr * 64 + fr, fq * 8), boff = lds_byte(wc * 32 + fr, fq * 8);
#define PG8_SA(b, h) (((b) * 2 + (h)) * HTB)
#define PG8_SB(b, h) ((4 + (b) * 2 + (h)) * HTB)
#define PG8_STAGE(bufoff, gbase, voff) do { _Pragma("unroll") for (int _i = 0; _i < 2; ++_i) \
        __builtin_amdgcn_global_load_lds((const unsigned*)((const char*)(gbase) + (voff)[_i]), (PG8_LAS unsigned*)(lds + (bufoff) + ldsw + _i * 8192), 16, 0, 0); } while (0)
#define PG8_LDA(dst, b, h) do { _Pragma("unroll") for (int m = 0; m < 4; ++m) _Pragma("unroll") for (int k = 0; k < 2; ++k) dst[m][k] = *(const PG8_LAS bf16x8*)(lds + PG8_SA(b, h) + aoff + m * 2048 + k * 1024); } while (0)
#define PG8_LDB(dst, b, h) do { _Pragma("unroll") for (int n = 0; n < 2; ++n) _Pragma("unroll") for (int k = 0; k < 2; ++k) dst[n][k] = *(const PG8_LAS bf16x8*)(lds + PG8_SB(b, h) + boff + n * 2048 + k * 1024); } while (0)
#define PG8_MMA(ai, bj, At, Bt) do { __builtin_amdgcn_s_setprio(1); _Pragma("unroll") for (int m = 0; m < 4; ++m) _Pragma("unroll") for (int n = 0; n < 2; ++n) _Pragma("unroll") for (int k = 0; k < 2; ++k) \
        acc[ai][bj][m][n] = __builtin_amdgcn_mfma_f32_16x16x32_bf16(Bt[n][k], At[m][k], acc[ai][bj][m][n], 0, 0, 0); __builtin_amdgcn_s_setprio(0); } while (0)
#define PG8_WAIT_V(n) asm volatile("s_waitcnt vmcnt(" #n ")" ::: "memory")
#define PG8_WAIT_L(n) asm volatile("s_waitcnt lgkmcnt(" #n ")" ::: "memory")
#define PG8_BAR __builtin_amdgcn_s_barrier()
#define PG8_SCHED __builtin_amdgcn_sched_barrier(0)
    Unit cur, nxt; int ui = 0;
    if (!S.next(0, cur)) return;
    f32x4 acc[2][2][4][2];
#pragma unroll
    for (int a = 0; a < 2; ++a)
#pragma unroll
        for (int b = 0; b < 2; ++b)
#pragma unroll
            for (int m = 0; m < 4; ++m)
#pragma unroll
                for (int n = 0; n < 2; ++n) acc[a][b][m][n] = (f32x4){0.f, 0.f, 0.f, 0.f};
    bf16x8 At[4][2], B0[2][2], B1[2][2];
    const char* cA = (const char*)g.A + (size_t)cur.pm * tstep; const char* cB = (const char*)g.Bt + (size_t)cur.pn * tstep;
    S.a_ready(cur);
    if constexpr (SP2) {
        PG8_STAGE(PG8_SB(0, 0), cB, voffB); PG8_STAGE(PG8_SB(0, 1), cB + hstep, voffB); PG8_STAGE(PG8_SA(0, 0), cA, voffA); PG8_STAGE(PG8_SA(0, 1), cA + hstep, voffA);
        if (wr == 1) PG8_BAR;
        PG8_WAIT_V(2); PG8_BAR;
        PG8_STAGE(PG8_SB(1, 0), cB + kstep, voffB); PG8_STAGE(PG8_SA(1, 0), cA + kstep, voffA); PG8_STAGE(PG8_SB(1, 1), cB + hstep + kstep, voffB);
        PG8_WAIT_V(6); PG8_BAR;
    } else {
        PG8_STAGE(PG8_SB(0, 0), cB, voffB); PG8_STAGE(PG8_SA(0, 0), cA, voffA); PG8_STAGE(PG8_SB(0, 1), cB + hstep, voffB); PG8_STAGE(PG8_SA(0, 1), cA + hstep, voffA);
        if (wr == 1) PG8_BAR;
        PG8_WAIT_V(4); PG8_BAR;
        PG8_STAGE(PG8_SB(1, 0), cB + kstep, voffB); PG8_STAGE(PG8_SA(1, 0), cA + kstep, voffA); PG8_STAGE(PG8_SB(1, 1), cB + hstep + kstep, voffB);
        PG8_WAIT_V(6); PG8_BAR;
    }
    for (;;) {
        const bool has_next = S.next(ui + 1, nxt);
        const char* nA = has_next ? (const char*)g.A + (size_t)nxt.pm * tstep : cA; const char* nB = has_next ? (const char*)g.Bt + (size_t)nxt.pn * tstep : cB;
        for (int t = 0; t < nt; t += 2) {
            const bool last = (t == nt - 2);
            const char* a1 = cA + (size_t)(t + 1) * kstep;
            const char* a2 = last ? nA : cA + (size_t)(t + 2) * kstep; const char* b2 = last ? nB : cB + (size_t)(t + 2) * kstep;
            const char* a3 = a2 + kstep; const char* b3 = b2 + kstep;
            if (last && has_next) S.a_ready(nxt);
            if constexpr (SP2) {
            PG8_LDB(B0, 0, 0); PG8_LDB(B1, 0, 1); PG8_SCHED; PG8_LDA(At, 0, 0); PG8_STAGE(PG8_SA(1, 1), a1 + hstep, voffA);
            PG8_WAIT_V(8); PG8_WAIT_L(0); PG8_BAR; PG8_MMA(0, 0, At, B0); PG8_MMA(0, 1, At, B1); PG8_BAR; PG8_SCHED;
            PG8_LDA(At, 0, 1); PG8_STAGE(PG8_SB(0, 0), b2, voffB); PG8_STAGE(PG8_SB(0, 1), b2 + hstep, voffB); PG8_STAGE(PG8_SA(0, 0), a2, voffA);
            PG8_WAIT_V(8); PG8_WAIT_L(0); PG8_BAR; PG8_MMA(1, 0, At, B0); PG8_MMA(1, 1, At, B1); PG8_BAR; PG8_SCHED;
            PG8_LDB(B0, 1, 0); PG8_LDB(B1, 1, 1); PG8_SCHED; PG8_LDA(At, 1, 0); PG8_STAGE(PG8_SA(0, 1), a2 + hstep, voffA);
            PG8_WAIT_V(8); PG8_WAIT_L(0); PG8_BAR; PG8_MMA(0, 0, At, B0); PG8_MMA(0, 1, At, B1); PG8_BAR; PG8_SCHED;
            PG8_LDA(At, 1, 1); PG8_STAGE(PG8_SB(1, 0), b3, voffB); PG8_STAGE(PG8_SB(1, 1), b3 + hstep, voffB); PG8_STAGE(PG8_SA(1, 0), a3, voffA);
            PG8_WAIT_V(8); PG8_WAIT_L(0); PG8_BAR; PG8_MMA(1, 0, At, B0); PG8_MMA(1, 1, At, B1); PG8_BAR; PG8_SCHED;
            } else {
            PG8_LDB(B0, 0, 0); PG8_SCHED; PG8_LDA(At, 0, 0); PG8_STAGE(PG8_SA(1, 1), a1 + hstep, voffA);
            PG8_WAIT_L(8); PG8_BAR; PG8_WAIT_L(0); PG8_MMA(0, 0, At, B0); PG8_BAR; PG8_SCHED;
            PG8_LDB(B1, 0, 1); PG8_STAGE(PG8_SB(0, 0), b2, voffB);
            PG8_BAR; PG8_WAIT_L(0); PG8_MMA(0, 1, At, B1); PG8_BAR;
            PG8_LDA(At, 0, 1); PG8_STAGE(PG8_SA(0, 0), a2, voffA);
            PG8_BAR; PG8_WAIT_L(0); PG8_MMA(1, 0, At, B0); PG8_BAR; PG8_SCHED;
            PG8_STAGE(PG8_SB(0, 1), b2 + hstep, voffB);
            PG8_WAIT_V(6); PG8_BAR; PG8_MMA(1, 1, At, B1); PG8_BAR;
            PG8_LDB(B0, 1, 0); PG8_SCHED; PG8_LDA(At, 1, 0); PG8_STAGE(PG8_SA(0, 1), a2 + hstep, voffA);
            PG8_WAIT_L(8); PG8_BAR; PG8_WAIT_L(0); PG8_MMA(0, 0, At, B0); PG8_BAR; PG8_SCHED;
            PG8_LDB(B1, 1, 1); PG8_STAGE(PG8_SB(1, 0), b3, voffB);
            PG8_BAR; PG8_WAIT_L(0); PG8_MMA(0, 1, At, B1); PG8_BAR;
            PG8_LDA(At, 1, 1); PG8_STAGE(PG8_SA(1, 0), a3, voffA);
            PG8_BAR; PG8_WAIT_L(0); PG8_MMA(1, 0, At, B0); PG8_BAR; PG8_SCHED;
            PG8_STAGE(PG8_SB(1, 1), b3 + hstep, voffB);
            PG8_WAIT_V(6); PG8_BAR; PG8_MMA(1, 1, At, B1); PG8_BAR;
            }
        }
        if constexpr (ALIGN_EPI) { if (wr == 0) PG8_BAR; }
        if constexpr (!Epi::AFTER_DRAIN) { E(acc, cur, wr, wc, fr, fq); S.done(cur); }
        if (!has_next) break;
#pragma unroll
        for (int a = 0; a < 2; ++a)
#pragma unroll
            for (int b = 0; b < 2; ++b)
#pragma unroll
                for (int m = 0; m < 4; ++m)
#pragma unroll
                    for (int n = 0; n < 2; ++n) acc[a][b][m][n] = (f32x4){0.f, 0.f, 0.f, 0.f};
        cur = nxt; cA = nA; cB = nB; ++ui;
        if constexpr (ALIGN_EPI) { if (wr == 1) PG8_BAR; }
    }
    PG8_WAIT_V(0);
    if constexpr (!ALIGN_EPI) { if (wr == 0) PG8_BAR; }
    PG8_BAR;
    if constexpr (Epi::AFTER_DRAIN) { E.fused(acc, cur, wr, wc, fr, fq, lds, wid, lane); S.done(cur); }
#undef PG8_SA
#undef PG8_SB
#undef PG8_STAGE
#undef PG8_LDA
#undef PG8_LDB
#undef PG8_MMA
#undef PG8_WAIT_V
#undef PG8_WAIT_L
#undef PG8_BAR
#undef PG8_SCHED
}
template <class Epi, class Sched, bool ALIGN_EPI = false, bool SP2 = false>
__device__ __forceinline__ void gemm_phase_g(PG8_LAS unsigned char* lds, const int K, const Sched& S, const Epi& E) {
    const int tid = threadIdx.x, wid = __builtin_amdgcn_readfirstlane(tid >> 6), lane = tid & 63, wr = wid >> 2, wc = wid & 3, fr = lane & 15, fq = lane >> 4;
    const int nt = K / BK;
    unsigned voffB[2]; int rowA[2], colA[2];
#pragma unroll
    for (int i = 0; i < 2; ++i) { int R, C; stage_rc(tid * 16 + i * 8192, R, C); const int Rb = Epi::PERM ? ((R & ~31) + perm32(R & 31)) : R;
        rowA[i] = R; colA[i] = C * 2; voffB[i] = (unsigned)(Rb * K + C) * 2u; }
    const size_t kstep = (size_t)(BK * 2);
    const size_t hstep = (size_t)HALF * K * 2;
    const size_t tstep = 2 * hstep;
    const unsigned ldsw = (unsigned)wid * 1024u;
    const int aoff = lds_byte(wr * 64 + fr, fq * 8), boff = lds_byte(wc * 32 + fr, fq * 8);
#define PG8_SA(b, h) (((b) * 2 + (h)) * HTB)
#define PG8_SB(b, h) ((4 + (b) * 2 + (h)) * HTB)
#define PG8_STAGE(bufoff, gbase, voff) do { _Pragma("unroll") for (int _i = 0; _i < 2; ++_i) \
        __builtin_amdgcn_global_load_lds((const unsigned*)((const char*)(gbase) + (voff)[_i]), (PG8_LAS unsigned*)(lds + (bufoff) + ldsw + _i * 8192), 16, 0, 0); } while (0)
#define PG8_STAGEA(bufoff, P0, P1, koff) do { \
        __builtin_amdgcn_global_load_lds((const unsigned*)(Ab + (size_t)(P0) + (koff)), (PG8_LAS unsigned*)(lds + (bufoff) + ldsw), 16, 0, 0); \
        __builtin_amdgcn_global_load_lds((const unsigned*)(Ab + (size_t)(P1) + (koff)), (PG8_LAS unsigned*)(lds + (bufoff) + ldsw + 8192), 16, 0, 0); } while (0)
#define PG8_LDA(dst, b, h) do { _Pragma("unroll") for (int m = 0; m < 4; ++m) _Pragma("unroll") for (int k = 0; k < 2; ++k) dst[m][k] = *(const PG8_LAS bf16x8*)(lds + PG8_SA(b, h) + aoff + m * 2048 + k * 1024); } while (0)
#define PG8_LDB(dst, b, h) do { _Pragma("unroll") for (int n = 0; n < 2; ++n) _Pragma("unroll") for (int k = 0; k < 2; ++k) dst[n][k] = *(const PG8_LAS bf16x8*)(lds + PG8_SB(b, h) + boff + n * 2048 + k * 1024); } while (0)
#define PG8_MMA(ai, bj, At, Bt) do { __builtin_amdgcn_s_setprio(1); _Pragma("unroll") for (int m = 0; m < 4; ++m) _Pragma("unroll") for (int n = 0; n < 2; ++n) _Pragma("unroll") for (int k = 0; k < 2; ++k) \
        acc[ai][bj][m][n] = __builtin_amdgcn_mfma_f32_16x16x32_bf16(Bt[n][k], At[m][k], acc[ai][bj][m][n], 0, 0, 0); __builtin_amdgcn_s_setprio(0); } while (0)
#define PG8_WAIT_V(n) asm volatile("s_waitcnt vmcnt(" #n ")" ::: "memory")
#define PG8_WAIT_L(n) asm volatile("s_waitcnt lgkmcnt(" #n ")" ::: "memory")
#define PG8_BAR __builtin_amdgcn_s_barrier()
#define PG8_SCHED __builtin_amdgcn_sched_barrier(0)
    Unit cur, nxt, un2; int ui = 0, sb_cur = 0;
    if (!S.next(0, cur)) return;
    int fillv = S.fill_issue(cur); S.fill_write(0, fillv);
    __syncthreads();
    fillv = 0; if (S.next(1, nxt)) fillv = S.fill_issue(nxt);
    f32x4 acc[2][2][4][2];
#pragma unroll
    for (int a = 0; a < 2; ++a)
#pragma unroll
        for (int b = 0; b < 2; ++b)
#pragma unroll
            for (int m = 0; m < 4; ++m)
#pragma unroll
                for (int n = 0; n < 2; ++n) acc[a][b][m][n] = (f32x4){0.f, 0.f, 0.f, 0.f};
    bf16x8 At[4][2], B0[2][2], B1[2][2];
    const char* cB = S.b_base(cur);
    unsigned cA00, cA01, cA10, cA11, nA00, nA01, nA10, nA11;
    const char* const Ab = S.a_base();
    S.a_rows(0, rowA, colA, cA00, cA01, cA10, cA11);
    S.a_ready(cur);
    if constexpr (SP2) {
        PG8_STAGE(PG8_SB(0, 0), cB, voffB); PG8_STAGE(PG8_SB(0, 1), cB + hstep, voffB); PG8_STAGEA(PG8_SA(0, 0), cA00, cA01, 0); PG8_STAGEA(PG8_SA(0, 1), cA10, cA11, 0);
        if (wr == 1) PG8_BAR;
        PG8_WAIT_V(2); PG8_BAR;
        PG8_STAGE(PG8_SB(1, 0), cB + kstep, voffB); PG8_STAGEA(PG8_SA(1, 0), cA00, cA01, kstep); PG8_STAGE(PG8_SB(1, 1), cB + hstep + kstep, voffB);
        PG8_WAIT_V(6); PG8_BAR;
    } else {
        PG8_STAGE(PG8_SB(0, 0), cB, voffB); PG8_STAGEA(PG8_SA(0, 0), cA00, cA01, 0); PG8_STAGE(PG8_SB(0, 1), cB + hstep, voffB); PG8_STAGEA(PG8_SA(0, 1), cA10, cA11, 0);
        if (wr == 1) PG8_BAR;
        PG8_WAIT_V(4); PG8_BAR;
        PG8_STAGE(PG8_SB(1, 0), cB + kstep, voffB); PG8_STAGEA(PG8_SA(1, 0), cA00, cA01, kstep); PG8_STAGE(PG8_SB(1, 1), cB + hstep + kstep, voffB);
        PG8_WAIT_V(6); PG8_BAR;
    }
    for (;;) {
        const bool has_next = S.next(ui + 1, nxt);
        const char* nB = has_next ? S.b_base(nxt) : cB;
        const int sb_n = sb_cur == 2 ? 0 : sb_cur + 1;
        if (has_next) { S.fill_write(sb_n, fillv); if (S.next(ui + 2, un2)) fillv = S.fill_issue(un2); }
        nA00 = cA00; nA01 = cA01; nA10 = cA10; nA11 = cA11;
#pragma unroll 1
        for (int t = 0; t < nt; t += 2) {
            const bool last = (t == nt - 2);
            const size_t k1 = (size_t)(t + 1) * kstep;
            const size_t k2 = last ? 0 : (size_t)(t + 2) * kstep; const char* b2 = last ? nB : cB + (size_t)(t + 2) * kstep;
            const unsigned q00 = last ? nA00 : cA00, q01 = last ? nA01 : cA01, q10 = last ? nA10 : cA10, q11 = last ? nA11 : cA11;
            const size_t k3 = k2 + kstep; const char* b3 = b2 + kstep;
            if (last && has_next) S.a_ready(nxt);
            if constexpr (SP2) {
            PG8_LDB(B0, 0, 0); PG8_LDB(B1, 0, 1); PG8_SCHED; PG8_LDA(At, 0, 0); PG8_STAGEA(PG8_SA(1, 1), cA10, cA11, k1);
            PG8_WAIT_V(8); PG8_WAIT_L(0); PG8_BAR; PG8_MMA(0, 0, At, B0); PG8_MMA(0, 1, At, B1); PG8_BAR; PG8_SCHED;
            PG8_LDA(At, 0, 1); PG8_STAGE(PG8_SB(0, 0), b2, voffB); PG8_STAGE(PG8_SB(0, 1), b2 + hstep, voffB); PG8_STAGEA(PG8_SA(0, 0), q00, q01, k2);
            PG8_WAIT_V(8); PG8_WAIT_L(0); PG8_BAR; PG8_MMA(1, 0, At, B0); PG8_MMA(1, 1, At, B1); PG8_BAR; PG8_SCHED;
            PG8_LDB(B0, 1, 0); PG8_LDB(B1, 1, 1); PG8_SCHED; PG8_LDA(At, 1, 0); PG8_STAGEA(PG8_SA(0, 1), q10, q11, k2);
            PG8_WAIT_V(8); PG8_WAIT_L(0); PG8_BAR; PG8_MMA(0, 0, At, B0); PG8_MMA(0, 1, At, B1); PG8_BAR; PG8_SCHED;
            PG8_LDA(At, 1, 1); PG8_STAGE(PG8_SB(1, 0), b3, voffB); PG8_STAGE(PG8_SB(1, 1), b3 + hstep, voffB); PG8_STAGEA(PG8_SA(1, 0), q00, q01, k3);
            PG8_WAIT_V(8); PG8_WAIT_L(0); PG8_BAR; PG8_MMA(1, 0, At, B0); PG8_MMA(1, 1, At, B1); PG8_BAR; PG8_SCHED;
            } else {
            PG8_LDB(B0, 0, 0); PG8_SCHED; PG8_LDA(At, 0, 0); PG8_STAGEA(PG8_SA(1, 1), cA10, cA11, k1);
            PG8_WAIT_L(8); PG8_BAR; PG8_WAIT_L(0); PG8_MMA(0, 0, At, B0); PG8_BAR; PG8_SCHED;
            PG8_LDB(B1, 0, 1); PG8_STAGE(PG8_SB(0, 0), b2, voffB);
            PG8_BAR; PG8_WAIT_L(0); PG8_MMA(0, 1, At, B1); PG8_BAR;
            PG8_LDA(At, 0, 1); PG8_STAGEA(PG8_SA(0, 0), q00, q01, k2);
            PG8_BAR; PG8_WAIT_L(0); PG8_MMA(1, 0, At, B0); PG8_BAR; PG8_SCHED;
            PG8_STAGE(PG8_SB(0, 1), b2 + hstep, voffB);
            PG8_WAIT_V(6); PG8_BAR; PG8_MMA(1, 1, At, B1); PG8_BAR;
            PG8_LDB(B0, 1, 0); PG8_SCHED; PG8_LDA(At, 1, 0); PG8_STAGEA(PG8_SA(0, 1), q10, q11, k2);
            PG8_WAIT_L(8); PG8_BAR; PG8_WAIT_L(0); PG8_MMA(0, 0, At, B0); PG8_BAR; PG8_SCHED;
            PG8_LDB(B1, 1, 1); PG8_STAGE(PG8_SB(1, 0), b3, voffB);
            PG8_BAR; PG8_WAIT_L(0); PG8_MMA(0, 1, At, B1); PG8_BAR;
            PG8_LDA(At, 1, 1); PG8_STAGEA(PG8_SA(1, 0), q00, q01, k3);
            PG8_BAR; PG8_WAIT_L(0); PG8_MMA(1, 0, At, B0); PG8_BAR; PG8_SCHED;
            PG8_STAGE(PG8_SB(1, 1), b3 + hstep, voffB);
            PG8_WAIT_V(6); PG8_BAR; PG8_MMA(1, 1, At, B1); PG8_BAR;
            }
            if (t == nt - 4 && has_next) S.a_rows(sb_n, rowA, colA, nA00, nA01, nA10, nA11);
        }
        if constexpr (ALIGN_EPI) { if (wr == 0) PG8_BAR; }
        if constexpr (!Epi::AFTER_DRAIN) { E(acc, cur, wr, wc, fr, fq, sb_cur); S.done(cur); }
        if (!has_next) break;
#pragma unroll
        for (int a = 0; a < 2; ++a)
#pragma unroll
            for (int b = 0; b < 2; ++b)
#pragma unroll
                for (int m = 0; m < 4; ++m)
#pragma unroll
                    for (int n = 0; n < 2; ++n) acc[a][b][m][n] = (f32x4){0.f, 0.f, 0.f, 0.f};
        cur = nxt; cA00 = nA00; cA01 = nA01; cA10 = nA10; cA11 = nA11; cB = nB; ++ui; sb_cur = sb_n;
        if constexpr (ALIGN_EPI) { if (wr == 1) PG8_BAR; }
    }
    PG8_WAIT_V(0);
    if constexpr (!ALIGN_EPI) { if (wr == 0) PG8_BAR; }
    PG8_BAR;
    if constexpr (Epi::AFTER_DRAIN) { E.fused(acc, cur, wr, wc, fr, fq, lds, wid, lane); S.done(cur); }
#undef PG8_SA
#undef PG8_SB
#undef PG8_STAGE
#undef PG8_STAGEA
#undef PG8_LDA
#undef PG8_LDB
#undef PG8_MMA
#undef PG8_WAIT_V
#undef PG8_WAIT_L
#undef PG8_BAR
#undef PG8_SCHED
}
}

DEVI void wt_colinfo(const Params& p, int R, const float*& src, int& ld, float& scale) {
    scale = 1.0f; src = nullptr; ld = 0;
    if (R < WT_AT) {
        const int pn = R >> 8, cl = R & 255; ld = DIN_; int col = -1;
        if (pn < 4) { const int wcq = (cl >> 5) & 3; col = (pn >> 1) * 512 + (2 * (pn & 1) + (wcq >> 1)) * 128 + 64 * (cl >> 7) + 32 * (wcq & 1) + (cl & 31);
                      if (pn >= 2) scale = KSCALE_; }
        else if (pn < 8)  col = 2048 + (pn - 4) * 256 + cl;
        else if (pn < 10) { col = 3072 + (pn - 8) * 256 + cl; scale = KSCALE_; }
        else if (pn < 14) col = 5120 + (pn - 10) * 256 + cl;
        else if (pn < 22) col = 6160 + (pn - 14) * 256 + cl;
        else if (cl < 16) col = 6144 + cl;
        if (col >= 0) src = p.w_in + col;
    } else if (R < WT_RET) {
        const int Rr = R - WT_AT, pm = Rr >> 8, rl = Rr & 255; ld = DIN_; int col;
        if (pm < 2) { col = 512 + (2 * pm + ((rl >> 6) & 1)) * 128 + 64 * (rl >> 7) + (rl & 63); scale = KSCALE_; }
        else if (pm < 6)  col = 1024 + (pm - 2) * 256 + rl;
        else if (pm < 10) col = 4096 + (pm - 6) * 256 + rl;
        else              col = 3584 + (pm - 10) * 256 + rl;
        src = p.w_in + col;
    } else {
        int Rr, ldd; const float* base;
        if (R < WT_GLA)    { Rr = R - WT_RET; base = p.w_ret_out; ldd = 1024; }
        else if (R < WT_O) { Rr = R - WT_GLA; base = p.w_gla_out; ldd = 1024; }
        else if (R < WT_R) { Rr = R - WT_O;   base = p.w_o;       ldd = 1024; }
        else               { Rr = R - WT_R;   base = p.router_w;  ldd = 256; }
        src = base + ((R >= WT_R) ? ((Rr & ~127) + vperm(Rr & 127)) : Rr); ld = ldd;
    }
}

DEVI void phase0(const Params& p, unsigned char* smem) {
    const int tid = VT, nb = VG, bid = VB;
    float2* cs = (float2*)(p.ws + OFF_CS);
    for (int i = bid * 256 + tid; i < 4096 * 64; i += nb * 256) {
        const int pos = i >> 6, k = i & 63;
        const float angf = (float)pos * c_inv_freq[k];
        const double a = (double)angf;
        const double TWO_PI = 6.283185307179586476925286766559, HALF_PI = 1.5707963267948966192313216916398;
        const double kk = rint(a * (1.0 / TWO_PI));
        const double r = a - kk * TWO_PI;
        const double qd = rint(r * (1.0 / HALF_PI));
        const double y = r - qd * HALF_PI;
        const double y2 = y * y;
        double sn = y * (1.0 + y2 * (-1.0 / 6 + y2 * (1.0 / 120 + y2 * (-1.0 / 5040 + y2 * (1.0 / 362880 + y2 * (-1.0 / 39916800 + y2 * (1.0 / 6227020800.0)))))));
        double cn = 1.0 + y2 * (-0.5 + y2 * (1.0 / 24 + y2 * (-1.0 / 720 + y2 * (1.0 / 40320 + y2 * (-1.0 / 3628800 + y2 * (1.0 / 479001600.0))))));
        const int qi = ((int)qd) & 3;
        double s, c;
        if (qi == 0) { s = sn; c = cn; } else if (qi == 1) { s = cn; c = -sn; } else if (qi == 2) { s = -sn; c = -cn; } else { s = -cn; c = sn; }
        cs[i] = make_float2((float)c, (float)s);
    }
    if (bid == 0) { int* cnt = (int*)(p.ws + OFF_CNT); cnt[tid * CNT_STRIDE] = 0; }
    {
        const f32x4* xs = (const f32x4*)p.x; u32x4* xd = (u32x4*)(p.ws + OFF_XB);
        const int n8 = T_ * D_ / 8;
        for (int g = bid * 256 + tid; g < n8; g += nb * 256) {
            const f32x4 v0 = xs[2 * g], v1 = xs[2 * g + 1];
            u32x4 o; o.x = pk2(v0[0], v0[1]); o.y = pk2(v0[2], v0[3]); o.z = pk2(v1[0], v1[1]); o.w = pk2(v1[2], v1[3]);
            xd[g] = o;
        }
    }
    {
        float* tile = (float*)smem;
        bf16_t* wt = (bf16_t*)(p.ws + OFF_WT);
        const int ntask = (WT_ROWS / 64) * 16;
        for (int task = bid; task < ntask; task += nb) {
            const int rt = task >> 4, kt = task & 15, R0 = rt * 64, k0 = kt * 64;
            {
                const int n = tid & 63, kq = tid >> 6;
                const float* src; int ld; float sc; wt_colinfo(p, R0 + n, src, ld, sc);
#pragma unroll
                for (int i = 0; i < 16; ++i) { const int k = kq + 4 * i; tile[k * 65 + n] = src ? src[(size_t)(k0 + k) * ld] * sc : 0.f; }
            }
            __syncthreads();
            {
                const int n = tid >> 2, ks = (tid & 3) * 16;
                unsigned o[8];
#pragma unroll
                for (int j = 0; j < 8; ++j) o[j] = pk2(tile[(ks + 2 * j) * 65 + n], tile[(ks + 2 * j + 1) * 65 + n]);
                u32x4* dst = (u32x4*)(wt + (size_t)(R0 + n) * 1024 + k0 + ks);
                dst[0] = (u32x4){o[0], o[1], o[2], o[3]}; dst[1] = (u32x4){o[4], o[5], o[6], o[7]};
            }
            __syncthreads();
        }
    }
}

struct EpiP1N {
    static constexpr bool PERM = true, AFTER_DRAIN = false;
    unsigned char* ws;
    __device__ __forceinline__ void operator()(const pg8::f32x4 (&acc)[2][2][4][2], const pg8::Unit& u, int wr, int wc, int fr, int fq) const {
        const int pn = u.pn, row0 = u.pm * 256 + wr * 64 + fr, c8 = wc * 32 + 8 * fq;
        if (pn < 4) {
            const float2* cs = (const float2*)(ws + OFF_CS); bf16_t* Qr = (bf16_t*)(ws + (pn < 2 ? OFF_QR : OFF_KR));
            const int head = 2 * (pn & 1) + (wc >> 1), d0 = 32 * (wc & 1) + 8 * fq;
#pragma unroll
            for (int ai = 0; ai < 2; ++ai)
#pragma unroll
                for (int m = 0; m < 4; ++m) {
                    const size_t row = row0 + ai * 128 + m * 16; const int pos = (int)(row & 4095);
                    f32x4 c4[4];
#pragma unroll
                    for (int j = 0; j < 4; ++j) c4[j] = *(const f32x4*)(cs + pos * 64 + d0 + 2 * j);
                    f32x4 o1[2], o2[2];
#pragma unroll
                    for (int n = 0; n < 2; ++n)
#pragma unroll
                        for (int r = 0; r < 4; ++r) {
                            const f32x4 cc = c4[2 * n + (r >> 1)]; const float c_ = cc[(r & 1) * 2], s_ = cc[(r & 1) * 2 + 1];
                            const float x1 = acc[ai][0][m][n][r], x2 = acc[ai][1][m][n][r];
                            o1[n][r] = x1 * c_ - x2 * s_; o2[n][r] = x1 * s_ + x2 * c_;
                        }
                    *(u32x4*)(Qr + row * 512 + head * 128 + d0) = pk8(o1[0], o1[1]);
                    *(u32x4*)(Qr + row * 512 + head * 128 + 64 + d0) = pk8(o2[0], o2[1]);
                    asm volatile("" ::: "memory");
                }
        } else {
#pragma unroll
            for (int ai = 0; ai < 2; ++ai)
#pragma unroll
                for (int m = 0; m < 4; ++m) {
                    const size_t row = row0 + ai * 128 + m * 16;
#pragma unroll
                    for (int bj = 0; bj < 2; ++bj) {
                        const int cl = bj * 128 + c8;
                        f32x4 v0 = acc[ai][bj][m][0], v1 = acc[ai][bj][m][1];
                        if (pn < 8) {
#pragma unroll
                            for (int r = 0; r < 4; ++r) { v0[r] = siluf_(v0[r]); v1[r] = siluf_(v1[r]); }
                            *(u32x4*)((bf16_t*)(ws + OFF_GS) + row * 2048 + (pn - 4) * 256 + cl) = pk8(v0, v1);
                        } else if (pn < 10) {
                            *(u32x4*)((bf16_t*)(ws + OFF_QGN) + row * 512 + (pn - 8) * 256 + cl) = pk8(v0, v1);
                        } else if (pn < 14) {
#pragma unroll
                            for (int r = 0; r < 4; ++r) { v0[r] = siluf_(v0[r]); v1[r] = siluf_(v1[r]); }
                            *(u32x4*)((bf16_t*)(ws + OFF_GS) + row * 2048 + 1024 + (pn - 10) * 256 + cl) = pk8(v0, v1);
                        } else if (pn < 22) {
#pragma unroll
                            for (int r = 0; r < 4; ++r) { v0[r] = sigmoidf_(v0[r]); v1[r] = sigmoidf_(v1[r]); }
                            *(u32x4*)((bf16_t*)(ws + OFF_MG) + row * 2048 + (pn - 14) * 256 + cl) = pk8(v0, v1);
                        } else if (cl < 16) {
                            float* Ga = (float*)(ws + OFF_GA); *(f32x4*)(Ga + row * 16 + cl) = v0; *(f32x4*)(Ga + row * 16 + cl + 4) = v1;
                        }
                    }
                    asm volatile("" ::: "memory");
                }
        }
    }
};
struct EpiP1V {
    static constexpr bool PERM = true, AFTER_DRAIN = false;
    unsigned char* ws;
    __device__ __forceinline__ void operator()(const pg8::f32x4 (&acc)[2][2][4][2], const pg8::Unit& u, int wr, int wc, int fr, int fq) const {
        bf16_t* dst = (bf16_t*)(ws + (u.pm < 4 ? OFF_VRT : OFF_VGT)); const int head = u.pm & 3;
#pragma unroll
        for (int bj = 0; bj < 2; ++bj) {
            const int tok0 = u.pn * 256 + bj * 128 + wc * 32 + 8 * fq; const int item = (tok0 >> 6) * 4 + head, m0 = tok0 & 63;
#pragma unroll
            for (int ai = 0; ai < 2; ++ai)
#pragma unroll
                for (int m = 0; m < 4; ++m) {
                    *(u32x4*)(dst + vf_off(item, ai * 128 + wr * 64 + m * 16 + fr, m0)) = pk8(acc[ai][bj][m][0], acc[ai][bj][m][1]);
                    asm volatile("" ::: "memory");
                }
        }
    }
};
struct EpiP1G {
    static constexpr bool PERM = true, AFTER_DRAIN = false;
    unsigned char* ws;
    __device__ __forceinline__ void operator()(const pg8::f32x4 (&acc)[2][2][4][2], const pg8::Unit& u, int wr, int wc, int fr, int fq) const {
        bf16_t* dst = (bf16_t*)(ws + OFF_KGT);
#pragma unroll
        for (int bj = 0; bj < 2; ++bj) {
            const int tok0 = u.pn * 256 + bj * 128 + wc * 32 + 8 * fq; const int m0 = tok0 & 63;
#pragma unroll
            for (int ai = 0; ai < 2; ++ai) {
                const unsigned item = (unsigned)((tok0 >> 6) * 4 + 2 * u.pm + ai);
#pragma unroll
                for (int m = 0; m < 4; ++m) {
                    *(u32x4*)(dst + (item * 128u + (unsigned)(wr * 64 + m * 16 + fr)) * 64u + (unsigned)m0) = pk8(acc[ai][bj][m][0], acc[ai][bj][m][1]);
                    asm volatile("" ::: "memory");
                }
            }
        }
    }
};
DEVI void phase1(const Params& p, unsigned char* smem_all) {
    {
        pg8::StaticOrder S; S.init(T_, 5888, RG, RB);
        pg8::Gemm g; g.A = (const bf16_t*)(p.ws + OFF_XB); g.Bt = (const bf16_t*)(p.ws + OFF_WT) + (size_t)WT_BN * 1024; g.M = T_; g.N = 5888; g.K = 1024;
        EpiP1N E; E.ws = p.ws;
        pg8::gemm_phase<EpiP1N, pg8::StaticOrder, true, true>((PG8_LAS unsigned char*)smem_all, g, S, E);
    }
    __syncthreads();
    {
        pg8::StaticOrder S; S.init(2048, T_, RG, RB);
        pg8::Gemm g; g.A = (const bf16_t*)(p.ws + OFF_WT) + (size_t)(WT_AT + 512) * 1024; g.Bt = (const bf16_t*)(p.ws + OFF_XB); g.M = 2048; g.N = T_; g.K = 1024;
        EpiP1V E; E.ws = p.ws;
        pg8::gemm_phase<EpiP1V, pg8::StaticOrder, true, true>((PG8_LAS unsigned char*)smem_all, g, S, E);
    }
    __syncthreads();
    {
        pg8::StaticOrder S; S.init(512, T_, RG, RB);
        pg8::Gemm g; g.A = (const bf16_t*)(p.ws + OFF_WT) + (size_t)(WT_AT + 2560) * 1024; g.Bt = (const bf16_t*)(p.ws + OFF_XB); g.M = 512; g.N = T_; g.K = 1024;
        EpiP1G E; E.ws = p.ws;
        pg8::gemm_phase<EpiP1G, pg8::StaticOrder, true, true>((PG8_LAS unsigned char*)smem_all, g, S, E);
    }
}

DEVI void phase2(const Params& p, unsigned char* smem) {
    float* ga_s = (float*)smem;
    float* tot = (float*)(smem + 4096);
    const int tid = VT;
    const float* Ga = (const float*)(p.ws + OFF_GA);
    const bf16_t* Kgt = (const bf16_t*)(p.ws + OFF_KGT); bf16_t* Kg2 = (bf16_t*)(p.ws + OFF_KG2);
    float* dec = (float*)(p.ws + OFF_DEC);
    for (int it = VB; it < 2048; it += VG) {
        const int h = it & 3, c = (it >> 2) & 63, b = it >> 8;
        const int tok0 = b * 4096 + c * 64;
        ((f32x4*)ga_s)[tid] = ((const f32x4*)(Ga + (size_t)tok0 * 16))[tid];
        const int dk = tid & 127, half = tid >> 7;
        float w2[16];
#pragma unroll
        for (int r = 0; r < 16; ++r) w2[r] = p.gate_w2[r * 512 + h * 128 + dk];
        const float bias = p.gate_b[h * 128 + dk];
        __syncthreads();
        float run = 0.f; float bc[32];
#pragma unroll
        for (int ml = 0; ml < 32; ++ml) {
            const int m = half * 32 + ml;
            float z = bias;
#pragma unroll
            for (int r4 = 0; r4 < 4; ++r4) { const f32x4 g4 = *(const f32x4*)&ga_s[m * 16 + 4 * r4];
                z += g4[0] * w2[4 * r4] + g4[1] * w2[4 * r4 + 1] + g4[2] * w2[4 * r4 + 2] + g4[3] * w2[4 * r4 + 3]; }
            const float la = (fminf(z, 0.f) - __logf(1.0f + __expf(-fabsf(z)))) * (1.0f / 16.0f);
            run += la; bc[ml] = run;
        }
        tot[half * 128 + dk] = run;
        __syncthreads();
        const float t0 = tot[dk], t1 = tot[128 + dk];
        const float bend = t0 + t1, off = half ? t0 : 0.f;
        const u32x4* kp = (const u32x4*)(Kgt + ((size_t)it * 128 + dk) * 64 + half * 32);
        bf16_t* const kqb = Kg2;
#pragma unroll
        for (int j = 0; j < 4; ++j) {
            u32x4 v = kp[j];
            unsigned uu[4] = {v.x, v.y, v.z, v.w};
#pragma unroll
            for (int e = 0; e < 4; ++e) {
                const float f0 = bflo(uu[e]) * __expf(bend - (bc[8 * j + 2 * e] + off));
                const float f1 = bfhi(uu[e]) * __expf(bend - (bc[8 * j + 2 * e + 1] + off));
                uu[e] = pk2(f0, f1);
            }
            *(u32x4*)(kqb + kf_off(it, dk, half * 32 + 8 * j)) = (u32x4){uu[0], uu[1], uu[2], uu[3]};
        }
        if (half == 0) dec[(size_t)it * 128 + dk] = __expf(bend);
        {
            const bf16_t* Qn = (const bf16_t*)(p.ws + OFF_QGN); bf16_t* QF = (bf16_t*)(p.ws + OFF_QG);
            const int m = tid & 63, qd = tid >> 6, bc = b * 64 + c;
            const u32x4* qs = (const u32x4*)(Qn + ((size_t)tok0 + m) * 512 + h * 128 + 32 * qd);
            u32x4 qv[4];
#pragma unroll
            for (int j = 0; j < 4; ++j) qv[j] = qs[j];
#pragma unroll
            for (int j = 0; j < 4; ++j) {
                *(u32x2*)(QF + qf_off(bc, h, m, 32 * qd + 8 * j, 0)) = (u32x2){qv[j].x, qv[j].y};
                *(u32x2*)(QF + qf_off(bc, h, m, 32 * qd + 8 * j, 1)) = (u32x2){qv[j].z, qv[j].w};
            }
        }
        __syncthreads();
    }
    {
        bf16_t* tile = (bf16_t*)smem;
        const bf16_t* Kr = (const bf16_t*)(p.ws + OFF_KR); bf16_t* Krt = (bf16_t*)(p.ws + OFF_KRT);
        for (int it = VB; it < 2048; it += VG) {
            const int h = it & 3, c = (it >> 2) & 63, b = it >> 8;
            const size_t tok0 = (size_t)b * 4096 + c * 64;
            const int m = tid & 63, qd = tid >> 6;
            const float kd = exp2f(gamma_log2(h) * (float)(63 - m));
            const u32x4* src = (const u32x4*)(Kr + (tok0 + m) * 512 + h * 128 + 32 * qd);
            u32x4 v[4];
#pragma unroll
            for (int j = 0; j < 4; ++j) v[j] = src[j];
#pragma unroll
            for (int j = 0; j < 4; ++j) {
                const unsigned uu[4] = {v[j].x, v[j].y, v[j].z, v[j].w};
#pragma unroll
                for (int e = 0; e < 4; ++e) {
                    const int dk = 32 * qd + 8 * j + 2 * e;
                    tile[dk * 72 + m] = f2bf(bflo(uu[e]) * kd); tile[(dk + 1) * 72 + m] = f2bf(bfhi(uu[e]) * kd);
                }
            }
            {
                const bf16_t* Qr = (const bf16_t*)(p.ws + OFF_QR); bf16_t* QF = (bf16_t*)(p.ws + OFF_QFR);
                const u32x4* qs = (const u32x4*)(Qr + (tok0 + m) * 512 + h * 128 + 32 * qd);
                u32x4 qv[4];
#pragma unroll
                for (int j = 0; j < 4; ++j) qv[j] = qs[j];
                const int bc = b * 64 + c;
#pragma unroll
                for (int j = 0; j < 4; ++j) {
                    *(u32x2*)(QF + qf_off(bc, h, m, 32 * qd + 8 * j, 0)) = (u32x2){qv[j].x, qv[j].y};
                    *(u32x2*)(QF + qf_off(bc, h, m, 32 * qd + 8 * j, 1)) = (u32x2){qv[j].z, qv[j].w};
                }
            }
            __syncthreads();
            {
                const int dk = tid >> 1, hf = tid & 1;
#pragma unroll
                for (int j = 0; j < 4; ++j) *(u32x4*)(Krt + kf_off(it, dk, hf * 32 + 8 * j)) = *(const u32x4*)&tile[dk * 72 + hf * 32 + 8 * j];
            }
            __syncthreads();
        }
    }
}

typedef float f32x16 __attribute__((ext_vector_type(16)));
DEVI f32x16 mfma32(bf16x8 a, bf16x8 b, f32x16 c) { return __builtin_amdgcn_mfma_f32_32x32x16_bf16(a, b, c, 0, 0, 0); }
#ifndef SCAN_DEPTH
#define SCAN_DEPTH 1
#endif
struct ScanSet { bf16x8 kf[4], vf[4], qf[2][2]; f32x4 dc[4]; };
template <bool GLA>
DEVI void scan_tile(const Params& p, unsigned char* zb  , int b, int h, int s, int dummy) {
    const int t = VT >> 6, lane = VT & 63, r = lane & 31, hh = lane >> 5;
    const bf16_t* Ktb = (const bf16_t*)(p.ws + (GLA ? OFF_KG2 : OFF_KRT));
    const bf16_t* Vtb = (const bf16_t*)(p.ws + (GLA ? OFF_VGT : OFF_VRT));
    const bf16_t* Qb  = (const bf16_t*)(p.ws + (GLA ? OFF_QG : OFF_QFR));
    const float* dec = (const float*)(p.ws + OFF_DEC);
    bf16_t* Oo = (bf16_t*)(p.ws + OFF_OO);
    const float lg = gamma_log2(h);
    const float cd = exp2f(lg * 64.0f);
    f32x16 S;
#pragma unroll
    for (int i = 0; i < 16; ++i) S[i] = 0.f;
    const unsigned it0 = (unsigned)(b * 64 * 4 + h);
    const bf16_t* const kp = Ktb + ((size_t)it0 * 4 + t) * 4 * 512; const unsigned ko = (unsigned)lane * 8;
    const bf16_t* const vp = Vtb + ((size_t)it0 * 8 + s) * 4 * 512; const unsigned vo = (unsigned)lane * 8;
    const bf16_t* const qp = Qb + ((((size_t)(b * 64) * 4 + h) * 2) * 4 + t) * 2 * 512; const unsigned qo = (unsigned)lane * 8;
    const float* const dp = dec + (size_t)it0 * 128 + t * 32; const unsigned dofs = 4 * hh;
    const int rt = t >> 1, rg0 = 2 * (t & 1);
    bf16_t* const op = Oo + (size_t)b * 4096 * 2048 + (GLA ? 1024 : 0) + h * 256 + s * 32 + (size_t)rt * 32 * 2048; const unsigned oo = (unsigned)r * 2048 + 4 * hh;
    const float qd = GLA ? 1.0f : exp2f(lg * (float)(32 * rt + r + 1));
    bf16_t* const ob = Oo + (size_t)b * 4096 * 2048 + (GLA ? 1024 : 0) + h * 256 + s * 32;
#define ST_LOAD(SET, C) do { const int c_ = dummy ? 0 : ((C) < 64 ? (C) : 63); \
        const bf16_t* kq = kp + (size_t)c_ * (4 * 16 * 512) + ko; const bf16_t* vq = vp + (size_t)c_ * (4 * 32 * 512) + vo; const bf16_t* qq = qp + (size_t)c_ * (4 * 16 * 512) + qo; \
        _Pragma("unroll") for (int ks = 0; ks < 4; ++ks) { (SET).kf[ks] = *(const bf16x8*)(kq + ks * 512); (SET).vf[ks] = *(const bf16x8*)(vq + ks * 512); } \
        _Pragma("unroll") for (int ss = 0; ss < 2; ++ss) _Pragma("unroll") for (int tt = 0; tt < 2; ++tt) (SET).qf[ss][tt] = *(const bf16x8*)(qq + tt * (8 * 512) + ss * 512); \
        } while (0)
#define ST_LOADDC(SET, C) do { if (GLA) { const int c_ = (C) < 64 ? (C) : 63; const float* dq = dp + (size_t)c_ * (4 * 128) + dofs; \
        _Pragma("unroll") for (int g = 0; g < 4; ++g) (SET).dc[g] = *(const f32x4*)(dq + 8 * g); } } while (0)
#define ST_Z(SET, ZC) do { \
        _Pragma("unroll") for (int tt = 0; tt < 2; ++tt) { \
            f32x16 Zt; _Pragma("unroll") for (int i = 0; i < 16; ++i) Zt[i] = 0.f; \
            _Pragma("unroll") for (int ss = 0; ss < 2; ++ss) { \
                u32x4 pk; pk.x = pk2(S[8 * ss + 0], S[8 * ss + 1]); pk.y = pk2(S[8 * ss + 2], S[8 * ss + 3]); pk.z = pk2(S[8 * ss + 4], S[8 * ss + 5]); pk.w = pk2(S[8 * ss + 6], S[8 * ss + 7]); \
                Zt = mfma32(__builtin_bit_cast(bf16x8, pk), (SET).qf[ss][tt], Zt); } \
            _Pragma("unroll") for (int g = 0; g < 4; ++g) { \
                f32x4 z4; z4[0] = Zt[4 * g]; z4[1] = Zt[4 * g + 1]; z4[2] = Zt[4 * g + 2]; z4[3] = Zt[4 * g + 3]; \
                *(u32x2*)((ZC) + (((t * 2 + tt) * 4 + g) * 64 + lane) * 8) = pk4(z4); } } } while (0)
#define ST_UPD(SET) do { \
        if (GLA) { _Pragma("unroll") for (int g = 0; g < 4; ++g) _Pragma("unroll") for (int i = 0; i < 4; ++i) S[4 * g + i] *= (SET).dc[g][i]; } \
        else { _Pragma("unroll") for (int i = 0; i < 16; ++i) S[i] *= cd; } \
        _Pragma("unroll") for (int ks = 0; ks < 4; ++ks) S = mfma32((SET).kf[ks], (SET).vf[ks], S); } while (0)
#define ST_STEP(CUR, NXT, OTH, C) do { \
        ST_LOAD(NXT, (C) + SCAN_DEPTH); ST_LOADDC(OTH, (C) + 1);      \
        __builtin_amdgcn_sched_barrier(0); \
        unsigned char* zc = zb + ((C) & 1) * 16384; \
        if (GLA) { ST_UPD(CUR); ST_Z(CUR, zc); } else { ST_Z(CUR, zc); ST_UPD(CUR); } \
        __syncthreads(); \
        _Pragma("unroll") for (int gi = 0; gi < 2; ++gi) { const int g = rg0 + gi; \
            f32x4 o = (f32x4){0.f, 0.f, 0.f, 0.f}; \
            _Pragma("unroll") for (int t2 = 0; t2 < 4; ++t2) o += unpk4(*(const u32x2*)(zc + (((t2 * 2 + rt) * 4 + g) * 64 + lane) * 8)); \
            *(u32x2*)(zb + 32768 + ((C) & 7) * 4096 + (32 * rt + r) * 64 + (8 * g + 4 * hh) * 2) = pk4(o * qd); } \
          \
        if (((C) & 7) == 7) { __syncthreads(); \
            _Pragma("unroll") for (int i = 0; i < 8; ++i) { const int idx = i * 256 + VT, row = idx >> 2, part = idx & 3; \
                *(u32x4*)(ob + ((size_t)((C) - 7) * 64 + row) * 2048 + part * 8) = *(const u32x4*)(zb + 32768 + row * 64 + part * 16); } } } while (0)
#if SCAN_DEPTH == 2
    ScanSet A, B, Cc;
    ST_LOAD(A, 0); ST_LOADDC(A, 0); ST_LOAD(B, 1);
#pragma unroll 1
    for (int c0 = 0; c0 < 63; c0 += 3) { ST_STEP(A, Cc, B, c0); ST_STEP(B, A, Cc, c0 + 1); ST_STEP(Cc, B, A, c0 + 2); }
    ST_STEP(A, Cc, B, 63);
#else
    ScanSet A, B;
    ST_LOAD(A, 0); ST_LOADDC(A, 0);
#pragma unroll 1
    for (int c0 = 0; c0 < 64; c0 += 2) { ST_STEP(A, B, B, c0); ST_STEP(B, A, A, c0 + 1); }
#endif
    __syncthreads();
#undef ST_STEP
#undef ST_UPD
#undef ST_Z
#undef ST_LOADDC
#undef ST_LOAD
}
DEVI void phase3t(const Params& p, unsigned char* smem, int dummy) {
    for (int it0 = VB; it0 < 512; it0 += VG) {
        const int lcl = (RB >> 3) * 2 + VH;
        const int it = (VG == 512) ? ((RB & 7) * 8 + lcl / 8) * 8 + (lcl & 7) : it0;
        const int s = it & 7, h = (it >> 3) & 3, b = (it >> 5) & 7, br = it >> 8;
        if (br == 0) scan_tile<false>(p, smem, b, h, s, dummy); else scan_tile<true>(p, smem, b, h, s, dummy);
    }
}

constexpr int PS_LD = 72;
DEVI void phase4(const Params& p, unsigned char* smem) {
    const int t = VT, lane = t & 63, w = t >> 6, l15 = lane & 15, q = lane >> 4;
    bf16_t* Ps = (bf16_t*)smem + w * 16 * PS_LD;
    const bf16_t* Qr = (const bf16_t*)(p.ws + OFF_QR); const bf16_t* Kr = (const bf16_t*)(p.ws + OFF_KR);
    const bf16_t* Vrt = (const bf16_t*)(p.ws + OFF_VRT); const bf16_t* Oo = (const bf16_t*)(p.ws + OFF_OO);
    const bf16_t* Gs = (const bf16_t*)(p.ws + OFF_GS); bf16_t* Y = (bf16_t*)(p.ws + OFF_Y);
    for (int it = VB; it < 4096; it += VG) {
        const int br = it >> 11, idx = it & 2047;
        const int h = idx & 3, c = (idx >> 2) & 63, b = idx >> 8;
        const size_t tok0 = (size_t)b * 4096 + c * 64;
        const size_t tok = tok0 + 16 * w + l15;
        f32x4 O[16];
        const bf16_t* orow = Oo + tok * 2048 + br * 1024 + h * 256 + 4 * q;
        const bf16_t* grow = Gs + tok * 2048 + br * 1024 + h * 256 + 4 * q;
        u32x2 oraw[16], graw[16];
        if (br == 0) {
            const float lg = gamma_log2(h);
            bf16x8 vf[8][2];
#pragma unroll
            for (int nt = 0; nt < 8; ++nt) { vf[nt][0] = *(const bf16x8*)(Vrt + vf_off(idx, 16 * nt + l15, q * 8)); vf[nt][1] = *(const bf16x8*)(Vrt + vf_off(idx, 16 * nt + l15, 32 + q * 8)); }
            __builtin_amdgcn_sched_barrier(0);
            f32x4 P[4] = {(f32x4){0.f, 0.f, 0.f, 0.f}, (f32x4){0.f, 0.f, 0.f, 0.f}, (f32x4){0.f, 0.f, 0.f, 0.f}, (f32x4){0.f, 0.f, 0.f, 0.f}};
#pragma unroll
            for (int ks = 0; ks < 4; ++ks) {
                const bf16x8 qf = *(const bf16x8*)(Qr + tok * 512 + h * 128 + ks * 32 + q * 8);
#pragma unroll
                for (int mt = 0; mt < 4; ++mt) {
                    const bf16x8 kf = *(const bf16x8*)(Kr + (tok0 + 16 * mt + l15) * 512 + h * 128 + ks * 32 + q * 8);
                    P[mt] = mfma16(kf, qf, P[mt]);
                }
            }
            const int j = 16 * w + l15;
#pragma unroll
            for (int mt = 0; mt < 4; ++mt) {
                f32x4 v = P[mt];
#pragma unroll
                for (int r = 0; r < 4; ++r) { const int m = 16 * mt + 4 * q + r; const int dd = j > m ? j - m : m - j; v[r] *= exp2f(lg * (float)dd); }
                *(u32x2*)&Ps[l15 * PS_LD + 16 * mt + 4 * q] = pk4(v);
            }
            __syncthreads();
            const bf16x8 pf0 = *(const bf16x8*)&Ps[l15 * PS_LD + q * 8];
            const bf16x8 pf1 = *(const bf16x8*)&Ps[l15 * PS_LD + 32 + q * 8];
            __builtin_amdgcn_sched_barrier(0);
#pragma unroll
            for (int nt = 0; nt < 8; ++nt) {
                f32x4 o = (f32x4){0.f, 0.f, 0.f, 0.f};
                o = mfma16(vf[nt][0], pf0, o); O[nt] = mfma16(vf[nt][1], pf1, o);
            }
            __builtin_amdgcn_sched_barrier(0);
#pragma unroll
            for (int nt = 0; nt < 8; ++nt) { vf[nt][0] = *(const bf16x8*)(Vrt + vf_off(idx, 16 * (8 + nt) + l15, q * 8)); vf[nt][1] = *(const bf16x8*)(Vrt + vf_off(idx, 16 * (8 + nt) + l15, 32 + q * 8)); }
#pragma unroll
            for (int nt = 0; nt < 16; ++nt) { oraw[nt] = *(const u32x2*)(orow + 16 * nt); graw[nt] = *(const u32x2*)(grow + 16 * nt); }
            __builtin_amdgcn_sched_barrier(0);
#pragma unroll
            for (int nt = 0; nt < 8; ++nt) {
                f32x4 o = (f32x4){0.f, 0.f, 0.f, 0.f};
                o = mfma16(vf[nt][0], pf0, o); O[8 + nt] = mfma16(vf[nt][1], pf1, o);
            }
#pragma unroll
            for (int nt = 0; nt < 16; ++nt) O[nt] += unpk4(oraw[nt]);
            __syncthreads();
        } else {
#pragma unroll
            for (int nt = 0; nt < 16; ++nt) { oraw[nt] = *(const u32x2*)(orow + 16 * nt); graw[nt] = *(const u32x2*)(grow + 16 * nt); }
#pragma unroll
            for (int nt = 0; nt < 16; ++nt) O[nt] = unpk4(oraw[nt]);
        }
        float s1 = 0.f;
#pragma unroll
        for (int nt = 0; nt < 16; ++nt) s1 += (O[nt][0] + O[nt][1]) + (O[nt][2] + O[nt][3]);
        s1 += __shfl_xor(s1, 16); s1 += __shfl_xor(s1, 32);
        const float mean = (br == 0) ? s1 * (1.0f / 256.0f) : 0.f;
        float s2 = 0.f;
#pragma unroll
        for (int nt = 0; nt < 16; ++nt) {
#pragma unroll
            for (int r = 0; r < 4; ++r) { const float dlt = O[nt][r] - mean; s2 += dlt * dlt; }
        }
        s2 += __shfl_xor(s2, 16); s2 += __shfl_xor(s2, 32);
        const float rstd = rsqrtf(s2 * (1.0f / 256.0f) + (br == 0 ? 1e-5f : 1e-6f));
        const float* gw = (br == 0 ? p.ret_norm_g : p.gla_norm_g) + h * 256 + 4 * q;
        bf16_t* yrow = Y + ((size_t)br * T_ + tok) * 1024 + h * 256 + 4 * q;
#pragma unroll
        for (int nt = 0; nt < 16; ++nt) {
            const f32x4 g = *(const f32x4*)(gw + 16 * nt);
            const f32x4 gate = unpk4(graw[nt]);
            f32x4 y;
#pragma unroll
            for (int r = 0; r < 4; ++r) y[r] = (O[nt][r] - mean) * rstd * g[r] * gate[r];
            *(u32x2*)(yrow + 16 * nt) = pk4(y);
        }
    }
}

struct EpiMerge {
    static constexpr bool PERM = true, AFTER_DRAIN = false;
    const bf16_t* Mg; bf16_t* Mrg; int pass;
    __device__ __forceinline__ void operator()(const pg8::f32x4 (&acc)[2][2][4][2], const pg8::Unit& u, int wr, int wc, int fr, int fq) const {
        const int row0 = u.pm * 256 + wr * 64 + fr, col0 = u.pn * 256 + wc * 32 + 8 * fq;
#pragma unroll
        for (int ai = 0; ai < 2; ++ai) {
            u32x4 gg[4][2], pr[4][2];
#pragma unroll
            for (int m = 0; m < 4; ++m)
#pragma unroll
                for (int bj = 0; bj < 2; ++bj) {
                    const size_t row = row0 + ai * 128 + m * 16; const int col = col0 + bj * 128;
                    gg[m][bj] = *(const u32x4*)(Mg + row * 2048 + pass * 1024 + col);
                    if (pass) pr[m][bj] = *(const u32x4*)(Mrg + row * 1024 + col);
                }
#pragma unroll
            for (int m = 0; m < 4; ++m)
#pragma unroll
                for (int bj = 0; bj < 2; ++bj) {
                    const size_t row = row0 + ai * 128 + m * 16; const int col = col0 + bj * 128;
                    f32x4 g0, g1; unpk8(gg[m][bj], g0, g1);
                    f32x4 o0 = acc[ai][bj][m][0] * g0, o1 = acc[ai][bj][m][1] * g1;
                    if (pass) { f32x4 p0, p1; unpk8(pr[m][bj], p0, p1); o0 += p0; o1 += p1; }
                    *(u32x4*)(Mrg + row * 1024 + col) = pk8(o0, o1);
                }
        }
    }
};
DEVI void phase5(const Params& p, unsigned char* smem_all) {
    pg8::StaticOrder S; S.init(T_, 1024, RG, RB);
    const bf16_t* Y = (const bf16_t*)(p.ws + OFF_Y); const bf16_t* wt = (const bf16_t*)(p.ws + OFF_WT);
    for (int pass = 0; pass < 2; ++pass) {
        pg8::Gemm g; g.A = Y + (size_t)pass * T_ * 1024; g.Bt = wt + (size_t)(pass ? WT_GLA : WT_RET) * 1024; g.M = T_; g.N = 1024; g.K = 1024;
        EpiMerge E; E.Mg = (const bf16_t*)(p.ws + OFF_MG); E.Mrg = (bf16_t*)(p.ws + OFF_MRG); E.pass = pass;
        pg8::gemm_phase<EpiMerge, pg8::StaticOrder, true, true>((PG8_LAS unsigned char*)smem_all, g, S, E);
        __syncthreads();
    }
}

struct EpiResid {
    static constexpr bool PERM = true, AFTER_DRAIN = false;
    const float* x; bf16_t* T1;
    __device__ __forceinline__ void operator()(const pg8::f32x4 (&acc)[2][2][4][2], const pg8::Unit& u, int wr, int wc, int fr, int fq) const {
        const int row0 = u.pm * 256 + wr * 64 + fr, col0 = u.pn * 256 + wc * 32 + 8 * fq;
#pragma unroll
        for (int ai = 0; ai < 2; ++ai)
#pragma unroll
            for (int m = 0; m < 4; ++m) {
                const size_t row = row0 + ai * 128 + m * 16;
                f32x4 xv[2][2];
#pragma unroll
                for (int bj = 0; bj < 2; ++bj) { xv[bj][0] = *(const f32x4*)(x + row * 1024 + col0 + bj * 128); xv[bj][1] = *(const f32x4*)(x + row * 1024 + col0 + bj * 128 + 4); }
#pragma unroll
                for (int bj = 0; bj < 2; ++bj)
                    *(u32x4*)(T1 + row * 1024 + col0 + bj * 128) = pk8(xv[bj][0] * ALPHA_ + acc[ai][bj][m][0], xv[bj][1] * ALPHA_ + acc[ai][bj][m][1]);
            }
    }
};
DEVI void phase6(const Params& p, unsigned char* smem_all) {
    pg8::StaticOrder S; S.init(T_, 1024, RG, RB);
    pg8::Gemm g; g.A = (const bf16_t*)(p.ws + OFF_MRG); g.Bt = (const bf16_t*)(p.ws + OFF_WT) + (size_t)WT_O * 1024; g.M = T_; g.N = 1024; g.K = 1024;
    EpiResid E; E.x = p.x; E.T1 = (bf16_t*)(p.ws + OFF_T1);
    pg8::gemm_phase<EpiResid, pg8::StaticOrder, true, true>((PG8_LAS unsigned char*)smem_all, g, S, E);
}

DEVI void conv_expert_weights(const Params& p, unsigned char* smem) {
    bf16_t* tile = (bf16_t*)smem;
    const int t = VT, ng = t & 31, kg = t >> 5;
    bf16_t* WGU = (bf16_t*)(p.ws + OFF_WGU); bf16_t* WD = (bf16_t*)(p.ws + OFF_WD);
    const int ntask = 257 * 3 * 32;
    for (int task = VB; task < ntask; task += VG) {
        const int e = task / 96, rem = task - e * 96, mat = rem >> 5, tl = rem & 31;
        const float* src; bf16_t* dst; int K, N, kt, nt;
        if (mat < 2) { K = 1024; N = 256; kt = tl >> 1; nt = tl & 1;
            src = (mat == 0) ? (e < 256 ? p.ew_gate + (size_t)e * 262144 : p.sw_gate) : (e < 256 ? p.ew_up + (size_t)e * 262144 : p.sw_up);
            dst = WGU + (size_t)e * 524288 + (size_t)(nt + mat) * 131072; }
        else { K = 256; N = 1024; kt = tl >> 3; nt = tl & 7;
            src = e < 256 ? p.ew_down + (size_t)e * 262144 : p.sw_down; dst = WD + (size_t)e * 262144; }
        const float* sp = src + (size_t)(kt * 64 + 4 * kg) * N + nt * 128 + 4 * ng;
        f32x4 rf[8];
#pragma unroll
        for (int i = 0; i < 4; ++i) { rf[i] = *(const f32x4*)(sp + (size_t)i * N); rf[4 + i] = *(const f32x4*)(sp + (size_t)(32 + i) * N); }
#pragma unroll
        for (int i = 0; i < 4; ++i) {
            u32x2 v0, v1;
            v0.x = pk2(rf[0][i], rf[1][i]); v0.y = pk2(rf[2][i], rf[3][i]); v1.x = pk2(rf[4][i], rf[5][i]); v1.y = pk2(rf[6][i], rf[7][i]);
            *(u32x2*)&tile[(4 * ng + i) * 72 + 4 * kg] = v0; *(u32x2*)&tile[(4 * ng + i) * 72 + 32 + 4 * kg] = v1;
        }
        __syncthreads();
        {
            const int n = t >> 1, hf = t & 1;
            bf16_t* dp = dst + (size_t)(nt * 128 + n) * K + kt * 64 + hf * 32;
#pragma unroll
            for (int j = 0; j < 4; ++j) *(u32x4*)(dp + 8 * j) = *(const u32x4*)&tile[n * 72 + hf * 32 + 8 * j];
        }
        __syncthreads();
    }
}

DEVI void phase7(const Params& p, unsigned char* smem) {
    const int t = VT, lane = t & 63, w = t >> 6;
    const bf16_t* T1 = (const bf16_t*)(p.ws + OFF_T1); bf16_t* X1b = (bf16_t*)(p.ws + OFF_X1B);
    for (int row = VB * 4 + w; row < T_; row += VG * 4) {
        f32x4 v[4]; float s = 0.f;
#pragma unroll
        for (int i = 0; i < 4; ++i) { v[i] = unpk4(*(const u32x2*)(T1 + (size_t)row * 1024 + i * 256 + lane * 4)); s += (v[i][0] + v[i][1]) + (v[i][2] + v[i][3]); }
#pragma unroll
        for (int o = 32; o > 0; o >>= 1) s += __shfl_xor(s, o);
        const float mean = s * (1.0f / 1024.0f); float s2 = 0.f;
#pragma unroll
        for (int i = 0; i < 4; ++i)
#pragma unroll
            for (int r = 0; r < 4; ++r) { const float d = v[i][r] - mean; s2 += d * d; }
#pragma unroll
        for (int o = 32; o > 0; o >>= 1) s2 += __shfl_xor(s2, o);
        const float rstd = rsqrtf(s2 * (1.0f / 1024.0f) + 1e-5f);
#pragma unroll
        for (int i = 0; i < 4; ++i) {
            const int col = i * 256 + lane * 4;
            const f32x4 g = *(const f32x4*)(p.ln1_g + col), bb = *(const f32x4*)(p.ln1_b + col);
            f32x4 y;
#pragma unroll
            for (int r = 0; r < 4; ++r) y[r] = (v[i][r] - mean) * rstd * g[r] + bb[r];
            *(u32x2*)(X1b + (size_t)row * 1024 + col) = pk4(y);
        }
    }
    conv_expert_weights(p, smem);
}

DEVI void phase8(const Params& p, unsigned char* smem) {
    GemmSmem& sm = *(GemmSmem*)smem;
    const int t = VT, lane = t & 63, w = t >> 6, wr = w >> 1, wc = w & 1, l15 = lane & 15, q = lane >> 4;
    const bf16_t* X1b = (const bf16_t*)(p.ws + OFF_X1B); const bf16_t* wt = (const bf16_t*)(p.ws + OFF_WT);
    float* LG = (float*)(p.ws + OFF_LOG);
    for (int tile = VB; tile < 256 * 2; tile += VG) {
        const int mtg = tile >> 1, ntg = tile & 1, m0 = mtg * 128, n0 = ntg * 128;
        const bf16_t* pa0 = X1b + (size_t)(m0 + (t >> 3)) * 1024 + gemm_src_chunk(t);
        const bf16_t* pb0 = wt + (size_t)(WT_R + n0 + (t >> 3)) * 1024 + gemm_src_chunk(t);
        const bf16_t* const pa[4] = {pa0, pa0 + 32 * 1024, pa0 + 64 * 1024, pa0 + 96 * 1024};
        const bf16_t* const pb[4] = {pb0, pb0 + 32 * 1024, pb0 + 64 * 1024, pb0 + 96 * 1024};
        f32x4 acc[4][4]; zero_acc(acc);
        gemm_kloop<true, 0>(acc, pa, pb, nullptr, 0, 16, sm);
#pragma unroll
        for (int mt = 0; mt < 4; ++mt)
#pragma unroll
            for (int nt = 0; nt < 4; ++nt) {
                const int row = m0 + wr * 64 + mt * 16 + l15, col = n0 + wc * 64 + (nt >> 1) * 32 + 8 * q + 4 * (nt & 1);
                *(f32x4*)(LG + (size_t)row * 256 + col) = acc[mt][nt];
            }
    }
}

DEVI unsigned f2ord(float f) { const unsigned u = __float_as_uint(f); return (u & 0x80000000u) ? ~u : (u | 0x80000000u); }
template <int CTRL> DEVI float dppf(float v) { const int x = __float_as_int(v); return __int_as_float(__builtin_amdgcn_update_dpp(x, x, CTRL, 0xf, 0xf, false)); }
template <int CTRL> DEVI void top2_merge(float& m1, float& m2) {
    const float p1 = dppf<CTRL>(m1), p2 = dppf<CTRL>(m2);
    const float n1 = fmaxf(m1, p1), n2 = fmaxf(fminf(m1, p1), fmaxf(m2, p2));
    m1 = n1; m2 = n2;
}
template <bool DRY> DEVI void phase9(const Params& p) {
    const int t = VT, lane = t & 63, w = t >> 6;
    const float* LG = (const float*)(p.ws + OFF_LOG);
    int* cnt = (int*)(p.ws + OFF_CNT); int* list = (int*)(p.ws + OFF_LIST); float* wl = (float*)(p.ws + OFF_WL);
    const int tstep = VG * 4;
    int tok = VB * 4 + w;
    const f32x4 rb = *(const f32x4*)(p.router_bias + 4 * lane);
    f32x4 lgn = {0.f, 0.f, 0.f, 0.f};
    if (tok < T_) lgn = *(const f32x4*)(LG + (size_t)tok * 256 + 4 * lane);
    const int mygrp = lane >> 3;
    int ppos = 0, pe = -1, ptk9 = 0; float pw = 0.f;
    for (; tok < T_; tok += tstep) {
        float sc[4], bi[4];
#pragma unroll
        for (int r = 0; r < 4; ++r) { sc[r] = sigmoidf_(lgn[r]); bi[r] = sc[r] + rb[r]; }
        { const int tn = tok + tstep; if (tn < T_) lgn = *(const f32x4*)(LG + (size_t)tn * 256 + 4 * lane); }
        float m1, m2;
        { const float h01 = fmaxf(bi[0], bi[1]), l01 = fminf(bi[0], bi[1]), h23 = fmaxf(bi[2], bi[3]), l23 = fminf(bi[2], bi[3]);
          m1 = fmaxf(h01, h23); m2 = fmaxf(fminf(h01, h23), fmaxf(l01, l23)); }
        top2_merge<0xB1>(m1, m2);
        top2_merge<0x4E>(m1, m2);
        top2_merge<0x141>(m1, m2);
        const float gown = m1 + m2;
        int rank = 0;
#pragma unroll
        for (int g2 = 0; g2 < 8; ++g2) {
            const float go = __builtin_bit_cast(float, __builtin_amdgcn_readlane(__builtin_bit_cast(int, gown), 8 * g2));
            rank += (go > gown || (go == gown && g2 < mygrp)) ? 1 : 0;
        }
        unsigned ck[4];
#pragma unroll
        for (int r = 0; r < 4; ++r) ck[r] = rank < 4 ? f2ord(bi[r]) : 0u;
        unsigned thr = 0u; bool exact = false;
#pragma unroll 1
        for (int bit = 31; bit >= 0; --bit) {
            const unsigned cnd = thr | (1u << bit);
            const int c8 = __popcll(__ballot(ck[0] >= cnd)) + __popcll(__ballot(ck[1] >= cnd)) + __popcll(__ballot(ck[2] >= cnd)) + __popcll(__ballot(ck[3] >= cnd));
            if (c8 >= 8) { thr = cnd; if (c8 == 8) { exact = true; break; } }
        }
        unsigned long long selm[4];
        if (exact) {
#pragma unroll
            for (int r = 0; r < 4; ++r) selm[r] = __ballot(ck[r] >= thr);
        } else {
            unsigned long long eq[4], any = 0ull; int need = 8;
#pragma unroll
            for (int r = 0; r < 4; ++r) { selm[r] = __ballot(ck[r] > thr); eq[r] = __ballot(ck[r] == thr); need -= __popcll(selm[r]); any |= eq[r]; }
            while (need > 0 && any != 0ull) {
                const int L = __builtin_ctzll(any); any &= any - 1ull;
#pragma unroll
                for (int r = 0; r < 4; ++r) if (((eq[r] >> L) & 1ull) != 0ull && need > 0) { selm[r] |= 1ull << L; --need; }
            }
        }
        float wsum = 0.f, myw = 0.f; int mye = 0, kk = 0;
#pragma unroll
        for (int r = 0; r < 4; ++r) {
            unsigned long long m = selm[r];
            while (m != 0ull) {
                const int L = __builtin_ctzll(m); m &= m - 1ull;
                const float sv = __builtin_bit_cast(float, __builtin_amdgcn_readlane(__builtin_bit_cast(int, sc[r]), L));
                wsum += sv;
                if (lane == kk) { mye = 4 * L + r; myw = sv; }
                ++kk;
            }
        }
        if (DRY) { asm volatile("" :: "v"(mye), "v"(myw), "v"(wsum)); }
        else if (lane < 8) {
            if (pe >= 0) { list[(size_t)pe * T_ + ppos] = ptk9; wl[(size_t)pe * T_ + ppos] = pw; }
            ppos = atomicAdd(&cnt[mye * CNT_STRIDE], 1); pe = mye; ptk9 = tok * 9 + lane; pw = myw / wsum * 2.5f;
        }
    }
    if (!DRY && lane < 8 && pe >= 0) { list[(size_t)pe * T_ + ppos] = ptk9; wl[(size_t)pe * T_ + ppos] = pw; }
}

DEVI void moe_prefix(const Params& p, int* pre  , int xg) {
    const int tid = VT;
    const int* cnt = (const int*)(p.ws + OFF_CNT);
    __syncthreads();
    if (tid < 64) {
        int v = 0;
        if (tid < 32) v = (__hip_atomic_load(&cnt[(xg + 8 * tid) * CNT_STRIDE], __ATOMIC_RELAXED, __HIP_MEMORY_SCOPE_AGENT) + 127) >> 7;
        else if (tid == 32) v = 32;
#pragma unroll
        for (int o = 1; o < 64; o <<= 1) { const int u = __shfl_up(v, o); if (tid >= o) v += u; }
        if (tid < 33) pre[tid + 1] = v;
        if (tid == 0) pre[0] = 0;
    }
    __syncthreads();
}
DEVI int moe_find(const int* pre, int mb) {
    int lo = 0, hi = 32;
    while (lo < hi) { const int mid = (lo + hi + 1) >> 1; if (pre[mid] <= mb) lo = mid; else hi = mid - 1; }
    return lo;
}
DEVI int moe_tk9(const int* list, int e, int pos) { return e < 256 ? list[(size_t)e * T_ + pos] : pos * 9 + 8; }

DEVI void moe_prefix256(const Params& p, int* pre  , int xg) {
    const int tid = threadIdx.x;
    const int* cnt = (const int*)(p.ws + OFF_CNT);
    __syncthreads();
    if (tid < 64) {
        int v = 0;
        if (tid < 32) { const int c = __hip_atomic_load(&cnt[(xg + 8 * tid) * CNT_STRIDE], __ATOMIC_RELAXED, __HIP_MEMORY_SCOPE_AGENT); pre[40 + tid] = c; v = (c + 255) >> 8; }
        else if (tid == 32) { v = 16; pre[40 + 32] = T_; }
#pragma unroll
        for (int o = 1; o < 64; o <<= 1) { const int u = __shfl_up(v, o); if (tid >= o) v += u; }
        if (tid < 33) pre[tid + 1] = v;
        if (tid == 0) pre[0] = 0;
    }
    __syncthreads();
}
struct MoeSched {
    const int* pre; const unsigned char* ws; bool need_w;
    int* sbuf;
    int xg, jl, nloc, nun;
    const char* Abase; int arow_bytes; bool by_token;
    const char* Bbase; size_t b_expert_bytes, b_unit_bytes;
    __device__ __forceinline__ bool next(int i, pg8::Unit& u) const { const int item = jl + i * nloc; if (item >= pre[33] * nun) return false; u.pm = item / nun; u.pn = item - u.pm * nun; return true; }
    __device__ __forceinline__ void decode(const pg8::Unit& u, int& e, int& r0, int& ce) const {
        const int gi = moe_find(pre, u.pm), mb = u.pm - pre[gi];
        e = gi < 32 ? xg + 8 * gi : 256; ce = pre[40 + gi]; r0 = (e < 256 ? 0 : xg * 4096) + mb * 256;
    }
    __device__ __forceinline__ int fill_issue(const pg8::Unit& u) const {
        int e, r0, ce; decode(u, e, r0, ce);
        const int pos = r0 + (int)(threadIdx.x & 255); const bool w = threadIdx.x >= 256;
        int v = w ? 0 : -1;
        if (pos < ce && !(w && !need_w)) {
            const unsigned off = (w ? (unsigned)OFF_WL : (unsigned)OFF_LIST) + ((unsigned)e * (unsigned)T_ + (unsigned)pos) * 4u;
            v = e < 256 ? *(const int*)(ws + off) : (w ? 0x3f800000 : pos * 9 + 8);
        }
        return v;
    }
    __device__ __forceinline__ void fill_write(int buf, int v) const { sbuf[(threadIdx.x >= 256 ? 768 : 0) + buf * 256 + (int)(threadIdx.x & 255)] = v; }
    __device__ __forceinline__ const char* a_base() const { return Abase; }
    __device__ __forceinline__ void a_rows(int buf, const int (&rowA)[2], const int (&colA)[2], unsigned& p00, unsigned& p01, unsigned& p10, unsigned& p11) const {
        const int* sb = sbuf + buf * 256; const int s0 = sb[0];
        int s4[4];
#pragma unroll
        for (int k = 0; k < 4; ++k) { int sl = sb[(k >> 1) * 128 + rowA[k & 1]]; if (sl < 0) sl = s0; s4[k] = sl; }
#pragma unroll
        for (int k = 0; k < 4; ++k) if (by_token) s4[k] = s4[k] / 9;
        p00 = (unsigned)s4[0] * (unsigned)arow_bytes + (unsigned)colA[0]; p01 = (unsigned)s4[1] * (unsigned)arow_bytes + (unsigned)colA[1];
        p10 = (unsigned)s4[2] * (unsigned)arow_bytes + (unsigned)colA[0]; p11 = (unsigned)s4[3] * (unsigned)arow_bytes + (unsigned)colA[1];
    }
    __device__ __forceinline__ const char* b_base(const pg8::Unit& u) const { int e, r0, ce; decode(u, e, r0, ce); return Bbase + (size_t)e * b_expert_bytes + (size_t)u.pn * b_unit_bytes; }
    __device__ __forceinline__ void a_ready(const pg8::Unit&) const {}
    __device__ __forceinline__ void done(const pg8::Unit&) const {}
};
struct EpiMoe1 {
    static constexpr bool PERM = true, AFTER_DRAIN = false;
    const MoeSched* S; bf16_t* H;
    __device__ __forceinline__ void operator()(const pg8::f32x4 (&acc)[2][2][4][2], const pg8::Unit& u, int wr, int wc, int fr, int fq, int buf) const {
        const int* sb = S->sbuf + buf * 256 + wr * 64 + fr;
#pragma unroll
        for (int ai = 0; ai < 2; ++ai) {
            int sl[4];
#pragma unroll
            for (int m = 0; m < 4; ++m) sl[m] = sb[ai * 128 + m * 16];
#pragma unroll
            for (int m = 0; m < 4; ++m) if (sl[m] >= 0) {
                f32x4 h0, h1;
#pragma unroll
                for (int r = 0; r < 4; ++r) { h0[r] = siluf_(acc[ai][0][m][0][r]) * acc[ai][1][m][0][r]; h1[r] = siluf_(acc[ai][0][m][1][r]) * acc[ai][1][m][1][r]; }
                *(u32x4*)(H + (size_t)sl[m] * 256 + u.pn * 128 + wc * 32 + 8 * fq) = pk8(h0, h1);
            }
            asm volatile("" ::: "memory");
        }
    }
};
struct EpiMoe2 {
    static constexpr bool PERM = true, AFTER_DRAIN = false;
    const MoeSched* S; unsigned char* YX;
    __device__ __forceinline__ void operator()(const pg8::f32x4 (&acc)[2][2][4][2], const pg8::Unit& u, int wr, int wc, int fr, int fq, int buf) const {
        const int* sb = S->sbuf + buf * 256 + wr * 64 + fr;
#pragma unroll
        for (int ai = 0; ai < 2; ++ai) {
            int sl[4]; float wg[4];
#pragma unroll
            for (int m = 0; m < 4; ++m) { sl[m] = sb[ai * 128 + m * 16]; wg[m] = __int_as_float(sb[768 + ai * 128 + m * 16]) * YX_SCALE; }
#pragma unroll
            for (int m = 0; m < 4; ++m) if (sl[m] >= 0) {
#pragma unroll
                for (int bj = 0; bj < 2; ++bj)
                    { u32x2 w8; w8.x = pk4_fp8(clamp4(acc[ai][bj][m][0] * wg[m], 440.f)); w8.y = pk4_fp8(clamp4(acc[ai][bj][m][1] * wg[m], 440.f));
                      *(u32x2*)(YX + (size_t)sl[m] * 1024 + u.pn * 256 + bj * 128 + wc * 32 + 8 * fq) = w8; }
            }
            asm volatile("" ::: "memory");
        }
    }
};
DEVI void moe_sched_init(const Params& p, MoeSched& S, int* pre) {
    S.pre = pre; S.ws = p.ws; S.need_w = false; S.sbuf = (int*)(smem_all_g + 2 * SMEM_HALF);
    S.xg = RB & 7; S.jl = RB >> 3; S.nloc = RG >> 3;
}
DEVI void phase10(const Params& p, unsigned char* smem_all) {
    int* pre = (int*)(smem_all + 131072);
    MoeSched S; moe_sched_init(p, S, pre); moe_prefix256(p, pre, S.xg);
    S.nun = 2; S.Abase = (const char*)(p.ws + OFF_X1B); S.arow_bytes = 2048; S.by_token = true;
    S.Bbase = (const char*)(p.ws + OFF_WGU); S.b_expert_bytes = (size_t)512 * 1024 * 2; S.b_unit_bytes = (size_t)256 * 1024 * 2;
    EpiMoe1 E; E.S = &S; E.H = (bf16_t*)(p.ws + OFF_H);
    pg8::gemm_phase_g<EpiMoe1, MoeSched, true, true>((PG8_LAS unsigned char*)smem_all, 1024, S, E);
}
DEVI void phase11(const Params& p, unsigned char* smem_all) {
    int* pre = (int*)(smem_all + 131072);
    MoeSched S; moe_sched_init(p, S, pre); moe_prefix256(p, pre, S.xg);
    S.nun = 4; S.Abase = (const char*)(p.ws + OFF_H); S.arow_bytes = 512; S.by_token = false;
    S.Bbase = (const char*)(p.ws + OFF_WD); S.b_expert_bytes = (size_t)1024 * 256 * 2; S.b_unit_bytes = (size_t)256 * 256 * 2;
    S.need_w = true;
    EpiMoe2 E; E.S = &S; E.YX = (unsigned char*)(p.ws + OFF_YX);
    pg8::gemm_phase_g<EpiMoe2, MoeSched, true, true>((PG8_LAS unsigned char*)smem_all, 256, S, E);
}

DEVI void phase12(const Params& p) {
    const int t = VT, lane = t & 63, w = t >> 6;
    const bf16_t* X1b = (const bf16_t*)(p.ws + OFF_X1B); const unsigned char* YX = (const unsigned char*)(p.ws + OFF_YX);
    for (int row = VB * 4 + w; row < T_; row += VG * 4) {
        f32x4 v[4]; float s = 0.f;
#pragma unroll
        for (int i = 0; i < 4; ++i) {
            const int col = i * 256 + lane * 4;
            f32x4 a = unpk4(*(const u32x2*)(X1b + (size_t)row * 1024 + col)) * ALPHA_;
            f32x4 ys = (f32x4){0.f, 0.f, 0.f, 0.f};
#pragma unroll
            for (int k = 0; k < 9; ++k) ys += unpk4_fp8(*(const unsigned*)(YX + ((size_t)row * 9 + k) * 1024 + col));
            a += ys * (1.0f / YX_SCALE);
            v[i] = a; s += (a[0] + a[1]) + (a[2] + a[3]);
        }
#pragma unroll
        for (int o = 32; o > 0; o >>= 1) s += __shfl_xor(s, o);
        const float mean = s * (1.0f / 1024.0f); float s2 = 0.f;
#pragma unroll
        for (int i = 0; i < 4; ++i)
#pragma unroll
            for (int r = 0; r < 4; ++r) { const float d = v[i][r] - mean; s2 += d * d; }
#pragma unroll
        for (int o = 32; o > 0; o >>= 1) s2 += __shfl_xor(s2, o);
        const float rstd = rsqrtf(s2 * (1.0f / 1024.0f) + 1e-5f);
#pragma unroll
        for (int i = 0; i < 4; ++i) {
            const int col = i * 256 + lane * 4;
            const f32x4 g = *(const f32x4*)(p.ln2_g + col), bb = *(const f32x4*)(p.ln2_b + col);
            f32x4 y;
#pragma unroll
            for (int r = 0; r < 4; ++r) y[r] = (v[i][r] - mean) * rstd * g[r] + bb[r];
            *(f32x4*)(p.out + (size_t)row * 1024 + col) = y;
        }
    }
}


#define XB_TMO      128
#define XB_XCNT(j)  (256  + 64 * (j))
#define XB_XSUB(j)  (1280 + 64 * (j))
#define XB_XGEN(j)  (2304 + 64 * (j))
#define XB_TOP      3328
#define XB_TOPGEN   3392
#define XCD_BAR_WORDS 3456
#define XB_SPIN_CAP (1u << 20)
#define LAS __attribute__((address_space(3)))
DEVI unsigned xb_ld(unsigned* p)              { return __hip_atomic_load(p, __ATOMIC_RELAXED, __HIP_MEMORY_SCOPE_AGENT); }
DEVI unsigned xb_add(unsigned* p, unsigned v) { return __hip_atomic_fetch_add(p, v, __ATOMIC_RELAXED, __HIP_MEMORY_SCOPE_AGENT); }
DEVI unsigned xb_xcc_id() { return (unsigned)__builtin_amdgcn_s_getreg((3 << 11) | 20) & 0xFu; }
#define XB_SPIN(cond, bar) do { unsigned _sp = 0; while (cond) { __builtin_amdgcn_s_sleep(1); \
    if ((++_sp & 255u) == 0u) { if (xb_ld(&(bar)[XB_TMO])) break; if (_sp > XB_SPIN_CAP) { atomicAdd(&(bar)[XB_TMO], 1u); break; } } } } while (0)
struct XcdBarrier { unsigned* bar; unsigned x; volatile LAS unsigned* st; };
DEVI XcdBarrier xcd_barrier_post(unsigned* bar, volatile LAS unsigned* st) {
    XcdBarrier b; b.bar = bar; b.x = xb_xcc_id(); b.st = st;
    if (threadIdx.x == 0) st[3] = xb_add(&bar[XB_XCNT(b.x)], 1u);
    return b;
}
DEVI void xcd_barrier_complete(unsigned* bar, unsigned x, unsigned& nloc, unsigned& nx) {
    const unsigned G = gridDim.x * gridDim.y * gridDim.z;
    unsigned sum, cnt, mine, sp = 0u;
    for (;;) {
        sum = 0u; cnt = 0u; mine = 0u;
#pragma unroll
        for (unsigned j = 0; j < 16; ++j) { const unsigned c = xb_ld(&bar[XB_XCNT(j)]); sum += c; cnt += (c > 0u) ? 1u : 0u; mine = (j == x) ? c : mine; }
        if (sum == G) break;
        __builtin_amdgcn_s_sleep(1);
        if ((++sp & 255u) == 0u) { if (xb_ld(&bar[XB_TMO])) break; if (sp > XB_SPIN_CAP) { atomicAdd(&bar[XB_TMO], 1u); break; } }
    }
    nloc = mine > 0u ? mine : 1u; nx = cnt > 0u ? cnt : 1u;
}
DEVI void xcd_barrier(const XcdBarrier& b) {
    asm volatile("s_waitcnt vmcnt(0)" ::: "memory");
    __syncthreads();
    if (threadIdx.x == 0) {
        unsigned* bar = b.bar;
        __builtin_amdgcn_s_waitcnt(0);
        unsigned nloc = b.st[0], nx = b.st[1];
        if (nloc == 0u) { xcd_barrier_complete(bar, b.x, nloc, nx); b.st[0] = nloc; b.st[1] = nx; }
        const unsigned old = xb_add(&bar[XB_XSUB(b.x)], 1u);
        const unsigned gen = old / nloc;
        if (old + 1u == (gen + 1u) * nloc) {
            __builtin_amdgcn_fence(__ATOMIC_RELEASE, "agent");
            asm volatile("s_waitcnt vmcnt(0)" ::: "memory");
            const unsigned og = xb_add(&bar[XB_TOP], 1u);
            const unsigned tg = og / nx;
            if (og + 1u == (tg + 1u) * nx) xb_add(&bar[XB_TOPGEN], 1u);
            else XB_SPIN(xb_ld(&bar[XB_TOPGEN]) == tg, bar);
            __builtin_amdgcn_fence(__ATOMIC_ACQUIRE, "agent");
            xb_add(&bar[XB_XGEN(b.x)], 1u);
            asm volatile("s_waitcnt vmcnt(0)" ::: "memory");
        } else {
            XB_SPIN(xb_ld(&bar[XB_XGEN(b.x)]) == gen, bar);
            __builtin_amdgcn_fence(__ATOMIC_ACQUIRE, "agent");
            asm volatile("s_waitcnt vmcnt(0)" ::: "memory");
        }
    }
    __syncthreads();
}
constexpr size_t OFF_BAR = 131072;

#ifndef DBG
#define DBG 0
#endif
DEVI void dump_f32(const Params& p, size_t off) {
    const f32x4* src = (const f32x4*)(p.ws + off); f32x4* dst = (f32x4*)p.out;
    for (int i = blockIdx.x * 256 + threadIdx.x; i < T_ * D_ / 4; i += gridDim.x * 256) dst[i] = src[i];
}
DEVI void dump_bf16(const Params& p, size_t off, int ld, int coff) {
    const bf16_t* src = (const bf16_t*)(p.ws + off);
    for (int i = blockIdx.x * 256 + threadIdx.x; i < T_ * D_; i += gridDim.x * 256) { const int row = i >> 10, col = i & 1023; p.out[i] = bf2f(src[(size_t)row * ld + coff + col]); }
}
DEVI float flat_bf(const Params& p, size_t off, size_t n, size_t i) { const bf16_t* b = (const bf16_t*)(p.ws + off); float a = 0.f; for (size_t j = i; j < n; j += (size_t)T_ * D_) a += bf2f(b[j]); return a; }
DEVI void dump_p1(const Params& p) {
    const size_t N = (size_t)T_ * D_;
    for (size_t i = (size_t)blockIdx.x * 256 + threadIdx.x; i < N; i += (size_t)gridDim.x * 256) {
        float a = 0.f;
        a += flat_bf(p, OFF_MG, 2 * N, i) + flat_bf(p, OFF_GS, 2 * N, i);
        a += flat_bf(p, OFF_QR, N / 2, i % (N / 2)) + flat_bf(p, OFF_KR, N / 2, i % (N / 2)) + flat_bf(p, OFF_QG, N / 2, i % (N / 2));
        a += flat_bf(p, OFF_KRT, N / 2, i % (N / 2)) + flat_bf(p, OFF_KGT, N / 2, i % (N / 2));
        a += flat_bf(p, OFF_VRT, N, i) + flat_bf(p, OFF_VGT, N, i);
        a += ((const float*)(p.ws + OFF_GA))[i % ((size_t)T_ * 16)];
        p.out[i] = a;
    }
}
constexpr int NPHASE = 13;
__global__ void __launch_bounds__(512, 2) fwd_megakernel(Params p) {
    unsigned char* const smem_all = smem_all_g;
    unsigned char* smem = smem_all + VH * SMEM_HALF;
    uint4* xb_words = (uint4*)(smem_all + 2 * SMEM_HALF - 16);
    if (threadIdx.x == 0) *xb_words = make_uint4(0u, 0u, blockIdx.x, 0u);
    __syncthreads();
    const XcdBarrier xb = xcd_barrier_post((unsigned*)(p.ws + OFF_BAR), (volatile LAS unsigned*)xb_words);
#ifndef REPMASK
#define REPMASK 0
#endif
#ifndef TIMEPHASE
#define TIMEPHASE -1
#endif
#define RUN_PHASE(K, CALL) do { if (p.phase_lo <= (K) && (K) < p.phase_hi) { \
        const unsigned long long tp0_ = (TIMEPHASE == (K)) ? __builtin_amdgcn_s_memrealtime() : 0ull; \
        _Pragma("unroll 1") for (int rep_ = ((REPMASK >> (K)) & 1); rep_ >= 0; --rep_) { CALL; if (rep_ > 0 || (K) + 1 < p.phase_hi) xcd_barrier(xb); } \
        if (TIMEPHASE == (K)) { const unsigned long long tp1_ = __builtin_amdgcn_s_memrealtime(); while (__builtin_amdgcn_s_memrealtime() - tp1_ < tp1_ - tp0_) __builtin_amdgcn_s_sleep(8); } } } while (0)
    RUN_PHASE(0, phase0(p, smem));
    if (p.phase_lo == 0 && p.phase_hi > 1) {
        if (threadIdx.x == 0) {
            unsigned* bar = (unsigned*)(p.ws + OFF_BAR); bool ok = (gridDim.x & 7u) == 0u && xb.x < 8u;
            for (unsigned j = 0; j < 16; ++j) { const unsigned c = xb_ld(&bar[XB_XCNT(j)]); ok = ok && (j < 8 ? c == gridDim.x / 8u : c == 0u); }
            if (ok) ((volatile int*)xb_words)[2] = (int)(((volatile unsigned*)xb_words)[3] * 8u + xb.x);
        }
        __syncthreads();
    }
    RUN_PHASE(1, phase1(p, smem_all));
#if DBG == 2
    dump_p1(p); return;
#endif
    RUN_PHASE(2, phase2(p, smem));
#if DBG == 5
    { const size_t N = (size_t)T_ * D_; for (size_t i = (size_t)blockIdx.x * 256 + threadIdx.x; i < N; i += (size_t)gridDim.x * 256) p.out[i] = flat_bf(p, OFF_KG2, N / 2, i % (N / 2)) + ((const float*)(p.ws + OFF_DEC))[i % (2048 * 128)]; } return;
#endif
#ifdef SCANPROBE
    phase3t(p, smem, 1); xcd_barrier(xb);
#endif
    RUN_PHASE(3, phase3t(p, smem, 0));
#if DBG == 6
    dump_bf16(p, OFF_OO, 2048, 1024); return;
#endif
#if DBG == 7
    { const bf16_t* src = (const bf16_t*)(p.ws + OFF_OO);
      for (int i = blockIdx.x * 256 + threadIdx.x; i < T_ * D_; i += gridDim.x * 256) { const int row = i >> 10, col = i & 1023; const float v = bf2f(src[(size_t)row * 2048 + 1024 + col]); p.out[i] = (fabsf(v) < 1e30f) ? v : 12345.0f; } } return;
#endif
    RUN_PHASE(4, phase4(p, smem));
#if DBG == 3
    dump_bf16(p, OFF_Y, 2048, 0); return;
#endif
#if DBG == 4
    dump_bf16(p, OFF_Y, 2048, 1024); return;
#endif
    RUN_PHASE(5, phase5(p, smem_all));
    RUN_PHASE(6, phase6(p, smem_all));
    RUN_PHASE(7, phase7(p, smem));
#if DBG == 1
    return;
#endif
    RUN_PHASE(8, phase8(p, smem));
#ifdef P9DRY
    RUN_PHASE(9, (phase9<true>(p), phase9<false>(p)));
#else
    RUN_PHASE(9, phase9<false>(p));
#endif
    RUN_PHASE(10, phase10(p, smem_all));
    RUN_PHASE(11, phase11(p, smem_all));
    RUN_PHASE(12, phase12(p));
#undef RUN_PHASE
}

extern "C" void kernel_launch(void* const* d_in, const int* in_sizes, int n_in, void* d_out, int out_size, void* d_ws, size_t ws_size,
                              hipStream_t stream) {
    static int grid_blocks = 0;
    if (!grid_blocks) {
        int dev = 0, cus = 0, per_cu = 0;
        hipGetDevice(&dev);
        hipDeviceGetAttribute(&cus, hipDeviceAttributeMultiprocessorCount, dev);
        hipOccupancyMaxActiveBlocksPerMultiprocessor(&per_cu, fwd_megakernel, 512, 0);
        if (per_cu > 1) per_cu = 1;
        if (per_cu < 1) per_cu = 1;
        grid_blocks = cus * per_cu;
    }
    if (ws_size < WS_NEEDED) { fprintf(stderr, "workspace too small: %zu < %zu\n", ws_size, (size_t)WS_NEEDED); return; }
    Params p{};
    p.x = (const float*)d_in[0]; p.w_in = (const float*)d_in[1]; p.ret_norm_g = (const float*)d_in[2]; p.gate_w2 = (const float*)d_in[3];
    p.gate_b = (const float*)d_in[4]; p.gla_norm_g = (const float*)d_in[5]; p.w_ret_out = (const float*)d_in[6]; p.w_gla_out = (const float*)d_in[7];
    p.w_o = (const float*)d_in[8]; p.ln1_g = (const float*)d_in[9]; p.ln1_b = (const float*)d_in[10]; p.router_w = (const float*)d_in[11];
    p.router_bias = (const float*)d_in[12]; p.ew_gate = (const float*)d_in[13]; p.ew_up = (const float*)d_in[14]; p.ew_down = (const float*)d_in[15];
    p.sw_gate = (const float*)d_in[16]; p.sw_up = (const float*)d_in[17]; p.sw_down = (const float*)d_in[18]; p.ln2_g = (const float*)d_in[19];
    p.ln2_b = (const float*)d_in[20];
    p.out = (float*)d_out; p.ws = (unsigned char*)d_ws; p.phase_lo = 0; p.phase_hi = NPHASE;
    void* args[] = {&p};
    (void)hipMemsetAsync((unsigned char*)d_ws + OFF_BAR, 0, XCD_BAR_WORDS * 4, stream);
    hipError_t e = hipLaunchCooperativeKernel((void*)fwd_megakernel, dim3(grid_blocks), dim3(512), args, 0, stream);
    if (e != hipSuccess) fprintf(stderr, "cooperative launch failed: %s (grid %d)\n", hipGetErrorString(e), grid_blocks);
}
```

```cpp
#include <hip/hip_runtime.h>
#include <hip/hip_cooperative_groups.h>
#include <cstdio>
#include <cstdint>
namespace cg = cooperative_groups;

typedef unsigned short bf16_t;
typedef short bf16x8 __attribute__((ext_vector_type(8)));
typedef float f32x4 __attribute__((ext_vector_type(4)));
typedef unsigned u32x2 __attribute__((ext_vector_type(2)));
typedef unsigned u32x4 __attribute__((ext_vector_type(4)));
#define DEVI __device__ __forceinline__
#define VH ((int)(threadIdx.x >> 8))
#define VT ((int)(threadIdx.x & 255))
#define RB (__builtin_amdgcn_readfirstlane(((const int*)(smem_all_g + 2 * SMEM_HALF - 16))[2]))
#define RG ((int)gridDim.x)
#define VB (RB * 2 + VH)
#define VG (RG * 2)

constexpr int T_ = 32768;
constexpr int D_ = 1024;
constexpr int DIN_ = 8208;
constexpr int NE_ = 256;
constexpr float ALPHA_ = 1.189207115002721f;
constexpr float KSCALE_ = 0.08838834764831845f;

constexpr size_t MB = 1ull << 20;
constexpr size_t OFF_CNT  = (size_t)766 << 20;
constexpr int CNT_STRIDE = 1024;
constexpr size_t OFF_CS   = 1 * MB;
constexpr size_t OFF_WT   = 3 * MB;
constexpr size_t FB = 27 * MB;
constexpr size_t OFF_QR   = FB + 0 * MB;
constexpr size_t OFF_KR   = FB + 32 * MB;
constexpr size_t OFF_VRT  = FB + 64 * MB;
constexpr size_t OFF_GS   = FB + 128 * MB;
constexpr size_t OFF_MG   = FB + 256 * MB;
constexpr size_t OFF_KRT  = FB + 384 * MB;
constexpr size_t OFF_QG   = FB + 416 * MB;
constexpr size_t OFF_VGT  = FB + 448 * MB;
constexpr size_t OFF_KGT  = FB + 512 * MB;
constexpr size_t OFF_GA   = FB + 544 * MB;
constexpr size_t OFF_XB   = FB + 546 * MB;
constexpr size_t OFF_KG2  = FB + 546 * MB;
constexpr size_t OFF_DEC  = FB + 578 * MB;
constexpr size_t OFF_OO   = FB + 579 * MB;
constexpr size_t OFF_Y    = FB + 384 * MB;
constexpr size_t OFF_MRG  = FB + 0 * MB;
constexpr size_t OFF_QGN  = 767 * MB;
constexpr size_t OFF_QFR  = 734 * MB;
constexpr size_t OFF_WGU  = 767 * MB;
constexpr size_t OFF_X1B  = FB + 0 * MB;
constexpr size_t OFF_WD   = FB + 64 * MB;
constexpr size_t OFF_LIST = FB + 193 * MB;
constexpr size_t OFF_WL   = 686 * MB;
constexpr size_t OFF_H    = FB + 227 * MB;
constexpr size_t OFF_YX   = FB + 371 * MB;
constexpr size_t OFF_T1   = FB + 371 * MB;
constexpr size_t OFF_LOG  = FB + 435 * MB;
constexpr size_t WS_NEEDED = 1024 * MB;

constexpr int WT_BN = 0, WT_AT = 5888, WT_RET = 8960, WT_GLA = 9984, WT_O = 11008, WT_R = 12032, WT_ROWS = 12288;

struct Params {
    const float *x, *w_in, *ret_norm_g, *gate_w2, *gate_b, *gla_norm_g, *w_ret_out, *w_gla_out, *w_o, *ln1_g, *ln1_b,
                *router_w, *router_bias, *ew_gate, *ew_up, *ew_down, *sw_gate, *sw_up, *sw_down, *ln2_g, *ln2_b;
    float* out;
    unsigned char* ws;
    int phase_lo, phase_hi;
};

static __device__ const float c_inv_freq[64] = {
  1.000000000e+00f, 8.659643531e-01f, 7.498942018e-01f, 6.493816376e-01f,
  5.623413324e-01f, 4.869675338e-01f, 4.216965139e-01f, 3.651741147e-01f,
  3.162277639e-01f, 2.738419771e-01f, 2.371373773e-01f, 2.053525001e-01f,
  1.778279394e-01f, 1.539926529e-01f, 1.333521456e-01f, 1.154781953e-01f,
  1.000000015e-01f, 8.659642935e-02f, 7.498942316e-02f, 6.493816525e-02f,
  5.623413250e-02f, 4.869675264e-02f, 4.216964915e-02f, 3.651741147e-02f,
  3.162277490e-02f, 2.738419548e-02f, 2.371373773e-02f, 2.053525113e-02f,
  1.778279431e-02f, 1.539926510e-02f, 1.333521400e-02f, 1.154781971e-02f,
  9.999999776e-03f, 8.659643121e-03f, 7.498942316e-03f, 6.493816152e-03f,
  5.623413250e-03f, 4.869675264e-03f, 4.216964822e-03f, 3.651741194e-03f,
  3.162277630e-03f, 2.738419687e-03f, 2.371373819e-03f, 2.053525066e-03f,
  1.778279431e-03f, 1.539926510e-03f, 1.333521446e-03f, 1.154782018e-03f,
  1.000000047e-03f, 8.659643354e-04f, 7.498941850e-04f, 6.493816036e-04f,
  5.623413017e-04f, 4.869675322e-04f, 4.216965172e-04f, 3.651741135e-04f,
  3.162277571e-04f, 2.738419571e-04f, 2.371373703e-04f, 2.053525095e-04f,
  1.778279402e-04f, 1.539926598e-04f, 1.333521504e-04f, 1.154782003e-04f };

DEVI float bf2f(unsigned short u) { return __uint_as_float(((unsigned)u) << 16); }
DEVI float bflo(unsigned u) { return __uint_as_float(u << 16); }
DEVI float bfhi(unsigned u) { return __uint_as_float(u & 0xffff0000u); }
typedef float f32x2 __attribute__((ext_vector_type(2)));
typedef __bf16 bf16x2_t __attribute__((ext_vector_type(2)));
DEVI unsigned pk2(float lo, float hi) { const f32x2 v = {lo, hi}; const bf16x2_t b = __builtin_convertvector(v, bf16x2_t); return __builtin_bit_cast(unsigned, b); }
DEVI unsigned short f2bf(float f) { return (unsigned short)(pk2(f, 0.f) & 0xffffu); }
DEVI u32x2 pk4(f32x4 v) { u32x2 r; r.x = pk2(v[0], v[1]); r.y = pk2(v[2], v[3]); return r; }
DEVI f32x4 unpk4(u32x2 u) { f32x4 r; r[0] = bflo(u.x); r[1] = bfhi(u.x); r[2] = bflo(u.y); r[3] = bfhi(u.y); return r; }
constexpr float YX_SCALE = 16.0f;
DEVI unsigned pk4_fp8(f32x4 v) { int w = 0; w = __builtin_amdgcn_cvt_pk_fp8_f32(v[0], v[1], w, false); w = __builtin_amdgcn_cvt_pk_fp8_f32(v[2], v[3], w, true); return (unsigned)w; }
DEVI f32x4 unpk4_fp8(unsigned u) { f32x4 r; r[0] = __builtin_amdgcn_cvt_f32_fp8((int)u, 0); r[1] = __builtin_amdgcn_cvt_f32_fp8((int)u, 1); r[2] = __builtin_amdgcn_cvt_f32_fp8((int)u, 2); r[3] = __builtin_amdgcn_cvt_f32_fp8((int)u, 3); return r; }
DEVI f32x4 clamp4(f32x4 v, float lim) { f32x4 r; for (int i = 0; i < 4; ++i) r[i] = fminf(fmaxf(v[i], -lim), lim); return r; }
DEVI float sigmoidf_(float v) { return 1.0f / (1.0f + __expf(-v)); }
DEVI float siluf_(float v) { return v / (1.0f + __expf(-v)); }
DEVI float gamma_log2(int h) { return log2f(1.0f - exp2f(-5.0f - (float)h)); }
DEVI f32x4 mfma16(bf16x8 a, bf16x8 b, f32x4 c) { return __builtin_amdgcn_mfma_f32_16x16x32_bf16(a, b, c, 0, 0, 0); }
DEVI unsigned kf_off(int item, int dk, int m8) { return ((((unsigned)item * 4u + (unsigned)(dk >> 5)) * 4u + (unsigned)(m8 >> 4)) * 64u + (unsigned)((m8 >> 3) & 1) * 32u + (unsigned)(dk & 31)) * 8u; }
DEVI unsigned vf_off(int item, int dv, int m8) { return ((((unsigned)item * 8u + (unsigned)(dv >> 5)) * 4u + (unsigned)(m8 >> 4)) * 64u + (unsigned)((m8 >> 3) & 1) * 32u + (unsigned)(dv & 31)) * 8u; }
DEVI unsigned qf_off(int bc, int h, int tokl, int dk8, int hh) {
    return ((((((unsigned)bc * 4u + (unsigned)h) * 2u + (unsigned)(tokl >> 5)) * 4u + (unsigned)(dk8 >> 5)) * 2u + (unsigned)((dk8 >> 4) & 1)) * 64u + (unsigned)hh * 32u + (unsigned)(tokl & 31)) * 8u + (unsigned)((dk8 >> 3) & 1) * 4u; }
DEVI int vperm(int n) { const int wc = n >> 6, nt = (n >> 4) & 3, i = n & 15; return wc * 64 + (nt >> 1) * 32 + 8 * (i >> 2) + 4 * (nt & 1) + (i & 3); }
DEVI int dperm2(int v) { return ((v >> 5) & 1) * 64 + (v >> 6) * 32 + (v & 31); }
DEVI u32x4 pk8(f32x4 a, f32x4 b) { u32x4 r; r.x = pk2(a[0], a[1]); r.y = pk2(a[2], a[3]); r.z = pk2(b[0], b[1]); r.w = pk2(b[2], b[3]); return r; }
DEVI void unpk8(u32x4 u, f32x4& a, f32x4& b) { a[0] = bflo(u.x); a[1] = bfhi(u.x); a[2] = bflo(u.y); a[3] = bfhi(u.y); b[0] = bflo(u.z); b[1] = bfhi(u.z); b[2] = bflo(u.w); b[3] = bfhi(u.w); }
DEVI int dperm(int v) { const int wc = v >> 6, nt = (v >> 4) & 3, c = v & 15; return (nt & 1) * 16 + wc * 32 + c + (nt >> 1) * 64; }

struct __attribute__((aligned(16))) GemmSmem { bf16_t a[2][128 * 64]; bf16_t b[2][128 * 64]; };
constexpr int SMEM_GEMM = sizeof(GemmSmem);
constexpr int SMEM_BYTES = SMEM_GEMM + 2048 + 16;
constexpr int SMEM_HALF = (SMEM_BYTES + 255) & ~255;
constexpr int SMEM_MOE = 6144;
__shared__ __attribute__((aligned(16))) unsigned char smem_all_g[2 * SMEM_HALF + SMEM_MOE];
DEVI int gemm_src_chunk(int t) { return ((t & 7) ^ ((t >> 4) & 7)) * 8; }

template <bool SWAP, int BKIND>
DEVI void gemm_kloop(f32x4 (&acc)[4][4], const bf16_t* const (&pa)[4], const bf16_t* const (&pb)[4],
                     const float* pbf, int ldb, int nk, GemmSmem& sm) {
    const int t = VT, lane = t & 63, w = t >> 6, wr = w >> 1, wc = w & 1, l15 = lane & 15, q = lane >> 4;
    const int kg = t & 7, ng = t >> 3;
    f32x4 rf[8];
#define GEMM_ISSUE(BUF, KO) do { \
        _Pragma("unroll") for (int i = 0; i < 4; ++i) \
            __builtin_amdgcn_global_load_lds((const unsigned*)(pa[i] + (KO)), (unsigned*)((char*)sm.a[BUF] + i * 4096 + t * 16), 16, 0, 0); \
        if (BKIND == 0) { _Pragma("unroll") for (int i = 0; i < 4; ++i) \
            __builtin_amdgcn_global_load_lds((const unsigned*)(pb[i] + (KO)), (unsigned*)((char*)sm.b[BUF] + i * 4096 + t * 16), 16, 0, 0); } \
        else { const float* pp = pbf + (size_t)((KO) + 4 * kg) * ldb; \
            _Pragma("unroll") for (int i = 0; i < 4; ++i) { rf[i] = *(const f32x4*)(pp + (size_t)i * ldb); rf[4 + i] = *(const f32x4*)(pp + (size_t)(32 + i) * ldb); } } } while (0)
#define GEMM_LSTORE_B(BUF) do { if (BKIND == 1) { \
            _Pragma("unroll") for (int i = 0; i < 4; ++i) { \
                u32x2 v0, v1; \
                v0.x = pk2(rf[0][i], rf[1][i]); v0.y = pk2(rf[2][i], rf[3][i]); v1.x = pk2(rf[4][i], rf[5][i]); v1.y = pk2(rf[6][i], rf[7][i]); \
                const int n = 4 * ng + i, sw = (n >> 1) & 7; \
                char* rowp = (char*)sm.b[BUF] + n * 128 + (kg & 1) * 8; \
                *(u32x2*)(rowp + (((kg >> 1) ^ sw) * 16)) = v0; *(u32x2*)(rowp + (((4 + (kg >> 1)) ^ sw) * 16)) = v1; } } } while (0)
    GEMM_ISSUE(0, 0);
    GEMM_LSTORE_B(0);
    __syncthreads();
#define GEMM_KSTEP(CUR, KT) do { \
        const bool more = ((KT) + 1 < nk); \
        if (more) { GEMM_ISSUE((CUR) ^ 1, ((KT) + 1) * 64); } \
        __builtin_amdgcn_sched_barrier(0); \
        _Pragma("unroll") for (int ss = 0; ss < 2; ++ss) { \
            bf16x8 af[4], bfr[4]; \
            const int coff = ((ss * 4 + q) ^ (l15 >> 1)) * 16; \
            _Pragma("unroll") for (int i = 0; i < 4; ++i) { \
                af[i]  = *(const bf16x8*)((const char*)sm.a[CUR] + (wr * 64 + i * 16 + l15) * 128 + coff); \
                bfr[i] = *(const bf16x8*)((const char*)sm.b[CUR] + (wc * 64 + i * 16 + l15) * 128 + coff); } \
            _Pragma("unroll") for (int mt = 0; mt < 4; ++mt) \
                _Pragma("unroll") for (int nt = 0; nt < 4; ++nt) \
                    acc[mt][nt] = SWAP ? mfma16(bfr[nt], af[mt], acc[mt][nt]) : mfma16(af[mt], bfr[nt], acc[mt][nt]); } \
        __builtin_amdgcn_sched_barrier(0); \
        if (more) { GEMM_LSTORE_B((CUR) ^ 1); } \
        __syncthreads(); } while (0)
#pragma unroll 1
    for (int kt = 0; kt < nk; kt += 2) { GEMM_KSTEP(0, kt); GEMM_KSTEP(1, kt + 1); }
#undef GEMM_KSTEP
#undef GEMM_LSTORE_B
#undef GEMM_ISSUE
}

DEVI void zero_acc(f32x4 (&acc)[4][4]) {
#pragma unroll
    for (int i = 0; i < 4; ++i)
#pragma unroll
        for (int j = 0; j < 4; ++j) acc[i][j] = (f32x4){0.f, 0.f, 0.f, 0.f};
}

namespace pg8 {
#define PG8_LAS __attribute__((address_space(3)))
typedef unsigned short bf16_t;
typedef short bf16x8 __attribute__((ext_vector_type(8)));
typedef float f32x4 __attribute__((ext_vector_type(4)));
typedef unsigned u32x4 __attribute__((ext_vector_type(4)));
constexpr int BM = 256, BK = 64, HALF = 128, HTB = HALF * BK * 2  , STAGE_BYTES = 8 * HTB, NXCD = 8, WGM = 8;

__host__ __device__ __forceinline__ int lds_byte(int r, int c) { const int st = (r >> 4) * 2 + (c >> 5), rr = r & 15, cc = c & 31, ob = rr * 64 + cc * 2; return st * 1024 + (ob ^ (((ob >> 9) & 1) << 5)); }
__host__ __device__ __forceinline__ void stage_rc(int b, int& R, int& C) { const int st = b / 1024, sb = b % 1024, swz = sb ^ (((sb >> 9) & 1) << 5); R = (st >> 1) * 16 + swz / 64; C = (st & 1) * 32 + (swz % 64) / 2; }
__host__ __device__ __forceinline__ int perm32(int rho) { const int n = rho >> 4, i = rho & 15; return 8 * (i >> 2) + 4 * n + (i & 3); }

struct Unit { int pm, pn, e, r0, ce; };
struct Gemm { const bf16_t* A; const bf16_t* Bt; int M, N, K; };

struct StaticOrder {
    int nM, nN, nwg, G, c;
    __host__ __device__ void init(int M, int N, int G_, int c_) { nM = M / BM; nN = N / BM; nwg = nM * nN; G = G_; c = c_; }
    __host__ __device__ bool next(int i, Unit& u) const {
        const long L = (long)i * G + c; if (L >= nwg) return false;
        int wgid = (int)L; { const int q = nwg / NXCD, r = nwg % NXCD, xcd = wgid % NXCD, off = wgid / NXCD; wgid = (xcd < r ? xcd * (q + 1) : r * (q + 1) + (xcd - r) * q) + off; }
        const int nig = WGM * nN, gid = wgid / nig, fm = gid * WGM, gsz = (nM - fm) < WGM ? (nM - fm) : WGM;
        u.pm = fm + ((wgid % nig) % gsz); u.pn = (wgid % nig) / gsz; return true;
    }
    __device__ __forceinline__ void a_ready(const Unit&) const {}
    __device__ __forceinline__ void done(const Unit&) const {}
};


template <class Epi, class Sched, bool ALIGN_EPI = false, bool SP2 = false>
__device__ __forceinline__ void gemm_phase(PG8_LAS unsigned char* lds, const Gemm g, const Sched& S, const Epi& E) {
    const int tid = threadIdx.x, wid = __builtin_amdgcn_readfirstlane(tid >> 6), lane = tid & 63, wr = wid >> 2, wc = wid & 3, fr = lane & 15, fq = lane >> 4;
    const int K = g.K, nt = K / BK;
    unsigned voffA[2], voffB[2];
#pragma unroll
    for (int i = 0; i < 2; ++i) { int R, C; stage_rc(tid * 16 + i * 8192, R, C); const int Rb = Epi::PERM ? ((R & ~31) + perm32(R & 31)) : R;
        voffA[i] = (unsigned)(R * K + C) * 2u; voffB[i] = (unsigned)(Rb * K + C) * 2u; }
    const size_t kstep = (size_t)(BK * 2);
    const size_t hstep = (size_t)HALF * K * 2;
    const size_t tstep = 2 * hstep;
    const unsigned ldsw = (unsigned)wid * 1024u;
    const int aoff = lds_byte(wr * 64 + fr, fq * 8), boff = lds_byte(wc * 32 + fr, fq * 8);
#define PG8_SA(b, h) (((b) * 2 + (h)) * HTB)
#define PG8_SB(b, h) ((4 + (b) * 2 + (h)) * HTB)
#define PG8_STAGE(bufoff, gbase, voff) do { _Pragma("unroll") for (int _i = 0; _i < 2; ++_i) \
        __builtin_amdgcn_global_load_lds((const unsigned*)((const char*)(gbase) + (voff)[_i]), (PG8_LAS unsigned*)(lds + (bufoff) + ldsw + _i * 8192), 16, 0, 0); } while (0)
#define PG8_LDA(dst, b, h) do { _Pragma("unroll") for (int m = 0; m < 4; ++m) _Pragma("unroll") for (int k = 0; k < 2; ++k) dst[m][k] = *(const PG8_LAS bf16x8*)(lds + PG8_SA(b, h) + aoff + m * 2048 + k * 1024); } while (0)
#define PG8_LDB(dst, b, h) do { _Pragma("unroll") for (int n = 0; n < 2; ++n) _Pragma("unroll") for (int k = 0; k < 2; ++k) dst[n][k] = *(const PG8_LAS bf16x8*)(lds + PG8_SB(b, h) + boff + n * 2048 + k * 1024); } while (0)
#define PG8_MMA(ai, bj, At, Bt) do { __builtin_amdgcn_s_setprio(1); _Pragma("unroll") for (int m = 0; m < 4; ++m) _Pragma("unroll") for (int n = 0; n < 2; ++n) _Pragma("unroll") for (int k = 0; k < 2; ++k) \
        acc[ai][bj][m][n] = __builtin_amdgcn_mfma_f32_16x16x32_bf16(Bt[n][k], At[m][k], acc[ai][bj][m][n], 0, 0, 0); __builtin_amdgcn_s_setprio(0); } while (0)
#define PG8_WAIT_V(n) asm volatile("s_waitcnt vmcnt(" #n ")" ::: "memory")
#define PG8_WAIT_L(n) asm volatile("s_waitcnt lgkmcnt(" #n ")" ::: "memory")
#define PG8_BAR __builtin_amdgcn_s_barrier()
#define PG8_SCHED __builtin_amdgcn_sched_barrier(0)
    Unit cur, nxt; int ui = 0;
    if (!S.next(0, cur)) return;
    f32x4 acc[2][2][4][2];
#pragma unroll
    for (int a = 0; a < 2; ++a)
#pragma unroll
        for (int b = 0; b < 2; ++b)
#pragma unroll
            for (int m = 0; m < 4; ++m)
#pragma unroll
                for (int n = 0; n < 2; ++n) acc[a][b][m][n] = (f32x4){0.f, 0.f, 0.f, 0.f};
    bf16x8 At[4][2], B0[2][2], B1[2][2];
    const char* cA = (const char*)g.A + (size_t)cur.pm * tstep; const char* cB = (const char*)g.Bt + (size_t)cur.pn * tstep;
    S.a_ready(cur);
    if constexpr (SP2) {
        PG8_STAGE(PG8_SB(0, 0), cB, voffB); PG8_STAGE(PG8_SB(0, 1), cB + hstep, voffB); PG8_STAGE(PG8_SA(0, 0), cA, voffA); PG8_STAGE(PG8_SA(0, 1), cA + hstep, voffA);
        if (wr == 1) PG8_BAR;
        PG8_WAIT_V(2); PG8_BAR;
        PG8_STAGE(PG8_SB(1, 0), cB + kstep, voffB); PG8_STAGE(PG8_SA(1, 0), cA + kstep, voffA); PG8_STAGE(PG8_SB(1, 1), cB + hstep + kstep, voffB);
        PG8_WAIT_V(6); PG8_BAR;
    } else {
        PG8_STAGE(PG8_SB(0, 0), cB, voffB); PG8_STAGE(PG8_SA(0, 0), cA, voffA); PG8_STAGE(PG8_SB(0, 1), cB + hstep, voffB); PG8_STAGE(PG8_SA(0, 1), cA + hstep, voffA);
        if (wr == 1) PG8_BAR;
        PG8_WAIT_V(4); PG8_BAR;
        PG8_STAGE(PG8_SB(1, 0), cB + kstep, voffB); PG8_STAGE(PG8_SA(1, 0), cA + kstep, voffA); PG8_STAGE(PG8_SB(1, 1), cB + hstep + kstep, voffB);
        PG8_WAIT_V(6); PG8_BAR;
    }
    for (;;) {
        const bool has_next = S.next(ui + 1, nxt);
        const char* nA = has_next ? (const char*)g.A + (size_t)nxt.pm * tstep : cA; const char* nB = has_next ? (const char*)g.Bt + (size_t)nxt.pn * tstep : cB;
        for (int t = 0; t < nt; t += 2) {
            const bool last = (t == nt - 2);
            const char* a1 = cA + (size_t)(t + 1) * kstep;
            const char* a2 = last ? nA : cA + (size_t)(t + 2) * kstep; const char* b2 = last ? nB : cB + (size_t)(t + 2) * kstep;
            const char* a3 = a2 + kstep; const char* b3 = b2 + kstep;
            if (last && has_next) S.a_ready(nxt);
            if constexpr (SP2) {
            PG8_LDB(B0, 0, 0); PG8_LDB(B1, 0, 1); PG8_SCHED; PG8_LDA(At, 0, 0); PG8_STAGE(PG8_SA(1, 1), a1 + hstep, voffA);
            PG8_WAIT_V(8); PG8_WAIT_L(0); PG8_BAR; PG8_MMA(0, 0, At, B0); PG8_MMA(0, 1, At, B1); PG8_BAR; PG8_SCHED;
            PG8_LDA(At, 0, 1); PG8_STAGE(PG8_SB(0, 0), b2, voffB); PG8_STAGE(PG8_SB(0, 1), b2 + hstep, voffB); PG8_STAGE(PG8_SA(0, 0), a2, voffA);
            PG8_WAIT_V(8); PG8_WAIT_L(0); PG8_BAR; PG8_MMA(1, 0, At, B0); PG8_MMA(1, 1, At, B1); PG8_BAR; PG8_SCHED;
            PG8_LDB(B0, 1, 0); PG8_LDB(B1, 1, 1); PG8_SCHED; PG8_LDA(At, 1, 0); PG8_STAGE(PG8_SA(0, 1), a2 + hstep, voffA);
            PG8_WAIT_V(8); PG8_WAIT_L(0); PG8_BAR; PG8_MMA(0, 0, At, B0); PG8_MMA(0, 1, At, B1); PG8_BAR; PG8_SCHED;
            PG8_LDA(At, 1, 1); PG8_STAGE(PG8_SB(1, 0), b3, voffB); PG8_STAGE(PG8_SB(1, 1), b3 + hstep, voffB); PG8_STAGE(PG8_SA(1, 0), a3, voffA);
            PG8_WAIT_V(8); PG8_WAIT_L(0); PG8_BAR; PG8_MMA(1, 0, At, B0); PG8_MMA(1, 1, At, B1); PG8_BAR; PG8_SCHED;
            } else {
            PG8_LDB(B0, 0, 0); PG8_SCHED; PG8_LDA(At, 0, 0); PG8_STAGE(PG8_SA(1, 1), a1 + hstep, voffA);
            PG8_WAIT_L(8); PG8_BAR; PG8_WAIT_L(0); PG8_MMA(0, 0, At, B0); PG8_BAR; PG8_SCHED;
            PG8_LDB(B1, 0, 1); PG8_STAGE(PG8_SB(0, 0), b2, voffB);
            PG8_BAR; PG8_WAIT_L(0); PG8_MMA(0, 1, At, B1); PG8_BAR;
            PG8_LDA(At, 0, 1); PG8_STAGE(PG8_SA(0, 0), a2, voffA);
            PG8_BAR; PG8_WAIT_L(0); PG8_MMA(1, 0, At, B0); PG8_BAR; PG8_SCHED;
            PG8_STAGE(PG8_SB(0, 1), b2 + hstep, voffB);
            PG8_WAIT_V(6); PG8_BAR; PG8_MMA(1, 1, At, B1); PG8_BAR;
            PG8_LDB(B0, 1, 0); PG8_SCHED; PG8_LDA(At, 1, 0); PG8_STAGE(PG8_SA(0, 1), a2 + hstep, voffA);
            PG8_WAIT_L(8); PG8_BAR; PG8_WAIT_L(0); PG8_MMA(0, 0, At, B0); PG8_BAR; PG8_SCHED;
            PG8_LDB(B1, 1, 1); PG8_STAGE(PG8_SB(1, 0), b3, voffB);
            PG8_BAR; PG8_WAIT_L(0); PG8_MMA(0, 1, At, B1); PG8_BAR;
            PG8_LDA(At, 1, 1); PG8_STAGE(PG8_SA(1, 0), a3, voffA);
            PG8_BAR; PG8_WAIT_L(0); PG8_MMA(1, 0, At, B0); PG8_BAR; PG8_SCHED;
            PG8_STAGE(PG8_SB(1, 1), b3 + hstep, voffB);
            PG8_WAIT_V(6); PG8_BAR; PG8_MMA(1, 1, At, B1); PG8_BAR;
            }
        }
        if constexpr (ALIGN_EPI) { if (wr == 0) PG8_BAR; }
        if constexpr (!Epi::AFTER_DRAIN) { E(acc, cur, wr, wc, fr, fq); S.done(cur); }
        if (!has_next) break;
#pragma unroll
        for (int a = 0; a < 2; ++a)
#pragma unroll
            for (int b = 0; b < 2; ++b)
#pragma unroll
                for (int m = 0; m < 4; ++m)
#pragma unroll
                    for (int n = 0; n < 2; ++n) acc[a][b][m][n] = (f32x4){0.f, 0.f, 0.f, 0.f};
        cur = nxt; cA = nA; cB = nB; ++ui;
        if constexpr (ALIGN_EPI) { if (wr == 1) PG8_BAR; }
    }
    PG8_WAIT_V(0);
    if constexpr (!ALIGN_EPI) { if (wr == 0) PG8_BAR; }
    PG8_BAR;
    if constexpr (Epi::AFTER_DRAIN) { E.fused(acc, cur, wr, wc, fr, fq, lds, wid, lane); S.done(cur); }
#undef PG8_SA
#undef PG8_SB
#undef PG8_STAGE
#undef PG8_LDA
#undef PG8_LDB
#undef PG8_MMA
#undef PG8_WAIT_V
#undef PG8_WAIT_L
#undef PG8_BAR
#undef PG8_SCHED
}
template <class Epi, class Sched, bool ALIGN_EPI = false, bool SP2 = false>
__device__ __forceinline__ void gemm_phase_g(PG8_LAS unsigned char* lds, const int K, const Sched& S, const Epi& E) {
    const int tid = threadIdx.x, wid = __builtin_amdgcn_readfirstlane(tid >> 6), lane = tid & 63, wr = wid >> 2, wc = wid & 3, fr = lane & 15, fq = lane >> 4;
    const int nt = K / BK;
    unsigned voffB[2]; int rowA[2], colA[2];
#pragma unroll
    for (int i = 0; i < 2; ++i) { int R, C; stage_rc(tid * 16 + i * 8192, R, C); const int lc = perm32(R & 31);
        const int Rb = Epi::BJI ? (64 * (R >> 5) + 16 * (lc >> 3) + (lc & 7)) : (Epi::PERM ? ((R & ~31) + lc) : R);
        rowA[i] = R; colA[i] = C * 2; voffB[i] = (unsigned)(Rb * K + C) * 2u; }
    const size_t kstep = (size_t)(BK * 2);
    const size_t hstep = Epi::BJI ? (size_t)8 * K * 2 : (size_t)HALF * K * 2;
    const size_t tstep = 2 * hstep;
    const unsigned ldsw = (unsigned)wid * 1024u;
    const int aoff = lds_byte(wr * 64 + fr, fq * 8), boff = lds_byte(wc * 32 + fr, fq * 8);
#define PG8_SA(b, h) (((b) * 2 + (h)) * HTB)
#define PG8_SB(b, h) ((4 + (b) * 2 + (h)) * HTB)
#define PG8_STAGE(bufoff, gbase, voff) do { _Pragma("unroll") for (int _i = 0; _i < 2; ++_i) \
        __builtin_amdgcn_global_load_lds((const unsigned*)((const char*)(gbase) + (voff)[_i]), (PG8_LAS unsigned*)(lds + (bufoff) + ldsw + _i * 8192), 16, 0, 0); } while (0)
#define PG8_STAGEA(bufoff, P0, P1, koff) do { \
        __builtin_amdgcn_global_load_lds((const unsigned*)(Ab + (size_t)(P0) + (koff)), (PG8_LAS unsigned*)(lds + (bufoff) + ldsw), 16, 0, 0); \
        __builtin_amdgcn_global_load_lds((const unsigned*)(Ab + (size_t)(P1) + (koff)), (PG8_LAS unsigned*)(lds + (bufoff) + ldsw + 8192), 16, 0, 0); } while (0)
#define PG8_LDA(dst, b, h) do { _Pragma("unroll") for (int m = 0; m < 4; ++m) _Pragma("unroll") for (int k = 0; k < 2; ++k) dst[m][k] = *(const PG8_LAS bf16x8*)(lds + PG8_SA(b, h) + aoff + m * 2048 + k * 1024); } while (0)
#define PG8_LDB(dst, b, h) do { _Pragma("unroll") for (int n = 0; n < 2; ++n) _Pragma("unroll") for (int k = 0; k < 2; ++k) dst[n][k] = *(const PG8_LAS bf16x8*)(lds + PG8_SB(b, h) + boff + n * 2048 + k * 1024); } while (0)
#define PG8_MMA(ai, bj, At, Bt) do { __builtin_amdgcn_s_setprio(1); _Pragma("unroll") for (int m = 0; m < 4; ++m) _Pragma("unroll") for (int n = 0; n < 2; ++n) _Pragma("unroll") for (int k = 0; k < 2; ++k) \
        acc[ai][bj][m][n] = __builtin_amdgcn_mfma_f32_16x16x32_bf16(Bt[n][k], At[m][k], acc[ai][bj][m][n], 0, 0, 0); __builtin_amdgcn_s_setprio(0); } while (0)
#define PG8_WAIT_V(n) asm volatile("s_waitcnt vmcnt(" #n ")" ::: "memory")
#define PG8_WAIT_L(n) asm volatile("s_waitcnt lgkmcnt(" #n ")" ::: "memory")
#define PG8_BAR __builtin_amdgcn_s_barrier()
#define PG8_SCHED __builtin_amdgcn_sched_barrier(0)
    Unit cur, nxt, un2; int ui = 0, sb_cur = 0;
    if (!S.next(0, cur)) return;
    int fillv = S.fill_issue(cur); S.fill_write(0, fillv);
    __syncthreads();
    bool has_next = S.next(1, nxt);
    fillv = 0; if (has_next) fillv = S.fill_issue(nxt);
    f32x4 acc[2][2][4][2];
#pragma unroll
    for (int a = 0; a < 2; ++a)
#pragma unroll
        for (int b = 0; b < 2; ++b)
#pragma unroll
            for (int m = 0; m < 4; ++m)
#pragma unroll
                for (int n = 0; n < 2; ++n) acc[a][b][m][n] = (f32x4){0.f, 0.f, 0.f, 0.f};
    bf16x8 At[4][2], B0[2][2], B1[2][2];
    const char* cB = S.b_base(cur);
    unsigned cA00, cA01, cA10, cA11, nA00, nA01, nA10, nA11;
    const char* const Ab = S.a_base();
    S.a_rows(0, rowA, colA, cA00, cA01, cA10, cA11);
    S.a_ready(cur);
    if constexpr (SP2) {
        PG8_STAGE(PG8_SB(0, 0), cB, voffB); PG8_STAGE(PG8_SB(0, 1), cB + hstep, voffB); PG8_STAGEA(PG8_SA(0, 0), cA00, cA01, 0); PG8_STAGEA(PG8_SA(0, 1), cA10, cA11, 0);
        if (wr == 1) PG8_BAR;
        PG8_WAIT_V(2); PG8_BAR;
        PG8_STAGE(PG8_SB(1, 0), cB + kstep, voffB); PG8_STAGEA(PG8_SA(1, 0), cA00, cA01, kstep); PG8_STAGE(PG8_SB(1, 1), cB + hstep + kstep, voffB);
        PG8_WAIT_V(6); PG8_BAR;
    } else {
        PG8_STAGE(PG8_SB(0, 0), cB, voffB); PG8_STAGEA(PG8_SA(0, 0), cA00, cA01, 0); PG8_STAGE(PG8_SB(0, 1), cB + hstep, voffB); PG8_STAGEA(PG8_SA(0, 1), cA10, cA11, 0);
        if (wr == 1) PG8_BAR;
        PG8_WAIT_V(4); PG8_BAR;
        PG8_STAGE(PG8_SB(1, 0), cB + kstep, voffB); PG8_STAGEA(PG8_SA(1, 0), cA00, cA01, kstep); PG8_STAGE(PG8_SB(1, 1), cB + hstep + kstep, voffB);
        PG8_WAIT_V(6); PG8_BAR;
    }
    for (;;) {
        const char* nB = has_next ? S.b_base(nxt) : cB;
        const int sb_n = sb_cur == 2 ? 0 : sb_cur + 1;
        bool has2 = false;
        if (has_next) { S.fill_write(sb_n, fillv); has2 = S.next(ui + 2, un2); if (has2) fillv = S.fill_issue(un2); }
        nA00 = cA00; nA01 = cA01; nA10 = cA10; nA11 = cA11;
#pragma unroll 1
        for (int t = 0; t < nt; t += 2) {
            const bool last = (t == nt - 2);
            const size_t k1 = (size_t)(t + 1) * kstep;
            const size_t k2 = last ? 0 : (size_t)(t + 2) * kstep; const char* b2 = last ? nB : cB + (size_t)(t + 2) * kstep;
            const unsigned q00 = last ? nA00 : cA00, q01 = last ? nA01 : cA01, q10 = last ? nA10 : cA10, q11 = last ? nA11 : cA11;
            const size_t k3 = k2 + kstep; const char* b3 = b2 + kstep;
            if (last && has_next) S.a_ready(nxt);
            if constexpr (SP2) {
            PG8_LDB(B0, 0, 0); PG8_LDB(B1, 0, 1); PG8_SCHED; PG8_LDA(At, 0, 0); PG8_STAGEA(PG8_SA(1, 1), cA10, cA11, k1);
            PG8_WAIT_V(8); PG8_WAIT_L(0); PG8_BAR; PG8_MMA(0, 0, At, B0); PG8_MMA(0, 1, At, B1); PG8_BAR; PG8_SCHED;
            PG8_LDA(At, 0, 1); PG8_STAGE(PG8_SB(0, 0), b2, voffB); PG8_STAGE(PG8_SB(0, 1), b2 + hstep, voffB); PG8_STAGEA(PG8_SA(0, 0), q00, q01, k2);
            PG8_WAIT_V(8); PG8_WAIT_L(0); PG8_BAR; PG8_MMA(1, 0, At, B0); PG8_MMA(1, 1, At, B1); PG8_BAR; PG8_SCHED;
            PG8_LDB(B0, 1, 0); PG8_LDB(B1, 1, 1); PG8_SCHED; PG8_LDA(At, 1, 0); PG8_STAGEA(PG8_SA(0, 1), q10, q11, k2);
            PG8_WAIT_V(8); PG8_WAIT_L(0); PG8_BAR; PG8_MMA(0, 0, At, B0); PG8_MMA(0, 1, At, B1); PG8_BAR; PG8_SCHED;
            PG8_LDA(At, 1, 1); PG8_STAGE(PG8_SB(1, 0), b3, voffB); PG8_STAGE(PG8_SB(1, 1), b3 + hstep, voffB); PG8_STAGEA(PG8_SA(1, 0), q00, q01, k3);
            PG8_WAIT_V(8); PG8_WAIT_L(0); PG8_BAR; PG8_MMA(1, 0, At, B0); PG8_MMA(1, 1, At, B1); PG8_BAR; PG8_SCHED;
            } else {
            PG8_LDB(B0, 0, 0); PG8_SCHED; PG8_LDA(At, 0, 0); PG8_STAGEA(PG8_SA(1, 1), cA10, cA11, k1);
            PG8_WAIT_L(8); PG8_BAR; PG8_WAIT_L(0); PG8_MMA(0, 0, At, B0); PG8_BAR; PG8_SCHED;
            PG8_LDB(B1, 0, 1); PG8_STAGE(PG8_SB(0, 0), b2, voffB);
            PG8_BAR; PG8_WAIT_L(0); PG8_MMA(0, 1, At, B1); PG8_BAR;
            PG8_LDA(At, 0, 1); PG8_STAGEA(PG8_SA(0, 0), q00, q01, k2);
            PG8_BAR; PG8_WAIT_L(0); PG8_MMA(1, 0, At, B0); PG8_BAR; PG8_SCHED;
            PG8_STAGE(PG8_SB(0, 1), b2 + hstep, voffB);
            PG8_WAIT_V(6); PG8_BAR; PG8_MMA(1, 1, At, B1); PG8_BAR;
            PG8_LDB(B0, 1, 0); PG8_SCHED; PG8_LDA(At, 1, 0); PG8_STAGEA(PG8_SA(0, 1), q10, q11, k2);
            PG8_WAIT_L(8); PG8_BAR; PG8_WAIT_L(0); PG8_MMA(0, 0, At, B0); PG8_BAR; PG8_SCHED;
            PG8_LDB(B1, 1, 1); PG8_STAGE(PG8_SB(1, 0), b3, voffB);
            PG8_BAR; PG8_WAIT_L(0); PG8_MMA(0, 1, At, B1); PG8_BAR;
            PG8_LDA(At, 1, 1); PG8_STAGEA(PG8_SA(1, 0), q00, q01, k3);
            PG8_BAR; PG8_WAIT_L(0); PG8_MMA(1, 0, At, B0); PG8_BAR; PG8_SCHED;
            PG8_STAGE(PG8_SB(1, 1), b3 + hstep, voffB);
            PG8_WAIT_V(6); PG8_BAR; PG8_MMA(1, 1, At, B1); PG8_BAR;
            }
            if (t == nt - 4 && has_next) S.a_rows(sb_n, rowA, colA, nA00, nA01, nA10, nA11);
        }
        if constexpr (ALIGN_EPI) { if (wr == 0) PG8_BAR; }
        if constexpr (!Epi::AFTER_DRAIN) { E(acc, cur, wr, wc, fr, fq, sb_cur); S.done(cur); }
        if (!has_next) break;
#pragma unroll
        for (int a = 0; a < 2; ++a)
#pragma unroll
            for (int b = 0; b < 2; ++b)
#pragma unroll
                for (int m = 0; m < 4; ++m)
#pragma unroll
                    for (int n = 0; n < 2; ++n) acc[a][b][m][n] = (f32x4){0.f, 0.f, 0.f, 0.f};
        cur = nxt; nxt = un2; has_next = has2; cA00 = nA00; cA01 = nA01; cA10 = nA10; cA11 = nA11; cB = nB; ++ui; sb_cur = sb_n;
        if constexpr (ALIGN_EPI) { if (wr == 1) PG8_BAR; }
    }
    PG8_WAIT_V(0);
    if constexpr (!ALIGN_EPI) { if (wr == 0) PG8_BAR; }
    PG8_BAR;
    if constexpr (Epi::AFTER_DRAIN) { E.fused(acc, cur, wr, wc, fr, fq, lds, wid, lane); S.done(cur); }
#undef PG8_SA
#undef PG8_SB
#undef PG8_STAGE
#undef PG8_STAGEA
#undef PG8_LDA
#undef PG8_LDB
#undef PG8_MMA
#undef PG8_WAIT_V
#undef PG8_WAIT_L
#undef PG8_BAR
#undef PG8_SCHED
}
}

DEVI void wt_colinfo(const Params& p, int R, const float*& src, int& ld, float& scale) {
    scale = 1.0f; src = nullptr; ld = 0;
    if (R < WT_AT) {
        const int pn = R >> 8, cl = R & 255; ld = DIN_; int col = -1;
        if (pn < 4) { const int wcq = (cl >> 5) & 3; col = (pn >> 1) * 512 + (2 * (pn & 1) + (wcq >> 1)) * 128 + 64 * (cl >> 7) + 32 * (wcq & 1) + (cl & 31);
                      if (pn >= 2) scale = KSCALE_; }
        else if (pn < 8)  col = 2048 + (pn - 4) * 256 + cl;
        else if (pn < 10) { col = 3072 + (pn - 8) * 256 + cl; scale = KSCALE_; }
        else if (pn < 14) col = 5120 + (pn - 10) * 256 + cl;
        else if (pn < 22) col = 6160 + (pn - 14) * 256 + cl;
        else if (cl < 16) col = 6144 + cl;
        if (col >= 0) src = p.w_in + col;
    } else if (R < WT_RET) {
        const int Rr = R - WT_AT, pm = Rr >> 8, rl = Rr & 255; ld = DIN_; int col;
        if (pm < 2) { col = 512 + (2 * pm + ((rl >> 6) & 1)) * 128 + 64 * (rl >> 7) + (rl & 63); scale = KSCALE_; }
        else if (pm < 6)  col = 1024 + (pm - 2) * 256 + rl;
        else if (pm < 10) col = 4096 + (pm - 6) * 256 + rl;
        else              col = 3584 + (pm - 10) * 256 + rl;
        src = p.w_in + col;
    } else {
        int Rr, ldd; const float* base;
        if (R < WT_GLA)    { Rr = R - WT_RET; base = p.w_ret_out; ldd = 1024; }
        else if (R < WT_O) { Rr = R - WT_GLA; base = p.w_gla_out; ldd = 1024; }
        else if (R < WT_R) { Rr = R - WT_O;   base = p.w_o;       ldd = 1024; }
        else               { Rr = R - WT_R;   base = p.router_w;  ldd = 256; }
        src = base + ((R >= WT_R) ? ((Rr & ~127) + vperm(Rr & 127)) : Rr); ld = ldd;
    }
}

DEVI void phase0(const Params& p, unsigned char* smem) {
    const int tid = VT, nb = VG, bid = VB;
    float2* cs = (float2*)(p.ws + OFF_CS);
    for (int i = bid * 256 + tid; i < 4096 * 64; i += nb * 256) {
        const int pos = i >> 6, k = i & 63;
        const float angf = (float)pos * c_inv_freq[k];
        const double a = (double)angf;
        const double TWO_PI = 6.283185307179586476925286766559, HALF_PI = 1.5707963267948966192313216916398;
        const double kk = rint(a * (1.0 / TWO_PI));
        const double r = a - kk * TWO_PI;
        const double qd = rint(r * (1.0 / HALF_PI));
        const double y = r - qd * HALF_PI;
        const double y2 = y * y;
        double sn = y * (1.0 + y2 * (-1.0 / 6 + y2 * (1.0 / 120 + y2 * (-1.0 / 5040 + y2 * (1.0 / 362880 + y2 * (-1.0 / 39916800 + y2 * (1.0 / 6227020800.0)))))));
        double cn = 1.0 + y2 * (-0.5 + y2 * (1.0 / 24 + y2 * (-1.0 / 720 + y2 * (1.0 / 40320 + y2 * (-1.0 / 3628800 + y2 * (1.0 / 479001600.0))))));
        const int qi = ((int)qd) & 3;
        double s, c;
        if (qi == 0) { s = sn; c = cn; } else if (qi == 1) { s = cn; c = -sn; } else if (qi == 2) { s = -sn; c = -cn; } else { s = -cn; c = sn; }
        cs[i] = make_float2((float)c, (float)s);
    }
    if (bid == 0) { int* cnt = (int*)(p.ws + OFF_CNT); cnt[tid * CNT_STRIDE] = 0; }
    {
        const f32x4* xs = (const f32x4*)p.x; u32x4* xd = (u32x4*)(p.ws + OFF_XB);
        const int n8 = T_ * D_ / 8;
        for (int g = bid * 256 + tid; g < n8; g += nb * 256) {
            const f32x4 v0 = xs[2 * g], v1 = xs[2 * g + 1];
            u32x4 o; o.x = pk2(v0[0], v0[1]); o.y = pk2(v0[2], v0[3]); o.z = pk2(v1[0], v1[1]); o.w = pk2(v1[2], v1[3]);
            xd[g] = o;
        }
    }
    {
        float* tile = (float*)smem;
        bf16_t* wt = (bf16_t*)(p.ws + OFF_WT);
        const int ntask = (WT_ROWS / 64) * 16;
        for (int task = bid; task < ntask; task += nb) {
            const int rt = task >> 4, kt = task & 15, R0 = rt * 64, k0 = kt * 64;
            {
                const int n = tid & 63, kq = tid >> 6;
                const float* src; int ld; float sc; wt_colinfo(p, R0 + n, src, ld, sc);
#pragma unroll
                for (int i = 0; i < 16; ++i) { const int k = kq + 4 * i; tile[k * 65 + n] = src ? src[(size_t)(k0 + k) * ld] * sc : 0.f; }
            }
            __syncthreads();
            {
                const int n = tid >> 2, ks = (tid & 3) * 16;
                unsigned o[8];
#pragma unroll
                for (int j = 0; j < 8; ++j) o[j] = pk2(tile[(ks + 2 * j) * 65 + n], tile[(ks + 2 * j + 1) * 65 + n]);
                u32x4* dst = (u32x4*)(wt + (size_t)(R0 + n) * 1024 + k0 + ks);
                dst[0] = (u32x4){o[0], o[1], o[2], o[3]}; dst[1] = (u32x4){o[4], o[5], o[6], o[7]};
            }
            __syncthreads();
        }
    }
}

struct EpiP1N {
    static constexpr bool PERM = true, AFTER_DRAIN = false;
    unsigned char* ws;
    __device__ __forceinline__ void operator()(const pg8::f32x4 (&acc)[2][2][4][2], const pg8::Unit& u, int wr, int wc, int fr, int fq) const {
        const int pn = u.pn, row0 = u.pm * 256 + wr * 64 + fr, c8 = wc * 32 + 8 * fq;
        if (pn < 4) {
            const float2* cs = (const float2*)(ws + OFF_CS); bf16_t* Qr = (bf16_t*)(ws + (pn < 2 ? OFF_QR : OFF_KR));
            const int head = 2 * (pn & 1) + (wc >> 1), d0 = 32 * (wc & 1) + 8 * fq;
#pragma unroll
            for (int ai = 0; ai < 2; ++ai)
#pragma unroll
                for (int m = 0; m < 4; ++m) {
                    const size_t row = row0 + ai * 128 + m * 16; const int pos = (int)(row & 4095);
                    f32x4 c4[4];
#pragma unroll
                    for (int j = 0; j < 4; ++j) c4[j] = *(const f32x4*)(cs + pos * 64 + d0 + 2 * j);
                    f32x4 o1[2], o2[2];
#pragma unroll
                    for (int n = 0; n < 2; ++n)
#pragma unroll
                        for (int r = 0; r < 4; ++r) {
                            const f32x4 cc = c4[2 * n + (r >> 1)]; const float c_ = cc[(r & 1) * 2], s_ = cc[(r & 1) * 2 + 1];
                            const float x1 = acc[ai][0][m][n][r], x2 = acc[ai][1][m][n][r];
                            o1[n][r] = x1 * c_ - x2 * s_; o2[n][r] = x1 * s_ + x2 * c_;
                        }
                    *(u32x4*)(Qr + row * 512 + head * 128 + d0) = pk8(o1[0], o1[1]);
                    *(u32x4*)(Qr + row * 512 + head * 128 + 64 + d0) = pk8(o2[0], o2[1]);
                    asm volatile("" ::: "memory");
                }
        } else {
#pragma unroll
            for (int ai = 0; ai < 2; ++ai)
#pragma unroll
                for (int m = 0; m < 4; ++m) {
                    const size_t row = row0 + ai * 128 + m * 16;
#pragma unroll
                    for (int bj = 0; bj < 2; ++bj) {
                        const int cl = bj * 128 + c8;
                        f32x4 v0 = acc[ai][bj][m][0], v1 = acc[ai][bj][m][1];
                        if (pn < 8) {
#pragma unroll
                            for (int r = 0; r < 4; ++r) { v0[r] = siluf_(v0[r]); v1[r] = siluf_(v1[r]); }
                            *(u32x4*)((bf16_t*)(ws + OFF_GS) + row * 2048 + (pn - 4) * 256 + cl) = pk8(v0, v1);
                        } else if (pn < 10) {
                            *(u32x4*)((bf16_t*)(ws + OFF_QGN) + row * 512 + (pn - 8) * 256 + cl) = pk8(v0, v1);
                        } else if (pn < 14) {
#pragma unroll
                            for (int r = 0; r < 4; ++r) { v0[r] = siluf_(v0[r]); v1[r] = siluf_(v1[r]); }
                            *(u32x4*)((bf16_t*)(ws + OFF_GS) + row * 2048 + 1024 + (pn - 10) * 256 + cl) = pk8(v0, v1);
                        } else if (pn < 22) {
#pragma unroll
                            for (int r = 0; r < 4; ++r) { v0[r] = sigmoidf_(v0[r]); v1[r] = sigmoidf_(v1[r]); }
                            *(u32x4*)((bf16_t*)(ws + OFF_MG) + row * 2048 + (pn - 14) * 256 + cl) = pk8(v0, v1);
                        } else if (cl < 16) {
                            float* Ga = (float*)(ws + OFF_GA); *(f32x4*)(Ga + row * 16 + cl) = v0; *(f32x4*)(Ga + row * 16 + cl + 4) = v1;
                        }
                    }
                    asm volatile("" ::: "memory");
                }
        }
    }
};
struct EpiP1V {
    static constexpr bool PERM = true, AFTER_DRAIN = false;
    unsigned char* ws;
    __device__ __forceinline__ void operator()(const pg8::f32x4 (&acc)[2][2][4][2], const pg8::Unit& u, int wr, int wc, int fr, int fq) const {
        bf16_t* dst = (bf16_t*)(ws + (u.pm < 4 ? OFF_VRT : OFF_VGT)); const int head = u.pm & 3;
#pragma unroll
        for (int bj = 0; bj < 2; ++bj) {
            const int tok0 = u.pn * 256 + bj * 128 + wc * 32 + 8 * fq; const int item = (tok0 >> 6) * 4 + head, m0 = tok0 & 63;
#pragma unroll
            for (int ai = 0; ai < 2; ++ai)
#pragma unroll
                for (int m = 0; m < 4; ++m) {
                    *(u32x4*)(dst + vf_off(item, ai * 128 + wr * 64 + m * 16 + fr, m0)) = pk8(acc[ai][bj][m][0], acc[ai][bj][m][1]);
                    asm volatile("" ::: "memory");
                }
        }
    }
};
struct EpiP1G {
    static constexpr bool PERM = true, AFTER_DRAIN = false;
    unsigned char* ws;
    __device__ __forceinline__ void operator()(const pg8::f32x4 (&acc)[2][2][4][2], const pg8::Unit& u, int wr, int wc, int fr, int fq) const {
        bf16_t* dst = (bf16_t*)(ws + OFF_KGT);
#pragma unroll
        for (int bj = 0; bj < 2; ++bj) {
            const int tok0 = u.pn * 256 + bj * 128 + wc * 32 + 8 * fq; const int m0 = tok0 & 63;
#pragma unroll
            for (int ai = 0; ai < 2; ++ai) {
                const unsigned item = (unsigned)((tok0 >> 6) * 4 + 2 * u.pm + ai);
#pragma unroll
                for (int m = 0; m < 4; ++m) {
                    *(u32x4*)(dst + (item * 128u + (unsigned)(wr * 64 + m * 16 + fr)) * 64u + (unsigned)m0) = pk8(acc[ai][bj][m][0], acc[ai][bj][m][1]);
                    asm volatile("" ::: "memory");
                }
            }
        }
    }
};
DEVI void phase1(const Params& p, unsigned char* smem_all) {
    {
        pg8::StaticOrder S; S.init(T_, 5888, RG, RB);
        pg8::Gemm g; g.A = (const bf16_t*)(p.ws + OFF_XB); g.Bt = (const bf16_t*)(p.ws + OFF_WT) + (size_t)WT_BN * 1024; g.M = T_; g.N = 5888; g.K = 1024;
        EpiP1N E; E.ws = p.ws;
        pg8::gemm_phase<EpiP1N, pg8::StaticOrder, true, true>((PG8_LAS unsigned char*)smem_all, g, S, E);
    }
    __syncthreads();
    {
        pg8::StaticOrder S; S.init(2048, T_, RG, RB);
        pg8::Gemm g; g.A = (const bf16_t*)(p.ws + OFF_WT) + (size_t)(WT_AT + 512) * 1024; g.Bt = (const bf16_t*)(p.ws + OFF_XB); g.M = 2048; g.N = T_; g.K = 1024;
        EpiP1V E; E.ws = p.ws;
        pg8::gemm_phase<EpiP1V, pg8::StaticOrder, true, true>((PG8_LAS unsigned char*)smem_all, g, S, E);
    }
    __syncthreads();
    {
        pg8::StaticOrder S; S.init(512, T_, RG, RB);
        pg8::Gemm g; g.A = (const bf16_t*)(p.ws + OFF_WT) + (size_t)(WT_AT + 2560) * 1024; g.Bt = (const bf16_t*)(p.ws + OFF_XB); g.M = 512; g.N = T_; g.K = 1024;
        EpiP1G E; E.ws = p.ws;
        pg8::gemm_phase<EpiP1G, pg8::StaticOrder, true, true>((PG8_LAS unsigned char*)smem_all, g, S, E);
    }
}

DEVI void phase2(const Params& p, unsigned char* smem) {
    float* ga_s = (float*)smem;
    float* tot = (float*)(smem + 4096);
    const int tid = VT;
    const float* Ga = (const float*)(p.ws + OFF_GA);
    const bf16_t* Kgt = (const bf16_t*)(p.ws + OFF_KGT); bf16_t* Kg2 = (bf16_t*)(p.ws + OFF_KG2);
    float* dec = (float*)(p.ws + OFF_DEC);
    for (int it = VB; it < 2048; it += VG) {
        const int h = it & 3, c = (it >> 2) & 63, b = it >> 8;
        const int tok0 = b * 4096 + c * 64;
        ((f32x4*)ga_s)[tid] = ((const f32x4*)(Ga + (size_t)tok0 * 16))[tid];
        const int dk = tid & 127, half = tid >> 7;
        float w2[16];
#pragma unroll
        for (int r = 0; r < 16; ++r) w2[r] = p.gate_w2[r * 512 + h * 128 + dk];
        const float bias = p.gate_b[h * 128 + dk];
        __syncthreads();
        float run = 0.f; float bc[32];
#pragma unroll
        for (int ml = 0; ml < 32; ++ml) {
            const int m = half * 32 + ml;
            float z = bias;
#pragma unroll
            for (int r4 = 0; r4 < 4; ++r4) { const f32x4 g4 = *(const f32x4*)&ga_s[m * 16 + 4 * r4];
                z += g4[0] * w2[4 * r4] + g4[1] * w2[4 * r4 + 1] + g4[2] * w2[4 * r4 + 2] + g4[3] * w2[4 * r4 + 3]; }
            const float la = (fminf(z, 0.f) - __logf(1.0f + __expf(-fabsf(z)))) * (1.0f / 16.0f);
            run += la; bc[ml] = run;
        }
        tot[half * 128 + dk] = run;
        __syncthreads();
        const float t0 = tot[dk], t1 = tot[128 + dk];
        const float bend = t0 + t1, off = half ? t0 : 0.f;
        const u32x4* kp = (const u32x4*)(Kgt + ((size_t)it * 128 + dk) * 64 + half * 32);
        bf16_t* const kqb = Kg2;
#pragma unroll
        for (int j = 0; j < 4; ++j) {
            u32x4 v = kp[j];
            unsigned uu[4] = {v.x, v.y, v.z, v.w};
#pragma unroll
            for (int e = 0; e < 4; ++e) {
                const float f0 = bflo(uu[e]) * __expf(bend - (bc[8 * j + 2 * e] + off));
                const float f1 = bfhi(uu[e]) * __expf(bend - (bc[8 * j + 2 * e + 1] + off));
                uu[e] = pk2(f0, f1);
            }
            *(u32x4*)(kqb + kf_off(it, dk, half * 32 + 8 * j)) = (u32x4){uu[0], uu[1], uu[2], uu[3]};
        }
        if (half == 0) dec[(size_t)it * 128 + dk] = __expf(bend);
        {
            const bf16_t* Qn = (const bf16_t*)(p.ws + OFF_QGN); bf16_t* QF = (bf16_t*)(p.ws + OFF_QG);
            const int m = tid & 63, qd = tid >> 6, bc = b * 64 + c;
            const u32x4* qs = (const u32x4*)(Qn + ((size_t)tok0 + m) * 512 + h * 128 + 32 * qd);
            u32x4 qv[4];
#pragma unroll
            for (int j = 0; j < 4; ++j) qv[j] = qs[j];
#pragma unroll
            for (int j = 0; j < 4; ++j) {
                *(u32x2*)(QF + qf_off(bc, h, m, 32 * qd + 8 * j, 0)) = (u32x2){qv[j].x, qv[j].y};
                *(u32x2*)(QF + qf_off(bc, h, m, 32 * qd + 8 * j, 1)) = (u32x2){qv[j].z, qv[j].w};
            }
        }
        __syncthreads();
    }
    {
        bf16_t* tile = (bf16_t*)smem;
        const bf16_t* Kr = (const bf16_t*)(p.ws + OFF_KR); bf16_t* Krt = (bf16_t*)(p.ws + OFF_KRT);
        for (int it = VB; it < 2048; it += VG) {
            const int h = it & 3, c = (it >> 2) & 63, b = it >> 8;
            const size_t tok0 = (size_t)b * 4096 + c * 64;
            const int m = tid & 63, qd = tid >> 6;
            const float kd = exp2f(gamma_log2(h) * (float)(63 - m));
            const u32x4* src = (const u32x4*)(Kr + (tok0 + m) * 512 + h * 128 + 32 * qd);
            u32x4 v[4];
#pragma unroll
            for (int j = 0; j < 4; ++j) v[j] = src[j];
#pragma unroll
            for (int j = 0; j < 4; ++j) {
                const unsigned uu[4] = {v[j].x, v[j].y, v[j].z, v[j].w};
#pragma unroll
                for (int e = 0; e < 4; ++e) {
                    const int dk = 32 * qd + 8 * j + 2 * e;
                    tile[dk * 72 + m] = f2bf(bflo(uu[e]) * kd); tile[(dk + 1) * 72 + m] = f2bf(bfhi(uu[e]) * kd);
                }
            }
            {
                const bf16_t* Qr = (const bf16_t*)(p.ws + OFF_QR); bf16_t* QF = (bf16_t*)(p.ws + OFF_QFR);
                const u32x4* qs = (const u32x4*)(Qr + (tok0 + m) * 512 + h * 128 + 32 * qd);
                u32x4 qv[4];
#pragma unroll
                for (int j = 0; j < 4; ++j) qv[j] = qs[j];
                const int bc = b * 64 + c;
#pragma unroll
                for (int j = 0; j < 4; ++j) {
                    *(u32x2*)(QF + qf_off(bc, h, m, 32 * qd + 8 * j, 0)) = (u32x2){qv[j].x, qv[j].y};
                    *(u32x2*)(QF + qf_off(bc, h, m, 32 * qd + 8 * j, 1)) = (u32x2){qv[j].z, qv[j].w};
                }
            }
            __syncthreads();
            {
                const int dk = tid >> 1, hf = tid & 1;
#pragma unroll
                for (int j = 0; j < 4; ++j) *(u32x4*)(Krt + kf_off(it, dk, hf * 32 + 8 * j)) = *(const u32x4*)&tile[dk * 72 + hf * 32 + 8 * j];
            }
            __syncthreads();
        }
    }
}

typedef float f32x16 __attribute__((ext_vector_type(16)));
DEVI f32x16 mfma32(bf16x8 a, bf16x8 b, f32x16 c) { return __builtin_amdgcn_mfma_f32_32x32x16_bf16(a, b, c, 0, 0, 0); }
#ifndef SCAN_DEPTH
#define SCAN_DEPTH 1
#endif
struct ScanSet { bf16x8 kf[4], vf[4], qf[2][2]; f32x4 dc[4]; };
template <bool GLA>
DEVI void scan_tile(const Params& p, unsigned char* zb  , int b, int h, int s, int dummy) {
    const int t = VT >> 6, lane = VT & 63, r = lane & 31, hh = lane >> 5;
    const bf16_t* Ktb = (const bf16_t*)(p.ws + (GLA ? OFF_KG2 : OFF_KRT));
    const bf16_t* Vtb = (const bf16_t*)(p.ws + (GLA ? OFF_VGT : OFF_VRT));
    const bf16_t* Qb  = (const bf16_t*)(p.ws + (GLA ? OFF_QG : OFF_QFR));
    const float* dec = (const float*)(p.ws + OFF_DEC);
    bf16_t* Oo = (bf16_t*)(p.ws + OFF_OO);
    const float lg = gamma_log2(h);
    const float cd = exp2f(lg * 64.0f);
    f32x16 S;
#pragma unroll
    for (int i = 0; i < 16; ++i) S[i] = 0.f;
    const unsigned it0 = (unsigned)(b * 64 * 4 + h);
    const bf16_t* const kp = Ktb + ((size_t)it0 * 4 + t) * 4 * 512; const unsigned ko = (unsigned)lane * 8;
    const bf16_t* const vp = Vtb + ((size_t)it0 * 8 + s) * 4 * 512; const unsigned vo = (unsigned)lane * 8;
    const bf16_t* const qp = Qb + ((((size_t)(b * 64) * 4 + h) * 2) * 4 + t) * 2 * 512; const unsigned qo = (unsigned)lane * 8;
    const float* const dp = dec + (size_t)it0 * 128 + t * 32; const unsigned dofs = 4 * hh;
    const int rt = t >> 1, rg0 = 2 * (t & 1);
    bf16_t* const op = Oo + (size_t)b * 4096 * 2048 + (GLA ? 1024 : 0) + h * 256 + s * 32 + (size_t)rt * 32 * 2048; const unsigned oo = (unsigned)r * 2048 + 4 * hh;
    const float qd = GLA ? 1.0f : exp2f(lg * (float)(32 * rt + r + 1));
    bf16_t* const ob = Oo + (size_t)b * 4096 * 2048 + (GLA ? 1024 : 0) + h * 256 + s * 32;
#define ST_LOAD(SET, C) do { const int c_ = dummy ? 0 : ((C) < 64 ? (C) : 63); \
        const bf16_t* kq = kp + (size_t)c_ * (4 * 16 * 512) + ko; const bf16_t* vq = vp + (size_t)c_ * (4 * 32 * 512) + vo; const bf16_t* qq = qp + (size_t)c_ * (4 * 16 * 512) + qo; \
        _Pragma("unroll") for (int ks = 0; ks < 4; ++ks) { (SET).kf[ks] = *(const bf16x8*)(kq + ks * 512); (SET).vf[ks] = *(const bf16x8*)(vq + ks * 512); } \
        _Pragma("unroll") for (int ss = 0; ss < 2; ++ss) _Pragma("unroll") for (int tt = 0; tt < 2; ++tt) (SET).qf[ss][tt] = *(const bf16x8*)(qq + tt * (8 * 512) + ss * 512); \
        } while (0)
#define ST_LOADDC(SET, C) do { if (GLA) { const int c_ = (C) < 64 ? (C) : 63; const float* dq = dp + (size_t)c_ * (4 * 128) + dofs; \
        _Pragma("unroll") for (int g = 0; g < 4; ++g) (SET).dc[g] = *(const f32x4*)(dq + 8 * g); } } while (0)
#define ST_Z(SET, ZC) do { \
        _Pragma("unroll") for (int tt = 0; tt < 2; ++tt) { \
            f32x16 Zt; _Pragma("unroll") for (int i = 0; i < 16; ++i) Zt[i] = 0.f; \
            _Pragma("unroll") for (int ss = 0; ss < 2; ++ss) { \
                u32x4 pk; pk.x = pk2(S[8 * ss + 0], S[8 * ss + 1]); pk.y = pk2(S[8 * ss + 2], S[8 * ss + 3]); pk.z = pk2(S[8 * ss + 4], S[8 * ss + 5]); pk.w = pk2(S[8 * ss + 6], S[8 * ss + 7]); \
                Zt = mfma32(__builtin_bit_cast(bf16x8, pk), (SET).qf[ss][tt], Zt); } \
            _Pragma("unroll") for (int g = 0; g < 4; ++g) { \
                f32x4 z4; z4[0] = Zt[4 * g]; z4[1] = Zt[4 * g + 1]; z4[2] = Zt[4 * g + 2]; z4[3] = Zt[4 * g + 3]; \
                *(u32x2*)((ZC) + (((t * 2 + tt) * 4 + g) * 64 + lane) * 8) = pk4(z4); } } } while (0)
#define ST_UPD(SET) do { \
        if (GLA) { _Pragma("unroll") for (int g = 0; g < 4; ++g) _Pragma("unroll") for (int i = 0; i < 4; ++i) S[4 * g + i] *= (SET).dc[g][i]; } \
        else { _Pragma("unroll") for (int i = 0; i < 16; ++i) S[i] *= cd; } \
        _Pragma("unroll") for (int ks = 0; ks < 4; ++ks) S = mfma32((SET).kf[ks], (SET).vf[ks], S); } while (0)
#define ST_STEP(CUR, NXT, OTH, C) do { \
        ST_LOAD(NXT, (C) + SCAN_DEPTH); ST_LOADDC(OTH, (C) + 1);      \
        __builtin_amdgcn_sched_barrier(0); \
        unsigned char* zc = zb + ((C) & 1) * 16384; \
        if (GLA) { ST_UPD(CUR); ST_Z(CUR, zc); } else { ST_Z(CUR, zc); ST_UPD(CUR); } \
        __syncthreads(); \
        _Pragma("unroll") for (int gi = 0; gi < 2; ++gi) { const int g = rg0 + gi; \
            f32x4 o = (f32x4){0.f, 0.f, 0.f, 0.f}; \
            _Pragma("unroll") for (int t2 = 0; t2 < 4; ++t2) o += unpk4(*(const u32x2*)(zc + (((t2 * 2 + rt) * 4 + g) * 64 + lane) * 8)); \
            *(u32x2*)(zb + 32768 + ((C) & 7) * 4096 + (32 * rt + r) * 64 + (8 * g + 4 * hh) * 2) = pk4(o * qd); } \
          \
        if (((C) & 7) == 7) { __syncthreads(); \
            _Pragma("unroll") for (int i = 0; i < 8; ++i) { const int idx = i * 256 + VT, row = idx >> 2, part = idx & 3; \
                *(u32x4*)(ob + ((size_t)((C) - 7) * 64 + row) * 2048 + part * 8) = *(const u32x4*)(zb + 32768 + row * 64 + part * 16); } } } while (0)
#if SCAN_DEPTH == 2
    ScanSet A, B, Cc;
    ST_LOAD(A, 0); ST_LOADDC(A, 0); ST_LOAD(B, 1);
#pragma unroll 1
    for (int c0 = 0; c0 < 63; c0 += 3) { ST_STEP(A, Cc, B, c0); ST_STEP(B, A, Cc, c0 + 1); ST_STEP(Cc, B, A, c0 + 2); }
    ST_STEP(A, Cc, B, 63);
#else
    ScanSet A, B;
    ST_LOAD(A, 0); ST_LOADDC(A, 0);
#pragma unroll 1
    for (int c0 = 0; c0 < 64; c0 += 2) { ST_STEP(A, B, B, c0); ST_STEP(B, A, A, c0 + 1); }
#endif
    __syncthreads();
#undef ST_STEP
#undef ST_UPD
#undef ST_Z
#undef ST_LOADDC
#undef ST_LOAD
}
DEVI void phase3t(const Params& p, unsigned char* smem, int dummy) {
    for (int it0 = VB; it0 < 512; it0 += VG) {
        const int lcl = (RB >> 3) * 2 + VH;
        const int it = (VG == 512) ? ((RB & 7) * 8 + lcl / 8) * 8 + (lcl & 7) : it0;
        const int s = it & 7, h = (it >> 3) & 3, b = (it >> 5) & 7, br = it >> 8;
        if (br == 0) scan_tile<false>(p, smem, b, h, s, dummy); else scan_tile<true>(p, smem, b, h, s, dummy);
    }
}

constexpr int PS_LD = 72;
DEVI void phase4(const Params& p, unsigned char* smem) {
    const int t = VT, lane = t & 63, w = t >> 6, l15 = lane & 15, q = lane >> 4;
    bf16_t* Ps = (bf16_t*)smem + w * 16 * PS_LD;
    const bf16_t* Qr = (const bf16_t*)(p.ws + OFF_QR); const bf16_t* Kr = (const bf16_t*)(p.ws + OFF_KR);
    const bf16_t* Vrt = (const bf16_t*)(p.ws + OFF_VRT); const bf16_t* Oo = (const bf16_t*)(p.ws + OFF_OO);
    const bf16_t* Gs = (const bf16_t*)(p.ws + OFF_GS); bf16_t* Y = (bf16_t*)(p.ws + OFF_Y);
    for (int it = VB; it < 4096; it += VG) {
        const int br = it >> 11, idx = it & 2047;
        const int h = idx & 3, c = (idx >> 2) & 63, b = idx >> 8;
        const size_t tok0 = (size_t)b * 4096 + c * 64;
        const size_t tok = tok0 + 16 * w + l15;
        f32x4 O[16];
        const bf16_t* orow = Oo + tok * 2048 + br * 1024 + h * 256 + 4 * q;
        const bf16_t* grow = Gs + tok * 2048 + br * 1024 + h * 256 + 4 * q;
        u32x2 oraw[16], graw[16];
        if (br == 0) {
            const float lg = gamma_log2(h);
            bf16x8 vf[8][2];
#pragma unroll
            for (int nt = 0; nt < 8; ++nt) { vf[nt][0] = *(const bf16x8*)(Vrt + vf_off(idx, 16 * nt + l15, q * 8)); vf[nt][1] = *(const bf16x8*)(Vrt + vf_off(idx, 16 * nt + l15, 32 + q * 8)); }
            __builtin_amdgcn_sched_barrier(0);
            f32x4 P[4] = {(f32x4){0.f, 0.f, 0.f, 0.f}, (f32x4){0.f, 0.f, 0.f, 0.f}, (f32x4){0.f, 0.f, 0.f, 0.f}, (f32x4){0.f, 0.f, 0.f, 0.f}};
#pragma unroll
            for (int ks = 0; ks < 4; ++ks) {
                const bf16x8 qf = *(const bf16x8*)(Qr + tok * 512 + h * 128 + ks * 32 + q * 8);
#pragma unroll
                for (int mt = 0; mt < 4; ++mt) {
                    const bf16x8 kf = *(const bf16x8*)(Kr + (tok0 + 16 * mt + l15) * 512 + h * 128 + ks * 32 + q * 8);
                    P[mt] = mfma16(kf, qf, P[mt]);
                }
            }
            const int j = 16 * w + l15;
#pragma unroll
            for (int mt = 0; mt < 4; ++mt) {
                f32x4 v = P[mt];
#pragma unroll
                for (int r = 0; r < 4; ++r) { const int m = 16 * mt + 4 * q + r; const int dd = j > m ? j - m : m - j; v[r] *= exp2f(lg * (float)dd); }
                *(u32x2*)&Ps[l15 * PS_LD + 16 * mt + 4 * q] = pk4(v);
            }
            __syncthreads();
            const bf16x8 pf0 = *(const bf16x8*)&Ps[l15 * PS_LD + q * 8];
            const bf16x8 pf1 = *(const bf16x8*)&Ps[l15 * PS_LD + 32 + q * 8];
            __builtin_amdgcn_sched_barrier(0);
#pragma unroll
            for (int nt = 0; nt < 8; ++nt) {
                f32x4 o = (f32x4){0.f, 0.f, 0.f, 0.f};
                o = mfma16(vf[nt][0], pf0, o); O[nt] = mfma16(vf[nt][1], pf1, o);
            }
            __builtin_amdgcn_sched_barrier(0);
#pragma unroll
            for (int nt = 0; nt < 8; ++nt) { vf[nt][0] = *(const bf16x8*)(Vrt + vf_off(idx, 16 * (8 + nt) + l15, q * 8)); vf[nt][1] = *(const bf16x8*)(Vrt + vf_off(idx, 16 * (8 + nt) + l15, 32 + q * 8)); }
#pragma unroll
            for (int nt = 0; nt < 16; ++nt) { oraw[nt] = *(const u32x2*)(orow + 16 * nt); graw[nt] = *(const u32x2*)(grow + 16 * nt); }
            __builtin_amdgcn_sched_barrier(0);
#pragma unroll
            for (int nt = 0; nt < 8; ++nt) {
                f32x4 o = (f32x4){0.f, 0.f, 0.f, 0.f};
                o = mfma16(vf[nt][0], pf0, o); O[8 + nt] = mfma16(vf[nt][1], pf1, o);
            }
#pragma unroll
            for (int nt = 0; nt < 16; ++nt) O[nt] += unpk4(oraw[nt]);
            __syncthreads();
        } else {
#pragma unroll
            for (int nt = 0; nt < 16; ++nt) { oraw[nt] = *(const u32x2*)(orow + 16 * nt); graw[nt] = *(const u32x2*)(grow + 16 * nt); }
#pragma unroll
            for (int nt = 0; nt < 16; ++nt) O[nt] = unpk4(oraw[nt]);
        }
        float s1 = 0.f;
#pragma unroll
        for (int nt = 0; nt < 16; ++nt) s1 += (O[nt][0] + O[nt][1]) + (O[nt][2] + O[nt][3]);
        s1 += __shfl_xor(s1, 16); s1 += __shfl_xor(s1, 32);
        const float mean = (br == 0) ? s1 * (1.0f / 256.0f) : 0.f;
        float s2 = 0.f;
#pragma unroll
        for (int nt = 0; nt < 16; ++nt) {
#pragma unroll
            for (int r = 0; r < 4; ++r) { const float dlt = O[nt][r] - mean; s2 += dlt * dlt; }
        }
        s2 += __shfl_xor(s2, 16); s2 += __shfl_xor(s2, 32);
        const float rstd = rsqrtf(s2 * (1.0f / 256.0f) + (br == 0 ? 1e-5f : 1e-6f));
        const float* gw = (br == 0 ? p.ret_norm_g : p.gla_norm_g) + h * 256 + 4 * q;
        bf16_t* yrow = Y + ((size_t)br * T_ + tok) * 1024 + h * 256 + 4 * q;
#pragma unroll
        for (int nt = 0; nt < 16; ++nt) {
            const f32x4 g = *(const f32x4*)(gw + 16 * nt);
            const f32x4 gate = unpk4(graw[nt]);
            f32x4 y;
#pragma unroll
            for (int r = 0; r < 4; ++r) y[r] = (O[nt][r] - mean) * rstd * g[r] * gate[r];
            *(u32x2*)(yrow + 16 * nt) = pk4(y);
        }
    }
}

struct EpiMerge {
    static constexpr bool PERM = true, AFTER_DRAIN = false;
    const bf16_t* Mg; bf16_t* Mrg; int pass;
    __device__ __forceinline__ void operator()(const pg8::f32x4 (&acc)[2][2][4][2], const pg8::Unit& u, int wr, int wc, int fr, int fq) const {
        const int row0 = u.pm * 256 + wr * 64 + fr, col0 = u.pn * 256 + wc * 32 + 8 * fq;
#pragma unroll
        for (int ai = 0; ai < 2; ++ai) {
            u32x4 gg[4][2], pr[4][2];
#pragma unroll
            for (int m = 0; m < 4; ++m)
#pragma unroll
                for (int bj = 0; bj < 2; ++bj) {
                    const size_t row = row0 + ai * 128 + m * 16; const int col = col0 + bj * 128;
                    gg[m][bj] = *(const u32x4*)(Mg + row * 2048 + pass * 1024 + col);
                    if (pass) pr[m][bj] = *(const u32x4*)(Mrg + row * 1024 + col);
                }
#pragma unroll
            for (int m = 0; m < 4; ++m)
#pragma unroll
                for (int bj = 0; bj < 2; ++bj) {
                    const size_t row = row0 + ai * 128 + m * 16; const int col = col0 + bj * 128;
                    f32x4 g0, g1; unpk8(gg[m][bj], g0, g1);
                    f32x4 o0 = acc[ai][bj][m][0] * g0, o1 = acc[ai][bj][m][1] * g1;
                    if (pass) { f32x4 p0, p1; unpk8(pr[m][bj], p0, p1); o0 += p0; o1 += p1; }
                    *(u32x4*)(Mrg + row * 1024 + col) = pk8(o0, o1);
                }
        }
    }
};
DEVI void phase5(const Params& p, unsigned char* smem_all) {
    pg8::StaticOrder S; S.init(T_, 1024, RG, RB);
    const bf16_t* Y = (const bf16_t*)(p.ws + OFF_Y); const bf16_t* wt = (const bf16_t*)(p.ws + OFF_WT);
    for (int pass = 0; pass < 2; ++pass) {
        pg8::Gemm g; g.A = Y + (size_t)pass * T_ * 1024; g.Bt = wt + (size_t)(pass ? WT_GLA : WT_RET) * 1024; g.M = T_; g.N = 1024; g.K = 1024;
        EpiMerge E; E.Mg = (const bf16_t*)(p.ws + OFF_MG); E.Mrg = (bf16_t*)(p.ws + OFF_MRG); E.pass = pass;
        pg8::gemm_phase<EpiMerge, pg8::StaticOrder, true, true>((PG8_LAS unsigned char*)smem_all, g, S, E);
        __syncthreads();
    }
}

struct EpiResid {
    static constexpr bool PERM = true, AFTER_DRAIN = false;
    const float* x; bf16_t* T1;
    __device__ __forceinline__ void operator()(const pg8::f32x4 (&acc)[2][2][4][2], const pg8::Unit& u, int wr, int wc, int fr, int fq) const {
        const int row0 = u.pm * 256 + wr * 64 + fr, col0 = u.pn * 256 + wc * 32 + 8 * fq;
#pragma unroll
        for (int ai = 0; ai < 2; ++ai)
#pragma unroll
            for (int m = 0; m < 4; ++m) {
                const size_t row = row0 + ai * 128 + m * 16;
                f32x4 xv[2][2];
#pragma unroll
                for (int bj = 0; bj < 2; ++bj) { xv[bj][0] = *(const f32x4*)(x + row * 1024 + col0 + bj * 128); xv[bj][1] = *(const f32x4*)(x + row * 1024 + col0 + bj * 128 + 4); }
#pragma unroll
                for (int bj = 0; bj < 2; ++bj)
                    *(u32x4*)(T1 + row * 1024 + col0 + bj * 128) = pk8(xv[bj][0] * ALPHA_ + acc[ai][bj][m][0], xv[bj][1] * ALPHA_ + acc[ai][bj][m][1]);
            }
    }
};
DEVI void phase6(const Params& p, unsigned char* smem_all) {
    pg8::StaticOrder S; S.init(T_, 1024, RG, RB);
    pg8::Gemm g; g.A = (const bf16_t*)(p.ws + OFF_MRG); g.Bt = (const bf16_t*)(p.ws + OFF_WT) + (size_t)WT_O * 1024; g.M = T_; g.N = 1024; g.K = 1024;
    EpiResid E; E.x = p.x; E.T1 = (bf16_t*)(p.ws + OFF_T1);
    pg8::gemm_phase<EpiResid, pg8::StaticOrder, true, true>((PG8_LAS unsigned char*)smem_all, g, S, E);
}

DEVI void conv_expert_weights(const Params& p, unsigned char* smem) {
    bf16_t* tile = (bf16_t*)smem;
    const int t = VT, ng = t & 31, kg = t >> 5;
    bf16_t* WGU = (bf16_t*)(p.ws + OFF_WGU); bf16_t* WD = (bf16_t*)(p.ws + OFF_WD);
    const int ntask = 257 * 3 * 32;
    for (int task = VB; task < ntask; task += VG) {
        const int e = task / 96, rem = task - e * 96, mat = rem >> 5, tl = rem & 31;
        const float* src; bf16_t* dst; int K, N, kt, nt;
        if (mat < 2) { K = 1024; N = 256; kt = tl >> 1; nt = tl & 1;
            src = (mat == 0) ? (e < 256 ? p.ew_gate + (size_t)e * 262144 : p.sw_gate) : (e < 256 ? p.ew_up + (size_t)e * 262144 : p.sw_up);
            dst = WGU + (size_t)e * 524288 + (size_t)(nt + mat) * 131072; }
        else { K = 256; N = 1024; kt = tl >> 3; nt = tl & 7;
            src = e < 256 ? p.ew_down + (size_t)e * 262144 : p.sw_down; dst = WD + (size_t)e * 262144; }
        const float* sp = src + (size_t)(kt * 64 + 4 * kg) * N + nt * 128 + 4 * ng;
        f32x4 rf[8];
#pragma unroll
        for (int i = 0; i < 4; ++i) { rf[i] = *(const f32x4*)(sp + (size_t)i * N); rf[4 + i] = *(const f32x4*)(sp + (size_t)(32 + i) * N); }
#pragma unroll
        for (int i = 0; i < 4; ++i) {
            u32x2 v0, v1;
            v0.x = pk2(rf[0][i], rf[1][i]); v0.y = pk2(rf[2][i], rf[3][i]); v1.x = pk2(rf[4][i], rf[5][i]); v1.y = pk2(rf[6][i], rf[7][i]);
            *(u32x2*)&tile[(4 * ng + i) * 72 + 4 * kg] = v0; *(u32x2*)&tile[(4 * ng + i) * 72 + 32 + 4 * kg] = v1;
        }
        __syncthreads();
        {
            const int n = t >> 1, hf = t & 1;
            bf16_t* dp = dst + (size_t)(nt * 128 + n) * K + kt * 64 + hf * 32;
#pragma unroll
            for (int j = 0; j < 4; ++j) *(u32x4*)(dp + 8 * j) = *(const u32x4*)&tile[n * 72 + hf * 32 + 8 * j];
        }
        __syncthreads();
    }
}

DEVI void phase7(const Params& p, unsigned char* smem) {
    const int t = VT, lane = t & 63, w = t >> 6;
    const bf16_t* T1 = (const bf16_t*)(p.ws + OFF_T1); bf16_t* X1b = (bf16_t*)(p.ws + OFF_X1B);
    for (int row = VB * 4 + w; row < T_; row += VG * 4) {
        f32x4 v[4]; float s = 0.f;
#pragma unroll
        for (int i = 0; i < 4; ++i) { v[i] = unpk4(*(const u32x2*)(T1 + (size_t)row * 1024 + i * 256 + lane * 4)); s += (v[i][0] + v[i][1]) + (v[i][2] + v[i][3]); }
#pragma unroll
        for (int o = 32; o > 0; o >>= 1) s += __shfl_xor(s, o);
        const float mean = s * (1.0f / 1024.0f); float s2 = 0.f;
#pragma unroll
        for (int i = 0; i < 4; ++i)
#pragma unroll
            for (int r = 0; r < 4; ++r) { const float d = v[i][r] - mean; s2 += d * d; }
#pragma unroll
        for (int o = 32; o > 0; o >>= 1) s2 += __shfl_xor(s2, o);
        const float rstd = rsqrtf(s2 * (1.0f / 1024.0f) + 1e-5f);
#pragma unroll
        for (int i = 0; i < 4; ++i) {
            const int col = i * 256 + lane * 4;
            const f32x4 g = *(const f32x4*)(p.ln1_g + col), bb = *(const f32x4*)(p.ln1_b + col);
            f32x4 y;
#pragma unroll
            for (int r = 0; r < 4; ++r) y[r] = (v[i][r] - mean) * rstd * g[r] + bb[r];
            *(u32x2*)(X1b + (size_t)row * 1024 + col) = pk4(y);
        }
    }
    conv_expert_weights(p, smem);
}

DEVI void phase8(const Params& p, unsigned char* smem) {
    GemmSmem& sm = *(GemmSmem*)smem;
    const int t = VT, lane = t & 63, w = t >> 6, wr = w >> 1, wc = w & 1, l15 = lane & 15, q = lane >> 4;
    const bf16_t* X1b = (const bf16_t*)(p.ws + OFF_X1B); const bf16_t* wt = (const bf16_t*)(p.ws + OFF_WT);
    float* LG = (float*)(p.ws + OFF_LOG);
    for (int tile = VB; tile < 256 * 2; tile += VG) {
        const int mtg = tile >> 1, ntg = tile & 1, m0 = mtg * 128, n0 = ntg * 128;
        const bf16_t* pa0 = X1b + (size_t)(m0 + (t >> 3)) * 1024 + gemm_src_chunk(t);
        const bf16_t* pb0 = wt + (size_t)(WT_R + n0 + (t >> 3)) * 1024 + gemm_src_chunk(t);
        const bf16_t* const pa[4] = {pa0, pa0 + 32 * 1024, pa0 + 64 * 1024, pa0 + 96 * 1024};
        const bf16_t* const pb[4] = {pb0, pb0 + 32 * 1024, pb0 + 64 * 1024, pb0 + 96 * 1024};
        f32x4 acc[4][4]; zero_acc(acc);
        gemm_kloop<true, 0>(acc, pa, pb, nullptr, 0, 16, sm);
#pragma unroll
        for (int mt = 0; mt < 4; ++mt)
#pragma unroll
            for (int nt = 0; nt < 4; ++nt) {
                const int row = m0 + wr * 64 + mt * 16 + l15, col = n0 + wc * 64 + (nt >> 1) * 32 + 8 * q + 4 * (nt & 1);
                *(f32x4*)(LG + (size_t)row * 256 + col) = acc[mt][nt];
            }
    }
}

DEVI unsigned f2ord(float f) { const unsigned u = __float_as_uint(f); return (u & 0x80000000u) ? ~u : (u | 0x80000000u); }
template <int CTRL> DEVI float dppf(float v) { const int x = __float_as_int(v); return __int_as_float(__builtin_amdgcn_update_dpp(x, x, CTRL, 0xf, 0xf, false)); }
template <int CTRL> DEVI void top2_merge(float& m1, float& m2) {
    const float p1 = dppf<CTRL>(m1), p2 = dppf<CTRL>(m2);
    const float n1 = fmaxf(m1, p1), n2 = fmaxf(fminf(m1, p1), fmaxf(m2, p2));
    m1 = n1; m2 = n2;
}
template <bool DRY> DEVI void phase9(const Params& p) {
    const int t = VT, lane = t & 63, w = t >> 6;
    const float* LG = (const float*)(p.ws + OFF_LOG);
    int* cnt = (int*)(p.ws + OFF_CNT); int* list = (int*)(p.ws + OFF_LIST); float* wl = (float*)(p.ws + OFF_WL);
    const int tstep = VG * 4;
    int tok = VB * 4 + w;
    const f32x4 rb = *(const f32x4*)(p.router_bias + 4 * lane);
    f32x4 lgn = {0.f, 0.f, 0.f, 0.f};
    if (tok < T_) lgn = *(const f32x4*)(LG + (size_t)tok * 256 + 4 * lane);
    const int mygrp = lane >> 3;
    int ppos = 0, pe = -1, ptk9 = 0; float pw = 0.f;
    for (; tok < T_; tok += tstep) {
        float sc[4], bi[4];
#pragma unroll
        for (int r = 0; r < 4; ++r) { sc[r] = sigmoidf_(lgn[r]); bi[r] = sc[r] + rb[r]; }
        { const int tn = tok + tstep; if (tn < T_) lgn = *(const f32x4*)(LG + (size_t)tn * 256 + 4 * lane); }
        float m1, m2;
        { const float h01 = fmaxf(bi[0], bi[1]), l01 = fminf(bi[0], bi[1]), h23 = fmaxf(bi[2], bi[3]), l23 = fminf(bi[2], bi[3]);
          m1 = fmaxf(h01, h23); m2 = fmaxf(fminf(h01, h23), fmaxf(l01, l23)); }
        top2_merge<0xB1>(m1, m2);
        top2_merge<0x4E>(m1, m2);
        top2_merge<0x141>(m1, m2);
        const float gown = m1 + m2;
        int rank = 0;
#pragma unroll
        for (int g2 = 0; g2 < 8; ++g2) {
            const float go = __builtin_bit_cast(float, __builtin_amdgcn_readlane(__builtin_bit_cast(int, gown), 8 * g2));
            rank += (go > gown || (go == gown && g2 < mygrp)) ? 1 : 0;
        }
        unsigned ck[4];
#pragma unroll
        for (int r = 0; r < 4; ++r) ck[r] = rank < 4 ? f2ord(bi[r]) : 0u;
        unsigned thr = 0u; bool exact = false;
#pragma unroll 1
        for (int bit = 31; bit >= 0; --bit) {
            const unsigned cnd = thr | (1u << bit);
            const int c8 = __popcll(__ballot(ck[0] >= cnd)) + __popcll(__ballot(ck[1] >= cnd)) + __popcll(__ballot(ck[2] >= cnd)) + __popcll(__ballot(ck[3] >= cnd));
            if (c8 >= 8) { thr = cnd; if (c8 == 8) { exact = true; break; } }
        }
        unsigned long long selm[4];
        if (exact) {
#pragma unroll
            for (int r = 0; r < 4; ++r) selm[r] = __ballot(ck[r] >= thr);
        } else {
            unsigned long long eq[4], any = 0ull; int need = 8;
#pragma unroll
            for (int r = 0; r < 4; ++r) { selm[r] = __ballot(ck[r] > thr); eq[r] = __ballot(ck[r] == thr); need -= __popcll(selm[r]); any |= eq[r]; }
            while (need > 0 && any != 0ull) {
                const int L = __builtin_ctzll(any); any &= any - 1ull;
#pragma unroll
                for (int r = 0; r < 4; ++r) if (((eq[r] >> L) & 1ull) != 0ull && need > 0) { selm[r] |= 1ull << L; --need; }
            }
        }
        float wsum = 0.f, myw = 0.f; int mye = 0, kk = 0;
#pragma unroll
        for (int r = 0; r < 4; ++r) {
            unsigned long long m = selm[r];
            while (m != 0ull) {
                const int L = __builtin_ctzll(m); m &= m - 1ull;
                const float sv = __builtin_bit_cast(float, __builtin_amdgcn_readlane(__builtin_bit_cast(int, sc[r]), L));
                wsum += sv;
                if (lane == kk) { mye = 4 * L + r; myw = sv; }
                ++kk;
            }
        }
        if (DRY) { asm volatile("" :: "v"(mye), "v"(myw), "v"(wsum)); }
        else if (lane < 8) {
            if (pe >= 0) { list[(size_t)pe * T_ + ppos] = ptk9; wl[(size_t)pe * T_ + ppos] = pw; }
            ppos = atomicAdd(&cnt[mye * CNT_STRIDE], 1); pe = mye; ptk9 = tok * 9 + lane; pw = myw / wsum * 2.5f;
        }
    }
    if (!DRY && lane < 8 && pe >= 0) { list[(size_t)pe * T_ + ppos] = ptk9; wl[(size_t)pe * T_ + ppos] = pw; }
}

DEVI void moe_prefix256(const Params& p, int* pre  , int xg) {
    const int tid = threadIdx.x;
    const int* cnt = (const int*)(p.ws + OFF_CNT);
    __syncthreads();
    if (tid < 64) {
        int v = 0;
        if (tid < 32) { const int c = __hip_atomic_load(&cnt[(xg + 8 * tid) * CNT_STRIDE], __ATOMIC_RELAXED, __HIP_MEMORY_SCOPE_AGENT); pre[40 + tid] = c; v = (c + 255) >> 8; }
        else if (tid == 32) { v = 16; pre[40 + 32] = T_; }
#pragma unroll
        for (int o = 1; o < 64; o <<= 1) { const int u = __shfl_up(v, o); if (tid >= o) v += u; }
        if (tid < 33) pre[tid + 1] = v;
        if (tid == 0) pre[0] = 0;
    }
    __syncthreads();
}
struct MoeSched {
    const int* pre; const unsigned char* ws; bool need_w;
    int* sbuf;
    int xg, jl, nloc, nsh, nitems;
    const char* Abase; int arow_bytes; bool by_token;
    const char* Bbase; size_t b_expert_bytes, b_unit_bytes;
    __device__ __forceinline__ bool next(int i, pg8::Unit& u) const {
        const int item = jl + i * nloc; if (item >= nitems) return false;
        u.pm = item >> nsh; u.pn = item - (u.pm << nsh);
        const int lane = (int)(threadIdx.x & 63), li = lane < 33 ? lane : 32;
        const int pv = pre[li], cv = pre[40 + li];
        const int gi = __popcll(__ballot(lane < 33 && pv <= u.pm)) - 1;
        const int pg = __builtin_amdgcn_readlane(pv, gi);
        u.ce = __builtin_amdgcn_readlane(cv, gi);
        u.e = gi < 32 ? xg + 8 * gi : 256; u.r0 = (gi < 32 ? 0 : xg * 4096) + (u.pm - pg) * 256;
        return true;
    }
    __device__ __forceinline__ void decode(const pg8::Unit& u, int& e, int& r0, int& ce) const { e = u.e; r0 = u.r0; ce = u.ce; }
    __device__ __forceinline__ int fill_issue(const pg8::Unit& u) const {
        int e, r0, ce; decode(u, e, r0, ce);
        const int pos = r0 + (int)(threadIdx.x & 255); const bool w = threadIdx.x >= 256;
        int v = w ? 0 : -1;
        if (pos < ce && !(w && !need_w)) {
            const unsigned off = (w ? (unsigned)OFF_WL : (unsigned)OFF_LIST) + ((unsigned)e * (unsigned)T_ + (unsigned)pos) * 4u;
            v = e < 256 ? *(const int*)(ws + off) : (w ? 0x3f800000 : pos * 9 + 8);
        }
        return v;
    }
    __device__ __forceinline__ void fill_write(int buf, int v) const { sbuf[(threadIdx.x >= 256 ? 768 : 0) + buf * 256 + (int)(threadIdx.x & 255)] = v; }
    __device__ __forceinline__ const char* a_base() const { return Abase; }
    __device__ __forceinline__ void a_rows(int buf, const int (&rowA)[2], const int (&colA)[2], unsigned& p00, unsigned& p01, unsigned& p10, unsigned& p11) const {
        const int* sb = sbuf + buf * 256; const int s0 = sb[0];
        int s4[4];
#pragma unroll
        for (int k = 0; k < 4; ++k) { int sl = sb[(k >> 1) * 128 + rowA[k & 1]]; if (sl < 0) sl = s0; s4[k] = sl; }
#pragma unroll
        for (int k = 0; k < 4; ++k) if (by_token) s4[k] = s4[k] / 9;
        p00 = (unsigned)s4[0] * (unsigned)arow_bytes + (unsigned)colA[0]; p01 = (unsigned)s4[1] * (unsigned)arow_bytes + (unsigned)colA[1];
        p10 = (unsigned)s4[2] * (unsigned)arow_bytes + (unsigned)colA[0]; p11 = (unsigned)s4[3] * (unsigned)arow_bytes + (unsigned)colA[1];
    }
    __device__ __forceinline__ const char* b_base(const pg8::Unit& u) const { int e, r0, ce; decode(u, e, r0, ce); return Bbase + (size_t)e * b_expert_bytes + (size_t)u.pn * b_unit_bytes; }
    __device__ __forceinline__ void a_ready(const pg8::Unit&) const {}
    __device__ __forceinline__ void done(const pg8::Unit&) const {}
};
struct EpiMoe1 {
    static constexpr bool PERM = true, AFTER_DRAIN = false, BJI = false;
    const MoeSched* S; bf16_t* H;
    __device__ __forceinline__ void operator()(const pg8::f32x4 (&acc)[2][2][4][2], const pg8::Unit& u, int wr, int wc, int fr, int fq, int buf) const {
        const int* sb = S->sbuf + buf * 256 + wr * 64 + fr;
#pragma unroll
        for (int ai = 0; ai < 2; ++ai) {
            int sl[4];
#pragma unroll
            for (int m = 0; m < 4; ++m) sl[m] = sb[ai * 128 + m * 16];
#pragma unroll
            for (int m = 0; m < 4; ++m) if (sl[m] >= 0) {
                f32x4 h0, h1;
#pragma unroll
                for (int r = 0; r < 4; ++r) { h0[r] = siluf_(acc[ai][0][m][0][r]) * acc[ai][1][m][0][r]; h1[r] = siluf_(acc[ai][0][m][1][r]) * acc[ai][1][m][1][r]; }
                *(u32x4*)(H + (size_t)sl[m] * 256 + u.pn * 128 + wc * 32 + 8 * fq) = pk8(h0, h1);
            }
            asm volatile("" ::: "memory");
        }
    }
};
struct EpiMoe2 {
    static constexpr bool PERM = true, AFTER_DRAIN = false, BJI = true;
    const MoeSched* S; unsigned char* YX;
    __device__ __forceinline__ void operator()(const pg8::f32x4 (&acc)[2][2][4][2], const pg8::Unit& u, int wr, int wc, int fr, int fq, int buf) const {
        const int* sb = S->sbuf + buf * 256 + wr * 64 + fr;
#pragma unroll
        for (int ai = 0; ai < 2; ++ai) {
            int sl[4]; float wg[4];
#pragma unroll
            for (int m = 0; m < 4; ++m) { sl[m] = sb[ai * 128 + m * 16]; wg[m] = __int_as_float(sb[768 + ai * 128 + m * 16]) * YX_SCALE; }
#pragma unroll
            for (int m = 0; m < 4; ++m) if (sl[m] >= 0) {
                u32x4 w8;
                w8.x = pk4_fp8(clamp4(acc[ai][0][m][0] * wg[m], 440.f)); w8.y = pk4_fp8(clamp4(acc[ai][0][m][1] * wg[m], 440.f));
                w8.z = pk4_fp8(clamp4(acc[ai][1][m][0] * wg[m], 440.f)); w8.w = pk4_fp8(clamp4(acc[ai][1][m][1] * wg[m], 440.f));
                *(u32x4*)(YX + (size_t)sl[m] * 1024 + u.pn * 256 + wc * 64 + 16 * fq) = w8;
            }
            asm volatile("" ::: "memory");
        }
    }
};
DEVI void moe_sched_init(const Params& p, MoeSched& S, int* pre) {
    S.pre = pre; S.ws = p.ws; S.need_w = false; S.sbuf = (int*)(smem_all_g + 2 * SMEM_HALF);
    S.xg = RB & 7; S.jl = RB >> 3; S.nloc = RG >> 3;
}
DEVI void phase10(const Params& p, unsigned char* smem_all) {
    int* pre = (int*)(smem_all + 131072);
    MoeSched S; moe_sched_init(p, S, pre); moe_prefix256(p, pre, S.xg);
    S.nsh = 1; S.nitems = pre[33] << 1; S.Abase = (const char*)(p.ws + OFF_X1B); S.arow_bytes = 2048; S.by_token = true;
    S.Bbase = (const char*)(p.ws + OFF_WGU); S.b_expert_bytes = (size_t)512 * 1024 * 2; S.b_unit_bytes = (size_t)256 * 1024 * 2;
    EpiMoe1 E; E.S = &S; E.H = (bf16_t*)(p.ws + OFF_H);
    pg8::gemm_phase_g<EpiMoe1, MoeSched, true, true>((PG8_LAS unsigned char*)smem_all, 1024, S, E);
}
DEVI void phase11(const Params& p, unsigned char* smem_all) {
    int* pre = (int*)(smem_all + 131072);
    MoeSched S; moe_sched_init(p, S, pre); moe_prefix256(p, pre, S.xg);
    S.nsh = 2; S.nitems = pre[33] << 2; S.Abase = (const char*)(p.ws + OFF_H); S.arow_bytes = 512; S.by_token = false;
    S.Bbase = (const char*)(p.ws + OFF_WD); S.b_expert_bytes = (size_t)1024 * 256 * 2; S.b_unit_bytes = (size_t)256 * 256 * 2;
    S.need_w = true;
    EpiMoe2 E; E.S = &S; E.YX = (unsigned char*)(p.ws + OFF_YX);
    pg8::gemm_phase_g<EpiMoe2, MoeSched, true, true>((PG8_LAS unsigned char*)smem_all, 256, S, E);
}

DEVI void phase12(const Params& p) {
    const int t = VT, lane = t & 63, w = t >> 6;
    const bf16_t* X1b = (const bf16_t*)(p.ws + OFF_X1B); const unsigned char* YX = (const unsigned char*)(p.ws + OFF_YX);
    for (int row = VB * 4 + w; row < T_; row += VG * 4) {
        f32x4 v[4]; float s = 0.f;
#pragma unroll
        for (int i = 0; i < 4; ++i) {
            const int col = i * 256 + lane * 4;
            f32x4 a = unpk4(*(const u32x2*)(X1b + (size_t)row * 1024 + col)) * ALPHA_;
            f32x4 ys = (f32x4){0.f, 0.f, 0.f, 0.f};
#pragma unroll
            for (int k = 0; k < 9; ++k) ys += unpk4_fp8(*(const unsigned*)(YX + ((size_t)row * 9 + k) * 1024 + col));
            a += ys * (1.0f / YX_SCALE);
            v[i] = a; s += (a[0] + a[1]) + (a[2] + a[3]);
        }
#pragma unroll
        for (int o = 32; o > 0; o >>= 1) s += __shfl_xor(s, o);
        const float mean = s * (1.0f / 1024.0f); float s2 = 0.f;
#pragma unroll
        for (int i = 0; i < 4; ++i)
#pragma unroll
            for (int r = 0; r < 4; ++r) { const float d = v[i][r] - mean; s2 += d * d; }
#pragma unroll
        for (int o = 32; o > 0; o >>= 1) s2 += __shfl_xor(s2, o);
        const float rstd = rsqrtf(s2 * (1.0f / 1024.0f) + 1e-5f);
#pragma unroll
        for (int i = 0; i < 4; ++i) {
            const int col = i * 256 + lane * 4;
            const f32x4 g = *(const f32x4*)(p.ln2_g + col), bb = *(const f32x4*)(p.ln2_b + col);
            f32x4 y;
#pragma unroll
            for (int r = 0; r < 4; ++r) y[r] = (v[i][r] - mean) * rstd * g[r] + bb[r];
            *(f32x4*)(p.out + (size_t)row * 1024 + col) = y;
        }
    }
}


#define XB_TMO      128
#define XB_XCNT(j)  (256  + 64 * (j))
#define XB_XSUB(j)  (1280 + 64 * (j))
#define XB_XGEN(j)  (2304 + 64 * (j))
#define XB_TOP      3328
#define XB_TOPGEN   3392
#define XCD_BAR_WORDS 3456
#define XB_SPIN_CAP (1u << 20)
#define LAS __attribute__((address_space(3)))
DEVI unsigned xb_ld(unsigned* p)              { return __hip_atomic_load(p, __ATOMIC_RELAXED, __HIP_MEMORY_SCOPE_AGENT); }
DEVI unsigned xb_add(unsigned* p, unsigned v) { return __hip_atomic_fetch_add(p, v, __ATOMIC_RELAXED, __HIP_MEMORY_SCOPE_AGENT); }
DEVI unsigned xb_xcc_id() { return (unsigned)__builtin_amdgcn_s_getreg((3 << 11) | 20) & 0xFu; }
#define XB_SPIN(cond, bar) do { unsigned _sp = 0; while (cond) { __builtin_amdgcn_s_sleep(1); \
    if ((++_sp & 255u) == 0u) { if (xb_ld(&(bar)[XB_TMO])) break; if (_sp > XB_SPIN_CAP) { atomicAdd(&(bar)[XB_TMO], 1u); break; } } } } while (0)
struct XcdBarrier { unsigned* bar; unsigned x; volatile LAS unsigned* st; };
DEVI XcdBarrier xcd_barrier_post(unsigned* bar, volatile LAS unsigned* st) {
    XcdBarrier b; b.bar = bar; b.x = xb_xcc_id(); b.st = st;
    if (threadIdx.x == 0) st[3] = xb_add(&bar[XB_XCNT(b.x)], 1u);
    return b;
}
DEVI void xcd_barrier_complete(unsigned* bar, unsigned x, unsigned& nloc, unsigned& nx) {
    const unsigned G = gridDim.x * gridDim.y * gridDim.z;
    unsigned sum, cnt, mine, sp = 0u;
    for (;;) {
        sum = 0u; cnt = 0u; mine = 0u;
#pragma unroll
        for (unsigned j = 0; j < 16; ++j) { const unsigned c = xb_ld(&bar[XB_XCNT(j)]); sum += c; cnt += (c > 0u) ? 1u : 0u; mine = (j == x) ? c : mine; }
        if (sum == G) break;
        __builtin_amdgcn_s_sleep(1);
        if ((++sp & 255u) == 0u) { if (xb_ld(&bar[XB_TMO])) break; if (sp > XB_SPIN_CAP) { atomicAdd(&bar[XB_TMO], 1u); break; } }
    }
    nloc = mine > 0u ? mine : 1u; nx = cnt > 0u ? cnt : 1u;
}
DEVI void xcd_barrier(const XcdBarrier& b) {
    asm volatile("s_waitcnt vmcnt(0)" ::: "memory");
    __syncthreads();
    if (threadIdx.x == 0) {
        unsigned* bar = b.bar;
        __builtin_amdgcn_s_waitcnt(0);
        unsigned nloc = b.st[0], nx = b.st[1];
        if (nloc == 0u) { xcd_barrier_complete(bar, b.x, nloc, nx); b.st[0] = nloc; b.st[1] = nx; }
        const unsigned old = xb_add(&bar[XB_XSUB(b.x)], 1u);
        const unsigned gen = old / nloc;
        if (old + 1u == (gen + 1u) * nloc) {
            __builtin_amdgcn_fence(__ATOMIC_RELEASE, "agent");
            asm volatile("s_waitcnt vmcnt(0)" ::: "memory");
            const unsigned og = xb_add(&bar[XB_TOP], 1u);
            const unsigned tg = og / nx;
            if (og + 1u == (tg + 1u) * nx) xb_add(&bar[XB_TOPGEN], 1u);
            else XB_SPIN(xb_ld(&bar[XB_TOPGEN]) == tg, bar);
            __builtin_amdgcn_fence(__ATOMIC_ACQUIRE, "agent");
            xb_add(&bar[XB_XGEN(b.x)], 1u);
            asm volatile("s_waitcnt vmcnt(0)" ::: "memory");
        } else {
            XB_SPIN(xb_ld(&bar[XB_XGEN(b.x)]) == gen, bar);
            __builtin_amdgcn_fence(__ATOMIC_ACQUIRE, "agent");
            asm volatile("s_waitcnt vmcnt(0)" ::: "memory");
        }
    }
    __syncthreads();
}
constexpr size_t OFF_BAR = 131072;

#ifndef DBG
#define DBG 0
#endif
DEVI void dump_f32(const Params& p, size_t off) {
    const f32x4* src = (const f32x4*)(p.ws + off); f32x4* dst = (f32x4*)p.out;
    for (int i = blockIdx.x * 256 + threadIdx.x; i < T_ * D_ / 4; i += gridDim.x * 256) dst[i] = src[i];
}
DEVI void dump_bf16(const Params& p, size_t off, int ld, int coff) {
    const bf16_t* src = (const bf16_t*)(p.ws + off);
    for (int i = blockIdx.x * 256 + threadIdx.x; i < T_ * D_; i += gridDim.x * 256) { const int row = i >> 10, col = i & 1023; p.out[i] = bf2f(src[(size_t)row * ld + coff + col]); }
}
DEVI float flat_bf(const Params& p, size_t off, size_t n, size_t i) { const bf16_t* b = (const bf16_t*)(p.ws + off); float a = 0.f; for (size_t j = i; j < n; j += (size_t)T_ * D_) a += bf2f(b[j]); return a; }
DEVI void dump_p1(const Params& p) {
    const size_t N = (size_t)T_ * D_;
    for (size_t i = (size_t)blockIdx.x * 256 + threadIdx.x; i < N; i += (size_t)gridDim.x * 256) {
        float a = 0.f;
        a += flat_bf(p, OFF_MG, 2 * N, i) + flat_bf(p, OFF_GS, 2 * N, i);
        a += flat_bf(p, OFF_QR, N / 2, i % (N / 2)) + flat_bf(p, OFF_KR, N / 2, i % (N / 2)) + flat_bf(p, OFF_QG, N / 2, i % (N / 2));
        a += flat_bf(p, OFF_KRT, N / 2, i % (N / 2)) + flat_bf(p, OFF_KGT, N / 2, i % (N / 2));
        a += flat_bf(p, OFF_VRT, N, i) + flat_bf(p, OFF_VGT, N, i);
        a += ((const float*)(p.ws + OFF_GA))[i % ((size_t)T_ * 16)];
        p.out[i] = a;
    }
}
constexpr int NPHASE = 13;
__global__ void __launch_bounds__(512, 2) fwd_megakernel(Params p) {
    unsigned char* const smem_all = smem_all_g;
    unsigned char* smem = smem_all + VH * SMEM_HALF;
    uint4* xb_words = (uint4*)(smem_all + 2 * SMEM_HALF - 16);
    if (threadIdx.x == 0) *xb_words = make_uint4(0u, 0u, blockIdx.x, 0u);
    __syncthreads();
    const XcdBarrier xb = xcd_barrier_post((unsigned*)(p.ws + OFF_BAR), (volatile LAS unsigned*)xb_words);
#ifndef REPMASK
#define REPMASK 0
#endif
#ifndef TIMEPHASE
#define TIMEPHASE -1
#endif
#define RUN_PHASE(K, CALL) do { if (p.phase_lo <= (K) && (K) < p.phase_hi) { \
        const unsigned long long tp0_ = (TIMEPHASE == (K)) ? __builtin_amdgcn_s_memrealtime() : 0ull; \
        _Pragma("unroll 1") for (int rep_ = ((REPMASK >> (K)) & 1); rep_ >= 0; --rep_) { CALL; if (rep_ > 0 || (K) + 1 < p.phase_hi) xcd_barrier(xb); } \
        if (TIMEPHASE == (K)) { const unsigned long long tp1_ = __builtin_amdgcn_s_memrealtime(); while (__builtin_amdgcn_s_memrealtime() - tp1_ < tp1_ - tp0_) __builtin_amdgcn_s_sleep(8); } } } while (0)
    RUN_PHASE(0, phase0(p, smem));
    if (p.phase_lo == 0 && p.phase_hi > 1) {
        if (threadIdx.x == 0) {
            unsigned* bar = (unsigned*)(p.ws + OFF_BAR); bool ok = (gridDim.x & 7u) == 0u && xb.x < 8u;
            for (unsigned j = 0; j < 16; ++j) { const unsigned c = xb_ld(&bar[XB_XCNT(j)]); ok = ok && (j < 8 ? c == gridDim.x / 8u : c == 0u); }
            if (ok) ((volatile int*)xb_words)[2] = (int)(((volatile unsigned*)xb_words)[3] * 8u + xb.x);
        }
        __syncthreads();
    }
    RUN_PHASE(1, phase1(p, smem_all));
#if DBG == 2
    dump_p1(p); return;
#endif
    RUN_PHASE(2, phase2(p, smem));
#if DBG == 5
    { const size_t N = (size_t)T_ * D_; for (size_t i = (size_t)blockIdx.x * 256 + threadIdx.x; i < N; i += (size_t)gridDim.x * 256) p.out[i] = flat_bf(p, OFF_KG2, N / 2, i % (N / 2)) + ((const float*)(p.ws + OFF_DEC))[i % (2048 * 128)]; } return;
#endif
#ifdef SCANPROBE
    phase3t(p, smem, 1); xcd_barrier(xb);
#endif
    RUN_PHASE(3, phase3t(p, smem, 0));
#if DBG == 6
    dump_bf16(p, OFF_OO, 2048, 1024); return;
#endif
#if DBG == 7
    { const bf16_t* src = (const bf16_t*)(p.ws + OFF_OO);
      for (int i = blockIdx.x * 256 + threadIdx.x; i < T_ * D_; i += gridDim.x * 256) { const int row = i >> 10, col = i & 1023; const float v = bf2f(src[(size_t)row * 2048 + 1024 + col]); p.out[i] = (fabsf(v) < 1e30f) ? v : 12345.0f; } } return;
#endif
    RUN_PHASE(4, phase4(p, smem));
#if DBG == 3
    dump_bf16(p, OFF_Y, 2048, 0); return;
#endif
#if DBG == 4
    dump_bf16(p, OFF_Y, 2048, 1024); return;
#endif
    RUN_PHASE(5, phase5(p, smem_all));
    RUN_PHASE(6, phase6(p, smem_all));
    RUN_PHASE(7, phase7(p, smem));
#if DBG == 1
    return;
#endif
    RUN_PHASE(8, phase8(p, smem));
#ifdef P9DRY
    RUN_PHASE(9, (phase9<true>(p), phase9<false>(p)));
#else
    RUN_PHASE(9, phase9<false>(p));
#endif
    RUN_PHASE(10, phase10(p, smem_all));
    RUN_PHASE(11, phase11(p, smem_all));
    RUN_PHASE(12, phase12(p));
#undef RUN_PHASE
}

extern "C" void kernel_launch(void* const* d_in, const int* in_sizes, int n_in, void* d_out, int out_size, void* d_ws, size_t ws_size,
                              hipStream_t stream) {
    static int grid_blocks = 0;
    if (!grid_blocks) {
        int dev = 0, cus = 0, per_cu = 0;
        hipGetDevice(&dev);
        hipDeviceGetAttribute(&cus, hipDeviceAttributeMultiprocessorCount, dev);
        hipOccupancyMaxActiveBlocksPerMultiprocessor(&per_cu, fwd_megakernel, 512, 0);
        if (per_cu > 1) per_cu = 1;
        if (per_cu < 1) per_cu = 1;
        grid_blocks = cus * per_cu;
    }
    if (ws_size < WS_NEEDED) { fprintf(stderr, "workspace too small: %zu < %zu\n", ws_size, (size_t)WS_NEEDED); return; }
    Params p{};
    p.x = (const float*)d_in[0]; p.w_in = (const float*)d_in[1]; p.ret_norm_g = (const float*)d_in[2]; p.gate_w2 = (const float*)d_in[3];
    p.gate_b = (const float*)d_in[4]; p.gla_norm_g = (const float*)d_in[5]; p.w_ret_out = (const float*)d_in[6]; p.w_gla_out = (const float*)d_in[7];
    p.w_o = (const float*)d_in[8]; p.ln1_g = (const float*)d_in[9]; p.ln1_b = (const float*)d_in[10]; p.router_w = (const float*)d_in[11];
    p.router_bias = (const float*)d_in[12]; p.ew_gate = (const float*)d_in[13]; p.ew_up = (const float*)d_in[14]; p.ew_down = (const float*)d_in[15];
    p.sw_gate = (const float*)d_in[16]; p.sw_up = (const float*)d_in[17]; p.sw_down = (const float*)d_in[18]; p.ln2_g = (const float*)d_in[19];
    p.ln2_b = (const float*)d_in[20];
    p.out = (float*)d_out; p.ws = (unsigned char*)d_ws; p.phase_lo = 0; p.phase_hi = NPHASE;
    void* args[] = {&p};
    (void)hipMemsetAsync((unsigned char*)d_ws + OFF_BAR, 0, XCD_BAR_WORDS * 4, stream);
    hipError_t e = hipLaunchCooperativeKernel((void*)fwd_megakernel, dim3(grid_blocks), dim3(512), args, 0, stream);
    if (e != hipSuccess) fprintf(stderr, "cooperative launch failed: %s (grid %d)\n", hipGetErrorString(e), grid_blocks);
}
```

```cpp
#include <hip/hip_runtime.h>
#include <hip/hip_cooperative_groups.h>
#include <cstdio>
#include <cstdint>
namespace cg = cooperative_groups;

typedef unsigned short bf16_t;
typedef short bf16x8 __attribute__((ext_vector_type(8)));
typedef float f32x4 __attribute__((ext_vector_type(4)));
typedef unsigned u32x2 __attribute__((ext_vector_type(2)));
typedef unsigned u32x4 __attribute__((ext_vector_type(4)));
#define DEVI __device__ __forceinline__
#define VH ((int)(threadIdx.x >> 8))
#define VT ((int)(threadIdx.x & 255))
#define RB (__builtin_amdgcn_readfirstlane(((const int*)(smem_all_g + 2 * SMEM_HALF - 16))[2]))
#define RG ((int)gridDim.x)
#define VB (RB * 2 + VH)
#define VG (RG * 2)

constexpr int T_ = 32768;
constexpr int D_ = 1024;
constexpr int DIN_ = 8208;
constexpr int NE_ = 256;
constexpr float ALPHA_ = 1.189207115002721f;
constexpr float KSCALE_ = 0.08838834764831845f;

constexpr size_t MB = 1ull << 20;
constexpr size_t OFF_CNT  = (size_t)766 << 20;
constexpr int CNT_STRIDE = 1024;
constexpr size_t OFF_CS   = 1 * MB;
constexpr size_t OFF_WT   = 3 * MB;
constexpr size_t FB = 27 * MB;
constexpr size_t OFF_QR   = FB + 0 * MB;
constexpr size_t OFF_KR   = FB + 32 * MB;
constexpr size_t OFF_VRT  = FB + 64 * MB;
constexpr size_t OFF_GS   = FB + 128 * MB;
constexpr size_t OFF_MG   = FB + 256 * MB;
constexpr size_t OFF_KRT  = FB + 384 * MB;
constexpr size_t OFF_QG   = FB + 416 * MB;
constexpr size_t OFF_VGT  = FB + 448 * MB;
constexpr size_t OFF_KGT  = FB + 512 * MB;
constexpr size_t OFF_GA   = FB + 544 * MB;
constexpr size_t OFF_XB   = FB + 546 * MB;
constexpr size_t OFF_KG2  = FB + 546 * MB;
constexpr size_t OFF_DEC  = FB + 578 * MB;
constexpr size_t OFF_OO   = FB + 579 * MB;
constexpr size_t OFF_Y    = FB + 384 * MB;
constexpr size_t OFF_MRG  = FB + 0 * MB;
constexpr size_t OFF_QGN  = 767 * MB;
constexpr size_t OFF_QFR  = 734 * MB;
constexpr size_t OFF_WGU  = 767 * MB;
constexpr size_t OFF_X1B  = FB + 0 * MB;
constexpr size_t OFF_WD   = FB + 64 * MB;
constexpr size_t OFF_LIST = FB + 193 * MB;
constexpr size_t OFF_WL   = 686 * MB;
constexpr size_t OFF_H    = FB + 227 * MB;
constexpr size_t OFF_YX   = FB + 371 * MB;
constexpr size_t OFF_T1   = FB + 371 * MB;
constexpr size_t OFF_LOG  = FB + 435 * MB;
constexpr size_t WS_NEEDED = 1024 * MB;

constexpr int WT_BN = 0, WT_AT = 5888, WT_RET = 8960, WT_GLA = 9984, WT_O = 11008, WT_R = 12032, WT_ROWS = 12288;

struct Params {
    const float *x, *w_in, *ret_norm_g, *gate_w2, *gate_b, *gla_norm_g, *w_ret_out, *w_gla_out, *w_o, *ln1_g, *ln1_b,
                *router_w, *router_bias, *ew_gate, *ew_up, *ew_down, *sw_gate, *sw_up, *sw_down, *ln2_g, *ln2_b;
    float* out;
    unsigned char* ws;
    int phase_lo, phase_hi;
};

static __device__ const float c_inv_freq[64] = {
  1.000000000e+00f, 8.659643531e-01f, 7.498942018e-01f, 6.493816376e-01f,
  5.623413324e-01f, 4.869675338e-01f, 4.216965139e-01f, 3.651741147e-01f,
  3.162277639e-01f, 2.738419771e-01f, 2.371373773e-01f, 2.053525001e-01f,
  1.778279394e-01f, 1.539926529e-01f, 1.333521456e-01f, 1.154781953e-01f,
  1.000000015e-01f, 8.659642935e-02f, 7.498942316e-02f, 6.493816525e-02f,
  5.623413250e-02f, 4.869675264e-02f, 4.216964915e-02f, 3.651741147e-02f,
  3.162277490e-02f, 2.738419548e-02f, 2.371373773e-02f, 2.053525113e-02f,
  1.778279431e-02f, 1.539926510e-02f, 1.333521400e-02f, 1.154781971e-02f,
  9.999999776e-03f, 8.659643121e-03f, 7.498942316e-03f, 6.493816152e-03f,
  5.623413250e-03f, 4.869675264e-03f, 4.216964822e-03f, 3.651741194e-03f,
  3.162277630e-03f, 2.738419687e-03f, 2.371373819e-03f, 2.053525066e-03f,
  1.778279431e-03f, 1.539926510e-03f, 1.333521446e-03f, 1.154782018e-03f,
  1.000000047e-03f, 8.659643354e-04f, 7.498941850e-04f, 6.493816036e-04f,
  5.623413017e-04f, 4.869675322e-04f, 4.216965172e-04f, 3.651741135e-04f,
  3.162277571e-04f, 2.738419571e-04f, 2.371373703e-04f, 2.053525095e-04f,
  1.778279402e-04f, 1.539926598e-04f, 1.333521504e-04f, 1.154782003e-04f };

DEVI float bf2f(unsigned short u) { return __uint_as_float(((unsigned)u) << 16); }
DEVI float bflo(unsigned u) { return __uint_as_float(u << 16); }
DEVI float bfhi(unsigned u) { return __uint_as_float(u & 0xffff0000u); }
typedef float f32x2 __attribute__((ext_vector_type(2)));
typedef __bf16 bf16x2_t __attribute__((ext_vector_type(2)));
DEVI unsigned pk2(float lo, float hi) { const f32x2 v = {lo, hi}; const bf16x2_t b = __builtin_convertvector(v, bf16x2_t); return __builtin_bit_cast(unsigned, b); }
DEVI unsigned short f2bf(float f) { return (unsigned short)(pk2(f, 0.f) & 0xffffu); }
DEVI u32x2 pk4(f32x4 v) { u32x2 r; r.x = pk2(v[0], v[1]); r.y = pk2(v[2], v[3]); return r; }
DEVI f32x4 unpk4(u32x2 u) { f32x4 r; r[0] = bflo(u.x); r[1] = bfhi(u.x); r[2] = bflo(u.y); r[3] = bfhi(u.y); return r; }
constexpr float YX_SCALE = 16.0f;
DEVI unsigned pk4_fp8(f32x4 v) { int w = 0; w = __builtin_amdgcn_cvt_pk_fp8_f32(v[0], v[1], w, false); w = __builtin_amdgcn_cvt_pk_fp8_f32(v[2], v[3], w, true); return (unsigned)w; }
DEVI f32x4 unpk4_fp8(unsigned u) { f32x4 r; r[0] = __builtin_amdgcn_cvt_f32_fp8((int)u, 0); r[1] = __builtin_amdgcn_cvt_f32_fp8((int)u, 1); r[2] = __builtin_amdgcn_cvt_f32_fp8((int)u, 2); r[3] = __builtin_amdgcn_cvt_f32_fp8((int)u, 3); return r; }
DEVI f32x4 clamp4(f32x4 v, float lim) { f32x4 r; for (int i = 0; i < 4; ++i) r[i] = fminf(fmaxf(v[i], -lim), lim); return r; }
DEVI float sigmoidf_(float v) { return 1.0f / (1.0f + __expf(-v)); }
DEVI float siluf_(float v) { return v / (1.0f + __expf(-v)); }
DEVI float gamma_log2(int h) { return log2f(1.0f - exp2f(-5.0f - (float)h)); }
DEVI f32x4 mfma16(bf16x8 a, bf16x8 b, f32x4 c) { return __builtin_amdgcn_mfma_f32_16x16x32_bf16(a, b, c, 0, 0, 0); }
DEVI unsigned kf_off(int item, int dk, int m8) { return ((((unsigned)item * 4u + (unsigned)(dk >> 5)) * 4u + (unsigned)(m8 >> 4)) * 64u + (unsigned)((m8 >> 3) & 1) * 32u + (unsigned)(dk & 31)) * 8u; }
DEVI unsigned vf_off(int item, int dv, int m8) { return ((((unsigned)item * 8u + (unsigned)(dv >> 5)) * 4u + (unsigned)(m8 >> 4)) * 64u + (unsigned)((m8 >> 3) & 1) * 32u + (unsigned)(dv & 31)) * 8u; }
DEVI unsigned qf_off(int bc, int h, int tokl, int dk8, int hh) {
    return ((((((unsigned)bc * 4u + (unsigned)h) * 2u + (unsigned)(tokl >> 5)) * 4u + (unsigned)(dk8 >> 5)) * 2u + (unsigned)((dk8 >> 4) & 1)) * 64u + (unsigned)hh * 32u + (unsigned)(tokl & 31)) * 8u + (unsigned)((dk8 >> 3) & 1) * 4u; }
DEVI int vperm(int n) { const int wc = n >> 6, nt = (n >> 4) & 3, i = n & 15; return wc * 64 + (nt >> 1) * 32 + 8 * (i >> 2) + 4 * (nt & 1) + (i & 3); }
DEVI int dperm2(int v) { return ((v >> 5) & 1) * 64 + (v >> 6) * 32 + (v & 31); }
DEVI u32x4 pk8(f32x4 a, f32x4 b) { u32x4 r; r.x = pk2(a[0], a[1]); r.y = pk2(a[2], a[3]); r.z = pk2(b[0], b[1]); r.w = pk2(b[2], b[3]); return r; }
DEVI void unpk8(u32x4 u, f32x4& a, f32x4& b) { a[0] = bflo(u.x); a[1] = bfhi(u.x); a[2] = bflo(u.y); a[3] = bfhi(u.y); b[0] = bflo(u.z); b[1] = bfhi(u.z); b[2] = bflo(u.w); b[3] = bfhi(u.w); }
DEVI int dperm(int v) { const int wc = v >> 6, nt = (v >> 4) & 3, c = v & 15; return (nt & 1) * 16 + wc * 32 + c + (nt >> 1) * 64; }

struct __attribute__((aligned(16))) GemmSmem { bf16_t a[2][128 * 64]; bf16_t b[2][128 * 64]; };
constexpr int SMEM_GEMM = sizeof(GemmSmem);
constexpr int SMEM_BYTES = SMEM_GEMM + 2048 + 16;
constexpr int SMEM_HALF = (SMEM_BYTES + 255) & ~255;
constexpr int SMEM_MOE = 16384;
__shared__ __attribute__((aligned(16))) unsigned char smem_all_g[2 * SMEM_HALF + SMEM_MOE];
DEVI int gemm_src_chunk(int t) { return ((t & 7) ^ ((t >> 4) & 7)) * 8; }

template <bool SWAP, int BKIND>
DEVI void gemm_kloop(f32x4 (&acc)[4][4], const bf16_t* const (&pa)[4], const bf16_t* const (&pb)[4],
                     const float* pbf, int ldb, int nk, GemmSmem& sm) {
    const int t = VT, lane = t & 63, w = t >> 6, wr = w >> 1, wc = w & 1, l15 = lane & 15, q = lane >> 4;
    const int kg = t & 7, ng = t >> 3;
    f32x4 rf[8];
#define GEMM_ISSUE(BUF, KO) do { \
        _Pragma("unroll") for (int i = 0; i < 4; ++i) \
            __builtin_amdgcn_global_load_lds((const unsigned*)(pa[i] + (KO)), (unsigned*)((char*)sm.a[BUF] + i * 4096 + t * 16), 16, 0, 0); \
        if (BKIND == 0) { _Pragma("unroll") for (int i = 0; i < 4; ++i) \
            __builtin_amdgcn_global_load_lds((const unsigned*)(pb[i] + (KO)), (unsigned*)((char*)sm.b[BUF] + i * 4096 + t * 16), 16, 0, 0); } \
        else { const float* pp = pbf + (size_t)((KO) + 4 * kg) * ldb; \
            _Pragma("unroll") for (int i = 0; i < 4; ++i) { rf[i] = *(const f32x4*)(pp + (size_t)i * ldb); rf[4 + i] = *(const f32x4*)(pp + (size_t)(32 + i) * ldb); } } } while (0)
#define GEMM_LSTORE_B(BUF) do { if (BKIND == 1) { \
            _Pragma("unroll") for (int i = 0; i < 4; ++i) { \
                u32x2 v0, v1; \
                v0.x = pk2(rf[0][i], rf[1][i]); v0.y = pk2(rf[2][i], rf[3][i]); v1.x = pk2(rf[4][i], rf[5][i]); v1.y = pk2(rf[6][i], rf[7][i]); \
                const int n = 4 * ng + i, sw = (n >> 1) & 7; \
                char* rowp = (char*)sm.b[BUF] + n * 128 + (kg & 1) * 8; \
                *(u32x2*)(rowp + (((kg >> 1) ^ sw) * 16)) = v0; *(u32x2*)(rowp + (((4 + (kg >> 1)) ^ sw) * 16)) = v1; } } } while (0)
    GEMM_ISSUE(0, 0);
    GEMM_LSTORE_B(0);
    __syncthreads();
#define GEMM_KSTEP(CUR, KT) do { \
        const bool more = ((KT) + 1 < nk); \
        if (more) { GEMM_ISSUE((CUR) ^ 1, ((KT) + 1) * 64); } \
        __builtin_amdgcn_sched_barrier(0); \
        _Pragma("unroll") for (int ss = 0; ss < 2; ++ss) { \
            bf16x8 af[4], bfr[4]; \
            const int coff = ((ss * 4 + q) ^ (l15 >> 1)) * 16; \
            _Pragma("unroll") for (int i = 0; i < 4; ++i) { \
                af[i]  = *(const bf16x8*)((const char*)sm.a[CUR] + (wr * 64 + i * 16 + l15) * 128 + coff); \
                bfr[i] = *(const bf16x8*)((const char*)sm.b[CUR] + (wc * 64 + i * 16 + l15) * 128 + coff); } \
            _Pragma("unroll") for (int mt = 0; mt < 4; ++mt) \
                _Pragma("unroll") for (int nt = 0; nt < 4; ++nt) \
                    acc[mt][nt] = SWAP ? mfma16(bfr[nt], af[mt], acc[mt][nt]) : mfma16(af[mt], bfr[nt], acc[mt][nt]); } \
        __builtin_amdgcn_sched_barrier(0); \
        if (more) { GEMM_LSTORE_B((CUR) ^ 1); } \
        __syncthreads(); } while (0)
#pragma unroll 1
    for (int kt = 0; kt < nk; kt += 2) { GEMM_KSTEP(0, kt); GEMM_KSTEP(1, kt + 1); }
#undef GEMM_KSTEP
#undef GEMM_LSTORE_B
#undef GEMM_ISSUE
}

DEVI void zero_acc(f32x4 (&acc)[4][4]) {
#pragma unroll
    for (int i = 0; i < 4; ++i)
#pragma unroll
        for (int j = 0; j < 4; ++j) acc[i][j] = (f32x4){0.f, 0.f, 0.f, 0.f};
}

namespace pg8 {
#define PG8_LAS __attribute__((address_space(3)))
typedef unsigned short bf16_t;
typedef short bf16x8 __attribute__((ext_vector_type(8)));
typedef float f32x4 __attribute__((ext_vector_type(4)));
typedef unsigned u32x4 __attribute__((ext_vector_type(4)));
constexpr int BM = 256, BK = 64, HALF = 128, HTB = HALF * BK * 2  , STAGE_BYTES = 8 * HTB, NXCD = 8, WGM = 8;

__host__ __device__ __forceinline__ int lds_byte(int r, int c) { const int st = (r >> 4) * 2 + (c >> 5), rr = r & 15, cc = c & 31, ob = rr * 64 + cc * 2; return st * 1024 + (ob ^ (((ob >> 9) & 1) << 5)); }
__host__ __device__ __forceinline__ void stage_rc(int b, int& R, int& C) { const int st = b / 1024, sb = b % 1024, swz = sb ^ (((sb >> 9) & 1) << 5); R = (st >> 1) * 16 + swz / 64; C = (st & 1) * 32 + (swz % 64) / 2; }
__host__ __device__ __forceinline__ int perm32(int rho) { const int n = rho >> 4, i = rho & 15; return 8 * (i >> 2) + 4 * n + (i & 3); }

struct Unit { int pm, pn, e, r0, ce; };
struct Gemm { const bf16_t* A; const bf16_t* Bt; int M, N, K; };

struct StaticOrder {
    int nM, nN, nwg, G, c;
    __host__ __device__ void init(int M, int N, int G_, int c_) { nM = M / BM; nN = N / BM; nwg = nM * nN; G = G_; c = c_; }
    __host__ __device__ bool next(int i, Unit& u) const {
        const long L = (long)i * G + c; if (L >= nwg) return false;
        int wgid = (int)L; { const int q = nwg / NXCD, r = nwg % NXCD, xcd = wgid % NXCD, off = wgid / NXCD; wgid = (xcd < r ? xcd * (q + 1) : r * (q + 1) + (xcd - r) * q) + off; }
        const int nig = WGM * nN, gid = wgid / nig, fm = gid * WGM, gsz = (nM - fm) < WGM ? (nM - fm) : WGM;
        u.pm = fm + ((wgid % nig) % gsz); u.pn = (wgid % nig) / gsz; return true;
    }
    __device__ __forceinline__ void a_ready(const Unit&) const {}
    __device__ __forceinline__ void done(const Unit&) const {}
};


template <class Epi, class Sched, bool ALIGN_EPI = false, bool SP2 = false>
__device__ __forceinline__ void gemm_phase(PG8_LAS unsigned char* lds, const Gemm g, const Sched& S, const Epi& E) {
    const int tid = threadIdx.x, wid = __builtin_amdgcn_readfirstlane(tid >> 6), lane = tid & 63, wr = wid >> 2, wc = wid & 3, fr = lane & 15, fq = lane >> 4;
    const int K = g.K, nt = K / BK;
    unsigned voffA[2], voffB[2];
#pragma unroll
    for (int i = 0; i < 2; ++i) { int R, C; stage_rc(tid * 16 + i * 8192, R, C); const int Rb = Epi::PERM ? ((R & ~31) + perm32(R & 31)) : R;
        voffA[i] = (unsigned)(R * K + C) * 2u; voffB[i] = (unsigned)(Rb * K + C) * 2u; }
    const size_t kstep = (size_t)(BK * 2);
    const size_t hstep = (size_t)HALF * K * 2;
    const size_t tstep = 2 * hstep;
    const unsigned ldsw = (unsigned)wid * 1024u;
    const int aoff = lds_byte(wr * 64 + fr, fq * 8), boff = lds_byte(wc * 32 + fr, fq * 8);
#define PG8_SA(b, h) (((b) * 2 + (h)) * HTB)
#define PG8_SB(b, h) ((4 + (b) * 2 + (h)) * HTB)
#define PG8_STAGE(bufoff, gbase, voff) do { _Pragma("unroll") for (int _i = 0; _i < 2; ++_i) \
        __builtin_amdgcn_global_load_lds((const unsigned*)((const char*)(gbase) + (voff)[_i]), (PG8_LAS unsigned*)(lds + (bufoff) + ldsw + _i * 8192), 16, 0, 0); } while (0)
#define PG8_LDA(dst, b, h) do { _Pragma("unroll") for (int m = 0; m < 4; ++m) _Pragma("unroll") for (int k = 0; k < 2; ++k) dst[m][k] = *(const PG8_LAS bf16x8*)(lds + PG8_SA(b, h) + aoff + m * 2048 + k * 1024); } while (0)
#define PG8_LDB(dst, b, h) do { _Pragma("unroll") for (int n = 0; n < 2; ++n) _Pragma("unroll") for (int k = 0; k < 2; ++k) dst[n][k] = *(const PG8_LAS bf16x8*)(lds + PG8_SB(b, h) + boff + n * 2048 + k * 1024); } while (0)
#define PG8_MMA(ai, bj, At, Bt) do { __builtin_amdgcn_s_setprio(1); _Pragma("unroll") for (int m = 0; m < 4; ++m) _Pragma("unroll") for (int n = 0; n < 2; ++n) _Pragma("unroll") for (int k = 0; k < 2; ++k) \
        acc[ai][bj][m][n] = __builtin_amdgcn_mfma_f32_16x16x32_bf16(Bt[n][k], At[m][k], acc[ai][bj][m][n], 0, 0, 0); __builtin_amdgcn_s_setprio(0); } while (0)
#define PG8_WAIT_V(n) asm volatile("s_waitcnt vmcnt(" #n ")" ::: "memory")
#define PG8_WAIT_L(n) asm volatile("s_waitcnt lgkmcnt(" #n ")" ::: "memory")
#define PG8_BAR __builtin_amdgcn_s_barrier()
#define PG8_SCHED __builtin_amdgcn_sched_barrier(0)
    Unit cur, nxt; int ui = 0;
    if (!S.next(0, cur)) return;
    f32x4 acc[2][2][4][2];
#pragma unroll
    for (int a = 0; a < 2; ++a)
#pragma unroll
        for (int b = 0; b < 2; ++b)
#pragma unroll
            for (int m = 0; m < 4; ++m)
#pragma unroll
                for (int n = 0; n < 2; ++n) acc[a][b][m][n] = (f32x4){0.f, 0.f, 0.f, 0.f};
    bf16x8 At[4][2], B0[2][2], B1[2][2];
    const char* cA = (const char*)g.A + (size_t)cur.pm * tstep; const char* cB = (const char*)g.Bt + (size_t)cur.pn * tstep;
    S.a_ready(cur);
    if constexpr (SP2) {
        PG8_STAGE(PG8_SB(0, 0), cB, voffB); PG8_STAGE(PG8_SB(0, 1), cB + hstep, voffB); PG8_STAGE(PG8_SA(0, 0), cA, voffA); PG8_STAGE(PG8_SA(0, 1), cA + hstep, voffA);
        if (wr == 1) PG8_BAR;
        PG8_WAIT_V(2); PG8_BAR;
        PG8_STAGE(PG8_SB(1, 0), cB + kstep, voffB); PG8_STAGE(PG8_SA(1, 0), cA + kstep, voffA); PG8_STAGE(PG8_SB(1, 1), cB + hstep + kstep, voffB);
        PG8_WAIT_V(6); PG8_BAR;
    } else {
        PG8_STAGE(PG8_SB(0, 0), cB, voffB); PG8_STAGE(PG8_SA(0, 0), cA, voffA); PG8_STAGE(PG8_SB(0, 1), cB + hstep, voffB); PG8_STAGE(PG8_SA(0, 1), cA + hstep, voffA);
        if (wr == 1) PG8_BAR;
        PG8_WAIT_V(4); PG8_BAR;
        PG8_STAGE(PG8_SB(1, 0), cB + kstep, voffB); PG8_STAGE(PG8_SA(1, 0), cA + kstep, voffA); PG8_STAGE(PG8_SB(1, 1), cB + hstep + kstep, voffB);
        PG8_WAIT_V(6); PG8_BAR;
    }
    for (;;) {
        const bool has_next = S.next(ui + 1, nxt);
        const char* nA = has_next ? (const char*)g.A + (size_t)nxt.pm * tstep : cA; const char* nB = has_next ? (const char*)g.Bt + (size_t)nxt.pn * tstep : cB;
        for (int t = 0; t < nt; t += 2) {
            const bool last = (t == nt - 2);
            const char* a1 = cA + (size_t)(t + 1) * kstep;
            const char* a2 = last ? nA : cA + (size_t)(t + 2) * kstep; const char* b2 = last ? nB : cB + (size_t)(t + 2) * kstep;
            const char* a3 = a2 + kstep; const char* b3 = b2 + kstep;
            if (last && has_next) S.a_ready(nxt);
            if constexpr (SP2) {
            PG8_LDB(B0, 0, 0); PG8_LDB(B1, 0, 1); PG8_SCHED; PG8_LDA(At, 0, 0); PG8_STAGE(PG8_SA(1, 1), a1 + hstep, voffA);
            PG8_WAIT_V(8); PG8_WAIT_L(0); PG8_BAR; PG8_MMA(0, 0, At, B0); PG8_MMA(0, 1, At, B1); PG8_BAR; PG8_SCHED;
            PG8_LDA(At, 0, 1); PG8_STAGE(PG8_SB(0, 0), b2, voffB); PG8_STAGE(PG8_SB(0, 1), b2 + hstep, voffB); PG8_STAGE(PG8_SA(0, 0), a2, voffA);
            PG8_WAIT_V(8); PG8_WAIT_L(0); PG8_BAR; PG8_MMA(1, 0, At, B0); PG8_MMA(1, 1, At, B1); PG8_BAR; PG8_SCHED;
            PG8_LDB(B0, 1, 0); PG8_LDB(B1, 1, 1); PG8_SCHED; PG8_LDA(At, 1, 0); PG8_STAGE(PG8_SA(0, 1), a2 + hstep, voffA);
            PG8_WAIT_V(8); PG8_WAIT_L(0); PG8_BAR; PG8_MMA(0, 0, At, B0); PG8_MMA(0, 1, At, B1); PG8_BAR; PG8_SCHED;
            PG8_LDA(At, 1, 1); PG8_STAGE(PG8_SB(1, 0), b3, voffB); PG8_STAGE(PG8_SB(1, 1), b3 + hstep, voffB); PG8_STAGE(PG8_SA(1, 0), a3, voffA);
            PG8_WAIT_V(8); PG8_WAIT_L(0); PG8_BAR; PG8_MMA(1, 0, At, B0); PG8_MMA(1, 1, At, B1); PG8_BAR; PG8_SCHED;
            } else {
            PG8_LDB(B0, 0, 0); PG8_SCHED; PG8_LDA(At, 0, 0); PG8_STAGE(PG8_SA(1, 1), a1 + hstep, voffA);
            PG8_WAIT_L(8); PG8_BAR; PG8_WAIT_L(0); PG8_MMA(0, 0, At, B0); PG8_BAR; PG8_SCHED;
            PG8_LDB(B1, 0, 1); PG8_STAGE(PG8_SB(0, 0), b2, voffB);
            PG8_BAR; PG8_WAIT_L(0); PG8_MMA(0, 1, At, B1); PG8_BAR;
            PG8_LDA(At, 0, 1); PG8_STAGE(PG8_SA(0, 0), a2, voffA);
            PG8_BAR; PG8_WAIT_L(0); PG8_MMA(1, 0, At, B0); PG8_BAR; PG8_SCHED;
            PG8_STAGE(PG8_SB(0, 1), b2 + hstep, voffB);
            PG8_WAIT_V(6); PG8_BAR; PG8_MMA(1, 1, At, B1); PG8_BAR;
            PG8_LDB(B0, 1, 0); PG8_SCHED; PG8_LDA(At, 1, 0); PG8_STAGE(PG8_SA(0, 1), a2 + hstep, voffA);
            PG8_WAIT_L(8); PG8_BAR; PG8_WAIT_L(0); PG8_MMA(0, 0, At, B0); PG8_BAR; PG8_SCHED;
            PG8_LDB(B1, 1, 1); PG8_STAGE(PG8_SB(1, 0), b3, voffB);
            PG8_BAR; PG8_WAIT_L(0); PG8_MMA(0, 1, At, B1); PG8_BAR;
            PG8_LDA(At, 1, 1); PG8_STAGE(PG8_SA(1, 0), a3, voffA);
            PG8_BAR; PG8_WAIT_L(0); PG8_MMA(1, 0, At, B0); PG8_BAR; PG8_SCHED;
            PG8_STAGE(PG8_SB(1, 1), b3 + hstep, voffB);
            PG8_WAIT_V(6); PG8_BAR; PG8_MMA(1, 1, At, B1); PG8_BAR;
            }
        }
        if constexpr (ALIGN_EPI) { if (wr == 0) PG8_BAR; }
        if constexpr (!Epi::AFTER_DRAIN) { E(acc, cur, wr, wc, fr, fq); S.done(cur); }
        if (!has_next) break;
#pragma unroll
        for (int a = 0; a < 2; ++a)
#pragma unroll
            for (int b = 0; b < 2; ++b)
#pragma unroll
                for (int m = 0; m < 4; ++m)
#pragma unroll
                    for (int n = 0; n < 2; ++n) acc[a][b][m][n] = (f32x4){0.f, 0.f, 0.f, 0.f};
        cur = nxt; cA = nA; cB = nB; ++ui;
        if constexpr (ALIGN_EPI) { if (wr == 1) PG8_BAR; }
    }
    PG8_WAIT_V(0);
    if constexpr (!ALIGN_EPI) { if (wr == 0) PG8_BAR; }
    PG8_BAR;
    if constexpr (Epi::AFTER_DRAIN) { E.fused(acc, cur, wr, wc, fr, fq, lds, wid, lane); S.done(cur); }
#undef PG8_SA
#undef PG8_SB
#undef PG8_STAGE
#undef PG8_LDA
#undef PG8_LDB
#undef PG8_MMA
#undef PG8_WAIT_V
#undef PG8_WAIT_L
#undef PG8_BAR
#undef PG8_SCHED
}
template <class Epi, class Sched, bool ALIGN_EPI = false, bool SP2 = false>
__device__ __forceinline__ void gemm_phase_g(PG8_LAS unsigned char* lds, const int K, const Sched& S, const Epi& E) {
    const int tid = threadIdx.x, wid = __builtin_amdgcn_readfirstlane(tid >> 6), lane = tid & 63, wr = wid >> 2, wc = wid & 3, fr = lane & 15, fq = lane >> 4;
    const int nt = K / BK;
    unsigned voffB[2]; int rowA[2], colA[2];
#pragma unroll
    for (int i = 0; i < 2; ++i) { int R, C; stage_rc(tid * 16 + i * 8192, R, C); const int lc = perm32(R & 31);
        const int Rb = Epi::BJI ? (64 * (R >> 5) + 16 * (lc >> 3) + (lc & 7)) : (Epi::PERM ? ((R & ~31) + lc) : R);
        rowA[i] = R; colA[i] = C * 2; voffB[i] = (unsigned)(Rb * K + C) * 2u; }
    const size_t kstep = (size_t)(BK * 2);
    const size_t hstep = Epi::BJI ? (size_t)8 * K * 2 : (size_t)HALF * K * 2;
    const size_t tstep = 2 * hstep;
    const unsigned ldsw = (unsigned)wid * 1024u;
    const int aoff = lds_byte(wr * 64 + fr, fq * 8), boff = lds_byte(wc * 32 + fr, fq * 8);
#define PG8_SA(b, h) (((b) * 2 + (h)) * HTB)
#define PG8_SB(b, h) ((4 + (b) * 2 + (h)) * HTB)
#define PG8_STAGE(bufoff, gbase, voff) do { _Pragma("unroll") for (int _i = 0; _i < 2; ++_i) \
        __builtin_amdgcn_global_load_lds((const unsigned*)((const char*)(gbase) + (voff)[_i]), (PG8_LAS unsigned*)(lds + (bufoff) + ldsw + _i * 8192), 16, 0, 0); } while (0)
#define PG8_STAGEA(bufoff, P0, P1, koff) do { \
        __builtin_amdgcn_global_load_lds((const unsigned*)(Ab + (size_t)(P0) + (koff)), (PG8_LAS unsigned*)(lds + (bufoff) + ldsw), 16, 0, 0); \
        __builtin_amdgcn_global_load_lds((const unsigned*)(Ab + (size_t)(P1) + (koff)), (PG8_LAS unsigned*)(lds + (bufoff) + ldsw + 8192), 16, 0, 0); } while (0)
#define PG8_LDA(dst, b, h) do { _Pragma("unroll") for (int m = 0; m < 4; ++m) _Pragma("unroll") for (int k = 0; k < 2; ++k) dst[m][k] = *(const PG8_LAS bf16x8*)(lds + PG8_SA(b, h) + aoff + m * 2048 + k * 1024); } while (0)
#define PG8_LDB(dst, b, h) do { _Pragma("unroll") for (int n = 0; n < 2; ++n) _Pragma("unroll") for (int k = 0; k < 2; ++k) dst[n][k] = *(const PG8_LAS bf16x8*)(lds + PG8_SB(b, h) + boff + n * 2048 + k * 1024); } while (0)
#define PG8_MMA(ai, bj, At, Bt) do { __builtin_amdgcn_s_setprio(1); _Pragma("unroll") for (int m = 0; m < 4; ++m) _Pragma("unroll") for (int n = 0; n < 2; ++n) _Pragma("unroll") for (int k = 0; k < 2; ++k) \
        acc[ai][bj][m][n] = __builtin_amdgcn_mfma_f32_16x16x32_bf16(Bt[n][k], At[m][k], acc[ai][bj][m][n], 0, 0, 0); __builtin_amdgcn_s_setprio(0); } while (0)
#define PG8_WAIT_V(n) asm volatile("s_waitcnt vmcnt(" #n ")" ::: "memory")
#define PG8_WAIT_L(n) asm volatile("s_waitcnt lgkmcnt(" #n ")" ::: "memory")
#define PG8_BAR __builtin_amdgcn_s_barrier()
#define PG8_SCHED __builtin_amdgcn_sched_barrier(0)
    Unit cur, nxt, un2; int ui = 0, sb_cur = 0;
    if (!S.next(0, cur)) return;
    int fillv = S.fill_issue(cur); S.fill_write(0, fillv);
    __syncthreads();
    bool has_next = S.next(1, nxt);
    fillv = 0; if (has_next) fillv = S.fill_issue(nxt);
    f32x4 acc[2][2][4][2];
#pragma unroll
    for (int a = 0; a < 2; ++a)
#pragma unroll
        for (int b = 0; b < 2; ++b)
#pragma unroll
            for (int m = 0; m < 4; ++m)
#pragma unroll
                for (int n = 0; n < 2; ++n) acc[a][b][m][n] = (f32x4){0.f, 0.f, 0.f, 0.f};
    bf16x8 At[4][2], B0[2][2], B1[2][2];
    const char* cB = S.b_base(cur);
    unsigned cA00, cA01, cA10, cA11, nA00, nA01, nA10, nA11;
    const char* const Ab = S.a_base();
    S.a_rows(0, rowA, colA, cA00, cA01, cA10, cA11);
    S.a_ready(cur);
    if constexpr (SP2) {
        PG8_STAGE(PG8_SB(0, 0), cB, voffB); PG8_STAGE(PG8_SB(0, 1), cB + hstep, voffB); PG8_STAGEA(PG8_SA(0, 0), cA00, cA01, 0); PG8_STAGEA(PG8_SA(0, 1), cA10, cA11, 0);
        if (wr == 1) PG8_BAR;
        PG8_WAIT_V(2); PG8_BAR;
        PG8_STAGE(PG8_SB(1, 0), cB + kstep, voffB); PG8_STAGEA(PG8_SA(1, 0), cA00, cA01, kstep); PG8_STAGE(PG8_SB(1, 1), cB + hstep + kstep, voffB);
        PG8_WAIT_V(6); PG8_BAR;
    } else {
        PG8_STAGE(PG8_SB(0, 0), cB, voffB); PG8_STAGEA(PG8_SA(0, 0), cA00, cA01, 0); PG8_STAGE(PG8_SB(0, 1), cB + hstep, voffB); PG8_STAGEA(PG8_SA(0, 1), cA10, cA11, 0);
        if (wr == 1) PG8_BAR;
        PG8_WAIT_V(4); PG8_BAR;
        PG8_STAGE(PG8_SB(1, 0), cB + kstep, voffB); PG8_STAGEA(PG8_SA(1, 0), cA00, cA01, kstep); PG8_STAGE(PG8_SB(1, 1), cB + hstep + kstep, voffB);
        PG8_WAIT_V(6); PG8_BAR;
    }
    for (;;) {
        const char* nB = has_next ? S.b_base(nxt) : cB;
        const int sb_n = sb_cur == 2 ? 0 : sb_cur + 1;
        bool has2 = false;
        if (has_next) { S.fill_write(sb_n, fillv); has2 = S.next(ui + 2, un2); if (has2) fillv = S.fill_issue(un2); }
        nA00 = cA00; nA01 = cA01; nA10 = cA10; nA11 = cA11;
#pragma unroll 1
        for (int t = 0; t < nt; t += 2) {
            const bool last = (t == nt - 2);
            const size_t k1 = (size_t)(t + 1) * kstep;
            const size_t k2 = last ? 0 : (size_t)(t + 2) * kstep; const char* b2 = last ? nB : cB + (size_t)(t + 2) * kstep;
            const unsigned q00 = last ? nA00 : cA00, q01 = last ? nA01 : cA01, q10 = last ? nA10 : cA10, q11 = last ? nA11 : cA11;
            const size_t k3 = k2 + kstep; const char* b3 = b2 + kstep;
            if (last && has_next) S.a_ready(nxt);
            if constexpr (SP2) {
            PG8_LDB(B0, 0, 0); PG8_LDB(B1, 0, 1); PG8_SCHED; PG8_LDA(At, 0, 0); PG8_STAGEA(PG8_SA(1, 1), cA10, cA11, k1);
            PG8_WAIT_V(8); PG8_WAIT_L(0); PG8_BAR; PG8_MMA(0, 0, At, B0); PG8_MMA(0, 1, At, B1); PG8_BAR; PG8_SCHED;
            PG8_LDA(At, 0, 1); PG8_STAGE(PG8_SB(0, 0), b2, voffB); PG8_STAGE(PG8_SB(0, 1), b2 + hstep, voffB); PG8_STAGEA(PG8_SA(0, 0), q00, q01, k2);
            PG8_WAIT_V(8); PG8_WAIT_L(0); PG8_BAR; PG8_MMA(1, 0, At, B0); PG8_MMA(1, 1, At, B1); PG8_BAR; PG8_SCHED;
            PG8_LDB(B0, 1, 0); PG8_LDB(B1, 1, 1); PG8_SCHED; PG8_LDA(At, 1, 0); PG8_STAGEA(PG8_SA(0, 1), q10, q11, k2);
            PG8_WAIT_V(8); PG8_WAIT_L(0); PG8_BAR; PG8_MMA(0, 0, At, B0); PG8_MMA(0, 1, At, B1); PG8_BAR; PG8_SCHED;
            PG8_LDA(At, 1, 1); PG8_STAGE(PG8_SB(1, 0), b3, voffB); PG8_STAGE(PG8_SB(1, 1), b3 + hstep, voffB); PG8_STAGEA(PG8_SA(1, 0), q00, q01, k3);
            PG8_WAIT_V(8); PG8_WAIT_L(0); PG8_BAR; PG8_MMA(1, 0, At, B0); PG8_MMA(1, 1, At, B1); PG8_BAR; PG8_SCHED;
            } else {
            PG8_LDB(B0, 0, 0); PG8_SCHED; PG8_LDA(At, 0, 0); PG8_STAGEA(PG8_SA(1, 1), cA10, cA11, k1);
            PG8_WAIT_L(8); PG8_BAR; PG8_WAIT_L(0); PG8_MMA(0, 0, At, B0); PG8_BAR; PG8_SCHED;
            PG8_LDB(B1, 0, 1); PG8_STAGE(PG8_SB(0, 0), b2, voffB);
            PG8_BAR; PG8_WAIT_L(0); PG8_MMA(0, 1, At, B1); PG8_BAR;
            PG8_LDA(At, 0, 1); PG8_STAGEA(PG8_SA(0, 0), q00, q01, k2);
            PG8_BAR; PG8_WAIT_L(0); PG8_MMA(1, 0, At, B0); PG8_BAR; PG8_SCHED;
            PG8_STAGE(PG8_SB(0, 1), b2 + hstep, voffB);
            PG8_WAIT_V(6); PG8_BAR; PG8_MMA(1, 1, At, B1); PG8_BAR;
            PG8_LDB(B0, 1, 0); PG8_SCHED; PG8_LDA(At, 1, 0); PG8_STAGEA(PG8_SA(0, 1), q10, q11, k2);
            PG8_WAIT_L(8); PG8_BAR; PG8_WAIT_L(0); PG8_MMA(0, 0, At, B0); PG8_BAR; PG8_SCHED;
            PG8_LDB(B1, 1, 1); PG8_STAGE(PG8_SB(1, 0), b3, voffB);
            PG8_BAR; PG8_WAIT_L(0); PG8_MMA(0, 1, At, B1); PG8_BAR;
            PG8_LDA(At, 1, 1); PG8_STAGEA(PG8_SA(1, 0), q00, q01, k3);
            PG8_BAR; PG8_WAIT_L(0); PG8_MMA(1, 0, At, B0); PG8_BAR; PG8_SCHED;
            PG8_STAGE(PG8_SB(1, 1), b3 + hstep, voffB);
            PG8_WAIT_V(6); PG8_BAR; PG8_MMA(1, 1, At, B1); PG8_BAR;
            }
            if (t == nt - 4 && has_next) S.a_rows(sb_n, rowA, colA, nA00, nA01, nA10, nA11);
        }
        if constexpr (ALIGN_EPI) { if (wr == 0) PG8_BAR; }
        if constexpr (!Epi::AFTER_DRAIN) { E(acc, cur, wr, wc, fr, fq, sb_cur); S.done(cur); }
        if (!has_next) break;
#pragma unroll
        for (int a = 0; a < 2; ++a)
#pragma unroll
            for (int b = 0; b < 2; ++b)
#pragma unroll
                for (int m = 0; m < 4; ++m)
#pragma unroll
                    for (int n = 0; n < 2; ++n) acc[a][b][m][n] = (f32x4){0.f, 0.f, 0.f, 0.f};
        cur = nxt; nxt = un2; has_next = has2; cA00 = nA00; cA01 = nA01; cA10 = nA10; cA11 = nA11; cB = nB; ++ui; sb_cur = sb_n;
        if constexpr (ALIGN_EPI) { if (wr == 1) PG8_BAR; }
    }
    PG8_WAIT_V(0);
    if constexpr (!ALIGN_EPI) { if (wr == 0) PG8_BAR; }
    PG8_BAR;
    if constexpr (Epi::AFTER_DRAIN) { E.fused(acc, cur, wr, wc, fr, fq, lds, wid, lane); S.done(cur); }
#undef PG8_SA
#undef PG8_SB
#undef PG8_STAGE
#undef PG8_STAGEA
#undef PG8_LDA
#undef PG8_LDB
#undef PG8_MMA
#undef PG8_WAIT_V
#undef PG8_WAIT_L
#undef PG8_BAR
#undef PG8_SCHED
}
}

DEVI void wt_colinfo(const Params& p, int R, const float*& src, int& ld, float& scale) {
    scale = 1.0f; src = nullptr; ld = 0;
    if (R < WT_AT) {
        const int pn = R >> 8, cl = R & 255; ld = DIN_; int col = -1;
        if (pn < 4) { const int wcq = (cl >> 5) & 3; col = (pn >> 1) * 512 + (2 * (pn & 1) + (wcq >> 1)) * 128 + 64 * (cl >> 7) + 32 * (wcq & 1) + (cl & 31);
                      if (pn >= 2) scale = KSCALE_; }
        else if (pn < 8)  col = 2048 + (pn - 4) * 256 + cl;
        else if (pn < 10) { col = 3072 + (pn - 8) * 256 + cl; scale = KSCALE_; }
        else if (pn < 14) col = 5120 + (pn - 10) * 256 + cl;
        else if (pn < 22) col = 6160 + (pn - 14) * 256 + cl;
        else if (cl < 16) col = 6144 + cl;
        if (col >= 0) src = p.w_in + col;
    } else if (R < WT_RET) {
        const int Rr = R - WT_AT, pm = Rr >> 8, rl = Rr & 255; ld = DIN_; int col;
        if (pm < 2) { col = 512 + (2 * pm + ((rl >> 6) & 1)) * 128 + 64 * (rl >> 7) + (rl & 63); scale = KSCALE_; }
        else if (pm < 6)  col = 1024 + (pm - 2) * 256 + rl;
        else if (pm < 10) col = 4096 + (pm - 6) * 256 + rl;
        else              col = 3584 + (pm - 10) * 256 + rl;
        src = p.w_in + col;
    } else {
        int Rr, ldd; const float* base;
        if (R < WT_GLA)    { Rr = R - WT_RET; base = p.w_ret_out; ldd = 1024; }
        else if (R < WT_O) { Rr = R - WT_GLA; base = p.w_gla_out; ldd = 1024; }
        else if (R < WT_R) { Rr = R - WT_O;   base = p.w_o;       ldd = 1024; }
        else               { Rr = R - WT_R;   base = p.router_w;  ldd = 256; }
        src = base + ((R >= WT_R) ? ((Rr & ~127) + vperm(Rr & 127)) : Rr); ld = ldd;
    }
}

DEVI void phase0(const Params& p, unsigned char* smem) {
    const int tid = VT, nb = VG, bid = VB;
    float2* cs = (float2*)(p.ws + OFF_CS);
    for (int i = bid * 256 + tid; i < 4096 * 64; i += nb * 256) {
        const int pos = i >> 6, k = i & 63;
        const float angf = (float)pos * c_inv_freq[k];
        const double a = (double)angf;
        const double TWO_PI = 6.283185307179586476925286766559, HALF_PI = 1.5707963267948966192313216916398;
        const double kk = rint(a * (1.0 / TWO_PI));
        const double r = a - kk * TWO_PI;
        const double qd = rint(r * (1.0 / HALF_PI));
        const double y = r - qd * HALF_PI;
        const double y2 = y * y;
        double sn = y * (1.0 + y2 * (-1.0 / 6 + y2 * (1.0 / 120 + y2 * (-1.0 / 5040 + y2 * (1.0 / 362880 + y2 * (-1.0 / 39916800 + y2 * (1.0 / 6227020800.0)))))));
        double cn = 1.0 + y2 * (-0.5 + y2 * (1.0 / 24 + y2 * (-1.0 / 720 + y2 * (1.0 / 40320 + y2 * (-1.0 / 3628800 + y2 * (1.0 / 479001600.0))))));
        const int qi = ((int)qd) & 3;
        double s, c;
        if (qi == 0) { s = sn; c = cn; } else if (qi == 1) { s = cn; c = -sn; } else if (qi == 2) { s = -sn; c = -cn; } else { s = -cn; c = sn; }
        cs[i] = make_float2((float)c, (float)s);
    }
    if (bid == 0) { int* cnt = (int*)(p.ws + OFF_CNT); cnt[tid * CNT_STRIDE] = 0; }
    {
        const f32x4* xs = (const f32x4*)p.x; u32x4* xd = (u32x4*)(p.ws + OFF_XB);
        const int n8 = T_ * D_ / 8;
        for (int g = bid * 256 + tid; g < n8; g += nb * 256) {
            const f32x4 v0 = xs[2 * g], v1 = xs[2 * g + 1];
            u32x4 o; o.x = pk2(v0[0], v0[1]); o.y = pk2(v0[2], v0[3]); o.z = pk2(v1[0], v1[1]); o.w = pk2(v1[2], v1[3]);
            xd[g] = o;
        }
    }
    {
        float* tile = (float*)smem;
        bf16_t* wt = (bf16_t*)(p.ws + OFF_WT);
        const int ntask = (WT_ROWS / 64) * 16;
        for (int task = bid; task < ntask; task += nb) {
            const int rt = task >> 4, kt = task & 15, R0 = rt * 64, k0 = kt * 64;
            {
                const int n = tid & 63, kq = tid >> 6;
                const float* src; int ld; float sc; wt_colinfo(p, R0 + n, src, ld, sc);
#pragma unroll
                for (int i = 0; i < 16; ++i) { const int k = kq + 4 * i; tile[k * 65 + n] = src ? src[(size_t)(k0 + k) * ld] * sc : 0.f; }
            }
            __syncthreads();
            {
                const int n = tid >> 2, ks = (tid & 3) * 16;
                unsigned o[8];
#pragma unroll
                for (int j = 0; j < 8; ++j) o[j] = pk2(tile[(ks + 2 * j) * 65 + n], tile[(ks + 2 * j + 1) * 65 + n]);
                u32x4* dst = (u32x4*)(wt + (size_t)(R0 + n) * 1024 + k0 + ks);
                dst[0] = (u32x4){o[0], o[1], o[2], o[3]}; dst[1] = (u32x4){o[4], o[5], o[6], o[7]};
            }
            __syncthreads();
        }
    }
}

struct EpiP1N {
    static constexpr bool PERM = true, AFTER_DRAIN = false;
    unsigned char* ws;
    __device__ __forceinline__ void operator()(const pg8::f32x4 (&acc)[2][2][4][2], const pg8::Unit& u, int wr, int wc, int fr, int fq) const {
        const int pn = u.pn, row0 = u.pm * 256 + wr * 64 + fr, c8 = wc * 32 + 8 * fq;
        if (pn < 4) {
            const float2* cs = (const float2*)(ws + OFF_CS); bf16_t* Qr = (bf16_t*)(ws + (pn < 2 ? OFF_QR : OFF_KR));
            const int head = 2 * (pn & 1) + (wc >> 1), d0 = 32 * (wc & 1) + 8 * fq;
#pragma unroll
            for (int ai = 0; ai < 2; ++ai)
#pragma unroll
                for (int m = 0; m < 4; ++m) {
                    const size_t row = row0 + ai * 128 + m * 16; const int pos = (int)(row & 4095);
                    f32x4 c4[4];
#pragma unroll
                    for (int j = 0; j < 4; ++j) c4[j] = *(const f32x4*)(cs + pos * 64 + d0 + 2 * j);
                    f32x4 o1[2], o2[2];
#pragma unroll
                    for (int n = 0; n < 2; ++n)
#pragma unroll
                        for (int r = 0; r < 4; ++r) {
                            const f32x4 cc = c4[2 * n + (r >> 1)]; const float c_ = cc[(r & 1) * 2], s_ = cc[(r & 1) * 2 + 1];
                            const float x1 = acc[ai][0][m][n][r], x2 = acc[ai][1][m][n][r];
                            o1[n][r] = x1 * c_ - x2 * s_; o2[n][r] = x1 * s_ + x2 * c_;
                        }
                    *(u32x4*)(Qr + row * 512 + head * 128 + d0) = pk8(o1[0], o1[1]);
                    *(u32x4*)(Qr + row * 512 + head * 128 + 64 + d0) = pk8(o2[0], o2[1]);
                    asm volatile("" ::: "memory");
                }
        } else {
#pragma unroll
            for (int ai = 0; ai < 2; ++ai)
#pragma unroll
                for (int m = 0; m < 4; ++m) {
                    const size_t row = row0 + ai * 128 + m * 16;
#pragma unroll
                    for (int bj = 0; bj < 2; ++bj) {
                        const int cl = bj * 128 + c8;
                        f32x4 v0 = acc[ai][bj][m][0], v1 = acc[ai][bj][m][1];
                        if (pn < 8) {
#pragma unroll
                            for (int r = 0; r < 4; ++r) { v0[r] = siluf_(v0[r]); v1[r] = siluf_(v1[r]); }
                            *(u32x4*)((bf16_t*)(ws + OFF_GS) + row * 2048 + (pn - 4) * 256 + cl) = pk8(v0, v1);
                        } else if (pn < 10) {
                            *(u32x4*)((bf16_t*)(ws + OFF_QGN) + row * 512 + (pn - 8) * 256 + cl) = pk8(v0, v1);
                        } else if (pn < 14) {
#pragma unroll
                            for (int r = 0; r < 4; ++r) { v0[r] = siluf_(v0[r]); v1[r] = siluf_(v1[r]); }
                            *(u32x4*)((bf16_t*)(ws + OFF_GS) + row * 2048 + 1024 + (pn - 10) * 256 + cl) = pk8(v0, v1);
                        } else if (pn < 22) {
#pragma unroll
                            for (int r = 0; r < 4; ++r) { v0[r] = sigmoidf_(v0[r]); v1[r] = sigmoidf_(v1[r]); }
                            *(u32x4*)((bf16_t*)(ws + OFF_MG) + row * 2048 + (pn - 14) * 256 + cl) = pk8(v0, v1);
                        } else if (cl < 16) {
                            float* Ga = (float*)(ws + OFF_GA); *(f32x4*)(Ga + row * 16 + cl) = v0; *(f32x4*)(Ga + row * 16 + cl + 4) = v1;
                        }
                    }
                    asm volatile("" ::: "memory");
                }
        }
    }
};
struct EpiP1V {
    static constexpr bool PERM = true, AFTER_DRAIN = false;
    unsigned char* ws;
    __device__ __forceinline__ void operator()(const pg8::f32x4 (&acc)[2][2][4][2], const pg8::Unit& u, int wr, int wc, int fr, int fq) const {
        bf16_t* dst = (bf16_t*)(ws + (u.pm < 4 ? OFF_VRT : OFF_VGT)); const int head = u.pm & 3;
#pragma unroll
        for (int bj = 0; bj < 2; ++bj) {
            const int tok0 = u.pn * 256 + bj * 128 + wc * 32 + 8 * fq; const int item = (tok0 >> 6) * 4 + head, m0 = tok0 & 63;
#pragma unroll
            for (int ai = 0; ai < 2; ++ai)
#pragma unroll
                for (int m = 0; m < 4; ++m) {
                    *(u32x4*)(dst + vf_off(item, ai * 128 + wr * 64 + m * 16 + fr, m0)) = pk8(acc[ai][bj][m][0], acc[ai][bj][m][1]);
                    asm volatile("" ::: "memory");
                }
        }
    }
};
struct EpiP1G {
    static constexpr bool PERM = true, AFTER_DRAIN = false;
    unsigned char* ws;
    __device__ __forceinline__ void operator()(const pg8::f32x4 (&acc)[2][2][4][2], const pg8::Unit& u, int wr, int wc, int fr, int fq) const {
        bf16_t* dst = (bf16_t*)(ws + OFF_KGT);
#pragma unroll
        for (int bj = 0; bj < 2; ++bj) {
            const int tok0 = u.pn * 256 + bj * 128 + wc * 32 + 8 * fq; const int m0 = tok0 & 63;
#pragma unroll
            for (int ai = 0; ai < 2; ++ai) {
                const unsigned item = (unsigned)((tok0 >> 6) * 4 + 2 * u.pm + ai);
#pragma unroll
                for (int m = 0; m < 4; ++m) {
                    *(u32x4*)(dst + (item * 128u + (unsigned)(wr * 64 + m * 16 + fr)) * 64u + (unsigned)m0) = pk8(acc[ai][bj][m][0], acc[ai][bj][m][1]);
                    asm volatile("" ::: "memory");
                }
            }
        }
    }
};
DEVI void phase1(const Params& p, unsigned char* smem_all) {
    {
        pg8::StaticOrder S; S.init(T_, 5888, RG, RB);
        pg8::Gemm g; g.A = (const bf16_t*)(p.ws + OFF_XB); g.Bt = (const bf16_t*)(p.ws + OFF_WT) + (size_t)WT_BN * 1024; g.M = T_; g.N = 5888; g.K = 1024;
        EpiP1N E; E.ws = p.ws;
        pg8::gemm_phase<EpiP1N, pg8::StaticOrder, true, true>((PG8_LAS unsigned char*)smem_all, g, S, E);
    }
    __syncthreads();
    {
        pg8::StaticOrder S; S.init(2048, T_, RG, RB);
        pg8::Gemm g; g.A = (const bf16_t*)(p.ws + OFF_WT) + (size_t)(WT_AT + 512) * 1024; g.Bt = (const bf16_t*)(p.ws + OFF_XB); g.M = 2048; g.N = T_; g.K = 1024;
        EpiP1V E; E.ws = p.ws;
        pg8::gemm_phase<EpiP1V, pg8::StaticOrder, true, true>((PG8_LAS unsigned char*)smem_all, g, S, E);
    }
    __syncthreads();
    {
        pg8::StaticOrder S; S.init(512, T_, RG, RB);
        pg8::Gemm g; g.A = (const bf16_t*)(p.ws + OFF_WT) + (size_t)(WT_AT + 2560) * 1024; g.Bt = (const bf16_t*)(p.ws + OFF_XB); g.M = 512; g.N = T_; g.K = 1024;
        EpiP1G E; E.ws = p.ws;
        pg8::gemm_phase<EpiP1G, pg8::StaticOrder, true, true>((PG8_LAS unsigned char*)smem_all, g, S, E);
    }
}

DEVI void phase2(const Params& p, unsigned char* smem) {
    float* ga_s = (float*)smem;
    float* tot = (float*)(smem + 4096);
    const int tid = VT;
    const float* Ga = (const float*)(p.ws + OFF_GA);
    const bf16_t* Kgt = (const bf16_t*)(p.ws + OFF_KGT); bf16_t* Kg2 = (bf16_t*)(p.ws + OFF_KG2);
    float* dec = (float*)(p.ws + OFF_DEC);
    for (int it = VB; it < 2048; it += VG) {
        const int h = it & 3, c = (it >> 2) & 63, b = it >> 8;
        const int tok0 = b * 4096 + c * 64;
        ((f32x4*)ga_s)[tid] = ((const f32x4*)(Ga + (size_t)tok0 * 16))[tid];
        const int dk = tid & 127, half = tid >> 7;
        float w2[16];
#pragma unroll
        for (int r = 0; r < 16; ++r) w2[r] = p.gate_w2[r * 512 + h * 128 + dk];
        const float bias = p.gate_b[h * 128 + dk];
        __syncthreads();
        float run = 0.f; float bc[32];
#pragma unroll
        for (int ml = 0; ml < 32; ++ml) {
            const int m = half * 32 + ml;
            float z = bias;
#pragma unroll
            for (int r4 = 0; r4 < 4; ++r4) { const f32x4 g4 = *(const f32x4*)&ga_s[m * 16 + 4 * r4];
                z += g4[0] * w2[4 * r4] + g4[1] * w2[4 * r4 + 1] + g4[2] * w2[4 * r4 + 2] + g4[3] * w2[4 * r4 + 3]; }
            const float la = (fminf(z, 0.f) - __logf(1.0f + __expf(-fabsf(z)))) * (1.0f / 16.0f);
            run += la; bc[ml] = run;
        }
        tot[half * 128 + dk] = run;
        __syncthreads();
        const float t0 = tot[dk], t1 = tot[128 + dk];
        const float bend = t0 + t1, off = half ? t0 : 0.f;
        const u32x4* kp = (const u32x4*)(Kgt + ((size_t)it * 128 + dk) * 64 + half * 32);
        bf16_t* const kqb = Kg2;
#pragma unroll
        for (int j = 0; j < 4; ++j) {
            u32x4 v = kp[j];
            unsigned uu[4] = {v.x, v.y, v.z, v.w};
#pragma unroll
            for (int e = 0; e < 4; ++e) {
                const float f0 = bflo(uu[e]) * __expf(bend - (bc[8 * j + 2 * e] + off));
                const float f1 = bfhi(uu[e]) * __expf(bend - (bc[8 * j + 2 * e + 1] + off));
                uu[e] = pk2(f0, f1);
            }
            *(u32x4*)(kqb + kf_off(it, dk, half * 32 + 8 * j)) = (u32x4){uu[0], uu[1], uu[2], uu[3]};
        }
        if (half == 0) dec[(size_t)it * 128 + dk] = __expf(bend);
        {
            const bf16_t* Qn = (const bf16_t*)(p.ws + OFF_QGN); bf16_t* QF = (bf16_t*)(p.ws + OFF_QG);
            const int m = tid & 63, qd = tid >> 6, bc = b * 64 + c;
            const u32x4* qs = (const u32x4*)(Qn + ((size_t)tok0 + m) * 512 + h * 128 + 32 * qd);
            u32x4 qv[4];
#pragma unroll
            for (int j = 0; j < 4; ++j) qv[j] = qs[j];
#pragma unroll
            for (int j = 0; j < 4; ++j) {
                *(u32x2*)(QF + qf_off(bc, h, m, 32 * qd + 8 * j, 0)) = (u32x2){qv[j].x, qv[j].y};
                *(u32x2*)(QF + qf_off(bc, h, m, 32 * qd + 8 * j, 1)) = (u32x2){qv[j].z, qv[j].w};
            }
        }
        __syncthreads();
    }
    {
        bf16_t* tile = (bf16_t*)smem;
        const bf16_t* Kr = (const bf16_t*)(p.ws + OFF_KR); bf16_t* Krt = (bf16_t*)(p.ws + OFF_KRT);
        for (int it = VB; it < 2048; it += VG) {
            const int h = it & 3, c = (it >> 2) & 63, b = it >> 8;
            const size_t tok0 = (size_t)b * 4096 + c * 64;
            const int m = tid & 63, qd = tid >> 6;
            const float kd = exp2f(gamma_log2(h) * (float)(63 - m));
            const u32x4* src = (const u32x4*)(Kr + (tok0 + m) * 512 + h * 128 + 32 * qd);
            u32x4 v[4];
#pragma unroll
            for (int j = 0; j < 4; ++j) v[j] = src[j];
#pragma unroll
            for (int j = 0; j < 4; ++j) {
                const unsigned uu[4] = {v[j].x, v[j].y, v[j].z, v[j].w};
#pragma unroll
                for (int e = 0; e < 4; ++e) {
                    const int dk = 32 * qd + 8 * j + 2 * e;
                    tile[dk * 72 + m] = f2bf(bflo(uu[e]) * kd); tile[(dk + 1) * 72 + m] = f2bf(bfhi(uu[e]) * kd);
                }
            }
            {
                const bf16_t* Qr = (const bf16_t*)(p.ws + OFF_QR); bf16_t* QF = (bf16_t*)(p.ws + OFF_QFR);
                const u32x4* qs = (const u32x4*)(Qr + (tok0 + m) * 512 + h * 128 + 32 * qd);
                u32x4 qv[4];
#pragma unroll
                for (int j = 0; j < 4; ++j) qv[j] = qs[j];
                const int bc = b * 64 + c;
#pragma unroll
                for (int j = 0; j < 4; ++j) {
                    *(u32x2*)(QF + qf_off(bc, h, m, 32 * qd + 8 * j, 0)) = (u32x2){qv[j].x, qv[j].y};
                    *(u32x2*)(QF + qf_off(bc, h, m, 32 * qd + 8 * j, 1)) = (u32x2){qv[j].z, qv[j].w};
                }
            }
            __syncthreads();
            {
                const int dk = tid >> 1, hf = tid & 1;
#pragma unroll
                for (int j = 0; j < 4; ++j) *(u32x4*)(Krt + kf_off(it, dk, hf * 32 + 8 * j)) = *(const u32x4*)&tile[dk * 72 + hf * 32 + 8 * j];
            }
            __syncthreads();
        }
    }
}

typedef float f32x16 __attribute__((ext_vector_type(16)));
DEVI f32x16 mfma32(bf16x8 a, bf16x8 b, f32x16 c) { return __builtin_amdgcn_mfma_f32_32x32x16_bf16(a, b, c, 0, 0, 0); }
struct ScanSet { bf16x8 kf[4], vq, qf[2][2]; f32x4 dc[4]; };
template <bool GLA>
DEVI void scan_tile(const Params& p, unsigned char* zb  , int b, int h, int s, int dummy) {
    int vt_ = VT; asm volatile("" : "+v"(vt_));
    const int t = __builtin_amdgcn_readfirstlane(vt_ >> 6), lane = vt_ & 63, r = lane & 31, hh = lane >> 5;
    const bf16_t* Ktb = (const bf16_t*)(p.ws + (GLA ? OFF_KG2 : OFF_KRT));
    const bf16_t* Vtb = (const bf16_t*)(p.ws + (GLA ? OFF_VGT : OFF_VRT));
    const bf16_t* Qb  = (const bf16_t*)(p.ws + (GLA ? OFF_QG : OFF_QFR));
    const float* dec = (const float*)(p.ws + OFF_DEC);
    bf16_t* Oo = (bf16_t*)(p.ws + OFF_OO);
    const float lg = gamma_log2(h);
    const float cd = exp2f(lg * 64.0f);
    f32x16 S;
#pragma unroll
    for (int i = 0; i < 16; ++i) S[i] = 0.f;
    const unsigned it0 = (unsigned)(b * 64 * 4 + h);
    const bf16_t* const kp = Ktb + ((size_t)it0 * 4 + t) * 4 * 512; const unsigned ko = (unsigned)lane * 8;
    const bf16_t* const vp = Vtb + ((size_t)it0 * 8 + s) * 4 * 512 + t * 512; const unsigned vo = (unsigned)lane * 8;
    const bf16_t* const qp = Qb + ((((size_t)(b * 64) * 4 + h) * 2) * 4 + t) * 2 * 512; const unsigned qo = (unsigned)lane * 8;
    const float* const dp = dec + (size_t)it0 * 128 + t * 32; const unsigned dofs = 4 * hh;
    unsigned char* const vring = smem_all_g + 2 * SMEM_HALF + VH * 8192;
    const int rt = t >> 1, rg0 = 2 * (t & 1);
    const float qd = GLA ? 1.0f : exp2f(lg * (float)(32 * rt + r + 1));
    bf16_t* const ob = Oo + (size_t)b * 4096 * 2048 + (GLA ? 1024 : 0) + h * 256 + s * 32;
#define ST_CL(C) (dummy ? 0 : ((C) < 64 ? (C) : 63))
#define ST_LOAD(SET, C) do { const int c_ = ST_CL(C), cv_ = ST_CL((C) + 1); \
        const bf16_t* kq = kp + (size_t)c_ * (4 * 16 * 512) + ko; const bf16_t* qq = qp + (size_t)c_ * (4 * 16 * 512) + qo; \
        _Pragma("unroll") for (int ks = 0; ks < 4; ++ks) (SET).kf[ks] = *(const bf16x8*)(kq + ks * 512); \
        (SET).vq = *(const bf16x8*)(vp + (size_t)cv_ * (4 * 32 * 512) + vo); \
        _Pragma("unroll") for (int ss = 0; ss < 2; ++ss) _Pragma("unroll") for (int tt = 0; tt < 2; ++tt) (SET).qf[ss][tt] = *(const bf16x8*)(qq + tt * (8 * 512) + ss * 512); \
        } while (0)
#define ST_LOADDC(SET, C) do { if (GLA) { const int c_ = (C) < 64 ? (C) : 63; const float* dq = dp + (size_t)c_ * (4 * 128) + dofs; \
        _Pragma("unroll") for (int g = 0; g < 4; ++g) (SET).dc[g] = *(const f32x4*)(dq + 8 * g); } } while (0)
#define ST_Z(SET, ZC) do { \
        _Pragma("unroll") for (int tt = 0; tt < 2; ++tt) { \
            f32x16 Zt; _Pragma("unroll") for (int i = 0; i < 16; ++i) Zt[i] = 0.f; \
            _Pragma("unroll") for (int ss = 0; ss < 2; ++ss) { \
                u32x4 pk; pk.x = pk2(S[8 * ss + 0], S[8 * ss + 1]); pk.y = pk2(S[8 * ss + 2], S[8 * ss + 3]); pk.z = pk2(S[8 * ss + 4], S[8 * ss + 5]); pk.w = pk2(S[8 * ss + 6], S[8 * ss + 7]); \
                Zt = mfma32(__builtin_bit_cast(bf16x8, pk), (SET).qf[ss][tt], Zt); } \
            _Pragma("unroll") for (int g = 0; g < 4; ++g) { \
                f32x4 z4; z4[0] = Zt[4 * g]; z4[1] = Zt[4 * g + 1]; z4[2] = Zt[4 * g + 2]; z4[3] = Zt[4 * g + 3]; \
                *(u32x2*)((ZC) + (((t * 2 + tt) * 4 + g) * 64 + lane) * 8) = pk4(z4); } } } while (0)
#define ST_UPD(SET, C) do { \
        if (GLA) { _Pragma("unroll") for (int g = 0; g < 4; ++g) _Pragma("unroll") for (int i = 0; i < 4; ++i) S[4 * g + i] *= (SET).dc[g][i]; } \
        else { _Pragma("unroll") for (int i = 0; i < 16; ++i) S[i] *= cd; } \
        _Pragma("unroll") for (int ks = 0; ks < 4; ++ks) S = mfma32((SET).kf[ks], *(const bf16x8*)(vring + ((C) & 1) * 4096 + ks * 1024 + lane * 16), S); } while (0)
#define ST_STEP(CUR, NXT, OTH, C) do { \
        ST_LOADDC(OTH, (C) + 1); ST_LOAD(NXT, (C) + 2);       \
        __builtin_amdgcn_sched_barrier(0); \
        unsigned char* zc = zb + ((C) & 1) * 16384; \
        if (GLA) { ST_UPD(CUR, C); ST_Z(CUR, zc); } else { ST_Z(CUR, zc); ST_UPD(CUR, C); } \
        *(bf16x8*)(vring + (((C) + 1) & 1) * 4096 + t * 1024 + lane * 16) = (CUR).vq; \
        __syncthreads(); \
        _Pragma("unroll") for (int gi = 0; gi < 2; ++gi) { const int g = rg0 + gi; \
            f32x4 o = (f32x4){0.f, 0.f, 0.f, 0.f}; \
            _Pragma("unroll") for (int t2 = 0; t2 < 4; ++t2) o += unpk4(*(const u32x2*)(zc + (((t2 * 2 + rt) * 4 + g) * 64 + lane) * 8)); \
            *(u32x2*)(zb + 32768 + ((C) & 7) * 4096 + (32 * rt + r) * 64 + (8 * g + 4 * hh) * 2) = pk4(o * qd); } \
          \
        if (((C) & 7) == 7) { __syncthreads(); \
            _Pragma("unroll") for (int i = 0; i < 8; ++i)   \
                *(u32x4*)((unsigned char*)ob + (size_t)(((C) - 7) * 64 + i * 64) * 4096 + fo) = *(const u32x4*)(zb + 32768 + i * 4096 + fl); } } while (0)
    const unsigned fo = (unsigned)(vt_ >> 2) * 4096u + (unsigned)(vt_ & 3) * 16u, fl = (unsigned)(vt_ >> 2) * 64u + (unsigned)(vt_ & 3) * 16u;
    ScanSet A, B, Cc;
    { const bf16x8 v0 = *(const bf16x8*)(vp + vo); *(bf16x8*)(vring + t * 1024 + lane * 16) = v0; }
    ST_LOAD(A, 0); ST_LOADDC(A, 0); ST_LOAD(B, 1);
    __syncthreads();
#pragma unroll 1
    for (int c0 = 0; c0 < 66; c0 += 3) { ST_STEP(A, Cc, B, c0); ST_STEP(B, A, Cc, c0 + 1); ST_STEP(Cc, B, A, c0 + 2); }
    __syncthreads();
#undef ST_STEP
#undef ST_UPD
#undef ST_Z
#undef ST_LOADDC
#undef ST_LOAD
#undef ST_CL
}
DEVI void phase3t(const Params& p, unsigned char* smem, int dummy) {
    for (int it0 = VB; it0 < 512; it0 += VG) {
        const int lcl = (RB >> 3) * 2 + VH;
        const int it = (VG == 512) ? ((RB & 7) * 8 + lcl / 8) * 8 + (lcl & 7) : it0;
        const int s = it & 7, h = (it >> 3) & 3, b = (it >> 5) & 7, br = it >> 8;
        if (br == 0) scan_tile<false>(p, smem, b, h, s, dummy); else scan_tile<true>(p, smem, b, h, s, dummy);
    }
}

constexpr int PS_LD = 72;
DEVI void phase4(const Params& p, unsigned char* smem) {
    const int t = VT, lane = t & 63, w = t >> 6, l15 = lane & 15, q = lane >> 4;
    bf16_t* Ps = (bf16_t*)smem + w * 16 * PS_LD;
    const bf16_t* Qr = (const bf16_t*)(p.ws + OFF_QR); const bf16_t* Kr = (const bf16_t*)(p.ws + OFF_KR);
    const bf16_t* Vrt = (const bf16_t*)(p.ws + OFF_VRT); const bf16_t* Oo = (const bf16_t*)(p.ws + OFF_OO);
    const bf16_t* Gs = (const bf16_t*)(p.ws + OFF_GS); bf16_t* Y = (bf16_t*)(p.ws + OFF_Y);
    for (int it = VB; it < 4096; it += VG) {
        const int br = it >> 11, idx = it & 2047;
        const int h = idx & 3, c = (idx >> 2) & 63, b = idx >> 8;
        const size_t tok0 = (size_t)b * 4096 + c * 64;
        const size_t tok = tok0 + 16 * w + l15;
        f32x4 O[16];
        const bf16_t* orow = Oo + tok * 2048 + br * 1024 + h * 256 + 4 * q;
        const bf16_t* grow = Gs + tok * 2048 + br * 1024 + h * 256 + 4 * q;
        u32x2 oraw[16], graw[16];
        if (br == 0) {
            const float lg = gamma_log2(h);
            bf16x8 vf[8][2];
#pragma unroll
            for (int nt = 0; nt < 8; ++nt) { vf[nt][0] = *(const bf16x8*)(Vrt + vf_off(idx, 16 * nt + l15, q * 8)); vf[nt][1] = *(const bf16x8*)(Vrt + vf_off(idx, 16 * nt + l15, 32 + q * 8)); }
            __builtin_amdgcn_sched_barrier(0);
            f32x4 P[4] = {(f32x4){0.f, 0.f, 0.f, 0.f}, (f32x4){0.f, 0.f, 0.f, 0.f}, (f32x4){0.f, 0.f, 0.f, 0.f}, (f32x4){0.f, 0.f, 0.f, 0.f}};
#pragma unroll
            for (int ks = 0; ks < 4; ++ks) {
                const bf16x8 qf = *(const bf16x8*)(Qr + tok * 512 + h * 128 + ks * 32 + q * 8);
#pragma unroll
                for (int mt = 0; mt < 4; ++mt) {
                    const bf16x8 kf = *(const bf16x8*)(Kr + (tok0 + 16 * mt + l15) * 512 + h * 128 + ks * 32 + q * 8);
                    P[mt] = mfma16(kf, qf, P[mt]);
                }
            }
            const int j = 16 * w + l15;
#pragma unroll
            for (int mt = 0; mt < 4; ++mt) {
                f32x4 v = P[mt];
#pragma unroll
                for (int r = 0; r < 4; ++r) { const int m = 16 * mt + 4 * q + r; const int dd = j > m ? j - m : m - j; v[r] *= exp2f(lg * (float)dd); }
                *(u32x2*)&Ps[l15 * PS_LD + 16 * mt + 4 * q] = pk4(v);
            }
            __syncthreads();
            const bf16x8 pf0 = *(const bf16x8*)&Ps[l15 * PS_LD + q * 8];
            const bf16x8 pf1 = *(const bf16x8*)&Ps[l15 * PS_LD + 32 + q * 8];
            __builtin_amdgcn_sched_barrier(0);
#pragma unroll
            for (int nt = 0; nt < 8; ++nt) {
                f32x4 o = (f32x4){0.f, 0.f, 0.f, 0.f};
                o = mfma16(vf[nt][0], pf0, o); O[nt] = mfma16(vf[nt][1], pf1, o);
            }
            __builtin_amdgcn_sched_barrier(0);
#pragma unroll
            for (int nt = 0; nt < 8; ++nt) { vf[nt][0] = *(const bf16x8*)(Vrt + vf_off(idx, 16 * (8 + nt) + l15, q * 8)); vf[nt][1] = *(const bf16x8*)(Vrt + vf_off(idx, 16 * (8 + nt) + l15, 32 + q * 8)); }
#pragma unroll
            for (int nt = 0; nt < 16; ++nt) { oraw[nt] = *(const u32x2*)(orow + 16 * nt); graw[nt] = *(const u32x2*)(grow + 16 * nt); }
            __builtin_amdgcn_sched_barrier(0);
#pragma unroll
            for (int nt = 0; nt < 8; ++nt) {
                f32x4 o = (f32x4){0.f, 0.f, 0.f, 0.f};
                o = mfma16(vf[nt][0], pf0, o); O[8 + nt] = mfma16(vf[nt][1], pf1, o);
            }
#pragma unroll
            for (int nt = 0; nt < 16; ++nt) O[nt] += unpk4(oraw[nt]);
            __syncthreads();
        } else {
#pragma unroll
            for (int nt = 0; nt < 16; ++nt) { oraw[nt] = *(const u32x2*)(orow + 16 * nt); graw[nt] = *(const u32x2*)(grow + 16 * nt); }
#pragma unroll
            for (int nt = 0; nt < 16; ++nt) O[nt] = unpk4(oraw[nt]);
        }
        float s1 = 0.f;
#pragma unroll
        for (int nt = 0; nt < 16; ++nt) s1 += (O[nt][0] + O[nt][1]) + (O[nt][2] + O[nt][3]);
        s1 += __shfl_xor(s1, 16); s1 += __shfl_xor(s1, 32);
        const float mean = (br == 0) ? s1 * (1.0f / 256.0f) : 0.f;
        float s2 = 0.f;
#pragma unroll
        for (int nt = 0; nt < 16; ++nt) {
#pragma unroll
            for (int r = 0; r < 4; ++r) { const float dlt = O[nt][r] - mean; s2 += dlt * dlt; }
        }
        s2 += __shfl_xor(s2, 16); s2 += __shfl_xor(s2, 32);
        const float rstd = rsqrtf(s2 * (1.0f / 256.0f) + (br == 0 ? 1e-5f : 1e-6f));
        const float* gw = (br == 0 ? p.ret_norm_g : p.gla_norm_g) + h * 256 + 4 * q;
        bf16_t* yrow = Y + ((size_t)br * T_ + tok) * 1024 + h * 256 + 4 * q;
#pragma unroll
        for (int nt = 0; nt < 16; ++nt) {
            const f32x4 g = *(const f32x4*)(gw + 16 * nt);
            const f32x4 gate = unpk4(graw[nt]);
            f32x4 y;
#pragma unroll
            for (int r = 0; r < 4; ++r) y[r] = (O[nt][r] - mean) * rstd * g[r] * gate[r];
            *(u32x2*)(yrow + 16 * nt) = pk4(y);
        }
    }
}

struct EpiMerge {
    static constexpr bool PERM = true, AFTER_DRAIN = false;
    const bf16_t* Mg; bf16_t* Mrg; int pass;
    __device__ __forceinline__ void operator()(const pg8::f32x4 (&acc)[2][2][4][2], const pg8::Unit& u, int wr, int wc, int fr, int fq) const {
        const int row0 = u.pm * 256 + wr * 64 + fr, col0 = u.pn * 256 + wc * 32 + 8 * fq;
#pragma unroll
        for (int ai = 0; ai < 2; ++ai) {
            u32x4 gg[4][2], pr[4][2];
#pragma unroll
            for (int m = 0; m < 4; ++m)
#pragma unroll
                for (int bj = 0; bj < 2; ++bj) {
                    const size_t row = row0 + ai * 128 + m * 16; const int col = col0 + bj * 128;
                    gg[m][bj] = *(const u32x4*)(Mg + row * 2048 + pass * 1024 + col);
                    if (pass) pr[m][bj] = *(const u32x4*)(Mrg + row * 1024 + col);
                }
#pragma unroll
            for (int m = 0; m < 4; ++m)
#pragma unroll
                for (int bj = 0; bj < 2; ++bj) {
                    const size_t row = row0 + ai * 128 + m * 16; const int col = col0 + bj * 128;
                    f32x4 g0, g1; unpk8(gg[m][bj], g0, g1);
                    f32x4 o0 = acc[ai][bj][m][0] * g0, o1 = acc[ai][bj][m][1] * g1;
                    if (pass) { f32x4 p0, p1; unpk8(pr[m][bj], p0, p1); o0 += p0; o1 += p1; }
                    *(u32x4*)(Mrg + row * 1024 + col) = pk8(o0, o1);
                }
        }
    }
};
DEVI void phase5(const Params& p, unsigned char* smem_all) {
    pg8::StaticOrder S; S.init(T_, 1024, RG, RB);
    const bf16_t* Y = (const bf16_t*)(p.ws + OFF_Y); const bf16_t* wt = (const bf16_t*)(p.ws + OFF_WT);
    for (int pass = 0; pass < 2; ++pass) {
        pg8::Gemm g; g.A = Y + (size_t)pass * T_ * 1024; g.Bt = wt + (size_t)(pass ? WT_GLA : WT_RET) * 1024; g.M = T_; g.N = 1024; g.K = 1024;
        EpiMerge E; E.Mg = (const bf16_t*)(p.ws + OFF_MG); E.Mrg = (bf16_t*)(p.ws + OFF_MRG); E.pass = pass;
        pg8::gemm_phase<EpiMerge, pg8::StaticOrder, true, true>((PG8_LAS unsigned char*)smem_all, g, S, E);
        __syncthreads();
    }
}

struct EpiResid {
    static constexpr bool PERM = true, AFTER_DRAIN = false;
    const float* x; bf16_t* T1;
    __device__ __forceinline__ void operator()(const pg8::f32x4 (&acc)[2][2][4][2], const pg8::Unit& u, int wr, int wc, int fr, int fq) const {
        const int row0 = u.pm * 256 + wr * 64 + fr, col0 = u.pn * 256 + wc * 32 + 8 * fq;
#pragma unroll
        for (int ai = 0; ai < 2; ++ai)
#pragma unroll
            for (int m = 0; m < 4; ++m) {
                const size_t row = row0 + ai * 128 + m * 16;
                f32x4 xv[2][2];
#pragma unroll
                for (int bj = 0; bj < 2; ++bj) { xv[bj][0] = *(const f32x4*)(x + row * 1024 + col0 + bj * 128); xv[bj][1] = *(const f32x4*)(x + row * 1024 + col0 + bj * 128 + 4); }
#pragma unroll
                for (int bj = 0; bj < 2; ++bj)
                    *(u32x4*)(T1 + row * 1024 + col0 + bj * 128) = pk8(xv[bj][0] * ALPHA_ + acc[ai][bj][m][0], xv[bj][1] * ALPHA_ + acc[ai][bj][m][1]);
            }
    }
};
DEVI void phase6(const Params& p, unsigned char* smem_all) {
    pg8::StaticOrder S; S.init(T_, 1024, RG, RB);
    pg8::Gemm g; g.A = (const bf16_t*)(p.ws + OFF_MRG); g.Bt = (const bf16_t*)(p.ws + OFF_WT) + (size_t)WT_O * 1024; g.M = T_; g.N = 1024; g.K = 1024;
    EpiResid E; E.x = p.x; E.T1 = (bf16_t*)(p.ws + OFF_T1);
    pg8::gemm_phase<EpiResid, pg8::StaticOrder, true, true>((PG8_LAS unsigned char*)smem_all, g, S, E);
}

DEVI void conv_expert_weights(const Params& p, unsigned char* smem) {
    bf16_t* tile = (bf16_t*)smem;
    const int t = VT, ng = t & 31, kg = t >> 5;
    bf16_t* WGU = (bf16_t*)(p.ws + OFF_WGU); bf16_t* WD = (bf16_t*)(p.ws + OFF_WD);
    const int ntask = 257 * 3 * 32;
    for (int task = VB; task < ntask; task += VG) {
        const int e = task / 96, rem = task - e * 96, mat = rem >> 5, tl = rem & 31;
        const float* src; bf16_t* dst; int K, N, kt, nt;
        if (mat < 2) { K = 1024; N = 256; kt = tl >> 1; nt = tl & 1;
            src = (mat == 0) ? (e < 256 ? p.ew_gate + (size_t)e * 262144 : p.sw_gate) : (e < 256 ? p.ew_up + (size_t)e * 262144 : p.sw_up);
            dst = WGU + (size_t)e * 524288 + (size_t)(nt + mat) * 131072; }
        else { K = 256; N = 1024; kt = tl >> 3; nt = tl & 7;
            src = e < 256 ? p.ew_down + (size_t)e * 262144 : p.sw_down; dst = WD + (size_t)e * 262144; }
        const float* sp = src + (size_t)(kt * 64 + 4 * kg) * N + nt * 128 + 4 * ng;
        f32x4 rf[8];
#pragma unroll
        for (int i = 0; i < 4; ++i) { rf[i] = *(const f32x4*)(sp + (size_t)i * N); rf[4 + i] = *(const f32x4*)(sp + (size_t)(32 + i) * N); }
#pragma unroll
        for (int i = 0; i < 4; ++i) {
            u32x2 v0, v1;
            v0.x = pk2(rf[0][i], rf[1][i]); v0.y = pk2(rf[2][i], rf[3][i]); v1.x = pk2(rf[4][i], rf[5][i]); v1.y = pk2(rf[6][i], rf[7][i]);
            *(u32x2*)&tile[(4 * ng + i) * 72 + 4 * kg] = v0; *(u32x2*)&tile[(4 * ng + i) * 72 + 32 + 4 * kg] = v1;
        }
        __syncthreads();
        {
            const int n = t >> 1, hf = t & 1;
            bf16_t* dp = dst + (size_t)(nt * 128 + n) * K + kt * 64 + hf * 32;
#pragma unroll
            for (int j = 0; j < 4; ++j) *(u32x4*)(dp + 8 * j) = *(const u32x4*)&tile[n * 72 + hf * 32 + 8 * j];
        }
        __syncthreads();
    }
}

DEVI void phase7(const Params& p, unsigned char* smem) {
    const int t = VT, lane = t & 63, w = t >> 6;
    const bf16_t* T1 = (const bf16_t*)(p.ws + OFF_T1); bf16_t* X1b = (bf16_t*)(p.ws + OFF_X1B);
    for (int row = VB * 4 + w; row < T_; row += VG * 4) {
        f32x4 v[4]; float s = 0.f;
#pragma unroll
        for (int i = 0; i < 4; ++i) { v[i] = unpk4(*(const u32x2*)(T1 + (size_t)row * 1024 + i * 256 + lane * 4)); s += (v[i][0] + v[i][1]) + (v[i][2] + v[i][3]); }
#pragma unroll
        for (int o = 32; o > 0; o >>= 1) s += __shfl_xor(s, o);
        const float mean = s * (1.0f / 1024.0f); float s2 = 0.f;
#pragma unroll
        for (int i = 0; i < 4; ++i)
#pragma unroll
            for (int r = 0; r < 4; ++r) { const float d = v[i][r] - mean; s2 += d * d; }
#pragma unroll
        for (int o = 32; o > 0; o >>= 1) s2 += __shfl_xor(s2, o);
        const float rstd = rsqrtf(s2 * (1.0f / 1024.0f) + 1e-5f);
#pragma unroll
        for (int i = 0; i < 4; ++i) {
            const int col = i * 256 + lane * 4;
            const f32x4 g = *(const f32x4*)(p.ln1_g + col), bb = *(const f32x4*)(p.ln1_b + col);
            f32x4 y;
#pragma unroll
            for (int r = 0; r < 4; ++r) y[r] = (v[i][r] - mean) * rstd * g[r] + bb[r];
            *(u32x2*)(X1b + (size_t)row * 1024 + col) = pk4(y);
        }
    }
    conv_expert_weights(p, smem);
}

DEVI void phase8(const Params& p, unsigned char* smem) {
    GemmSmem& sm = *(GemmSmem*)smem;
    const int t = VT, lane = t & 63, w = t >> 6, wr = w >> 1, wc = w & 1, l15 = lane & 15, q = lane >> 4;
    const bf16_t* X1b = (const bf16_t*)(p.ws + OFF_X1B); const bf16_t* wt = (const bf16_t*)(p.ws + OFF_WT);
    float* LG = (float*)(p.ws + OFF_LOG);
    for (int tile = VB; tile < 256 * 2; tile += VG) {
        const int mtg = tile >> 1, ntg = tile & 1, m0 = mtg * 128, n0 = ntg * 128;
        const bf16_t* pa0 = X1b + (size_t)(m0 + (t >> 3)) * 1024 + gemm_src_chunk(t);
        const bf16_t* pb0 = wt + (size_t)(WT_R + n0 + (t >> 3)) * 1024 + gemm_src_chunk(t);
        const bf16_t* const pa[4] = {pa0, pa0 + 32 * 1024, pa0 + 64 * 1024, pa0 + 96 * 1024};
        const bf16_t* const pb[4] = {pb0, pb0 + 32 * 1024, pb0 + 64 * 1024, pb0 + 96 * 1024};
        f32x4 acc[4][4]; zero_acc(acc);
        gemm_kloop<true, 0>(acc, pa, pb, nullptr, 0, 16, sm);
#pragma unroll
        for (int mt = 0; mt < 4; ++mt)
#pragma unroll
            for (int nt = 0; nt < 4; ++nt) {
                const int row = m0 + wr * 64 + mt * 16 + l15, col = n0 + wc * 64 + (nt >> 1) * 32 + 8 * q + 4 * (nt & 1);
                *(f32x4*)(LG + (size_t)row * 256 + col) = acc[mt][nt];
            }
    }
}

DEVI unsigned f2ord(float f) { const unsigned u = __float_as_uint(f); return (u & 0x80000000u) ? ~u : (u | 0x80000000u); }
template <int CTRL> DEVI float dppf(float v) { const int x = __float_as_int(v); return __int_as_float(__builtin_amdgcn_update_dpp(x, x, CTRL, 0xf, 0xf, false)); }
template <int CTRL> DEVI void top2_merge(float& m1, float& m2) {
    const float p1 = dppf<CTRL>(m1), p2 = dppf<CTRL>(m2);
    const float n1 = fmaxf(m1, p1), n2 = fmaxf(fminf(m1, p1), fmaxf(m2, p2));
    m1 = n1; m2 = n2;
}
template <bool DRY> DEVI void phase9(const Params& p) {
    const int t = VT, lane = t & 63, w = t >> 6;
    const float* LG = (const float*)(p.ws + OFF_LOG);
    int* cnt = (int*)(p.ws + OFF_CNT); int* list = (int*)(p.ws + OFF_LIST); float* wl = (float*)(p.ws + OFF_WL);
    const int tstep = VG * 4;
    int tok = VB * 4 + w;
    const f32x4 rb = *(const f32x4*)(p.router_bias + 4 * lane);
    f32x4 lgn = {0.f, 0.f, 0.f, 0.f};
    if (tok < T_) lgn = *(const f32x4*)(LG + (size_t)tok * 256 + 4 * lane);
    const int mygrp = lane >> 3;
    int ppos = 0, pe = -1, ptk9 = 0; float pw = 0.f;
    for (; tok < T_; tok += tstep) {
        float sc[4], bi[4];
#pragma unroll
        for (int r = 0; r < 4; ++r) { sc[r] = sigmoidf_(lgn[r]); bi[r] = sc[r] + rb[r]; }
        { const int tn = tok + tstep; if (tn < T_) lgn = *(const f32x4*)(LG + (size_t)tn * 256 + 4 * lane); }
        float m1, m2;
        { const float h01 = fmaxf(bi[0], bi[1]), l01 = fminf(bi[0], bi[1]), h23 = fmaxf(bi[2], bi[3]), l23 = fminf(bi[2], bi[3]);
          m1 = fmaxf(h01, h23); m2 = fmaxf(fminf(h01, h23), fmaxf(l01, l23)); }
        top2_merge<0xB1>(m1, m2);
        top2_merge<0x4E>(m1, m2);
        top2_merge<0x141>(m1, m2);
        const float gown = m1 + m2;
        int rank = 0;
#pragma unroll
        for (int g2 = 0; g2 < 8; ++g2) {
            const float go = __builtin_bit_cast(float, __builtin_amdgcn_readlane(__builtin_bit_cast(int, gown), 8 * g2));
            rank += (go > gown || (go == gown && g2 < mygrp)) ? 1 : 0;
        }
        unsigned ck[4];
#pragma unroll
        for (int r = 0; r < 4; ++r) ck[r] = rank < 4 ? f2ord(bi[r]) : 0u;
        unsigned thr = 0u; bool exact = false;
#pragma unroll 1
        for (int bit = 31; bit >= 0; --bit) {
            const unsigned cnd = thr | (1u << bit);
            const int c8 = __popcll(__ballot(ck[0] >= cnd)) + __popcll(__ballot(ck[1] >= cnd)) + __popcll(__ballot(ck[2] >= cnd)) + __popcll(__ballot(ck[3] >= cnd));
            if (c8 >= 8) { thr = cnd; if (c8 == 8) { exact = true; break; } }
        }
        unsigned long long selm[4];
        if (exact) {
#pragma unroll
            for (int r = 0; r < 4; ++r) selm[r] = __ballot(ck[r] >= thr);
        } else {
            unsigned long long eq[4], any = 0ull; int need = 8;
#pragma unroll
            for (int r = 0; r < 4; ++r) { selm[r] = __ballot(ck[r] > thr); eq[r] = __ballot(ck[r] == thr); need -= __popcll(selm[r]); any |= eq[r]; }
            while (need > 0 && any != 0ull) {
                const int L = __builtin_ctzll(any); any &= any - 1ull;
#pragma unroll
                for (int r = 0; r < 4; ++r) if (((eq[r] >> L) & 1ull) != 0ull && need > 0) { selm[r] |= 1ull << L; --need; }
            }
        }
        float wsum = 0.f, myw = 0.f; int mye = 0, kk = 0;
#pragma unroll
        for (int r = 0; r < 4; ++r) {
            unsigned long long m = selm[r];
            while (m != 0ull) {
                const int L = __builtin_ctzll(m); m &= m - 1ull;
                const float sv = __builtin_bit_cast(float, __builtin_amdgcn_readlane(__builtin_bit_cast(int, sc[r]), L));
                wsum += sv;
                if (lane == kk) { mye = 4 * L + r; myw = sv; }
                ++kk;
            }
        }
        if (DRY) { asm volatile("" :: "v"(mye), "v"(myw), "v"(wsum)); }
        else if (lane < 8) {
            if (pe >= 0) { list[(size_t)pe * T_ + ppos] = ptk9; wl[(size_t)pe * T_ + ppos] = pw; }
            ppos = atomicAdd(&cnt[mye * CNT_STRIDE], 1); pe = mye; ptk9 = tok * 9 + lane; pw = myw / wsum * 2.5f;
        }
    }
    if (!DRY && lane < 8 && pe >= 0) { list[(size_t)pe * T_ + ppos] = ptk9; wl[(size_t)pe * T_ + ppos] = pw; }
}

DEVI void moe_prefix256(const Params& p, int* pre  , int xg) {
    const int tid = threadIdx.x;
    const int* cnt = (const int*)(p.ws + OFF_CNT);
    __syncthreads();
    if (tid < 64) {
        int v = 0;
        if (tid < 32) { const int c = __hip_atomic_load(&cnt[(xg + 8 * tid) * CNT_STRIDE], __ATOMIC_RELAXED, __HIP_MEMORY_SCOPE_AGENT); pre[40 + tid] = c; v = (c + 255) >> 8; }
        else if (tid == 32) { v = 16; pre[40 + 32] = T_; }
#pragma unroll
        for (int o = 1; o < 64; o <<= 1) { const int u = __shfl_up(v, o); if (tid >= o) v += u; }
        if (tid < 33) pre[tid + 1] = v;
        if (tid == 0) pre[0] = 0;
    }
    __syncthreads();
}
struct MoeSched {
    const int* pre; const unsigned char* ws; bool need_w;
    int* sbuf;
    int xg, jl, nloc, nsh, nitems;
    const char* Abase; int arow_bytes; bool by_token;
    const char* Bbase; size_t b_expert_bytes, b_unit_bytes;
    __device__ __forceinline__ bool next(int i, pg8::Unit& u) const {
        const int item = jl + i * nloc; if (item >= nitems) return false;
        u.pm = item >> nsh; u.pn = item - (u.pm << nsh);
        const int lane = (int)(threadIdx.x & 63), li = lane < 33 ? lane : 32;
        const int pv = pre[li], cv = pre[40 + li];
        const int gi = __popcll(__ballot(lane < 33 && pv <= u.pm)) - 1;
        const int pg = __builtin_amdgcn_readlane(pv, gi);
        u.ce = __builtin_amdgcn_readlane(cv, gi);
        u.e = gi < 32 ? xg + 8 * gi : 256; u.r0 = (gi < 32 ? 0 : xg * 4096) + (u.pm - pg) * 256;
        return true;
    }
    __device__ __forceinline__ void decode(const pg8::Unit& u, int& e, int& r0, int& ce) const { e = u.e; r0 = u.r0; ce = u.ce; }
    __device__ __forceinline__ int fill_issue(const pg8::Unit& u) const {
        int e, r0, ce; decode(u, e, r0, ce);
        const int pos = r0 + (int)(threadIdx.x & 255); const bool w = threadIdx.x >= 256;
        int v = w ? 0 : -1;
        if (pos < ce && !(w && !need_w)) {
            const unsigned off = (w ? (unsigned)OFF_WL : (unsigned)OFF_LIST) + ((unsigned)e * (unsigned)T_ + (unsigned)pos) * 4u;
            v = e < 256 ? *(const int*)(ws + off) : (w ? 0x3f800000 : pos * 9 + 8);
        }
        return v;
    }
    __device__ __forceinline__ void fill_write(int buf, int v) const { sbuf[(threadIdx.x >= 256 ? 768 : 0) + buf * 256 + (int)(threadIdx.x & 255)] = v; }
    __device__ __forceinline__ const char* a_base() const { return Abase; }
    __device__ __forceinline__ void a_rows(int buf, const int (&rowA)[2], const int (&colA)[2], unsigned& p00, unsigned& p01, unsigned& p10, unsigned& p11) const {
        const int* sb = sbuf + buf * 256; const int s0 = sb[0];
        int s4[4];
#pragma unroll
        for (int k = 0; k < 4; ++k) { int sl = sb[(k >> 1) * 128 + rowA[k & 1]]; if (sl < 0) sl = s0; s4[k] = sl; }
#pragma unroll
        for (int k = 0; k < 4; ++k) if (by_token) s4[k] = s4[k] / 9;
        p00 = (unsigned)s4[0] * (unsigned)arow_bytes + (unsigned)colA[0]; p01 = (unsigned)s4[1] * (unsigned)arow_bytes + (unsigned)colA[1];
        p10 = (unsigned)s4[2] * (unsigned)arow_bytes + (unsigned)colA[0]; p11 = (unsigned)s4[3] * (unsigned)arow_bytes + (unsigned)colA[1];
    }
    __device__ __forceinline__ const char* b_base(const pg8::Unit& u) const { int e, r0, ce; decode(u, e, r0, ce); return Bbase + (size_t)e * b_expert_bytes + (size_t)u.pn * b_unit_bytes; }
    __device__ __forceinline__ void a_ready(const pg8::Unit&) const {}
    __device__ __forceinline__ void done(const pg8::Unit&) const {}
};
struct EpiMoe1 {
    static constexpr bool PERM = true, AFTER_DRAIN = false, BJI = false;
    const MoeSched* S; bf16_t* H;
    __device__ __forceinline__ void operator()(const pg8::f32x4 (&acc)[2][2][4][2], const pg8::Unit& u, int wr, int wc, int fr, int fq, int buf) const {
        const int* sb = S->sbuf + buf * 256 + wr * 64 + fr;
#pragma unroll
        for (int ai = 0; ai < 2; ++ai) {
            int sl[4];
#pragma unroll
            for (int m = 0; m < 4; ++m) sl[m] = sb[ai * 128 + m * 16];
#pragma unroll
            for (int m = 0; m < 4; ++m) if (sl[m] >= 0) {
                f32x4 h0, h1;
#pragma unroll
                for (int r = 0; r < 4; ++r) { h0[r] = siluf_(acc[ai][0][m][0][r]) * acc[ai][1][m][0][r]; h1[r] = siluf_(acc[ai][0][m][1][r]) * acc[ai][1][m][1][r]; }
                *(u32x4*)(H + (size_t)sl[m] * 256 + u.pn * 128 + wc * 32 + 8 * fq) = pk8(h0, h1);
            }
            asm volatile("" ::: "memory");
        }
    }
};
struct EpiMoe2 {
    static constexpr bool PERM = true, AFTER_DRAIN = false, BJI = true;
    const MoeSched* S; unsigned char* YX;
    __device__ __forceinline__ void operator()(const pg8::f32x4 (&acc)[2][2][4][2], const pg8::Unit& u, int wr, int wc, int fr, int fq, int buf) const {
        const int* sb = S->sbuf + buf * 256 + wr * 64 + fr;
#pragma unroll
        for (int ai = 0; ai < 2; ++ai) {
            int sl[4]; float wg[4];
#pragma unroll
            for (int m = 0; m < 4; ++m) { sl[m] = sb[ai * 128 + m * 16]; wg[m] = __int_as_float(sb[768 + ai * 128 + m * 16]) * YX_SCALE; }
#pragma unroll
            for (int m = 0; m < 4; ++m) if (sl[m] >= 0) {
                u32x4 w8;
                w8.x = pk4_fp8(clamp4(acc[ai][0][m][0] * wg[m], 440.f)); w8.y = pk4_fp8(clamp4(acc[ai][0][m][1] * wg[m], 440.f));
                w8.z = pk4_fp8(clamp4(acc[ai][1][m][0] * wg[m], 440.f)); w8.w = pk4_fp8(clamp4(acc[ai][1][m][1] * wg[m], 440.f));
                *(u32x4*)(YX + (size_t)sl[m] * 1024 + u.pn * 256 + wc * 64 + 16 * fq) = w8;
            }
            asm volatile("" ::: "memory");
        }
    }
};
DEVI void moe_sched_init(const Params& p, MoeSched& S, int* pre) {
    S.pre = pre; S.ws = p.ws; S.need_w = false; S.sbuf = (int*)(smem_all_g + 2 * SMEM_HALF);
    S.xg = RB & 7; S.jl = RB >> 3; S.nloc = RG >> 3;
}
DEVI void phase10(const Params& p, unsigned char* smem_all) {
    int* pre = (int*)(smem_all + 131072);
    MoeSched S; moe_sched_init(p, S, pre); moe_prefix256(p, pre, S.xg);
    S.nsh = 1; S.nitems = pre[33] << 1; S.Abase = (const char*)(p.ws + OFF_X1B); S.arow_bytes = 2048; S.by_token = true;
    S.Bbase = (const char*)(p.ws + OFF_WGU); S.b_expert_bytes = (size_t)512 * 1024 * 2; S.b_unit_bytes = (size_t)256 * 1024 * 2;
    EpiMoe1 E; E.S = &S; E.H = (bf16_t*)(p.ws + OFF_H);
    pg8::gemm_phase_g<EpiMoe1, MoeSched, true, true>((PG8_LAS unsigned char*)smem_all, 1024, S, E);
}
DEVI void phase11(const Params& p, unsigned char* smem_all) {
    int* pre = (int*)(smem_all + 131072);
    MoeSched S; moe_sched_init(p, S, pre); moe_prefix256(p, pre, S.xg);
    S.nsh = 2; S.nitems = pre[33] << 2; S.Abase = (const char*)(p.ws + OFF_H); S.arow_bytes = 512; S.by_token = false;
    S.Bbase = (const char*)(p.ws + OFF_WD); S.b_expert_bytes = (size_t)1024 * 256 * 2; S.b_unit_bytes = (size_t)256 * 256 * 2;
    S.need_w = true;
    EpiMoe2 E; E.S = &S; E.YX = (unsigned char*)(p.ws + OFF_YX);
    pg8::gemm_phase_g<EpiMoe2, MoeSched, true, true>((PG8_LAS unsigned char*)smem_all, 256, S, E);
}

DEVI void phase12(const Params& p) {
    const int t = VT, lane = t & 63, w = t >> 6;
    const bf16_t* X1b = (const bf16_t*)(p.ws + OFF_X1B); const unsigned char* YX = (const unsigned char*)(p.ws + OFF_YX);
    for (int row = VB * 4 + w; row < T_; row += VG * 4) {
        f32x4 v[4]; float s = 0.f;
#pragma unroll
        for (int i = 0; i < 4; ++i) {
            const int col = i * 256 + lane * 4;
            f32x4 a = unpk4(*(const u32x2*)(X1b + (size_t)row * 1024 + col)) * ALPHA_;
            f32x4 ys = (f32x4){0.f, 0.f, 0.f, 0.f};
#pragma unroll
            for (int k = 0; k < 9; ++k) ys += unpk4_fp8(*(const unsigned*)(YX + ((size_t)row * 9 + k) * 1024 + col));
            a += ys * (1.0f / YX_SCALE);
            v[i] = a; s += (a[0] + a[1]) + (a[2] + a[3]);
        }
#pragma unroll
        for (int o = 32; o > 0; o >>= 1) s += __shfl_xor(s, o);
        const float mean = s * (1.0f / 1024.0f); float s2 = 0.f;
#pragma unroll
        for (int i = 0; i < 4; ++i)
#pragma unroll
            for (int r = 0; r < 4; ++r) { const float d = v[i][r] - mean; s2 += d * d; }
#pragma unroll
        for (int o = 32; o > 0; o >>= 1) s2 += __shfl_xor(s2, o);
        const float rstd = rsqrtf(s2 * (1.0f / 1024.0f) + 1e-5f);
#pragma unroll
        for (int i = 0; i < 4; ++i) {
            const int col = i * 256 + lane * 4;
            const f32x4 g = *(const f32x4*)(p.ln2_g + col), bb = *(const f32x4*)(p.ln2_b + col);
            f32x4 y;
#pragma unroll
            for (int r = 0; r < 4; ++r) y[r] = (v[i][r] - mean) * rstd * g[r] + bb[r];
            *(f32x4*)(p.out + (size_t)row * 1024 + col) = y;
        }
    }
}


#define XB_TMO      128
#define XB_XCNT(j)  (256  + 64 * (j))
#define XB_XSUB(j)  (1280 + 64 * (j))
#define XB_XGEN(j)  (2304 + 64 * (j))
#define XB_TOP      3328
#define XB_TOPGEN   3392
#define XCD_BAR_WORDS 3456
#define XB_SPIN_CAP (1u << 20)
#define LAS __attribute__((address_space(3)))
DEVI unsigned xb_ld(unsigned* p)              { return __hip_atomic_load(p, __ATOMIC_RELAXED, __HIP_MEMORY_SCOPE_AGENT); }
DEVI unsigned xb_add(unsigned* p, unsigned v) { return __hip_atomic_fetch_add(p, v, __ATOMIC_RELAXED, __HIP_MEMORY_SCOPE_AGENT); }
DEVI unsigned xb_xcc_id() { return (unsigned)__builtin_amdgcn_s_getreg((3 << 11) | 20) & 0xFu; }
#define XB_SPIN(cond, bar) do { unsigned _sp = 0; while (cond) { __builtin_amdgcn_s_sleep(1); \
    if ((++_sp & 255u) == 0u) { if (xb_ld(&(bar)[XB_TMO])) break; if (_sp > XB_SPIN_CAP) { atomicAdd(&(bar)[XB_TMO], 1u); break; } } } } while (0)
struct XcdBarrier { unsigned* bar; unsigned x; volatile LAS unsigned* st; };
DEVI XcdBarrier xcd_barrier_post(unsigned* bar, volatile LAS unsigned* st) {
    XcdBarrier b; b.bar = bar; b.x = xb_xcc_id(); b.st = st;
    if (threadIdx.x == 0) st[3] = xb_add(&bar[XB_XCNT(b.x)], 1u);
    return b;
}
DEVI void xcd_barrier_complete(unsigned* bar, unsigned x, unsigned& nloc, unsigned& nx) {
    const unsigned G = gridDim.x * gridDim.y * gridDim.z;
    unsigned sum, cnt, mine, sp = 0u;
    for (;;) {
        sum = 0u; cnt = 0u; mine = 0u;
#pragma unroll
        for (unsigned j = 0; j < 16; ++j) { const unsigned c = xb_ld(&bar[XB_XCNT(j)]); sum += c; cnt += (c > 0u) ? 1u : 0u; mine = (j == x) ? c : mine; }
        if (sum == G) break;
        __builtin_amdgcn_s_sleep(1);
        if ((++sp & 255u) == 0u) { if (xb_ld(&bar[XB_TMO])) break; if (sp > XB_SPIN_CAP) { atomicAdd(&bar[XB_TMO], 1u); break; } }
    }
    nloc = mine > 0u ? mine : 1u; nx = cnt > 0u ? cnt : 1u;
}
DEVI void xcd_barrier(const XcdBarrier& b) {
    asm volatile("s_waitcnt vmcnt(0)" ::: "memory");
    __syncthreads();
    if (threadIdx.x == 0) {
        unsigned* bar = b.bar;
        __builtin_amdgcn_s_waitcnt(0);
        unsigned nloc = b.st[0], nx = b.st[1];
        if (nloc == 0u) { xcd_barrier_complete(bar, b.x, nloc, nx); b.st[0] = nloc; b.st[1] = nx; }
        const unsigned old = xb_add(&bar[XB_XSUB(b.x)], 1u);
        const unsigned gen = old / nloc;
        if (old + 1u == (gen + 1u) * nloc) {
            __builtin_amdgcn_fence(__ATOMIC_RELEASE, "agent");
            asm volatile("s_waitcnt vmcnt(0)" ::: "memory");
            const unsigned og = xb_add(&bar[XB_TOP], 1u);
            const unsigned tg = og / nx;
            if (og + 1u == (tg + 1u) * nx) xb_add(&bar[XB_TOPGEN], 1u);
            else XB_SPIN(xb_ld(&bar[XB_TOPGEN]) == tg, bar);
            __builtin_amdgcn_fence(__ATOMIC_ACQUIRE, "agent");
            xb_add(&bar[XB_XGEN(b.x)], 1u);
            asm volatile("s_waitcnt vmcnt(0)" ::: "memory");
        } else {
            XB_SPIN(xb_ld(&bar[XB_XGEN(b.x)]) == gen, bar);
            __builtin_amdgcn_fence(__ATOMIC_ACQUIRE, "agent");
            asm volatile("s_waitcnt vmcnt(0)" ::: "memory");
        }
    }
    __syncthreads();
}
constexpr size_t OFF_BAR = 131072;

#ifndef DBG
#define DBG 0
#endif
DEVI void dump_f32(const Params& p, size_t off) {
    const f32x4* src = (const f32x4*)(p.ws + off); f32x4* dst = (f32x4*)p.out;
    for (int i = blockIdx.x * 256 + threadIdx.x; i < T_ * D_ / 4; i += gridDim.x * 256) dst[i] = src[i];
}
DEVI void dump_bf16(const Params& p, size_t off, int ld, int coff) {
    const bf16_t* src = (const bf16_t*)(p.ws + off);
    for (int i = blockIdx.x * 256 + threadIdx.x; i < T_ * D_; i += gridDim.x * 256) { const int row = i >> 10, col = i & 1023; p.out[i] = bf2f(src[(size_t)row * ld + coff + col]); }
}
DEVI float flat_bf(const Params& p, size_t off, size_t n, size_t i) { const bf16_t* b = (const bf16_t*)(p.ws + off); float a = 0.f; for (size_t j = i; j < n; j += (size_t)T_ * D_) a += bf2f(b[j]); return a; }
DEVI void dump_p1(const Params& p) {
    const size_t N = (size_t)T_ * D_;
    for (size_t i = (size_t)blockIdx.x * 256 + threadIdx.x; i < N; i += (size_t)gridDim.x * 256) {
        float a = 0.f;
        a += flat_bf(p, OFF_MG, 2 * N, i) + flat_bf(p, OFF_GS, 2 * N, i);
        a += flat_bf(p, OFF_QR, N / 2, i % (N / 2)) + flat_bf(p, OFF_KR, N / 2, i % (N / 2)) + flat_bf(p, OFF_QG, N / 2, i % (N / 2));
        a += flat_bf(p, OFF_KRT, N / 2, i % (N / 2)) + flat_bf(p, OFF_KGT, N / 2, i % (N / 2));
        a += flat_bf(p, OFF_VRT, N, i) + flat_bf(p, OFF_VGT, N, i);
        a += ((const float*)(p.ws + OFF_GA))[i % ((size_t)T_ * 16)];
        p.out[i] = a;
    }
}
constexpr int NPHASE = 13;
__global__ void __launch_bounds__(512, 2) fwd_megakernel(Params p) {
    unsigned char* const smem_all = smem_all_g;
    unsigned char* smem = smem_all + VH * SMEM_HALF;
    uint4* xb_words = (uint4*)(smem_all + 2 * SMEM_HALF - 16);
    if (threadIdx.x == 0) *xb_words = make_uint4(0u, 0u, blockIdx.x, 0u);
    __syncthreads();
    const XcdBarrier xb = xcd_barrier_post((unsigned*)(p.ws + OFF_BAR), (volatile LAS unsigned*)xb_words);
#ifndef REPMASK
#define REPMASK 0
#endif
#ifndef TIMEPHASE
#define TIMEPHASE -1
#endif
#define RUN_PHASE(K, CALL) do { if (p.phase_lo <= (K) && (K) < p.phase_hi) { \
        const unsigned long long tp0_ = (TIMEPHASE == (K)) ? __builtin_amdgcn_s_memrealtime() : 0ull; \
        _Pragma("unroll 1") for (int rep_ = ((REPMASK >> (K)) & 1); rep_ >= 0; --rep_) { CALL; if (rep_ > 0 || (K) + 1 < p.phase_hi) xcd_barrier(xb); } \
        if (TIMEPHASE == (K)) { const unsigned long long tp1_ = __builtin_amdgcn_s_memrealtime(); while (__builtin_amdgcn_s_memrealtime() - tp1_ < tp1_ - tp0_) __builtin_amdgcn_s_sleep(8); } } } while (0)
    RUN_PHASE(0, phase0(p, smem));
    if (p.phase_lo == 0 && p.phase_hi > 1) {
        if (threadIdx.x == 0) {
            unsigned* bar = (unsigned*)(p.ws + OFF_BAR); bool ok = (gridDim.x & 7u) == 0u && xb.x < 8u;
            for (unsigned j = 0; j < 16; ++j) { const unsigned c = xb_ld(&bar[XB_XCNT(j)]); ok = ok && (j < 8 ? c == gridDim.x / 8u : c == 0u); }
            if (ok) ((volatile int*)xb_words)[2] = (int)(((volatile unsigned*)xb_words)[3] * 8u + xb.x);
        }
        __syncthreads();
    }
    RUN_PHASE(1, phase1(p, smem_all));
#if DBG == 2
    dump_p1(p); return;
#endif
    RUN_PHASE(2, phase2(p, smem));
#if DBG == 5
    { const size_t N = (size_t)T_ * D_; for (size_t i = (size_t)blockIdx.x * 256 + threadIdx.x; i < N; i += (size_t)gridDim.x * 256) p.out[i] = flat_bf(p, OFF_KG2, N / 2, i % (N / 2)) + ((const float*)(p.ws + OFF_DEC))[i % (2048 * 128)]; } return;
#endif
#ifdef SCANPROBE
    phase3t(p, smem, 1); xcd_barrier(xb);
#endif
    RUN_PHASE(3, phase3t(p, smem, 0));
#if DBG == 6
    dump_bf16(p, OFF_OO, 2048, 1024); return;
#endif
#if DBG == 7
    { const bf16_t* src = (const bf16_t*)(p.ws + OFF_OO);
      for (int i = blockIdx.x * 256 + threadIdx.x; i < T_ * D_; i += gridDim.x * 256) { const int row = i >> 10, col = i & 1023; const float v = bf2f(src[(size_t)row * 2048 + 1024 + col]); p.out[i] = (fabsf(v) < 1e30f) ? v : 12345.0f; } } return;
#endif
    RUN_PHASE(4, phase4(p, smem));
#if DBG == 3
    dump_bf16(p, OFF_Y, 2048, 0); return;
#endif
#if DBG == 4
    dump_bf16(p, OFF_Y, 2048, 1024); return;
#endif
    RUN_PHASE(5, phase5(p, smem_all));
    RUN_PHASE(6, phase6(p, smem_all));
    RUN_PHASE(7, phase7(p, smem));
#if DBG == 1
    return;
#endif
    RUN_PHASE(8, phase8(p, smem));
#ifdef P9DRY
    RUN_PHASE(9, (phase9<true>(p), phase9<false>(p)));
#else
    RUN_PHASE(9, phase9<false>(p));
#endif
    RUN_PHASE(10, phase10(p, smem_all));
    RUN_PHASE(11, phase11(p, smem_all));
    RUN_PHASE(12, phase12(p));
#undef RUN_PHASE
}

extern "C" void kernel_launch(void* const* d_in, const int* in_sizes, int n_in, void* d_out, int out_size, void* d_ws, size_t ws_size,
                              hipStream_t stream) {
    static int grid_blocks = 0;
    if (!grid_blocks) {
        int dev = 0, cus = 0, per_cu = 0;
        hipGetDevice(&dev);
        hipDeviceGetAttribute(&cus, hipDeviceAttributeMultiprocessorCount, dev);
        hipOccupancyMaxActiveBlocksPerMultiprocessor(&per_cu, fwd_megakernel, 512, 0);
        if (per_cu > 1) per_cu = 1;
        if (per_cu < 1) per_cu = 1;
        grid_blocks = cus * per_cu;
    }
    if (ws_size < WS_NEEDED) { fprintf(stderr, "workspace too small: %zu < %zu\n", ws_size, (size_t)WS_NEEDED); return; }
    Params p{};
    p.x = (const float*)d_in[0]; p.w_in = (const float*)d_in[1]; p.ret_norm_g = (const float*)d_in[2]; p.gate_w2 = (const float*)d_in[3];
    p.gate_b = (const float*)d_in[4]; p.gla_norm_g = (const float*)d_in[5]; p.w_ret_out = (const float*)d_in[6]; p.w_gla_out = (const float*)d_in[7];
    p.w_o = (const float*)d_in[8]; p.ln1_g = (const float*)d_in[9]; p.ln1_b = (const float*)d_in[10]; p.router_w = (const float*)d_in[11];
    p.router_bias = (const float*)d_in[12]; p.ew_gate = (const float*)d_in[13]; p.ew_up = (const float*)d_in[14]; p.ew_down = (const float*)d_in[15];
    p.sw_gate = (const float*)d_in[16]; p.sw_up = (const float*)d_in[17]; p.sw_down = (const float*)d_in[18]; p.ln2_g = (const float*)d_in[19];
    p.ln2_b = (const float*)d_in[20];
    p.out = (float*)d_out; p.ws = (unsigned char*)d_ws; p.phase_lo = 0; p.phase_hi = NPHASE;
    void* args[] = {&p};
    (void)hipMemsetAsync((unsigned char*)d_ws + OFF_BAR, 0, XCD_BAR_WORDS * 4, stream);
    hipError_t e = hipLaunchCooperativeKernel((void*)fwd_megakernel, dim3(grid_blocks), dim3(512), args, 0, stream);
    if (e != hipSuccess) fprintf(stderr, "cooperative launch failed: %s (grid %d)\n", hipGetErrorString(e), grid_blocks);
}
```

```cpp
#include <hip/hip_runtime.h>
#include <hip/hip_cooperative_groups.h>
#include <cstdio>
#include <cstdint>
namespace cg = cooperative_groups;

typedef unsigned short bf16_t;
typedef short bf16x8 __attribute__((ext_vector_type(8)));
typedef float f32x4 __attribute__((ext_vector_type(4)));
typedef unsigned u32x2 __attribute__((ext_vector_type(2)));
typedef unsigned u32x4 __attribute__((ext_vector_type(4)));
#define DEVI __device__ __forceinline__
#define VH ((int)(threadIdx.x >> 8))
#define VT ((int)(threadIdx.x & 255))
#define RB (__builtin_amdgcn_readfirstlane(((const int*)(smem_all_g + 2 * SMEM_HALF - 16))[2]))
#define RG ((int)gridDim.x)
#define VB (RB * 2 + VH)
#define VG (RG * 2)

constexpr int T_ = 32768;
constexpr int D_ = 1024;
constexpr int DIN_ = 8208;
constexpr int NE_ = 256;
constexpr float ALPHA_ = 1.189207115002721f;
constexpr float KSCALE_ = 0.08838834764831845f;

constexpr size_t MB = 1ull << 20;
constexpr size_t OFF_CNT  = (size_t)766 << 20;
constexpr int CNT_STRIDE = 1024;
constexpr size_t OFF_CS   = 1 * MB;
constexpr size_t OFF_WT   = 3 * MB;
constexpr size_t FB = 27 * MB;
constexpr size_t OFF_QR   = FB + 0 * MB;
constexpr size_t OFF_KR   = FB + 32 * MB;
constexpr size_t OFF_VRT  = FB + 64 * MB;
constexpr size_t OFF_GS   = FB + 128 * MB;
constexpr size_t OFF_MG   = FB + 256 * MB;
constexpr size_t OFF_KRT  = FB + 384 * MB;
constexpr size_t OFF_QG   = FB + 416 * MB;
constexpr size_t OFF_VGT  = FB + 448 * MB;
constexpr size_t OFF_KGT  = FB + 512 * MB;
constexpr size_t OFF_GA   = FB + 544 * MB;
constexpr size_t OFF_XB   = FB + 546 * MB;
constexpr size_t OFF_KG2  = FB + 546 * MB;
constexpr size_t OFF_DEC  = FB + 578 * MB;
constexpr size_t OFF_OO   = FB + 579 * MB;
constexpr size_t OFF_Y    = FB + 384 * MB;
constexpr size_t OFF_MRG  = FB + 0 * MB;
constexpr size_t OFF_QGN  = 767 * MB;
constexpr size_t OFF_QFR  = 734 * MB;
constexpr size_t OFF_WGU  = 767 * MB;
constexpr size_t OFF_X1B  = FB + 0 * MB;
constexpr size_t OFF_WD   = FB + 64 * MB;
constexpr size_t OFF_LIST = FB + 193 * MB;
constexpr size_t OFF_WL   = FB + 193 * MB + 512 * MB;
constexpr size_t OFF_H    = FB + 227 * MB;
constexpr size_t OFF_YX   = FB + 371 * MB;
constexpr size_t OFF_T1   = FB + 371 * MB;
constexpr size_t WS_NEEDED = 1024 * MB;

constexpr int WT_BN = 0, WT_AT = 5888, WT_RET = 8960, WT_GLA = 9984, WT_O = 11008, WT_R = 12032, WT_ROWS = 12288;

struct Params {
    const float *x, *w_in, *ret_norm_g, *gate_w2, *gate_b, *gla_norm_g, *w_ret_out, *w_gla_out, *w_o, *ln1_g, *ln1_b,
                *router_w, *router_bias, *ew_gate, *ew_up, *ew_down, *sw_gate, *sw_up, *sw_down, *ln2_g, *ln2_b;
    float* out;
    unsigned char* ws;
    int phase_lo, phase_hi;
};

static __device__ const float c_inv_freq[64] = {
  1.000000000e+00f, 8.659643531e-01f, 7.498942018e-01f, 6.493816376e-01f,
  5.623413324e-01f, 4.869675338e-01f, 4.216965139e-01f, 3.651741147e-01f,
  3.162277639e-01f, 2.738419771e-01f, 2.371373773e-01f, 2.053525001e-01f,
  1.778279394e-01f, 1.539926529e-01f, 1.333521456e-01f, 1.154781953e-01f,
  1.000000015e-01f, 8.659642935e-02f, 7.498942316e-02f, 6.493816525e-02f,
  5.623413250e-02f, 4.869675264e-02f, 4.216964915e-02f, 3.651741147e-02f,
  3.162277490e-02f, 2.738419548e-02f, 2.371373773e-02f, 2.053525113e-02f,
  1.778279431e-02f, 1.539926510e-02f, 1.333521400e-02f, 1.154781971e-02f,
  9.999999776e-03f, 8.659643121e-03f, 7.498942316e-03f, 6.493816152e-03f,
  5.623413250e-03f, 4.869675264e-03f, 4.216964822e-03f, 3.651741194e-03f,
  3.162277630e-03f, 2.738419687e-03f, 2.371373819e-03f, 2.053525066e-03f,
  1.778279431e-03f, 1.539926510e-03f, 1.333521446e-03f, 1.154782018e-03f,
  1.000000047e-03f, 8.659643354e-04f, 7.498941850e-04f, 6.493816036e-04f,
  5.623413017e-04f, 4.869675322e-04f, 4.216965172e-04f, 3.651741135e-04f,
  3.162277571e-04f, 2.738419571e-04f, 2.371373703e-04f, 2.053525095e-04f,
  1.778279402e-04f, 1.539926598e-04f, 1.333521504e-04f, 1.154782003e-04f };

DEVI float bf2f(unsigned short u) { return __uint_as_float(((unsigned)u) << 16); }
DEVI float bflo(unsigned u) { return __uint_as_float(u << 16); }
DEVI float bfhi(unsigned u) { return __uint_as_float(u & 0xffff0000u); }
typedef float f32x2 __attribute__((ext_vector_type(2)));
typedef __bf16 bf16x2_t __attribute__((ext_vector_type(2)));
DEVI unsigned pk2(float lo, float hi) { const f32x2 v = {lo, hi}; const bf16x2_t b = __builtin_convertvector(v, bf16x2_t); return __builtin_bit_cast(unsigned, b); }
DEVI unsigned short f2bf(float f) { return (unsigned short)(pk2(f, 0.f) & 0xffffu); }
DEVI u32x2 pk4(f32x4 v) { u32x2 r; r.x = pk2(v[0], v[1]); r.y = pk2(v[2], v[3]); return r; }
DEVI f32x4 unpk4(u32x2 u) { f32x4 r; r[0] = bflo(u.x); r[1] = bfhi(u.x); r[2] = bflo(u.y); r[3] = bfhi(u.y); return r; }
constexpr float YX_SCALE = 16.0f;
DEVI unsigned pk4_fp8(f32x4 v) { int w = 0; w = __builtin_amdgcn_cvt_pk_fp8_f32(v[0], v[1], w, false); w = __builtin_amdgcn_cvt_pk_fp8_f32(v[2], v[3], w, true); return (unsigned)w; }
DEVI f32x4 unpk4_fp8(unsigned u) { f32x4 r; r[0] = __builtin_amdgcn_cvt_f32_fp8((int)u, 0); r[1] = __builtin_amdgcn_cvt_f32_fp8((int)u, 1); r[2] = __builtin_amdgcn_cvt_f32_fp8((int)u, 2); r[3] = __builtin_amdgcn_cvt_f32_fp8((int)u, 3); return r; }
DEVI f32x4 clamp4(f32x4 v, float lim) { f32x4 r; for (int i = 0; i < 4; ++i) r[i] = fminf(fmaxf(v[i], -lim), lim); return r; }
DEVI float sigmoidf_(float v) { return 1.0f / (1.0f + __expf(-v)); }
DEVI float siluf_(float v) { return v / (1.0f + __expf(-v)); }
DEVI float gamma_log2(int h) { return log2f(1.0f - exp2f(-5.0f - (float)h)); }
DEVI f32x4 mfma16(bf16x8 a, bf16x8 b, f32x4 c) { return __builtin_amdgcn_mfma_f32_16x16x32_bf16(a, b, c, 0, 0, 0); }
DEVI unsigned kf_off(int item, int dk, int m8) { return ((((unsigned)item * 4u + (unsigned)(dk >> 5)) * 4u + (unsigned)(m8 >> 4)) * 64u + (unsigned)((m8 >> 3) & 1) * 32u + (unsigned)(dk & 31)) * 8u; }
DEVI unsigned vf_off(int item, int dv, int m8) { return ((((unsigned)item * 8u + (unsigned)(dv >> 5)) * 4u + (unsigned)(m8 >> 4)) * 64u + (unsigned)((m8 >> 3) & 1) * 32u + (unsigned)(dv & 31)) * 8u; }
DEVI unsigned qf_off(int bc, int h, int tokl, int dk8, int hh) {
    return ((((((unsigned)bc * 4u + (unsigned)h) * 2u + (unsigned)(tokl >> 5)) * 4u + (unsigned)(dk8 >> 5)) * 2u + (unsigned)((dk8 >> 4) & 1)) * 64u + (unsigned)hh * 32u + (unsigned)(tokl & 31)) * 8u + (unsigned)((dk8 >> 3) & 1) * 4u; }
DEVI int vperm(int n) { const int wc = n >> 6, nt = (n >> 4) & 3, i = n & 15; return wc * 64 + (nt >> 1) * 32 + 8 * (i >> 2) + 4 * (nt & 1) + (i & 3); }
DEVI int dperm2(int v) { return ((v >> 5) & 1) * 64 + (v >> 6) * 32 + (v & 31); }
DEVI u32x4 pk8(f32x4 a, f32x4 b) { u32x4 r; r.x = pk2(a[0], a[1]); r.y = pk2(a[2], a[3]); r.z = pk2(b[0], b[1]); r.w = pk2(b[2], b[3]); return r; }
DEVI void unpk8(u32x4 u, f32x4& a, f32x4& b) { a[0] = bflo(u.x); a[1] = bfhi(u.x); a[2] = bflo(u.y); a[3] = bfhi(u.y); b[0] = bflo(u.z); b[1] = bfhi(u.z); b[2] = bflo(u.w); b[3] = bfhi(u.w); }
DEVI int dperm(int v) { const int wc = v >> 6, nt = (v >> 4) & 3, c = v & 15; return (nt & 1) * 16 + wc * 32 + c + (nt >> 1) * 64; }

struct __attribute__((aligned(16))) GemmSmem { bf16_t a[2][128 * 64]; bf16_t b[2][128 * 64]; };
constexpr int SMEM_GEMM = sizeof(GemmSmem);
constexpr int SMEM_BYTES = SMEM_GEMM + 2048 + 16;
constexpr int SMEM_HALF = (SMEM_BYTES + 255) & ~255;
constexpr int SMEM_MOE = 16384;
__shared__ __attribute__((aligned(16))) unsigned char smem_all_g[2 * SMEM_HALF + SMEM_MOE];
DEVI int gemm_src_chunk(int t) { return ((t & 7) ^ ((t >> 4) & 7)) * 8; }

template <bool SWAP, int BKIND>
DEVI void gemm_kloop(f32x4 (&acc)[4][4], const bf16_t* const (&pa)[4], const bf16_t* const (&pb)[4],
                     const float* pbf, int ldb, int nk, GemmSmem& sm) {
    const int t = VT, lane = t & 63, w = t >> 6, wr = w >> 1, wc = w & 1, l15 = lane & 15, q = lane >> 4;
    const int kg = t & 7, ng = t >> 3;
    f32x4 rf[8];
#define GEMM_ISSUE(BUF, KO) do { \
        _Pragma("unroll") for (int i = 0; i < 4; ++i) \
            __builtin_amdgcn_global_load_lds((const unsigned*)(pa[i] + (KO)), (unsigned*)((char*)sm.a[BUF] + i * 4096 + t * 16), 16, 0, 0); \
        if (BKIND == 0) { _Pragma("unroll") for (int i = 0; i < 4; ++i) \
            __builtin_amdgcn_global_load_lds((const unsigned*)(pb[i] + (KO)), (unsigned*)((char*)sm.b[BUF] + i * 4096 + t * 16), 16, 0, 0); } \
        else { const float* pp = pbf + (size_t)((KO) + 4 * kg) * ldb; \
            _Pragma("unroll") for (int i = 0; i < 4; ++i) { rf[i] = *(const f32x4*)(pp + (size_t)i * ldb); rf[4 + i] = *(const f32x4*)(pp + (size_t)(32 + i) * ldb); } } } while (0)
#define GEMM_LSTORE_B(BUF) do { if (BKIND == 1) { \
            _Pragma("unroll") for (int i = 0; i < 4; ++i) { \
                u32x2 v0, v1; \
                v0.x = pk2(rf[0][i], rf[1][i]); v0.y = pk2(rf[2][i], rf[3][i]); v1.x = pk2(rf[4][i], rf[5][i]); v1.y = pk2(rf[6][i], rf[7][i]); \
                const int n = 4 * ng + i, sw = (n >> 1) & 7; \
                char* rowp = (char*)sm.b[BUF] + n * 128 + (kg & 1) * 8; \
                *(u32x2*)(rowp + (((kg >> 1) ^ sw) * 16)) = v0; *(u32x2*)(rowp + (((4 + (kg >> 1)) ^ sw) * 16)) = v1; } } } while (0)
    GEMM_ISSUE(0, 0);
    GEMM_LSTORE_B(0);
    __syncthreads();
#define GEMM_KSTEP(CUR, KT) do { \
        const bool more = ((KT) + 1 < nk); \
        if (more) { GEMM_ISSUE((CUR) ^ 1, ((KT) + 1) * 64); } \
        __builtin_amdgcn_sched_barrier(0); \
        _Pragma("unroll") for (int ss = 0; ss < 2; ++ss) { \
            bf16x8 af[4], bfr[4]; \
            const int coff = ((ss * 4 + q) ^ (l15 >> 1)) * 16; \
            _Pragma("unroll") for (int i = 0; i < 4; ++i) { \
                af[i]  = *(const bf16x8*)((const char*)sm.a[CUR] + (wr * 64 + i * 16 + l15) * 128 + coff); \
                bfr[i] = *(const bf16x8*)((const char*)sm.b[CUR] + (wc * 64 + i * 16 + l15) * 128 + coff); } \
            _Pragma("unroll") for (int mt = 0; mt < 4; ++mt) \
                _Pragma("unroll") for (int nt = 0; nt < 4; ++nt) \
                    acc[mt][nt] = SWAP ? mfma16(bfr[nt], af[mt], acc[mt][nt]) : mfma16(af[mt], bfr[nt], acc[mt][nt]); } \
        __builtin_amdgcn_sched_barrier(0); \
        if (more) { GEMM_LSTORE_B((CUR) ^ 1); } \
        __syncthreads(); } while (0)
#pragma unroll 1
    for (int kt = 0; kt < nk; kt += 2) { GEMM_KSTEP(0, kt); GEMM_KSTEP(1, kt + 1); }
#undef GEMM_KSTEP
#undef GEMM_LSTORE_B
#undef GEMM_ISSUE
}

DEVI void zero_acc(f32x4 (&acc)[4][4]) {
#pragma unroll
    for (int i = 0; i < 4; ++i)
#pragma unroll
        for (int j = 0; j < 4; ++j) acc[i][j] = (f32x4){0.f, 0.f, 0.f, 0.f};
}

namespace pg8 {
#define PG8_LAS __attribute__((address_space(3)))
typedef unsigned short bf16_t;
typedef short bf16x8 __attribute__((ext_vector_type(8)));
typedef float f32x4 __attribute__((ext_vector_type(4)));
typedef unsigned u32x4 __attribute__((ext_vector_type(4)));
constexpr int BM = 256, BK = 64, HALF = 128, HTB = HALF * BK * 2  , STAGE_BYTES = 8 * HTB, NXCD = 8, WGM = 8;

__host__ __device__ __forceinline__ int lds_byte(int r, int c) { const int st = (r >> 4) * 2 + (c >> 5), rr = r & 15, cc = c & 31, ob = rr * 64 + cc * 2; return st * 1024 + (ob ^ (((ob >> 9) & 1) << 5)); }
__host__ __device__ __forceinline__ void stage_rc(int b, int& R, int& C) { const int st = b / 1024, sb = b % 1024, swz = sb ^ (((sb >> 9) & 1) << 5); R = (st >> 1) * 16 + swz / 64; C = (st & 1) * 32 + (swz % 64) / 2; }
__host__ __device__ __forceinline__ int perm32(int rho) { const int n = rho >> 4, i = rho & 15; return 8 * (i >> 2) + 4 * n + (i & 3); }

struct Unit { int pm, pn, e, r0, ce; };
struct Gemm { const bf16_t* A; const bf16_t* Bt; int M, N, K; };

struct StaticOrder {
    int nM, nN, nwg, G, c;
    __host__ __device__ void init(int M, int N, int G_, int c_) { nM = M / BM; nN = N / BM; nwg = nM * nN; G = G_; c = c_; }
    __host__ __device__ bool next(int i, Unit& u) const {
        const long L = (long)i * G + c; if (L >= nwg) return false;
        int wgid = (int)L; { const int q = nwg / NXCD, r = nwg % NXCD, xcd = wgid % NXCD, off = wgid / NXCD; wgid = (xcd < r ? xcd * (q + 1) : r * (q + 1) + (xcd - r) * q) + off; }
        const int nig = WGM * nN, gid = wgid / nig, fm = gid * WGM, gsz = (nM - fm) < WGM ? (nM - fm) : WGM;
        u.pm = fm + ((wgid % nig) % gsz); u.pn = (wgid % nig) / gsz; return true;
    }
    __device__ __forceinline__ void a_ready(const Unit&) const {}
    __device__ __forceinline__ void done(const Unit&) const {}
};


template <class Epi, class Sched, bool ALIGN_EPI = false, bool SP2 = false>
__device__ __forceinline__ void gemm_phase(PG8_LAS unsigned char* lds, const Gemm g, const Sched& S, const Epi& E) {
    const int tid = threadIdx.x, wid = __builtin_amdgcn_readfirstlane(tid >> 6), lane = tid & 63, wr = wid >> 2, wc = wid & 3, fr = lane & 15, fq = lane >> 4;
    const int K = g.K, nt = K / BK;
    unsigned voffA[2], voffB[2];
#pragma unroll
    for (int i = 0; i < 2; ++i) { int R, C; stage_rc(tid * 16 + i * 8192, R, C); const int Rb = Epi::PERM ? ((R & ~31) + perm32(R & 31)) : R;
        voffA[i] = (unsigned)(R * K + C) * 2u; voffB[i] = (unsigned)(Rb * K + C) * 2u; }
    const size_t kstep = (size_t)(BK * 2);
    const size_t hstep = (size_t)HALF * K * 2;
    const size_t tstep = 2 * hstep;
    const unsigned ldsw = (unsigned)wid * 1024u;
    const int aoff = lds_byte(wr * 64 + fr, fq * 8), boff = lds_byte(wc * 32 + fr, fq * 8);
#define PG8_SA(b, h) (((b) * 2 + (h)) * HTB)
#define PG8_SB(b, h) ((4 + (b) * 2 + (h)) * HTB)
#define PG8_STAGE(bufoff, gbase, voff) do { _Pragma("unroll") for (int _i = 0; _i < 2; ++_i) \
        __builtin_amdgcn_global_load_lds((const unsigned*)((const char*)(gbase) + (voff)[_i]), (PG8_LAS unsigned*)(lds + (bufoff) + ldsw + _i * 8192), 16, 0, 0); } while (0)
#define PG8_LDA(dst, b, h) do { _Pragma("unroll") for (int m = 0; m < 4; ++m) _Pragma("unroll") for (int k = 0; k < 2; ++k) dst[m][k] = *(const PG8_LAS bf16x8*)(lds + PG8_SA(b, h) + aoff + m * 2048 + k * 1024); } while (0)
#define PG8_LDB(dst, b, h) do { _Pragma("unroll") for (int n = 0; n < 2; ++n) _Pragma("unroll") for (int k = 0; k < 2; ++k) dst[n][k] = *(const PG8_LAS bf16x8*)(lds + PG8_SB(b, h) + boff + n * 2048 + k * 1024); } while (0)
#define PG8_MMA(ai, bj, At, Bt) do { __builtin_amdgcn_s_setprio(1); _Pragma("unroll") for (int m = 0; m < 4; ++m) _Pragma("unroll") for (int n = 0; n < 2; ++n) _Pragma("unroll") for (int k = 0; k < 2; ++k) \
        acc[ai][bj][m][n] = __builtin_amdgcn_mfma_f32_16x16x32_bf16(Bt[n][k], At[m][k], acc[ai][bj][m][n], 0, 0, 0); __builtin_amdgcn_s_setprio(0); } while (0)
#define PG8_WAIT_V(n) asm volatile("s_waitcnt vmcnt(" #n ")" ::: "memory")
#define PG8_WAIT_L(n) asm volatile("s_waitcnt lgkmcnt(" #n ")" ::: "memory")
#define PG8_BAR __builtin_amdgcn_s_barrier()
#define PG8_SCHED __builtin_amdgcn_sched_barrier(0)
    Unit cur, nxt; int ui = 0;
    if (!S.next(0, cur)) return;
    f32x4 acc[2][2][4][2];
#pragma unroll
    for (int a = 0; a < 2; ++a)
#pragma unroll
        for (int b = 0; b < 2; ++b)
#pragma unroll
            for (int m = 0; m < 4; ++m)
#pragma unroll
                for (int n = 0; n < 2; ++n) acc[a][b][m][n] = (f32x4){0.f, 0.f, 0.f, 0.f};
    bf16x8 At[4][2], B0[2][2], B1[2][2];
    const char* cA = (const char*)g.A + (size_t)cur.pm * tstep; const char* cB = (const char*)g.Bt + (size_t)cur.pn * tstep;
    S.a_ready(cur);
    if constexpr (SP2) {
        PG8_STAGE(PG8_SB(0, 0), cB, voffB); PG8_STAGE(PG8_SB(0, 1), cB + hstep, voffB); PG8_STAGE(PG8_SA(0, 0), cA, voffA); PG8_STAGE(PG8_SA(0, 1), cA + hstep, voffA);
        if (wr == 1) PG8_BAR;
        PG8_WAIT_V(2); PG8_BAR;
        PG8_STAGE(PG8_SB(1, 0), cB + kstep, voffB); PG8_STAGE(PG8_SA(1, 0), cA + kstep, voffA); PG8_STAGE(PG8_SB(1, 1), cB + hstep + kstep, voffB);
        PG8_WAIT_V(6); PG8_BAR;
    } else {
        PG8_STAGE(PG8_SB(0, 0), cB, voffB); PG8_STAGE(PG8_SA(0, 0), cA, voffA); PG8_STAGE(PG8_SB(0, 1), cB + hstep, voffB); PG8_STAGE(PG8_SA(0, 1), cA + hstep, voffA);
        if (wr == 1) PG8_BAR;
        PG8_WAIT_V(4); PG8_BAR;
        PG8_STAGE(PG8_SB(1, 0), cB + kstep, voffB); PG8_STAGE(PG8_SA(1, 0), cA + kstep, voffA); PG8_STAGE(PG8_SB(1, 1), cB + hstep + kstep, voffB);
        PG8_WAIT_V(6); PG8_BAR;
    }
    for (;;) {
        const bool has_next = S.next(ui + 1, nxt);
        const char* nA = has_next ? (const char*)g.A + (size_t)nxt.pm * tstep : cA; const char* nB = has_next ? (const char*)g.Bt + (size_t)nxt.pn * tstep : cB;
        for (int t = 0; t < nt; t += 2) {
            const bool last = (t == nt - 2);
            const char* a1 = cA + (size_t)(t + 1) * kstep;
            const char* a2 = last ? nA : cA + (size_t)(t + 2) * kstep; const char* b2 = last ? nB : cB + (size_t)(t + 2) * kstep;
            const char* a3 = a2 + kstep; const char* b3 = b2 + kstep;
            if (last && has_next) S.a_ready(nxt);
            if constexpr (SP2) {
            PG8_LDB(B0, 0, 0); PG8_LDB(B1, 0, 1); PG8_SCHED; PG8_LDA(At, 0, 0); PG8_STAGE(PG8_SA(1, 1), a1 + hstep, voffA);
            PG8_WAIT_V(8); PG8_WAIT_L(0); PG8_BAR; PG8_MMA(0, 0, At, B0); PG8_MMA(0, 1, At, B1); PG8_BAR; PG8_SCHED;
            PG8_LDA(At, 0, 1); PG8_STAGE(PG8_SB(0, 0), b2, voffB); PG8_STAGE(PG8_SB(0, 1), b2 + hstep, voffB); PG8_STAGE(PG8_SA(0, 0), a2, voffA);
            PG8_WAIT_V(8); PG8_WAIT_L(0); PG8_BAR; PG8_MMA(1, 0, At, B0); PG8_MMA(1, 1, At, B1); PG8_BAR; PG8_SCHED;
            PG8_LDB(B0, 1, 0); PG8_LDB(B1, 1, 1); PG8_SCHED; PG8_LDA(At, 1, 0); PG8_STAGE(PG8_SA(0, 1), a2 + hstep, voffA);
            PG8_WAIT_V(8); PG8_WAIT_L(0); PG8_BAR; PG8_MMA(0, 0, At, B0); PG8_MMA(0, 1, At, B1); PG8_BAR; PG8_SCHED;
            PG8_LDA(At, 1, 1); PG8_STAGE(PG8_SB(1, 0), b3, voffB); PG8_STAGE(PG8_SB(1, 1), b3 + hstep, voffB); PG8_STAGE(PG8_SA(1, 0), a3, voffA);
            PG8_WAIT_V(8); PG8_WAIT_L(0); PG8_BAR; PG8_MMA(1, 0, At, B0); PG8_MMA(1, 1, At, B1); PG8_BAR; PG8_SCHED;
            } else {
            PG8_LDB(B0, 0, 0); PG8_SCHED; PG8_LDA(At, 0, 0); PG8_STAGE(PG8_SA(1, 1), a1 + hstep, voffA);
            PG8_WAIT_L(8); PG8_BAR; PG8_WAIT_L(0); PG8_MMA(0, 0, At, B0); PG8_BAR; PG8_SCHED;
            PG8_LDB(B1, 0, 1); PG8_STAGE(PG8_SB(0, 0), b2, voffB);
            PG8_BAR; PG8_WAIT_L(0); PG8_MMA(0, 1, At, B1); PG8_BAR;
            PG8_LDA(At, 0, 1); PG8_STAGE(PG8_SA(0, 0), a2, voffA);
            PG8_BAR; PG8_WAIT_L(0); PG8_MMA(1, 0, At, B0); PG8_BAR; PG8_SCHED;
            PG8_STAGE(PG8_SB(0, 1), b2 + hstep, voffB);
            PG8_WAIT_V(6); PG8_BAR; PG8_MMA(1, 1, At, B1); PG8_BAR;
            PG8_LDB(B0, 1, 0); PG8_SCHED; PG8_LDA(At, 1, 0); PG8_STAGE(PG8_SA(0, 1), a2 + hstep, voffA);
            PG8_WAIT_L(8); PG8_BAR; PG8_WAIT_L(0); PG8_MMA(0, 0, At, B0); PG8_BAR; PG8_SCHED;
            PG8_LDB(B1, 1, 1); PG8_STAGE(PG8_SB(1, 0), b3, voffB);
            PG8_BAR; PG8_WAIT_L(0); PG8_MMA(0, 1, At, B1); PG8_BAR;
            PG8_LDA(At, 1, 1); PG8_STAGE(PG8_SA(1, 0), a3, voffA);
            PG8_BAR; PG8_WAIT_L(0); PG8_MMA(1, 0, At, B0); PG8_BAR; PG8_SCHED;
            PG8_STAGE(PG8_SB(1, 1), b3 + hstep, voffB);
            PG8_WAIT_V(6); PG8_BAR; PG8_MMA(1, 1, At, B1); PG8_BAR;
            }
        }
        if constexpr (ALIGN_EPI) { if (wr == 0) PG8_BAR; }
        if constexpr (!Epi::AFTER_DRAIN) { E(acc, cur, wr, wc, fr, fq); S.done(cur); }
        if (!has_next) break;
#pragma unroll
        for (int a = 0; a < 2; ++a)
#pragma unroll
            for (int b = 0; b < 2; ++b)
#pragma unroll
                for (int m = 0; m < 4; ++m)
#pragma unroll
                    for (int n = 0; n < 2; ++n) acc[a][b][m][n] = (f32x4){0.f, 0.f, 0.f, 0.f};
        cur = nxt; cA = nA; cB = nB; ++ui;
        if constexpr (ALIGN_EPI) { if (wr == 1) PG8_BAR; }
    }
    PG8_WAIT_V(0);
    if constexpr (!ALIGN_EPI) { if (wr == 0) PG8_BAR; }
    PG8_BAR;
    if constexpr (Epi::AFTER_DRAIN) { E.fused(acc, cur, wr, wc, fr, fq, lds, wid, lane); S.done(cur); }
#undef PG8_SA
#undef PG8_SB
#undef PG8_STAGE
#undef PG8_LDA
#undef PG8_LDB
#undef PG8_MMA
#undef PG8_WAIT_V
#undef PG8_WAIT_L
#undef PG8_BAR
#undef PG8_SCHED
}
template <class Epi, class Sched, bool ALIGN_EPI = false, bool SP2 = false>
__device__ __forceinline__ void gemm_phase_g(PG8_LAS unsigned char* lds, const int K, const Sched& S, const Epi& E) {
    const int tid = threadIdx.x, wid = __builtin_amdgcn_readfirstlane(tid >> 6), lane = tid & 63, wr = wid >> 2, wc = wid & 3, fr = lane & 15, fq = lane >> 4;
    const int nt = K / BK;
    unsigned voffB[2]; int rowA[2], colA[2];
#pragma unroll
    for (int i = 0; i < 2; ++i) { int R, C; stage_rc(tid * 16 + i * 8192, R, C); const int lc = perm32(R & 31);
        const int Rb = Epi::BJI ? (64 * (R >> 5) + 16 * (lc >> 3) + (lc & 7)) : (Epi::PERM ? ((R & ~31) + lc) : R);
        rowA[i] = R; colA[i] = C * 2; voffB[i] = (unsigned)(Rb * K + C) * 2u; }
    const size_t kstep = (size_t)(BK * 2);
    const size_t hstep = Epi::BJI ? (size_t)8 * K * 2 : (size_t)HALF * K * 2;
    const size_t tstep = 2 * hstep;
    const unsigned ldsw = (unsigned)wid * 1024u;
    const int aoff = lds_byte(wr * 64 + fr, fq * 8), boff = lds_byte(wc * 32 + fr, fq * 8);
#define PG8_SA(b, h) (((b) * 2 + (h)) * HTB)
#define PG8_SB(b, h) ((4 + (b) * 2 + (h)) * HTB)
#define PG8_STAGE(bufoff, gbase, voff) do { _Pragma("unroll") for (int _i = 0; _i < 2; ++_i) \
        __builtin_amdgcn_global_load_lds((const unsigned*)((const char*)(gbase) + (voff)[_i]), (PG8_LAS unsigned*)(lds + (bufoff) + ldsw + _i * 8192), 16, 0, 0); } while (0)
#define PG8_STAGEA(bufoff, P0, P1, koff) do { \
        __builtin_amdgcn_global_load_lds((const unsigned*)(Ab + (size_t)(P0) + (koff)), (PG8_LAS unsigned*)(lds + (bufoff) + ldsw), 16, 0, 0); \
        __builtin_amdgcn_global_load_lds((const unsigned*)(Ab + (size_t)(P1) + (koff)), (PG8_LAS unsigned*)(lds + (bufoff) + ldsw + 8192), 16, 0, 0); } while (0)
#define PG8_LDA(dst, b, h) do { _Pragma("unroll") for (int m = 0; m < 4; ++m) _Pragma("unroll") for (int k = 0; k < 2; ++k) dst[m][k] = *(const PG8_LAS bf16x8*)(lds + PG8_SA(b, h) + aoff + m * 2048 + k * 1024); } while (0)
#define PG8_LDB(dst, b, h) do { _Pragma("unroll") for (int n = 0; n < 2; ++n) _Pragma("unroll") for (int k = 0; k < 2; ++k) dst[n][k] = *(const PG8_LAS bf16x8*)(lds + PG8_SB(b, h) + boff + n * 2048 + k * 1024); } while (0)
#define PG8_MMA(ai, bj, At, Bt) do { __builtin_amdgcn_s_setprio(1); _Pragma("unroll") for (int m = 0; m < 4; ++m) _Pragma("unroll") for (int n = 0; n < 2; ++n) _Pragma("unroll") for (int k = 0; k < 2; ++k) \
        acc[ai][bj][m][n] = __builtin_amdgcn_mfma_f32_16x16x32_bf16(Bt[n][k], At[m][k], acc[ai][bj][m][n], 0, 0, 0); __builtin_amdgcn_s_setprio(0); } while (0)
#define PG8_WAIT_V(n) asm volatile("s_waitcnt vmcnt(" #n ")" ::: "memory")
#define PG8_WAIT_L(n) asm volatile("s_waitcnt lgkmcnt(" #n ")" ::: "memory")
#define PG8_BAR __builtin_amdgcn_s_barrier()
#define PG8_SCHED __builtin_amdgcn_sched_barrier(0)
    Unit cur, nxt, un2; int ui = 0, sb_cur = 0;
    if (!S.next(0, cur)) return;
    int fillv = S.fill_issue(cur); S.fill_write(0, fillv);
    __syncthreads();
    bool has_next = S.next(1, nxt);
    fillv = 0; if (has_next) fillv = S.fill_issue(nxt);
    f32x4 acc[2][2][4][2];
#pragma unroll
    for (int a = 0; a < 2; ++a)
#pragma unroll
        for (int b = 0; b < 2; ++b)
#pragma unroll
            for (int m = 0; m < 4; ++m)
#pragma unroll
                for (int n = 0; n < 2; ++n) acc[a][b][m][n] = (f32x4){0.f, 0.f, 0.f, 0.f};
    bf16x8 At[4][2], B0[2][2], B1[2][2];
    const char* cB = S.b_base(cur);
    unsigned cA00, cA01, cA10, cA11, nA00, nA01, nA10, nA11;
    const char* const Ab = S.a_base();
    S.a_rows(0, rowA, colA, cA00, cA01, cA10, cA11);
    S.a_ready(cur);
    if constexpr (SP2) {
        PG8_STAGE(PG8_SB(0, 0), cB, voffB); PG8_STAGE(PG8_SB(0, 1), cB + hstep, voffB); PG8_STAGEA(PG8_SA(0, 0), cA00, cA01, 0); PG8_STAGEA(PG8_SA(0, 1), cA10, cA11, 0);
        if (wr == 1) PG8_BAR;
        PG8_WAIT_V(2); PG8_BAR;
        PG8_STAGE(PG8_SB(1, 0), cB + kstep, voffB); PG8_STAGEA(PG8_SA(1, 0), cA00, cA01, kstep); PG8_STAGE(PG8_SB(1, 1), cB + hstep + kstep, voffB);
        PG8_WAIT_V(6); PG8_BAR;
    } else {
        PG8_STAGE(PG8_SB(0, 0), cB, voffB); PG8_STAGEA(PG8_SA(0, 0), cA00, cA01, 0); PG8_STAGE(PG8_SB(0, 1), cB + hstep, voffB); PG8_STAGEA(PG8_SA(0, 1), cA10, cA11, 0);
        if (wr == 1) PG8_BAR;
        PG8_WAIT_V(4); PG8_BAR;
        PG8_STAGE(PG8_SB(1, 0), cB + kstep, voffB); PG8_STAGEA(PG8_SA(1, 0), cA00, cA01, kstep); PG8_STAGE(PG8_SB(1, 1), cB + hstep + kstep, voffB);
        PG8_WAIT_V(6); PG8_BAR;
    }
    for (;;) {
        const char* nB = has_next ? S.b_base(nxt) : cB;
        const int sb_n = sb_cur == 2 ? 0 : sb_cur + 1;
        bool has2 = false;
        if (has_next) { S.fill_write(sb_n, fillv); has2 = S.next(ui + 2, un2); if (has2) fillv = S.fill_issue(un2); }
        nA00 = cA00; nA01 = cA01; nA10 = cA10; nA11 = cA11;
#pragma unroll 1
        for (int t = 0; t < nt; t += 2) {
            const bool last = (t == nt - 2);
            const size_t k1 = (size_t)(t + 1) * kstep;
            const size_t k2 = last ? 0 : (size_t)(t + 2) * kstep; const char* b2 = last ? nB : cB + (size_t)(t + 2) * kstep;
            const unsigned q00 = last ? nA00 : cA00, q01 = last ? nA01 : cA01, q10 = last ? nA10 : cA10, q11 = last ? nA11 : cA11;
            const size_t k3 = k2 + kstep; const char* b3 = b2 + kstep;
            if (last && has_next) S.a_ready(nxt);
            if constexpr (SP2) {
            PG8_LDB(B0, 0, 0); PG8_LDB(B1, 0, 1); PG8_SCHED; PG8_LDA(At, 0, 0); PG8_STAGEA(PG8_SA(1, 1), cA10, cA11, k1);
            PG8_WAIT_V(8); PG8_WAIT_L(0); PG8_BAR; PG8_MMA(0, 0, At, B0); PG8_MMA(0, 1, At, B1); PG8_BAR; PG8_SCHED;
            PG8_LDA(At, 0, 1); PG8_STAGE(PG8_SB(0, 0), b2, voffB); PG8_STAGE(PG8_SB(0, 1), b2 + hstep, voffB); PG8_STAGEA(PG8_SA(0, 0), q00, q01, k2);
            PG8_WAIT_V(8); PG8_WAIT_L(0); PG8_BAR; PG8_MMA(1, 0, At, B0); PG8_MMA(1, 1, At, B1); PG8_BAR; PG8_SCHED;
            PG8_LDB(B0, 1, 0); PG8_LDB(B1, 1, 1); PG8_SCHED; PG8_LDA(At, 1, 0); PG8_STAGEA(PG8_SA(0, 1), q10, q11, k2);
            PG8_WAIT_V(8); PG8_WAIT_L(0); PG8_BAR; PG8_MMA(0, 0, At, B0); PG8_MMA(0, 1, At, B1); PG8_BAR; PG8_SCHED;
            PG8_LDA(At, 1, 1); PG8_STAGE(PG8_SB(1, 0), b3, voffB); PG8_STAGE(PG8_SB(1, 1), b3 + hstep, voffB); PG8_STAGEA(PG8_SA(1, 0), q00, q01, k3);
            PG8_WAIT_V(8); PG8_WAIT_L(0); PG8_BAR; PG8_MMA(1, 0, At, B0); PG8_MMA(1, 1, At, B1); PG8_BAR; PG8_SCHED;
            } else {
            PG8_LDB(B0, 0, 0); PG8_SCHED; PG8_LDA(At, 0, 0); PG8_STAGEA(PG8_SA(1, 1), cA10, cA11, k1);
            PG8_WAIT_L(8); PG8_BAR; PG8_WAIT_L(0); PG8_MMA(0, 0, At, B0); PG8_BAR; PG8_SCHED;
            PG8_LDB(B1, 0, 1); PG8_STAGE(PG8_SB(0, 0), b2, voffB);
            PG8_BAR; PG8_WAIT_L(0); PG8_MMA(0, 1, At, B1); PG8_BAR;
            PG8_LDA(At, 0, 1); PG8_STAGEA(PG8_SA(0, 0), q00, q01, k2);
            PG8_BAR; PG8_WAIT_L(0); PG8_MMA(1, 0, At, B0); PG8_BAR; PG8_SCHED;
            PG8_STAGE(PG8_SB(0, 1), b2 + hstep, voffB);
            PG8_WAIT_V(6); PG8_BAR; PG8_MMA(1, 1, At, B1); PG8_BAR;
            PG8_LDB(B0, 1, 0); PG8_SCHED; PG8_LDA(At, 1, 0); PG8_STAGEA(PG8_SA(0, 1), q10, q11, k2);
            PG8_WAIT_L(8); PG8_BAR; PG8_WAIT_L(0); PG8_MMA(0, 0, At, B0); PG8_BAR; PG8_SCHED;
            PG8_LDB(B1, 1, 1); PG8_STAGE(PG8_SB(1, 0), b3, voffB);
            PG8_BAR; PG8_WAIT_L(0); PG8_MMA(0, 1, At, B1); PG8_BAR;
            PG8_LDA(At, 1, 1); PG8_STAGEA(PG8_SA(1, 0), q00, q01, k3);
            PG8_BAR; PG8_WAIT_L(0); PG8_MMA(1, 0, At, B0); PG8_BAR; PG8_SCHED;
            PG8_STAGE(PG8_SB(1, 1), b3 + hstep, voffB);
            PG8_WAIT_V(6); PG8_BAR; PG8_MMA(1, 1, At, B1); PG8_BAR;
            }
            if (t == nt - 4 && has_next) S.a_rows(sb_n, rowA, colA, nA00, nA01, nA10, nA11);
        }
        if constexpr (ALIGN_EPI) { if (wr == 0) PG8_BAR; }
        if constexpr (!Epi::AFTER_DRAIN) { E(acc, cur, wr, wc, fr, fq, sb_cur); S.done(cur); }
        if (!has_next) break;
#pragma unroll
        for (int a = 0; a < 2; ++a)
#pragma unroll
            for (int b = 0; b < 2; ++b)
#pragma unroll
                for (int m = 0; m < 4; ++m)
#pragma unroll
                    for (int n = 0; n < 2; ++n) acc[a][b][m][n] = (f32x4){0.f, 0.f, 0.f, 0.f};
        cur = nxt; nxt = un2; has_next = has2; cA00 = nA00; cA01 = nA01; cA10 = nA10; cA11 = nA11; cB = nB; ++ui; sb_cur = sb_n;
        if constexpr (ALIGN_EPI) { if (wr == 1) PG8_BAR; }
    }
    PG8_WAIT_V(0);
    if constexpr (!ALIGN_EPI) { if (wr == 0) PG8_BAR; }
    PG8_BAR;
    if constexpr (Epi::AFTER_DRAIN) { E.fused(acc, cur, wr, wc, fr, fq, lds, wid, lane); S.done(cur); }
#undef PG8_SA
#undef PG8_SB
#undef PG8_STAGE
#undef PG8_STAGEA
#undef PG8_LDA
#undef PG8_LDB
#undef PG8_MMA
#undef PG8_WAIT_V
#undef PG8_WAIT_L
#undef PG8_BAR
#undef PG8_SCHED
}
}

DEVI void wt_colinfo(const Params& p, int R, const float*& src, int& ld, float& scale) {
    scale = 1.0f; src = nullptr; ld = 0;
    if (R < WT_AT) {
        const int pn = R >> 8, cl = R & 255; ld = DIN_; int col = -1;
        if (pn < 4) { const int wcq = (cl >> 5) & 3; col = (pn >> 1) * 512 + (2 * (pn & 1) + (wcq >> 1)) * 128 + 64 * (cl >> 7) + 32 * (wcq & 1) + (cl & 31);
                      if (pn >= 2) scale = KSCALE_; }
        else if (pn < 8)  col = 2048 + (pn - 4) * 256 + cl;
        else if (pn < 10) { col = 3072 + (pn - 8) * 256 + cl; scale = KSCALE_; }
        else if (pn < 14) col = 5120 + (pn - 10) * 256 + cl;
        else if (pn < 22) col = 6160 + (pn - 14) * 256 + cl;
        else if (cl < 16) col = 6144 + cl;
        if (col >= 0) src = p.w_in + col;
    } else if (R < WT_RET) {
        const int Rr = R - WT_AT, pm = Rr >> 8, rl = Rr & 255; ld = DIN_; int col;
        if (pm < 2) { col = 512 + (2 * pm + ((rl >> 6) & 1)) * 128 + 64 * (rl >> 7) + (rl & 63); scale = KSCALE_; }
        else if (pm < 6)  col = 1024 + (pm - 2) * 256 + rl;
        else if (pm < 10) col = 4096 + (pm - 6) * 256 + rl;
        else              col = 3584 + (pm - 10) * 256 + rl;
        src = p.w_in + col;
    } else {
        int Rr, ldd; const float* base;
        if (R < WT_GLA)    { Rr = R - WT_RET; base = p.w_ret_out; ldd = 1024; }
        else if (R < WT_O) { Rr = R - WT_GLA; base = p.w_gla_out; ldd = 1024; }
        else if (R < WT_R) { Rr = R - WT_O;   base = p.w_o;       ldd = 1024; }
        else               { Rr = R - WT_R;   base = p.router_w;  ldd = 256; }
        src = base + ((R >= WT_R) ? ((Rr & ~127) + vperm(Rr & 127)) : Rr); ld = ldd;
    }
}

DEVI void phase0(const Params& p, unsigned char* smem) {
    const int tid = VT, nb = VG, bid = VB;
    float2* cs = (float2*)(p.ws + OFF_CS);
    for (int i = bid * 256 + tid; i < 4096 * 64; i += nb * 256) {
        const int pos = i >> 6, k = i & 63;
        const float angf = (float)pos * c_inv_freq[k];
        const double a = (double)angf;
        const double TWO_PI = 6.283185307179586476925286766559, HALF_PI = 1.5707963267948966192313216916398;
        const double kk = rint(a * (1.0 / TWO_PI));
        const double r = a - kk * TWO_PI;
        const double qd = rint(r * (1.0 / HALF_PI));
        const double y = r - qd * HALF_PI;
        const double y2 = y * y;
        double sn = y * (1.0 + y2 * (-1.0 / 6 + y2 * (1.0 / 120 + y2 * (-1.0 / 5040 + y2 * (1.0 / 362880 + y2 * (-1.0 / 39916800 + y2 * (1.0 / 6227020800.0)))))));
        double cn = 1.0 + y2 * (-0.5 + y2 * (1.0 / 24 + y2 * (-1.0 / 720 + y2 * (1.0 / 40320 + y2 * (-1.0 / 3628800 + y2 * (1.0 / 479001600.0))))));
        const int qi = ((int)qd) & 3;
        double s, c;
        if (qi == 0) { s = sn; c = cn; } else if (qi == 1) { s = cn; c = -sn; } else if (qi == 2) { s = -sn; c = -cn; } else { s = -cn; c = sn; }
        cs[i] = make_float2((float)c, (float)s);
    }
    if (bid == 0) { int* cnt = (int*)(p.ws + OFF_CNT); cnt[tid * CNT_STRIDE] = 0; }
    {
        const f32x4* xs = (const f32x4*)p.x; u32x4* xd = (u32x4*)(p.ws + OFF_XB);
        const int n8 = T_ * D_ / 8;
        for (int g = bid * 256 + tid; g < n8; g += nb * 256) {
            const f32x4 v0 = xs[2 * g], v1 = xs[2 * g + 1];
            u32x4 o; o.x = pk2(v0[0], v0[1]); o.y = pk2(v0[2], v0[3]); o.z = pk2(v1[0], v1[1]); o.w = pk2(v1[2], v1[3]);
            xd[g] = o;
        }
    }
    {
        float* tile = (float*)smem;
        bf16_t* wt = (bf16_t*)(p.ws + OFF_WT);
        const int ntask = (WT_ROWS / 64) * 16;
        for (int task = bid; task < ntask; task += nb) {
            const int rt = task >> 4, kt = task & 15, R0 = rt * 64, k0 = kt * 64;
            {
                const int n = tid & 63, kq = tid >> 6;
                const float* src; int ld; float sc; wt_colinfo(p, R0 + n, src, ld, sc);
#pragma unroll
                for (int i = 0; i < 16; ++i) { const int k = kq + 4 * i; tile[k * 65 + n] = src ? src[(size_t)(k0 + k) * ld] * sc : 0.f; }
            }
            __syncthreads();
            {
                const int n = tid >> 2, ks = (tid & 3) * 16;
                unsigned o[8];
#pragma unroll
                for (int j = 0; j < 8; ++j) o[j] = pk2(tile[(ks + 2 * j) * 65 + n], tile[(ks + 2 * j + 1) * 65 + n]);
                u32x4* dst = (u32x4*)(wt + (size_t)(R0 + n) * 1024 + k0 + ks);
                dst[0] = (u32x4){o[0], o[1], o[2], o[3]}; dst[1] = (u32x4){o[4], o[5], o[6], o[7]};
            }
            __syncthreads();
        }
    }
}

struct EpiP1N {
    static constexpr bool PERM = true, AFTER_DRAIN = false;
    unsigned char* ws;
    __device__ __forceinline__ void operator()(const pg8::f32x4 (&acc)[2][2][4][2], const pg8::Unit& u, int wr, int wc, int fr, int fq) const {
        const int pn = u.pn, row0 = u.pm * 256 + wr * 64 + fr, c8 = wc * 32 + 8 * fq;
        if (pn < 4) {
            const float2* cs = (const float2*)(ws + OFF_CS); bf16_t* Qr = (bf16_t*)(ws + (pn < 2 ? OFF_QR : OFF_KR));
            const int head = 2 * (pn & 1) + (wc >> 1), d0 = 32 * (wc & 1) + 8 * fq;
#pragma unroll
            for (int ai = 0; ai < 2; ++ai)
#pragma unroll
                for (int m = 0; m < 4; ++m) {
                    const size_t row = row0 + ai * 128 + m * 16; const int pos = (int)(row & 4095);
                    f32x4 c4[4];
#pragma unroll
                    for (int j = 0; j < 4; ++j) c4[j] = *(const f32x4*)(cs + pos * 64 + d0 + 2 * j);
                    f32x4 o1[2], o2[2];
#pragma unroll
                    for (int n = 0; n < 2; ++n)
#pragma unroll
                        for (int r = 0; r < 4; ++r) {
                            const f32x4 cc = c4[2 * n + (r >> 1)]; const float c_ = cc[(r & 1) * 2], s_ = cc[(r & 1) * 2 + 1];
                            const float x1 = acc[ai][0][m][n][r], x2 = acc[ai][1][m][n][r];
                            o1[n][r] = x1 * c_ - x2 * s_; o2[n][r] = x1 * s_ + x2 * c_;
                        }
                    *(u32x4*)(Qr + row * 512 + head * 128 + d0) = pk8(o1[0], o1[1]);
                    *(u32x4*)(Qr + row * 512 + head * 128 + 64 + d0) = pk8(o2[0], o2[1]);
                    asm volatile("" ::: "memory");
                }
        } else {
#pragma unroll
            for (int ai = 0; ai < 2; ++ai)
#pragma unroll
                for (int m = 0; m < 4; ++m) {
                    const size_t row = row0 + ai * 128 + m * 16;
#pragma unroll
                    for (int bj = 0; bj < 2; ++bj) {
                        const int cl = bj * 128 + c8;
                        f32x4 v0 = acc[ai][bj][m][0], v1 = acc[ai][bj][m][1];
                        if (pn < 8) {
#pragma unroll
                            for (int r = 0; r < 4; ++r) { v0[r] = siluf_(v0[r]); v1[r] = siluf_(v1[r]); }
                            *(u32x4*)((bf16_t*)(ws + OFF_GS) + row * 2048 + (pn - 4) * 256 + cl) = pk8(v0, v1);
                        } else if (pn < 10) {
                            *(u32x4*)((bf16_t*)(ws + OFF_QGN) + row * 512 + (pn - 8) * 256 + cl) = pk8(v0, v1);
                        } else if (pn < 14) {
#pragma unroll
                            for (int r = 0; r < 4; ++r) { v0[r] = siluf_(v0[r]); v1[r] = siluf_(v1[r]); }
                            *(u32x4*)((bf16_t*)(ws + OFF_GS) + row * 2048 + 1024 + (pn - 10) * 256 + cl) = pk8(v0, v1);
                        } else if (pn < 22) {
#pragma unroll
                            for (int r = 0; r < 4; ++r) { v0[r] = sigmoidf_(v0[r]); v1[r] = sigmoidf_(v1[r]); }
                            *(u32x4*)((bf16_t*)(ws + OFF_MG) + row * 2048 + (pn - 14) * 256 + cl) = pk8(v0, v1);
                        } else if (cl < 16) {
                            int frl = fr; asm volatile("" : "+v"(frl));
                            const unsigned ofs = (unsigned)OFF_GA + ((unsigned)(u.pm * 256 + wr * 64 + frl + ai * 128 + m * 16) * 16u + (unsigned)cl) * 4u;
                            *(f32x4*)(ws + ofs) = v0; *(f32x4*)(ws + ofs + 16) = v1;
                        }
                    }
                    asm volatile("" ::: "memory");
                }
        }
    }
};
struct EpiP1V {
    static constexpr bool PERM = true, AFTER_DRAIN = false;
    unsigned char* ws;
    __device__ __forceinline__ void operator()(const pg8::f32x4 (&acc)[2][2][4][2], const pg8::Unit& u, int wr, int wc, int fr, int fq) const {
        bf16_t* dst = (bf16_t*)(ws + (u.pm < 4 ? OFF_VRT : OFF_VGT)); const int head = u.pm & 3;
#pragma unroll
        for (int bj = 0; bj < 2; ++bj) {
            const int tok0 = u.pn * 256 + bj * 128 + wc * 32 + 8 * fq; const int item = (tok0 >> 6) * 4 + head, m0 = tok0 & 63;
#pragma unroll
            for (int ai = 0; ai < 2; ++ai)
#pragma unroll
                for (int m = 0; m < 4; ++m) {
                    *(u32x4*)(dst + vf_off(item, ai * 128 + wr * 64 + m * 16 + fr, m0)) = pk8(acc[ai][bj][m][0], acc[ai][bj][m][1]);
                    asm volatile("" ::: "memory");
                }
        }
    }
};
struct EpiP1G {
    static constexpr bool PERM = true, AFTER_DRAIN = false;
    unsigned char* ws;
    __device__ __forceinline__ void operator()(const pg8::f32x4 (&acc)[2][2][4][2], const pg8::Unit& u, int wr, int wc, int fr, int fq) const {
        bf16_t* dst = (bf16_t*)(ws + OFF_KGT);
#pragma unroll
        for (int bj = 0; bj < 2; ++bj) {
            const int tok0 = u.pn * 256 + bj * 128 + wc * 32 + 8 * fq; const int m0 = tok0 & 63;
#pragma unroll
            for (int ai = 0; ai < 2; ++ai) {
                const unsigned item = (unsigned)((tok0 >> 6) * 4 + 2 * u.pm + ai);
#pragma unroll
                for (int m = 0; m < 4; ++m) {
                    *(u32x4*)(dst + (item * 128u + (unsigned)(wr * 64 + m * 16 + fr)) * 64u + (unsigned)m0) = pk8(acc[ai][bj][m][0], acc[ai][bj][m][1]);
                    asm volatile("" ::: "memory");
                }
            }
        }
    }
};
DEVI void phase1(const Params& p, unsigned char* smem_all) {
    {
        pg8::StaticOrder S; S.init(T_, 5888, RG, RB);
        pg8::Gemm g; g.A = (const bf16_t*)(p.ws + OFF_XB); g.Bt = (const bf16_t*)(p.ws + OFF_WT) + (size_t)WT_BN * 1024; g.M = T_; g.N = 5888; g.K = 1024;
        EpiP1N E; E.ws = p.ws;
        pg8::gemm_phase<EpiP1N, pg8::StaticOrder, true, true>((PG8_LAS unsigned char*)smem_all, g, S, E);
    }
    __syncthreads();
    {
        pg8::StaticOrder S; S.init(2048, T_, RG, RB);
        pg8::Gemm g; g.A = (const bf16_t*)(p.ws + OFF_WT) + (size_t)(WT_AT + 512) * 1024; g.Bt = (const bf16_t*)(p.ws + OFF_XB); g.M = 2048; g.N = T_; g.K = 1024;
        EpiP1V E; E.ws = p.ws;
        pg8::gemm_phase<EpiP1V, pg8::StaticOrder, true, true>((PG8_LAS unsigned char*)smem_all, g, S, E);
    }
    __syncthreads();
    {
        pg8::StaticOrder S; S.init(512, T_, RG, RB);
        pg8::Gemm g; g.A = (const bf16_t*)(p.ws + OFF_WT) + (size_t)(WT_AT + 2560) * 1024; g.Bt = (const bf16_t*)(p.ws + OFF_XB); g.M = 512; g.N = T_; g.K = 1024;
        EpiP1G E; E.ws = p.ws;
        pg8::gemm_phase<EpiP1G, pg8::StaticOrder, true, true>((PG8_LAS unsigned char*)smem_all, g, S, E);
    }
}

DEVI void phase2(const Params& p, unsigned char* smem) {
    float* ga_s = (float*)smem;
    float* tot = (float*)(smem + 4096);
    const int tid = VT;
    const float* Ga = (const float*)(p.ws + OFF_GA);
    const bf16_t* Kgt = (const bf16_t*)(p.ws + OFF_KGT); bf16_t* Kg2 = (bf16_t*)(p.ws + OFF_KG2);
    float* dec = (float*)(p.ws + OFF_DEC);
    for (int it = VB; it < 2048; it += VG) {
        const int h = it & 3, c = (it >> 2) & 63, b = it >> 8;
        const int tok0 = b * 4096 + c * 64;
        ((f32x4*)ga_s)[tid] = ((const f32x4*)(Ga + (size_t)tok0 * 16))[tid];
        const int dk = tid & 127, half = tid >> 7;
        float w2[16];
#pragma unroll
        for (int r = 0; r < 16; ++r) w2[r] = p.gate_w2[r * 512 + h * 128 + dk];
        const float bias = p.gate_b[h * 128 + dk];
        __syncthreads();
        float run = 0.f; float bc[32];
#pragma unroll
        for (int ml = 0; ml < 32; ++ml) {
            const int m = half * 32 + ml;
            float z = bias;
#pragma unroll
            for (int r4 = 0; r4 < 4; ++r4) { const f32x4 g4 = *(const f32x4*)&ga_s[m * 16 + 4 * r4];
                z += g4[0] * w2[4 * r4] + g4[1] * w2[4 * r4 + 1] + g4[2] * w2[4 * r4 + 2] + g4[3] * w2[4 * r4 + 3]; }
            const float la = (fminf(z, 0.f) - __logf(1.0f + __expf(-fabsf(z)))) * (1.0f / 16.0f);
            run += la; bc[ml] = run;
        }
        tot[half * 128 + dk] = run;
        __syncthreads();
        const float t0 = tot[dk], t1 = tot[128 + dk];
        const float bend = t0 + t1, off = half ? t0 : 0.f;
        const u32x4* kp = (const u32x4*)(Kgt + ((size_t)it * 128 + dk) * 64 + half * 32);
        bf16_t* const kqb = Kg2;
#pragma unroll
        for (int j = 0; j < 4; ++j) {
            u32x4 v = kp[j];
            unsigned uu[4] = {v.x, v.y, v.z, v.w};
#pragma unroll
            for (int e = 0; e < 4; ++e) {
                const float f0 = bflo(uu[e]) * __expf(bend - (bc[8 * j + 2 * e] + off));
                const float f1 = bfhi(uu[e]) * __expf(bend - (bc[8 * j + 2 * e + 1] + off));
                uu[e] = pk2(f0, f1);
            }
            *(u32x4*)(kqb + kf_off(it, dk, half * 32 + 8 * j)) = (u32x4){uu[0], uu[1], uu[2], uu[3]};
        }
        if (half == 0) dec[(size_t)it * 128 + dk] = __expf(bend);
        {
            const bf16_t* Qn = (const bf16_t*)(p.ws + OFF_QGN); bf16_t* QF = (bf16_t*)(p.ws + OFF_QG);
            const int m = tid & 63, qd = tid >> 6, bc = b * 64 + c;
            const u32x4* qs = (const u32x4*)(Qn + ((size_t)tok0 + m) * 512 + h * 128 + 32 * qd);
            u32x4 qv[4];
#pragma unroll
            for (int j = 0; j < 4; ++j) qv[j] = qs[j];
#pragma unroll
            for (int j = 0; j < 4; ++j) {
                *(u32x2*)(QF + qf_off(bc, h, m, 32 * qd + 8 * j, 0)) = (u32x2){qv[j].x, qv[j].y};
                *(u32x2*)(QF + qf_off(bc, h, m, 32 * qd + 8 * j, 1)) = (u32x2){qv[j].z, qv[j].w};
            }
        }
        __syncthreads();
    }
    {
        bf16_t* tile = (bf16_t*)smem;
        const bf16_t* Kr = (const bf16_t*)(p.ws + OFF_KR); bf16_t* Krt = (bf16_t*)(p.ws + OFF_KRT);
        for (int it = VB; it < 2048; it += VG) {
            const int h = it & 3, c = (it >> 2) & 63, b = it >> 8;
            const size_t tok0 = (size_t)b * 4096 + c * 64;
            const int m = tid & 63, qd = tid >> 6;
            const float kd = exp2f(gamma_log2(h) * (float)(63 - m));
            const u32x4* src = (const u32x4*)(Kr + (tok0 + m) * 512 + h * 128 + 32 * qd);
            u32x4 v[4];
#pragma unroll
            for (int j = 0; j < 4; ++j) v[j] = src[j];
#pragma unroll
            for (int j = 0; j < 4; ++j) {
                const unsigned uu[4] = {v[j].x, v[j].y, v[j].z, v[j].w};
#pragma unroll
                for (int e = 0; e < 4; ++e) {
                    const int dk = 32 * qd + 8 * j + 2 * e;
                    tile[dk * 72 + m] = f2bf(bflo(uu[e]) * kd); tile[(dk + 1) * 72 + m] = f2bf(bfhi(uu[e]) * kd);
                }
            }
            {
                const bf16_t* Qr = (const bf16_t*)(p.ws + OFF_QR); bf16_t* QF = (bf16_t*)(p.ws + OFF_QFR);
                const u32x4* qs = (const u32x4*)(Qr + (tok0 + m) * 512 + h * 128 + 32 * qd);
                u32x4 qv[4];
#pragma unroll
                for (int j = 0; j < 4; ++j) qv[j] = qs[j];
                const int bc = b * 64 + c;
#pragma unroll
                for (int j = 0; j < 4; ++j) {
                    *(u32x2*)(QF + qf_off(bc, h, m, 32 * qd + 8 * j, 0)) = (u32x2){qv[j].x, qv[j].y};
                    *(u32x2*)(QF + qf_off(bc, h, m, 32 * qd + 8 * j, 1)) = (u32x2){qv[j].z, qv[j].w};
                }
            }
            __syncthreads();
            {
                const int dk = tid >> 1, hf = tid & 1;
#pragma unroll
                for (int j = 0; j < 4; ++j) *(u32x4*)(Krt + kf_off(it, dk, hf * 32 + 8 * j)) = *(const u32x4*)&tile[dk * 72 + hf * 32 + 8 * j];
            }
            __syncthreads();
        }
    }
}

typedef float f32x16 __attribute__((ext_vector_type(16)));
DEVI f32x16 mfma32(bf16x8 a, bf16x8 b, f32x16 c) { return __builtin_amdgcn_mfma_f32_32x32x16_bf16(a, b, c, 0, 0, 0); }
struct ScanSet { bf16x8 kf[4], vq, qf[2][2]; f32x4 dc[4]; };
template <bool GLA>
DEVI void scan_tile(const Params& p, unsigned char* zb  , int b, int h, int s, int dummy) {
    int vt_ = VT; asm volatile("" : "+v"(vt_));
    const int t = __builtin_amdgcn_readfirstlane(vt_ >> 6), lane = vt_ & 63, r = lane & 31, hh = lane >> 5;
    const bf16_t* Ktb = (const bf16_t*)(p.ws + (GLA ? OFF_KG2 : OFF_KRT));
    const bf16_t* Vtb = (const bf16_t*)(p.ws + (GLA ? OFF_VGT : OFF_VRT));
    const bf16_t* Qb  = (const bf16_t*)(p.ws + (GLA ? OFF_QG : OFF_QFR));
    const float* dec = (const float*)(p.ws + OFF_DEC);
    bf16_t* Oo = (bf16_t*)(p.ws + OFF_OO);
    const float lg = gamma_log2(h);
    const float cd = exp2f(lg * 64.0f);
    f32x16 S;
#pragma unroll
    for (int i = 0; i < 16; ++i) S[i] = 0.f;
    const unsigned it0 = (unsigned)(b * 64 * 4 + h);
    const bf16_t* const kp = Ktb + ((size_t)it0 * 4 + t) * 4 * 512; const unsigned ko = (unsigned)lane * 8;
    const bf16_t* const vp = Vtb + ((size_t)it0 * 8 + s) * 4 * 512 + t * 512; const unsigned vo = (unsigned)lane * 8;
    const bf16_t* const qp = Qb + ((((size_t)(b * 64) * 4 + h) * 2) * 4 + t) * 2 * 512; const unsigned qo = (unsigned)lane * 8;
    const float* const dp = dec + (size_t)it0 * 128 + t * 32; const unsigned dofs = 4 * hh;
    unsigned char* const vring = smem_all_g + 2 * SMEM_HALF + VH * 8192;
    const int rt = t >> 1, rg0 = 2 * (t & 1);
    const float qd = GLA ? 1.0f : exp2f(lg * (float)(32 * rt + r + 1));
    bf16_t* const ob = Oo + (size_t)b * 4096 * 2048 + (GLA ? 1024 : 0) + h * 256 + s * 32;
#define ST_CL(C) (dummy ? 0 : ((C) < 64 ? (C) : 63))
#define ST_LOAD(SET, C) do { const int c_ = ST_CL(C), cv_ = ST_CL((C) + 1); \
        const bf16_t* kq = kp + (size_t)c_ * (4 * 16 * 512) + ko; const bf16_t* qq = qp + (size_t)c_ * (4 * 16 * 512) + qo; \
        _Pragma("unroll") for (int ks = 0; ks < 4; ++ks) (SET).kf[ks] = *(const bf16x8*)(kq + ks * 512); \
        (SET).vq = *(const bf16x8*)(vp + (size_t)cv_ * (4 * 32 * 512) + vo); \
        _Pragma("unroll") for (int ss = 0; ss < 2; ++ss) _Pragma("unroll") for (int tt = 0; tt < 2; ++tt) (SET).qf[ss][tt] = *(const bf16x8*)(qq + tt * (8 * 512) + ss * 512); \
        } while (0)
#define ST_LOADDC(SET, C) do { if (GLA) { const int c_ = (C) < 64 ? (C) : 63; const float* dq = dp + (size_t)c_ * (4 * 128) + dofs; \
        _Pragma("unroll") for (int g = 0; g < 4; ++g) (SET).dc[g] = *(const f32x4*)(dq + 8 * g); } } while (0)
#define ST_Z(SET, ZC) do { \
        _Pragma("unroll") for (int tt = 0; tt < 2; ++tt) { \
            f32x16 Zt; _Pragma("unroll") for (int i = 0; i < 16; ++i) Zt[i] = 0.f; \
            _Pragma("unroll") for (int ss = 0; ss < 2; ++ss) { \
                u32x4 pk; pk.x = pk2(S[8 * ss + 0], S[8 * ss + 1]); pk.y = pk2(S[8 * ss + 2], S[8 * ss + 3]); pk.z = pk2(S[8 * ss + 4], S[8 * ss + 5]); pk.w = pk2(S[8 * ss + 6], S[8 * ss + 7]); \
                Zt = mfma32(__builtin_bit_cast(bf16x8, pk), (SET).qf[ss][tt], Zt); } \
            _Pragma("unroll") for (int g = 0; g < 4; ++g) { \
                f32x4 z4; z4[0] = Zt[4 * g]; z4[1] = Zt[4 * g + 1]; z4[2] = Zt[4 * g + 2]; z4[3] = Zt[4 * g + 3]; \
                *(u32x2*)((ZC) + (((t * 2 + tt) * 4 + g) * 64 + lane) * 8) = pk4(z4); } } } while (0)
#define ST_UPD(SET, C) do { \
        if (GLA) { _Pragma("unroll") for (int g = 0; g < 4; ++g) _Pragma("unroll") for (int i = 0; i < 4; ++i) S[4 * g + i] *= (SET).dc[g][i]; } \
        else { _Pragma("unroll") for (int i = 0; i < 16; ++i) S[i] *= cd; } \
        _Pragma("unroll") for (int ks = 0; ks < 4; ++ks) S = mfma32((SET).kf[ks], *(const bf16x8*)(vring + ((C) & 1) * 4096 + ks * 1024 + lane * 16), S); } while (0)
#define ST_STEP(CUR, NXT, OTH, C) do { \
        ST_LOADDC(OTH, (C) + 1); ST_LOAD(NXT, (C) + 2);       \
        __builtin_amdgcn_sched_barrier(0); \
        unsigned char* zc = zb + ((C) & 1) * 16384; \
        if (GLA) { ST_UPD(CUR, C); ST_Z(CUR, zc); } else { ST_Z(CUR, zc); ST_UPD(CUR, C); } \
        *(bf16x8*)(vring + (((C) + 1) & 1) * 4096 + t * 1024 + lane * 16) = (CUR).vq; \
        __syncthreads(); \
        _Pragma("unroll") for (int gi = 0; gi < 2; ++gi) { const int g = rg0 + gi; \
            f32x4 o = (f32x4){0.f, 0.f, 0.f, 0.f}; \
            _Pragma("unroll") for (int t2 = 0; t2 < 4; ++t2) o += unpk4(*(const u32x2*)(zc + (((t2 * 2 + rt) * 4 + g) * 64 + lane) * 8)); \
            *(u32x2*)(zb + 32768 + ((C) & 7) * 4096 + (32 * rt + r) * 64 + (8 * g + 4 * hh) * 2) = pk4(o * qd); } \
          \
        if (((C) & 7) == 7) { __syncthreads(); \
            _Pragma("unroll") for (int i = 0; i < 8; ++i)   \
                *(u32x4*)((unsigned char*)ob + (size_t)(((C) - 7) * 64 + i * 64) * 4096 + fo) = *(const u32x4*)(zb + 32768 + i * 4096 + fl); } } while (0)
    const unsigned fo = (unsigned)(vt_ >> 2) * 4096u + (unsigned)(vt_ & 3) * 16u, fl = (unsigned)(vt_ >> 2) * 64u + (unsigned)(vt_ & 3) * 16u;
    ScanSet A, B, Cc;
    { const bf16x8 v0 = *(const bf16x8*)(vp + vo); *(bf16x8*)(vring + t * 1024 + lane * 16) = v0; }
    ST_LOAD(A, 0); ST_LOADDC(A, 0); ST_LOAD(B, 1);
    __syncthreads();
#pragma unroll 1
    for (int c0 = 0; c0 < 66; c0 += 3) { ST_STEP(A, Cc, B, c0); ST_STEP(B, A, Cc, c0 + 1); ST_STEP(Cc, B, A, c0 + 2); }
    __syncthreads();
#undef ST_STEP
#undef ST_UPD
#undef ST_Z
#undef ST_LOADDC
#undef ST_LOAD
#undef ST_CL
}
DEVI void phase3t(const Params& p, unsigned char* smem, int dummy) {
    for (int it0 = VB; it0 < 512; it0 += VG) {
        const int lcl = (RB >> 3) * 2 + VH;
        const int it = (VG == 512) ? ((RB & 7) * 8 + lcl / 8) * 8 + (lcl & 7) : it0;
        const int s = it & 7, h = (it >> 3) & 3, b = (it >> 5) & 7, br = it >> 8;
        if (br == 0) scan_tile<false>(p, smem, b, h, s, dummy); else scan_tile<true>(p, smem, b, h, s, dummy);
    }
}

constexpr int PS_LD = 72;
DEVI void phase4(const Params& p, unsigned char* smem) {
    const int t = VT, lane = t & 63, w = t >> 6, l15 = lane & 15, q = lane >> 4;
    bf16_t* Ps = (bf16_t*)smem + w * 16 * PS_LD;
    const bf16_t* Qr = (const bf16_t*)(p.ws + OFF_QR); const bf16_t* Kr = (const bf16_t*)(p.ws + OFF_KR);
    const bf16_t* Vrt = (const bf16_t*)(p.ws + OFF_VRT); const bf16_t* Oo = (const bf16_t*)(p.ws + OFF_OO);
    const bf16_t* Gs = (const bf16_t*)(p.ws + OFF_GS); bf16_t* Y = (bf16_t*)(p.ws + OFF_Y);
    for (int it = VB; it < 4096; it += VG) {
        const int br = it >> 11, idx = it & 2047;
        const int h = idx & 3, c = (idx >> 2) & 63, b = idx >> 8;
        const size_t tok0 = (size_t)b * 4096 + c * 64;
        const size_t tok = tok0 + 16 * w + l15;
        f32x4 O[16];
        const bf16_t* orow = Oo + tok * 2048 + br * 1024 + h * 256 + 4 * q;
        const bf16_t* grow = Gs + tok * 2048 + br * 1024 + h * 256 + 4 * q;
        u32x2 oraw[16], graw[16];
        if (br == 0) {
            const float lg = gamma_log2(h);
            bf16x8 vf[8][2];
#pragma unroll
            for (int nt = 0; nt < 8; ++nt) { vf[nt][0] = *(const bf16x8*)(Vrt + vf_off(idx, 16 * nt + l15, q * 8)); vf[nt][1] = *(const bf16x8*)(Vrt + vf_off(idx, 16 * nt + l15, 32 + q * 8)); }
            __builtin_amdgcn_sched_barrier(0);
            f32x4 P[4] = {(f32x4){0.f, 0.f, 0.f, 0.f}, (f32x4){0.f, 0.f, 0.f, 0.f}, (f32x4){0.f, 0.f, 0.f, 0.f}, (f32x4){0.f, 0.f, 0.f, 0.f}};
#pragma unroll
            for (int ks = 0; ks < 4; ++ks) {
                const bf16x8 qf = *(const bf16x8*)(Qr + tok * 512 + h * 128 + ks * 32 + q * 8);
#pragma unroll
                for (int mt = 0; mt < 4; ++mt) {
                    const bf16x8 kf = *(const bf16x8*)(Kr + (tok0 + 16 * mt + l15) * 512 + h * 128 + ks * 32 + q * 8);
                    P[mt] = mfma16(kf, qf, P[mt]);
                }
            }
            const int j = 16 * w + l15;
#pragma unroll
            for (int mt = 0; mt < 4; ++mt) {
                f32x4 v = P[mt];
#pragma unroll
                for (int r = 0; r < 4; ++r) { const int m = 16 * mt + 4 * q + r; const int dd = j > m ? j - m : m - j; v[r] *= exp2f(lg * (float)dd); }
                *(u32x2*)&Ps[l15 * PS_LD + 16 * mt + 4 * q] = pk4(v);
            }
            __syncthreads();
            const bf16x8 pf0 = *(const bf16x8*)&Ps[l15 * PS_LD + q * 8];
            const bf16x8 pf1 = *(const bf16x8*)&Ps[l15 * PS_LD + 32 + q * 8];
            __builtin_amdgcn_sched_barrier(0);
#pragma unroll
            for (int nt = 0; nt < 8; ++nt) {
                f32x4 o = (f32x4){0.f, 0.f, 0.f, 0.f};
                o = mfma16(vf[nt][0], pf0, o); O[nt] = mfma16(vf[nt][1], pf1, o);
            }
            __builtin_amdgcn_sched_barrier(0);
#pragma unroll
            for (int nt = 0; nt < 8; ++nt) { vf[nt][0] = *(const bf16x8*)(Vrt + vf_off(idx, 16 * (8 + nt) + l15, q * 8)); vf[nt][1] = *(const bf16x8*)(Vrt + vf_off(idx, 16 * (8 + nt) + l15, 32 + q * 8)); }
#pragma unroll
            for (int nt = 0; nt < 16; ++nt) { oraw[nt] = *(const u32x2*)(orow + 16 * nt); graw[nt] = *(const u32x2*)(grow + 16 * nt); }
            __builtin_amdgcn_sched_barrier(0);
#pragma unroll
            for (int nt = 0; nt < 8; ++nt) {
                f32x4 o = (f32x4){0.f, 0.f, 0.f, 0.f};
                o = mfma16(vf[nt][0], pf0, o); O[8 + nt] = mfma16(vf[nt][1], pf1, o);
            }
#pragma unroll
            for (int nt = 0; nt < 16; ++nt) O[nt] += unpk4(oraw[nt]);
            __syncthreads();
        } else {
#pragma unroll
            for (int nt = 0; nt < 16; ++nt) { oraw[nt] = *(const u32x2*)(orow + 16 * nt); graw[nt] = *(const u32x2*)(grow + 16 * nt); }
#pragma unroll
            for (int nt = 0; nt < 16; ++nt) O[nt] = unpk4(oraw[nt]);
        }
        float s1 = 0.f;
#pragma unroll
        for (int nt = 0; nt < 16; ++nt) s1 += (O[nt][0] + O[nt][1]) + (O[nt][2] + O[nt][3]);
        s1 += __shfl_xor(s1, 16); s1 += __shfl_xor(s1, 32);
        const float mean = (br == 0) ? s1 * (1.0f / 256.0f) : 0.f;
        float s2 = 0.f;
#pragma unroll
        for (int nt = 0; nt < 16; ++nt) {
#pragma unroll
            for (int r = 0; r < 4; ++r) { const float dlt = O[nt][r] - mean; s2 += dlt * dlt; }
        }
        s2 += __shfl_xor(s2, 16); s2 += __shfl_xor(s2, 32);
        const float rstd = rsqrtf(s2 * (1.0f / 256.0f) + (br == 0 ? 1e-5f : 1e-6f));
        const float* gw = (br == 0 ? p.ret_norm_g : p.gla_norm_g) + h * 256 + 4 * q;
        bf16_t* yrow = Y + ((size_t)br * T_ + tok) * 1024 + h * 256 + 4 * q;
#pragma unroll
        for (int nt = 0; nt < 16; ++nt) {
            const f32x4 g = *(const f32x4*)(gw + 16 * nt);
            const f32x4 gate = unpk4(graw[nt]);
            f32x4 y;
#pragma unroll
            for (int r = 0; r < 4; ++r) y[r] = (O[nt][r] - mean) * rstd * g[r] * gate[r];
            *(u32x2*)(yrow + 16 * nt) = pk4(y);
        }
    }
}

struct EpiMerge {
    static constexpr bool PERM = true, AFTER_DRAIN = false;
    const bf16_t* Mg; bf16_t* Mrg; int pass;
    __device__ __forceinline__ void operator()(const pg8::f32x4 (&acc)[2][2][4][2], const pg8::Unit& u, int wr, int wc, int fr, int fq) const {
        const int row0 = u.pm * 256 + wr * 64 + fr, col0 = u.pn * 256 + wc * 32 + 8 * fq;
#pragma unroll
        for (int ai = 0; ai < 2; ++ai) {
            u32x4 gg[4][2], pr[4][2];
#pragma unroll
            for (int m = 0; m < 4; ++m)
#pragma unroll
                for (int bj = 0; bj < 2; ++bj) {
                    const size_t row = row0 + ai * 128 + m * 16; const int col = col0 + bj * 128;
                    gg[m][bj] = *(const u32x4*)(Mg + row * 2048 + pass * 1024 + col);
                    if (pass) pr[m][bj] = *(const u32x4*)(Mrg + row * 1024 + col);
                }
#pragma unroll
            for (int m = 0; m < 4; ++m)
#pragma unroll
                for (int bj = 0; bj < 2; ++bj) {
                    const size_t row = row0 + ai * 128 + m * 16; const int col = col0 + bj * 128;
                    f32x4 g0, g1; unpk8(gg[m][bj], g0, g1);
                    f32x4 o0 = acc[ai][bj][m][0] * g0, o1 = acc[ai][bj][m][1] * g1;
                    if (pass) { f32x4 p0, p1; unpk8(pr[m][bj], p0, p1); o0 += p0; o1 += p1; }
                    *(u32x4*)(Mrg + row * 1024 + col) = pk8(o0, o1);
                }
        }
    }
};
DEVI void phase5(const Params& p, unsigned char* smem_all) {
    pg8::StaticOrder S; S.init(T_, 1024, RG, RB);
    const bf16_t* Y = (const bf16_t*)(p.ws + OFF_Y); const bf16_t* wt = (const bf16_t*)(p.ws + OFF_WT);
    for (int pass = 0; pass < 2; ++pass) {
        pg8::Gemm g; g.A = Y + (size_t)pass * T_ * 1024; g.Bt = wt + (size_t)(pass ? WT_GLA : WT_RET) * 1024; g.M = T_; g.N = 1024; g.K = 1024;
        EpiMerge E; E.Mg = (const bf16_t*)(p.ws + OFF_MG); E.Mrg = (bf16_t*)(p.ws + OFF_MRG); E.pass = pass;
        pg8::gemm_phase<EpiMerge, pg8::StaticOrder, true, true>((PG8_LAS unsigned char*)smem_all, g, S, E);
        __syncthreads();
    }
}

struct EpiResid {
    static constexpr bool PERM = true, AFTER_DRAIN = false;
    const float* x; bf16_t* T1;
    __device__ __forceinline__ void operator()(const pg8::f32x4 (&acc)[2][2][4][2], const pg8::Unit& u, int wr, int wc, int fr, int fq) const {
        const int row0 = u.pm * 256 + wr * 64 + fr, col0 = u.pn * 256 + wc * 32 + 8 * fq;
#pragma unroll
        for (int ai = 0; ai < 2; ++ai)
#pragma unroll
            for (int m = 0; m < 4; ++m) {
                const size_t row = row0 + ai * 128 + m * 16;
                f32x4 xv[2][2];
#pragma unroll
                for (int bj = 0; bj < 2; ++bj) { xv[bj][0] = *(const f32x4*)(x + row * 1024 + col0 + bj * 128); xv[bj][1] = *(const f32x4*)(x + row * 1024 + col0 + bj * 128 + 4); }
#pragma unroll
                for (int bj = 0; bj < 2; ++bj)
                    *(u32x4*)(T1 + row * 1024 + col0 + bj * 128) = pk8(xv[bj][0] * ALPHA_ + acc[ai][bj][m][0], xv[bj][1] * ALPHA_ + acc[ai][bj][m][1]);
            }
    }
};
DEVI void phase6(const Params& p, unsigned char* smem_all) {
    pg8::StaticOrder S; S.init(T_, 1024, RG, RB);
    pg8::Gemm g; g.A = (const bf16_t*)(p.ws + OFF_MRG); g.Bt = (const bf16_t*)(p.ws + OFF_WT) + (size_t)WT_O * 1024; g.M = T_; g.N = 1024; g.K = 1024;
    EpiResid E; E.x = p.x; E.T1 = (bf16_t*)(p.ws + OFF_T1);
    pg8::gemm_phase<EpiResid, pg8::StaticOrder, true, true>((PG8_LAS unsigned char*)smem_all, g, S, E);
}

DEVI void conv_expert_weights(const Params& p, unsigned char* smem) {
    bf16_t* tile = (bf16_t*)smem;
    const int t = VT, ng = t & 31, kg = t >> 5;
    bf16_t* WGU = (bf16_t*)(p.ws + OFF_WGU); bf16_t* WD = (bf16_t*)(p.ws + OFF_WD);
    const int ntask = 257 * 3 * 32;
    for (int task = VB; task < ntask; task += VG) {
        const int e = task / 96, rem = task - e * 96, mat = rem >> 5, tl = rem & 31;
        const float* src; bf16_t* dst; int K, N, kt, nt;
        if (mat < 2) { K = 1024; N = 256; kt = tl >> 1; nt = tl & 1;
            src = (mat == 0) ? (e < 256 ? p.ew_gate + (size_t)e * 262144 : p.sw_gate) : (e < 256 ? p.ew_up + (size_t)e * 262144 : p.sw_up);
            dst = WGU + (size_t)e * 524288 + (size_t)(nt + mat) * 131072; }
        else { K = 256; N = 1024; kt = tl >> 3; nt = tl & 7;
            src = e < 256 ? p.ew_down + (size_t)e * 262144 : p.sw_down; dst = WD + (size_t)e * 262144; }
        const float* sp = src + (size_t)(kt * 64 + 4 * kg) * N + nt * 128 + 4 * ng;
        f32x4 rf[8];
#pragma unroll
        for (int i = 0; i < 4; ++i) { rf[i] = *(const f32x4*)(sp + (size_t)i * N); rf[4 + i] = *(const f32x4*)(sp + (size_t)(32 + i) * N); }
#pragma unroll
        for (int i = 0; i < 4; ++i) {
            u32x2 v0, v1;
            v0.x = pk2(rf[0][i], rf[1][i]); v0.y = pk2(rf[2][i], rf[3][i]); v1.x = pk2(rf[4][i], rf[5][i]); v1.y = pk2(rf[6][i], rf[7][i]);
            *(u32x2*)&tile[(4 * ng + i) * 72 + 4 * kg] = v0; *(u32x2*)&tile[(4 * ng + i) * 72 + 32 + 4 * kg] = v1;
        }
        __syncthreads();
        {
            const int n = t >> 1, hf = t & 1;
            bf16_t* dp = dst + (size_t)(nt * 128 + n) * K + kt * 64 + hf * 32;
#pragma unroll
            for (int j = 0; j < 4; ++j) *(u32x4*)(dp + 8 * j) = *(const u32x4*)&tile[n * 72 + hf * 32 + 8 * j];
        }
        __syncthreads();
    }
}

DEVI void phase7(const Params& p, unsigned char* smem) {
    const int t = VT, lane = t & 63, w = t >> 6;
    const bf16_t* T1 = (const bf16_t*)(p.ws + OFF_T1); bf16_t* X1b = (bf16_t*)(p.ws + OFF_X1B);
    for (int row = VB * 4 + w; row < T_; row += VG * 4) {
        f32x4 v[4]; float s = 0.f;
#pragma unroll
        for (int i = 0; i < 4; ++i) { v[i] = unpk4(*(const u32x2*)(T1 + (size_t)row * 1024 + i * 256 + lane * 4)); s += (v[i][0] + v[i][1]) + (v[i][2] + v[i][3]); }
#pragma unroll
        for (int o = 32; o > 0; o >>= 1) s += __shfl_xor(s, o);
        const float mean = s * (1.0f / 1024.0f); float s2 = 0.f;
#pragma unroll
        for (int i = 0; i < 4; ++i)
#pragma unroll
            for (int r = 0; r < 4; ++r) { const float d = v[i][r] - mean; s2 += d * d; }
#pragma unroll
        for (int o = 32; o > 0; o >>= 1) s2 += __shfl_xor(s2, o);
        const float rstd = rsqrtf(s2 * (1.0f / 1024.0f) + 1e-5f);
#pragma unroll
        for (int i = 0; i < 4; ++i) {
            const int col = i * 256 + lane * 4;
            const f32x4 g = *(const f32x4*)(p.ln1_g + col), bb = *(const f32x4*)(p.ln1_b + col);
            f32x4 y;
#pragma unroll
            for (int r = 0; r < 4; ++r) y[r] = (v[i][r] - mean) * rstd * g[r] + bb[r];
            *(u32x2*)(X1b + (size_t)row * 1024 + col) = pk4(y);
        }
    }
    conv_expert_weights(p, smem);
}

DEVI unsigned f2ord(float f) { const unsigned u = __float_as_uint(f); return (u & 0x80000000u) ? ~u : (u | 0x80000000u); }
template <int CTRL> DEVI float dppf(float v) { const int x = __float_as_int(v); return __int_as_float(__builtin_amdgcn_update_dpp(x, x, CTRL, 0xf, 0xf, false)); }
template <int CTRL> DEVI void top2_merge(float& m1, float& m2) {
    const float p1 = dppf<CTRL>(m1), p2 = dppf<CTRL>(m2);
    const float n1 = fmaxf(m1, p1), n2 = fmaxf(fminf(m1, p1), fmaxf(m2, p2));
    m1 = n1; m2 = n2;
}
DEVI void route_token(const f32x4 lg, const f32x4 rb, int lane, int& mye, float& myw) {
    const int mygrp = lane >> 3;
    float sc[4], bi[4];
#pragma unroll
    for (int r = 0; r < 4; ++r) { sc[r] = sigmoidf_(lg[r]); bi[r] = sc[r] + rb[r]; }
    float m1, m2;
    { const float h01 = fmaxf(bi[0], bi[1]), l01 = fminf(bi[0], bi[1]), h23 = fmaxf(bi[2], bi[3]), l23 = fminf(bi[2], bi[3]);
      m1 = fmaxf(h01, h23); m2 = fmaxf(fminf(h01, h23), fmaxf(l01, l23)); }
    top2_merge<0xB1>(m1, m2);
    top2_merge<0x4E>(m1, m2);
    top2_merge<0x141>(m1, m2);
    const float gown = m1 + m2;
    int rank = 0;
#pragma unroll
    for (int g2 = 0; g2 < 8; ++g2) {
        const float go = __builtin_bit_cast(float, __builtin_amdgcn_readlane(__builtin_bit_cast(int, gown), 8 * g2));
        rank += (go > gown || (go == gown && g2 < mygrp)) ? 1 : 0;
    }
    unsigned ck[4];
#pragma unroll
    for (int r = 0; r < 4; ++r) ck[r] = rank < 4 ? f2ord(bi[r]) : 0u;
    unsigned thr = 0u; bool exact = false;
#pragma unroll 1
    for (int bit = 31; bit >= 0; --bit) {
        const unsigned cnd = thr | (1u << bit);
        const int c8 = __popcll(__ballot(ck[0] >= cnd)) + __popcll(__ballot(ck[1] >= cnd)) + __popcll(__ballot(ck[2] >= cnd)) + __popcll(__ballot(ck[3] >= cnd));
        if (c8 >= 8) { thr = cnd; if (c8 == 8) { exact = true; break; } }
    }
    unsigned long long selm[4];
    if (exact) {
#pragma unroll
        for (int r = 0; r < 4; ++r) selm[r] = __ballot(ck[r] >= thr);
    } else {
        unsigned long long eq[4], any = 0ull; int need = 8;
#pragma unroll
        for (int r = 0; r < 4; ++r) { selm[r] = __ballot(ck[r] > thr); eq[r] = __ballot(ck[r] == thr); need -= __popcll(selm[r]); any |= eq[r]; }
        while (need > 0 && any != 0ull) {
            const int L = __builtin_ctzll(any); any &= any - 1ull;
#pragma unroll
            for (int r = 0; r < 4; ++r) if (((eq[r] >> L) & 1ull) != 0ull && need > 0) { selm[r] |= 1ull << L; --need; }
        }
    }
    float wsum = 0.f; int kk = 0;
    mye = 0; myw = 0.f;
#pragma unroll
    for (int r = 0; r < 4; ++r) {
        unsigned long long m = selm[r];
        while (m != 0ull) {
            const int L = __builtin_ctzll(m); m &= m - 1ull;
            const float sv = __builtin_bit_cast(float, __builtin_amdgcn_readlane(__builtin_bit_cast(int, sc[r]), L));
            wsum += sv;
            if (lane == kk) { mye = 4 * L + r; myw = sv; }
            ++kk;
        }
    }
    myw = myw / wsum * 2.5f;
}
DEVI void router_gemm(const Params& p, unsigned char* smem_all, int m0, f32x4 (&acc)[4][4]) {
    typedef __attribute__((address_space(3))) unsigned char lds8;
    lds8* const L = (lds8*)smem_all;
    const int tid = (int)threadIdx.x, lane = tid & 63, wv = __builtin_amdgcn_readfirstlane(tid >> 6), wr = wv >> 2, wc = wv & 3, l15 = lane & 15, q = lane >> 4;
    const bf16_t* pa = (const bf16_t*)(p.ws + OFF_X1B) + (size_t)(m0 + (tid >> 3)) * 1024 + gemm_src_chunk(tid);
    const bf16_t* pb = (const bf16_t*)(p.ws + OFF_WT) + (size_t)(WT_R + (tid >> 3)) * 1024 + gemm_src_chunk(tid);
    constexpr int STG = 49152;
#define RG_BOFF(BUF, I) ((BUF) * STG + 16384 + (I) * 8192 + (((BUF) == 2 && (I) >= 2) ? (2 * SMEM_HALF - 131072) : 0))
#define RG_ISSUE(BUF, KT) do { \
        _Pragma("unroll") for (int i = 0; i < 2; ++i) __builtin_amdgcn_global_load_lds((const unsigned*)(pa + (size_t)i * 65536 + (KT) * 64), (__attribute__((address_space(3))) unsigned*)(L + (BUF) * STG + i * 8192 + wv * 1024), 16, 0, 0); \
        _Pragma("unroll") for (int i = 0; i < 4; ++i) __builtin_amdgcn_global_load_lds((const unsigned*)(pb + (size_t)i * 65536 + (KT) * 64), (__attribute__((address_space(3))) unsigned*)(L + RG_BOFF(BUF, i) + wv * 1024), 16, 0, 0); } while (0)
    static_assert(2 * STG + 16384 + 2 * 8192 == 131072 && 2 * SMEM_HALF + 2 * 8192 <= 2 * SMEM_HALF + SMEM_MOE, "router GEMM stage map");
    RG_ISSUE(0, 0); RG_ISSUE(1, 1);
    int buf = 0;
#pragma unroll 1
    for (int kt = 0; kt < 16; ++kt) {
        if (kt + 1 < 16) asm volatile("s_waitcnt vmcnt(6)" ::: "memory"); else asm volatile("s_waitcnt vmcnt(0)" ::: "memory");
        __builtin_amdgcn_s_barrier();
        if (kt + 2 < 16) { const int b2 = buf == 0 ? 2 : buf - 1; RG_ISSUE(b2, kt + 2); }
        __builtin_amdgcn_sched_barrier(0);
#pragma unroll
        for (int ss = 0; ss < 2; ++ss) {
            bf16x8 af[4], bfr[4];
            const int coff = ((ss * 4 + q) ^ (l15 >> 1)) * 16;
#pragma unroll
            for (int i = 0; i < 4; ++i) {
                af[i]  = *(const __attribute__((address_space(3))) bf16x8*)(L + buf * STG + (wr * 64 + i * 16 + l15) * 128 + coff);
                bfr[i] = *(const __attribute__((address_space(3))) bf16x8*)(L + RG_BOFF(buf, wc) + (i * 16 + l15) * 128 + coff); }
#pragma unroll
            for (int mt = 0; mt < 4; ++mt)
#pragma unroll
                for (int nt = 0; nt < 4; ++nt) acc[mt][nt] = mfma16(bfr[nt], af[mt], acc[mt][nt]);
        }
        __builtin_amdgcn_sched_barrier(0);
        buf = buf == 2 ? 0 : buf + 1;
    }
#undef RG_ISSUE
#undef RG_BOFF
    __syncthreads();
}
DEVI void phase8(const Params& p, unsigned char* smem_all) {
    const int tid = (int)threadIdx.x, lane = tid & 63, wv = tid >> 6, wr = wv >> 2, wc = wv & 3, l15 = lane & 15, q = lane >> 4;
    int* hist = (int*)(smem_all + 2 * SMEM_HALF); int* rec = hist + 256; float* wrec = (float*)(rec + 1024);
    int* cnt = (int*)(p.ws + OFF_CNT); int* list = (int*)(p.ws + OFF_LIST); float* wl = (float*)(p.ws + OFF_WL);
    const f32x4 rb = *(const f32x4*)(p.router_bias + 4 * lane);
    for (int mtg = RB; mtg < 256; mtg += RG) {
        const int m0 = mtg * 128;
        f32x4 acc[4][4]; zero_acc(acc);
        router_gemm(p, smem_all, m0, acc);
        if (tid < 256) hist[tid] = 0;
#pragma unroll
        for (int mt = 0; mt < 4; ++mt)
#pragma unroll
            for (int nt = 0; nt < 4; ++nt) {
                const int row = wr * 64 + mt * 16 + l15, col = wc * 64 + (nt >> 1) * 32 + 8 * q + 4 * (nt & 1);
                *(f32x4*)(smem_all + row * 1024 + (((col >> 2) ^ (row & 15)) * 16)) = acc[mt][nt];
            }
        __syncthreads();
#pragma unroll 1
        for (int i = 0; i < 16; ++i) {
            const int tl = wv + 8 * i;
            const f32x4 lg = *(const f32x4*)(smem_all + tl * 1024 + ((lane ^ (tl & 15)) * 16));
            int mye; float myw; route_token(lg, rb, lane, mye, myw);
            if (lane < 8) {
                const int lpos = __hip_atomic_fetch_add(&hist[mye], 1, __ATOMIC_RELAXED, __HIP_MEMORY_SCOPE_WORKGROUP);
                rec[tl * 8 + lane] = mye | (lpos << 8); wrec[tl * 8 + lane] = myw;
            }
        }
        __syncthreads();
        if (tid < 256) { const int c = hist[tid]; hist[tid] = c > 0 ? atomicAdd(&cnt[tid * CNT_STRIDE], c) : 0; }
        __syncthreads();
        for (int i = tid; i < 1024; i += 512) {
            const int rc = rec[i], e = rc & 255, pos = hist[e] + (rc >> 8);
            list[(size_t)e * T_ + pos] = (m0 + (i >> 3)) * 9 + (i & 7); wl[(size_t)e * T_ + pos] = wrec[i];
        }
        __syncthreads();
    }
}

DEVI void moe_prefix256(const Params& p, int* pre  , int xg) {
    const int tid = threadIdx.x;
    const int* cnt = (const int*)(p.ws + OFF_CNT);
    __syncthreads();
    if (tid < 64) {
        int v = 0;
        if (tid < 32) { const int c = __hip_atomic_load(&cnt[(xg + 8 * tid) * CNT_STRIDE], __ATOMIC_RELAXED, __HIP_MEMORY_SCOPE_AGENT); pre[40 + tid] = c; v = (c + 255) >> 8; }
        else if (tid == 32) { v = 16; pre[40 + 32] = T_; }
#pragma unroll
        for (int o = 1; o < 64; o <<= 1) { const int u = __shfl_up(v, o); if (tid >= o) v += u; }
        if (tid < 33) pre[tid + 1] = v;
        if (tid == 0) pre[0] = 0;
    }
    __syncthreads();
}
struct MoeSched {
    const int* pre; const unsigned char* ws; bool need_w;
    int* sbuf;
    int xg, jl, nloc, nsh, nitems;
    const char* Abase; int arow_bytes; bool by_token;
    const char* Bbase; size_t b_expert_bytes, b_unit_bytes;
    __device__ __forceinline__ bool next(int i, pg8::Unit& u) const {
        const int item = jl + i * nloc; if (item >= nitems) return false;
        u.pm = item >> nsh; u.pn = item - (u.pm << nsh);
        const int lane = (int)(threadIdx.x & 63), li = lane < 33 ? lane : 32;
        const int pv = pre[li], cv = pre[40 + li];
        const int gi = __popcll(__ballot(lane < 33 && pv <= u.pm)) - 1;
        const int pg = __builtin_amdgcn_readlane(pv, gi);
        u.ce = __builtin_amdgcn_readlane(cv, gi);
        u.e = gi < 32 ? xg + 8 * gi : 256; u.r0 = (gi < 32 ? 0 : xg * 4096) + (u.pm - pg) * 256;
        return true;
    }
    __device__ __forceinline__ void decode(const pg8::Unit& u, int& e, int& r0, int& ce) const { e = u.e; r0 = u.r0; ce = u.ce; }
    __device__ __forceinline__ int fill_issue(const pg8::Unit& u) const {
        int e, r0, ce; decode(u, e, r0, ce);
        const int pos = r0 + (int)(threadIdx.x & 255); const bool w = threadIdx.x >= 256;
        int v = w ? 0 : -1;
        if (pos < ce && !(w && !need_w)) {
            unsigned hi = threadIdx.x >> 8; asm volatile("" : "+v"(hi));
            static_assert(OFF_WL == OFF_LIST + (512u << 20), "weight list sits 512 MB above the slot list");
            const unsigned off = (unsigned)OFF_LIST + (hi << 29) + ((unsigned)e * (unsigned)T_ + (unsigned)pos) * 4u;
            v = e < 256 ? *(const int*)(ws + off) : (w ? 0x3f800000 : pos * 9 + 8);
        }
        return v;
    }
    __device__ __forceinline__ void fill_write(int buf, int v) const { sbuf[(threadIdx.x >= 256 ? 768 : 0) + buf * 256 + (int)(threadIdx.x & 255)] = v; }
    __device__ __forceinline__ const char* a_base() const { return Abase; }
    __device__ __forceinline__ void a_rows(int buf, const int (&rowA)[2], const int (&colA)[2], unsigned& p00, unsigned& p01, unsigned& p10, unsigned& p11) const {
        const int* sb = sbuf + buf * 256; const int s0 = sb[0];
        int s4[4];
#pragma unroll
        for (int k = 0; k < 4; ++k) { int sl = sb[(k >> 1) * 128 + rowA[k & 1]]; if (sl < 0) sl = s0; s4[k] = sl; }
#pragma unroll
        for (int k = 0; k < 4; ++k) if (by_token) s4[k] = s4[k] / 9;
        p00 = (unsigned)s4[0] * (unsigned)arow_bytes + (unsigned)colA[0]; p01 = (unsigned)s4[1] * (unsigned)arow_bytes + (unsigned)colA[1];
        p10 = (unsigned)s4[2] * (unsigned)arow_bytes + (unsigned)colA[0]; p11 = (unsigned)s4[3] * (unsigned)arow_bytes + (unsigned)colA[1];
    }
    __device__ __forceinline__ const char* b_base(const pg8::Unit& u) const { int e, r0, ce; decode(u, e, r0, ce); return Bbase + (size_t)e * b_expert_bytes + (size_t)u.pn * b_unit_bytes; }
    __device__ __forceinline__ void a_ready(const pg8::Unit&) const {}
    __device__ __forceinline__ void done(const pg8::Unit&) const {}
};
struct EpiMoe1 {
    static constexpr bool PERM = true, AFTER_DRAIN = false, BJI = false;
    const MoeSched* S; bf16_t* H;
    __device__ __forceinline__ void operator()(const pg8::f32x4 (&acc)[2][2][4][2], const pg8::Unit& u, int wr, int wc, int fr, int fq, int buf) const {
        const int* sb = S->sbuf + buf * 256 + wr * 64 + fr;
#pragma unroll
        for (int ai = 0; ai < 2; ++ai) {
            int sl[4];
#pragma unroll
            for (int m = 0; m < 4; ++m) sl[m] = sb[ai * 128 + m * 16];
#pragma unroll
            for (int m = 0; m < 4; ++m) if (sl[m] >= 0) {
                f32x4 h0, h1;
#pragma unroll
                for (int r = 0; r < 4; ++r) { h0[r] = siluf_(acc[ai][0][m][0][r]) * acc[ai][1][m][0][r]; h1[r] = siluf_(acc[ai][0][m][1][r]) * acc[ai][1][m][1][r]; }
                *(u32x4*)(H + (size_t)sl[m] * 256 + u.pn * 128 + wc * 32 + 8 * fq) = pk8(h0, h1);
            }
            asm volatile("" ::: "memory");
        }
    }
};
struct EpiMoe2 {
    static constexpr bool PERM = true, AFTER_DRAIN = false, BJI = true;
    const MoeSched* S; unsigned char* YX;
    __device__ __forceinline__ void operator()(const pg8::f32x4 (&acc)[2][2][4][2], const pg8::Unit& u, int wr, int wc, int fr, int fq, int buf) const {
        const int* sb = S->sbuf + buf * 256 + wr * 64 + fr;
#pragma unroll
        for (int ai = 0; ai < 2; ++ai) {
            int sl[4]; float wg[4];
#pragma unroll
            for (int m = 0; m < 4; ++m) { sl[m] = sb[ai * 128 + m * 16]; wg[m] = __int_as_float(sb[768 + ai * 128 + m * 16]) * YX_SCALE; }
#pragma unroll
            for (int m = 0; m < 4; ++m) if (sl[m] >= 0) {
                u32x4 w8;
                w8.x = pk4_fp8(clamp4(acc[ai][0][m][0] * wg[m], 440.f)); w8.y = pk4_fp8(clamp4(acc[ai][0][m][1] * wg[m], 440.f));
                w8.z = pk4_fp8(clamp4(acc[ai][1][m][0] * wg[m], 440.f)); w8.w = pk4_fp8(clamp4(acc[ai][1][m][1] * wg[m], 440.f));
                *(u32x4*)(YX + (size_t)sl[m] * 1024 + u.pn * 256 + wc * 64 + 16 * fq) = w8;
            }
            asm volatile("" ::: "memory");
        }
    }
};
DEVI void moe_sched_init(const Params& p, MoeSched& S, int* pre) {
    S.pre = pre; S.ws = p.ws; S.need_w = false; S.sbuf = (int*)(smem_all_g + 2 * SMEM_HALF);
    S.xg = RB & 7; S.jl = RB >> 3; S.nloc = RG >> 3;
}
DEVI void phase10(const Params& p, unsigned char* smem_all) {
    int* pre = (int*)(smem_all + 131072);
    MoeSched S; moe_sched_init(p, S, pre); moe_prefix256(p, pre, S.xg);
    S.nsh = 1; S.nitems = pre[33] << 1; S.Abase = (const char*)(p.ws + OFF_X1B); S.arow_bytes = 2048; S.by_token = true;
    S.Bbase = (const char*)(p.ws + OFF_WGU); S.b_expert_bytes = (size_t)512 * 1024 * 2; S.b_unit_bytes = (size_t)256 * 1024 * 2;
    EpiMoe1 E; E.S = &S; E.H = (bf16_t*)(p.ws + OFF_H);
    pg8::gemm_phase_g<EpiMoe1, MoeSched, true, true>((PG8_LAS unsigned char*)smem_all, 1024, S, E);
}
DEVI void phase11(const Params& p, unsigned char* smem_all) {
    int* pre = (int*)(smem_all + 131072);
    MoeSched S; moe_sched_init(p, S, pre); moe_prefix256(p, pre, S.xg);
    S.nsh = 2; S.nitems = pre[33] << 2; S.Abase = (const char*)(p.ws + OFF_H); S.arow_bytes = 512; S.by_token = false;
    S.Bbase = (const char*)(p.ws + OFF_WD); S.b_expert_bytes = (size_t)1024 * 256 * 2; S.b_unit_bytes = (size_t)256 * 256 * 2;
    S.need_w = true;
    EpiMoe2 E; E.S = &S; E.YX = (unsigned char*)(p.ws + OFF_YX);
    pg8::gemm_phase_g<EpiMoe2, MoeSched, true, true>((PG8_LAS unsigned char*)smem_all, 256, S, E);
}

DEVI void phase12(const Params& p) {
    const int t = VT, lane = t & 63, w = t >> 6;
    const bf16_t* X1b = (const bf16_t*)(p.ws + OFF_X1B); const unsigned char* YX = (const unsigned char*)(p.ws + OFF_YX);
    for (int row = VB * 4 + w; row < T_; row += VG * 4) {
        f32x4 v[4]; float s = 0.f;
#pragma unroll
        for (int i = 0; i < 4; ++i) {
            const int col = i * 256 + lane * 4;
            f32x4 a = unpk4(*(const u32x2*)(X1b + (size_t)row * 1024 + col)) * ALPHA_;
            f32x4 ys = (f32x4){0.f, 0.f, 0.f, 0.f};
#pragma unroll
            for (int k = 0; k < 9; ++k) ys += unpk4_fp8(*(const unsigned*)(YX + ((size_t)row * 9 + k) * 1024 + col));
            a += ys * (1.0f / YX_SCALE);
            v[i] = a; s += (a[0] + a[1]) + (a[2] + a[3]);
        }
#pragma unroll
        for (int o = 32; o > 0; o >>= 1) s += __shfl_xor(s, o);
        const float mean = s * (1.0f / 1024.0f); float s2 = 0.f;
#pragma unroll
        for (int i = 0; i < 4; ++i)
#pragma unroll
            for (int r = 0; r < 4; ++r) { const float d = v[i][r] - mean; s2 += d * d; }
#pragma unroll
        for (int o = 32; o > 0; o >>= 1) s2 += __shfl_xor(s2, o);
        const float rstd = rsqrtf(s2 * (1.0f / 1024.0f) + 1e-5f);
#pragma unroll
        for (int i = 0; i < 4; ++i) {
            const int col = i * 256 + lane * 4;
            const f32x4 g = *(const f32x4*)(p.ln2_g + col), bb = *(const f32x4*)(p.ln2_b + col);
            f32x4 y;
#pragma unroll
            for (int r = 0; r < 4; ++r) y[r] = (v[i][r] - mean) * rstd * g[r] + bb[r];
            *(f32x4*)(p.out + (size_t)row * 1024 + col) = y;
        }
    }
}


#define XB_TMO      128
#define XB_XCNT(j)  (256  + 64 * (j))
#define XB_XSUB(j)  (1280 + 64 * (j))
#define XB_XGEN(j)  (2304 + 64 * (j))
#define XB_TOP      3328
#define XB_TOPGEN   3392
#define XCD_BAR_WORDS 3456
#define XB_SPIN_CAP (1u << 20)
#define LAS __attribute__((address_space(3)))
DEVI unsigned xb_ld(unsigned* p)              { return __hip_atomic_load(p, __ATOMIC_RELAXED, __HIP_MEMORY_SCOPE_AGENT); }
DEVI unsigned xb_add(unsigned* p, unsigned v) { return __hip_atomic_fetch_add(p, v, __ATOMIC_RELAXED, __HIP_MEMORY_SCOPE_AGENT); }
DEVI unsigned xb_xcc_id() { return (unsigned)__builtin_amdgcn_s_getreg((3 << 11) | 20) & 0xFu; }
#define XB_SPIN(cond, bar) do { unsigned _sp = 0; while (cond) { __builtin_amdgcn_s_sleep(1); \
    if ((++_sp & 255u) == 0u) { if (xb_ld(&(bar)[XB_TMO])) break; if (_sp > XB_SPIN_CAP) { atomicAdd(&(bar)[XB_TMO], 1u); break; } } } } while (0)
struct XcdBarrier { unsigned* bar; unsigned x; volatile LAS unsigned* st; };
DEVI XcdBarrier xcd_barrier_post(unsigned* bar, volatile LAS unsigned* st) {
    XcdBarrier b; b.bar = bar; b.x = xb_xcc_id(); b.st = st;
    if (threadIdx.x == 0) st[3] = xb_add(&bar[XB_XCNT(b.x)], 1u);
    return b;
}
DEVI void xcd_barrier_complete(unsigned* bar, unsigned x, unsigned& nloc, unsigned& nx) {
    const unsigned G = gridDim.x * gridDim.y * gridDim.z;
    unsigned sum, cnt, mine, sp = 0u;
    for (;;) {
        sum = 0u; cnt = 0u; mine = 0u;
#pragma unroll
        for (unsigned j = 0; j < 16; ++j) { const unsigned c = xb_ld(&bar[XB_XCNT(j)]); sum += c; cnt += (c > 0u) ? 1u : 0u; mine = (j == x) ? c : mine; }
        if (sum == G) break;
        __builtin_amdgcn_s_sleep(1);
        if ((++sp & 255u) == 0u) { if (xb_ld(&bar[XB_TMO])) break; if (sp > XB_SPIN_CAP) { atomicAdd(&bar[XB_TMO], 1u); break; } }
    }
    nloc = mine > 0u ? mine : 1u; nx = cnt > 0u ? cnt : 1u;
}
DEVI void xcd_barrier(const XcdBarrier& b) {
    asm volatile("s_waitcnt vmcnt(0)" ::: "memory");
    __syncthreads();
    if (threadIdx.x == 0) {
        unsigned* bar = b.bar;
        __builtin_amdgcn_s_waitcnt(0);
        unsigned nloc = b.st[0], nx = b.st[1];
        if (nloc == 0u) { xcd_barrier_complete(bar, b.x, nloc, nx); b.st[0] = nloc; b.st[1] = nx; }
        const unsigned old = xb_add(&bar[XB_XSUB(b.x)], 1u);
        const unsigned gen = old / nloc;
        if (old + 1u == (gen + 1u) * nloc) {
            __builtin_amdgcn_fence(__ATOMIC_RELEASE, "agent");
            asm volatile("s_waitcnt vmcnt(0)" ::: "memory");
            const unsigned og = xb_add(&bar[XB_TOP], 1u);
            const unsigned tg = og / nx;
            if (og + 1u == (tg + 1u) * nx) xb_add(&bar[XB_TOPGEN], 1u);
            else XB_SPIN(xb_ld(&bar[XB_TOPGEN]) == tg, bar);
            __builtin_amdgcn_fence(__ATOMIC_ACQUIRE, "agent");
            xb_add(&bar[XB_XGEN(b.x)], 1u);
            asm volatile("s_waitcnt vmcnt(0)" ::: "memory");
        } else {
            XB_SPIN(xb_ld(&bar[XB_XGEN(b.x)]) == gen, bar);
            __builtin_amdgcn_fence(__ATOMIC_ACQUIRE, "agent");
            asm volatile("s_waitcnt vmcnt(0)" ::: "memory");
        }
    }
    __syncthreads();
}
constexpr size_t OFF_BAR = 131072;

#ifndef DBG
#define DBG 0
#endif
DEVI void dump_f32(const Params& p, size_t off) {
    const f32x4* src = (const f32x4*)(p.ws + off); f32x4* dst = (f32x4*)p.out;
    for (int i = blockIdx.x * 256 + threadIdx.x; i < T_ * D_ / 4; i += gridDim.x * 256) dst[i] = src[i];
}
DEVI void dump_bf16(const Params& p, size_t off, int ld, int coff) {
    const bf16_t* src = (const bf16_t*)(p.ws + off);
    for (int i = blockIdx.x * 256 + threadIdx.x; i < T_ * D_; i += gridDim.x * 256) { const int row = i >> 10, col = i & 1023; p.out[i] = bf2f(src[(size_t)row * ld + coff + col]); }
}
DEVI float flat_bf(const Params& p, size_t off, size_t n, size_t i) { const bf16_t* b = (const bf16_t*)(p.ws + off); float a = 0.f; for (size_t j = i; j < n; j += (size_t)T_ * D_) a += bf2f(b[j]); return a; }
DEVI void dump_p1(const Params& p) {
    const size_t N = (size_t)T_ * D_;
    for (size_t i = (size_t)blockIdx.x * 256 + threadIdx.x; i < N; i += (size_t)gridDim.x * 256) {
        float a = 0.f;
        a += flat_bf(p, OFF_MG, 2 * N, i) + flat_bf(p, OFF_GS, 2 * N, i);
        a += flat_bf(p, OFF_QR, N / 2, i % (N / 2)) + flat_bf(p, OFF_KR, N / 2, i % (N / 2)) + flat_bf(p, OFF_QG, N / 2, i % (N / 2));
        a += flat_bf(p, OFF_KRT, N / 2, i % (N / 2)) + flat_bf(p, OFF_KGT, N / 2, i % (N / 2));
        a += flat_bf(p, OFF_VRT, N, i) + flat_bf(p, OFF_VGT, N, i);
        a += ((const float*)(p.ws + OFF_GA))[i % ((size_t)T_ * 16)];
        p.out[i] = a;
    }
}
constexpr int NPHASE = 13;
__global__ void __launch_bounds__(512, 2) fwd_megakernel(Params p) {
    unsigned char* const smem_all = smem_all_g;
    unsigned char* smem = smem_all + VH * SMEM_HALF;
    uint4* xb_words = (uint4*)(smem_all + 2 * SMEM_HALF - 16);
    if (threadIdx.x == 0) *xb_words = make_uint4(0u, 0u, blockIdx.x, 0u);
    __syncthreads();
    const XcdBarrier xb = xcd_barrier_post((unsigned*)(p.ws + OFF_BAR), (volatile LAS unsigned*)xb_words);
#ifndef REPMASK
#define REPMASK 0
#endif
#ifndef TIMEPHASE
#define TIMEPHASE -1
#endif
#define RUN_PHASE(K, CALL) do { if (p.phase_lo <= (K) && (K) < p.phase_hi) { \
        const unsigned long long tp0_ = (TIMEPHASE == (K)) ? __builtin_amdgcn_s_memrealtime() : 0ull; \
        _Pragma("unroll 1") for (int rep_ = ((REPMASK >> (K)) & 1); rep_ >= 0; --rep_) { CALL; if (rep_ > 0 || (K) + 1 < p.phase_hi) xcd_barrier(xb); } \
        if (TIMEPHASE == (K)) { const unsigned long long tp1_ = __builtin_amdgcn_s_memrealtime(); while (__builtin_amdgcn_s_memrealtime() - tp1_ < tp1_ - tp0_) __builtin_amdgcn_s_sleep(8); } } } while (0)
    RUN_PHASE(0, phase0(p, smem));
    if (p.phase_lo == 0 && p.phase_hi > 1) {
        if (threadIdx.x == 0) {
            unsigned* bar = (unsigned*)(p.ws + OFF_BAR); bool ok = (gridDim.x & 7u) == 0u && xb.x < 8u;
            for (unsigned j = 0; j < 16; ++j) { const unsigned c = xb_ld(&bar[XB_XCNT(j)]); ok = ok && (j < 8 ? c == gridDim.x / 8u : c == 0u); }
            if (ok) ((volatile int*)xb_words)[2] = (int)(((volatile unsigned*)xb_words)[3] * 8u + xb.x);
        }
        __syncthreads();
    }
    RUN_PHASE(1, phase1(p, smem_all));
#if DBG == 2
    dump_p1(p); return;
#endif
    RUN_PHASE(2, phase2(p, smem));
#if DBG == 5
    { const size_t N = (size_t)T_ * D_; for (size_t i = (size_t)blockIdx.x * 256 + threadIdx.x; i < N; i += (size_t)gridDim.x * 256) p.out[i] = flat_bf(p, OFF_KG2, N / 2, i % (N / 2)) + ((const float*)(p.ws + OFF_DEC))[i % (2048 * 128)]; } return;
#endif
#ifdef SCANPROBE
    phase3t(p, smem, 1); xcd_barrier(xb);
#endif
    RUN_PHASE(3, phase3t(p, smem, 0));
#if DBG == 6
    dump_bf16(p, OFF_OO, 2048, 1024); return;
#endif
#if DBG == 7
    { const bf16_t* src = (const bf16_t*)(p.ws + OFF_OO);
      for (int i = blockIdx.x * 256 + threadIdx.x; i < T_ * D_; i += gridDim.x * 256) { const int row = i >> 10, col = i & 1023; const float v = bf2f(src[(size_t)row * 2048 + 1024 + col]); p.out[i] = (fabsf(v) < 1e30f) ? v : 12345.0f; } } return;
#endif
    RUN_PHASE(4, phase4(p, smem));
#if DBG == 3
    dump_bf16(p, OFF_Y, 2048, 0); return;
#endif
#if DBG == 4
    dump_bf16(p, OFF_Y, 2048, 1024); return;
#endif
    RUN_PHASE(5, phase5(p, smem_all));
    RUN_PHASE(6, phase6(p, smem_all));
    RUN_PHASE(7, phase7(p, smem));
#if DBG == 1
    return;
#endif
    RUN_PHASE(8, phase8(p, smem_all));
    RUN_PHASE(10, phase10(p, smem_all));
    RUN_PHASE(11, phase11(p, smem_all));
    RUN_PHASE(12, phase12(p));
#ifdef BARPROBE
    _Pragma("unroll 1") for (int bp_ = 0; bp_ < 20; ++bp_) xcd_barrier(xb);
#endif
#undef RUN_PHASE
}

extern "C" void kernel_launch(void* const* d_in, const int* in_sizes, int n_in, void* d_out, int out_size, void* d_ws, size_t ws_size,
                              hipStream_t stream) {
    static int grid_blocks = 0;
    if (!grid_blocks) {
        int dev = 0, cus = 0, per_cu = 0;
        hipGetDevice(&dev);
        hipDeviceGetAttribute(&cus, hipDeviceAttributeMultiprocessorCount, dev);
        hipOccupancyMaxActiveBlocksPerMultiprocessor(&per_cu, fwd_megakernel, 512, 0);
        if (per_cu > 1) per_cu = 1;
        if (per_cu < 1) per_cu = 1;
        grid_blocks = cus * per_cu;
    }
    if (ws_size < WS_NEEDED) { fprintf(stderr, "workspace too small: %zu < %zu\n", ws_size, (size_t)WS_NEEDED); return; }
    Params p{};
    p.x = (const float*)d_in[0]; p.w_in = (const float*)d_in[1]; p.ret_norm_g = (const float*)d_in[2]; p.gate_w2 = (const float*)d_in[3];
    p.gate_b = (const float*)d_in[4]; p.gla_norm_g = (const float*)d_in[5]; p.w_ret_out = (const float*)d_in[6]; p.w_gla_out = (const float*)d_in[7];
    p.w_o = (const float*)d_in[8]; p.ln1_g = (const float*)d_in[9]; p.ln1_b = (const float*)d_in[10]; p.router_w = (const float*)d_in[11];
    p.router_bias = (const float*)d_in[12]; p.ew_gate = (const float*)d_in[13]; p.ew_up = (const float*)d_in[14]; p.ew_down = (const float*)d_in[15];
    p.sw_gate = (const float*)d_in[16]; p.sw_up = (const float*)d_in[17]; p.sw_down = (const float*)d_in[18]; p.ln2_g = (const float*)d_in[19];
    p.ln2_b = (const float*)d_in[20];
    p.out = (float*)d_out; p.ws = (unsigned char*)d_ws; p.phase_lo = 0; p.phase_hi = NPHASE;
    void* args[] = {&p};
    (void)hipMemsetAsync((unsigned char*)d_ws + OFF_BAR, 0, XCD_BAR_WORDS * 4, stream);
    hipError_t e = hipLaunchCooperativeKernel((void*)fwd_megakernel, dim3(grid_blocks), dim3(512), args, 0, stream);
    if (e != hipSuccess) fprintf(stderr, "cooperative launch failed: %s (grid %d)\n", hipGetErrorString(e), grid_blocks);
}
```

```cpp
#include <hip/hip_runtime.h>
#include <hip/hip_cooperative_groups.h>
#include <cstdio>
#include <cstdint>
namespace cg = cooperative_groups;

typedef unsigned short bf16_t;
typedef short bf16x8 __attribute__((ext_vector_type(8)));
typedef float f32x4 __attribute__((ext_vector_type(4)));
typedef unsigned u32x2 __attribute__((ext_vector_type(2)));
typedef unsigned u32x4 __attribute__((ext_vector_type(4)));
#define DEVI __device__ __forceinline__
#define VH ((int)(threadIdx.x >> 8))
#define VT ((int)(threadIdx.x & 255))
#define RB (__builtin_amdgcn_readfirstlane(((const int*)(smem_all_g + 2 * SMEM_HALF - 16))[2]))
#define RG ((int)gridDim.x)
#define VB (RB * 2 + VH)
#define VG (RG * 2)

constexpr int T_ = 32768;
constexpr int D_ = 1024;
constexpr int DIN_ = 8208;
constexpr int NE_ = 256;
constexpr float ALPHA_ = 1.189207115002721f;
constexpr float KSCALE_ = 0.08838834764831845f;

constexpr size_t MB = 1ull << 20;
constexpr size_t OFF_CNT  = (size_t)766 << 20;
constexpr int CNT_STRIDE = 1024;
constexpr size_t OFF_CS   = 1 * MB;
constexpr size_t OFF_WT   = 3 * MB;
constexpr size_t FB = 27 * MB;
constexpr size_t OFF_QR   = FB + 0 * MB;
constexpr size_t OFF_KR   = FB + 32 * MB;
constexpr size_t OFF_VRT  = FB + 64 * MB;
constexpr size_t OFF_GS   = FB + 128 * MB;
constexpr size_t OFF_MG   = FB + 256 * MB;
constexpr size_t OFF_KRT  = FB + 384 * MB;
constexpr size_t OFF_QG   = FB + 416 * MB;
constexpr size_t OFF_VGT  = FB + 448 * MB;
constexpr size_t OFF_KGT  = FB + 512 * MB;
constexpr size_t OFF_GA   = FB + 544 * MB;
constexpr size_t OFF_XB   = FB + 546 * MB;
constexpr size_t OFF_KG2  = FB + 546 * MB;
constexpr size_t OFF_DEC  = FB + 578 * MB;
constexpr size_t OFF_OO   = FB + 579 * MB;
constexpr size_t OFF_Y    = FB + 384 * MB;
constexpr size_t OFF_MRG  = FB + 0 * MB;
constexpr size_t OFF_QGN  = 767 * MB;
constexpr size_t OFF_QFR  = 734 * MB;
constexpr size_t OFF_WGU  = 767 * MB;
constexpr size_t OFF_X1B  = FB + 0 * MB;
constexpr size_t OFF_WD   = FB + 64 * MB;
constexpr size_t OFF_LIST = FB + 193 * MB;
constexpr size_t OFF_WL   = FB + 193 * MB + 512 * MB;
constexpr size_t OFF_H    = FB + 227 * MB;
constexpr size_t OFF_YX   = FB + 371 * MB;
constexpr size_t OFF_T1   = FB + 371 * MB;
constexpr size_t WS_NEEDED = 1024 * MB;

constexpr int WT_BN = 0, WT_AT = 5888, WT_RET = 8960, WT_GLA = 9984, WT_O = 11008, WT_R = 12032, WT_ROWS = 12288;

struct Params {
    const float *x, *w_in, *ret_norm_g, *gate_w2, *gate_b, *gla_norm_g, *w_ret_out, *w_gla_out, *w_o, *ln1_g, *ln1_b,
                *router_w, *router_bias, *ew_gate, *ew_up, *ew_down, *sw_gate, *sw_up, *sw_down, *ln2_g, *ln2_b;
    float* out;
    unsigned char* ws;
    int phase_lo, phase_hi;
};

static __device__ const float c_inv_freq[64] = {
  1.000000000e+00f, 8.659643531e-01f, 7.498942018e-01f, 6.493816376e-01f,
  5.623413324e-01f, 4.869675338e-01f, 4.216965139e-01f, 3.651741147e-01f,
  3.162277639e-01f, 2.738419771e-01f, 2.371373773e-01f, 2.053525001e-01f,
  1.778279394e-01f, 1.539926529e-01f, 1.333521456e-01f, 1.154781953e-01f,
  1.000000015e-01f, 8.659642935e-02f, 7.498942316e-02f, 6.493816525e-02f,
  5.623413250e-02f, 4.869675264e-02f, 4.216964915e-02f, 3.651741147e-02f,
  3.162277490e-02f, 2.738419548e-02f, 2.371373773e-02f, 2.053525113e-02f,
  1.778279431e-02f, 1.539926510e-02f, 1.333521400e-02f, 1.154781971e-02f,
  9.999999776e-03f, 8.659643121e-03f, 7.498942316e-03f, 6.493816152e-03f,
  5.623413250e-03f, 4.869675264e-03f, 4.216964822e-03f, 3.651741194e-03f,
  3.162277630e-03f, 2.738419687e-03f, 2.371373819e-03f, 2.053525066e-03f,
  1.778279431e-03f, 1.539926510e-03f, 1.333521446e-03f, 1.154782018e-03f,
  1.000000047e-03f, 8.659643354e-04f, 7.498941850e-04f, 6.493816036e-04f,
  5.623413017e-04f, 4.869675322e-04f, 4.216965172e-04f, 3.651741135e-04f,
  3.162277571e-04f, 2.738419571e-04f, 2.371373703e-04f, 2.053525095e-04f,
  1.778279402e-04f, 1.539926598e-04f, 1.333521504e-04f, 1.154782003e-04f };

DEVI float bf2f(unsigned short u) { return __uint_as_float(((unsigned)u) << 16); }
DEVI float bflo(unsigned u) { return __uint_as_float(u << 16); }
DEVI float bfhi(unsigned u) { return __uint_as_float(u & 0xffff0000u); }
typedef float f32x2 __attribute__((ext_vector_type(2)));
typedef __bf16 bf16x2_t __attribute__((ext_vector_type(2)));
DEVI unsigned pk2(float lo, float hi) { const f32x2 v = {lo, hi}; const bf16x2_t b = __builtin_convertvector(v, bf16x2_t); return __builtin_bit_cast(unsigned, b); }
DEVI unsigned short f2bf(float f) { return (unsigned short)(pk2(f, 0.f) & 0xffffu); }
DEVI u32x2 pk4(f32x4 v) { u32x2 r; r.x = pk2(v[0], v[1]); r.y = pk2(v[2], v[3]); return r; }
DEVI f32x4 unpk4(u32x2 u) { f32x4 r; r[0] = bflo(u.x); r[1] = bfhi(u.x); r[2] = bflo(u.y); r[3] = bfhi(u.y); return r; }
constexpr float YX_SCALE = 16.0f;
DEVI unsigned pk4_fp8(f32x4 v) { int w = 0; w = __builtin_amdgcn_cvt_pk_fp8_f32(v[0], v[1], w, false); w = __builtin_amdgcn_cvt_pk_fp8_f32(v[2], v[3], w, true); return (unsigned)w; }
DEVI f32x4 unpk4_fp8(unsigned u) { f32x4 r; r[0] = __builtin_amdgcn_cvt_f32_fp8((int)u, 0); r[1] = __builtin_amdgcn_cvt_f32_fp8((int)u, 1); r[2] = __builtin_amdgcn_cvt_f32_fp8((int)u, 2); r[3] = __builtin_amdgcn_cvt_f32_fp8((int)u, 3); return r; }
DEVI f32x4 clamp4(f32x4 v, float lim) { f32x4 r; for (int i = 0; i < 4; ++i) r[i] = __builtin_amdgcn_fmed3f(v[i], -lim, lim); return r; }
DEVI float sigmoidf_(float v) { return __builtin_amdgcn_rcpf(1.0f + __builtin_amdgcn_exp2f(v * -1.4426950408889634f)); }
DEVI float siluf_(float v) { return v * __builtin_amdgcn_rcpf(1.0f + __builtin_amdgcn_exp2f(v * -1.4426950408889634f)); }
DEVI float gamma_log2(int h) { return log2f(1.0f - exp2f(-5.0f - (float)h)); }
DEVI f32x4 mfma16(bf16x8 a, bf16x8 b, f32x4 c) { return __builtin_amdgcn_mfma_f32_16x16x32_bf16(a, b, c, 0, 0, 0); }
DEVI unsigned kf_off(int item, int dk, int m8) { return ((((unsigned)item * 4u + (unsigned)(dk >> 5)) * 4u + (unsigned)(m8 >> 4)) * 64u + (unsigned)((m8 >> 3) & 1) * 32u + (unsigned)(dk & 31)) * 8u; }
DEVI unsigned vf_off(int item, int dv, int m8) { return ((((unsigned)item * 8u + (unsigned)(dv >> 5)) * 4u + (unsigned)(m8 >> 4)) * 64u + (unsigned)((m8 >> 3) & 1) * 32u + (unsigned)(dv & 31)) * 8u; }
DEVI unsigned qf_off(int bc, int h, int tokl, int dk8, int hh) {
    return ((((((unsigned)bc * 4u + (unsigned)h) * 2u + (unsigned)(tokl >> 5)) * 4u + (unsigned)(dk8 >> 5)) * 2u + (unsigned)((dk8 >> 4) & 1)) * 64u + (unsigned)hh * 32u + (unsigned)(tokl & 31)) * 8u + (unsigned)((dk8 >> 3) & 1) * 4u; }
DEVI int vperm(int n) { const int wc = n >> 6, nt = (n >> 4) & 3, i = n & 15; return wc * 64 + (nt >> 1) * 32 + 8 * (i >> 2) + 4 * (nt & 1) + (i & 3); }
DEVI int dperm2(int v) { return ((v >> 5) & 1) * 64 + (v >> 6) * 32 + (v & 31); }
DEVI u32x4 pk8(f32x4 a, f32x4 b) { u32x4 r; r.x = pk2(a[0], a[1]); r.y = pk2(a[2], a[3]); r.z = pk2(b[0], b[1]); r.w = pk2(b[2], b[3]); return r; }
DEVI void unpk8(u32x4 u, f32x4& a, f32x4& b) { a[0] = bflo(u.x); a[1] = bfhi(u.x); a[2] = bflo(u.y); a[3] = bfhi(u.y); b[0] = bflo(u.z); b[1] = bfhi(u.z); b[2] = bflo(u.w); b[3] = bfhi(u.w); }
DEVI int dperm(int v) { const int wc = v >> 6, nt = (v >> 4) & 3, c = v & 15; return (nt & 1) * 16 + wc * 32 + c + (nt >> 1) * 64; }

struct __attribute__((aligned(16))) GemmSmem { bf16_t a[2][128 * 64]; bf16_t b[2][128 * 64]; };
constexpr int SMEM_GEMM = sizeof(GemmSmem);
constexpr int SMEM_BYTES = SMEM_GEMM + 2048 + 16;
constexpr int SMEM_HALF = (SMEM_BYTES + 255) & ~255;
constexpr int SMEM_MOE = 16384;
__shared__ __attribute__((aligned(16))) unsigned char smem_all_g[2 * SMEM_HALF + SMEM_MOE];
DEVI int gemm_src_chunk(int t) { return ((t & 7) ^ ((t >> 4) & 7)) * 8; }

template <bool SWAP, int BKIND>
DEVI void gemm_kloop(f32x4 (&acc)[4][4], const bf16_t* const (&pa)[4], const bf16_t* const (&pb)[4],
                     const float* pbf, int ldb, int nk, GemmSmem& sm) {
    const int t = VT, lane = t & 63, w = t >> 6, wr = w >> 1, wc = w & 1, l15 = lane & 15, q = lane >> 4;
    const int kg = t & 7, ng = t >> 3;
    f32x4 rf[8];
#define GEMM_ISSUE(BUF, KO) do { \
        _Pragma("unroll") for (int i = 0; i < 4; ++i) \
            __builtin_amdgcn_global_load_lds((const unsigned*)(pa[i] + (KO)), (unsigned*)((char*)sm.a[BUF] + i * 4096 + t * 16), 16, 0, 0); \
        if (BKIND == 0) { _Pragma("unroll") for (int i = 0; i < 4; ++i) \
            __builtin_amdgcn_global_load_lds((const unsigned*)(pb[i] + (KO)), (unsigned*)((char*)sm.b[BUF] + i * 4096 + t * 16), 16, 0, 0); } \
        else { const float* pp = pbf + (size_t)((KO) + 4 * kg) * ldb; \
            _Pragma("unroll") for (int i = 0; i < 4; ++i) { rf[i] = *(const f32x4*)(pp + (size_t)i * ldb); rf[4 + i] = *(const f32x4*)(pp + (size_t)(32 + i) * ldb); } } } while (0)
#define GEMM_LSTORE_B(BUF) do { if (BKIND == 1) { \
            _Pragma("unroll") for (int i = 0; i < 4; ++i) { \
                u32x2 v0, v1; \
                v0.x = pk2(rf[0][i], rf[1][i]); v0.y = pk2(rf[2][i], rf[3][i]); v1.x = pk2(rf[4][i], rf[5][i]); v1.y = pk2(rf[6][i], rf[7][i]); \
                const int n = 4 * ng + i, sw = (n >> 1) & 7; \
                char* rowp = (char*)sm.b[BUF] + n * 128 + (kg & 1) * 8; \
                *(u32x2*)(rowp + (((kg >> 1) ^ sw) * 16)) = v0; *(u32x2*)(rowp + (((4 + (kg >> 1)) ^ sw) * 16)) = v1; } } } while (0)
    GEMM_ISSUE(0, 0);
    GEMM_LSTORE_B(0);
    __syncthreads();
#define GEMM_KSTEP(CUR, KT) do { \
        const bool more = ((KT) + 1 < nk); \
        if (more) { GEMM_ISSUE((CUR) ^ 1, ((KT) + 1) * 64); } \
        __builtin_amdgcn_sched_barrier(0); \
        _Pragma("unroll") for (int ss = 0; ss < 2; ++ss) { \
            bf16x8 af[4], bfr[4]; \
            const int coff = ((ss * 4 + q) ^ (l15 >> 1)) * 16; \
            _Pragma("unroll") for (int i = 0; i < 4; ++i) { \
                af[i]  = *(const bf16x8*)((const char*)sm.a[CUR] + (wr * 64 + i * 16 + l15) * 128 + coff); \
                bfr[i] = *(const bf16x8*)((const char*)sm.b[CUR] + (wc * 64 + i * 16 + l15) * 128 + coff); } \
            _Pragma("unroll") for (int mt = 0; mt < 4; ++mt) \
                _Pragma("unroll") for (int nt = 0; nt < 4; ++nt) \
                    acc[mt][nt] = SWAP ? mfma16(bfr[nt], af[mt], acc[mt][nt]) : mfma16(af[mt], bfr[nt], acc[mt][nt]); } \
        __builtin_amdgcn_sched_barrier(0); \
        if (more) { GEMM_LSTORE_B((CUR) ^ 1); } \
        __syncthreads(); } while (0)
#pragma unroll 1
    for (int kt = 0; kt < nk; kt += 2) { GEMM_KSTEP(0, kt); GEMM_KSTEP(1, kt + 1); }
#undef GEMM_KSTEP
#undef GEMM_LSTORE_B
#undef GEMM_ISSUE
}

DEVI void zero_acc(f32x4 (&acc)[4][4]) {
#pragma unroll
    for (int i = 0; i < 4; ++i)
#pragma unroll
        for (int j = 0; j < 4; ++j) acc[i][j] = (f32x4){0.f, 0.f, 0.f, 0.f};
}

namespace pg8 {
#define PG8_LAS __attribute__((address_space(3)))
typedef unsigned short bf16_t;
typedef short bf16x8 __attribute__((ext_vector_type(8)));
typedef float f32x4 __attribute__((ext_vector_type(4)));
typedef unsigned u32x4 __attribute__((ext_vector_type(4)));
constexpr int BM = 256, BK = 64, HALF = 128, HTB = HALF * BK * 2  , STAGE_BYTES = 8 * HTB, NXCD = 8, WGM = 8;

__host__ __device__ __forceinline__ int lds_byte(int r, int c) { const int st = (r >> 4) * 2 + (c >> 5), rr = r & 15, cc = c & 31, ob = rr * 64 + cc * 2; return st * 1024 + (ob ^ (((ob >> 9) & 1) << 5)); }
__host__ __device__ __forceinline__ void stage_rc(int b, int& R, int& C) { const int st = b / 1024, sb = b % 1024, swz = sb ^ (((sb >> 9) & 1) << 5); R = (st >> 1) * 16 + swz / 64; C = (st & 1) * 32 + (swz % 64) / 2; }
__host__ __device__ __forceinline__ int perm32(int rho) { const int n = rho >> 4, i = rho & 15; return 8 * (i >> 2) + 4 * n + (i & 3); }

struct Unit { int pm, pn, e, r0, ce; };
struct Gemm { const bf16_t* A; const bf16_t* Bt; int M, N, K; };

struct StaticOrder {
    int nM, nN, nwg, G, c;
    __host__ __device__ void init(int M, int N, int G_, int c_) { nM = M / BM; nN = N / BM; nwg = nM * nN; G = G_; c = c_; }
    __host__ __device__ bool next(int i, Unit& u) const {
        const long L = (long)i * G + c; if (L >= nwg) return false;
        int wgid = (int)L; { const int q = nwg / NXCD, r = nwg % NXCD, xcd = wgid % NXCD, off = wgid / NXCD; wgid = (xcd < r ? xcd * (q + 1) : r * (q + 1) + (xcd - r) * q) + off; }
        const int nig = WGM * nN, gid = wgid / nig, fm = gid * WGM, gsz = (nM - fm) < WGM ? (nM - fm) : WGM;
        u.pm = fm + ((wgid % nig) % gsz); u.pn = (wgid % nig) / gsz; return true;
    }
    __device__ __forceinline__ void a_ready(const Unit&) const {}
    __device__ __forceinline__ void done(const Unit&) const {}
};


template <class Epi, class Sched, bool ALIGN_EPI = false, bool SP2 = false>
__device__ __forceinline__ void gemm_phase(PG8_LAS unsigned char* lds, const Gemm g, const Sched& S, const Epi& E) {
    const int tid = threadIdx.x, wid = __builtin_amdgcn_readfirstlane(tid >> 6), lane = tid & 63, wr = wid >> 2, wc = wid & 3, fr = lane & 15, fq = lane >> 4;
    const int K = g.K, nt = K / BK;
    unsigned voffA[2], voffB[2];
#pragma unroll
    for (int i = 0; i < 2; ++i) { int R, C; stage_rc(tid * 16 + i * 8192, R, C); const int Rb = Epi::PERM ? ((R & ~31) + perm32(R & 31)) : R;
        voffA[i] = (unsigned)(R * K + C) * 2u; voffB[i] = (unsigned)(Rb * K + C) * 2u; }
    const size_t kstep = (size_t)(BK * 2);
    const size_t hstep = (size_t)HALF * K * 2;
    const size_t tstep = 2 * hstep;
    const unsigned ldsw = (unsigned)wid * 1024u;
    const int aoff = lds_byte(wr * 64 + fr, fq * 8), boff = lds_byte(wc * 32 + fr, fq * 8);
#define PG8_SA(b, h) (((b) * 2 + (h)) * HTB)
#define PG8_SB(b, h) ((4 + (b) * 2 + (h)) * HTB)
#define PG8_STAGE(bufoff, gbase, voff) do { _Pragma("unroll") for (int _i = 0; _i < 2; ++_i) \
        __builtin_amdgcn_global_load_lds((const unsigned*)((const char*)(gbase) + (voff)[_i]), (PG8_LAS unsigned*)(lds + (bufoff) + ldsw + _i * 8192), 16, 0, 0); } while (0)
#define PG8_LDA(dst, b, h) do { _Pragma("unroll") for (int m = 0; m < 4; ++m) _Pragma("unroll") for (int k = 0; k < 2; ++k) dst[m][k] = *(const PG8_LAS bf16x8*)(lds + PG8_SA(b, h) + aoff + m * 2048 + k * 1024); } while (0)
#define PG8_LDB(dst, b, h) do { _Pragma("unroll") for (int n = 0; n < 2; ++n) _Pragma("unroll") for (int k = 0; k < 2; ++k) dst[n][k] = *(const PG8_LAS bf16x8*)(lds + PG8_SB(b, h) + boff + n * 2048 + k * 1024); } while (0)
#define PG8_MMA(ai, bj, At, Bt) do { __builtin_amdgcn_s_setprio(1); _Pragma("unroll") for (int m = 0; m < 4; ++m) _Pragma("unroll") for (int n = 0; n < 2; ++n) _Pragma("unroll") for (int k = 0; k < 2; ++k) \
        acc[ai][bj][m][n] = __builtin_amdgcn_mfma_f32_16x16x32_bf16(Bt[n][k], At[m][k], acc[ai][bj][m][n], 0, 0, 0); __builtin_amdgcn_s_setprio(0); } while (0)
#define PG8_WAIT_V(n) asm volatile("s_waitcnt vmcnt(" #n ")" ::: "memory")
#define PG8_WAIT_L(n) asm volatile("s_waitcnt lgkmcnt(" #n ")" ::: "memory")
#define PG8_BAR __builtin_amdgcn_s_barrier()
#define PG8_SCHED __builtin_amdgcn_sched_barrier(0)
    Unit cur, nxt; int ui = 0;
    if (!S.next(0, cur)) return;
    f32x4 acc[2][2][4][2];
#pragma unroll
    for (int a = 0; a < 2; ++a)
#pragma unroll
        for (int b = 0; b < 2; ++b)
#pragma unroll
            for (int m = 0; m < 4; ++m)
#pragma unroll
                for (int n = 0; n < 2; ++n) acc[a][b][m][n] = (f32x4){0.f, 0.f, 0.f, 0.f};
    bf16x8 At[4][2], B0[2][2], B1[2][2];
    const char* cA = (const char*)g.A + (size_t)cur.pm * tstep; const char* cB = (const char*)g.Bt + (size_t)cur.pn * tstep;
    S.a_ready(cur);
    if constexpr (SP2) {
        PG8_STAGE(PG8_SB(0, 0), cB, voffB); PG8_STAGE(PG8_SB(0, 1), cB + hstep, voffB); PG8_STAGE(PG8_SA(0, 0), cA, voffA); PG8_STAGE(PG8_SA(0, 1), cA + hstep, voffA);
        if (wr == 1) PG8_BAR;
        PG8_WAIT_V(2); PG8_BAR;
        PG8_STAGE(PG8_SB(1, 0), cB + kstep, voffB); PG8_STAGE(PG8_SA(1, 0), cA + kstep, voffA); PG8_STAGE(PG8_SB(1, 1), cB + hstep + kstep, voffB);
        PG8_WAIT_V(6); PG8_BAR;
    } else {
        PG8_STAGE(PG8_SB(0, 0), cB, voffB); PG8_STAGE(PG8_SA(0, 0), cA, voffA); PG8_STAGE(PG8_SB(0, 1), cB + hstep, voffB); PG8_STAGE(PG8_SA(0, 1), cA + hstep, voffA);
        if (wr == 1) PG8_BAR;
        PG8_WAIT_V(4); PG8_BAR;
        PG8_STAGE(PG8_SB(1, 0), cB + kstep, voffB); PG8_STAGE(PG8_SA(1, 0), cA + kstep, voffA); PG8_STAGE(PG8_SB(1, 1), cB + hstep + kstep, voffB);
        PG8_WAIT_V(6); PG8_BAR;
    }
    for (;;) {
        const bool has_next = S.next(ui + 1, nxt);
        const char* nA = has_next ? (const char*)g.A + (size_t)nxt.pm * tstep : cA; const char* nB = has_next ? (const char*)g.Bt + (size_t)nxt.pn * tstep : cB;
        for (int t = 0; t < nt; t += 2) {
            const bool last = (t == nt - 2);
            const char* a1 = cA + (size_t)(t + 1) * kstep;
            const char* a2 = last ? nA : cA + (size_t)(t + 2) * kstep; const char* b2 = last ? nB : cB + (size_t)(t + 2) * kstep;
            const char* a3 = a2 + kstep; const char* b3 = b2 + kstep;
            if (last && has_next) S.a_ready(nxt);
            if constexpr (SP2) {
            PG8_LDB(B0, 0, 0); PG8_LDB(B1, 0, 1); PG8_SCHED; PG8_LDA(At, 0, 0); PG8_STAGE(PG8_SA(1, 1), a1 + hstep, voffA);
            PG8_WAIT_V(8); PG8_WAIT_L(0); PG8_BAR; PG8_MMA(0, 0, At, B0); PG8_MMA(0, 1, At, B1); PG8_BAR; PG8_SCHED;
            PG8_LDA(At, 0, 1); PG8_STAGE(PG8_SB(0, 0), b2, voffB); PG8_STAGE(PG8_SB(0, 1), b2 + hstep, voffB); PG8_STAGE(PG8_SA(0, 0), a2, voffA);
            PG8_WAIT_V(8); PG8_WAIT_L(0); PG8_BAR; PG8_MMA(1, 0, At, B0); PG8_MMA(1, 1, At, B1); PG8_BAR; PG8_SCHED;
            PG8_LDB(B0, 1, 0); PG8_LDB(B1, 1, 1); PG8_SCHED; PG8_LDA(At, 1, 0); PG8_STAGE(PG8_SA(0, 1), a2 + hstep, voffA);
            PG8_WAIT_V(8); PG8_WAIT_L(0); PG8_BAR; PG8_MMA(0, 0, At, B0); PG8_MMA(0, 1, At, B1); PG8_BAR; PG8_SCHED;
            PG8_LDA(At, 1, 1); PG8_STAGE(PG8_SB(1, 0), b3, voffB); PG8_STAGE(PG8_SB(1, 1), b3 + hstep, voffB); PG8_STAGE(PG8_SA(1, 0), a3, voffA);
            PG8_WAIT_V(8); PG8_WAIT_L(0); PG8_BAR; PG8_MMA(1, 0, At, B0); PG8_MMA(1, 1, At, B1); PG8_BAR; PG8_SCHED;
            } else {
            PG8_LDB(B0, 0, 0); PG8_SCHED; PG8_LDA(At, 0, 0); PG8_STAGE(PG8_SA(1, 1), a1 + hstep, voffA);
            PG8_WAIT_L(8); PG8_BAR; PG8_WAIT_L(0); PG8_MMA(0, 0, At, B0); PG8_BAR; PG8_SCHED;
            PG8_LDB(B1, 0, 1); PG8_STAGE(PG8_SB(0, 0), b2, voffB);
            PG8_BAR; PG8_WAIT_L(0); PG8_MMA(0, 1, At, B1); PG8_BAR;
            PG8_LDA(At, 0, 1); PG8_STAGE(PG8_SA(0, 0), a2, voffA);
            PG8_BAR; PG8_WAIT_L(0); PG8_MMA(1, 0, At, B0); PG8_BAR; PG8_SCHED;
            PG8_STAGE(PG8_SB(0, 1), b2 + hstep, voffB);
            PG8_WAIT_V(6); PG8_BAR; PG8_MMA(1, 1, At, B1); PG8_BAR;
            PG8_LDB(B0, 1, 0); PG8_SCHED; PG8_LDA(At, 1, 0); PG8_STAGE(PG8_SA(0, 1), a2 + hstep, voffA);
            PG8_WAIT_L(8); PG8_BAR; PG8_WAIT_L(0); PG8_MMA(0, 0, At, B0); PG8_BAR; PG8_SCHED;
            PG8_LDB(B1, 1, 1); PG8_STAGE(PG8_SB(1, 0), b3, voffB);
            PG8_BAR; PG8_WAIT_L(0); PG8_MMA(0, 1, At, B1); PG8_BAR;
            PG8_LDA(At, 1, 1); PG8_STAGE(PG8_SA(1, 0), a3, voffA);
            PG8_BAR; PG8_WAIT_L(0); PG8_MMA(1, 0, At, B0); PG8_BAR; PG8_SCHED;
            PG8_STAGE(PG8_SB(1, 1), b3 + hstep, voffB);
            PG8_WAIT_V(6); PG8_BAR; PG8_MMA(1, 1, At, B1); PG8_BAR;
            }
        }
        if constexpr (ALIGN_EPI) { if (wr == 0) PG8_BAR; }
        if constexpr (!Epi::AFTER_DRAIN) { E(acc, cur, wr, wc, fr, fq); S.done(cur); }
        if (!has_next) break;
#pragma unroll
        for (int a = 0; a < 2; ++a)
#pragma unroll
            for (int b = 0; b < 2; ++b)
#pragma unroll
                for (int m = 0; m < 4; ++m)
#pragma unroll
                    for (int n = 0; n < 2; ++n) acc[a][b][m][n] = (f32x4){0.f, 0.f, 0.f, 0.f};
        cur = nxt; cA = nA; cB = nB; ++ui;
        if constexpr (ALIGN_EPI) { if (wr == 1) PG8_BAR; }
    }
    PG8_WAIT_V(0);
    if constexpr (!ALIGN_EPI) { if (wr == 0) PG8_BAR; }
    PG8_BAR;
    if constexpr (Epi::AFTER_DRAIN) { E.fused(acc, cur, wr, wc, fr, fq, lds, wid, lane); S.done(cur); }
#undef PG8_SA
#undef PG8_SB
#undef PG8_STAGE
#undef PG8_LDA
#undef PG8_LDB
#undef PG8_MMA
#undef PG8_WAIT_V
#undef PG8_WAIT_L
#undef PG8_BAR
#undef PG8_SCHED
}
template <class Epi, class Sched, bool ALIGN_EPI = false, bool SP2 = false>
__device__ __forceinline__ void gemm_phase_g(PG8_LAS unsigned char* lds, const int K, const Sched& S, const Epi& E) {
    const int tid = threadIdx.x, wid = __builtin_amdgcn_readfirstlane(tid >> 6), lane = tid & 63, wr = wid >> 2, wc = wid & 3, fr = lane & 15, fq = lane >> 4;
    const int nt = K / BK;
    unsigned voffB[2]; int rowA[2], colA[2];
#pragma unroll
    for (int i = 0; i < 2; ++i) { int R, C; stage_rc(tid * 16 + i * 8192, R, C); const int lc = perm32(R & 31);
        const int Rb = Epi::BJI ? (64 * (R >> 5) + 16 * (lc >> 3) + (lc & 7)) : (Epi::PERM ? ((R & ~31) + lc) : R);
        rowA[i] = R; colA[i] = C * 2; voffB[i] = (unsigned)(Rb * K + C) * 2u; }
    const size_t kstep = (size_t)(BK * 2);
    const size_t hstep = Epi::BJI ? (size_t)8 * K * 2 : (size_t)HALF * K * 2;
    const size_t tstep = 2 * hstep;
    const unsigned ldsw = (unsigned)wid * 1024u;
    const int aoff = lds_byte(wr * 64 + fr, fq * 8), boff = lds_byte(wc * 32 + fr, fq * 8);
#define PG8_SA(b, h) (((b) * 2 + (h)) * HTB)
#define PG8_SB(b, h) ((4 + (b) * 2 + (h)) * HTB)
#define PG8_STAGE(bufoff, gbase, voff) do { _Pragma("unroll") for (int _i = 0; _i < 2; ++_i) \
        __builtin_amdgcn_global_load_lds((const unsigned*)((const char*)(gbase) + (voff)[_i]), (PG8_LAS unsigned*)(lds + (bufoff) + ldsw + _i * 8192), 16, 0, 0); } while (0)
#define PG8_STAGEA(bufoff, P0, P1, koff) do { \
        __builtin_amdgcn_global_load_lds((const unsigned*)(Ab + (size_t)(P0) + (koff)), (PG8_LAS unsigned*)(lds + (bufoff) + ldsw), 16, 0, 0); \
        __builtin_amdgcn_global_load_lds((const unsigned*)(Ab + (size_t)(P1) + (koff)), (PG8_LAS unsigned*)(lds + (bufoff) + ldsw + 8192), 16, 0, 0); } while (0)
#define PG8_LDA(dst, b, h) do { _Pragma("unroll") for (int m = 0; m < 4; ++m) _Pragma("unroll") for (int k = 0; k < 2; ++k) dst[m][k] = *(const PG8_LAS bf16x8*)(lds + PG8_SA(b, h) + aoff + m * 2048 + k * 1024); } while (0)
#define PG8_LDB(dst, b, h) do { _Pragma("unroll") for (int n = 0; n < 2; ++n) _Pragma("unroll") for (int k = 0; k < 2; ++k) dst[n][k] = *(const PG8_LAS bf16x8*)(lds + PG8_SB(b, h) + boff + n * 2048 + k * 1024); } while (0)
#define PG8_MMA(ai, bj, At, Bt) do { __builtin_amdgcn_s_setprio(1); _Pragma("unroll") for (int m = 0; m < 4; ++m) _Pragma("unroll") for (int n = 0; n < 2; ++n) _Pragma("unroll") for (int k = 0; k < 2; ++k) \
        acc[ai][bj][m][n] = __builtin_amdgcn_mfma_f32_16x16x32_bf16(Bt[n][k], At[m][k], acc[ai][bj][m][n], 0, 0, 0); __builtin_amdgcn_s_setprio(0); } while (0)
#define PG8_WAIT_V(n) asm volatile("s_waitcnt vmcnt(" #n ")" ::: "memory")
#define PG8_WAIT_L(n) asm volatile("s_waitcnt lgkmcnt(" #n ")" ::: "memory")
#define PG8_BAR __builtin_amdgcn_s_barrier()
#define PG8_SCHED __builtin_amdgcn_sched_barrier(0)
    Unit cur, nxt, un2; int ui = 0, sb_cur = 0;
    if (!S.next(0, cur)) return;
    int fillv = S.fill_issue(cur); S.fill_write(0, fillv);
    __syncthreads();
    bool has_next = S.next(1, nxt);
    fillv = 0; if (has_next) fillv = S.fill_issue(nxt);
    f32x4 acc[2][2][4][2];
#pragma unroll
    for (int a = 0; a < 2; ++a)
#pragma unroll
        for (int b = 0; b < 2; ++b)
#pragma unroll
            for (int m = 0; m < 4; ++m)
#pragma unroll
                for (int n = 0; n < 2; ++n) acc[a][b][m][n] = (f32x4){0.f, 0.f, 0.f, 0.f};
    bf16x8 At[4][2], B0[2][2], B1[2][2];
    const char* cB = S.b_base(cur);
    unsigned cA00, cA01, cA10, cA11, nA00, nA01, nA10, nA11;
    const char* const Ab = S.a_base();
    S.a_rows(0, rowA, colA, cA00, cA01, cA10, cA11);
    S.a_ready(cur);
    if constexpr (SP2) {
        PG8_STAGE(PG8_SB(0, 0), cB, voffB); PG8_STAGE(PG8_SB(0, 1), cB + hstep, voffB); PG8_STAGEA(PG8_SA(0, 0), cA00, cA01, 0); PG8_STAGEA(PG8_SA(0, 1), cA10, cA11, 0);
        if (wr == 1) PG8_BAR;
        PG8_WAIT_V(2); PG8_BAR;
        PG8_STAGE(PG8_SB(1, 0), cB + kstep, voffB); PG8_STAGEA(PG8_SA(1, 0), cA00, cA01, kstep); PG8_STAGE(PG8_SB(1, 1), cB + hstep + kstep, voffB);
        PG8_WAIT_V(6); PG8_BAR;
    } else {
        PG8_STAGE(PG8_SB(0, 0), cB, voffB); PG8_STAGEA(PG8_SA(0, 0), cA00, cA01, 0); PG8_STAGE(PG8_SB(0, 1), cB + hstep, voffB); PG8_STAGEA(PG8_SA(0, 1), cA10, cA11, 0);
        if (wr == 1) PG8_BAR;
        PG8_WAIT_V(4); PG8_BAR;
        PG8_STAGE(PG8_SB(1, 0), cB + kstep, voffB); PG8_STAGEA(PG8_SA(1, 0), cA00, cA01, kstep); PG8_STAGE(PG8_SB(1, 1), cB + hstep + kstep, voffB);
        PG8_WAIT_V(6); PG8_BAR;
    }
    for (;;) {
        const char* nB = has_next ? S.b_base(nxt) : cB;
        const int sb_n = sb_cur == 2 ? 0 : sb_cur + 1;
        bool has2 = false;
        if (has_next) { S.fill_write(sb_n, fillv); has2 = S.next(ui + 2, un2); if (has2) fillv = S.fill_issue(un2); }
        nA00 = cA00; nA01 = cA01; nA10 = cA10; nA11 = cA11;
#pragma unroll 1
        for (int t = 0; t < nt; t += 2) {
            const bool last = (t == nt - 2);
            const size_t k1 = (size_t)(t + 1) * kstep;
            const size_t k2 = last ? 0 : (size_t)(t + 2) * kstep; const char* b2 = last ? nB : cB + (size_t)(t + 2) * kstep;
            const unsigned q00 = last ? nA00 : cA00, q01 = last ? nA01 : cA01, q10 = last ? nA10 : cA10, q11 = last ? nA11 : cA11;
            const size_t k3 = k2 + kstep; const char* b3 = b2 + kstep;
            if (last && has_next) S.a_ready(nxt);
            if constexpr (SP2) {
            PG8_LDB(B0, 0, 0); PG8_LDB(B1, 0, 1); PG8_SCHED; PG8_LDA(At, 0, 0); PG8_STAGEA(PG8_SA(1, 1), cA10, cA11, k1);
            PG8_WAIT_V(8); PG8_WAIT_L(0); PG8_BAR; PG8_MMA(0, 0, At, B0); PG8_MMA(0, 1, At, B1); PG8_BAR; PG8_SCHED;
            PG8_LDA(At, 0, 1); PG8_STAGE(PG8_SB(0, 0), b2, voffB); PG8_STAGE(PG8_SB(0, 1), b2 + hstep, voffB); PG8_STAGEA(PG8_SA(0, 0), q00, q01, k2);
            PG8_WAIT_V(8); PG8_WAIT_L(0); PG8_BAR; PG8_MMA(1, 0, At, B0); PG8_MMA(1, 1, At, B1); PG8_BAR; PG8_SCHED;
            PG8_LDB(B0, 1, 0); PG8_LDB(B1, 1, 1); PG8_SCHED; PG8_LDA(At, 1, 0); PG8_STAGEA(PG8_SA(0, 1), q10, q11, k2);
            PG8_WAIT_V(8); PG8_WAIT_L(0); PG8_BAR; PG8_MMA(0, 0, At, B0); PG8_MMA(0, 1, At, B1); PG8_BAR; PG8_SCHED;
            PG8_LDA(At, 1, 1); PG8_STAGE(PG8_SB(1, 0), b3, voffB); PG8_STAGE(PG8_SB(1, 1), b3 + hstep, voffB); PG8_STAGEA(PG8_SA(1, 0), q00, q01, k3);
            PG8_WAIT_V(8); PG8_WAIT_L(0); PG8_BAR; PG8_MMA(1, 0, At, B0); PG8_MMA(1, 1, At, B1); PG8_BAR; PG8_SCHED;
            } else {
            PG8_LDB(B0, 0, 0); PG8_SCHED; PG8_LDA(At, 0, 0); PG8_STAGEA(PG8_SA(1, 1), cA10, cA11, k1);
            PG8_WAIT_L(8); PG8_BAR; PG8_WAIT_L(0); PG8_MMA(0, 0, At, B0); PG8_BAR; PG8_SCHED;
            PG8_LDB(B1, 0, 1); PG8_STAGE(PG8_SB(0, 0), b2, voffB);
            PG8_BAR; PG8_WAIT_L(0); PG8_MMA(0, 1, At, B1); PG8_BAR;
            PG8_LDA(At, 0, 1); PG8_STAGEA(PG8_SA(0, 0), q00, q01, k2);
            PG8_BAR; PG8_WAIT_L(0); PG8_MMA(1, 0, At, B0); PG8_BAR; PG8_SCHED;
            PG8_STAGE(PG8_SB(0, 1), b2 + hstep, voffB);
            PG8_WAIT_V(6); PG8_BAR; PG8_MMA(1, 1, At, B1); PG8_BAR;
            PG8_LDB(B0, 1, 0); PG8_SCHED; PG8_LDA(At, 1, 0); PG8_STAGEA(PG8_SA(0, 1), q10, q11, k2);
            PG8_WAIT_L(8); PG8_BAR; PG8_WAIT_L(0); PG8_MMA(0, 0, At, B0); PG8_BAR; PG8_SCHED;
            PG8_LDB(B1, 1, 1); PG8_STAGE(PG8_SB(1, 0), b3, voffB);
            PG8_BAR; PG8_WAIT_L(0); PG8_MMA(0, 1, At, B1); PG8_BAR;
            PG8_LDA(At, 1, 1); PG8_STAGEA(PG8_SA(1, 0), q00, q01, k3);
            PG8_BAR; PG8_WAIT_L(0); PG8_MMA(1, 0, At, B0); PG8_BAR; PG8_SCHED;
            PG8_STAGE(PG8_SB(1, 1), b3 + hstep, voffB);
            PG8_WAIT_V(6); PG8_BAR; PG8_MMA(1, 1, At, B1); PG8_BAR;
            }
            if (t == nt - 4 && has_next) S.a_rows(sb_n, rowA, colA, nA00, nA01, nA10, nA11);
        }
        if constexpr (ALIGN_EPI) { if (wr == 0) PG8_BAR; }
        if constexpr (!Epi::AFTER_DRAIN) { E(acc, cur, wr, wc, fr, fq, sb_cur); S.done(cur); }
        if (!has_next) break;
#pragma unroll
        for (int a = 0; a < 2; ++a)
#pragma unroll
            for (int b = 0; b < 2; ++b)
#pragma unroll
                for (int m = 0; m < 4; ++m)
#pragma unroll
                    for (int n = 0; n < 2; ++n) acc[a][b][m][n] = (f32x4){0.f, 0.f, 0.f, 0.f};
        cur = nxt; nxt = un2; has_next = has2; cA00 = nA00; cA01 = nA01; cA10 = nA10; cA11 = nA11; cB = nB; ++ui; sb_cur = sb_n;
        if constexpr (ALIGN_EPI) { if (wr == 1) PG8_BAR; }
    }
    PG8_WAIT_V(0);
    if constexpr (!ALIGN_EPI) { if (wr == 0) PG8_BAR; }
    PG8_BAR;
    if constexpr (Epi::AFTER_DRAIN) { E.fused(acc, cur, wr, wc, fr, fq, lds, wid, lane); S.done(cur); }
#undef PG8_SA
#undef PG8_SB
#undef PG8_STAGE
#undef PG8_STAGEA
#undef PG8_LDA
#undef PG8_LDB
#undef PG8_MMA
#undef PG8_WAIT_V
#undef PG8_WAIT_L
#undef PG8_BAR
#undef PG8_SCHED
}
}

DEVI void wt_colinfo(const Params& p, int R, const float*& src, int& ld, float& scale) {
    scale = 1.0f; src = nullptr; ld = 0;
    if (R < WT_AT) {
        const int pn = R >> 8, cl = R & 255; ld = DIN_; int col = -1;
        if (pn < 4) { const int wcq = (cl >> 5) & 3; col = (pn >> 1) * 512 + (2 * (pn & 1) + (wcq >> 1)) * 128 + 64 * (cl >> 7) + 32 * (wcq & 1) + (cl & 31);
                      if (pn >= 2) scale = KSCALE_; }
        else if (pn < 8)  col = 2048 + (pn - 4) * 256 + cl;
        else if (pn < 10) { col = 3072 + (pn - 8) * 256 + cl; scale = KSCALE_; }
        else if (pn < 14) col = 5120 + (pn - 10) * 256 + cl;
        else if (pn < 22) col = 6160 + (pn - 14) * 256 + cl;
        else if (cl < 16) col = 6144 + cl;
        if (col >= 0) src = p.w_in + col;
    } else if (R < WT_RET) {
        const int Rr = R - WT_AT, pm = Rr >> 8, rl = Rr & 255; ld = DIN_; int col;
        if (pm < 2) { col = 512 + (2 * pm + ((rl >> 6) & 1)) * 128 + 64 * (rl >> 7) + (rl & 63); scale = KSCALE_; }
        else if (pm < 6)  col = 1024 + (pm - 2) * 256 + rl;
        else if (pm < 10) col = 4096 + (pm - 6) * 256 + rl;
        else              col = 3584 + (pm - 10) * 256 + rl;
        src = p.w_in + col;
    } else {
        int Rr, ldd; const float* base;
        if (R < WT_GLA)    { Rr = R - WT_RET; base = p.w_ret_out; ldd = 1024; }
        else if (R < WT_O) { Rr = R - WT_GLA; base = p.w_gla_out; ldd = 1024; }
        else if (R < WT_R) { Rr = R - WT_O;   base = p.w_o;       ldd = 1024; }
        else               { Rr = R - WT_R;   base = p.router_w;  ldd = 256; }
        src = base + ((R >= WT_R) ? ((Rr & ~127) + vperm(Rr & 127)) : Rr); ld = ldd;
    }
}

DEVI void phase0(const Params& p, unsigned char* smem) {
    const int tid = VT, nb = VG, bid = VB;
    float2* cs = (float2*)(p.ws + OFF_CS);
    for (int i = bid * 256 + tid; i < 4096 * 64; i += nb * 256) {
        const int pos = i >> 6, k = i & 63;
        const float angf = (float)pos * c_inv_freq[k];
        const double a = (double)angf;
        const double TWO_PI = 6.283185307179586476925286766559, HALF_PI = 1.5707963267948966192313216916398;
        const double kk = rint(a * (1.0 / TWO_PI));
        const double r = a - kk * TWO_PI;
        const double qd = rint(r * (1.0 / HALF_PI));
        const double y = r - qd * HALF_PI;
        const double y2 = y * y;
        double sn = y * (1.0 + y2 * (-1.0 / 6 + y2 * (1.0 / 120 + y2 * (-1.0 / 5040 + y2 * (1.0 / 362880 + y2 * (-1.0 / 39916800 + y2 * (1.0 / 6227020800.0)))))));
        double cn = 1.0 + y2 * (-0.5 + y2 * (1.0 / 24 + y2 * (-1.0 / 720 + y2 * (1.0 / 40320 + y2 * (-1.0 / 3628800 + y2 * (1.0 / 479001600.0))))));
        const int qi = ((int)qd) & 3;
        double s, c;
        if (qi == 0) { s = sn; c = cn; } else if (qi == 1) { s = cn; c = -sn; } else if (qi == 2) { s = -sn; c = -cn; } else { s = -cn; c = sn; }
        cs[i] = make_float2((float)c, (float)s);
    }
    if (bid == 0) { int* cnt = (int*)(p.ws + OFF_CNT); cnt[tid * CNT_STRIDE] = 0; }
    {
        const f32x4* xs = (const f32x4*)p.x; u32x4* xd = (u32x4*)(p.ws + OFF_XB);
        const int n8 = T_ * D_ / 8;
        for (int g = bid * 256 + tid; g < n8; g += nb * 256) {
            const f32x4 v0 = xs[2 * g], v1 = xs[2 * g + 1];
            u32x4 o; o.x = pk2(v0[0], v0[1]); o.y = pk2(v0[2], v0[3]); o.z = pk2(v1[0], v1[1]); o.w = pk2(v1[2], v1[3]);
            xd[g] = o;
        }
    }
    {
        float* tile = (float*)smem;
        bf16_t* wt = (bf16_t*)(p.ws + OFF_WT);
        const int ntask = (WT_ROWS / 64) * 16;
        for (int task = bid; task < ntask; task += nb) {
            const int rt = task >> 4, kt = task & 15, R0 = rt * 64, k0 = kt * 64;
            {
                const int n = tid & 63, kq = tid >> 6;
                const float* src; int ld; float sc; wt_colinfo(p, R0 + n, src, ld, sc);
#pragma unroll
                for (int i = 0; i < 16; ++i) { const int k = kq + 4 * i; tile[k * 65 + n] = src ? src[(size_t)(k0 + k) * ld] * sc : 0.f; }
            }
            __syncthreads();
            {
                const int n = tid >> 2, ks = (tid & 3) * 16;
                unsigned o[8];
#pragma unroll
                for (int j = 0; j < 8; ++j) o[j] = pk2(tile[(ks + 2 * j) * 65 + n], tile[(ks + 2 * j + 1) * 65 + n]);
                u32x4* dst = (u32x4*)(wt + (size_t)(R0 + n) * 1024 + k0 + ks);
                dst[0] = (u32x4){o[0], o[1], o[2], o[3]}; dst[1] = (u32x4){o[4], o[5], o[6], o[7]};
            }
            __syncthreads();
        }
    }
}

struct EpiP1N {
    static constexpr bool PERM = true, AFTER_DRAIN = false;
    unsigned char* ws;
    __device__ __forceinline__ void operator()(const pg8::f32x4 (&acc)[2][2][4][2], const pg8::Unit& u, int wr, int wc, int fr, int fq) const {
        const int pn = u.pn, row0 = u.pm * 256 + wr * 64 + fr, c8 = wc * 32 + 8 * fq;
        if (pn < 4) {
            const float2* cs = (const float2*)(ws + OFF_CS); bf16_t* Qr = (bf16_t*)(ws + (pn < 2 ? OFF_QR : OFF_KR));
            const int head = 2 * (pn & 1) + (wc >> 1), d0 = 32 * (wc & 1) + 8 * fq;
#pragma unroll
            for (int ai = 0; ai < 2; ++ai)
#pragma unroll
                for (int m = 0; m < 4; ++m) {
                    const size_t row = row0 + ai * 128 + m * 16; const int pos = (int)(row & 4095);
                    f32x4 c4[4];
#pragma unroll
                    for (int j = 0; j < 4; ++j) c4[j] = *(const f32x4*)(cs + pos * 64 + d0 + 2 * j);
                    f32x4 o1[2], o2[2];
#pragma unroll
                    for (int n = 0; n < 2; ++n)
#pragma unroll
                        for (int r = 0; r < 4; ++r) {
                            const f32x4 cc = c4[2 * n + (r >> 1)]; const float c_ = cc[(r & 1) * 2], s_ = cc[(r & 1) * 2 + 1];
                            const float x1 = acc[ai][0][m][n][r], x2 = acc[ai][1][m][n][r];
                            o1[n][r] = x1 * c_ - x2 * s_; o2[n][r] = x1 * s_ + x2 * c_;
                        }
                    *(u32x4*)(Qr + row * 512 + head * 128 + d0) = pk8(o1[0], o1[1]);
                    *(u32x4*)(Qr + row * 512 + head * 128 + 64 + d0) = pk8(o2[0], o2[1]);
                    asm volatile("" ::: "memory");
                }
        } else {
#pragma unroll
            for (int ai = 0; ai < 2; ++ai)
#pragma unroll
                for (int m = 0; m < 4; ++m) {
                    const size_t row = row0 + ai * 128 + m * 16;
#pragma unroll
                    for (int bj = 0; bj < 2; ++bj) {
                        const int cl = bj * 128 + c8;
                        f32x4 v0 = acc[ai][bj][m][0], v1 = acc[ai][bj][m][1];
                        if (pn < 8) {
#pragma unroll
                            for (int r = 0; r < 4; ++r) { v0[r] = siluf_(v0[r]); v1[r] = siluf_(v1[r]); }
                            *(u32x4*)((bf16_t*)(ws + OFF_GS) + row * 2048 + (pn - 4) * 256 + cl) = pk8(v0, v1);
                        } else if (pn < 10) {
                            *(u32x4*)((bf16_t*)(ws + OFF_QGN) + row * 512 + (pn - 8) * 256 + cl) = pk8(v0, v1);
                        } else if (pn < 14) {
#pragma unroll
                            for (int r = 0; r < 4; ++r) { v0[r] = siluf_(v0[r]); v1[r] = siluf_(v1[r]); }
                            *(u32x4*)((bf16_t*)(ws + OFF_GS) + row * 2048 + 1024 + (pn - 10) * 256 + cl) = pk8(v0, v1);
                        } else if (pn < 22) {
#pragma unroll
                            for (int r = 0; r < 4; ++r) { v0[r] = sigmoidf_(v0[r]); v1[r] = sigmoidf_(v1[r]); }
                            *(u32x4*)((bf16_t*)(ws + OFF_MG) + row * 2048 + (pn - 14) * 256 + cl) = pk8(v0, v1);
                        } else if (cl < 16) {
                            int frl = fr; asm volatile("" : "+v"(frl));
                            const unsigned ofs = (unsigned)OFF_GA + ((unsigned)(u.pm * 256 + wr * 64 + frl + ai * 128 + m * 16) * 16u + (unsigned)cl) * 4u;
                            *(f32x4*)(ws + ofs) = v0; *(f32x4*)(ws + ofs + 16) = v1;
                        }
                    }
                    asm volatile("" ::: "memory");
                }
        }
    }
};
struct EpiP1V {
    static constexpr bool PERM = true, AFTER_DRAIN = false;
    unsigned char* ws;
    __device__ __forceinline__ void operator()(const pg8::f32x4 (&acc)[2][2][4][2], const pg8::Unit& u, int wr, int wc, int fr, int fq) const {
        bf16_t* dst = (bf16_t*)(ws + (u.pm < 4 ? OFF_VRT : OFF_VGT)); const int head = u.pm & 3;
#pragma unroll
        for (int bj = 0; bj < 2; ++bj) {
            const int tok0 = u.pn * 256 + bj * 128 + wc * 32 + 8 * fq; const int item = (tok0 >> 6) * 4 + head, m0 = tok0 & 63;
#pragma unroll
            for (int ai = 0; ai < 2; ++ai)
#pragma unroll
                for (int m = 0; m < 4; ++m) {
                    *(u32x4*)(dst + vf_off(item, ai * 128 + wr * 64 + m * 16 + fr, m0)) = pk8(acc[ai][bj][m][0], acc[ai][bj][m][1]);
                    asm volatile("" ::: "memory");
                }
        }
    }
};
struct EpiP1G {
    static constexpr bool PERM = true, AFTER_DRAIN = false;
    unsigned char* ws;
    __device__ __forceinline__ void operator()(const pg8::f32x4 (&acc)[2][2][4][2], const pg8::Unit& u, int wr, int wc, int fr, int fq) const {
        bf16_t* dst = (bf16_t*)(ws + OFF_KGT);
#pragma unroll
        for (int bj = 0; bj < 2; ++bj) {
            const int tok0 = u.pn * 256 + bj * 128 + wc * 32 + 8 * fq; const int m0 = tok0 & 63;
#pragma unroll
            for (int ai = 0; ai < 2; ++ai) {
                const unsigned item = (unsigned)((tok0 >> 6) * 4 + 2 * u.pm + ai);
#pragma unroll
                for (int m = 0; m < 4; ++m) {
                    *(u32x4*)(dst + (item * 128u + (unsigned)(wr * 64 + m * 16 + fr)) * 64u + (unsigned)m0) = pk8(acc[ai][bj][m][0], acc[ai][bj][m][1]);
                    asm volatile("" ::: "memory");
                }
            }
        }
    }
};
DEVI void phase1(const Params& p, unsigned char* smem_all) {
    {
        pg8::StaticOrder S; S.init(T_, 5888, RG, RB);
        pg8::Gemm g; g.A = (const bf16_t*)(p.ws + OFF_XB); g.Bt = (const bf16_t*)(p.ws + OFF_WT) + (size_t)WT_BN * 1024; g.M = T_; g.N = 5888; g.K = 1024;
        EpiP1N E; E.ws = p.ws;
        pg8::gemm_phase<EpiP1N, pg8::StaticOrder, true, true>((PG8_LAS unsigned char*)smem_all, g, S, E);
    }
    __syncthreads();
    {
        pg8::StaticOrder S; S.init(2048, T_, RG, RB);
        pg8::Gemm g; g.A = (const bf16_t*)(p.ws + OFF_WT) + (size_t)(WT_AT + 512) * 1024; g.Bt = (const bf16_t*)(p.ws + OFF_XB); g.M = 2048; g.N = T_; g.K = 1024;
        EpiP1V E; E.ws = p.ws;
        pg8::gemm_phase<EpiP1V, pg8::StaticOrder, true, true>((PG8_LAS unsigned char*)smem_all, g, S, E);
    }
    __syncthreads();
    {
        pg8::StaticOrder S; S.init(512, T_, RG, RB);
        pg8::Gemm g; g.A = (const bf16_t*)(p.ws + OFF_WT) + (size_t)(WT_AT + 2560) * 1024; g.Bt = (const bf16_t*)(p.ws + OFF_XB); g.M = 512; g.N = T_; g.K = 1024;
        EpiP1G E; E.ws = p.ws;
        pg8::gemm_phase<EpiP1G, pg8::StaticOrder, true, true>((PG8_LAS unsigned char*)smem_all, g, S, E);
    }
}

DEVI void phase2(const Params& p, unsigned char* smem) {
    float* ga_s = (float*)smem;
    float* tot = (float*)(smem + 4096);
    const int tid = VT;
    const float* Ga = (const float*)(p.ws + OFF_GA);
    const bf16_t* Kgt = (const bf16_t*)(p.ws + OFF_KGT); bf16_t* Kg2 = (bf16_t*)(p.ws + OFF_KG2);
    float* dec = (float*)(p.ws + OFF_DEC);
    for (int it = VB; it < 2048; it += VG) {
        const int h = it & 3, c = (it >> 2) & 63, b = it >> 8;
        const int tok0 = b * 4096 + c * 64;
        ((f32x4*)ga_s)[tid] = ((const f32x4*)(Ga + (size_t)tok0 * 16))[tid];
        const int dk = tid & 127, half = tid >> 7;
        float w2[16];
#pragma unroll
        for (int r = 0; r < 16; ++r) w2[r] = p.gate_w2[r * 512 + h * 128 + dk];
        const float bias = p.gate_b[h * 128 + dk];
        __syncthreads();
        float run = 0.f; float bc[32];
#pragma unroll
        for (int ml = 0; ml < 32; ++ml) {
            const int m = half * 32 + ml;
            float z = bias;
#pragma unroll
            for (int r4 = 0; r4 < 4; ++r4) { const f32x4 g4 = *(const f32x4*)&ga_s[m * 16 + 4 * r4];
                z += g4[0] * w2[4 * r4] + g4[1] * w2[4 * r4 + 1] + g4[2] * w2[4 * r4 + 2] + g4[3] * w2[4 * r4 + 3]; }
            const float la = (fminf(z, 0.f) - __logf(1.0f + __expf(-fabsf(z)))) * (1.0f / 16.0f);
            run += la; bc[ml] = run;
        }
        tot[half * 128 + dk] = run;
        __syncthreads();
        const float t0 = tot[dk], t1 = tot[128 + dk];
        const float bend = t0 + t1, off = half ? t0 : 0.f;
        const u32x4* kp = (const u32x4*)(Kgt + ((size_t)it * 128 + dk) * 64 + half * 32);
        bf16_t* const kqb = Kg2;
#pragma unroll
        for (int j = 0; j < 4; ++j) {
            u32x4 v = kp[j];
            unsigned uu[4] = {v.x, v.y, v.z, v.w};
#pragma unroll
            for (int e = 0; e < 4; ++e) {
                const float f0 = bflo(uu[e]) * __expf(bend - (bc[8 * j + 2 * e] + off));
                const float f1 = bfhi(uu[e]) * __expf(bend - (bc[8 * j + 2 * e + 1] + off));
                uu[e] = pk2(f0, f1);
            }
            *(u32x4*)(kqb + kf_off(it, dk, half * 32 + 8 * j)) = (u32x4){uu[0], uu[1], uu[2], uu[3]};
        }
        if (half == 0) dec[(size_t)it * 128 + dk] = __expf(bend);
        {
            const bf16_t* Qn = (const bf16_t*)(p.ws + OFF_QGN); bf16_t* QF = (bf16_t*)(p.ws + OFF_QG);
            const int m = tid & 63, qd = tid >> 6, bc = b * 64 + c;
            const u32x4* qs = (const u32x4*)(Qn + ((size_t)tok0 + m) * 512 + h * 128 + 32 * qd);
            u32x4 qv[4];
#pragma unroll
            for (int j = 0; j < 4; ++j) qv[j] = qs[j];
#pragma unroll
            for (int j = 0; j < 4; ++j) {
                *(u32x2*)(QF + qf_off(bc, h, m, 32 * qd + 8 * j, 0)) = (u32x2){qv[j].x, qv[j].y};
                *(u32x2*)(QF + qf_off(bc, h, m, 32 * qd + 8 * j, 1)) = (u32x2){qv[j].z, qv[j].w};
            }
        }
        __syncthreads();
    }
    {
        bf16_t* tile = (bf16_t*)smem;
        const bf16_t* Kr = (const bf16_t*)(p.ws + OFF_KR); bf16_t* Krt = (bf16_t*)(p.ws + OFF_KRT);
        for (int it = VB; it < 2048; it += VG) {
            const int h = it & 3, c = (it >> 2) & 63, b = it >> 8;
            const size_t tok0 = (size_t)b * 4096 + c * 64;
            const int m = tid & 63, qd = tid >> 6;
            const float kd = exp2f(gamma_log2(h) * (float)(63 - m));
            const u32x4* src = (const u32x4*)(Kr + (tok0 + m) * 512 + h * 128 + 32 * qd);
            u32x4 v[4];
#pragma unroll
            for (int j = 0; j < 4; ++j) v[j] = src[j];
#pragma unroll
            for (int j = 0; j < 4; ++j) {
                const unsigned uu[4] = {v[j].x, v[j].y, v[j].z, v[j].w};
#pragma unroll
                for (int e = 0; e < 4; ++e) {
                    const int dk = 32 * qd + 8 * j + 2 * e;
                    tile[dk * 72 + m] = f2bf(bflo(uu[e]) * kd); tile[(dk + 1) * 72 + m] = f2bf(bfhi(uu[e]) * kd);
                }
            }
            {
                const bf16_t* Qr = (const bf16_t*)(p.ws + OFF_QR); bf16_t* QF = (bf16_t*)(p.ws + OFF_QFR);
                const u32x4* qs = (const u32x4*)(Qr + (tok0 + m) * 512 + h * 128 + 32 * qd);
                u32x4 qv[4];
#pragma unroll
                for (int j = 0; j < 4; ++j) qv[j] = qs[j];
                const int bc = b * 64 + c;
#pragma unroll
                for (int j = 0; j < 4; ++j) {
                    *(u32x2*)(QF + qf_off(bc, h, m, 32 * qd + 8 * j, 0)) = (u32x2){qv[j].x, qv[j].y};
                    *(u32x2*)(QF + qf_off(bc, h, m, 32 * qd + 8 * j, 1)) = (u32x2){qv[j].z, qv[j].w};
                }
            }
            __syncthreads();
            {
                const int dk = tid >> 1, hf = tid & 1;
#pragma unroll
                for (int j = 0; j < 4; ++j) *(u32x4*)(Krt + kf_off(it, dk, hf * 32 + 8 * j)) = *(const u32x4*)&tile[dk * 72 + hf * 32 + 8 * j];
            }
            __syncthreads();
        }
    }
}

typedef float f32x16 __attribute__((ext_vector_type(16)));
DEVI f32x16 mfma32(bf16x8 a, bf16x8 b, f32x16 c) { return __builtin_amdgcn_mfma_f32_32x32x16_bf16(a, b, c, 0, 0, 0); }
struct ScanSet { bf16x8 kf[4], vq, qf[2][2]; f32x4 dc[4]; };
template <bool GLA>
DEVI void scan_tile(const Params& p, unsigned char* zb  , int b, int h, int s, int dummy) {
    int vt_ = VT; asm volatile("" : "+v"(vt_));
    const int t = __builtin_amdgcn_readfirstlane(vt_ >> 6), lane = vt_ & 63, r = lane & 31, hh = lane >> 5;
    const bf16_t* Ktb = (const bf16_t*)(p.ws + (GLA ? OFF_KG2 : OFF_KRT));
    const bf16_t* Vtb = (const bf16_t*)(p.ws + (GLA ? OFF_VGT : OFF_VRT));
    const bf16_t* Qb  = (const bf16_t*)(p.ws + (GLA ? OFF_QG : OFF_QFR));
    const float* dec = (const float*)(p.ws + OFF_DEC);
    bf16_t* Oo = (bf16_t*)(p.ws + OFF_OO);
    const float lg = gamma_log2(h);
    const float cd = exp2f(lg * 64.0f);
    f32x16 S;
#pragma unroll
    for (int i = 0; i < 16; ++i) S[i] = 0.f;
    const unsigned it0 = (unsigned)(b * 64 * 4 + h);
    const bf16_t* const kp = Ktb + ((size_t)it0 * 4 + t) * 4 * 512; const unsigned ko = (unsigned)lane * 8;
    const bf16_t* const vp = Vtb + ((size_t)it0 * 8 + s) * 4 * 512 + t * 512; const unsigned vo = (unsigned)lane * 8;
    const bf16_t* const qp = Qb + ((((size_t)(b * 64) * 4 + h) * 2) * 4 + t) * 2 * 512; const unsigned qo = (unsigned)lane * 8;
    const float* const dp = dec + (size_t)it0 * 128 + t * 32; const unsigned dofs = 4 * hh;
    unsigned char* const vring = smem_all_g + 2 * SMEM_HALF + VH * 8192;
    const int rt = t >> 1, rg0 = 2 * (t & 1);
    const float qd = GLA ? 1.0f : exp2f(lg * (float)(32 * rt + r + 1));
    bf16_t* const ob = Oo + (size_t)b * 4096 * 2048 + (GLA ? 1024 : 0) + h * 256 + s * 32;
#define ST_CL(C) (dummy ? 0 : ((C) < 64 ? (C) : 63))
#define ST_LOAD(SET, C) do { const int c_ = ST_CL(C), cv_ = ST_CL((C) + 1); \
        const bf16_t* kq = kp + (size_t)c_ * (4 * 16 * 512) + ko; const bf16_t* qq = qp + (size_t)c_ * (4 * 16 * 512) + qo; \
        _Pragma("unroll") for (int ks = 0; ks < 4; ++ks) (SET).kf[ks] = *(const bf16x8*)(kq + ks * 512); \
        (SET).vq = *(const bf16x8*)(vp + (size_t)cv_ * (4 * 32 * 512) + vo); \
        _Pragma("unroll") for (int ss = 0; ss < 2; ++ss) _Pragma("unroll") for (int tt = 0; tt < 2; ++tt) (SET).qf[ss][tt] = *(const bf16x8*)(qq + tt * (8 * 512) + ss * 512); \
        } while (0)
#define ST_LOADDC(SET, C) do { if (GLA) { const int c_ = (C) < 64 ? (C) : 63; const float* dq = dp + (size_t)c_ * (4 * 128) + dofs; \
        _Pragma("unroll") for (int g = 0; g < 4; ++g) (SET).dc[g] = *(const f32x4*)(dq + 8 * g); } } while (0)
#define ST_Z(SET, ZC) do { \
        _Pragma("unroll") for (int tt = 0; tt < 2; ++tt) { \
            f32x16 Zt; _Pragma("unroll") for (int i = 0; i < 16; ++i) Zt[i] = 0.f; \
            _Pragma("unroll") for (int ss = 0; ss < 2; ++ss) { \
                u32x4 pk; pk.x = pk2(S[8 * ss + 0], S[8 * ss + 1]); pk.y = pk2(S[8 * ss + 2], S[8 * ss + 3]); pk.z = pk2(S[8 * ss + 4], S[8 * ss + 5]); pk.w = pk2(S[8 * ss + 6], S[8 * ss + 7]); \
                Zt = mfma32(__builtin_bit_cast(bf16x8, pk), (SET).qf[ss][tt], Zt); } \
            _Pragma("unroll") for (int g = 0; g < 4; ++g) { \
                f32x4 z4; z4[0] = Zt[4 * g]; z4[1] = Zt[4 * g + 1]; z4[2] = Zt[4 * g + 2]; z4[3] = Zt[4 * g + 3]; \
                *(u32x2*)((ZC) + (((t * 2 + tt) * 4 + g) * 64 + lane) * 8) = pk4(z4); } } } while (0)
#define ST_UPD(SET, C) do { \
        if (GLA) { _Pragma("unroll") for (int g = 0; g < 4; ++g) _Pragma("unroll") for (int i = 0; i < 4; ++i) S[4 * g + i] *= (SET).dc[g][i]; } \
        else { _Pragma("unroll") for (int i = 0; i < 16; ++i) S[i] *= cd; } \
        _Pragma("unroll") for (int ks = 0; ks < 4; ++ks) S = mfma32((SET).kf[ks], *(const bf16x8*)(vring + ((C) & 1) * 4096 + ks * 1024 + lane * 16), S); } while (0)
#define ST_STEP(CUR, NXT, OTH, C) do { \
        ST_LOADDC(OTH, (C) + 1); ST_LOAD(NXT, (C) + 2);       \
        __builtin_amdgcn_sched_barrier(0); \
        unsigned char* zc = zb + ((C) & 1) * 16384; \
        if (GLA) { ST_UPD(CUR, C); ST_Z(CUR, zc); } else { ST_Z(CUR, zc); ST_UPD(CUR, C); } \
        *(bf16x8*)(vring + (((C) + 1) & 1) * 4096 + t * 1024 + lane * 16) = (CUR).vq; \
        __syncthreads(); \
        _Pragma("unroll") for (int gi = 0; gi < 2; ++gi) { const int g = rg0 + gi; \
            f32x4 o = (f32x4){0.f, 0.f, 0.f, 0.f}; \
            _Pragma("unroll") for (int t2 = 0; t2 < 4; ++t2) o += unpk4(*(const u32x2*)(zc + (((t2 * 2 + rt) * 4 + g) * 64 + lane) * 8)); \
            *(u32x2*)(zb + 32768 + ((C) & 7) * 4096 + (32 * rt + r) * 64 + (8 * g + 4 * hh) * 2) = pk4(o * qd); } \
          \
        if (((C) & 7) == 7) { __syncthreads(); \
            _Pragma("unroll") for (int i = 0; i < 8; ++i)   \
                *(u32x4*)((unsigned char*)ob + (size_t)(((C) - 7) * 64 + i * 64) * 4096 + fo) = *(const u32x4*)(zb + 32768 + i * 4096 + fl); } } while (0)
    const unsigned fo = (unsigned)(vt_ >> 2) * 4096u + (unsigned)(vt_ & 3) * 16u, fl = (unsigned)(vt_ >> 2) * 64u + (unsigned)(vt_ & 3) * 16u;
    ScanSet A, B, Cc;
    { const bf16x8 v0 = *(const bf16x8*)(vp + vo); *(bf16x8*)(vring + t * 1024 + lane * 16) = v0; }
    ST_LOAD(A, 0); ST_LOADDC(A, 0); ST_LOAD(B, 1);
    __syncthreads();
#pragma unroll 1
    for (int c0 = 0; c0 < 66; c0 += 3) { ST_STEP(A, Cc, B, c0); ST_STEP(B, A, Cc, c0 + 1); ST_STEP(Cc, B, A, c0 + 2); }
    __syncthreads();
#undef ST_STEP
#undef ST_UPD
#undef ST_Z
#undef ST_LOADDC
#undef ST_LOAD
#undef ST_CL
}
DEVI void phase3t(const Params& p, unsigned char* smem, int dummy) {
    for (int it0 = VB; it0 < 512; it0 += VG) {
        const int lcl = (RB >> 3) * 2 + VH;
        const int it = (VG == 512) ? ((RB & 7) * 8 + lcl / 8) * 8 + (lcl & 7) : it0;
        const int s = it & 7, h = (it >> 3) & 3, b = (it >> 5) & 7, br = it >> 8;
        if (br == 0) scan_tile<false>(p, smem, b, h, s, dummy); else scan_tile<true>(p, smem, b, h, s, dummy);
    }
}

constexpr int PS_LD = 72;
DEVI void phase4(const Params& p, unsigned char* smem) {
    const int t = VT, lane = t & 63, w = t >> 6, l15 = lane & 15, q = lane >> 4;
    bf16_t* Ps = (bf16_t*)smem + w * 16 * PS_LD;
    const bf16_t* Qr = (const bf16_t*)(p.ws + OFF_QR); const bf16_t* Kr = (const bf16_t*)(p.ws + OFF_KR);
    const bf16_t* Vrt = (const bf16_t*)(p.ws + OFF_VRT); const bf16_t* Oo = (const bf16_t*)(p.ws + OFF_OO);
    const bf16_t* Gs = (const bf16_t*)(p.ws + OFF_GS); bf16_t* Y = (bf16_t*)(p.ws + OFF_Y);
    for (int it = VB; it < 4096; it += VG) {
        const int br = it >> 11, idx = it & 2047;
        const int h = idx & 3, c = (idx >> 2) & 63, b = idx >> 8;
        const size_t tok0 = (size_t)b * 4096 + c * 64;
        const size_t tok = tok0 + 16 * w + l15;
        f32x4 O[16];
        const bf16_t* orow = Oo + tok * 2048 + br * 1024 + h * 256 + 4 * q;
        const bf16_t* grow = Gs + tok * 2048 + br * 1024 + h * 256 + 4 * q;
        u32x2 oraw[16], graw[16];
        if (br == 0) {
            const float lg = gamma_log2(h);
            bf16x8 vf[8][2];
#pragma unroll
            for (int nt = 0; nt < 8; ++nt) { vf[nt][0] = *(const bf16x8*)(Vrt + vf_off(idx, 16 * nt + l15, q * 8)); vf[nt][1] = *(const bf16x8*)(Vrt + vf_off(idx, 16 * nt + l15, 32 + q * 8)); }
            __builtin_amdgcn_sched_barrier(0);
            f32x4 P[4] = {(f32x4){0.f, 0.f, 0.f, 0.f}, (f32x4){0.f, 0.f, 0.f, 0.f}, (f32x4){0.f, 0.f, 0.f, 0.f}, (f32x4){0.f, 0.f, 0.f, 0.f}};
#pragma unroll
            for (int ks = 0; ks < 4; ++ks) {
                const bf16x8 qf = *(const bf16x8*)(Qr + tok * 512 + h * 128 + ks * 32 + q * 8);
#pragma unroll
                for (int mt = 0; mt < 4; ++mt) {
                    const bf16x8 kf = *(const bf16x8*)(Kr + (tok0 + 16 * mt + l15) * 512 + h * 128 + ks * 32 + q * 8);
                    P[mt] = mfma16(kf, qf, P[mt]);
                }
            }
            const int j = 16 * w + l15;
#pragma unroll
            for (int mt = 0; mt < 4; ++mt) {
                f32x4 v = P[mt];
#pragma unroll
                for (int r = 0; r < 4; ++r) { const int m = 16 * mt + 4 * q + r; const int dd = j > m ? j - m : m - j; v[r] *= exp2f(lg * (float)dd); }
                *(u32x2*)&Ps[l15 * PS_LD + 16 * mt + 4 * q] = pk4(v);
            }
            __syncthreads();
            const bf16x8 pf0 = *(const bf16x8*)&Ps[l15 * PS_LD + q * 8];
            const bf16x8 pf1 = *(const bf16x8*)&Ps[l15 * PS_LD + 32 + q * 8];
            __builtin_amdgcn_sched_barrier(0);
#pragma unroll
            for (int nt = 0; nt < 8; ++nt) {
                f32x4 o = (f32x4){0.f, 0.f, 0.f, 0.f};
                o = mfma16(vf[nt][0], pf0, o); O[nt] = mfma16(vf[nt][1], pf1, o);
            }
            __builtin_amdgcn_sched_barrier(0);
#pragma unroll
            for (int nt = 0; nt < 8; ++nt) { vf[nt][0] = *(const bf16x8*)(Vrt + vf_off(idx, 16 * (8 + nt) + l15, q * 8)); vf[nt][1] = *(const bf16x8*)(Vrt + vf_off(idx, 16 * (8 + nt) + l15, 32 + q * 8)); }
#pragma unroll
            for (int nt = 0; nt < 16; ++nt) { oraw[nt] = *(const u32x2*)(orow + 16 * nt); graw[nt] = *(const u32x2*)(grow + 16 * nt); }
            __builtin_amdgcn_sched_barrier(0);
#pragma unroll
            for (int nt = 0; nt < 8; ++nt) {
                f32x4 o = (f32x4){0.f, 0.f, 0.f, 0.f};
                o = mfma16(vf[nt][0], pf0, o); O[8 + nt] = mfma16(vf[nt][1], pf1, o);
            }
#pragma unroll
            for (int nt = 0; nt < 16; ++nt) O[nt] += unpk4(oraw[nt]);
            __syncthreads();
        } else {
#pragma unroll
            for (int nt = 0; nt < 16; ++nt) { oraw[nt] = *(const u32x2*)(orow + 16 * nt); graw[nt] = *(const u32x2*)(grow + 16 * nt); }
#pragma unroll
            for (int nt = 0; nt < 16; ++nt) O[nt] = unpk4(oraw[nt]);
        }
        float s1 = 0.f;
#pragma unroll
        for (int nt = 0; nt < 16; ++nt) s1 += (O[nt][0] + O[nt][1]) + (O[nt][2] + O[nt][3]);
        s1 += __shfl_xor(s1, 16); s1 += __shfl_xor(s1, 32);
        const float mean = (br == 0) ? s1 * (1.0f / 256.0f) : 0.f;
        float s2 = 0.f;
#pragma unroll
        for (int nt = 0; nt < 16; ++nt) {
#pragma unroll
            for (int r = 0; r < 4; ++r) { const float dlt = O[nt][r] - mean; s2 += dlt * dlt; }
        }
        s2 += __shfl_xor(s2, 16); s2 += __shfl_xor(s2, 32);
        const float rstd = rsqrtf(s2 * (1.0f / 256.0f) + (br == 0 ? 1e-5f : 1e-6f));
        const float* gw = (br == 0 ? p.ret_norm_g : p.gla_norm_g) + h * 256 + 4 * q;
        bf16_t* yrow = Y + ((size_t)br * T_ + tok) * 1024 + h * 256 + 4 * q;
#pragma unroll
        for (int nt = 0; nt < 16; ++nt) {
            const f32x4 g = *(const f32x4*)(gw + 16 * nt);
            const f32x4 gate = unpk4(graw[nt]);
            f32x4 y;
#pragma unroll
            for (int r = 0; r < 4; ++r) y[r] = (O[nt][r] - mean) * rstd * g[r] * gate[r];
            *(u32x2*)(yrow + 16 * nt) = pk4(y);
        }
    }
}

struct EpiMerge {
    static constexpr bool PERM = true, AFTER_DRAIN = false;
    const bf16_t* Mg; bf16_t* Mrg; int pass;
    __device__ __forceinline__ void operator()(const pg8::f32x4 (&acc)[2][2][4][2], const pg8::Unit& u, int wr, int wc, int fr, int fq) const {
        const int row0 = u.pm * 256 + wr * 64 + fr, col0 = u.pn * 256 + wc * 32 + 8 * fq;
#pragma unroll
        for (int ai = 0; ai < 2; ++ai) {
            u32x4 gg[4][2], pr[4][2];
#pragma unroll
            for (int m = 0; m < 4; ++m)
#pragma unroll
                for (int bj = 0; bj < 2; ++bj) {
                    const size_t row = row0 + ai * 128 + m * 16; const int col = col0 + bj * 128;
                    gg[m][bj] = *(const u32x4*)(Mg + row * 2048 + pass * 1024 + col);
                    if (pass) pr[m][bj] = *(const u32x4*)(Mrg + row * 1024 + col);
                }
#pragma unroll
            for (int m = 0; m < 4; ++m)
#pragma unroll
                for (int bj = 0; bj < 2; ++bj) {
                    const size_t row = row0 + ai * 128 + m * 16; const int col = col0 + bj * 128;
                    f32x4 g0, g1; unpk8(gg[m][bj], g0, g1);
                    f32x4 o0 = acc[ai][bj][m][0] * g0, o1 = acc[ai][bj][m][1] * g1;
                    if (pass) { f32x4 p0, p1; unpk8(pr[m][bj], p0, p1); o0 += p0; o1 += p1; }
                    *(u32x4*)(Mrg + row * 1024 + col) = pk8(o0, o1);
                }
        }
    }
};
DEVI void phase5(const Params& p, unsigned char* smem_all) {
    pg8::StaticOrder S; S.init(T_, 1024, RG, RB);
    const bf16_t* Y = (const bf16_t*)(p.ws + OFF_Y); const bf16_t* wt = (const bf16_t*)(p.ws + OFF_WT);
    for (int pass = 0; pass < 2; ++pass) {
        pg8::Gemm g; g.A = Y + (size_t)pass * T_ * 1024; g.Bt = wt + (size_t)(pass ? WT_GLA : WT_RET) * 1024; g.M = T_; g.N = 1024; g.K = 1024;
        EpiMerge E; E.Mg = (const bf16_t*)(p.ws + OFF_MG); E.Mrg = (bf16_t*)(p.ws + OFF_MRG); E.pass = pass;
        pg8::gemm_phase<EpiMerge, pg8::StaticOrder, true, true>((PG8_LAS unsigned char*)smem_all, g, S, E);
        __syncthreads();
    }
}

struct EpiResid {
    static constexpr bool PERM = true, AFTER_DRAIN = false;
    const float* x; bf16_t* T1;
    __device__ __forceinline__ void operator()(const pg8::f32x4 (&acc)[2][2][4][2], const pg8::Unit& u, int wr, int wc, int fr, int fq) const {
        const int row0 = u.pm * 256 + wr * 64 + fr, col0 = u.pn * 256 + wc * 32 + 8 * fq;
#pragma unroll
        for (int ai = 0; ai < 2; ++ai)
#pragma unroll
            for (int m = 0; m < 4; ++m) {
                const size_t row = row0 + ai * 128 + m * 16;
                f32x4 xv[2][2];
#pragma unroll
                for (int bj = 0; bj < 2; ++bj) { xv[bj][0] = *(const f32x4*)(x + row * 1024 + col0 + bj * 128); xv[bj][1] = *(const f32x4*)(x + row * 1024 + col0 + bj * 128 + 4); }
#pragma unroll
                for (int bj = 0; bj < 2; ++bj)
                    *(u32x4*)(T1 + row * 1024 + col0 + bj * 128) = pk8(xv[bj][0] * ALPHA_ + acc[ai][bj][m][0], xv[bj][1] * ALPHA_ + acc[ai][bj][m][1]);
            }
    }
};
DEVI void phase6(const Params& p, unsigned char* smem_all) {
    pg8::StaticOrder S; S.init(T_, 1024, RG, RB);
    pg8::Gemm g; g.A = (const bf16_t*)(p.ws + OFF_MRG); g.Bt = (const bf16_t*)(p.ws + OFF_WT) + (size_t)WT_O * 1024; g.M = T_; g.N = 1024; g.K = 1024;
    EpiResid E; E.x = p.x; E.T1 = (bf16_t*)(p.ws + OFF_T1);
    pg8::gemm_phase<EpiResid, pg8::StaticOrder, true, true>((PG8_LAS unsigned char*)smem_all, g, S, E);
}

DEVI void conv_expert_weights(const Params& p, unsigned char* smem) {
    bf16_t* tile = (bf16_t*)smem;
    const int t = VT, ng = t & 31, kg = t >> 5;
    bf16_t* WGU = (bf16_t*)(p.ws + OFF_WGU); bf16_t* WD = (bf16_t*)(p.ws + OFF_WD);
    const int ntask = 257 * 3 * 32;
    for (int task = VB; task < ntask; task += VG) {
        const int e = task / 96, rem = task - e * 96, mat = rem >> 5, tl = rem & 31;
        const float* src; bf16_t* dst; int K, N, kt, nt;
        if (mat < 2) { K = 1024; N = 256; kt = tl >> 1; nt = tl & 1;
            src = (mat == 0) ? (e < 256 ? p.ew_gate + (size_t)e * 262144 : p.sw_gate) : (e < 256 ? p.ew_up + (size_t)e * 262144 : p.sw_up);
            dst = WGU + (size_t)e * 524288 + (size_t)(nt + mat) * 131072; }
        else { K = 256; N = 1024; kt = tl >> 3; nt = tl & 7;
            src = e < 256 ? p.ew_down + (size_t)e * 262144 : p.sw_down; dst = WD + (size_t)e * 262144; }
        const float* sp = src + (size_t)(kt * 64 + 4 * kg) * N + nt * 128 + 4 * ng;
        f32x4 rf[8];
#pragma unroll
        for (int i = 0; i < 4; ++i) { rf[i] = *(const f32x4*)(sp + (size_t)i * N); rf[4 + i] = *(const f32x4*)(sp + (size_t)(32 + i) * N); }
#pragma unroll
        for (int i = 0; i < 4; ++i) {
            u32x2 v0, v1;
            v0.x = pk2(rf[0][i], rf[1][i]); v0.y = pk2(rf[2][i], rf[3][i]); v1.x = pk2(rf[4][i], rf[5][i]); v1.y = pk2(rf[6][i], rf[7][i]);
            *(u32x2*)&tile[(4 * ng + i) * 72 + 4 * kg] = v0; *(u32x2*)&tile[(4 * ng + i) * 72 + 32 + 4 * kg] = v1;
        }
        __syncthreads();
        {
            const int n = t >> 1, hf = t & 1;
            bf16_t* dp = dst + (size_t)(nt * 128 + n) * K + kt * 64 + hf * 32;
#pragma unroll
            for (int j = 0; j < 4; ++j) *(u32x4*)(dp + 8 * j) = *(const u32x4*)&tile[n * 72 + hf * 32 + 8 * j];
        }
        __syncthreads();
    }
}

DEVI void phase7(const Params& p, unsigned char* smem) {
    const int t = VT, lane = t & 63, w = t >> 6;
    const bf16_t* T1 = (const bf16_t*)(p.ws + OFF_T1); bf16_t* X1b = (bf16_t*)(p.ws + OFF_X1B);
    for (int row = VB * 4 + w; row < T_; row += VG * 4) {
        f32x4 v[4]; float s = 0.f;
#pragma unroll
        for (int i = 0; i < 4; ++i) { v[i] = unpk4(*(const u32x2*)(T1 + (size_t)row * 1024 + i * 256 + lane * 4)); s += (v[i][0] + v[i][1]) + (v[i][2] + v[i][3]); }
#pragma unroll
        for (int o = 32; o > 0; o >>= 1) s += __shfl_xor(s, o);
        const float mean = s * (1.0f / 1024.0f); float s2 = 0.f;
#pragma unroll
        for (int i = 0; i < 4; ++i)
#pragma unroll
            for (int r = 0; r < 4; ++r) { const float d = v[i][r] - mean; s2 += d * d; }
#pragma unroll
        for (int o = 32; o > 0; o >>= 1) s2 += __shfl_xor(s2, o);
        const float rstd = rsqrtf(s2 * (1.0f / 1024.0f) + 1e-5f);
#pragma unroll
        for (int i = 0; i < 4; ++i) {
            const int col = i * 256 + lane * 4;
            const f32x4 g = *(const f32x4*)(p.ln1_g + col), bb = *(const f32x4*)(p.ln1_b + col);
            f32x4 y;
#pragma unroll
            for (int r = 0; r < 4; ++r) y[r] = (v[i][r] - mean) * rstd * g[r] + bb[r];
            *(u32x2*)(X1b + (size_t)row * 1024 + col) = pk4(y);
        }
    }
    conv_expert_weights(p, smem);
}

DEVI unsigned f2ord(float f) { const unsigned u = __float_as_uint(f); return (u & 0x80000000u) ? ~u : (u | 0x80000000u); }
template <int CTRL> DEVI float dppf(float v) { const int x = __float_as_int(v); return __int_as_float(__builtin_amdgcn_update_dpp(x, x, CTRL, 0xf, 0xf, false)); }
template <int CTRL> DEVI void top2_merge(float& m1, float& m2) {
    const float p1 = dppf<CTRL>(m1), p2 = dppf<CTRL>(m2);
    const float n1 = fmaxf(m1, p1), n2 = fmaxf(fminf(m1, p1), fmaxf(m2, p2));
    m1 = n1; m2 = n2;
}
DEVI void route_token(const f32x4 lg, const f32x4 rb, int lane, int& mye, float& myw) {
    const int mygrp = lane >> 3;
    float sc[4], bi[4];
#pragma unroll
    for (int r = 0; r < 4; ++r) { sc[r] = sigmoidf_(lg[r]); bi[r] = sc[r] + rb[r]; }
    float m1, m2;
    { const float h01 = fmaxf(bi[0], bi[1]), l01 = fminf(bi[0], bi[1]), h23 = fmaxf(bi[2], bi[3]), l23 = fminf(bi[2], bi[3]);
      m1 = fmaxf(h01, h23); m2 = fmaxf(fminf(h01, h23), fmaxf(l01, l23)); }
    top2_merge<0xB1>(m1, m2);
    top2_merge<0x4E>(m1, m2);
    top2_merge<0x141>(m1, m2);
    const float gown = m1 + m2;
    int rank = 0;
#pragma unroll
    for (int g2 = 0; g2 < 8; ++g2) {
        const float go = __builtin_bit_cast(float, __builtin_amdgcn_readlane(__builtin_bit_cast(int, gown), 8 * g2));
        rank += (go > gown || (go == gown && g2 < mygrp)) ? 1 : 0;
    }
    unsigned ck[4];
#pragma unroll
    for (int r = 0; r < 4; ++r) ck[r] = rank < 4 ? f2ord(bi[r]) : 0u;
    unsigned thr = 0u; bool exact = false;
#pragma unroll 1
    for (int bit = 31; bit >= 0; --bit) {
        const unsigned cnd = thr | (1u << bit);
        const int c8 = __popcll(__ballot(ck[0] >= cnd)) + __popcll(__ballot(ck[1] >= cnd)) + __popcll(__ballot(ck[2] >= cnd)) + __popcll(__ballot(ck[3] >= cnd));
        if (c8 >= 8) { thr = cnd; if (c8 == 8) { exact = true; break; } }
    }
    unsigned long long selm[4];
    if (exact) {
#pragma unroll
        for (int r = 0; r < 4; ++r) selm[r] = __ballot(ck[r] >= thr);
    } else {
        unsigned long long eq[4], any = 0ull; int need = 8;
#pragma unroll
        for (int r = 0; r < 4; ++r) { selm[r] = __ballot(ck[r] > thr); eq[r] = __ballot(ck[r] == thr); need -= __popcll(selm[r]); any |= eq[r]; }
        while (need > 0 && any != 0ull) {
            const int L = __builtin_ctzll(any); any &= any - 1ull;
#pragma unroll
            for (int r = 0; r < 4; ++r) if (((eq[r] >> L) & 1ull) != 0ull && need > 0) { selm[r] |= 1ull << L; --need; }
        }
    }
    float wsum = 0.f; int kk = 0;
    mye = 0; myw = 0.f;
#pragma unroll
    for (int r = 0; r < 4; ++r) {
        unsigned long long m = selm[r];
        while (m != 0ull) {
            const int L = __builtin_ctzll(m); m &= m - 1ull;
            const float sv = __builtin_bit_cast(float, __builtin_amdgcn_readlane(__builtin_bit_cast(int, sc[r]), L));
            wsum += sv;
            if (lane == kk) { mye = 4 * L + r; myw = sv; }
            ++kk;
        }
    }
    myw = myw / wsum * 2.5f;
}
DEVI void router_gemm(const Params& p, unsigned char* smem_all, int m0, f32x4 (&acc)[4][4]) {
    typedef __attribute__((address_space(3))) unsigned char lds8;
    lds8* const L = (lds8*)smem_all;
    const int tid = (int)threadIdx.x, lane = tid & 63, wv = __builtin_amdgcn_readfirstlane(tid >> 6), wr = wv >> 2, wc = wv & 3, l15 = lane & 15, q = lane >> 4;
    const bf16_t* pa = (const bf16_t*)(p.ws + OFF_X1B) + (size_t)(m0 + (tid >> 3)) * 1024 + gemm_src_chunk(tid);
    const bf16_t* pb = (const bf16_t*)(p.ws + OFF_WT) + (size_t)(WT_R + (tid >> 3)) * 1024 + gemm_src_chunk(tid);
    constexpr int STG = 49152;
#define RG_BOFF(BUF, I) ((BUF) * STG + 16384 + (I) * 8192 + (((BUF) == 2 && (I) >= 2) ? (2 * SMEM_HALF - 131072) : 0))
#define RG_ISSUE(BUF, KT) do { \
        _Pragma("unroll") for (int i = 0; i < 2; ++i) __builtin_amdgcn_global_load_lds((const unsigned*)(pa + (size_t)i * 65536 + (KT) * 64), (__attribute__((address_space(3))) unsigned*)(L + (BUF) * STG + i * 8192 + wv * 1024), 16, 0, 0); \
        _Pragma("unroll") for (int i = 0; i < 4; ++i) __builtin_amdgcn_global_load_lds((const unsigned*)(pb + (size_t)i * 65536 + (KT) * 64), (__attribute__((address_space(3))) unsigned*)(L + RG_BOFF(BUF, i) + wv * 1024), 16, 0, 0); } while (0)
    static_assert(2 * STG + 16384 + 2 * 8192 == 131072 && 2 * SMEM_HALF + 2 * 8192 <= 2 * SMEM_HALF + SMEM_MOE, "router GEMM stage map");
    RG_ISSUE(0, 0); RG_ISSUE(1, 1);
    int buf = 0;
#pragma unroll 1
    for (int kt = 0; kt < 16; ++kt) {
        if (kt + 1 < 16) asm volatile("s_waitcnt vmcnt(6)" ::: "memory"); else asm volatile("s_waitcnt vmcnt(0)" ::: "memory");
        __builtin_amdgcn_s_barrier();
        if (kt + 2 < 16) { const int b2 = buf == 0 ? 2 : buf - 1; RG_ISSUE(b2, kt + 2); }
        __builtin_amdgcn_sched_barrier(0);
#pragma unroll
        for (int ss = 0; ss < 2; ++ss) {
            bf16x8 af[4], bfr[4];
            const int coff = ((ss * 4 + q) ^ (l15 >> 1)) * 16;
#pragma unroll
            for (int i = 0; i < 4; ++i) {
                af[i]  = *(const __attribute__((address_space(3))) bf16x8*)(L + buf * STG + (wr * 64 + i * 16 + l15) * 128 + coff);
                bfr[i] = *(const __attribute__((address_space(3))) bf16x8*)(L + RG_BOFF(buf, wc) + (i * 16 + l15) * 128 + coff); }
#pragma unroll
            for (int mt = 0; mt < 4; ++mt)
#pragma unroll
                for (int nt = 0; nt < 4; ++nt) acc[mt][nt] = mfma16(bfr[nt], af[mt], acc[mt][nt]);
        }
        __builtin_amdgcn_sched_barrier(0);
        buf = buf == 2 ? 0 : buf + 1;
    }
#undef RG_ISSUE
#undef RG_BOFF
    __syncthreads();
}
DEVI void phase8(const Params& p, unsigned char* smem_all) {
    const int tid = (int)threadIdx.x, lane = tid & 63, wv = tid >> 6, wr = wv >> 2, wc = wv & 3, l15 = lane & 15, q = lane >> 4;
    int* hist = (int*)(smem_all + 2 * SMEM_HALF); int* rec = hist + 256; float* wrec = (float*)(rec + 1024);
    int* cnt = (int*)(p.ws + OFF_CNT); int* list = (int*)(p.ws + OFF_LIST); float* wl = (float*)(p.ws + OFF_WL);
    const f32x4 rb = *(const f32x4*)(p.router_bias + 4 * lane);
    for (int mtg = RB; mtg < 256; mtg += RG) {
        const int m0 = mtg * 128;
        f32x4 acc[4][4]; zero_acc(acc);
        router_gemm(p, smem_all, m0, acc);
        if (tid < 256) hist[tid] = 0;
#pragma unroll
        for (int mt = 0; mt < 4; ++mt)
#pragma unroll
            for (int nt = 0; nt < 4; ++nt) {
                const int row = wr * 64 + mt * 16 + l15, col = wc * 64 + (nt >> 1) * 32 + 8 * q + 4 * (nt & 1);
                *(f32x4*)(smem_all + row * 1024 + (((col >> 2) ^ (row & 15)) * 16)) = acc[mt][nt];
            }
        __syncthreads();
#pragma unroll 1
        for (int i = 0; i < 16; ++i) {
            const int tl = wv + 8 * i;
            const f32x4 lg = *(const f32x4*)(smem_all + tl * 1024 + ((lane ^ (tl & 15)) * 16));
            int mye; float myw; route_token(lg, rb, lane, mye, myw);
            if (lane < 8) {
                const int lpos = __hip_atomic_fetch_add(&hist[mye], 1, __ATOMIC_RELAXED, __HIP_MEMORY_SCOPE_WORKGROUP);
                rec[tl * 8 + lane] = mye | (lpos << 8); wrec[tl * 8 + lane] = myw;
            }
        }
        __syncthreads();
        if (tid < 256) { const int c = hist[tid]; hist[tid] = c > 0 ? atomicAdd(&cnt[tid * CNT_STRIDE], c) : 0; }
        __syncthreads();
        for (int i = tid; i < 1024; i += 512) {
            const int rc = rec[i], e = rc & 255, pos = hist[e] + (rc >> 8);
            list[(size_t)e * T_ + pos] = (m0 + (i >> 3)) * 9 + (i & 7); wl[(size_t)e * T_ + pos] = wrec[i];
        }
        __syncthreads();
    }
}

DEVI void moe_prefix256(const Params& p, int* pre  , int xg) {
    const int tid = threadIdx.x;
    const int* cnt = (const int*)(p.ws + OFF_CNT);
    __syncthreads();
    if (tid < 64) {
        int v = 0;
        if (tid < 32) { const int c = __hip_atomic_load(&cnt[(xg + 8 * tid) * CNT_STRIDE], __ATOMIC_RELAXED, __HIP_MEMORY_SCOPE_AGENT); pre[40 + tid] = c; v = (c + 255) >> 8; }
        else if (tid == 32) { v = 16; pre[40 + 32] = T_; }
#pragma unroll
        for (int o = 1; o < 64; o <<= 1) { const int u = __shfl_up(v, o); if (tid >= o) v += u; }
        if (tid < 33) pre[tid + 1] = v;
        if (tid == 0) pre[0] = 0;
    }
    __syncthreads();
}
struct MoeSched {
    const int* pre; const unsigned char* ws; bool need_w;
    int* sbuf;
    int xg, jl, nloc, nsh, nitems;
    const char* Abase; int arow_bytes; bool by_token;
    const char* Bbase; size_t b_expert_bytes, b_unit_bytes;
    __device__ __forceinline__ bool next(int i, pg8::Unit& u) const {
        const int item = jl + i * nloc; if (item >= nitems) return false;
        u.pm = item >> nsh; u.pn = item - (u.pm << nsh);
        const int lane = (int)(threadIdx.x & 63), li = lane < 33 ? lane : 32;
        const int pv = pre[li], cv = pre[40 + li];
        const int gi = __popcll(__ballot(lane < 33 && pv <= u.pm)) - 1;
        const int pg = __builtin_amdgcn_readlane(pv, gi);
        u.ce = __builtin_amdgcn_readlane(cv, gi);
        u.e = gi < 32 ? xg + 8 * gi : 256; u.r0 = (gi < 32 ? 0 : xg * 4096) + (u.pm - pg) * 256;
        return true;
    }
    __device__ __forceinline__ void decode(const pg8::Unit& u, int& e, int& r0, int& ce) const { e = u.e; r0 = u.r0; ce = u.ce; }
    __device__ __forceinline__ int fill_issue(const pg8::Unit& u) const {
        int e, r0, ce; decode(u, e, r0, ce);
        const int pos = r0 + (int)(threadIdx.x & 255); const bool w = threadIdx.x >= 256;
        int v = w ? 0 : -1;
        if (pos < ce && !(w && !need_w)) {
            unsigned hi = threadIdx.x >> 8; asm volatile("" : "+v"(hi));
            static_assert(OFF_WL == OFF_LIST + (512u << 20), "weight list sits 512 MB above the slot list");
            const unsigned off = (unsigned)OFF_LIST + (hi << 29) + ((unsigned)e * (unsigned)T_ + (unsigned)pos) * 4u;
            v = e < 256 ? *(const int*)(ws + off) : (w ? 0x3f800000 : pos * 9 + 8);
        }
        return v;
    }
    __device__ __forceinline__ void fill_write(int buf, int v) const { sbuf[(threadIdx.x >= 256 ? 768 : 0) + buf * 256 + (int)(threadIdx.x & 255)] = v; }
    __device__ __forceinline__ const char* a_base() const { return Abase; }
    __device__ __forceinline__ void a_rows(int buf, const int (&rowA)[2], const int (&colA)[2], unsigned& p00, unsigned& p01, unsigned& p10, unsigned& p11) const {
        const int* sb = sbuf + buf * 256; const int s0 = sb[0];
        int s4[4];
#pragma unroll
        for (int k = 0; k < 4; ++k) { int sl = sb[(k >> 1) * 128 + rowA[k & 1]]; if (sl < 0) sl = s0; s4[k] = sl; }
#pragma unroll
        for (int k = 0; k < 4; ++k) if (by_token) s4[k] = s4[k] / 9;
        p00 = (unsigned)s4[0] * (unsigned)arow_bytes + (unsigned)colA[0]; p01 = (unsigned)s4[1] * (unsigned)arow_bytes + (unsigned)colA[1];
        p10 = (unsigned)s4[2] * (unsigned)arow_bytes + (unsigned)colA[0]; p11 = (unsigned)s4[3] * (unsigned)arow_bytes + (unsigned)colA[1];
    }
    __device__ __forceinline__ const char* b_base(const pg8::Unit& u) const { int e, r0, ce; decode(u, e, r0, ce); return Bbase + (size_t)e * b_expert_bytes + (size_t)u.pn * b_unit_bytes; }
    __device__ __forceinline__ void a_ready(const pg8::Unit&) const {}
    __device__ __forceinline__ void done(const pg8::Unit&) const {}
};
struct EpiMoe1 {
    static constexpr bool PERM = true, AFTER_DRAIN = false, BJI = false;
    const MoeSched* S; bf16_t* H;
    __device__ __forceinline__ void operator()(const pg8::f32x4 (&acc)[2][2][4][2], const pg8::Unit& u, int wr, int wc, int fr, int fq, int buf) const {
        const int* sb = S->sbuf + buf * 256 + wr * 64 + fr;
#pragma unroll
        for (int ai = 0; ai < 2; ++ai) {
            int sl[4];
#pragma unroll
            for (int m = 0; m < 4; ++m) sl[m] = sb[ai * 128 + m * 16];
#pragma unroll
            for (int m = 0; m < 4; ++m) if (sl[m] >= 0) {
                f32x4 h0, h1;
#pragma unroll
                for (int r = 0; r < 4; ++r) { h0[r] = siluf_(acc[ai][0][m][0][r]) * acc[ai][1][m][0][r]; h1[r] = siluf_(acc[ai][0][m][1][r]) * acc[ai][1][m][1][r]; }
                *(u32x4*)(H + (size_t)sl[m] * 256 + u.pn * 128 + wc * 32 + 8 * fq) = pk8(h0, h1);
            }
            asm volatile("" ::: "memory");
        }
    }
};
struct EpiMoe2 {
    static constexpr bool PERM = true, AFTER_DRAIN = false, BJI = true;
    const MoeSched* S; unsigned char* YX;
    __device__ __forceinline__ void operator()(const pg8::f32x4 (&acc)[2][2][4][2], const pg8::Unit& u, int wr, int wc, int fr, int fq, int buf) const {
        const int* sb = S->sbuf + buf * 256 + wr * 64 + fr;
#pragma unroll
        for (int ai = 0; ai < 2; ++ai) {
            int sl[4]; float wg[4];
#pragma unroll
            for (int m = 0; m < 4; ++m) { sl[m] = sb[ai * 128 + m * 16]; wg[m] = __int_as_float(sb[768 + ai * 128 + m * 16]) * YX_SCALE; }
#pragma unroll
            for (int m = 0; m < 4; ++m) if (sl[m] >= 0) {
                u32x4 w8;
                w8.x = pk4_fp8(clamp4(acc[ai][0][m][0] * wg[m], 440.f)); w8.y = pk4_fp8(clamp4(acc[ai][0][m][1] * wg[m], 440.f));
                w8.z = pk4_fp8(clamp4(acc[ai][1][m][0] * wg[m], 440.f)); w8.w = pk4_fp8(clamp4(acc[ai][1][m][1] * wg[m], 440.f));
                *(u32x4*)(YX + (size_t)sl[m] * 1024 + u.pn * 256 + wc * 64 + 16 * fq) = w8;
            }
            asm volatile("" ::: "memory");
        }
    }
};
DEVI void moe_sched_init(const Params& p, MoeSched& S, int* pre) {
    S.pre = pre; S.ws = p.ws; S.need_w = false; S.sbuf = (int*)(smem_all_g + 2 * SMEM_HALF);
    S.xg = RB & 7; S.jl = RB >> 3; S.nloc = RG >> 3;
}
DEVI void phase10(const Params& p, unsigned char* smem_all) {
    int* pre = (int*)(smem_all + 131072);
    MoeSched S; moe_sched_init(p, S, pre); moe_prefix256(p, pre, S.xg);
    S.nsh = 1; S.nitems = pre[33] << 1; S.Abase = (const char*)(p.ws + OFF_X1B); S.arow_bytes = 2048; S.by_token = true;
    S.Bbase = (const char*)(p.ws + OFF_WGU); S.b_expert_bytes = (size_t)512 * 1024 * 2; S.b_unit_bytes = (size_t)256 * 1024 * 2;
    EpiMoe1 E; E.S = &S; E.H = (bf16_t*)(p.ws + OFF_H);
    pg8::gemm_phase_g<EpiMoe1, MoeSched, true, true>((PG8_LAS unsigned char*)smem_all, 1024, S, E);
}
DEVI void phase11(const Params& p, unsigned char* smem_all) {
    int* pre = (int*)(smem_all + 131072);
    MoeSched S; moe_sched_init(p, S, pre); moe_prefix256(p, pre, S.xg);
    S.nsh = 2; S.nitems = pre[33] << 2; S.Abase = (const char*)(p.ws + OFF_H); S.arow_bytes = 512; S.by_token = false;
    S.Bbase = (const char*)(p.ws + OFF_WD); S.b_expert_bytes = (size_t)1024 * 256 * 2; S.b_unit_bytes = (size_t)256 * 256 * 2;
    S.need_w = true;
    EpiMoe2 E; E.S = &S; E.YX = (unsigned char*)(p.ws + OFF_YX);
    pg8::gemm_phase_g<EpiMoe2, MoeSched, true, true>((PG8_LAS unsigned char*)smem_all, 256, S, E);
}

DEVI void phase12(const Params& p) {
    const int t = VT, lane = t & 63, w = t >> 6;
    const bf16_t* X1b = (const bf16_t*)(p.ws + OFF_X1B); const unsigned char* YX = (const unsigned char*)(p.ws + OFF_YX);
    for (int row = VB * 4 + w; row < T_; row += VG * 4) {
        f32x4 v[4]; float s = 0.f;
#pragma unroll
        for (int i = 0; i < 4; ++i) {
            const int col = i * 256 + lane * 4;
            f32x4 a = unpk4(*(const u32x2*)(X1b + (size_t)row * 1024 + col)) * ALPHA_;
            f32x4 ys = (f32x4){0.f, 0.f, 0.f, 0.f};
#pragma unroll
            for (int k = 0; k < 9; ++k) ys += unpk4_fp8(*(const unsigned*)(YX + ((size_t)row * 9 + k) * 1024 + col));
            a += ys * (1.0f / YX_SCALE);
            v[i] = a; s += (a[0] + a[1]) + (a[2] + a[3]);
        }
#pragma unroll
        for (int o = 32; o > 0; o >>= 1) s += __shfl_xor(s, o);
        const float mean = s * (1.0f / 1024.0f); float s2 = 0.f;
#pragma unroll
        for (int i = 0; i < 4; ++i)
#pragma unroll
            for (int r = 0; r < 4; ++r) { const float d = v[i][r] - mean; s2 += d * d; }
#pragma unroll
        for (int o = 32; o > 0; o >>= 1) s2 += __shfl_xor(s2, o);
        const float rstd = rsqrtf(s2 * (1.0f / 1024.0f) + 1e-5f);
#pragma unroll
        for (int i = 0; i < 4; ++i) {
            const int col = i * 256 + lane * 4;
            const f32x4 g = *(const f32x4*)(p.ln2_g + col), bb = *(const f32x4*)(p.ln2_b + col);
            f32x4 y;
#pragma unroll
            for (int r = 0; r < 4; ++r) y[r] = (v[i][r] - mean) * rstd * g[r] + bb[r];
            *(f32x4*)(p.out + (size_t)row * 1024 + col) = y;
        }
    }
}


#define XB_TMO      128
#define XB_XCNT(j)  (256  + 64 * (j))
#define XB_XSUB(j)  (1280 + 64 * (j))
#define XB_XGEN(j)  (2304 + 64 * (j))
#define XB_TOP      3328
#define XB_TOPGEN   3392
#define XCD_BAR_WORDS 3456
#define XB_SPIN_CAP (1u << 20)
#define LAS __attribute__((address_space(3)))
DEVI unsigned xb_ld(unsigned* p)              { return __hip_atomic_load(p, __ATOMIC_RELAXED, __HIP_MEMORY_SCOPE_AGENT); }
DEVI unsigned xb_add(unsigned* p, unsigned v) { return __hip_atomic_fetch_add(p, v, __ATOMIC_RELAXED, __HIP_MEMORY_SCOPE_AGENT); }
DEVI unsigned xb_xcc_id() { return (unsigned)__builtin_amdgcn_s_getreg((3 << 11) | 20) & 0xFu; }
#define XB_SPIN(cond, bar) do { unsigned _sp = 0; while (cond) { __builtin_amdgcn_s_sleep(1); \
    if ((++_sp & 255u) == 0u) { if (xb_ld(&(bar)[XB_TMO])) break; if (_sp > XB_SPIN_CAP) { atomicAdd(&(bar)[XB_TMO], 1u); break; } } } } while (0)
struct XcdBarrier { unsigned* bar; unsigned x; volatile LAS unsigned* st; };
DEVI XcdBarrier xcd_barrier_post(unsigned* bar, volatile LAS unsigned* st) {
    XcdBarrier b; b.bar = bar; b.x = xb_xcc_id(); b.st = st;
    if (threadIdx.x == 0) st[3] = xb_add(&bar[XB_XCNT(b.x)], 1u);
    return b;
}
DEVI void xcd_barrier_complete(unsigned* bar, unsigned x, unsigned& nloc, unsigned& nx) {
    const unsigned G = gridDim.x * gridDim.y * gridDim.z;
    unsigned sum, cnt, mine, sp = 0u;
    for (;;) {
        sum = 0u; cnt = 0u; mine = 0u;
#pragma unroll
        for (unsigned j = 0; j < 16; ++j) { const unsigned c = xb_ld(&bar[XB_XCNT(j)]); sum += c; cnt += (c > 0u) ? 1u : 0u; mine = (j == x) ? c : mine; }
        if (sum == G) break;
        __builtin_amdgcn_s_sleep(1);
        if ((++sp & 255u) == 0u) { if (xb_ld(&bar[XB_TMO])) break; if (sp > XB_SPIN_CAP) { atomicAdd(&bar[XB_TMO], 1u); break; } }
    }
    nloc = mine > 0u ? mine : 1u; nx = cnt > 0u ? cnt : 1u;
}
DEVI void xcd_barrier(const XcdBarrier& b) {
    asm volatile("s_waitcnt vmcnt(0)" ::: "memory");
    __syncthreads();
    if (threadIdx.x == 0) {
        unsigned* bar = b.bar;
        __builtin_amdgcn_s_waitcnt(0);
        unsigned nloc = b.st[0], nx = b.st[1];
        if (nloc == 0u) { xcd_barrier_complete(bar, b.x, nloc, nx); b.st[0] = nloc; b.st[1] = nx; }
        const unsigned old = xb_add(&bar[XB_XSUB(b.x)], 1u);
        const unsigned gen = old / nloc;
        if (old + 1u == (gen + 1u) * nloc) {
            __builtin_amdgcn_fence(__ATOMIC_RELEASE, "agent");
            asm volatile("s_waitcnt vmcnt(0)" ::: "memory");
            const unsigned og = xb_add(&bar[XB_TOP], 1u);
            const unsigned tg = og / nx;
            if (og + 1u == (tg + 1u) * nx) xb_add(&bar[XB_TOPGEN], 1u);
            else XB_SPIN(xb_ld(&bar[XB_TOPGEN]) == tg, bar);
            __builtin_amdgcn_fence(__ATOMIC_ACQUIRE, "agent");
            xb_add(&bar[XB_XGEN(b.x)], 1u);
            asm volatile("s_waitcnt vmcnt(0)" ::: "memory");
        } else {
            XB_SPIN(xb_ld(&bar[XB_XGEN(b.x)]) == gen, bar);
            __builtin_amdgcn_fence(__ATOMIC_ACQUIRE, "agent");
            asm volatile("s_waitcnt vmcnt(0)" ::: "memory");
        }
    }
    __syncthreads();
}
constexpr size_t OFF_BAR = 131072;

#ifndef DBG
#define DBG 0
#endif
DEVI void dump_f32(const Params& p, size_t off) {
    const f32x4* src = (const f32x4*)(p.ws + off); f32x4* dst = (f32x4*)p.out;
    for (int i = blockIdx.x * 256 + threadIdx.x; i < T_ * D_ / 4; i += gridDim.x * 256) dst[i] = src[i];
}
DEVI void dump_bf16(const Params& p, size_t off, int ld, int coff) {
    const bf16_t* src = (const bf16_t*)(p.ws + off);
    for (int i = blockIdx.x * 256 + threadIdx.x; i < T_ * D_; i += gridDim.x * 256) { const int row = i >> 10, col = i & 1023; p.out[i] = bf2f(src[(size_t)row * ld + coff + col]); }
}
DEVI float flat_bf(const Params& p, size_t off, size_t n, size_t i) { const bf16_t* b = (const bf16_t*)(p.ws + off); float a = 0.f; for (size_t j = i; j < n; j += (size_t)T_ * D_) a += bf2f(b[j]); return a; }
DEVI void dump_p1(const Params& p) {
    const size_t N = (size_t)T_ * D_;
    for (size_t i = (size_t)blockIdx.x * 256 + threadIdx.x; i < N; i += (size_t)gridDim.x * 256) {
        float a = 0.f;
        a += flat_bf(p, OFF_MG, 2 * N, i) + flat_bf(p, OFF_GS, 2 * N, i);
        a += flat_bf(p, OFF_QR, N / 2, i % (N / 2)) + flat_bf(p, OFF_KR, N / 2, i % (N / 2)) + flat_bf(p, OFF_QG, N / 2, i % (N / 2));
        a += flat_bf(p, OFF_KRT, N / 2, i % (N / 2)) + flat_bf(p, OFF_KGT, N / 2, i % (N / 2));
        a += flat_bf(p, OFF_VRT, N, i) + flat_bf(p, OFF_VGT, N, i);
        a += ((const float*)(p.ws + OFF_GA))[i % ((size_t)T_ * 16)];
        p.out[i] = a;
    }
}
constexpr int NPHASE = 13;
__global__ void __launch_bounds__(512, 2) fwd_megakernel(Params p) {
    unsigned char* const smem_all = smem_all_g;
    unsigned char* smem = smem_all + VH * SMEM_HALF;
    uint4* xb_words = (uint4*)(smem_all + 2 * SMEM_HALF - 16);
    if (threadIdx.x == 0) *xb_words = make_uint4(0u, 0u, blockIdx.x, 0u);
    __syncthreads();
    const XcdBarrier xb = xcd_barrier_post((unsigned*)(p.ws + OFF_BAR), (volatile LAS unsigned*)xb_words);
#ifndef REPMASK
#define REPMASK 0
#endif
#ifndef TIMEPHASE
#define TIMEPHASE -1
#endif
#define RUN_PHASE(K, CALL) do { if (p.phase_lo <= (K) && (K) < p.phase_hi) { \
        const unsigned long long tp0_ = (TIMEPHASE == (K)) ? __builtin_amdgcn_s_memrealtime() : 0ull; \
        _Pragma("unroll 1") for (int rep_ = ((REPMASK >> (K)) & 1); rep_ >= 0; --rep_) { CALL; if (rep_ > 0 || (K) + 1 < p.phase_hi) xcd_barrier(xb); } \
        if (TIMEPHASE == (K)) { const unsigned long long tp1_ = __builtin_amdgcn_s_memrealtime(); while (__builtin_amdgcn_s_memrealtime() - tp1_ < tp1_ - tp0_) __builtin_amdgcn_s_sleep(8); } } } while (0)
    RUN_PHASE(0, phase0(p, smem));
    if (p.phase_lo == 0 && p.phase_hi > 1) {
        if (threadIdx.x == 0) {
            unsigned* bar = (unsigned*)(p.ws + OFF_BAR); bool ok = (gridDim.x & 7u) == 0u && xb.x < 8u;
            for (unsigned j = 0; j < 16; ++j) { const unsigned c = xb_ld(&bar[XB_XCNT(j)]); ok = ok && (j < 8 ? c == gridDim.x / 8u : c == 0u); }
            if (ok) ((volatile int*)xb_words)[2] = (int)(((volatile unsigned*)xb_words)[3] * 8u + xb.x);
        }
        __syncthreads();
    }
    RUN_PHASE(1, phase1(p, smem_all));
#if DBG == 2
    dump_p1(p); return;
#endif
    RUN_PHASE(2, phase2(p, smem));
#if DBG == 5
    { const size_t N = (size_t)T_ * D_; for (size_t i = (size_t)blockIdx.x * 256 + threadIdx.x; i < N; i += (size_t)gridDim.x * 256) p.out[i] = flat_bf(p, OFF_KG2, N / 2, i % (N / 2)) + ((const float*)(p.ws + OFF_DEC))[i % (2048 * 128)]; } return;
#endif
#ifdef SCANPROBE
    phase3t(p, smem, 1); xcd_barrier(xb);
#endif
    RUN_PHASE(3, phase3t(p, smem, 0));
#if DBG == 6
    dump_bf16(p, OFF_OO, 2048, 1024); return;
#endif
#if DBG == 7
    { const bf16_t* src = (const bf16_t*)(p.ws + OFF_OO);
      for (int i = blockIdx.x * 256 + threadIdx.x; i < T_ * D_; i += gridDim.x * 256) { const int row = i >> 10, col = i & 1023; const float v = bf2f(src[(size_t)row * 2048 + 1024 + col]); p.out[i] = (fabsf(v) < 1e30f) ? v : 12345.0f; } } return;
#endif
    RUN_PHASE(4, phase4(p, smem));
#if DBG == 3
    dump_bf16(p, OFF_Y, 2048, 0); return;
#endif
#if DBG == 4
    dump_bf16(p, OFF_Y, 2048, 1024); return;
#endif
    RUN_PHASE(5, phase5(p, smem_all));
    RUN_PHASE(6, phase6(p, smem_all));
    RUN_PHASE(7, phase7(p, smem));
#if DBG == 1
    return;
#endif
    RUN_PHASE(8, phase8(p, smem_all));
    RUN_PHASE(10, phase10(p, smem_all));
    RUN_PHASE(11, phase11(p, smem_all));
    RUN_PHASE(12, phase12(p));
#ifdef BARPROBE
    _Pragma("unroll 1") for (int bp_ = 0; bp_ < 20; ++bp_) xcd_barrier(xb);
#endif
#undef RUN_PHASE
}

extern "C" void kernel_launch(void* const* d_in, const int* in_sizes, int n_in, void* d_out, int out_size, void* d_ws, size_t ws_size,
                              hipStream_t stream) {
    static int grid_blocks = 0;
    if (!grid_blocks) {
        int dev = 0, cus = 0, per_cu = 0;
        hipGetDevice(&dev);
        hipDeviceGetAttribute(&cus, hipDeviceAttributeMultiprocessorCount, dev);
        hipOccupancyMaxActiveBlocksPerMultiprocessor(&per_cu, fwd_megakernel, 512, 0);
        if (per_cu > 1) per_cu = 1;
        if (per_cu < 1) per_cu = 1;
        grid_blocks = cus * per_cu;
    }
    if (ws_size < WS_NEEDED) { fprintf(stderr, "workspace too small: %zu < %zu\n", ws_size, (size_t)WS_NEEDED); return; }
    Params p{};
    p.x = (const float*)d_in[0]; p.w_in = (const float*)d_in[1]; p.ret_norm_g = (const float*)d_in[2]; p.gate_w2 = (const float*)d_in[3];
    p.gate_b = (const float*)d_in[4]; p.gla_norm_g = (const float*)d_in[5]; p.w_ret_out = (const float*)d_in[6]; p.w_gla_out = (const float*)d_in[7];
    p.w_o = (const float*)d_in[8]; p.ln1_g = (const float*)d_in[9]; p.ln1_b = (const float*)d_in[10]; p.router_w = (const float*)d_in[11];
    p.router_bias = (const float*)d_in[12]; p.ew_gate = (const float*)d_in[13]; p.ew_up = (const float*)d_in[14]; p.ew_down = (const float*)d_in[15];
    p.sw_gate = (const float*)d_in[16]; p.sw_up = (const float*)d_in[17]; p.sw_down = (const float*)d_in[18]; p.ln2_g = (const float*)d_in[19];
    p.ln2_b = (const float*)d_in[20];
    p.out = (float*)d_out; p.ws = (unsigned char*)d_ws; p.phase_lo = 0; p.phase_hi = NPHASE;
    void* args[] = {&p};
    (void)hipMemsetAsync((unsigned char*)d_ws + OFF_BAR, 0, XCD_BAR_WORDS * 4, stream);
    hipError_t e = hipLaunchCooperativeKernel((void*)fwd_megakernel, dim3(grid_blocks), dim3(512), args, 0, stream);
    if (e != hipSuccess) fprintf(stderr, "cooperative launch failed: %s (grid %d)\n", hipGetErrorString(e), grid_blocks);
}
```

```cpp
#include <hip/hip_runtime.h>
#include <hip/hip_cooperative_groups.h>
#include <cstdio>
#include <cstdint>
namespace cg = cooperative_groups;

typedef unsigned short bf16_t;
typedef short bf16x8 __attribute__((ext_vector_type(8)));
typedef float f32x4 __attribute__((ext_vector_type(4)));
typedef unsigned u32x2 __attribute__((ext_vector_type(2)));
typedef unsigned u32x4 __attribute__((ext_vector_type(4)));
#define DEVI __device__ __forceinline__
#define VH ((int)(threadIdx.x >> 8))
#define VT ((int)(threadIdx.x & 255))
static __device__ __forceinline__ int vh_fresh() { int v = (int)(threadIdx.x >> 8); asm volatile("" : "+v"(v)); return v; }
#define RB (__builtin_amdgcn_readfirstlane(((const int*)(smem_all_g + 2 * SMEM_HALF - 16))[2]))
#define RG ((int)gridDim.x)
#define VB (RB * 2 + VH)
#define VG (RG * 2)

constexpr int T_ = 32768;
constexpr int D_ = 1024;
constexpr int DIN_ = 8208;
constexpr int NE_ = 256;
constexpr float ALPHA_ = 1.189207115002721f;
constexpr float KSCALE_ = 0.08838834764831845f;

constexpr size_t MB = 1ull << 20;
constexpr size_t OFF_CNT  = (size_t)766 << 20;
constexpr int CNT_STRIDE = 1024;
constexpr size_t OFF_CS   = 1 * MB;
constexpr size_t OFF_WT   = 3 * MB;
constexpr size_t FB = 27 * MB;
constexpr size_t OFF_QR   = FB + 0 * MB;
constexpr size_t OFF_KR   = FB + 32 * MB;
constexpr size_t OFF_VRT  = FB + 64 * MB;
constexpr size_t OFF_GS   = FB + 128 * MB;
constexpr size_t OFF_MG   = FB + 256 * MB;
constexpr size_t OFF_KRT  = FB + 384 * MB;
constexpr size_t OFF_QG   = FB + 416 * MB;
constexpr size_t OFF_VGT  = FB + 448 * MB;
constexpr size_t OFF_KGT  = FB + 512 * MB;
constexpr size_t OFF_GA   = FB + 544 * MB;
constexpr size_t OFF_XB   = FB + 546 * MB;
constexpr size_t OFF_KG2  = FB + 546 * MB;
constexpr size_t OFF_DEC  = FB + 578 * MB;
constexpr size_t OFF_OO   = FB + 579 * MB;
constexpr size_t OFF_Y    = FB + 384 * MB;
constexpr size_t OFF_MRG  = FB + 0 * MB;
constexpr size_t OFF_QGN  = 767 * MB;
constexpr size_t OFF_QFR  = 734 * MB;
constexpr size_t OFF_WGU  = 767 * MB;
constexpr size_t OFF_X1B  = FB + 0 * MB;
constexpr size_t OFF_WD   = FB + 64 * MB;
constexpr size_t OFF_LIST = FB + 193 * MB;
constexpr size_t OFF_WL   = FB + 193 * MB + 512 * MB;
constexpr size_t OFF_H    = FB + 227 * MB;
constexpr size_t OFF_YX   = FB + 371 * MB;
constexpr size_t OFF_T1   = FB + 371 * MB;
constexpr size_t WS_NEEDED = 1024 * MB;

constexpr int WT_BN = 0, WT_AT = 5888, WT_RET = 8960, WT_GLA = 9984, WT_O = 11008, WT_R = 12032, WT_ROWS = 12288;

struct Params {
    const float *x, *w_in, *ret_norm_g, *gate_w2, *gate_b, *gla_norm_g, *w_ret_out, *w_gla_out, *w_o, *ln1_g, *ln1_b,
                *router_w, *router_bias, *ew_gate, *ew_up, *ew_down, *sw_gate, *sw_up, *sw_down, *ln2_g, *ln2_b;
    float* out;
    unsigned char* ws;
    int phase_lo, phase_hi;
};

static __device__ const float c_inv_freq[64] = {
  1.000000000e+00f, 8.659643531e-01f, 7.498942018e-01f, 6.493816376e-01f,
  5.623413324e-01f, 4.869675338e-01f, 4.216965139e-01f, 3.651741147e-01f,
  3.162277639e-01f, 2.738419771e-01f, 2.371373773e-01f, 2.053525001e-01f,
  1.778279394e-01f, 1.539926529e-01f, 1.333521456e-01f, 1.154781953e-01f,
  1.000000015e-01f, 8.659642935e-02f, 7.498942316e-02f, 6.493816525e-02f,
  5.623413250e-02f, 4.869675264e-02f, 4.216964915e-02f, 3.651741147e-02f,
  3.162277490e-02f, 2.738419548e-02f, 2.371373773e-02f, 2.053525113e-02f,
  1.778279431e-02f, 1.539926510e-02f, 1.333521400e-02f, 1.154781971e-02f,
  9.999999776e-03f, 8.659643121e-03f, 7.498942316e-03f, 6.493816152e-03f,
  5.623413250e-03f, 4.869675264e-03f, 4.216964822e-03f, 3.651741194e-03f,
  3.162277630e-03f, 2.738419687e-03f, 2.371373819e-03f, 2.053525066e-03f,
  1.778279431e-03f, 1.539926510e-03f, 1.333521446e-03f, 1.154782018e-03f,
  1.000000047e-03f, 8.659643354e-04f, 7.498941850e-04f, 6.493816036e-04f,
  5.623413017e-04f, 4.869675322e-04f, 4.216965172e-04f, 3.651741135e-04f,
  3.162277571e-04f, 2.738419571e-04f, 2.371373703e-04f, 2.053525095e-04f,
  1.778279402e-04f, 1.539926598e-04f, 1.333521504e-04f, 1.154782003e-04f };

DEVI float bf2f(unsigned short u) { return __uint_as_float(((unsigned)u) << 16); }
DEVI float bflo(unsigned u) { return __uint_as_float(u << 16); }
DEVI float bfhi(unsigned u) { return __uint_as_float(u & 0xffff0000u); }
typedef float f32x2 __attribute__((ext_vector_type(2)));
typedef __bf16 bf16x2_t __attribute__((ext_vector_type(2)));
DEVI unsigned pk2(float lo, float hi) { const f32x2 v = {lo, hi}; const bf16x2_t b = __builtin_convertvector(v, bf16x2_t); return __builtin_bit_cast(unsigned, b); }
DEVI unsigned short f2bf(float f) { return (unsigned short)(pk2(f, 0.f) & 0xffffu); }
DEVI u32x2 pk4(f32x4 v) { u32x2 r; r.x = pk2(v[0], v[1]); r.y = pk2(v[2], v[3]); return r; }
DEVI f32x4 unpk4(u32x2 u) { f32x4 r; r[0] = bflo(u.x); r[1] = bfhi(u.x); r[2] = bflo(u.y); r[3] = bfhi(u.y); return r; }
constexpr float YX_SCALE = 16.0f;
DEVI unsigned pk4_fp8(f32x4 v) { int w = 0; w = __builtin_amdgcn_cvt_pk_fp8_f32(v[0], v[1], w, false); w = __builtin_amdgcn_cvt_pk_fp8_f32(v[2], v[3], w, true); return (unsigned)w; }
DEVI f32x4 unpk4_fp8(unsigned u) { f32x4 r; r[0] = __builtin_amdgcn_cvt_f32_fp8((int)u, 0); r[1] = __builtin_amdgcn_cvt_f32_fp8((int)u, 1); r[2] = __builtin_amdgcn_cvt_f32_fp8((int)u, 2); r[3] = __builtin_amdgcn_cvt_f32_fp8((int)u, 3); return r; }
DEVI f32x4 clamp4(f32x4 v, float lim) { f32x4 r; for (int i = 0; i < 4; ++i) r[i] = __builtin_amdgcn_fmed3f(v[i], -lim, lim); return r; }
DEVI float sigmoidf_(float v) { return __builtin_amdgcn_rcpf(1.0f + __builtin_amdgcn_exp2f(v * -1.4426950408889634f)); }
DEVI float siluf_(float v) { return v * __builtin_amdgcn_rcpf(1.0f + __builtin_amdgcn_exp2f(v * -1.4426950408889634f)); }
DEVI float gamma_log2(int h) { return log2f(1.0f - exp2f(-5.0f - (float)h)); }
DEVI f32x4 mfma16(bf16x8 a, bf16x8 b, f32x4 c) { return __builtin_amdgcn_mfma_f32_16x16x32_bf16(a, b, c, 0, 0, 0); }
DEVI unsigned kf_off(int item, int dk, int m8) { return ((((unsigned)item * 4u + (unsigned)(dk >> 5)) * 4u + (unsigned)(m8 >> 4)) * 64u + (unsigned)((m8 >> 3) & 1) * 32u + (unsigned)(dk & 31)) * 8u; }
DEVI unsigned vf_off(int item, int dv, int m8) { return ((((unsigned)item * 8u + (unsigned)(dv >> 5)) * 4u + (unsigned)(m8 >> 4)) * 64u + (unsigned)((m8 >> 3) & 1) * 32u + (unsigned)(dv & 31)) * 8u; }
DEVI unsigned qf_off(int bc, int h, int tokl, int dk8, int hh) {
    return ((((((unsigned)bc * 4u + (unsigned)h) * 2u + (unsigned)(tokl >> 5)) * 4u + (unsigned)(dk8 >> 5)) * 2u + (unsigned)((dk8 >> 4) & 1)) * 64u + (unsigned)hh * 32u + (unsigned)(tokl & 31)) * 8u + (unsigned)((dk8 >> 3) & 1) * 4u; }
DEVI int vperm(int n) { const int wc = n >> 6, nt = (n >> 4) & 3, i = n & 15; return wc * 64 + (nt >> 1) * 32 + 8 * (i >> 2) + 4 * (nt & 1) + (i & 3); }
DEVI int dperm2(int v) { return ((v >> 5) & 1) * 64 + (v >> 6) * 32 + (v & 31); }
DEVI u32x4 pk8(f32x4 a, f32x4 b) { u32x4 r; r.x = pk2(a[0], a[1]); r.y = pk2(a[2], a[3]); r.z = pk2(b[0], b[1]); r.w = pk2(b[2], b[3]); return r; }
DEVI void unpk8(u32x4 u, f32x4& a, f32x4& b) { a[0] = bflo(u.x); a[1] = bfhi(u.x); a[2] = bflo(u.y); a[3] = bfhi(u.y); b[0] = bflo(u.z); b[1] = bfhi(u.z); b[2] = bflo(u.w); b[3] = bfhi(u.w); }
DEVI int dperm(int v) { const int wc = v >> 6, nt = (v >> 4) & 3, c = v & 15; return (nt & 1) * 16 + wc * 32 + c + (nt >> 1) * 64; }

struct __attribute__((aligned(16))) GemmSmem { bf16_t a[2][128 * 64]; bf16_t b[2][128 * 64]; };
constexpr int SMEM_GEMM = sizeof(GemmSmem);
constexpr int SMEM_BYTES = SMEM_GEMM + 2048 + 16;
constexpr int SMEM_HALF = (SMEM_BYTES + 255) & ~255;
constexpr int SMEM_MOE = 16384;
__shared__ __attribute__((aligned(16))) unsigned char smem_all_g[2 * SMEM_HALF + SMEM_MOE];
DEVI int gemm_src_chunk(int t) { return ((t & 7) ^ ((t >> 4) & 7)) * 8; }

template <bool SWAP, int BKIND>
DEVI void gemm_kloop(f32x4 (&acc)[4][4], const bf16_t* const (&pa)[4], const bf16_t* const (&pb)[4],
                     const float* pbf, int ldb, int nk, GemmSmem& sm) {
    const int t = VT, lane = t & 63, w = t >> 6, wr = w >> 1, wc = w & 1, l15 = lane & 15, q = lane >> 4;
    const int kg = t & 7, ng = t >> 3;
    f32x4 rf[8];
#define GEMM_ISSUE(BUF, KO) do { \
        _Pragma("unroll") for (int i = 0; i < 4; ++i) \
            __builtin_amdgcn_global_load_lds((const unsigned*)(pa[i] + (KO)), (unsigned*)((char*)sm.a[BUF] + i * 4096 + t * 16), 16, 0, 0); \
        if (BKIND == 0) { _Pragma("unroll") for (int i = 0; i < 4; ++i) \
            __builtin_amdgcn_global_load_lds((const unsigned*)(pb[i] + (KO)), (unsigned*)((char*)sm.b[BUF] + i * 4096 + t * 16), 16, 0, 0); } \
        else { const float* pp = pbf + (size_t)((KO) + 4 * kg) * ldb; \
            _Pragma("unroll") for (int i = 0; i < 4; ++i) { rf[i] = *(const f32x4*)(pp + (size_t)i * ldb); rf[4 + i] = *(const f32x4*)(pp + (size_t)(32 + i) * ldb); } } } while (0)
#define GEMM_LSTORE_B(BUF) do { if (BKIND == 1) { \
            _Pragma("unroll") for (int i = 0; i < 4; ++i) { \
                u32x2 v0, v1; \
                v0.x = pk2(rf[0][i], rf[1][i]); v0.y = pk2(rf[2][i], rf[3][i]); v1.x = pk2(rf[4][i], rf[5][i]); v1.y = pk2(rf[6][i], rf[7][i]); \
                const int n = 4 * ng + i, sw = (n >> 1) & 7; \
                char* rowp = (char*)sm.b[BUF] + n * 128 + (kg & 1) * 8; \
                *(u32x2*)(rowp + (((kg >> 1) ^ sw) * 16)) = v0; *(u32x2*)(rowp + (((4 + (kg >> 1)) ^ sw) * 16)) = v1; } } } while (0)
    GEMM_ISSUE(0, 0);
    GEMM_LSTORE_B(0);
    __syncthreads();
#define GEMM_KSTEP(CUR, KT) do { \
        const bool more = ((KT) + 1 < nk); \
        if (more) { GEMM_ISSUE((CUR) ^ 1, ((KT) + 1) * 64); } \
        __builtin_amdgcn_sched_barrier(0); \
        _Pragma("unroll") for (int ss = 0; ss < 2; ++ss) { \
            bf16x8 af[4], bfr[4]; \
            const int coff = ((ss * 4 + q) ^ (l15 >> 1)) * 16; \
            _Pragma("unroll") for (int i = 0; i < 4; ++i) { \
                af[i]  = *(const bf16x8*)((const char*)sm.a[CUR] + (wr * 64 + i * 16 + l15) * 128 + coff); \
                bfr[i] = *(const bf16x8*)((const char*)sm.b[CUR] + (wc * 64 + i * 16 + l15) * 128 + coff); } \
            _Pragma("unroll") for (int mt = 0; mt < 4; ++mt) \
                _Pragma("unroll") for (int nt = 0; nt < 4; ++nt) \
                    acc[mt][nt] = SWAP ? mfma16(bfr[nt], af[mt], acc[mt][nt]) : mfma16(af[mt], bfr[nt], acc[mt][nt]); } \
        __builtin_amdgcn_sched_barrier(0); \
        if (more) { GEMM_LSTORE_B((CUR) ^ 1); } \
        __syncthreads(); } while (0)
#pragma unroll 1
    for (int kt = 0; kt < nk; kt += 2) { GEMM_KSTEP(0, kt); GEMM_KSTEP(1, kt + 1); }
#undef GEMM_KSTEP
#undef GEMM_LSTORE_B
#undef GEMM_ISSUE
}

DEVI void zero_acc(f32x4 (&acc)[4][4]) {
#pragma unroll
    for (int i = 0; i < 4; ++i)
#pragma unroll
        for (int j = 0; j < 4; ++j) acc[i][j] = (f32x4){0.f, 0.f, 0.f, 0.f};
}

namespace pg8 {
#define PG8_LAS __attribute__((address_space(3)))
typedef unsigned short bf16_t;
typedef short bf16x8 __attribute__((ext_vector_type(8)));
typedef float f32x4 __attribute__((ext_vector_type(4)));
typedef unsigned u32x4 __attribute__((ext_vector_type(4)));
constexpr int BM = 256, BK = 64, HALF = 128, HTB = HALF * BK * 2  , STAGE_BYTES = 8 * HTB, NXCD = 8, WGM = 8;

__host__ __device__ __forceinline__ int lds_byte(int r, int c) { const int st = (r >> 4) * 2 + (c >> 5), rr = r & 15, cc = c & 31, ob = rr * 64 + cc * 2; return st * 1024 + (ob ^ (((ob >> 9) & 1) << 5)); }
__host__ __device__ __forceinline__ void stage_rc(int b, int& R, int& C) { const int st = b / 1024, sb = b % 1024, swz = sb ^ (((sb >> 9) & 1) << 5); R = (st >> 1) * 16 + swz / 64; C = (st & 1) * 32 + (swz % 64) / 2; }
__host__ __device__ __forceinline__ int perm32(int rho) { const int n = rho >> 4, i = rho & 15; return 8 * (i >> 2) + 4 * n + (i & 3); }

struct Unit { int pm, pn, e, r0, ce; };
struct Gemm { const bf16_t* A; const bf16_t* Bt; int M, N, K; };

struct StaticOrder {
    int nM, nN, nwg, G, c;
    __host__ __device__ void init(int M, int N, int G_, int c_) { nM = M / BM; nN = N / BM; nwg = nM * nN; G = G_; c = c_; }
    __host__ __device__ bool next(int i, Unit& u) const {
        const long L = (long)i * G + c; if (L >= nwg) return false;
        int wgid = (int)L; { const int q = nwg / NXCD, r = nwg % NXCD, xcd = wgid % NXCD, off = wgid / NXCD; wgid = (xcd < r ? xcd * (q + 1) : r * (q + 1) + (xcd - r) * q) + off; }
        const int nig = WGM * nN, gid = wgid / nig, fm = gid * WGM, gsz = (nM - fm) < WGM ? (nM - fm) : WGM;
        u.pm = fm + ((wgid % nig) % gsz); u.pn = (wgid % nig) / gsz; return true;
    }
    __device__ __forceinline__ void a_ready(const Unit&) const {}
    __device__ __forceinline__ void done(const Unit&) const {}
};


template <class Epi, class Sched, bool ALIGN_EPI = false, bool SP2 = false>
__device__ __forceinline__ void gemm_phase(PG8_LAS unsigned char* lds, const Gemm g, const Sched& S, const Epi& E) {
    const int tid = threadIdx.x, wid = __builtin_amdgcn_readfirstlane(tid >> 6), lane = tid & 63, wr = wid >> 2, wc = wid & 3, fr = lane & 15, fq = lane >> 4;
    const int K = g.K, nt = K / BK;
    unsigned voffA[2], voffB[2];
#pragma unroll
    for (int i = 0; i < 2; ++i) { int R, C; stage_rc(tid * 16 + i * 8192, R, C); const int Rb = Epi::PERM ? ((R & ~31) + perm32(R & 31)) : R;
        voffA[i] = (unsigned)(R * K + C) * 2u; voffB[i] = (unsigned)(Rb * K + C) * 2u; }
    const size_t kstep = (size_t)(BK * 2);
    const size_t hstep = (size_t)HALF * K * 2;
    const size_t tstep = 2 * hstep;
    const unsigned ldsw = (unsigned)wid * 1024u;
    const int aoff = lds_byte(wr * 64 + fr, fq * 8), boff = lds_byte(wc * 32 + fr, fq * 8);
#define PG8_SA(b, h) (((b) * 2 + (h)) * HTB)
#define PG8_SB(b, h) ((4 + (b) * 2 + (h)) * HTB)
#define PG8_STAGE(bufoff, gbase, voff) do { _Pragma("unroll") for (int _i = 0; _i < 2; ++_i) \
        __builtin_amdgcn_global_load_lds((const unsigned*)((const char*)(gbase) + (voff)[_i]), (PG8_LAS unsigned*)(lds + (bufoff) + ldsw + _i * 8192), 16, 0, 0); } while (0)
#define PG8_LDA(dst, b, h) do { _Pragma("unroll") for (int m = 0; m < 4; ++m) _Pragma("unroll") for (int k = 0; k < 2; ++k) dst[m][k] = *(const PG8_LAS bf16x8*)(lds + PG8_SA(b, h) + aoff + m * 2048 + k * 1024); } while (0)
#define PG8_LDB(dst, b, h) do { _Pragma("unroll") for (int n = 0; n < 2; ++n) _Pragma("unroll") for (int k = 0; k < 2; ++k) dst[n][k] = *(const PG8_LAS bf16x8*)(lds + PG8_SB(b, h) + boff + n * 2048 + k * 1024); } while (0)
#define PG8_MMA(ai, bj, At, Bt) do { __builtin_amdgcn_s_setprio(1); _Pragma("unroll") for (int m = 0; m < 4; ++m) _Pragma("unroll") for (int n = 0; n < 2; ++n) _Pragma("unroll") for (int k = 0; k < 2; ++k) \
        acc[ai][bj][m][n] = __builtin_amdgcn_mfma_f32_16x16x32_bf16(Bt[n][k], At[m][k], acc[ai][bj][m][n], 0, 0, 0); __builtin_amdgcn_s_setprio(0); } while (0)
#define PG8_WAIT_V(n) asm volatile("s_waitcnt vmcnt(" #n ")" ::: "memory")
#define PG8_WAIT_L(n) asm volatile("s_waitcnt lgkmcnt(" #n ")" ::: "memory")
#define PG8_BAR __builtin_amdgcn_s_barrier()
#define PG8_SCHED __builtin_amdgcn_sched_barrier(0)
    Unit cur, nxt; int ui = 0;
    if (!S.next(0, cur)) return;
    f32x4 acc[2][2][4][2];
#pragma unroll
    for (int a = 0; a < 2; ++a)
#pragma unroll
        for (int b = 0; b < 2; ++b)
#pragma unroll
            for (int m = 0; m < 4; ++m)
#pragma unroll
                for (int n = 0; n < 2; ++n) acc[a][b][m][n] = (f32x4){0.f, 0.f, 0.f, 0.f};
    bf16x8 At[4][2], B0[2][2], B1[2][2];
    const char* cA = (const char*)g.A + (size_t)cur.pm * tstep; const char* cB = (const char*)g.Bt + (size_t)cur.pn * tstep;
    S.a_ready(cur);
    if constexpr (SP2) {
        PG8_STAGE(PG8_SB(0, 0), cB, voffB); PG8_STAGE(PG8_SB(0, 1), cB + hstep, voffB); PG8_STAGE(PG8_SA(0, 0), cA, voffA); PG8_STAGE(PG8_SA(0, 1), cA + hstep, voffA);
        if (wr == 1) PG8_BAR;
        PG8_WAIT_V(2); PG8_BAR;
        PG8_STAGE(PG8_SB(1, 0), cB + kstep, voffB); PG8_STAGE(PG8_SA(1, 0), cA + kstep, voffA); PG8_STAGE(PG8_SB(1, 1), cB + hstep + kstep, voffB);
        PG8_WAIT_V(6); PG8_BAR;
    } else {
        PG8_STAGE(PG8_SB(0, 0), cB, voffB); PG8_STAGE(PG8_SA(0, 0), cA, voffA); PG8_STAGE(PG8_SB(0, 1), cB + hstep, voffB); PG8_STAGE(PG8_SA(0, 1), cA + hstep, voffA);
        if (wr == 1) PG8_BAR;
        PG8_WAIT_V(4); PG8_BAR;
        PG8_STAGE(PG8_SB(1, 0), cB + kstep, voffB); PG8_STAGE(PG8_SA(1, 0), cA + kstep, voffA); PG8_STAGE(PG8_SB(1, 1), cB + hstep + kstep, voffB);
        PG8_WAIT_V(6); PG8_BAR;
    }
    for (;;) {
        const bool has_next = S.next(ui + 1, nxt);
        const char* nA = has_next ? (const char*)g.A + (size_t)nxt.pm * tstep : cA; const char* nB = has_next ? (const char*)g.Bt + (size_t)nxt.pn * tstep : cB;
        for (int t = 0; t < nt; t += 2) {
            const bool last = (t == nt - 2);
            const char* a1 = cA + (size_t)(t + 1) * kstep;
            const char* a2 = last ? nA : cA + (size_t)(t + 2) * kstep; const char* b2 = last ? nB : cB + (size_t)(t + 2) * kstep;
            const char* a3 = a2 + kstep; const char* b3 = b2 + kstep;
            if (last && has_next) S.a_ready(nxt);
            if constexpr (SP2) {
            PG8_LDB(B0, 0, 0); PG8_LDB(B1, 0, 1); PG8_SCHED; PG8_LDA(At, 0, 0); PG8_STAGE(PG8_SA(1, 1), a1 + hstep, voffA);
            PG8_WAIT_V(8); PG8_WAIT_L(0); PG8_BAR; PG8_MMA(0, 0, At, B0); PG8_MMA(0, 1, At, B1); PG8_BAR; PG8_SCHED;
            PG8_LDA(At, 0, 1); PG8_STAGE(PG8_SB(0, 0), b2, voffB); PG8_STAGE(PG8_SB(0, 1), b2 + hstep, voffB); PG8_STAGE(PG8_SA(0, 0), a2, voffA);
            PG8_WAIT_V(8); PG8_WAIT_L(0); PG8_BAR; PG8_MMA(1, 0, At, B0); PG8_MMA(1, 1, At, B1); PG8_BAR; PG8_SCHED;
            PG8_LDB(B0, 1, 0); PG8_LDB(B1, 1, 1); PG8_SCHED; PG8_LDA(At, 1, 0); PG8_STAGE(PG8_SA(0, 1), a2 + hstep, voffA);
            PG8_WAIT_V(8); PG8_WAIT_L(0); PG8_BAR; PG8_MMA(0, 0, At, B0); PG8_MMA(0, 1, At, B1); PG8_BAR; PG8_SCHED;
            PG8_LDA(At, 1, 1); PG8_STAGE(PG8_SB(1, 0), b3, voffB); PG8_STAGE(PG8_SB(1, 1), b3 + hstep, voffB); PG8_STAGE(PG8_SA(1, 0), a3, voffA);
            PG8_WAIT_V(8); PG8_WAIT_L(0); PG8_BAR; PG8_MMA(1, 0, At, B0); PG8_MMA(1, 1, At, B1); PG8_BAR; PG8_SCHED;
            } else {
            PG8_LDB(B0, 0, 0); PG8_SCHED; PG8_LDA(At, 0, 0); PG8_STAGE(PG8_SA(1, 1), a1 + hstep, voffA);
            PG8_WAIT_L(8); PG8_BAR; PG8_WAIT_L(0); PG8_MMA(0, 0, At, B0); PG8_BAR; PG8_SCHED;
            PG8_LDB(B1, 0, 1); PG8_STAGE(PG8_SB(0, 0), b2, voffB);
            PG8_BAR; PG8_WAIT_L(0); PG8_MMA(0, 1, At, B1); PG8_BAR;
            PG8_LDA(At, 0, 1); PG8_STAGE(PG8_SA(0, 0), a2, voffA);
            PG8_BAR; PG8_WAIT_L(0); PG8_MMA(1, 0, At, B0); PG8_BAR; PG8_SCHED;
            PG8_STAGE(PG8_SB(0, 1), b2 + hstep, voffB);
            PG8_WAIT_V(6); PG8_BAR; PG8_MMA(1, 1, At, B1); PG8_BAR;
            PG8_LDB(B0, 1, 0); PG8_SCHED; PG8_LDA(At, 1, 0); PG8_STAGE(PG8_SA(0, 1), a2 + hstep, voffA);
            PG8_WAIT_L(8); PG8_BAR; PG8_WAIT_L(0); PG8_MMA(0, 0, At, B0); PG8_BAR; PG8_SCHED;
            PG8_LDB(B1, 1, 1); PG8_STAGE(PG8_SB(1, 0), b3, voffB);
            PG8_BAR; PG8_WAIT_L(0); PG8_MMA(0, 1, At, B1); PG8_BAR;
            PG8_LDA(At, 1, 1); PG8_STAGE(PG8_SA(1, 0), a3, voffA);
            PG8_BAR; PG8_WAIT_L(0); PG8_MMA(1, 0, At, B0); PG8_BAR; PG8_SCHED;
            PG8_STAGE(PG8_SB(1, 1), b3 + hstep, voffB);
            PG8_WAIT_V(6); PG8_BAR; PG8_MMA(1, 1, At, B1); PG8_BAR;
            }
        }
        if constexpr (ALIGN_EPI) { if (wr == 0) PG8_BAR; }
        if constexpr (!Epi::AFTER_DRAIN) { E(acc, cur, wr, wc, fr, fq); S.done(cur); }
        if (!has_next) break;
#pragma unroll
        for (int a = 0; a < 2; ++a)
#pragma unroll
            for (int b = 0; b < 2; ++b)
#pragma unroll
                for (int m = 0; m < 4; ++m)
#pragma unroll
                    for (int n = 0; n < 2; ++n) acc[a][b][m][n] = (f32x4){0.f, 0.f, 0.f, 0.f};
        cur = nxt; cA = nA; cB = nB; ++ui;
        if constexpr (ALIGN_EPI) { if (wr == 1) PG8_BAR; }
    }
    PG8_WAIT_V(0);
    if constexpr (!ALIGN_EPI) { if (wr == 0) PG8_BAR; }
    PG8_BAR;
    if constexpr (Epi::AFTER_DRAIN) { E.fused(acc, cur, wr, wc, fr, fq, lds, wid, lane); S.done(cur); }
#undef PG8_SA
#undef PG8_SB
#undef PG8_STAGE
#undef PG8_LDA
#undef PG8_LDB
#undef PG8_MMA
#undef PG8_WAIT_V
#undef PG8_WAIT_L
#undef PG8_BAR
#undef PG8_SCHED
}
template <class Epi, class Sched, bool ALIGN_EPI = false, bool SP2 = false>
__device__ __forceinline__ void gemm_phase_g(PG8_LAS unsigned char* lds, const int K, const Sched& S, const Epi& E) {
    const int tid = threadIdx.x, wid = __builtin_amdgcn_readfirstlane(tid >> 6), lane = tid & 63, wr = wid >> 2, wc = wid & 3, fr = lane & 15, fq = lane >> 4;
    const int nt = K / BK;
    unsigned voffB[2]; int rowA[2], colA[2];
#pragma unroll
    for (int i = 0; i < 2; ++i) { int R, C; stage_rc(tid * 16 + i * 8192, R, C); const int lc = perm32(R & 31);
        const int Rb = Epi::BJI ? (64 * (R >> 5) + 16 * (lc >> 3) + (lc & 7)) : (Epi::PERM ? ((R & ~31) + lc) : R);
        rowA[i] = R; colA[i] = C * 2; voffB[i] = (unsigned)(Rb * K + C) * 2u; }
    const size_t kstep = (size_t)(BK * 2);
    const size_t hstep = Epi::BJI ? (size_t)8 * K * 2 : (size_t)HALF * K * 2;
    const size_t tstep = 2 * hstep;
    const unsigned ldsw = (unsigned)wid * 1024u;
    const int aoff = lds_byte(wr * 64 + fr, fq * 8), boff = lds_byte(wc * 32 + fr, fq * 8);
#define PG8_SA(b, h) (((b) * 2 + (h)) * HTB)
#define PG8_SB(b, h) ((4 + (b) * 2 + (h)) * HTB)
#define PG8_STAGE(bufoff, gbase, voff) do { _Pragma("unroll") for (int _i = 0; _i < 2; ++_i) \
        __builtin_amdgcn_global_load_lds((const unsigned*)((const char*)(gbase) + (voff)[_i]), (PG8_LAS unsigned*)(lds + (bufoff) + ldsw + _i * 8192), 16, 0, 0); } while (0)
#define PG8_STAGEA(bufoff, P0, P1, koff) do { \
        __builtin_amdgcn_global_load_lds((const unsigned*)(Ab + (size_t)(P0) + (koff)), (PG8_LAS unsigned*)(lds + (bufoff) + ldsw), 16, 0, 0); \
        __builtin_amdgcn_global_load_lds((const unsigned*)(Ab + (size_t)(P1) + (koff)), (PG8_LAS unsigned*)(lds + (bufoff) + ldsw + 8192), 16, 0, 0); } while (0)
#define PG8_LDA(dst, b, h) do { _Pragma("unroll") for (int m = 0; m < 4; ++m) _Pragma("unroll") for (int k = 0; k < 2; ++k) dst[m][k] = *(const PG8_LAS bf16x8*)(lds + PG8_SA(b, h) + aoff + m * 2048 + k * 1024); } while (0)
#define PG8_LDB(dst, b, h) do { _Pragma("unroll") for (int n = 0; n < 2; ++n) _Pragma("unroll") for (int k = 0; k < 2; ++k) dst[n][k] = *(const PG8_LAS bf16x8*)(lds + PG8_SB(b, h) + boff + n * 2048 + k * 1024); } while (0)
#define PG8_MMA(ai, bj, At, Bt) do { __builtin_amdgcn_s_setprio(1); _Pragma("unroll") for (int m = 0; m < 4; ++m) _Pragma("unroll") for (int n = 0; n < 2; ++n) _Pragma("unroll") for (int k = 0; k < 2; ++k) \
        acc[ai][bj][m][n] = __builtin_amdgcn_mfma_f32_16x16x32_bf16(Bt[n][k], At[m][k], acc[ai][bj][m][n], 0, 0, 0); __builtin_amdgcn_s_setprio(0); } while (0)
#define PG8_WAIT_V(n) asm volatile("s_waitcnt vmcnt(" #n ")" ::: "memory")
#define PG8_WAIT_L(n) asm volatile("s_waitcnt lgkmcnt(" #n ")" ::: "memory")
#define PG8_BAR __builtin_amdgcn_s_barrier()
#define PG8_SCHED __builtin_amdgcn_sched_barrier(0)
    Unit cur, nxt, un2; int ui = 0, sb_cur = 0;
    if (!S.next(0, cur)) return;
    int fillv = S.fill_issue(cur); S.fill_write(0, fillv);
    __syncthreads();
    bool has_next = S.next(1, nxt);
    fillv = 0; if (has_next) fillv = S.fill_issue(nxt);
    f32x4 acc[2][2][4][2];
#pragma unroll
    for (int a = 0; a < 2; ++a)
#pragma unroll
        for (int b = 0; b < 2; ++b)
#pragma unroll
            for (int m = 0; m < 4; ++m)
#pragma unroll
                for (int n = 0; n < 2; ++n) acc[a][b][m][n] = (f32x4){0.f, 0.f, 0.f, 0.f};
    bf16x8 At[4][2], B0[2][2], B1[2][2];
    const char* cB = S.b_base(cur);
    unsigned cA00, cA01, cA10, cA11, nA00, nA01, nA10, nA11;
    const char* const Ab = S.a_base();
    S.a_rows(0, rowA, colA, cA00, cA01, cA10, cA11);
    S.a_ready(cur);
    if constexpr (SP2) {
        PG8_STAGE(PG8_SB(0, 0), cB, voffB); PG8_STAGE(PG8_SB(0, 1), cB + hstep, voffB); PG8_STAGEA(PG8_SA(0, 0), cA00, cA01, 0); PG8_STAGEA(PG8_SA(0, 1), cA10, cA11, 0);
        if (wr == 1) PG8_BAR;
        PG8_WAIT_V(2); PG8_BAR;
        PG8_STAGE(PG8_SB(1, 0), cB + kstep, voffB); PG8_STAGEA(PG8_SA(1, 0), cA00, cA01, kstep); PG8_STAGE(PG8_SB(1, 1), cB + hstep + kstep, voffB);
        PG8_WAIT_V(6); PG8_BAR;
    } else {
        PG8_STAGE(PG8_SB(0, 0), cB, voffB); PG8_STAGEA(PG8_SA(0, 0), cA00, cA01, 0); PG8_STAGE(PG8_SB(0, 1), cB + hstep, voffB); PG8_STAGEA(PG8_SA(0, 1), cA10, cA11, 0);
        if (wr == 1) PG8_BAR;
        PG8_WAIT_V(4); PG8_BAR;
        PG8_STAGE(PG8_SB(1, 0), cB + kstep, voffB); PG8_STAGEA(PG8_SA(1, 0), cA00, cA01, kstep); PG8_STAGE(PG8_SB(1, 1), cB + hstep + kstep, voffB);
        PG8_WAIT_V(6); PG8_BAR;
    }
    for (;;) {
        const char* nB = has_next ? S.b_base(nxt) : cB;
        const int sb_n = sb_cur == 2 ? 0 : sb_cur + 1;
        bool has2 = false;
        if (has_next) { S.fill_write(sb_n, fillv); has2 = S.next(ui + 2, un2); if (has2) fillv = S.fill_issue(un2); }
        nA00 = cA00; nA01 = cA01; nA10 = cA10; nA11 = cA11;
#pragma unroll 1
        for (int t = 0; t < nt; t += 2) {
            const bool last = (t == nt - 2);
            const size_t k1 = (size_t)(t + 1) * kstep;
            const size_t k2 = last ? 0 : (size_t)(t + 2) * kstep; const char* b2 = last ? nB : cB + (size_t)(t + 2) * kstep;
            const unsigned q00 = last ? nA00 : cA00, q01 = last ? nA01 : cA01, q10 = last ? nA10 : cA10, q11 = last ? nA11 : cA11;
            const size_t k3 = k2 + kstep; const char* b3 = b2 + kstep;
            if (last && has_next) S.a_ready(nxt);
            if constexpr (SP2) {
            PG8_LDB(B0, 0, 0); PG8_LDB(B1, 0, 1); PG8_SCHED; PG8_LDA(At, 0, 0); PG8_STAGEA(PG8_SA(1, 1), cA10, cA11, k1);
            PG8_WAIT_V(8); PG8_WAIT_L(0); PG8_BAR; PG8_MMA(0, 0, At, B0); PG8_MMA(0, 1, At, B1); PG8_BAR; PG8_SCHED;
            PG8_LDA(At, 0, 1); PG8_STAGE(PG8_SB(0, 0), b2, voffB); PG8_STAGE(PG8_SB(0, 1), b2 + hstep, voffB); PG8_STAGEA(PG8_SA(0, 0), q00, q01, k2);
            PG8_WAIT_V(8); PG8_WAIT_L(0); PG8_BAR; PG8_MMA(1, 0, At, B0); PG8_MMA(1, 1, At, B1); PG8_BAR; PG8_SCHED;
            PG8_LDB(B0, 1, 0); PG8_LDB(B1, 1, 1); PG8_SCHED; PG8_LDA(At, 1, 0); PG8_STAGEA(PG8_SA(0, 1), q10, q11, k2);
            PG8_WAIT_V(8); PG8_WAIT_L(0); PG8_BAR; PG8_MMA(0, 0, At, B0); PG8_MMA(0, 1, At, B1); PG8_BAR; PG8_SCHED;
            PG8_LDA(At, 1, 1); PG8_STAGE(PG8_SB(1, 0), b3, voffB); PG8_STAGE(PG8_SB(1, 1), b3 + hstep, voffB); PG8_STAGEA(PG8_SA(1, 0), q00, q01, k3);
            PG8_WAIT_V(8); PG8_WAIT_L(0); PG8_BAR; PG8_MMA(1, 0, At, B0); PG8_MMA(1, 1, At, B1); PG8_BAR; PG8_SCHED;
            } else {
            PG8_LDB(B0, 0, 0); PG8_SCHED; PG8_LDA(At, 0, 0); PG8_STAGEA(PG8_SA(1, 1), cA10, cA11, k1);
            PG8_WAIT_L(8); PG8_BAR; PG8_WAIT_L(0); PG8_MMA(0, 0, At, B0); PG8_BAR; PG8_SCHED;
            PG8_LDB(B1, 0, 1); PG8_STAGE(PG8_SB(0, 0), b2, voffB);
            PG8_BAR; PG8_WAIT_L(0); PG8_MMA(0, 1, At, B1); PG8_BAR;
            PG8_LDA(At, 0, 1); PG8_STAGEA(PG8_SA(0, 0), q00, q01, k2);
            PG8_BAR; PG8_WAIT_L(0); PG8_MMA(1, 0, At, B0); PG8_BAR; PG8_SCHED;
            PG8_STAGE(PG8_SB(0, 1), b2 + hstep, voffB);
            PG8_WAIT_V(6); PG8_BAR; PG8_MMA(1, 1, At, B1); PG8_BAR;
            PG8_LDB(B0, 1, 0); PG8_SCHED; PG8_LDA(At, 1, 0); PG8_STAGEA(PG8_SA(0, 1), q10, q11, k2);
            PG8_WAIT_L(8); PG8_BAR; PG8_WAIT_L(0); PG8_MMA(0, 0, At, B0); PG8_BAR; PG8_SCHED;
            PG8_LDB(B1, 1, 1); PG8_STAGE(PG8_SB(1, 0), b3, voffB);
            PG8_BAR; PG8_WAIT_L(0); PG8_MMA(0, 1, At, B1); PG8_BAR;
            PG8_LDA(At, 1, 1); PG8_STAGEA(PG8_SA(1, 0), q00, q01, k3);
            PG8_BAR; PG8_WAIT_L(0); PG8_MMA(1, 0, At, B0); PG8_BAR; PG8_SCHED;
            PG8_STAGE(PG8_SB(1, 1), b3 + hstep, voffB);
            PG8_WAIT_V(6); PG8_BAR; PG8_MMA(1, 1, At, B1); PG8_BAR;
            }
            if (t == nt - 4 && has_next) S.a_rows(sb_n, rowA, colA, nA00, nA01, nA10, nA11);
        }
        if constexpr (ALIGN_EPI) { if (wr == 0) PG8_BAR; }
        if constexpr (!Epi::AFTER_DRAIN) { E(acc, cur, wr, wc, fr, fq, sb_cur); S.done(cur); }
        if (!has_next) break;
#pragma unroll
        for (int a = 0; a < 2; ++a)
#pragma unroll
            for (int b = 0; b < 2; ++b)
#pragma unroll
                for (int m = 0; m < 4; ++m)
#pragma unroll
                    for (int n = 0; n < 2; ++n) acc[a][b][m][n] = (f32x4){0.f, 0.f, 0.f, 0.f};
        cur = nxt; nxt = un2; has_next = has2; cA00 = nA00; cA01 = nA01; cA10 = nA10; cA11 = nA11; cB = nB; ++ui; sb_cur = sb_n;
        if constexpr (ALIGN_EPI) { if (wr == 1) PG8_BAR; }
    }
    PG8_WAIT_V(0);
    if constexpr (!ALIGN_EPI) { if (wr == 0) PG8_BAR; }
    PG8_BAR;
    if constexpr (Epi::AFTER_DRAIN) { E.fused(acc, cur, wr, wc, fr, fq, lds, wid, lane); S.done(cur); }
#undef PG8_SA
#undef PG8_SB
#undef PG8_STAGE
#undef PG8_STAGEA
#undef PG8_LDA
#undef PG8_LDB
#undef PG8_MMA
#undef PG8_WAIT_V
#undef PG8_WAIT_L
#undef PG8_BAR
#undef PG8_SCHED
}
}

DEVI void wt_colinfo(const Params& p, int R, const float*& src, int& ld, float& scale) {
    scale = 1.0f; src = nullptr; ld = 0;
    if (R < WT_AT) {
        const int pn = R >> 8, cl = R & 255; ld = DIN_; int col = -1;
        if (pn < 4) { const int wcq = (cl >> 5) & 3; col = (pn >> 1) * 512 + (2 * (pn & 1) + (wcq >> 1)) * 128 + 64 * (cl >> 7) + 32 * (wcq & 1) + (cl & 31);
                      if (pn >= 2) scale = KSCALE_; }
        else if (pn < 8)  col = 2048 + (pn - 4) * 256 + cl;
        else if (pn < 10) { col = 3072 + (pn - 8) * 256 + cl; scale = KSCALE_; }
        else if (pn < 14) col = 5120 + (pn - 10) * 256 + cl;
        else if (pn < 22) col = 6160 + (pn - 14) * 256 + cl;
        else if (cl < 16) col = 6144 + cl;
        if (col >= 0) src = p.w_in + col;
    } else if (R < WT_RET) {
        const int Rr = R - WT_AT, pm = Rr >> 8, rl = Rr & 255; ld = DIN_; int col;
        if (pm < 2) { col = 512 + (2 * pm + ((rl >> 6) & 1)) * 128 + 64 * (rl >> 7) + (rl & 63); scale = KSCALE_; }
        else if (pm < 6)  col = 1024 + (pm - 2) * 256 + rl;
        else if (pm < 10) col = 4096 + (pm - 6) * 256 + rl;
        else              col = 3584 + (pm - 10) * 256 + rl;
        src = p.w_in + col;
    } else {
        int Rr, ldd; const float* base;
        if (R < WT_GLA)    { Rr = R - WT_RET; base = p.w_ret_out; ldd = 1024; }
        else if (R < WT_O) { Rr = R - WT_GLA; base = p.w_gla_out; ldd = 1024; }
        else if (R < WT_R) { Rr = R - WT_O;   base = p.w_o;       ldd = 1024; }
        else               { Rr = R - WT_R;   base = p.router_w;  ldd = 256; }
        src = base + ((R >= WT_R) ? ((Rr & ~127) + vperm(Rr & 127)) : Rr); ld = ldd;
    }
}

DEVI void phase0(const Params& p, unsigned char* smem) {
    const int tid = VT, nb = VG, bid = VB;
    float2* cs = (float2*)(p.ws + OFF_CS);
    for (int i = bid * 256 + tid; i < 4096 * 64; i += nb * 256) {
        const int pos = i >> 6, k = i & 63;
        const float angf = (float)pos * c_inv_freq[k];
        const double a = (double)angf;
        const double TWO_PI = 6.283185307179586476925286766559, HALF_PI = 1.5707963267948966192313216916398;
        const double kk = rint(a * (1.0 / TWO_PI));
        const double r = a - kk * TWO_PI;
        const double qd = rint(r * (1.0 / HALF_PI));
        const double y = r - qd * HALF_PI;
        const double y2 = y * y;
        double sn = y * (1.0 + y2 * (-1.0 / 6 + y2 * (1.0 / 120 + y2 * (-1.0 / 5040 + y2 * (1.0 / 362880 + y2 * (-1.0 / 39916800 + y2 * (1.0 / 6227020800.0)))))));
        double cn = 1.0 + y2 * (-0.5 + y2 * (1.0 / 24 + y2 * (-1.0 / 720 + y2 * (1.0 / 40320 + y2 * (-1.0 / 3628800 + y2 * (1.0 / 479001600.0))))));
        const int qi = ((int)qd) & 3;
        double s, c;
        if (qi == 0) { s = sn; c = cn; } else if (qi == 1) { s = cn; c = -sn; } else if (qi == 2) { s = -sn; c = -cn; } else { s = -cn; c = sn; }
        cs[i] = make_float2((float)c, (float)s);
    }
    if (bid == 0) { int* cnt = (int*)(p.ws + OFF_CNT); cnt[tid * CNT_STRIDE] = 0; }
    {
        u32x4* bfr = (u32x4*)smem;
        for (int idx = tid; idx < 32 * 64; idx += 256) {
            const int sst = idx >> 6, l = idx & 63;
            const float* wp = p.w_in + (size_t)(128 * (sst >> 2) + 32 * (l >> 4) + 8 * (sst & 3)) * DIN_ + 6144 + (l & 15);
            float w8[8];
#pragma unroll
            for (int j = 0; j < 8; ++j) w8[j] = wp[(size_t)j * DIN_];
            u32x4 o; o.x = pk2(w8[0], w8[1]); o.y = pk2(w8[2], w8[3]); o.z = pk2(w8[4], w8[5]); o.w = pk2(w8[6], w8[7]);
            bfr[idx] = o;
        }
        __syncthreads();
        const int lane = tid & 63, row = lane & 15, kg = lane >> 4;
        float* Ga = (float*)(p.ws + OFF_GA);
        for (int rb = bid * 4 + (tid >> 6); rb < T_ / 16; rb += nb * 4) {
            const float* xr = p.x + (size_t)(rb * 16 + row) * 1024 + 32 * kg;
            bf16_t* xo = (bf16_t*)(p.ws + OFF_XB) + (size_t)(rb * 16 + row) * 1024 + 32 * kg;
            f32x4 acc = (f32x4){0.f, 0.f, 0.f, 0.f};
#pragma unroll 1
            for (int q0 = 0; q0 < 8; q0 += 2) {
                f32x4 v[2][8];
#pragma unroll
                for (int u = 0; u < 2; ++u)
#pragma unroll
                    for (int j = 0; j < 8; ++j) v[u][j] = *(const f32x4*)(xr + 128 * (q0 + u) + 4 * j);
#pragma unroll
                for (int u = 0; u < 2; ++u)
#pragma unroll
                    for (int m = 0; m < 4; ++m) {
                        u32x4 o; o.x = pk2(v[u][2 * m][0], v[u][2 * m][1]); o.y = pk2(v[u][2 * m][2], v[u][2 * m][3]); o.z = pk2(v[u][2 * m + 1][0], v[u][2 * m + 1][1]); o.w = pk2(v[u][2 * m + 1][2], v[u][2 * m + 1][3]);
                        *(u32x4*)(xo + 128 * (q0 + u) + 8 * m) = o;
                        acc = mfma16(__builtin_bit_cast(bf16x8, o), __builtin_bit_cast(bf16x8, bfr[((q0 + u) * 4 + m) * 64 + lane]), acc);
                    }
            }
#pragma unroll
            for (int r = 0; r < 4; ++r) Ga[(size_t)(rb * 16 + 4 * kg + r) * 16 + row] = acc[r];
        }
        __syncthreads();
    }
    {
        float* tile = (float*)smem;
        bf16_t* wt = (bf16_t*)(p.ws + OFF_WT);
        const int ntask = (WT_ROWS / 64) * 16;
        for (int task = bid; task < ntask; task += nb) {
            const int rt = task >> 4, kt = task & 15, R0 = rt * 64, k0 = kt * 64;
            {
                const int n = tid & 63, kq = tid >> 6;
                const float* src; int ld; float sc; wt_colinfo(p, R0 + n, src, ld, sc);
#pragma unroll
                for (int i = 0; i < 16; ++i) { const int k = kq + 4 * i; tile[k * 65 + n] = src ? src[(size_t)(k0 + k) * ld] * sc : 0.f; }
            }
            __syncthreads();
            {
                const int n = tid >> 2, ks = (tid & 3) * 16;
                unsigned o[8];
#pragma unroll
                for (int j = 0; j < 8; ++j) o[j] = pk2(tile[(ks + 2 * j) * 65 + n], tile[(ks + 2 * j + 1) * 65 + n]);
                u32x4* dst = (u32x4*)(wt + (size_t)(R0 + n) * 1024 + k0 + ks);
                dst[0] = (u32x4){o[0], o[1], o[2], o[3]}; dst[1] = (u32x4){o[4], o[5], o[6], o[7]};
            }
            __syncthreads();
        }
    }
}

struct EpiP1N {
    static constexpr bool PERM = true, AFTER_DRAIN = false;
    unsigned char* ws;
    __device__ __forceinline__ void operator()(const pg8::f32x4 (&acc)[2][2][4][2], const pg8::Unit& u, int wr, int wc, int fr, int fq) const {
        const int pn = u.pn, row0 = u.pm * 256 + wr * 64 + fr, c8 = wc * 32 + 8 * fq;
        if (pn < 4) {
            const float2* cs = (const float2*)(ws + OFF_CS); bf16_t* Qr = (bf16_t*)(ws + (pn < 2 ? OFF_QR : OFF_KR));
            const int head = 2 * (pn & 1) + (wc >> 1), d0 = 32 * (wc & 1) + 8 * fq;
#pragma unroll
            for (int ai = 0; ai < 2; ++ai)
#pragma unroll
                for (int m = 0; m < 4; ++m) {
                    const size_t row = row0 + ai * 128 + m * 16; const int pos = (int)(row & 4095);
                    f32x4 c4[4];
#pragma unroll
                    for (int j = 0; j < 4; ++j) c4[j] = *(const f32x4*)(cs + pos * 64 + d0 + 2 * j);
                    f32x4 o1[2], o2[2];
#pragma unroll
                    for (int n = 0; n < 2; ++n)
#pragma unroll
                        for (int r = 0; r < 4; ++r) {
                            const f32x4 cc = c4[2 * n + (r >> 1)]; const float c_ = cc[(r & 1) * 2], s_ = cc[(r & 1) * 2 + 1];
                            const float x1 = acc[ai][0][m][n][r], x2 = acc[ai][1][m][n][r];
                            o1[n][r] = x1 * c_ - x2 * s_; o2[n][r] = x1 * s_ + x2 * c_;
                        }
                    *(u32x4*)(Qr + row * 512 + head * 128 + d0) = pk8(o1[0], o1[1]);
                    *(u32x4*)(Qr + row * 512 + head * 128 + 64 + d0) = pk8(o2[0], o2[1]);
                    asm volatile("" ::: "memory");
                }
        } else {
#pragma unroll
            for (int ai = 0; ai < 2; ++ai)
#pragma unroll
                for (int m = 0; m < 4; ++m) {
                    const size_t row = row0 + ai * 128 + m * 16;
#pragma unroll
                    for (int bj = 0; bj < 2; ++bj) {
                        const int cl = bj * 128 + c8;
                        f32x4 v0 = acc[ai][bj][m][0], v1 = acc[ai][bj][m][1];
                        if (pn < 8) {
#pragma unroll
                            for (int r = 0; r < 4; ++r) { v0[r] = siluf_(v0[r]); v1[r] = siluf_(v1[r]); }
                            *(u32x4*)((bf16_t*)(ws + OFF_GS) + row * 2048 + (pn - 4) * 256 + cl) = pk8(v0, v1);
                        } else if (pn < 10) {
                            *(u32x4*)((bf16_t*)(ws + OFF_QGN) + row * 512 + (pn - 8) * 256 + cl) = pk8(v0, v1);
                        } else if (pn < 14) {
#pragma unroll
                            for (int r = 0; r < 4; ++r) { v0[r] = siluf_(v0[r]); v1[r] = siluf_(v1[r]); }
                            *(u32x4*)((bf16_t*)(ws + OFF_GS) + row * 2048 + 1024 + (pn - 10) * 256 + cl) = pk8(v0, v1);
                        } else if (pn < 22) {
#pragma unroll
                            for (int r = 0; r < 4; ++r) { v0[r] = sigmoidf_(v0[r]); v1[r] = sigmoidf_(v1[r]); }
                            *(u32x4*)((bf16_t*)(ws + OFF_MG) + row * 2048 + (pn - 14) * 256 + cl) = pk8(v0, v1);
                        } else if (cl < 16) {
                            int frl = fr; asm volatile("" : "+v"(frl));
                            const unsigned ofs = (unsigned)OFF_GA + ((unsigned)(u.pm * 256 + wr * 64 + frl + ai * 128 + m * 16) * 16u + (unsigned)cl) * 4u;
                            *(f32x4*)(ws + ofs) = v0; *(f32x4*)(ws + ofs + 16) = v1;
                        }
                    }
                    asm volatile("" ::: "memory");
                }
        }
    }
};
struct EpiP1V {
    static constexpr bool PERM = true, AFTER_DRAIN = false;
    unsigned char* ws;
    __device__ __forceinline__ void operator()(const pg8::f32x4 (&acc)[2][2][4][2], const pg8::Unit& u, int wr, int wc, int fr, int fq) const {
        bf16_t* dst = (bf16_t*)(ws + (u.pm < 4 ? OFF_VRT : OFF_VGT)); const int head = u.pm & 3;
#pragma unroll
        for (int bj = 0; bj < 2; ++bj) {
            const int tok0 = u.pn * 256 + bj * 128 + wc * 32 + 8 * fq; const int item = (tok0 >> 6) * 4 + head, m0 = tok0 & 63;
#pragma unroll
            for (int ai = 0; ai < 2; ++ai)
#pragma unroll
                for (int m = 0; m < 4; ++m) {
                    *(u32x4*)(dst + vf_off(item, ai * 128 + wr * 64 + m * 16 + fr, m0)) = pk8(acc[ai][bj][m][0], acc[ai][bj][m][1]);
                    asm volatile("" ::: "memory");
                }
        }
    }
};
struct EpiP1G {
    static constexpr bool PERM = true, AFTER_DRAIN = false;
    unsigned char* ws;
    __device__ __forceinline__ void operator()(const pg8::f32x4 (&acc)[2][2][4][2], const pg8::Unit& u, int wr, int wc, int fr, int fq) const {
        bf16_t* dst = (bf16_t*)(ws + OFF_KGT);
#pragma unroll
        for (int bj = 0; bj < 2; ++bj) {
            const int tok0 = u.pn * 256 + bj * 128 + wc * 32 + 8 * fq; const int m0 = tok0 & 63;
#pragma unroll
            for (int ai = 0; ai < 2; ++ai) {
                const unsigned item = (unsigned)((tok0 >> 6) * 4 + 2 * u.pm + ai);
#pragma unroll
                for (int m = 0; m < 4; ++m) {
                    *(u32x4*)(dst + (item * 128u + (unsigned)(wr * 64 + m * 16 + fr)) * 64u + (unsigned)m0) = pk8(acc[ai][bj][m][0], acc[ai][bj][m][1]);
                    asm volatile("" ::: "memory");
                }
            }
        }
    }
};
DEVI void phase1(const Params& p, unsigned char* smem_all) {
    {
        pg8::StaticOrder S; S.init(T_, 5632, RG, RB);
        pg8::Gemm g; g.A = (const bf16_t*)(p.ws + OFF_XB); g.Bt = (const bf16_t*)(p.ws + OFF_WT) + (size_t)WT_BN * 1024; g.M = T_; g.N = 5632; g.K = 1024;
        EpiP1N E; E.ws = p.ws;
        pg8::gemm_phase<EpiP1N, pg8::StaticOrder, true, true>((PG8_LAS unsigned char*)smem_all, g, S, E);
    }
    __syncthreads();
    {
        pg8::StaticOrder S; S.init(2048, T_, RG, RB);
        pg8::Gemm g; g.A = (const bf16_t*)(p.ws + OFF_WT) + (size_t)(WT_AT + 512) * 1024; g.Bt = (const bf16_t*)(p.ws + OFF_XB); g.M = 2048; g.N = T_; g.K = 1024;
        EpiP1V E; E.ws = p.ws;
        pg8::gemm_phase<EpiP1V, pg8::StaticOrder, true, true>((PG8_LAS unsigned char*)smem_all, g, S, E);
    }
    __syncthreads();
    {
        pg8::StaticOrder S; S.init(512, T_, RG, RB);
        pg8::Gemm g; g.A = (const bf16_t*)(p.ws + OFF_WT) + (size_t)(WT_AT + 2560) * 1024; g.Bt = (const bf16_t*)(p.ws + OFF_XB); g.M = 512; g.N = T_; g.K = 1024;
        EpiP1G E; E.ws = p.ws;
        pg8::gemm_phase<EpiP1G, pg8::StaticOrder, true, true>((PG8_LAS unsigned char*)smem_all, g, S, E);
    }
}

DEVI void phase2(const Params& p, unsigned char* smem) {
    float* ga_s = (float*)smem;
    float* tot = (float*)(smem + 4096);
    const int tid = VT;
    const float* Ga = (const float*)(p.ws + OFF_GA);
    const bf16_t* Kgt = (const bf16_t*)(p.ws + OFF_KGT); bf16_t* Kg2 = (bf16_t*)(p.ws + OFF_KG2);
    float* dec = (float*)(p.ws + OFF_DEC);
    for (int it = VB; it < 2048; it += VG) {
        const int h = it & 3, c = (it >> 2) & 63, b = it >> 8;
        const int tok0 = b * 4096 + c * 64;
        ((f32x4*)ga_s)[tid] = ((const f32x4*)(Ga + (size_t)tok0 * 16))[tid];
        const int dk = tid & 127, half = tid >> 7;
        float w2[16];
#pragma unroll
        for (int r = 0; r < 16; ++r) w2[r] = p.gate_w2[r * 512 + h * 128 + dk];
        const float bias = p.gate_b[h * 128 + dk];
        __syncthreads();
        float run = 0.f; float bc[32];
#pragma unroll
        for (int ml = 0; ml < 32; ++ml) {
            const int m = half * 32 + ml;
            float z = bias;
#pragma unroll
            for (int r4 = 0; r4 < 4; ++r4) { const f32x4 g4 = *(const f32x4*)&ga_s[m * 16 + 4 * r4];
                z += g4[0] * w2[4 * r4] + g4[1] * w2[4 * r4 + 1] + g4[2] * w2[4 * r4 + 2] + g4[3] * w2[4 * r4 + 3]; }
            const float la = (fminf(z, 0.f) - __logf(1.0f + __expf(-fabsf(z)))) * (1.0f / 16.0f);
            run += la; bc[ml] = run;
        }
        tot[half * 128 + dk] = run;
        __syncthreads();
        const float t0 = tot[dk], t1 = tot[128 + dk];
        const float bend = t0 + t1, off = half ? t0 : 0.f;
        const u32x4* kp = (const u32x4*)(Kgt + ((size_t)it * 128 + dk) * 64 + half * 32);
        bf16_t* const kqb = Kg2;
#pragma unroll
        for (int j = 0; j < 4; ++j) {
            u32x4 v = kp[j];
            unsigned uu[4] = {v.x, v.y, v.z, v.w};
#pragma unroll
            for (int e = 0; e < 4; ++e) {
                const float f0 = bflo(uu[e]) * __expf(bend - (bc[8 * j + 2 * e] + off));
                const float f1 = bfhi(uu[e]) * __expf(bend - (bc[8 * j + 2 * e + 1] + off));
                uu[e] = pk2(f0, f1);
            }
            *(u32x4*)(kqb + kf_off(it, dk, half * 32 + 8 * j)) = (u32x4){uu[0], uu[1], uu[2], uu[3]};
        }
        if (half == 0) dec[(size_t)it * 128 + dk] = __expf(bend);
        {
            const bf16_t* Qn = (const bf16_t*)(p.ws + OFF_QGN); bf16_t* QF = (bf16_t*)(p.ws + OFF_QG);
            const int m = tid & 63, qd = tid >> 6, bc = b * 64 + c;
            const u32x4* qs = (const u32x4*)(Qn + ((size_t)tok0 + m) * 512 + h * 128 + 32 * qd);
            u32x4 qv[4];
#pragma unroll
            for (int j = 0; j < 4; ++j) qv[j] = qs[j];
#pragma unroll
            for (int j = 0; j < 4; ++j) {
                *(u32x2*)(QF + qf_off(bc, h, m, 32 * qd + 8 * j, 0)) = (u32x2){qv[j].x, qv[j].y};
                *(u32x2*)(QF + qf_off(bc, h, m, 32 * qd + 8 * j, 1)) = (u32x2){qv[j].z, qv[j].w};
            }
        }
        __syncthreads();
    }
    {
        bf16_t* tile = (bf16_t*)smem;
        const bf16_t* Kr = (const bf16_t*)(p.ws + OFF_KR); bf16_t* Krt = (bf16_t*)(p.ws + OFF_KRT);
        for (int it = VB; it < 2048; it += VG) {
            const int h = it & 3, c = (it >> 2) & 63, b = it >> 8;
            const size_t tok0 = (size_t)b * 4096 + c * 64;
            const int m = tid & 63, qd = tid >> 6;
            const float kd = exp2f(gamma_log2(h) * (float)(63 - m));
            const u32x4* src = (const u32x4*)(Kr + (tok0 + m) * 512 + h * 128 + 32 * qd);
            u32x4 v[4];
#pragma unroll
            for (int j = 0; j < 4; ++j) v[j] = src[j];
#pragma unroll
            for (int j = 0; j < 4; ++j) {
                const unsigned uu[4] = {v[j].x, v[j].y, v[j].z, v[j].w};
#pragma unroll
                for (int e = 0; e < 4; ++e) {
                    const int dk = 32 * qd + 8 * j + 2 * e;
                    tile[dk * 72 + m] = f2bf(bflo(uu[e]) * kd); tile[(dk + 1) * 72 + m] = f2bf(bfhi(uu[e]) * kd);
                }
            }
            {
                const bf16_t* Qr = (const bf16_t*)(p.ws + OFF_QR); bf16_t* QF = (bf16_t*)(p.ws + OFF_QFR);
                const u32x4* qs = (const u32x4*)(Qr + (tok0 + m) * 512 + h * 128 + 32 * qd);
                u32x4 qv[4];
#pragma unroll
                for (int j = 0; j < 4; ++j) qv[j] = qs[j];
                const int bc = b * 64 + c;
#pragma unroll
                for (int j = 0; j < 4; ++j) {
                    *(u32x2*)(QF + qf_off(bc, h, m, 32 * qd + 8 * j, 0)) = (u32x2){qv[j].x, qv[j].y};
                    *(u32x2*)(QF + qf_off(bc, h, m, 32 * qd + 8 * j, 1)) = (u32x2){qv[j].z, qv[j].w};
                }
            }
            __syncthreads();
            {
                const int dk = tid >> 1, hf = tid & 1;
#pragma unroll
                for (int j = 0; j < 4; ++j) *(u32x4*)(Krt + kf_off(it, dk, hf * 32 + 8 * j)) = *(const u32x4*)&tile[dk * 72 + hf * 32 + 8 * j];
            }
            __syncthreads();
        }
    }
}

typedef float f32x16 __attribute__((ext_vector_type(16)));
DEVI f32x16 mfma32(bf16x8 a, bf16x8 b, f32x16 c) { return __builtin_amdgcn_mfma_f32_32x32x16_bf16(a, b, c, 0, 0, 0); }
struct ScanSet { bf16x8 kf[4], vq, qf[2][2]; f32x4 dc[4]; };
template <bool GLA>
DEVI void scan_tile(const Params& p, unsigned char* zb  , int b, int h, int s, int dummy) {
    int vt_ = VT; asm volatile("" : "+v"(vt_));
    const int t = __builtin_amdgcn_readfirstlane(vt_ >> 6), lane = vt_ & 63, r = lane & 31, hh = lane >> 5;
    const bf16_t* Ktb = (const bf16_t*)(p.ws + (GLA ? OFF_KG2 : OFF_KRT));
    const bf16_t* Vtb = (const bf16_t*)(p.ws + (GLA ? OFF_VGT : OFF_VRT));
    const bf16_t* Qb  = (const bf16_t*)(p.ws + (GLA ? OFF_QG : OFF_QFR));
    const float* dec = (const float*)(p.ws + OFF_DEC);
    bf16_t* Oo = (bf16_t*)(p.ws + OFF_OO);
    const float lg = gamma_log2(h);
    const float cd = exp2f(lg * 64.0f);
    f32x16 S;
#pragma unroll
    for (int i = 0; i < 16; ++i) S[i] = 0.f;
    const unsigned it0 = (unsigned)(b * 64 * 4 + h);
    const bf16_t* const kp = Ktb + ((size_t)it0 * 4 + t) * 4 * 512; const unsigned ko = (unsigned)lane * 8;
    const bf16_t* const vp = Vtb + ((size_t)it0 * 8 + s) * 4 * 512 + t * 512; const unsigned vo = (unsigned)lane * 8;
    const bf16_t* const qp = Qb + ((((size_t)(b * 64) * 4 + h) * 2) * 4 + t) * 2 * 512; const unsigned qo = (unsigned)lane * 8;
    const float* const dp = dec + (size_t)it0 * 128 + t * 32; const unsigned dofs = 4 * hh;
    unsigned char* const vring = smem_all_g + 2 * SMEM_HALF + VH * 8192;
    const int rt = t >> 1, rg0 = 2 * (t & 1);
    const float qd = GLA ? 1.0f : exp2f(lg * (float)(32 * rt + r + 1));
    bf16_t* const ob = Oo + (size_t)b * 4096 * 2048 + (GLA ? 1024 : 0) + h * 256 + s * 32;
#define ST_CL(C) (dummy ? 0 : ((C) < 64 ? (C) : 63))
#define ST_LOAD(SET, C) do { const int c_ = ST_CL(C), cv_ = ST_CL((C) + 1); \
        const bf16_t* kq = kp + (size_t)c_ * (4 * 16 * 512) + ko; const bf16_t* qq = qp + (size_t)c_ * (4 * 16 * 512) + qo; \
        _Pragma("unroll") for (int ks = 0; ks < 4; ++ks) (SET).kf[ks] = *(const bf16x8*)(kq + ks * 512); \
        (SET).vq = *(const bf16x8*)(vp + (size_t)cv_ * (4 * 32 * 512) + vo); \
        _Pragma("unroll") for (int ss = 0; ss < 2; ++ss) _Pragma("unroll") for (int tt = 0; tt < 2; ++tt) (SET).qf[ss][tt] = *(const bf16x8*)(qq + tt * (8 * 512) + ss * 512); \
        } while (0)
#define ST_LOADDC(SET, C) do { if (GLA) { const int c_ = (C) < 64 ? (C) : 63; const float* dq = dp + (size_t)c_ * (4 * 128) + dofs; \
        _Pragma("unroll") for (int g = 0; g < 4; ++g) (SET).dc[g] = *(const f32x4*)(dq + 8 * g); } } while (0)
#define ST_Z(SET, ZC) do { \
        _Pragma("unroll") for (int tt = 0; tt < 2; ++tt) { \
            f32x16 Zt; _Pragma("unroll") for (int i = 0; i < 16; ++i) Zt[i] = 0.f; \
            _Pragma("unroll") for (int ss = 0; ss < 2; ++ss) { \
                u32x4 pk; pk.x = pk2(S[8 * ss + 0], S[8 * ss + 1]); pk.y = pk2(S[8 * ss + 2], S[8 * ss + 3]); pk.z = pk2(S[8 * ss + 4], S[8 * ss + 5]); pk.w = pk2(S[8 * ss + 6], S[8 * ss + 7]); \
                Zt = mfma32(__builtin_bit_cast(bf16x8, pk), (SET).qf[ss][tt], Zt); } \
            _Pragma("unroll") for (int g = 0; g < 4; ++g) { \
                f32x4 z4; z4[0] = Zt[4 * g]; z4[1] = Zt[4 * g + 1]; z4[2] = Zt[4 * g + 2]; z4[3] = Zt[4 * g + 3]; \
                *(u32x2*)((ZC) + (((t * 2 + tt) * 4 + g) * 64 + lane) * 8) = pk4(z4); } } } while (0)
#define ST_UPD(SET, C) do { \
        if (GLA) { _Pragma("unroll") for (int g = 0; g < 4; ++g) _Pragma("unroll") for (int i = 0; i < 4; ++i) S[4 * g + i] *= (SET).dc[g][i]; } \
        else { _Pragma("unroll") for (int i = 0; i < 16; ++i) S[i] *= cd; } \
        _Pragma("unroll") for (int ks = 0; ks < 4; ++ks) S = mfma32((SET).kf[ks], *(const bf16x8*)(vring + ((C) & 1) * 4096 + ks * 1024 + lane * 16), S); } while (0)
#define ST_STEP(CUR, NXT, OTH, C) do { \
        ST_LOADDC(OTH, (C) + 1); ST_LOAD(NXT, (C) + 2);       \
        __builtin_amdgcn_sched_barrier(0); \
        unsigned char* zc = zb + ((C) & 1) * 16384; \
        if (GLA) { ST_UPD(CUR, C); ST_Z(CUR, zc); } else { ST_Z(CUR, zc); ST_UPD(CUR, C); } \
        *(bf16x8*)(vring + (((C) + 1) & 1) * 4096 + t * 1024 + lane * 16) = (CUR).vq; \
        __syncthreads(); \
        _Pragma("unroll") for (int gi = 0; gi < 2; ++gi) { const int g = rg0 + gi; \
            f32x4 o = (f32x4){0.f, 0.f, 0.f, 0.f}; \
            _Pragma("unroll") for (int t2 = 0; t2 < 4; ++t2) o += unpk4(*(const u32x2*)(zc + (((t2 * 2 + rt) * 4 + g) * 64 + lane) * 8)); \
            *(u32x2*)(zb + 32768 + ((C) & 7) * 4096 + (32 * rt + r) * 64 + (8 * g + 4 * hh) * 2) = pk4(o * qd); } \
          \
        if (((C) & 7) == 7) { __syncthreads(); \
            _Pragma("unroll") for (int i = 0; i < 8; ++i)   \
                *(u32x4*)((unsigned char*)ob + (size_t)(((C) - 7) * 64 + i * 64) * 4096 + fo) = *(const u32x4*)(zb + 32768 + i * 4096 + fl); } } while (0)
    const unsigned fo = (unsigned)(vt_ >> 2) * 4096u + (unsigned)(vt_ & 3) * 16u, fl = (unsigned)(vt_ >> 2) * 64u + (unsigned)(vt_ & 3) * 16u;
    ScanSet A, B, Cc;
    { const bf16x8 v0 = *(const bf16x8*)(vp + vo); *(bf16x8*)(vring + t * 1024 + lane * 16) = v0; }
    ST_LOAD(A, 0); ST_LOADDC(A, 0); ST_LOAD(B, 1);
    __syncthreads();
#pragma unroll 1
    for (int c0 = 0; c0 < 66; c0 += 3) { ST_STEP(A, Cc, B, c0); ST_STEP(B, A, Cc, c0 + 1); ST_STEP(Cc, B, A, c0 + 2); }
    __syncthreads();
#undef ST_STEP
#undef ST_UPD
#undef ST_Z
#undef ST_LOADDC
#undef ST_LOAD
#undef ST_CL
}
DEVI void phase3t(const Params& p, unsigned char* smem, int dummy) {
    for (int it0 = VB; it0 < 512; it0 += VG) {
        const int lcl = (RB >> 3) * 2 + VH;
        const int it = (VG == 512) ? ((RB & 7) * 8 + lcl / 8) * 8 + (lcl & 7) : it0;
        const int s = it & 7, h = (it >> 3) & 3, b = (it >> 5) & 7, br = it >> 8;
        if (br == 0) scan_tile<false>(p, smem, b, h, s, dummy); else scan_tile<true>(p, smem, b, h, s, dummy);
    }
}

constexpr int PS_LD = 72;
DEVI void phase4(const Params& p, unsigned char* smem) {
    const int t = VT, lane = t & 63, w = t >> 6, l15 = lane & 15, q = lane >> 4;
    bf16_t* Ps = (bf16_t*)smem + w * 16 * PS_LD;
    const bf16_t* Qr = (const bf16_t*)(p.ws + OFF_QR); const bf16_t* Kr = (const bf16_t*)(p.ws + OFF_KR);
    const bf16_t* Vrt = (const bf16_t*)(p.ws + OFF_VRT); const bf16_t* Oo = (const bf16_t*)(p.ws + OFF_OO);
    const bf16_t* Gs = (const bf16_t*)(p.ws + OFF_GS); bf16_t* Y = (bf16_t*)(p.ws + OFF_Y);
    for (int it = VB; it < 4096; it += VG) {
        const int br = it >> 11, idx = it & 2047;
        const int h = idx & 3, c = (idx >> 2) & 63, b = idx >> 8;
        const size_t tok0 = (size_t)b * 4096 + c * 64;
        const size_t tok = tok0 + 16 * w + l15;
        f32x4 O[16];
        const bf16_t* orow = Oo + tok * 2048 + br * 1024 + h * 256 + 4 * q;
        const bf16_t* grow = Gs + tok * 2048 + br * 1024 + h * 256 + 4 * q;
        u32x2 oraw[16], graw[16];
        if (br == 0) {
            const float lg = gamma_log2(h);
            bf16x8 vf[8][2];
#pragma unroll
            for (int nt = 0; nt < 8; ++nt) { vf[nt][0] = *(const bf16x8*)(Vrt + vf_off(idx, 16 * nt + l15, q * 8)); vf[nt][1] = *(const bf16x8*)(Vrt + vf_off(idx, 16 * nt + l15, 32 + q * 8)); }
            __builtin_amdgcn_sched_barrier(0);
            f32x4 P[4] = {(f32x4){0.f, 0.f, 0.f, 0.f}, (f32x4){0.f, 0.f, 0.f, 0.f}, (f32x4){0.f, 0.f, 0.f, 0.f}, (f32x4){0.f, 0.f, 0.f, 0.f}};
#pragma unroll
            for (int ks = 0; ks < 4; ++ks) {
                const bf16x8 qf = *(const bf16x8*)(Qr + tok * 512 + h * 128 + ks * 32 + q * 8);
#pragma unroll
                for (int mt = 0; mt < 4; ++mt) {
                    const bf16x8 kf = *(const bf16x8*)(Kr + (tok0 + 16 * mt + l15) * 512 + h * 128 + ks * 32 + q * 8);
                    P[mt] = mfma16(kf, qf, P[mt]);
                }
            }
            const int j = 16 * w + l15;
#pragma unroll
            for (int mt = 0; mt < 4; ++mt) {
                f32x4 v = P[mt];
#pragma unroll
                for (int r = 0; r < 4; ++r) { const int m = 16 * mt + 4 * q + r; const int dd = j > m ? j - m : m - j; v[r] *= exp2f(lg * (float)dd); }
                *(u32x2*)&Ps[l15 * PS_LD + 16 * mt + 4 * q] = pk4(v);
            }
            __syncthreads();
            const bf16x8 pf0 = *(const bf16x8*)&Ps[l15 * PS_LD + q * 8];
            const bf16x8 pf1 = *(const bf16x8*)&Ps[l15 * PS_LD + 32 + q * 8];
            __builtin_amdgcn_sched_barrier(0);
#pragma unroll
            for (int nt = 0; nt < 8; ++nt) {
                f32x4 o = (f32x4){0.f, 0.f, 0.f, 0.f};
                o = mfma16(vf[nt][0], pf0, o); O[nt] = mfma16(vf[nt][1], pf1, o);
            }
            __builtin_amdgcn_sched_barrier(0);
#pragma unroll
            for (int nt = 0; nt < 8; ++nt) { vf[nt][0] = *(const bf16x8*)(Vrt + vf_off(idx, 16 * (8 + nt) + l15, q * 8)); vf[nt][1] = *(const bf16x8*)(Vrt + vf_off(idx, 16 * (8 + nt) + l15, 32 + q * 8)); }
#pragma unroll
            for (int nt = 0; nt < 16; ++nt) { oraw[nt] = *(const u32x2*)(orow + 16 * nt); graw[nt] = *(const u32x2*)(grow + 16 * nt); }
            __builtin_amdgcn_sched_barrier(0);
#pragma unroll
            for (int nt = 0; nt < 8; ++nt) {
                f32x4 o = (f32x4){0.f, 0.f, 0.f, 0.f};
                o = mfma16(vf[nt][0], pf0, o); O[8 + nt] = mfma16(vf[nt][1], pf1, o);
            }
#pragma unroll
            for (int nt = 0; nt < 16; ++nt) O[nt] += unpk4(oraw[nt]);
            __syncthreads();
        } else {
#pragma unroll
            for (int nt = 0; nt < 16; ++nt) { oraw[nt] = *(const u32x2*)(orow + 16 * nt); graw[nt] = *(const u32x2*)(grow + 16 * nt); }
#pragma unroll
            for (int nt = 0; nt < 16; ++nt) O[nt] = unpk4(oraw[nt]);
        }
        float s1 = 0.f;
#pragma unroll
        for (int nt = 0; nt < 16; ++nt) s1 += (O[nt][0] + O[nt][1]) + (O[nt][2] + O[nt][3]);
        s1 += __shfl_xor(s1, 16); s1 += __shfl_xor(s1, 32);
        const float mean = (br == 0) ? s1 * (1.0f / 256.0f) : 0.f;
        float s2 = 0.f;
#pragma unroll
        for (int nt = 0; nt < 16; ++nt) {
#pragma unroll
            for (int r = 0; r < 4; ++r) { const float dlt = O[nt][r] - mean; s2 += dlt * dlt; }
        }
        s2 += __shfl_xor(s2, 16); s2 += __shfl_xor(s2, 32);
        const float rstd = rsqrtf(s2 * (1.0f / 256.0f) + (br == 0 ? 1e-5f : 1e-6f));
        const float* gw = (br == 0 ? p.ret_norm_g : p.gla_norm_g) + h * 256 + 4 * q;
        bf16_t* yrow = Y + ((size_t)br * T_ + tok) * 1024 + h * 256 + 4 * q;
#pragma unroll
        for (int nt = 0; nt < 16; ++nt) {
            const f32x4 g = *(const f32x4*)(gw + 16 * nt);
            const f32x4 gate = unpk4(graw[nt]);
            f32x4 y;
#pragma unroll
            for (int r = 0; r < 4; ++r) y[r] = (O[nt][r] - mean) * rstd * g[r] * gate[r];
            *(u32x2*)(yrow + 16 * nt) = pk4(y);
        }
    }
}

struct EpiMerge {
    static constexpr bool PERM = true, AFTER_DRAIN = false;
    const bf16_t* Mg; bf16_t* Mrg; int pass;
    __device__ __forceinline__ void operator()(const pg8::f32x4 (&acc)[2][2][4][2], const pg8::Unit& u, int wr, int wc, int fr, int fq) const {
        const int row0 = u.pm * 256 + wr * 64 + fr, col0 = u.pn * 256 + wc * 32 + 8 * fq;
#pragma unroll
        for (int ai = 0; ai < 2; ++ai) {
            u32x4 gg[4][2], pr[4][2];
#pragma unroll
            for (int m = 0; m < 4; ++m)
#pragma unroll
                for (int bj = 0; bj < 2; ++bj) {
                    const size_t row = row0 + ai * 128 + m * 16; const int col = col0 + bj * 128;
                    gg[m][bj] = *(const u32x4*)(Mg + row * 2048 + pass * 1024 + col);
                    if (pass) pr[m][bj] = *(const u32x4*)(Mrg + row * 1024 + col);
                }
#pragma unroll
            for (int m = 0; m < 4; ++m)
#pragma unroll
                for (int bj = 0; bj < 2; ++bj) {
                    const size_t row = row0 + ai * 128 + m * 16; const int col = col0 + bj * 128;
                    f32x4 g0, g1; unpk8(gg[m][bj], g0, g1);
                    f32x4 o0 = acc[ai][bj][m][0] * g0, o1 = acc[ai][bj][m][1] * g1;
                    if (pass) { f32x4 p0, p1; unpk8(pr[m][bj], p0, p1); o0 += p0; o1 += p1; }
                    *(u32x4*)(Mrg + row * 1024 + col) = pk8(o0, o1);
                }
        }
    }
};
DEVI void phase5(const Params& p, unsigned char* smem_all) {
    pg8::StaticOrder S; S.init(T_, 1024, RG, RB);
    const bf16_t* Y = (const bf16_t*)(p.ws + OFF_Y); const bf16_t* wt = (const bf16_t*)(p.ws + OFF_WT);
    for (int pass = 0; pass < 2; ++pass) {
        pg8::Gemm g; g.A = Y + (size_t)pass * T_ * 1024; g.Bt = wt + (size_t)(pass ? WT_GLA : WT_RET) * 1024; g.M = T_; g.N = 1024; g.K = 1024;
        EpiMerge E; E.Mg = (const bf16_t*)(p.ws + OFF_MG); E.Mrg = (bf16_t*)(p.ws + OFF_MRG); E.pass = pass;
        pg8::gemm_phase<EpiMerge, pg8::StaticOrder, true, true>((PG8_LAS unsigned char*)smem_all, g, S, E);
        __syncthreads();
    }
}

struct EpiResid {
    static constexpr bool PERM = true, AFTER_DRAIN = false;
    const float* x; bf16_t* T1;
    __device__ __forceinline__ void operator()(const pg8::f32x4 (&acc)[2][2][4][2], const pg8::Unit& u, int wr, int wc, int fr, int fq) const {
        const int row0 = u.pm * 256 + wr * 64 + fr, col0 = u.pn * 256 + wc * 32 + 8 * fq;
#pragma unroll
        for (int ai = 0; ai < 2; ++ai)
#pragma unroll
            for (int m = 0; m < 4; ++m) {
                const size_t row = row0 + ai * 128 + m * 16;
                f32x4 xv[2][2];
#pragma unroll
                for (int bj = 0; bj < 2; ++bj) { xv[bj][0] = *(const f32x4*)(x + row * 1024 + col0 + bj * 128); xv[bj][1] = *(const f32x4*)(x + row * 1024 + col0 + bj * 128 + 4); }
#pragma unroll
                for (int bj = 0; bj < 2; ++bj)
                    *(u32x4*)(T1 + row * 1024 + col0 + bj * 128) = pk8(xv[bj][0] * ALPHA_ + acc[ai][bj][m][0], xv[bj][1] * ALPHA_ + acc[ai][bj][m][1]);
            }
    }
};
DEVI void phase6(const Params& p, unsigned char* smem_all) {
    pg8::StaticOrder S; S.init(T_, 1024, RG, RB);
    pg8::Gemm g; g.A = (const bf16_t*)(p.ws + OFF_MRG); g.Bt = (const bf16_t*)(p.ws + OFF_WT) + (size_t)WT_O * 1024; g.M = T_; g.N = 1024; g.K = 1024;
    EpiResid E; E.x = p.x; E.T1 = (bf16_t*)(p.ws + OFF_T1);
    pg8::gemm_phase<EpiResid, pg8::StaticOrder, true, true>((PG8_LAS unsigned char*)smem_all, g, S, E);
}

constexpr int CONV_WTASKS = 257 * 3 * 128;
struct ConvW { const float* sp; bf16_t* dp; int N, K; };
DEVI ConvW convw_task(const Params& p, int task, int lane) {
    const int e = task / 384, rem = task - e * 384, mat = rem >> 7, tl = rem & 127;
    const int ng = lane & 15, kgrp = lane >> 4;
    ConvW c; int kt, n64;
    if (mat < 2) { c.K = 1024; c.N = 256; kt = tl >> 2; n64 = tl & 3;
        const float* src = (mat == 0) ? (e < 256 ? p.ew_gate + (size_t)e * 262144 : p.sw_gate) : (e < 256 ? p.ew_up + (size_t)e * 262144 : p.sw_up);
        const int n = n64 * 64 + 4 * ng;
        c.sp = src + (size_t)(kt * 32 + 8 * kgrp) * 256 + n;
        c.dp = (bf16_t*)(p.ws + OFF_WGU) + ((size_t)e * 512 + (n >> 7) * 256 + mat * 128 + (n & 127)) * 1024 + kt * 32 + 8 * kgrp; }
    else { c.K = 256; c.N = 1024; kt = tl >> 4; n64 = tl & 15;
        const float* src = e < 256 ? p.ew_down + (size_t)e * 262144 : p.sw_down;
        const int n = n64 * 64 + 4 * ng;
        c.sp = src + (size_t)(kt * 32 + 8 * kgrp) * 1024 + n;
        c.dp = (bf16_t*)(p.ws + OFF_WD) + ((size_t)e * 1024 + n) * 256 + kt * 32 + 8 * kgrp; }
    return c;
}
#define CW_LOAD(V, C) do { _Pragma("unroll") for (int r = 0; r < 8; ++r) V[r] = *(const f32x4*)((C).sp + (size_t)r * (C).N); } while (0)
#define CW_STORE(V, C) do { _Pragma("unroll") for (int i = 0; i < 4; ++i) { \
        u32x4 o; o.x = pk2(V[0][i], V[1][i]); o.y = pk2(V[2][i], V[3][i]); o.z = pk2(V[4][i], V[5][i]); o.w = pk2(V[6][i], V[7][i]); \
        *(u32x4*)((C).dp + (size_t)i * (C).K) = o; } } while (0)
DEVI void conv_wave_loop(const Params& p, int first, int stride, int lane) {
    if (first >= CONV_WTASKS) return;
    int task = first;
#define CW_CL(T) ((T) < CONV_WTASKS ? (T) : task)
    f32x4 va[8], vb[8], vc[8];
    ConvW ca = convw_task(p, task, lane), cb = convw_task(p, CW_CL(task + stride), lane), cc = ca;
    CW_LOAD(va, ca); CW_LOAD(vb, cb);
#pragma unroll 1
    for (;;) {
        cc = convw_task(p, CW_CL(task + 2 * stride), lane); CW_LOAD(vc, cc);
        CW_STORE(va, ca);
        task += stride; if (task >= CONV_WTASKS) break;
        ca = convw_task(p, CW_CL(task + 2 * stride), lane); CW_LOAD(va, ca);
        CW_STORE(vb, cb);
        task += stride; if (task >= CONV_WTASKS) break;
        cb = convw_task(p, CW_CL(task + 2 * stride), lane); CW_LOAD(vb, cb);
        CW_STORE(vc, cc);
        task += stride; if (task >= CONV_WTASKS) break;
    }
#undef CW_CL
}
DEVI void conv_expert_weights(const Params& p, unsigned char* smem) {
    const int lane = (int)(threadIdx.x & 63), gw = RB * 8 + (int)(threadIdx.x >> 6);
    conv_wave_loop(p, gw, RG * 8, lane);
}

DEVI void ln1_row(const Params& p, int row, int lane) {
    const bf16_t* T1 = (const bf16_t*)(p.ws + OFF_T1); bf16_t* X1b = (bf16_t*)(p.ws + OFF_X1B);
    f32x4 v[4]; float s = 0.f;
#pragma unroll
    for (int i = 0; i < 4; ++i) { v[i] = unpk4(*(const u32x2*)(T1 + (size_t)row * 1024 + i * 256 + lane * 4)); s += (v[i][0] + v[i][1]) + (v[i][2] + v[i][3]); }
#pragma unroll
    for (int o = 32; o > 0; o >>= 1) s += __shfl_xor(s, o);
    const float mean = s * (1.0f / 1024.0f); float s2 = 0.f;
#pragma unroll
    for (int i = 0; i < 4; ++i)
#pragma unroll
        for (int r = 0; r < 4; ++r) { const float d = v[i][r] - mean; s2 += d * d; }
#pragma unroll
    for (int o = 32; o > 0; o >>= 1) s2 += __shfl_xor(s2, o);
    const float rstd = rsqrtf(s2 * (1.0f / 1024.0f) + 1e-5f);
#pragma unroll
    for (int i = 0; i < 4; ++i) {
        const int col = i * 256 + lane * 4;
        const f32x4 g = *(const f32x4*)(p.ln1_g + col), bb = *(const f32x4*)(p.ln1_b + col);
        f32x4 y;
#pragma unroll
        for (int r = 0; r < 4; ++r) y[r] = (v[i][r] - mean) * rstd * g[r] + bb[r];
        *(u32x2*)(X1b + (size_t)row * 1024 + col) = pk4(y);
    }
}

DEVI unsigned f2ord(float f) { const unsigned u = __float_as_uint(f); return (u & 0x80000000u) ? ~u : (u | 0x80000000u); }
template <int CTRL> DEVI float dppf(float v) { const int x = __float_as_int(v); return __int_as_float(__builtin_amdgcn_update_dpp(x, x, CTRL, 0xf, 0xf, false)); }
template <int CTRL> DEVI void top2_merge(float& m1, float& m2) {
    const float p1 = dppf<CTRL>(m1), p2 = dppf<CTRL>(m2);
    const float n1 = fmaxf(m1, p1), n2 = fmaxf(fminf(m1, p1), fmaxf(m2, p2));
    m1 = n1; m2 = n2;
}
DEVI void route_token(const f32x4 lg, const f32x4 rb, int lane, int& mye, float& myw) {
    const int mygrp = lane >> 3;
    float sc[4], bi[4];
#pragma unroll
    for (int r = 0; r < 4; ++r) { sc[r] = sigmoidf_(lg[r]); bi[r] = sc[r] + rb[r]; }
    float m1, m2;
    { const float h01 = fmaxf(bi[0], bi[1]), l01 = fminf(bi[0], bi[1]), h23 = fmaxf(bi[2], bi[3]), l23 = fminf(bi[2], bi[3]);
      m1 = fmaxf(h01, h23); m2 = fmaxf(fminf(h01, h23), fmaxf(l01, l23)); }
    top2_merge<0xB1>(m1, m2);
    top2_merge<0x4E>(m1, m2);
    top2_merge<0x141>(m1, m2);
    const float gown = m1 + m2;
    int rank = 0;
#pragma unroll
    for (int g2 = 0; g2 < 8; ++g2) {
        const float go = __builtin_bit_cast(float, __builtin_amdgcn_readlane(__builtin_bit_cast(int, gown), 8 * g2));
        rank += (go > gown || (go == gown && g2 < mygrp)) ? 1 : 0;
    }
    unsigned ck[4];
#pragma unroll
    for (int r = 0; r < 4; ++r) ck[r] = rank < 4 ? f2ord(bi[r]) : 0u;
    unsigned thr = 0u; bool exact = false;
#pragma unroll 1
    for (int bit = 31; bit >= 0; --bit) {
        const unsigned cnd = thr | (1u << bit);
        const int c8 = __popcll(__ballot(ck[0] >= cnd)) + __popcll(__ballot(ck[1] >= cnd)) + __popcll(__ballot(ck[2] >= cnd)) + __popcll(__ballot(ck[3] >= cnd));
        if (c8 >= 8) { thr = cnd; if (c8 == 8) { exact = true; break; } }
    }
    unsigned long long selm[4];
    if (exact) {
#pragma unroll
        for (int r = 0; r < 4; ++r) selm[r] = __ballot(ck[r] >= thr);
    } else {
        unsigned long long eq[4], any = 0ull; int need = 8;
#pragma unroll
        for (int r = 0; r < 4; ++r) { selm[r] = __ballot(ck[r] > thr); eq[r] = __ballot(ck[r] == thr); need -= __popcll(selm[r]); any |= eq[r]; }
        while (need > 0 && any != 0ull) {
            const int L = __builtin_ctzll(any); any &= any - 1ull;
#pragma unroll
            for (int r = 0; r < 4; ++r) if (((eq[r] >> L) & 1ull) != 0ull && need > 0) { selm[r] |= 1ull << L; --need; }
        }
    }
    float wsum = 0.f; int kk = 0;
    mye = 0; myw = 0.f;
#pragma unroll
    for (int r = 0; r < 4; ++r) {
        unsigned long long m = selm[r];
        while (m != 0ull) {
            const int L = __builtin_ctzll(m); m &= m - 1ull;
            const float sv = __builtin_bit_cast(float, __builtin_amdgcn_readlane(__builtin_bit_cast(int, sc[r]), L));
            wsum += sv;
            if (lane == kk) { mye = 4 * L + r; myw = sv; }
            ++kk;
        }
    }
    myw = myw / wsum * 2.5f;
}
DEVI void router_gemm(const Params& p, unsigned char* smem_all, int m0, f32x4 (&acc)[4][4]) {
    typedef __attribute__((address_space(3))) unsigned char lds8;
    lds8* const L = (lds8*)smem_all;
    const int tid = (int)threadIdx.x, lane = tid & 63, wv = __builtin_amdgcn_readfirstlane(tid >> 6), wr = wv >> 2, wc = wv & 3, l15 = lane & 15, q = lane >> 4;
    const bf16_t* pa = (const bf16_t*)(p.ws + OFF_X1B) + (size_t)(m0 + (tid >> 3)) * 1024 + gemm_src_chunk(tid);
    const bf16_t* pb = (const bf16_t*)(p.ws + OFF_WT) + (size_t)(WT_R + (tid >> 3)) * 1024 + gemm_src_chunk(tid);
    constexpr int STG = 49152;
#define RG_BOFF(BUF, I) ((BUF) * STG + 16384 + (I) * 8192 + (((BUF) == 2 && (I) >= 2) ? (2 * SMEM_HALF - 131072) : 0))
#define RG_ISSUE(BUF, KT) do { \
        _Pragma("unroll") for (int i = 0; i < 2; ++i) __builtin_amdgcn_global_load_lds((const unsigned*)(pa + (size_t)i * 65536 + (KT) * 64), (__attribute__((address_space(3))) unsigned*)(L + (BUF) * STG + i * 8192 + wv * 1024), 16, 0, 0); \
        _Pragma("unroll") for (int i = 0; i < 4; ++i) __builtin_amdgcn_global_load_lds((const unsigned*)(pb + (size_t)i * 65536 + (KT) * 64), (__attribute__((address_space(3))) unsigned*)(L + RG_BOFF(BUF, i) + wv * 1024), 16, 0, 0); } while (0)
    static_assert(2 * STG + 16384 + 2 * 8192 == 131072 && 2 * SMEM_HALF + 2 * 8192 <= 2 * SMEM_HALF + SMEM_MOE, "router GEMM stage map");
    RG_ISSUE(0, 0); RG_ISSUE(1, 1);
    int buf = 0;
#pragma unroll 1
    for (int kt = 0; kt < 16; ++kt) {
        if (kt + 1 < 16) asm volatile("s_waitcnt vmcnt(6)" ::: "memory"); else asm volatile("s_waitcnt vmcnt(0)" ::: "memory");
        __builtin_amdgcn_s_barrier();
        if (kt + 2 < 16) { const int b2 = buf == 0 ? 2 : buf - 1; RG_ISSUE(b2, kt + 2); }
        __builtin_amdgcn_sched_barrier(0);
#pragma unroll
        for (int ss = 0; ss < 2; ++ss) {
            bf16x8 af[4], bfr[4];
            const int coff = ((ss * 4 + q) ^ (l15 >> 1)) * 16;
#pragma unroll
            for (int i = 0; i < 4; ++i) {
                af[i]  = *(const __attribute__((address_space(3))) bf16x8*)(L + buf * STG + (wr * 64 + i * 16 + l15) * 128 + coff);
                bfr[i] = *(const __attribute__((address_space(3))) bf16x8*)(L + RG_BOFF(buf, wc) + (i * 16 + l15) * 128 + coff); }
#pragma unroll
            for (int mt = 0; mt < 4; ++mt)
#pragma unroll
                for (int nt = 0; nt < 4; ++nt) acc[mt][nt] = mfma16(bfr[nt], af[mt], acc[mt][nt]);
        }
        __builtin_amdgcn_sched_barrier(0);
        buf = buf == 2 ? 0 : buf + 1;
    }
#undef RG_ISSUE
#undef RG_BOFF
    __syncthreads();
}
DEVI void phase8(const Params& p, unsigned char* smem_all) {
    const int tid = (int)threadIdx.x, lane = tid & 63, wv = tid >> 6, wr = wv >> 2, wc = wv & 3, l15 = lane & 15, q = lane >> 4;
    int* hist = (int*)(smem_all + 2 * SMEM_HALF); int* rec = hist + 256; float* wrec = (float*)(rec + 1024);
    int* cnt = (int*)(p.ws + OFF_CNT); int* list = (int*)(p.ws + OFF_LIST); float* wl = (float*)(p.ws + OFF_WL);
    const f32x4 rb = *(const f32x4*)(p.router_bias + 4 * lane);
    for (int mtg = RB; mtg < 256; mtg += RG) {
        const int m0 = mtg * 128;
#pragma unroll 1
        for (int i = 0; i < 16; i += 4) {
#pragma unroll
            for (int j = 0; j < 4; ++j) ln1_row(p, m0 + wv * 16 + i + j, lane);
        }
        asm volatile("s_waitcnt vmcnt(0)" ::: "memory");
        __syncthreads();
        f32x4 acc[4][4]; zero_acc(acc);
        router_gemm(p, smem_all, m0, acc);
        if (tid < 256) hist[tid] = 0;
#pragma unroll
        for (int mt = 0; mt < 4; ++mt)
#pragma unroll
            for (int nt = 0; nt < 4; ++nt) {
                const int row = wr * 64 + mt * 16 + l15, col = wc * 64 + (nt >> 1) * 32 + 8 * q + 4 * (nt & 1);
                *(f32x4*)(smem_all + row * 1024 + (((col >> 2) ^ (row & 15)) * 16)) = acc[mt][nt];
            }
        __syncthreads();
#pragma unroll 1
        for (int i = 0; i < 16; ++i) {
            const int tl = wv + 8 * i;
            const f32x4 lg = *(const f32x4*)(smem_all + tl * 1024 + ((lane ^ (tl & 15)) * 16));
            int mye; float myw; route_token(lg, rb, lane, mye, myw);
            if (lane < 8) {
                const int lpos = __hip_atomic_fetch_add(&hist[mye], 1, __ATOMIC_RELAXED, __HIP_MEMORY_SCOPE_WORKGROUP);
                rec[tl * 8 + lane] = mye | (lpos << 8); wrec[tl * 8 + lane] = myw;
            }
        }
        __syncthreads();
        if (tid < 256) { const int c = hist[tid]; hist[tid] = c > 0 ? atomicAdd(&cnt[tid * CNT_STRIDE], c) : 0; }
        __syncthreads();
        for (int i = tid; i < 1024; i += 512) {
            const int rc = rec[i], e = rc & 255, pos = hist[e] + (rc >> 8);
            list[(size_t)e * T_ + pos] = (m0 + (i >> 3)) * 9 + (i & 7); wl[(size_t)e * T_ + pos] = wrec[i];
        }
        __syncthreads();
    }
}

DEVI void moe_prefix256(const Params& p, int* pre  , int xg) {
    const int tid = threadIdx.x;
    const int* cnt = (const int*)(p.ws + OFF_CNT);
    __syncthreads();
    if (tid < 64) {
        int v = 0;
        if (tid < 32) { const int c = __hip_atomic_load(&cnt[(xg + 8 * tid) * CNT_STRIDE], __ATOMIC_RELAXED, __HIP_MEMORY_SCOPE_AGENT); pre[40 + tid] = c; v = (c + 255) >> 8; }
        else if (tid == 32) { v = 16; pre[40 + 32] = T_; }
#pragma unroll
        for (int o = 1; o < 64; o <<= 1) { const int u = __shfl_up(v, o); if (tid >= o) v += u; }
        if (tid < 33) pre[tid + 1] = v;
        if (tid == 0) pre[0] = 0;
    }
    __syncthreads();
}
struct MoeSched {
    const int* pre; const unsigned char* ws; bool need_w;
    int* sbuf;
    int xg, jl, nloc, nsh, nitems;
    const char* Abase; int arow_bytes; bool by_token;
    const char* Bbase; size_t b_expert_bytes, b_unit_bytes;
    __device__ __forceinline__ bool next(int i, pg8::Unit& u) const {
        const int item = jl + i * nloc; if (item >= nitems) return false;
        u.pm = item >> nsh; u.pn = item - (u.pm << nsh);
        const int lane = (int)(threadIdx.x & 63), li = lane < 33 ? lane : 32;
        const int pv = pre[li], cv = pre[40 + li];
        const int gi = __popcll(__ballot(lane < 33 && pv <= u.pm)) - 1;
        const int pg = __builtin_amdgcn_readlane(pv, gi);
        u.ce = __builtin_amdgcn_readlane(cv, gi);
        u.e = gi < 32 ? xg + 8 * gi : 256; u.r0 = (gi < 32 ? 0 : xg * 4096) + (u.pm - pg) * 256;
        return true;
    }
    __device__ __forceinline__ void decode(const pg8::Unit& u, int& e, int& r0, int& ce) const { e = u.e; r0 = u.r0; ce = u.ce; }
    __device__ __forceinline__ int fill_issue(const pg8::Unit& u) const {
        int e, r0, ce; decode(u, e, r0, ce);
        const int pos = r0 + (int)(threadIdx.x & 255); const bool w = threadIdx.x >= 256;
        int v = w ? 0 : -1;
        if (pos < ce && !(w && !need_w)) {
            unsigned hi = threadIdx.x >> 8; asm volatile("" : "+v"(hi));
            static_assert(OFF_WL == OFF_LIST + (512u << 20), "weight list sits 512 MB above the slot list");
            const unsigned off = (unsigned)OFF_LIST + (hi << 29) + ((unsigned)e * (unsigned)T_ + (unsigned)pos) * 4u;
            v = e < 256 ? *(const int*)(ws + off) : (w ? 0x3f800000 : pos * 9 + 8);
        }
        return v;
    }
    __device__ __forceinline__ void fill_write(int buf, int v) const { sbuf[(threadIdx.x >= 256 ? 768 : 0) + buf * 256 + (int)(threadIdx.x & 255)] = v; }
    __device__ __forceinline__ const char* a_base() const { return Abase; }
    __device__ __forceinline__ void a_rows(int buf, const int (&rowA)[2], const int (&colA)[2], unsigned& p00, unsigned& p01, unsigned& p10, unsigned& p11) const {
        const int* sb = sbuf + buf * 256; const int s0 = sb[0];
        int s4[4];
#pragma unroll
        for (int k = 0; k < 4; ++k) { int sl = sb[(k >> 1) * 128 + rowA[k & 1]]; if (sl < 0) sl = s0; s4[k] = sl; }
#pragma unroll
        for (int k = 0; k < 4; ++k) if (by_token) s4[k] = s4[k] / 9;
        p00 = (unsigned)s4[0] * (unsigned)arow_bytes + (unsigned)colA[0]; p01 = (unsigned)s4[1] * (unsigned)arow_bytes + (unsigned)colA[1];
        p10 = (unsigned)s4[2] * (unsigned)arow_bytes + (unsigned)colA[0]; p11 = (unsigned)s4[3] * (unsigned)arow_bytes + (unsigned)colA[1];
    }
    __device__ __forceinline__ const char* b_base(const pg8::Unit& u) const { int e, r0, ce; decode(u, e, r0, ce); return Bbase + (size_t)e * b_expert_bytes + (size_t)u.pn * b_unit_bytes; }
    __device__ __forceinline__ void a_ready(const pg8::Unit&) const {}
    __device__ __forceinline__ void done(const pg8::Unit&) const {}
};
struct EpiMoe1 {
    static constexpr bool PERM = true, AFTER_DRAIN = false, BJI = false;
    const MoeSched* S; bf16_t* H;
    __device__ __forceinline__ void operator()(const pg8::f32x4 (&acc)[2][2][4][2], const pg8::Unit& u, int wr, int wc, int fr, int fq, int buf) const {
        const int* sb = S->sbuf + buf * 256 + wr * 64 + fr;
#pragma unroll
        for (int ai = 0; ai < 2; ++ai) {
            int sl[4];
#pragma unroll
            for (int m = 0; m < 4; ++m) sl[m] = sb[ai * 128 + m * 16];
#pragma unroll
            for (int m = 0; m < 4; ++m) if (sl[m] >= 0) {
                f32x4 h0, h1;
#pragma unroll
                for (int r = 0; r < 4; ++r) { h0[r] = siluf_(acc[ai][0][m][0][r]) * acc[ai][1][m][0][r]; h1[r] = siluf_(acc[ai][0][m][1][r]) * acc[ai][1][m][1][r]; }
                *(u32x4*)(H + (size_t)sl[m] * 256 + u.pn * 128 + wc * 32 + 8 * fq) = pk8(h0, h1);
            }
            asm volatile("" ::: "memory");
        }
    }
};
struct EpiMoe2 {
    static constexpr bool PERM = true, AFTER_DRAIN = false, BJI = true;
    const MoeSched* S; unsigned char* YX;
    __device__ __forceinline__ void operator()(const pg8::f32x4 (&acc)[2][2][4][2], const pg8::Unit& u, int wr, int wc, int fr, int fq, int buf) const {
        const int* sb = S->sbuf + buf * 256 + wr * 64 + fr;
#pragma unroll
        for (int ai = 0; ai < 2; ++ai) {
            int sl[4]; float wg[4];
#pragma unroll
            for (int m = 0; m < 4; ++m) { sl[m] = sb[ai * 128 + m * 16]; wg[m] = __int_as_float(sb[768 + ai * 128 + m * 16]) * YX_SCALE; }
#pragma unroll
            for (int m = 0; m < 4; ++m) if (sl[m] >= 0) {
                u32x4 w8;
                w8.x = pk4_fp8(clamp4(acc[ai][0][m][0] * wg[m], 440.f)); w8.y = pk4_fp8(clamp4(acc[ai][0][m][1] * wg[m], 440.f));
                w8.z = pk4_fp8(clamp4(acc[ai][1][m][0] * wg[m], 440.f)); w8.w = pk4_fp8(clamp4(acc[ai][1][m][1] * wg[m], 440.f));
                *(u32x4*)(YX + (size_t)sl[m] * 1024 + u.pn * 256 + wc * 64 + 16 * fq) = w8;
            }
            asm volatile("" ::: "memory");
        }
    }
};
DEVI void moe_sched_init(const Params& p, MoeSched& S, int* pre) {
    S.pre = pre; S.ws = p.ws; S.need_w = false; S.sbuf = (int*)(smem_all_g + 2 * SMEM_HALF);
    S.xg = RB & 7; S.jl = RB >> 3; S.nloc = RG >> 3;
}
DEVI void phase10(const Params& p, unsigned char* smem_all) {
    int* pre = (int*)(smem_all + 131072);
    MoeSched S; moe_sched_init(p, S, pre); moe_prefix256(p, pre, S.xg);
    S.nsh = 1; S.nitems = pre[33] << 1; S.Abase = (const char*)(p.ws + OFF_X1B); S.arow_bytes = 2048; S.by_token = true;
    S.Bbase = (const char*)(p.ws + OFF_WGU); S.b_expert_bytes = (size_t)512 * 1024 * 2; S.b_unit_bytes = (size_t)256 * 1024 * 2;
    EpiMoe1 E; E.S = &S; E.H = (bf16_t*)(p.ws + OFF_H);
    pg8::gemm_phase_g<EpiMoe1, MoeSched, true, true>((PG8_LAS unsigned char*)smem_all, 1024, S, E);
}
DEVI void phase11(const Params& p, unsigned char* smem_all) {
    int* pre = (int*)(smem_all + 131072);
    MoeSched S; moe_sched_init(p, S, pre); moe_prefix256(p, pre, S.xg);
    S.nsh = 2; S.nitems = pre[33] << 2; S.Abase = (const char*)(p.ws + OFF_H); S.arow_bytes = 512; S.by_token = false;
    S.Bbase = (const char*)(p.ws + OFF_WD); S.b_expert_bytes = (size_t)1024 * 256 * 2; S.b_unit_bytes = (size_t)256 * 256 * 2;
    S.need_w = true;
    EpiMoe2 E; E.S = &S; E.YX = (unsigned char*)(p.ws + OFF_YX);
    pg8::gemm_phase_g<EpiMoe2, MoeSched, true, true>((PG8_LAS unsigned char*)smem_all, 256, S, E);
}

DEVI void phase12(const Params& p) {
    const int t = VT, lane = t & 63, w = t >> 6;
    const bf16_t* X1b = (const bf16_t*)(p.ws + OFF_X1B); const unsigned char* YX = (const unsigned char*)(p.ws + OFF_YX);
    for (int row = VB * 4 + w; row < T_; row += VG * 4) {
        f32x4 v[4]; float s = 0.f;
#pragma unroll
        for (int i = 0; i < 4; ++i) {
            const int col = i * 256 + lane * 4;
            f32x4 a = unpk4(*(const u32x2*)(X1b + (size_t)row * 1024 + col)) * ALPHA_;
            f32x4 ys = (f32x4){0.f, 0.f, 0.f, 0.f};
#pragma unroll
            for (int k = 0; k < 9; ++k) ys += unpk4_fp8(*(const unsigned*)(YX + ((size_t)row * 9 + k) * 1024 + col));
            a += ys * (1.0f / YX_SCALE);
            v[i] = a; s += (a[0] + a[1]) + (a[2] + a[3]);
        }
#pragma unroll
        for (int o = 32; o > 0; o >>= 1) s += __shfl_xor(s, o);
        const float mean = s * (1.0f / 1024.0f); float s2 = 0.f;
#pragma unroll
        for (int i = 0; i < 4; ++i)
#pragma unroll
            for (int r = 0; r < 4; ++r) { const float d = v[i][r] - mean; s2 += d * d; }
#pragma unroll
        for (int o = 32; o > 0; o >>= 1) s2 += __shfl_xor(s2, o);
        const float rstd = rsqrtf(s2 * (1.0f / 1024.0f) + 1e-5f);
#pragma unroll
        for (int i = 0; i < 4; ++i) {
            const int col = i * 256 + lane * 4;
            const f32x4 g = *(const f32x4*)(p.ln2_g + col), bb = *(const f32x4*)(p.ln2_b + col);
            f32x4 y;
#pragma unroll
            for (int r = 0; r < 4; ++r) y[r] = (v[i][r] - mean) * rstd * g[r] + bb[r];
            *(f32x4*)(p.out + (size_t)row * 1024 + col) = y;
        }
    }
}


#define XB_TMO      128
#define XB_XCNT(j)  (256  + 64 * (j))
#define XB_XSUB(j)  (1280 + 64 * (j))
#define XB_XGEN(j)  (2304 + 64 * (j))
#define XB_TOP      3328
#define XB_TOPGEN   3392
#define XCD_BAR_WORDS 3456
#define XB_SPIN_CAP (1u << 20)
#define LAS __attribute__((address_space(3)))
DEVI unsigned xb_ld(unsigned* p)              { return __hip_atomic_load(p, __ATOMIC_RELAXED, __HIP_MEMORY_SCOPE_AGENT); }
DEVI unsigned xb_add(unsigned* p, unsigned v) { return __hip_atomic_fetch_add(p, v, __ATOMIC_RELAXED, __HIP_MEMORY_SCOPE_AGENT); }
DEVI unsigned xb_xcc_id() { return (unsigned)__builtin_amdgcn_s_getreg((3 << 11) | 20) & 0xFu; }
#define XB_SPIN(cond, bar) do { unsigned _sp = 0; while (cond) { __builtin_amdgcn_s_sleep(1); \
    if ((++_sp & 255u) == 0u) { if (xb_ld(&(bar)[XB_TMO])) break; if (_sp > XB_SPIN_CAP) { atomicAdd(&(bar)[XB_TMO], 1u); break; } } } } while (0)
struct XcdBarrier { unsigned* bar; unsigned x; volatile LAS unsigned* st; };
DEVI XcdBarrier xcd_barrier_post(unsigned* bar, volatile LAS unsigned* st) {
    XcdBarrier b; b.bar = bar; b.x = xb_xcc_id(); b.st = st;
    if (threadIdx.x == 0) st[3] = xb_add(&bar[XB_XCNT(b.x)], 1u);
    return b;
}
DEVI void xcd_barrier_complete(unsigned* bar, unsigned x, unsigned& nloc, unsigned& nx) {
    const unsigned G = gridDim.x * gridDim.y * gridDim.z;
    unsigned sum, cnt, mine, sp = 0u;
    for (;;) {
        sum = 0u; cnt = 0u; mine = 0u;
#pragma unroll
        for (unsigned j = 0; j < 16; ++j) { const unsigned c = xb_ld(&bar[XB_XCNT(j)]); sum += c; cnt += (c > 0u) ? 1u : 0u; mine = (j == x) ? c : mine; }
        if (sum == G) break;
        __builtin_amdgcn_s_sleep(1);
        if ((++sp & 255u) == 0u) { if (xb_ld(&bar[XB_TMO])) break; if (sp > XB_SPIN_CAP) { atomicAdd(&bar[XB_TMO], 1u); break; } }
    }
    nloc = mine > 0u ? mine : 1u; nx = cnt > 0u ? cnt : 1u;
}
DEVI void xcd_barrier(const XcdBarrier& b) {
    asm volatile("s_waitcnt vmcnt(0)" ::: "memory");
    __syncthreads();
    if (threadIdx.x == 0) {
        unsigned* bar = b.bar;
        __builtin_amdgcn_s_waitcnt(0);
        unsigned nloc = b.st[0], nx = b.st[1];
        if (nloc == 0u) { xcd_barrier_complete(bar, b.x, nloc, nx); b.st[0] = nloc; b.st[1] = nx; }
        const unsigned old = xb_add(&bar[XB_XSUB(b.x)], 1u);
        const unsigned gen = old / nloc;
        if (old + 1u == (gen + 1u) * nloc) {
            __builtin_amdgcn_fence(__ATOMIC_RELEASE, "agent");
            asm volatile("s_waitcnt vmcnt(0)" ::: "memory");
            const unsigned og = xb_add(&bar[XB_TOP], 1u);
            const unsigned tg = og / nx;
            if (og + 1u == (tg + 1u) * nx) xb_add(&bar[XB_TOPGEN], 1u);
            else XB_SPIN(xb_ld(&bar[XB_TOPGEN]) == tg, bar);
            __builtin_amdgcn_fence(__ATOMIC_ACQUIRE, "agent");
            xb_add(&bar[XB_XGEN(b.x)], 1u);
            asm volatile("s_waitcnt vmcnt(0)" ::: "memory");
        } else {
            XB_SPIN(xb_ld(&bar[XB_XGEN(b.x)]) == gen, bar);
            __builtin_amdgcn_fence(__ATOMIC_ACQUIRE, "agent");
            asm volatile("s_waitcnt vmcnt(0)" ::: "memory");
        }
    }
    __syncthreads();
}
constexpr size_t OFF_BAR = 131072;

#ifndef DBG
#define DBG 0
#endif
DEVI void dump_f32(const Params& p, size_t off) {
    const f32x4* src = (const f32x4*)(p.ws + off); f32x4* dst = (f32x4*)p.out;
    for (int i = blockIdx.x * 256 + threadIdx.x; i < T_ * D_ / 4; i += gridDim.x * 256) dst[i] = src[i];
}
DEVI void dump_bf16(const Params& p, size_t off, int ld, int coff) {
    const bf16_t* src = (const bf16_t*)(p.ws + off);
    for (int i = blockIdx.x * 256 + threadIdx.x; i < T_ * D_; i += gridDim.x * 256) { const int row = i >> 10, col = i & 1023; p.out[i] = bf2f(src[(size_t)row * ld + coff + col]); }
}
DEVI float flat_bf(const Params& p, size_t off, size_t n, size_t i) { const bf16_t* b = (const bf16_t*)(p.ws + off); float a = 0.f; for (size_t j = i; j < n; j += (size_t)T_ * D_) a += bf2f(b[j]); return a; }
DEVI void dump_p1(const Params& p) {
    const size_t N = (size_t)T_ * D_;
    for (size_t i = (size_t)blockIdx.x * 256 + threadIdx.x; i < N; i += (size_t)gridDim.x * 256) {
        float a = 0.f;
        a += flat_bf(p, OFF_MG, 2 * N, i) + flat_bf(p, OFF_GS, 2 * N, i);
        a += flat_bf(p, OFF_QR, N / 2, i % (N / 2)) + flat_bf(p, OFF_KR, N / 2, i % (N / 2)) + flat_bf(p, OFF_QG, N / 2, i % (N / 2));
        a += flat_bf(p, OFF_KRT, N / 2, i % (N / 2)) + flat_bf(p, OFF_KGT, N / 2, i % (N / 2));
        a += flat_bf(p, OFF_VRT, N, i) + flat_bf(p, OFF_VGT, N, i);
        a += ((const float*)(p.ws + OFF_GA))[i % ((size_t)T_ * 16)];
        p.out[i] = a;
    }
}
constexpr int NPHASE = 13;
__global__ void __launch_bounds__(512, 2) fwd_megakernel(Params p) {
    unsigned char* const smem_all = smem_all_g;
#define smem (smem_all_g + vh_fresh() * SMEM_HALF)
    uint4* xb_words = (uint4*)(smem_all + 2 * SMEM_HALF - 16);
    if (threadIdx.x == 0) *xb_words = make_uint4(0u, 0u, blockIdx.x, 0u);
    __syncthreads();
    const XcdBarrier xb = xcd_barrier_post((unsigned*)(p.ws + OFF_BAR), (volatile LAS unsigned*)xb_words);
#ifndef REPMASK
#define REPMASK 0
#endif
#ifndef TIMEPHASE
#define TIMEPHASE -1
#endif
#define RUN_PHASE(K, CALL) do { if (p.phase_lo <= (K) && (K) < p.phase_hi) { \
        const unsigned long long tp0_ = (TIMEPHASE == (K)) ? __builtin_amdgcn_s_memrealtime() : 0ull; \
        _Pragma("unroll 1") for (int rep_ = ((REPMASK >> (K)) & 1); rep_ >= 0; --rep_) { CALL; if (rep_ > 0 || (K) + 1 < p.phase_hi) xcd_barrier(xb); } \
        if (TIMEPHASE == (K)) { const unsigned long long tp1_ = __builtin_amdgcn_s_memrealtime(); while (__builtin_amdgcn_s_memrealtime() - tp1_ < tp1_ - tp0_) __builtin_amdgcn_s_sleep(8); } } } while (0)
    RUN_PHASE(0, phase0(p, smem));
    if (p.phase_lo == 0 && p.phase_hi > 1) {
        if (threadIdx.x == 0) {
            unsigned* bar = (unsigned*)(p.ws + OFF_BAR); bool ok = (gridDim.x & 7u) == 0u && xb.x < 8u;
            for (unsigned j = 0; j < 16; ++j) { const unsigned c = xb_ld(&bar[XB_XCNT(j)]); ok = ok && (j < 8 ? c == gridDim.x / 8u : c == 0u); }
            if (ok) ((volatile int*)xb_words)[2] = (int)(((volatile unsigned*)xb_words)[3] * 8u + xb.x);
        }
        __syncthreads();
    }
    RUN_PHASE(1, phase1(p, smem_all));
#if DBG == 2
    dump_p1(p); return;
#endif
    RUN_PHASE(2, phase2(p, smem));
#if DBG == 5
    { const size_t N = (size_t)T_ * D_; for (size_t i = (size_t)blockIdx.x * 256 + threadIdx.x; i < N; i += (size_t)gridDim.x * 256) p.out[i] = flat_bf(p, OFF_KG2, N / 2, i % (N / 2)) + ((const float*)(p.ws + OFF_DEC))[i % (2048 * 128)]; } return;
#endif
#ifdef SCANPROBE
    phase3t(p, smem, 1); xcd_barrier(xb);
#endif
    RUN_PHASE(3, phase3t(p, smem, 0));
#if DBG == 6
    dump_bf16(p, OFF_OO, 2048, 1024); return;
#endif
#if DBG == 7
    { const bf16_t* src = (const bf16_t*)(p.ws + OFF_OO);
      for (int i = blockIdx.x * 256 + threadIdx.x; i < T_ * D_; i += gridDim.x * 256) { const int row = i >> 10, col = i & 1023; const float v = bf2f(src[(size_t)row * 2048 + 1024 + col]); p.out[i] = (fabsf(v) < 1e30f) ? v : 12345.0f; } } return;
#endif
    RUN_PHASE(4, phase4(p, smem));
#if DBG == 3
    dump_bf16(p, OFF_Y, 2048, 0); return;
#endif
#if DBG == 4
    dump_bf16(p, OFF_Y, 2048, 1024); return;
#endif
    RUN_PHASE(5, phase5(p, smem_all));
    RUN_PHASE(6, phase6(p, smem_all));
    RUN_PHASE(7, (((RB >> 3) & 1) ? (phase8(p, smem_all), conv_expert_weights(p, smem)) : (conv_expert_weights(p, smem), phase8(p, smem_all))));
#if DBG == 1
    return;
#endif
    RUN_PHASE(10, phase10(p, smem_all));
    RUN_PHASE(11, phase11(p, smem_all));
    RUN_PHASE(12, phase12(p));
#ifdef BARPROBE
    _Pragma("unroll 1") for (int bp_ = 0; bp_ < 20; ++bp_) xcd_barrier(xb);
#endif
#undef RUN_PHASE
}

extern "C" void kernel_launch(void* const* d_in, const int* in_sizes, int n_in, void* d_out, int out_size, void* d_ws, size_t ws_size,
                              hipStream_t stream) {
    static int grid_blocks = 0;
    if (!grid_blocks) {
        int dev = 0, cus = 0, per_cu = 0;
        hipGetDevice(&dev);
        hipDeviceGetAttribute(&cus, hipDeviceAttributeMultiprocessorCount, dev);
        hipOccupancyMaxActiveBlocksPerMultiprocessor(&per_cu, fwd_megakernel, 512, 0);
        if (per_cu > 1) per_cu = 1;
        if (per_cu < 1) per_cu = 1;
        grid_blocks = cus * per_cu;
    }
    if (ws_size < WS_NEEDED) { fprintf(stderr, "workspace too small: %zu < %zu\n", ws_size, (size_t)WS_NEEDED); return; }
    Params p{};
    p.x = (const float*)d_in[0]; p.w_in = (const float*)d_in[1]; p.ret_norm_g = (const float*)d_in[2]; p.gate_w2 = (const float*)d_in[3];
    p.gate_b = (const float*)d_in[4]; p.gla_norm_g = (const float*)d_in[5]; p.w_ret_out = (const float*)d_in[6]; p.w_gla_out = (const float*)d_in[7];
    p.w_o = (const float*)d_in[8]; p.ln1_g = (const float*)d_in[9]; p.ln1_b = (const float*)d_in[10]; p.router_w = (const float*)d_in[11];
    p.router_bias = (const float*)d_in[12]; p.ew_gate = (const float*)d_in[13]; p.ew_up = (const float*)d_in[14]; p.ew_down = (const float*)d_in[15];
    p.sw_gate = (const float*)d_in[16]; p.sw_up = (const float*)d_in[17]; p.sw_down = (const float*)d_in[18]; p.ln2_g = (const float*)d_in[19];
    p.ln2_b = (const float*)d_in[20];
    p.out = (float*)d_out; p.ws = (unsigned char*)d_ws; p.phase_lo = 0; p.phase_hi = NPHASE;
    void* args[] = {&p};
    (void)hipMemsetAsync((unsigned char*)d_ws + OFF_BAR, 0, XCD_BAR_WORDS * 4, stream);
    hipError_t e = hipLaunchCooperativeKernel((void*)fwd_megakernel, dim3(grid_blocks), dim3(512), args, 0, stream);
    if (e != hipSuccess) fprintf(stderr, "cooperative launch failed: %s (grid %d)\n", hipGetErrorString(e), grid_blocks);
}
```

```cpp
#include <hip/hip_runtime.h>
#include <hip/hip_cooperative_groups.h>
#include <cstdio>
#include <cstdint>
namespace cg = cooperative_groups;

typedef unsigned short bf16_t;
typedef short bf16x8 __attribute__((ext_vector_type(8)));
typedef float f32x4 __attribute__((ext_vector_type(4)));
typedef unsigned u32x2 __attribute__((ext_vector_type(2)));
typedef unsigned u32x4 __attribute__((ext_vector_type(4)));
#define DEVI __device__ __forceinline__
#define VH ((int)(threadIdx.x >> 8))
#define VT ((int)(threadIdx.x & 255))
#define RB (__builtin_amdgcn_readfirstlane(((const int*)(smem_all_g + 2 * SMEM_HALF - 16))[2]))
#define RG ((int)gridDim.x)
#define VB (RB * 2 + VH)
#define VG (RG * 2)

constexpr int T_ = 32768;
constexpr int D_ = 1024;
constexpr int DIN_ = 8208;
constexpr int NE_ = 256;
constexpr float ALPHA_ = 1.189207115002721f;
constexpr float KSCALE_ = 0.08838834764831845f;

constexpr size_t MB = 1ull << 20;
constexpr size_t OFF_CNT  = (size_t)766 << 20;
constexpr int CNT_STRIDE = 1024;
constexpr size_t OFF_CS   = 1 * MB;
constexpr size_t OFF_WT   = 3 * MB;
constexpr size_t FB = 27 * MB;
constexpr size_t OFF_QR   = FB + 0 * MB;
constexpr size_t OFF_KR   = FB + 32 * MB;
constexpr size_t OFF_VRT  = FB + 64 * MB;
constexpr size_t OFF_GS   = FB + 128 * MB;
constexpr size_t OFF_MG   = FB + 256 * MB;
constexpr size_t OFF_KRT  = FB + 384 * MB;
constexpr size_t OFF_QG   = FB + 416 * MB;
constexpr size_t OFF_VGT  = FB + 448 * MB;
constexpr size_t OFF_KGT  = FB + 512 * MB;
constexpr size_t OFF_GA   = FB + 544 * MB;
constexpr size_t OFF_XB   = FB + 546 * MB;
constexpr size_t OFF_KG2  = FB + 546 * MB;
constexpr size_t OFF_DEC  = FB + 578 * MB;
constexpr size_t OFF_OO   = FB + 579 * MB;
constexpr size_t OFF_Y    = FB + 384 * MB;
constexpr size_t OFF_MRG  = FB + 0 * MB;
constexpr size_t OFF_QGN  = 767 * MB;
constexpr size_t OFF_QFR  = 734 * MB;
constexpr size_t OFF_WGU  = 767 * MB;
constexpr size_t OFF_X1B  = FB + 0 * MB;
constexpr size_t OFF_WD   = FB + 64 * MB;
constexpr size_t OFF_LIST = FB + 193 * MB;
constexpr size_t OFF_WL   = FB + 193 * MB + 512 * MB;
constexpr size_t OFF_H    = FB + 227 * MB;
constexpr size_t OFF_YX   = FB + 371 * MB;
constexpr size_t OFF_T1   = FB + 371 * MB;
constexpr size_t WS_NEEDED = 1024 * MB;

constexpr int WT_BN = 0, WT_AT = 5888, WT_RET = 8960, WT_GLA = 9984, WT_O = 11008, WT_R = 12032, WT_ROWS = 12288;

struct Params {
    const float *x, *w_in, *ret_norm_g, *gate_w2, *gate_b, *gla_norm_g, *w_ret_out, *w_gla_out, *w_o, *ln1_g, *ln1_b,
                *router_w, *router_bias, *ew_gate, *ew_up, *ew_down, *sw_gate, *sw_up, *sw_down, *ln2_g, *ln2_b;
    float* out;
    unsigned char* ws;
    int phase_lo, phase_hi;
};

static __device__ const float c_inv_freq[64] = {
  1.000000000e+00f, 8.659643531e-01f, 7.498942018e-01f, 6.493816376e-01f,
  5.623413324e-01f, 4.869675338e-01f, 4.216965139e-01f, 3.651741147e-01f,
  3.162277639e-01f, 2.738419771e-01f, 2.371373773e-01f, 2.053525001e-01f,
  1.778279394e-01f, 1.539926529e-01f, 1.333521456e-01f, 1.154781953e-01f,
  1.000000015e-01f, 8.659642935e-02f, 7.498942316e-02f, 6.493816525e-02f,
  5.623413250e-02f, 4.869675264e-02f, 4.216964915e-02f, 3.651741147e-02f,
  3.162277490e-02f, 2.738419548e-02f, 2.371373773e-02f, 2.053525113e-02f,
  1.778279431e-02f, 1.539926510e-02f, 1.333521400e-02f, 1.154781971e-02f,
  9.999999776e-03f, 8.659643121e-03f, 7.498942316e-03f, 6.493816152e-03f,
  5.623413250e-03f, 4.869675264e-03f, 4.216964822e-03f, 3.651741194e-03f,
  3.162277630e-03f, 2.738419687e-03f, 2.371373819e-03f, 2.053525066e-03f,
  1.778279431e-03f, 1.539926510e-03f, 1.333521446e-03f, 1.154782018e-03f,
  1.000000047e-03f, 8.659643354e-04f, 7.498941850e-04f, 6.493816036e-04f,
  5.623413017e-04f, 4.869675322e-04f, 4.216965172e-04f, 3.651741135e-04f,
  3.162277571e-04f, 2.738419571e-04f, 2.371373703e-04f, 2.053525095e-04f,
  1.778279402e-04f, 1.539926598e-04f, 1.333521504e-04f, 1.154782003e-04f };

DEVI float bf2f(unsigned short u) { return __uint_as_float(((unsigned)u) << 16); }
DEVI float bflo(unsigned u) { return __uint_as_float(u << 16); }
DEVI float bfhi(unsigned u) { return __uint_as_float(u & 0xffff0000u); }
typedef float f32x2 __attribute__((ext_vector_type(2)));
typedef __bf16 bf16x2_t __attribute__((ext_vector_type(2)));
DEVI unsigned pk2(float lo, float hi) { const f32x2 v = {lo, hi}; const bf16x2_t b = __builtin_convertvector(v, bf16x2_t); return __builtin_bit_cast(unsigned, b); }
DEVI unsigned short f2bf(float f) { return (unsigned short)(pk2(f, 0.f) & 0xffffu); }
DEVI u32x2 pk4(f32x4 v) { u32x2 r; r.x = pk2(v[0], v[1]); r.y = pk2(v[2], v[3]); return r; }
DEVI f32x4 unpk4(u32x2 u) { f32x4 r; r[0] = bflo(u.x); r[1] = bfhi(u.x); r[2] = bflo(u.y); r[3] = bfhi(u.y); return r; }
constexpr float YX_SCALE = 16.0f;
DEVI unsigned pk4_fp8(f32x4 v) { int w = 0; w = __builtin_amdgcn_cvt_pk_fp8_f32(v[0], v[1], w, false); w = __builtin_amdgcn_cvt_pk_fp8_f32(v[2], v[3], w, true); return (unsigned)w; }
DEVI f32x4 unpk4_fp8(unsigned u) { f32x4 r; r[0] = __builtin_amdgcn_cvt_f32_fp8((int)u, 0); r[1] = __builtin_amdgcn_cvt_f32_fp8((int)u, 1); r[2] = __builtin_amdgcn_cvt_f32_fp8((int)u, 2); r[3] = __builtin_amdgcn_cvt_f32_fp8((int)u, 3); return r; }
DEVI f32x4 clamp4(f32x4 v, float lim) { f32x4 r; for (int i = 0; i < 4; ++i) r[i] = __builtin_amdgcn_fmed3f(v[i], -lim, lim); return r; }
DEVI float sigmoidf_(float v) { return __builtin_amdgcn_rcpf(1.0f + __builtin_amdgcn_exp2f(v * -1.4426950408889634f)); }
DEVI float siluf_(float v) { return v * __builtin_amdgcn_rcpf(1.0f + __builtin_amdgcn_exp2f(v * -1.4426950408889634f)); }
DEVI float gamma_log2(int h) { return log2f(1.0f - exp2f(-5.0f - (float)h)); }
DEVI f32x4 mfma16(bf16x8 a, bf16x8 b, f32x4 c) { return __builtin_amdgcn_mfma_f32_16x16x32_bf16(a, b, c, 0, 0, 0); }
DEVI unsigned kf_off(int item, int dk, int m8) { return ((((unsigned)item * 4u + (unsigned)(dk >> 5)) * 4u + (unsigned)(m8 >> 4)) * 64u + (unsigned)((m8 >> 3) & 1) * 32u + (unsigned)(dk & 31)) * 8u; }
DEVI unsigned vf_off(int item, int dv, int m8) { return ((((unsigned)item * 8u + (unsigned)(dv >> 5)) * 4u + (unsigned)(m8 >> 4)) * 64u + (unsigned)((m8 >> 3) & 1) * 32u + (unsigned)(dv & 31)) * 8u; }
DEVI unsigned qf_off(int bc, int h, int tokl, int dk8, int hh) {
    return ((((((unsigned)bc * 4u + (unsigned)h) * 2u + (unsigned)(tokl >> 5)) * 4u + (unsigned)(dk8 >> 5)) * 2u + (unsigned)((dk8 >> 4) & 1)) * 64u + (unsigned)hh * 32u + (unsigned)(tokl & 31)) * 8u + (unsigned)((dk8 >> 3) & 1) * 4u; }
DEVI int vperm(int n) { const int wc = n >> 6, nt = (n >> 4) & 3, i = n & 15; return wc * 64 + (nt >> 1) * 32 + 8 * (i >> 2) + 4 * (nt & 1) + (i & 3); }
DEVI int dperm2(int v) { return ((v >> 5) & 1) * 64 + (v >> 6) * 32 + (v & 31); }
DEVI u32x4 pk8(f32x4 a, f32x4 b) { u32x4 r; r.x = pk2(a[0], a[1]); r.y = pk2(a[2], a[3]); r.z = pk2(b[0], b[1]); r.w = pk2(b[2], b[3]); return r; }
DEVI void unpk8(u32x4 u, f32x4& a, f32x4& b) { a[0] = bflo(u.x); a[1] = bfhi(u.x); a[2] = bflo(u.y); a[3] = bfhi(u.y); b[0] = bflo(u.z); b[1] = bfhi(u.z); b[2] = bflo(u.w); b[3] = bfhi(u.w); }
DEVI int dperm(int v) { const int wc = v >> 6, nt = (v >> 4) & 3, c = v & 15; return (nt & 1) * 16 + wc * 32 + c + (nt >> 1) * 64; }

struct __attribute__((aligned(16))) GemmSmem { bf16_t a[2][128 * 64]; bf16_t b[2][128 * 64]; };
constexpr int SMEM_GEMM = sizeof(GemmSmem);
constexpr int SMEM_BYTES = SMEM_GEMM + 2048 + 16;
constexpr int SMEM_HALF = (SMEM_BYTES + 255) & ~255;
constexpr int SMEM_MOE = 163840 - 2 * SMEM_HALF;
__shared__ __attribute__((aligned(16))) unsigned char smem_all_g[2 * SMEM_HALF + SMEM_MOE];
DEVI int gemm_src_chunk(int t) { return ((t & 7) ^ ((t >> 4) & 7)) * 8; }

template <bool SWAP, int BKIND>
DEVI void gemm_kloop(f32x4 (&acc)[4][4], const bf16_t* const (&pa)[4], const bf16_t* const (&pb)[4],
                     const float* pbf, int ldb, int nk, GemmSmem& sm) {
    const int t = VT, lane = t & 63, w = t >> 6, wr = w >> 1, wc = w & 1, l15 = lane & 15, q = lane >> 4;
    const int kg = t & 7, ng = t >> 3;
    f32x4 rf[8];
#define GEMM_ISSUE(BUF, KO) do { \
        _Pragma("unroll") for (int i = 0; i < 4; ++i) \
            __builtin_amdgcn_global_load_lds((const unsigned*)(pa[i] + (KO)), (unsigned*)((char*)sm.a[BUF] + i * 4096 + t * 16), 16, 0, 0); \
        if (BKIND == 0) { _Pragma("unroll") for (int i = 0; i < 4; ++i) \
            __builtin_amdgcn_global_load_lds((const unsigned*)(pb[i] + (KO)), (unsigned*)((char*)sm.b[BUF] + i * 4096 + t * 16), 16, 0, 0); } \
        else { const float* pp = pbf + (size_t)((KO) + 4 * kg) * ldb; \
            _Pragma("unroll") for (int i = 0; i < 4; ++i) { rf[i] = *(const f32x4*)(pp + (size_t)i * ldb); rf[4 + i] = *(const f32x4*)(pp + (size_t)(32 + i) * ldb); } } } while (0)
#define GEMM_LSTORE_B(BUF) do { if (BKIND == 1) { \
            _Pragma("unroll") for (int i = 0; i < 4; ++i) { \
                u32x2 v0, v1; \
                v0.x = pk2(rf[0][i], rf[1][i]); v0.y = pk2(rf[2][i], rf[3][i]); v1.x = pk2(rf[4][i], rf[5][i]); v1.y = pk2(rf[6][i], rf[7][i]); \
                const int n = 4 * ng + i, sw = (n >> 1) & 7; \
                char* rowp = (char*)sm.b[BUF] + n * 128 + (kg & 1) * 8; \
                *(u32x2*)(rowp + (((kg >> 1) ^ sw) * 16)) = v0; *(u32x2*)(rowp + (((4 + (kg >> 1)) ^ sw) * 16)) = v1; } } } while (0)
    GEMM_ISSUE(0, 0);
    GEMM_LSTORE_B(0);
    __syncthreads();
#define GEMM_KSTEP(CUR, KT) do { \
        const bool more = ((KT) + 1 < nk); \
        if (more) { GEMM_ISSUE((CUR) ^ 1, ((KT) + 1) * 64); } \
        __builtin_amdgcn_sched_barrier(0); \
        _Pragma("unroll") for (int ss = 0; ss < 2; ++ss) { \
            bf16x8 af[4], bfr[4]; \
            const int coff = ((ss * 4 + q) ^ (l15 >> 1)) * 16; \
            _Pragma("unroll") for (int i = 0; i < 4; ++i) { \
                af[i]  = *(const bf16x8*)((const char*)sm.a[CUR] + (wr * 64 + i * 16 + l15) * 128 + coff); \
                bfr[i] = *(const bf16x8*)((const char*)sm.b[CUR] + (wc * 64 + i * 16 + l15) * 128 + coff); } \
            _Pragma("unroll") for (int mt = 0; mt < 4; ++mt) \
                _Pragma("unroll") for (int nt = 0; nt < 4; ++nt) \
                    acc[mt][nt] = SWAP ? mfma16(bfr[nt], af[mt], acc[mt][nt]) : mfma16(af[mt], bfr[nt], acc[mt][nt]); } \
        __builtin_amdgcn_sched_barrier(0); \
        if (more) { GEMM_LSTORE_B((CUR) ^ 1); } \
        __syncthreads(); } while (0)
#pragma unroll 1
    for (int kt = 0; kt < nk; kt += 2) { GEMM_KSTEP(0, kt); GEMM_KSTEP(1, kt + 1); }
#undef GEMM_KSTEP
#undef GEMM_LSTORE_B
#undef GEMM_ISSUE
}

DEVI void zero_acc(f32x4 (&acc)[4][4]) {
#pragma unroll
    for (int i = 0; i < 4; ++i)
#pragma unroll
        for (int j = 0; j < 4; ++j) acc[i][j] = (f32x4){0.f, 0.f, 0.f, 0.f};
}

namespace pg8 {
#define PG8_LAS __attribute__((address_space(3)))
typedef unsigned short bf16_t;
typedef short bf16x8 __attribute__((ext_vector_type(8)));
typedef float f32x4 __attribute__((ext_vector_type(4)));
typedef unsigned u32x4 __attribute__((ext_vector_type(4)));
constexpr int BM = 256, BK = 64, HALF = 128, HTB = HALF * BK * 2  , STAGE_BYTES = 8 * HTB, NXCD = 8, WGM = 8;

__host__ __device__ __forceinline__ int lds_byte(int r, int c) { const int st = (r >> 4) * 2 + (c >> 5), rr = r & 15, cc = c & 31, ob = rr * 64 + cc * 2; return st * 1024 + (ob ^ (((ob >> 9) & 1) << 5)); }
__host__ __device__ __forceinline__ void stage_rc(int b, int& R, int& C) { const int st = b / 1024, sb = b % 1024, swz = sb ^ (((sb >> 9) & 1) << 5); R = (st >> 1) * 16 + swz / 64; C = (st & 1) * 32 + (swz % 64) / 2; }
__host__ __device__ __forceinline__ int perm32(int rho) { const int n = rho >> 4, i = rho & 15; return 8 * (i >> 2) + 4 * n + (i & 3); }

struct Unit { int pm, pn, e, r0, ce; };
struct Gemm { const bf16_t* A; const bf16_t* Bt; int M, N, K; };

struct StaticOrder {
    int nM, nN, nwg, G, c;
    __host__ __device__ void init(int M, int N, int G_, int c_) { nM = M / BM; nN = N / BM; nwg = nM * nN; G = G_; c = c_; }
    __host__ __device__ bool next(int i, Unit& u) const {
        const long L = (long)i * G + c; if (L >= nwg) return false;
        int wgid = (int)L; { const int q = nwg / NXCD, r = nwg % NXCD, xcd = wgid % NXCD, off = wgid / NXCD; wgid = (xcd < r ? xcd * (q + 1) : r * (q + 1) + (xcd - r) * q) + off; }
        const int nig = WGM * nN, gid = wgid / nig, fm = gid * WGM, gsz = (nM - fm) < WGM ? (nM - fm) : WGM;
        u.pm = fm + ((wgid % nig) % gsz); u.pn = (wgid % nig) / gsz; return true;
    }
    __device__ __forceinline__ void a_ready(const Unit&) const {}
    __device__ __forceinline__ void done(const Unit&) const {}
};


template <class Epi, class Sched, bool ALIGN_EPI = false, bool SP2 = false>
__device__ __forceinline__ void gemm_phase(PG8_LAS unsigned char* lds, const Gemm g, const Sched& S, const Epi& E) {
    const int tid = threadIdx.x, wid = __builtin_amdgcn_readfirstlane(tid >> 6), lane = tid & 63, wr = wid >> 2, wc = wid & 3, fr = lane & 15, fq = lane >> 4;
    const int K = g.K, nt = K / BK;
    unsigned voffA[2], voffB[2];
#pragma unroll
    for (int i = 0; i < 2; ++i) { int R, C; stage_rc(tid * 16 + i * 8192, R, C); const int Rb = Epi::PERM ? ((R & ~31) + perm32(R & 31)) : R;
        voffA[i] = (unsigned)(R * K + C) * 2u; voffB[i] = (unsigned)(Rb * K + C) * 2u; }
    const size_t kstep = (size_t)(BK * 2);
    const size_t hstep = (size_t)HALF * K * 2;
    const size_t tstep = 2 * hstep;
    const unsigned ldsw = (unsigned)wid * 1024u;
    const int aoff = lds_byte(wr * 64 + fr, fq * 8), boff = lds_byte(wc * 32 + fr, fq * 8);
#define PG8_SA(b, h) (((b) * 2 + (h)) * HTB)
#define PG8_SB(b, h) ((4 + (b) * 2 + (h)) * HTB)
#define PG8_STAGE(bufoff, gbase, voff) do { _Pragma("unroll") for (int _i = 0; _i < 2; ++_i) \
        __builtin_amdgcn_global_load_lds((const unsigned*)((const char*)(gbase) + (voff)[_i]), (PG8_LAS unsigned*)(lds + (bufoff) + ldsw + _i * 8192), 16, 0, 0); } while (0)
#define PG8_LDA(dst, b, h) do { _Pragma("unroll") for (int m = 0; m < 4; ++m) _Pragma("unroll") for (int k = 0; k < 2; ++k) dst[m][k] = *(const PG8_LAS bf16x8*)(lds + PG8_SA(b, h) + aoff + m * 2048 + k * 1024); } while (0)
#define PG8_LDB(dst, b, h) do { _Pragma("unroll") for (int n = 0; n < 2; ++n) _Pragma("unroll") for (int k = 0; k < 2; ++k) dst[n][k] = *(const PG8_LAS bf16x8*)(lds + PG8_SB(b, h) + boff + n * 2048 + k * 1024); } while (0)
#define PG8_MMA(ai, bj, At, Bt) do { __builtin_amdgcn_s_setprio(1); _Pragma("unroll") for (int m = 0; m < 4; ++m) _Pragma("unroll") for (int n = 0; n < 2; ++n) _Pragma("unroll") for (int k = 0; k < 2; ++k) \
        acc[ai][bj][m][n] = __builtin_amdgcn_mfma_f32_16x16x32_bf16(Bt[n][k], At[m][k], acc[ai][bj][m][n], 0, 0, 0); __builtin_amdgcn_s_setprio(0); } while (0)
#define PG8_WAIT_V(n) asm volatile("s_waitcnt vmcnt(" #n ")" ::: "memory")
#define PG8_WAIT_L(n) asm volatile("s_waitcnt lgkmcnt(" #n ")" ::: "memory")
#define PG8_BAR __builtin_amdgcn_s_barrier()
#define PG8_SCHED __builtin_amdgcn_sched_barrier(0)
    Unit cur, nxt; int ui = 0;
    if (!S.next(0, cur)) return;
    f32x4 acc[2][2][4][2];
#pragma unroll
    for (int a = 0; a < 2; ++a)
#pragma unroll
        for (int b = 0; b < 2; ++b)
#pragma unroll
            for (int m = 0; m < 4; ++m)
#pragma unroll
                for (int n = 0; n < 2; ++n) acc[a][b][m][n] = (f32x4){0.f, 0.f, 0.f, 0.f};
    bf16x8 At[4][2], B0[2][2], B1[2][2];
    const char* cA = (const char*)g.A + (size_t)cur.pm * tstep; const char* cB = (const char*)g.Bt + (size_t)cur.pn * tstep;
    S.a_ready(cur);
    if constexpr (SP2) {
        PG8_STAGE(PG8_SB(0, 0), cB, voffB); PG8_STAGE(PG8_SB(0, 1), cB + hstep, voffB); PG8_STAGE(PG8_SA(0, 0), cA, voffA); PG8_STAGE(PG8_SA(0, 1), cA + hstep, voffA);
        if (wr == 1) PG8_BAR;
        PG8_WAIT_V(2); PG8_BAR;
        PG8_STAGE(PG8_SB(1, 0), cB + kstep, voffB); PG8_STAGE(PG8_SA(1, 0), cA + kstep, voffA); PG8_STAGE(PG8_SB(1, 1), cB + hstep + kstep, voffB);
        PG8_WAIT_V(6); PG8_BAR;
    } else {
        PG8_STAGE(PG8_SB(0, 0), cB, voffB); PG8_STAGE(PG8_SA(0, 0), cA, voffA); PG8_STAGE(PG8_SB(0, 1), cB + hstep, voffB); PG8_STAGE(PG8_SA(0, 1), cA + hstep, voffA);
        if (wr == 1) PG8_BAR;
        PG8_WAIT_V(4); PG8_BAR;
        PG8_STAGE(PG8_SB(1, 0), cB + kstep, voffB); PG8_STAGE(PG8_SA(1, 0), cA + kstep, voffA); PG8_STAGE(PG8_SB(1, 1), cB + hstep + kstep, voffB);
        PG8_WAIT_V(6); PG8_BAR;
    }
    for (;;) {
        const bool has_next = S.next(ui + 1, nxt);
        const char* nA = has_next ? (const char*)g.A + (size_t)nxt.pm * tstep : cA; const char* nB = has_next ? (const char*)g.Bt + (size_t)nxt.pn * tstep : cB;
        for (int t = 0; t < nt; t += 2) {
            const bool last = (t == nt - 2);
            const char* a1 = cA + (size_t)(t + 1) * kstep;
            const char* a2 = last ? nA : cA + (size_t)(t + 2) * kstep; const char* b2 = last ? nB : cB + (size_t)(t + 2) * kstep;
            const char* a3 = a2 + kstep; const char* b3 = b2 + kstep;
            if (last && has_next) S.a_ready(nxt);
            if constexpr (SP2) {
            PG8_LDB(B0, 0, 0); PG8_LDB(B1, 0, 1); PG8_SCHED; PG8_LDA(At, 0, 0); PG8_STAGE(PG8_SA(1, 1), a1 + hstep, voffA);
            PG8_WAIT_V(8); PG8_WAIT_L(0); PG8_BAR; PG8_MMA(0, 0, At, B0); PG8_MMA(0, 1, At, B1); PG8_BAR; PG8_SCHED;
            PG8_LDA(At, 0, 1); PG8_STAGE(PG8_SB(0, 0), b2, voffB); PG8_STAGE(PG8_SB(0, 1), b2 + hstep, voffB); PG8_STAGE(PG8_SA(0, 0), a2, voffA);
            PG8_WAIT_V(8); PG8_WAIT_L(0); PG8_BAR; PG8_MMA(1, 0, At, B0); PG8_MMA(1, 1, At, B1); PG8_BAR; PG8_SCHED;
            PG8_LDB(B0, 1, 0); PG8_LDB(B1, 1, 1); PG8_SCHED; PG8_LDA(At, 1, 0); PG8_STAGE(PG8_SA(0, 1), a2 + hstep, voffA);
            PG8_WAIT_V(8); PG8_WAIT_L(0); PG8_BAR; PG8_MMA(0, 0, At, B0); PG8_MMA(0, 1, At, B1); PG8_BAR; PG8_SCHED;
            PG8_LDA(At, 1, 1); PG8_STAGE(PG8_SB(1, 0), b3, voffB); PG8_STAGE(PG8_SB(1, 1), b3 + hstep, voffB); PG8_STAGE(PG8_SA(1, 0), a3, voffA);
            PG8_WAIT_V(8); PG8_WAIT_L(0); PG8_BAR; PG8_MMA(1, 0, At, B0); PG8_MMA(1, 1, At, B1); PG8_BAR; PG8_SCHED;
            } else {
            PG8_LDB(B0, 0, 0); PG8_SCHED; PG8_LDA(At, 0, 0); PG8_STAGE(PG8_SA(1, 1), a1 + hstep, voffA);
            PG8_WAIT_L(8); PG8_BAR; PG8_WAIT_L(0); PG8_MMA(0, 0, At, B0); PG8_BAR; PG8_SCHED;
            PG8_LDB(B1, 0, 1); PG8_STAGE(PG8_SB(0, 0), b2, voffB);
            PG8_BAR; PG8_WAIT_L(0); PG8_MMA(0, 1, At, B1); PG8_BAR;
            PG8_LDA(At, 0, 1); PG8_STAGE(PG8_SA(0, 0), a2, voffA);
            PG8_BAR; PG8_WAIT_L(0); PG8_MMA(1, 0, At, B0); PG8_BAR; PG8_SCHED;
            PG8_STAGE(PG8_SB(0, 1), b2 + hstep, voffB);
            PG8_WAIT_V(6); PG8_BAR; PG8_MMA(1, 1, At, B1); PG8_BAR;
            PG8_LDB(B0, 1, 0); PG8_SCHED; PG8_LDA(At, 1, 0); PG8_STAGE(PG8_SA(0, 1), a2 + hstep, voffA);
            PG8_WAIT_L(8); PG8_BAR; PG8_WAIT_L(0); PG8_MMA(0, 0, At, B0); PG8_BAR; PG8_SCHED;
            PG8_LDB(B1, 1, 1); PG8_STAGE(PG8_SB(1, 0), b3, voffB);
            PG8_BAR; PG8_WAIT_L(0); PG8_MMA(0, 1, At, B1); PG8_BAR;
            PG8_LDA(At, 1, 1); PG8_STAGE(PG8_SA(1, 0), a3, voffA);
            PG8_BAR; PG8_WAIT_L(0); PG8_MMA(1, 0, At, B0); PG8_BAR; PG8_SCHED;
            PG8_STAGE(PG8_SB(1, 1), b3 + hstep, voffB);
            PG8_WAIT_V(6); PG8_BAR; PG8_MMA(1, 1, At, B1); PG8_BAR;
            }
        }
        if constexpr (ALIGN_EPI) { if (wr == 0) PG8_BAR; }
        if constexpr (!Epi::AFTER_DRAIN) { E(acc, cur, wr, wc, fr, fq); S.done(cur); }
        if (!has_next) break;
#pragma unroll
        for (int a = 0; a < 2; ++a)
#pragma unroll
            for (int b = 0; b < 2; ++b)
#pragma unroll
                for (int m = 0; m < 4; ++m)
#pragma unroll
                    for (int n = 0; n < 2; ++n) acc[a][b][m][n] = (f32x4){0.f, 0.f, 0.f, 0.f};
        cur = nxt; cA = nA; cB = nB; ++ui;
        if constexpr (ALIGN_EPI) { if (wr == 1) PG8_BAR; }
    }
    PG8_WAIT_V(0);
    if constexpr (!ALIGN_EPI) { if (wr == 0) PG8_BAR; }
    PG8_BAR;
    if constexpr (Epi::AFTER_DRAIN) { E.fused(acc, cur, wr, wc, fr, fq, lds, wid, lane); S.done(cur); }
#undef PG8_SA
#undef PG8_SB
#undef PG8_STAGE
#undef PG8_LDA
#undef PG8_LDB
#undef PG8_MMA
#undef PG8_WAIT_V
#undef PG8_WAIT_L
#undef PG8_BAR
#undef PG8_SCHED
}
template <class Epi, class Sched, bool ALIGN_EPI = false, bool SP2 = false>
__device__ __forceinline__ void gemm_phase_g(PG8_LAS unsigned char* lds, const int K, const Sched& S, const Epi& E) {
    const int tid = threadIdx.x, wid = __builtin_amdgcn_readfirstlane(tid >> 6), lane = tid & 63, wr = wid >> 2, wc = wid & 3, fr = lane & 15, fq = lane >> 4;
    const int nt = K / BK;
    unsigned voffB[2]; int rowA[2], colA[2];
#pragma unroll
    for (int i = 0; i < 2; ++i) { int R, C; stage_rc(tid * 16 + i * 8192, R, C); const int lc = perm32(R & 31);
        const int Rb = Epi::BJI ? (64 * (R >> 5) + 16 * (lc >> 3) + (lc & 7)) : (Epi::PERM ? ((R & ~31) + lc) : R);
        rowA[i] = R; colA[i] = C * 2; voffB[i] = (unsigned)(Rb * K + C) * 2u; }
    const size_t kstep = (size_t)(BK * 2);
    const size_t hstep = Epi::BJI ? (size_t)8 * K * 2 : (size_t)HALF * K * 2;
    const size_t tstep = 2 * hstep;
    const unsigned ldsw = (unsigned)wid * 1024u;
    const int aoff = lds_byte(wr * 64 + fr, fq * 8), boff = lds_byte(wc * 32 + fr, fq * 8);
#define PG8_SA(b, h) (((b) * 2 + (h)) * HTB)
#define PG8_SB(b, h) ((4 + (b) * 2 + (h)) * HTB)
#define PG8_STAGE(bufoff, gbase, voff) do { _Pragma("unroll") for (int _i = 0; _i < 2; ++_i) \
        __builtin_amdgcn_global_load_lds((const unsigned*)((const char*)(gbase) + (voff)[_i]), (PG8_LAS unsigned*)(lds + (bufoff) + ldsw + _i * 8192), 16, 0, 0); } while (0)
#define PG8_STAGEA(bufoff, P0, P1, koff) do { \
        __builtin_amdgcn_global_load_lds((const unsigned*)(Ab + (size_t)(P0) + (koff)), (PG8_LAS unsigned*)(lds + (bufoff) + ldsw), 16, 0, 0); \
        __builtin_amdgcn_global_load_lds((const unsigned*)(Ab + (size_t)(P1) + (koff)), (PG8_LAS unsigned*)(lds + (bufoff) + ldsw + 8192), 16, 0, 0); } while (0)
#define PG8_LDA(dst, b, h) do { _Pragma("unroll") for (int m = 0; m < 4; ++m) _Pragma("unroll") for (int k = 0; k < 2; ++k) dst[m][k] = *(const PG8_LAS bf16x8*)(lds + PG8_SA(b, h) + aoff + m * 2048 + k * 1024); } while (0)
#define PG8_LDB(dst, b, h) do { _Pragma("unroll") for (int n = 0; n < 2; ++n) _Pragma("unroll") for (int k = 0; k < 2; ++k) dst[n][k] = *(const PG8_LAS bf16x8*)(lds + PG8_SB(b, h) + boff + n * 2048 + k * 1024); } while (0)
#define PG8_MMA(ai, bj, At, Bt) do { __builtin_amdgcn_s_setprio(1); _Pragma("unroll") for (int m = 0; m < 4; ++m) _Pragma("unroll") for (int n = 0; n < 2; ++n) _Pragma("unroll") for (int k = 0; k < 2; ++k) \
        acc[ai][bj][m][n] = __builtin_amdgcn_mfma_f32_16x16x32_bf16(Bt[n][k], At[m][k], acc[ai][bj][m][n], 0, 0, 0); __builtin_amdgcn_s_setprio(0); } while (0)
#define PG8_WAIT_V(n) asm volatile("s_waitcnt vmcnt(" #n ")" ::: "memory")
#define PG8_WAIT_L(n) asm volatile("s_waitcnt lgkmcnt(" #n ")" ::: "memory")
#define PG8_BAR __builtin_amdgcn_s_barrier()
#define PG8_SCHED __builtin_amdgcn_sched_barrier(0)
    Unit cur, nxt, un2; int ui = 0, sb_cur = 0;
    if (!S.next(0, cur)) return;
    int fillv = S.fill_issue(cur); S.fill_write(0, fillv);
    __syncthreads();
    bool has_next = S.next(1, nxt);
    fillv = 0; if (has_next) fillv = S.fill_issue(nxt);
    f32x4 acc[2][2][4][2];
#pragma unroll
    for (int a = 0; a < 2; ++a)
#pragma unroll
        for (int b = 0; b < 2; ++b)
#pragma unroll
            for (int m = 0; m < 4; ++m)
#pragma unroll
                for (int n = 0; n < 2; ++n) acc[a][b][m][n] = (f32x4){0.f, 0.f, 0.f, 0.f};
    bf16x8 At[4][2], B0[2][2], B1[2][2];
    const char* cB = S.b_base(cur);
    unsigned cA00, cA01, cA10, cA11, nA00, nA01, nA10, nA11;
    const char* const Ab = S.a_base();
    S.a_rows(0, rowA, colA, cA00, cA01, cA10, cA11);
    S.a_ready(cur);
    if constexpr (SP2) {
        PG8_STAGE(PG8_SB(0, 0), cB, voffB); PG8_STAGE(PG8_SB(0, 1), cB + hstep, voffB); PG8_STAGEA(PG8_SA(0, 0), cA00, cA01, 0); PG8_STAGEA(PG8_SA(0, 1), cA10, cA11, 0);
        if (wr == 1) PG8_BAR;
        PG8_WAIT_V(2); PG8_BAR;
        PG8_STAGE(PG8_SB(1, 0), cB + kstep, voffB); PG8_STAGEA(PG8_SA(1, 0), cA00, cA01, kstep); PG8_STAGE(PG8_SB(1, 1), cB + hstep + kstep, voffB);
        PG8_WAIT_V(6); PG8_BAR;
    } else {
        PG8_STAGE(PG8_SB(0, 0), cB, voffB); PG8_STAGEA(PG8_SA(0, 0), cA00, cA01, 0); PG8_STAGE(PG8_SB(0, 1), cB + hstep, voffB); PG8_STAGEA(PG8_SA(0, 1), cA10, cA11, 0);
        if (wr == 1) PG8_BAR;
        PG8_WAIT_V(4); PG8_BAR;
        PG8_STAGE(PG8_SB(1, 0), cB + kstep, voffB); PG8_STAGEA(PG8_SA(1, 0), cA00, cA01, kstep); PG8_STAGE(PG8_SB(1, 1), cB + hstep + kstep, voffB);
        PG8_WAIT_V(6); PG8_BAR;
    }
    for (;;) {
        const char* nB = has_next ? S.b_base(nxt) : cB;
        const int sb_n = sb_cur == 2 ? 0 : sb_cur + 1;
        bool has2 = false;
        if (has_next) { S.fill_write(sb_n, fillv); has2 = S.next(ui + 2, un2); if (has2) fillv = S.fill_issue(un2); }
        nA00 = cA00; nA01 = cA01; nA10 = cA10; nA11 = cA11;
#pragma unroll 1
        for (int t = 0; t < nt; t += 2) {
            const bool last = (t == nt - 2);
            const size_t k1 = (size_t)(t + 1) * kstep;
            const size_t k2 = last ? 0 : (size_t)(t + 2) * kstep; const char* b2 = last ? nB : cB + (size_t)(t + 2) * kstep;
            const unsigned q00 = last ? nA00 : cA00, q01 = last ? nA01 : cA01, q10 = last ? nA10 : cA10, q11 = last ? nA11 : cA11;
            const size_t k3 = k2 + kstep; const char* b3 = b2 + kstep;
            if (last && has_next) S.a_ready(nxt);
            if constexpr (SP2) {
            PG8_LDB(B0, 0, 0); PG8_LDB(B1, 0, 1); PG8_SCHED; PG8_LDA(At, 0, 0); PG8_STAGEA(PG8_SA(1, 1), cA10, cA11, k1);
            PG8_WAIT_V(8); PG8_WAIT_L(0); PG8_BAR; PG8_MMA(0, 0, At, B0); PG8_MMA(0, 1, At, B1); PG8_BAR; PG8_SCHED;
            PG8_LDA(At, 0, 1); PG8_STAGE(PG8_SB(0, 0), b2, voffB); PG8_STAGE(PG8_SB(0, 1), b2 + hstep, voffB); PG8_STAGEA(PG8_SA(0, 0), q00, q01, k2);
            PG8_WAIT_V(8); PG8_WAIT_L(0); PG8_BAR; PG8_MMA(1, 0, At, B0); PG8_MMA(1, 1, At, B1); PG8_BAR; PG8_SCHED;
            PG8_LDB(B0, 1, 0); PG8_LDB(B1, 1, 1); PG8_SCHED; PG8_LDA(At, 1, 0); PG8_STAGEA(PG8_SA(0, 1), q10, q11, k2);
            PG8_WAIT_V(8); PG8_WAIT_L(0); PG8_BAR; PG8_MMA(0, 0, At, B0); PG8_MMA(0, 1, At, B1); PG8_BAR; PG8_SCHED;
            PG8_LDA(At, 1, 1); PG8_STAGE(PG8_SB(1, 0), b3, voffB); PG8_STAGE(PG8_SB(1, 1), b3 + hstep, voffB); PG8_STAGEA(PG8_SA(1, 0), q00, q01, k3);
            PG8_WAIT_V(8); PG8_WAIT_L(0); PG8_BAR; PG8_MMA(1, 0, At, B0); PG8_MMA(1, 1, At, B1); PG8_BAR; PG8_SCHED;
            } else {
            PG8_LDB(B0, 0, 0); PG8_SCHED; PG8_LDA(At, 0, 0); PG8_STAGEA(PG8_SA(1, 1), cA10, cA11, k1);
            PG8_WAIT_L(8); PG8_BAR; PG8_WAIT_L(0); PG8_MMA(0, 0, At, B0); PG8_BAR; PG8_SCHED;
            PG8_LDB(B1, 0, 1); PG8_STAGE(PG8_SB(0, 0), b2, voffB);
            PG8_BAR; PG8_WAIT_L(0); PG8_MMA(0, 1, At, B1); PG8_BAR;
            PG8_LDA(At, 0, 1); PG8_STAGEA(PG8_SA(0, 0), q00, q01, k2);
            PG8_BAR; PG8_WAIT_L(0); PG8_MMA(1, 0, At, B0); PG8_BAR; PG8_SCHED;
            PG8_STAGE(PG8_SB(0, 1), b2 + hstep, voffB);
            PG8_WAIT_V(6); PG8_BAR; PG8_MMA(1, 1, At, B1); PG8_BAR;
            PG8_LDB(B0, 1, 0); PG8_SCHED; PG8_LDA(At, 1, 0); PG8_STAGEA(PG8_SA(0, 1), q10, q11, k2);
            PG8_WAIT_L(8); PG8_BAR; PG8_WAIT_L(0); PG8_MMA(0, 0, At, B0); PG8_BAR; PG8_SCHED;
            PG8_LDB(B1, 1, 1); PG8_STAGE(PG8_SB(1, 0), b3, voffB);
            PG8_BAR; PG8_WAIT_L(0); PG8_MMA(0, 1, At, B1); PG8_BAR;
            PG8_LDA(At, 1, 1); PG8_STAGEA(PG8_SA(1, 0), q00, q01, k3);
            PG8_BAR; PG8_WAIT_L(0); PG8_MMA(1, 0, At, B0); PG8_BAR; PG8_SCHED;
            PG8_STAGE(PG8_SB(1, 1), b3 + hstep, voffB);
            PG8_WAIT_V(6); PG8_BAR; PG8_MMA(1, 1, At, B1); PG8_BAR;
            }
            if (t == nt - 4 && has_next) S.a_rows(sb_n, rowA, colA, nA00, nA01, nA10, nA11);
        }
        if constexpr (ALIGN_EPI) { if (wr == 0) PG8_BAR; }
        if constexpr (!Epi::AFTER_DRAIN) { E(acc, cur, wr, wc, fr, fq, sb_cur); S.done(cur); }
        if (!has_next) break;
#pragma unroll
        for (int a = 0; a < 2; ++a)
#pragma unroll
            for (int b = 0; b < 2; ++b)
#pragma unroll
                for (int m = 0; m < 4; ++m)
#pragma unroll
                    for (int n = 0; n < 2; ++n) acc[a][b][m][n] = (f32x4){0.f, 0.f, 0.f, 0.f};
        cur = nxt; nxt = un2; has_next = has2; cA00 = nA00; cA01 = nA01; cA10 = nA10; cA11 = nA11; cB = nB; ++ui; sb_cur = sb_n;
        if constexpr (ALIGN_EPI) { if (wr == 1) PG8_BAR; }
    }
    PG8_WAIT_V(0);
    if constexpr (!ALIGN_EPI) { if (wr == 0) PG8_BAR; }
    PG8_BAR;
    if constexpr (Epi::AFTER_DRAIN) { E.fused(acc, cur, wr, wc, fr, fq, lds, wid, lane); S.done(cur); }
#undef PG8_SA
#undef PG8_SB
#undef PG8_STAGE
#undef PG8_STAGEA
#undef PG8_LDA
#undef PG8_LDB
#undef PG8_MMA
#undef PG8_WAIT_V
#undef PG8_WAIT_L
#undef PG8_BAR
#undef PG8_SCHED
}
}

DEVI void wt_colinfo(const Params& p, int R, const float*& src, int& ld, float& scale) {
    scale = 1.0f; src = nullptr; ld = 0;
    if (R < WT_AT) {
        const int pn = R >> 8, cl = R & 255; ld = DIN_; int col = -1;
        if (pn < 4) { const int wcq = (cl >> 5) & 3; col = (pn >> 1) * 512 + (2 * (pn & 1) + (wcq >> 1)) * 128 + 64 * (cl >> 7) + 32 * (wcq & 1) + (cl & 31);
                      if (pn >= 2) scale = KSCALE_; }
        else if (pn < 8)  col = 2048 + (pn - 4) * 256 + cl;
        else if (pn < 10) { col = 3072 + (pn - 8) * 256 + cl; scale = KSCALE_; }
        else if (pn < 14) col = 5120 + (pn - 10) * 256 + cl;
        else if (pn < 22) col = 6160 + (pn - 14) * 256 + cl;
        else if (cl < 16) col = 6144 + cl;
        if (col >= 0) src = p.w_in + col;
    } else if (R < WT_RET) {
        const int Rr = R - WT_AT, pm = Rr >> 8, rl = Rr & 255; ld = DIN_; int col;
        if (pm < 2) { col = 512 + (2 * pm + ((rl >> 6) & 1)) * 128 + 64 * (rl >> 7) + (rl & 63); scale = KSCALE_; }
        else if (pm < 6)  col = 1024 + (pm - 2) * 256 + rl;
        else if (pm < 10) col = 4096 + (pm - 6) * 256 + rl;
        else              col = 3584 + (pm - 10) * 256 + rl;
        src = p.w_in + col;
    } else {
        int Rr, ldd; const float* base;
        if (R < WT_GLA)    { Rr = R - WT_RET; base = p.w_ret_out; ldd = 1024; }
        else if (R < WT_O) { Rr = R - WT_GLA; base = p.w_gla_out; ldd = 1024; }
        else if (R < WT_R) { Rr = R - WT_O;   base = p.w_o;       ldd = 1024; }
        else               { Rr = R - WT_R;   base = p.router_w;  ldd = 256; }
        src = base + ((R >= WT_R) ? ((Rr & ~127) + vperm(Rr & 127)) : Rr); ld = ldd;
    }
}

DEVI void phase0(const Params& p, unsigned char* smem) {
    const int tid = VT, nb = VG, bid = VB;
    float2* cs = (float2*)(p.ws + OFF_CS);
    for (int i = bid * 256 + tid; i < 4096 * 64; i += nb * 256) {
        const int pos = i >> 6, k = i & 63;
        const float angf = (float)pos * c_inv_freq[k];
        const double a = (double)angf;
        const double TWO_PI = 6.283185307179586476925286766559, HALF_PI = 1.5707963267948966192313216916398;
        const double kk = rint(a * (1.0 / TWO_PI));
        const double r = a - kk * TWO_PI;
        const double qd = rint(r * (1.0 / HALF_PI));
        const double y = r - qd * HALF_PI;
        const double y2 = y * y;
        double sn = y * (1.0 + y2 * (-1.0 / 6 + y2 * (1.0 / 120 + y2 * (-1.0 / 5040 + y2 * (1.0 / 362880 + y2 * (-1.0 / 39916800 + y2 * (1.0 / 6227020800.0)))))));
        double cn = 1.0 + y2 * (-0.5 + y2 * (1.0 / 24 + y2 * (-1.0 / 720 + y2 * (1.0 / 40320 + y2 * (-1.0 / 3628800 + y2 * (1.0 / 479001600.0))))));
        const int qi = ((int)qd) & 3;
        double s, c;
        if (qi == 0) { s = sn; c = cn; } else if (qi == 1) { s = cn; c = -sn; } else if (qi == 2) { s = -sn; c = -cn; } else { s = -cn; c = sn; }
        cs[i] = make_float2((float)c, (float)s);
    }
    if (bid == 0) { int* cnt = (int*)(p.ws + OFF_CNT); cnt[tid * CNT_STRIDE] = 0; }
    {
        u32x4* bfr = (u32x4*)smem;
        for (int idx = tid; idx < 32 * 64; idx += 256) {
            const int sst = idx >> 6, l = idx & 63;
            const float* wp = p.w_in + (size_t)(32 * sst + 8 * (l >> 4)) * DIN_ + 6144 + (l & 15);
            float w8[8];
#pragma unroll
            for (int j = 0; j < 8; ++j) w8[j] = wp[(size_t)j * DIN_];
            u32x4 o; o.x = pk2(w8[0], w8[1]); o.y = pk2(w8[2], w8[3]); o.z = pk2(w8[4], w8[5]); o.w = pk2(w8[6], w8[7]);
            bfr[idx] = o;
        }
        __syncthreads();
        const int lane = tid & 63, row = lane & 15, kg = lane >> 4;
        float* Ga = (float*)(p.ws + OFF_GA);
        for (int rb = bid * 4 + (tid >> 6); rb < T_ / 16; rb += nb * 4) {
            const float* xr = p.x + (size_t)(rb * 16 + row) * 1024 + 8 * kg;
            bf16_t* xo = (bf16_t*)(p.ws + OFF_XB) + (size_t)(rb * 16 + row) * 1024 + 8 * kg;
            f32x4 acc = (f32x4){0.f, 0.f, 0.f, 0.f};
#pragma unroll 1
            for (int s0 = 0; s0 < 32; s0 += 8) {
                f32x4 v[8][2];
#pragma unroll
                for (int j = 0; j < 8; ++j) { v[j][0] = *(const f32x4*)(xr + 32 * (s0 + j)); v[j][1] = *(const f32x4*)(xr + 32 * (s0 + j) + 4); }
#pragma unroll
                for (int j = 0; j < 8; ++j) {
                    u32x4 o; o.x = pk2(v[j][0][0], v[j][0][1]); o.y = pk2(v[j][0][2], v[j][0][3]); o.z = pk2(v[j][1][0], v[j][1][1]); o.w = pk2(v[j][1][2], v[j][1][3]);
                    *(u32x4*)(xo + 32 * (s0 + j)) = o;
                    acc = mfma16(__builtin_bit_cast(bf16x8, o), __builtin_bit_cast(bf16x8, bfr[(s0 + j) * 64 + lane]), acc);
                }
            }
#pragma unroll
            for (int r = 0; r < 4; ++r) Ga[(size_t)(rb * 16 + 4 * kg + r) * 16 + row] = acc[r];
        }
        __syncthreads();
    }
    {
        float* tile = (float*)smem;
        bf16_t* wt = (bf16_t*)(p.ws + OFF_WT);
        const int ntask = (WT_ROWS / 64) * 16;
        for (int task = bid; task < ntask; task += nb) {
            const int rt = task >> 4, kt = task & 15, R0 = rt * 64, k0 = kt * 64;
            {
                const int n = tid & 63, kq = tid >> 6;
                const float* src; int ld; float sc; wt_colinfo(p, R0 + n, src, ld, sc);
#pragma unroll
                for (int i = 0; i < 16; ++i) { const int k = kq + 4 * i; tile[k * 65 + n] = src ? src[(size_t)(k0 + k) * ld] * sc : 0.f; }
            }
            __syncthreads();
            {
                const int n = tid >> 2, ks = (tid & 3) * 16;
                unsigned o[8];
#pragma unroll
                for (int j = 0; j < 8; ++j) o[j] = pk2(tile[(ks + 2 * j) * 65 + n], tile[(ks + 2 * j + 1) * 65 + n]);
                u32x4* dst = (u32x4*)(wt + (size_t)(R0 + n) * 1024 + k0 + ks);
                dst[0] = (u32x4){o[0], o[1], o[2], o[3]}; dst[1] = (u32x4){o[4], o[5], o[6], o[7]};
            }
            __syncthreads();
        }
    }
}

struct EpiP1N {
    static constexpr bool PERM = true, AFTER_DRAIN = false;
    unsigned char* ws;
    __device__ __forceinline__ void operator()(const pg8::f32x4 (&acc)[2][2][4][2], const pg8::Unit& u, int wr, int wc, int fr, int fq) const {
        const int pn = u.pn, row0 = u.pm * 256 + wr * 64 + fr, c8 = wc * 32 + 8 * fq;
        if (pn < 4) {
            const float2* cs = (const float2*)(ws + OFF_CS); bf16_t* Qr = (bf16_t*)(ws + (pn < 2 ? OFF_QR : OFF_KR));
            const int head = 2 * (pn & 1) + (wc >> 1), d0 = 32 * (wc & 1) + 8 * fq;
#pragma unroll
            for (int ai = 0; ai < 2; ++ai)
#pragma unroll
                for (int m = 0; m < 4; ++m) {
                    const size_t row = row0 + ai * 128 + m * 16; const int pos = (int)(row & 4095);
                    f32x4 c4[4];
#pragma unroll
                    for (int j = 0; j < 4; ++j) c4[j] = *(const f32x4*)(cs + pos * 64 + d0 + 2 * j);
                    f32x4 o1[2], o2[2];
#pragma unroll
                    for (int n = 0; n < 2; ++n)
#pragma unroll
                        for (int r = 0; r < 4; ++r) {
                            const f32x4 cc = c4[2 * n + (r >> 1)]; const float c_ = cc[(r & 1) * 2], s_ = cc[(r & 1) * 2 + 1];
                            const float x1 = acc[ai][0][m][n][r], x2 = acc[ai][1][m][n][r];
                            o1[n][r] = x1 * c_ - x2 * s_; o2[n][r] = x1 * s_ + x2 * c_;
                        }
                    *(u32x4*)(Qr + row * 512 + head * 128 + d0) = pk8(o1[0], o1[1]);
                    *(u32x4*)(Qr + row * 512 + head * 128 + 64 + d0) = pk8(o2[0], o2[1]);
                    asm volatile("" ::: "memory");
                }
        } else {
#pragma unroll
            for (int ai = 0; ai < 2; ++ai)
#pragma unroll
                for (int m = 0; m < 4; ++m) {
                    const size_t row = row0 + ai * 128 + m * 16;
#pragma unroll
                    for (int bj = 0; bj < 2; ++bj) {
                        const int cl = bj * 128 + c8;
                        f32x4 v0 = acc[ai][bj][m][0], v1 = acc[ai][bj][m][1];
                        if (pn < 8) {
#pragma unroll
                            for (int r = 0; r < 4; ++r) { v0[r] = siluf_(v0[r]); v1[r] = siluf_(v1[r]); }
                            *(u32x4*)((bf16_t*)(ws + OFF_GS) + row * 2048 + (pn - 4) * 256 + cl) = pk8(v0, v1);
                        } else if (pn < 10) {
                            *(u32x4*)((bf16_t*)(ws + OFF_QGN) + row * 512 + (pn - 8) * 256 + cl) = pk8(v0, v1);
                        } else if (pn < 14) {
#pragma unroll
                            for (int r = 0; r < 4; ++r) { v0[r] = siluf_(v0[r]); v1[r] = siluf_(v1[r]); }
                            *(u32x4*)((bf16_t*)(ws + OFF_GS) + row * 2048 + 1024 + (pn - 10) * 256 + cl) = pk8(v0, v1);
                        } else if (pn < 22) {
#pragma unroll
                            for (int r = 0; r < 4; ++r) { v0[r] = sigmoidf_(v0[r]); v1[r] = sigmoidf_(v1[r]); }
                            *(u32x4*)((bf16_t*)(ws + OFF_MG) + row * 2048 + (pn - 14) * 256 + cl) = pk8(v0, v1);
                        } else if (cl < 16) {
                            int frl = fr; asm volatile("" : "+v"(frl));
                            const unsigned ofs = (unsigned)OFF_GA + ((unsigned)(u.pm * 256 + wr * 64 + frl + ai * 128 + m * 16) * 16u + (unsigned)cl) * 4u;
                            *(f32x4*)(ws + ofs) = v0; *(f32x4*)(ws + ofs + 16) = v1;
                        }
                    }
                    asm volatile("" ::: "memory");
                }
        }
    }
};
struct EpiP1V {
    static constexpr bool PERM = true, AFTER_DRAIN = false;
    unsigned char* ws;
    __device__ __forceinline__ void operator()(const pg8::f32x4 (&acc)[2][2][4][2], const pg8::Unit& u, int wr, int wc, int fr, int fq) const {
        bf16_t* dst = (bf16_t*)(ws + (u.pm < 4 ? OFF_VRT : OFF_VGT)); const int head = u.pm & 3;
#pragma unroll
        for (int bj = 0; bj < 2; ++bj) {
            const int tok0 = u.pn * 256 + bj * 128 + wc * 32 + 8 * fq; const int item = (tok0 >> 6) * 4 + head, m0 = tok0 & 63;
#pragma unroll
            for (int ai = 0; ai < 2; ++ai)
#pragma unroll
                for (int m = 0; m < 4; ++m) {
                    *(u32x4*)(dst + vf_off(item, ai * 128 + wr * 64 + m * 16 + fr, m0)) = pk8(acc[ai][bj][m][0], acc[ai][bj][m][1]);
                    asm volatile("" ::: "memory");
                }
        }
    }
};
struct EpiP1G {
    static constexpr bool PERM = true, AFTER_DRAIN = false;
    unsigned char* ws;
    __device__ __forceinline__ void operator()(const pg8::f32x4 (&acc)[2][2][4][2], const pg8::Unit& u, int wr, int wc, int fr, int fq) const {
        bf16_t* dst = (bf16_t*)(ws + OFF_KGT);
#pragma unroll
        for (int bj = 0; bj < 2; ++bj) {
            const int tok0 = u.pn * 256 + bj * 128 + wc * 32 + 8 * fq; const int m0 = tok0 & 63;
#pragma unroll
            for (int ai = 0; ai < 2; ++ai) {
                const unsigned item = (unsigned)((tok0 >> 6) * 4 + 2 * u.pm + ai);
#pragma unroll
                for (int m = 0; m < 4; ++m) {
                    *(u32x4*)(dst + (item * 128u + (unsigned)(wr * 64 + m * 16 + fr)) * 64u + (unsigned)m0) = pk8(acc[ai][bj][m][0], acc[ai][bj][m][1]);
                    asm volatile("" ::: "memory");
                }
            }
        }
    }
};
DEVI void phase1(const Params& p, unsigned char* smem_all) {
    {
        pg8::StaticOrder S; S.init(T_, 5632, RG, RB);
        pg8::Gemm g; g.A = (const bf16_t*)(p.ws + OFF_XB); g.Bt = (const bf16_t*)(p.ws + OFF_WT) + (size_t)WT_BN * 1024; g.M = T_; g.N = 5632; g.K = 1024;
        EpiP1N E; E.ws = p.ws;
        pg8::gemm_phase<EpiP1N, pg8::StaticOrder, true, true>((PG8_LAS unsigned char*)smem_all, g, S, E);
    }
    __syncthreads();
    {
        pg8::StaticOrder S; S.init(2048, T_, RG, RB);
        pg8::Gemm g; g.A = (const bf16_t*)(p.ws + OFF_WT) + (size_t)(WT_AT + 512) * 1024; g.Bt = (const bf16_t*)(p.ws + OFF_XB); g.M = 2048; g.N = T_; g.K = 1024;
        EpiP1V E; E.ws = p.ws;
        pg8::gemm_phase<EpiP1V, pg8::StaticOrder, true, true>((PG8_LAS unsigned char*)smem_all, g, S, E);
    }
    __syncthreads();
    {
        pg8::StaticOrder S; S.init(512, T_, RG, RB);
        pg8::Gemm g; g.A = (const bf16_t*)(p.ws + OFF_WT) + (size_t)(WT_AT + 2560) * 1024; g.Bt = (const bf16_t*)(p.ws + OFF_XB); g.M = 512; g.N = T_; g.K = 1024;
        EpiP1G E; E.ws = p.ws;
        pg8::gemm_phase<EpiP1G, pg8::StaticOrder, true, true>((PG8_LAS unsigned char*)smem_all, g, S, E);
    }
}

DEVI void phase2(const Params& p, unsigned char* smem) {
    float* ga_s = (float*)smem;
    float* tot = (float*)(smem + 4096);
    const int tid = VT;
    const float* Ga = (const float*)(p.ws + OFF_GA);
    const bf16_t* Kgt = (const bf16_t*)(p.ws + OFF_KGT); bf16_t* Kg2 = (bf16_t*)(p.ws + OFF_KG2);
    float* dec = (float*)(p.ws + OFF_DEC);
    for (int it = VB; it < 2048; it += VG) {
        const int h = it & 3, c = (it >> 2) & 63, b = it >> 8;
        const int tok0 = b * 4096 + c * 64;
        ((f32x4*)ga_s)[tid] = ((const f32x4*)(Ga + (size_t)tok0 * 16))[tid];
        const int dk = tid & 127, half = tid >> 7;
        float w2[16];
#pragma unroll
        for (int r = 0; r < 16; ++r) w2[r] = p.gate_w2[r * 512 + h * 128 + dk];
        const float bias = p.gate_b[h * 128 + dk];
        __syncthreads();
        float run = 0.f; float bc[32];
#pragma unroll
        for (int ml = 0; ml < 32; ++ml) {
            const int m = half * 32 + ml;
            float z = bias;
#pragma unroll
            for (int r4 = 0; r4 < 4; ++r4) { const f32x4 g4 = *(const f32x4*)&ga_s[m * 16 + 4 * r4];
                z += g4[0] * w2[4 * r4] + g4[1] * w2[4 * r4 + 1] + g4[2] * w2[4 * r4 + 2] + g4[3] * w2[4 * r4 + 3]; }
            const float la = (fminf(z, 0.f) - __logf(1.0f + __expf(-fabsf(z)))) * (1.0f / 16.0f);
            run += la; bc[ml] = run;
        }
        tot[half * 128 + dk] = run;
        __syncthreads();
        const float t0 = tot[dk], t1 = tot[128 + dk];
        const float bend = t0 + t1, off = half ? t0 : 0.f;
        const u32x4* kp = (const u32x4*)(Kgt + ((size_t)it * 128 + dk) * 64 + half * 32);
        bf16_t* const kqb = Kg2;
#pragma unroll
        for (int j = 0; j < 4; ++j) {
            u32x4 v = kp[j];
            unsigned uu[4] = {v.x, v.y, v.z, v.w};
#pragma unroll
            for (int e = 0; e < 4; ++e) {
                const float f0 = bflo(uu[e]) * __expf(bend - (bc[8 * j + 2 * e] + off));
                const float f1 = bfhi(uu[e]) * __expf(bend - (bc[8 * j + 2 * e + 1] + off));
                uu[e] = pk2(f0, f1);
            }
            *(u32x4*)(kqb + kf_off(it, dk, half * 32 + 8 * j)) = (u32x4){uu[0], uu[1], uu[2], uu[3]};
        }
        if (half == 0) dec[(size_t)it * 128 + dk] = __expf(bend);
        {
            const bf16_t* Qn = (const bf16_t*)(p.ws + OFF_QGN); bf16_t* QF = (bf16_t*)(p.ws + OFF_QG);
            const int m = tid & 63, qd = tid >> 6, bc = b * 64 + c;
            const u32x4* qs = (const u32x4*)(Qn + ((size_t)tok0 + m) * 512 + h * 128 + 32 * qd);
            u32x4 qv[4];
#pragma unroll
            for (int j = 0; j < 4; ++j) qv[j] = qs[j];
#pragma unroll
            for (int j = 0; j < 4; ++j) {
                *(u32x2*)(QF + qf_off(bc, h, m, 32 * qd + 8 * j, 0)) = (u32x2){qv[j].x, qv[j].y};
                *(u32x2*)(QF + qf_off(bc, h, m, 32 * qd + 8 * j, 1)) = (u32x2){qv[j].z, qv[j].w};
            }
        }
        __syncthreads();
    }
    {
        bf16_t* tile = (bf16_t*)smem;
        const bf16_t* Kr = (const bf16_t*)(p.ws + OFF_KR); bf16_t* Krt = (bf16_t*)(p.ws + OFF_KRT);
        for (int it = VB; it < 2048; it += VG) {
            const int h = it & 3, c = (it >> 2) & 63, b = it >> 8;
            const size_t tok0 = (size_t)b * 4096 + c * 64;
            const int m = tid & 63, qd = tid >> 6;
            const float kd = exp2f(gamma_log2(h) * (float)(63 - m));
            const u32x4* src = (const u32x4*)(Kr + (tok0 + m) * 512 + h * 128 + 32 * qd);
            u32x4 v[4];
#pragma unroll
            for (int j = 0; j < 4; ++j) v[j] = src[j];
#pragma unroll
            for (int j = 0; j < 4; ++j) {
                const unsigned uu[4] = {v[j].x, v[j].y, v[j].z, v[j].w};
#pragma unroll
                for (int e = 0; e < 4; ++e) {
                    const int dk = 32 * qd + 8 * j + 2 * e;
                    tile[dk * 72 + m] = f2bf(bflo(uu[e]) * kd); tile[(dk + 1) * 72 + m] = f2bf(bfhi(uu[e]) * kd);
                }
            }
            {
                const bf16_t* Qr = (const bf16_t*)(p.ws + OFF_QR); bf16_t* QF = (bf16_t*)(p.ws + OFF_QFR);
                const u32x4* qs = (const u32x4*)(Qr + (tok0 + m) * 512 + h * 128 + 32 * qd);
                u32x4 qv[4];
#pragma unroll
                for (int j = 0; j < 4; ++j) qv[j] = qs[j];
                const int bc = b * 64 + c;
#pragma unroll
                for (int j = 0; j < 4; ++j) {
                    *(u32x2*)(QF + qf_off(bc, h, m, 32 * qd + 8 * j, 0)) = (u32x2){qv[j].x, qv[j].y};
                    *(u32x2*)(QF + qf_off(bc, h, m, 32 * qd + 8 * j, 1)) = (u32x2){qv[j].z, qv[j].w};
                }
            }
            __syncthreads();
            {
                const int dk = tid >> 1, hf = tid & 1;
#pragma unroll
                for (int j = 0; j < 4; ++j) *(u32x4*)(Krt + kf_off(it, dk, hf * 32 + 8 * j)) = *(const u32x4*)&tile[dk * 72 + hf * 32 + 8 * j];
            }
            __syncthreads();
        }
    }
}

typedef float f32x16 __attribute__((ext_vector_type(16)));
DEVI f32x16 mfma32(bf16x8 a, bf16x8 b, f32x16 c) { return __builtin_amdgcn_mfma_f32_32x32x16_bf16(a, b, c, 0, 0, 0); }
struct ScanSet { bf16x8 kf[4], vq, qf[2][2]; f32x4 dc[4]; };
template <bool GLA>
DEVI void scan_tile(const Params& p, unsigned char* zb  , int b, int h, int s, int dummy) {
    int vt_ = VT; asm volatile("" : "+v"(vt_));
    const int t = __builtin_amdgcn_readfirstlane(vt_ >> 6), lane = vt_ & 63, r = lane & 31, hh = lane >> 5;
    const bf16_t* Ktb = (const bf16_t*)(p.ws + (GLA ? OFF_KG2 : OFF_KRT));
    const bf16_t* Vtb = (const bf16_t*)(p.ws + (GLA ? OFF_VGT : OFF_VRT));
    const bf16_t* Qb  = (const bf16_t*)(p.ws + (GLA ? OFF_QG : OFF_QFR));
    const float* dec = (const float*)(p.ws + OFF_DEC);
    bf16_t* Oo = (bf16_t*)(p.ws + OFF_OO);
    const float lg = gamma_log2(h);
    const float cd = exp2f(lg * 64.0f);
    f32x16 S;
#pragma unroll
    for (int i = 0; i < 16; ++i) S[i] = 0.f;
    const unsigned it0 = (unsigned)(b * 64 * 4 + h);
    const bf16_t* const kp = Ktb + ((size_t)it0 * 4 + t) * 4 * 512; const unsigned ko = (unsigned)lane * 8;
    const bf16_t* const vp = Vtb + ((size_t)it0 * 8 + s) * 4 * 512 + t * 512; const unsigned vo = (unsigned)lane * 8;
    const bf16_t* const qp = Qb + ((((size_t)(b * 64) * 4 + h) * 2) * 4 + t) * 2 * 512; const unsigned qo = (unsigned)lane * 8;
    const float* const dp = dec + (size_t)it0 * 128 + t * 32; const unsigned dofs = 4 * hh;
    unsigned char* const vring = smem_all_g + 2 * SMEM_HALF + VH * 8192;
    const int rt = t >> 1, rg0 = 2 * (t & 1);
    const float qd = GLA ? 1.0f : exp2f(lg * (float)(32 * rt + r + 1));
    bf16_t* const ob = Oo + (size_t)b * 4096 * 2048 + (GLA ? 1024 : 0) + h * 256 + s * 32;
#define ST_CL(C) (dummy ? 0 : ((C) < 64 ? (C) : 63))
#define ST_LOAD(SET, C) do { const int c_ = ST_CL(C), cv_ = ST_CL((C) + 1); \
        const bf16_t* kq = kp + (size_t)c_ * (4 * 16 * 512) + ko; const bf16_t* qq = qp + (size_t)c_ * (4 * 16 * 512) + qo; \
        _Pragma("unroll") for (int ks = 0; ks < 4; ++ks) (SET).kf[ks] = *(const bf16x8*)(kq + ks * 512); \
        (SET).vq = *(const bf16x8*)(vp + (size_t)cv_ * (4 * 32 * 512) + vo); \
        _Pragma("unroll") for (int ss = 0; ss < 2; ++ss) _Pragma("unroll") for (int tt = 0; tt < 2; ++tt) (SET).qf[ss][tt] = *(const bf16x8*)(qq + tt * (8 * 512) + ss * 512); \
        } while (0)
#define ST_LOADDC(SET, C) do { if (GLA) { const int c_ = (C) < 64 ? (C) : 63; const float* dq = dp + (size_t)c_ * (4 * 128) + dofs; \
        _Pragma("unroll") for (int g = 0; g < 4; ++g) (SET).dc[g] = *(const f32x4*)(dq + 8 * g); } } while (0)
#define ST_Z(SET, ZC) do { \
        _Pragma("unroll") for (int tt = 0; tt < 2; ++tt) { \
            f32x16 Zt; _Pragma("unroll") for (int i = 0; i < 16; ++i) Zt[i] = 0.f; \
            _Pragma("unroll") for (int ss = 0; ss < 2; ++ss) { \
                u32x4 pk; pk.x = pk2(S[8 * ss + 0], S[8 * ss + 1]); pk.y = pk2(S[8 * ss + 2], S[8 * ss + 3]); pk.z = pk2(S[8 * ss + 4], S[8 * ss + 5]); pk.w = pk2(S[8 * ss + 6], S[8 * ss + 7]); \
                Zt = mfma32(__builtin_bit_cast(bf16x8, pk), (SET).qf[ss][tt], Zt); } \
            _Pragma("unroll") for (int g = 0; g < 4; ++g) { \
                f32x4 z4; z4[0] = Zt[4 * g]; z4[1] = Zt[4 * g + 1]; z4[2] = Zt[4 * g + 2]; z4[3] = Zt[4 * g + 3]; \
                *(u32x2*)((ZC) + (((t * 2 + tt) * 4 + g) * 64 + lane) * 8) = pk4(z4); } } } while (0)
#define ST_UPD(SET, C) do { \
        if (GLA) { _Pragma("unroll") for (int g = 0; g < 4; ++g) _Pragma("unroll") for (int i = 0; i < 4; ++i) S[4 * g + i] *= (SET).dc[g][i]; } \
        else { _Pragma("unroll") for (int i = 0; i < 16; ++i) S[i] *= cd; } \
        _Pragma("unroll") for (int ks = 0; ks < 4; ++ks) S = mfma32((SET).kf[ks], *(const bf16x8*)(vring + ((C) & 1) * 4096 + ks * 1024 + lane * 16), S); } while (0)
#define ST_STEP(CUR, NXT, OTH, C) do { \
        ST_LOADDC(OTH, (C) + 1); ST_LOAD(NXT, (C) + 2);       \
        __builtin_amdgcn_sched_barrier(0); \
        unsigned char* zc = zb + ((C) & 1) * 16384; \
        if (GLA) { ST_UPD(CUR, C); ST_Z(CUR, zc); } else { ST_Z(CUR, zc); ST_UPD(CUR, C); } \
        *(bf16x8*)(vring + (((C) + 1) & 1) * 4096 + t * 1024 + lane * 16) = (CUR).vq; \
        __syncthreads(); \
        _Pragma("unroll") for (int gi = 0; gi < 2; ++gi) { const int g = rg0 + gi; \
            f32x4 o = (f32x4){0.f, 0.f, 0.f, 0.f}; \
            _Pragma("unroll") for (int t2 = 0; t2 < 4; ++t2) o += unpk4(*(const u32x2*)(zc + (((t2 * 2 + rt) * 4 + g) * 64 + lane) * 8)); \
            *(u32x2*)(zb + 32768 + ((C) & 7) * 4096 + (32 * rt + r) * 64 + (8 * g + 4 * hh) * 2) = pk4(o * qd); } \
          \
        if (((C) & 7) == 7) { __syncthreads(); \
            _Pragma("unroll") for (int i = 0; i < 8; ++i)   \
                *(u32x4*)((unsigned char*)ob + (size_t)(((C) - 7) * 64 + i * 64) * 4096 + fo) = *(const u32x4*)(zb + 32768 + i * 4096 + fl); } } while (0)
    const unsigned fo = (unsigned)(vt_ >> 2) * 4096u + (unsigned)(vt_ & 3) * 16u, fl = (unsigned)(vt_ >> 2) * 64u + (unsigned)(vt_ & 3) * 16u;
    ScanSet A, B, Cc;
    { const bf16x8 v0 = *(const bf16x8*)(vp + vo); *(bf16x8*)(vring + t * 1024 + lane * 16) = v0; }
    ST_LOAD(A, 0); ST_LOADDC(A, 0); ST_LOAD(B, 1);
    __syncthreads();
#pragma unroll 1
    for (int c0 = 0; c0 < 66; c0 += 3) { ST_STEP(A, Cc, B, c0); ST_STEP(B, A, Cc, c0 + 1); ST_STEP(Cc, B, A, c0 + 2); }
    __syncthreads();
#undef ST_STEP
#undef ST_UPD
#undef ST_Z
#undef ST_LOADDC
#undef ST_LOAD
#undef ST_CL
}
DEVI void phase3t(const Params& p, unsigned char* smem, int dummy) {
    for (int it0 = VB; it0 < 512; it0 += VG) {
        const int lcl = (RB >> 3) * 2 + VH;
        const int it = (VG == 512) ? ((RB & 7) * 8 + lcl / 8) * 8 + (lcl & 7) : it0;
        const int s = it & 7, h = (it >> 3) & 3, b = (it >> 5) & 7, br = it >> 8;
        if (br == 0) scan_tile<false>(p, smem, b, h, s, dummy); else scan_tile<true>(p, smem, b, h, s, dummy);
    }
}

constexpr int PS_LD = 72;
DEVI void phase4(const Params& p, unsigned char* smem) {
    const int t = VT, lane = t & 63, w = t >> 6, l15 = lane & 15, q = lane >> 4;
    bf16_t* Ps = (bf16_t*)smem + w * 16 * PS_LD;
    const bf16_t* Qr = (const bf16_t*)(p.ws + OFF_QR); const bf16_t* Kr = (const bf16_t*)(p.ws + OFF_KR);
    const bf16_t* Vrt = (const bf16_t*)(p.ws + OFF_VRT); const bf16_t* Oo = (const bf16_t*)(p.ws + OFF_OO);
    const bf16_t* Gs = (const bf16_t*)(p.ws + OFF_GS); bf16_t* Y = (bf16_t*)(p.ws + OFF_Y);
    for (int it = VB; it < 4096; it += VG) {
        const int br = it >> 11, idx = it & 2047;
        const int h = idx & 3, c = (idx >> 2) & 63, b = idx >> 8;
        const size_t tok0 = (size_t)b * 4096 + c * 64;
        const size_t tok = tok0 + 16 * w + l15;
        f32x4 O[16];
        const bf16_t* orow = Oo + tok * 2048 + br * 1024 + h * 256 + 4 * q;
        const bf16_t* grow = Gs + tok * 2048 + br * 1024 + h * 256 + 4 * q;
        u32x2 oraw[16], graw[16];
        if (br == 0) {
            const float lg = gamma_log2(h);
            bf16x8 vf[8][2];
#pragma unroll
            for (int nt = 0; nt < 8; ++nt) { vf[nt][0] = *(const bf16x8*)(Vrt + vf_off(idx, 16 * nt + l15, q * 8)); vf[nt][1] = *(const bf16x8*)(Vrt + vf_off(idx, 16 * nt + l15, 32 + q * 8)); }
            __builtin_amdgcn_sched_barrier(0);
            f32x4 P[4] = {(f32x4){0.f, 0.f, 0.f, 0.f}, (f32x4){0.f, 0.f, 0.f, 0.f}, (f32x4){0.f, 0.f, 0.f, 0.f}, (f32x4){0.f, 0.f, 0.f, 0.f}};
#pragma unroll
            for (int ks = 0; ks < 4; ++ks) {
                const bf16x8 qf = *(const bf16x8*)(Qr + tok * 512 + h * 128 + ks * 32 + q * 8);
#pragma unroll
                for (int mt = 0; mt < 4; ++mt) {
                    const bf16x8 kf = *(const bf16x8*)(Kr + (tok0 + 16 * mt + l15) * 512 + h * 128 + ks * 32 + q * 8);
                    P[mt] = mfma16(kf, qf, P[mt]);
                }
            }
            const int j = 16 * w + l15;
#pragma unroll
            for (int mt = 0; mt < 4; ++mt) {
                f32x4 v = P[mt];
#pragma unroll
                for (int r = 0; r < 4; ++r) { const int m = 16 * mt + 4 * q + r; const int dd = j > m ? j - m : m - j; v[r] *= exp2f(lg * (float)dd); }
                *(u32x2*)&Ps[l15 * PS_LD + 16 * mt + 4 * q] = pk4(v);
            }
            __syncthreads();
            const bf16x8 pf0 = *(const bf16x8*)&Ps[l15 * PS_LD + q * 8];
            const bf16x8 pf1 = *(const bf16x8*)&Ps[l15 * PS_LD + 32 + q * 8];
            __builtin_amdgcn_sched_barrier(0);
#pragma unroll
            for (int nt = 0; nt < 8; ++nt) {
                f32x4 o = (f32x4){0.f, 0.f, 0.f, 0.f};
                o = mfma16(vf[nt][0], pf0, o); O[nt] = mfma16(vf[nt][1], pf1, o);
            }
            __builtin_amdgcn_sched_barrier(0);
#pragma unroll
            for (int nt = 0; nt < 8; ++nt) { vf[nt][0] = *(const bf16x8*)(Vrt + vf_off(idx, 16 * (8 + nt) + l15, q * 8)); vf[nt][1] = *(const bf16x8*)(Vrt + vf_off(idx, 16 * (8 + nt) + l15, 32 + q * 8)); }
#pragma unroll
            for (int nt = 0; nt < 16; ++nt) { oraw[nt] = *(const u32x2*)(orow + 16 * nt); graw[nt] = *(const u32x2*)(grow + 16 * nt); }
            __builtin_amdgcn_sched_barrier(0);
#pragma unroll
            for (int nt = 0; nt < 8; ++nt) {
                f32x4 o = (f32x4){0.f, 0.f, 0.f, 0.f};
                o = mfma16(vf[nt][0], pf0, o); O[8 + nt] = mfma16(vf[nt][1], pf1, o);
            }
#pragma unroll
            for (int nt = 0; nt < 16; ++nt) O[nt] += unpk4(oraw[nt]);
            __syncthreads();
        } else {
#pragma unroll
            for (int nt = 0; nt < 16; ++nt) { oraw[nt] = *(const u32x2*)(orow + 16 * nt); graw[nt] = *(const u32x2*)(grow + 16 * nt); }
#pragma unroll
            for (int nt = 0; nt < 16; ++nt) O[nt] = unpk4(oraw[nt]);
        }
        float s1 = 0.f;
#pragma unroll
        for (int nt = 0; nt < 16; ++nt) s1 += (O[nt][0] + O[nt][1]) + (O[nt][2] + O[nt][3]);
        s1 += __shfl_xor(s1, 16); s1 += __shfl_xor(s1, 32);
        const float mean = (br == 0) ? s1 * (1.0f / 256.0f) : 0.f;
        float s2 = 0.f;
#pragma unroll
        for (int nt = 0; nt < 16; ++nt) {
#pragma unroll
            for (int r = 0; r < 4; ++r) { const float dlt = O[nt][r] - mean; s2 += dlt * dlt; }
        }
        s2 += __shfl_xor(s2, 16); s2 += __shfl_xor(s2, 32);
        const float rstd = rsqrtf(s2 * (1.0f / 256.0f) + (br == 0 ? 1e-5f : 1e-6f));
        const float* gw = (br == 0 ? p.ret_norm_g : p.gla_norm_g) + h * 256 + 4 * q;
        bf16_t* yrow = Y + ((size_t)br * T_ + tok) * 1024 + h * 256 + 4 * q;
#pragma unroll
        for (int nt = 0; nt < 16; ++nt) {
            const f32x4 g = *(const f32x4*)(gw + 16 * nt);
            const f32x4 gate = unpk4(graw[nt]);
            f32x4 y;
#pragma unroll
            for (int r = 0; r < 4; ++r) y[r] = (O[nt][r] - mean) * rstd * g[r] * gate[r];
            *(u32x2*)(yrow + 16 * nt) = pk4(y);
        }
    }
}

struct EpiMerge {
    static constexpr bool PERM = true, AFTER_DRAIN = false;
    const bf16_t* Mg; bf16_t* Mrg; int pass;
    __device__ __forceinline__ void operator()(const pg8::f32x4 (&acc)[2][2][4][2], const pg8::Unit& u, int wr, int wc, int fr, int fq) const {
        const int row0 = u.pm * 256 + wr * 64 + fr, col0 = u.pn * 256 + wc * 32 + 8 * fq;
#pragma unroll
        for (int ai = 0; ai < 2; ++ai) {
            u32x4 gg[4][2], pr[4][2];
#pragma unroll
            for (int m = 0; m < 4; ++m)
#pragma unroll
                for (int bj = 0; bj < 2; ++bj) {
                    const size_t row = row0 + ai * 128 + m * 16; const int col = col0 + bj * 128;
                    gg[m][bj] = *(const u32x4*)(Mg + row * 2048 + pass * 1024 + col);
                    if (pass) pr[m][bj] = *(const u32x4*)(Mrg + row * 1024 + col);
                }
#pragma unroll
            for (int m = 0; m < 4; ++m)
#pragma unroll
                for (int bj = 0; bj < 2; ++bj) {
                    const size_t row = row0 + ai * 128 + m * 16; const int col = col0 + bj * 128;
                    f32x4 g0, g1; unpk8(gg[m][bj], g0, g1);
                    f32x4 o0 = acc[ai][bj][m][0] * g0, o1 = acc[ai][bj][m][1] * g1;
                    if (pass) { f32x4 p0, p1; unpk8(pr[m][bj], p0, p1); o0 += p0; o1 += p1; }
                    *(u32x4*)(Mrg + row * 1024 + col) = pk8(o0, o1);
                }
        }
    }
};
DEVI void phase5(const Params& p, unsigned char* smem_all) {
    pg8::StaticOrder S; S.init(T_, 1024, RG, RB);
    const bf16_t* Y = (const bf16_t*)(p.ws + OFF_Y); const bf16_t* wt = (const bf16_t*)(p.ws + OFF_WT);
    for (int pass = 0; pass < 2; ++pass) {
        pg8::Gemm g; g.A = Y + (size_t)pass * T_ * 1024; g.Bt = wt + (size_t)(pass ? WT_GLA : WT_RET) * 1024; g.M = T_; g.N = 1024; g.K = 1024;
        EpiMerge E; E.Mg = (const bf16_t*)(p.ws + OFF_MG); E.Mrg = (bf16_t*)(p.ws + OFF_MRG); E.pass = pass;
        pg8::gemm_phase<EpiMerge, pg8::StaticOrder, true, true>((PG8_LAS unsigned char*)smem_all, g, S, E);
        __syncthreads();
    }
}

struct EpiResid {
    static constexpr bool PERM = true, AFTER_DRAIN = false;
    const float* x; bf16_t* T1;
    __device__ __forceinline__ void operator()(const pg8::f32x4 (&acc)[2][2][4][2], const pg8::Unit& u, int wr, int wc, int fr, int fq) const {
        const int row0 = u.pm * 256 + wr * 64 + fr, col0 = u.pn * 256 + wc * 32 + 8 * fq;
#pragma unroll
        for (int ai = 0; ai < 2; ++ai)
#pragma unroll
            for (int m = 0; m < 4; ++m) {
                const size_t row = row0 + ai * 128 + m * 16;
                f32x4 xv[2][2];
#pragma unroll
                for (int bj = 0; bj < 2; ++bj) { xv[bj][0] = *(const f32x4*)(x + row * 1024 + col0 + bj * 128); xv[bj][1] = *(const f32x4*)(x + row * 1024 + col0 + bj * 128 + 4); }
#pragma unroll
                for (int bj = 0; bj < 2; ++bj)
                    *(u32x4*)(T1 + row * 1024 + col0 + bj * 128) = pk8(xv[bj][0] * ALPHA_ + acc[ai][bj][m][0], xv[bj][1] * ALPHA_ + acc[ai][bj][m][1]);
            }
    }
};
DEVI void phase6(const Params& p, unsigned char* smem_all) {
    pg8::StaticOrder S; S.init(T_, 1024, RG, RB);
    pg8::Gemm g; g.A = (const bf16_t*)(p.ws + OFF_MRG); g.Bt = (const bf16_t*)(p.ws + OFF_WT) + (size_t)WT_O * 1024; g.M = T_; g.N = 1024; g.K = 1024;
    EpiResid E; E.x = p.x; E.T1 = (bf16_t*)(p.ws + OFF_T1);
    pg8::gemm_phase<EpiResid, pg8::StaticOrder, true, true>((PG8_LAS unsigned char*)smem_all, g, S, E);
}

struct ConvTask { const float* sp; bf16_t* dp; int N; };
DEVI ConvTask conv_task(const Params& p, int task, int t) {
    const int ng = t & 31, kg = t >> 5;
    bf16_t* WGU = (bf16_t*)(p.ws + OFF_WGU); bf16_t* WD = (bf16_t*)(p.ws + OFF_WD);
    const int e = task / 96, rem = task - e * 96, mat = rem >> 5, tl = rem & 31;
    const float* src; bf16_t* dst; int K, N, kt, nt;
    if (mat < 2) { K = 1024; N = 256; kt = tl >> 1; nt = tl & 1;
        src = (mat == 0) ? (e < 256 ? p.ew_gate + (size_t)e * 262144 : p.sw_gate) : (e < 256 ? p.ew_up + (size_t)e * 262144 : p.sw_up);
        dst = WGU + (size_t)e * 524288 + (size_t)(nt + mat) * 131072; }
    else { K = 256; N = 1024; kt = tl >> 3; nt = tl & 7;
        src = e < 256 ? p.ew_down + (size_t)e * 262144 : p.sw_down; dst = WD + (size_t)e * 262144; }
    ConvTask c; c.N = N;
    c.sp = src + (size_t)(kt * 64 + 4 * kg) * N + nt * 128 + 4 * ng;
    c.dp = dst + (size_t)(nt * 128 + (t >> 1)) * K + kt * 64 + (t & 1) * 32;
    return c;
}
DEVI ConvTask convs_task(const Params& p, int st, int t) {
    const int ng = t & 15, kg = t >> 4, task = st >> 1, sub = st & 1;
    bf16_t* WGU = (bf16_t*)(p.ws + OFF_WGU); bf16_t* WD = (bf16_t*)(p.ws + OFF_WD);
    const int e = task / 96, rem = task - e * 96, mat = rem >> 5, tl = rem & 31;
    const float* src; bf16_t* dst; int K, N, kt, nt;
    if (mat < 2) { K = 1024; N = 256; kt = tl >> 1; nt = tl & 1;
        src = (mat == 0) ? (e < 256 ? p.ew_gate + (size_t)e * 262144 : p.sw_gate) : (e < 256 ? p.ew_up + (size_t)e * 262144 : p.sw_up);
        dst = WGU + (size_t)e * 524288 + (size_t)(nt + mat) * 131072; }
    else { K = 256; N = 1024; kt = tl >> 3; nt = tl & 7;
        src = e < 256 ? p.ew_down + (size_t)e * 262144 : p.sw_down; dst = WD + (size_t)e * 262144; }
    ConvTask c; c.N = N;
    c.sp = src + (size_t)(kt * 64 + 4 * kg) * N + nt * 128 + sub * 64 + 4 * ng;
    c.dp = dst + (size_t)(nt * 128 + sub * 64 + (t >> 2)) * K + kt * 64 + (t & 3) * 16;
    return c;
}
DEVI void conv_expert_weights(const Params& p, unsigned char* smem) {
    bf16_t* tile = (bf16_t*)smem;
    const int t = VT, ng = t & 31, kg = t >> 5;
    const int ntask = 257 * 3 * 32;
#define CV_LOAD(RF, C) do { _Pragma("unroll") for (int i = 0; i < 4; ++i) { RF[i] = *(const f32x4*)((C).sp + (size_t)i * (C).N); RF[4 + i] = *(const f32x4*)((C).sp + (size_t)(32 + i) * (C).N); } } while (0)
#define CV_PROC(RF, C) do { \
        _Pragma("unroll") for (int i = 0; i < 4; ++i) { \
            u32x2 v0, v1; \
            v0.x = pk2(RF[0][i], RF[1][i]); v0.y = pk2(RF[2][i], RF[3][i]); v1.x = pk2(RF[4][i], RF[5][i]); v1.y = pk2(RF[6][i], RF[7][i]); \
            *(u32x2*)&tile[(4 * ng + i) * 72 + 4 * kg] = v0; *(u32x2*)&tile[(4 * ng + i) * 72 + 32 + 4 * kg] = v1; } \
        asm volatile("s_waitcnt lgkmcnt(0)" ::: "memory"); __builtin_amdgcn_s_barrier(); asm volatile("" ::: "memory"); \
        { const int n = t >> 1, hf = t & 1; \
          _Pragma("unroll") for (int j = 0; j < 4; ++j) *(u32x4*)((C).dp + 8 * j) = *(const u32x4*)&tile[n * 72 + hf * 32 + 8 * j]; } \
        asm volatile("s_waitcnt lgkmcnt(0)" ::: "memory"); __builtin_amdgcn_s_barrier(); asm volatile("" ::: "memory"); } while (0)
    f32x4 ra[8], rb[8];
    int task = 8 * VG + VB;
    if (task >= ntask) return;
    ConvTask ca = conv_task(p, task, t), cb = ca;
    CV_LOAD(ra, ca);
#pragma unroll 1
    for (;;) {
        bool more = task + VG < ntask;
        cb = conv_task(p, more ? task + VG : task, t); CV_LOAD(rb, cb);
        CV_PROC(ra, ca);
        if (!more) break;
        task += VG;
        more = task + VG < ntask;
        ca = conv_task(p, more ? task + VG : task, t); CV_LOAD(ra, ca);
        CV_PROC(rb, cb);
        if (!more) break;
        task += VG;
    }
#undef CV_LOAD
#undef CV_PROC
}

DEVI void ln1_row(const Params& p, int row, int lane) {
    const bf16_t* T1 = (const bf16_t*)(p.ws + OFF_T1); bf16_t* X1b = (bf16_t*)(p.ws + OFF_X1B);
    f32x4 v[4]; float s = 0.f;
#pragma unroll
    for (int i = 0; i < 4; ++i) { v[i] = unpk4(*(const u32x2*)(T1 + (size_t)row * 1024 + i * 256 + lane * 4)); s += (v[i][0] + v[i][1]) + (v[i][2] + v[i][3]); }
#pragma unroll
    for (int o = 32; o > 0; o >>= 1) s += __shfl_xor(s, o);
    const float mean = s * (1.0f / 1024.0f); float s2 = 0.f;
#pragma unroll
    for (int i = 0; i < 4; ++i)
#pragma unroll
        for (int r = 0; r < 4; ++r) { const float d = v[i][r] - mean; s2 += d * d; }
#pragma unroll
    for (int o = 32; o > 0; o >>= 1) s2 += __shfl_xor(s2, o);
    const float rstd = rsqrtf(s2 * (1.0f / 1024.0f) + 1e-5f);
#pragma unroll
    for (int i = 0; i < 4; ++i) {
        const int col = i * 256 + lane * 4;
        const f32x4 g = *(const f32x4*)(p.ln1_g + col), bb = *(const f32x4*)(p.ln1_b + col);
        f32x4 y;
#pragma unroll
        for (int r = 0; r < 4; ++r) y[r] = (v[i][r] - mean) * rstd * g[r] + bb[r];
        *(u32x2*)(X1b + (size_t)row * 1024 + col) = pk4(y);
    }
}

DEVI unsigned f2ord(float f) { const unsigned u = __float_as_uint(f); return (u & 0x80000000u) ? ~u : (u | 0x80000000u); }
template <int CTRL> DEVI float dppf(float v) { const int x = __float_as_int(v); return __int_as_float(__builtin_amdgcn_update_dpp(x, x, CTRL, 0xf, 0xf, false)); }
template <int CTRL> DEVI void top2_merge(float& m1, float& m2) {
    const float p1 = dppf<CTRL>(m1), p2 = dppf<CTRL>(m2);
    const float n1 = fmaxf(m1, p1), n2 = fmaxf(fminf(m1, p1), fmaxf(m2, p2));
    m1 = n1; m2 = n2;
}
DEVI void route_token(const f32x4 lg, const f32x4 rb, int lane, int& mye, float& myw) {
    const int mygrp = lane >> 3;
    float sc[4], bi[4];
#pragma unroll
    for (int r = 0; r < 4; ++r) { sc[r] = sigmoidf_(lg[r]); bi[r] = sc[r] + rb[r]; }
    float m1, m2;
    { const float h01 = fmaxf(bi[0], bi[1]), l01 = fminf(bi[0], bi[1]), h23 = fmaxf(bi[2], bi[3]), l23 = fminf(bi[2], bi[3]);
      m1 = fmaxf(h01, h23); m2 = fmaxf(fminf(h01, h23), fmaxf(l01, l23)); }
    top2_merge<0xB1>(m1, m2);
    top2_merge<0x4E>(m1, m2);
    top2_merge<0x141>(m1, m2);
    const float gown = m1 + m2;
    int rank = 0;
#pragma unroll
    for (int g2 = 0; g2 < 8; ++g2) {
        const float go = __builtin_bit_cast(float, __builtin_amdgcn_readlane(__builtin_bit_cast(int, gown), 8 * g2));
        rank += (go > gown || (go == gown && g2 < mygrp)) ? 1 : 0;
    }
    unsigned ck[4];
#pragma unroll
    for (int r = 0; r < 4; ++r) ck[r] = rank < 4 ? f2ord(bi[r]) : 0u;
    unsigned thr = 0u; bool exact = false;
#pragma unroll 1
    for (int bit = 31; bit >= 0; --bit) {
        const unsigned cnd = thr | (1u << bit);
        const int c8 = __popcll(__ballot(ck[0] >= cnd)) + __popcll(__ballot(ck[1] >= cnd)) + __popcll(__ballot(ck[2] >= cnd)) + __popcll(__ballot(ck[3] >= cnd));
        if (c8 >= 8) { thr = cnd; if (c8 == 8) { exact = true; break; } }
    }
    unsigned long long selm[4];
    if (exact) {
#pragma unroll
        for (int r = 0; r < 4; ++r) selm[r] = __ballot(ck[r] >= thr);
    } else {
        unsigned long long eq[4], any = 0ull; int need = 8;
#pragma unroll
        for (int r = 0; r < 4; ++r) { selm[r] = __ballot(ck[r] > thr); eq[r] = __ballot(ck[r] == thr); need -= __popcll(selm[r]); any |= eq[r]; }
        while (need > 0 && any != 0ull) {
            const int L = __builtin_ctzll(any); any &= any - 1ull;
#pragma unroll
            for (int r = 0; r < 4; ++r) if (((eq[r] >> L) & 1ull) != 0ull && need > 0) { selm[r] |= 1ull << L; --need; }
        }
    }
    float wsum = 0.f; int kk = 0;
    mye = 0; myw = 0.f;
#pragma unroll
    for (int r = 0; r < 4; ++r) {
        unsigned long long m = selm[r];
        while (m != 0ull) {
            const int L = __builtin_ctzll(m); m &= m - 1ull;
            const float sv = __builtin_bit_cast(float, __builtin_amdgcn_readlane(__builtin_bit_cast(int, sc[r]), L));
            wsum += sv;
            if (lane == kk) { mye = 4 * L + r; myw = sv; }
            ++kk;
        }
    }
    myw = myw / wsum * 2.5f;
}
DEVI void router_gemm(const Params& p, unsigned char* smem_all, int m0, f32x4 (&acc)[4][4]) {
    typedef __attribute__((address_space(3))) unsigned char lds8;
    lds8* const L = (lds8*)smem_all;
    const int tid = (int)threadIdx.x, lane = tid & 63, wv = __builtin_amdgcn_readfirstlane(tid >> 6), wr = wv >> 2, wc = wv & 3, l15 = lane & 15, q = lane >> 4;
    const bf16_t* pa = (const bf16_t*)(p.ws + OFF_X1B) + (size_t)(m0 + (tid >> 3)) * 1024 + gemm_src_chunk(tid);
    const bf16_t* pb = (const bf16_t*)(p.ws + OFF_WT) + (size_t)(WT_R + (tid >> 3)) * 1024 + gemm_src_chunk(tid);
    constexpr int STG = 49152;
#define RG_BOFF(BUF, I) ((BUF) * STG + 16384 + (I) * 8192 + (((BUF) == 2 && (I) >= 2) ? (2 * SMEM_HALF - 131072) : 0))
#define RG_ISSUE(BUF, KT) do { \
        _Pragma("unroll") for (int i = 0; i < 2; ++i) __builtin_amdgcn_global_load_lds((const unsigned*)(pa + (size_t)i * 65536 + (KT) * 64), (__attribute__((address_space(3))) unsigned*)(L + (BUF) * STG + i * 8192 + wv * 1024), 16, 0, 0); \
        _Pragma("unroll") for (int i = 0; i < 4; ++i) __builtin_amdgcn_global_load_lds((const unsigned*)(pb + (size_t)i * 65536 + (KT) * 64), (__attribute__((address_space(3))) unsigned*)(L + RG_BOFF(BUF, i) + wv * 1024), 16, 0, 0); } while (0)
    static_assert(2 * STG + 16384 + 2 * 8192 == 131072 && 2 * SMEM_HALF + 2 * 8192 <= 2 * SMEM_HALF + SMEM_MOE, "router GEMM stage map");
    RG_ISSUE(0, 0); RG_ISSUE(1, 1);
    int buf = 0;
#pragma unroll 1
    for (int kt = 0; kt < 16; ++kt) {
        if (kt + 1 < 16) asm volatile("s_waitcnt vmcnt(6)" ::: "memory"); else asm volatile("s_waitcnt vmcnt(0)" ::: "memory");
        __builtin_amdgcn_s_barrier();
        if (kt + 2 < 16) { const int b2 = buf == 0 ? 2 : buf - 1; RG_ISSUE(b2, kt + 2); }
        __builtin_amdgcn_sched_barrier(0);
#pragma unroll
        for (int ss = 0; ss < 2; ++ss) {
            bf16x8 af[4], bfr[4];
            const int coff = ((ss * 4 + q) ^ (l15 >> 1)) * 16;
#pragma unroll
            for (int i = 0; i < 4; ++i) {
                af[i]  = *(const __attribute__((address_space(3))) bf16x8*)(L + buf * STG + (wr * 64 + i * 16 + l15) * 128 + coff);
                bfr[i] = *(const __attribute__((address_space(3))) bf16x8*)(L + RG_BOFF(buf, wc) + (i * 16 + l15) * 128 + coff); }
#pragma unroll
            for (int mt = 0; mt < 4; ++mt)
#pragma unroll
                for (int nt = 0; nt < 4; ++nt) acc[mt][nt] = mfma16(bfr[nt], af[mt], acc[mt][nt]);
        }
        __builtin_amdgcn_sched_barrier(0);
        buf = buf == 2 ? 0 : buf + 1;
    }
#undef RG_ISSUE
#undef RG_BOFF
    __syncthreads();
}
DEVI void phase8(const Params& p, unsigned char* smem_all) {
    const int tid = (int)threadIdx.x, lane = tid & 63, wv = tid >> 6, wr = wv >> 2, wc = wv & 3, l15 = lane & 15, q = lane >> 4;
    int* hist = (int*)(smem_all + 2 * SMEM_HALF); int* rec = hist + 256; float* wrec = (float*)(rec + 1024);
    int* cnt = (int*)(p.ws + OFF_CNT); int* list = (int*)(p.ws + OFF_LIST); float* wl = (float*)(p.ws + OFF_WL);
    const f32x4 rb = *(const f32x4*)(p.router_bias + 4 * lane);
    for (int mtg = RB; mtg < 256; mtg += RG) {
        const int m0 = mtg * 128;
#pragma unroll 1
        for (int i = 0; i < 16; i += 4) {
#pragma unroll
            for (int j = 0; j < 4; ++j) ln1_row(p, m0 + wv * 16 + i + j, lane);
        }
        asm volatile("s_waitcnt vmcnt(0)" ::: "memory");
        __syncthreads();
        f32x4 acc[4][4]; zero_acc(acc);
        router_gemm(p, smem_all, m0, acc);
        if (tid < 256) hist[tid] = 0;
#pragma unroll
        for (int mt = 0; mt < 4; ++mt)
#pragma unroll
            for (int nt = 0; nt < 4; ++nt) {
                const int row = wr * 64 + mt * 16 + l15, col = wc * 64 + (nt >> 1) * 32 + 8 * q + 4 * (nt & 1);
                *(f32x4*)(smem_all + row * 1024 + (((col >> 2) ^ (row & 15)) * 16)) = acc[mt][nt];
            }
        __syncthreads();
        bf16_t* ctile = (bf16_t*)(smem_all + 2 * SMEM_HALF + 9216 + VH * 9216);
        const int vt = VT, cng = vt & 15, ckg = vt >> 4;
#define P8_BAR do { asm volatile("s_waitcnt lgkmcnt(0)" ::: "memory"); __builtin_amdgcn_s_barrier(); asm volatile("" ::: "memory"); } while (0)
#define P8_CLOAD(RF, C) do { _Pragma("unroll") for (int r = 0; r < 4; ++r) RF[r] = *(const f32x4*)((C).sp + (size_t)r * (C).N); } while (0)
#define P8_CPROC(RF, C) do { \
            _Pragma("unroll") for (int c4 = 0; c4 < 4; ++c4) { u32x2 w; w.x = pk2(RF[0][c4], RF[1][c4]); w.y = pk2(RF[2][c4], RF[3][c4]); *(u32x2*)&ctile[(4 * cng + c4) * 72 + 4 * ckg] = w; } \
            P8_BAR; \
            { const u32x4 o0 = *(const u32x4*)&ctile[(vt >> 2) * 72 + (vt & 3) * 16], o1 = *(const u32x4*)&ctile[(vt >> 2) * 72 + (vt & 3) * 16 + 8]; \
              *(u32x4*)((C).dp) = o0; *(u32x4*)((C).dp + 8) = o1; } \
            P8_BAR; } while (0)
#define P8_ROUTE(I) do { const int tl = wv + 8 * (I); \
            const f32x4 lg = *(const f32x4*)(smem_all + tl * 1024 + ((lane ^ (tl & 15)) * 16)); \
            int mye; float myw; route_token(lg, rb, lane, mye, myw); \
            if (lane < 8) { \
                const int lpos = __hip_atomic_fetch_add(&hist[mye], 1, __ATOMIC_RELAXED, __HIP_MEMORY_SCOPE_WORKGROUP); \
                rec[tl * 8 + lane] = mye | (lpos << 8); wrec[tl * 8 + lane] = myw; } } while (0)
        {
            f32x4 fa[4], fb[4];
            const int st0 = (mtg == RB) ? VB : 0x7fffffff;
            ConvTask ka = convs_task(p, st0 < 16 * VG ? st0 : 0, vt), kb = ka;
            P8_CLOAD(fa, ka);
#pragma unroll 1
            for (int i = 0; i < 16; i += 2) {
                kb = convs_task(p, st0 < 16 * VG ? st0 + (i + 1) * VG : 0, vt); P8_CLOAD(fb, kb);
                P8_ROUTE(i);
                if (st0 < 16 * VG) P8_CPROC(fa, ka); else { P8_BAR; P8_BAR; }
                ka = convs_task(p, (st0 < 16 * VG && i + 2 < 16) ? st0 + (i + 2) * VG : 0, vt); P8_CLOAD(fa, ka);
                P8_ROUTE(i + 1);
                if (st0 < 16 * VG) P8_CPROC(fb, kb); else { P8_BAR; P8_BAR; }
            }
        }
#undef P8_ROUTE
#undef P8_CPROC
#undef P8_CLOAD
#undef P8_BAR
        __syncthreads();
        if (tid < 256) { const int c = hist[tid]; hist[tid] = c > 0 ? atomicAdd(&cnt[tid * CNT_STRIDE], c) : 0; }
        __syncthreads();
        for (int i = tid; i < 1024; i += 512) {
            const int rc = rec[i], e = rc & 255, pos = hist[e] + (rc >> 8);
            list[(size_t)e * T_ + pos] = (m0 + (i >> 3)) * 9 + (i & 7); wl[(size_t)e * T_ + pos] = wrec[i];
        }
        __syncthreads();
    }
}

DEVI void moe_prefix256(const Params& p, int* pre  , int xg) {
    const int tid = threadIdx.x;
    const int* cnt = (const int*)(p.ws + OFF_CNT);
    __syncthreads();
    if (tid < 64) {
        int v = 0;
        if (tid < 32) { const int c = __hip_atomic_load(&cnt[(xg + 8 * tid) * CNT_STRIDE], __ATOMIC_RELAXED, __HIP_MEMORY_SCOPE_AGENT); pre[40 + tid] = c; v = (c + 255) >> 8; }
        else if (tid == 32) { v = 16; pre[40 + 32] = T_; }
#pragma unroll
        for (int o = 1; o < 64; o <<= 1) { const int u = __shfl_up(v, o); if (tid >= o) v += u; }
        if (tid < 33) pre[tid + 1] = v;
        if (tid == 0) pre[0] = 0;
    }
    __syncthreads();
}
struct MoeSched {
    const int* pre; const unsigned char* ws; bool need_w;
    int* sbuf;
    int xg, jl, nloc, nsh, nitems;
    const char* Abase; int arow_bytes; bool by_token;
    const char* Bbase; size_t b_expert_bytes, b_unit_bytes;
    __device__ __forceinline__ bool next(int i, pg8::Unit& u) const {
        const int item = jl + i * nloc; if (item >= nitems) return false;
        u.pm = item >> nsh; u.pn = item - (u.pm << nsh);
        const int lane = (int)(threadIdx.x & 63), li = lane < 33 ? lane : 32;
        const int pv = pre[li], cv = pre[40 + li];
        const int gi = __popcll(__ballot(lane < 33 && pv <= u.pm)) - 1;
        const int pg = __builtin_amdgcn_readlane(pv, gi);
        u.ce = __builtin_amdgcn_readlane(cv, gi);
        u.e = gi < 32 ? xg + 8 * gi : 256; u.r0 = (gi < 32 ? 0 : xg * 4096) + (u.pm - pg) * 256;
        return true;
    }
    __device__ __forceinline__ void decode(const pg8::Unit& u, int& e, int& r0, int& ce) const { e = u.e; r0 = u.r0; ce = u.ce; }
    __device__ __forceinline__ int fill_issue(const pg8::Unit& u) const {
        int e, r0, ce; decode(u, e, r0, ce);
        const int pos = r0 + (int)(threadIdx.x & 255); const bool w = threadIdx.x >= 256;
        int v = w ? 0 : -1;
        if (pos < ce && !(w && !need_w)) {
            unsigned hi = threadIdx.x >> 8; asm volatile("" : "+v"(hi));
            static_assert(OFF_WL == OFF_LIST + (512u << 20), "weight list sits 512 MB above the slot list");
            const unsigned off = (unsigned)OFF_LIST + (hi << 29) + ((unsigned)e * (unsigned)T_ + (unsigned)pos) * 4u;
            v = e < 256 ? *(const int*)(ws + off) : (w ? 0x3f800000 : pos * 9 + 8);
        }
        return v;
    }
    __device__ __forceinline__ void fill_write(int buf, int v) const { sbuf[(threadIdx.x >= 256 ? 768 : 0) + buf * 256 + (int)(threadIdx.x & 255)] = v; }
    __device__ __forceinline__ const char* a_base() const { return Abase; }
    __device__ __forceinline__ void a_rows(int buf, const int (&rowA)[2], const int (&colA)[2], unsigned& p00, unsigned& p01, unsigned& p10, unsigned& p11) const {
        const int* sb = sbuf + buf * 256; const int s0 = sb[0];
        int s4[4];
#pragma unroll
        for (int k = 0; k < 4; ++k) { int sl = sb[(k >> 1) * 128 + rowA[k & 1]]; if (sl < 0) sl = s0; s4[k] = sl; }
#pragma unroll
        for (int k = 0; k < 4; ++k) if (by_token) s4[k] = s4[k] / 9;
        p00 = (unsigned)s4[0] * (unsigned)arow_bytes + (unsigned)colA[0]; p01 = (unsigned)s4[1] * (unsigned)arow_bytes + (unsigned)colA[1];
        p10 = (unsigned)s4[2] * (unsigned)arow_bytes + (unsigned)colA[0]; p11 = (unsigned)s4[3] * (unsigned)arow_bytes + (unsigned)colA[1];
    }
    __device__ __forceinline__ const char* b_base(const pg8::Unit& u) const { int e, r0, ce; decode(u, e, r0, ce); return Bbase + (size_t)e * b_expert_bytes + (size_t)u.pn * b_unit_bytes; }
    __device__ __forceinline__ void a_ready(const pg8::Unit&) const {}
    __device__ __forceinline__ void done(const pg8::Unit&) const {}
};
struct EpiMoe1 {
    static constexpr bool PERM = true, AFTER_DRAIN = false, BJI = false;
    const MoeSched* S; bf16_t* H;
    __device__ __forceinline__ void operator()(const pg8::f32x4 (&acc)[2][2][4][2], const pg8::Unit& u, int wr, int wc, int fr, int fq, int buf) const {
        const int* sb = S->sbuf + buf * 256 + wr * 64 + fr;
#pragma unroll
        for (int ai = 0; ai < 2; ++ai) {
            int sl[4];
#pragma unroll
            for (int m = 0; m < 4; ++m) sl[m] = sb[ai * 128 + m * 16];
#pragma unroll
            for (int m = 0; m < 4; ++m) if (sl[m] >= 0) {
                f32x4 h0, h1;
#pragma unroll
                for (int r = 0; r < 4; ++r) { h0[r] = siluf_(acc[ai][0][m][0][r]) * acc[ai][1][m][0][r]; h1[r] = siluf_(acc[ai][0][m][1][r]) * acc[ai][1][m][1][r]; }
                *(u32x4*)(H + (size_t)sl[m] * 256 + u.pn * 128 + wc * 32 + 8 * fq) = pk8(h0, h1);
            }
            asm volatile("" ::: "memory");
        }
    }
};
struct EpiMoe2 {
    static constexpr bool PERM = true, AFTER_DRAIN = false, BJI = true;
    const MoeSched* S; unsigned char* YX;
    __device__ __forceinline__ void operator()(const pg8::f32x4 (&acc)[2][2][4][2], const pg8::Unit& u, int wr, int wc, int fr, int fq, int buf) const {
        const int* sb = S->sbuf + buf * 256 + wr * 64 + fr;
#pragma unroll
        for (int ai = 0; ai < 2; ++ai) {
            int sl[4]; float wg[4];
#pragma unroll
            for (int m = 0; m < 4; ++m) { sl[m] = sb[ai * 128 + m * 16]; wg[m] = __int_as_float(sb[768 + ai * 128 + m * 16]) * YX_SCALE; }
#pragma unroll
            for (int m = 0; m < 4; ++m) if (sl[m] >= 0) {
                u32x4 w8;
                w8.x = pk4_fp8(clamp4(acc[ai][0][m][0] * wg[m], 440.f)); w8.y = pk4_fp8(clamp4(acc[ai][0][m][1] * wg[m], 440.f));
                w8.z = pk4_fp8(clamp4(acc[ai][1][m][0] * wg[m], 440.f)); w8.w = pk4_fp8(clamp4(acc[ai][1][m][1] * wg[m], 440.f));
                *(u32x4*)(YX + (size_t)sl[m] * 1024 + u.pn * 256 + wc * 64 + 16 * fq) = w8;
            }
            asm volatile("" ::: "memory");
        }
    }
};
DEVI void moe_sched_init(const Params& p, MoeSched& S, int* pre) {
    S.pre = pre; S.ws = p.ws; S.need_w = false; S.sbuf = (int*)(smem_all_g + 2 * SMEM_HALF);
    S.xg = RB & 7; S.jl = RB >> 3; S.nloc = RG >> 3;
}
DEVI void phase10(const Params& p, unsigned char* smem_all) {
    int* pre = (int*)(smem_all + 131072);
    MoeSched S; moe_sched_init(p, S, pre); moe_prefix256(p, pre, S.xg);
    S.nsh = 1; S.nitems = pre[33] << 1; S.Abase = (const char*)(p.ws + OFF_X1B); S.arow_bytes = 2048; S.by_token = true;
    S.Bbase = (const char*)(p.ws + OFF_WGU); S.b_expert_bytes = (size_t)512 * 1024 * 2; S.b_unit_bytes = (size_t)256 * 1024 * 2;
    EpiMoe1 E; E.S = &S; E.H = (bf16_t*)(p.ws + OFF_H);
    pg8::gemm_phase_g<EpiMoe1, MoeSched, true, true>((PG8_LAS unsigned char*)smem_all, 1024, S, E);
}
DEVI void phase11(const Params& p, unsigned char* smem_all) {
    int* pre = (int*)(smem_all + 131072);
    MoeSched S; moe_sched_init(p, S, pre); moe_prefix256(p, pre, S.xg);
    S.nsh = 2; S.nitems = pre[33] << 2; S.Abase = (const char*)(p.ws + OFF_H); S.arow_bytes = 512; S.by_token = false;
    S.Bbase = (const char*)(p.ws + OFF_WD); S.b_expert_bytes = (size_t)1024 * 256 * 2; S.b_unit_bytes = (size_t)256 * 256 * 2;
    S.need_w = true;
    EpiMoe2 E; E.S = &S; E.YX = (unsigned char*)(p.ws + OFF_YX);
    pg8::gemm_phase_g<EpiMoe2, MoeSched, true, true>((PG8_LAS unsigned char*)smem_all, 256, S, E);
}

DEVI void phase12(const Params& p) {
    const int t = VT, lane = t & 63, w = t >> 6;
    const bf16_t* X1b = (const bf16_t*)(p.ws + OFF_X1B); const unsigned char* YX = (const unsigned char*)(p.ws + OFF_YX);
    for (int row = VB * 4 + w; row < T_; row += VG * 4) {
        f32x4 v[4]; float s = 0.f;
#pragma unroll
        for (int i = 0; i < 4; ++i) {
            const int col = i * 256 + lane * 4;
            f32x4 a = unpk4(*(const u32x2*)(X1b + (size_t)row * 1024 + col)) * ALPHA_;
            f32x4 ys = (f32x4){0.f, 0.f, 0.f, 0.f};
#pragma unroll
            for (int k = 0; k < 9; ++k) ys += unpk4_fp8(*(const unsigned*)(YX + ((size_t)row * 9 + k) * 1024 + col));
            a += ys * (1.0f / YX_SCALE);
            v[i] = a; s += (a[0] + a[1]) + (a[2] + a[3]);
        }
#pragma unroll
        for (int o = 32; o > 0; o >>= 1) s += __shfl_xor(s, o);
        const float mean = s * (1.0f / 1024.0f); float s2 = 0.f;
#pragma unroll
        for (int i = 0; i < 4; ++i)
#pragma unroll
            for (int r = 0; r < 4; ++r) { const float d = v[i][r] - mean; s2 += d * d; }
#pragma unroll
        for (int o = 32; o > 0; o >>= 1) s2 += __shfl_xor(s2, o);
        const float rstd = rsqrtf(s2 * (1.0f / 1024.0f) + 1e-5f);
#pragma unroll
        for (int i = 0; i < 4; ++i) {
            const int col = i * 256 + lane * 4;
            const f32x4 g = *(const f32x4*)(p.ln2_g + col), bb = *(const f32x4*)(p.ln2_b + col);
            f32x4 y;
#pragma unroll
            for (int r = 0; r < 4; ++r) y[r] = (v[i][r] - mean) * rstd * g[r] + bb[r];
            *(f32x4*)(p.out + (size_t)row * 1024 + col) = y;
        }
    }
}


#define XB_TMO      128
#define XB_XCNT(j)  (256  + 64 * (j))
#define XB_XSUB(j)  (1280 + 64 * (j))
#define XB_XGEN(j)  (2304 + 64 * (j))
#define XB_TOP      3328
#define XB_TOPGEN   3392
#define XCD_BAR_WORDS 3456
#define XB_SPIN_CAP (1u << 20)
#define LAS __attribute__((address_space(3)))
DEVI unsigned xb_ld(unsigned* p)              { return __hip_atomic_load(p, __ATOMIC_RELAXED, __HIP_MEMORY_SCOPE_AGENT); }
DEVI unsigned xb_add(unsigned* p, unsigned v) { return __hip_atomic_fetch_add(p, v, __ATOMIC_RELAXED, __HIP_MEMORY_SCOPE_AGENT); }
DEVI unsigned xb_xcc_id() { return (unsigned)__builtin_amdgcn_s_getreg((3 << 11) | 20) & 0xFu; }
#define XB_SPIN(cond, bar) do { unsigned _sp = 0; while (cond) { __builtin_amdgcn_s_sleep(1); \
    if ((++_sp & 255u) == 0u) { if (xb_ld(&(bar)[XB_TMO])) break; if (_sp > XB_SPIN_CAP) { atomicAdd(&(bar)[XB_TMO], 1u); break; } } } } while (0)
struct XcdBarrier { unsigned* bar; unsigned x; volatile LAS unsigned* st; };
DEVI XcdBarrier xcd_barrier_post(unsigned* bar, volatile LAS unsigned* st) {
    XcdBarrier b; b.bar = bar; b.x = xb_xcc_id(); b.st = st;
    if (threadIdx.x == 0) st[3] = xb_add(&bar[XB_XCNT(b.x)], 1u);
    return b;
}
DEVI void xcd_barrier_complete(unsigned* bar, unsigned x, unsigned& nloc, unsigned& nx) {
    const unsigned G = gridDim.x * gridDim.y * gridDim.z;
    unsigned sum, cnt, mine, sp = 0u;
    for (;;) {
        sum = 0u; cnt = 0u; mine = 0u;
#pragma unroll
        for (unsigned j = 0; j < 16; ++j) { const unsigned c = xb_ld(&bar[XB_XCNT(j)]); sum += c; cnt += (c > 0u) ? 1u : 0u; mine = (j == x) ? c : mine; }
        if (sum == G) break;
        __builtin_amdgcn_s_sleep(1);
        if ((++sp & 255u) == 0u) { if (xb_ld(&bar[XB_TMO])) break; if (sp > XB_SPIN_CAP) { atomicAdd(&bar[XB_TMO], 1u); break; } }
    }
    nloc = mine > 0u ? mine : 1u; nx = cnt > 0u ? cnt : 1u;
}
DEVI void xcd_barrier(const XcdBarrier& b) {
    asm volatile("s_waitcnt vmcnt(0)" ::: "memory");
    __syncthreads();
    if (threadIdx.x == 0) {
        unsigned* bar = b.bar;
        __builtin_amdgcn_s_waitcnt(0);
        unsigned nloc = b.st[0], nx = b.st[1];
        if (nloc == 0u) { xcd_barrier_complete(bar, b.x, nloc, nx); b.st[0] = nloc; b.st[1] = nx; }
        const unsigned old = xb_add(&bar[XB_XSUB(b.x)], 1u);
        const unsigned gen = old / nloc;
        if (old + 1u == (gen + 1u) * nloc) {
            __builtin_amdgcn_fence(__ATOMIC_RELEASE, "agent");
            asm volatile("s_waitcnt vmcnt(0)" ::: "memory");
            const unsigned og = xb_add(&bar[XB_TOP], 1u);
            const unsigned tg = og / nx;
            if (og + 1u == (tg + 1u) * nx) xb_add(&bar[XB_TOPGEN], 1u);
            else XB_SPIN(xb_ld(&bar[XB_TOPGEN]) == tg, bar);
            __builtin_amdgcn_fence(__ATOMIC_ACQUIRE, "agent");
            xb_add(&bar[XB_XGEN(b.x)], 1u);
            asm volatile("s_waitcnt vmcnt(0)" ::: "memory");
        } else {
            XB_SPIN(xb_ld(&bar[XB_XGEN(b.x)]) == gen, bar);
            __builtin_amdgcn_fence(__ATOMIC_ACQUIRE, "agent");
            asm volatile("s_waitcnt vmcnt(0)" ::: "memory");
        }
    }
    __syncthreads();
}
constexpr size_t OFF_BAR = 131072;

#ifndef DBG
#define DBG 0
#endif
DEVI void dump_f32(const Params& p, size_t off) {
    const f32x4* src = (const f32x4*)(p.ws + off); f32x4* dst = (f32x4*)p.out;
    for (int i = blockIdx.x * 256 + threadIdx.x; i < T_ * D_ / 4; i += gridDim.x * 256) dst[i] = src[i];
}
DEVI void dump_bf16(const Params& p, size_t off, int ld, int coff) {
    const bf16_t* src = (const bf16_t*)(p.ws + off);
    for (int i = blockIdx.x * 256 + threadIdx.x; i < T_ * D_; i += gridDim.x * 256) { const int row = i >> 10, col = i & 1023; p.out[i] = bf2f(src[(size_t)row * ld + coff + col]); }
}
DEVI float flat_bf(const Params& p, size_t off, size_t n, size_t i) { const bf16_t* b = (const bf16_t*)(p.ws + off); float a = 0.f; for (size_t j = i; j < n; j += (size_t)T_ * D_) a += bf2f(b[j]); return a; }
DEVI void dump_p1(const Params& p) {
    const size_t N = (size_t)T_ * D_;
    for (size_t i = (size_t)blockIdx.x * 256 + threadIdx.x; i < N; i += (size_t)gridDim.x * 256) {
        float a = 0.f;
        a += flat_bf(p, OFF_MG, 2 * N, i) + flat_bf(p, OFF_GS, 2 * N, i);
        a += flat_bf(p, OFF_QR, N / 2, i % (N / 2)) + flat_bf(p, OFF_KR, N / 2, i % (N / 2)) + flat_bf(p, OFF_QG, N / 2, i % (N / 2));
        a += flat_bf(p, OFF_KRT, N / 2, i % (N / 2)) + flat_bf(p, OFF_KGT, N / 2, i % (N / 2));
        a += flat_bf(p, OFF_VRT, N, i) + flat_bf(p, OFF_VGT, N, i);
        a += ((const float*)(p.ws + OFF_GA))[i % ((size_t)T_ * 16)];
        p.out[i] = a;
    }
}
constexpr int NPHASE = 13;
__global__ void __launch_bounds__(512, 2) fwd_megakernel(Params p) {
    unsigned char* const smem_all = smem_all_g;
    unsigned char* smem = smem_all + VH * SMEM_HALF;
    uint4* xb_words = (uint4*)(smem_all + 2 * SMEM_HALF - 16);
    if (threadIdx.x == 0) *xb_words = make_uint4(0u, 0u, blockIdx.x, 0u);
    __syncthreads();
    const XcdBarrier xb = xcd_barrier_post((unsigned*)(p.ws + OFF_BAR), (volatile LAS unsigned*)xb_words);
#ifndef REPMASK
#define REPMASK 0
#endif
#ifndef TIMEPHASE
#define TIMEPHASE -1
#endif
#define RUN_PHASE(K, CALL) do { if (p.phase_lo <= (K) && (K) < p.phase_hi) { \
        const unsigned long long tp0_ = (TIMEPHASE == (K)) ? __builtin_amdgcn_s_memrealtime() : 0ull; \
        _Pragma("unroll 1") for (int rep_ = ((REPMASK >> (K)) & 1); rep_ >= 0; --rep_) { CALL; if (rep_ > 0 || (K) + 1 < p.phase_hi) xcd_barrier(xb); } \
        if (TIMEPHASE == (K)) { const unsigned long long tp1_ = __builtin_amdgcn_s_memrealtime(); while (__builtin_amdgcn_s_memrealtime() - tp1_ < tp1_ - tp0_) __builtin_amdgcn_s_sleep(8); } } } while (0)
    RUN_PHASE(0, phase0(p, smem));
    if (p.phase_lo == 0 && p.phase_hi > 1) {
        if (threadIdx.x == 0) {
            unsigned* bar = (unsigned*)(p.ws + OFF_BAR); bool ok = (gridDim.x & 7u) == 0u && xb.x < 8u;
            for (unsigned j = 0; j < 16; ++j) { const unsigned c = xb_ld(&bar[XB_XCNT(j)]); ok = ok && (j < 8 ? c == gridDim.x / 8u : c == 0u); }
            if (ok) ((volatile int*)xb_words)[2] = (int)(((volatile unsigned*)xb_words)[3] * 8u + xb.x);
        }
        __syncthreads();
    }
    RUN_PHASE(1, phase1(p, smem_all));
#if DBG == 2
    dump_p1(p); return;
#endif
    RUN_PHASE(2, phase2(p, smem));
#if DBG == 5
    { const size_t N = (size_t)T_ * D_; for (size_t i = (size_t)blockIdx.x * 256 + threadIdx.x; i < N; i += (size_t)gridDim.x * 256) p.out[i] = flat_bf(p, OFF_KG2, N / 2, i % (N / 2)) + ((const float*)(p.ws + OFF_DEC))[i % (2048 * 128)]; } return;
#endif
#ifdef SCANPROBE
    phase3t(p, smem, 1); xcd_barrier(xb);
#endif
    RUN_PHASE(3, phase3t(p, smem, 0));
#if DBG == 6
    dump_bf16(p, OFF_OO, 2048, 1024); return;
#endif
#if DBG == 7
    { const bf16_t* src = (const bf16_t*)(p.ws + OFF_OO);
      for (int i = blockIdx.x * 256 + threadIdx.x; i < T_ * D_; i += gridDim.x * 256) { const int row = i >> 10, col = i & 1023; const float v = bf2f(src[(size_t)row * 2048 + 1024 + col]); p.out[i] = (fabsf(v) < 1e30f) ? v : 12345.0f; } } return;
#endif
    RUN_PHASE(4, phase4(p, smem));
#if DBG == 3
    dump_bf16(p, OFF_Y, 2048, 0); return;
#endif
#if DBG == 4
    dump_bf16(p, OFF_Y, 2048, 1024); return;
#endif
    RUN_PHASE(5, phase5(p, smem_all));
    RUN_PHASE(6, phase6(p, smem_all));
    RUN_PHASE(7, (((RB >> 3) & 1) ? (phase8(p, smem_all), conv_expert_weights(p, smem)) : (conv_expert_weights(p, smem), phase8(p, smem_all))));
#if DBG == 1
    return;
#endif
    RUN_PHASE(10, phase10(p, smem_all));
    RUN_PHASE(11, phase11(p, smem_all));
    RUN_PHASE(12, phase12(p));
#ifdef BARPROBE
    _Pragma("unroll 1") for (int bp_ = 0; bp_ < 20; ++bp_) xcd_barrier(xb);
#endif
#undef RUN_PHASE
}

extern "C" void kernel_launch(void* const* d_in, const int* in_sizes, int n_in, void* d_out, int out_size, void* d_ws, size_t ws_size,
                              hipStream_t stream) {
    static int grid_blocks = 0;
    if (!grid_blocks) {
        int dev = 0, cus = 0, per_cu = 0;
        hipGetDevice(&dev);
        hipDeviceGetAttribute(&cus, hipDeviceAttributeMultiprocessorCount, dev);
        hipOccupancyMaxActiveBlocksPerMultiprocessor(&per_cu, fwd_megakernel, 512, 0);
        if (per_cu > 1) per_cu = 1;
        if (per_cu < 1) per_cu = 1;
        grid_blocks = cus * per_cu;
    }
    if (ws_size < WS_NEEDED) { fprintf(stderr, "workspace too small: %zu < %zu\n", ws_size, (size_t)WS_NEEDED); return; }
    Params p{};
    p.x = (const float*)d_in[0]; p.w_in = (const float*)d_in[1]; p.ret_norm_g = (const float*)d_in[2]; p.gate_w2 = (const float*)d_in[3];
    p.gate_b = (const float*)d_in[4]; p.gla_norm_g = (const float*)d_in[5]; p.w_ret_out = (const float*)d_in[6]; p.w_gla_out = (const float*)d_in[7];
    p.w_o = (const float*)d_in[8]; p.ln1_g = (const float*)d_in[9]; p.ln1_b = (const float*)d_in[10]; p.router_w = (const float*)d_in[11];
    p.router_bias = (const float*)d_in[12]; p.ew_gate = (const float*)d_in[13]; p.ew_up = (const float*)d_in[14]; p.ew_down = (const float*)d_in[15];
    p.sw_gate = (const float*)d_in[16]; p.sw_up = (const float*)d_in[17]; p.sw_down = (const float*)d_in[18]; p.ln2_g = (const float*)d_in[19];
    p.ln2_b = (const float*)d_in[20];
    p.out = (float*)d_out; p.ws = (unsigned char*)d_ws; p.phase_lo = 0; p.phase_hi = NPHASE;
    void* args[] = {&p};
    (void)hipMemsetAsync((unsigned char*)d_ws + OFF_BAR, 0, XCD_BAR_WORDS * 4, stream);
    hipError_t e = hipLaunchCooperativeKernel((void*)fwd_megakernel, dim3(grid_blocks), dim3(512), args, 0, stream);
    if (e != hipSuccess) fprintf(stderr, "cooperative launch failed: %s (grid %d)\n", hipGetErrorString(e), grid_blocks);
}
```

```cpp
#include <hip/hip_runtime.h>
#include <hip/hip_cooperative_groups.h>
#include <cstdio>
#include <cstdint>
namespace cg = cooperative_groups;

typedef unsigned short bf16_t;
typedef short bf16x8 __attribute__((ext_vector_type(8)));
typedef float f32x4 __attribute__((ext_vector_type(4)));
typedef unsigned u32x2 __attribute__((ext_vector_type(2)));
typedef unsigned u32x4 __attribute__((ext_vector_type(4)));
#define DEVI __device__ __forceinline__
#define VH ((int)(threadIdx.x >> 8))
#define VT ((int)(threadIdx.x & 255))
#define RB (__builtin_amdgcn_readfirstlane(((const int*)(smem_all_g + 2 * SMEM_HALF - 16))[2]))
#define RG ((int)gridDim.x)
#define VB (RB * 2 + VH)
#define VG (RG * 2)

constexpr int T_ = 32768;
constexpr int D_ = 1024;
constexpr int DIN_ = 8208;
constexpr int NE_ = 256;
constexpr float ALPHA_ = 1.189207115002721f;
constexpr float KSCALE_ = 0.08838834764831845f;

constexpr size_t MB = 1ull << 20;
constexpr size_t OFF_CNT  = (size_t)766 << 20;
constexpr int CNT_STRIDE = 1024;
constexpr size_t OFF_CS   = 1 * MB;
constexpr size_t OFF_WT   = 3 * MB;
constexpr size_t FB = 27 * MB;
constexpr size_t OFF_QR   = FB + 0 * MB;
constexpr size_t OFF_KR   = FB + 32 * MB;
constexpr size_t OFF_VRT  = FB + 64 * MB;
constexpr size_t OFF_GS   = FB + 128 * MB;
constexpr size_t OFF_MG   = FB + 256 * MB;
constexpr size_t OFF_KRT  = FB + 384 * MB;
constexpr size_t OFF_QG   = FB + 416 * MB;
constexpr size_t OFF_VGT  = FB + 448 * MB;
constexpr size_t OFF_KGT  = FB + 512 * MB;
constexpr size_t OFF_GA   = FB + 544 * MB;
constexpr size_t OFF_XB   = FB + 546 * MB;
constexpr size_t OFF_KG2  = FB + 546 * MB;
constexpr size_t OFF_DEC  = FB + 578 * MB;
constexpr size_t OFF_OO   = FB + 579 * MB;
constexpr size_t OFF_Y    = FB + 384 * MB;
constexpr size_t OFF_MRG  = FB + 0 * MB;
constexpr size_t OFF_QGN  = 767 * MB;
constexpr size_t OFF_QFR  = 734 * MB;
constexpr size_t OFF_WGU  = 767 * MB;
constexpr size_t OFF_X1B  = FB + 0 * MB;
constexpr size_t OFF_WD   = FB + 64 * MB;
constexpr size_t OFF_LIST = FB + 193 * MB;
constexpr size_t OFF_WL   = FB + 193 * MB + 512 * MB;
constexpr size_t OFF_H    = FB + 227 * MB;
constexpr size_t OFF_YX   = FB + 371 * MB;
constexpr size_t OFF_T1   = FB + 371 * MB;
constexpr size_t WS_NEEDED = 1024 * MB;

constexpr int WT_BN = 0, WT_AT = 5888, WT_RET = 8960, WT_GLA = 9984, WT_O = 11008, WT_R = 12032, WT_ROWS = 12288;

struct Params {
    const float *x, *w_in, *ret_norm_g, *gate_w2, *gate_b, *gla_norm_g, *w_ret_out, *w_gla_out, *w_o, *ln1_g, *ln1_b,
                *router_w, *router_bias, *ew_gate, *ew_up, *ew_down, *sw_gate, *sw_up, *sw_down, *ln2_g, *ln2_b;
    float* out;
    unsigned char* ws;
    int phase_lo, phase_hi;
};

static __device__ const float c_inv_freq[64] = {
  1.000000000e+00f, 8.659643531e-01f, 7.498942018e-01f, 6.493816376e-01f,
  5.623413324e-01f, 4.869675338e-01f, 4.216965139e-01f, 3.651741147e-01f,
  3.162277639e-01f, 2.738419771e-01f, 2.371373773e-01f, 2.053525001e-01f,
  1.778279394e-01f, 1.539926529e-01f, 1.333521456e-01f, 1.154781953e-01f,
  1.000000015e-01f, 8.659642935e-02f, 7.498942316e-02f, 6.493816525e-02f,
  5.623413250e-02f, 4.869675264e-02f, 4.216964915e-02f, 3.651741147e-02f,
  3.162277490e-02f, 2.738419548e-02f, 2.371373773e-02f, 2.053525113e-02f,
  1.778279431e-02f, 1.539926510e-02f, 1.333521400e-02f, 1.154781971e-02f,
  9.999999776e-03f, 8.659643121e-03f, 7.498942316e-03f, 6.493816152e-03f,
  5.623413250e-03f, 4.869675264e-03f, 4.216964822e-03f, 3.651741194e-03f,
  3.162277630e-03f, 2.738419687e-03f, 2.371373819e-03f, 2.053525066e-03f,
  1.778279431e-03f, 1.539926510e-03f, 1.333521446e-03f, 1.154782018e-03f,
  1.000000047e-03f, 8.659643354e-04f, 7.498941850e-04f, 6.493816036e-04f,
  5.623413017e-04f, 4.869675322e-04f, 4.216965172e-04f, 3.651741135e-04f,
  3.162277571e-04f, 2.738419571e-04f, 2.371373703e-04f, 2.053525095e-04f,
  1.778279402e-04f, 1.539926598e-04f, 1.333521504e-04f, 1.154782003e-04f };

DEVI float bf2f(unsigned short u) { return __uint_as_float(((unsigned)u) << 16); }
DEVI float bflo(unsigned u) { return __uint_as_float(u << 16); }
DEVI float bfhi(unsigned u) { return __uint_as_float(u & 0xffff0000u); }
typedef float f32x2 __attribute__((ext_vector_type(2)));
typedef __bf16 bf16x2_t __attribute__((ext_vector_type(2)));
DEVI unsigned pk2(float lo, float hi) { const f32x2 v = {lo, hi}; const bf16x2_t b = __builtin_convertvector(v, bf16x2_t); return __builtin_bit_cast(unsigned, b); }
DEVI unsigned short f2bf(float f) { return (unsigned short)(pk2(f, 0.f) & 0xffffu); }
DEVI u32x2 pk4(f32x4 v) { u32x2 r; r.x = pk2(v[0], v[1]); r.y = pk2(v[2], v[3]); return r; }
DEVI f32x4 unpk4(u32x2 u) { f32x4 r; r[0] = bflo(u.x); r[1] = bfhi(u.x); r[2] = bflo(u.y); r[3] = bfhi(u.y); return r; }
constexpr float YX_SCALE = 16.0f;
DEVI unsigned pk4_fp8(f32x4 v) { int w = 0; w = __builtin_amdgcn_cvt_pk_fp8_f32(v[0], v[1], w, false); w = __builtin_amdgcn_cvt_pk_fp8_f32(v[2], v[3], w, true); return (unsigned)w; }
DEVI f32x4 unpk4_fp8(unsigned u) { f32x4 r; r[0] = __builtin_amdgcn_cvt_f32_fp8((int)u, 0); r[1] = __builtin_amdgcn_cvt_f32_fp8((int)u, 1); r[2] = __builtin_amdgcn_cvt_f32_fp8((int)u, 2); r[3] = __builtin_amdgcn_cvt_f32_fp8((int)u, 3); return r; }
DEVI f32x4 clamp4(f32x4 v, float lim) { f32x4 r; for (int i = 0; i < 4; ++i) r[i] = __builtin_amdgcn_fmed3f(v[i], -lim, lim); return r; }
DEVI float sigmoidf_(float v) { return __builtin_amdgcn_rcpf(1.0f + __builtin_amdgcn_exp2f(v * -1.4426950408889634f)); }
DEVI float siluf_(float v) { return v * __builtin_amdgcn_rcpf(1.0f + __builtin_amdgcn_exp2f(v * -1.4426950408889634f)); }
DEVI float gamma_log2(int h) { return log2f(1.0f - exp2f(-5.0f - (float)h)); }
DEVI f32x4 mfma16(bf16x8 a, bf16x8 b, f32x4 c) { return __builtin_amdgcn_mfma_f32_16x16x32_bf16(a, b, c, 0, 0, 0); }
DEVI unsigned kf_off(int item, int dk, int m8) { return ((((unsigned)item * 4u + (unsigned)(dk >> 5)) * 4u + (unsigned)(m8 >> 4)) * 64u + (unsigned)((m8 >> 3) & 1) * 32u + (unsigned)(dk & 31)) * 8u; }
DEVI unsigned vf_off(int item, int dv, int m8) { return ((((unsigned)item * 8u + (unsigned)(dv >> 5)) * 4u + (unsigned)(m8 >> 4)) * 64u + (unsigned)((m8 >> 3) & 1) * 32u + (unsigned)(dv & 31)) * 8u; }
DEVI unsigned qf_off(int bc, int h, int tokl, int dk8, int hh) {
    return ((((((unsigned)bc * 4u + (unsigned)h) * 2u + (unsigned)(tokl >> 5)) * 4u + (unsigned)(dk8 >> 5)) * 2u + (unsigned)((dk8 >> 4) & 1)) * 64u + (unsigned)hh * 32u + (unsigned)(tokl & 31)) * 8u + (unsigned)((dk8 >> 3) & 1) * 4u; }
DEVI int vperm(int n) { const int wc = n >> 6, nt = (n >> 4) & 3, i = n & 15; return wc * 64 + (nt >> 1) * 32 + 8 * (i >> 2) + 4 * (nt & 1) + (i & 3); }
DEVI int dperm2(int v) { return ((v >> 5) & 1) * 64 + (v >> 6) * 32 + (v & 31); }
DEVI u32x4 pk8(f32x4 a, f32x4 b) { u32x4 r; r.x = pk2(a[0], a[1]); r.y = pk2(a[2], a[3]); r.z = pk2(b[0], b[1]); r.w = pk2(b[2], b[3]); return r; }
DEVI void unpk8(u32x4 u, f32x4& a, f32x4& b) { a[0] = bflo(u.x); a[1] = bfhi(u.x); a[2] = bflo(u.y); a[3] = bfhi(u.y); b[0] = bflo(u.z); b[1] = bfhi(u.z); b[2] = bflo(u.w); b[3] = bfhi(u.w); }
DEVI int dperm(int v) { const int wc = v >> 6, nt = (v >> 4) & 3, c = v & 15; return (nt & 1) * 16 + wc * 32 + c + (nt >> 1) * 64; }

struct __attribute__((aligned(16))) GemmSmem { bf16_t a[2][128 * 64]; bf16_t b[2][128 * 64]; };
constexpr int SMEM_GEMM = sizeof(GemmSmem);
constexpr int SMEM_BYTES = SMEM_GEMM + 2048 + 16;
constexpr int SMEM_HALF = (SMEM_BYTES + 255) & ~255;
constexpr int SMEM_MOE = 163840 - 2 * SMEM_HALF;
__shared__ __attribute__((aligned(16))) unsigned char smem_all_g[2 * SMEM_HALF + SMEM_MOE];
DEVI int gemm_src_chunk(int t) { return ((t & 7) ^ ((t >> 4) & 7)) * 8; }

template <bool SWAP, int BKIND>
DEVI void gemm_kloop(f32x4 (&acc)[4][4], const bf16_t* const (&pa)[4], const bf16_t* const (&pb)[4],
                     const float* pbf, int ldb, int nk, GemmSmem& sm) {
    const int t = VT, lane = t & 63, w = t >> 6, wr = w >> 1, wc = w & 1, l15 = lane & 15, q = lane >> 4;
    const int kg = t & 7, ng = t >> 3;
    f32x4 rf[8];
#define GEMM_ISSUE(BUF, KO) do { \
        _Pragma("unroll") for (int i = 0; i < 4; ++i) \
            __builtin_amdgcn_global_load_lds((const unsigned*)(pa[i] + (KO)), (unsigned*)((char*)sm.a[BUF] + i * 4096 + t * 16), 16, 0, 0); \
        if (BKIND == 0) { _Pragma("unroll") for (int i = 0; i < 4; ++i) \
            __builtin_amdgcn_global_load_lds((const unsigned*)(pb[i] + (KO)), (unsigned*)((char*)sm.b[BUF] + i * 4096 + t * 16), 16, 0, 0); } \
        else { const float* pp = pbf + (size_t)((KO) + 4 * kg) * ldb; \
            _Pragma("unroll") for (int i = 0; i < 4; ++i) { rf[i] = *(const f32x4*)(pp + (size_t)i * ldb); rf[4 + i] = *(const f32x4*)(pp + (size_t)(32 + i) * ldb); } } } while (0)
#define GEMM_LSTORE_B(BUF) do { if (BKIND == 1) { \
            _Pragma("unroll") for (int i = 0; i < 4; ++i) { \
                u32x2 v0, v1; \
                v0.x = pk2(rf[0][i], rf[1][i]); v0.y = pk2(rf[2][i], rf[3][i]); v1.x = pk2(rf[4][i], rf[5][i]); v1.y = pk2(rf[6][i], rf[7][i]); \
                const int n = 4 * ng + i, sw = (n >> 1) & 7; \
                char* rowp = (char*)sm.b[BUF] + n * 128 + (kg & 1) * 8; \
                *(u32x2*)(rowp + (((kg >> 1) ^ sw) * 16)) = v0; *(u32x2*)(rowp + (((4 + (kg >> 1)) ^ sw) * 16)) = v1; } } } while (0)
    GEMM_ISSUE(0, 0);
    GEMM_LSTORE_B(0);
    __syncthreads();
#define GEMM_KSTEP(CUR, KT) do { \
        const bool more = ((KT) + 1 < nk); \
        if (more) { GEMM_ISSUE((CUR) ^ 1, ((KT) + 1) * 64); } \
        __builtin_amdgcn_sched_barrier(0); \
        _Pragma("unroll") for (int ss = 0; ss < 2; ++ss) { \
            bf16x8 af[4], bfr[4]; \
            const int coff = ((ss * 4 + q) ^ (l15 >> 1)) * 16; \
            _Pragma("unroll") for (int i = 0; i < 4; ++i) { \
                af[i]  = *(const bf16x8*)((const char*)sm.a[CUR] + (wr * 64 + i * 16 + l15) * 128 + coff); \
                bfr[i] = *(const bf16x8*)((const char*)sm.b[CUR] + (wc * 64 + i * 16 + l15) * 128 + coff); } \
            _Pragma("unroll") for (int mt = 0; mt < 4; ++mt) \
                _Pragma("unroll") for (int nt = 0; nt < 4; ++nt) \
                    acc[mt][nt] = SWAP ? mfma16(bfr[nt], af[mt], acc[mt][nt]) : mfma16(af[mt], bfr[nt], acc[mt][nt]); } \
        __builtin_amdgcn_sched_barrier(0); \
        if (more) { GEMM_LSTORE_B((CUR) ^ 1); } \
        __syncthreads(); } while (0)
#pragma unroll 1
    for (int kt = 0; kt < nk; kt += 2) { GEMM_KSTEP(0, kt); GEMM_KSTEP(1, kt + 1); }
#undef GEMM_KSTEP
#undef GEMM_LSTORE_B
#undef GEMM_ISSUE
}

DEVI void zero_acc(f32x4 (&acc)[4][4]) {
#pragma unroll
    for (int i = 0; i < 4; ++i)
#pragma unroll
        for (int j = 0; j < 4; ++j) acc[i][j] = (f32x4){0.f, 0.f, 0.f, 0.f};
}

namespace pg8 {
#define PG8_LAS __attribute__((address_space(3)))
typedef unsigned short bf16_t;
typedef short bf16x8 __attribute__((ext_vector_type(8)));
typedef float f32x4 __attribute__((ext_vector_type(4)));
typedef unsigned u32x4 __attribute__((ext_vector_type(4)));
constexpr int BM = 256, BK = 64, HALF = 128, HTB = HALF * BK * 2  , STAGE_BYTES = 8 * HTB, NXCD = 8, WGM = 8;

__host__ __device__ __forceinline__ int lds_byte(int r, int c) { const int st = (r >> 4) * 2 + (c >> 5), rr = r & 15, cc = c & 31, ob = rr * 64 + cc * 2; return st * 1024 + (ob ^ (((ob >> 9) & 1) << 5)); }
__host__ __device__ __forceinline__ void stage_rc(int b, int& R, int& C) { const int st = b / 1024, sb = b % 1024, swz = sb ^ (((sb >> 9) & 1) << 5); R = (st >> 1) * 16 + swz / 64; C = (st & 1) * 32 + (swz % 64) / 2; }
__host__ __device__ __forceinline__ int perm32(int rho) { const int n = rho >> 4, i = rho & 15; return 8 * (i >> 2) + 4 * n + (i & 3); }

struct Unit { int pm, pn, e, r0, ce; };
struct Gemm { const bf16_t* A; const bf16_t* Bt; int M, N, K; };

struct StaticOrder {
    int nM, nN, nwg, G, c;
    __host__ __device__ void init(int M, int N, int G_, int c_) { nM = M / BM; nN = N / BM; nwg = nM * nN; G = G_; c = c_; }
    __host__ __device__ bool next(int i, Unit& u) const {
        const long L = (long)i * G + c; if (L >= nwg) return false;
        int wgid = (int)L; { const int q = nwg / NXCD, r = nwg % NXCD, xcd = wgid % NXCD, off = wgid / NXCD; wgid = (xcd < r ? xcd * (q + 1) : r * (q + 1) + (xcd - r) * q) + off; }
        const int nig = WGM * nN, gid = wgid / nig, fm = gid * WGM, gsz = (nM - fm) < WGM ? (nM - fm) : WGM;
        u.pm = fm + ((wgid % nig) % gsz); u.pn = (wgid % nig) / gsz; return true;
    }
    __device__ __forceinline__ void a_ready(const Unit&) const {}
    __device__ __forceinline__ void done(const Unit&) const {}
};


template <class Epi, class Sched, bool ALIGN_EPI = false, bool SP2 = false>
__device__ __forceinline__ void gemm_phase(PG8_LAS unsigned char* lds, const Gemm g, const Sched& S, const Epi& E) {
    const int tid = threadIdx.x, wid = __builtin_amdgcn_readfirstlane(tid >> 6), lane = tid & 63, wr = wid >> 2, wc = wid & 3, fr = lane & 15, fq = lane >> 4;
    const int K = g.K, nt = K / BK;
    unsigned voffA[2], voffB[2];
#pragma unroll
    for (int i = 0; i < 2; ++i) { int R, C; stage_rc(tid * 16 + i * 8192, R, C); const int Rb = Epi::PERM ? ((R & ~31) + perm32(R & 31)) : R;
        voffA[i] = (unsigned)(R * K + C) * 2u; voffB[i] = (unsigned)(Rb * K + C) * 2u; }
    const size_t kstep = (size_t)(BK * 2);
    const size_t hstep = (size_t)HALF * K * 2;
    const size_t tstep = 2 * hstep;
    const unsigned ldsw = (unsigned)wid * 1024u;
    const int aoff = lds_byte(wr * 64 + fr, fq * 8), boff = lds_byte(wc * 32 + fr, fq * 8);
#define PG8_SA(b, h) (((b) * 2 + (h)) * HTB)
#define PG8_SB(b, h) ((4 + (b) * 2 + (h)) * HTB)
#define PG8_STAGE(bufoff, gbase, voff) do { _Pragma("unroll") for (int _i = 0; _i < 2; ++_i) \
        __builtin_amdgcn_global_load_lds((const unsigned*)((const char*)(gbase) + (voff)[_i]), (PG8_LAS unsigned*)(lds + (bufoff) + ldsw + _i * 8192), 16, 0, 0); } while (0)
#define PG8_LDA(dst, b, h) do { _Pragma("unroll") for (int m = 0; m < 4; ++m) _Pragma("unroll") for (int k = 0; k < 2; ++k) dst[m][k] = *(const PG8_LAS bf16x8*)(lds + PG8_SA(b, h) + aoff + m * 2048 + k * 1024); } while (0)
#define PG8_LDB(dst, b, h) do { _Pragma("unroll") for (int n = 0; n < 2; ++n) _Pragma("unroll") for (int k = 0; k < 2; ++k) dst[n][k] = *(const PG8_LAS bf16x8*)(lds + PG8_SB(b, h) + boff + n * 2048 + k * 1024); } while (0)
#define PG8_MMA(ai, bj, At, Bt) do { __builtin_amdgcn_s_setprio(1); _Pragma("unroll") for (int m = 0; m < 4; ++m) _Pragma("unroll") for (int n = 0; n < 2; ++n) _Pragma("unroll") for (int k = 0; k < 2; ++k) \
        acc[ai][bj][m][n] = __builtin_amdgcn_mfma_f32_16x16x32_bf16(Bt[n][k], At[m][k], acc[ai][bj][m][n], 0, 0, 0); __builtin_amdgcn_s_setprio(0); } while (0)
#define PG8_WAIT_V(n) asm volatile("s_waitcnt vmcnt(" #n ")" ::: "memory")
#define PG8_WAIT_L(n) asm volatile("s_waitcnt lgkmcnt(" #n ")" ::: "memory")
#define PG8_BAR __builtin_amdgcn_s_barrier()
#define PG8_SCHED __builtin_amdgcn_sched_barrier(0)
    Unit cur, nxt; int ui = 0;
    if (!S.next(0, cur)) return;
    f32x4 acc[2][2][4][2];
#pragma unroll
    for (int a = 0; a < 2; ++a)
#pragma unroll
        for (int b = 0; b < 2; ++b)
#pragma unroll
            for (int m = 0; m < 4; ++m)
#pragma unroll
                for (int n = 0; n < 2; ++n) acc[a][b][m][n] = (f32x4){0.f, 0.f, 0.f, 0.f};
    bf16x8 At[4][2], B0[2][2], B1[2][2];
    const char* cA = (const char*)g.A + (size_t)cur.pm * tstep; const char* cB = (const char*)g.Bt + (size_t)cur.pn * tstep;
    S.a_ready(cur);
    if constexpr (SP2) {
        PG8_STAGE(PG8_SB(0, 0), cB, voffB); PG8_STAGE(PG8_SB(0, 1), cB + hstep, voffB); PG8_STAGE(PG8_SA(0, 0), cA, voffA); PG8_STAGE(PG8_SA(0, 1), cA + hstep, voffA);
        if (wr == 1) PG8_BAR;
        PG8_WAIT_V(2); PG8_BAR;
        PG8_STAGE(PG8_SB(1, 0), cB + kstep, voffB); PG8_STAGE(PG8_SA(1, 0), cA + kstep, voffA); PG8_STAGE(PG8_SB(1, 1), cB + hstep + kstep, voffB);
        PG8_WAIT_V(6); PG8_BAR;
    } else {
        PG8_STAGE(PG8_SB(0, 0), cB, voffB); PG8_STAGE(PG8_SA(0, 0), cA, voffA); PG8_STAGE(PG8_SB(0, 1), cB + hstep, voffB); PG8_STAGE(PG8_SA(0, 1), cA + hstep, voffA);
        if (wr == 1) PG8_BAR;
        PG8_WAIT_V(4); PG8_BAR;
        PG8_STAGE(PG8_SB(1, 0), cB + kstep, voffB); PG8_STAGE(PG8_SA(1, 0), cA + kstep, voffA); PG8_STAGE(PG8_SB(1, 1), cB + hstep + kstep, voffB);
        PG8_WAIT_V(6); PG8_BAR;
    }
    for (;;) {
        const bool has_next = S.next(ui + 1, nxt);
        const char* nA = has_next ? (const char*)g.A + (size_t)nxt.pm * tstep : cA; const char* nB = has_next ? (const char*)g.Bt + (size_t)nxt.pn * tstep : cB;
        for (int t = 0; t < nt; t += 2) {
            const bool last = (t == nt - 2);
            const char* a1 = cA + (size_t)(t + 1) * kstep;
            const char* a2 = last ? nA : cA + (size_t)(t + 2) * kstep; const char* b2 = last ? nB : cB + (size_t)(t + 2) * kstep;
            const char* a3 = a2 + kstep; const char* b3 = b2 + kstep;
            if (last && has_next) S.a_ready(nxt);
            if constexpr (SP2) {
            PG8_LDB(B0, 0, 0); PG8_LDB(B1, 0, 1); PG8_SCHED; PG8_LDA(At, 0, 0); PG8_STAGE(PG8_SA(1, 1), a1 + hstep, voffA);
            PG8_WAIT_V(8); PG8_WAIT_L(0); PG8_BAR; PG8_MMA(0, 0, At, B0); PG8_MMA(0, 1, At, B1); PG8_BAR; PG8_SCHED;
            PG8_LDA(At, 0, 1); PG8_STAGE(PG8_SB(0, 0), b2, voffB); PG8_STAGE(PG8_SB(0, 1), b2 + hstep, voffB); PG8_STAGE(PG8_SA(0, 0), a2, voffA);
            PG8_WAIT_V(8); PG8_WAIT_L(0); PG8_BAR; PG8_MMA(1, 0, At, B0); PG8_MMA(1, 1, At, B1); PG8_BAR; PG8_SCHED;
            PG8_LDB(B0, 1, 0); PG8_LDB(B1, 1, 1); PG8_SCHED; PG8_LDA(At, 1, 0); PG8_STAGE(PG8_SA(0, 1), a2 + hstep, voffA);
            PG8_WAIT_V(8); PG8_WAIT_L(0); PG8_BAR; PG8_MMA(0, 0, At, B0); PG8_MMA(0, 1, At, B1); PG8_BAR; PG8_SCHED;
            PG8_LDA(At, 1, 1); PG8_STAGE(PG8_SB(1, 0), b3, voffB); PG8_STAGE(PG8_SB(1, 1), b3 + hstep, voffB); PG8_STAGE(PG8_SA(1, 0), a3, voffA);
            PG8_WAIT_V(8); PG8_WAIT_L(0); PG8_BAR; PG8_MMA(1, 0, At, B0); PG8_MMA(1, 1, At, B1); PG8_BAR; PG8_SCHED;
            } else {
            PG8_LDB(B0, 0, 0); PG8_SCHED; PG8_LDA(At, 0, 0); PG8_STAGE(PG8_SA(1, 1), a1 + hstep, voffA);
            PG8_WAIT_L(8); PG8_BAR; PG8_WAIT_L(0); PG8_MMA(0, 0, At, B0); PG8_BAR; PG8_SCHED;
            PG8_LDB(B1, 0, 1); PG8_STAGE(PG8_SB(0, 0), b2, voffB);
            PG8_BAR; PG8_WAIT_L(0); PG8_MMA(0, 1, At, B1); PG8_BAR;
            PG8_LDA(At, 0, 1); PG8_STAGE(PG8_SA(0, 0), a2, voffA);
            PG8_BAR; PG8_WAIT_L(0); PG8_MMA(1, 0, At, B0); PG8_BAR; PG8_SCHED;
            PG8_STAGE(PG8_SB(0, 1), b2 + hstep, voffB);
            PG8_WAIT_V(6); PG8_BAR; PG8_MMA(1, 1, At, B1); PG8_BAR;
            PG8_LDB(B0, 1, 0); PG8_SCHED; PG8_LDA(At, 1, 0); PG8_STAGE(PG8_SA(0, 1), a2 + hstep, voffA);
            PG8_WAIT_L(8); PG8_BAR; PG8_WAIT_L(0); PG8_MMA(0, 0, At, B0); PG8_BAR; PG8_SCHED;
            PG8_LDB(B1, 1, 1); PG8_STAGE(PG8_SB(1, 0), b3, voffB);
            PG8_BAR; PG8_WAIT_L(0); PG8_MMA(0, 1, At, B1); PG8_BAR;
            PG8_LDA(At, 1, 1); PG8_STAGE(PG8_SA(1, 0), a3, voffA);
            PG8_BAR; PG8_WAIT_L(0); PG8_MMA(1, 0, At, B0); PG8_BAR; PG8_SCHED;
            PG8_STAGE(PG8_SB(1, 1), b3 + hstep, voffB);
            PG8_WAIT_V(6); PG8_BAR; PG8_MMA(1, 1, At, B1); PG8_BAR;
            }
        }
        if constexpr (ALIGN_EPI) { if (wr == 0) PG8_BAR; }
        if constexpr (!Epi::AFTER_DRAIN) { E(acc, cur, wr, wc, fr, fq); S.done(cur); }
        if (!has_next) break;
#pragma unroll
        for (int a = 0; a < 2; ++a)
#pragma unroll
            for (int b = 0; b < 2; ++b)
#pragma unroll
                for (int m = 0; m < 4; ++m)
#pragma unroll
                    for (int n = 0; n < 2; ++n) acc[a][b][m][n] = (f32x4){0.f, 0.f, 0.f, 0.f};
        cur = nxt; cA = nA; cB = nB; ++ui;
        if constexpr (ALIGN_EPI) { if (wr == 1) PG8_BAR; }
    }
    PG8_WAIT_V(0);
    if constexpr (!ALIGN_EPI) { if (wr == 0) PG8_BAR; }
    PG8_BAR;
    if constexpr (Epi::AFTER_DRAIN) { E.fused(acc, cur, wr, wc, fr, fq, lds, wid, lane); S.done(cur); }
#undef PG8_SA
#undef PG8_SB
#undef PG8_STAGE
#undef PG8_LDA
#undef PG8_LDB
#undef PG8_MMA
#undef PG8_WAIT_V
#undef PG8_WAIT_L
#undef PG8_BAR
#undef PG8_SCHED
}
template <class Epi, class Sched, bool ALIGN_EPI = false, bool SP2 = false>
__device__ __forceinline__ void gemm_phase_g(PG8_LAS unsigned char* lds, const int K, const Sched& S, const Epi& E) {
    const int tid = threadIdx.x, wid = __builtin_amdgcn_readfirstlane(tid >> 6), lane = tid & 63, wr = wid >> 2, wc = wid & 3, fr = lane & 15, fq = lane >> 4;
    const int nt = K / BK;
    unsigned voffB[2]; int rowA[2], colA[2];
#pragma unroll
    for (int i = 0; i < 2; ++i) { int R, C; stage_rc(tid * 16 + i * 8192, R, C); const int lc = perm32(R & 31);
        const int Rb = Epi::BJI ? (64 * (R >> 5) + 16 * (lc >> 3) + (lc & 7)) : (Epi::PERM ? ((R & ~31) + lc) : R);
        rowA[i] = R; colA[i] = C * 2; voffB[i] = (unsigned)(Rb * K + C) * 2u; }
    const size_t kstep = (size_t)(BK * 2);
    const size_t hstep = Epi::BJI ? (size_t)8 * K * 2 : (size_t)HALF * K * 2;
    const size_t tstep = 2 * hstep;
    const unsigned ldsw = (unsigned)wid * 1024u;
    const int aoff = lds_byte(wr * 64 + fr, fq * 8), boff = lds_byte(wc * 32 + fr, fq * 8);
#define PG8_SA(b, h) (((b) * 2 + (h)) * HTB)
#define PG8_SB(b, h) ((4 + (b) * 2 + (h)) * HTB)
#define PG8_STAGE(bufoff, gbase, voff) do { _Pragma("unroll") for (int _i = 0; _i < 2; ++_i) \
        __builtin_amdgcn_global_load_lds((const unsigned*)((const char*)(gbase) + (voff)[_i]), (PG8_LAS unsigned*)(lds + (bufoff) + ldsw + _i * 8192), 16, 0, 0); } while (0)
#define PG8_STAGEA(bufoff, P0, P1, koff) do { \
        __builtin_amdgcn_global_load_lds((const unsigned*)(Ab + (size_t)(P0) + (koff)), (PG8_LAS unsigned*)(lds + (bufoff) + ldsw), 16, 0, 0); \
        __builtin_amdgcn_global_load_lds((const unsigned*)(Ab + (size_t)(P1) + (koff)), (PG8_LAS unsigned*)(lds + (bufoff) + ldsw + 8192), 16, 0, 0); } while (0)
#define PG8_LDA(dst, b, h) do { _Pragma("unroll") for (int m = 0; m < 4; ++m) _Pragma("unroll") for (int k = 0; k < 2; ++k) dst[m][k] = *(const PG8_LAS bf16x8*)(lds + PG8_SA(b, h) + aoff + m * 2048 + k * 1024); } while (0)
#define PG8_LDB(dst, b, h) do { _Pragma("unroll") for (int n = 0; n < 2; ++n) _Pragma("unroll") for (int k = 0; k < 2; ++k) dst[n][k] = *(const PG8_LAS bf16x8*)(lds + PG8_SB(b, h) + boff + n * 2048 + k * 1024); } while (0)
#define PG8_MMA(ai, bj, At, Bt) do { __builtin_amdgcn_s_setprio(1); _Pragma("unroll") for (int m = 0; m < 4; ++m) _Pragma("unroll") for (int n = 0; n < 2; ++n) _Pragma("unroll") for (int k = 0; k < 2; ++k) \
        acc[ai][bj][m][n] = __builtin_amdgcn_mfma_f32_16x16x32_bf16(Bt[n][k], At[m][k], acc[ai][bj][m][n], 0, 0, 0); __builtin_amdgcn_s_setprio(0); } while (0)
#define PG8_WAIT_V(n) asm volatile("s_waitcnt vmcnt(" #n ")" ::: "memory")
#define PG8_WAIT_L(n) asm volatile("s_waitcnt lgkmcnt(" #n ")" ::: "memory")
#define PG8_BAR __builtin_amdgcn_s_barrier()
#define PG8_SCHED __builtin_amdgcn_sched_barrier(0)
    Unit cur, nxt, un2; int ui = 0, sb_cur = 0;
    if (!S.next(0, cur)) return;
    int fillv = S.fill_issue(cur); S.fill_write(0, fillv);
    __syncthreads();
    bool has_next = S.next(1, nxt);
    fillv = 0; if (has_next) fillv = S.fill_issue(nxt);
    f32x4 acc[2][2][4][2];
#pragma unroll
    for (int a = 0; a < 2; ++a)
#pragma unroll
        for (int b = 0; b < 2; ++b)
#pragma unroll
            for (int m = 0; m < 4; ++m)
#pragma unroll
                for (int n = 0; n < 2; ++n) acc[a][b][m][n] = (f32x4){0.f, 0.f, 0.f, 0.f};
    bf16x8 At[4][2], B0[2][2], B1[2][2];
    const char* cB = S.b_base(cur);
    unsigned cA00, cA01, cA10, cA11, nA00, nA01, nA10, nA11;
    const char* const Ab = S.a_base();
    S.a_rows(0, rowA, colA, cA00, cA01, cA10, cA11);
    S.a_ready(cur);
    if constexpr (SP2) {
        PG8_STAGE(PG8_SB(0, 0), cB, voffB); PG8_STAGE(PG8_SB(0, 1), cB + hstep, voffB); PG8_STAGEA(PG8_SA(0, 0), cA00, cA01, 0); PG8_STAGEA(PG8_SA(0, 1), cA10, cA11, 0);
        if (wr == 1) PG8_BAR;
        PG8_WAIT_V(2); PG8_BAR;
        PG8_STAGE(PG8_SB(1, 0), cB + kstep, voffB); PG8_STAGEA(PG8_SA(1, 0), cA00, cA01, kstep); PG8_STAGE(PG8_SB(1, 1), cB + hstep + kstep, voffB);
        PG8_WAIT_V(6); PG8_BAR;
    } else {
        PG8_STAGE(PG8_SB(0, 0), cB, voffB); PG8_STAGEA(PG8_SA(0, 0), cA00, cA01, 0); PG8_STAGE(PG8_SB(0, 1), cB + hstep, voffB); PG8_STAGEA(PG8_SA(0, 1), cA10, cA11, 0);
        if (wr == 1) PG8_BAR;
        PG8_WAIT_V(4); PG8_BAR;
        PG8_STAGE(PG8_SB(1, 0), cB + kstep, voffB); PG8_STAGEA(PG8_SA(1, 0), cA00, cA01, kstep); PG8_STAGE(PG8_SB(1, 1), cB + hstep + kstep, voffB);
        PG8_WAIT_V(6); PG8_BAR;
    }
    for (;;) {
        const char* nB = has_next ? S.b_base(nxt) : cB;
        const int sb_n = sb_cur == 2 ? 0 : sb_cur + 1;
        bool has2 = false;
        if (has_next) { S.fill_write(sb_n, fillv); has2 = S.next(ui + 2, un2); if (has2) fillv = S.fill_issue(un2); }
        nA00 = cA00; nA01 = cA01; nA10 = cA10; nA11 = cA11;
#pragma unroll 1
        for (int t = 0; t < nt; t += 2) {
            const bool last = (t == nt - 2);
            const size_t k1 = (size_t)(t + 1) * kstep;
            const size_t k2 = last ? 0 : (size_t)(t + 2) * kstep; const char* b2 = last ? nB : cB + (size_t)(t + 2) * kstep;
            const unsigned q00 = last ? nA00 : cA00, q01 = last ? nA01 : cA01, q10 = last ? nA10 : cA10, q11 = last ? nA11 : cA11;
            const size_t k3 = k2 + kstep; const char* b3 = b2 + kstep;
            if (last && has_next) S.a_ready(nxt);
            if constexpr (SP2) {
            PG8_LDB(B0, 0, 0); PG8_LDB(B1, 0, 1); PG8_SCHED; PG8_LDA(At, 0, 0); PG8_STAGEA(PG8_SA(1, 1), cA10, cA11, k1);
            PG8_WAIT_V(8); PG8_WAIT_L(0); PG8_BAR; PG8_MMA(0, 0, At, B0); PG8_MMA(0, 1, At, B1); PG8_BAR; PG8_SCHED;
            PG8_LDA(At, 0, 1); PG8_STAGE(PG8_SB(0, 0), b2, voffB); PG8_STAGE(PG8_SB(0, 1), b2 + hstep, voffB); PG8_STAGEA(PG8_SA(0, 0), q00, q01, k2);
            PG8_WAIT_V(8); PG8_WAIT_L(0); PG8_BAR; PG8_MMA(1, 0, At, B0); PG8_MMA(1, 1, At, B1); PG8_BAR; PG8_SCHED;
            PG8_LDB(B0, 1, 0); PG8_LDB(B1, 1, 1); PG8_SCHED; PG8_LDA(At, 1, 0); PG8_STAGEA(PG8_SA(0, 1), q10, q11, k2);
            PG8_WAIT_V(8); PG8_WAIT_L(0); PG8_BAR; PG8_MMA(0, 0, At, B0); PG8_MMA(0, 1, At, B1); PG8_BAR; PG8_SCHED;
            PG8_LDA(At, 1, 1); PG8_STAGE(PG8_SB(1, 0), b3, voffB); PG8_STAGE(PG8_SB(1, 1), b3 + hstep, voffB); PG8_STAGEA(PG8_SA(1, 0), q00, q01, k3);
            PG8_WAIT_V(8); PG8_WAIT_L(0); PG8_BAR; PG8_MMA(1, 0, At, B0); PG8_MMA(1, 1, At, B1); PG8_BAR; PG8_SCHED;
            } else {
            PG8_LDB(B0, 0, 0); PG8_SCHED; PG8_LDA(At, 0, 0); PG8_STAGEA(PG8_SA(1, 1), cA10, cA11, k1);
            PG8_WAIT_L(8); PG8_BAR; PG8_WAIT_L(0); PG8_MMA(0, 0, At, B0); PG8_BAR; PG8_SCHED;
            PG8_LDB(B1, 0, 1); PG8_STAGE(PG8_SB(0, 0), b2, voffB);
            PG8_BAR; PG8_WAIT_L(0); PG8_MMA(0, 1, At, B1); PG8_BAR;
            PG8_LDA(At, 0, 1); PG8_STAGEA(PG8_SA(0, 0), q00, q01, k2);
            PG8_BAR; PG8_WAIT_L(0); PG8_MMA(1, 0, At, B0); PG8_BAR; PG8_SCHED;
            PG8_STAGE(PG8_SB(0, 1), b2 + hstep, voffB);
            PG8_WAIT_V(6); PG8_BAR; PG8_MMA(1, 1, At, B1); PG8_BAR;
            PG8_LDB(B0, 1, 0); PG8_SCHED; PG8_LDA(At, 1, 0); PG8_STAGEA(PG8_SA(0, 1), q10, q11, k2);
            PG8_WAIT_L(8); PG8_BAR; PG8_WAIT_L(0); PG8_MMA(0, 0, At, B0); PG8_BAR; PG8_SCHED;
            PG8_LDB(B1, 1, 1); PG8_STAGE(PG8_SB(1, 0), b3, voffB);
            PG8_BAR; PG8_WAIT_L(0); PG8_MMA(0, 1, At, B1); PG8_BAR;
            PG8_LDA(At, 1, 1); PG8_STAGEA(PG8_SA(1, 0), q00, q01, k3);
            PG8_BAR; PG8_WAIT_L(0); PG8_MMA(1, 0, At, B0); PG8_BAR; PG8_SCHED;
            PG8_STAGE(PG8_SB(1, 1), b3 + hstep, voffB);
            PG8_WAIT_V(6); PG8_BAR; PG8_MMA(1, 1, At, B1); PG8_BAR;
            }
            if (t == nt - 4 && has_next) S.a_rows(sb_n, rowA, colA, nA00, nA01, nA10, nA11);
        }
        if constexpr (ALIGN_EPI) { if (wr == 0) PG8_BAR; }
        if constexpr (!Epi::AFTER_DRAIN) { E(acc, cur, wr, wc, fr, fq, sb_cur); S.done(cur); }
        if (!has_next) break;
#pragma unroll
        for (int a = 0; a < 2; ++a)
#pragma unroll
            for (int b = 0; b < 2; ++b)
#pragma unroll
                for (int m = 0; m < 4; ++m)
#pragma unroll
                    for (int n = 0; n < 2; ++n) acc[a][b][m][n] = (f32x4){0.f, 0.f, 0.f, 0.f};
        cur = nxt; nxt = un2; has_next = has2; cA00 = nA00; cA01 = nA01; cA10 = nA10; cA11 = nA11; cB = nB; ++ui; sb_cur = sb_n;
        if constexpr (ALIGN_EPI) { if (wr == 1) PG8_BAR; }
    }
    PG8_WAIT_V(0);
    if constexpr (!ALIGN_EPI) { if (wr == 0) PG8_BAR; }
    PG8_BAR;
    if constexpr (Epi::AFTER_DRAIN) { E.fused(acc, cur, wr, wc, fr, fq, lds, wid, lane); S.done(cur); }
#undef PG8_SA
#undef PG8_SB
#undef PG8_STAGE
#undef PG8_STAGEA
#undef PG8_LDA
#undef PG8_LDB
#undef PG8_MMA
#undef PG8_WAIT_V
#undef PG8_WAIT_L
#undef PG8_BAR
#undef PG8_SCHED
}
}

DEVI void wt_colinfo(const Params& p, int R, const float*& src, int& ld, float& scale) {
    scale = 1.0f; src = nullptr; ld = 0;
    if (R < WT_AT) {
        const int pn = R >> 8, cl = R & 255; ld = DIN_; int col = -1;
        if (pn < 4) { const int wcq = (cl >> 5) & 3; col = (pn >> 1) * 512 + (2 * (pn & 1) + (wcq >> 1)) * 128 + 64 * (cl >> 7) + 32 * (wcq & 1) + (cl & 31);
                      if (pn >= 2) scale = KSCALE_; }
        else if (pn < 8)  col = 2048 + (pn - 4) * 256 + cl;
        else if (pn < 10) { col = 3072 + (pn - 8) * 256 + cl; scale = KSCALE_; }
        else if (pn < 14) col = 5120 + (pn - 10) * 256 + cl;
        else if (pn < 22) col = 6160 + (pn - 14) * 256 + cl;
        else if (cl < 16) col = 6144 + cl;
        if (col >= 0) src = p.w_in + col;
    } else if (R < WT_RET) {
        const int Rr = R - WT_AT, pm = Rr >> 8, rl = Rr & 255; ld = DIN_; int col;
        if (pm < 2) { col = 512 + (2 * pm + ((rl >> 6) & 1)) * 128 + 64 * (rl >> 7) + (rl & 63); scale = KSCALE_; }
        else if (pm < 6)  col = 1024 + (pm - 2) * 256 + rl;
        else if (pm < 10) col = 4096 + (pm - 6) * 256 + rl;
        else              col = 3584 + (pm - 10) * 256 + rl;
        src = p.w_in + col;
    } else {
        int Rr, ldd; const float* base;
        if (R < WT_GLA)    { Rr = R - WT_RET; base = p.w_ret_out; ldd = 1024; }
        else if (R < WT_O) { Rr = R - WT_GLA; base = p.w_gla_out; ldd = 1024; }
        else if (R < WT_R) { Rr = R - WT_O;   base = p.w_o;       ldd = 1024; }
        else               { Rr = R - WT_R;   base = p.router_w;  ldd = 256; }
        src = base + ((R >= WT_R) ? ((Rr & ~127) + vperm(Rr & 127)) : Rr); ld = ldd;
    }
}

DEVI void phase0(const Params& p, unsigned char* smem) {
    const int tid = VT, nb = VG, bid = VB;
    float2* cs = (float2*)(p.ws + OFF_CS);
    for (int i = bid * 256 + tid; i < 4096 * 64; i += nb * 256) {
        const int pos = i >> 6, k = i & 63;
        const float angf = (float)pos * c_inv_freq[k];
        const double a = (double)angf;
        const double TWO_PI = 6.283185307179586476925286766559, HALF_PI = 1.5707963267948966192313216916398;
        const double kk = rint(a * (1.0 / TWO_PI));
        const double r = a - kk * TWO_PI;
        const double qd = rint(r * (1.0 / HALF_PI));
        const double y = r - qd * HALF_PI;
        const double y2 = y * y;
        double sn = y * (1.0 + y2 * (-1.0 / 6 + y2 * (1.0 / 120 + y2 * (-1.0 / 5040 + y2 * (1.0 / 362880 + y2 * (-1.0 / 39916800 + y2 * (1.0 / 6227020800.0)))))));
        double cn = 1.0 + y2 * (-0.5 + y2 * (1.0 / 24 + y2 * (-1.0 / 720 + y2 * (1.0 / 40320 + y2 * (-1.0 / 3628800 + y2 * (1.0 / 479001600.0))))));
        const int qi = ((int)qd) & 3;
        double s, c;
        if (qi == 0) { s = sn; c = cn; } else if (qi == 1) { s = cn; c = -sn; } else if (qi == 2) { s = -sn; c = -cn; } else { s = -cn; c = sn; }
        cs[i] = make_float2((float)c, (float)s);
    }
    if (bid == 0) { int* cnt = (int*)(p.ws + OFF_CNT); cnt[tid * CNT_STRIDE] = 0; }
    {
        u32x4* bfr = (u32x4*)smem;
        for (int idx = tid; idx < 32 * 64; idx += 256) {
            const int sst = idx >> 6, l = idx & 63;
            const float* wp = p.w_in + (size_t)(32 * sst + 8 * (l >> 4)) * DIN_ + 6144 + (l & 15);
            float w8[8];
#pragma unroll
            for (int j = 0; j < 8; ++j) w8[j] = wp[(size_t)j * DIN_];
            u32x4 o; o.x = pk2(w8[0], w8[1]); o.y = pk2(w8[2], w8[3]); o.z = pk2(w8[4], w8[5]); o.w = pk2(w8[6], w8[7]);
            bfr[idx] = o;
        }
        __syncthreads();
        const int lane = tid & 63, row = lane & 15, kg = lane >> 4;
        float* Ga = (float*)(p.ws + OFF_GA);
        for (int rb = bid * 4 + (tid >> 6); rb < T_ / 16; rb += nb * 4) {
            const float* xr = p.x + (size_t)(rb * 16 + row) * 1024 + 8 * kg;
            bf16_t* xo = (bf16_t*)(p.ws + OFF_XB) + (size_t)(rb * 16 + row) * 1024 + 8 * kg;
            f32x4 acc = (f32x4){0.f, 0.f, 0.f, 0.f};
#pragma unroll 1
            for (int s0 = 0; s0 < 32; s0 += 8) {
                f32x4 v[8][2];
#pragma unroll
                for (int j = 0; j < 8; ++j) { v[j][0] = *(const f32x4*)(xr + 32 * (s0 + j)); v[j][1] = *(const f32x4*)(xr + 32 * (s0 + j) + 4); }
#pragma unroll
                for (int j = 0; j < 8; ++j) {
                    u32x4 o; o.x = pk2(v[j][0][0], v[j][0][1]); o.y = pk2(v[j][0][2], v[j][0][3]); o.z = pk2(v[j][1][0], v[j][1][1]); o.w = pk2(v[j][1][2], v[j][1][3]);
                    *(u32x4*)(xo + 32 * (s0 + j)) = o;
                    acc = mfma16(__builtin_bit_cast(bf16x8, o), __builtin_bit_cast(bf16x8, bfr[(s0 + j) * 64 + lane]), acc);
                }
            }
#pragma unroll
            for (int r = 0; r < 4; ++r) Ga[(size_t)(rb * 16 + 4 * kg + r) * 16 + row] = acc[r];
        }
        __syncthreads();
    }
    {
        float* tile = (float*)smem;
        bf16_t* wt = (bf16_t*)(p.ws + OFF_WT);
        const int ntask = (WT_ROWS / 64) * 16;
        const int n = tid & 63, kq = tid >> 6;
#define TR_BAR do { asm volatile("s_waitcnt lgkmcnt(0)" ::: "memory"); __builtin_amdgcn_s_barrier(); asm volatile("" ::: "memory"); } while (0)
#define TR_LOAD(V, SC, TASK) do { const int rt_ = (TASK) >> 4, kt_ = (TASK) & 15; const float* src_; int ld_; wt_colinfo(p, rt_ * 64 + n, src_, ld_, SC); \
            if (src_ == nullptr) { src_ = p.w_in; SC = 0.f; } \
            _Pragma("unroll") for (int i = 0; i < 16; ++i) V[i] = src_[(size_t)(kt_ * 64 + kq + 4 * i) * ld_]; } while (0)
#define TR_PROC(V, SC, TASK) do { const int rt_ = (TASK) >> 4, kt_ = (TASK) & 15; \
            _Pragma("unroll") for (int i = 0; i < 16; ++i) tile[(kq + 4 * i) * 65 + n] = V[i] * SC; \
            TR_BAR; \
            { const int n2 = tid >> 2, ks = (tid & 3) * 16; unsigned o[8]; \
              _Pragma("unroll") for (int j = 0; j < 8; ++j) o[j] = pk2(tile[(ks + 2 * j) * 65 + n2], tile[(ks + 2 * j + 1) * 65 + n2]); \
              u32x4* dst = (u32x4*)(wt + (size_t)(rt_ * 64 + n2) * 1024 + kt_ * 64 + ks); \
              dst[0] = (u32x4){o[0], o[1], o[2], o[3]}; dst[1] = (u32x4){o[4], o[5], o[6], o[7]}; } \
            TR_BAR; } while (0)
        int task = bid;
        if (task < ntask) {
            float va[16], vb[16], sa, sb;
            TR_LOAD(va, sa, task);
#pragma unroll 1
            for (;;) {
                bool more = task + nb < ntask;
                TR_LOAD(vb, sb, more ? task + nb : task);
                TR_PROC(va, sa, task);
                if (!more) break;
                task += nb;
                more = task + nb < ntask;
                TR_LOAD(va, sa, more ? task + nb : task);
                TR_PROC(vb, sb, task);
                if (!more) break;
                task += nb;
            }
        }
#undef TR_PROC
#undef TR_LOAD
#undef TR_BAR
    }
}

struct EpiP1N {
    static constexpr bool PERM = true, AFTER_DRAIN = false;
    unsigned char* ws;
    __device__ __forceinline__ void operator()(const pg8::f32x4 (&acc)[2][2][4][2], const pg8::Unit& u, int wr, int wc, int fr, int fq) const {
        const int pn = u.pn, row0 = u.pm * 256 + wr * 64 + fr, c8 = wc * 32 + 8 * fq;
        if (pn < 4) {
            const float2* cs = (const float2*)(ws + OFF_CS); bf16_t* Qr = (bf16_t*)(ws + (pn < 2 ? OFF_QR : OFF_KR));
            const int head = 2 * (pn & 1) + (wc >> 1), d0 = 32 * (wc & 1) + 8 * fq;
#pragma unroll
            for (int ai = 0; ai < 2; ++ai)
#pragma unroll
                for (int m = 0; m < 4; ++m) {
                    const size_t row = row0 + ai * 128 + m * 16; const int pos = (int)(row & 4095);
                    f32x4 c4[4];
#pragma unroll
                    for (int j = 0; j < 4; ++j) c4[j] = *(const f32x4*)(cs + pos * 64 + d0 + 2 * j);
                    f32x4 o1[2], o2[2];
#pragma unroll
                    for (int n = 0; n < 2; ++n)
#pragma unroll
                        for (int r = 0; r < 4; ++r) {
                            const f32x4 cc = c4[2 * n + (r >> 1)]; const float c_ = cc[(r & 1) * 2], s_ = cc[(r & 1) * 2 + 1];
                            const float x1 = acc[ai][0][m][n][r], x2 = acc[ai][1][m][n][r];
                            o1[n][r] = x1 * c_ - x2 * s_; o2[n][r] = x1 * s_ + x2 * c_;
                        }
                    *(u32x4*)(Qr + row * 512 + head * 128 + d0) = pk8(o1[0], o1[1]);
                    *(u32x4*)(Qr + row * 512 + head * 128 + 64 + d0) = pk8(o2[0], o2[1]);
                    asm volatile("" ::: "memory");
                }
        } else {
#pragma unroll
            for (int ai = 0; ai < 2; ++ai)
#pragma unroll
                for (int m = 0; m < 4; ++m) {
                    const size_t row = row0 + ai * 128 + m * 16;
#pragma unroll
                    for (int bj = 0; bj < 2; ++bj) {
                        const int cl = bj * 128 + c8;
                        f32x4 v0 = acc[ai][bj][m][0], v1 = acc[ai][bj][m][1];
                        if (pn < 8) {
#pragma unroll
                            for (int r = 0; r < 4; ++r) { v0[r] = siluf_(v0[r]); v1[r] = siluf_(v1[r]); }
                            *(u32x4*)((bf16_t*)(ws + OFF_GS) + row * 2048 + (pn - 4) * 256 + cl) = pk8(v0, v1);
                        } else if (pn < 10) {
                            *(u32x4*)((bf16_t*)(ws + OFF_QGN) + row * 512 + (pn - 8) * 256 + cl) = pk8(v0, v1);
                        } else if (pn < 14) {
#pragma unroll
                            for (int r = 0; r < 4; ++r) { v0[r] = siluf_(v0[r]); v1[r] = siluf_(v1[r]); }
                            *(u32x4*)((bf16_t*)(ws + OFF_GS) + row * 2048 + 1024 + (pn - 10) * 256 + cl) = pk8(v0, v1);
                        } else if (pn < 22) {
#pragma unroll
                            for (int r = 0; r < 4; ++r) { v0[r] = sigmoidf_(v0[r]); v1[r] = sigmoidf_(v1[r]); }
                            *(u32x4*)((bf16_t*)(ws + OFF_MG) + row * 2048 + (pn - 14) * 256 + cl) = pk8(v0, v1);
                        } else if (cl < 16) {
                            int frl = fr; asm volatile("" : "+v"(frl));
                            const unsigned ofs = (unsigned)OFF_GA + ((unsigned)(u.pm * 256 + wr * 64 + frl + ai * 128 + m * 16) * 16u + (unsigned)cl) * 4u;
                            *(f32x4*)(ws + ofs) = v0; *(f32x4*)(ws + ofs + 16) = v1;
                        }
                    }
                    asm volatile("" ::: "memory");
                }
        }
    }
};
struct EpiP1V {
    static constexpr bool PERM = true, AFTER_DRAIN = false;
    unsigned char* ws;
    __device__ __forceinline__ void operator()(const pg8::f32x4 (&acc)[2][2][4][2], const pg8::Unit& u, int wr, int wc, int fr, int fq) const {
        bf16_t* dst = (bf16_t*)(ws + (u.pm < 4 ? OFF_VRT : OFF_VGT)); const int head = u.pm & 3;
#pragma unroll
        for (int bj = 0; bj < 2; ++bj) {
            const int tok0 = u.pn * 256 + bj * 128 + wc * 32 + 8 * fq; const int item = (tok0 >> 6) * 4 + head, m0 = tok0 & 63;
#pragma unroll
            for (int ai = 0; ai < 2; ++ai)
#pragma unroll
                for (int m = 0; m < 4; ++m) {
                    *(u32x4*)(dst + vf_off(item, ai * 128 + wr * 64 + m * 16 + fr, m0)) = pk8(acc[ai][bj][m][0], acc[ai][bj][m][1]);
                    asm volatile("" ::: "memory");
                }
        }
    }
};
struct EpiP1G {
    static constexpr bool PERM = true, AFTER_DRAIN = false;
    unsigned char* ws;
    __device__ __forceinline__ void operator()(const pg8::f32x4 (&acc)[2][2][4][2], const pg8::Unit& u, int wr, int wc, int fr, int fq) const {
        bf16_t* dst = (bf16_t*)(ws + OFF_KGT);
#pragma unroll
        for (int bj = 0; bj < 2; ++bj) {
            const int tok0 = u.pn * 256 + bj * 128 + wc * 32 + 8 * fq; const int m0 = tok0 & 63;
#pragma unroll
            for (int ai = 0; ai < 2; ++ai) {
                const unsigned item = (unsigned)((tok0 >> 6) * 4 + 2 * u.pm + ai);
#pragma unroll
                for (int m = 0; m < 4; ++m) {
                    *(u32x4*)(dst + (item * 128u + (unsigned)(wr * 64 + m * 16 + fr)) * 64u + (unsigned)m0) = pk8(acc[ai][bj][m][0], acc[ai][bj][m][1]);
                    asm volatile("" ::: "memory");
                }
            }
        }
    }
};
DEVI void phase1(const Params& p, unsigned char* smem_all) {
    {
        pg8::StaticOrder S; S.init(T_, 5632, RG, RB);
        pg8::Gemm g; g.A = (const bf16_t*)(p.ws + OFF_XB); g.Bt = (const bf16_t*)(p.ws + OFF_WT) + (size_t)WT_BN * 1024; g.M = T_; g.N = 5632; g.K = 1024;
        EpiP1N E; E.ws = p.ws;
        pg8::gemm_phase<EpiP1N, pg8::StaticOrder, true, true>((PG8_LAS unsigned char*)smem_all, g, S, E);
    }
    __syncthreads();
    {
        pg8::StaticOrder S; S.init(2048, T_, RG, RB);
        pg8::Gemm g; g.A = (const bf16_t*)(p.ws + OFF_WT) + (size_t)(WT_AT + 512) * 1024; g.Bt = (const bf16_t*)(p.ws + OFF_XB); g.M = 2048; g.N = T_; g.K = 1024;
        EpiP1V E; E.ws = p.ws;
        pg8::gemm_phase<EpiP1V, pg8::StaticOrder, true, true>((PG8_LAS unsigned char*)smem_all, g, S, E);
    }
    __syncthreads();
    {
        pg8::StaticOrder S; S.init(512, T_, RG, RB);
        pg8::Gemm g; g.A = (const bf16_t*)(p.ws + OFF_WT) + (size_t)(WT_AT + 2560) * 1024; g.Bt = (const bf16_t*)(p.ws + OFF_XB); g.M = 512; g.N = T_; g.K = 1024;
        EpiP1G E; E.ws = p.ws;
        pg8::gemm_phase<EpiP1G, pg8::StaticOrder, true, true>((PG8_LAS unsigned char*)smem_all, g, S, E);
    }
}

DEVI void phase2(const Params& p, unsigned char* smem) {
    float* ga_s = (float*)smem;
    float* tot = (float*)(smem + 4096);
    const int tid = VT;
    const float* Ga = (const float*)(p.ws + OFF_GA);
    const bf16_t* Kgt = (const bf16_t*)(p.ws + OFF_KGT); bf16_t* Kg2 = (bf16_t*)(p.ws + OFF_KG2);
    float* dec = (float*)(p.ws + OFF_DEC);
    for (int it = VB; it < 2048; it += VG) {
        const int h = it & 3, c = (it >> 2) & 63, b = it >> 8;
        const int tok0 = b * 4096 + c * 64;
        ((f32x4*)ga_s)[tid] = ((const f32x4*)(Ga + (size_t)tok0 * 16))[tid];
        const int dk = tid & 127, half = tid >> 7;
        float w2[16];
#pragma unroll
        for (int r = 0; r < 16; ++r) w2[r] = p.gate_w2[r * 512 + h * 128 + dk];
        const float bias = p.gate_b[h * 128 + dk];
        __syncthreads();
        float run = 0.f; float bc[32];
#pragma unroll
        for (int ml = 0; ml < 32; ++ml) {
            const int m = half * 32 + ml;
            float z = bias;
#pragma unroll
            for (int r4 = 0; r4 < 4; ++r4) { const f32x4 g4 = *(const f32x4*)&ga_s[m * 16 + 4 * r4];
                z += g4[0] * w2[4 * r4] + g4[1] * w2[4 * r4 + 1] + g4[2] * w2[4 * r4 + 2] + g4[3] * w2[4 * r4 + 3]; }
            const float la = (fminf(z, 0.f) - __logf(1.0f + __expf(-fabsf(z)))) * (1.0f / 16.0f);
            run += la; bc[ml] = run;
        }
        tot[half * 128 + dk] = run;
        __syncthreads();
        const float t0 = tot[dk], t1 = tot[128 + dk];
        const float bend = t0 + t1, off = half ? t0 : 0.f;
        const u32x4* kp = (const u32x4*)(Kgt + ((size_t)it * 128 + dk) * 64 + half * 32);
        bf16_t* const kqb = Kg2;
#pragma unroll
        for (int j = 0; j < 4; ++j) {
            u32x4 v = kp[j];
            unsigned uu[4] = {v.x, v.y, v.z, v.w};
#pragma unroll
            for (int e = 0; e < 4; ++e) {
                const float f0 = bflo(uu[e]) * __expf(bend - (bc[8 * j + 2 * e] + off));
                const float f1 = bfhi(uu[e]) * __expf(bend - (bc[8 * j + 2 * e + 1] + off));
                uu[e] = pk2(f0, f1);
            }
            *(u32x4*)(kqb + kf_off(it, dk, half * 32 + 8 * j)) = (u32x4){uu[0], uu[1], uu[2], uu[3]};
        }
        if (half == 0) dec[(size_t)it * 128 + dk] = __expf(bend);
        {
            const bf16_t* Qn = (const bf16_t*)(p.ws + OFF_QGN); bf16_t* QF = (bf16_t*)(p.ws + OFF_QG);
            const int m = tid & 63, qd = tid >> 6, bc = b * 64 + c;
            const u32x4* qs = (const u32x4*)(Qn + ((size_t)tok0 + m) * 512 + h * 128 + 32 * qd);
            u32x4 qv[4];
#pragma unroll
            for (int j = 0; j < 4; ++j) qv[j] = qs[j];
#pragma unroll
            for (int j = 0; j < 4; ++j) {
                *(u32x2*)(QF + qf_off(bc, h, m, 32 * qd + 8 * j, 0)) = (u32x2){qv[j].x, qv[j].y};
                *(u32x2*)(QF + qf_off(bc, h, m, 32 * qd + 8 * j, 1)) = (u32x2){qv[j].z, qv[j].w};
            }
        }
        __syncthreads();
    }
    {
        bf16_t* tile = (bf16_t*)smem;
        const bf16_t* Kr = (const bf16_t*)(p.ws + OFF_KR); bf16_t* Krt = (bf16_t*)(p.ws + OFF_KRT);
        for (int it = VB; it < 2048; it += VG) {
            const int h = it & 3, c = (it >> 2) & 63, b = it >> 8;
            const size_t tok0 = (size_t)b * 4096 + c * 64;
            const int m = tid & 63, qd = tid >> 6;
            const float kd = exp2f(gamma_log2(h) * (float)(63 - m));
            const u32x4* src = (const u32x4*)(Kr + (tok0 + m) * 512 + h * 128 + 32 * qd);
            u32x4 v[4];
#pragma unroll
            for (int j = 0; j < 4; ++j) v[j] = src[j];
#pragma unroll
            for (int j = 0; j < 4; ++j) {
                const unsigned uu[4] = {v[j].x, v[j].y, v[j].z, v[j].w};
#pragma unroll
                for (int e = 0; e < 4; ++e) {
                    const int dk = 32 * qd + 8 * j + 2 * e;
                    tile[dk * 72 + m] = f2bf(bflo(uu[e]) * kd); tile[(dk + 1) * 72 + m] = f2bf(bfhi(uu[e]) * kd);
                }
            }
            {
                const bf16_t* Qr = (const bf16_t*)(p.ws + OFF_QR); bf16_t* QF = (bf16_t*)(p.ws + OFF_QFR);
                const u32x4* qs = (const u32x4*)(Qr + (tok0 + m) * 512 + h * 128 + 32 * qd);
                u32x4 qv[4];
#pragma unroll
                for (int j = 0; j < 4; ++j) qv[j] = qs[j];
                const int bc = b * 64 + c;
#pragma unroll
                for (int j = 0; j < 4; ++j) {
                    *(u32x2*)(QF + qf_off(bc, h, m, 32 * qd + 8 * j, 0)) = (u32x2){qv[j].x, qv[j].y};
                    *(u32x2*)(QF + qf_off(bc, h, m, 32 * qd + 8 * j, 1)) = (u32x2){qv[j].z, qv[j].w};
                }
            }
            __syncthreads();
            {
                const int dk = tid >> 1, hf = tid & 1;
#pragma unroll
                for (int j = 0; j < 4; ++j) *(u32x4*)(Krt + kf_off(it, dk, hf * 32 + 8 * j)) = *(const u32x4*)&tile[dk * 72 + hf * 32 + 8 * j];
            }
            __syncthreads();
        }
    }
}

typedef float f32x16 __attribute__((ext_vector_type(16)));
DEVI f32x16 mfma32(bf16x8 a, bf16x8 b, f32x16 c) { return __builtin_amdgcn_mfma_f32_32x32x16_bf16(a, b, c, 0, 0, 0); }
struct ScanSet { bf16x8 kf[4], vq, qf[2][2]; f32x4 dc[4]; };
template <bool GLA>
DEVI void scan_tile(const Params& p, unsigned char* zb  , int b, int h, int s, int dummy) {
    int vt_ = VT; asm volatile("" : "+v"(vt_));
    const int t = __builtin_amdgcn_readfirstlane(vt_ >> 6), lane = vt_ & 63, r = lane & 31, hh = lane >> 5;
    const bf16_t* Ktb = (const bf16_t*)(p.ws + (GLA ? OFF_KG2 : OFF_KRT));
    const bf16_t* Vtb = (const bf16_t*)(p.ws + (GLA ? OFF_VGT : OFF_VRT));
    const bf16_t* Qb  = (const bf16_t*)(p.ws + (GLA ? OFF_QG : OFF_QFR));
    const float* dec = (const float*)(p.ws + OFF_DEC);
    bf16_t* Oo = (bf16_t*)(p.ws + OFF_OO);
    const float lg = gamma_log2(h);
    const float cd = exp2f(lg * 64.0f);
    f32x16 S;
#pragma unroll
    for (int i = 0; i < 16; ++i) S[i] = 0.f;
    const unsigned it0 = (unsigned)(b * 64 * 4 + h);
    const bf16_t* const kp = Ktb + ((size_t)it0 * 4 + t) * 4 * 512; const unsigned ko = (unsigned)lane * 8;
    const bf16_t* const vp = Vtb + ((size_t)it0 * 8 + s) * 4 * 512 + t * 512; const unsigned vo = (unsigned)lane * 8;
    const bf16_t* const qp = Qb + ((((size_t)(b * 64) * 4 + h) * 2) * 4 + t) * 2 * 512; const unsigned qo = (unsigned)lane * 8;
    const float* const dp = dec + (size_t)it0 * 128 + t * 32; const unsigned dofs = 4 * hh;
    unsigned char* const vring = smem_all_g + 2 * SMEM_HALF + VH * 8192;
    const int rt = t >> 1, rg0 = 2 * (t & 1);
    const float qd = GLA ? 1.0f : exp2f(lg * (float)(32 * rt + r + 1));
    bf16_t* const ob = Oo + (size_t)b * 4096 * 2048 + (GLA ? 1024 : 0) + h * 256 + s * 32;
#define ST_CL(C) (dummy ? 0 : ((C) < 64 ? (C) : 63))
#define ST_LOAD(SET, C) do { const int c_ = ST_CL(C), cv_ = ST_CL((C) + 1); \
        const bf16_t* kq = kp + (size_t)c_ * (4 * 16 * 512) + ko; const bf16_t* qq = qp + (size_t)c_ * (4 * 16 * 512) + qo; \
        _Pragma("unroll") for (int ks = 0; ks < 4; ++ks) (SET).kf[ks] = *(const bf16x8*)(kq + ks * 512); \
        (SET).vq = *(const bf16x8*)(vp + (size_t)cv_ * (4 * 32 * 512) + vo); \
        _Pragma("unroll") for (int ss = 0; ss < 2; ++ss) _Pragma("unroll") for (int tt = 0; tt < 2; ++tt) (SET).qf[ss][tt] = *(const bf16x8*)(qq + tt * (8 * 512) + ss * 512); \
        } while (0)
#define ST_LOADDC(SET, C) do { if (GLA) { const int c_ = (C) < 64 ? (C) : 63; const float* dq = dp + (size_t)c_ * (4 * 128) + dofs; \
        _Pragma("unroll") for (int g = 0; g < 4; ++g) (SET).dc[g] = *(const f32x4*)(dq + 8 * g); } } while (0)
#define ST_Z(SET, ZC) do { \
        _Pragma("unroll") for (int tt = 0; tt < 2; ++tt) { \
            f32x16 Zt; _Pragma("unroll") for (int i = 0; i < 16; ++i) Zt[i] = 0.f; \
            _Pragma("unroll") for (int ss = 0; ss < 2; ++ss) { \
                u32x4 pk; pk.x = pk2(S[8 * ss + 0], S[8 * ss + 1]); pk.y = pk2(S[8 * ss + 2], S[8 * ss + 3]); pk.z = pk2(S[8 * ss + 4], S[8 * ss + 5]); pk.w = pk2(S[8 * ss + 6], S[8 * ss + 7]); \
                Zt = mfma32(__builtin_bit_cast(bf16x8, pk), (SET).qf[ss][tt], Zt); } \
            _Pragma("unroll") for (int g = 0; g < 4; ++g) { \
                f32x4 z4; z4[0] = Zt[4 * g]; z4[1] = Zt[4 * g + 1]; z4[2] = Zt[4 * g + 2]; z4[3] = Zt[4 * g + 3]; \
                *(u32x2*)((ZC) + (((t * 2 + tt) * 4 + g) * 64 + lane) * 8) = pk4(z4); } } } while (0)
#define ST_UPD(SET, C) do { \
        if (GLA) { _Pragma("unroll") for (int g = 0; g < 4; ++g) _Pragma("unroll") for (int i = 0; i < 4; ++i) S[4 * g + i] *= (SET).dc[g][i]; } \
        else { _Pragma("unroll") for (int i = 0; i < 16; ++i) S[i] *= cd; } \
        _Pragma("unroll") for (int ks = 0; ks < 4; ++ks) S = mfma32((SET).kf[ks], *(const bf16x8*)(vring + ((C) & 1) * 4096 + ks * 1024 + lane * 16), S); } while (0)
#define ST_STEP(CUR, NXT, OTH, C) do { \
        ST_LOADDC(OTH, (C) + 1); ST_LOAD(NXT, (C) + 2);       \
        __builtin_amdgcn_sched_barrier(0); \
        unsigned char* zc = zb + ((C) & 1) * 16384; \
        if (GLA) { ST_UPD(CUR, C); ST_Z(CUR, zc); } else { ST_Z(CUR, zc); ST_UPD(CUR, C); } \
        *(bf16x8*)(vring + (((C) + 1) & 1) * 4096 + t * 1024 + lane * 16) = (CUR).vq; \
        __syncthreads(); \
        _Pragma("unroll") for (int gi = 0; gi < 2; ++gi) { const int g = rg0 + gi; \
            f32x4 o = (f32x4){0.f, 0.f, 0.f, 0.f}; \
            _Pragma("unroll") for (int t2 = 0; t2 < 4; ++t2) o += unpk4(*(const u32x2*)(zc + (((t2 * 2 + rt) * 4 + g) * 64 + lane) * 8)); \
            *(u32x2*)(zb + 32768 + ((C) & 7) * 4096 + (32 * rt + r) * 64 + (8 * g + 4 * hh) * 2) = pk4(o * qd); } \
          \
        if (((C) & 7) == 7) { __syncthreads(); \
            _Pragma("unroll") for (int i = 0; i < 8; ++i)   \
                *(u32x4*)((unsigned char*)ob + (size_t)(((C) - 7) * 64 + i * 64) * 4096 + fo) = *(const u32x4*)(zb + 32768 + i * 4096 + fl); } } while (0)
    const unsigned fo = (unsigned)(vt_ >> 2) * 4096u + (unsigned)(vt_ & 3) * 16u, fl = (unsigned)(vt_ >> 2) * 64u + (unsigned)(vt_ & 3) * 16u;
    ScanSet A, B, Cc;
    { const bf16x8 v0 = *(const bf16x8*)(vp + vo); *(bf16x8*)(vring + t * 1024 + lane * 16) = v0; }
    ST_LOAD(A, 0); ST_LOADDC(A, 0); ST_LOAD(B, 1);
    __syncthreads();
#pragma unroll 1
    for (int c0 = 0; c0 < 66; c0 += 3) { ST_STEP(A, Cc, B, c0); ST_STEP(B, A, Cc, c0 + 1); ST_STEP(Cc, B, A, c0 + 2); }
    __syncthreads();
#undef ST_STEP
#undef ST_UPD
#undef ST_Z
#undef ST_LOADDC
#undef ST_LOAD
#undef ST_CL
}
DEVI void phase3t(const Params& p, unsigned char* smem, int dummy) {
    for (int it0 = VB; it0 < 512; it0 += VG) {
        const int lcl = (RB >> 3) * 2 + VH;
        const int it = (VG == 512) ? ((RB & 7) * 8 + lcl / 8) * 8 + (lcl & 7) : it0;
        const int s = it & 7, h = (it >> 3) & 3, b = (it >> 5) & 7, br = it >> 8;
        if (br == 0) scan_tile<false>(p, smem, b, h, s, dummy); else scan_tile<true>(p, smem, b, h, s, dummy);
    }
}

constexpr int PS_LD = 72;
DEVI void phase4(const Params& p, unsigned char* smem) {
    const int t = VT, lane = t & 63, w = t >> 6, l15 = lane & 15, q = lane >> 4;
    bf16_t* Ps = (bf16_t*)smem + w * 16 * PS_LD;
    const bf16_t* Qr = (const bf16_t*)(p.ws + OFF_QR); const bf16_t* Kr = (const bf16_t*)(p.ws + OFF_KR);
    const bf16_t* Vrt = (const bf16_t*)(p.ws + OFF_VRT); const bf16_t* Oo = (const bf16_t*)(p.ws + OFF_OO);
    const bf16_t* Gs = (const bf16_t*)(p.ws + OFF_GS); bf16_t* Y = (bf16_t*)(p.ws + OFF_Y);
    for (int it = VB; it < 4096; it += VG) {
        const int br = it >> 11, idx = it & 2047;
        const int h = idx & 3, c = (idx >> 2) & 63, b = idx >> 8;
        const size_t tok0 = (size_t)b * 4096 + c * 64;
        const size_t tok = tok0 + 16 * w + l15;
        f32x4 O[16];
        const bf16_t* orow = Oo + tok * 2048 + br * 1024 + h * 256 + 4 * q;
        const bf16_t* grow = Gs + tok * 2048 + br * 1024 + h * 256 + 4 * q;
        u32x2 oraw[16], graw[16];
        if (br == 0) {
            const float lg = gamma_log2(h);
            bf16x8 vf[8][2];
#pragma unroll
            for (int nt = 0; nt < 8; ++nt) { vf[nt][0] = *(const bf16x8*)(Vrt + vf_off(idx, 16 * nt + l15, q * 8)); vf[nt][1] = *(const bf16x8*)(Vrt + vf_off(idx, 16 * nt + l15, 32 + q * 8)); }
            __builtin_amdgcn_sched_barrier(0);
            f32x4 P[4] = {(f32x4){0.f, 0.f, 0.f, 0.f}, (f32x4){0.f, 0.f, 0.f, 0.f}, (f32x4){0.f, 0.f, 0.f, 0.f}, (f32x4){0.f, 0.f, 0.f, 0.f}};
#pragma unroll
            for (int ks = 0; ks < 4; ++ks) {
                const bf16x8 qf = *(const bf16x8*)(Qr + tok * 512 + h * 128 + ks * 32 + q * 8);
#pragma unroll
                for (int mt = 0; mt < 4; ++mt) {
                    const bf16x8 kf = *(const bf16x8*)(Kr + (tok0 + 16 * mt + l15) * 512 + h * 128 + ks * 32 + q * 8);
                    P[mt] = mfma16(kf, qf, P[mt]);
                }
            }
            const int j = 16 * w + l15;
#pragma unroll
            for (int mt = 0; mt < 4; ++mt) {
                f32x4 v = P[mt];
#pragma unroll
                for (int r = 0; r < 4; ++r) { const int m = 16 * mt + 4 * q + r; const int dd = j > m ? j - m : m - j; v[r] *= exp2f(lg * (float)dd); }
                *(u32x2*)&Ps[l15 * PS_LD + 16 * mt + 4 * q] = pk4(v);
            }
            __syncthreads();
            const bf16x8 pf0 = *(const bf16x8*)&Ps[l15 * PS_LD + q * 8];
            const bf16x8 pf1 = *(const bf16x8*)&Ps[l15 * PS_LD + 32 + q * 8];
            __builtin_amdgcn_sched_barrier(0);
#pragma unroll
            for (int nt = 0; nt < 8; ++nt) {
                f32x4 o = (f32x4){0.f, 0.f, 0.f, 0.f};
                o = mfma16(vf[nt][0], pf0, o); O[nt] = mfma16(vf[nt][1], pf1, o);
            }
            __builtin_amdgcn_sched_barrier(0);
#pragma unroll
            for (int nt = 0; nt < 8; ++nt) { vf[nt][0] = *(const bf16x8*)(Vrt + vf_off(idx, 16 * (8 + nt) + l15, q * 8)); vf[nt][1] = *(const bf16x8*)(Vrt + vf_off(idx, 16 * (8 + nt) + l15, 32 + q * 8)); }
#pragma unroll
            for (int nt = 0; nt < 16; ++nt) { oraw[nt] = *(const u32x2*)(orow + 16 * nt); graw[nt] = *(const u32x2*)(grow + 16 * nt); }
            __builtin_amdgcn_sched_barrier(0);
#pragma unroll
            for (int nt = 0; nt < 8; ++nt) {
                f32x4 o = (f32x4){0.f, 0.f, 0.f, 0.f};
                o = mfma16(vf[nt][0], pf0, o); O[8 + nt] = mfma16(vf[nt][1], pf1, o);
            }
#pragma unroll
            for (int nt = 0; nt < 16; ++nt) O[nt] += unpk4(oraw[nt]);
            __syncthreads();
        } else {
#pragma unroll
            for (int nt = 0; nt < 16; ++nt) { oraw[nt] = *(const u32x2*)(orow + 16 * nt); graw[nt] = *(const u32x2*)(grow + 16 * nt); }
#pragma unroll
            for (int nt = 0; nt < 16; ++nt) O[nt] = unpk4(oraw[nt]);
        }
        float s1 = 0.f;
#pragma unroll
        for (int nt = 0; nt < 16; ++nt) s1 += (O[nt][0] + O[nt][1]) + (O[nt][2] + O[nt][3]);
        s1 += __shfl_xor(s1, 16); s1 += __shfl_xor(s1, 32);
        const float mean = (br == 0) ? s1 * (1.0f / 256.0f) : 0.f;
        float s2 = 0.f;
#pragma unroll
        for (int nt = 0; nt < 16; ++nt) {
#pragma unroll
            for (int r = 0; r < 4; ++r) { const float dlt = O[nt][r] - mean; s2 += dlt * dlt; }
        }
        s2 += __shfl_xor(s2, 16); s2 += __shfl_xor(s2, 32);
        const float rstd = rsqrtf(s2 * (1.0f / 256.0f) + (br == 0 ? 1e-5f : 1e-6f));
        const float* gw = (br == 0 ? p.ret_norm_g : p.gla_norm_g) + h * 256 + 4 * q;
        bf16_t* yrow = Y + ((size_t)br * T_ + tok) * 1024 + h * 256 + 4 * q;
#pragma unroll
        for (int nt = 0; nt < 16; ++nt) {
            const f32x4 g = *(const f32x4*)(gw + 16 * nt);
            const f32x4 gate = unpk4(graw[nt]);
            f32x4 y;
#pragma unroll
            for (int r = 0; r < 4; ++r) y[r] = (O[nt][r] - mean) * rstd * g[r] * gate[r];
            *(u32x2*)(yrow + 16 * nt) = pk4(y);
        }
    }
}

struct EpiMerge {
    static constexpr bool PERM = true, AFTER_DRAIN = false;
    const bf16_t* Mg; bf16_t* Mrg; int pass;
    __device__ __forceinline__ void operator()(const pg8::f32x4 (&acc)[2][2][4][2], const pg8::Unit& u, int wr, int wc, int fr, int fq) const {
        const int row0 = u.pm * 256 + wr * 64 + fr, col0 = u.pn * 256 + wc * 32 + 8 * fq;
#pragma unroll
        for (int ai = 0; ai < 2; ++ai) {
            u32x4 gg[4][2], pr[4][2];
#pragma unroll
            for (int m = 0; m < 4; ++m)
#pragma unroll
                for (int bj = 0; bj < 2; ++bj) {
                    const size_t row = row0 + ai * 128 + m * 16; const int col = col0 + bj * 128;
                    gg[m][bj] = *(const u32x4*)(Mg + row * 2048 + pass * 1024 + col);
                    if (pass) pr[m][bj] = *(const u32x4*)(Mrg + row * 1024 + col);
                }
#pragma unroll
            for (int m = 0; m < 4; ++m)
#pragma unroll
                for (int bj = 0; bj < 2; ++bj) {
                    const size_t row = row0 + ai * 128 + m * 16; const int col = col0 + bj * 128;
                    f32x4 g0, g1; unpk8(gg[m][bj], g0, g1);
                    f32x4 o0 = acc[ai][bj][m][0] * g0, o1 = acc[ai][bj][m][1] * g1;
                    if (pass) { f32x4 p0, p1; unpk8(pr[m][bj], p0, p1); o0 += p0; o1 += p1; }
                    *(u32x4*)(Mrg + row * 1024 + col) = pk8(o0, o1);
                }
        }
    }
};
DEVI void phase5(const Params& p, unsigned char* smem_all) {
    pg8::StaticOrder S; S.init(T_, 1024, RG, RB);
    const bf16_t* Y = (const bf16_t*)(p.ws + OFF_Y); const bf16_t* wt = (const bf16_t*)(p.ws + OFF_WT);
    for (int pass = 0; pass < 2; ++pass) {
        pg8::Gemm g; g.A = Y + (size_t)pass * T_ * 1024; g.Bt = wt + (size_t)(pass ? WT_GLA : WT_RET) * 1024; g.M = T_; g.N = 1024; g.K = 1024;
        EpiMerge E; E.Mg = (const bf16_t*)(p.ws + OFF_MG); E.Mrg = (bf16_t*)(p.ws + OFF_MRG); E.pass = pass;
        pg8::gemm_phase<EpiMerge, pg8::StaticOrder, true, true>((PG8_LAS unsigned char*)smem_all, g, S, E);
        __syncthreads();
    }
}

struct EpiResid {
    static constexpr bool PERM = true, AFTER_DRAIN = false;
    const float* x; bf16_t* T1;
    __device__ __forceinline__ void operator()(const pg8::f32x4 (&acc)[2][2][4][2], const pg8::Unit& u, int wr, int wc, int fr, int fq) const {
        const int row0 = u.pm * 256 + wr * 64 + fr, col0 = u.pn * 256 + wc * 32 + 8 * fq;
#pragma unroll
        for (int ai = 0; ai < 2; ++ai)
#pragma unroll
            for (int m = 0; m < 4; ++m) {
                const size_t row = row0 + ai * 128 + m * 16;
                f32x4 xv[2][2];
#pragma unroll
                for (int bj = 0; bj < 2; ++bj) { xv[bj][0] = *(const f32x4*)(x + row * 1024 + col0 + bj * 128); xv[bj][1] = *(const f32x4*)(x + row * 1024 + col0 + bj * 128 + 4); }
#pragma unroll
                for (int bj = 0; bj < 2; ++bj)
                    *(u32x4*)(T1 + row * 1024 + col0 + bj * 128) = pk8(xv[bj][0] * ALPHA_ + acc[ai][bj][m][0], xv[bj][1] * ALPHA_ + acc[ai][bj][m][1]);
            }
    }
};
DEVI void phase6(const Params& p, unsigned char* smem_all) {
    pg8::StaticOrder S; S.init(T_, 1024, RG, RB);
    pg8::Gemm g; g.A = (const bf16_t*)(p.ws + OFF_MRG); g.Bt = (const bf16_t*)(p.ws + OFF_WT) + (size_t)WT_O * 1024; g.M = T_; g.N = 1024; g.K = 1024;
    EpiResid E; E.x = p.x; E.T1 = (bf16_t*)(p.ws + OFF_T1);
    pg8::gemm_phase<EpiResid, pg8::StaticOrder, true, true>((PG8_LAS unsigned char*)smem_all, g, S, E);
}

struct ConvTask { const float* sp; bf16_t* dp; int N; };
DEVI ConvTask conv_task(const Params& p, int task, int t) {
    const int ng = t & 31, kg = t >> 5;
    bf16_t* WGU = (bf16_t*)(p.ws + OFF_WGU); bf16_t* WD = (bf16_t*)(p.ws + OFF_WD);
    const int e = task / 96, rem = task - e * 96, mat = rem >> 5, tl = rem & 31;
    const float* src; bf16_t* dst; int K, N, kt, nt;
    if (mat < 2) { K = 1024; N = 256; kt = tl >> 1; nt = tl & 1;
        src = (mat == 0) ? (e < 256 ? p.ew_gate + (size_t)e * 262144 : p.sw_gate) : (e < 256 ? p.ew_up + (size_t)e * 262144 : p.sw_up);
        dst = WGU + (size_t)e * 524288 + (size_t)(nt + mat) * 131072; }
    else { K = 256; N = 1024; kt = tl >> 3; nt = tl & 7;
        src = e < 256 ? p.ew_down + (size_t)e * 262144 : p.sw_down; dst = WD + (size_t)e * 262144; }
    ConvTask c; c.N = N;
    c.sp = src + (size_t)(kt * 64 + 4 * kg) * N + nt * 128 + 4 * ng;
    c.dp = dst + (size_t)(nt * 128 + (t >> 1)) * K + kt * 64 + (t & 1) * 32;
    return c;
}
DEVI ConvTask convs_task(const Params& p, int st, int t) {
    const int ng = t & 15, kg = t >> 4, task = st >> 1, sub = st & 1;
    bf16_t* WGU = (bf16_t*)(p.ws + OFF_WGU); bf16_t* WD = (bf16_t*)(p.ws + OFF_WD);
    const int e = task / 96, rem = task - e * 96, mat = rem >> 5, tl = rem & 31;
    const float* src; bf16_t* dst; int K, N, kt, nt;
    if (mat < 2) { K = 1024; N = 256; kt = tl >> 1; nt = tl & 1;
        src = (mat == 0) ? (e < 256 ? p.ew_gate + (size_t)e * 262144 : p.sw_gate) : (e < 256 ? p.ew_up + (size_t)e * 262144 : p.sw_up);
        dst = WGU + (size_t)e * 524288 + (size_t)(nt + mat) * 131072; }
    else { K = 256; N = 1024; kt = tl >> 3; nt = tl & 7;
        src = e < 256 ? p.ew_down + (size_t)e * 262144 : p.sw_down; dst = WD + (size_t)e * 262144; }
    ConvTask c; c.N = N;
    c.sp = src + (size_t)(kt * 64 + 4 * kg) * N + nt * 128 + sub * 64 + 4 * ng;
    c.dp = dst + (size_t)(nt * 128 + sub * 64 + (t >> 2)) * K + kt * 64 + (t & 3) * 16;
    return c;
}
DEVI void conv_expert_weights(const Params& p, unsigned char* smem) {
    bf16_t* tile = (bf16_t*)smem;
    const int t = VT, ng = t & 31, kg = t >> 5;
    const int ntask = 257 * 3 * 32;
#define CV_LOAD(RF, C) do { _Pragma("unroll") for (int i = 0; i < 4; ++i) { RF[i] = *(const f32x4*)((C).sp + (size_t)i * (C).N); RF[4 + i] = *(const f32x4*)((C).sp + (size_t)(32 + i) * (C).N); } } while (0)
#define CV_PROC(RF, C) do { \
        _Pragma("unroll") for (int i = 0; i < 4; ++i) { \
            u32x2 v0, v1; \
            v0.x = pk2(RF[0][i], RF[1][i]); v0.y = pk2(RF[2][i], RF[3][i]); v1.x = pk2(RF[4][i], RF[5][i]); v1.y = pk2(RF[6][i], RF[7][i]); \
            *(u32x2*)&tile[(4 * ng + i) * 72 + 4 * kg] = v0; *(u32x2*)&tile[(4 * ng + i) * 72 + 32 + 4 * kg] = v1; } \
        asm volatile("s_waitcnt lgkmcnt(0)" ::: "memory"); __builtin_amdgcn_s_barrier(); asm volatile("" ::: "memory"); \
        { const int n = t >> 1, hf = t & 1; \
          _Pragma("unroll") for (int j = 0; j < 4; ++j) *(u32x4*)((C).dp + 8 * j) = *(const u32x4*)&tile[n * 72 + hf * 32 + 8 * j]; } \
        asm volatile("s_waitcnt lgkmcnt(0)" ::: "memory"); __builtin_amdgcn_s_barrier(); asm volatile("" ::: "memory"); } while (0)
    f32x4 ra[8], rb[8];
    int task = 8 * VG + VB;
    if (task >= ntask) return;
    ConvTask ca = conv_task(p, task, t), cb = ca;
    CV_LOAD(ra, ca);
#pragma unroll 1
    for (;;) {
        bool more = task + VG < ntask;
        cb = conv_task(p, more ? task + VG : task, t); CV_LOAD(rb, cb);
        CV_PROC(ra, ca);
        if (!more) break;
        task += VG;
        more = task + VG < ntask;
        ca = conv_task(p, more ? task + VG : task, t); CV_LOAD(ra, ca);
        CV_PROC(rb, cb);
        if (!more) break;
        task += VG;
    }
#undef CV_LOAD
#undef CV_PROC
}

DEVI void ln1_row(const Params& p, int row, int lane) {
    const bf16_t* T1 = (const bf16_t*)(p.ws + OFF_T1); bf16_t* X1b = (bf16_t*)(p.ws + OFF_X1B);
    f32x4 v[4]; float s = 0.f;
#pragma unroll
    for (int i = 0; i < 4; ++i) { v[i] = unpk4(*(const u32x2*)(T1 + (size_t)row * 1024 + i * 256 + lane * 4)); s += (v[i][0] + v[i][1]) + (v[i][2] + v[i][3]); }
#pragma unroll
    for (int o = 32; o > 0; o >>= 1) s += __shfl_xor(s, o);
    const float mean = s * (1.0f / 1024.0f); float s2 = 0.f;
#pragma unroll
    for (int i = 0; i < 4; ++i)
#pragma unroll
        for (int r = 0; r < 4; ++r) { const float d = v[i][r] - mean; s2 += d * d; }
#pragma unroll
    for (int o = 32; o > 0; o >>= 1) s2 += __shfl_xor(s2, o);
    const float rstd = rsqrtf(s2 * (1.0f / 1024.0f) + 1e-5f);
#pragma unroll
    for (int i = 0; i < 4; ++i) {
        const int col = i * 256 + lane * 4;
        const f32x4 g = *(const f32x4*)(p.ln1_g + col), bb = *(const f32x4*)(p.ln1_b + col);
        f32x4 y;
#pragma unroll
        for (int r = 0; r < 4; ++r) y[r] = (v[i][r] - mean) * rstd * g[r] + bb[r];
        *(u32x2*)(X1b + (size_t)row * 1024 + col) = pk4(y);
    }
}

DEVI unsigned f2ord(float f) { const unsigned u = __float_as_uint(f); return (u & 0x80000000u) ? ~u : (u | 0x80000000u); }
template <int CTRL> DEVI float dppf(float v) { const int x = __float_as_int(v); return __int_as_float(__builtin_amdgcn_update_dpp(x, x, CTRL, 0xf, 0xf, false)); }
template <int CTRL> DEVI void top2_merge(float& m1, float& m2) {
    const float p1 = dppf<CTRL>(m1), p2 = dppf<CTRL>(m2);
    const float n1 = fmaxf(m1, p1), n2 = fmaxf(fminf(m1, p1), fmaxf(m2, p2));
    m1 = n1; m2 = n2;
}
DEVI void route_token(const f32x4 lg, const f32x4 rb, int lane, int& mye, float& myw) {
    const int mygrp = lane >> 3;
    float sc[4], bi[4];
#pragma unroll
    for (int r = 0; r < 4; ++r) { sc[r] = sigmoidf_(lg[r]); bi[r] = sc[r] + rb[r]; }
    float m1, m2;
    { const float h01 = fmaxf(bi[0], bi[1]), l01 = fminf(bi[0], bi[1]), h23 = fmaxf(bi[2], bi[3]), l23 = fminf(bi[2], bi[3]);
      m1 = fmaxf(h01, h23); m2 = fmaxf(fminf(h01, h23), fmaxf(l01, l23)); }
    top2_merge<0xB1>(m1, m2);
    top2_merge<0x4E>(m1, m2);
    top2_merge<0x141>(m1, m2);
    const float gown = m1 + m2;
    int rank = 0;
#pragma unroll
    for (int g2 = 0; g2 < 8; ++g2) {
        const float go = __builtin_bit_cast(float, __builtin_amdgcn_readlane(__builtin_bit_cast(int, gown), 8 * g2));
        rank += (go > gown || (go == gown && g2 < mygrp)) ? 1 : 0;
    }
    unsigned ck[4];
#pragma unroll
    for (int r = 0; r < 4; ++r) ck[r] = rank < 4 ? f2ord(bi[r]) : 0u;
    unsigned thr = 0u; bool exact = false;
#pragma unroll 1
    for (int bit = 31; bit >= 0; --bit) {
        const unsigned cnd = thr | (1u << bit);
        const int c8 = __popcll(__ballot(ck[0] >= cnd)) + __popcll(__ballot(ck[1] >= cnd)) + __popcll(__ballot(ck[2] >= cnd)) + __popcll(__ballot(ck[3] >= cnd));
        if (c8 >= 8) { thr = cnd; if (c8 == 8) { exact = true; break; } }
    }
    unsigned long long selm[4];
    if (exact) {
#pragma unroll
        for (int r = 0; r < 4; ++r) selm[r] = __ballot(ck[r] >= thr);
    } else {
        unsigned long long eq[4], any = 0ull; int need = 8;
#pragma unroll
        for (int r = 0; r < 4; ++r) { selm[r] = __ballot(ck[r] > thr); eq[r] = __ballot(ck[r] == thr); need -= __popcll(selm[r]); any |= eq[r]; }
        while (need > 0 && any != 0ull) {
            const int L = __builtin_ctzll(any); any &= any - 1ull;
#pragma unroll
            for (int r = 0; r < 4; ++r) if (((eq[r] >> L) & 1ull) != 0ull && need > 0) { selm[r] |= 1ull << L; --need; }
        }
    }
    float wsum = 0.f; int kk = 0;
    mye = 0; myw = 0.f;
#pragma unroll
    for (int r = 0; r < 4; ++r) {
        unsigned long long m = selm[r];
        while (m != 0ull) {
            const int L = __builtin_ctzll(m); m &= m - 1ull;
            const float sv = __builtin_bit_cast(float, __builtin_amdgcn_readlane(__builtin_bit_cast(int, sc[r]), L));
            wsum += sv;
            if (lane == kk) { mye = 4 * L + r; myw = sv; }
            ++kk;
        }
    }
    myw = myw / wsum * 2.5f;
}
DEVI void router_gemm(const Params& p, unsigned char* smem_all, int m0, f32x4 (&acc)[4][4]) {
    typedef __attribute__((address_space(3))) unsigned char lds8;
    lds8* const L = (lds8*)smem_all;
    const int tid = (int)threadIdx.x, lane = tid & 63, wv = __builtin_amdgcn_readfirstlane(tid >> 6), wr = wv >> 2, wc = wv & 3, l15 = lane & 15, q = lane >> 4;
    const bf16_t* pa = (const bf16_t*)(p.ws + OFF_X1B) + (size_t)(m0 + (tid >> 3)) * 1024 + gemm_src_chunk(tid);
    const bf16_t* pb = (const bf16_t*)(p.ws + OFF_WT) + (size_t)(WT_R + (tid >> 3)) * 1024 + gemm_src_chunk(tid);
    constexpr int STG = 49152;
#define RG_BOFF(BUF, I) ((BUF) * STG + 16384 + (I) * 8192 + (((BUF) == 2 && (I) >= 2) ? (2 * SMEM_HALF - 131072) : 0))
#define RG_ISSUE(BUF, KT) do { \
        _Pragma("unroll") for (int i = 0; i < 2; ++i) __builtin_amdgcn_global_load_lds((const unsigned*)(pa + (size_t)i * 65536 + (KT) * 64), (__attribute__((address_space(3))) unsigned*)(L + (BUF) * STG + i * 8192 + wv * 1024), 16, 0, 0); \
        _Pragma("unroll") for (int i = 0; i < 4; ++i) __builtin_amdgcn_global_load_lds((const unsigned*)(pb + (size_t)i * 65536 + (KT) * 64), (__attribute__((address_space(3))) unsigned*)(L + RG_BOFF(BUF, i) + wv * 1024), 16, 0, 0); } while (0)
    static_assert(2 * STG + 16384 + 2 * 8192 == 131072 && 2 * SMEM_HALF + 2 * 8192 <= 2 * SMEM_HALF + SMEM_MOE, "router GEMM stage map");
    RG_ISSUE(0, 0); RG_ISSUE(1, 1);
    int buf = 0;
#pragma unroll 1
    for (int kt = 0; kt < 16; ++kt) {
        if (kt + 1 < 16) asm volatile("s_waitcnt vmcnt(6)" ::: "memory"); else asm volatile("s_waitcnt vmcnt(0)" ::: "memory");
        __builtin_amdgcn_s_barrier();
        if (kt + 2 < 16) { const int b2 = buf == 0 ? 2 : buf - 1; RG_ISSUE(b2, kt + 2); }
        __builtin_amdgcn_sched_barrier(0);
#pragma unroll
        for (int ss = 0; ss < 2; ++ss) {
            bf16x8 af[4], bfr[4];
            const int coff = ((ss * 4 + q) ^ (l15 >> 1)) * 16;
#pragma unroll
            for (int i = 0; i < 4; ++i) {
                af[i]  = *(const __attribute__((address_space(3))) bf16x8*)(L + buf * STG + (wr * 64 + i * 16 + l15) * 128 + coff);
                bfr[i] = *(const __attribute__((address_space(3))) bf16x8*)(L + RG_BOFF(buf, wc) + (i * 16 + l15) * 128 + coff); }
#pragma unroll
            for (int mt = 0; mt < 4; ++mt)
#pragma unroll
                for (int nt = 0; nt < 4; ++nt) acc[mt][nt] = mfma16(bfr[nt], af[mt], acc[mt][nt]);
        }
        __builtin_amdgcn_sched_barrier(0);
        buf = buf == 2 ? 0 : buf + 1;
    }
#undef RG_ISSUE
#undef RG_BOFF
    __syncthreads();
}
DEVI void phase8(const Params& p, unsigned char* smem_all) {
    const int tid = (int)threadIdx.x, lane = tid & 63, wv = tid >> 6, wr = wv >> 2, wc = wv & 3, l15 = lane & 15, q = lane >> 4;
    int* hist = (int*)(smem_all + 2 * SMEM_HALF); int* rec = hist + 256; float* wrec = (float*)(rec + 1024);
    int* cnt = (int*)(p.ws + OFF_CNT); int* list = (int*)(p.ws + OFF_LIST); float* wl = (float*)(p.ws + OFF_WL);
    const f32x4 rb = *(const f32x4*)(p.router_bias + 4 * lane);
    for (int mtg = RB; mtg < 256; mtg += RG) {
        const int m0 = mtg * 128;
#pragma unroll 1
        for (int i = 0; i < 16; i += 4) {
#pragma unroll
            for (int j = 0; j < 4; ++j) ln1_row(p, m0 + wv * 16 + i + j, lane);
        }
        asm volatile("s_waitcnt vmcnt(0)" ::: "memory");
        __syncthreads();
        f32x4 acc[4][4]; zero_acc(acc);
        router_gemm(p, smem_all, m0, acc);
        if (tid < 256) hist[tid] = 0;
#pragma unroll
        for (int mt = 0; mt < 4; ++mt)
#pragma unroll
            for (int nt = 0; nt < 4; ++nt) {
                const int row = wr * 64 + mt * 16 + l15, col = wc * 64 + (nt >> 1) * 32 + 8 * q + 4 * (nt & 1);
                *(f32x4*)(smem_all + row * 1024 + (((col >> 2) ^ (row & 15)) * 16)) = acc[mt][nt];
            }
        __syncthreads();
        bf16_t* ctile = (bf16_t*)(smem_all + 2 * SMEM_HALF + 9216 + VH * 9216);
        const int vt = VT, cng = vt & 15, ckg = vt >> 4;
#define P8_BAR do { asm volatile("s_waitcnt lgkmcnt(0)" ::: "memory"); __builtin_amdgcn_s_barrier(); asm volatile("" ::: "memory"); } while (0)
#define P8_CLOAD(RF, C) do { _Pragma("unroll") for (int r = 0; r < 4; ++r) RF[r] = *(const f32x4*)((C).sp + (size_t)r * (C).N); } while (0)
#define P8_CPROC(RF, C) do { \
            _Pragma("unroll") for (int c4 = 0; c4 < 4; ++c4) { u32x2 w; w.x = pk2(RF[0][c4], RF[1][c4]); w.y = pk2(RF[2][c4], RF[3][c4]); *(u32x2*)&ctile[(4 * cng + c4) * 72 + 4 * ckg] = w; } \
            P8_BAR; \
            { const u32x4 o0 = *(const u32x4*)&ctile[(vt >> 2) * 72 + (vt & 3) * 16], o1 = *(const u32x4*)&ctile[(vt >> 2) * 72 + (vt & 3) * 16 + 8]; \
              *(u32x4*)((C).dp) = o0; *(u32x4*)((C).dp + 8) = o1; } \
            P8_BAR; } while (0)
#define P8_ROUTE(I) do { const int tl = wv + 8 * (I); \
            const f32x4 lg = *(const f32x4*)(smem_all + tl * 1024 + ((lane ^ (tl & 15)) * 16)); \
            int mye; float myw; route_token(lg, rb, lane, mye, myw); \
            if (lane < 8) { \
                const int lpos = __hip_atomic_fetch_add(&hist[mye], 1, __ATOMIC_RELAXED, __HIP_MEMORY_SCOPE_WORKGROUP); \
                rec[tl * 8 + lane] = mye | (lpos << 8); wrec[tl * 8 + lane] = myw; } } while (0)
        {
            f32x4 fa[4], fb[4];
            const int st0 = (mtg == RB) ? VB : 0x7fffffff;
            ConvTask ka = convs_task(p, st0 < 16 * VG ? st0 : 0, vt), kb = ka;
            P8_CLOAD(fa, ka);
#pragma unroll 1
            for (int i = 0; i < 16; i += 2) {
                kb = convs_task(p, st0 < 16 * VG ? st0 + (i + 1) * VG : 0, vt); P8_CLOAD(fb, kb);
                P8_ROUTE(i);
                if (st0 < 16 * VG) P8_CPROC(fa, ka); else { P8_BAR; P8_BAR; }
                ka = convs_task(p, (st0 < 16 * VG && i + 2 < 16) ? st0 + (i + 2) * VG : 0, vt); P8_CLOAD(fa, ka);
                P8_ROUTE(i + 1);
                if (st0 < 16 * VG) P8_CPROC(fb, kb); else { P8_BAR; P8_BAR; }
            }
        }
#undef P8_ROUTE
#undef P8_CPROC
#undef P8_CLOAD
#undef P8_BAR
        __syncthreads();
        if (tid < 256) { const int c = hist[tid]; hist[tid] = c > 0 ? atomicAdd(&cnt[tid * CNT_STRIDE], c) : 0; }
        __syncthreads();
        for (int i = tid; i < 1024; i += 512) {
            const int rc = rec[i], e = rc & 255, pos = hist[e] + (rc >> 8);
            list[(size_t)e * T_ + pos] = (m0 + (i >> 3)) * 9 + (i & 7); wl[(size_t)e * T_ + pos] = wrec[i];
        }
        __syncthreads();
    }
}

DEVI void moe_prefix256(const Params& p, int* pre  , int xg) {
    const int tid = threadIdx.x;
    const int* cnt = (const int*)(p.ws + OFF_CNT);
    __syncthreads();
    if (tid < 64) {
        int v = 0;
        if (tid < 32) { const int c = __hip_atomic_load(&cnt[(xg + 8 * tid) * CNT_STRIDE], __ATOMIC_RELAXED, __HIP_MEMORY_SCOPE_AGENT); pre[40 + tid] = c; v = (c + 255) >> 8; }
        else if (tid == 32) { v = 16; pre[40 + 32] = T_; }
#pragma unroll
        for (int o = 1; o < 64; o <<= 1) { const int u = __shfl_up(v, o); if (tid >= o) v += u; }
        if (tid < 33) pre[tid + 1] = v;
        if (tid == 0) pre[0] = 0;
    }
    __syncthreads();
}
struct MoeSched {
    const int* pre; const unsigned char* ws; bool need_w;
    int* sbuf;
    int xg, jl, nloc, nsh, nitems;
    const char* Abase; int arow_bytes; bool by_token;
    const char* Bbase; size_t b_expert_bytes, b_unit_bytes;
    __device__ __forceinline__ bool next(int i, pg8::Unit& u) const {
        const int item = jl + i * nloc; if (item >= nitems) return false;
        u.pm = item >> nsh; u.pn = item - (u.pm << nsh);
        const int lane = (int)(threadIdx.x & 63), li = lane < 33 ? lane : 32;
        const int pv = pre[li], cv = pre[40 + li];
        const int gi = __popcll(__ballot(lane < 33 && pv <= u.pm)) - 1;
        const int pg = __builtin_amdgcn_readlane(pv, gi);
        u.ce = __builtin_amdgcn_readlane(cv, gi);
        u.e = gi < 32 ? xg + 8 * gi : 256; u.r0 = (gi < 32 ? 0 : xg * 4096) + (u.pm - pg) * 256;
        return true;
    }
    __device__ __forceinline__ void decode(const pg8::Unit& u, int& e, int& r0, int& ce) const { e = u.e; r0 = u.r0; ce = u.ce; }
    __device__ __forceinline__ int fill_issue(const pg8::Unit& u) const {
        int e, r0, ce; decode(u, e, r0, ce);
        const int pos = r0 + (int)(threadIdx.x & 255); const bool w = threadIdx.x >= 256;
        int v = w ? 0 : -1;
        if (pos < ce && !(w && !need_w)) {
            unsigned hi = threadIdx.x >> 8; asm volatile("" : "+v"(hi));
            static_assert(OFF_WL == OFF_LIST + (512u << 20), "weight list sits 512 MB above the slot list");
            const unsigned off = (unsigned)OFF_LIST + (hi << 29) + ((unsigned)e * (unsigned)T_ + (unsigned)pos) * 4u;
            v = e < 256 ? *(const int*)(ws + off) : (w ? 0x3f800000 : pos * 9 + 8);
        }
        return v;
    }
    __device__ __forceinline__ void fill_write(int buf, int v) const { sbuf[(threadIdx.x >= 256 ? 768 : 0) + buf * 256 + (int)(threadIdx.x & 255)] = v; }
    __device__ __forceinline__ const char* a_base() const { return Abase; }
    __device__ __forceinline__ void a_rows(int buf, const int (&rowA)[2], const int (&colA)[2], unsigned& p00, unsigned& p01, unsigned& p10, unsigned& p11) const {
        const int* sb = sbuf + buf * 256; const int s0 = sb[0];
        int s4[4];
#pragma unroll
        for (int k = 0; k < 4; ++k) { int sl = sb[(k >> 1) * 128 + rowA[k & 1]]; if (sl < 0) sl = s0; s4[k] = sl; }
#pragma unroll
        for (int k = 0; k < 4; ++k) if (by_token) s4[k] = s4[k] / 9;
        p00 = (unsigned)s4[0] * (unsigned)arow_bytes + (unsigned)colA[0]; p01 = (unsigned)s4[1] * (unsigned)arow_bytes + (unsigned)colA[1];
        p10 = (unsigned)s4[2] * (unsigned)arow_bytes + (unsigned)colA[0]; p11 = (unsigned)s4[3] * (unsigned)arow_bytes + (unsigned)colA[1];
    }
    __device__ __forceinline__ const char* b_base(const pg8::Unit& u) const { int e, r0, ce; decode(u, e, r0, ce); return Bbase + (size_t)e * b_expert_bytes + (size_t)u.pn * b_unit_bytes; }
    __device__ __forceinline__ void a_ready(const pg8::Unit&) const {}
    __device__ __forceinline__ void done(const pg8::Unit&) const {}
};
struct EpiMoe1 {
    static constexpr bool PERM = true, AFTER_DRAIN = false, BJI = false;
    const MoeSched* S; bf16_t* H;
    __device__ __forceinline__ void operator()(const pg8::f32x4 (&acc)[2][2][4][2], const pg8::Unit& u, int wr, int wc, int fr, int fq, int buf) const {
        const int* sb = S->sbuf + buf * 256 + wr * 64 + fr;
#pragma unroll
        for (int ai = 0; ai < 2; ++ai) {
            int sl[4];
#pragma unroll
            for (int m = 0; m < 4; ++m) sl[m] = sb[ai * 128 + m * 16];
#pragma unroll
            for (int m = 0; m < 4; ++m) if (sl[m] >= 0) {
                f32x4 h0, h1;
#pragma unroll
                for (int r = 0; r < 4; ++r) { h0[r] = siluf_(acc[ai][0][m][0][r]) * acc[ai][1][m][0][r]; h1[r] = siluf_(acc[ai][0][m][1][r]) * acc[ai][1][m][1][r]; }
                *(u32x4*)(H + (size_t)sl[m] * 256 + u.pn * 128 + wc * 32 + 8 * fq) = pk8(h0, h1);
            }
            asm volatile("" ::: "memory");
        }
    }
};
struct EpiMoe2 {
    static constexpr bool PERM = true, AFTER_DRAIN = false, BJI = true;
    const MoeSched* S; unsigned char* YX;
    __device__ __forceinline__ void operator()(const pg8::f32x4 (&acc)[2][2][4][2], const pg8::Unit& u, int wr, int wc, int fr, int fq, int buf) const {
        const int* sb = S->sbuf + buf * 256 + wr * 64 + fr;
#pragma unroll
        for (int ai = 0; ai < 2; ++ai) {
            int sl[4]; float wg[4];
#pragma unroll
            for (int m = 0; m < 4; ++m) { sl[m] = sb[ai * 128 + m * 16]; wg[m] = __int_as_float(sb[768 + ai * 128 + m * 16]) * YX_SCALE; }
#pragma unroll
            for (int m = 0; m < 4; ++m) if (sl[m] >= 0) {
                u32x4 w8;
                w8.x = pk4_fp8(clamp4(acc[ai][0][m][0] * wg[m], 440.f)); w8.y = pk4_fp8(clamp4(acc[ai][0][m][1] * wg[m], 440.f));
                w8.z = pk4_fp8(clamp4(acc[ai][1][m][0] * wg[m], 440.f)); w8.w = pk4_fp8(clamp4(acc[ai][1][m][1] * wg[m], 440.f));
                *(u32x4*)(YX + (size_t)sl[m] * 1024 + u.pn * 256 + wc * 64 + 16 * fq) = w8;
            }
            asm volatile("" ::: "memory");
        }
    }
};
DEVI void moe_sched_init(const Params& p, MoeSched& S, int* pre) {
    S.pre = pre; S.ws = p.ws; S.need_w = false; S.sbuf = (int*)(smem_all_g + 2 * SMEM_HALF);
    S.xg = RB & 7; S.jl = RB >> 3; S.nloc = RG >> 3;
}
DEVI void phase10(const Params& p, unsigned char* smem_all) {
    int* pre = (int*)(smem_all + 131072);
    MoeSched S; moe_sched_init(p, S, pre); moe_prefix256(p, pre, S.xg);
    S.nsh = 1; S.nitems = pre[33] << 1; S.Abase = (const char*)(p.ws + OFF_X1B); S.arow_bytes = 2048; S.by_token = true;
    S.Bbase = (const char*)(p.ws + OFF_WGU); S.b_expert_bytes = (size_t)512 * 1024 * 2; S.b_unit_bytes = (size_t)256 * 1024 * 2;
    EpiMoe1 E; E.S = &S; E.H = (bf16_t*)(p.ws + OFF_H);
    pg8::gemm_phase_g<EpiMoe1, MoeSched, true, true>((PG8_LAS unsigned char*)smem_all, 1024, S, E);
}
DEVI void phase11(const Params& p, unsigned char* smem_all) {
    int* pre = (int*)(smem_all + 131072);
    MoeSched S; moe_sched_init(p, S, pre); moe_prefix256(p, pre, S.xg);
    S.nsh = 2; S.nitems = pre[33] << 2; S.Abase = (const char*)(p.ws + OFF_H); S.arow_bytes = 512; S.by_token = false;
    S.Bbase = (const char*)(p.ws + OFF_WD); S.b_expert_bytes = (size_t)1024 * 256 * 2; S.b_unit_bytes = (size_t)256 * 256 * 2;
    S.need_w = true;
    EpiMoe2 E; E.S = &S; E.YX = (unsigned char*)(p.ws + OFF_YX);
    pg8::gemm_phase_g<EpiMoe2, MoeSched, true, true>((PG8_LAS unsigned char*)smem_all, 256, S, E);
}

DEVI void phase12(const Params& p) {
    const int t = VT, lane = t & 63, w = t >> 6;
    const bf16_t* X1b = (const bf16_t*)(p.ws + OFF_X1B); const unsigned char* YX = (const unsigned char*)(p.ws + OFF_YX);
    for (int row = VB * 4 + w; row < T_; row += VG * 4) {
        f32x4 v[4]; float s = 0.f;
#pragma unroll
        for (int i = 0; i < 4; ++i) {
            const int col = i * 256 + lane * 4;
            f32x4 a = unpk4(*(const u32x2*)(X1b + (size_t)row * 1024 + col)) * ALPHA_;
            f32x4 ys = (f32x4){0.f, 0.f, 0.f, 0.f};
#pragma unroll
            for (int k = 0; k < 9; ++k) ys += unpk4_fp8(*(const unsigned*)(YX + ((size_t)row * 9 + k) * 1024 + col));
            a += ys * (1.0f / YX_SCALE);
            v[i] = a; s += (a[0] + a[1]) + (a[2] + a[3]);
        }
#pragma unroll
        for (int o = 32; o > 0; o >>= 1) s += __shfl_xor(s, o);
        const float mean = s * (1.0f / 1024.0f); float s2 = 0.f;
#pragma unroll
        for (int i = 0; i < 4; ++i)
#pragma unroll
            for (int r = 0; r < 4; ++r) { const float d = v[i][r] - mean; s2 += d * d; }
#pragma unroll
        for (int o = 32; o > 0; o >>= 1) s2 += __shfl_xor(s2, o);
        const float rstd = rsqrtf(s2 * (1.0f / 1024.0f) + 1e-5f);
#pragma unroll
        for (int i = 0; i < 4; ++i) {
            const int col = i * 256 + lane * 4;
            const f32x4 g = *(const f32x4*)(p.ln2_g + col), bb = *(const f32x4*)(p.ln2_b + col);
            f32x4 y;
#pragma unroll
            for (int r = 0; r < 4; ++r) y[r] = (v[i][r] - mean) * rstd * g[r] + bb[r];
            *(f32x4*)(p.out + (size_t)row * 1024 + col) = y;
        }
    }
}


#define XB_TMO      128
#define XB_XCNT(j)  (256  + 64 * (j))
#define XB_XSUB(j)  (1280 + 64 * (j))
#define XB_XGEN(j)  (2304 + 64 * (j))
#define XB_TOP      3328
#define XB_TOPGEN   3392
#define XCD_BAR_WORDS 3456
#define XB_SPIN_CAP (1u << 20)
#define LAS __attribute__((address_space(3)))
DEVI unsigned xb_ld(unsigned* p)              { return __hip_atomic_load(p, __ATOMIC_RELAXED, __HIP_MEMORY_SCOPE_AGENT); }
DEVI unsigned xb_add(unsigned* p, unsigned v) { return __hip_atomic_fetch_add(p, v, __ATOMIC_RELAXED, __HIP_MEMORY_SCOPE_AGENT); }
DEVI unsigned xb_xcc_id() { return (unsigned)__builtin_amdgcn_s_getreg((3 << 11) | 20) & 0xFu; }
#define XB_SPIN(cond, bar) do { unsigned _sp = 0; while (cond) { __builtin_amdgcn_s_sleep(1); \
    if ((++_sp & 255u) == 0u) { if (xb_ld(&(bar)[XB_TMO])) break; if (_sp > XB_SPIN_CAP) { atomicAdd(&(bar)[XB_TMO], 1u); break; } } } } while (0)
struct XcdBarrier { unsigned* bar; unsigned x; volatile LAS unsigned* st; };
DEVI XcdBarrier xcd_barrier_post(unsigned* bar, volatile LAS unsigned* st) {
    XcdBarrier b; b.bar = bar; b.x = xb_xcc_id(); b.st = st;
    if (threadIdx.x == 0) st[3] = xb_add(&bar[XB_XCNT(b.x)], 1u);
    return b;
}
DEVI void xcd_barrier_complete(unsigned* bar, unsigned x, unsigned& nloc, unsigned& nx) {
    const unsigned G = gridDim.x * gridDim.y * gridDim.z;
    unsigned sum, cnt, mine, sp = 0u;
    for (;;) {
        sum = 0u; cnt = 0u; mine = 0u;
#pragma unroll
        for (unsigned j = 0; j < 16; ++j) { const unsigned c = xb_ld(&bar[XB_XCNT(j)]); sum += c; cnt += (c > 0u) ? 1u : 0u; mine = (j == x) ? c : mine; }
        if (sum == G) break;
        __builtin_amdgcn_s_sleep(1);
        if ((++sp & 255u) == 0u) { if (xb_ld(&bar[XB_TMO])) break; if (sp > XB_SPIN_CAP) { atomicAdd(&bar[XB_TMO], 1u); break; } }
    }
    nloc = mine > 0u ? mine : 1u; nx = cnt > 0u ? cnt : 1u;
}
DEVI void xcd_barrier(const XcdBarrier& b) {
    asm volatile("s_waitcnt vmcnt(0)" ::: "memory");
    __syncthreads();
    if (threadIdx.x == 0) {
        unsigned* bar = b.bar;
        __builtin_amdgcn_s_waitcnt(0);
        unsigned nloc = b.st[0], nx = b.st[1];
        if (nloc == 0u) { xcd_barrier_complete(bar, b.x, nloc, nx); b.st[0] = nloc; b.st[1] = nx; }
        const unsigned old = xb_add(&bar[XB_XSUB(b.x)], 1u);
        const unsigned gen = old / nloc;
        if (old + 1u == (gen + 1u) * nloc) {
            __builtin_amdgcn_fence(__ATOMIC_RELEASE, "agent");
            asm volatile("s_waitcnt vmcnt(0)" ::: "memory");
            const unsigned og = xb_add(&bar[XB_TOP], 1u);
            const unsigned tg = og / nx;
            if (og + 1u == (tg + 1u) * nx) xb_add(&bar[XB_TOPGEN], 1u);
            else XB_SPIN(xb_ld(&bar[XB_TOPGEN]) == tg, bar);
            __builtin_amdgcn_fence(__ATOMIC_ACQUIRE, "agent");
            xb_add(&bar[XB_XGEN(b.x)], 1u);
            asm volatile("s_waitcnt vmcnt(0)" ::: "memory");
        } else {
            XB_SPIN(xb_ld(&bar[XB_XGEN(b.x)]) == gen, bar);
            __builtin_amdgcn_fence(__ATOMIC_ACQUIRE, "agent");
            asm volatile("s_waitcnt vmcnt(0)" ::: "memory");
        }
    }
    __syncthreads();
}
constexpr size_t OFF_BAR = 131072;

#ifndef DBG
#define DBG 0
#endif
DEVI void dump_f32(const Params& p, size_t off) {
    const f32x4* src = (const f32x4*)(p.ws + off); f32x4* dst = (f32x4*)p.out;
    for (int i = blockIdx.x * 256 + threadIdx.x; i < T_ * D_ / 4; i += gridDim.x * 256) dst[i] = src[i];
}
DEVI void dump_bf16(const Params& p, size_t off, int ld, int coff) {
    const bf16_t* src = (const bf16_t*)(p.ws + off);
    for (int i = blockIdx.x * 256 + threadIdx.x; i < T_ * D_; i += gridDim.x * 256) { const int row = i >> 10, col = i & 1023; p.out[i] = bf2f(src[(size_t)row * ld + coff + col]); }
}
DEVI float flat_bf(const Params& p, size_t off, size_t n, size_t i) { const bf16_t* b = (const bf16_t*)(p.ws + off); float a = 0.f; for (size_t j = i; j < n; j += (size_t)T_ * D_) a += bf2f(b[j]); return a; }
DEVI void dump_p1(const Params& p) {
    const size_t N = (size_t)T_ * D_;
    for (size_t i = (size_t)blockIdx.x * 256 + threadIdx.x; i < N; i += (size_t)gridDim.x * 256) {
        float a = 0.f;
        a += flat_bf(p, OFF_MG, 2 * N, i) + flat_bf(p, OFF_GS, 2 * N, i);
        a += flat_bf(p, OFF_QR, N / 2, i % (N / 2)) + flat_bf(p, OFF_KR, N / 2, i % (N / 2)) + flat_bf(p, OFF_QG, N / 2, i % (N / 2));
        a += flat_bf(p, OFF_KRT, N / 2, i % (N / 2)) + flat_bf(p, OFF_KGT, N / 2, i % (N / 2));
        a += flat_bf(p, OFF_VRT, N, i) + flat_bf(p, OFF_VGT, N, i);
        a += ((const float*)(p.ws + OFF_GA))[i % ((size_t)T_ * 16)];
        p.out[i] = a;
    }
}
constexpr int NPHASE = 13;
__global__ void __launch_bounds__(512, 2) fwd_megakernel(Params p) {
    unsigned char* const smem_all = smem_all_g;
    unsigned char* smem = smem_all + VH * SMEM_HALF;
    uint4* xb_words = (uint4*)(smem_all + 2 * SMEM_HALF - 16);
    if (threadIdx.x == 0) *xb_words = make_uint4(0u, 0u, blockIdx.x, 0u);
    __syncthreads();
    const XcdBarrier xb = xcd_barrier_post((unsigned*)(p.ws + OFF_BAR), (volatile LAS unsigned*)xb_words);
#ifndef REPMASK
#define REPMASK 0
#endif
#ifndef TIMEPHASE
#define TIMEPHASE -1
#endif
#define RUN_PHASE(K, CALL) do { if (p.phase_lo <= (K) && (K) < p.phase_hi) { \
        const unsigned long long tp0_ = (TIMEPHASE == (K)) ? __builtin_amdgcn_s_memrealtime() : 0ull; \
        _Pragma("unroll 1") for (int rep_ = ((REPMASK >> (K)) & 1); rep_ >= 0; --rep_) { CALL; if (rep_ > 0 || (K) + 1 < p.phase_hi) xcd_barrier(xb); } \
        if (TIMEPHASE == (K)) { const unsigned long long tp1_ = __builtin_amdgcn_s_memrealtime(); while (__builtin_amdgcn_s_memrealtime() - tp1_ < tp1_ - tp0_) __builtin_amdgcn_s_sleep(8); } } } while (0)
    RUN_PHASE(0, phase0(p, smem));
    if (p.phase_lo == 0 && p.phase_hi > 1) {
        if (threadIdx.x == 0) {
            unsigned* bar = (unsigned*)(p.ws + OFF_BAR); bool ok = (gridDim.x & 7u) == 0u && xb.x < 8u;
            for (unsigned j = 0; j < 16; ++j) { const unsigned c = xb_ld(&bar[XB_XCNT(j)]); ok = ok && (j < 8 ? c == gridDim.x / 8u : c == 0u); }
            if (ok) ((volatile int*)xb_words)[2] = (int)(((volatile unsigned*)xb_words)[3] * 8u + xb.x);
        }
        __syncthreads();
    }
    RUN_PHASE(1, phase1(p, smem_all));
#if DBG == 2
    dump_p1(p); return;
#endif
    RUN_PHASE(2, phase2(p, smem));
#if DBG == 5
    { const size_t N = (size_t)T_ * D_; for (size_t i = (size_t)blockIdx.x * 256 + threadIdx.x; i < N; i += (size_t)gridDim.x * 256) p.out[i] = flat_bf(p, OFF_KG2, N / 2, i % (N / 2)) + ((const float*)(p.ws + OFF_DEC))[i % (2048 * 128)]; } return;
#endif
#ifdef SCANPROBE
    phase3t(p, smem, 1); xcd_barrier(xb);
#endif
    RUN_PHASE(3, phase3t(p, smem, 0));
#if DBG == 6
    dump_bf16(p, OFF_OO, 2048, 1024); return;
#endif
#if DBG == 7
    { const bf16_t* src = (const bf16_t*)(p.ws + OFF_OO);
      for (int i = blockIdx.x * 256 + threadIdx.x; i < T_ * D_; i += gridDim.x * 256) { const int row = i >> 10, col = i & 1023; const float v = bf2f(src[(size_t)row * 2048 + 1024 + col]); p.out[i] = (fabsf(v) < 1e30f) ? v : 12345.0f; } } return;
#endif
    RUN_PHASE(4, phase4(p, smem));
#if DBG == 3
    dump_bf16(p, OFF_Y, 2048, 0); return;
#endif
#if DBG == 4
    dump_bf16(p, OFF_Y, 2048, 1024); return;
#endif
    RUN_PHASE(5, phase5(p, smem_all));
    RUN_PHASE(6, phase6(p, smem_all));
    RUN_PHASE(7, (((RB >> 3) & 1) ? (phase8(p, smem_all), conv_expert_weights(p, smem)) : (conv_expert_weights(p, smem), phase8(p, smem_all))));
#if DBG == 1
    return;
#endif
    RUN_PHASE(10, phase10(p, smem_all));
    RUN_PHASE(11, phase11(p, smem_all));
    RUN_PHASE(12, phase12(p));
#ifdef BARPROBE
    _Pragma("unroll 1") for (int bp_ = 0; bp_ < 20; ++bp_) xcd_barrier(xb);
#endif
#undef RUN_PHASE
}

extern "C" void kernel_launch(void* const* d_in, const int* in_sizes, int n_in, void* d_out, int out_size, void* d_ws, size_t ws_size,
                              hipStream_t stream) {
    static int grid_blocks = 0;
    if (!grid_blocks) {
        int dev = 0, cus = 0, per_cu = 0;
        hipGetDevice(&dev);
        hipDeviceGetAttribute(&cus, hipDeviceAttributeMultiprocessorCount, dev);
        hipOccupancyMaxActiveBlocksPerMultiprocessor(&per_cu, fwd_megakernel, 512, 0);
        if (per_cu > 1) per_cu = 1;
        if (per_cu < 1) per_cu = 1;
        grid_blocks = cus * per_cu;
    }
    if (ws_size < WS_NEEDED) { fprintf(stderr, "workspace too small: %zu < %zu\n", ws_size, (size_t)WS_NEEDED); return; }
    Params p{};
    p.x = (const float*)d_in[0]; p.w_in = (const float*)d_in[1]; p.ret_norm_g = (const float*)d_in[2]; p.gate_w2 = (const float*)d_in[3];
    p.gate_b = (const float*)d_in[4]; p.gla_norm_g = (const float*)d_in[5]; p.w_ret_out = (const float*)d_in[6]; p.w_gla_out = (const float*)d_in[7];
    p.w_o = (const float*)d_in[8]; p.ln1_g = (const float*)d_in[9]; p.ln1_b = (const float*)d_in[10]; p.router_w = (const float*)d_in[11];
    p.router_bias = (const float*)d_in[12]; p.ew_gate = (const float*)d_in[13]; p.ew_up = (const float*)d_in[14]; p.ew_down = (const float*)d_in[15];
    p.sw_gate = (const float*)d_in[16]; p.sw_up = (const float*)d_in[17]; p.sw_down = (const float*)d_in[18]; p.ln2_g = (const float*)d_in[19];
    p.ln2_b = (const float*)d_in[20];
    p.out = (float*)d_out; p.ws = (unsigned char*)d_ws; p.phase_lo = 0; p.phase_hi = NPHASE;
    void* args[] = {&p};
    (void)hipMemsetAsync((unsigned char*)d_ws + OFF_BAR, 0, XCD_BAR_WORDS * 4, stream);
    hipError_t e = hipLaunchCooperativeKernel((void*)fwd_megakernel, dim3(grid_blocks), dim3(512), args, 0, stream);
    if (e != hipSuccess) fprintf(stderr, "cooperative launch failed: %s (grid %d)\n", hipGetErrorString(e), grid_blocks);
}
```

```cpp
#include <hip/hip_runtime.h>
#include <hip/hip_cooperative_groups.h>
#include <cstdio>
#include <cstdint>
namespace cg = cooperative_groups;

typedef unsigned short bf16_t;
typedef short bf16x8 __attribute__((ext_vector_type(8)));
typedef float f32x4 __attribute__((ext_vector_type(4)));
typedef unsigned u32x2 __attribute__((ext_vector_type(2)));
typedef unsigned u32x4 __attribute__((ext_vector_type(4)));
#define DEVI __device__ __forceinline__
#define VH ((int)(threadIdx.x >> 8))
#define VT ((int)(threadIdx.x & 255))
static __device__ __forceinline__ int vh_fresh() { int v = (int)(threadIdx.x >> 8); asm volatile("" : "+v"(v)); return v; }
#define RB (__builtin_amdgcn_readfirstlane(((const int*)(smem_all_g + 2 * SMEM_HALF - 16))[2]))
#define RG ((int)gridDim.x)
#define VB (RB * 2 + VH)
#define VG (RG * 2)

constexpr int T_ = 32768;
constexpr int D_ = 1024;
constexpr int DIN_ = 8208;
constexpr int NE_ = 256;
constexpr float ALPHA_ = 1.189207115002721f;
constexpr float KSCALE_ = 0.08838834764831845f;

constexpr size_t MB = 1ull << 20;
constexpr size_t OFF_CNT  = (size_t)766 << 20;
constexpr int CNT_STRIDE = 1024;
constexpr size_t OFF_CS   = 1 * MB;
constexpr size_t OFF_WT   = 3 * MB;
constexpr size_t FB = 27 * MB;
constexpr size_t OFF_QR   = FB + 0 * MB;
constexpr size_t OFF_KR   = FB + 32 * MB;
constexpr size_t OFF_VRT  = FB + 64 * MB;
constexpr size_t OFF_GS   = FB + 128 * MB;
constexpr size_t OFF_MG   = FB + 256 * MB;
constexpr size_t OFF_KRT  = FB + 384 * MB;
constexpr size_t OFF_QG   = FB + 416 * MB;
constexpr size_t OFF_VGT  = FB + 448 * MB;
constexpr size_t OFF_KGT  = FB + 512 * MB;
constexpr size_t OFF_GA   = FB + 544 * MB;
constexpr size_t OFF_XB   = 800 * MB;
constexpr size_t OFF_KG2  = FB + 546 * MB;
constexpr size_t OFF_DEC  = FB + 578 * MB;
constexpr size_t OFF_OO   = FB + 579 * MB;
constexpr size_t OFF_Y    = FB + 384 * MB;
constexpr size_t OFF_MRG  = FB + 0 * MB;
constexpr size_t OFF_QGN  = 767 * MB;
constexpr size_t OFF_QFR  = 734 * MB;
constexpr size_t OFF_WGU  = 767 * MB;
constexpr size_t OFF_X1B  = FB + 0 * MB;
constexpr size_t OFF_WD   = FB + 64 * MB;
constexpr size_t OFF_LIST = FB + 193 * MB;
constexpr size_t OFF_WL   = FB + 193 * MB + 512 * MB;
constexpr size_t OFF_H    = FB + 227 * MB;
constexpr size_t OFF_YX   = FB + 371 * MB;
constexpr size_t OFF_T1   = FB + 371 * MB;
constexpr size_t WS_NEEDED = 1024 * MB;

constexpr int WT_BN = 0, WT_AT = 5888, WT_RET = 8960, WT_GLA = 9984, WT_O = 11008, WT_R = 12032, WT_ROWS = 12288;

struct Params {
    const float *x, *w_in, *ret_norm_g, *gate_w2, *gate_b, *gla_norm_g, *w_ret_out, *w_gla_out, *w_o, *ln1_g, *ln1_b,
                *router_w, *router_bias, *ew_gate, *ew_up, *ew_down, *sw_gate, *sw_up, *sw_down, *ln2_g, *ln2_b;
    float* out;
    unsigned char* ws;
    int phase_lo, phase_hi;
};

static __device__ const float c_inv_freq[64] = {
  1.000000000e+00f, 8.659643531e-01f, 7.498942018e-01f, 6.493816376e-01f,
  5.623413324e-01f, 4.869675338e-01f, 4.216965139e-01f, 3.651741147e-01f,
  3.162277639e-01f, 2.738419771e-01f, 2.371373773e-01f, 2.053525001e-01f,
  1.778279394e-01f, 1.539926529e-01f, 1.333521456e-01f, 1.154781953e-01f,
  1.000000015e-01f, 8.659642935e-02f, 7.498942316e-02f, 6.493816525e-02f,
  5.623413250e-02f, 4.869675264e-02f, 4.216964915e-02f, 3.651741147e-02f,
  3.162277490e-02f, 2.738419548e-02f, 2.371373773e-02f, 2.053525113e-02f,
  1.778279431e-02f, 1.539926510e-02f, 1.333521400e-02f, 1.154781971e-02f,
  9.999999776e-03f, 8.659643121e-03f, 7.498942316e-03f, 6.493816152e-03f,
  5.623413250e-03f, 4.869675264e-03f, 4.216964822e-03f, 3.651741194e-03f,
  3.162277630e-03f, 2.738419687e-03f, 2.371373819e-03f, 2.053525066e-03f,
  1.778279431e-03f, 1.539926510e-03f, 1.333521446e-03f, 1.154782018e-03f,
  1.000000047e-03f, 8.659643354e-04f, 7.498941850e-04f, 6.493816036e-04f,
  5.623413017e-04f, 4.869675322e-04f, 4.216965172e-04f, 3.651741135e-04f,
  3.162277571e-04f, 2.738419571e-04f, 2.371373703e-04f, 2.053525095e-04f,
  1.778279402e-04f, 1.539926598e-04f, 1.333521504e-04f, 1.154782003e-04f };

DEVI float bf2f(unsigned short u) { return __uint_as_float(((unsigned)u) << 16); }
DEVI float bflo(unsigned u) { return __uint_as_float(u << 16); }
DEVI float bfhi(unsigned u) { return __uint_as_float(u & 0xffff0000u); }
typedef float f32x2 __attribute__((ext_vector_type(2)));
typedef __bf16 bf16x2_t __attribute__((ext_vector_type(2)));
DEVI unsigned pk2(float lo, float hi) { const f32x2 v = {lo, hi}; const bf16x2_t b = __builtin_convertvector(v, bf16x2_t); return __builtin_bit_cast(unsigned, b); }
DEVI unsigned short f2bf(float f) { return (unsigned short)(pk2(f, 0.f) & 0xffffu); }
DEVI u32x2 pk4(f32x4 v) { u32x2 r; r.x = pk2(v[0], v[1]); r.y = pk2(v[2], v[3]); return r; }
DEVI f32x4 unpk4(u32x2 u) { f32x4 r; r[0] = bflo(u.x); r[1] = bfhi(u.x); r[2] = bflo(u.y); r[3] = bfhi(u.y); return r; }
constexpr float YX_SCALE = 16.0f;
DEVI unsigned pk4_fp8(f32x4 v) { int w = 0; w = __builtin_amdgcn_cvt_pk_fp8_f32(v[0], v[1], w, false); w = __builtin_amdgcn_cvt_pk_fp8_f32(v[2], v[3], w, true); return (unsigned)w; }
DEVI f32x4 unpk4_fp8(unsigned u) { f32x4 r; r[0] = __builtin_amdgcn_cvt_f32_fp8((int)u, 0); r[1] = __builtin_amdgcn_cvt_f32_fp8((int)u, 1); r[2] = __builtin_amdgcn_cvt_f32_fp8((int)u, 2); r[3] = __builtin_amdgcn_cvt_f32_fp8((int)u, 3); return r; }
DEVI f32x4 clamp4(f32x4 v, float lim) { f32x4 r; for (int i = 0; i < 4; ++i) r[i] = __builtin_amdgcn_fmed3f(v[i], -lim, lim); return r; }
DEVI float sigmoidf_(float v) { return __builtin_amdgcn_rcpf(1.0f + __builtin_amdgcn_exp2f(v * -1.4426950408889634f)); }
DEVI float siluf_(float v) { return v * __builtin_amdgcn_rcpf(1.0f + __builtin_amdgcn_exp2f(v * -1.4426950408889634f)); }
DEVI float gamma_log2(int h) { return log2f(1.0f - exp2f(-5.0f - (float)h)); }
DEVI f32x4 mfma16(bf16x8 a, bf16x8 b, f32x4 c) { return __builtin_amdgcn_mfma_f32_16x16x32_bf16(a, b, c, 0, 0, 0); }
DEVI unsigned kf_off(int item, int dk, int m8) { return ((((unsigned)item * 4u + (unsigned)(dk >> 5)) * 4u + (unsigned)(m8 >> 4)) * 64u + (unsigned)((m8 >> 3) & 1) * 32u + (unsigned)(dk & 31)) * 8u; }
DEVI unsigned vf_off(int item, int dv, int m8) { return ((((unsigned)item * 8u + (unsigned)(dv >> 5)) * 4u + (unsigned)(m8 >> 4)) * 64u + (unsigned)((m8 >> 3) & 1) * 32u + (unsigned)(dv & 31)) * 8u; }
DEVI unsigned qf_off(int bc, int h, int tokl, int dk8, int hh) {
    return ((((((unsigned)bc * 4u + (unsigned)h) * 2u + (unsigned)(tokl >> 5)) * 4u + (unsigned)(dk8 >> 5)) * 2u + (unsigned)((dk8 >> 4) & 1)) * 64u + (unsigned)hh * 32u + (unsigned)(tokl & 31)) * 8u + (unsigned)((dk8 >> 3) & 1) * 4u; }
DEVI int vperm(int n) { const int wc = n >> 6, nt = (n >> 4) & 3, i = n & 15; return wc * 64 + (nt >> 1) * 32 + 8 * (i >> 2) + 4 * (nt & 1) + (i & 3); }
DEVI int dperm2(int v) { return ((v >> 5) & 1) * 64 + (v >> 6) * 32 + (v & 31); }
DEVI u32x4 pk8(f32x4 a, f32x4 b) { u32x4 r; r.x = pk2(a[0], a[1]); r.y = pk2(a[2], a[3]); r.z = pk2(b[0], b[1]); r.w = pk2(b[2], b[3]); return r; }
DEVI void unpk8(u32x4 u, f32x4& a, f32x4& b) { a[0] = bflo(u.x); a[1] = bfhi(u.x); a[2] = bflo(u.y); a[3] = bfhi(u.y); b[0] = bflo(u.z); b[1] = bfhi(u.z); b[2] = bflo(u.w); b[3] = bfhi(u.w); }
DEVI int dperm(int v) { const int wc = v >> 6, nt = (v >> 4) & 3, c = v & 15; return (nt & 1) * 16 + wc * 32 + c + (nt >> 1) * 64; }

struct __attribute__((aligned(16))) GemmSmem { bf16_t a[2][128 * 64]; bf16_t b[2][128 * 64]; };
constexpr int SMEM_GEMM = sizeof(GemmSmem);
constexpr int SMEM_BYTES = SMEM_GEMM + 2048 + 16;
constexpr int SMEM_HALF = (SMEM_BYTES + 255) & ~255;
constexpr int SMEM_MOE = 163840 - 2 * SMEM_HALF;
__shared__ __attribute__((aligned(16))) unsigned char smem_all_g[2 * SMEM_HALF + SMEM_MOE];
DEVI int gemm_src_chunk(int t) { return ((t & 7) ^ ((t >> 4) & 7)) * 8; }

template <bool SWAP, int BKIND>
DEVI void gemm_kloop(f32x4 (&acc)[4][4], const bf16_t* const (&pa)[4], const bf16_t* const (&pb)[4],
                     const float* pbf, int ldb, int nk, GemmSmem& sm) {
    const int t = VT, lane = t & 63, w = t >> 6, wr = w >> 1, wc = w & 1, l15 = lane & 15, q = lane >> 4;
    const int kg = t & 7, ng = t >> 3;
    f32x4 rf[8];
#define GEMM_ISSUE(BUF, KO) do { \
        _Pragma("unroll") for (int i = 0; i < 4; ++i) \
            __builtin_amdgcn_global_load_lds((const unsigned*)(pa[i] + (KO)), (unsigned*)((char*)sm.a[BUF] + i * 4096 + t * 16), 16, 0, 0); \
        if (BKIND == 0) { _Pragma("unroll") for (int i = 0; i < 4; ++i) \
            __builtin_amdgcn_global_load_lds((const unsigned*)(pb[i] + (KO)), (unsigned*)((char*)sm.b[BUF] + i * 4096 + t * 16), 16, 0, 0); } \
        else { const float* pp = pbf + (size_t)((KO) + 4 * kg) * ldb; \
            _Pragma("unroll") for (int i = 0; i < 4; ++i) { rf[i] = *(const f32x4*)(pp + (size_t)i * ldb); rf[4 + i] = *(const f32x4*)(pp + (size_t)(32 + i) * ldb); } } } while (0)
#define GEMM_LSTORE_B(BUF) do { if (BKIND == 1) { \
            _Pragma("unroll") for (int i = 0; i < 4; ++i) { \
                u32x2 v0, v1; \
                v0.x = pk2(rf[0][i], rf[1][i]); v0.y = pk2(rf[2][i], rf[3][i]); v1.x = pk2(rf[4][i], rf[5][i]); v1.y = pk2(rf[6][i], rf[7][i]); \
                const int n = 4 * ng + i, sw = (n >> 1) & 7; \
                char* rowp = (char*)sm.b[BUF] + n * 128 + (kg & 1) * 8; \
                *(u32x2*)(rowp + (((kg >> 1) ^ sw) * 16)) = v0; *(u32x2*)(rowp + (((4 + (kg >> 1)) ^ sw) * 16)) = v1; } } } while (0)
    GEMM_ISSUE(0, 0);
    GEMM_LSTORE_B(0);
    __syncthreads();
#define GEMM_KSTEP(CUR, KT) do { \
        const bool more = ((KT) + 1 < nk); \
        if (more) { GEMM_ISSUE((CUR) ^ 1, ((KT) + 1) * 64); } \
        __builtin_amdgcn_sched_barrier(0); \
        _Pragma("unroll") for (int ss = 0; ss < 2; ++ss) { \
            bf16x8 af[4], bfr[4]; \
            const int coff = ((ss * 4 + q) ^ (l15 >> 1)) * 16; \
            _Pragma("unroll") for (int i = 0; i < 4; ++i) { \
                af[i]  = *(const bf16x8*)((const char*)sm.a[CUR] + (wr * 64 + i * 16 + l15) * 128 + coff); \
                bfr[i] = *(const bf16x8*)((const char*)sm.b[CUR] + (wc * 64 + i * 16 + l15) * 128 + coff); } \
            _Pragma("unroll") for (int mt = 0; mt < 4; ++mt) \
                _Pragma("unroll") for (int nt = 0; nt < 4; ++nt) \
                    acc[mt][nt] = SWAP ? mfma16(bfr[nt], af[mt], acc[mt][nt]) : mfma16(af[mt], bfr[nt], acc[mt][nt]); } \
        __builtin_amdgcn_sched_barrier(0); \
        if (more) { GEMM_LSTORE_B((CUR) ^ 1); } \
        __syncthreads(); } while (0)
#pragma unroll 1
    for (int kt = 0; kt < nk; kt += 2) { GEMM_KSTEP(0, kt); GEMM_KSTEP(1, kt + 1); }
#undef GEMM_KSTEP
#undef GEMM_LSTORE_B
#undef GEMM_ISSUE
}

DEVI void zero_acc(f32x4 (&acc)[4][4]) {
#pragma unroll
    for (int i = 0; i < 4; ++i)
#pragma unroll
        for (int j = 0; j < 4; ++j) acc[i][j] = (f32x4){0.f, 0.f, 0.f, 0.f};
}

namespace pg8 {
#define PG8_LAS __attribute__((address_space(3)))
typedef unsigned short bf16_t;
typedef short bf16x8 __attribute__((ext_vector_type(8)));
typedef float f32x4 __attribute__((ext_vector_type(4)));
typedef unsigned u32x4 __attribute__((ext_vector_type(4)));
constexpr int BM = 256, BK = 64, HALF = 128, HTB = HALF * BK * 2  , STAGE_BYTES = 8 * HTB, NXCD = 8, WGM = 8;

__host__ __device__ __forceinline__ int lds_byte(int r, int c) { const int st = (r >> 4) * 2 + (c >> 5), rr = r & 15, cc = c & 31, ob = rr * 64 + cc * 2; return st * 1024 + (ob ^ (((ob >> 9) & 1) << 5)); }
__host__ __device__ __forceinline__ void stage_rc(int b, int& R, int& C) { const int st = b / 1024, sb = b % 1024, swz = sb ^ (((sb >> 9) & 1) << 5); R = (st >> 1) * 16 + swz / 64; C = (st & 1) * 32 + (swz % 64) / 2; }
__host__ __device__ __forceinline__ int perm32(int rho) { const int n = rho >> 4, i = rho & 15; return 8 * (i >> 2) + 4 * n + (i & 3); }

struct Unit { int pm, pn, e, r0, ce; };
struct Gemm { const bf16_t* A; const bf16_t* Bt; int M, N, K; };

struct StaticOrder {
    int nM, nN, nwg, G, c;
    __host__ __device__ void init(int M, int N, int G_, int c_) { nM = M / BM; nN = N / BM; nwg = nM * nN; G = G_; c = c_; }
    __host__ __device__ bool next(int i, Unit& u) const {
        const long L = (long)i * G + c; if (L >= nwg) return false;
        int wgid = (int)L; { const int q = nwg / NXCD, r = nwg % NXCD, xcd = wgid % NXCD, off = wgid / NXCD; wgid = (xcd < r ? xcd * (q + 1) : r * (q + 1) + (xcd - r) * q) + off; }
        const int nig = WGM * nN, gid = wgid / nig, fm = gid * WGM, gsz = (nM - fm) < WGM ? (nM - fm) : WGM;
        u.pm = fm + ((wgid % nig) % gsz); u.pn = (wgid % nig) / gsz; return true;
    }
    __device__ __forceinline__ void a_ready(const Unit&) const {}
    __device__ __forceinline__ void done(const Unit&) const {}
};


template <class Epi, class Sched, bool ALIGN_EPI = false, bool SP2 = false>
__device__ __forceinline__ void gemm_phase(PG8_LAS unsigned char* lds, const Gemm g, const Sched& S, const Epi& E) {
    const int tid = threadIdx.x, wid = __builtin_amdgcn_readfirstlane(tid >> 6), lane = tid & 63, wr = wid >> 2, wc = wid & 3, fr = lane & 15, fq = lane >> 4;
    const int K = g.K, nt = K / BK;
    unsigned voffA[2], voffB[2];
#pragma unroll
    for (int i = 0; i < 2; ++i) { int R, C; stage_rc(tid * 16 + i * 8192, R, C); const int lc = perm32(R & 31);
        const int Rb = Epi::BJI ? (64 * (R >> 5) + 16 * (lc >> 3) + (lc & 7)) : (Epi::PERM ? ((R & ~31) + lc) : R);
        voffA[i] = (unsigned)(R * K + C) * 2u; voffB[i] = (unsigned)(Rb * K + C) * 2u; }
    const size_t hstepB = Epi::BJI ? (size_t)8 * K * 2 : (size_t)HALF * K * 2;
    const size_t kstep = (size_t)(BK * 2);
    const size_t hstep = (size_t)HALF * K * 2;
    const size_t tstep = 2 * hstep;
    const unsigned ldsw = (unsigned)wid * 1024u;
    const int aoff = lds_byte(wr * 64 + fr, fq * 8), boff = lds_byte(wc * 32 + fr, fq * 8);
#define PG8_SA(b, h) (((b) * 2 + (h)) * HTB)
#define PG8_SB(b, h) ((4 + (b) * 2 + (h)) * HTB)
#define PG8_STAGE(bufoff, gbase, voff) do { _Pragma("unroll") for (int _i = 0; _i < 2; ++_i) \
        __builtin_amdgcn_global_load_lds((const unsigned*)((const char*)(gbase) + (voff)[_i]), (PG8_LAS unsigned*)(lds + (bufoff) + ldsw + _i * 8192), 16, 0, 0); } while (0)
#define PG8_LDA(dst, b, h) do { _Pragma("unroll") for (int m = 0; m < 4; ++m) _Pragma("unroll") for (int k = 0; k < 2; ++k) dst[m][k] = *(const PG8_LAS bf16x8*)(lds + PG8_SA(b, h) + aoff + m * 2048 + k * 1024); } while (0)
#define PG8_LDB(dst, b, h) do { _Pragma("unroll") for (int n = 0; n < 2; ++n) _Pragma("unroll") for (int k = 0; k < 2; ++k) dst[n][k] = *(const PG8_LAS bf16x8*)(lds + PG8_SB(b, h) + boff + n * 2048 + k * 1024); } while (0)
#define PG8_MMA(ai, bj, At, Bt) do { __builtin_amdgcn_s_setprio(1); _Pragma("unroll") for (int m = 0; m < 4; ++m) _Pragma("unroll") for (int n = 0; n < 2; ++n) _Pragma("unroll") for (int k = 0; k < 2; ++k) \
        acc[ai][bj][m][n] = __builtin_amdgcn_mfma_f32_16x16x32_bf16(Bt[n][k], At[m][k], acc[ai][bj][m][n], 0, 0, 0); __builtin_amdgcn_s_setprio(0); } while (0)
#define PG8_WAIT_V(n) asm volatile("s_waitcnt vmcnt(" #n ")" ::: "memory")
#define PG8_WAIT_L(n) asm volatile("s_waitcnt lgkmcnt(" #n ")" ::: "memory")
#define PG8_BAR __builtin_amdgcn_s_barrier()
#define PG8_SCHED __builtin_amdgcn_sched_barrier(0)
    Unit cur, nxt; int ui = 0;
    if (!S.next(0, cur)) return;
    f32x4 acc[2][2][4][2];
#pragma unroll
    for (int a = 0; a < 2; ++a)
#pragma unroll
        for (int b = 0; b < 2; ++b)
#pragma unroll
            for (int m = 0; m < 4; ++m)
#pragma unroll
                for (int n = 0; n < 2; ++n) acc[a][b][m][n] = (f32x4){0.f, 0.f, 0.f, 0.f};
    bf16x8 At[4][2], B0[2][2], B1[2][2];
    const char* cA = (const char*)g.A + (size_t)cur.pm * tstep; const char* cB = (const char*)g.Bt + (size_t)cur.pn * tstep;
    S.a_ready(cur);
    if constexpr (SP2) {
        PG8_STAGE(PG8_SB(0, 0), cB, voffB); PG8_STAGE(PG8_SB(0, 1), cB + hstepB, voffB); PG8_STAGE(PG8_SA(0, 0), cA, voffA); PG8_STAGE(PG8_SA(0, 1), cA + hstep, voffA);
        if (wr == 1) PG8_BAR;
        PG8_WAIT_V(2); PG8_BAR;
        PG8_STAGE(PG8_SB(1, 0), cB + kstep, voffB); PG8_STAGE(PG8_SA(1, 0), cA + kstep, voffA); PG8_STAGE(PG8_SB(1, 1), cB + hstepB + kstep, voffB);
        PG8_WAIT_V(6); PG8_BAR;
    } else {
        PG8_STAGE(PG8_SB(0, 0), cB, voffB); PG8_STAGE(PG8_SA(0, 0), cA, voffA); PG8_STAGE(PG8_SB(0, 1), cB + hstepB, voffB); PG8_STAGE(PG8_SA(0, 1), cA + hstep, voffA);
        if (wr == 1) PG8_BAR;
        PG8_WAIT_V(4); PG8_BAR;
        PG8_STAGE(PG8_SB(1, 0), cB + kstep, voffB); PG8_STAGE(PG8_SA(1, 0), cA + kstep, voffA); PG8_STAGE(PG8_SB(1, 1), cB + hstepB + kstep, voffB);
        PG8_WAIT_V(6); PG8_BAR;
    }
    for (;;) {
        const bool has_next = S.next(ui + 1, nxt);
        const char* nA = has_next ? (const char*)g.A + (size_t)nxt.pm * tstep : cA; const char* nB = has_next ? (const char*)g.Bt + (size_t)nxt.pn * tstep : cB;
        for (int t = 0; t < nt; t += 2) {
            const bool last = (t == nt - 2);
            const char* a1 = cA + (size_t)(t + 1) * kstep;
            const char* a2 = last ? nA : cA + (size_t)(t + 2) * kstep; const char* b2 = last ? nB : cB + (size_t)(t + 2) * kstep;
            const char* a3 = a2 + kstep; const char* b3 = b2 + kstep;
            if (last && has_next) S.a_ready(nxt);
            if constexpr (SP2) {
            PG8_LDB(B0, 0, 0); PG8_LDB(B1, 0, 1); PG8_SCHED; PG8_LDA(At, 0, 0); PG8_STAGE(PG8_SA(1, 1), a1 + hstep, voffA);
            PG8_WAIT_V(8); PG8_WAIT_L(0); PG8_BAR; PG8_MMA(0, 0, At, B0); PG8_MMA(0, 1, At, B1); PG8_BAR; PG8_SCHED;
            PG8_LDA(At, 0, 1); PG8_STAGE(PG8_SB(0, 0), b2, voffB); PG8_STAGE(PG8_SB(0, 1), b2 + hstepB, voffB); PG8_STAGE(PG8_SA(0, 0), a2, voffA);
            PG8_WAIT_V(8); PG8_WAIT_L(0); PG8_BAR; PG8_MMA(1, 0, At, B0); PG8_MMA(1, 1, At, B1); PG8_BAR; PG8_SCHED;
            PG8_LDB(B0, 1, 0); PG8_LDB(B1, 1, 1); PG8_SCHED; PG8_LDA(At, 1, 0); PG8_STAGE(PG8_SA(0, 1), a2 + hstep, voffA);
            PG8_WAIT_V(8); PG8_WAIT_L(0); PG8_BAR; PG8_MMA(0, 0, At, B0); PG8_MMA(0, 1, At, B1); PG8_BAR; PG8_SCHED;
            PG8_LDA(At, 1, 1); PG8_STAGE(PG8_SB(1, 0), b3, voffB); PG8_STAGE(PG8_SB(1, 1), b3 + hstepB, voffB); PG8_STAGE(PG8_SA(1, 0), a3, voffA);
            PG8_WAIT_V(8); PG8_WAIT_L(0); PG8_BAR; PG8_MMA(1, 0, At, B0); PG8_MMA(1, 1, At, B1); PG8_BAR; PG8_SCHED;
            } else {
            PG8_LDB(B0, 0, 0); PG8_SCHED; PG8_LDA(At, 0, 0); PG8_STAGE(PG8_SA(1, 1), a1 + hstep, voffA);
            PG8_WAIT_L(8); PG8_BAR; PG8_WAIT_L(0); PG8_MMA(0, 0, At, B0); PG8_BAR; PG8_SCHED;
            PG8_LDB(B1, 0, 1); PG8_STAGE(PG8_SB(0, 0), b2, voffB);
            PG8_BAR; PG8_WAIT_L(0); PG8_MMA(0, 1, At, B1); PG8_BAR;
            PG8_LDA(At, 0, 1); PG8_STAGE(PG8_SA(0, 0), a2, voffA);
            PG8_BAR; PG8_WAIT_L(0); PG8_MMA(1, 0, At, B0); PG8_BAR; PG8_SCHED;
            PG8_STAGE(PG8_SB(0, 1), b2 + hstepB, voffB);
            PG8_WAIT_V(6); PG8_BAR; PG8_MMA(1, 1, At, B1); PG8_BAR;
            PG8_LDB(B0, 1, 0); PG8_SCHED; PG8_LDA(At, 1, 0); PG8_STAGE(PG8_SA(0, 1), a2 + hstep, voffA);
            PG8_WAIT_L(8); PG8_BAR; PG8_WAIT_L(0); PG8_MMA(0, 0, At, B0); PG8_BAR; PG8_SCHED;
            PG8_LDB(B1, 1, 1); PG8_STAGE(PG8_SB(1, 0), b3, voffB);
            PG8_BAR; PG8_WAIT_L(0); PG8_MMA(0, 1, At, B1); PG8_BAR;
            PG8_LDA(At, 1, 1); PG8_STAGE(PG8_SA(1, 0), a3, voffA);
            PG8_BAR; PG8_WAIT_L(0); PG8_MMA(1, 0, At, B0); PG8_BAR; PG8_SCHED;
            PG8_STAGE(PG8_SB(1, 1), b3 + hstepB, voffB);
            PG8_WAIT_V(6); PG8_BAR; PG8_MMA(1, 1, At, B1); PG8_BAR;
            }
        }
        if constexpr (ALIGN_EPI) { if (wr == 0) PG8_BAR; }
        if constexpr (!Epi::AFTER_DRAIN) { E(acc, cur, wr, wc, fr, fq); S.done(cur); }
        if (!has_next) break;
        if (!Epi::CHAIN || (ui & 1)) {
#pragma unroll
        for (int a = 0; a < 2; ++a)
#pragma unroll
            for (int b = 0; b < 2; ++b)
#pragma unroll
                for (int m = 0; m < 4; ++m)
#pragma unroll
                    for (int n = 0; n < 2; ++n) acc[a][b][m][n] = (f32x4){0.f, 0.f, 0.f, 0.f};
        }
        cur = nxt; cA = nA; cB = nB; ++ui;
        if constexpr (ALIGN_EPI) { if (wr == 1) PG8_BAR; }
    }
    PG8_WAIT_V(0);
    if constexpr (!ALIGN_EPI) { if (wr == 0) PG8_BAR; }
    PG8_BAR;
    if constexpr (Epi::AFTER_DRAIN) { E.fused(acc, cur, wr, wc, fr, fq, lds, wid, lane); S.done(cur); }
#undef PG8_SA
#undef PG8_SB
#undef PG8_STAGE
#undef PG8_LDA
#undef PG8_LDB
#undef PG8_MMA
#undef PG8_WAIT_V
#undef PG8_WAIT_L
#undef PG8_BAR
#undef PG8_SCHED
}
template <class Epi, class Sched, bool ALIGN_EPI = false, bool SP2 = false>
__device__ __forceinline__ void gemm_phase_g(PG8_LAS unsigned char* lds, const int K, const Sched& S, const Epi& E) {
    const int tid = threadIdx.x, wid = __builtin_amdgcn_readfirstlane(tid >> 6), lane = tid & 63, wr = wid >> 2, wc = wid & 3, fr = lane & 15, fq = lane >> 4;
    const int nt = K / BK;
    unsigned voffB[2]; int rowA[2], colA[2];
#pragma unroll
    for (int i = 0; i < 2; ++i) { int R, C; stage_rc(tid * 16 + i * 8192, R, C); const int lc = perm32(R & 31);
        const int Rb = Epi::BJI ? (64 * (R >> 5) + 16 * (lc >> 3) + (lc & 7)) : (Epi::PERM ? ((R & ~31) + lc) : R);
        rowA[i] = R; colA[i] = C * 2; voffB[i] = (unsigned)(Rb * K + C) * 2u; }
    const size_t kstep = (size_t)(BK * 2);
    const size_t hstep = Epi::BJI ? (size_t)8 * K * 2 : (size_t)HALF * K * 2;
    const size_t tstep = 2 * hstep;
    const unsigned ldsw = (unsigned)wid * 1024u;
    const int aoff = lds_byte(wr * 64 + fr, fq * 8), boff = lds_byte(wc * 32 + fr, fq * 8);
#define PG8_SA(b, h) (((b) * 2 + (h)) * HTB)
#define PG8_SB(b, h) ((4 + (b) * 2 + (h)) * HTB)
#define PG8_STAGE(bufoff, gbase, voff) do { _Pragma("unroll") for (int _i = 0; _i < 2; ++_i) \
        __builtin_amdgcn_global_load_lds((const unsigned*)((const char*)(gbase) + (voff)[_i]), (PG8_LAS unsigned*)(lds + (bufoff) + ldsw + _i * 8192), 16, 0, 0); } while (0)
#define PG8_STAGEA(bufoff, P0, P1, koff) do { \
        __builtin_amdgcn_global_load_lds((const unsigned*)(Ab + (size_t)(P0) + (koff)), (PG8_LAS unsigned*)(lds + (bufoff) + ldsw), 16, 0, 0); \
        __builtin_amdgcn_global_load_lds((const unsigned*)(Ab + (size_t)(P1) + (koff)), (PG8_LAS unsigned*)(lds + (bufoff) + ldsw + 8192), 16, 0, 0); } while (0)
#define PG8_LDA(dst, b, h) do { _Pragma("unroll") for (int m = 0; m < 4; ++m) _Pragma("unroll") for (int k = 0; k < 2; ++k) dst[m][k] = *(const PG8_LAS bf16x8*)(lds + PG8_SA(b, h) + aoff + m * 2048 + k * 1024); } while (0)
#define PG8_LDB(dst, b, h) do { _Pragma("unroll") for (int n = 0; n < 2; ++n) _Pragma("unroll") for (int k = 0; k < 2; ++k) dst[n][k] = *(const PG8_LAS bf16x8*)(lds + PG8_SB(b, h) + boff + n * 2048 + k * 1024); } while (0)
#define PG8_MMA(ai, bj, At, Bt) do { __builtin_amdgcn_s_setprio(1); _Pragma("unroll") for (int m = 0; m < 4; ++m) _Pragma("unroll") for (int n = 0; n < 2; ++n) _Pragma("unroll") for (int k = 0; k < 2; ++k) \
        acc[ai][bj][m][n] = __builtin_amdgcn_mfma_f32_16x16x32_bf16(Bt[n][k], At[m][k], acc[ai][bj][m][n], 0, 0, 0); __builtin_amdgcn_s_setprio(0); } while (0)
#define PG8_WAIT_V(n) asm volatile("s_waitcnt vmcnt(" #n ")" ::: "memory")
#define PG8_WAIT_L(n) asm volatile("s_waitcnt lgkmcnt(" #n ")" ::: "memory")
#define PG8_BAR __builtin_amdgcn_s_barrier()
#define PG8_SCHED __builtin_amdgcn_sched_barrier(0)
    Unit cur, nxt, un2; int ui = 0, sb_cur = 0;
    if (!S.next(0, cur)) return;
    int fillv = S.fill_issue(cur); S.fill_write(0, fillv);
    __syncthreads();
    bool has_next = S.next(1, nxt);
    fillv = 0; if (has_next) fillv = S.fill_issue(nxt);
    f32x4 acc[2][2][4][2];
#pragma unroll
    for (int a = 0; a < 2; ++a)
#pragma unroll
        for (int b = 0; b < 2; ++b)
#pragma unroll
            for (int m = 0; m < 4; ++m)
#pragma unroll
                for (int n = 0; n < 2; ++n) acc[a][b][m][n] = (f32x4){0.f, 0.f, 0.f, 0.f};
    bf16x8 At[4][2], B0[2][2], B1[2][2];
    const char* cB = S.b_base(cur);
    unsigned cA00, cA01, cA10, cA11, nA00, nA01, nA10, nA11;
    const char* const Ab = S.a_base();
    S.a_rows(0, rowA, colA, cA00, cA01, cA10, cA11);
    S.a_ready(cur);
    if constexpr (SP2) {
        PG8_STAGE(PG8_SB(0, 0), cB, voffB); PG8_STAGE(PG8_SB(0, 1), cB + hstep, voffB); PG8_STAGEA(PG8_SA(0, 0), cA00, cA01, 0); PG8_STAGEA(PG8_SA(0, 1), cA10, cA11, 0);
        if (wr == 1) PG8_BAR;
        PG8_WAIT_V(2); PG8_BAR;
        PG8_STAGE(PG8_SB(1, 0), cB + kstep, voffB); PG8_STAGEA(PG8_SA(1, 0), cA00, cA01, kstep); PG8_STAGE(PG8_SB(1, 1), cB + hstep + kstep, voffB);
        PG8_WAIT_V(6); PG8_BAR;
    } else {
        PG8_STAGE(PG8_SB(0, 0), cB, voffB); PG8_STAGEA(PG8_SA(0, 0), cA00, cA01, 0); PG8_STAGE(PG8_SB(0, 1), cB + hstep, voffB); PG8_STAGEA(PG8_SA(0, 1), cA10, cA11, 0);
        if (wr == 1) PG8_BAR;
        PG8_WAIT_V(4); PG8_BAR;
        PG8_STAGE(PG8_SB(1, 0), cB + kstep, voffB); PG8_STAGEA(PG8_SA(1, 0), cA00, cA01, kstep); PG8_STAGE(PG8_SB(1, 1), cB + hstep + kstep, voffB);
        PG8_WAIT_V(6); PG8_BAR;
    }
    for (;;) {
        const char* nB = has_next ? S.b_base(nxt) : cB;
        const int sb_n = sb_cur == 2 ? 0 : sb_cur + 1;
        bool has2 = false;
        if (has_next) { S.fill_write(sb_n, fillv); has2 = S.next(ui + 2, un2); if (has2) fillv = S.fill_issue(un2); }
        nA00 = cA00; nA01 = cA01; nA10 = cA10; nA11 = cA11;
#pragma unroll 1
        for (int t = 0; t < nt; t += 2) {
            const bool last = (t == nt - 2);
            const size_t k1 = (size_t)(t + 1) * kstep;
            const size_t k2 = last ? 0 : (size_t)(t + 2) * kstep; const char* b2 = last ? nB : cB + (size_t)(t + 2) * kstep;
            const unsigned q00 = last ? nA00 : cA00, q01 = last ? nA01 : cA01, q10 = last ? nA10 : cA10, q11 = last ? nA11 : cA11;
            const size_t k3 = k2 + kstep; const char* b3 = b2 + kstep;
            if (last && has_next) S.a_ready(nxt);
            if constexpr (SP2) {
            PG8_LDB(B0, 0, 0); PG8_LDB(B1, 0, 1); PG8_SCHED; PG8_LDA(At, 0, 0); PG8_STAGEA(PG8_SA(1, 1), cA10, cA11, k1);
            PG8_WAIT_V(8); PG8_WAIT_L(0); PG8_BAR; PG8_MMA(0, 0, At, B0); PG8_MMA(0, 1, At, B1); PG8_BAR; PG8_SCHED;
            PG8_LDA(At, 0, 1); PG8_STAGE(PG8_SB(0, 0), b2, voffB); PG8_STAGE(PG8_SB(0, 1), b2 + hstep, voffB); PG8_STAGEA(PG8_SA(0, 0), q00, q01, k2);
            PG8_WAIT_V(8); PG8_WAIT_L(0); PG8_BAR; PG8_MMA(1, 0, At, B0); PG8_MMA(1, 1, At, B1); PG8_BAR; PG8_SCHED;
            PG8_LDB(B0, 1, 0); PG8_LDB(B1, 1, 1); PG8_SCHED; PG8_LDA(At, 1, 0); PG8_STAGEA(PG8_SA(0, 1), q10, q11, k2);
            PG8_WAIT_V(8); PG8_WAIT_L(0); PG8_BAR; PG8_MMA(0, 0, At, B0); PG8_MMA(0, 1, At, B1); PG8_BAR; PG8_SCHED;
            PG8_LDA(At, 1, 1); PG8_STAGE(PG8_SB(1, 0), b3, voffB); PG8_STAGE(PG8_SB(1, 1), b3 + hstep, voffB); PG8_STAGEA(PG8_SA(1, 0), q00, q01, k3);
            PG8_WAIT_V(8); PG8_WAIT_L(0); PG8_BAR; PG8_MMA(1, 0, At, B0); PG8_MMA(1, 1, At, B1); PG8_BAR; PG8_SCHED;
            } else {
            PG8_LDB(B0, 0, 0); PG8_SCHED; PG8_LDA(At, 0, 0); PG8_STAGEA(PG8_SA(1, 1), cA10, cA11, k1);
            PG8_WAIT_L(8); PG8_BAR; PG8_WAIT_L(0); PG8_MMA(0, 0, At, B0); PG8_BAR; PG8_SCHED;
            PG8_LDB(B1, 0, 1); PG8_STAGE(PG8_SB(0, 0), b2, voffB);
            PG8_BAR; PG8_WAIT_L(0); PG8_MMA(0, 1, At, B1); PG8_BAR;
            PG8_LDA(At, 0, 1); PG8_STAGEA(PG8_SA(0, 0), q00, q01, k2);
            PG8_BAR; PG8_WAIT_L(0); PG8_MMA(1, 0, At, B0); PG8_BAR; PG8_SCHED;
            PG8_STAGE(PG8_SB(0, 1), b2 + hstep, voffB);
            PG8_WAIT_V(6); PG8_BAR; PG8_MMA(1, 1, At, B1); PG8_BAR;
            PG8_LDB(B0, 1, 0); PG8_SCHED; PG8_LDA(At, 1, 0); PG8_STAGEA(PG8_SA(0, 1), q10, q11, k2);
            PG8_WAIT_L(8); PG8_BAR; PG8_WAIT_L(0); PG8_MMA(0, 0, At, B0); PG8_BAR; PG8_SCHED;
            PG8_LDB(B1, 1, 1); PG8_STAGE(PG8_SB(1, 0), b3, voffB);
            PG8_BAR; PG8_WAIT_L(0); PG8_MMA(0, 1, At, B1); PG8_BAR;
            PG8_LDA(At, 1, 1); PG8_STAGEA(PG8_SA(1, 0), q00, q01, k3);
            PG8_BAR; PG8_WAIT_L(0); PG8_MMA(1, 0, At, B0); PG8_BAR; PG8_SCHED;
            PG8_STAGE(PG8_SB(1, 1), b3 + hstep, voffB);
            PG8_WAIT_V(6); PG8_BAR; PG8_MMA(1, 1, At, B1); PG8_BAR;
            }
            if (t == nt - 4 && has_next) S.a_rows(sb_n, rowA, colA, nA00, nA01, nA10, nA11);
        }
        if constexpr (ALIGN_EPI) { if (wr == 0) PG8_BAR; }
        if constexpr (!Epi::AFTER_DRAIN) { E(acc, cur, wr, wc, fr, fq, sb_cur); S.done(cur); }
        if (!has_next) break;
#pragma unroll
        for (int a = 0; a < 2; ++a)
#pragma unroll
            for (int b = 0; b < 2; ++b)
#pragma unroll
                for (int m = 0; m < 4; ++m)
#pragma unroll
                    for (int n = 0; n < 2; ++n) acc[a][b][m][n] = (f32x4){0.f, 0.f, 0.f, 0.f};
        cur = nxt; nxt = un2; has_next = has2; cA00 = nA00; cA01 = nA01; cA10 = nA10; cA11 = nA11; cB = nB; ++ui; sb_cur = sb_n;
        if constexpr (ALIGN_EPI) { if (wr == 1) PG8_BAR; }
    }
    PG8_WAIT_V(0);
    if constexpr (!ALIGN_EPI) { if (wr == 0) PG8_BAR; }
    PG8_BAR;
    if constexpr (Epi::AFTER_DRAIN) { E.fused(acc, cur, wr, wc, fr, fq, lds, wid, lane); S.done(cur); }
#undef PG8_SA
#undef PG8_SB
#undef PG8_STAGE
#undef PG8_STAGEA
#undef PG8_LDA
#undef PG8_LDB
#undef PG8_MMA
#undef PG8_WAIT_V
#undef PG8_WAIT_L
#undef PG8_BAR
#undef PG8_SCHED
}
}

DEVI void wt_colinfo(const Params& p, int R, const float*& src, int& ld, float& scale) {
    scale = 1.0f; src = nullptr; ld = 0;
    if (R < WT_AT) {
        const int pn = R >> 8, cl = R & 255; ld = DIN_; int col = -1;
        if (pn < 4) { const int wcq = (cl >> 5) & 3; col = (pn >> 1) * 512 + (2 * (pn & 1) + (wcq >> 1)) * 128 + 64 * (cl >> 7) + 32 * (wcq & 1) + (cl & 31);
                      if (pn >= 2) scale = KSCALE_; }
        else if (pn < 8)  col = 2048 + (pn - 4) * 256 + 64 * ((cl >> 5) & 3) + 16 * ((cl >> 3) & 3) + 8 * (cl >> 7) + (cl & 7);
        else if (pn < 10) { col = 3072 + (pn - 8) * 256 + cl; scale = KSCALE_; }
        else if (pn < 14) col = 5120 + (pn - 10) * 256 + 64 * ((cl >> 5) & 3) + 16 * ((cl >> 3) & 3) + 8 * (cl >> 7) + (cl & 7);
        else if (pn < 22) col = 6160 + (pn - 14) * 256 + 64 * ((cl >> 5) & 3) + 16 * ((cl >> 3) & 3) + 8 * (cl >> 7) + (cl & 7);
        else if (cl < 16) col = 6144 + cl;
        if (col >= 0) src = p.w_in + col;
    } else if (R < WT_RET) {
        const int Rr = R - WT_AT, pm = Rr >> 8, rl = Rr & 255; ld = DIN_; int col;
        if (pm < 2) { col = 512 + (2 * pm + ((rl >> 6) & 1)) * 128 + 64 * (rl >> 7) + (rl & 63); scale = KSCALE_; }
        else if (pm < 6)  col = 1024 + (pm - 2) * 256 + rl;
        else if (pm < 10) col = 4096 + (pm - 6) * 256 + rl;
        else              col = 3584 + (pm - 10) * 256 + rl;
        src = p.w_in + col;
    } else {
        int Rr, ldd; const float* base;
        if (R < WT_GLA)    { Rr = R - WT_RET; base = p.w_ret_out; ldd = 1024; }
        else if (R < WT_O) { Rr = R - WT_GLA; base = p.w_gla_out; ldd = 1024; }
        else if (R < WT_R) { Rr = R - WT_O;   base = p.w_o;       ldd = 1024; }
        else               { Rr = R - WT_R;   base = p.router_w;  ldd = 256; }
        src = base + ((R >= WT_R) ? ((Rr & ~127) + vperm(Rr & 127)) : Rr); ld = ldd;
    }
}

DEVI void phase0(const Params& p, unsigned char* smem) {
    const int tid = VT, nb = VG, bid = VB;
    float2* cs = (float2*)(p.ws + OFF_CS);
    for (int i = bid * 256 + tid; i < 4096 * 64; i += nb * 256) {
        const int pos = i >> 6, k = i & 63;
        const float angf = (float)pos * c_inv_freq[k];
        const double a = (double)angf;
        const double TWO_PI = 6.283185307179586476925286766559, HALF_PI = 1.5707963267948966192313216916398;
        const double kk = rint(a * (1.0 / TWO_PI));
        const double r = a - kk * TWO_PI;
        const double qd = rint(r * (1.0 / HALF_PI));
        const double y = r - qd * HALF_PI;
        const double y2 = y * y;
        double sn = y * (1.0 + y2 * (-1.0 / 6 + y2 * (1.0 / 120 + y2 * (-1.0 / 5040 + y2 * (1.0 / 362880 + y2 * (-1.0 / 39916800 + y2 * (1.0 / 6227020800.0)))))));
        double cn = 1.0 + y2 * (-0.5 + y2 * (1.0 / 24 + y2 * (-1.0 / 720 + y2 * (1.0 / 40320 + y2 * (-1.0 / 3628800 + y2 * (1.0 / 479001600.0))))));
        const int qi = ((int)qd) & 3;
        double s, c;
        if (qi == 0) { s = sn; c = cn; } else if (qi == 1) { s = cn; c = -sn; } else if (qi == 2) { s = -sn; c = -cn; } else { s = -cn; c = sn; }
        cs[i] = make_float2((float)c, (float)s);
    }
    if (bid == 0) { int* cnt = (int*)(p.ws + OFF_CNT); cnt[tid * CNT_STRIDE] = 0; }
    {
        u32x4* bfr = (u32x4*)smem;
        for (int idx = tid; idx < 32 * 64; idx += 256) {
            const int sst = idx >> 6, l = idx & 63;
            const float* wp = p.w_in + (size_t)(32 * sst + 8 * (l >> 4)) * DIN_ + 6144 + (l & 15);
            float w8[8];
#pragma unroll
            for (int j = 0; j < 8; ++j) w8[j] = wp[(size_t)j * DIN_];
            u32x4 o; o.x = pk2(w8[0], w8[1]); o.y = pk2(w8[2], w8[3]); o.z = pk2(w8[4], w8[5]); o.w = pk2(w8[6], w8[7]);
            bfr[idx] = o;
        }
        __syncthreads();
        const int lane = tid & 63, row = lane & 15, kg = lane >> 4;
        float* Ga = (float*)(p.ws + OFF_GA);
        for (int rb = bid * 4 + (tid >> 6); rb < T_ / 16; rb += nb * 4) {
            const float* xr = p.x + (size_t)(rb * 16 + row) * 1024 + 8 * kg;
            bf16_t* xo = (bf16_t*)(p.ws + OFF_XB) + (size_t)(rb * 16 + row) * 1024 + 8 * kg;
            f32x4 acc = (f32x4){0.f, 0.f, 0.f, 0.f};
#pragma unroll 1
            for (int s0 = 0; s0 < 32; s0 += 8) {
                f32x4 v[8][2];
#pragma unroll
                for (int j = 0; j < 8; ++j) { v[j][0] = *(const f32x4*)(xr + 32 * (s0 + j)); v[j][1] = *(const f32x4*)(xr + 32 * (s0 + j) + 4); }
#pragma unroll
                for (int j = 0; j < 8; ++j) {
                    u32x4 o; o.x = pk2(v[j][0][0], v[j][0][1]); o.y = pk2(v[j][0][2], v[j][0][3]); o.z = pk2(v[j][1][0], v[j][1][1]); o.w = pk2(v[j][1][2], v[j][1][3]);
                    *(u32x4*)(xo + 32 * (s0 + j)) = o;
                    acc = mfma16(__builtin_bit_cast(bf16x8, o), __builtin_bit_cast(bf16x8, bfr[(s0 + j) * 64 + lane]), acc);
                }
            }
#pragma unroll
            for (int r = 0; r < 4; ++r) Ga[(size_t)(rb * 16 + 4 * kg + r) * 16 + row] = acc[r];
        }
        __syncthreads();
    }
    {
        float* tile = (float*)smem;
        bf16_t* wt = (bf16_t*)(p.ws + OFF_WT);
        const int ntask = (WT_ROWS / 64) * 16;
        const int n = tid & 63, kq = tid >> 6;
#define TR_BAR do { asm volatile("s_waitcnt lgkmcnt(0)" ::: "memory"); __builtin_amdgcn_s_barrier(); asm volatile("" ::: "memory"); } while (0)
#define TR_LOAD(V, SC, TASK) do { const int rt_ = (TASK) >> 4, kt_ = (TASK) & 15; const float* src_; int ld_; wt_colinfo(p, rt_ * 64 + n, src_, ld_, SC); \
            if (src_ == nullptr) { src_ = p.w_in; SC = 0.f; } \
            _Pragma("unroll") for (int i = 0; i < 16; ++i) V[i] = src_[(size_t)(kt_ * 64 + kq + 4 * i) * ld_]; } while (0)
#define TR_PROC(V, SC, TASK) do { const int rt_ = (TASK) >> 4, kt_ = (TASK) & 15; \
            _Pragma("unroll") for (int i = 0; i < 16; ++i) tile[(kq + 4 * i) * 65 + n] = V[i] * SC; \
            TR_BAR; \
            { const int n2 = tid >> 2, ks = (tid & 3) * 16; unsigned o[8]; \
              _Pragma("unroll") for (int j = 0; j < 8; ++j) o[j] = pk2(tile[(ks + 2 * j) * 65 + n2], tile[(ks + 2 * j + 1) * 65 + n2]); \
              u32x4* dst = (u32x4*)(wt + (size_t)(rt_ * 64 + n2) * 1024 + kt_ * 64 + ks); \
              dst[0] = (u32x4){o[0], o[1], o[2], o[3]}; dst[1] = (u32x4){o[4], o[5], o[6], o[7]}; } \
            TR_BAR; } while (0)
        int task = bid;
        if (task < ntask) {
            float va[16], vb[16], sa, sb;
            TR_LOAD(va, sa, task);
#pragma unroll 1
            for (;;) {
                bool more = task + nb < ntask;
                TR_LOAD(vb, sb, more ? task + nb : task);
                TR_PROC(va, sa, task);
                if (!more) break;
                task += nb;
                more = task + nb < ntask;
                TR_LOAD(va, sa, more ? task + nb : task);
                TR_PROC(vb, sb, task);
                if (!more) break;
                task += nb;
            }
        }
#undef TR_PROC
#undef TR_LOAD
#undef TR_BAR
    }
}

struct EpiP1N {
    static constexpr bool PERM = true, AFTER_DRAIN = false; static constexpr bool CHAIN = false; static constexpr bool BJI = false;
    unsigned char* ws;
    __device__ __forceinline__ void operator()(const pg8::f32x4 (&acc)[2][2][4][2], const pg8::Unit& u, int wr, int wc, int fr, int fq) const {
        const int pn = u.pn, row0 = u.pm * 256 + wr * 64 + fr, c8 = wc * 32 + 8 * fq;
        if (pn < 4) {
            const float2* cs = (const float2*)(ws + OFF_CS); bf16_t* Qr = (bf16_t*)(ws + (pn < 2 ? OFF_QR : OFF_KR));
            const int head = 2 * (pn & 1) + (wc >> 1), d0 = 32 * (wc & 1) + 8 * fq;
#pragma unroll
            for (int ai = 0; ai < 2; ++ai)
#pragma unroll
                for (int m = 0; m < 4; ++m) {
                    const size_t row = row0 + ai * 128 + m * 16; const int pos = (int)(row & 4095);
                    f32x4 c4[4];
#pragma unroll
                    for (int j = 0; j < 4; ++j) c4[j] = *(const f32x4*)(cs + pos * 64 + d0 + 2 * j);
                    f32x4 o1[2], o2[2];
#pragma unroll
                    for (int n = 0; n < 2; ++n)
#pragma unroll
                        for (int r = 0; r < 4; ++r) {
                            const f32x4 cc = c4[2 * n + (r >> 1)]; const float c_ = cc[(r & 1) * 2], s_ = cc[(r & 1) * 2 + 1];
                            const float x1 = acc[ai][0][m][n][r], x2 = acc[ai][1][m][n][r];
                            o1[n][r] = x1 * c_ - x2 * s_; o2[n][r] = x1 * s_ + x2 * c_;
                        }
                    *(u32x4*)(Qr + row * 512 + head * 128 + d0) = pk8(o1[0], o1[1]);
                    *(u32x4*)(Qr + row * 512 + head * 128 + 64 + d0) = pk8(o2[0], o2[1]);
                    asm volatile("" ::: "memory");
                }
        } else {
#pragma unroll
            for (int ai = 0; ai < 2; ++ai)
#pragma unroll
                for (int m = 0; m < 4; ++m) {
                    const size_t row = row0 + ai * 128 + m * 16;
                    if (pn >= 14 || (pn >= 4 && pn < 8) || pn >= 10) {
                        u32x4 w8;
                        w8.x = pk4_fp8(clamp4(acc[ai][0][m][0] * 8.0f, 440.f)); w8.y = pk4_fp8(clamp4(acc[ai][0][m][1] * 8.0f, 440.f));
                        w8.z = pk4_fp8(clamp4(acc[ai][1][m][0] * 8.0f, 440.f)); w8.w = pk4_fp8(clamp4(acc[ai][1][m][1] * 8.0f, 440.f));
                        const unsigned gofs = pn >= 14 ? (unsigned)OFF_MG + (pn - 14) * 256 : (pn < 8 ? (unsigned)OFF_GS + (pn - 4) * 256 : (unsigned)OFF_GS + 1024 + (pn - 10) * 256);
                        *(u32x4*)(ws + gofs + row * 2048 + wc * 64 + 16 * fq) = w8;
                        asm volatile("" ::: "memory");
                        continue;
                    }
#pragma unroll
                    for (int bj = 0; bj < 2; ++bj) {
                        const int cl = bj * 128 + c8;
                        f32x4 v0 = acc[ai][bj][m][0], v1 = acc[ai][bj][m][1];
                        if (pn < 8) {
                            *(u32x4*)((bf16_t*)(ws + OFF_GS) + row * 2048 + (pn - 4) * 256 + cl) = pk8(v0, v1);
                        } else if (pn < 10) {
                            int frl = fr, fql = fq; asm volatile("" : "+v"(frl), "+v"(fql));
                            const u32x4 v8 = pk8(v0, v1); const int sp = fql & 1;
                            const unsigned s0_ = sp ? v8.x : v8.z, s1_ = sp ? v8.y : v8.w;
                            const unsigned r0_ = (unsigned)__shfl_xor((int)s0_, 16), r1_ = (unsigned)__shfl_xor((int)s1_, 16);
                            const u32x4 pc = sp ? (u32x4){r0_, r1_, v8.z, v8.w} : (u32x4){v8.x, v8.y, r0_, r1_};
                            const int rowl = u.pm * 256 + wr * 64 + frl + ai * 128 + m * 16;
                            const int tokl = rowl & 63, bcq = rowl >> 6, hd = (pn - 8) * 2 + bj;
                            const int P = ((((tokl >> 5) * 4 + wc) * 2 + (fql >> 1)) * 64) + sp * 32 + (tokl & 31);
                            const unsigned ofs = (unsigned)OFF_QG + (unsigned)((bcq * 4 + hd) * 1024 + P) * 16u;
                            *(u32x4*)(ws + ofs) = pc;
                        } else if (pn < 14) {
                            *(u32x4*)((bf16_t*)(ws + OFF_GS) + row * 2048 + 1024 + (pn - 10) * 256 + cl) = pk8(v0, v1);
                        } else if (pn < 22) {
                            *(u32x4*)((bf16_t*)(ws + OFF_MG) + row * 2048 + (pn - 14) * 256 + cl) = pk8(v0, v1);
                        } else if (cl < 16) {
                            int frl = fr; asm volatile("" : "+v"(frl));
                            const unsigned ofs = (unsigned)OFF_GA + ((unsigned)(u.pm * 256 + wr * 64 + frl + ai * 128 + m * 16) * 16u + (unsigned)cl) * 4u;
                            *(f32x4*)(ws + ofs) = v0; *(f32x4*)(ws + ofs + 16) = v1;
                        }
                    }
                    asm volatile("" ::: "memory");
                }
        }
    }
};
struct EpiP1V {
    static constexpr bool PERM = true, AFTER_DRAIN = false; static constexpr bool CHAIN = false; static constexpr bool BJI = false;
    unsigned char* ws;
    __device__ __forceinline__ void operator()(const pg8::f32x4 (&acc)[2][2][4][2], const pg8::Unit& u, int wr, int wc, int fr, int fq) const {
        bf16_t* dst = (bf16_t*)(ws + (u.pm < 4 ? OFF_VRT : OFF_VGT)); const int head = u.pm & 3;
#pragma unroll
        for (int bj = 0; bj < 2; ++bj) {
            const int tok0 = u.pn * 256 + bj * 128 + wc * 32 + 8 * fq; const int item = (tok0 >> 6) * 4 + head, m0 = tok0 & 63;
#pragma unroll
            for (int ai = 0; ai < 2; ++ai)
#pragma unroll
                for (int m = 0; m < 4; ++m) {
                    *(u32x4*)(dst + vf_off(item, ai * 128 + wr * 64 + m * 16 + fr, m0)) = pk8(acc[ai][bj][m][0], acc[ai][bj][m][1]);
                    asm volatile("" ::: "memory");
                }
        }
    }
};
struct EpiP1G {
    static constexpr bool PERM = true, AFTER_DRAIN = false; static constexpr bool CHAIN = false; static constexpr bool BJI = false;
    unsigned char* ws;
    __device__ __forceinline__ void operator()(const pg8::f32x4 (&acc)[2][2][4][2], const pg8::Unit& u, int wr, int wc, int fr, int fq) const {
        bf16_t* dst = (bf16_t*)(ws + OFF_KGT);
#pragma unroll
        for (int bj = 0; bj < 2; ++bj) {
            const int tok0 = u.pn * 256 + bj * 128 + wc * 32 + 8 * fq; const int m0 = tok0 & 63;
#pragma unroll
            for (int ai = 0; ai < 2; ++ai) {
                const unsigned item = (unsigned)((tok0 >> 6) * 4 + 2 * u.pm + ai);
#pragma unroll
                for (int m = 0; m < 4; ++m) {
                    *(u32x4*)(dst + (item * 128u + (unsigned)(wr * 64 + m * 16 + fr)) * 64u + (unsigned)m0) = pk8(acc[ai][bj][m][0], acc[ai][bj][m][1]);
                    asm volatile("" ::: "memory");
                }
            }
        }
    }
};
DEVI void phase1(const Params& p, unsigned char* smem_all) {
    {
        pg8::StaticOrder S; S.init(T_, 5632, RG, RB);
        pg8::Gemm g; g.A = (const bf16_t*)(p.ws + OFF_XB); g.Bt = (const bf16_t*)(p.ws + OFF_WT) + (size_t)WT_BN * 1024; g.M = T_; g.N = 5632; g.K = 1024;
        EpiP1N E; E.ws = p.ws;
        pg8::gemm_phase<EpiP1N, pg8::StaticOrder, false, true>((PG8_LAS unsigned char*)smem_all, g, S, E);
    }
    __syncthreads();
    {
        pg8::StaticOrder S; S.init(2048, T_, RG, RB);
        pg8::Gemm g; g.A = (const bf16_t*)(p.ws + OFF_WT) + (size_t)(WT_AT + 512) * 1024; g.Bt = (const bf16_t*)(p.ws + OFF_XB); g.M = 2048; g.N = T_; g.K = 1024;
        EpiP1V E; E.ws = p.ws;
        pg8::gemm_phase<EpiP1V, pg8::StaticOrder, false, true>((PG8_LAS unsigned char*)smem_all, g, S, E);
    }
    __syncthreads();
    {
        pg8::StaticOrder S; S.init(512, T_, RG, RB);
        pg8::Gemm g; g.A = (const bf16_t*)(p.ws + OFF_WT) + (size_t)(WT_AT + 2560) * 1024; g.Bt = (const bf16_t*)(p.ws + OFF_XB); g.M = 512; g.N = T_; g.K = 1024;
        EpiP1G E; E.ws = p.ws;
        pg8::gemm_phase<EpiP1G, pg8::StaticOrder, false, true>((PG8_LAS unsigned char*)smem_all, g, S, E);
    }
}

#define Q_LOAD(QV, SRC, TOK0, H) do { _Pragma("unroll") for (int j = 0; j < 4; ++j) { const int id_ = j * 256 + tid; \
        QV[j] = *(const u32x4*)((SRC) + ((size_t)(TOK0) + (id_ >> 4)) * 512 + (H) * 128 + (id_ & 15) * 8); } } while (0)
#define Q_TO_LDS(QV, QT) do { _Pragma("unroll") for (int j = 0; j < 4; ++j) { const int id_ = j * 256 + tid; *(u32x4*)((QT) + (id_ >> 4) * 272 + (id_ & 15) * 16) = QV[j]; } } while (0)
#define Q_STORE(QT, DST, BC, H) do { bf16_t* const ib_ = (DST) + (size_t)(((BC) * 4 + (H)) * 1024) * 8; \
        _Pragma("unroll") for (int j = 0; j < 4; ++j) { const int P_ = j * 256 + tid; \
            const int tok_ = 32 * (P_ >> 9) + (P_ & 31), dkb_ = 32 * ((P_ >> 7) & 3) + 16 * ((P_ >> 6) & 1) + 4 * ((P_ >> 5) & 1); \
            const u32x2 lo_ = *(const u32x2*)((QT) + tok_ * 272 + dkb_ * 2), hi_ = *(const u32x2*)((QT) + tok_ * 272 + (dkb_ + 8) * 2); \
            *(u32x4*)(ib_ + (size_t)P_ * 8) = (u32x4){lo_.x, lo_.y, hi_.x, hi_.y}; } } while (0)
DEVI void phase2(const Params& p, unsigned char* smem) {
    float* ga_s = (float*)smem;
    float* tot = (float*)(smem + 4096);
    const int tid = VT;
    const float* Ga = (const float*)(p.ws + OFF_GA);
    const bf16_t* Kgt = (const bf16_t*)(p.ws + OFF_KGT); bf16_t* Kg2 = (bf16_t*)(p.ws + OFF_KG2);
    float* dec = (float*)(p.ws + OFF_DEC);
    for (int it = VB; it < 2048; it += VG) {
        const int h = it & 3, c = (it >> 2) & 63, b = it >> 8;
        const int tok0 = b * 4096 + c * 64;
        ((f32x4*)ga_s)[tid] = ((const f32x4*)(Ga + (size_t)tok0 * 16))[tid];
        unsigned char* const qt = smem + 8192;
        const int dk = tid & 127, half = tid >> 7;
        float w2[16];
#pragma unroll
        for (int r = 0; r < 16; ++r) w2[r] = p.gate_w2[r * 512 + h * 128 + dk];
        const float bias = p.gate_b[h * 128 + dk];
        __syncthreads();
        float run = 0.f; float bc[32];
#pragma unroll
        for (int ml = 0; ml < 32; ++ml) {
            const int m = half * 32 + ml;
            float z = bias;
#pragma unroll
            for (int r4 = 0; r4 < 4; ++r4) { const f32x4 g4 = *(const f32x4*)&ga_s[m * 16 + 4 * r4];
                z += g4[0] * w2[4 * r4] + g4[1] * w2[4 * r4 + 1] + g4[2] * w2[4 * r4 + 2] + g4[3] * w2[4 * r4 + 3]; }
            const float la = (fminf(z, 0.f) - __logf(1.0f + __expf(-fabsf(z)))) * (1.0f / 16.0f);
            run += la; bc[ml] = run;
        }
        tot[half * 128 + dk] = run;
        __syncthreads();
        const float t0 = tot[dk], t1 = tot[128 + dk];
        const float bend = t0 + t1, off = half ? t0 : 0.f;
        const u32x4* kp = (const u32x4*)(Kgt + ((size_t)it * 128 + dk) * 64 + half * 32);
        bf16_t* const kqb = Kg2;
#pragma unroll
        for (int j = 0; j < 4; ++j) {
            u32x4 v = kp[j];
            unsigned uu[4] = {v.x, v.y, v.z, v.w};
#pragma unroll
            for (int e = 0; e < 4; ++e) {
                const float f0 = bflo(uu[e]) * __expf(bend - (bc[8 * j + 2 * e] + off));
                const float f1 = bfhi(uu[e]) * __expf(bend - (bc[8 * j + 2 * e + 1] + off));
                uu[e] = pk2(f0, f1);
            }
            *(u32x4*)(kqb + kf_off(it, dk, half * 32 + 8 * j)) = (u32x4){uu[0], uu[1], uu[2], uu[3]};
        }
        if (half == 0) dec[(size_t)it * 128 + dk] = __expf(bend);
        __syncthreads();
    }
    {
        bf16_t* tile = (bf16_t*)smem;
        const bf16_t* Kr = (const bf16_t*)(p.ws + OFF_KR); bf16_t* Krt = (bf16_t*)(p.ws + OFF_KRT);
        for (int it = VB; it < 2048; it += VG) {
            const int h = it & 3, c = (it >> 2) & 63, b = it >> 8;
            const size_t tok0 = (size_t)b * 4096 + c * 64;
            const int m = tid & 63, qd = tid >> 6;
            const float kd = exp2f(gamma_log2(h) * (float)(63 - m));
            const u32x4* src = (const u32x4*)(Kr + (tok0 + m) * 512 + h * 128 + 32 * qd);
            u32x4 v[4];
#pragma unroll
            for (int j = 0; j < 4; ++j) v[j] = src[j];
#pragma unroll
            for (int j = 0; j < 4; ++j) {
                const unsigned uu[4] = {v[j].x, v[j].y, v[j].z, v[j].w};
#pragma unroll
                for (int e = 0; e < 4; ++e) {
                    const int dk = 32 * qd + 8 * j + 2 * e;
                    tile[dk * 72 + m] = f2bf(bflo(uu[e]) * kd); tile[(dk + 1) * 72 + m] = f2bf(bfhi(uu[e]) * kd);
                }
            }
            unsigned char* const qt = smem + 20480;
            { u32x4 qv[4]; Q_LOAD(qv, (const bf16_t*)(p.ws + OFF_QR), tok0, h); Q_TO_LDS(qv, qt); }
            __syncthreads();
            Q_STORE(qt, (bf16_t*)(p.ws + OFF_QFR), b * 64 + c, h);
            {
                const int dk = tid >> 1, hf = tid & 1;
#pragma unroll
                for (int j = 0; j < 4; ++j) *(u32x4*)(Krt + kf_off(it, dk, hf * 32 + 8 * j)) = *(const u32x4*)&tile[dk * 72 + hf * 32 + 8 * j];
            }
            __syncthreads();
        }
    }
}

#undef Q_STORE
#undef Q_TO_LDS
#undef Q_LOAD
typedef float f32x16 __attribute__((ext_vector_type(16)));
DEVI f32x16 mfma32(bf16x8 a, bf16x8 b, f32x16 c) { return __builtin_amdgcn_mfma_f32_32x32x16_bf16(a, b, c, 0, 0, 0); }
struct ScanSet { bf16x8 kf[4], vq, qf[2][2]; f32x4 dc[4]; };
template <bool GLA>
DEVI void scan_tile(const Params& p, unsigned char* zb  , int b, int h, int s, int dummy) {
    int vt_ = VT; asm volatile("" : "+v"(vt_));
    const int t = __builtin_amdgcn_readfirstlane(vt_ >> 6), lane = vt_ & 63, r = lane & 31, hh = lane >> 5;
    const bf16_t* Ktb = (const bf16_t*)(p.ws + (GLA ? OFF_KG2 : OFF_KRT));
    const bf16_t* Vtb = (const bf16_t*)(p.ws + (GLA ? OFF_VGT : OFF_VRT));
    const bf16_t* Qb  = (const bf16_t*)(p.ws + (GLA ? OFF_QG : OFF_QFR));
    const float* dec = (const float*)(p.ws + OFF_DEC);
    bf16_t* Oo = (bf16_t*)(p.ws + OFF_OO);
    const float lg = gamma_log2(h);
    const float cd = exp2f(lg * 64.0f);
    f32x16 S;
#pragma unroll
    for (int i = 0; i < 16; ++i) S[i] = 0.f;
    const unsigned it0 = (unsigned)(b * 64 * 4 + h);
    const bf16_t* const kp = Ktb + ((size_t)it0 * 4 + t) * 4 * 512; const unsigned ko = (unsigned)lane * 8;
    const bf16_t* const vp = Vtb + ((size_t)it0 * 8 + s) * 4 * 512 + t * 512; const unsigned vo = (unsigned)lane * 8;
    const bf16_t* const qp = Qb + ((((size_t)(b * 64) * 4 + h) * 2) * 4 + t) * 2 * 512; const unsigned qo = (unsigned)lane * 8;
    const float* const dp = dec + (size_t)it0 * 128 + t * 32; const unsigned dofs = 4 * hh;
    unsigned char* const vring = smem_all_g + 2 * SMEM_HALF + VH * 8192;
    const int rt = t >> 1, rg0 = 2 * (t & 1);
    const float qd = GLA ? 1.0f : exp2f(lg * (float)(32 * rt + r + 1));
    bf16_t* const ob = Oo + (size_t)b * 4096 * 2048 + (GLA ? 1024 : 0) + h * 256 + s * 32;
#define ST_CL(C) (dummy ? 0 : ((C) < 64 ? (C) : 63))
#define ST_LOAD(SET, C) do { const int c_ = ST_CL(C), cv_ = ST_CL((C) + 1); \
        const bf16_t* kq = kp + (size_t)c_ * (4 * 16 * 512) + ko; const bf16_t* qq = qp + (size_t)c_ * (4 * 16 * 512) + qo; \
        _Pragma("unroll") for (int ks = 0; ks < 4; ++ks) (SET).kf[ks] = *(const bf16x8*)(kq + ks * 512); \
        (SET).vq = *(const bf16x8*)(vp + (size_t)cv_ * (4 * 32 * 512) + vo); \
        _Pragma("unroll") for (int ss = 0; ss < 2; ++ss) _Pragma("unroll") for (int tt = 0; tt < 2; ++tt) (SET).qf[ss][tt] = *(const bf16x8*)(qq + tt * (8 * 512) + ss * 512); \
        } while (0)
#define ST_LOADDC(SET, C) do { if (GLA) { const int c_ = (C) < 64 ? (C) : 63; const float* dq = dp + (size_t)c_ * (4 * 128) + dofs; \
        _Pragma("unroll") for (int g = 0; g < 4; ++g) (SET).dc[g] = *(const f32x4*)(dq + 8 * g); } } while (0)
#define ST_Z(SET, ZC) do { \
        _Pragma("unroll") for (int tt = 0; tt < 2; ++tt) { \
            f32x16 Zt; _Pragma("unroll") for (int i = 0; i < 16; ++i) Zt[i] = 0.f; \
            _Pragma("unroll") for (int ss = 0; ss < 2; ++ss) { \
                u32x4 pk; pk.x = pk2(S[8 * ss + 0], S[8 * ss + 1]); pk.y = pk2(S[8 * ss + 2], S[8 * ss + 3]); pk.z = pk2(S[8 * ss + 4], S[8 * ss + 5]); pk.w = pk2(S[8 * ss + 6], S[8 * ss + 7]); \
                Zt = mfma32(__builtin_bit_cast(bf16x8, pk), (SET).qf[ss][tt], Zt); } \
            _Pragma("unroll") for (int g = 0; g < 4; ++g) { \
                f32x4 z4; z4[0] = Zt[4 * g]; z4[1] = Zt[4 * g + 1]; z4[2] = Zt[4 * g + 2]; z4[3] = Zt[4 * g + 3]; \
                *(u32x2*)((ZC) + (((t * 2 + tt) * 4 + g) * 64 + lane) * 8) = pk4(z4); } } } while (0)
#define ST_UPD(SET, C) do { \
        if (GLA) { _Pragma("unroll") for (int g = 0; g < 4; ++g) _Pragma("unroll") for (int i = 0; i < 4; ++i) S[4 * g + i] *= (SET).dc[g][i]; } \
        else { _Pragma("unroll") for (int i = 0; i < 16; ++i) S[i] *= cd; } \
        _Pragma("unroll") for (int ks = 0; ks < 4; ++ks) S = mfma32((SET).kf[ks], *(const bf16x8*)(vring + ((C) & 1) * 4096 + ks * 1024 + lane * 16), S); } while (0)
#define ST_STEP(CUR, NXT, OTH, C) do { \
        ST_LOADDC(OTH, (C) + 1); ST_LOAD(NXT, (C) + 2);       \
        __builtin_amdgcn_sched_barrier(0); \
        unsigned char* zc = zb + ((C) & 1) * 16384; \
        if (GLA) { ST_UPD(CUR, C); ST_Z(CUR, zc); } else { ST_Z(CUR, zc); ST_UPD(CUR, C); } \
        *(bf16x8*)(vring + (((C) + 1) & 1) * 4096 + t * 1024 + lane * 16) = (CUR).vq; \
        __syncthreads(); \
        _Pragma("unroll") for (int gi = 0; gi < 2; ++gi) { const int g = rg0 + gi; \
            f32x4 o = (f32x4){0.f, 0.f, 0.f, 0.f}; \
            _Pragma("unroll") for (int t2 = 0; t2 < 4; ++t2) o += unpk4(*(const u32x2*)(zc + (((t2 * 2 + rt) * 4 + g) * 64 + lane) * 8)); \
            *(u32x2*)(zb + 32768 + ((C) & 7) * 4096 + (32 * rt + r) * 64 + (8 * g + 4 * hh) * 2) = pk4(o * qd); } \
          \
        if (((C) & 7) == 7) { __syncthreads(); \
            _Pragma("unroll") for (int i = 0; i < 8; ++i)   \
                *(u32x4*)((unsigned char*)ob + (size_t)(((C) - 7) * 64 + i * 64) * 4096 + fo) = *(const u32x4*)(zb + 32768 + i * 4096 + fl); } } while (0)
    const unsigned fo = (unsigned)(vt_ >> 2) * 4096u + (unsigned)(vt_ & 3) * 16u, fl = (unsigned)(vt_ >> 2) * 64u + (unsigned)(vt_ & 3) * 16u;
    ScanSet A, B, Cc;
    { const bf16x8 v0 = *(const bf16x8*)(vp + vo); *(bf16x8*)(vring + t * 1024 + lane * 16) = v0; }
    ST_LOAD(A, 0); ST_LOADDC(A, 0); ST_LOAD(B, 1);
    __syncthreads();
#pragma unroll 1
    for (int c0 = 0; c0 < 66; c0 += 3) { ST_STEP(A, Cc, B, c0); ST_STEP(B, A, Cc, c0 + 1); ST_STEP(Cc, B, A, c0 + 2); }
    __syncthreads();
#undef ST_STEP
#undef ST_UPD
#undef ST_Z
#undef ST_LOADDC
#undef ST_LOAD
#undef ST_CL
}
DEVI void phase3t(const Params& p, unsigned char* smem, int dummy) {
    for (int it0 = VB; it0 < 512; it0 += VG) {
        const int lcl = (RB >> 3) * 2 + VH;
        const int it = (VG == 512) ? ((RB & 7) * 8 + lcl / 8) * 8 + (lcl & 7) : it0;
        const int s = it & 7, h = (it >> 3) & 3, b = (it >> 5) & 7, br = it >> 8;
        if (br == 0) scan_tile<false>(p, smem, b, h, s, dummy); else scan_tile<true>(p, smem, b, h, s, dummy);
    }
}

constexpr int PS_LD = 72;
template <int CTRL> DEVI float dpp_add(float v) { const int x = __float_as_int(v); return v + __int_as_float(__builtin_amdgcn_update_dpp(x, x, CTRL, 0xf, 0xf, false)); }
DEVI float sum32(float v) {
    v = dpp_add<0xB1>(v); v = dpp_add<0x4E>(v); v = dpp_add<0x141>(v); v = dpp_add<0x140>(v);
    return v + __shfl_xor(v, 16);
}
DEVI void phase4(const Params& p, unsigned char* smem) {
    const int t = VT, lane = t & 63, w = t >> 6, l15 = lane & 15, q = lane >> 4;
    bf16_t* Ps = (bf16_t*)smem + w * 16 * PS_LD;
    const bf16_t* Qr = (const bf16_t*)(p.ws + OFF_QR); const bf16_t* Kr = (const bf16_t*)(p.ws + OFF_KR);
    const bf16_t* Vrt = (const bf16_t*)(p.ws + OFF_VRT); const bf16_t* Oo = (const bf16_t*)(p.ws + OFF_OO);
    const unsigned char* Gs8 = (const unsigned char*)(p.ws + OFF_GS); bf16_t* Y = (bf16_t*)(p.ws + OFF_Y);
    for (int it = VB; it < 4096; it += VG) {
        const int br = it >> 11, idx = it & 2047;
        const int h = idx & 3, c = (idx >> 2) & 63, b = idx >> 8;
        const size_t tok0 = (size_t)b * 4096 + c * 64;
        if (br == 1) {
            const int r2 = lane >> 5, c8 = (lane & 31) * 8;
            const size_t rowg = tok0 + 16 * w + r2;
            const bf16_t* ob = Oo + rowg * 2048 + 1024 + h * 256 + c8; const unsigned char* gb = Gs8 + rowg * 2048 + 1024 + h * 256 + c8;
            u32x4 ov[8]; u32x2 gv[8];
#pragma unroll
            for (int st = 0; st < 8; ++st) { ov[st] = *(const u32x4*)(ob + (size_t)st * 2 * 2048); gv[st] = *(const u32x2*)(gb + (size_t)st * 2 * 2048); }
            const f32x4 w0 = *(const f32x4*)(p.gla_norm_g + h * 256 + c8), w1 = *(const f32x4*)(p.gla_norm_g + h * 256 + c8 + 4);
            bf16_t* yb = Y + ((size_t)T_ + rowg) * 1024 + h * 256 + c8;
#pragma unroll
            for (int st = 0; st < 8; ++st) {
                f32x4 a0, a1; unpk8(ov[st], a0, a1);
                const f32x4 g0 = unpk4_fp8(gv[st].x) * 0.125f, g1 = unpk4_fp8(gv[st].y) * 0.125f;
                float s2 = 0.f;
#pragma unroll
                for (int r = 0; r < 4; ++r) s2 += a0[r] * a0[r] + a1[r] * a1[r];
                s2 = sum32(s2);
                const float rstd = rsqrtf(s2 * (1.0f / 256.0f) + 1e-6f);
                f32x4 y0, y1;
#pragma unroll
                for (int r = 0; r < 4; ++r) { y0[r] = a0[r] * rstd * w0[r] * siluf_(g0[r]); y1[r] = a1[r] * rstd * w1[r] * siluf_(g1[r]); }
                *(u32x4*)(yb + (size_t)st * 2 * 1024) = pk8(y0, y1);
            }
            continue;
        }
        const size_t tok = tok0 + 16 * w + l15;
        f32x4 O[16];
        const float lg = gamma_log2(h);
        unsigned char* const kl = smem + 9216;
        unsigned char* const vl = smem + 9216 + 64 * 272;
        u32x4 kq[4], vq[8];
        { const int kr = 16 * w + (lane >> 2), kc = (lane & 3) * 4;
          const u32x4* ks_ = (const u32x4*)(Kr + (tok0 + kr) * 512 + h * 128) + kc;
#pragma unroll
          for (int i = 0; i < 4; ++i) kq[i] = ks_[i];
          const u32x4* vs_ = (const u32x4*)(Vrt + (size_t)idx * 16384) + w * 512 + lane;
#pragma unroll
          for (int i = 0; i < 8; ++i) vq[i] = vs_[i * 64]; }
        bf16x8 qf[4];
#pragma unroll
        for (int ks = 0; ks < 4; ++ks) qf[ks] = *(const bf16x8*)(Qr + tok * 512 + h * 128 + ks * 32 + q * 8);
        const int r2 = lane >> 5, c8 = (lane & 31) * 8;
        const size_t rowg = tok0 + 16 * w + r2;
        u32x4 ov[8]; u32x2 gv[8];
        { const bf16_t* ob = Oo + rowg * 2048 + h * 256 + c8; const unsigned char* gb = Gs8 + rowg * 2048 + h * 256 + c8;
#pragma unroll
          for (int st = 0; st < 8; ++st) { ov[st] = *(const u32x4*)(ob + (size_t)st * 2 * 2048); gv[st] = *(const u32x2*)(gb + (size_t)st * 2 * 2048); } }
        { const int kr = 16 * w + (lane >> 2), kc = (lane & 3) * 4;
#pragma unroll
          for (int i = 0; i < 4; ++i) *(u32x4*)(kl + kr * 272 + (kc + i) * 16) = kq[i];
#pragma unroll
          for (int i = 0; i < 8; ++i) *(u32x4*)(vl + ((w * 512 + i * 64 + lane) * 16)) = vq[i]; }
        __syncthreads();
        f32x4 P[4] = {(f32x4){0.f, 0.f, 0.f, 0.f}, (f32x4){0.f, 0.f, 0.f, 0.f}, (f32x4){0.f, 0.f, 0.f, 0.f}, (f32x4){0.f, 0.f, 0.f, 0.f}};
#pragma unroll
        for (int ks = 0; ks < 4; ++ks) {
#pragma unroll
            for (int mt = 0; mt < 4; ++mt) {
                const bf16x8 kf = *(const bf16x8*)(kl + (16 * mt + l15) * 272 + (ks * 4 + q) * 16);
                P[mt] = mfma16(kf, qf[ks], P[mt]);
            }
        }
        const int j = 16 * w + l15;
#pragma unroll
        for (int mt = 0; mt < 4; ++mt) {
            f32x4 v = P[mt];
#pragma unroll
            for (int r = 0; r < 4; ++r) { const int m = 16 * mt + 4 * q + r; const int dd = j > m ? j - m : m - j; v[r] *= exp2f(lg * (float)dd); }
            *(u32x2*)&Ps[l15 * PS_LD + 16 * mt + 4 * q] = pk4(v);
        }
        __syncthreads();
        const bf16x8 pf0 = *(const bf16x8*)&Ps[l15 * PS_LD + q * 8];
        const bf16x8 pf1 = *(const bf16x8*)&Ps[l15 * PS_LD + 32 + q * 8];
#pragma unroll
        for (int nt = 0; nt < 16; ++nt) {
            const int pbase = ((nt >> 1) * 4) * 64 + (nt & 1) * 16 + l15;
            const bf16x8 v0 = *(const bf16x8*)(vl + (pbase + (q >> 1) * 64 + (q & 1) * 32) * 16);
            const bf16x8 v1 = *(const bf16x8*)(vl + (pbase + (2 + (q >> 1)) * 64 + (q & 1) * 32) * 16);
            f32x4 o = (f32x4){0.f, 0.f, 0.f, 0.f};
            o = mfma16(v0, pf0, o); O[nt] = mfma16(v1, pf1, o);
        }
        __syncthreads();
        bf16_t* Ot = (bf16_t*)(smem + 9216) + w * (16 * 264);
#pragma unroll
        for (int nt = 0; nt < 16; ++nt) *(u32x2*)&Ot[l15 * 264 + 16 * nt + 4 * q] = pk4(O[nt]);
        const f32x4 w0 = *(const f32x4*)(p.ret_norm_g + h * 256 + c8), w1 = *(const f32x4*)(p.ret_norm_g + h * 256 + c8 + 4);
        bf16_t* yb = Y + rowg * 1024 + h * 256 + c8;
#pragma unroll
        for (int st = 0; st < 8; ++st) {
            f32x4 a0, a1, i0, i1;
            unpk8(*(const u32x4*)&Ot[(2 * st + r2) * 264 + c8], i0, i1); unpk8(ov[st], a0, a1);
            const f32x4 g0 = unpk4_fp8(gv[st].x) * 0.125f, g1 = unpk4_fp8(gv[st].y) * 0.125f;
            a0 += i0; a1 += i1;
            float s1 = (a0[0] + a0[1]) + (a0[2] + a0[3]) + (a1[0] + a1[1]) + (a1[2] + a1[3]);
            s1 = sum32(s1);
            const float mean = s1 * (1.0f / 256.0f);
            float s2 = 0.f;
#pragma unroll
            for (int r = 0; r < 4; ++r) { const float d0 = a0[r] - mean, d1 = a1[r] - mean; s2 += d0 * d0 + d1 * d1; }
            s2 = sum32(s2);
            const float rstd = rsqrtf(s2 * (1.0f / 256.0f) + 1e-5f);
            f32x4 y0, y1;
#pragma unroll
            for (int r = 0; r < 4; ++r) { y0[r] = (a0[r] - mean) * rstd * w0[r] * siluf_(g0[r]); y1[r] = (a1[r] - mean) * rstd * w1[r] * siluf_(g1[r]); }
            *(u32x4*)(yb + (size_t)st * 2 * 1024) = pk8(y0, y1);
        }
        __syncthreads();
    }
}

struct EpiMerge {
    static constexpr bool PERM = true, AFTER_DRAIN = false, CHAIN = true, BJI = true;
    const unsigned char* Mg; bf16_t* Mrg;
    __device__ __forceinline__ void operator()(pg8::f32x4 (&acc)[2][2][4][2], const pg8::Unit& u, int wr, int wc, int fr, int fq) const {
        const int pass = u.pm >> 7;
        const int row0 = (u.pm & 127) * 256 + wr * 64 + fr, col0 = (u.pn & 3) * 256 + wc * 64 + 16 * fq;
        constexpr float NL2E8 = -1.4426950408889634f * 0.125f;
#pragma unroll
        for (int ai = 0; ai < 2; ++ai) {
            u32x4 gz2[4], gz1[4];
#pragma unroll
            for (int m = 0; m < 4; ++m) {
                const size_t row = row0 + ai * 128 + m * 16;
                gz2[m] = *(const u32x4*)(Mg + row * 2048 + 1024 + col0);
                if (!pass) gz1[m] = *(const u32x4*)(Mg + row * 2048 + col0);
            }
#pragma unroll
            for (int m = 0; m < 4; ++m) {
                const unsigned w2[4] = {gz2[m].x, gz2[m].y, gz2[m].z, gz2[m].w};
                if (!pass) {
                    const unsigned w1[4] = {gz1[m].x, gz1[m].y, gz1[m].z, gz1[m].w};
#pragma unroll
                    for (int bj = 0; bj < 2; ++bj)
#pragma unroll
                        for (int n = 0; n < 2; ++n) {
                            const f32x4 z2 = unpk4_fp8(w2[2 * bj + n]), z1 = unpk4_fp8(w1[2 * bj + n]);
#pragma unroll
                            for (int r = 0; r < 4; ++r)
                                acc[ai][bj][m][n][r] *= (1.0f + __builtin_amdgcn_exp2f(NL2E8 * z2[r])) * __builtin_amdgcn_rcpf(1.0f + __builtin_amdgcn_exp2f(NL2E8 * z1[r]));
                        }
                } else {
                    const size_t row = row0 + ai * 128 + m * 16;
#pragma unroll
                    for (int bj = 0; bj < 2; ++bj) {
                        f32x4 o[2];
#pragma unroll
                        for (int n = 0; n < 2; ++n) {
                            const f32x4 z2 = unpk4_fp8(w2[2 * bj + n]);
#pragma unroll
                            for (int r = 0; r < 4; ++r) o[n][r] = acc[ai][bj][m][n][r] * __builtin_amdgcn_rcpf(1.0f + __builtin_amdgcn_exp2f(NL2E8 * z2[r]));
                        }
                        *(u32x4*)(Mrg + row * 1024 + col0 + 8 * bj) = pk8(o[0], o[1]);
                    }
                }
            }
        }
    }
};
struct MergeOrder {
    pg8::StaticOrder base;
    __device__ __forceinline__ bool next(int i, pg8::Unit& u) const { if (!base.next(i >> 1, u)) return false; u.pm += 128 * (i & 1); u.pn += 4 * (i & 1); return true; }
    __device__ __forceinline__ void a_ready(const pg8::Unit&) const {}
    __device__ __forceinline__ void done(const pg8::Unit&) const {}
};
DEVI void phase5(const Params& p, unsigned char* smem_all) {
    static_assert(WT_GLA == WT_RET + 1024, "the two branch out-projection blocks are adjacent");
    MergeOrder S; S.base.init(T_, 1024, RG, RB);
    pg8::Gemm g; g.A = (const bf16_t*)(p.ws + OFF_Y); g.Bt = (const bf16_t*)(p.ws + OFF_WT) + (size_t)WT_RET * 1024; g.M = 2 * T_; g.N = 2048; g.K = 1024;
    EpiMerge E; E.Mg = (const unsigned char*)(p.ws + OFF_MG); E.Mrg = (bf16_t*)(p.ws + OFF_MRG);
    pg8::gemm_phase<EpiMerge, MergeOrder, false, true>((PG8_LAS unsigned char*)smem_all, g, S, E);
    __syncthreads();
}

struct EpiResid {
    static constexpr bool PERM = true, AFTER_DRAIN = false; static constexpr bool CHAIN = false; static constexpr bool BJI = false;
    const bf16_t* xb; bf16_t* T1;
    __device__ __forceinline__ void operator()(const pg8::f32x4 (&acc)[2][2][4][2], const pg8::Unit& u, int wr, int wc, int fr, int fq) const {
        const int row0 = u.pm * 256 + wr * 64 + fr, col0 = u.pn * 256 + wc * 32 + 8 * fq;
#pragma unroll
        for (int ai = 0; ai < 2; ++ai)
#pragma unroll
            for (int m = 0; m < 4; ++m) {
                const size_t row = row0 + ai * 128 + m * 16;
                f32x4 xv[2][2];
#pragma unroll
                for (int bj = 0; bj < 2; ++bj) unpk8(*(const u32x4*)(xb + row * 1024 + col0 + bj * 128), xv[bj][0], xv[bj][1]);
#pragma unroll
                for (int bj = 0; bj < 2; ++bj)
                    *(u32x4*)(T1 + row * 1024 + col0 + bj * 128) = pk8(xv[bj][0] * ALPHA_ + acc[ai][bj][m][0], xv[bj][1] * ALPHA_ + acc[ai][bj][m][1]);
            }
    }
};
DEVI void phase6(const Params& p, unsigned char* smem_all) {
    pg8::StaticOrder S; S.init(T_, 1024, RG, RB);
    pg8::Gemm g; g.A = (const bf16_t*)(p.ws + OFF_MRG); g.Bt = (const bf16_t*)(p.ws + OFF_WT) + (size_t)WT_O * 1024; g.M = T_; g.N = 1024; g.K = 1024;
    EpiResid E; E.xb = (const bf16_t*)(p.ws + OFF_XB); E.T1 = (bf16_t*)(p.ws + OFF_T1);
    pg8::gemm_phase<EpiResid, pg8::StaticOrder, false, true>((PG8_LAS unsigned char*)smem_all, g, S, E);
}

struct ConvTask { const float* sp; bf16_t* dp; int N; };
DEVI ConvTask conv_task(const Params& p, int task, int t) {
    const int ng = t & 31, kg = t >> 5;
    bf16_t* WGU = (bf16_t*)(p.ws + OFF_WGU); bf16_t* WD = (bf16_t*)(p.ws + OFF_WD);
    const int e = task / 96, rem = task - e * 96, mat = rem >> 5, tl = rem & 31;
    const float* src; bf16_t* dst; int K, N, kt, nt;
    if (mat < 2) { K = 1024; N = 256; kt = tl >> 1; nt = tl & 1;
        src = (mat == 0) ? (e < 256 ? p.ew_gate + (size_t)e * 262144 : p.sw_gate) : (e < 256 ? p.ew_up + (size_t)e * 262144 : p.sw_up);
        dst = WGU + (size_t)e * 524288 + (size_t)(nt + mat) * 131072; }
    else { K = 256; N = 1024; kt = tl >> 3; nt = tl & 7;
        src = e < 256 ? p.ew_down + (size_t)e * 262144 : p.sw_down; dst = WD + (size_t)e * 262144; }
    ConvTask c; c.N = N;
    c.sp = src + (size_t)(kt * 64 + 4 * kg) * N + nt * 128 + 4 * ng;
    c.dp = dst + (size_t)(nt * 128 + (t >> 1)) * K + kt * 64 + (t & 1) * 32;
    return c;
}
DEVI ConvTask convs_task(const Params& p, int st, int t) {
    const int ng = t & 15, kg = t >> 4, task = st >> 1, sub = st & 1;
    bf16_t* WGU = (bf16_t*)(p.ws + OFF_WGU); bf16_t* WD = (bf16_t*)(p.ws + OFF_WD);
    const int e = task / 96, rem = task - e * 96, mat = rem >> 5, tl = rem & 31;
    const float* src; bf16_t* dst; int K, N, kt, nt;
    if (mat < 2) { K = 1024; N = 256; kt = tl >> 1; nt = tl & 1;
        src = (mat == 0) ? (e < 256 ? p.ew_gate + (size_t)e * 262144 : p.sw_gate) : (e < 256 ? p.ew_up + (size_t)e * 262144 : p.sw_up);
        dst = WGU + (size_t)e * 524288 + (size_t)(nt + mat) * 131072; }
    else { K = 256; N = 1024; kt = tl >> 3; nt = tl & 7;
        src = e < 256 ? p.ew_down + (size_t)e * 262144 : p.sw_down; dst = WD + (size_t)e * 262144; }
    ConvTask c; c.N = N;
    c.sp = src + (size_t)(kt * 64 + 4 * kg) * N + nt * 128 + sub * 64 + 4 * ng;
    c.dp = dst + (size_t)(nt * 128 + sub * 64 + (t >> 2)) * K + kt * 64 + (t & 3) * 16;
    return c;
}
DEVI void conv_expert_weights(const Params& p, unsigned char* smem) {
    bf16_t* tile = (bf16_t*)smem;
    const int t = VT, ng = t & 31, kg = t >> 5;
    const int ntask = 257 * 3 * 32;
#define CV_LOAD(RF, C) do { _Pragma("unroll") for (int i = 0; i < 4; ++i) { RF[i] = *(const f32x4*)((C).sp + (size_t)i * (C).N); RF[4 + i] = *(const f32x4*)((C).sp + (size_t)(32 + i) * (C).N); } } while (0)
#define CV_PROC(RF, C) do { \
        _Pragma("unroll") for (int i = 0; i < 4; ++i) { \
            u32x2 v0, v1; \
            v0.x = pk2(RF[0][i], RF[1][i]); v0.y = pk2(RF[2][i], RF[3][i]); v1.x = pk2(RF[4][i], RF[5][i]); v1.y = pk2(RF[6][i], RF[7][i]); \
            *(u32x2*)&tile[(4 * ng + i) * 72 + 4 * kg] = v0; *(u32x2*)&tile[(4 * ng + i) * 72 + 32 + 4 * kg] = v1; } \
        asm volatile("s_waitcnt lgkmcnt(0)" ::: "memory"); __builtin_amdgcn_s_barrier(); asm volatile("" ::: "memory"); \
        { const int n = t >> 1, hf = t & 1; \
          _Pragma("unroll") for (int j = 0; j < 4; ++j) *(u32x4*)((C).dp + 8 * j) = *(const u32x4*)&tile[n * 72 + hf * 32 + 8 * j]; } \
        asm volatile("s_waitcnt lgkmcnt(0)" ::: "memory"); __builtin_amdgcn_s_barrier(); asm volatile("" ::: "memory"); } while (0)
    f32x4 ra[8], rb[8];
    int task = 8 * VG + VB;
    if (task >= ntask) return;
    ConvTask ca = conv_task(p, task, t), cb = ca;
    CV_LOAD(ra, ca);
#pragma unroll 1
    for (;;) {
        bool more = task + VG < ntask;
        cb = conv_task(p, more ? task + VG : task, t); CV_LOAD(rb, cb);
        CV_PROC(ra, ca);
        if (!more) break;
        task += VG;
        more = task + VG < ntask;
        ca = conv_task(p, more ? task + VG : task, t); CV_LOAD(ra, ca);
        CV_PROC(rb, cb);
        if (!more) break;
        task += VG;
    }
#undef CV_LOAD
#undef CV_PROC
}

DEVI void ln1_row(const Params& p, int row, int lane) {
    const bf16_t* T1 = (const bf16_t*)(p.ws + OFF_T1); bf16_t* X1b = (bf16_t*)(p.ws + OFF_X1B);
    f32x4 v[4]; float s = 0.f;
#pragma unroll
    for (int i = 0; i < 4; ++i) { v[i] = unpk4(*(const u32x2*)(T1 + (size_t)row * 1024 + i * 256 + lane * 4)); s += (v[i][0] + v[i][1]) + (v[i][2] + v[i][3]); }
#pragma unroll
    for (int o = 32; o > 0; o >>= 1) s += __shfl_xor(s, o);
    const float mean = s * (1.0f / 1024.0f); float s2 = 0.f;
#pragma unroll
    for (int i = 0; i < 4; ++i)
#pragma unroll
        for (int r = 0; r < 4; ++r) { const float d = v[i][r] - mean; s2 += d * d; }
#pragma unroll
    for (int o = 32; o > 0; o >>= 1) s2 += __shfl_xor(s2, o);
    const float rstd = rsqrtf(s2 * (1.0f / 1024.0f) + 1e-5f);
#pragma unroll
    for (int i = 0; i < 4; ++i) {
        const int col = i * 256 + lane * 4;
        const f32x4 g = *(const f32x4*)(p.ln1_g + col), bb = *(const f32x4*)(p.ln1_b + col);
        f32x4 y;
#pragma unroll
        for (int r = 0; r < 4; ++r) y[r] = (v[i][r] - mean) * rstd * g[r] + bb[r];
        *(u32x2*)(X1b + (size_t)row * 1024 + col) = pk4(y);
    }
}

DEVI unsigned f2ord(float f) { const unsigned u = __float_as_uint(f); return (u & 0x80000000u) ? ~u : (u | 0x80000000u); }
template <int CTRL> DEVI float dppf(float v) { const int x = __float_as_int(v); return __int_as_float(__builtin_amdgcn_update_dpp(x, x, CTRL, 0xf, 0xf, false)); }
template <int CTRL> DEVI void top2_merge(float& m1, float& m2) {
    const float p1 = dppf<CTRL>(m1), p2 = dppf<CTRL>(m2);
    const float n1 = fmaxf(m1, p1), n2 = fmaxf(fminf(m1, p1), fmaxf(m2, p2));
    m1 = n1; m2 = n2;
}
DEVI void route_token(const f32x4 lg, const f32x4 rb, int lane, int& mye, float& myw) {
    const int mygrp = lane >> 3;
    float sc[4], bi[4];
#pragma unroll
    for (int r = 0; r < 4; ++r) { sc[r] = sigmoidf_(lg[r]); bi[r] = sc[r] + rb[r]; }
    float m1, m2;
    { const float h01 = fmaxf(bi[0], bi[1]), l01 = fminf(bi[0], bi[1]), h23 = fmaxf(bi[2], bi[3]), l23 = fminf(bi[2], bi[3]);
      m1 = fmaxf(h01, h23); m2 = fmaxf(fminf(h01, h23), fmaxf(l01, l23)); }
    top2_merge<0xB1>(m1, m2);
    top2_merge<0x4E>(m1, m2);
    top2_merge<0x141>(m1, m2);
    const float gown = m1 + m2;
    int rank = 0;
#pragma unroll
    for (int g2 = 0; g2 < 8; ++g2) {
        const float go = __builtin_bit_cast(float, __builtin_amdgcn_readlane(__builtin_bit_cast(int, gown), 8 * g2));
        rank += (go > gown || (go == gown && g2 < mygrp)) ? 1 : 0;
    }
    unsigned ck[4];
#pragma unroll
    for (int r = 0; r < 4; ++r) ck[r] = rank < 4 ? f2ord(bi[r]) : 0u;
    unsigned thr = 0u; bool exact = false;
#pragma unroll 1
    for (int bit = 31; bit >= 0; --bit) {
        const unsigned cnd = thr | (1u << bit);
        const int c8 = __popcll(__ballot(ck[0] >= cnd)) + __popcll(__ballot(ck[1] >= cnd)) + __popcll(__ballot(ck[2] >= cnd)) + __popcll(__ballot(ck[3] >= cnd));
        if (c8 >= 8) { thr = cnd; if (c8 == 8) { exact = true; break; } }
    }
    unsigned long long selm[4];
    if (exact) {
#pragma unroll
        for (int r = 0; r < 4; ++r) selm[r] = __ballot(ck[r] >= thr);
    } else {
        unsigned long long eq[4], any = 0ull; int need = 8;
#pragma unroll
        for (int r = 0; r < 4; ++r) { selm[r] = __ballot(ck[r] > thr); eq[r] = __ballot(ck[r] == thr); need -= __popcll(selm[r]); any |= eq[r]; }
        while (need > 0 && any != 0ull) {
            const int L = __builtin_ctzll(any); any &= any - 1ull;
#pragma unroll
            for (int r = 0; r < 4; ++r) if (((eq[r] >> L) & 1ull) != 0ull && need > 0) { selm[r] |= 1ull << L; --need; }
        }
    }
    float wsum = 0.f; int kk = 0;
    mye = 0; myw = 0.f;
#pragma unroll
    for (int r = 0; r < 4; ++r) {
        unsigned long long m = selm[r];
        while (m != 0ull) {
            const int L = __builtin_ctzll(m); m &= m - 1ull;
            const float sv = __builtin_bit_cast(float, __builtin_amdgcn_readlane(__builtin_bit_cast(int, sc[r]), L));
            wsum += sv;
            if (lane == kk) { mye = 4 * L + r; myw = sv; }
            ++kk;
        }
    }
    myw = myw / wsum * 2.5f;
}
DEVI void route_token2(const f32x4 lgA, const f32x4 lgB, const f32x4 rb, int lane, int& myeA, float& mywA, int& myeB, float& mywB) {
    const int mygrp = lane >> 3;
    float sc[2][4], bi[2][4];
#pragma unroll
    for (int r = 0; r < 4; ++r) { sc[0][r] = sigmoidf_(lgA[r]); bi[0][r] = sc[0][r] + rb[r]; sc[1][r] = sigmoidf_(lgB[r]); bi[1][r] = sc[1][r] + rb[r]; }
    unsigned ck[2][4];
#pragma unroll
    for (int t = 0; t < 2; ++t) {
        float m1, m2;
        { const float h01 = fmaxf(bi[t][0], bi[t][1]), l01 = fminf(bi[t][0], bi[t][1]), h23 = fmaxf(bi[t][2], bi[t][3]), l23 = fminf(bi[t][2], bi[t][3]);
          m1 = fmaxf(h01, h23); m2 = fmaxf(fminf(h01, h23), fmaxf(l01, l23)); }
        top2_merge<0xB1>(m1, m2); top2_merge<0x4E>(m1, m2); top2_merge<0x141>(m1, m2);
        const float gown = m1 + m2;
        int rank = 0;
#pragma unroll
        for (int g2 = 0; g2 < 8; ++g2) {
            const float go = __builtin_bit_cast(float, __builtin_amdgcn_readlane(__builtin_bit_cast(int, gown), 8 * g2));
            rank += (go > gown || (go == gown && g2 < mygrp)) ? 1 : 0;
        }
#pragma unroll
        for (int r = 0; r < 4; ++r) ck[t][r] = rank < 4 ? f2ord(bi[t][r]) : 0u;
    }
    unsigned thrA = 0u, thrB = 0u; bool exA = false, exB = false;
#pragma unroll 1
    for (int bit = 31; bit >= 0; --bit) {
        if (exA && exB) break;
        const unsigned cA = thrA | (1u << bit), cB = thrB | (1u << bit);
        const int nA = __popcll(__ballot(ck[0][0] >= cA)) + __popcll(__ballot(ck[0][1] >= cA)) + __popcll(__ballot(ck[0][2] >= cA)) + __popcll(__ballot(ck[0][3] >= cA));
        const int nB = __popcll(__ballot(ck[1][0] >= cB)) + __popcll(__ballot(ck[1][1] >= cB)) + __popcll(__ballot(ck[1][2] >= cB)) + __popcll(__ballot(ck[1][3] >= cB));
        if (!exA && nA >= 8) { thrA = cA; exA = (nA == 8); }
        if (!exB && nB >= 8) { thrB = cB; exB = (nB == 8); }
    }
#pragma unroll
    for (int t = 0; t < 2; ++t) {
        const unsigned thr = t ? thrB : thrA; const bool exact = t ? exB : exA;
        unsigned long long selm[4];
        if (exact) {
#pragma unroll
            for (int r = 0; r < 4; ++r) selm[r] = __ballot(ck[t][r] >= thr);
        } else {
            unsigned long long eq[4], any = 0ull; int need = 8;
#pragma unroll
            for (int r = 0; r < 4; ++r) { selm[r] = __ballot(ck[t][r] > thr); eq[r] = __ballot(ck[t][r] == thr); need -= __popcll(selm[r]); any |= eq[r]; }
            while (need > 0 && any != 0ull) {
                const int L = __builtin_ctzll(any); any &= any - 1ull;
#pragma unroll
                for (int r = 0; r < 4; ++r) if (((eq[r] >> L) & 1ull) != 0ull && need > 0) { selm[r] |= 1ull << L; --need; }
            }
        }
        float wsum = 0.f, myw = 0.f; int kk = 0, mye = 0;
#pragma unroll
        for (int r = 0; r < 4; ++r) {
            unsigned long long m = selm[r];
            while (m != 0ull) {
                const int L = __builtin_ctzll(m); m &= m - 1ull;
                const float sv = __builtin_bit_cast(float, __builtin_amdgcn_readlane(__builtin_bit_cast(int, sc[t][r]), L));
                wsum += sv;
                if (lane == kk) { mye = 4 * L + r; myw = sv; }
                ++kk;
            }
        }
        myw = myw / wsum * 2.5f;
        if (t == 0) { myeA = mye; mywA = myw; } else { myeB = mye; mywB = myw; }
    }
}
DEVI void router_gemm(const Params& p, unsigned char* smem_all, int m0, f32x4 (&acc)[4][4]) {
    typedef __attribute__((address_space(3))) unsigned char lds8;
    lds8* const L = (lds8*)smem_all;
    const int tid = (int)threadIdx.x, lane = tid & 63, wv = __builtin_amdgcn_readfirstlane(tid >> 6), wr = wv >> 2, wc = wv & 3, l15 = lane & 15, q = lane >> 4;
    const bf16_t* pa = (const bf16_t*)(p.ws + OFF_X1B) + (size_t)(m0 + (tid >> 3)) * 1024 + gemm_src_chunk(tid);
    const bf16_t* pb = (const bf16_t*)(p.ws + OFF_WT) + (size_t)(WT_R + (tid >> 3)) * 1024 + gemm_src_chunk(tid);
    constexpr int STG = 49152;
#define RG_BOFF(BUF, I) ((BUF) * STG + 16384 + (I) * 8192 + (((BUF) == 2 && (I) >= 2) ? (2 * SMEM_HALF - 131072) : 0))
#define RG_ISSUE(BUF, KT) do { \
        _Pragma("unroll") for (int i = 0; i < 2; ++i) __builtin_amdgcn_global_load_lds((const unsigned*)(pa + (size_t)i * 65536 + (KT) * 64), (__attribute__((address_space(3))) unsigned*)(L + (BUF) * STG + i * 8192 + wv * 1024), 16, 0, 0); \
        _Pragma("unroll") for (int i = 0; i < 4; ++i) __builtin_amdgcn_global_load_lds((const unsigned*)(pb + (size_t)i * 65536 + (KT) * 64), (__attribute__((address_space(3))) unsigned*)(L + RG_BOFF(BUF, i) + wv * 1024), 16, 0, 0); } while (0)
    static_assert(2 * STG + 16384 + 2 * 8192 == 131072 && 2 * SMEM_HALF + 2 * 8192 <= 2 * SMEM_HALF + SMEM_MOE, "router GEMM stage map");
    RG_ISSUE(0, 0); RG_ISSUE(1, 1);
    int buf = 0;
#pragma unroll 1
    for (int kt = 0; kt < 16; ++kt) {
        if (kt + 1 < 16) asm volatile("s_waitcnt vmcnt(6)" ::: "memory"); else asm volatile("s_waitcnt vmcnt(0)" ::: "memory");
        __builtin_amdgcn_s_barrier();
        if (kt + 2 < 16) { const int b2 = buf == 0 ? 2 : buf - 1; RG_ISSUE(b2, kt + 2); }
        __builtin_amdgcn_sched_barrier(0);
#pragma unroll
        for (int ss = 0; ss < 2; ++ss) {
            bf16x8 af[4], bfr[4];
            const int coff = ((ss * 4 + q) ^ (l15 >> 1)) * 16;
#pragma unroll
            for (int i = 0; i < 4; ++i) {
                af[i]  = *(const __attribute__((address_space(3))) bf16x8*)(L + buf * STG + (wr * 64 + i * 16 + l15) * 128 + coff);
                bfr[i] = *(const __attribute__((address_space(3))) bf16x8*)(L + RG_BOFF(buf, wc) + (i * 16 + l15) * 128 + coff); }
#pragma unroll
            for (int mt = 0; mt < 4; ++mt)
#pragma unroll
                for (int nt = 0; nt < 4; ++nt) acc[mt][nt] = mfma16(bfr[nt], af[mt], acc[mt][nt]);
        }
        __builtin_amdgcn_sched_barrier(0);
        buf = buf == 2 ? 0 : buf + 1;
    }
#undef RG_ISSUE
#undef RG_BOFF
    __syncthreads();
}
DEVI void phase8(const Params& p, unsigned char* smem_all) {
    const int tid = (int)threadIdx.x, lane = tid & 63, wv = tid >> 6, wr = wv >> 2, wc = wv & 3, l15 = lane & 15, q = lane >> 4;
    int* hist = (int*)(smem_all + 2 * SMEM_HALF); int* rec = hist + 256; float* wrec = (float*)(rec + 1024);
    int* cnt = (int*)(p.ws + OFF_CNT); int* list = (int*)(p.ws + OFF_LIST); float* wl = (float*)(p.ws + OFF_WL);
    const f32x4 rb = *(const f32x4*)(p.router_bias + 4 * lane);
    for (int mtg = RB; mtg < 256; mtg += RG) {
        const int m0 = mtg * 128;
#pragma unroll 1
        for (int i = 0; i < 16; i += 4) {
#pragma unroll
            for (int j = 0; j < 4; ++j) ln1_row(p, m0 + wv * 16 + i + j, lane);
        }
        asm volatile("s_waitcnt vmcnt(0)" ::: "memory");
        __syncthreads();
        f32x4 acc[4][4]; zero_acc(acc);
        router_gemm(p, smem_all, m0, acc);
        if (tid < 256) hist[tid] = 0;
#pragma unroll
        for (int mt = 0; mt < 4; ++mt)
#pragma unroll
            for (int nt = 0; nt < 4; ++nt) {
                const int row = wr * 64 + mt * 16 + l15, col = wc * 64 + (nt >> 1) * 32 + 8 * q + 4 * (nt & 1);
                *(f32x4*)(smem_all + row * 1024 + (((col >> 2) ^ (row & 15)) * 16)) = acc[mt][nt];
            }
        __syncthreads();
        bf16_t* ctile = (bf16_t*)(smem_all + 2 * SMEM_HALF + 9216 + VH * 9216);
        const int vt = VT, cng = vt & 15, ckg = vt >> 4;
#define P8_BAR do { asm volatile("s_waitcnt lgkmcnt(0)" ::: "memory"); __builtin_amdgcn_s_barrier(); asm volatile("" ::: "memory"); } while (0)
#define P8_CLOAD(RF, C) do { _Pragma("unroll") for (int r = 0; r < 4; ++r) RF[r] = *(const f32x4*)((C).sp + (size_t)r * (C).N); } while (0)
#define P8_CPROC(RF, C) do { \
            _Pragma("unroll") for (int c4 = 0; c4 < 4; ++c4) { u32x2 w; w.x = pk2(RF[0][c4], RF[1][c4]); w.y = pk2(RF[2][c4], RF[3][c4]); *(u32x2*)&ctile[(4 * cng + c4) * 72 + 4 * ckg] = w; } \
            P8_BAR; \
            { const u32x4 o0 = *(const u32x4*)&ctile[(vt >> 2) * 72 + (vt & 3) * 16], o1 = *(const u32x4*)&ctile[(vt >> 2) * 72 + (vt & 3) * 16 + 8]; \
              *(u32x4*)((C).dp) = o0; *(u32x4*)((C).dp + 8) = o1; } \
            P8_BAR; } while (0)
#define P8_ROUTE2(I) do { const int tlA = wv + 8 * (I), tlB = wv + 8 * ((I) + 1); \
            const f32x4 lgA = *(const f32x4*)(smem_all + tlA * 1024 + ((lane ^ (tlA & 15)) * 16)); \
            const f32x4 lgB = *(const f32x4*)(smem_all + tlB * 1024 + ((lane ^ (tlB & 15)) * 16)); \
            int eA, eB; float wA, wB; route_token2(lgA, lgB, rb, lane, eA, wA, eB, wB); \
            if (lane < 8) { \
                const int lpA = __hip_atomic_fetch_add(&hist[eA], 1, __ATOMIC_RELAXED, __HIP_MEMORY_SCOPE_WORKGROUP); \
                rec[tlA * 8 + lane] = eA | (lpA << 8); wrec[tlA * 8 + lane] = wA; \
                const int lpB = __hip_atomic_fetch_add(&hist[eB], 1, __ATOMIC_RELAXED, __HIP_MEMORY_SCOPE_WORKGROUP); \
                rec[tlB * 8 + lane] = eB | (lpB << 8); wrec[tlB * 8 + lane] = wB; } } while (0)
        {
            f32x4 fa[4], fb[4];
            const int st0 = (mtg == RB) ? VB : 0x7fffffff;
            const bool cv = st0 < 16 * VG;
            ConvTask ka = convs_task(p, cv ? st0 : 0, vt), kb = convs_task(p, cv ? st0 + VG : 0, vt);
            P8_CLOAD(fa, ka); P8_CLOAD(fb, kb);
#pragma unroll 1
            for (int i = 0; i < 16; i += 2) {
                P8_ROUTE2(i);
                if (cv) { P8_CPROC(fa, ka); P8_CPROC(fb, kb); } else { P8_BAR; P8_BAR; P8_BAR; P8_BAR; }
                ka = convs_task(p, (cv && i + 2 < 16) ? st0 + (i + 2) * VG : 0, vt); P8_CLOAD(fa, ka);
                kb = convs_task(p, (cv && i + 3 < 16) ? st0 + (i + 3) * VG : 0, vt); P8_CLOAD(fb, kb);
            }
        }
#undef P8_ROUTE2
#undef P8_CPROC
#undef P8_CLOAD
#undef P8_BAR
        __syncthreads();
        if (tid < 256) { const int c = hist[tid]; hist[tid] = c > 0 ? atomicAdd(&cnt[tid * CNT_STRIDE], c) : 0; }
        __syncthreads();
        for (int i = tid; i < 1024; i += 512) {
            const int rc = rec[i], e = rc & 255, pos = hist[e] + (rc >> 8);
            list[(size_t)e * T_ + pos] = (m0 + (i >> 3)) * 9 + (i & 7); wl[(size_t)e * T_ + pos] = wrec[i];
        }
        __syncthreads();
    }
}

DEVI void moe_prefix256(const Params& p, int* pre  , int xg) {
    const int tid = threadIdx.x;
    const int* cnt = (const int*)(p.ws + OFF_CNT);
    __syncthreads();
    if (tid < 8) pre[80 + tid] = 0;
    __syncthreads();
    if (tid < 256) {
        const int c = __hip_atomic_load(&cnt[tid * CNT_STRIDE], __ATOMIC_RELAXED, __HIP_MEMORY_SCOPE_AGENT);
        __hip_atomic_fetch_add(&pre[80 + (tid & 7)], (c + 255) >> 8, __ATOMIC_RELAXED, __HIP_MEMORY_SCOPE_WORKGROUP);
        if ((tid & 7) == xg) pre[40 + (tid >> 3)] = c;
    }
    __syncthreads();
    if (tid == 0) {
        int E[8], lvl = 0, sum = 0;
#pragma unroll
        for (int g = 0; g < 8; ++g) { E[g] = pre[80 + g]; sum += E[g]; }
        lvl = (sum + 128 + 7) / 8;
        for (;;) { int need = 0;
#pragma unroll
            for (int g = 0; g < 8; ++g) need += lvl - 1 > E[g] ? lvl - 1 - E[g] : 0;
            if (need < 128) break; --lvl; }
        int left = 128, base = 0, mine = 0, mybase = 0;
#pragma unroll
        for (int g = 0; g < 8; ++g) { int sg = lvl > E[g] ? lvl - E[g] : 0; if (sg > left) sg = left; if (g == xg) { mine = sg; mybase = base; } base += sg; left -= sg; }
        pre[90] = mybase; pre[91] = mine; pre[40 + 32] = T_;
    }
    __syncthreads();
    if (tid < 64) {
        int v = 0;
        if (tid < 32) v = (pre[40 + tid] + 255) >> 8;
        else if (tid == 32) v = pre[91];
#pragma unroll
        for (int o = 1; o < 64; o <<= 1) { const int u = __shfl_up(v, o); if (tid >= o) v += u; }
        if (tid < 33) pre[tid + 1] = v;
        if (tid == 0) pre[0] = 0;
    }
    __syncthreads();
}
struct MoeSched {
    const int* pre; const unsigned char* ws; bool need_w;
    int* sbuf;
    int xg, jl, nloc, nsh, nitems, shared0;
    const char* Abase; int arow_bytes; bool by_token;
    const char* Bbase; size_t b_expert_bytes, b_unit_bytes;
    __device__ __forceinline__ bool next(int i, pg8::Unit& u) const {
        const int item = jl + i * nloc; if (item >= nitems) return false;
        u.pm = item >> nsh; u.pn = item - (u.pm << nsh);
        const int lane = (int)(threadIdx.x & 63), li = lane < 33 ? lane : 32;
        const int pv = pre[li], cv = pre[40 + li];
        const int gi = __popcll(__ballot(lane < 33 && pv <= u.pm)) - 1;
        const int pg = __builtin_amdgcn_readlane(pv, gi);
        u.ce = __builtin_amdgcn_readlane(cv, gi);
        u.e = gi < 32 ? xg + 8 * gi : 256; u.r0 = (gi < 32 ? 0 : shared0) + (u.pm - pg) * 256;
        return true;
    }
    __device__ __forceinline__ void decode(const pg8::Unit& u, int& e, int& r0, int& ce) const { e = u.e; r0 = u.r0; ce = u.ce; }
    __device__ __forceinline__ int fill_issue(const pg8::Unit& u) const {
        int e, r0, ce; decode(u, e, r0, ce);
        const int pos = r0 + (int)(threadIdx.x & 255); const bool w = threadIdx.x >= 256;
        int v = w ? 0 : -1;
        if (pos < ce && !(w && !need_w)) {
            unsigned hi = threadIdx.x >> 8; asm volatile("" : "+v"(hi));
            static_assert(OFF_WL == OFF_LIST + (512u << 20), "weight list sits 512 MB above the slot list");
            const unsigned off = (unsigned)OFF_LIST + (hi << 29) + ((unsigned)e * (unsigned)T_ + (unsigned)pos) * 4u;
            v = e < 256 ? *(const int*)(ws + off) : (w ? 0x3f800000 : pos * 9 + 8);
        }
        return v;
    }
    __device__ __forceinline__ void fill_write(int buf, int v) const { sbuf[(threadIdx.x >= 256 ? 768 : 0) + buf * 256 + (int)(threadIdx.x & 255)] = v; }
    __device__ __forceinline__ const char* a_base() const { return Abase; }
    __device__ __forceinline__ void a_rows(int buf, const int (&rowA)[2], const int (&colA)[2], unsigned& p00, unsigned& p01, unsigned& p10, unsigned& p11) const {
        const int* sb = sbuf + buf * 256; const int s0 = sb[0];
        int s4[4];
#pragma unroll
        for (int k = 0; k < 4; ++k) { int sl = sb[(k >> 1) * 128 + rowA[k & 1]]; if (sl < 0) sl = s0; s4[k] = sl; }
#pragma unroll
        for (int k = 0; k < 4; ++k) if (by_token) s4[k] = s4[k] / 9;
        p00 = (unsigned)s4[0] * (unsigned)arow_bytes + (unsigned)colA[0]; p01 = (unsigned)s4[1] * (unsigned)arow_bytes + (unsigned)colA[1];
        p10 = (unsigned)s4[2] * (unsigned)arow_bytes + (unsigned)colA[0]; p11 = (unsigned)s4[3] * (unsigned)arow_bytes + (unsigned)colA[1];
    }
    __device__ __forceinline__ const char* b_base(const pg8::Unit& u) const { int e, r0, ce; decode(u, e, r0, ce); return Bbase + (size_t)e * b_expert_bytes + (size_t)u.pn * b_unit_bytes; }
    __device__ __forceinline__ void a_ready(const pg8::Unit&) const {}
    __device__ __forceinline__ void done(const pg8::Unit&) const {}
};
struct EpiMoe1 {
    static constexpr bool PERM = true, AFTER_DRAIN = false, BJI = false;
    const MoeSched* S; bf16_t* H;
    __device__ __forceinline__ void operator()(const pg8::f32x4 (&acc)[2][2][4][2], const pg8::Unit& u, int wr, int wc, int fr, int fq, int buf) const {
        const int* sb = S->sbuf + buf * 256 + wr * 64 + fr;
#pragma unroll
        for (int ai = 0; ai < 2; ++ai) {
            int sl[4]; float wg[4];
#pragma unroll
            for (int m = 0; m < 4; ++m) { sl[m] = sb[ai * 128 + m * 16]; wg[m] = __int_as_float(sb[768 + ai * 128 + m * 16]) * YX_SCALE; }
#pragma unroll
            for (int m = 0; m < 4; ++m) if (sl[m] >= 0) {
                f32x4 h0, h1;
#pragma unroll
                for (int r = 0; r < 4; ++r) { h0[r] = siluf_(acc[ai][0][m][0][r]) * (acc[ai][1][m][0][r] * wg[m]); h1[r] = siluf_(acc[ai][0][m][1][r]) * (acc[ai][1][m][1][r] * wg[m]); }
                *(u32x4*)(H + (size_t)sl[m] * 256 + u.pn * 128 + wc * 32 + 8 * fq) = pk8(h0, h1);
            }
            asm volatile("" ::: "memory");
        }
    }
};
struct EpiMoe2 {
    static constexpr bool PERM = true, AFTER_DRAIN = false, BJI = true;
    const MoeSched* S; unsigned char* YX;
    __device__ __forceinline__ void operator()(const pg8::f32x4 (&acc)[2][2][4][2], const pg8::Unit& u, int wr, int wc, int fr, int fq, int buf) const {
        const int* sb = S->sbuf + buf * 256 + wr * 64 + fr;
#pragma unroll
        for (int ai = 0; ai < 2; ++ai) {
            int sl[4];
#pragma unroll
            for (int m = 0; m < 4; ++m) sl[m] = sb[ai * 128 + m * 16];
#pragma unroll
            for (int m = 0; m < 4; ++m) if (sl[m] >= 0) {
                u32x4 w8;
                w8.x = pk4_fp8(clamp4(acc[ai][0][m][0], 440.f)); w8.y = pk4_fp8(clamp4(acc[ai][0][m][1], 440.f));
                w8.z = pk4_fp8(clamp4(acc[ai][1][m][0], 440.f)); w8.w = pk4_fp8(clamp4(acc[ai][1][m][1], 440.f));
                *(u32x4*)(YX + (size_t)sl[m] * 1024 + u.pn * 256 + wc * 64 + 16 * fq) = w8;
            }
            asm volatile("" ::: "memory");
        }
    }
};
DEVI void moe_sched_init(const Params& p, MoeSched& S, int* pre) {
    S.pre = pre; S.ws = p.ws; S.need_w = false; S.sbuf = (int*)(smem_all_g + 2 * SMEM_HALF);
    S.xg = RB & 7; S.jl = RB >> 3; S.nloc = RG >> 3;
}
DEVI void phase10(const Params& p, unsigned char* smem_all) {
    int* pre = (int*)(smem_all + 131072);
    MoeSched S; moe_sched_init(p, S, pre); moe_prefix256(p, pre, S.xg);
    S.nsh = 1; S.nitems = pre[33] << 1; S.shared0 = pre[90] * 256; S.Abase = (const char*)(p.ws + OFF_X1B); S.arow_bytes = 2048; S.by_token = true;
    S.Bbase = (const char*)(p.ws + OFF_WGU); S.b_expert_bytes = (size_t)512 * 1024 * 2; S.b_unit_bytes = (size_t)256 * 1024 * 2;
    S.need_w = true;
    EpiMoe1 E; E.S = &S; E.H = (bf16_t*)(p.ws + OFF_H);
    pg8::gemm_phase_g<EpiMoe1, MoeSched, true, true>((PG8_LAS unsigned char*)smem_all, 1024, S, E);
}
DEVI void phase11(const Params& p, unsigned char* smem_all) {
    int* pre = (int*)(smem_all + 131072);
    MoeSched S; moe_sched_init(p, S, pre); moe_prefix256(p, pre, S.xg);
    S.nsh = 2; S.nitems = pre[33] << 2; S.shared0 = pre[90] * 256; S.Abase = (const char*)(p.ws + OFF_H); S.arow_bytes = 512; S.by_token = false;
    S.Bbase = (const char*)(p.ws + OFF_WD); S.b_expert_bytes = (size_t)1024 * 256 * 2; S.b_unit_bytes = (size_t)256 * 256 * 2;
    EpiMoe2 E; E.S = &S; E.YX = (unsigned char*)(p.ws + OFF_YX);
    pg8::gemm_phase_g<EpiMoe2, MoeSched, true, true>((PG8_LAS unsigned char*)smem_all, 256, S, E);
}

DEVI void phase12(const Params& p) {
    const int t = VT, lane = t & 63, w = t >> 6;
    const bf16_t* X1b = (const bf16_t*)(p.ws + OFF_X1B); const unsigned char* YX = (const unsigned char*)(p.ws + OFF_YX);
    for (int row = VB * 4 + w; row < T_; row += VG * 4) {
        f32x4 v[4]; float s = 0.f;
#pragma unroll
        for (int i = 0; i < 4; ++i) {
            const int col = i * 256 + lane * 4;
            f32x4 a = unpk4(*(const u32x2*)(X1b + (size_t)row * 1024 + col)) * ALPHA_;
            f32x4 ys = (f32x4){0.f, 0.f, 0.f, 0.f};
#pragma unroll
            for (int k = 0; k < 9; ++k) ys += unpk4_fp8(*(const unsigned*)(YX + ((size_t)row * 9 + k) * 1024 + col));
            a += ys * (1.0f / YX_SCALE);
            v[i] = a; s += (a[0] + a[1]) + (a[2] + a[3]);
        }
#pragma unroll
        for (int o = 32; o > 0; o >>= 1) s += __shfl_xor(s, o);
        const float mean = s * (1.0f / 1024.0f); float s2 = 0.f;
#pragma unroll
        for (int i = 0; i < 4; ++i)
#pragma unroll
            for (int r = 0; r < 4; ++r) { const float d = v[i][r] - mean; s2 += d * d; }
#pragma unroll
        for (int o = 32; o > 0; o >>= 1) s2 += __shfl_xor(s2, o);
        const float rstd = rsqrtf(s2 * (1.0f / 1024.0f) + 1e-5f);
#pragma unroll
        for (int i = 0; i < 4; ++i) {
            const int col = i * 256 + lane * 4;
            const f32x4 g = *(const f32x4*)(p.ln2_g + col), bb = *(const f32x4*)(p.ln2_b + col);
            f32x4 y;
#pragma unroll
            for (int r = 0; r < 4; ++r) y[r] = (v[i][r] - mean) * rstd * g[r] + bb[r];
            *(f32x4*)(p.out + (size_t)row * 1024 + col) = y;
        }
    }
}


#define XB_TMO      128
#define XB_XCNT(j)  (256  + 64 * (j))
#define XB_XSUB(j)  (1280 + 64 * (j))
#define XB_XGEN(j)  (2304 + 64 * (j))
#define XB_TOP      3328
#define XB_TOPGEN   3392
#define XCD_BAR_WORDS 3456
#define XB_SPIN_CAP (1u << 20)
#define LAS __attribute__((address_space(3)))
DEVI unsigned xb_ld(unsigned* p)              { return __hip_atomic_load(p, __ATOMIC_RELAXED, __HIP_MEMORY_SCOPE_AGENT); }
DEVI unsigned xb_add(unsigned* p, unsigned v) { return __hip_atomic_fetch_add(p, v, __ATOMIC_RELAXED, __HIP_MEMORY_SCOPE_AGENT); }
DEVI unsigned xb_xcc_id() { return (unsigned)__builtin_amdgcn_s_getreg((3 << 11) | 20) & 0xFu; }
#define XB_SPIN(cond, bar) do { unsigned _sp = 0; while (cond) { __builtin_amdgcn_s_sleep(1); \
    if ((++_sp & 255u) == 0u) { if (xb_ld(&(bar)[XB_TMO])) break; if (_sp > XB_SPIN_CAP) { atomicAdd(&(bar)[XB_TMO], 1u); break; } } } } while (0)
struct XcdBarrier { unsigned* bar; unsigned x; volatile LAS unsigned* st; };
DEVI XcdBarrier xcd_barrier_post(unsigned* bar, volatile LAS unsigned* st) {
    XcdBarrier b; b.bar = bar; b.x = xb_xcc_id(); b.st = st;
    if (threadIdx.x == 0) st[3] = xb_add(&bar[XB_XCNT(b.x)], 1u);
    return b;
}
DEVI void xcd_barrier_complete(unsigned* bar, unsigned x, unsigned& nloc, unsigned& nx) {
    const unsigned G = gridDim.x * gridDim.y * gridDim.z;
    unsigned sum, cnt, mine, sp = 0u;
    for (;;) {
        sum = 0u; cnt = 0u; mine = 0u;
#pragma unroll
        for (unsigned j = 0; j < 16; ++j) { const unsigned c = xb_ld(&bar[XB_XCNT(j)]); sum += c; cnt += (c > 0u) ? 1u : 0u; mine = (j == x) ? c : mine; }
        if (sum == G) break;
        __builtin_amdgcn_s_sleep(1);
        if ((++sp & 255u) == 0u) { if (xb_ld(&bar[XB_TMO])) break; if (sp > XB_SPIN_CAP) { atomicAdd(&bar[XB_TMO], 1u); break; } }
    }
    nloc = mine > 0u ? mine : 1u; nx = cnt > 0u ? cnt : 1u;
}
DEVI void xcd_barrier(const XcdBarrier& b) {
    asm volatile("s_waitcnt vmcnt(0)" ::: "memory");
    __syncthreads();
    if (threadIdx.x == 0) {
        unsigned* bar = b.bar;
        __builtin_amdgcn_s_waitcnt(0);
        unsigned nloc = b.st[0], nx = b.st[1];
        if (nloc == 0u) { xcd_barrier_complete(bar, b.x, nloc, nx); b.st[0] = nloc; b.st[1] = nx; }
        const unsigned old = xb_add(&bar[XB_XSUB(b.x)], 1u);
        const unsigned gen = old / nloc;
        if (old + 1u == (gen + 1u) * nloc) {
            __builtin_amdgcn_fence(__ATOMIC_RELEASE, "agent");
            asm volatile("s_waitcnt vmcnt(0)" ::: "memory");
            const unsigned og = xb_add(&bar[XB_TOP], 1u);
            const unsigned tg = og / nx;
            if (og + 1u == (tg + 1u) * nx) xb_add(&bar[XB_TOPGEN], 1u);
            else XB_SPIN(xb_ld(&bar[XB_TOPGEN]) == tg, bar);
            __builtin_amdgcn_fence(__ATOMIC_ACQUIRE, "agent");
            xb_add(&bar[XB_XGEN(b.x)], 1u);
            asm volatile("s_waitcnt vmcnt(0)" ::: "memory");
        } else {
            XB_SPIN(xb_ld(&bar[XB_XGEN(b.x)]) == gen, bar);
            __builtin_amdgcn_fence(__ATOMIC_ACQUIRE, "agent");
            asm volatile("s_waitcnt vmcnt(0)" ::: "memory");
        }
    }
    __syncthreads();
}
constexpr size_t OFF_BAR = 131072;

#ifndef DBG
#define DBG 0
#endif
DEVI void dump_f32(const Params& p, size_t off) {
    const f32x4* src = (const f32x4*)(p.ws + off); f32x4* dst = (f32x4*)p.out;
    for (int i = blockIdx.x * 256 + threadIdx.x; i < T_ * D_ / 4; i += gridDim.x * 256) dst[i] = src[i];
}
DEVI void dump_bf16(const Params& p, size_t off, int ld, int coff) {
    const bf16_t* src = (const bf16_t*)(p.ws + off);
    for (int i = blockIdx.x * 256 + threadIdx.x; i < T_ * D_; i += gridDim.x * 256) { const int row = i >> 10, col = i & 1023; p.out[i] = bf2f(src[(size_t)row * ld + coff + col]); }
}
DEVI float flat_bf(const Params& p, size_t off, size_t n, size_t i) { const bf16_t* b = (const bf16_t*)(p.ws + off); float a = 0.f; for (size_t j = i; j < n; j += (size_t)T_ * D_) a += bf2f(b[j]); return a; }
DEVI void dump_p1(const Params& p) {
    const size_t N = (size_t)T_ * D_;
    for (size_t i = (size_t)blockIdx.x * 256 + threadIdx.x; i < N; i += (size_t)gridDim.x * 256) {
        float a = 0.f;
        a += flat_bf(p, OFF_MG, 2 * N, i) + flat_bf(p, OFF_GS, 2 * N, i);
        a += flat_bf(p, OFF_QR, N / 2, i % (N / 2)) + flat_bf(p, OFF_KR, N / 2, i % (N / 2)) + flat_bf(p, OFF_QG, N / 2, i % (N / 2));
        a += flat_bf(p, OFF_KRT, N / 2, i % (N / 2)) + flat_bf(p, OFF_KGT, N / 2, i % (N / 2));
        a += flat_bf(p, OFF_VRT, N, i) + flat_bf(p, OFF_VGT, N, i);
        a += ((const float*)(p.ws + OFF_GA))[i % ((size_t)T_ * 16)];
        p.out[i] = a;
    }
}
constexpr int NPHASE = 13;
__global__ void __launch_bounds__(512, 2) fwd_megakernel(Params p) {
    unsigned char* const smem_all = smem_all_g;
#define smem (smem_all_g + vh_fresh() * SMEM_HALF)
    uint4* xb_words = (uint4*)(smem_all + 2 * SMEM_HALF - 16);
    if (threadIdx.x == 0) *xb_words = make_uint4(0u, 0u, blockIdx.x, 0u);
    __syncthreads();
    const XcdBarrier xb = xcd_barrier_post((unsigned*)(p.ws + OFF_BAR), (volatile LAS unsigned*)xb_words);
#ifndef REPMASK
#define REPMASK 0
#endif
#ifndef TIMEPHASE
#define TIMEPHASE -1
#endif
#define RUN_PHASE(K, CALL) do { if (p.phase_lo <= (K) && (K) < p.phase_hi) { \
        const unsigned long long tp0_ = (TIMEPHASE == (K)) ? __builtin_amdgcn_s_memrealtime() : 0ull; \
        _Pragma("unroll 1") for (int rep_ = ((REPMASK >> (K)) & 1); rep_ >= 0; --rep_) { CALL; if (rep_ > 0 || (K) + 1 < p.phase_hi) xcd_barrier(xb); } \
        if (TIMEPHASE == (K)) { const unsigned long long tp1_ = __builtin_amdgcn_s_memrealtime(); while (__builtin_amdgcn_s_memrealtime() - tp1_ < tp1_ - tp0_) __builtin_amdgcn_s_sleep(8); } } } while (0)
    RUN_PHASE(0, phase0(p, smem));
    if (p.phase_lo == 0 && p.phase_hi > 1) {
        if (threadIdx.x == 0) {
            unsigned* bar = (unsigned*)(p.ws + OFF_BAR); bool ok = (gridDim.x & 7u) == 0u && xb.x < 8u;
            for (unsigned j = 0; j < 16; ++j) { const unsigned c = xb_ld(&bar[XB_XCNT(j)]); ok = ok && (j < 8 ? c == gridDim.x / 8u : c == 0u); }
            if (ok) ((volatile int*)xb_words)[2] = (int)(((volatile unsigned*)xb_words)[3] * 8u + xb.x);
        }
        __syncthreads();
    }
    RUN_PHASE(1, phase1(p, smem_all));
#if DBG == 2
    dump_p1(p); return;
#endif
    RUN_PHASE(2, phase2(p, smem));
#if DBG == 5
    { const size_t N = (size_t)T_ * D_; for (size_t i = (size_t)blockIdx.x * 256 + threadIdx.x; i < N; i += (size_t)gridDim.x * 256) p.out[i] = flat_bf(p, OFF_KG2, N / 2, i % (N / 2)) + ((const float*)(p.ws + OFF_DEC))[i % (2048 * 128)]; } return;
#endif
#ifdef SCANPROBE
    phase3t(p, smem, 1); xcd_barrier(xb);
#endif
    RUN_PHASE(3, phase3t(p, smem, 0));
#if DBG == 6
    dump_bf16(p, OFF_OO, 2048, 1024); return;
#endif
#if DBG == 7
    { const bf16_t* src = (const bf16_t*)(p.ws + OFF_OO);
      for (int i = blockIdx.x * 256 + threadIdx.x; i < T_ * D_; i += gridDim.x * 256) { const int row = i >> 10, col = i & 1023; const float v = bf2f(src[(size_t)row * 2048 + 1024 + col]); p.out[i] = (fabsf(v) < 1e30f) ? v : 12345.0f; } } return;
#endif
    RUN_PHASE(4, phase4(p, smem));
#if DBG == 3
    dump_bf16(p, OFF_Y, 2048, 0); return;
#endif
#if DBG == 4
    dump_bf16(p, OFF_Y, 2048, 1024); return;
#endif
    RUN_PHASE(5, phase5(p, smem_all));
    RUN_PHASE(6, phase6(p, smem_all));
    RUN_PHASE(7, (((RB >> 3) & 1) ? (phase8(p, smem_all), conv_expert_weights(p, smem)) : (conv_expert_weights(p, smem), phase8(p, smem_all))));
#if DBG == 1
    return;
#endif
    RUN_PHASE(10, phase10(p, smem_all));
    RUN_PHASE(11, phase11(p, smem_all));
    RUN_PHASE(12, phase12(p));
#ifdef BARPROBE
    _Pragma("unroll 1") for (int bp_ = 0; bp_ < 20; ++bp_) xcd_barrier(xb);
#endif
#undef RUN_PHASE
}

#undef smem
extern "C" void kernel_launch(void* const* d_in, const int* in_sizes, int n_in, void* d_out, int out_size, void* d_ws, size_t ws_size,
                              hipStream_t stream) {
    static int grid_blocks = 0;
    if (!grid_blocks) {
        int dev = 0, cus = 0, per_cu = 0;
        hipGetDevice(&dev);
        hipDeviceGetAttribute(&cus, hipDeviceAttributeMultiprocessorCount, dev);
        hipOccupancyMaxActiveBlocksPerMultiprocessor(&per_cu, fwd_megakernel, 512, 0);
        if (per_cu > 1) per_cu = 1;
        if (per_cu < 1) per_cu = 1;
        grid_blocks = cus * per_cu;
    }
    if (ws_size < WS_NEEDED) { fprintf(stderr, "workspace too small: %zu < %zu\n", ws_size, (size_t)WS_NEEDED); return; }
    Params p{};
    p.x = (const float*)d_in[0]; p.w_in = (const float*)d_in[1]; p.ret_norm_g = (const float*)d_in[2]; p.gate_w2 = (const float*)d_in[3];
    p.gate_b = (const float*)d_in[4]; p.gla_norm_g = (const float*)d_in[5]; p.w_ret_out = (const float*)d_in[6]; p.w_gla_out = (const float*)d_in[7];
    p.w_o = (const float*)d_in[8]; p.ln1_g = (const float*)d_in[9]; p.ln1_b = (const float*)d_in[10]; p.router_w = (const float*)d_in[11];
    p.router_bias = (const float*)d_in[12]; p.ew_gate = (const float*)d_in[13]; p.ew_up = (const float*)d_in[14]; p.ew_down = (const float*)d_in[15];
    p.sw_gate = (const float*)d_in[16]; p.sw_up = (const float*)d_in[17]; p.sw_down = (const float*)d_in[18]; p.ln2_g = (const float*)d_in[19];
    p.ln2_b = (const float*)d_in[20];
    p.out = (float*)d_out; p.ws = (unsigned char*)d_ws; p.phase_lo = 0; p.phase_hi = NPHASE;
    void* args[] = {&p};
    (void)hipMemsetAsync((unsigned char*)d_ws + OFF_BAR, 0, XCD_BAR_WORDS * 4, stream);
    hipError_t e = hipLaunchCooperativeKernel((void*)fwd_megakernel, dim3(grid_blocks), dim3(512), args, 0, stream);
    if (e != hipSuccess) fprintf(stderr, "cooperative launch failed: %s (grid %d)\n", hipGetErrorString(e), grid_blocks);
}
```
